# Optimizing an MI355X kernel written in HIP

```python
import math
import jax
import jax.numpy as jnp
from jax import lax
import numpy as np

D_MODEL = 1024
BATCH = 4
SEQ = 4096
DEPTH = 2

CTX_LEN = 256
GRID_W = 64
EPS = 1e-6

SSD_HEADS = 16
SSD_HEAD_DIM = 64
SSD_WIDTH = SSD_HEADS * SSD_HEAD_DIM
SSD_GROUPS = 2
SSD_STATE = 128
SSD_CONV = 5
SSD_CHUNK = 128
SSD_XBC = SSD_WIDTH + 2 * SSD_GROUPS * SSD_STATE
DT_MIN = 0.001
DT_MAX = 0.1

ATT_HEADS = 8
ATT_KV_HEADS = 2
ATT_HEAD_DIM = 64
ATT_WIDTH = ATT_HEADS * ATT_HEAD_DIM
ATT_KV_WIDTH = ATT_KV_HEADS * ATT_HEAD_DIM
WINDOW = 128
ATT_BLOCK = 128
ROPE_BASE = 10000.0

CONV_WIDTH = 512
CONV_KERNEL = 31

MIX_WIDTH = SSD_WIDTH + ATT_WIDTH + CONV_WIDTH
IN_SIZES = (SSD_XBC, SSD_WIDTH, 2 * SSD_HEADS, ATT_WIDTH, ATT_KV_WIDTH, ATT_KV_WIDTH, ATT_WIDTH, 2 * CONV_WIDTH, CONV_WIDTH)
IN_WIDTH = sum(IN_SIZES)

kernel_name = 'hybrid_ssd_swa_conformer_prefix_block'


def rmsnorm(x, w):
    xf = x.astype(jnp.float32)
    y = xf * lax.rsqrt(jnp.mean(xf * xf, axis=-1, keepdims=True) + EPS)
    return (y * w.astype(jnp.float32)).astype(x.dtype)


def group_rmsnorm(x, w, groups):
    shp = x.shape
    xf = x.astype(jnp.float32).reshape(shp[:-1] + (groups, shp[-1] // groups))
    xf = xf * lax.rsqrt(jnp.mean(xf * xf, axis=-1, keepdims=True) + EPS)
    return (xf.reshape(shp) * w.astype(jnp.float32)).astype(x.dtype)


def layernorm(x, w, b):
    xf = x.astype(jnp.float32)
    xc = xf - jnp.mean(xf, axis=-1, keepdims=True)
    var = jnp.mean(xc * xc, axis=-1, keepdims=True)
    return (xc * lax.rsqrt(var + EPS) * w.astype(jnp.float32) + b.astype(jnp.float32)).astype(x.dtype)


def split_cols(u):
    parts, off = [], 0
    for size in IN_SIZES:
        parts.append(u[..., off:off + size])
        off += size
    return parts


def dwconv_centred(x, w, b):
    k, ch = w.shape
    pad = (k - 1) // 2
    y = lax.conv_general_dilated(x, w[:, None, :].astype(x.dtype), window_strides=(1,), padding=[(pad, pad)],
                                 dimension_numbers=('NWC', 'WIO', 'NWC'), feature_group_count=ch)
    return y + b.astype(x.dtype)


def axial_rope_tables(n_tokens):
    rows = n_tokens // GRID_W
    row = jnp.repeat(jnp.arange(rows, dtype=jnp.float32), GRID_W)
    col = jnp.tile(jnp.arange(GRID_W, dtype=jnp.float32), rows)
    axis_dim = ATT_HEAD_DIM // 2
    inv_freq = ROPE_BASE ** (-jnp.arange(0, axis_dim, 2, dtype=jnp.float32) / axis_dim)
    ang = jnp.stack([row[:, None] * inv_freq, col[:, None] * inv_freq], axis=1)
    return jnp.cos(ang), jnp.sin(ang)


def apply_axial_rope(t, cos, sin):
    shp = t.shape
    tr = t.astype(jnp.float32).reshape(shp[:-1] + (2, 2, ATT_HEAD_DIM // 4))
    t1, t2 = tr[..., 0, :], tr[..., 1, :]
    cs, sn = cos[None, :, None], sin[None, :, None]
    out = jnp.stack([t1 * cs - t2 * sn, t2 * cs + t1 * sn], axis=-2)
    return out.reshape(shp).astype(t.dtype)


def ssd_chunked_scan(x, dt, a, b_in, c_in, init_state):
    bsz, n, nh, hp = x.shape
    ng, ns = b_in.shape[-2:]
    rep = nh // ng
    q = SSD_CHUNK
    nc = n // q
    f32 = jnp.float32
    xd = (x.astype(f32) * dt[..., None]).reshape(bsz, nc, q, ng, rep, hp)
    da = (dt * a).reshape(bsz, nc, q, ng, rep)
    bc = b_in.astype(f32).reshape(bsz, nc, q, ng, ns)
    cc = c_in.astype(f32).reshape(bsz, nc, q, ng, ns)
    cs = jnp.moveaxis(jnp.cumsum(da, axis=2), 2, -1)
    tril = jnp.tril(jnp.ones((q, q), dtype=bool))
    seg = cs[..., :, None] - cs[..., None, :]
    decay = jnp.exp(jnp.where(tril, seg, -jnp.inf))
    cb = jnp.einsum('bclgn,bcsgn->bcgls', cc, bc)
    y_diag = jnp.einsum('bcgrls,bcsgrp->bclgrp', cb[:, :, :, None] * decay, xd)
    decay_to_end = jnp.exp(cs[..., -1:] - cs)
    states = jnp.einsum('bclgn,bcgrl,bclgrp->bcgrpn', bc, decay_to_end, xd)
    chunk_decay = jnp.exp(cs[..., -1])

    def step(s, inp):
        st, dec = inp
        return s * dec[..., None, None] + st, s

    s0 = init_state.astype(f32).reshape(bsz, ng, rep, hp, ns)
    final, entering = lax.scan(step, s0, (jnp.moveaxis(states, 1, 0), jnp.moveaxis(chunk_decay, 1, 0)))
    entering = jnp.moveaxis(entering, 0, 1)
    y_off = jnp.einsum('bclgn,bcgrpn,bcgrl->bclgrp', cc, entering, jnp.exp(cs))
    y = (y_diag + y_off).reshape(bsz, n, nh, hp)
    return y, final.reshape(bsz, nh, hp, ns)


def ssd_bidirectional(xs, dt, bm, cm, a, init_f, init_b):
    y_f, fin_f = ssd_chunked_scan(xs, dt[:, :, 0], a[0], bm, cm, init_f)
    rev = lambda t: jnp.flip(t, axis=1)
    y_b, fin_b = ssd_chunked_scan(rev(xs), rev(dt[:, :, 1]), a[1], rev(bm), rev(cm), init_b)
    return y_f + rev(y_b), fin_f, fin_b


def window_attention(q, k, v, kc, vc, sink):
    bsz, seq = q.shape[:2]
    nb = seq // ATT_BLOCK
    rep = ATT_HEADS // ATT_KV_HEADS
    scale = ATT_HEAD_DIM ** -0.5
    n_ctx = kc.shape[1]
    qb = q.reshape(bsz, nb, ATT_BLOCK, ATT_KV_HEADS, rep, ATT_HEAD_DIM)

    def band(t):
        tp = jnp.pad(t, ((0, 0), (ATT_BLOCK, ATT_BLOCK), (0, 0), (0, 0)))
        tp = tp.reshape(bsz, nb + 2, ATT_BLOCK, ATT_KV_HEADS, ATT_HEAD_DIM)
        return jnp.concatenate([tp[:, :-2], tp[:, 1:-1], tp[:, 2:]], axis=2)

    kw, vw = band(k), band(v)
    s_win = jnp.einsum('bnqgrd,bnkgd->bngrqk', qb, kw).astype(jnp.float32) * scale
    qpos = jnp.arange(nb)[:, None] * ATT_BLOCK + jnp.arange(ATT_BLOCK)[None]
    kpos = jnp.arange(nb)[:, None] * ATT_BLOCK - ATT_BLOCK + jnp.arange(3 * ATT_BLOCK)[None]
    valid = ((jnp.abs(qpos[:, :, None] - kpos[:, None, :]) <= WINDOW)
             & (kpos[:, None, :] >= 0) & (kpos[:, None, :] < seq))
    s_win = jnp.where(valid[None, :, None, None], s_win, jnp.finfo(jnp.float32).min)
    s_ctx = jnp.einsum('bnqgrd,btgd->bngrqt', qb, kc).astype(jnp.float32) * scale
    sink_col = jnp.broadcast_to(sink.astype(jnp.float32).reshape(1, 1, ATT_KV_HEADS, rep, 1, 1), s_ctx.shape[:-1] + (1,))
    p = jax.nn.softmax(jnp.concatenate([sink_col, s_ctx, s_win], axis=-1), axis=-1).astype(v.dtype)
    out = (jnp.einsum('bngrqt,btgd->bnqgrd', p[..., 1:1 + n_ctx], vc)
           + jnp.einsum('bngrqk,bnkgd->bnqgrd', p[..., 1 + n_ctx:], vw))
    return out.reshape(bsz, seq, ATT_WIDTH)


def context_attention(qc, kc, vc, sink):
    bsz, n_ctx = qc.shape[:2]
    rep = ATT_HEADS // ATT_KV_HEADS
    qg = qc.reshape(bsz, n_ctx, ATT_KV_HEADS, rep, ATT_HEAD_DIM)
    s = jnp.einsum('bqgrd,btgd->bgrqt', qg, kc).astype(jnp.float32) * ATT_HEAD_DIM ** -0.5
    sink_col = jnp.broadcast_to(sink.astype(jnp.float32).reshape(1, ATT_KV_HEADS, rep, 1, 1), s.shape[:-1] + (1,))
    p = jax.nn.softmax(jnp.concatenate([sink_col, s], axis=-1), axis=-1).astype(vc.dtype)
    out = jnp.einsum('bgrqt,btgd->bqgrd', p[..., 1:], vc)
    return out.reshape(bsz, n_ctx, ATT_WIDTH)


def conformer_conv(u, dw_w, dw_b, ln_w, ln_b, pw_w, pw_b):
    val, gt = u[..., :CONV_WIDTH], u[..., CONV_WIDTH:]
    hdn = val * jax.nn.sigmoid(gt)
    hdn = dwconv_centred(hdn, dw_w, dw_b)
    hdn = jax.nn.silu(layernorm(hdn, ln_w, ln_b))
    return hdn @ pw_w + pw_b


def hybrid_layer(x, xc, c, c_ctx, w_mod, b_mod, norm_w, w_in, ssd_conv_w, ssd_conv_b, ssd_dt_bias, ssd_a_log,
                 ssd_d, ssd_norm_w, attn_sink, conv_dw_w, conv_dw_b, conv_ln_w, conv_ln_b, conv_pw_w, conv_pw_b,
                 w_out, update_ctx):
    bsz, seq = x.shape[:2]
    n_ctx = xc.shape[1]
    f32 = jnp.float32
    shift, scale, gate = jnp.split((jax.nn.silu(c) @ w_mod + b_mod)[:, None, :], 3, axis=-1)
    shift_c, scale_c, gate_c = jnp.split(jax.nn.silu(c_ctx) @ w_mod + b_mod, 3, axis=-1)
    h = rmsnorm(x, norm_w) * (1 + scale) + shift
    hc = rmsnorm(xc, norm_w) * (1 + scale_c) + shift_c
    p_lat = split_cols(h @ w_in)
    p_ctx = split_cols(hc @ w_in)

    a = -jnp.exp(ssd_a_log.astype(f32))

    def ssd_inputs(xbc, dt_raw):
        xbc = jax.nn.silu(dwconv_centred(xbc, ssd_conv_w, ssd_conv_b))
        n = xbc.shape[1]
        gn = SSD_GROUPS * SSD_STATE
        xs = xbc[..., :SSD_WIDTH].reshape(bsz, n, SSD_HEADS, SSD_HEAD_DIM)
        bm = xbc[..., SSD_WIDTH:SSD_WIDTH + gn].reshape(bsz, n, SSD_GROUPS, SSD_STATE)
        cm = xbc[..., SSD_WIDTH + gn:].reshape(bsz, n, SSD_GROUPS, SSD_STATE)
        dt = jax.nn.softplus(dt_raw.astype(f32).reshape(bsz, n, 2, SSD_HEADS) + ssd_dt_bias.astype(f32))
        return xs, dt, bm, cm

    def ssd_out(y, xs, z):
        n = xs.shape[1]
        y = y + ssd_d.astype(f32)[:, None] * xs.astype(f32)
        y = y.reshape(bsz, n, SSD_WIDTH).astype(z.dtype)
        return group_rmsnorm(y * jax.nn.silu(z), ssd_norm_w, SSD_GROUPS)

    zero = jnp.zeros((bsz, SSD_HEADS, SSD_HEAD_DIM, SSD_STATE), f32)
    xs_c, dt_c, bm_c, cm_c = ssd_inputs(p_ctx[0], p_ctx[2])
    y_c, fin_f, fin_b = ssd_bidirectional(xs_c, dt_c, bm_c, cm_c, a, zero, zero)
    xs_l, dt_l, bm_l, cm_l = ssd_inputs(p_lat[0], p_lat[2])
    y_l, _, _ = ssd_bidirectional(xs_l, dt_l, bm_l, cm_l, a, fin_f, fin_b)
    o_ssd = ssd_out(y_l, xs_l, p_lat[1])

    cos, sin = axial_rope_tables(seq)
    q = apply_axial_rope(p_lat[3].reshape(bsz, seq, ATT_HEADS, ATT_HEAD_DIM), cos, sin)
    k = apply_axial_rope(p_lat[4].reshape(bsz, seq, ATT_KV_HEADS, ATT_HEAD_DIM), cos, sin)
    v = p_lat[5].reshape(bsz, seq, ATT_KV_HEADS, ATT_HEAD_DIM)
    kc = p_ctx[4].reshape(bsz, n_ctx, ATT_KV_HEADS, ATT_HEAD_DIM)
    vc = p_ctx[5].reshape(bsz, n_ctx, ATT_KV_HEADS, ATT_HEAD_DIM)
    o_att = window_attention(q, k, v, kc, vc, attn_sink) * jax.nn.silu(p_lat[6])

    o_conv = conformer_conv(p_lat[7], conv_dw_w, conv_dw_b, conv_ln_w, conv_ln_b, conv_pw_w, conv_pw_b) * jax.nn.silu(p_lat[8])

    x = x + gate * (jnp.concatenate([o_ssd, o_att, o_conv], axis=-1) @ w_out)

    if update_ctx:
        qc = p_ctx[3].reshape(bsz, n_ctx, ATT_HEADS, ATT_HEAD_DIM)
        o_ssd_c = ssd_out(y_c, xs_c, p_ctx[1])
        o_att_c = context_attention(qc, kc, vc, attn_sink) * jax.nn.silu(p_ctx[6])
        o_conv_c = conformer_conv(p_ctx[7], conv_dw_w, conv_dw_b, conv_ln_w, conv_ln_b, conv_pw_w, conv_pw_b) * jax.nn.silu(p_ctx[8])
        xc = xc + gate_c * (jnp.concatenate([o_ssd_c, o_att_c, o_conv_c], axis=-1) @ w_out)
    return x, xc


def setup_inputs(seed: int = 0) -> dict:
    key = jax.random.key(seed)
    ks = jax.random.split(key, 24)
    f32 = jnp.float32

    def nrm(k, shape, s):
        return jax.random.normal(k, shape, f32) * s

    u = jax.random.uniform(ks[10], (DEPTH, 2, SSD_HEADS), f32)
    dt0 = jnp.exp(u * (math.log(DT_MAX) - math.log(DT_MIN)) + math.log(DT_MIN))
    return {
        'x': nrm(ks[0], (BATCH, SEQ, D_MODEL), 1.0),
        'c': nrm(ks[1], (BATCH, D_MODEL), 1.0),
        'ctx': nrm(ks[2], (BATCH, CTX_LEN, D_MODEL), 1.0),
        'c_ctx': nrm(ks[3], (D_MODEL,), 1.0),
        'w_mod': nrm(ks[4], (DEPTH, D_MODEL, 3 * D_MODEL), 0.5 * D_MODEL ** -0.5),
        'b_mod': nrm(ks[5], (DEPTH, 3 * D_MODEL), 0.02),
        'norm_w': 1.0 + nrm(ks[6], (DEPTH, D_MODEL), 0.02),
        'w_in': nrm(ks[7], (DEPTH, D_MODEL, IN_WIDTH), D_MODEL ** -0.5),
        'ssd_conv_w': nrm(ks[8], (DEPTH, SSD_CONV, SSD_XBC), SSD_CONV ** -0.5),
        'ssd_conv_b': nrm(ks[9], (DEPTH, SSD_XBC), 0.02),
        'ssd_dt_bias': dt0 + jnp.log(-jnp.expm1(-dt0)),
        'ssd_a_log': jnp.log(jax.random.uniform(ks[11], (DEPTH, 2, SSD_HEADS), f32, 1.0, 16.0)),
        'ssd_d': 1.0 + nrm(ks[12], (DEPTH, SSD_HEADS), 0.1),
        'ssd_norm_w': 1.0 + nrm(ks[13], (DEPTH, SSD_WIDTH), 0.02),
        'attn_sink': nrm(ks[14], (DEPTH, ATT_HEADS), 0.5),
        'conv_dw_w': nrm(ks[15], (DEPTH, CONV_KERNEL, CONV_WIDTH), CONV_KERNEL ** -0.5),
        'conv_dw_b': nrm(ks[16], (DEPTH, CONV_WIDTH), 0.02),
        'conv_ln_w': 1.0 + nrm(ks[17], (DEPTH, CONV_WIDTH), 0.02),
        'conv_ln_b': nrm(ks[18], (DEPTH, CONV_WIDTH), 0.02),
        'conv_pw_w': nrm(ks[19], (DEPTH, CONV_WIDTH, CONV_WIDTH), CONV_WIDTH ** -0.5),
        'conv_pw_b': nrm(ks[20], (DEPTH, CONV_WIDTH), 0.02),
        'w_out': nrm(ks[21], (DEPTH, MIX_WIDTH, D_MODEL), MIX_WIDTH ** -0.5),
        'final_norm_w': 1.0 + nrm(ks[22], (D_MODEL,), 0.02),
    }


def reference(x, c, ctx, c_ctx, w_mod, b_mod, norm_w, w_in, ssd_conv_w, ssd_conv_b, ssd_dt_bias, ssd_a_log,
              ssd_d, ssd_norm_w, attn_sink, conv_dw_w, conv_dw_b, conv_ln_w, conv_ln_b, conv_pw_w, conv_pw_b,
              w_out, final_norm_w):
    xc = ctx
    for l in range(DEPTH):
        x, xc = hybrid_layer(x, xc, c, c_ctx, w_mod[l], b_mod[l], norm_w[l], w_in[l], ssd_conv_w[l], ssd_conv_b[l],
                             ssd_dt_bias[l], ssd_a_log[l], ssd_d[l], ssd_norm_w[l], attn_sink[l], conv_dw_w[l],
                             conv_dw_b[l], conv_ln_w[l], conv_ln_b[l], conv_pw_w[l], conv_pw_b[l], w_out[l],
                             l < DEPTH - 1)
    return rmsnorm(x, final_norm_w)
```

```cpp
#include <hip/hip_runtime.h>
#include <hip/hip_cooperative_groups.h>
#include <stdint.h>
#include <stdio.h>
namespace cg = cooperative_groups;

#ifndef ONE_LAUNCH
#define ONE_LAUNCH 1
#endif

#define DI __device__ __forceinline__
typedef unsigned short bf16_t;
using bf16x8 = __attribute__((ext_vector_type(8))) short;
using s16x4 = __attribute__((ext_vector_type(4))) short;
using f32x16 = __attribute__((ext_vector_type(16))) float;
#define MFMA(a, b, c) __builtin_amdgcn_mfma_f32_32x32x16_bf16((a), (b), (c), 0, 0, 0)

constexpr int R_ = 17408;
constexpr int RL_ = 16384;
constexpr int NCK = 136;

constexpr size_t SZ_WIN = (size_t)5504 * 1024 * 2;
constexpr size_t SZ_WOUT = (size_t)1024 * 2048 * 2;
constexpr size_t SZ_PW = (size_t)512 * 512 * 2;
constexpr size_t SZ_MODS = (size_t)2 * 5 * 3072 * 4;
constexpr size_t SZ_XC = (size_t)1024 * 1024 * 4;
constexpr size_t SZ_RSTD = (size_t)R_ * 2 * 4;
constexpr size_t SZ_CDEC = (size_t)NCK * 32 * 4 + 256 - ((size_t)NCK * 32 * 4) % 256;
constexpr size_t SZ_R512 = (size_t)R_ * 512 * 2;
constexpr size_t OFF_WIN = 0;
constexpr size_t OFF_WOUT = OFF_WIN + SZ_WIN;
constexpr size_t OFF_PW = OFF_WOUT + SZ_WOUT;
constexpr size_t OFF_MODS = OFF_PW + SZ_PW;
constexpr size_t OFF_XC = OFF_MODS + SZ_MODS;
constexpr size_t OFF_RSTD = OFF_XC + SZ_XC;
constexpr size_t OFF_CDEC = OFF_RSTD + SZ_RSTD;
constexpr size_t OFF_H = OFF_CDEC + SZ_CDEC;
constexpr size_t OFF_XBC = OFF_H + 2 * SZ_R512;
constexpr size_t OFF_GLU = OFF_XBC + 3 * SZ_R512;
constexpr size_t OFF_ST = OFF_XBC;
constexpr size_t OFF_Z = OFF_GLU + SZ_R512;
constexpr size_t OFF_DT = OFF_Z + 2 * SZ_R512;
constexpr size_t OFF_CS = OFF_DT + (size_t)R_ * 32 * 4;
constexpr size_t OFF_Q = OFF_CS + (size_t)R_ * 32 * 4;
constexpr size_t OFF_KV = OFF_Q + SZ_R512;
constexpr size_t OFF_AG = OFF_KV + SZ_R512 / 2;
constexpr size_t OFF_CG = OFF_AG + SZ_R512;
constexpr size_t OFF_BC = OFF_CG + SZ_R512;
constexpr size_t OFF_HDN = OFF_BC + SZ_R512;
constexpr size_t WS_TOTAL = OFF_HDN + SZ_R512;
static_assert(WS_TOTAL <= (size_t)256 * 1024 * 1024, "workspace too large");

struct Params {
  const float *x, *c, *ctx, *c_ctx, *w_mod, *b_mod, *norm_w, *w_in, *ssd_conv_w, *ssd_conv_b, *ssd_dt_bias, *ssd_a_log,
      *ssd_d, *ssd_norm_w, *attn_sink, *conv_dw_w, *conv_dw_b, *conv_ln_w, *conv_ln_b, *conv_pw_w, *conv_pw_b, *w_out,
      *final_norm_w;
  float* out;
  char* ws;
};

DI unsigned short f2bf(float x) { unsigned u = __float_as_uint(x); u += 0x7fffu + ((u >> 16) & 1u); return (unsigned short)(u >> 16); }
DI float bf2f(unsigned short b) { return __uint_as_float(((unsigned)b) << 16); }
DI unsigned pack2(float a, float b) { return (unsigned)f2bf(a) | ((unsigned)f2bf(b) << 16); }
DI float lo2f(unsigned u) { return __uint_as_float(u << 16); }
DI float hi2f(unsigned u) { return __uint_as_float(u & 0xffff0000u); }
DI float silu_f(float x) { return x / (1.f + __expf(-x)); }
DI float sigmoid_f(float x) { return 1.f / (1.f + __expf(-x)); }
DI int crow(int reg, int h) { return (reg & 3) + 8 * (reg >> 2) + 4 * h; }

DI bf16x8 tr_frag(const bf16_t* s, int ld, int row_lo, int row_hi, int col0) {
  const int lane = threadIdx.x & 63;
  const int i16 = lane & 15, q = i16 >> 2, pp = i16 & 3, blk = (lane >> 4) & 1;
  const unsigned a0 = (unsigned)(size_t)(s + (row_lo + q) * ld + col0 + 16 * blk + 4 * pp);
  const unsigned a1 = (unsigned)(size_t)(s + (row_hi + q) * ld + col0 + 16 * blk + 4 * pp);
  s16x4 lo, hi;
  asm volatile("ds_read_b64_tr_b16 %0, %2\n\tds_read_b64_tr_b16 %1, %3\n\ts_waitcnt lgkmcnt(0)"
               : "=&v"(lo), "=&v"(hi) : "v"(a0), "v"(a1) : "memory");
  return __builtin_shufflevector(lo, hi, 0, 1, 2, 3, 4, 5, 6, 7);
}

struct GemmS { bf16_t a[2][128][40]; bf16_t b[2][128][40]; };

template <class AF, class BF>
DI void gemm_core(f32x16 (&acc)[2][2], GemmS* s, AF aptr, BF bptr, int nk) {
  const int tid = threadIdx.x, lane = tid & 63, wave = tid >> 6, wr = wave >> 1, wc = wave & 1;
  const int r0 = tid >> 2, kv = tid & 3;
  const int fr = lane & 31, fh = lane >> 5;
  uint4 ra0 = *(const uint4*)aptr(0, r0, kv), ra1 = *(const uint4*)aptr(0, r0 + 64, kv);
  uint4 rb0 = *(const uint4*)bptr(0, r0, kv), rb1 = *(const uint4*)bptr(0, r0 + 64, kv);
  *(uint4*)&s->a[0][r0][kv * 8] = ra0; *(uint4*)&s->a[0][r0 + 64][kv * 8] = ra1;
  *(uint4*)&s->b[0][r0][kv * 8] = rb0; *(uint4*)&s->b[0][r0 + 64][kv * 8] = rb1;
  __syncthreads();
#pragma unroll 1
  for (int kt = 0; kt < nk; ++kt) {
    const int buf = kt & 1;
    if (kt + 1 < nk) {
      ra0 = *(const uint4*)aptr(kt + 1, r0, kv); ra1 = *(const uint4*)aptr(kt + 1, r0 + 64, kv);
      rb0 = *(const uint4*)bptr(kt + 1, r0, kv); rb1 = *(const uint4*)bptr(kt + 1, r0 + 64, kv);
    }
#pragma unroll
    for (int ks = 0; ks < 2; ++ks) {
      bf16x8 af[2], bq[2];
#pragma unroll
      for (int i = 0; i < 2; ++i) af[i] = *(const bf16x8*)&s->a[buf][wr * 64 + i * 32 + fr][ks * 16 + fh * 8];
#pragma unroll
      for (int j = 0; j < 2; ++j) bq[j] = *(const bf16x8*)&s->b[buf][wc * 64 + j * 32 + fr][ks * 16 + fh * 8];
#pragma unroll
      for (int i = 0; i < 2; ++i)
#pragma unroll
        for (int j = 0; j < 2; ++j) acc[i][j] = MFMA(af[i], bq[j], acc[i][j]);
    }
    if (kt + 1 < nk) {
      *(uint4*)&s->a[buf ^ 1][r0][kv * 8] = ra0; *(uint4*)&s->a[buf ^ 1][r0 + 64][kv * 8] = ra1;
      *(uint4*)&s->b[buf ^ 1][r0][kv * 8] = rb0; *(uint4*)&s->b[buf ^ 1][r0 + 64][kv * 8] = rb1;
    }
    __syncthreads();
  }
}

DI void zero_acc(f32x16 (&acc)[2][2]) {
#pragma unroll
  for (int i = 0; i < 2; ++i)
#pragma unroll
    for (int j = 0; j < 2; ++j)
#pragma unroll
      for (int r = 0; r < 16; ++r) acc[i][j][r] = 0.f;
}

template <class EPI>
DI void epilogue_lds(f32x16 (&acc)[2][2], char* smem, EPI epi) {
  float* T = (float*)smem;
  const int tid = threadIdx.x, lane = tid & 63, wave = tid >> 6, wr = wave >> 1, wc = wave & 1, fr = lane & 31, fh = lane >> 5;
#pragma unroll
  for (int i = 0; i < 2; ++i) {
#pragma unroll
    for (int j = 0; j < 2; ++j)
#pragma unroll
      for (int r = 0; r < 16; ++r) T[(wr * 32 + crow(r, fh)) * 132 + wc * 64 + j * 32 + fr] = acc[i][j][r];
    __syncthreads();
#pragma unroll 2
    for (int e = tid; e < 2048; e += 256) {
      const int tr = e >> 5, c4 = (e & 31) * 4;
      const float4 v = *(const float4*)&T[tr * 132 + c4];
      epi((tr >> 5) * 64 + i * 32 + (tr & 31), c4, v);
    }
    __syncthreads();
  }
}

DI void phase_mods(const Params& p_in, char* smem) {
  Params p = p_in;
  asm volatile("" : "+s"(p.ws));

  float* ssc = (float*)smem;
  float* red = (float*)(smem + 20480);
  float* mods = (float*)(p.ws + OFF_MODS);
  const int tid = threadIdx.x;
  for (int it = blockIdx.x; it < 96; it += gridDim.x) {
    const int l = it / 48, col0 = (it % 48) * 64;
    __syncthreads();
    for (int e = tid; e < 5120; e += 256) {
      const int v = e >> 10, k = e & 1023;
      const float cv = (v < 4) ? p.c[v * 1024 + k] : p.c_ctx[k];
      ssc[e] = silu_f(cv);
    }
    __syncthreads();
    const int col = tid & 63, kg = tid >> 6;
    float a[5] = {0.f, 0.f, 0.f, 0.f, 0.f};
    const float* w = p.w_mod + (size_t)l * 1024 * 3072 + col0 + col;
    for (int k = kg * 256; k < kg * 256 + 256; ++k) {
      const float wv = w[(size_t)k * 3072];
#pragma unroll
      for (int v = 0; v < 5; ++v) a[v] += ssc[v * 1024 + k] * wv;
    }
#pragma unroll
    for (int v = 0; v < 5; ++v) red[(kg * 5 + v) * 64 + col] = a[v];
    __syncthreads();
    for (int e = tid; e < 320; e += 256) {
      const int v = e >> 6, cc = e & 63;
      float sum = p.b_mod[l * 3072 + col0 + cc];
      for (int g = 0; g < 4; ++g) sum += red[(g * 5 + v) * 64 + cc];
      mods[(l * 5 + v) * 3072 + col0 + cc] = sum;
    }
  }
}

DI int win_colmap(int n) {
  if (n < 2560) return n;
  if (n < 3840) return n + 32;
  if (n < 4864) {
    const int j = n - 3840, q64 = j >> 6, w = j & 63;
    return (w < 32) ? (3872 + q64 * 32 + w) : (3872 + 512 + q64 * 32 + (w - 32));
  }
  if (n < 5376) return n + 32;
  if (n < 5408) return n - 5376 + 2560;
  return -1;
}

DI void transpose_tile(const float* src, int ldsrc, int kind, const float* rowscale, bf16_t* dst, int lddst, int n0, int k0, float* tile) {
  const int tid = threadIdx.x, tx = tid & 63, ty = tid >> 6;
  __syncthreads();
  const int n = (kind == 0) ? win_colmap(n0 + tx) : (n0 + tx);
  for (int r = ty; r < 64; r += 4) {
    const int k = k0 + r;
    float v = 0.f;
    if (n >= 0) v = src[(size_t)k * ldsrc + n];
    if (rowscale != nullptr && k < 1024) v *= rowscale[k];
    tile[r * 65 + tx] = v;
  }
  __syncthreads();
  for (int r = ty; r < 64; r += 4) dst[(size_t)(n0 + r) * lddst + k0 + tx] = f2bf(tile[tx * 65 + r]);
}

DI void phase_prep(const Params& p_in, int l, char* smem) {
  Params p = p_in;
  asm volatile("" : "+s"(p.ws));

  const int tid = threadIdx.x, lane = tid & 63, wave = tid >> 6;
  const float* mods = (const float*)(p.ws + OFF_MODS);
  bf16_t* H = (bf16_t*)(p.ws + OFF_H);
  const int NT_WIN = 86 * 16, NT_WOUT = 16 * 32, NT_PW = 64, NT_CONV = NT_WIN + NT_WOUT + NT_PW;
  const int NT = NT_CONV + R_ / 4;
  for (int it = blockIdx.x; it < NT; it += gridDim.x) {
    if (it < NT_WIN) {
      transpose_tile(p.w_in + (size_t)l * 1024 * 5408, 5408, 0, nullptr, (bf16_t*)(p.ws + OFF_WIN), 1024, (it / 16) * 64, (it % 16) * 64, (float*)smem);
    } else if (it < NT_WIN + NT_WOUT) {
      const int t = it - NT_WIN;
      transpose_tile(p.w_out + (size_t)l * 2048 * 1024, 1024, 1, p.ssd_norm_w + l * 1024, (bf16_t*)(p.ws + OFF_WOUT), 2048, (t / 32) * 64, (t % 32) * 64, (float*)smem);
    } else if (it < NT_CONV) {
      const int t = it - NT_WIN - NT_WOUT;
      transpose_tile(p.conv_pw_w + (size_t)l * 512 * 512, 512, 1, nullptr, (bf16_t*)(p.ws + OFF_PW), 512, (t / 8) * 64, (t % 8) * 64, (float*)smem);
    } else {
      const int rho = (it - NT_CONV) * 4 + wave;
      const float* xs;
      if (l == 0) xs = (rho < RL_) ? (p.x + (size_t)rho * 1024) : (p.ctx + (size_t)(rho - RL_) * 1024);
      else xs = (rho < RL_) ? (p.out + (size_t)rho * 1024) : ((const float*)(p.ws + OFF_XC) + (size_t)(rho - RL_) * 1024);
      const int v = (rho < RL_) ? (rho >> 12) : 4;
      const float* md = mods + (l * 5 + v) * 3072;
      float4 xv[4];
      float ss = 0.f;
#pragma unroll
      for (int i = 0; i < 4; ++i) {
        xv[i] = *(const float4*)(xs + lane * 4 + i * 256);
        ss += xv[i].x * xv[i].x + xv[i].y * xv[i].y + xv[i].z * xv[i].z + xv[i].w * xv[i].w;
      }
#pragma unroll
      for (int o = 32; o >= 1; o >>= 1) ss += __shfl_xor(ss, o);
      const float rs = rsqrtf(ss * (1.f / 1024.f) + 1e-6f);
#pragma unroll
      for (int i = 0; i < 4; ++i) {
        const int cidx = lane * 4 + i * 256;
        const float4 nw = *(const float4*)(p.norm_w + l * 1024 + cidx);
        const float4 sh = *(const float4*)(md + cidx);
        const float4 sc = *(const float4*)(md + 1024 + cidx);
        uint2 o;
        o.x = pack2(xv[i].x * rs * nw.x * (1.f + sc.x) + sh.x, xv[i].y * rs * nw.y * (1.f + sc.y) + sh.y);
        o.y = pack2(xv[i].z * rs * nw.z * (1.f + sc.z) + sh.z, xv[i].w * rs * nw.w * (1.f + sc.w) + sh.w);
        *(uint2*)(H + (size_t)rho * 1024 + cidx) = o;
      }
    }
  }
}

DI void phase_inproj(const Params& p_in, char* smem) {
  Params p = p_in;
  asm volatile("" : "+s"(p.ws));

  GemmS* s = (GemmS*)smem;
  const int tid = threadIdx.x, lane = tid & 63, wave = tid >> 6, wr = wave >> 1, wc = wave & 1, fr = lane & 31, fh = lane >> 5;
  const bf16_t* H = (const bf16_t*)(p.ws + OFF_H);
  const bf16_t* W = (const bf16_t*)(p.ws + OFF_WIN);
  for (int it = blockIdx.x; it < NCK * 43; it += gridDim.x) {
    const int mt = it / 43, nt = it % 43;
    f32x16 acc[2][2];
    zero_acc(acc);
    const bf16_t* Ab = H + (size_t)mt * 128 * 1024;
    const bf16_t* Bb = W + (size_t)nt * 128 * 1024;
    gemm_core(acc, s,
              [&](int kt, int r, int kv) { return Ab + (size_t)r * 1024 + kt * 32 + kv * 8; },
              [&](int kt, int r, int kv) { return Bb + (size_t)r * 1024 + kt * 32 + kv * 8; }, 32);
    const int row0 = mt * 128;
    if (nt >= 30 && nt < 38) {
#pragma unroll
      for (int i = 0; i < 2; ++i)
#pragma unroll
        for (int r = 0; r < 16; ++r) acc[i][0][r] = acc[i][0][r] * sigmoid_f(acc[i][1][r]);
      bf16_t* G = (bf16_t*)(p.ws + OFF_GLU);
      const int cb0 = (nt - 30) * 64;
      epilogue_lds(acc, smem, [&](int rl, int c4, float4 v) {
        if ((c4 & 32) == 0) {
          uint2 o; o.x = pack2(v.x, v.y); o.y = pack2(v.z, v.w);
          *(uint2*)(G + (size_t)(row0 + rl) * 512 + cb0 + (c4 >> 6) * 32 + (c4 & 31)) = o;
        }
      });
    } else if (nt == 42) {
      float* DT = (float*)(p.ws + OFF_DT);
      epilogue_lds(acc, smem, [&](int rl, int c4, float4 v) {
        if (c4 < 32) *(float4*)(DT + (size_t)(row0 + rl) * 32 + c4) = v;
      });
    } else {
      bf16_t* dst; int ld, cb;
      if (nt < 12) { dst = (bf16_t*)(p.ws + OFF_XBC); ld = 1536; cb = nt * 128; }
      else if (nt < 20) { dst = (bf16_t*)(p.ws + OFF_Z); ld = 1024; cb = nt * 128 - 1536; }
      else if (nt < 24) { dst = (bf16_t*)(p.ws + OFF_Q); ld = 512; cb = nt * 128 - 2560; }
      else if (nt < 26) { dst = (bf16_t*)(p.ws + OFF_KV); ld = 256; cb = nt * 128 - 3072; }
      else if (nt < 30) { dst = (bf16_t*)(p.ws + OFF_AG); ld = 512; cb = nt * 128 - 3328; }
      else { dst = (bf16_t*)(p.ws + OFF_CG); ld = 512; cb = nt * 128 - 4864; }
      epilogue_lds(acc, smem, [&](int rl, int c4, float4 v) {
        uint2 o; o.x = pack2(v.x, v.y); o.y = pack2(v.z, v.w);
        *(uint2*)(dst + (size_t)(row0 + rl) * ld + cb + c4) = o;
      });
    }
  }
}

DI void phase_local(const Params& p_in, int l, char* smem) {
  Params p = p_in;
  asm volatile("" : "+s"(p.ws));

  const int tid = threadIdx.x, lane = tid & 63;
  const bf16_t* XBC = (const bf16_t*)(p.ws + OFF_XBC);
  bf16_t* XS = (bf16_t*)(p.ws + OFF_H);
  bf16_t* BC = (bf16_t*)(p.ws + OFF_BC);
  float* DT = (float*)(p.ws + OFF_DT);
  float* CS = (float*)(p.ws + OFF_CS);
  const bf16_t* GLU = (const bf16_t*)(p.ws + OFF_GLU);
  bf16_t* HDN = (bf16_t*)(p.ws + OFF_HDN);
  bf16_t* Q = (bf16_t*)(p.ws + OFF_Q);
  bf16_t* KV = (bf16_t*)(p.ws + OFF_KV);
  const int N_CONV = R_ * 192 / 256;
  const int N_DT = NCK;
  const int N_CF = R_ / 16;
  const int N_ROPE = RL_ * 320 / 256;
  const int N_QC = 1024 * 256 / 256;
  const int NT = N_CF + N_DT + N_CONV + N_ROPE + N_QC;
  for (int it0 = blockIdx.x; it0 < NT; it0 += gridDim.x) {
    int it = it0;
    if (it < N_CF) {
      float* sv = (float*)smem;
      float* sst = (float*)(smem + 32768);
      const int row0 = it * 16;
      const int seq0 = (row0 < RL_) ? (row0 & ~4095) : (RL_ + ((row0 - RL_) & ~255));
      const int slen = (row0 < RL_) ? 4096 : 256;
      const int c0 = tid * 2;
      __syncthreads();
      if (tid < 32) sst[tid] = 0.f;
      float w0[31], w1[31];
#pragma unroll
      for (int k = 0; k < 31; ++k) {
        const float2 wv = *(const float2*)(p.conv_dw_w + ((size_t)l * 31 + k) * 512 + c0);
        w0[k] = wv.x; w1[k] = wv.y;
      }
      const float2 bv = *(const float2*)(p.conv_dw_b + l * 512 + c0);
      __syncthreads();
#pragma unroll 1
      for (int r = 0; r < 16; ++r) {
        const int t = row0 + r - seq0;
        float a0 = bv.x, a1 = bv.y;
#pragma unroll
        for (int k = 0; k < 31; ++k) {
          const int tt = t + k - 15;
          if (tt >= 0 && tt < slen) {
            const unsigned u = *(const unsigned*)(GLU + (size_t)(seq0 + tt) * 512 + c0);
            a0 += w0[k] * lo2f(u); a1 += w1[k] * hi2f(u);
          }
        }
        sv[r * 512 + c0] = a0; sv[r * 512 + c0 + 1] = a1;
        float s1 = a0 + a1, s2 = a0 * a0 + a1 * a1;
#pragma unroll
        for (int o = 32; o >= 1; o >>= 1) { s1 += __shfl_xor(s1, o); s2 += __shfl_xor(s2, o); }
        if (lane == 0) { atomicAdd(&sst[r * 2], s1); atomicAdd(&sst[r * 2 + 1], s2); }
      }
      __syncthreads();
      const float2 lw = *(const float2*)(p.conv_ln_w + l * 512 + c0);
      const float2 lb = *(const float2*)(p.conv_ln_b + l * 512 + c0);
#pragma unroll 1
      for (int r = 0; r < 16; ++r) {
        const float mean = sst[r * 2] * (1.f / 512.f);
        const float var = fmaxf(sst[r * 2 + 1] * (1.f / 512.f) - mean * mean, 0.f);
        const float rs = rsqrtf(var + 1e-6f);
        const float y0 = (sv[r * 512 + c0] - mean) * rs * lw.x + lb.x;
        const float y1 = (sv[r * 512 + c0 + 1] - mean) * rs * lw.y + lb.y;
        *(unsigned*)(HDN + (size_t)(row0 + r) * 512 + c0) = pack2(silu_f(y0), silu_f(y1));
      }
      continue;
    }
    it -= N_CF;
    if (it < N_DT) {
      float* sdt = (float*)smem;
      const int row0 = it * 128;
      __syncthreads();
      for (int e = tid; e < 4096; e += 256) {
        const int r = e >> 5, cidx = e & 31;
        const float raw = DT[(size_t)(row0 + r) * 32 + cidx] + p.ssd_dt_bias[l * 32 + cidx];
        const float sp = (raw > 20.f) ? raw : log1pf(expf(raw));
        DT[(size_t)(row0 + r) * 32 + cidx] = sp;
        sdt[r * 33 + cidx] = sp;
      }
      __syncthreads();
      if (tid < 32) {
        const float a = -expf(p.ssd_a_log[l * 32 + tid]);
        float run = 0.f;
        if (tid < 16) {
          for (int r = 0; r < 128; ++r) { run += sdt[r * 33 + tid] * a; CS[(size_t)(row0 + r) * 32 + tid] = run; }
        } else {
          for (int r = 127; r >= 0; --r) { run += sdt[r * 33 + tid] * a; CS[(size_t)(row0 + r) * 32 + tid] = run; }
        }
      }
      continue;
    }
    it -= N_DT;
    if (it < N_CONV) {
      const int e = it * 256 + tid;
      const int rho = e / 192, cgp = e % 192, ch0 = cgp * 8;
      const int seq0 = (rho < RL_) ? (rho & ~4095) : (RL_ + ((rho - RL_) & ~255));
      const int slen = (rho < RL_) ? 4096 : 256;
      const int t = rho - seq0;
      float a[8];
      {
        const float4 b0 = *(const float4*)(p.ssd_conv_b + l * 1536 + ch0);
        const float4 b1 = *(const float4*)(p.ssd_conv_b + l * 1536 + ch0 + 4);
        a[0] = b0.x; a[1] = b0.y; a[2] = b0.z; a[3] = b0.w; a[4] = b1.x; a[5] = b1.y; a[6] = b1.z; a[7] = b1.w;
      }
#pragma unroll
      for (int k = 0; k < 5; ++k) {
        const int tt = t + k - 2;
        if (tt >= 0 && tt < slen) {
          const uint4 u = *(const uint4*)(XBC + (size_t)(seq0 + tt) * 1536 + ch0);
          const float4 w0 = *(const float4*)(p.ssd_conv_w + ((size_t)l * 5 + k) * 1536 + ch0);
          const float4 w1 = *(const float4*)(p.ssd_conv_w + ((size_t)l * 5 + k) * 1536 + ch0 + 4);
          a[0] += w0.x * lo2f(u.x); a[1] += w0.y * hi2f(u.x); a[2] += w0.z * lo2f(u.y); a[3] += w0.w * hi2f(u.y);
          a[4] += w1.x * lo2f(u.z); a[5] += w1.y * hi2f(u.z); a[6] += w1.z * lo2f(u.w); a[7] += w1.w * hi2f(u.w);
        }
      }
      uint4 o;
      o.x = pack2(silu_f(a[0]), silu_f(a[1])); o.y = pack2(silu_f(a[2]), silu_f(a[3]));
      o.z = pack2(silu_f(a[4]), silu_f(a[5])); o.w = pack2(silu_f(a[6]), silu_f(a[7]));
      if (ch0 < 1024) *(uint4*)(XS + (size_t)rho * 1024 + ch0) = o;
      else *(uint4*)(BC + (size_t)rho * 512 + (ch0 - 1024)) = o;
      continue;
    }
    it -= N_CONV;
    if (it < N_ROPE) {
      const int e = it * 256 + tid;
      const int rho = e / 320, rem = e % 320, hd = rem >> 5, pi = rem & 31;
      const int axis = pi >> 4, f = pi & 15;
      const int t = rho & 4095;
      const float pos = (float)(axis == 0 ? (t >> 6) : (t & 63));
      const float invf = powf(10000.f, -(float)(2 * f) / 32.f);
      const float ang = pos * invf;
      const float cs = cosf(ang), sn = sinf(ang);
      bf16_t* base = (hd < 8) ? (Q + (size_t)rho * 512 + hd * 64) : (KV + (size_t)rho * 256 + (hd - 8) * 64);
      const float sc = (hd < 8) ? 0.125f : 1.f;
      const int i1 = axis * 32 + f, i2 = i1 + 16;
      const float t1 = bf2f(base[i1]), t2 = bf2f(base[i2]);
      base[i1] = f2bf((t1 * cs - t2 * sn) * sc);
      base[i2] = f2bf((t2 * cs + t1 * sn) * sc);
      continue;
    }
    it -= N_ROPE;
    {
      const int e = it * 256 + tid;
      const int rho = RL_ + e / 256, c2 = (e % 256) * 2;
      unsigned* ptr = (unsigned*)(Q + (size_t)rho * 512 + c2);
      const unsigned u = *ptr;
      *ptr = pack2(lo2f(u) * 0.125f, hi2f(u) * 0.125f);
    }
  }
}

DI void attn_item(const Params& p_in, int l, char* smem, int b, int qblk, int g, int hp, bool ctxq) {
  Params p = p_in;
  asm volatile("" : "+s"(p.ws));

  bf16_t* sK = (bf16_t*)smem;
  bf16_t* sV = (bf16_t*)(smem + 128 * 72 * 2);
  const int tid = threadIdx.x, lane = tid & 63, wave = tid >> 6, fr = lane & 31, fh = lane >> 5;
  const int head = g * 4 + hp * 2 + (wave >> 1);
  const int qh = wave & 1;
  const int qrow0 = (ctxq ? (RL_ + b * 256) : (b * 4096)) + qblk * 128 + qh * 64;
  const int qpos0 = qblk * 128 + qh * 64;
  bf16_t* Q = (bf16_t*)(p.ws + OFF_Q);
  const bf16_t* KV = (const bf16_t*)(p.ws + OFF_KV);
  const bf16_t* AG = (const bf16_t*)(p.ws + OFF_AG);
  bf16x8 qf[2][4];
#pragma unroll
  for (int j = 0; j < 2; ++j)
#pragma unroll
    for (int ks = 0; ks < 4; ++ks)
      qf[j][ks] = *(const bf16x8*)(Q + (size_t)(qrow0 + j * 32 + fr) * 512 + head * 64 + ks * 16 + fh * 8);
  f32x16 o[2][2];
  zero_acc(o);
  float m[2], lsum[2];
  m[0] = m[1] = p.attn_sink[l * 8 + head];
  lsum[0] = lsum[1] = 1.f;
  const int nblk = ctxq ? 2 : 5;
  for (int bi = 0; bi < nblk; ++bi) {
    int krow0, kpos0 = 0;
    bool masked = false;
    if (bi < 2) {
      krow0 = RL_ + b * 256 + bi * 128;
    } else {
      const int kb = qblk + bi - 3;
      if (kb < 0 || kb >= 32) continue;
      krow0 = b * 4096 + kb * 128;
      kpos0 = kb * 128;
      masked = (bi != 3);
    }
    __syncthreads();
    for (int v = tid; v < 1024; v += 256) {
      const int r = v >> 3, cv = v & 7;
      *(uint4*)&sK[r * 72 + cv * 8] = *(const uint4*)(KV + (size_t)(krow0 + r) * 256 + g * 64 + cv * 8);
      *(uint4*)&sV[r * 72 + cv * 8] = *(const uint4*)(KV + (size_t)(krow0 + r) * 256 + 128 + g * 64 + cv * 8);
    }
    __syncthreads();
#pragma unroll 1
    for (int kb = 0; kb < 4; ++kb) {
      f32x16 st[2];
#pragma unroll
      for (int j = 0; j < 2; ++j)
#pragma unroll
        for (int r = 0; r < 16; ++r) st[j][r] = 0.f;
#pragma unroll
      for (int ks = 0; ks < 4; ++ks) {
        const bf16x8 kf = *(const bf16x8*)&sK[(kb * 32 + fr) * 72 + ks * 16 + fh * 8];
#pragma unroll
        for (int j = 0; j < 2; ++j) st[j] = MFMA(kf, qf[j][ks], st[j]);
      }
      bf16x8 pb[2][2];
#pragma unroll
      for (int j = 0; j < 2; ++j) {
        if (masked) {
          const int qpos = qpos0 + j * 32 + fr;
#pragma unroll
          for (int r = 0; r < 16; ++r) {
            const int d = qpos - (kpos0 + kb * 32 + crow(r, fh));
            if (d > 128 || d < -128) st[j][r] = -1e30f;
          }
        }
        float mx = st[j][0];
#pragma unroll
        for (int r = 1; r < 16; ++r) mx = fmaxf(mx, st[j][r]);
        mx = fmaxf(mx, __shfl_xor(mx, 32));
        const float mnew = fmaxf(m[j], mx);
        const float alpha = __expf(m[j] - mnew);
        float rs = 0.f;
#pragma unroll
        for (int r = 0; r < 16; ++r) { const float pv = __expf(st[j][r] - mnew); st[j][r] = pv; rs += pv; }
        rs += __shfl_xor(rs, 32);
        lsum[j] = lsum[j] * alpha + rs;
        m[j] = mnew;
#pragma unroll
        for (int mt = 0; mt < 2; ++mt)
#pragma unroll
          for (int r = 0; r < 16; ++r) o[mt][j][r] *= alpha;
#pragma unroll
        for (int s = 0; s < 2; ++s)
#pragma unroll
          for (int jj = 0; jj < 8; ++jj) pb[j][s][jj] = (short)f2bf(st[j][8 * s + jj]);
      }
#pragma unroll
      for (int s = 0; s < 2; ++s)
#pragma unroll
        for (int mt = 0; mt < 2; ++mt) {
          const bf16x8 vf = tr_frag(sV, 72, kb * 32 + 16 * s + 4 * fh, kb * 32 + 16 * s + 8 + 4 * fh, mt * 32);
#pragma unroll
          for (int j = 0; j < 2; ++j) o[mt][j] = MFMA(vf, pb[j][s], o[mt][j]);
        }
    }
  }
#pragma unroll
  for (int j = 0; j < 2; ++j) {
    const float inv = 1.f / lsum[j];
    const size_t rho = (size_t)(qrow0 + j * 32 + fr);
#pragma unroll
    for (int mt = 0; mt < 2; ++mt)
#pragma unroll
      for (int g4 = 0; g4 < 4; ++g4) {
        const int d0 = mt * 32 + 8 * g4 + 4 * fh;
        const uint2 gv = *(const uint2*)(AG + rho * 512 + head * 64 + d0);
        uint2 ov;
        ov.x = pack2(o[mt][j][g4 * 4 + 0] * inv * silu_f(lo2f(gv.x)), o[mt][j][g4 * 4 + 1] * inv * silu_f(hi2f(gv.x)));
        ov.y = pack2(o[mt][j][g4 * 4 + 2] * inv * silu_f(lo2f(gv.y)), o[mt][j][g4 * 4 + 3] * inv * silu_f(hi2f(gv.y)));
        *(uint2*)(Q + rho * 512 + head * 64 + d0) = ov;
      }
  }
}

DI void states_item(const Params& p_in, char* smem, int ck, int g, int hq) {
  Params p = p_in;
  asm volatile("" : "+s"(p.ws));

  bf16_t* sB = (bf16_t*)smem;
  bf16_t* sX = (bf16_t*)(smem + 128 * 136 * 2);
  const int tid = threadIdx.x, lane = tid & 63, wave = tid >> 6, wr = wave >> 1, wc = wave & 1, fr = lane & 31, fh = lane >> 5;
  const bf16_t* BC = (const bf16_t*)(p.ws + OFF_BC);
  const bf16_t* XS = (const bf16_t*)(p.ws + OFF_H);
  const float* DT = (const float*)(p.ws + OFF_DT);
  const float* CS = (const float*)(p.ws + OFF_CS);
  bf16_t* ST = (bf16_t*)(p.ws + OFF_ST);
  float* CDEC = (float*)(p.ws + OFF_CDEC);
  const int row0 = ck * 128;
  __syncthreads();
  for (int v = tid; v < 2048; v += 256) {
    const int r = v >> 4, cv = v & 15;
    *(uint4*)&sB[r * 136 + cv * 8] = *(const uint4*)(BC + (size_t)(row0 + r) * 512 + g * 128 + cv * 8);
  }
  __syncthreads();
  bf16x8 bfr[2][8];
#pragma unroll
  for (int j = 0; j < 2; ++j)
#pragma unroll
    for (int ks = 0; ks < 8; ++ks) bfr[j][ks] = tr_frag(sB, 136, ks * 16 + 8 * fh, ks * 16 + 8 * fh + 4, wc * 64 + j * 32);
#pragma unroll 1
  for (int hd = 0; hd < 8; ++hd) {
    const int head = g * 8 + hq * 4 + (hd >> 1), d = hd & 1;
    const int col = d * 16 + head;
    const float cend = CS[(size_t)(row0 + (d == 0 ? 127 : 0)) * 32 + col];
    for (int v = tid; v < 1024; v += 256) {
      const int lr = v >> 3, cv = v & 7;
      const size_t rho = (size_t)(row0 + lr);
      const float sc = DT[rho * 32 + col] * __expf(cend - CS[rho * 32 + col]);
      const uint4 u = *(const uint4*)(XS + rho * 1024 + head * 64 + cv * 8);
      uint4 o;
      o.x = pack2(lo2f(u.x) * sc, hi2f(u.x) * sc); o.y = pack2(lo2f(u.y) * sc, hi2f(u.y) * sc);
      o.z = pack2(lo2f(u.z) * sc, hi2f(u.z) * sc); o.w = pack2(lo2f(u.w) * sc, hi2f(u.w) * sc);
      *(uint4*)&sX[lr * 72 + cv * 8] = o;
    }
    __syncthreads();
    f32x16 acc[2];
#pragma unroll
    for (int j = 0; j < 2; ++j)
#pragma unroll
      for (int r = 0; r < 16; ++r) acc[j][r] = 0.f;
#pragma unroll
    for (int ks = 0; ks < 8; ++ks) {
      const bf16x8 af = tr_frag(sX, 72, ks * 16 + 8 * fh, ks * 16 + 8 * fh + 4, wr * 32);
#pragma unroll
      for (int j = 0; j < 2; ++j) acc[j] = MFMA(af, bfr[j][ks], acc[j]);
    }
    bf16_t* dst = ST + ((size_t)(ck * 2 + d) * 16 + head) * 8192;
#pragma unroll
    for (int j = 0; j < 2; ++j)
#pragma unroll
      for (int r = 0; r < 16; ++r) dst[(wr * 32 + crow(r, fh)) * 128 + wc * 64 + j * 32 + fr] = f2bf(acc[j][r]);
    if (tid == 0) CDEC[(ck * 2 + d) * 16 + head] = __expf(cend);
    __syncthreads();
  }
}

DI void pw_item(const Params& p_in, int l, char* smem, int mt, int nt) {
  Params p = p_in;
  asm volatile("" : "+s"(p.ws));

  GemmS* s = (GemmS*)smem;
  const int tid = threadIdx.x, lane = tid & 63, wave = tid >> 6, wr = wave >> 1, wc = wave & 1, fr = lane & 31, fh = lane >> 5;
  const bf16_t* Ab = (const bf16_t*)(p.ws + OFF_HDN) + (size_t)mt * 128 * 512;
  const bf16_t* Bb = (const bf16_t*)(p.ws + OFF_PW) + (size_t)nt * 128 * 512;
  bf16_t* CG = (bf16_t*)(p.ws + OFF_CG);
  f32x16 acc[2][2];
  zero_acc(acc);
  gemm_core(acc, s,
            [&](int kt, int r, int kv) { return Ab + (size_t)r * 512 + kt * 32 + kv * 8; },
            [&](int kt, int r, int kv) { return Bb + (size_t)r * 512 + kt * 32 + kv * 8; }, 16);
  const float* pwb = p.conv_pw_b + l * 512 + nt * 128;
  epilogue_lds(acc, smem, [&](int rl, int c4, float4 v) {
    bf16_t* ptr = CG + (size_t)(mt * 128 + rl) * 512 + nt * 128 + c4;
    const uint2 gv = *(const uint2*)ptr;
    const float4 bb = *(const float4*)(pwb + c4);
    uint2 o;
    o.x = pack2((v.x + bb.x) * silu_f(lo2f(gv.x)), (v.y + bb.y) * silu_f(hi2f(gv.x)));
    o.y = pack2((v.z + bb.z) * silu_f(lo2f(gv.y)), (v.w + bb.w) * silu_f(hi2f(gv.y)));
    *(uint2*)ptr = o;
  });
}

DI void phase_mix(const Params& p, int l, char* smem) {
  const int N_ATT = 512 + (l == 0 ? 32 : 0);
  const int N_ST = NCK * 4;
  const int N_PW = NCK * 4;
  const int NT = N_ATT + N_ST + N_PW;
  for (int it0 = blockIdx.x; it0 < NT; it0 += gridDim.x) {
    int it = it0;
    if (it < N_ATT) {
      if (it < 512) attn_item(p, l, smem, it >> 7, (it >> 2) & 31, (it >> 1) & 1, it & 1, false);
      else { const int t = it - 512; attn_item(p, l, smem, t >> 3, (t >> 2) & 1, (t >> 1) & 1, t & 1, true); }
      continue;
    }
    it -= N_ATT;
    if (it < N_ST) { states_item(p, smem, it >> 2, (it >> 1) & 1, it & 1); continue; }
    it -= N_ST;
    pw_item(p, l, smem, it >> 2, it & 3);
  }
}

DI void phase_scan(const Params& p_in) {
  Params p = p_in;
  asm volatile("" : "+s"(p.ws));

  bf16_t* ST = (bf16_t*)(p.ws + OFF_ST);
  const float* CDEC = (const float*)(p.ws + OFF_CDEC);
  for (int it = blockIdx.x; it < 512; it += gridDim.x) {
    const int e = it * 256 + threadIdx.x;
    const int bdh = e >> 10, v8 = e & 1023;
    const int b = bdh >> 5, d = (bdh >> 4) & 1, h = bdh & 15;
    float s[8];
#pragma unroll
    for (int i = 0; i < 8; ++i) s[i] = 0.f;
    auto ckof = [&](int i) {
      if (d == 0) return (i < 2) ? (128 + 2 * b + i) : (32 * b + (i - 2));
      return (i < 2) ? (128 + 2 * b + (1 - i)) : (32 * b + 31 - (i - 2));
    };
    int ck = ckof(0);
    uint4* ptr = (uint4*)(ST + ((size_t)(ck * 2 + d) * 16 + h) * 8192 + v8 * 8);
    uint4 cur = *ptr;
    float dec = CDEC[(ck * 2 + d) * 16 + h];
#pragma unroll 1
    for (int i = 0; i < 34; ++i) {
      uint4 nxt = cur; float ndec = 0.f; uint4* nptr = ptr;
      if (i + 1 < 34) {
        const int nck = ckof(i + 1);
        nptr = (uint4*)(ST + ((size_t)(nck * 2 + d) * 16 + h) * 8192 + v8 * 8);
        nxt = *nptr;
        ndec = CDEC[(nck * 2 + d) * 16 + h];
      }
      uint4 o;
      o.x = pack2(s[0], s[1]); o.y = pack2(s[2], s[3]); o.z = pack2(s[4], s[5]); o.w = pack2(s[6], s[7]);
      *ptr = o;
      s[0] = s[0] * dec + lo2f(cur.x); s[1] = s[1] * dec + hi2f(cur.x);
      s[2] = s[2] * dec + lo2f(cur.y); s[3] = s[3] * dec + hi2f(cur.y);
      s[4] = s[4] * dec + lo2f(cur.z); s[5] = s[5] * dec + hi2f(cur.z);
      s[6] = s[6] * dec + lo2f(cur.w); s[7] = s[7] * dec + hi2f(cur.w);
      cur = nxt; dec = ndec; ptr = nptr;
    }
  }
}

DI void phase_ssdy(const Params& p_in, int l, char* smem) {
  Params p = p_in;
  asm volatile("" : "+s"(p.ws));

  bf16_t* sB = (bf16_t*)smem;
  bf16_t* sX = (bf16_t*)(smem + 128 * 136 * 2);
  float* sF = (float*)(smem + 128 * 136 * 2 + 128 * 72 * 2);
  float* sSS = sF + 512;
  const int tid = threadIdx.x, lane = tid & 63, wave = tid >> 6, fr = lane & 31, fh = lane >> 5;
  const int wl = wave >> 1, w2 = wave & 1;
  const bf16_t* BC = (const bf16_t*)(p.ws + OFF_BC);
  const bf16_t* XS = (const bf16_t*)(p.ws + OFF_H);
  const float* DT = (const float*)(p.ws + OFF_DT);
  const float* CS = (const float*)(p.ws + OFF_CS);
  const bf16_t* ST = (const bf16_t*)(p.ws + OFF_ST);
  bf16_t* Z = (bf16_t*)(p.ws + OFF_Z);
  float* RSTD = (float*)(p.ws + OFF_RSTD);
  const int nck = (l == 0) ? NCK : 128;
  for (int it = blockIdx.x; it < nck * 4; it += gridDim.x) {
    const int ck = it >> 2, g = (it >> 1) & 1, lh = it & 1;
    const int row0 = ck * 128;
    const int lbase = lh * 64 + wl * 32;
    __syncthreads();
    for (int v = tid; v < 2048; v += 256) {
      const int r = v >> 4, cv = v & 15;
      *(uint4*)&sB[r * 136 + cv * 8] = *(const uint4*)(BC + (size_t)(row0 + r) * 512 + g * 128 + cv * 8);
    }
    if (tid < 64) sSS[tid] = 0.f;
    bf16x8 cf[8];
#pragma unroll
    for (int ks = 0; ks < 8; ++ks)
      cf[ks] = *(const bf16x8*)(BC + (size_t)(row0 + lbase + fr) * 512 + 256 + g * 128 + ks * 16 + fh * 8);
    __syncthreads();
    f32x16 cb[2];
#pragma unroll
    for (int j = 0; j < 2; ++j) {
#pragma unroll
      for (int r = 0; r < 16; ++r) cb[j][r] = 0.f;
#pragma unroll
      for (int ks = 0; ks < 8; ++ks) {
        const bf16x8 bq = *(const bf16x8*)&sB[(w2 * 64 + j * 32 + fr) * 136 + ks * 16 + fh * 8];
        cb[j] = MFMA(cf[ks], bq, cb[j]);
      }
    }
    float ssq[16];
#pragma unroll
    for (int r = 0; r < 16; ++r) ssq[r] = 0.f;
#pragma unroll 1
    for (int hh = 0; hh < 8; ++hh) {
      const int head = g * 8 + hh;
      __syncthreads();
      for (int v = tid; v < 1024; v += 256) {
        const int lr = v >> 3, cv = v & 7;
        *(uint4*)&sX[lr * 72 + cv * 8] = *(const uint4*)(XS + (size_t)(row0 + lr) * 1024 + head * 64 + cv * 8);
      }
      if (tid < 128) {
        const size_t rho = (size_t)(row0 + tid);
        sF[tid] = CS[rho * 32 + head];
        sF[128 + tid] = CS[rho * 32 + 16 + head];
        sF[256 + tid] = DT[rho * 32 + head];
        sF[384 + tid] = DT[rho * 32 + 16 + head];
      }
      __syncthreads();
#pragma unroll
      for (int j = 0; j < 2; ++j) {
        const int sidx = w2 * 64 + j * 32 + fr;
        const float csf_s = sF[sidx], csb_s = sF[128 + sidx], dtf_s = sF[256 + sidx], dtb_s = sF[384 + sidx];
#pragma unroll
        for (int r = 0; r < 16; ++r) {
          const int lidx = lbase + crow(r, fh);
          float f = 0.f;
          if (sidx <= lidx) f += __expf(sF[lidx] - csf_s) * dtf_s;
          if (sidx >= lidx) f += __expf(sF[128 + lidx] - csb_s) * dtb_s;
          sB[(wl * 32 + crow(r, fh)) * 136 + sidx] = f2bf(cb[j][r] * f);
        }
      }
      __syncthreads();
      f32x16 accy;
#pragma unroll
      for (int r = 0; r < 16; ++r) accy[r] = 0.f;
#pragma unroll
      for (int ks = 0; ks < 8; ++ks) {
        const bf16x8 af = *(const bf16x8*)&sB[(wl * 32 + fr) * 136 + ks * 16 + fh * 8];
        const bf16x8 xf = tr_frag(sX, 72, ks * 16 + 8 * fh, ks * 16 + 8 * fh + 4, w2 * 32);
        accy = MFMA(af, xf, accy);
      }
#pragma unroll 1
      for (int d = 0; d < 2; ++d) {
        f32x16 acct;
#pragma unroll
        for (int r = 0; r < 16; ++r) acct[r] = 0.f;
        const bf16_t* Sd = ST + ((size_t)(ck * 2 + d) * 16 + head) * 8192;
#pragma unroll
        for (int ks = 0; ks < 8; ++ks) {
          const bf16x8 sf = *(const bf16x8*)(Sd + (w2 * 32 + fr) * 128 + ks * 16 + fh * 8);
          acct = MFMA(cf[ks], sf, acct);
        }
#pragma unroll
        for (int r = 0; r < 16; ++r) accy[r] += __expf(sF[d * 128 + lbase + crow(r, fh)]) * acct[r];
      }
      const float dsk = p.ssd_d[l * 16 + head];
      const int pidx = w2 * 32 + fr;
#pragma unroll
      for (int r = 0; r < 16; ++r) {
        const int lidx = lbase + crow(r, fh);
        const float xv = bf2f(sX[lidx * 72 + pidx]);
        const float y = accy[r] + dsk * xv;
        bf16_t* zp = Z + (size_t)(row0 + lidx) * 1024 + head * 64 + pidx;
        const float u = y * silu_f(bf2f(*zp));
        ssq[r] += u * u;
        *zp = f2bf(u);
      }
    }
#pragma unroll
    for (int r = 0; r < 16; ++r) {
      float v = ssq[r];
#pragma unroll
      for (int o = 16; o >= 1; o >>= 1) v += __shfl_xor(v, o);
      if (fr == 0) atomicAdd(&sSS[wl * 32 + crow(r, fh)], v);
    }
    __syncthreads();
    if (tid < 64) RSTD[(size_t)(row0 + lh * 64 + tid) * 2 + g] = rsqrtf(sSS[tid] * (1.f / 512.f) + 1e-6f);
  }
}

DI void phase_outproj(const Params& p_in, int l, char* smem) {
  Params p = p_in;
  asm volatile("" : "+s"(p.ws));

  GemmS* s = (GemmS*)smem;
  const int tid = threadIdx.x, lane = tid & 63, wave = tid >> 6, wr = wave >> 1, wc = wave & 1, fr = lane & 31, fh = lane >> 5;
  const bf16_t* Zb = (const bf16_t*)(p.ws + OFF_Z);
  const bf16_t* Qb = (const bf16_t*)(p.ws + OFF_Q);
  const bf16_t* Cb = (const bf16_t*)(p.ws + OFF_CG);
  const bf16_t* W = (const bf16_t*)(p.ws + OFF_WOUT);
  const float* RSTD = (const float*)(p.ws + OFF_RSTD);
  const float* mods = (const float*)(p.ws + OFF_MODS);
  float* XC = (float*)(p.ws + OFF_XC);
  const int nM = (l == 0) ? NCK : 128;
  for (int it = blockIdx.x; it < nM * 8; it += gridDim.x) {
    const int mt = it >> 3, nt = it & 7;
    f32x16 acc[2][2];
    zero_acc(acc);
    const bf16_t* Wb = W + (size_t)nt * 128 * 2048;
    const bf16_t* A0 = Zb + (size_t)mt * 128 * 1024;
    const bf16_t* A2 = Qb + (size_t)mt * 128 * 512;
    const bf16_t* A3 = Cb + (size_t)mt * 128 * 512;
    gemm_core(acc, s,
              [&](int kt, int r, int kv) { return A0 + (size_t)r * 1024 + kt * 32 + kv * 8; },
              [&](int kt, int r, int kv) { return Wb + (size_t)r * 2048 + kt * 32 + kv * 8; }, 16);
#pragma unroll
    for (int i = 0; i < 2; ++i)
#pragma unroll
      for (int r = 0; r < 16; ++r) {
        const size_t row = (size_t)(mt * 128 + wr * 64 + i * 32 + crow(r, fh));
        const float f = RSTD[row * 2] / RSTD[row * 2 + 1];
        acc[i][0][r] *= f; acc[i][1][r] *= f;
      }
    gemm_core(acc, s,
              [&](int kt, int r, int kv) { return A0 + (size_t)r * 1024 + 512 + kt * 32 + kv * 8; },
              [&](int kt, int r, int kv) { return Wb + (size_t)r * 2048 + 512 + kt * 32 + kv * 8; }, 16);
#pragma unroll
    for (int i = 0; i < 2; ++i)
#pragma unroll
      for (int r = 0; r < 16; ++r) {
        const size_t row = (size_t)(mt * 128 + wr * 64 + i * 32 + crow(r, fh));
        const float f = RSTD[row * 2 + 1];
        acc[i][0][r] *= f; acc[i][1][r] *= f;
      }
    gemm_core(acc, s,
              [&](int kt, int r, int kv) { return A2 + (size_t)r * 512 + kt * 32 + kv * 8; },
              [&](int kt, int r, int kv) { return Wb + (size_t)r * 2048 + 1024 + kt * 32 + kv * 8; }, 16);
    gemm_core(acc, s,
              [&](int kt, int r, int kv) { return A3 + (size_t)r * 512 + kt * 32 + kv * 8; },
              [&](int kt, int r, int kv) { return Wb + (size_t)r * 2048 + 1536 + kt * 32 + kv * 8; }, 16);
    {
      const int row0 = mt * 128;
      const int vv = (row0 < RL_) ? (row0 >> 12) : 4;
      const float* gate = mods + (l * 5 + vv) * 3072 + 2048 + nt * 128;
      float* xnew = (row0 < RL_) ? (p.out + (size_t)row0 * 1024) : (XC + (size_t)(row0 - RL_) * 1024);
      const float* xold = (l == 0) ? ((row0 < RL_) ? (p.x + (size_t)row0 * 1024) : (p.ctx + (size_t)(row0 - RL_) * 1024)) : xnew;
      epilogue_lds(acc, smem, [&](int rl, int c4, float4 v) {
        const int off = rl * 1024 + nt * 128 + c4;
        const float4 xo = *(const float4*)(xold + off);
        const float4 gt = *(const float4*)(gate + c4);
        float4 o;
        o.x = xo.x + gt.x * v.x; o.y = xo.y + gt.y * v.y; o.z = xo.z + gt.z * v.z; o.w = xo.w + gt.w * v.w;
        *(float4*)(xnew + off) = o;
      });
    }
  }
}

DI void phase_final(const Params& p) {
  const int lane = threadIdx.x & 63, wave = threadIdx.x >> 6;
  for (int it = blockIdx.x; it < RL_ / 4; it += gridDim.x) {
    float* xr = p.out + (size_t)(it * 4 + wave) * 1024;
    float4 xv[4];
    float ss = 0.f;
#pragma unroll
    for (int i = 0; i < 4; ++i) {
      xv[i] = *(const float4*)(xr + lane * 4 + i * 256);
      ss += xv[i].x * xv[i].x + xv[i].y * xv[i].y + xv[i].z * xv[i].z + xv[i].w * xv[i].w;
    }
#pragma unroll
    for (int o = 32; o >= 1; o >>= 1) ss += __shfl_xor(ss, o);
    const float rs = rsqrtf(ss * (1.f / 1024.f) + 1e-6f);
#pragma unroll
    for (int i = 0; i < 4; ++i) {
      const float4 w = *(const float4*)(p.final_norm_w + lane * 4 + i * 256);
      float4 o;
      o.x = xv[i].x * rs * w.x; o.y = xv[i].y * rs * w.y; o.z = xv[i].z * rs * w.z; o.w = xv[i].w * rs * w.w;
      *(float4*)(xr + lane * 4 + i * 256) = o;
    }
  }
}

DI void run_phase(const Params& p, int ph, char* smem) {
  if (ph == 0) { phase_mods(p, smem); return; }
  if (ph == 15) { phase_final(p); return; }
  const int l = (ph - 1) / 7, s = (ph - 1) % 7;
  switch (s) {
    case 0: phase_prep(p, l, smem); break;
    case 1: phase_inproj(p, smem); break;
    case 2: phase_local(p, l, smem); break;
    case 3: phase_mix(p, l, smem); break;
    case 4: phase_scan(p); break;
    case 5: phase_ssdy(p, l, smem); break;
    default: phase_outproj(p, l, smem); break;
  }
}

__global__ void __launch_bounds__(256, 1) fwd_megakernel(Params p, int ph_lo, int ph_hi, int coop) {
  __shared__ __attribute__((aligned(16))) char smem[57344];
  if (coop) {
    cg::grid_group grid = cg::this_grid();
    for (int ph = ph_lo; ph <= ph_hi; ++ph) {
      run_phase(p, ph, smem);
      if (ph < ph_hi) grid.sync();
    }
  } else {
    for (int ph = ph_lo; ph <= ph_hi; ++ph) run_phase(p, ph, smem);
  }
}

extern "C" void kernel_launch(void* const* d_in, const int* in_sizes, int n_in, void* d_out, int out_size, void* d_ws,
                              size_t ws_size, hipStream_t stream) {
  static int grid_blocks = 0;
  if (!grid_blocks) {
    int dev = 0, cus = 0, per_cu = 0;
    hipGetDevice(&dev);
    hipDeviceGetAttribute(&cus, hipDeviceAttributeMultiprocessorCount, dev);
    hipOccupancyMaxActiveBlocksPerMultiprocessor(&per_cu, fwd_megakernel, 256, 0);
    if (per_cu < 1) per_cu = 1;
    if (per_cu > 2) per_cu = 2;
    grid_blocks = cus * per_cu;
  }
  Params p{};
  const float** pp = (const float**)&p;
  for (int i = 0; i < 23; ++i) pp[i] = (const float*)d_in[i];
  p.out = (float*)d_out;
  p.ws = (char*)d_ws;
#if ONE_LAUNCH
  int lo = 0, hi = 15, coop = 1;
  void* args[] = {&p, &lo, &hi, &coop};
  hipError_t e = hipLaunchCooperativeKernel((void*)fwd_megakernel, dim3(grid_blocks), dim3(256), args, 0, stream);
  if (e != hipSuccess) fprintf(stderr, "cooperative launch failed: %s (grid %d)\n", hipGetErrorString(e), grid_blocks);
#else
  for (int ph = 0; ph <= 15; ++ph) fwd_megakernel<<<grid_blocks, 256, 0, stream>>>(p, ph, ph, 0);
#endif
}
```

```cpp
#include <hip/hip_runtime.h>
#include <hip/hip_cooperative_groups.h>
#include <stdint.h>
#include <stdio.h>
namespace cg = cooperative_groups;

#ifndef ONE_LAUNCH
#define ONE_LAUNCH 1
#endif

#define DI __device__ __forceinline__
typedef unsigned short bf16_t;
using bf16x8 = __attribute__((ext_vector_type(8))) short;
using s16x4 = __attribute__((ext_vector_type(4))) short;
using f32x16 = __attribute__((ext_vector_type(16))) float;
#define MFMA(a, b, c) __builtin_amdgcn_mfma_f32_32x32x16_bf16((a), (b), (c), 0, 0, 0)

constexpr int R_ = 17408;
constexpr int RL_ = 16384;
constexpr int NCK = 136;

constexpr size_t SZ_WIN = (size_t)5504 * 1024 * 2;
constexpr size_t SZ_WOUT = (size_t)1024 * 2048 * 2;
constexpr size_t SZ_PW = (size_t)512 * 512 * 2;
constexpr size_t SZ_MODS = (size_t)2 * 5 * 3072 * 4;
constexpr size_t SZ_XC = (size_t)1024 * 1024 * 4;
constexpr size_t SZ_RSTD = (size_t)R_ * 2 * 4;
constexpr size_t SZ_CDEC = (size_t)NCK * 32 * 4 + 256 - ((size_t)NCK * 32 * 4) % 256;
constexpr size_t SZ_R512 = (size_t)R_ * 512 * 2;
constexpr size_t OFF_WIN = 0;
constexpr size_t OFF_WOUT = OFF_WIN + SZ_WIN;
constexpr size_t OFF_PW = OFF_WOUT + SZ_WOUT;
constexpr size_t OFF_MODS = OFF_PW + SZ_PW;
constexpr size_t OFF_XC = OFF_MODS + SZ_MODS;
constexpr size_t OFF_RSTD = OFF_XC + SZ_XC;
constexpr size_t OFF_CDEC = OFF_RSTD + SZ_RSTD;
constexpr size_t OFF_H = OFF_CDEC + SZ_CDEC;
constexpr size_t OFF_XBC = OFF_H + 2 * SZ_R512;
constexpr size_t OFF_GLU = OFF_XBC + 3 * SZ_R512;
constexpr size_t OFF_ST = OFF_XBC;
constexpr size_t OFF_Z = OFF_GLU + SZ_R512;
constexpr size_t OFF_DT = OFF_Z + 2 * SZ_R512;
constexpr size_t OFF_CS = OFF_DT + (size_t)R_ * 32 * 4;
constexpr size_t OFF_Q = OFF_CS + (size_t)R_ * 32 * 4;
constexpr size_t OFF_KV = OFF_Q + SZ_R512;
constexpr size_t OFF_AG = OFF_KV + SZ_R512 / 2;
constexpr size_t OFF_CG = OFF_AG + SZ_R512;
constexpr size_t OFF_BC = OFF_CG + SZ_R512;
constexpr size_t OFF_HDN = OFF_BC + SZ_R512;
constexpr size_t WS_TOTAL = OFF_HDN + SZ_R512;
static_assert(WS_TOTAL <= (size_t)256 * 1024 * 1024, "workspace too large");

struct Params {
  const float *x, *c, *ctx, *c_ctx, *w_mod, *b_mod, *norm_w, *w_in, *ssd_conv_w, *ssd_conv_b, *ssd_dt_bias, *ssd_a_log,
      *ssd_d, *ssd_norm_w, *attn_sink, *conv_dw_w, *conv_dw_b, *conv_ln_w, *conv_ln_b, *conv_pw_w, *conv_pw_b, *w_out,
      *final_norm_w;
  float* out;
  char* ws;
};


DI Params load_params() {
  typedef const char __attribute__((address_space(4)))* kptr_t;
  typedef const float* const __attribute__((address_space(4)))* kfld_t;
  size_t off = 0;
  asm volatile("" : "+s"(off));
  kptr_t base = (kptr_t)__builtin_amdgcn_kernarg_segment_ptr() + off;
  Params p;
  const float** pp = (const float**)&p;
#pragma unroll
  for (int i = 0; i < 25; ++i) pp[i] = *(kfld_t)(base + 8 * i);
  return p;
}

DI unsigned short f2bf(float x) { unsigned u = __float_as_uint(x); u += 0x7fffu + ((u >> 16) & 1u); return (unsigned short)(u >> 16); }
DI float bf2f(unsigned short b) { return __uint_as_float(((unsigned)b) << 16); }
DI unsigned pack2(float a, float b) { return (unsigned)f2bf(a) | ((unsigned)f2bf(b) << 16); }
DI float lo2f(unsigned u) { return __uint_as_float(u << 16); }
DI float hi2f(unsigned u) { return __uint_as_float(u & 0xffff0000u); }
DI float silu_f(float x) { return x / (1.f + __expf(-x)); }
DI float sigmoid_f(float x) { return 1.f / (1.f + __expf(-x)); }
DI int crow(int reg, int h) { return (reg & 3) + 8 * (reg >> 2) + 4 * h; }

DI bf16x8 tr_frag(const bf16_t* s, int ld, int row_lo, int row_hi, int col0) {
  const int lane = threadIdx.x & 63;
  const int i16 = lane & 15, q = i16 >> 2, pp = i16 & 3, blk = (lane >> 4) & 1;
  const unsigned a0 = (unsigned)(size_t)(s + (row_lo + q) * ld + col0 + 16 * blk + 4 * pp);
  const unsigned a1 = (unsigned)(size_t)(s + (row_hi + q) * ld + col0 + 16 * blk + 4 * pp);
  s16x4 lo, hi;
  asm volatile("ds_read_b64_tr_b16 %0, %2\n\tds_read_b64_tr_b16 %1, %3\n\ts_waitcnt lgkmcnt(0)"
               : "=&v"(lo), "=&v"(hi) : "v"(a0), "v"(a1) : "memory");
  return __builtin_shufflevector(lo, hi, 0, 1, 2, 3, 4, 5, 6, 7);
}

struct GemmS { bf16_t a[2][128][40]; bf16_t b[2][128][40]; };

template <class AF, class BF>
DI void gemm_core(f32x16 (&acc)[2][2], GemmS* s, AF aptr, BF bptr, int nk) {
  int tid = threadIdx.x; asm volatile("" : "+v"(tid)); const int lane = tid & 63, wave = tid >> 6, wr = wave >> 1, wc = wave & 1;
  const int r0 = tid >> 2, kv = tid & 3;
  const int fr = lane & 31, fh = lane >> 5;
  uint4 ra0 = *(const uint4*)aptr(0, r0, kv), ra1 = *(const uint4*)aptr(0, r0 + 64, kv);
  uint4 rb0 = *(const uint4*)bptr(0, r0, kv), rb1 = *(const uint4*)bptr(0, r0 + 64, kv);
  *(uint4*)&s->a[0][r0][kv * 8] = ra0; *(uint4*)&s->a[0][r0 + 64][kv * 8] = ra1;
  *(uint4*)&s->b[0][r0][kv * 8] = rb0; *(uint4*)&s->b[0][r0 + 64][kv * 8] = rb1;
  __syncthreads();
#pragma unroll 1
  for (int kt = 0; kt < nk; ++kt) {
    const int buf = kt & 1;
    if (kt + 1 < nk) {
      ra0 = *(const uint4*)aptr(kt + 1, r0, kv); ra1 = *(const uint4*)aptr(kt + 1, r0 + 64, kv);
      rb0 = *(const uint4*)bptr(kt + 1, r0, kv); rb1 = *(const uint4*)bptr(kt + 1, r0 + 64, kv);
    }
#pragma unroll
    for (int ks = 0; ks < 2; ++ks) {
      bf16x8 af[2], bq[2];
#pragma unroll
      for (int i = 0; i < 2; ++i) af[i] = *(const bf16x8*)&s->a[buf][wr * 64 + i * 32 + fr][ks * 16 + fh * 8];
#pragma unroll
      for (int j = 0; j < 2; ++j) bq[j] = *(const bf16x8*)&s->b[buf][wc * 64 + j * 32 + fr][ks * 16 + fh * 8];
#pragma unroll
      for (int i = 0; i < 2; ++i)
#pragma unroll
        for (int j = 0; j < 2; ++j) acc[i][j] = MFMA(af[i], bq[j], acc[i][j]);
    }
    if (kt + 1 < nk) {
      *(uint4*)&s->a[buf ^ 1][r0][kv * 8] = ra0; *(uint4*)&s->a[buf ^ 1][r0 + 64][kv * 8] = ra1;
      *(uint4*)&s->b[buf ^ 1][r0][kv * 8] = rb0; *(uint4*)&s->b[buf ^ 1][r0 + 64][kv * 8] = rb1;
    }
    __syncthreads();
  }
}

DI void zero_acc(f32x16 (&acc)[2][2]) {
#pragma unroll
  for (int i = 0; i < 2; ++i)
#pragma unroll
    for (int j = 0; j < 2; ++j)
#pragma unroll
      for (int r = 0; r < 16; ++r) acc[i][j][r] = 0.f;
}

template <class EPI>
DI void epilogue_lds(f32x16 (&acc)[2][2], char* smem, EPI epi) {
  float* T = (float*)smem;
  int tid = threadIdx.x; asm volatile("" : "+v"(tid)); const int lane = tid & 63, wave = tid >> 6, wr = wave >> 1, wc = wave & 1, fr = lane & 31, fh = lane >> 5;
#pragma unroll
  for (int i = 0; i < 2; ++i) {
#pragma unroll
    for (int j = 0; j < 2; ++j)
#pragma unroll
      for (int r = 0; r < 16; ++r) T[(wr * 32 + crow(r, fh)) * 132 + wc * 64 + j * 32 + fr] = acc[i][j][r];
    __syncthreads();
#pragma unroll 2
    for (int e = tid; e < 2048; e += 256) {
      const int tr = e >> 5, c4 = (e & 31) * 4;
      const float4 v = *(const float4*)&T[tr * 132 + c4];
      epi((tr >> 5) * 64 + i * 32 + (tr & 31), c4, v);
    }
    __syncthreads();
  }
}

DI void phase_mods(const Params& p_in, char* smem) {
  const Params p = load_params();

  float* ssc = (float*)smem;
  float* red = (float*)(smem + 20480);
  float* mods = (float*)(p.ws + OFF_MODS);
  int tid = threadIdx.x; asm volatile("" : "+v"(tid));
  for (int it = blockIdx.x; it < 96; it += gridDim.x) {
    const int l = it / 48, col0 = (it % 48) * 64;
    __syncthreads();
    for (int e = tid; e < 5120; e += 256) {
      const int v = e >> 10, k = e & 1023;
      const float cv = (v < 4) ? p.c[v * 1024 + k] : p.c_ctx[k];
      ssc[e] = silu_f(cv);
    }
    __syncthreads();
    const int col = tid & 63, kg = tid >> 6;
    float a[5] = {0.f, 0.f, 0.f, 0.f, 0.f};
    const float* w = p.w_mod + (size_t)l * 1024 * 3072 + col0 + col;
    for (int k = kg * 256; k < kg * 256 + 256; ++k) {
      const float wv = w[(size_t)k * 3072];
#pragma unroll
      for (int v = 0; v < 5; ++v) a[v] += ssc[v * 1024 + k] * wv;
    }
#pragma unroll
    for (int v = 0; v < 5; ++v) red[(kg * 5 + v) * 64 + col] = a[v];
    __syncthreads();
    for (int e = tid; e < 320; e += 256) {
      const int v = e >> 6, cc = e & 63;
      float sum = p.b_mod[l * 3072 + col0 + cc];
      for (int g = 0; g < 4; ++g) sum += red[(g * 5 + v) * 64 + cc];
      mods[(l * 5 + v) * 3072 + col0 + cc] = sum;
    }
  }
}

DI int win_colmap(int n) {
  if (n < 2560) return n;
  if (n < 3840) return n + 32;
  if (n < 4864) {
    const int j = n - 3840, q64 = j >> 6, w = j & 63;
    return (w < 32) ? (3872 + q64 * 32 + w) : (3872 + 512 + q64 * 32 + (w - 32));
  }
  if (n < 5376) return n + 32;
  if (n < 5408) return n - 5376 + 2560;
  return -1;
}

DI void transpose_tile(const float* src, int ldsrc, int kind, const float* rowscale, bf16_t* dst, int lddst, int n0, int k0, float* tile) {
  int tid = threadIdx.x; asm volatile("" : "+v"(tid)); const int tx = tid & 63, ty = tid >> 6;
  __syncthreads();
  const int n = (kind == 0) ? win_colmap(n0 + tx) : (n0 + tx);
  for (int r = ty; r < 64; r += 4) {
    const int k = k0 + r;
    float v = 0.f;
    if (n >= 0) v = src[(size_t)k * ldsrc + n];
    if (rowscale != nullptr && k < 1024) v *= rowscale[k];
    tile[r * 65 + tx] = v;
  }
  __syncthreads();
  for (int r = ty; r < 64; r += 4) dst[(size_t)(n0 + r) * lddst + k0 + tx] = f2bf(tile[tx * 65 + r]);
}

DI void phase_prep(const Params& p_in, int l, char* smem) {
  const Params p = load_params();

  int tid = threadIdx.x; asm volatile("" : "+v"(tid)); const int lane = tid & 63, wave = tid >> 6;
  const float* mods = (const float*)(p.ws + OFF_MODS);
  bf16_t* H = (bf16_t*)(p.ws + OFF_H);
  const int NT_WIN = 86 * 16, NT_WOUT = 16 * 32, NT_PW = 64, NT_CONV = NT_WIN + NT_WOUT + NT_PW;
  const int NT = NT_CONV + R_ / 4;
  for (int it = blockIdx.x; it < NT; it += gridDim.x) {
    if (it < NT_WIN) {
      transpose_tile(p.w_in + (size_t)l * 1024 * 5408, 5408, 0, nullptr, (bf16_t*)(p.ws + OFF_WIN), 1024, (it / 16) * 64, (it % 16) * 64, (float*)smem);
    } else if (it < NT_WIN + NT_WOUT) {
      const int t = it - NT_WIN;
      transpose_tile(p.w_out + (size_t)l * 2048 * 1024, 1024, 1, p.ssd_norm_w + l * 1024, (bf16_t*)(p.ws + OFF_WOUT), 2048, (t / 32) * 64, (t % 32) * 64, (float*)smem);
    } else if (it < NT_CONV) {
      const int t = it - NT_WIN - NT_WOUT;
      transpose_tile(p.conv_pw_w + (size_t)l * 512 * 512, 512, 1, nullptr, (bf16_t*)(p.ws + OFF_PW), 512, (t / 8) * 64, (t % 8) * 64, (float*)smem);
    } else {
      const int rho = (it - NT_CONV) * 4 + wave;
      const float* xs;
      if (l == 0) xs = (rho < RL_) ? (p.x + (size_t)rho * 1024) : (p.ctx + (size_t)(rho - RL_) * 1024);
      else xs = (rho < RL_) ? (p.out + (size_t)rho * 1024) : ((const float*)(p.ws + OFF_XC) + (size_t)(rho - RL_) * 1024);
      const int v = (rho < RL_) ? (rho >> 12) : 4;
      const float* md = mods + (l * 5 + v) * 3072;
      float4 xv[4];
      float ss = 0.f;
#pragma unroll
      for (int i = 0; i < 4; ++i) {
        xv[i] = *(const float4*)(xs + lane * 4 + i * 256);
        ss += xv[i].x * xv[i].x + xv[i].y * xv[i].y + xv[i].z * xv[i].z + xv[i].w * xv[i].w;
      }
#pragma unroll
      for (int o = 32; o >= 1; o >>= 1) ss += __shfl_xor(ss, o);
      const float rs = rsqrtf(ss * (1.f / 1024.f) + 1e-6f);
#pragma unroll
      for (int i = 0; i < 4; ++i) {
        const int cidx = lane * 4 + i * 256;
        const float4 nw = *(const float4*)(p.norm_w + l * 1024 + cidx);
        const float4 sh = *(const float4*)(md + cidx);
        const float4 sc = *(const float4*)(md + 1024 + cidx);
        uint2 o;
        o.x = pack2(xv[i].x * rs * nw.x * (1.f + sc.x) + sh.x, xv[i].y * rs * nw.y * (1.f + sc.y) + sh.y);
        o.y = pack2(xv[i].z * rs * nw.z * (1.f + sc.z) + sh.z, xv[i].w * rs * nw.w * (1.f + sc.w) + sh.w);
        *(uint2*)(H + (size_t)rho * 1024 + cidx) = o;
      }
    }
  }
}

DI void phase_inproj(const Params& p_in, char* smem) {
  const Params p = load_params();

  GemmS* s = (GemmS*)smem;
  int tid = threadIdx.x; asm volatile("" : "+v"(tid)); const int lane = tid & 63, wave = tid >> 6, wr = wave >> 1, wc = wave & 1, fr = lane & 31, fh = lane >> 5;
  const bf16_t* H = (const bf16_t*)(p.ws + OFF_H);
  const bf16_t* W = (const bf16_t*)(p.ws + OFF_WIN);
  for (int it = blockIdx.x; it < NCK * 43; it += gridDim.x) {
    const int mt = it / 43, nt = it % 43;
    f32x16 acc[2][2];
    zero_acc(acc);
    const bf16_t* Ab = H + (size_t)mt * 128 * 1024;
    const bf16_t* Bb = W + (size_t)nt * 128 * 1024;
    gemm_core(acc, s,
              [&](int kt, int r, int kv) { return Ab + (size_t)r * 1024 + kt * 32 + kv * 8; },
              [&](int kt, int r, int kv) { return Bb + (size_t)r * 1024 + kt * 32 + kv * 8; }, 32);
    const int row0 = mt * 128;
    if (nt >= 30 && nt < 38) {
#pragma unroll
      for (int i = 0; i < 2; ++i)
#pragma unroll
        for (int r = 0; r < 16; ++r) acc[i][0][r] = acc[i][0][r] * sigmoid_f(acc[i][1][r]);
      bf16_t* G = (bf16_t*)(p.ws + OFF_GLU);
      const int cb0 = (nt - 30) * 64;
      epilogue_lds(acc, smem, [&](int rl, int c4, float4 v) {
        if ((c4 & 32) == 0) {
          uint2 o; o.x = pack2(v.x, v.y); o.y = pack2(v.z, v.w);
          *(uint2*)(G + (size_t)(row0 + rl) * 512 + cb0 + (c4 >> 6) * 32 + (c4 & 31)) = o;
        }
      });
    } else if (nt == 42) {
      float* DT = (float*)(p.ws + OFF_DT);
      epilogue_lds(acc, smem, [&](int rl, int c4, float4 v) {
        if (c4 < 32) *(float4*)(DT + (size_t)(row0 + rl) * 32 + c4) = v;
      });
    } else {
      bf16_t* dst; int ld, cb;
      if (nt < 12) { dst = (bf16_t*)(p.ws + OFF_XBC); ld = 1536; cb = nt * 128; }
      else if (nt < 20) { dst = (bf16_t*)(p.ws + OFF_Z); ld = 1024; cb = nt * 128 - 1536; }
      else if (nt < 24) { dst = (bf16_t*)(p.ws + OFF_Q); ld = 512; cb = nt * 128 - 2560; }
      else if (nt < 26) { dst = (bf16_t*)(p.ws + OFF_KV); ld = 256; cb = nt * 128 - 3072; }
      else if (nt < 30) { dst = (bf16_t*)(p.ws + OFF_AG); ld = 512; cb = nt * 128 - 3328; }
      else { dst = (bf16_t*)(p.ws + OFF_CG); ld = 512; cb = nt * 128 - 4864; }
      epilogue_lds(acc, smem, [&](int rl, int c4, float4 v) {
        uint2 o; o.x = pack2(v.x, v.y); o.y = pack2(v.z, v.w);
        *(uint2*)(dst + (size_t)(row0 + rl) * ld + cb + c4) = o;
      });
    }
  }
}

DI void phase_local(const Params& p_in, int l, char* smem) {
  const Params p = load_params();

  int tid = threadIdx.x; asm volatile("" : "+v"(tid)); const int lane = tid & 63;
  const bf16_t* XBC = (const bf16_t*)(p.ws + OFF_XBC);
  bf16_t* XS = (bf16_t*)(p.ws + OFF_H);
  bf16_t* BC = (bf16_t*)(p.ws + OFF_BC);
  float* DT = (float*)(p.ws + OFF_DT);
  float* CS = (float*)(p.ws + OFF_CS);
  const bf16_t* GLU = (const bf16_t*)(p.ws + OFF_GLU);
  bf16_t* HDN = (bf16_t*)(p.ws + OFF_HDN);
  bf16_t* Q = (bf16_t*)(p.ws + OFF_Q);
  bf16_t* KV = (bf16_t*)(p.ws + OFF_KV);
  const int N_CONV = R_ * 192 / 256;
  const int N_DT = NCK;
  const int N_CF = R_ / 16;
  const int N_ROPE = RL_ * 320 / 256;
  const int N_QC = 1024 * 256 / 256;
  const int NT = N_CF + N_DT + N_CONV + N_ROPE + N_QC;
  for (int it0 = blockIdx.x; it0 < NT; it0 += gridDim.x) {
    int it = it0;
    if (it < N_CF) {
      float* sv = (float*)smem;
      float* sst = (float*)(smem + 32768);
      const int row0 = it * 16;
      const int seq0 = (row0 < RL_) ? (row0 & ~4095) : (RL_ + ((row0 - RL_) & ~255));
      const int slen = (row0 < RL_) ? 4096 : 256;
      const int c0 = tid * 2;
      __syncthreads();
      if (tid < 32) sst[tid] = 0.f;
      float w0[31], w1[31];
#pragma unroll
      for (int k = 0; k < 31; ++k) {
        const float2 wv = *(const float2*)(p.conv_dw_w + ((size_t)l * 31 + k) * 512 + c0);
        w0[k] = wv.x; w1[k] = wv.y;
      }
      const float2 bv = *(const float2*)(p.conv_dw_b + l * 512 + c0);
      __syncthreads();
#pragma unroll 1
      for (int r = 0; r < 16; ++r) {
        const int t = row0 + r - seq0;
        float a0 = bv.x, a1 = bv.y;
#pragma unroll
        for (int k = 0; k < 31; ++k) {
          const int tt = t + k - 15;
          if (tt >= 0 && tt < slen) {
            const unsigned u = *(const unsigned*)(GLU + (size_t)(seq0 + tt) * 512 + c0);
            a0 += w0[k] * lo2f(u); a1 += w1[k] * hi2f(u);
          }
        }
        sv[r * 512 + c0] = a0; sv[r * 512 + c0 + 1] = a1;
        float s1 = a0 + a1, s2 = a0 * a0 + a1 * a1;
#pragma unroll
        for (int o = 32; o >= 1; o >>= 1) { s1 += __shfl_xor(s1, o); s2 += __shfl_xor(s2, o); }
        if (lane == 0) { atomicAdd(&sst[r * 2], s1); atomicAdd(&sst[r * 2 + 1], s2); }
      }
      __syncthreads();
      const float2 lw = *(const float2*)(p.conv_ln_w + l * 512 + c0);
      const float2 lb = *(const float2*)(p.conv_ln_b + l * 512 + c0);
#pragma unroll 1
      for (int r = 0; r < 16; ++r) {
        const float mean = sst[r * 2] * (1.f / 512.f);
        const float var = fmaxf(sst[r * 2 + 1] * (1.f / 512.f) - mean * mean, 0.f);
        const float rs = rsqrtf(var + 1e-6f);
        const float y0 = (sv[r * 512 + c0] - mean) * rs * lw.x + lb.x;
        const float y1 = (sv[r * 512 + c0 + 1] - mean) * rs * lw.y + lb.y;
        *(unsigned*)(HDN + (size_t)(row0 + r) * 512 + c0) = pack2(silu_f(y0), silu_f(y1));
      }
      continue;
    }
    it -= N_CF;
    if (it < N_DT) {
      float* sdt = (float*)smem;
      const int row0 = it * 128;
      __syncthreads();
      for (int e = tid; e < 4096; e += 256) {
        const int r = e >> 5, cidx = e & 31;
        const float raw = DT[(size_t)(row0 + r) * 32 + cidx] + p.ssd_dt_bias[l * 32 + cidx];
        const float sp = (raw > 20.f) ? raw : log1pf(expf(raw));
        DT[(size_t)(row0 + r) * 32 + cidx] = sp;
        sdt[r * 33 + cidx] = sp;
      }
      __syncthreads();
      if (tid < 32) {
        const float a = -expf(p.ssd_a_log[l * 32 + tid]);
        float run = 0.f;
        if (tid < 16) {
          for (int r = 0; r < 128; ++r) { run += sdt[r * 33 + tid] * a; CS[(size_t)(row0 + r) * 32 + tid] = run; }
        } else {
          for (int r = 127; r >= 0; --r) { run += sdt[r * 33 + tid] * a; CS[(size_t)(row0 + r) * 32 + tid] = run; }
        }
      }
      continue;
    }
    it -= N_DT;
    if (it < N_CONV) {
      const int e = it * 256 + tid;
      const int rho = e / 192, cgp = e % 192, ch0 = cgp * 8;
      const int seq0 = (rho < RL_) ? (rho & ~4095) : (RL_ + ((rho - RL_) & ~255));
      const int slen = (rho < RL_) ? 4096 : 256;
      const int t = rho - seq0;
      float a[8];
      {
        const float4 b0 = *(const float4*)(p.ssd_conv_b + l * 1536 + ch0);
        const float4 b1 = *(const float4*)(p.ssd_conv_b + l * 1536 + ch0 + 4);
        a[0] = b0.x; a[1] = b0.y; a[2] = b0.z; a[3] = b0.w; a[4] = b1.x; a[5] = b1.y; a[6] = b1.z; a[7] = b1.w;
      }
#pragma unroll
      for (int k = 0; k < 5; ++k) {
        const int tt = t + k - 2;
        if (tt >= 0 && tt < slen) {
          const uint4 u = *(const uint4*)(XBC + (size_t)(seq0 + tt) * 1536 + ch0);
          const float4 w0 = *(const float4*)(p.ssd_conv_w + ((size_t)l * 5 + k) * 1536 + ch0);
          const float4 w1 = *(const float4*)(p.ssd_conv_w + ((size_t)l * 5 + k) * 1536 + ch0 + 4);
          a[0] += w0.x * lo2f(u.x); a[1] += w0.y * hi2f(u.x); a[2] += w0.z * lo2f(u.y); a[3] += w0.w * hi2f(u.y);
          a[4] += w1.x * lo2f(u.z); a[5] += w1.y * hi2f(u.z); a[6] += w1.z * lo2f(u.w); a[7] += w1.w * hi2f(u.w);
        }
      }
      uint4 o;
      o.x = pack2(silu_f(a[0]), silu_f(a[1])); o.y = pack2(silu_f(a[2]), silu_f(a[3]));
      o.z = pack2(silu_f(a[4]), silu_f(a[5])); o.w = pack2(silu_f(a[6]), silu_f(a[7]));
      if (ch0 < 1024) *(uint4*)(XS + (size_t)rho * 1024 + ch0) = o;
      else *(uint4*)(BC + (size_t)rho * 512 + (ch0 - 1024)) = o;
      continue;
    }
    it -= N_CONV;
    if (it < N_ROPE) {
      const int e = it * 256 + tid;
      const int rho = e / 320, rem = e % 320, hd = rem >> 5, pi = rem & 31;
      const int axis = pi >> 4, f = pi & 15;
      const int t = rho & 4095;
      const float pos = (float)(axis == 0 ? (t >> 6) : (t & 63));
      const float invf = powf(10000.f, -(float)(2 * f) / 32.f);
      const float ang = pos * invf;
      const float cs = cosf(ang), sn = sinf(ang);
      bf16_t* base = (hd < 8) ? (Q + (size_t)rho * 512 + hd * 64) : (KV + (size_t)rho * 256 + (hd - 8) * 64);
      const float sc = (hd < 8) ? 0.125f : 1.f;
      const int i1 = axis * 32 + f, i2 = i1 + 16;
      const float t1 = bf2f(base[i1]), t2 = bf2f(base[i2]);
      base[i1] = f2bf((t1 * cs - t2 * sn) * sc);
      base[i2] = f2bf((t2 * cs + t1 * sn) * sc);
      continue;
    }
    it -= N_ROPE;
    {
      const int e = it * 256 + tid;
      const int rho = RL_ + e / 256, c2 = (e % 256) * 2;
      unsigned* ptr = (unsigned*)(Q + (size_t)rho * 512 + c2);
      const unsigned u = *ptr;
      *ptr = pack2(lo2f(u) * 0.125f, hi2f(u) * 0.125f);
    }
  }
}

DI void attn_item(const Params& p_in, int l, char* smem, int b, int qblk, int g, int hp, bool ctxq) {
  const Params p = load_params();

  bf16_t* sK = (bf16_t*)smem;
  bf16_t* sV = (bf16_t*)(smem + 128 * 72 * 2);
  int tid = threadIdx.x; asm volatile("" : "+v"(tid)); const int lane = tid & 63, wave = tid >> 6, fr = lane & 31, fh = lane >> 5;
  const int head = g * 4 + hp * 2 + (wave >> 1);
  const int qh = wave & 1;
  const int qrow0 = (ctxq ? (RL_ + b * 256) : (b * 4096)) + qblk * 128 + qh * 64;
  const int qpos0 = qblk * 128 + qh * 64;
  bf16_t* Q = (bf16_t*)(p.ws + OFF_Q);
  const bf16_t* KV = (const bf16_t*)(p.ws + OFF_KV);
  const bf16_t* AG = (const bf16_t*)(p.ws + OFF_AG);
  bf16x8 qf[2][4];
#pragma unroll
  for (int j = 0; j < 2; ++j)
#pragma unroll
    for (int ks = 0; ks < 4; ++ks)
      qf[j][ks] = *(const bf16x8*)(Q + (size_t)(qrow0 + j * 32 + fr) * 512 + head * 64 + ks * 16 + fh * 8);
  f32x16 o[2][2];
  zero_acc(o);
  float m[2], lsum[2];
  m[0] = m[1] = p.attn_sink[l * 8 + head];
  lsum[0] = lsum[1] = 1.f;
  const int nblk = ctxq ? 2 : 5;
  for (int bi = 0; bi < nblk; ++bi) {
    int krow0, kpos0 = 0;
    bool masked = false;
    if (bi < 2) {
      krow0 = RL_ + b * 256 + bi * 128;
    } else {
      const int kb = qblk + bi - 3;
      if (kb < 0 || kb >= 32) continue;
      krow0 = b * 4096 + kb * 128;
      kpos0 = kb * 128;
      masked = (bi != 3);
    }
    __syncthreads();
    for (int v = tid; v < 1024; v += 256) {
      const int r = v >> 3, cv = v & 7;
      *(uint4*)&sK[r * 72 + cv * 8] = *(const uint4*)(KV + (size_t)(krow0 + r) * 256 + g * 64 + cv * 8);
      *(uint4*)&sV[r * 72 + cv * 8] = *(const uint4*)(KV + (size_t)(krow0 + r) * 256 + 128 + g * 64 + cv * 8);
    }
    __syncthreads();
#pragma unroll 1
    for (int kb = 0; kb < 4; ++kb) {
      f32x16 st[2];
#pragma unroll
      for (int j = 0; j < 2; ++j)
#pragma unroll
        for (int r = 0; r < 16; ++r) st[j][r] = 0.f;
#pragma unroll
      for (int ks = 0; ks < 4; ++ks) {
        const bf16x8 kf = *(const bf16x8*)&sK[(kb * 32 + fr) * 72 + ks * 16 + fh * 8];
#pragma unroll
        for (int j = 0; j < 2; ++j) st[j] = MFMA(kf, qf[j][ks], st[j]);
      }
      bf16x8 pb[2][2];
#pragma unroll
      for (int j = 0; j < 2; ++j) {
        if (masked) {
          const int qpos = qpos0 + j * 32 + fr;
#pragma unroll
          for (int r = 0; r < 16; ++r) {
            const int d = qpos - (kpos0 + kb * 32 + crow(r, fh));
            if (d > 128 || d < -128) st[j][r] = -1e30f;
          }
        }
        float mx = st[j][0];
#pragma unroll
        for (int r = 1; r < 16; ++r) mx = fmaxf(mx, st[j][r]);
        mx = fmaxf(mx, __shfl_xor(mx, 32));
        const float mnew = fmaxf(m[j], mx);
        const float alpha = __expf(m[j] - mnew);
        float rs = 0.f;
#pragma unroll
        for (int r = 0; r < 16; ++r) { const float pv = __expf(st[j][r] - mnew); st[j][r] = pv; rs += pv; }
        rs += __shfl_xor(rs, 32);
        lsum[j] = lsum[j] * alpha + rs;
        m[j] = mnew;
#pragma unroll
        for (int mt = 0; mt < 2; ++mt)
#pragma unroll
          for (int r = 0; r < 16; ++r) o[mt][j][r] *= alpha;
#pragma unroll
        for (int s = 0; s < 2; ++s)
#pragma unroll
          for (int jj = 0; jj < 8; ++jj) pb[j][s][jj] = (short)f2bf(st[j][8 * s + jj]);
      }
#pragma unroll
      for (int s = 0; s < 2; ++s)
#pragma unroll
        for (int mt = 0; mt < 2; ++mt) {
          const bf16x8 vf = tr_frag(sV, 72, kb * 32 + 16 * s + 4 * fh, kb * 32 + 16 * s + 8 + 4 * fh, mt * 32);
#pragma unroll
          for (int j = 0; j < 2; ++j) o[mt][j] = MFMA(vf, pb[j][s], o[mt][j]);
        }
    }
  }
#pragma unroll
  for (int j = 0; j < 2; ++j) {
    const float inv = 1.f / lsum[j];
    const size_t rho = (size_t)(qrow0 + j * 32 + fr);
#pragma unroll
    for (int mt = 0; mt < 2; ++mt)
#pragma unroll
      for (int g4 = 0; g4 < 4; ++g4) {
        const int d0 = mt * 32 + 8 * g4 + 4 * fh;
        const uint2 gv = *(const uint2*)(AG + rho * 512 + head * 64 + d0);
        uint2 ov;
        ov.x = pack2(o[mt][j][g4 * 4 + 0] * inv * silu_f(lo2f(gv.x)), o[mt][j][g4 * 4 + 1] * inv * silu_f(hi2f(gv.x)));
        ov.y = pack2(o[mt][j][g4 * 4 + 2] * inv * silu_f(lo2f(gv.y)), o[mt][j][g4 * 4 + 3] * inv * silu_f(hi2f(gv.y)));
        *(uint2*)(Q + rho * 512 + head * 64 + d0) = ov;
      }
  }
}

DI void states_item(const Params& p_in, char* smem, int ck, int g, int hq) {
  const Params p = load_params();

  bf16_t* sB = (bf16_t*)smem;
  bf16_t* sX = (bf16_t*)(smem + 128 * 136 * 2);
  int tid = threadIdx.x; asm volatile("" : "+v"(tid)); const int lane = tid & 63, wave = tid >> 6, wr = wave >> 1, wc = wave & 1, fr = lane & 31, fh = lane >> 5;
  const bf16_t* BC = (const bf16_t*)(p.ws + OFF_BC);
  const bf16_t* XS = (const bf16_t*)(p.ws + OFF_H);
  const float* DT = (const float*)(p.ws + OFF_DT);
  const float* CS = (const float*)(p.ws + OFF_CS);
  bf16_t* ST = (bf16_t*)(p.ws + OFF_ST);
  float* CDEC = (float*)(p.ws + OFF_CDEC);
  const int row0 = ck * 128;
  __syncthreads();
  for (int v = tid; v < 2048; v += 256) {
    const int r = v >> 4, cv = v & 15;
    *(uint4*)&sB[r * 136 + cv * 8] = *(const uint4*)(BC + (size_t)(row0 + r) * 512 + g * 128 + cv * 8);
  }
  __syncthreads();
  bf16x8 bfr[2][8];
#pragma unroll
  for (int j = 0; j < 2; ++j)
#pragma unroll
    for (int ks = 0; ks < 8; ++ks) bfr[j][ks] = tr_frag(sB, 136, ks * 16 + 8 * fh, ks * 16 + 8 * fh + 4, wc * 64 + j * 32);
#pragma unroll 1
  for (int hd = 0; hd < 8; ++hd) {
    const int head = g * 8 + hq * 4 + (hd >> 1), d = hd & 1;
    const int col = d * 16 + head;
    const float cend = CS[(size_t)(row0 + (d == 0 ? 127 : 0)) * 32 + col];
    for (int v = tid; v < 1024; v += 256) {
      const int lr = v >> 3, cv = v & 7;
      const size_t rho = (size_t)(row0 + lr);
      const float sc = DT[rho * 32 + col] * __expf(cend - CS[rho * 32 + col]);
      const uint4 u = *(const uint4*)(XS + rho * 1024 + head * 64 + cv * 8);
      uint4 o;
      o.x = pack2(lo2f(u.x) * sc, hi2f(u.x) * sc); o.y = pack2(lo2f(u.y) * sc, hi2f(u.y) * sc);
      o.z = pack2(lo2f(u.z) * sc, hi2f(u.z) * sc); o.w = pack2(lo2f(u.w) * sc, hi2f(u.w) * sc);
      *(uint4*)&sX[lr * 72 + cv * 8] = o;
    }
    __syncthreads();
    f32x16 acc[2];
#pragma unroll
    for (int j = 0; j < 2; ++j)
#pragma unroll
      for (int r = 0; r < 16; ++r) acc[j][r] = 0.f;
#pragma unroll
    for (int ks = 0; ks < 8; ++ks) {
      const bf16x8 af = tr_frag(sX, 72, ks * 16 + 8 * fh, ks * 16 + 8 * fh + 4, wr * 32);
#pragma unroll
      for (int j = 0; j < 2; ++j) acc[j] = MFMA(af, bfr[j][ks], acc[j]);
    }
    bf16_t* dst = ST + ((size_t)(ck * 2 + d) * 16 + head) * 8192;
#pragma unroll
    for (int j = 0; j < 2; ++j)
#pragma unroll
      for (int r = 0; r < 16; ++r) dst[(wr * 32 + crow(r, fh)) * 128 + wc * 64 + j * 32 + fr] = f2bf(acc[j][r]);
    if (tid == 0) CDEC[(ck * 2 + d) * 16 + head] = __expf(cend);
    __syncthreads();
  }
}

DI void pw_item(const Params& p_in, int l, char* smem, int mt, int nt) {
  const Params p = load_params();

  GemmS* s = (GemmS*)smem;
  int tid = threadIdx.x; asm volatile("" : "+v"(tid)); const int lane = tid & 63, wave = tid >> 6, wr = wave >> 1, wc = wave & 1, fr = lane & 31, fh = lane >> 5;
  const bf16_t* Ab = (const bf16_t*)(p.ws + OFF_HDN) + (size_t)mt * 128 * 512;
  const bf16_t* Bb = (const bf16_t*)(p.ws + OFF_PW) + (size_t)nt * 128 * 512;
  bf16_t* CG = (bf16_t*)(p.ws + OFF_CG);
  f32x16 acc[2][2];
  zero_acc(acc);
  gemm_core(acc, s,
            [&](int kt, int r, int kv) { return Ab + (size_t)r * 512 + kt * 32 + kv * 8; },
            [&](int kt, int r, int kv) { return Bb + (size_t)r * 512 + kt * 32 + kv * 8; }, 16);
  const float* pwb = p.conv_pw_b + l * 512 + nt * 128;
  epilogue_lds(acc, smem, [&](int rl, int c4, float4 v) {
    bf16_t* ptr = CG + (size_t)(mt * 128 + rl) * 512 + nt * 128 + c4;
    const uint2 gv = *(const uint2*)ptr;
    const float4 bb = *(const float4*)(pwb + c4);
    uint2 o;
    o.x = pack2((v.x + bb.x) * silu_f(lo2f(gv.x)), (v.y + bb.y) * silu_f(hi2f(gv.x)));
    o.y = pack2((v.z + bb.z) * silu_f(lo2f(gv.y)), (v.w + bb.w) * silu_f(hi2f(gv.y)));
    *(uint2*)ptr = o;
  });
}

DI void phase_mix(const Params& p, int l, char* smem) {
  const int N_ATT = 512 + (l == 0 ? 32 : 0);
  const int N_ST = NCK * 4;
  const int N_PW = NCK * 4;
  const int NT = N_ATT + N_ST + N_PW;
  for (int it0 = blockIdx.x; it0 < NT; it0 += gridDim.x) {
    int it = it0;
    if (it < N_ATT) {
      if (it < 512) attn_item(p, l, smem, it >> 7, (it >> 2) & 31, (it >> 1) & 1, it & 1, false);
      else { const int t = it - 512; attn_item(p, l, smem, t >> 3, (t >> 2) & 1, (t >> 1) & 1, t & 1, true); }
      continue;
    }
    it -= N_ATT;
    if (it < N_ST) { states_item(p, smem, it >> 2, (it >> 1) & 1, it & 1); continue; }
    it -= N_ST;
    pw_item(p, l, smem, it >> 2, it & 3);
  }
}

DI void phase_scan(const Params& p_in) {
  const Params p = load_params();

  bf16_t* ST = (bf16_t*)(p.ws + OFF_ST);
  const float* CDEC = (const float*)(p.ws + OFF_CDEC);
  for (int it = blockIdx.x; it < 512; it += gridDim.x) {
    const int e = it * 256 + threadIdx.x;
    const int bdh = e >> 10, v8 = e & 1023;
    const int b = bdh >> 5, d = (bdh >> 4) & 1, h = bdh & 15;
    float s[8];
#pragma unroll
    for (int i = 0; i < 8; ++i) s[i] = 0.f;
    auto ckof = [&](int i) {
      if (d == 0) return (i < 2) ? (128 + 2 * b + i) : (32 * b + (i - 2));
      return (i < 2) ? (128 + 2 * b + (1 - i)) : (32 * b + 31 - (i - 2));
    };
    int ck = ckof(0);
    uint4* ptr = (uint4*)(ST + ((size_t)(ck * 2 + d) * 16 + h) * 8192 + v8 * 8);
    uint4 cur = *ptr;
    float dec = CDEC[(ck * 2 + d) * 16 + h];
#pragma unroll 1
    for (int i = 0; i < 34; ++i) {
      uint4 nxt = cur; float ndec = 0.f; uint4* nptr = ptr;
      if (i + 1 < 34) {
        const int nck = ckof(i + 1);
        nptr = (uint4*)(ST + ((size_t)(nck * 2 + d) * 16 + h) * 8192 + v8 * 8);
        nxt = *nptr;
        ndec = CDEC[(nck * 2 + d) * 16 + h];
      }
      uint4 o;
      o.x = pack2(s[0], s[1]); o.y = pack2(s[2], s[3]); o.z = pack2(s[4], s[5]); o.w = pack2(s[6], s[7]);
      *ptr = o;
      s[0] = s[0] * dec + lo2f(cur.x); s[1] = s[1] * dec + hi2f(cur.x);
      s[2] = s[2] * dec + lo2f(cur.y); s[3] = s[3] * dec + hi2f(cur.y);
      s[4] = s[4] * dec + lo2f(cur.z); s[5] = s[5] * dec + hi2f(cur.z);
      s[6] = s[6] * dec + lo2f(cur.w); s[7] = s[7] * dec + hi2f(cur.w);
      cur = nxt; dec = ndec; ptr = nptr;
    }
  }
}

DI void phase_ssdy(const Params& p_in, int l, char* smem) {
  const Params p = load_params();

  bf16_t* sB = (bf16_t*)smem;
  bf16_t* sX = (bf16_t*)(smem + 128 * 136 * 2);
  float* sF = (float*)(smem + 128 * 136 * 2 + 128 * 72 * 2);
  float* sSS = sF + 512;
  int tid = threadIdx.x; asm volatile("" : "+v"(tid)); const int lane = tid & 63, wave = tid >> 6, fr = lane & 31, fh = lane >> 5;
  const int wl = wave >> 1, w2 = wave & 1;
  const bf16_t* BC = (const bf16_t*)(p.ws + OFF_BC);
  const bf16_t* XS = (const bf16_t*)(p.ws + OFF_H);
  const float* DT = (const float*)(p.ws + OFF_DT);
  const float* CS = (const float*)(p.ws + OFF_CS);
  const bf16_t* ST = (const bf16_t*)(p.ws + OFF_ST);
  bf16_t* Z = (bf16_t*)(p.ws + OFF_Z);
  float* RSTD = (float*)(p.ws + OFF_RSTD);
  const int nck = (l == 0) ? NCK : 128;
  for (int it = blockIdx.x; it < nck * 4; it += gridDim.x) {
    const int ck = it >> 2, g = (it >> 1) & 1, lh = it & 1;
    const int row0 = ck * 128;
    const int lbase = lh * 64 + wl * 32;
    __syncthreads();
    for (int v = tid; v < 2048; v += 256) {
      const int r = v >> 4, cv = v & 15;
      *(uint4*)&sB[r * 136 + cv * 8] = *(const uint4*)(BC + (size_t)(row0 + r) * 512 + g * 128 + cv * 8);
    }
    if (tid < 64) sSS[tid] = 0.f;
    bf16x8 cf[8];
#pragma unroll
    for (int ks = 0; ks < 8; ++ks)
      cf[ks] = *(const bf16x8*)(BC + (size_t)(row0 + lbase + fr) * 512 + 256 + g * 128 + ks * 16 + fh * 8);
    __syncthreads();
    f32x16 cb[2];
#pragma unroll
    for (int j = 0; j < 2; ++j) {
#pragma unroll
      for (int r = 0; r < 16; ++r) cb[j][r] = 0.f;
#pragma unroll
      for (int ks = 0; ks < 8; ++ks) {
        const bf16x8 bq = *(const bf16x8*)&sB[(w2 * 64 + j * 32 + fr) * 136 + ks * 16 + fh * 8];
        cb[j] = MFMA(cf[ks], bq, cb[j]);
      }
    }
    float ssq[16];
#pragma unroll
    for (int r = 0; r < 16; ++r) ssq[r] = 0.f;
#pragma unroll 1
    for (int hh = 0; hh < 8; ++hh) {
      const int head = g * 8 + hh;
      __syncthreads();
      for (int v = tid; v < 1024; v += 256) {
        const int lr = v >> 3, cv = v & 7;
        *(uint4*)&sX[lr * 72 + cv * 8] = *(const uint4*)(XS + (size_t)(row0 + lr) * 1024 + head * 64 + cv * 8);
      }
      if (tid < 128) {
        const size_t rho = (size_t)(row0 + tid);
        sF[tid] = CS[rho * 32 + head];
        sF[128 + tid] = CS[rho * 32 + 16 + head];
        sF[256 + tid] = DT[rho * 32 + head];
        sF[384 + tid] = DT[rho * 32 + 16 + head];
      }
      __syncthreads();
#pragma unroll
      for (int j = 0; j < 2; ++j) {
        const int sidx = w2 * 64 + j * 32 + fr;
        const float csf_s = sF[sidx], csb_s = sF[128 + sidx], dtf_s = sF[256 + sidx], dtb_s = sF[384 + sidx];
#pragma unroll
        for (int r = 0; r < 16; ++r) {
          const int lidx = lbase + crow(r, fh);
          float f = 0.f;
          if (sidx <= lidx) f += __expf(sF[lidx] - csf_s) * dtf_s;
          if (sidx >= lidx) f += __expf(sF[128 + lidx] - csb_s) * dtb_s;
          sB[(wl * 32 + crow(r, fh)) * 136 + sidx] = f2bf(cb[j][r] * f);
        }
      }
      __syncthreads();
      f32x16 accy;
#pragma unroll
      for (int r = 0; r < 16; ++r) accy[r] = 0.f;
#pragma unroll
      for (int ks = 0; ks < 8; ++ks) {
        const bf16x8 af = *(const bf16x8*)&sB[(wl * 32 + fr) * 136 + ks * 16 + fh * 8];
        const bf16x8 xf = tr_frag(sX, 72, ks * 16 + 8 * fh, ks * 16 + 8 * fh + 4, w2 * 32);
        accy = MFMA(af, xf, accy);
      }
#pragma unroll 1
      for (int d = 0; d < 2; ++d) {
        f32x16 acct;
#pragma unroll
        for (int r = 0; r < 16; ++r) acct[r] = 0.f;
        const bf16_t* Sd = ST + ((size_t)(ck * 2 + d) * 16 + head) * 8192;
#pragma unroll
        for (int ks = 0; ks < 8; ++ks) {
          const bf16x8 sf = *(const bf16x8*)(Sd + (w2 * 32 + fr) * 128 + ks * 16 + fh * 8);
          acct = MFMA(cf[ks], sf, acct);
        }
#pragma unroll
        for (int r = 0; r < 16; ++r) accy[r] += __expf(sF[d * 128 + lbase + crow(r, fh)]) * acct[r];
      }
      const float dsk = p.ssd_d[l * 16 + head];
      const int pidx = w2 * 32 + fr;
#pragma unroll
      for (int r = 0; r < 16; ++r) {
        const int lidx = lbase + crow(r, fh);
        const float xv = bf2f(sX[lidx * 72 + pidx]);
        const float y = accy[r] + dsk * xv;
        bf16_t* zp = Z + (size_t)(row0 + lidx) * 1024 + head * 64 + pidx;
        const float u = y * silu_f(bf2f(*zp));
        ssq[r] += u * u;
        *zp = f2bf(u);
      }
    }
#pragma unroll
    for (int r = 0; r < 16; ++r) {
      float v = ssq[r];
#pragma unroll
      for (int o = 16; o >= 1; o >>= 1) v += __shfl_xor(v, o);
      if (fr == 0) atomicAdd(&sSS[wl * 32 + crow(r, fh)], v);
    }
    __syncthreads();
    if (tid < 64) RSTD[(size_t)(row0 + lh * 64 + tid) * 2 + g] = rsqrtf(sSS[tid] * (1.f / 512.f) + 1e-6f);
  }
}

DI void phase_outproj(const Params& p_in, int l, char* smem) {
  const Params p = load_params();

  GemmS* s = (GemmS*)smem;
  int tid = threadIdx.x; asm volatile("" : "+v"(tid)); const int lane = tid & 63, wave = tid >> 6, wr = wave >> 1, wc = wave & 1, fr = lane & 31, fh = lane >> 5;
  const bf16_t* Zb = (const bf16_t*)(p.ws + OFF_Z);
  const bf16_t* Qb = (const bf16_t*)(p.ws + OFF_Q);
  const bf16_t* Cb = (const bf16_t*)(p.ws + OFF_CG);
  const bf16_t* W = (const bf16_t*)(p.ws + OFF_WOUT);
  const float* RSTD = (const float*)(p.ws + OFF_RSTD);
  const float* mods = (const float*)(p.ws + OFF_MODS);
  float* XC = (float*)(p.ws + OFF_XC);
  const int nM = (l == 0) ? NCK : 128;
  for (int it = blockIdx.x; it < nM * 8; it += gridDim.x) {
    const int mt = it >> 3, nt = it & 7;
    f32x16 acc[2][2];
    zero_acc(acc);
    const bf16_t* Wb = W + (size_t)nt * 128 * 2048;
    const bf16_t* A0 = Zb + (size_t)mt * 128 * 1024;
    const bf16_t* A2 = Qb + (size_t)mt * 128 * 512;
    const bf16_t* A3 = Cb + (size_t)mt * 128 * 512;
    gemm_core(acc, s,
              [&](int kt, int r, int kv) { return A0 + (size_t)r * 1024 + kt * 32 + kv * 8; },
              [&](int kt, int r, int kv) { return Wb + (size_t)r * 2048 + kt * 32 + kv * 8; }, 16);
#pragma unroll
    for (int i = 0; i < 2; ++i)
#pragma unroll
      for (int r = 0; r < 16; ++r) {
        const size_t row = (size_t)(mt * 128 + wr * 64 + i * 32 + crow(r, fh));
        const float f = RSTD[row * 2] / RSTD[row * 2 + 1];
        acc[i][0][r] *= f; acc[i][1][r] *= f;
      }
    gemm_core(acc, s,
              [&](int kt, int r, int kv) { return A0 + (size_t)r * 1024 + 512 + kt * 32 + kv * 8; },
              [&](int kt, int r, int kv) { return Wb + (size_t)r * 2048 + 512 + kt * 32 + kv * 8; }, 16);
#pragma unroll
    for (int i = 0; i < 2; ++i)
#pragma unroll
      for (int r = 0; r < 16; ++r) {
        const size_t row = (size_t)(mt * 128 + wr * 64 + i * 32 + crow(r, fh));
        const float f = RSTD[row * 2 + 1];
        acc[i][0][r] *= f; acc[i][1][r] *= f;
      }
    gemm_core(acc, s,
              [&](int kt, int r, int kv) { return A2 + (size_t)r * 512 + kt * 32 + kv * 8; },
              [&](int kt, int r, int kv) { return Wb + (size_t)r * 2048 + 1024 + kt * 32 + kv * 8; }, 16);
    gemm_core(acc, s,
              [&](int kt, int r, int kv) { return A3 + (size_t)r * 512 + kt * 32 + kv * 8; },
              [&](int kt, int r, int kv) { return Wb + (size_t)r * 2048 + 1536 + kt * 32 + kv * 8; }, 16);
    {
      const int row0 = mt * 128;
      const int vv = (row0 < RL_) ? (row0 >> 12) : 4;
      const float* gate = mods + (l * 5 + vv) * 3072 + 2048 + nt * 128;
      float* xnew = (row0 < RL_) ? (p.out + (size_t)row0 * 1024) : (XC + (size_t)(row0 - RL_) * 1024);
      const float* xold = (l == 0) ? ((row0 < RL_) ? (p.x + (size_t)row0 * 1024) : (p.ctx + (size_t)(row0 - RL_) * 1024)) : xnew;
      epilogue_lds(acc, smem, [&](int rl, int c4, float4 v) {
        const int off = rl * 1024 + nt * 128 + c4;
        const float4 xo = *(const float4*)(xold + off);
        const float4 gt = *(const float4*)(gate + c4);
        float4 o;
        o.x = xo.x + gt.x * v.x; o.y = xo.y + gt.y * v.y; o.z = xo.z + gt.z * v.z; o.w = xo.w + gt.w * v.w;
        *(float4*)(xnew + off) = o;
      });
    }
  }
}

DI void phase_final(const Params& p_in) {
  const Params p = load_params();
  const int lane = threadIdx.x & 63, wave = threadIdx.x >> 6;
  for (int it = blockIdx.x; it < RL_ / 4; it += gridDim.x) {
    float* xr = p.out + (size_t)(it * 4 + wave) * 1024;
    float4 xv[4];
    float ss = 0.f;
#pragma unroll
    for (int i = 0; i < 4; ++i) {
      xv[i] = *(const float4*)(xr + lane * 4 + i * 256);
      ss += xv[i].x * xv[i].x + xv[i].y * xv[i].y + xv[i].z * xv[i].z + xv[i].w * xv[i].w;
    }
#pragma unroll
    for (int o = 32; o >= 1; o >>= 1) ss += __shfl_xor(ss, o);
    const float rs = rsqrtf(ss * (1.f / 1024.f) + 1e-6f);
#pragma unroll
    for (int i = 0; i < 4; ++i) {
      const float4 w = *(const float4*)(p.final_norm_w + lane * 4 + i * 256);
      float4 o;
      o.x = xv[i].x * rs * w.x; o.y = xv[i].y * rs * w.y; o.z = xv[i].z * rs * w.z; o.w = xv[i].w * rs * w.w;
      *(float4*)(xr + lane * 4 + i * 256) = o;
    }
  }
}

DI void run_phase(const Params& p, int ph, char* smem) {
  if (ph == 0) { phase_mods(p, smem); return; }
  if (ph == 15) { phase_final(p); return; }
  const int l = (ph - 1) / 7, s = (ph - 1) % 7;
  switch (s) {
    case 0: phase_prep(p, l, smem); break;
    case 1: phase_inproj(p, smem); break;
    case 2: phase_local(p, l, smem); break;
    case 3: phase_mix(p, l, smem); break;
    case 4: phase_scan(p); break;
    case 5: phase_ssdy(p, l, smem); break;
    default: phase_outproj(p, l, smem); break;
  }
}

__global__ void __launch_bounds__(256, 2) fwd_megakernel(Params p, int ph_lo, int ph_hi, int coop) {
  __shared__ __attribute__((aligned(16))) char smem[57344];
  if (coop) {
    cg::grid_group grid = cg::this_grid();
    for (int ph = ph_lo; ph <= ph_hi; ++ph) {
      run_phase(p, ph, smem);
      if (ph < ph_hi) grid.sync();
    }
  } else {
    for (int ph = ph_lo; ph <= ph_hi; ++ph) run_phase(p, ph, smem);
  }
}

extern "C" void kernel_launch(void* const* d_in, const int* in_sizes, int n_in, void* d_out, int out_size, void* d_ws,
                              size_t ws_size, hipStream_t stream) {
  static int grid_blocks = 0;
  if (!grid_blocks) {
    int dev = 0, cus = 0, per_cu = 0;
    hipGetDevice(&dev);
    hipDeviceGetAttribute(&cus, hipDeviceAttributeMultiprocessorCount, dev);
    hipOccupancyMaxActiveBlocksPerMultiprocessor(&per_cu, fwd_megakernel, 256, 0);
    if (per_cu < 1) per_cu = 1;
    if (per_cu > 2) per_cu = 2;
    grid_blocks = cus * per_cu;
  }
  Params p{};
  const float** pp = (const float**)&p;
  for (int i = 0; i < 23; ++i) pp[i] = (const float*)d_in[i];
  p.out = (float*)d_out;
  p.ws = (char*)d_ws;
#if ONE_LAUNCH
  int lo = 0, hi = 15, coop = 1;
  void* args[] = {&p, &lo, &hi, &coop};
  hipError_t e = hipLaunchCooperativeKernel((void*)fwd_megakernel, dim3(grid_blocks), dim3(256), args, 0, stream);
  if (e != hipSuccess) fprintf(stderr, "cooperative launch failed: %s (grid %d)\n", hipGetErrorString(e), grid_blocks);
#else
  for (int ph = 0; ph <= 15; ++ph) fwd_megakernel<<<grid_blocks, 256, 0, stream>>>(p, ph, ph, 0);
#endif
}
```

```cpp
#include <hip/hip_runtime.h>
#include <hip/hip_cooperative_groups.h>
#include <stdint.h>
#include <stdio.h>
namespace cg = cooperative_groups;

#ifndef ONE_LAUNCH
#define ONE_LAUNCH 1
#endif

#ifndef PROBE_S
#define PROBE_S -1
#endif
#define DI __device__ __forceinline__
typedef unsigned short bf16_t;
using bf16x8 = __attribute__((ext_vector_type(8))) short;
using s16x4 = __attribute__((ext_vector_type(4))) short;
using f32x16 = __attribute__((ext_vector_type(16))) float;
#define MFMA(a, b, c) __builtin_amdgcn_mfma_f32_32x32x16_bf16((a), (b), (c), 0, 0, 0)

constexpr int R_ = 17408;
constexpr int RL_ = 16384;
constexpr int NCK = 136;

constexpr size_t SZ_WIN = (size_t)5504 * 1024 * 2;
constexpr size_t SZ_WOUT = (size_t)1024 * 2048 * 2;
constexpr size_t SZ_PW = (size_t)512 * 512 * 2;
constexpr size_t SZ_MODS = (size_t)2 * 5 * 3072 * 4;
constexpr size_t SZ_XC = (size_t)1024 * 1024 * 4;
constexpr size_t SZ_RSTD = (size_t)R_ * 2 * 4;
constexpr size_t SZ_CDEC = (size_t)NCK * 32 * 4 + 256 - ((size_t)NCK * 32 * 4) % 256;
constexpr size_t SZ_R512 = (size_t)R_ * 512 * 2;
constexpr size_t OFF_WIN = 0;
constexpr size_t OFF_WOUT = OFF_WIN + SZ_WIN;
constexpr size_t OFF_PW = OFF_WOUT + SZ_WOUT;
constexpr size_t OFF_MODS = OFF_PW + SZ_PW;
constexpr size_t OFF_XC = OFF_MODS + SZ_MODS;
constexpr size_t OFF_RSTD = OFF_XC + SZ_XC;
constexpr size_t OFF_CDEC = OFF_RSTD + SZ_RSTD;
constexpr size_t OFF_H = OFF_CDEC + SZ_CDEC;
constexpr size_t OFF_XBC = OFF_H + 2 * SZ_R512;
constexpr size_t OFF_GLU = OFF_XBC + 3 * SZ_R512;
constexpr size_t OFF_ST = OFF_XBC;
constexpr size_t OFF_Z = OFF_GLU + SZ_R512;
constexpr size_t OFF_DT = OFF_Z + 2 * SZ_R512;
constexpr size_t OFF_CS = OFF_DT + (size_t)R_ * 32 * 4;
constexpr size_t OFF_Q = OFF_CS + (size_t)R_ * 32 * 4;
constexpr size_t OFF_KV = OFF_Q + SZ_R512;
constexpr size_t OFF_AG = OFF_KV + SZ_R512 / 2;
constexpr size_t OFF_CG = OFF_AG + SZ_R512;
constexpr size_t OFF_BC = OFF_CG + SZ_R512;
constexpr size_t OFF_HDN = OFF_BC + SZ_R512;
constexpr size_t WS_TOTAL = OFF_HDN + SZ_R512;
constexpr size_t OFF_BAR = WS_TOTAL;
static_assert(OFF_BAR + 16384 <= (size_t)256 * 1024 * 1024, "workspace too large");

struct Params {
  const float *x, *c, *ctx, *c_ctx, *w_mod, *b_mod, *norm_w, *w_in, *ssd_conv_w, *ssd_conv_b, *ssd_dt_bias, *ssd_a_log,
      *ssd_d, *ssd_norm_w, *attn_sink, *conv_dw_w, *conv_dw_b, *conv_ln_w, *conv_ln_b, *conv_pw_w, *conv_pw_b, *w_out,
      *final_norm_w;
  float* out;
  char* ws;
};


DI Params load_params() {
  typedef const char __attribute__((address_space(4)))* kptr_t;
  typedef const float* const __attribute__((address_space(4)))* kfld_t;
  size_t off = 0;
  asm volatile("" : "+s"(off));
  kptr_t base = (kptr_t)__builtin_amdgcn_kernarg_segment_ptr() + off;
  Params p;
  const float** pp = (const float**)&p;
#pragma unroll
  for (int i = 0; i < 25; ++i) pp[i] = *(kfld_t)(base + 8 * i);
  return p;
}

#define XB_TMO      128
#define XB_XCNT(j)  (256  + 64 * (j))
#define XB_XSUB(j)  (1280 + 64 * (j))
#define XB_XGEN(j)  (2304 + 64 * (j))
#define XB_TOP      3328
#define XB_TOPGEN   3392
#define XCD_BAR_WORDS 3456
#define XB_SPIN_CAP (1u << 18)
#define LAS __attribute__((address_space(3)))
DI unsigned xb_ld(unsigned* p)              { return __hip_atomic_load(p, __ATOMIC_RELAXED, __HIP_MEMORY_SCOPE_AGENT); }
DI unsigned xb_add(unsigned* p, unsigned v) { return __hip_atomic_fetch_add(p, v, __ATOMIC_RELAXED, __HIP_MEMORY_SCOPE_AGENT); }
DI unsigned xb_xcc_id() { return (unsigned)__builtin_amdgcn_s_getreg((3 << 11) | 20) & 0xFu; }
#define XB_SPIN(cond, bar) do { unsigned _sp = 0; while (cond) { __builtin_amdgcn_s_sleep(1); \
    if ((++_sp & 255u) == 0u) { if (xb_ld(&(bar)[XB_TMO])) break; if (_sp > XB_SPIN_CAP) { atomicAdd(&(bar)[XB_TMO], 1u); break; } } } } while (0)

DI void xcd_barrier_complete(unsigned* bar, unsigned x, unsigned& nloc, unsigned& nx) {
  const unsigned G = gridDim.x * gridDim.y * gridDim.z;
  unsigned sum, cnt, mine, sp = 0u;
  for (;;) {
    sum = 0u; cnt = 0u; mine = 0u;
#pragma unroll
    for (unsigned j = 0; j < 16; ++j) { const unsigned c = xb_ld(&bar[XB_XCNT(j)]); sum += c; cnt += (c > 0u) ? 1u : 0u; mine = (j == x) ? c : mine; }
    if (sum == G) break;
    __builtin_amdgcn_s_sleep(1);
    if ((++sp & 255u) == 0u) { if (xb_ld(&bar[XB_TMO])) break; if (sp > XB_SPIN_CAP) { atomicAdd(&bar[XB_TMO], 1u); break; } }
  }
  nloc = mine > 0u ? mine : 1u; nx = cnt > 0u ? cnt : 1u;
}

DI void xcd_barrier(volatile LAS unsigned* st) {
  asm volatile("s_waitcnt vmcnt(0)" ::: "memory");
  __syncthreads();
  if (threadIdx.x == 0) {
    const Params pb = load_params();
    unsigned* bar = (unsigned*)(pb.ws + OFF_BAR);
    const unsigned x = xb_xcc_id();
    __builtin_amdgcn_s_waitcnt(0);
    unsigned nloc = st[0], nx = st[1];
    if (nloc == 0u) { xcd_barrier_complete(bar, x, nloc, nx); st[0] = nloc; st[1] = nx; }
    const unsigned old = xb_add(&bar[XB_XSUB(x)], 1u);
    const unsigned gen = old / nloc;
    if (old + 1u == (gen + 1u) * nloc) {
      __builtin_amdgcn_fence(__ATOMIC_RELEASE, "agent");
      asm volatile("s_waitcnt vmcnt(0)" ::: "memory");
      const unsigned og = xb_add(&bar[XB_TOP], 1u);
      const unsigned tg = og / nx;
      if (og + 1u == (tg + 1u) * nx) xb_add(&bar[XB_TOPGEN], 1u);
      else XB_SPIN(xb_ld(&bar[XB_TOPGEN]) == tg, bar);
      __builtin_amdgcn_fence(__ATOMIC_ACQUIRE, "agent");
      xb_add(&bar[XB_XGEN(x)], 1u);
      asm volatile("s_waitcnt vmcnt(0)" ::: "memory");
    } else {
      XB_SPIN(xb_ld(&bar[XB_XGEN(x)]) == gen, bar);
      __builtin_amdgcn_fence(__ATOMIC_ACQUIRE, "agent");
      asm volatile("s_waitcnt vmcnt(0)" ::: "memory");
    }
  }
  __syncthreads();
}

DI unsigned short f2bf(float x) { unsigned u = __float_as_uint(x); u += 0x7fffu + ((u >> 16) & 1u); return (unsigned short)(u >> 16); }
DI float bf2f(unsigned short b) { return __uint_as_float(((unsigned)b) << 16); }
DI unsigned pack2(float a, float b) { return (unsigned)f2bf(a) | ((unsigned)f2bf(b) << 16); }
DI float lo2f(unsigned u) { return __uint_as_float(u << 16); }
DI float hi2f(unsigned u) { return __uint_as_float(u & 0xffff0000u); }
DI float silu_f(float x) { return x / (1.f + __expf(-x)); }
DI float sigmoid_f(float x) { return 1.f / (1.f + __expf(-x)); }
DI int crow(int reg, int h) { return (reg & 3) + 8 * (reg >> 2) + 4 * h; }

DI bf16x8 tr_frag(const bf16_t* s, int ld, int row_lo, int row_hi, int col0) {
  const int lane = threadIdx.x & 63;
  const int i16 = lane & 15, q = i16 >> 2, pp = i16 & 3, blk = (lane >> 4) & 1;
  const unsigned a0 = (unsigned)(size_t)(s + (row_lo + q) * ld + col0 + 16 * blk + 4 * pp);
  const unsigned a1 = (unsigned)(size_t)(s + (row_hi + q) * ld + col0 + 16 * blk + 4 * pp);
  s16x4 lo, hi;
  asm volatile("ds_read_b64_tr_b16 %0, %2\n\tds_read_b64_tr_b16 %1, %3\n\ts_waitcnt lgkmcnt(0)"
               : "=&v"(lo), "=&v"(hi) : "v"(a0), "v"(a1) : "memory");
  return __builtin_shufflevector(lo, hi, 0, 1, 2, 3, 4, 5, 6, 7);
}

struct GemmS { bf16_t a[2][128][40]; bf16_t b[2][128][40]; };

template <class AF, class BF>
DI void gemm_core(f32x16 (&acc)[2][2], GemmS* s, AF aptr, BF bptr, int nk) {
  int tid = threadIdx.x; asm volatile("" : "+v"(tid)); const int lane = tid & 63, wave = tid >> 6, wr = wave >> 1, wc = wave & 1;
  const int r0 = tid >> 2, kv = tid & 3;
  const int fr = lane & 31, fh = lane >> 5;
  uint4 ra0 = *(const uint4*)aptr(0, r0, kv), ra1 = *(const uint4*)aptr(0, r0 + 64, kv);
  uint4 rb0 = *(const uint4*)bptr(0, r0, kv), rb1 = *(const uint4*)bptr(0, r0 + 64, kv);
  *(uint4*)&s->a[0][r0][kv * 8] = ra0; *(uint4*)&s->a[0][r0 + 64][kv * 8] = ra1;
  *(uint4*)&s->b[0][r0][kv * 8] = rb0; *(uint4*)&s->b[0][r0 + 64][kv * 8] = rb1;
  __syncthreads();
#pragma unroll 1
  for (int kt = 0; kt < nk; ++kt) {
    const int buf = kt & 1;
    if (kt + 1 < nk) {
      ra0 = *(const uint4*)aptr(kt + 1, r0, kv); ra1 = *(const uint4*)aptr(kt + 1, r0 + 64, kv);
      rb0 = *(const uint4*)bptr(kt + 1, r0, kv); rb1 = *(const uint4*)bptr(kt + 1, r0 + 64, kv);
    }
#pragma unroll
    for (int ks = 0; ks < 2; ++ks) {
      bf16x8 af[2], bq[2];
#pragma unroll
      for (int i = 0; i < 2; ++i) af[i] = *(const bf16x8*)&s->a[buf][wr * 64 + i * 32 + fr][ks * 16 + fh * 8];
#pragma unroll
      for (int j = 0; j < 2; ++j) bq[j] = *(const bf16x8*)&s->b[buf][wc * 64 + j * 32 + fr][ks * 16 + fh * 8];
#pragma unroll
      for (int i = 0; i < 2; ++i)
#pragma unroll
        for (int j = 0; j < 2; ++j) acc[i][j] = MFMA(af[i], bq[j], acc[i][j]);
    }
    if (kt + 1 < nk) {
      *(uint4*)&s->a[buf ^ 1][r0][kv * 8] = ra0; *(uint4*)&s->a[buf ^ 1][r0 + 64][kv * 8] = ra1;
      *(uint4*)&s->b[buf ^ 1][r0][kv * 8] = rb0; *(uint4*)&s->b[buf ^ 1][r0 + 64][kv * 8] = rb1;
    }
    __syncthreads();
  }
}

DI void zero_acc(f32x16 (&acc)[2][2]) {
#pragma unroll
  for (int i = 0; i < 2; ++i)
#pragma unroll
    for (int j = 0; j < 2; ++j)
#pragma unroll
      for (int r = 0; r < 16; ++r) acc[i][j][r] = 0.f;
}

template <class EPI>
DI void epilogue_lds(f32x16 (&acc)[2][2], char* smem, EPI epi) {
  float* T = (float*)smem;
  int tid = threadIdx.x; asm volatile("" : "+v"(tid)); const int lane = tid & 63, wave = tid >> 6, wr = wave >> 1, wc = wave & 1, fr = lane & 31, fh = lane >> 5;
#pragma unroll
  for (int i = 0; i < 2; ++i) {
#pragma unroll
    for (int j = 0; j < 2; ++j)
#pragma unroll
      for (int r = 0; r < 16; ++r) T[(wr * 32 + crow(r, fh)) * 132 + wc * 64 + j * 32 + fr] = acc[i][j][r];
    __syncthreads();
#pragma unroll 2
    for (int e = tid; e < 2048; e += 256) {
      const int tr = e >> 5, c4 = (e & 31) * 4;
      const float4 v = *(const float4*)&T[tr * 132 + c4];
      epi((tr >> 5) * 64 + i * 32 + (tr & 31), c4, v);
    }
    __syncthreads();
  }
}

DI void phase_mods(const Params& p_in, char* smem) {
  const Params p = load_params();

  float* ssc = (float*)smem;
  float* red = (float*)(smem + 20480);
  float* mods = (float*)(p.ws + OFF_MODS);
  int tid = threadIdx.x; asm volatile("" : "+v"(tid));
  if (blockIdx.x == 0) { unsigned* bar = (unsigned*)(p.ws + OFF_BAR); for (int i = tid; i < XCD_BAR_WORDS; i += 256) bar[i] = 0u; }
  for (int it = blockIdx.x; it < 96; it += gridDim.x) {
    const int l = it / 48, col0 = (it % 48) * 64;
    __syncthreads();
    for (int e = tid; e < 5120; e += 256) {
      const int v = e >> 10, k = e & 1023;
      const float cv = (v < 4) ? p.c[v * 1024 + k] : p.c_ctx[k];
      ssc[e] = silu_f(cv);
    }
    __syncthreads();
    const int col = tid & 63, kg = tid >> 6;
    float a[5] = {0.f, 0.f, 0.f, 0.f, 0.f};
    const float* w = p.w_mod + (size_t)l * 1024 * 3072 + col0 + col;
    for (int k = kg * 256; k < kg * 256 + 256; ++k) {
      const float wv = w[(size_t)k * 3072];
#pragma unroll
      for (int v = 0; v < 5; ++v) a[v] += ssc[v * 1024 + k] * wv;
    }
#pragma unroll
    for (int v = 0; v < 5; ++v) red[(kg * 5 + v) * 64 + col] = a[v];
    __syncthreads();
    for (int e = tid; e < 320; e += 256) {
      const int v = e >> 6, cc = e & 63;
      float sum = p.b_mod[l * 3072 + col0 + cc];
      for (int g = 0; g < 4; ++g) sum += red[(g * 5 + v) * 64 + cc];
      mods[(l * 5 + v) * 3072 + col0 + cc] = sum;
    }
  }
}

DI int win_colmap(int n) {
  if (n < 2560) return n;
  if (n < 3840) return n + 32;
  if (n < 4864) {
    const int j = n - 3840, q64 = j >> 6, w = j & 63;
    return (w < 32) ? (3872 + q64 * 32 + w) : (3872 + 512 + q64 * 32 + (w - 32));
  }
  if (n < 5376) return n + 32;
  if (n < 5408) return n - 5376 + 2560;
  return -1;
}

DI void transpose_tile(const float* src, int ldsrc, int kind, const float* rowscale, bf16_t* dst, int lddst, int n0, int k0, float* tile) {
  int tid = threadIdx.x; asm volatile("" : "+v"(tid)); const int tx = tid & 63, ty = tid >> 6;
  __syncthreads();
  const int n = (kind == 0) ? win_colmap(n0 + tx) : (n0 + tx);
  for (int r = ty; r < 64; r += 4) {
    const int k = k0 + r;
    float v = 0.f;
    if (n >= 0) v = src[(size_t)k * ldsrc + n];
    if (rowscale != nullptr && k < 1024) v *= rowscale[k];
    tile[r * 65 + tx] = v;
  }
  __syncthreads();
  for (int r = ty; r < 64; r += 4) dst[(size_t)(n0 + r) * lddst + k0 + tx] = f2bf(tile[tx * 65 + r]);
}

DI void phase_prep(const Params& p_in, int l, char* smem) {
  const Params p = load_params();

  int tid = threadIdx.x; asm volatile("" : "+v"(tid)); const int lane = tid & 63, wave = tid >> 6;
  const float* mods = (const float*)(p.ws + OFF_MODS);
  bf16_t* H = (bf16_t*)(p.ws + OFF_H);
  const int NT_WIN = 86 * 16, NT_WOUT = 16 * 32, NT_PW = 64, NT_CONV = NT_WIN + NT_WOUT + NT_PW;
  const int NT = NT_CONV + R_ / 4;
  for (int it = blockIdx.x; it < NT; it += gridDim.x) {
    if (it < NT_WIN) {
      transpose_tile(p.w_in + (size_t)l * 1024 * 5408, 5408, 0, nullptr, (bf16_t*)(p.ws + OFF_WIN), 1024, (it / 16) * 64, (it % 16) * 64, (float*)smem);
    } else if (it < NT_WIN + NT_WOUT) {
      const int t = it - NT_WIN;
      transpose_tile(p.w_out + (size_t)l * 2048 * 1024, 1024, 1, p.ssd_norm_w + l * 1024, (bf16_t*)(p.ws + OFF_WOUT), 2048, (t / 32) * 64, (t % 32) * 64, (float*)smem);
    } else if (it < NT_CONV) {
      const int t = it - NT_WIN - NT_WOUT;
      transpose_tile(p.conv_pw_w + (size_t)l * 512 * 512, 512, 1, nullptr, (bf16_t*)(p.ws + OFF_PW), 512, (t / 8) * 64, (t % 8) * 64, (float*)smem);
    } else {
      const int rho = (it - NT_CONV) * 4 + wave;
      const float* xs;
      if (l == 0) xs = (rho < RL_) ? (p.x + (size_t)rho * 1024) : (p.ctx + (size_t)(rho - RL_) * 1024);
      else xs = (rho < RL_) ? (p.out + (size_t)rho * 1024) : ((const float*)(p.ws + OFF_XC) + (size_t)(rho - RL_) * 1024);
      const int v = (rho < RL_) ? (rho >> 12) : 4;
      const float* md = mods + (l * 5 + v) * 3072;
      float4 xv[4];
      float ss = 0.f;
#pragma unroll
      for (int i = 0; i < 4; ++i) {
        xv[i] = *(const float4*)(xs + lane * 4 + i * 256);
        ss += xv[i].x * xv[i].x + xv[i].y * xv[i].y + xv[i].z * xv[i].z + xv[i].w * xv[i].w;
      }
#pragma unroll
      for (int o = 32; o >= 1; o >>= 1) ss += __shfl_xor(ss, o);
      const float rs = rsqrtf(ss * (1.f / 1024.f) + 1e-6f);
#pragma unroll
      for (int i = 0; i < 4; ++i) {
        const int cidx = lane * 4 + i * 256;
        const float4 nw = *(const float4*)(p.norm_w + l * 1024 + cidx);
        const float4 sh = *(const float4*)(md + cidx);
        const float4 sc = *(const float4*)(md + 1024 + cidx);
        uint2 o;
        o.x = pack2(xv[i].x * rs * nw.x * (1.f + sc.x) + sh.x, xv[i].y * rs * nw.y * (1.f + sc.y) + sh.y);
        o.y = pack2(xv[i].z * rs * nw.z * (1.f + sc.z) + sh.z, xv[i].w * rs * nw.w * (1.f + sc.w) + sh.w);
        *(uint2*)(H + (size_t)rho * 1024 + cidx) = o;
      }
    }
  }
}

DI void phase_inproj(const Params& p_in, char* smem) {
  const Params p = load_params();

  GemmS* s = (GemmS*)smem;
  int tid = threadIdx.x; asm volatile("" : "+v"(tid)); const int lane = tid & 63, wave = tid >> 6, wr = wave >> 1, wc = wave & 1, fr = lane & 31, fh = lane >> 5;
  const bf16_t* H = (const bf16_t*)(p.ws + OFF_H);
  const bf16_t* W = (const bf16_t*)(p.ws + OFF_WIN);
  for (int it = blockIdx.x; it < NCK * 43; it += gridDim.x) {
    const int mt = it / 43, nt = it % 43;
    f32x16 acc[2][2];
    zero_acc(acc);
    const bf16_t* Ab = H + (size_t)mt * 128 * 1024;
    const bf16_t* Bb = W + (size_t)nt * 128 * 1024;
    gemm_core(acc, s,
              [&](int kt, int r, int kv) { return Ab + (size_t)r * 1024 + kt * 32 + kv * 8; },
              [&](int kt, int r, int kv) { return Bb + (size_t)r * 1024 + kt * 32 + kv * 8; }, 32);
    const int row0 = mt * 128;
    if (nt >= 30 && nt < 38) {
#pragma unroll
      for (int i = 0; i < 2; ++i)
#pragma unroll
        for (int r = 0; r < 16; ++r) acc[i][0][r] = acc[i][0][r] * sigmoid_f(acc[i][1][r]);
      bf16_t* G = (bf16_t*)(p.ws + OFF_GLU);
      const int cb0 = (nt - 30) * 64;
      epilogue_lds(acc, smem, [&](int rl, int c4, float4 v) {
        if ((c4 & 32) == 0) {
          uint2 o; o.x = pack2(v.x, v.y); o.y = pack2(v.z, v.w);
          *(uint2*)(G + (size_t)(row0 + rl) * 512 + cb0 + (c4 >> 6) * 32 + (c4 & 31)) = o;
        }
      });
    } else if (nt == 42) {
      float* DT = (float*)(p.ws + OFF_DT);
      epilogue_lds(acc, smem, [&](int rl, int c4, float4 v) {
        if (c4 < 32) *(float4*)(DT + (size_t)(row0 + rl) * 32 + c4) = v;
      });
    } else {
      bf16_t* dst; int ld, cb;
      if (nt < 12) { dst = (bf16_t*)(p.ws + OFF_XBC); ld = 1536; cb = nt * 128; }
      else if (nt < 20) { dst = (bf16_t*)(p.ws + OFF_Z); ld = 1024; cb = nt * 128 - 1536; }
      else if (nt < 24) { dst = (bf16_t*)(p.ws + OFF_Q); ld = 512; cb = nt * 128 - 2560; }
      else if (nt < 26) { dst = (bf16_t*)(p.ws + OFF_KV); ld = 256; cb = nt * 128 - 3072; }
      else if (nt < 30) { dst = (bf16_t*)(p.ws + OFF_AG); ld = 512; cb = nt * 128 - 3328; }
      else { dst = (bf16_t*)(p.ws + OFF_CG); ld = 512; cb = nt * 128 - 4864; }
      epilogue_lds(acc, smem, [&](int rl, int c4, float4 v) {
        uint2 o; o.x = pack2(v.x, v.y); o.y = pack2(v.z, v.w);
        *(uint2*)(dst + (size_t)(row0 + rl) * ld + cb + c4) = o;
      });
    }
  }
}

DI void phase_local(const Params& p_in, int l, char* smem) {
  const Params p = load_params();

  int tid = threadIdx.x; asm volatile("" : "+v"(tid)); const int lane = tid & 63;
  const bf16_t* XBC = (const bf16_t*)(p.ws + OFF_XBC);
  bf16_t* XS = (bf16_t*)(p.ws + OFF_H);
  bf16_t* BC = (bf16_t*)(p.ws + OFF_BC);
  float* DT = (float*)(p.ws + OFF_DT);
  float* CS = (float*)(p.ws + OFF_CS);
  const bf16_t* GLU = (const bf16_t*)(p.ws + OFF_GLU);
  bf16_t* HDN = (bf16_t*)(p.ws + OFF_HDN);
  bf16_t* Q = (bf16_t*)(p.ws + OFF_Q);
  bf16_t* KV = (bf16_t*)(p.ws + OFF_KV);
  const int N_CONV = R_ * 192 / 256;
  const int N_DT = NCK;
  const int N_CF = R_ / 16;
  const int N_ROPE = RL_ * 320 / 256;
  const int N_QC = 1024 * 256 / 256;
  const int NT = N_CF + N_DT + N_CONV + N_ROPE + N_QC;
  for (int it0 = blockIdx.x; it0 < NT; it0 += gridDim.x) {
    int it = it0;
    if (it < N_CF) {
      float* sv = (float*)smem;
      float* sst = (float*)(smem + 32768);
      const int row0 = it * 16;
      const int seq0 = (row0 < RL_) ? (row0 & ~4095) : (RL_ + ((row0 - RL_) & ~255));
      const int slen = (row0 < RL_) ? 4096 : 256;
      const int c0 = tid * 2;
      __syncthreads();
      if (tid < 32) sst[tid] = 0.f;
      float w0[31], w1[31];
#pragma unroll
      for (int k = 0; k < 31; ++k) {
        const float2 wv = *(const float2*)(p.conv_dw_w + ((size_t)l * 31 + k) * 512 + c0);
        w0[k] = wv.x; w1[k] = wv.y;
      }
      const float2 bv = *(const float2*)(p.conv_dw_b + l * 512 + c0);
      __syncthreads();
#pragma unroll 1
      for (int r = 0; r < 16; ++r) {
        const int t = row0 + r - seq0;
        float a0 = bv.x, a1 = bv.y;
#pragma unroll
        for (int k = 0; k < 31; ++k) {
          const int tt = t + k - 15;
          if (tt >= 0 && tt < slen) {
            const unsigned u = *(const unsigned*)(GLU + (size_t)(seq0 + tt) * 512 + c0);
            a0 += w0[k] * lo2f(u); a1 += w1[k] * hi2f(u);
          }
        }
        sv[r * 512 + c0] = a0; sv[r * 512 + c0 + 1] = a1;
        float s1 = a0 + a1, s2 = a0 * a0 + a1 * a1;
#pragma unroll
        for (int o = 32; o >= 1; o >>= 1) { s1 += __shfl_xor(s1, o); s2 += __shfl_xor(s2, o); }
        if (lane == 0) { atomicAdd(&sst[r * 2], s1); atomicAdd(&sst[r * 2 + 1], s2); }
      }
      __syncthreads();
      const float2 lw = *(const float2*)(p.conv_ln_w + l * 512 + c0);
      const float2 lb = *(const float2*)(p.conv_ln_b + l * 512 + c0);
#pragma unroll 1
      for (int r = 0; r < 16; ++r) {
        const float mean = sst[r * 2] * (1.f / 512.f);
        const float var = fmaxf(sst[r * 2 + 1] * (1.f / 512.f) - mean * mean, 0.f);
        const float rs = rsqrtf(var + 1e-6f);
        const float y0 = (sv[r * 512 + c0] - mean) * rs * lw.x + lb.x;
        const float y1 = (sv[r * 512 + c0 + 1] - mean) * rs * lw.y + lb.y;
        *(unsigned*)(HDN + (size_t)(row0 + r) * 512 + c0) = pack2(silu_f(y0), silu_f(y1));
      }
      continue;
    }
    it -= N_CF;
    if (it < N_DT) {
      float* sdt = (float*)smem;
      const int row0 = it * 128;
      __syncthreads();
      for (int e = tid; e < 4096; e += 256) {
        const int r = e >> 5, cidx = e & 31;
        const float raw = DT[(size_t)(row0 + r) * 32 + cidx] + p.ssd_dt_bias[l * 32 + cidx];
        const float sp = (raw > 20.f) ? raw : log1pf(expf(raw));
        DT[(size_t)(row0 + r) * 32 + cidx] = sp;
        sdt[r * 33 + cidx] = sp;
      }
      __syncthreads();
      if (tid < 32) {
        const float a = -expf(p.ssd_a_log[l * 32 + tid]);
        float run = 0.f;
        if (tid < 16) {
          for (int r = 0; r < 128; ++r) { run += sdt[r * 33 + tid] * a; CS[(size_t)(row0 + r) * 32 + tid] = run; }
        } else {
          for (int r = 127; r >= 0; --r) { run += sdt[r * 33 + tid] * a; CS[(size_t)(row0 + r) * 32 + tid] = run; }
        }
      }
      continue;
    }
    it -= N_DT;
    if (it < N_CONV) {
      const int e = it * 256 + tid;
      const int rho = e / 192, cgp = e % 192, ch0 = cgp * 8;
      const int seq0 = (rho < RL_) ? (rho & ~4095) : (RL_ + ((rho - RL_) & ~255));
      const int slen = (rho < RL_) ? 4096 : 256;
      const int t = rho - seq0;
      float a[8];
      {
        const float4 b0 = *(const float4*)(p.ssd_conv_b + l * 1536 + ch0);
        const float4 b1 = *(const float4*)(p.ssd_conv_b + l * 1536 + ch0 + 4);
        a[0] = b0.x; a[1] = b0.y; a[2] = b0.z; a[3] = b0.w; a[4] = b1.x; a[5] = b1.y; a[6] = b1.z; a[7] = b1.w;
      }
#pragma unroll
      for (int k = 0; k < 5; ++k) {
        const int tt = t + k - 2;
        if (tt >= 0 && tt < slen) {
          const uint4 u = *(const uint4*)(XBC + (size_t)(seq0 + tt) * 1536 + ch0);
          const float4 w0 = *(const float4*)(p.ssd_conv_w + ((size_t)l * 5 + k) * 1536 + ch0);
          const float4 w1 = *(const float4*)(p.ssd_conv_w + ((size_t)l * 5 + k) * 1536 + ch0 + 4);
          a[0] += w0.x * lo2f(u.x); a[1] += w0.y * hi2f(u.x); a[2] += w0.z * lo2f(u.y); a[3] += w0.w * hi2f(u.y);
          a[4] += w1.x * lo2f(u.z); a[5] += w1.y * hi2f(u.z); a[6] += w1.z * lo2f(u.w); a[7] += w1.w * hi2f(u.w);
        }
      }
      uint4 o;
      o.x = pack2(silu_f(a[0]), silu_f(a[1])); o.y = pack2(silu_f(a[2]), silu_f(a[3]));
      o.z = pack2(silu_f(a[4]), silu_f(a[5])); o.w = pack2(silu_f(a[6]), silu_f(a[7]));
      if (ch0 < 1024) *(uint4*)(XS + (size_t)rho * 1024 + ch0) = o;
      else *(uint4*)(BC + (size_t)rho * 512 + (ch0 - 1024)) = o;
      continue;
    }
    it -= N_CONV;
    if (it < N_ROPE) {
      const int e = it * 256 + tid;
      const int rho = e / 320, rem = e % 320, hd = rem >> 5, pi = rem & 31;
      const int axis = pi >> 4, f = pi & 15;
      const int t = rho & 4095;
      const float pos = (float)(axis == 0 ? (t >> 6) : (t & 63));
      const float invf = powf(10000.f, -(float)(2 * f) / 32.f);
      const float ang = pos * invf;
      const float cs = cosf(ang), sn = sinf(ang);
      bf16_t* base = (hd < 8) ? (Q + (size_t)rho * 512 + hd * 64) : (KV + (size_t)rho * 256 + (hd - 8) * 64);
      const float sc = (hd < 8) ? 0.125f : 1.f;
      const int i1 = axis * 32 + f, i2 = i1 + 16;
      const float t1 = bf2f(base[i1]), t2 = bf2f(base[i2]);
      base[i1] = f2bf((t1 * cs - t2 * sn) * sc);
      base[i2] = f2bf((t2 * cs + t1 * sn) * sc);
      continue;
    }
    it -= N_ROPE;
    {
      const int e = it * 256 + tid;
      const int rho = RL_ + e / 256, c2 = (e % 256) * 2;
      unsigned* ptr = (unsigned*)(Q + (size_t)rho * 512 + c2);
      const unsigned u = *ptr;
      *ptr = pack2(lo2f(u) * 0.125f, hi2f(u) * 0.125f);
    }
  }
}

DI void attn_item(const Params& p_in, int l, char* smem, int b, int qblk, int g, int hp, bool ctxq) {
  const Params p = load_params();

  bf16_t* sK = (bf16_t*)smem;
  bf16_t* sV = (bf16_t*)(smem + 128 * 72 * 2);
  int tid = threadIdx.x; asm volatile("" : "+v"(tid)); const int lane = tid & 63, wave = tid >> 6, fr = lane & 31, fh = lane >> 5;
  const int head = g * 4 + hp * 2 + (wave >> 1);
  const int qh = wave & 1;
  const int qrow0 = (ctxq ? (RL_ + b * 256) : (b * 4096)) + qblk * 128 + qh * 64;
  const int qpos0 = qblk * 128 + qh * 64;
  bf16_t* Q = (bf16_t*)(p.ws + OFF_Q);
  const bf16_t* KV = (const bf16_t*)(p.ws + OFF_KV);
  const bf16_t* AG = (const bf16_t*)(p.ws + OFF_AG);
  bf16x8 qf[2][4];
#pragma unroll
  for (int j = 0; j < 2; ++j)
#pragma unroll
    for (int ks = 0; ks < 4; ++ks)
      qf[j][ks] = *(const bf16x8*)(Q + (size_t)(qrow0 + j * 32 + fr) * 512 + head * 64 + ks * 16 + fh * 8);
  f32x16 o[2][2];
  zero_acc(o);
  float m[2], lsum[2];
  m[0] = m[1] = p.attn_sink[l * 8 + head];
  lsum[0] = lsum[1] = 1.f;
  const int nblk = ctxq ? 2 : 5;
  for (int bi = 0; bi < nblk; ++bi) {
    int krow0, kpos0 = 0;
    bool masked = false;
    if (bi < 2) {
      krow0 = RL_ + b * 256 + bi * 128;
    } else {
      const int kb = qblk + bi - 3;
      if (kb < 0 || kb >= 32) continue;
      krow0 = b * 4096 + kb * 128;
      kpos0 = kb * 128;
      masked = (bi != 3);
    }
    __syncthreads();
    for (int v = tid; v < 1024; v += 256) {
      const int r = v >> 3, cv = v & 7;
      *(uint4*)&sK[r * 72 + cv * 8] = *(const uint4*)(KV + (size_t)(krow0 + r) * 256 + g * 64 + cv * 8);
      *(uint4*)&sV[r * 72 + cv * 8] = *(const uint4*)(KV + (size_t)(krow0 + r) * 256 + 128 + g * 64 + cv * 8);
    }
    __syncthreads();
#pragma unroll 1
    for (int kb = 0; kb < 4; ++kb) {
      f32x16 st[2];
#pragma unroll
      for (int j = 0; j < 2; ++j)
#pragma unroll
        for (int r = 0; r < 16; ++r) st[j][r] = 0.f;
#pragma unroll
      for (int ks = 0; ks < 4; ++ks) {
        const bf16x8 kf = *(const bf16x8*)&sK[(kb * 32 + fr) * 72 + ks * 16 + fh * 8];
#pragma unroll
        for (int j = 0; j < 2; ++j) st[j] = MFMA(kf, qf[j][ks], st[j]);
      }
      bf16x8 pb[2][2];
#pragma unroll
      for (int j = 0; j < 2; ++j) {
        if (masked) {
          const int qpos = qpos0 + j * 32 + fr;
#pragma unroll
          for (int r = 0; r < 16; ++r) {
            const int d = qpos - (kpos0 + kb * 32 + crow(r, fh));
            if (d > 128 || d < -128) st[j][r] = -1e30f;
          }
        }
        float mx = st[j][0];
#pragma unroll
        for (int r = 1; r < 16; ++r) mx = fmaxf(mx, st[j][r]);
        mx = fmaxf(mx, __shfl_xor(mx, 32));
        const float mnew = fmaxf(m[j], mx);
        const float alpha = __expf(m[j] - mnew);
        float rs = 0.f;
#pragma unroll
        for (int r = 0; r < 16; ++r) { const float pv = __expf(st[j][r] - mnew); st[j][r] = pv; rs += pv; }
        rs += __shfl_xor(rs, 32);
        lsum[j] = lsum[j] * alpha + rs;
        m[j] = mnew;
#pragma unroll
        for (int mt = 0; mt < 2; ++mt)
#pragma unroll
          for (int r = 0; r < 16; ++r) o[mt][j][r] *= alpha;
#pragma unroll
        for (int s = 0; s < 2; ++s)
#pragma unroll
          for (int jj = 0; jj < 8; ++jj) pb[j][s][jj] = (short)f2bf(st[j][8 * s + jj]);
      }
#pragma unroll
      for (int s = 0; s < 2; ++s)
#pragma unroll
        for (int mt = 0; mt < 2; ++mt) {
          const bf16x8 vf = tr_frag(sV, 72, kb * 32 + 16 * s + 4 * fh, kb * 32 + 16 * s + 8 + 4 * fh, mt * 32);
#pragma unroll
          for (int j = 0; j < 2; ++j) o[mt][j] = MFMA(vf, pb[j][s], o[mt][j]);
        }
    }
  }
#pragma unroll
  for (int j = 0; j < 2; ++j) {
    const float inv = 1.f / lsum[j];
    const size_t rho = (size_t)(qrow0 + j * 32 + fr);
#pragma unroll
    for (int mt = 0; mt < 2; ++mt)
#pragma unroll
      for (int g4 = 0; g4 < 4; ++g4) {
        const int d0 = mt * 32 + 8 * g4 + 4 * fh;
        const uint2 gv = *(const uint2*)(AG + rho * 512 + head * 64 + d0);
        uint2 ov;
        ov.x = pack2(o[mt][j][g4 * 4 + 0] * inv * silu_f(lo2f(gv.x)), o[mt][j][g4 * 4 + 1] * inv * silu_f(hi2f(gv.x)));
        ov.y = pack2(o[mt][j][g4 * 4 + 2] * inv * silu_f(lo2f(gv.y)), o[mt][j][g4 * 4 + 3] * inv * silu_f(hi2f(gv.y)));
        *(uint2*)(Q + rho * 512 + head * 64 + d0) = ov;
      }
  }
}

DI void states_item(const Params& p_in, char* smem, int ck, int g, int hq) {
  const Params p = load_params();

  bf16_t* sB = (bf16_t*)smem;
  bf16_t* sX = (bf16_t*)(smem + 128 * 136 * 2);
  int tid = threadIdx.x; asm volatile("" : "+v"(tid)); const int lane = tid & 63, wave = tid >> 6, wr = wave >> 1, wc = wave & 1, fr = lane & 31, fh = lane >> 5;
  const bf16_t* BC = (const bf16_t*)(p.ws + OFF_BC);
  const bf16_t* XS = (const bf16_t*)(p.ws + OFF_H);
  const float* DT = (const float*)(p.ws + OFF_DT);
  const float* CS = (const float*)(p.ws + OFF_CS);
  bf16_t* ST = (bf16_t*)(p.ws + OFF_ST);
  float* CDEC = (float*)(p.ws + OFF_CDEC);
  const int row0 = ck * 128;
  __syncthreads();
  for (int v = tid; v < 2048; v += 256) {
    const int r = v >> 4, cv = v & 15;
    *(uint4*)&sB[r * 136 + cv * 8] = *(const uint4*)(BC + (size_t)(row0 + r) * 512 + g * 128 + cv * 8);
  }
  __syncthreads();
  bf16x8 bfr[2][8];
#pragma unroll
  for (int j = 0; j < 2; ++j)
#pragma unroll
    for (int ks = 0; ks < 8; ++ks) bfr[j][ks] = tr_frag(sB, 136, ks * 16 + 8 * fh, ks * 16 + 8 * fh + 4, wc * 64 + j * 32);
#pragma unroll 1
  for (int hd = 0; hd < 8; ++hd) {
    const int head = g * 8 + hq * 4 + (hd >> 1), d = hd & 1;
    const int col = d * 16 + head;
    const float cend = CS[(size_t)(row0 + (d == 0 ? 127 : 0)) * 32 + col];
    for (int v = tid; v < 1024; v += 256) {
      const int lr = v >> 3, cv = v & 7;
      const size_t rho = (size_t)(row0 + lr);
      const float sc = DT[rho * 32 + col] * __expf(cend - CS[rho * 32 + col]);
      const uint4 u = *(const uint4*)(XS + rho * 1024 + head * 64 + cv * 8);
      uint4 o;
      o.x = pack2(lo2f(u.x) * sc, hi2f(u.x) * sc); o.y = pack2(lo2f(u.y) * sc, hi2f(u.y) * sc);
      o.z = pack2(lo2f(u.z) * sc, hi2f(u.z) * sc); o.w = pack2(lo2f(u.w) * sc, hi2f(u.w) * sc);
      *(uint4*)&sX[lr * 72 + cv * 8] = o;
    }
    __syncthreads();
    f32x16 acc[2];
#pragma unroll
    for (int j = 0; j < 2; ++j)
#pragma unroll
      for (int r = 0; r < 16; ++r) acc[j][r] = 0.f;
#pragma unroll
    for (int ks = 0; ks < 8; ++ks) {
      const bf16x8 af = tr_frag(sX, 72, ks * 16 + 8 * fh, ks * 16 + 8 * fh + 4, wr * 32);
#pragma unroll
      for (int j = 0; j < 2; ++j) acc[j] = MFMA(af, bfr[j][ks], acc[j]);
    }
    bf16_t* dst = ST + ((size_t)(ck * 2 + d) * 16 + head) * 8192;
#pragma unroll
    for (int j = 0; j < 2; ++j)
#pragma unroll
      for (int r = 0; r < 16; ++r) dst[(wr * 32 + crow(r, fh)) * 128 + wc * 64 + j * 32 + fr] = f2bf(acc[j][r]);
    if (tid == 0) CDEC[(ck * 2 + d) * 16 + head] = __expf(cend);
    __syncthreads();
  }
}

DI void pw_item(const Params& p_in, int l, char* smem, int mt, int nt) {
  const Params p = load_params();

  GemmS* s = (GemmS*)smem;
  int tid = threadIdx.x; asm volatile("" : "+v"(tid)); const int lane = tid & 63, wave = tid >> 6, wr = wave >> 1, wc = wave & 1, fr = lane & 31, fh = lane >> 5;
  const bf16_t* Ab = (const bf16_t*)(p.ws + OFF_HDN) + (size_t)mt * 128 * 512;
  const bf16_t* Bb = (const bf16_t*)(p.ws + OFF_PW) + (size_t)nt * 128 * 512;
  bf16_t* CG = (bf16_t*)(p.ws + OFF_CG);
  f32x16 acc[2][2];
  zero_acc(acc);
  gemm_core(acc, s,
            [&](int kt, int r, int kv) { return Ab + (size_t)r * 512 + kt * 32 + kv * 8; },
            [&](int kt, int r, int kv) { return Bb + (size_t)r * 512 + kt * 32 + kv * 8; }, 16);
  const float* pwb = p.conv_pw_b + l * 512 + nt * 128;
  epilogue_lds(acc, smem, [&](int rl, int c4, float4 v) {
    bf16_t* ptr = CG + (size_t)(mt * 128 + rl) * 512 + nt * 128 + c4;
    const uint2 gv = *(const uint2*)ptr;
    const float4 bb = *(const float4*)(pwb + c4);
    uint2 o;
    o.x = pack2((v.x + bb.x) * silu_f(lo2f(gv.x)), (v.y + bb.y) * silu_f(hi2f(gv.x)));
    o.y = pack2((v.z + bb.z) * silu_f(lo2f(gv.y)), (v.w + bb.w) * silu_f(hi2f(gv.y)));
    *(uint2*)ptr = o;
  });
}

DI void phase_mix(const Params& p, int l, char* smem) {
  const int N_ATT = 512 + (l == 0 ? 32 : 0);
  const int N_ST = NCK * 4;
  const int N_PW = NCK * 4;
  const int NT = N_ATT + N_ST + N_PW;
  for (int it0 = blockIdx.x; it0 < NT; it0 += gridDim.x) {
    int it = it0;
    if (it < N_ATT) {
      if (it < 512) attn_item(p, l, smem, it >> 7, (it >> 2) & 31, (it >> 1) & 1, it & 1, false);
      else { const int t = it - 512; attn_item(p, l, smem, t >> 3, (t >> 2) & 1, (t >> 1) & 1, t & 1, true); }
      continue;
    }
    it -= N_ATT;
    if (it < N_ST) { states_item(p, smem, it >> 2, (it >> 1) & 1, it & 1); continue; }
    it -= N_ST;
    pw_item(p, l, smem, it >> 2, it & 3);
  }
}

DI void phase_scan(const Params& p_in) {
  const Params p = load_params();

  bf16_t* ST = (bf16_t*)(p.ws + OFF_ST);
  const float* CDEC = (const float*)(p.ws + OFF_CDEC);
  for (int it = blockIdx.x; it < 512; it += gridDim.x) {
    const int e = it * 256 + threadIdx.x;
    const int bdh = e >> 10, v8 = e & 1023;
    const int b = bdh >> 5, d = (bdh >> 4) & 1, h = bdh & 15;
    float s[8];
#pragma unroll
    for (int i = 0; i < 8; ++i) s[i] = 0.f;
    auto ckof = [&](int i) {
      if (d == 0) return (i < 2) ? (128 + 2 * b + i) : (32 * b + (i - 2));
      return (i < 2) ? (128 + 2 * b + (1 - i)) : (32 * b + 31 - (i - 2));
    };
    int ck = ckof(0);
    uint4* ptr = (uint4*)(ST + ((size_t)(ck * 2 + d) * 16 + h) * 8192 + v8 * 8);
    uint4 cur = *ptr;
    float dec = CDEC[(ck * 2 + d) * 16 + h];
#pragma unroll 1
    for (int i = 0; i < 34; ++i) {
      uint4 nxt = cur; float ndec = 0.f; uint4* nptr = ptr;
      if (i + 1 < 34) {
        const int nck = ckof(i + 1);
        nptr = (uint4*)(ST + ((size_t)(nck * 2 + d) * 16 + h) * 8192 + v8 * 8);
        nxt = *nptr;
        ndec = CDEC[(nck * 2 + d) * 16 + h];
      }
      uint4 o;
      o.x = pack2(s[0], s[1]); o.y = pack2(s[2], s[3]); o.z = pack2(s[4], s[5]); o.w = pack2(s[6], s[7]);
      *ptr = o;
      s[0] = s[0] * dec + lo2f(cur.x); s[1] = s[1] * dec + hi2f(cur.x);
      s[2] = s[2] * dec + lo2f(cur.y); s[3] = s[3] * dec + hi2f(cur.y);
      s[4] = s[4] * dec + lo2f(cur.z); s[5] = s[5] * dec + hi2f(cur.z);
      s[6] = s[6] * dec + lo2f(cur.w); s[7] = s[7] * dec + hi2f(cur.w);
      cur = nxt; dec = ndec; ptr = nptr;
    }
  }
}

DI void phase_ssdy(const Params& p_in, int l, char* smem) {
  const Params p = load_params();

  bf16_t* sB = (bf16_t*)smem;
  bf16_t* sX = (bf16_t*)(smem + 128 * 136 * 2);
  float* sF = (float*)(smem + 128 * 136 * 2 + 128 * 72 * 2);
  float* sSS = sF + 512;
  int tid = threadIdx.x; asm volatile("" : "+v"(tid)); const int lane = tid & 63, wave = tid >> 6, fr = lane & 31, fh = lane >> 5;
  const int wl = wave >> 1, w2 = wave & 1;
  const bf16_t* BC = (const bf16_t*)(p.ws + OFF_BC);
  const bf16_t* XS = (const bf16_t*)(p.ws + OFF_H);
  const float* DT = (const float*)(p.ws + OFF_DT);
  const float* CS = (const float*)(p.ws + OFF_CS);
  const bf16_t* ST = (const bf16_t*)(p.ws + OFF_ST);
  bf16_t* Z = (bf16_t*)(p.ws + OFF_Z);
  float* RSTD = (float*)(p.ws + OFF_RSTD);
  const int nck = (l == 0) ? NCK : 128;
  for (int it = blockIdx.x; it < nck * 4; it += gridDim.x) {
    const int ck = it >> 2, g = (it >> 1) & 1, lh = it & 1;
    const int row0 = ck * 128;
    const int lbase = lh * 64 + wl * 32;
    __syncthreads();
    for (int v = tid; v < 2048; v += 256) {
      const int r = v >> 4, cv = v & 15;
      *(uint4*)&sB[r * 136 + cv * 8] = *(const uint4*)(BC + (size_t)(row0 + r) * 512 + g * 128 + cv * 8);
    }
    if (tid < 64) sSS[tid] = 0.f;
    const bf16_t* cptr = BC + (size_t)(row0 + lbase + fr) * 512 + 256 + g * 128 + fh * 8;
    __syncthreads();
    f32x16 cb[2];
    {
    bf16x8 cf[8];
#pragma unroll
    for (int ks = 0; ks < 8; ++ks) cf[ks] = *(const bf16x8*)(cptr + ks * 16);
#pragma unroll
    for (int j = 0; j < 2; ++j) {
#pragma unroll
      for (int r = 0; r < 16; ++r) cb[j][r] = 0.f;
#pragma unroll
      for (int ks = 0; ks < 8; ++ks) {
        const bf16x8 bq = *(const bf16x8*)&sB[(w2 * 64 + j * 32 + fr) * 136 + ks * 16 + fh * 8];
        cb[j] = MFMA(cf[ks], bq, cb[j]);
      }
    }
    }
    float ssq[16];
#pragma unroll
    for (int r = 0; r < 16; ++r) ssq[r] = 0.f;
#pragma unroll 1
    for (int hh = 0; hh < 8; ++hh) {
      const int head = g * 8 + hh;
      __syncthreads();
      for (int v = tid; v < 1024; v += 256) {
        const int lr = v >> 3, cv = v & 7;
        *(uint4*)&sX[lr * 72 + cv * 8] = *(const uint4*)(XS + (size_t)(row0 + lr) * 1024 + head * 64 + cv * 8);
      }
      if (tid < 128) {
        const size_t rho = (size_t)(row0 + tid);
        sF[tid] = CS[rho * 32 + head];
        sF[128 + tid] = CS[rho * 32 + 16 + head];
        sF[256 + tid] = DT[rho * 32 + head];
        sF[384 + tid] = DT[rho * 32 + 16 + head];
      }
      __syncthreads();
#pragma unroll
      for (int j = 0; j < 2; ++j) {
        const int sidx = w2 * 64 + j * 32 + fr;
        const float csf_s = sF[sidx], csb_s = sF[128 + sidx], dtf_s = sF[256 + sidx], dtb_s = sF[384 + sidx];
#pragma unroll
        for (int r = 0; r < 16; ++r) {
          const int lidx = lbase + crow(r, fh);
          float f = 0.f;
          if (sidx <= lidx) f += __expf(sF[lidx] - csf_s) * dtf_s;
          if (sidx >= lidx) f += __expf(sF[128 + lidx] - csb_s) * dtb_s;
          sB[(wl * 32 + crow(r, fh)) * 136 + sidx] = f2bf(cb[j][r] * f);
        }
      }
      __syncthreads();
      f32x16 accy;
#pragma unroll
      for (int r = 0; r < 16; ++r) accy[r] = 0.f;
#pragma unroll
      for (int ks = 0; ks < 8; ++ks) {
        const bf16x8 af = *(const bf16x8*)&sB[(wl * 32 + fr) * 136 + ks * 16 + fh * 8];
        const bf16x8 xf = tr_frag(sX, 72, ks * 16 + 8 * fh, ks * 16 + 8 * fh + 4, w2 * 32);
        accy = MFMA(af, xf, accy);
      }
#pragma unroll 1
      for (int d = 0; d < 2; ++d) {
        f32x16 acct;
#pragma unroll
        for (int r = 0; r < 16; ++r) acct[r] = 0.f;
        const bf16_t* Sd = ST + ((size_t)(ck * 2 + d) * 16 + head) * 8192;
#pragma unroll
        for (int ks = 0; ks < 8; ++ks) {
          const bf16x8 sf = *(const bf16x8*)(Sd + (w2 * 32 + fr) * 128 + ks * 16 + fh * 8);
          const bf16x8 cfk = *(const bf16x8*)(cptr + ks * 16);
          acct = MFMA(cfk, sf, acct);
        }
#pragma unroll
        for (int r = 0; r < 16; ++r) accy[r] += __expf(sF[d * 128 + lbase + crow(r, fh)]) * acct[r];
      }
      const float dsk = p.ssd_d[l * 16 + head];
      const int pidx = w2 * 32 + fr;
#pragma unroll
      for (int r = 0; r < 16; ++r) {
        const int lidx = lbase + crow(r, fh);
        const float xv = bf2f(sX[lidx * 72 + pidx]);
        const float y = accy[r] + dsk * xv;
        bf16_t* zp = Z + (size_t)(row0 + lidx) * 1024 + head * 64 + pidx;
        const float u = y * silu_f(bf2f(*zp));
        ssq[r] += u * u;
        *zp = f2bf(u);
      }
    }
#pragma unroll
    for (int r = 0; r < 16; ++r) {
      float v = ssq[r];
#pragma unroll
      for (int o = 16; o >= 1; o >>= 1) v += __shfl_xor(v, o);
      if (fr == 0) atomicAdd(&sSS[wl * 32 + crow(r, fh)], v);
    }
    __syncthreads();
    if (tid < 64) RSTD[(size_t)(row0 + lh * 64 + tid) * 2 + g] = rsqrtf(sSS[tid] * (1.f / 512.f) + 1e-6f);
  }
}

DI void phase_outproj(const Params& p_in, int l, char* smem) {
  const Params p = load_params();

  GemmS* s = (GemmS*)smem;
  int tid = threadIdx.x; asm volatile("" : "+v"(tid)); const int lane = tid & 63, wave = tid >> 6, wr = wave >> 1, wc = wave & 1, fr = lane & 31, fh = lane >> 5;
  const bf16_t* Zb = (const bf16_t*)(p.ws + OFF_Z);
  const bf16_t* Qb = (const bf16_t*)(p.ws + OFF_Q);
  const bf16_t* Cb = (const bf16_t*)(p.ws + OFF_CG);
  const bf16_t* W = (const bf16_t*)(p.ws + OFF_WOUT);
  const float* RSTD = (const float*)(p.ws + OFF_RSTD);
  const float* mods = (const float*)(p.ws + OFF_MODS);
  float* XC = (float*)(p.ws + OFF_XC);
  const int nM = (l == 0) ? NCK : 128;
  for (int it = blockIdx.x; it < nM * 8; it += gridDim.x) {
    const int mt = it >> 3, nt = it & 7;
    f32x16 acc[2][2];
    zero_acc(acc);
    const bf16_t* Wb = W + (size_t)nt * 128 * 2048;
    const bf16_t* A0 = Zb + (size_t)mt * 128 * 1024;
    const bf16_t* A2 = Qb + (size_t)mt * 128 * 512;
    const bf16_t* A3 = Cb + (size_t)mt * 128 * 512;
    gemm_core(acc, s,
              [&](int kt, int r, int kv) { return A0 + (size_t)r * 1024 + kt * 32 + kv * 8; },
              [&](int kt, int r, int kv) { return Wb + (size_t)r * 2048 + kt * 32 + kv * 8; }, 16);
#pragma unroll
    for (int i = 0; i < 2; ++i)
#pragma unroll
      for (int r = 0; r < 16; ++r) {
        const size_t row = (size_t)(mt * 128 + wr * 64 + i * 32 + crow(r, fh));
        const float f = RSTD[row * 2] / RSTD[row * 2 + 1];
        acc[i][0][r] *= f; acc[i][1][r] *= f;
      }
    gemm_core(acc, s,
              [&](int kt, int r, int kv) { return A0 + (size_t)r * 1024 + 512 + kt * 32 + kv * 8; },
              [&](int kt, int r, int kv) { return Wb + (size_t)r * 2048 + 512 + kt * 32 + kv * 8; }, 16);
#pragma unroll
    for (int i = 0; i < 2; ++i)
#pragma unroll
      for (int r = 0; r < 16; ++r) {
        const size_t row = (size_t)(mt * 128 + wr * 64 + i * 32 + crow(r, fh));
        const float f = RSTD[row * 2 + 1];
        acc[i][0][r] *= f; acc[i][1][r] *= f;
      }
    gemm_core(acc, s,
              [&](int kt, int r, int kv) { return A2 + (size_t)r * 512 + kt * 32 + kv * 8; },
              [&](int kt, int r, int kv) { return Wb + (size_t)r * 2048 + 1024 + kt * 32 + kv * 8; }, 16);
    gemm_core(acc, s,
              [&](int kt, int r, int kv) { return A3 + (size_t)r * 512 + kt * 32 + kv * 8; },
              [&](int kt, int r, int kv) { return Wb + (size_t)r * 2048 + 1536 + kt * 32 + kv * 8; }, 16);
    {
      const int row0 = mt * 128;
      const int vv = (row0 < RL_) ? (row0 >> 12) : 4;
      const float* gate = mods + (l * 5 + vv) * 3072 + 2048 + nt * 128;
      float* xnew = (row0 < RL_) ? (p.out + (size_t)row0 * 1024) : (XC + (size_t)(row0 - RL_) * 1024);
      const float* xold = (l == 0) ? ((row0 < RL_) ? (p.x + (size_t)row0 * 1024) : (p.ctx + (size_t)(row0 - RL_) * 1024)) : xnew;
      epilogue_lds(acc, smem, [&](int rl, int c4, float4 v) {
        const int off = rl * 1024 + nt * 128 + c4;
        const float4 xo = *(const float4*)(xold + off);
        const float4 gt = *(const float4*)(gate + c4);
        float4 o;
        o.x = xo.x + gt.x * v.x; o.y = xo.y + gt.y * v.y; o.z = xo.z + gt.z * v.z; o.w = xo.w + gt.w * v.w;
        *(float4*)(xnew + off) = o;
      });
    }
  }
}

DI void phase_final(const Params& p_in) {
  const Params p = load_params();
  const int lane = threadIdx.x & 63, wave = threadIdx.x >> 6;
  for (int it = blockIdx.x; it < RL_ / 4; it += gridDim.x) {
    float* xr = p.out + (size_t)(it * 4 + wave) * 1024;
    float4 xv[4];
    float ss = 0.f;
#pragma unroll
    for (int i = 0; i < 4; ++i) {
      xv[i] = *(const float4*)(xr + lane * 4 + i * 256);
      ss += xv[i].x * xv[i].x + xv[i].y * xv[i].y + xv[i].z * xv[i].z + xv[i].w * xv[i].w;
    }
#pragma unroll
    for (int o = 32; o >= 1; o >>= 1) ss += __shfl_xor(ss, o);
    const float rs = rsqrtf(ss * (1.f / 1024.f) + 1e-6f);
#pragma unroll
    for (int i = 0; i < 4; ++i) {
      const float4 w = *(const float4*)(p.final_norm_w + lane * 4 + i * 256);
      float4 o;
      o.x = xv[i].x * rs * w.x; o.y = xv[i].y * rs * w.y; o.z = xv[i].z * rs * w.z; o.w = xv[i].w * rs * w.w;
      *(float4*)(xr + lane * 4 + i * 256) = o;
    }
  }
}

template <int PH>
DI void run_phase(const Params& p, char* smem) {
  constexpr int l = (PH - 1) / 7, s = (PH - 1) % 7;
  if constexpr (PH == 0) phase_mods(p, smem);
  else if constexpr (PH == 15) phase_final(p);
  else if constexpr (s == 0) phase_prep(p, l, smem);
  else if constexpr (s == 1) phase_inproj(p, smem);
  else if constexpr (s == 2) phase_local(p, l, smem);
  else if constexpr (s == 3) phase_mix(p, l, smem);
  else if constexpr (s == 4) phase_scan(p);
  else if constexpr (s == 5) phase_ssdy(p, l, smem);
  else phase_outproj(p, l, smem);
}

#if PROBE_S >= 0
#define PROBE_BEGIN() if (threadIdx.x == 0) pst[1] = wall_clock64();
#define PROBE_END(PH) if (threadIdx.x == 0 && (PH) >= 1 && (PH) <= 14 && (((PH) - 1) % 7) == PROBE_S) pst[0] += wall_clock64() - pst[1];
#else
#define PROBE_BEGIN()
#define PROBE_END(PH)
#endif
#define PHASE(PH) PROBE_BEGIN() run_phase<PH>(p, smem); xcd_barrier(xst); PROBE_END(PH)

__global__ void __launch_bounds__(256, 2) fwd_megakernel(Params p) {
  __shared__ __attribute__((aligned(16))) char smem[57344];
  cg::grid_group grid = cg::this_grid();
#if PROBE_S >= 0
  volatile unsigned long long* pst = (volatile unsigned long long*)(smem + 57344 - 16);
  if (threadIdx.x == 0) { pst[0] = 0; pst[1] = 0; }
#endif
  __shared__ uint4 xb_words;
  volatile LAS unsigned* xst = (volatile LAS unsigned*)&xb_words;
  if (threadIdx.x == 0) xb_words = make_uint4(0u, 0u, 0u, 0u);
  run_phase<0>(p, smem);
  grid.sync();
  if (threadIdx.x == 0) { unsigned* bar = (unsigned*)(load_params().ws + OFF_BAR); (void)xb_add(&bar[XB_XCNT(xb_xcc_id())], 1u); }
  PHASE(1) PHASE(2) PHASE(3) PHASE(4) PHASE(5) PHASE(6) PHASE(7)
  PHASE(8) PHASE(9) PHASE(10) PHASE(11) PHASE(12) PHASE(13) PHASE(14)
  run_phase<15>(p, smem);
#if PROBE_S >= 0
  if (blockIdx.x == 0 && threadIdx.x == 0) {
    const unsigned long long t1 = wall_clock64();
    const unsigned long long lim = 4ull * pst[0];
    while (wall_clock64() - t1 < lim) { __builtin_amdgcn_s_sleep(32); }
  }
#endif
}

extern "C" void kernel_launch(void* const* d_in, const int* in_sizes, int n_in, void* d_out, int out_size, void* d_ws,
                              size_t ws_size, hipStream_t stream) {
  static int grid_blocks = 0;
  if (!grid_blocks) {
    int dev = 0, cus = 0, per_cu = 0;
    hipGetDevice(&dev);
    hipDeviceGetAttribute(&cus, hipDeviceAttributeMultiprocessorCount, dev);
    hipOccupancyMaxActiveBlocksPerMultiprocessor(&per_cu, fwd_megakernel, 256, 0);
    if (per_cu < 1) per_cu = 1;
    if (per_cu > 2) per_cu = 2;
    grid_blocks = cus * per_cu;
  }
  Params p{};
  const float** pp = (const float**)&p;
  for (int i = 0; i < 23; ++i) pp[i] = (const float*)d_in[i];
  p.out = (float*)d_out;
  p.ws = (char*)d_ws;
  void* args[] = {&p};
  hipError_t e = hipLaunchCooperativeKernel((void*)fwd_megakernel, dim3(grid_blocks), dim3(256), args, 0, stream);
  if (e != hipSuccess) fprintf(stderr, "cooperative launch failed: %s (grid %d)\n", hipGetErrorString(e), grid_blocks);
}
```

```cpp
#include <hip/hip_runtime.h>
#include <hip/hip_cooperative_groups.h>
#include <stdint.h>
#include <stdio.h>
namespace cg = cooperative_groups;

#ifndef ONE_LAUNCH
#define ONE_LAUNCH 1
#endif

#ifndef PROBE_S
#define PROBE_S -1
#endif
#define DI __device__ __forceinline__
typedef unsigned short bf16_t;
using bf16x8 = __attribute__((ext_vector_type(8))) short;
using s16x4 = __attribute__((ext_vector_type(4))) short;
using f32x16 = __attribute__((ext_vector_type(16))) float;
#define MFMA(a, b, c) __builtin_amdgcn_mfma_f32_32x32x16_bf16((a), (b), (c), 0, 0, 0)

constexpr int R_ = 17408;
constexpr int RL_ = 16384;
constexpr int NCK = 136;

constexpr size_t SZ_WIN = (size_t)5504 * 1024 * 2;
constexpr size_t SZ_WOUT = (size_t)1024 * 2048 * 2;
constexpr size_t SZ_PW = (size_t)512 * 512 * 2;
constexpr size_t SZ_MODS = (size_t)2 * 5 * 3072 * 4;
constexpr size_t SZ_XC = (size_t)1024 * 1024 * 4;
constexpr size_t SZ_RSTD = (size_t)R_ * 2 * 4;
constexpr size_t SZ_CDEC = (size_t)NCK * 32 * 4 + 256 - ((size_t)NCK * 32 * 4) % 256;
constexpr size_t SZ_R512 = (size_t)R_ * 512 * 2;
constexpr size_t OFF_WIN = 0;
constexpr size_t OFF_WOUT = OFF_WIN + SZ_WIN;
constexpr size_t OFF_PW = OFF_WOUT + SZ_WOUT;
constexpr size_t OFF_MODS = OFF_PW + SZ_PW;
constexpr size_t OFF_XC = OFF_MODS + SZ_MODS;
constexpr size_t OFF_RSTD = OFF_XC + SZ_XC;
constexpr size_t OFF_CDEC = OFF_RSTD + SZ_RSTD;
constexpr size_t OFF_H = OFF_CDEC + SZ_CDEC;
constexpr size_t OFF_XBC = OFF_H + 2 * SZ_R512;
constexpr size_t OFF_GLU = OFF_XBC + 3 * SZ_R512;
constexpr size_t OFF_ST = OFF_XBC;
constexpr size_t OFF_Z = OFF_GLU + SZ_R512;
constexpr size_t OFF_DT = OFF_Z + 2 * SZ_R512;
constexpr size_t OFF_CS = OFF_DT + (size_t)R_ * 32 * 4;
constexpr size_t OFF_Q = OFF_CS + (size_t)R_ * 32 * 4;
constexpr size_t OFF_KV = OFF_Q + SZ_R512;
constexpr size_t OFF_AG = OFF_KV + SZ_R512 / 2;
constexpr size_t OFF_CG = OFF_AG + SZ_R512;
constexpr size_t OFF_BC = OFF_CG + SZ_R512;
constexpr size_t OFF_HDN = OFF_BC + SZ_R512;
constexpr size_t WS_TOTAL = OFF_HDN + SZ_R512;
constexpr size_t OFF_BAR = WS_TOTAL;
static_assert(OFF_BAR + 16384 <= (size_t)256 * 1024 * 1024, "workspace too large");

struct Params {
  const float *x, *c, *ctx, *c_ctx, *w_mod, *b_mod, *norm_w, *w_in, *ssd_conv_w, *ssd_conv_b, *ssd_dt_bias, *ssd_a_log,
      *ssd_d, *ssd_norm_w, *attn_sink, *conv_dw_w, *conv_dw_b, *conv_ln_w, *conv_ln_b, *conv_pw_w, *conv_pw_b, *w_out,
      *final_norm_w;
  float* out;
  char* ws;
};


DI Params load_params() {
  typedef const char __attribute__((address_space(4)))* kptr_t;
  typedef const float* const __attribute__((address_space(4)))* kfld_t;
  size_t off = 0;
  asm volatile("" : "+s"(off));
  kptr_t base = (kptr_t)__builtin_amdgcn_kernarg_segment_ptr() + off;
  Params p;
  const float** pp = (const float**)&p;
#pragma unroll
  for (int i = 0; i < 25; ++i) pp[i] = *(kfld_t)(base + 8 * i);
  return p;
}

#define XB_TMO      128
#define XB_XCNT(j)  (256  + 64 * (j))
#define XB_XSUB(j)  (1280 + 64 * (j))
#define XB_XGEN(j)  (2304 + 64 * (j))
#define XB_TOP      3328
#define XB_TOPGEN   3392
#define XCD_BAR_WORDS 3456
#define XB_SPIN_CAP (1u << 18)
#define LAS __attribute__((address_space(3)))
DI unsigned xb_ld(unsigned* p)              { return __hip_atomic_load(p, __ATOMIC_RELAXED, __HIP_MEMORY_SCOPE_AGENT); }
DI unsigned xb_add(unsigned* p, unsigned v) { return __hip_atomic_fetch_add(p, v, __ATOMIC_RELAXED, __HIP_MEMORY_SCOPE_AGENT); }
DI unsigned xb_xcc_id() { return (unsigned)__builtin_amdgcn_s_getreg((3 << 11) | 20) & 0xFu; }
#define XB_SPIN(cond, bar) do { unsigned _sp = 0; while (cond) { __builtin_amdgcn_s_sleep(1); \
    if ((++_sp & 255u) == 0u) { if (xb_ld(&(bar)[XB_TMO])) break; if (_sp > XB_SPIN_CAP) { atomicAdd(&(bar)[XB_TMO], 1u); break; } } } } while (0)

DI void xcd_barrier_complete(unsigned* bar, unsigned x, unsigned& nloc, unsigned& nx) {
  const unsigned G = gridDim.x * gridDim.y * gridDim.z;
  unsigned sum, cnt, mine, sp = 0u;
  for (;;) {
    sum = 0u; cnt = 0u; mine = 0u;
#pragma unroll
    for (unsigned j = 0; j < 16; ++j) { const unsigned c = xb_ld(&bar[XB_XCNT(j)]); sum += c; cnt += (c > 0u) ? 1u : 0u; mine = (j == x) ? c : mine; }
    if (sum == G) break;
    __builtin_amdgcn_s_sleep(1);
    if ((++sp & 255u) == 0u) { if (xb_ld(&bar[XB_TMO])) break; if (sp > XB_SPIN_CAP) { atomicAdd(&bar[XB_TMO], 1u); break; } }
  }
  nloc = mine > 0u ? mine : 1u; nx = cnt > 0u ? cnt : 1u;
}

DI void xcd_barrier(volatile LAS unsigned* st) {
  asm volatile("s_waitcnt vmcnt(0)" ::: "memory");
  __syncthreads();
  if (threadIdx.x == 0) {
    const Params pb = load_params();
    unsigned* bar = (unsigned*)(pb.ws + OFF_BAR);
    const unsigned x = xb_xcc_id();
    __builtin_amdgcn_s_waitcnt(0);
    unsigned nloc = st[0], nx = st[1];
    if (nloc == 0u) { xcd_barrier_complete(bar, x, nloc, nx); st[0] = nloc; st[1] = nx; }
    const unsigned old = xb_add(&bar[XB_XSUB(x)], 1u);
    const unsigned gen = old / nloc;
    if (old + 1u == (gen + 1u) * nloc) {
      __builtin_amdgcn_fence(__ATOMIC_RELEASE, "agent");
      asm volatile("s_waitcnt vmcnt(0)" ::: "memory");
      const unsigned og = xb_add(&bar[XB_TOP], 1u);
      const unsigned tg = og / nx;
      if (og + 1u == (tg + 1u) * nx) xb_add(&bar[XB_TOPGEN], 1u);
      else XB_SPIN(xb_ld(&bar[XB_TOPGEN]) == tg, bar);
      __builtin_amdgcn_fence(__ATOMIC_ACQUIRE, "agent");
      xb_add(&bar[XB_XGEN(x)], 1u);
      asm volatile("s_waitcnt vmcnt(0)" ::: "memory");
    } else {
      XB_SPIN(xb_ld(&bar[XB_XGEN(x)]) == gen, bar);
      __builtin_amdgcn_fence(__ATOMIC_ACQUIRE, "agent");
      asm volatile("s_waitcnt vmcnt(0)" ::: "memory");
    }
  }
  __syncthreads();
}

DI unsigned short f2bf(float x) { unsigned u = __float_as_uint(x); u += 0x7fffu + ((u >> 16) & 1u); return (unsigned short)(u >> 16); }
DI float bf2f(unsigned short b) { return __uint_as_float(((unsigned)b) << 16); }
DI unsigned pack2(float a, float b) { return (unsigned)f2bf(a) | ((unsigned)f2bf(b) << 16); }
DI float lo2f(unsigned u) { return __uint_as_float(u << 16); }
DI float hi2f(unsigned u) { return __uint_as_float(u & 0xffff0000u); }
DI float silu_f(float x) { return x / (1.f + __expf(-x)); }
DI float sigmoid_f(float x) { return 1.f / (1.f + __expf(-x)); }
DI int crow(int reg, int h) { return (reg & 3) + 8 * (reg >> 2) + 4 * h; }

DI bf16x8 tr_frag(const bf16_t* s, int ld, int row_lo, int row_hi, int col0) {
  const int lane = threadIdx.x & 63;
  const int i16 = lane & 15, q = i16 >> 2, pp = i16 & 3, blk = (lane >> 4) & 1;
  const unsigned a0 = (unsigned)(size_t)(s + (row_lo + q) * ld + col0 + 16 * blk + 4 * pp);
  const unsigned a1 = (unsigned)(size_t)(s + (row_hi + q) * ld + col0 + 16 * blk + 4 * pp);
  s16x4 lo, hi;
  asm volatile("ds_read_b64_tr_b16 %0, %2\n\tds_read_b64_tr_b16 %1, %3\n\ts_waitcnt lgkmcnt(0)"
               : "=&v"(lo), "=&v"(hi) : "v"(a0), "v"(a1) : "memory");
  return __builtin_shufflevector(lo, hi, 0, 1, 2, 3, 4, 5, 6, 7);
}

struct GemmS { bf16_t a[2][128][40]; bf16_t b[2][128][40]; };

template <class AF, class BF>
DI void gemm_core(f32x16 (&acc)[2][2], GemmS* s, AF aptr, BF bptr, int nk) {
  int tid = threadIdx.x; asm volatile("" : "+v"(tid)); const int lane = tid & 63, wave = tid >> 6, wr = wave >> 1, wc = wave & 1;
  const int r0 = tid >> 2, kv = tid & 3;
  const int fr = lane & 31, fh = lane >> 5;
  uint4 ra0 = *(const uint4*)aptr(0, r0, kv), ra1 = *(const uint4*)aptr(0, r0 + 64, kv);
  uint4 rb0 = *(const uint4*)bptr(0, r0, kv), rb1 = *(const uint4*)bptr(0, r0 + 64, kv);
  *(uint4*)&s->a[0][r0][kv * 8] = ra0; *(uint4*)&s->a[0][r0 + 64][kv * 8] = ra1;
  *(uint4*)&s->b[0][r0][kv * 8] = rb0; *(uint4*)&s->b[0][r0 + 64][kv * 8] = rb1;
  __syncthreads();
#pragma unroll 1
  for (int kt = 0; kt < nk; ++kt) {
    const int buf = kt & 1;
    if (kt + 1 < nk) {
      ra0 = *(const uint4*)aptr(kt + 1, r0, kv); ra1 = *(const uint4*)aptr(kt + 1, r0 + 64, kv);
      rb0 = *(const uint4*)bptr(kt + 1, r0, kv); rb1 = *(const uint4*)bptr(kt + 1, r0 + 64, kv);
    }
#pragma unroll
    for (int ks = 0; ks < 2; ++ks) {
      bf16x8 af[2], bq[2];
#pragma unroll
      for (int i = 0; i < 2; ++i) af[i] = *(const bf16x8*)&s->a[buf][wr * 64 + i * 32 + fr][ks * 16 + fh * 8];
#pragma unroll
      for (int j = 0; j < 2; ++j) bq[j] = *(const bf16x8*)&s->b[buf][wc * 64 + j * 32 + fr][ks * 16 + fh * 8];
#pragma unroll
      for (int i = 0; i < 2; ++i)
#pragma unroll
        for (int j = 0; j < 2; ++j) acc[i][j] = MFMA(af[i], bq[j], acc[i][j]);
    }
    if (kt + 1 < nk) {
      *(uint4*)&s->a[buf ^ 1][r0][kv * 8] = ra0; *(uint4*)&s->a[buf ^ 1][r0 + 64][kv * 8] = ra1;
      *(uint4*)&s->b[buf ^ 1][r0][kv * 8] = rb0; *(uint4*)&s->b[buf ^ 1][r0 + 64][kv * 8] = rb1;
    }
    __syncthreads();
  }
}

DI void zero_acc(f32x16 (&acc)[2][2]) {
#pragma unroll
  for (int i = 0; i < 2; ++i)
#pragma unroll
    for (int j = 0; j < 2; ++j)
#pragma unroll
      for (int r = 0; r < 16; ++r) acc[i][j][r] = 0.f;
}

template <class EPI>
DI void epilogue_lds(f32x16 (&acc)[2][2], char* smem, EPI epi) {
  float* T = (float*)smem;
  int tid = threadIdx.x; asm volatile("" : "+v"(tid)); const int lane = tid & 63, wave = tid >> 6, wr = wave >> 1, wc = wave & 1, fr = lane & 31, fh = lane >> 5;
#pragma unroll
  for (int i = 0; i < 2; ++i) {
#pragma unroll
    for (int j = 0; j < 2; ++j)
#pragma unroll
      for (int r = 0; r < 16; ++r) T[(wr * 32 + crow(r, fh)) * 132 + wc * 64 + j * 32 + fr] = acc[i][j][r];
    __syncthreads();
#pragma unroll 2
    for (int e = tid; e < 2048; e += 256) {
      const int tr = e >> 5, c4 = (e & 31) * 4;
      const float4 v = *(const float4*)&T[tr * 132 + c4];
      epi((tr >> 5) * 64 + i * 32 + (tr & 31), c4, v);
    }
    __syncthreads();
  }
}

DI void phase_mods(const Params& p_in, char* smem) {
  const Params p = load_params();

  float* ssc = (float*)smem;
  float* red = (float*)(smem + 20480);
  float* mods = (float*)(p.ws + OFF_MODS);
  int tid = threadIdx.x; asm volatile("" : "+v"(tid));
  if (blockIdx.x == 0) { unsigned* bar = (unsigned*)(p.ws + OFF_BAR); for (int i = tid; i < XCD_BAR_WORDS; i += 256) bar[i] = 0u; }
  for (int it = blockIdx.x; it < 96; it += gridDim.x) {
    const int l = it / 48, col0 = (it % 48) * 64;
    __syncthreads();
    for (int e = tid; e < 5120; e += 256) {
      const int v = e >> 10, k = e & 1023;
      const float cv = (v < 4) ? p.c[v * 1024 + k] : p.c_ctx[k];
      ssc[e] = silu_f(cv);
    }
    __syncthreads();
    const int col = tid & 63, kg = tid >> 6;
    float a[5] = {0.f, 0.f, 0.f, 0.f, 0.f};
    const float* w = p.w_mod + (size_t)l * 1024 * 3072 + col0 + col;
    for (int k = kg * 256; k < kg * 256 + 256; k += 8) {
      float wv[8];
#pragma unroll
      for (int u = 0; u < 8; ++u) wv[u] = w[(size_t)(k + u) * 3072];
#pragma unroll
      for (int u = 0; u < 8; ++u)
#pragma unroll
        for (int v = 0; v < 5; ++v) a[v] += ssc[v * 1024 + k + u] * wv[u];
    }
#pragma unroll
    for (int v = 0; v < 5; ++v) red[(kg * 5 + v) * 64 + col] = a[v];
    __syncthreads();
    for (int e = tid; e < 320; e += 256) {
      const int v = e >> 6, cc = e & 63;
      float sum = p.b_mod[l * 3072 + col0 + cc];
      for (int g = 0; g < 4; ++g) sum += red[(g * 5 + v) * 64 + cc];
      mods[(l * 5 + v) * 3072 + col0 + cc] = sum;
    }
  }
}

DI int win_colmap(int n) {
  if (n < 2560) return n;
  if (n < 3840) return n + 32;
  if (n < 4864) {
    const int j = n - 3840, q64 = j >> 6, w = j & 63;
    return (w < 32) ? (3872 + q64 * 32 + w) : (3872 + 512 + q64 * 32 + (w - 32));
  }
  if (n < 5376) return n + 32;
  if (n < 5408) return n - 5376 + 2560;
  return -1;
}

DI void transpose_tile(const float* src, int ldsrc, int kind, const float* rowscale, bf16_t* dst, int lddst, int n0, int k0, float* tile) {
  int tid = threadIdx.x; asm volatile("" : "+v"(tid)); const int tx = tid & 63, ty = tid >> 6;
  __syncthreads();
  const int n = (kind == 0) ? win_colmap(n0 + tx) : (n0 + tx);
  for (int r = ty; r < 64; r += 4) {
    const int k = k0 + r;
    float v = 0.f;
    if (n >= 0) v = src[(size_t)k * ldsrc + n];
    if (rowscale != nullptr && k < 1024) v *= rowscale[k];
    tile[r * 65 + tx] = v;
  }
  __syncthreads();
  for (int r = ty; r < 64; r += 4) dst[(size_t)(n0 + r) * lddst + k0 + tx] = f2bf(tile[tx * 65 + r]);
}

DI void phase_prep(const Params& p_in, int l, char* smem) {
  const Params p = load_params();

  int tid = threadIdx.x; asm volatile("" : "+v"(tid)); const int lane = tid & 63, wave = tid >> 6;
  const float* mods = (const float*)(p.ws + OFF_MODS);
  bf16_t* H = (bf16_t*)(p.ws + OFF_H);
  const int NT_WIN = 86 * 16, NT_WOUT = 16 * 32, NT_PW = 64, NT_CONV = NT_WIN + NT_WOUT + NT_PW;
  const int NT = NT_CONV + R_ / 4;
  for (int it = blockIdx.x; it < NT; it += gridDim.x) {
    if (it < NT_WIN) {
      transpose_tile(p.w_in + (size_t)l * 1024 * 5408, 5408, 0, nullptr, (bf16_t*)(p.ws + OFF_WIN), 1024, (it / 16) * 64, (it % 16) * 64, (float*)smem);
    } else if (it < NT_WIN + NT_WOUT) {
      const int t = it - NT_WIN;
      transpose_tile(p.w_out + (size_t)l * 2048 * 1024, 1024, 1, p.ssd_norm_w + l * 1024, (bf16_t*)(p.ws + OFF_WOUT), 2048, (t / 32) * 64, (t % 32) * 64, (float*)smem);
    } else if (it < NT_CONV) {
      const int t = it - NT_WIN - NT_WOUT;
      transpose_tile(p.conv_pw_w + (size_t)l * 512 * 512, 512, 1, nullptr, (bf16_t*)(p.ws + OFF_PW), 512, (t / 8) * 64, (t % 8) * 64, (float*)smem);
    } else {
      const int rho = (it - NT_CONV) * 4 + wave;
      const float* xs;
      if (l == 0) xs = (rho < RL_) ? (p.x + (size_t)rho * 1024) : (p.ctx + (size_t)(rho - RL_) * 1024);
      else xs = (rho < RL_) ? (p.out + (size_t)rho * 1024) : ((const float*)(p.ws + OFF_XC) + (size_t)(rho - RL_) * 1024);
      const int v = (rho < RL_) ? (rho >> 12) : 4;
      const float* md = mods + (l * 5 + v) * 3072;
      float4 xv[4];
      float ss = 0.f;
#pragma unroll
      for (int i = 0; i < 4; ++i) {
        xv[i] = *(const float4*)(xs + lane * 4 + i * 256);
        ss += xv[i].x * xv[i].x + xv[i].y * xv[i].y + xv[i].z * xv[i].z + xv[i].w * xv[i].w;
      }
#pragma unroll
      for (int o = 32; o >= 1; o >>= 1) ss += __shfl_xor(ss, o);
      const float rs = rsqrtf(ss * (1.f / 1024.f) + 1e-6f);
#pragma unroll
      for (int i = 0; i < 4; ++i) {
        const int cidx = lane * 4 + i * 256;
        const float4 nw = *(const float4*)(p.norm_w + l * 1024 + cidx);
        const float4 sh = *(const float4*)(md + cidx);
        const float4 sc = *(const float4*)(md + 1024 + cidx);
        uint2 o;
        o.x = pack2(xv[i].x * rs * nw.x * (1.f + sc.x) + sh.x, xv[i].y * rs * nw.y * (1.f + sc.y) + sh.y);
        o.y = pack2(xv[i].z * rs * nw.z * (1.f + sc.z) + sh.z, xv[i].w * rs * nw.w * (1.f + sc.w) + sh.w);
        *(uint2*)(H + (size_t)rho * 1024 + cidx) = o;
      }
    }
  }
}

DI void phase_inproj(const Params& p_in, char* smem) {
  const Params p = load_params();

  GemmS* s = (GemmS*)smem;
  int tid = threadIdx.x; asm volatile("" : "+v"(tid)); const int lane = tid & 63, wave = tid >> 6, wr = wave >> 1, wc = wave & 1, fr = lane & 31, fh = lane >> 5;
  const bf16_t* H = (const bf16_t*)(p.ws + OFF_H);
  const bf16_t* W = (const bf16_t*)(p.ws + OFF_WIN);
  for (int it = blockIdx.x; it < NCK * 43; it += gridDim.x) {
    const int mt = it / 43, nt = it % 43;
    f32x16 acc[2][2];
    zero_acc(acc);
    const bf16_t* Ab = H + (size_t)mt * 128 * 1024;
    const bf16_t* Bb = W + (size_t)nt * 128 * 1024;
    gemm_core(acc, s,
              [&](int kt, int r, int kv) { return Ab + (size_t)r * 1024 + kt * 32 + kv * 8; },
              [&](int kt, int r, int kv) { return Bb + (size_t)r * 1024 + kt * 32 + kv * 8; }, 32);
    const int row0 = mt * 128;
    if (nt >= 30 && nt < 38) {
#pragma unroll
      for (int i = 0; i < 2; ++i)
#pragma unroll
        for (int r = 0; r < 16; ++r) acc[i][0][r] = acc[i][0][r] * sigmoid_f(acc[i][1][r]);
      bf16_t* G = (bf16_t*)(p.ws + OFF_GLU);
      const int cb0 = (nt - 30) * 64;
      epilogue_lds(acc, smem, [&](int rl, int c4, float4 v) {
        if ((c4 & 32) == 0) {
          uint2 o; o.x = pack2(v.x, v.y); o.y = pack2(v.z, v.w);
          *(uint2*)(G + (size_t)(row0 + rl) * 512 + cb0 + (c4 >> 6) * 32 + (c4 & 31)) = o;
        }
      });
    } else if (nt == 42) {
      float* DT = (float*)(p.ws + OFF_DT);
      epilogue_lds(acc, smem, [&](int rl, int c4, float4 v) {
        if (c4 < 32) *(float4*)(DT + (size_t)(row0 + rl) * 32 + c4) = v;
      });
    } else {
      bf16_t* dst; int ld, cb;
      if (nt < 12) { dst = (bf16_t*)(p.ws + OFF_XBC); ld = 1536; cb = nt * 128; }
      else if (nt < 20) { dst = (bf16_t*)(p.ws + OFF_Z); ld = 1024; cb = nt * 128 - 1536; }
      else if (nt < 24) { dst = (bf16_t*)(p.ws + OFF_Q); ld = 512; cb = nt * 128 - 2560; }
      else if (nt < 26) { dst = (bf16_t*)(p.ws + OFF_KV); ld = 256; cb = nt * 128 - 3072; }
      else if (nt < 30) { dst = (bf16_t*)(p.ws + OFF_AG); ld = 512; cb = nt * 128 - 3328; }
      else { dst = (bf16_t*)(p.ws + OFF_CG); ld = 512; cb = nt * 128 - 4864; }
      epilogue_lds(acc, smem, [&](int rl, int c4, float4 v) {
        uint2 o; o.x = pack2(v.x, v.y); o.y = pack2(v.z, v.w);
        *(uint2*)(dst + (size_t)(row0 + rl) * ld + cb + c4) = o;
      });
    }
  }
}

DI void phase_local(const Params& p_in, int l, char* smem) {
  const Params p = load_params();

  int tid = threadIdx.x; asm volatile("" : "+v"(tid)); const int lane = tid & 63;
  const bf16_t* XBC = (const bf16_t*)(p.ws + OFF_XBC);
  bf16_t* XS = (bf16_t*)(p.ws + OFF_H);
  bf16_t* BC = (bf16_t*)(p.ws + OFF_BC);
  float* DT = (float*)(p.ws + OFF_DT);
  float* CS = (float*)(p.ws + OFF_CS);
  const bf16_t* GLU = (const bf16_t*)(p.ws + OFF_GLU);
  bf16_t* HDN = (bf16_t*)(p.ws + OFF_HDN);
  bf16_t* Q = (bf16_t*)(p.ws + OFF_Q);
  bf16_t* KV = (bf16_t*)(p.ws + OFF_KV);
  const int N_CONV = R_ * 192 / 256;
  const int N_DT = NCK;
  const int N_CF = R_ / 16;
  const int N_ROPE = RL_ * 40 / 256;
  const int N_QC = 1024 * 256 / 256;
  const int NT = N_CF + N_DT + N_CONV + N_ROPE + N_QC;
  for (int it0 = blockIdx.x; it0 < NT; it0 += gridDim.x) {
    int it = it0;
    if (it < N_CF) {
      float* sst = (float*)smem;
      unsigned* sIn = (unsigned*)(smem + 256);
      const int row0 = it * 16;
      const int seq0 = (row0 < RL_) ? (row0 & ~4095) : (RL_ + ((row0 - RL_) & ~255));
      const int slen = (row0 < RL_) ? 4096 : 256;
      const int t0 = row0 - seq0;
      const int c0 = tid * 2;
      __syncthreads();
      if (tid < 32) sst[tid] = 0.f;
      for (int idx = tid; idx < 46 * 64; idx += 256) {
        const int rr = idx >> 6, c16 = idx & 63;
        const int tt = t0 - 15 + rr;
        uint4 val = make_uint4(0u, 0u, 0u, 0u);
        if (tt >= 0 && tt < slen) val = *(const uint4*)(GLU + (size_t)(seq0 + tt) * 512 + c16 * 8);
        *(uint4*)&sIn[rr * 256 + c16 * 4] = val;
      }
      float w0[31], w1[31];
#pragma unroll
      for (int k = 0; k < 31; ++k) {
        const float2 wv = *(const float2*)(p.conv_dw_w + ((size_t)l * 31 + k) * 512 + c0);
        w0[k] = wv.x; w1[k] = wv.y;
      }
      const float2 bv = *(const float2*)(p.conv_dw_b + l * 512 + c0);
      float a0[16], a1[16];
#pragma unroll
      for (int r = 0; r < 16; ++r) { a0[r] = bv.x; a1[r] = bv.y; }
      __syncthreads();
#pragma unroll
      for (int tp = 0; tp < 46; ++tp) {
        const unsigned u = sIn[tp * 256 + tid];
        const float x0 = lo2f(u), x1 = hi2f(u);
#pragma unroll
        for (int r = 0; r < 16; ++r) {
          const int k = tp - r;
          if (k >= 0 && k < 31) { a0[r] += w0[k] * x0; a1[r] += w1[k] * x1; }
        }
      }
      {
        float v[32];
#pragma unroll
        for (int r = 0; r < 16; ++r) { v[2 * r] = a0[r] + a1[r]; v[2 * r + 1] = a0[r] * a0[r] + a1[r] * a1[r]; }
#pragma unroll
        for (int i = 0; i < 16; ++i) { const bool up = (lane & 32) != 0; const float keep = up ? v[i + 16] : v[i]; const float send = up ? v[i] : v[i + 16]; v[i] = keep + __shfl_xor(send, 32); }
#pragma unroll
        for (int i = 0; i < 8; ++i) { const bool up = (lane & 16) != 0; const float keep = up ? v[i + 8] : v[i]; const float send = up ? v[i] : v[i + 8]; v[i] = keep + __shfl_xor(send, 16); }
#pragma unroll
        for (int i = 0; i < 4; ++i) { const bool up = (lane & 8) != 0; const float keep = up ? v[i + 4] : v[i]; const float send = up ? v[i] : v[i + 4]; v[i] = keep + __shfl_xor(send, 8); }
#pragma unroll
        for (int i = 0; i < 2; ++i) { const bool up = (lane & 4) != 0; const float keep = up ? v[i + 2] : v[i]; const float send = up ? v[i] : v[i + 2]; v[i] = keep + __shfl_xor(send, 4); }
        { const bool up = (lane & 2) != 0; const float keep = up ? v[1] : v[0]; const float send = up ? v[0] : v[1]; v[0] = keep + __shfl_xor(send, 2); }
        v[0] += __shfl_xor(v[0], 1);
        __syncthreads();
        if ((lane & 1) == 0) atomicAdd(&sst[lane >> 1], v[0]);
      }
      __syncthreads();
      const float2 lw = *(const float2*)(p.conv_ln_w + l * 512 + c0);
      const float2 lb = *(const float2*)(p.conv_ln_b + l * 512 + c0);
#pragma unroll
      for (int r = 0; r < 16; ++r) {
        const float mean = sst[r * 2] * (1.f / 512.f);
        const float var = fmaxf(sst[r * 2 + 1] * (1.f / 512.f) - mean * mean, 0.f);
        const float rs = rsqrtf(var + 1e-6f);
        const float y0 = (a0[r] - mean) * rs * lw.x + lb.x;
        const float y1 = (a1[r] - mean) * rs * lw.y + lb.y;
        *(unsigned*)(HDN + (size_t)(row0 + r) * 512 + c0) = pack2(silu_f(y0), silu_f(y1));
      }
      continue;
    }
    it -= N_CF;
    if (it < N_DT) {
      float* sdt = (float*)smem;
      const int row0 = it * 128;
      __syncthreads();
      for (int e = tid; e < 4096; e += 256) {
        const int r = e >> 5, cidx = e & 31;
        const float raw = DT[(size_t)(row0 + r) * 32 + cidx] + p.ssd_dt_bias[l * 32 + cidx];
        const float sp = (raw > 20.f) ? raw : log1pf(expf(raw));
        DT[(size_t)(row0 + r) * 32 + cidx] = sp;
        sdt[r * 33 + cidx] = sp;
      }
      __syncthreads();
      if (tid < 32) {
        const float a = -expf(p.ssd_a_log[l * 32 + tid]);
        float run = 0.f;
        if (tid < 16) {
          for (int r = 0; r < 128; ++r) { run += sdt[r * 33 + tid] * a; CS[(size_t)(row0 + r) * 32 + tid] = run; }
        } else {
          for (int r = 127; r >= 0; --r) { run += sdt[r * 33 + tid] * a; CS[(size_t)(row0 + r) * 32 + tid] = run; }
        }
      }
      continue;
    }
    it -= N_DT;
    if (it < N_CONV) {
      const int e = it * 256 + tid;
      const int rho = e / 192, cgp = e % 192, ch0 = cgp * 8;
      const int seq0 = (rho < RL_) ? (rho & ~4095) : (RL_ + ((rho - RL_) & ~255));
      const int slen = (rho < RL_) ? 4096 : 256;
      const int t = rho - seq0;
      float a[8];
      {
        const float4 b0 = *(const float4*)(p.ssd_conv_b + l * 1536 + ch0);
        const float4 b1 = *(const float4*)(p.ssd_conv_b + l * 1536 + ch0 + 4);
        a[0] = b0.x; a[1] = b0.y; a[2] = b0.z; a[3] = b0.w; a[4] = b1.x; a[5] = b1.y; a[6] = b1.z; a[7] = b1.w;
      }
#pragma unroll
      for (int k = 0; k < 5; ++k) {
        const int tt = t + k - 2;
        if (tt >= 0 && tt < slen) {
          const uint4 u = *(const uint4*)(XBC + (size_t)(seq0 + tt) * 1536 + ch0);
          const float4 w0 = *(const float4*)(p.ssd_conv_w + ((size_t)l * 5 + k) * 1536 + ch0);
          const float4 w1 = *(const float4*)(p.ssd_conv_w + ((size_t)l * 5 + k) * 1536 + ch0 + 4);
          a[0] += w0.x * lo2f(u.x); a[1] += w0.y * hi2f(u.x); a[2] += w0.z * lo2f(u.y); a[3] += w0.w * hi2f(u.y);
          a[4] += w1.x * lo2f(u.z); a[5] += w1.y * hi2f(u.z); a[6] += w1.z * lo2f(u.w); a[7] += w1.w * hi2f(u.w);
        }
      }
      uint4 o;
      o.x = pack2(silu_f(a[0]), silu_f(a[1])); o.y = pack2(silu_f(a[2]), silu_f(a[3]));
      o.z = pack2(silu_f(a[4]), silu_f(a[5])); o.w = pack2(silu_f(a[6]), silu_f(a[7]));
      if (ch0 < 1024) *(uint4*)(XS + (size_t)rho * 1024 + ch0) = o;
      else *(uint4*)(BC + (size_t)rho * 512 + (ch0 - 1024)) = o;
      continue;
    }
    it -= N_CONV;
    if (it < N_ROPE) {
      const int e = it * 256 + tid;
      const int rho = e / 40, rem = e % 40, hd = rem >> 2, sub = rem & 3;
      const int axis = sub >> 1, half = sub & 1;
      const int t = rho & 4095;
      const float pos = (float)(axis == 0 ? (t >> 6) : (t & 63));
      bf16_t* base = ((hd < 8) ? (Q + (size_t)rho * 512 + hd * 64) : (KV + (size_t)rho * 256 + (hd - 8) * 64)) + axis * 32 + half * 8;
      const float sc = (hd < 8) ? 0.125f : 1.f;
      const uint4 u1 = *(const uint4*)base, u2 = *(const uint4*)(base + 16);
      const unsigned a1[4] = {u1.x, u1.y, u1.z, u1.w}, a2[4] = {u2.x, u2.y, u2.z, u2.w};
      unsigned o1[4], o2[4];
#pragma unroll
      for (int i = 0; i < 4; ++i) {
        float r1[2], r2[2];
#pragma unroll
        for (int hl = 0; hl < 2; ++hl) {
          const float f = (float)(half * 8 + 2 * i + hl);
          const float ang = pos * exp2f(-f * 0.8304820237218406f);
          const float cs = __cosf(ang), sn = __sinf(ang);
          const float t1 = hl ? hi2f(a1[i]) : lo2f(a1[i]);
          const float t2 = hl ? hi2f(a2[i]) : lo2f(a2[i]);
          r1[hl] = (t1 * cs - t2 * sn) * sc;
          r2[hl] = (t2 * cs + t1 * sn) * sc;
        }
        o1[i] = pack2(r1[0], r1[1]); o2[i] = pack2(r2[0], r2[1]);
      }
      *(uint4*)base = make_uint4(o1[0], o1[1], o1[2], o1[3]);
      *(uint4*)(base + 16) = make_uint4(o2[0], o2[1], o2[2], o2[3]);
      continue;
    }
    it -= N_ROPE;
    {
      const int e = it * 256 + tid;
      const int rho = RL_ + e / 256, c2 = (e % 256) * 2;
      unsigned* ptr = (unsigned*)(Q + (size_t)rho * 512 + c2);
      const unsigned u = *ptr;
      *ptr = pack2(lo2f(u) * 0.125f, hi2f(u) * 0.125f);
    }
  }
}

DI void attn_item(const Params& p_in, int l, char* smem, int b, int qblk, int g, int hp, bool ctxq) {
  const Params p = load_params();

  bf16_t* sK = (bf16_t*)smem;
  bf16_t* sV = (bf16_t*)(smem + 128 * 72 * 2);
  int tid = threadIdx.x; asm volatile("" : "+v"(tid)); const int lane = tid & 63, wave = tid >> 6, fr = lane & 31, fh = lane >> 5;
  const int head = g * 4 + hp * 2 + (wave >> 1);
  const int qh = wave & 1;
  const int qrow0 = (ctxq ? (RL_ + b * 256) : (b * 4096)) + qblk * 128 + qh * 64;
  const int qpos0 = qblk * 128 + qh * 64;
  bf16_t* Q = (bf16_t*)(p.ws + OFF_Q);
  const bf16_t* KV = (const bf16_t*)(p.ws + OFF_KV);
  const bf16_t* AG = (const bf16_t*)(p.ws + OFF_AG);
  bf16x8 qf[2][4];
#pragma unroll
  for (int j = 0; j < 2; ++j)
#pragma unroll
    for (int ks = 0; ks < 4; ++ks)
      qf[j][ks] = *(const bf16x8*)(Q + (size_t)(qrow0 + j * 32 + fr) * 512 + head * 64 + ks * 16 + fh * 8);
  f32x16 o[2][2];
  zero_acc(o);
  float m[2], lsum[2];
  m[0] = m[1] = p.attn_sink[l * 8 + head];
  lsum[0] = lsum[1] = 1.f;
  const int nblk = ctxq ? 2 : 5;
  for (int bi = 0; bi < nblk; ++bi) {
    int krow0, kpos0 = 0;
    bool masked = false;
    if (bi < 2) {
      krow0 = RL_ + b * 256 + bi * 128;
    } else {
      const int kb = qblk + bi - 3;
      if (kb < 0 || kb >= 32) continue;
      krow0 = b * 4096 + kb * 128;
      kpos0 = kb * 128;
      masked = (bi != 3);
    }
    __syncthreads();
    for (int v = tid; v < 1024; v += 256) {
      const int r = v >> 3, cv = v & 7;
      *(uint4*)&sK[r * 72 + cv * 8] = *(const uint4*)(KV + (size_t)(krow0 + r) * 256 + g * 64 + cv * 8);
      *(uint4*)&sV[r * 72 + cv * 8] = *(const uint4*)(KV + (size_t)(krow0 + r) * 256 + 128 + g * 64 + cv * 8);
    }
    __syncthreads();
#pragma unroll 1
    for (int kb = 0; kb < 4; ++kb) {
      f32x16 st[2];
#pragma unroll
      for (int j = 0; j < 2; ++j)
#pragma unroll
        for (int r = 0; r < 16; ++r) st[j][r] = 0.f;
#pragma unroll
      for (int ks = 0; ks < 4; ++ks) {
        const bf16x8 kf = *(const bf16x8*)&sK[(kb * 32 + fr) * 72 + ks * 16 + fh * 8];
#pragma unroll
        for (int j = 0; j < 2; ++j) st[j] = MFMA(kf, qf[j][ks], st[j]);
      }
      bf16x8 pb[2][2];
#pragma unroll
      for (int j = 0; j < 2; ++j) {
        if (masked) {
          const int qpos = qpos0 + j * 32 + fr;
#pragma unroll
          for (int r = 0; r < 16; ++r) {
            const int d = qpos - (kpos0 + kb * 32 + crow(r, fh));
            if (d > 128 || d < -128) st[j][r] = -1e30f;
          }
        }
        float mx = st[j][0];
#pragma unroll
        for (int r = 1; r < 16; ++r) mx = fmaxf(mx, st[j][r]);
        mx = fmaxf(mx, __shfl_xor(mx, 32));
        const float mnew = fmaxf(m[j], mx);
        const float alpha = __expf(m[j] - mnew);
        float rs = 0.f;
#pragma unroll
        for (int r = 0; r < 16; ++r) { const float pv = __expf(st[j][r] - mnew); st[j][r] = pv; rs += pv; }
        rs += __shfl_xor(rs, 32);
        lsum[j] = lsum[j] * alpha + rs;
        m[j] = mnew;
#pragma unroll
        for (int mt = 0; mt < 2; ++mt)
#pragma unroll
          for (int r = 0; r < 16; ++r) o[mt][j][r] *= alpha;
#pragma unroll
        for (int s = 0; s < 2; ++s)
#pragma unroll
          for (int jj = 0; jj < 8; ++jj) pb[j][s][jj] = (short)f2bf(st[j][8 * s + jj]);
      }
#pragma unroll
      for (int s = 0; s < 2; ++s)
#pragma unroll
        for (int mt = 0; mt < 2; ++mt) {
          const bf16x8 vf = tr_frag(sV, 72, kb * 32 + 16 * s + 4 * fh, kb * 32 + 16 * s + 8 + 4 * fh, mt * 32);
#pragma unroll
          for (int j = 0; j < 2; ++j) o[mt][j] = MFMA(vf, pb[j][s], o[mt][j]);
        }
    }
  }
#pragma unroll
  for (int j = 0; j < 2; ++j) {
    const float inv = 1.f / lsum[j];
    const size_t rho = (size_t)(qrow0 + j * 32 + fr);
#pragma unroll
    for (int mt = 0; mt < 2; ++mt)
#pragma unroll
      for (int g4 = 0; g4 < 4; ++g4) {
        const int d0 = mt * 32 + 8 * g4 + 4 * fh;
        const uint2 gv = *(const uint2*)(AG + rho * 512 + head * 64 + d0);
        uint2 ov;
        ov.x = pack2(o[mt][j][g4 * 4 + 0] * inv * silu_f(lo2f(gv.x)), o[mt][j][g4 * 4 + 1] * inv * silu_f(hi2f(gv.x)));
        ov.y = pack2(o[mt][j][g4 * 4 + 2] * inv * silu_f(lo2f(gv.y)), o[mt][j][g4 * 4 + 3] * inv * silu_f(hi2f(gv.y)));
        *(uint2*)(Q + rho * 512 + head * 64 + d0) = ov;
      }
  }
}

DI void states_item(const Params& p_in, char* smem, int ck, int g, int hq) {
  const Params p = load_params();

  bf16_t* sB = (bf16_t*)smem;
  bf16_t* sX = (bf16_t*)(smem + 128 * 136 * 2);
  int tid = threadIdx.x; asm volatile("" : "+v"(tid)); const int lane = tid & 63, wave = tid >> 6, wr = wave >> 1, wc = wave & 1, fr = lane & 31, fh = lane >> 5;
  const bf16_t* BC = (const bf16_t*)(p.ws + OFF_BC);
  const bf16_t* XS = (const bf16_t*)(p.ws + OFF_H);
  const float* DT = (const float*)(p.ws + OFF_DT);
  const float* CS = (const float*)(p.ws + OFF_CS);
  bf16_t* ST = (bf16_t*)(p.ws + OFF_ST);
  float* CDEC = (float*)(p.ws + OFF_CDEC);
  const int row0 = ck * 128;
  __syncthreads();
  for (int v = tid; v < 2048; v += 256) {
    const int r = v >> 4, cv = v & 15;
    *(uint4*)&sB[r * 136 + cv * 8] = *(const uint4*)(BC + (size_t)(row0 + r) * 512 + g * 128 + cv * 8);
  }
  __syncthreads();
  bf16x8 bfr[2][8];
#pragma unroll
  for (int j = 0; j < 2; ++j)
#pragma unroll
    for (int ks = 0; ks < 8; ++ks) bfr[j][ks] = tr_frag(sB, 136, ks * 16 + 8 * fh, ks * 16 + 8 * fh + 4, wc * 64 + j * 32);
#pragma unroll 1
  for (int hd = 0; hd < 8; ++hd) {
    const int head = g * 8 + hq * 4 + (hd >> 1), d = hd & 1;
    const int col = d * 16 + head;
    const float cend = CS[(size_t)(row0 + (d == 0 ? 127 : 0)) * 32 + col];
    for (int v = tid; v < 1024; v += 256) {
      const int lr = v >> 3, cv = v & 7;
      const size_t rho = (size_t)(row0 + lr);
      const float sc = DT[rho * 32 + col] * __expf(cend - CS[rho * 32 + col]);
      const uint4 u = *(const uint4*)(XS + rho * 1024 + head * 64 + cv * 8);
      uint4 o;
      o.x = pack2(lo2f(u.x) * sc, hi2f(u.x) * sc); o.y = pack2(lo2f(u.y) * sc, hi2f(u.y) * sc);
      o.z = pack2(lo2f(u.z) * sc, hi2f(u.z) * sc); o.w = pack2(lo2f(u.w) * sc, hi2f(u.w) * sc);
      *(uint4*)&sX[lr * 72 + cv * 8] = o;
    }
    __syncthreads();
    f32x16 acc[2];
#pragma unroll
    for (int j = 0; j < 2; ++j)
#pragma unroll
      for (int r = 0; r < 16; ++r) acc[j][r] = 0.f;
#pragma unroll
    for (int ks = 0; ks < 8; ++ks) {
      const bf16x8 af = tr_frag(sX, 72, ks * 16 + 8 * fh, ks * 16 + 8 * fh + 4, wr * 32);
#pragma unroll
      for (int j = 0; j < 2; ++j) acc[j] = MFMA(af, bfr[j][ks], acc[j]);
    }
    bf16_t* dst = ST + ((size_t)(ck * 2 + d) * 16 + head) * 8192;
#pragma unroll
    for (int j = 0; j < 2; ++j)
#pragma unroll
      for (int r = 0; r < 16; ++r) dst[(wr * 32 + crow(r, fh)) * 128 + wc * 64 + j * 32 + fr] = f2bf(acc[j][r]);
    if (tid == 0) CDEC[(ck * 2 + d) * 16 + head] = __expf(cend);
    __syncthreads();
  }
}

DI void pw_item(const Params& p_in, int l, char* smem, int mt, int nt) {
  const Params p = load_params();

  GemmS* s = (GemmS*)smem;
  int tid = threadIdx.x; asm volatile("" : "+v"(tid)); const int lane = tid & 63, wave = tid >> 6, wr = wave >> 1, wc = wave & 1, fr = lane & 31, fh = lane >> 5;
  const bf16_t* Ab = (const bf16_t*)(p.ws + OFF_HDN) + (size_t)mt * 128 * 512;
  const bf16_t* Bb = (const bf16_t*)(p.ws + OFF_PW) + (size_t)nt * 128 * 512;
  bf16_t* CG = (bf16_t*)(p.ws + OFF_CG);
  f32x16 acc[2][2];
  zero_acc(acc);
  gemm_core(acc, s,
            [&](int kt, int r, int kv) { return Ab + (size_t)r * 512 + kt * 32 + kv * 8; },
            [&](int kt, int r, int kv) { return Bb + (size_t)r * 512 + kt * 32 + kv * 8; }, 16);
  const float* pwb = p.conv_pw_b + l * 512 + nt * 128;
  epilogue_lds(acc, smem, [&](int rl, int c4, float4 v) {
    bf16_t* ptr = CG + (size_t)(mt * 128 + rl) * 512 + nt * 128 + c4;
    const uint2 gv = *(const uint2*)ptr;
    const float4 bb = *(const float4*)(pwb + c4);
    uint2 o;
    o.x = pack2((v.x + bb.x) * silu_f(lo2f(gv.x)), (v.y + bb.y) * silu_f(hi2f(gv.x)));
    o.y = pack2((v.z + bb.z) * silu_f(lo2f(gv.y)), (v.w + bb.w) * silu_f(hi2f(gv.y)));
    *(uint2*)ptr = o;
  });
}

DI void phase_mix(const Params& p, int l, char* smem) {
  const int N_ATT = 512 + (l == 0 ? 32 : 0);
  const int N_ST = NCK * 4;
  const int N_PW = NCK * 4;
  const int NT = N_ATT + N_ST + N_PW;
  for (int it0 = blockIdx.x; it0 < NT; it0 += gridDim.x) {
    int it = it0;
    if (it < N_ATT) {
      if (it < 512) attn_item(p, l, smem, it >> 7, (it >> 2) & 31, (it >> 1) & 1, it & 1, false);
      else { const int t = it - 512; attn_item(p, l, smem, t >> 3, (t >> 2) & 1, (t >> 1) & 1, t & 1, true); }
      continue;
    }
    it -= N_ATT;
    if (it < N_ST) { states_item(p, smem, it >> 2, (it >> 1) & 1, it & 1); continue; }
    it -= N_ST;
    pw_item(p, l, smem, it >> 2, it & 3);
  }
}

DI void phase_scan(const Params& p_in) {
  const Params p = load_params();

  bf16_t* ST = (bf16_t*)(p.ws + OFF_ST);
  const float* CDEC = (const float*)(p.ws + OFF_CDEC);
  for (int it = blockIdx.x; it < 512; it += gridDim.x) {
    const int e = it * 256 + threadIdx.x;
    const int bdh = e >> 10, v8 = e & 1023;
    const int b = bdh >> 5, d = (bdh >> 4) & 1, h = bdh & 15;
    float s[8];
#pragma unroll
    for (int i = 0; i < 8; ++i) s[i] = 0.f;
    auto ckof = [&](int i) {
      if (d == 0) return (i < 2) ? (128 + 2 * b + i) : (32 * b + (i - 2));
      return (i < 2) ? (128 + 2 * b + (1 - i)) : (32 * b + 31 - (i - 2));
    };
    auto pof = [&](int i) { const int ck = ckof(i); return (uint4*)(ST + ((size_t)(ck * 2 + d) * 16 + h) * 8192 + v8 * 8); };
    auto dof = [&](int i) { const int ck = ckof(i); return CDEC[(ck * 2 + d) * 16 + h]; };
    uint4 buf[4]; float dc[4];
#pragma unroll
    for (int i = 0; i < 3; ++i) { buf[i] = *pof(i); dc[i] = dof(i); }
#pragma unroll
    for (int i = 0; i < 34; ++i) {
      if (i + 3 < 34) { buf[(i + 3) & 3] = *pof(i + 3); dc[(i + 3) & 3] = dof(i + 3); }
      const uint4 cur = buf[i & 3];
      const float dec = dc[i & 3];
      uint4 o;
      o.x = pack2(s[0], s[1]); o.y = pack2(s[2], s[3]); o.z = pack2(s[4], s[5]); o.w = pack2(s[6], s[7]);
      *pof(i) = o;
      s[0] = s[0] * dec + lo2f(cur.x); s[1] = s[1] * dec + hi2f(cur.x);
      s[2] = s[2] * dec + lo2f(cur.y); s[3] = s[3] * dec + hi2f(cur.y);
      s[4] = s[4] * dec + lo2f(cur.z); s[5] = s[5] * dec + hi2f(cur.z);
      s[6] = s[6] * dec + lo2f(cur.w); s[7] = s[7] * dec + hi2f(cur.w);
    }
  }
}

DI void phase_ssdy(const Params& p_in, int l, char* smem) {
  const Params p = load_params();

  bf16_t* sB = (bf16_t*)smem;
  bf16_t* sX = (bf16_t*)(smem + 128 * 136 * 2);
  float* sF = (float*)(smem + 128 * 136 * 2 + 128 * 72 * 2);
  float* sSS = sF + 512;
  int tid = threadIdx.x; asm volatile("" : "+v"(tid)); const int lane = tid & 63, wave = tid >> 6, fr = lane & 31, fh = lane >> 5;
  const int wl = wave >> 1, w2 = wave & 1;
  const bf16_t* BC = (const bf16_t*)(p.ws + OFF_BC);
  const bf16_t* XS = (const bf16_t*)(p.ws + OFF_H);
  const float* DT = (const float*)(p.ws + OFF_DT);
  const float* CS = (const float*)(p.ws + OFF_CS);
  const bf16_t* ST = (const bf16_t*)(p.ws + OFF_ST);
  bf16_t* Z = (bf16_t*)(p.ws + OFF_Z);
  float* RSTD = (float*)(p.ws + OFF_RSTD);
  const int nck = (l == 0) ? NCK : 128;
  for (int it = blockIdx.x; it < nck * 4; it += gridDim.x) {
    const int ck = it >> 2, g = (it >> 1) & 1, lh = it & 1;
    const int row0 = ck * 128;
    const int lbase = lh * 64 + wl * 32;
    __syncthreads();
    for (int v = tid; v < 2048; v += 256) {
      const int r = v >> 4, cv = v & 15;
      *(uint4*)&sB[r * 136 + cv * 8] = *(const uint4*)(BC + (size_t)(row0 + r) * 512 + g * 128 + cv * 8);
    }
    if (tid < 64) sSS[tid] = 0.f;
    const bf16_t* cptr = BC + (size_t)(row0 + lbase + fr) * 512 + 256 + g * 128 + fh * 8;
    __syncthreads();
    f32x16 cb[2];
    {
    bf16x8 cf[8];
#pragma unroll
    for (int ks = 0; ks < 8; ++ks) cf[ks] = *(const bf16x8*)(cptr + ks * 16);
#pragma unroll
    for (int j = 0; j < 2; ++j) {
#pragma unroll
      for (int r = 0; r < 16; ++r) cb[j][r] = 0.f;
#pragma unroll
      for (int ks = 0; ks < 8; ++ks) {
        const bf16x8 bq = *(const bf16x8*)&sB[(w2 * 64 + j * 32 + fr) * 136 + ks * 16 + fh * 8];
        cb[j] = MFMA(cf[ks], bq, cb[j]);
      }
    }
    }
    float ssq[16];
#pragma unroll
    for (int r = 0; r < 16; ++r) ssq[r] = 0.f;
#pragma unroll 1
    for (int hh = 0; hh < 8; ++hh) {
      const int head = g * 8 + hh;
      __syncthreads();
      for (int v = tid; v < 1024; v += 256) {
        const int lr = v >> 3, cv = v & 7;
        *(uint4*)&sX[lr * 72 + cv * 8] = *(const uint4*)(XS + (size_t)(row0 + lr) * 1024 + head * 64 + cv * 8);
      }
      if (tid < 128) {
        const size_t rho = (size_t)(row0 + tid);
        sF[tid] = CS[rho * 32 + head];
        sF[128 + tid] = CS[rho * 32 + 16 + head];
        sF[256 + tid] = DT[rho * 32 + head];
        sF[384 + tid] = DT[rho * 32 + 16 + head];
      }
      __syncthreads();
#pragma unroll
      for (int j = 0; j < 2; ++j) {
        const int sidx = w2 * 64 + j * 32 + fr;
        const float csf_s = sF[sidx], csb_s = sF[128 + sidx], dtf_s = sF[256 + sidx], dtb_s = sF[384 + sidx];
#pragma unroll
        for (int r = 0; r < 16; ++r) {
          const int lidx = lbase + crow(r, fh);
          float f = 0.f;
          if (sidx <= lidx) f += __expf(sF[lidx] - csf_s) * dtf_s;
          if (sidx >= lidx) f += __expf(sF[128 + lidx] - csb_s) * dtb_s;
          sB[(wl * 32 + crow(r, fh)) * 136 + sidx] = f2bf(cb[j][r] * f);
        }
      }
      __syncthreads();
      f32x16 accy;
#pragma unroll
      for (int r = 0; r < 16; ++r) accy[r] = 0.f;
#pragma unroll
      for (int ks = 0; ks < 8; ++ks) {
        const bf16x8 af = *(const bf16x8*)&sB[(wl * 32 + fr) * 136 + ks * 16 + fh * 8];
        const bf16x8 xf = tr_frag(sX, 72, ks * 16 + 8 * fh, ks * 16 + 8 * fh + 4, w2 * 32);
        accy = MFMA(af, xf, accy);
      }
#pragma unroll 1
      for (int d = 0; d < 2; ++d) {
        f32x16 acct;
#pragma unroll
        for (int r = 0; r < 16; ++r) acct[r] = 0.f;
        const bf16_t* Sd = ST + ((size_t)(ck * 2 + d) * 16 + head) * 8192;
#pragma unroll
        for (int ks = 0; ks < 8; ++ks) {
          const bf16x8 sf = *(const bf16x8*)(Sd + (w2 * 32 + fr) * 128 + ks * 16 + fh * 8);
          const bf16x8 cfk = *(const bf16x8*)(cptr + ks * 16);
          acct = MFMA(cfk, sf, acct);
        }
#pragma unroll
        for (int r = 0; r < 16; ++r) accy[r] += __expf(sF[d * 128 + lbase + crow(r, fh)]) * acct[r];
      }
      const float dsk = p.ssd_d[l * 16 + head];
      const int pidx = w2 * 32 + fr;
#pragma unroll
      for (int r = 0; r < 16; ++r) {
        const int lidx = lbase + crow(r, fh);
        const float xv = bf2f(sX[lidx * 72 + pidx]);
        const float y = accy[r] + dsk * xv;
        bf16_t* zp = Z + (size_t)(row0 + lidx) * 1024 + head * 64 + pidx;
        const float u = y * silu_f(bf2f(*zp));
        ssq[r] += u * u;
        *zp = f2bf(u);
      }
    }
#pragma unroll
    for (int r = 0; r < 16; ++r) {
      float v = ssq[r];
#pragma unroll
      for (int o = 16; o >= 1; o >>= 1) v += __shfl_xor(v, o);
      if (fr == 0) atomicAdd(&sSS[wl * 32 + crow(r, fh)], v);
    }
    __syncthreads();
    if (tid < 64) RSTD[(size_t)(row0 + lh * 64 + tid) * 2 + g] = rsqrtf(sSS[tid] * (1.f / 512.f) + 1e-6f);
  }
}

DI void phase_outproj(const Params& p_in, int l, char* smem) {
  const Params p = load_params();

  GemmS* s = (GemmS*)smem;
  int tid = threadIdx.x; asm volatile("" : "+v"(tid)); const int lane = tid & 63, wave = tid >> 6, wr = wave >> 1, wc = wave & 1, fr = lane & 31, fh = lane >> 5;
  const bf16_t* Zb = (const bf16_t*)(p.ws + OFF_Z);
  const bf16_t* Qb = (const bf16_t*)(p.ws + OFF_Q);
  const bf16_t* Cb = (const bf16_t*)(p.ws + OFF_CG);
  const bf16_t* W = (const bf16_t*)(p.ws + OFF_WOUT);
  const float* RSTD = (const float*)(p.ws + OFF_RSTD);
  const float* mods = (const float*)(p.ws + OFF_MODS);
  float* XC = (float*)(p.ws + OFF_XC);
  const int nM = (l == 0) ? NCK : 128;
  for (int it = blockIdx.x; it < nM * 8; it += gridDim.x) {
    const int mt = it >> 3, nt = it & 7;
    f32x16 acc[2][2];
    zero_acc(acc);
    const bf16_t* Wb = W + (size_t)nt * 128 * 2048;
    const bf16_t* A0 = Zb + (size_t)mt * 128 * 1024;
    const bf16_t* A2 = Qb + (size_t)mt * 128 * 512;
    const bf16_t* A3 = Cb + (size_t)mt * 128 * 512;
    gemm_core(acc, s,
              [&](int kt, int r, int kv) { return A0 + (size_t)r * 1024 + kt * 32 + kv * 8; },
              [&](int kt, int r, int kv) { return Wb + (size_t)r * 2048 + kt * 32 + kv * 8; }, 16);
#pragma unroll
    for (int i = 0; i < 2; ++i)
#pragma unroll
      for (int r = 0; r < 16; ++r) {
        const size_t row = (size_t)(mt * 128 + wr * 64 + i * 32 + crow(r, fh));
        const float f = RSTD[row * 2] / RSTD[row * 2 + 1];
        acc[i][0][r] *= f; acc[i][1][r] *= f;
      }
    gemm_core(acc, s,
              [&](int kt, int r, int kv) { return A0 + (size_t)r * 1024 + 512 + kt * 32 + kv * 8; },
              [&](int kt, int r, int kv) { return Wb + (size_t)r * 2048 + 512 + kt * 32 + kv * 8; }, 16);
#pragma unroll
    for (int i = 0; i < 2; ++i)
#pragma unroll
      for (int r = 0; r < 16; ++r) {
        const size_t row = (size_t)(mt * 128 + wr * 64 + i * 32 + crow(r, fh));
        const float f = RSTD[row * 2 + 1];
        acc[i][0][r] *= f; acc[i][1][r] *= f;
      }
    gemm_core(acc, s,
              [&](int kt, int r, int kv) { return A2 + (size_t)r * 512 + kt * 32 + kv * 8; },
              [&](int kt, int r, int kv) { return Wb + (size_t)r * 2048 + 1024 + kt * 32 + kv * 8; }, 16);
    gemm_core(acc, s,
              [&](int kt, int r, int kv) { return A3 + (size_t)r * 512 + kt * 32 + kv * 8; },
              [&](int kt, int r, int kv) { return Wb + (size_t)r * 2048 + 1536 + kt * 32 + kv * 8; }, 16);
    {
      const int row0 = mt * 128;
      const int vv = (row0 < RL_) ? (row0 >> 12) : 4;
      const float* gate = mods + (l * 5 + vv) * 3072 + 2048 + nt * 128;
      float* xnew = (row0 < RL_) ? (p.out + (size_t)row0 * 1024) : (XC + (size_t)(row0 - RL_) * 1024);
      const float* xold = (l == 0) ? ((row0 < RL_) ? (p.x + (size_t)row0 * 1024) : (p.ctx + (size_t)(row0 - RL_) * 1024)) : xnew;
      epilogue_lds(acc, smem, [&](int rl, int c4, float4 v) {
        const int off = rl * 1024 + nt * 128 + c4;
        const float4 xo = *(const float4*)(xold + off);
        const float4 gt = *(const float4*)(gate + c4);
        float4 o;
        o.x = xo.x + gt.x * v.x; o.y = xo.y + gt.y * v.y; o.z = xo.z + gt.z * v.z; o.w = xo.w + gt.w * v.w;
        *(float4*)(xnew + off) = o;
      });
    }
  }
}

DI void phase_final(const Params& p_in) {
  const Params p = load_params();
  const int lane = threadIdx.x & 63, wave = threadIdx.x >> 6;
  for (int it = blockIdx.x; it < RL_ / 4; it += gridDim.x) {
    float* xr = p.out + (size_t)(it * 4 + wave) * 1024;
    float4 xv[4];
    float ss = 0.f;
#pragma unroll
    for (int i = 0; i < 4; ++i) {
      xv[i] = *(const float4*)(xr + lane * 4 + i * 256);
      ss += xv[i].x * xv[i].x + xv[i].y * xv[i].y + xv[i].z * xv[i].z + xv[i].w * xv[i].w;
    }
#pragma unroll
    for (int o = 32; o >= 1; o >>= 1) ss += __shfl_xor(ss, o);
    const float rs = rsqrtf(ss * (1.f / 1024.f) + 1e-6f);
#pragma unroll
    for (int i = 0; i < 4; ++i) {
      const float4 w = *(const float4*)(p.final_norm_w + lane * 4 + i * 256);
      float4 o;
      o.x = xv[i].x * rs * w.x; o.y = xv[i].y * rs * w.y; o.z = xv[i].z * rs * w.z; o.w = xv[i].w * rs * w.w;
      *(float4*)(xr + lane * 4 + i * 256) = o;
    }
  }
}

template <int PH>
DI void run_phase(const Params& p, char* smem) {
  constexpr int l = (PH - 1) / 7, s = (PH - 1) % 7;
  if constexpr (PH == 0) phase_mods(p, smem);
  else if constexpr (PH == 15) phase_final(p);
  else if constexpr (s == 0) phase_prep(p, l, smem);
  else if constexpr (s == 1) phase_inproj(p, smem);
  else if constexpr (s == 2) phase_local(p, l, smem);
  else if constexpr (s == 3) phase_mix(p, l, smem);
  else if constexpr (s == 4) phase_scan(p);
  else if constexpr (s == 5) phase_ssdy(p, l, smem);
  else phase_outproj(p, l, smem);
}

#if PROBE_S >= 0
#define PROBE_BEGIN() if (threadIdx.x == 0) pst[1] = wall_clock64();
#define PROBE_END(PH) if (threadIdx.x == 0 && (PH) >= 1 && (PH) <= 14 && (((PH) - 1) % 7) == PROBE_S) pst[0] += wall_clock64() - pst[1];
#else
#define PROBE_BEGIN()
#define PROBE_END(PH)
#endif
#define PHASE(PH) PROBE_BEGIN() run_phase<PH>(p, smem); xcd_barrier(xst); PROBE_END(PH)

__global__ void __launch_bounds__(256, 2) fwd_megakernel(Params p) {
  __shared__ __attribute__((aligned(16))) char smem[57344];
  cg::grid_group grid = cg::this_grid();
#if PROBE_S >= 0
  volatile unsigned long long* pst = (volatile unsigned long long*)(smem + 57344 - 16);
  if (threadIdx.x == 0) { pst[0] = 0; pst[1] = 0; }
#endif
  __shared__ uint4 xb_words;
  volatile LAS unsigned* xst = (volatile LAS unsigned*)&xb_words;
  if (threadIdx.x == 0) xb_words = make_uint4(0u, 0u, 0u, 0u);
  run_phase<0>(p, smem);
  grid.sync();
  if (threadIdx.x == 0) { unsigned* bar = (unsigned*)(load_params().ws + OFF_BAR); (void)xb_add(&bar[XB_XCNT(xb_xcc_id())], 1u); }
  PHASE(1) PHASE(2) PHASE(3) PHASE(4) PHASE(5) PHASE(6) PHASE(7)
  PHASE(8) PHASE(9) PHASE(10) PHASE(11) PHASE(12) PHASE(13) PHASE(14)
  run_phase<15>(p, smem);
#if PROBE_S >= 0
  if (blockIdx.x == 0 && threadIdx.x == 0) {
    const unsigned long long t1 = wall_clock64();
    const unsigned long long lim = 4ull * pst[0];
    while (wall_clock64() - t1 < lim) { __builtin_amdgcn_s_sleep(32); }
  }
#endif
}

extern "C" void kernel_launch(void* const* d_in, const int* in_sizes, int n_in, void* d_out, int out_size, void* d_ws,
                              size_t ws_size, hipStream_t stream) {
  static int grid_blocks = 0;
  if (!grid_blocks) {
    int dev = 0, cus = 0, per_cu = 0;
    hipGetDevice(&dev);
    hipDeviceGetAttribute(&cus, hipDeviceAttributeMultiprocessorCount, dev);
    hipOccupancyMaxActiveBlocksPerMultiprocessor(&per_cu, fwd_megakernel, 256, 0);
    if (per_cu < 1) per_cu = 1;
    if (per_cu > 2) per_cu = 2;
    grid_blocks = cus * per_cu;
  }
  Params p{};
  const float** pp = (const float**)&p;
  for (int i = 0; i < 23; ++i) pp[i] = (const float*)d_in[i];
  p.out = (float*)d_out;
  p.ws = (char*)d_ws;
  void* args[] = {&p};
  hipError_t e = hipLaunchCooperativeKernel((void*)fwd_megakernel, dim3(grid_blocks), dim3(256), args, 0, stream);
  if (e != hipSuccess) fprintf(stderr, "cooperative launch failed: %s (grid %d)\n", hipGetErrorString(e), grid_blocks);
}
```

```cpp
#include <hip/hip_runtime.h>
#include <hip/hip_cooperative_groups.h>
#include <stdint.h>
#include <stdio.h>
namespace cg = cooperative_groups;

#ifndef ONE_LAUNCH
#define ONE_LAUNCH 1
#endif

#ifndef PROBE_S
#define PROBE_S -1
#endif
#define DI __device__ __forceinline__
typedef unsigned short bf16_t;
using bf16x8 = __attribute__((ext_vector_type(8))) short;
using s16x4 = __attribute__((ext_vector_type(4))) short;
using f32x16 = __attribute__((ext_vector_type(16))) float;
#define MFMA(a, b, c) __builtin_amdgcn_mfma_f32_32x32x16_bf16((a), (b), (c), 0, 0, 0)

constexpr int R_ = 17408;
constexpr int RL_ = 16384;
constexpr int NCK = 136;

constexpr size_t SZ_WIN = (size_t)5504 * 1024 * 2;
constexpr size_t SZ_WOUT = (size_t)1024 * 2048 * 2;
constexpr size_t SZ_PW = (size_t)512 * 512 * 2;
constexpr size_t SZ_MODS = (size_t)2 * 5 * 3072 * 4;
constexpr size_t SZ_XC = (size_t)1024 * 1024 * 4;
constexpr size_t SZ_RSTD = (size_t)R_ * 2 * 4;
constexpr size_t SZ_CDEC = (size_t)NCK * 32 * 4 + 256 - ((size_t)NCK * 32 * 4) % 256;
constexpr size_t SZ_R512 = (size_t)R_ * 512 * 2;
constexpr size_t OFF_WIN = 0;
constexpr size_t OFF_WOUT = OFF_WIN + SZ_WIN;
constexpr size_t OFF_PW = OFF_WOUT + SZ_WOUT;
constexpr size_t OFF_MODS = OFF_PW + SZ_PW;
constexpr size_t OFF_XC = OFF_MODS + SZ_MODS;
constexpr size_t OFF_RSTD = OFF_XC + SZ_XC;
constexpr size_t OFF_CDEC = OFF_RSTD + SZ_RSTD;
constexpr size_t OFF_H = OFF_CDEC + SZ_CDEC;
constexpr size_t OFF_XBC = OFF_H + 2 * SZ_R512;
constexpr size_t OFF_GLU = OFF_XBC + 3 * SZ_R512;
constexpr size_t OFF_ST = OFF_XBC;
constexpr size_t OFF_Z = OFF_GLU + SZ_R512;
constexpr size_t OFF_DT = OFF_Z + 2 * SZ_R512;
constexpr size_t OFF_CS = OFF_DT + (size_t)R_ * 32 * 4;
constexpr size_t OFF_Q = OFF_CS + (size_t)R_ * 32 * 4;
constexpr size_t OFF_KV = OFF_Q + SZ_R512;
constexpr size_t OFF_AG = OFF_KV + SZ_R512 / 2;
constexpr size_t OFF_CG = OFF_AG + SZ_R512;
constexpr size_t OFF_BC = OFF_CG + SZ_R512;
constexpr size_t OFF_HDN = OFF_BC + SZ_R512;
constexpr size_t WS_TOTAL = OFF_HDN + SZ_R512;
constexpr size_t OFF_BAR = WS_TOTAL;
static_assert(OFF_BAR + 16384 <= (size_t)256 * 1024 * 1024, "workspace too large");

struct Params {
  const float *x, *c, *ctx, *c_ctx, *w_mod, *b_mod, *norm_w, *w_in, *ssd_conv_w, *ssd_conv_b, *ssd_dt_bias, *ssd_a_log,
      *ssd_d, *ssd_norm_w, *attn_sink, *conv_dw_w, *conv_dw_b, *conv_ln_w, *conv_ln_b, *conv_pw_w, *conv_pw_b, *w_out,
      *final_norm_w;
  float* out;
  char* ws;
};


DI Params load_params() {
  typedef const char __attribute__((address_space(4)))* kptr_t;
  typedef const float* const __attribute__((address_space(4)))* kfld_t;
  size_t off = 0;
  asm volatile("" : "+s"(off));
  kptr_t base = (kptr_t)__builtin_amdgcn_kernarg_segment_ptr() + off;
  Params p;
  const float** pp = (const float**)&p;
#pragma unroll
  for (int i = 0; i < 25; ++i) pp[i] = *(kfld_t)(base + 8 * i);
  return p;
}

#define XB_TMO      128
#define XB_XCNT(j)  (256  + 64 * (j))
#define XB_XSUB(j)  (1280 + 64 * (j))
#define XB_XGEN(j)  (2304 + 64 * (j))
#define XB_TOP      3328
#define XB_TOPGEN   3392
#define XCD_BAR_WORDS 3456
#define XB_SPIN_CAP (1u << 18)
#define LAS __attribute__((address_space(3)))
DI unsigned xb_ld(unsigned* p)              { return __hip_atomic_load(p, __ATOMIC_RELAXED, __HIP_MEMORY_SCOPE_AGENT); }
DI unsigned xb_add(unsigned* p, unsigned v) { return __hip_atomic_fetch_add(p, v, __ATOMIC_RELAXED, __HIP_MEMORY_SCOPE_AGENT); }
DI unsigned xb_xcc_id() { return (unsigned)__builtin_amdgcn_s_getreg((3 << 11) | 20) & 0xFu; }
#define XB_SPIN(cond, bar) do { unsigned _sp = 0; while (cond) { __builtin_amdgcn_s_sleep(1); \
    if ((++_sp & 255u) == 0u) { if (xb_ld(&(bar)[XB_TMO])) break; if (_sp > XB_SPIN_CAP) { atomicAdd(&(bar)[XB_TMO], 1u); break; } } } } while (0)

DI void xcd_barrier_complete(unsigned* bar, unsigned x, unsigned& nloc, unsigned& nx) {
  const unsigned G = gridDim.x * gridDim.y * gridDim.z;
  unsigned sum, cnt, mine, sp = 0u;
  for (;;) {
    sum = 0u; cnt = 0u; mine = 0u;
#pragma unroll
    for (unsigned j = 0; j < 16; ++j) { const unsigned c = xb_ld(&bar[XB_XCNT(j)]); sum += c; cnt += (c > 0u) ? 1u : 0u; mine = (j == x) ? c : mine; }
    if (sum == G) break;
    __builtin_amdgcn_s_sleep(1);
    if ((++sp & 255u) == 0u) { if (xb_ld(&bar[XB_TMO])) break; if (sp > XB_SPIN_CAP) { atomicAdd(&bar[XB_TMO], 1u); break; } }
  }
  nloc = mine > 0u ? mine : 1u; nx = cnt > 0u ? cnt : 1u;
}

DI void xcd_barrier(volatile LAS unsigned* st) {
  asm volatile("s_waitcnt vmcnt(0)" ::: "memory");
  __syncthreads();
  if (threadIdx.x == 0) {
    const Params pb = load_params();
    unsigned* bar = (unsigned*)(pb.ws + OFF_BAR);
    const unsigned x = xb_xcc_id();
    __builtin_amdgcn_s_waitcnt(0);
    unsigned nloc = st[0], nx = st[1];
    if (nloc == 0u) { xcd_barrier_complete(bar, x, nloc, nx); st[0] = nloc; st[1] = nx; }
    const unsigned old = xb_add(&bar[XB_XSUB(x)], 1u);
    const unsigned gen = old / nloc;
    if (old + 1u == (gen + 1u) * nloc) {
      __builtin_amdgcn_fence(__ATOMIC_RELEASE, "agent");
      asm volatile("s_waitcnt vmcnt(0)" ::: "memory");
      const unsigned og = xb_add(&bar[XB_TOP], 1u);
      const unsigned tg = og / nx;
      if (og + 1u == (tg + 1u) * nx) xb_add(&bar[XB_TOPGEN], 1u);
      else XB_SPIN(xb_ld(&bar[XB_TOPGEN]) == tg, bar);
      __builtin_amdgcn_fence(__ATOMIC_ACQUIRE, "agent");
      xb_add(&bar[XB_XGEN(x)], 1u);
      asm volatile("s_waitcnt vmcnt(0)" ::: "memory");
    } else {
      XB_SPIN(xb_ld(&bar[XB_XGEN(x)]) == gen, bar);
      __builtin_amdgcn_fence(__ATOMIC_ACQUIRE, "agent");
      asm volatile("s_waitcnt vmcnt(0)" ::: "memory");
    }
  }
  __syncthreads();
}

DI unsigned short f2bf(float x) { unsigned u = __float_as_uint(x); u += 0x7fffu + ((u >> 16) & 1u); return (unsigned short)(u >> 16); }
DI float bf2f(unsigned short b) { return __uint_as_float(((unsigned)b) << 16); }
DI unsigned pack2(float a, float b) { return (unsigned)f2bf(a) | ((unsigned)f2bf(b) << 16); }
DI float lo2f(unsigned u) { return __uint_as_float(u << 16); }
DI float hi2f(unsigned u) { return __uint_as_float(u & 0xffff0000u); }
DI float silu_f(float x) { return x / (1.f + __expf(-x)); }
DI float sigmoid_f(float x) { return 1.f / (1.f + __expf(-x)); }
DI int crow(int reg, int h) { return (reg & 3) + 8 * (reg >> 2) + 4 * h; }

DI bf16x8 tr_frag(const bf16_t* s, int ld, int row_lo, int row_hi, int col0) {
  const int lane = threadIdx.x & 63;
  const int i16 = lane & 15, q = i16 >> 2, pp = i16 & 3, blk = (lane >> 4) & 1;
  const unsigned a0 = (unsigned)(size_t)(s + (row_lo + q) * ld + col0 + 16 * blk + 4 * pp);
  const unsigned a1 = (unsigned)(size_t)(s + (row_hi + q) * ld + col0 + 16 * blk + 4 * pp);
  s16x4 lo, hi;
  asm volatile("ds_read_b64_tr_b16 %0, %2\n\tds_read_b64_tr_b16 %1, %3\n\ts_waitcnt lgkmcnt(0)"
               : "=&v"(lo), "=&v"(hi) : "v"(a0), "v"(a1) : "memory");
  return __builtin_shufflevector(lo, hi, 0, 1, 2, 3, 4, 5, 6, 7);
}

struct GemmS { bf16_t a[2][128][40]; bf16_t b[2][128][40]; };

template <class AF, class BF>
DI void gemm_core(f32x16 (&acc)[2][2], GemmS* s, AF aptr, BF bptr, int nk) {
  int tid = threadIdx.x; asm volatile("" : "+v"(tid)); const int lane = tid & 63, wave = tid >> 6, wr = wave >> 1, wc = wave & 1;
  const int r0 = tid >> 2, kv = tid & 3;
  const int fr = lane & 31, fh = lane >> 5;
  uint4 ra0 = *(const uint4*)aptr(0, r0, kv), ra1 = *(const uint4*)aptr(0, r0 + 64, kv);
  uint4 rb0 = *(const uint4*)bptr(0, r0, kv), rb1 = *(const uint4*)bptr(0, r0 + 64, kv);
  *(uint4*)&s->a[0][r0][kv * 8] = ra0; *(uint4*)&s->a[0][r0 + 64][kv * 8] = ra1;
  *(uint4*)&s->b[0][r0][kv * 8] = rb0; *(uint4*)&s->b[0][r0 + 64][kv * 8] = rb1;
  __syncthreads();
#pragma unroll 1
  for (int kt = 0; kt < nk; ++kt) {
    const int buf = kt & 1;
    if (kt + 1 < nk) {
      ra0 = *(const uint4*)aptr(kt + 1, r0, kv); ra1 = *(const uint4*)aptr(kt + 1, r0 + 64, kv);
      rb0 = *(const uint4*)bptr(kt + 1, r0, kv); rb1 = *(const uint4*)bptr(kt + 1, r0 + 64, kv);
    }
#pragma unroll
    for (int ks = 0; ks < 2; ++ks) {
      bf16x8 af[2], bq[2];
#pragma unroll
      for (int i = 0; i < 2; ++i) af[i] = *(const bf16x8*)&s->a[buf][wr * 64 + i * 32 + fr][ks * 16 + fh * 8];
#pragma unroll
      for (int j = 0; j < 2; ++j) bq[j] = *(const bf16x8*)&s->b[buf][wc * 64 + j * 32 + fr][ks * 16 + fh * 8];
#pragma unroll
      for (int i = 0; i < 2; ++i)
#pragma unroll
        for (int j = 0; j < 2; ++j) acc[i][j] = MFMA(af[i], bq[j], acc[i][j]);
    }
    if (kt + 1 < nk) {
      *(uint4*)&s->a[buf ^ 1][r0][kv * 8] = ra0; *(uint4*)&s->a[buf ^ 1][r0 + 64][kv * 8] = ra1;
      *(uint4*)&s->b[buf ^ 1][r0][kv * 8] = rb0; *(uint4*)&s->b[buf ^ 1][r0 + 64][kv * 8] = rb1;
    }
    __syncthreads();
  }
}


struct GemmS2 { bf16_t a[128][72]; bf16_t b[128][72]; };
DI void g2_compute(f32x16 (&acc)[2][2], const GemmS2* s, int wr, int wc, int fr, int fh) {
#pragma unroll
  for (int ks = 0; ks < 4; ++ks) {
    bf16x8 af[2], bq[2];
#pragma unroll
    for (int i = 0; i < 2; ++i) af[i] = *(const bf16x8*)&s->a[wr * 64 + i * 32 + fr][ks * 16 + fh * 8];
#pragma unroll
    for (int j = 0; j < 2; ++j) bq[j] = *(const bf16x8*)&s->b[wc * 64 + j * 32 + fr][ks * 16 + fh * 8];
#pragma unroll
    for (int i = 0; i < 2; ++i)
#pragma unroll
      for (int j = 0; j < 2; ++j) acc[i][j] = MFMA(af[i], bq[j], acc[i][j]);
  }
}

template <class AF, class BF, class HK>
DI void gemm_core2(f32x16 (&acc)[2][2], GemmS2* s, AF aptr, BF bptr, int nk, HK hook) {
  int tid = threadIdx.x; asm volatile("" : "+v"(tid));
  const int lane = tid & 63, wave = tid >> 6, wr = wave >> 1, wc = wave & 1;
  const int r0 = tid >> 3, kc = tid & 7;
  const int fr = lane & 31, fh = lane >> 5;
  uint4 p0a0, p0a1, p0a2, p0a3, p0b0, p0b1, p0b2, p0b3, p1a0, p1a1, p1a2, p1a3, p1b0, p1b1, p1b2, p1b3;
#define G2_LOAD(S, KT) { \
    S##a0 = *(const uint4*)aptr((KT), r0, kc);      S##b0 = *(const uint4*)bptr((KT), r0, kc); \
    S##a1 = *(const uint4*)aptr((KT), r0 + 32, kc); S##b1 = *(const uint4*)bptr((KT), r0 + 32, kc); \
    S##a2 = *(const uint4*)aptr((KT), r0 + 64, kc); S##b2 = *(const uint4*)bptr((KT), r0 + 64, kc); \
    S##a3 = *(const uint4*)aptr((KT), r0 + 96, kc); S##b3 = *(const uint4*)bptr((KT), r0 + 96, kc); }
#define G2_STORE(S) { \
    *(uint4*)&s->a[r0][kc * 8] = S##a0;      *(uint4*)&s->b[r0][kc * 8] = S##b0; \
    *(uint4*)&s->a[r0 + 32][kc * 8] = S##a1; *(uint4*)&s->b[r0 + 32][kc * 8] = S##b1; \
    *(uint4*)&s->a[r0 + 64][kc * 8] = S##a2; *(uint4*)&s->b[r0 + 64][kc * 8] = S##b2; \
    *(uint4*)&s->a[r0 + 96][kc * 8] = S##a3; *(uint4*)&s->b[r0 + 96][kc * 8] = S##b3; }
#define G2_COMPUTE() g2_compute(acc, s, wr, wc, fr, fh);
  G2_LOAD(p0, 0)
  G2_LOAD(p1, 1)
  G2_STORE(p0)
  __syncthreads();
#pragma unroll 1
  for (int kt = 0; kt < nk; kt += 2) {
    hook(kt);
    G2_COMPUTE()
    __syncthreads();
    G2_STORE(p1)
    if (kt + 2 < nk) G2_LOAD(p0, kt + 2)
    __syncthreads();
    hook(kt + 1);
    G2_COMPUTE()
    __syncthreads();
    if (kt + 2 < nk) {
      G2_STORE(p0)
      if (kt + 3 < nk) G2_LOAD(p1, kt + 3)
    }
    __syncthreads();
  }
#undef G2_LOAD
#undef G2_STORE
#undef G2_COMPUTE
}

DI void zero_acc(f32x16 (&acc)[2][2]) {
#pragma unroll
  for (int i = 0; i < 2; ++i)
#pragma unroll
    for (int j = 0; j < 2; ++j)
#pragma unroll
      for (int r = 0; r < 16; ++r) acc[i][j][r] = 0.f;
}

template <class EPI>
DI void epilogue_lds(f32x16 (&acc)[2][2], char* smem, EPI epi) {
  float* T = (float*)smem;
  int tid = threadIdx.x; asm volatile("" : "+v"(tid)); const int lane = tid & 63, wave = tid >> 6, wr = wave >> 1, wc = wave & 1, fr = lane & 31, fh = lane >> 5;
#pragma unroll
  for (int i = 0; i < 2; ++i) {
#pragma unroll
    for (int j = 0; j < 2; ++j)
#pragma unroll
      for (int r = 0; r < 16; ++r) T[(wr * 32 + crow(r, fh)) * 132 + wc * 64 + j * 32 + fr] = acc[i][j][r];
    __syncthreads();
#pragma unroll 2
    for (int e = tid; e < 2048; e += 256) {
      const int tr = e >> 5, c4 = (e & 31) * 4;
      const float4 v = *(const float4*)&T[tr * 132 + c4];
      epi((tr >> 5) * 64 + i * 32 + (tr & 31), c4, v);
    }
    __syncthreads();
  }
}

DI void phase_mods(const Params& p_in, char* smem) {
  const Params p = load_params();

  float* ssc = (float*)smem;
  float* red = (float*)(smem + 20480);
  float* mods = (float*)(p.ws + OFF_MODS);
  int tid = threadIdx.x; asm volatile("" : "+v"(tid));
  if (blockIdx.x == 0) { unsigned* bar = (unsigned*)(p.ws + OFF_BAR); for (int i = tid; i < XCD_BAR_WORDS; i += 256) bar[i] = 0u; }
  for (int it = blockIdx.x; it < 96; it += gridDim.x) {
    const int l = it / 48, col0 = (it % 48) * 64;
    __syncthreads();
    for (int e = tid; e < 5120; e += 256) {
      const int v = e >> 10, k = e & 1023;
      const float cv = (v < 4) ? p.c[v * 1024 + k] : p.c_ctx[k];
      ssc[e] = silu_f(cv);
    }
    __syncthreads();
    const int col = tid & 63, kg = tid >> 6;
    float a[5] = {0.f, 0.f, 0.f, 0.f, 0.f};
    const float* w = p.w_mod + (size_t)l * 1024 * 3072 + col0 + col;
    for (int k = kg * 256; k < kg * 256 + 256; k += 8) {
      float wv[8];
#pragma unroll
      for (int u = 0; u < 8; ++u) wv[u] = w[(size_t)(k + u) * 3072];
#pragma unroll
      for (int u = 0; u < 8; ++u)
#pragma unroll
        for (int v = 0; v < 5; ++v) a[v] += ssc[v * 1024 + k + u] * wv[u];
    }
#pragma unroll
    for (int v = 0; v < 5; ++v) red[(kg * 5 + v) * 64 + col] = a[v];
    __syncthreads();
    for (int e = tid; e < 320; e += 256) {
      const int v = e >> 6, cc = e & 63;
      float sum = p.b_mod[l * 3072 + col0 + cc];
      for (int g = 0; g < 4; ++g) sum += red[(g * 5 + v) * 64 + cc];
      mods[(l * 5 + v) * 3072 + col0 + cc] = sum;
    }
  }
}

DI int win_colmap(int n) {
  if (n < 2560) return n;
  if (n < 3840) return n + 32;
  if (n < 4864) {
    const int j = n - 3840, q64 = j >> 6, w = j & 63;
    return (w < 32) ? (3872 + q64 * 32 + w) : (3872 + 512 + q64 * 32 + (w - 32));
  }
  if (n < 5376) return n + 32;
  if (n < 5408) return n - 5376 + 2560;
  return -1;
}

DI void transpose_tile(const float* src, int ldsrc, int kind, const float* rowscale, bf16_t* dst, int lddst, int n0, int k0, float* tile) {
  int tid = threadIdx.x; asm volatile("" : "+v"(tid)); const int tx = tid & 63, ty = tid >> 6;
  __syncthreads();
  const int n = (kind == 0) ? win_colmap(n0 + tx) : (n0 + tx);
  for (int r = ty; r < 64; r += 4) {
    const int k = k0 + r;
    float v = 0.f;
    if (n >= 0) v = src[(size_t)k * ldsrc + n];
    if (rowscale != nullptr && k < 1024) v *= rowscale[k];
    tile[r * 65 + tx] = v;
  }
  __syncthreads();
  for (int r = ty; r < 64; r += 4) dst[(size_t)(n0 + r) * lddst + k0 + tx] = f2bf(tile[tx * 65 + r]);
}

DI void phase_prep(const Params& p_in, int l, char* smem) {
  const Params p = load_params();

  int tid = threadIdx.x; asm volatile("" : "+v"(tid)); const int lane = tid & 63, wave = tid >> 6;
  const float* mods = (const float*)(p.ws + OFF_MODS);
  bf16_t* H = (bf16_t*)(p.ws + OFF_H);
  const int NT_WIN = 86 * 16, NT_WOUT = 16 * 32, NT_PW = 64, NT_CONV = NT_WIN + NT_WOUT + NT_PW;
  const int NT = NT_CONV + R_ / 4;
  for (int it = blockIdx.x; it < NT; it += gridDim.x) {
    if (it < NT_WIN) {
      transpose_tile(p.w_in + (size_t)l * 1024 * 5408, 5408, 0, nullptr, (bf16_t*)(p.ws + OFF_WIN), 1024, (it / 16) * 64, (it % 16) * 64, (float*)smem);
    } else if (it < NT_WIN + NT_WOUT) {
      const int t = it - NT_WIN;
      transpose_tile(p.w_out + (size_t)l * 2048 * 1024, 1024, 1, p.ssd_norm_w + l * 1024, (bf16_t*)(p.ws + OFF_WOUT), 2048, (t / 32) * 64, (t % 32) * 64, (float*)smem);
    } else if (it < NT_CONV) {
      const int t = it - NT_WIN - NT_WOUT;
      transpose_tile(p.conv_pw_w + (size_t)l * 512 * 512, 512, 1, nullptr, (bf16_t*)(p.ws + OFF_PW), 512, (t / 8) * 64, (t % 8) * 64, (float*)smem);
    } else {
      const int rho = (it - NT_CONV) * 4 + wave;
      const float* xs;
      if (l == 0) xs = (rho < RL_) ? (p.x + (size_t)rho * 1024) : (p.ctx + (size_t)(rho - RL_) * 1024);
      else xs = (rho < RL_) ? (p.out + (size_t)rho * 1024) : ((const float*)(p.ws + OFF_XC) + (size_t)(rho - RL_) * 1024);
      const int v = (rho < RL_) ? (rho >> 12) : 4;
      const float* md = mods + (l * 5 + v) * 3072;
      float4 xv[4];
      float ss = 0.f;
#pragma unroll
      for (int i = 0; i < 4; ++i) {
        xv[i] = *(const float4*)(xs + lane * 4 + i * 256);
        ss += xv[i].x * xv[i].x + xv[i].y * xv[i].y + xv[i].z * xv[i].z + xv[i].w * xv[i].w;
      }
#pragma unroll
      for (int o = 32; o >= 1; o >>= 1) ss += __shfl_xor(ss, o);
      const float rs = rsqrtf(ss * (1.f / 1024.f) + 1e-6f);
#pragma unroll
      for (int i = 0; i < 4; ++i) {
        const int cidx = lane * 4 + i * 256;
        const float4 nw = *(const float4*)(p.norm_w + l * 1024 + cidx);
        const float4 sh = *(const float4*)(md + cidx);
        const float4 sc = *(const float4*)(md + 1024 + cidx);
        uint2 o;
        o.x = pack2(xv[i].x * rs * nw.x * (1.f + sc.x) + sh.x, xv[i].y * rs * nw.y * (1.f + sc.y) + sh.y);
        o.y = pack2(xv[i].z * rs * nw.z * (1.f + sc.z) + sh.z, xv[i].w * rs * nw.w * (1.f + sc.w) + sh.w);
        *(uint2*)(H + (size_t)rho * 1024 + cidx) = o;
      }
    }
  }
}

DI void phase_inproj(const Params& p_in, char* smem) {
  const Params p = load_params();

  GemmS* s = (GemmS*)smem;
  int tid = threadIdx.x; asm volatile("" : "+v"(tid)); const int lane = tid & 63, wave = tid >> 6, wr = wave >> 1, wc = wave & 1, fr = lane & 31, fh = lane >> 5;
  const bf16_t* H = (const bf16_t*)(p.ws + OFF_H);
  const bf16_t* W = (const bf16_t*)(p.ws + OFF_WIN);
  for (int it = blockIdx.x; it < NCK * 43; it += gridDim.x) {
    const int mt = it / 43, nt = it % 43;
    f32x16 acc[2][2];
    zero_acc(acc);
    const bf16_t* Ab = H + (size_t)mt * 128 * 1024;
    const bf16_t* Bb = W + (size_t)nt * 128 * 1024;
    gemm_core2(acc, (GemmS2*)smem,
               [&](int kt, int r, int kv) { return Ab + (size_t)r * 1024 + kt * 64 + kv * 8; },
               [&](int kt, int r, int kv) { return Bb + (size_t)r * 1024 + kt * 64 + kv * 8; }, 16, [](int) {});
    const int row0 = mt * 128;
    if (nt >= 30 && nt < 38) {
#pragma unroll
      for (int i = 0; i < 2; ++i)
#pragma unroll
        for (int r = 0; r < 16; ++r) acc[i][0][r] = acc[i][0][r] * sigmoid_f(acc[i][1][r]);
      bf16_t* G = (bf16_t*)(p.ws + OFF_GLU);
      const int cb0 = (nt - 30) * 64;
      epilogue_lds(acc, smem, [&](int rl, int c4, float4 v) {
        if ((c4 & 32) == 0) {
          uint2 o; o.x = pack2(v.x, v.y); o.y = pack2(v.z, v.w);
          *(uint2*)(G + (size_t)(row0 + rl) * 512 + cb0 + (c4 >> 6) * 32 + (c4 & 31)) = o;
        }
      });
    } else if (nt == 42) {
      float* DT = (float*)(p.ws + OFF_DT);
      epilogue_lds(acc, smem, [&](int rl, int c4, float4 v) {
        if (c4 < 32) *(float4*)(DT + (size_t)(row0 + rl) * 32 + c4) = v;
      });
    } else {
      bf16_t* dst; int ld, cb;
      if (nt < 12) { dst = (bf16_t*)(p.ws + OFF_XBC); ld = 1536; cb = nt * 128; }
      else if (nt < 20) { dst = (bf16_t*)(p.ws + OFF_Z); ld = 1024; cb = nt * 128 - 1536; }
      else if (nt < 24) { dst = (bf16_t*)(p.ws + OFF_Q); ld = 512; cb = nt * 128 - 2560; }
      else if (nt < 26) { dst = (bf16_t*)(p.ws + OFF_KV); ld = 256; cb = nt * 128 - 3072; }
      else if (nt < 30) { dst = (bf16_t*)(p.ws + OFF_AG); ld = 512; cb = nt * 128 - 3328; }
      else { dst = (bf16_t*)(p.ws + OFF_CG); ld = 512; cb = nt * 128 - 4864; }
      epilogue_lds(acc, smem, [&](int rl, int c4, float4 v) {
        uint2 o; o.x = pack2(v.x, v.y); o.y = pack2(v.z, v.w);
        *(uint2*)(dst + (size_t)(row0 + rl) * ld + cb + c4) = o;
      });
    }
  }
}

DI void phase_local(const Params& p_in, int l, char* smem) {
  const Params p = load_params();

  int tid = threadIdx.x; asm volatile("" : "+v"(tid)); const int lane = tid & 63;
  const bf16_t* XBC = (const bf16_t*)(p.ws + OFF_XBC);
  bf16_t* XS = (bf16_t*)(p.ws + OFF_H);
  bf16_t* BC = (bf16_t*)(p.ws + OFF_BC);
  float* DT = (float*)(p.ws + OFF_DT);
  float* CS = (float*)(p.ws + OFF_CS);
  const bf16_t* GLU = (const bf16_t*)(p.ws + OFF_GLU);
  bf16_t* HDN = (bf16_t*)(p.ws + OFF_HDN);
  bf16_t* Q = (bf16_t*)(p.ws + OFF_Q);
  bf16_t* KV = (bf16_t*)(p.ws + OFF_KV);
  const int N_CONV = R_ * 192 / 256;
  const int N_DT = NCK;
  const int N_CF = R_ / 16;
  const int N_ROPE = RL_ * 40 / 256;
  const int N_QC = 1024 * 256 / 256;
  const int NT = N_CF + N_DT + N_CONV + N_ROPE + N_QC;
  for (int it0 = blockIdx.x; it0 < NT; it0 += gridDim.x) {
    int it = it0;
    if (it < N_CF) {
      float* sst = (float*)smem;
      unsigned* sIn = (unsigned*)(smem + 256);
      const int row0 = it * 16;
      const int seq0 = (row0 < RL_) ? (row0 & ~4095) : (RL_ + ((row0 - RL_) & ~255));
      const int slen = (row0 < RL_) ? 4096 : 256;
      const int t0 = row0 - seq0;
      const int c0 = tid * 2;
      __syncthreads();
      if (tid < 32) sst[tid] = 0.f;
      for (int idx = tid; idx < 46 * 64; idx += 256) {
        const int rr = idx >> 6, c16 = idx & 63;
        const int tt = t0 - 15 + rr;
        uint4 val = make_uint4(0u, 0u, 0u, 0u);
        if (tt >= 0 && tt < slen) val = *(const uint4*)(GLU + (size_t)(seq0 + tt) * 512 + c16 * 8);
        *(uint4*)&sIn[rr * 256 + c16 * 4] = val;
      }
      float w0[31], w1[31];
#pragma unroll
      for (int k = 0; k < 31; ++k) {
        const float2 wv = *(const float2*)(p.conv_dw_w + ((size_t)l * 31 + k) * 512 + c0);
        w0[k] = wv.x; w1[k] = wv.y;
      }
      const float2 bv = *(const float2*)(p.conv_dw_b + l * 512 + c0);
      float a0[16], a1[16];
#pragma unroll
      for (int r = 0; r < 16; ++r) { a0[r] = bv.x; a1[r] = bv.y; }
      __syncthreads();
#pragma unroll
      for (int tp = 0; tp < 46; ++tp) {
        const unsigned u = sIn[tp * 256 + tid];
        const float x0 = lo2f(u), x1 = hi2f(u);
#pragma unroll
        for (int r = 0; r < 16; ++r) {
          const int k = tp - r;
          if (k >= 0 && k < 31) { a0[r] += w0[k] * x0; a1[r] += w1[k] * x1; }
        }
      }
      {
        float v[32];
#pragma unroll
        for (int r = 0; r < 16; ++r) { v[2 * r] = a0[r] + a1[r]; v[2 * r + 1] = a0[r] * a0[r] + a1[r] * a1[r]; }
#pragma unroll
        for (int i = 0; i < 16; ++i) { const bool up = (lane & 32) != 0; const float keep = up ? v[i + 16] : v[i]; const float send = up ? v[i] : v[i + 16]; v[i] = keep + __shfl_xor(send, 32); }
#pragma unroll
        for (int i = 0; i < 8; ++i) { const bool up = (lane & 16) != 0; const float keep = up ? v[i + 8] : v[i]; const float send = up ? v[i] : v[i + 8]; v[i] = keep + __shfl_xor(send, 16); }
#pragma unroll
        for (int i = 0; i < 4; ++i) { const bool up = (lane & 8) != 0; const float keep = up ? v[i + 4] : v[i]; const float send = up ? v[i] : v[i + 4]; v[i] = keep + __shfl_xor(send, 8); }
#pragma unroll
        for (int i = 0; i < 2; ++i) { const bool up = (lane & 4) != 0; const float keep = up ? v[i + 2] : v[i]; const float send = up ? v[i] : v[i + 2]; v[i] = keep + __shfl_xor(send, 4); }
        { const bool up = (lane & 2) != 0; const float keep = up ? v[1] : v[0]; const float send = up ? v[0] : v[1]; v[0] = keep + __shfl_xor(send, 2); }
        v[0] += __shfl_xor(v[0], 1);
        __syncthreads();
        if ((lane & 1) == 0) atomicAdd(&sst[lane >> 1], v[0]);
      }
      __syncthreads();
      const float2 lw = *(const float2*)(p.conv_ln_w + l * 512 + c0);
      const float2 lb = *(const float2*)(p.conv_ln_b + l * 512 + c0);
#pragma unroll
      for (int r = 0; r < 16; ++r) {
        const float mean = sst[r * 2] * (1.f / 512.f);
        const float var = fmaxf(sst[r * 2 + 1] * (1.f / 512.f) - mean * mean, 0.f);
        const float rs = rsqrtf(var + 1e-6f);
        const float y0 = (a0[r] - mean) * rs * lw.x + lb.x;
        const float y1 = (a1[r] - mean) * rs * lw.y + lb.y;
        *(unsigned*)(HDN + (size_t)(row0 + r) * 512 + c0) = pack2(silu_f(y0), silu_f(y1));
      }
      continue;
    }
    it -= N_CF;
    if (it < N_DT) {
      float* sdt = (float*)smem;
      const int row0 = it * 128;
      __syncthreads();
      for (int e = tid; e < 4096; e += 256) {
        const int r = e >> 5, cidx = e & 31;
        const float raw = DT[(size_t)(row0 + r) * 32 + cidx] + p.ssd_dt_bias[l * 32 + cidx];
        const float sp = (raw > 20.f) ? raw : log1pf(expf(raw));
        DT[(size_t)(row0 + r) * 32 + cidx] = sp;
        sdt[r * 33 + cidx] = sp;
      }
      __syncthreads();
      if (tid < 32) {
        const float a = -expf(p.ssd_a_log[l * 32 + tid]);
        float run = 0.f;
        if (tid < 16) {
          for (int r = 0; r < 128; ++r) { run += sdt[r * 33 + tid] * a; CS[(size_t)(row0 + r) * 32 + tid] = run; }
        } else {
          for (int r = 127; r >= 0; --r) { run += sdt[r * 33 + tid] * a; CS[(size_t)(row0 + r) * 32 + tid] = run; }
        }
      }
      continue;
    }
    it -= N_DT;
    if (it < N_CONV) {
      const int e = it * 256 + tid;
      const int rho = e / 192, cgp = e % 192, ch0 = cgp * 8;
      const int seq0 = (rho < RL_) ? (rho & ~4095) : (RL_ + ((rho - RL_) & ~255));
      const int slen = (rho < RL_) ? 4096 : 256;
      const int t = rho - seq0;
      float a[8];
      {
        const float4 b0 = *(const float4*)(p.ssd_conv_b + l * 1536 + ch0);
        const float4 b1 = *(const float4*)(p.ssd_conv_b + l * 1536 + ch0 + 4);
        a[0] = b0.x; a[1] = b0.y; a[2] = b0.z; a[3] = b0.w; a[4] = b1.x; a[5] = b1.y; a[6] = b1.z; a[7] = b1.w;
      }
#pragma unroll
      for (int k = 0; k < 5; ++k) {
        const int tt = t + k - 2;
        if (tt >= 0 && tt < slen) {
          const uint4 u = *(const uint4*)(XBC + (size_t)(seq0 + tt) * 1536 + ch0);
          const float4 w0 = *(const float4*)(p.ssd_conv_w + ((size_t)l * 5 + k) * 1536 + ch0);
          const float4 w1 = *(const float4*)(p.ssd_conv_w + ((size_t)l * 5 + k) * 1536 + ch0 + 4);
          a[0] += w0.x * lo2f(u.x); a[1] += w0.y * hi2f(u.x); a[2] += w0.z * lo2f(u.y); a[3] += w0.w * hi2f(u.y);
          a[4] += w1.x * lo2f(u.z); a[5] += w1.y * hi2f(u.z); a[6] += w1.z * lo2f(u.w); a[7] += w1.w * hi2f(u.w);
        }
      }
      uint4 o;
      o.x = pack2(silu_f(a[0]), silu_f(a[1])); o.y = pack2(silu_f(a[2]), silu_f(a[3]));
      o.z = pack2(silu_f(a[4]), silu_f(a[5])); o.w = pack2(silu_f(a[6]), silu_f(a[7]));
      if (ch0 < 1024) *(uint4*)(XS + (size_t)rho * 1024 + ch0) = o;
      else *(uint4*)(BC + (size_t)rho * 512 + (ch0 - 1024)) = o;
      continue;
    }
    it -= N_CONV;
    if (it < N_ROPE) {
      const int e = it * 256 + tid;
      const int rho = e / 40, rem = e % 40, hd = rem >> 2, sub = rem & 3;
      const int axis = sub >> 1, half = sub & 1;
      const int t = rho & 4095;
      const float pos = (float)(axis == 0 ? (t >> 6) : (t & 63));
      bf16_t* base = ((hd < 8) ? (Q + (size_t)rho * 512 + hd * 64) : (KV + (size_t)rho * 256 + (hd - 8) * 64)) + axis * 32 + half * 8;
      const float sc = (hd < 8) ? 0.125f : 1.f;
      const uint4 u1 = *(const uint4*)base, u2 = *(const uint4*)(base + 16);
      const unsigned a1[4] = {u1.x, u1.y, u1.z, u1.w}, a2[4] = {u2.x, u2.y, u2.z, u2.w};
      unsigned o1[4], o2[4];
#pragma unroll
      for (int i = 0; i < 4; ++i) {
        float r1[2], r2[2];
#pragma unroll
        for (int hl = 0; hl < 2; ++hl) {
          const float f = (float)(half * 8 + 2 * i + hl);
          const float ang = pos * exp2f(-f * 0.8304820237218406f);
          const float cs = __cosf(ang), sn = __sinf(ang);
          const float t1 = hl ? hi2f(a1[i]) : lo2f(a1[i]);
          const float t2 = hl ? hi2f(a2[i]) : lo2f(a2[i]);
          r1[hl] = (t1 * cs - t2 * sn) * sc;
          r2[hl] = (t2 * cs + t1 * sn) * sc;
        }
        o1[i] = pack2(r1[0], r1[1]); o2[i] = pack2(r2[0], r2[1]);
      }
      *(uint4*)base = make_uint4(o1[0], o1[1], o1[2], o1[3]);
      *(uint4*)(base + 16) = make_uint4(o2[0], o2[1], o2[2], o2[3]);
      continue;
    }
    it -= N_ROPE;
    {
      const int e = it * 256 + tid;
      const int rho = RL_ + e / 256, c2 = (e % 256) * 2;
      unsigned* ptr = (unsigned*)(Q + (size_t)rho * 512 + c2);
      const unsigned u = *ptr;
      *ptr = pack2(lo2f(u) * 0.125f, hi2f(u) * 0.125f);
    }
  }
}

DI void attn_item(const Params& p_in, int l, char* smem, int b, int qblk, int g, int hp, bool ctxq) {
  const Params p = load_params();

  bf16_t* sK = (bf16_t*)smem;
  bf16_t* sV = (bf16_t*)(smem + 128 * 72 * 2);
  int tid = threadIdx.x; asm volatile("" : "+v"(tid)); const int lane = tid & 63, wave = tid >> 6, fr = lane & 31, fh = lane >> 5;
  const int head = g * 4 + hp * 2 + (wave >> 1);
  const int qh = wave & 1;
  const int qrow0 = (ctxq ? (RL_ + b * 256) : (b * 4096)) + qblk * 128 + qh * 64;
  const int qpos0 = qblk * 128 + qh * 64;
  bf16_t* Q = (bf16_t*)(p.ws + OFF_Q);
  const bf16_t* KV = (const bf16_t*)(p.ws + OFF_KV);
  const bf16_t* AG = (const bf16_t*)(p.ws + OFF_AG);
  bf16x8 qf[2][4];
#pragma unroll
  for (int j = 0; j < 2; ++j)
#pragma unroll
    for (int ks = 0; ks < 4; ++ks)
      qf[j][ks] = *(const bf16x8*)(Q + (size_t)(qrow0 + j * 32 + fr) * 512 + head * 64 + ks * 16 + fh * 8);
  f32x16 o[2][2];
  zero_acc(o);
  float m[2], lsum[2];
  m[0] = m[1] = p.attn_sink[l * 8 + head];
  lsum[0] = lsum[1] = 1.f;
  const int nblk = ctxq ? 2 : 5;
  for (int bi = 0; bi < nblk; ++bi) {
    int krow0, kpos0 = 0;
    bool masked = false;
    if (bi < 2) {
      krow0 = RL_ + b * 256 + bi * 128;
    } else {
      const int kb = qblk + bi - 3;
      if (kb < 0 || kb >= 32) continue;
      krow0 = b * 4096 + kb * 128;
      kpos0 = kb * 128;
      masked = (bi != 3);
    }
    __syncthreads();
    for (int v = tid; v < 1024; v += 256) {
      const int r = v >> 3, cv = v & 7;
      *(uint4*)&sK[r * 72 + cv * 8] = *(const uint4*)(KV + (size_t)(krow0 + r) * 256 + g * 64 + cv * 8);
      *(uint4*)&sV[r * 72 + cv * 8] = *(const uint4*)(KV + (size_t)(krow0 + r) * 256 + 128 + g * 64 + cv * 8);
    }
    __syncthreads();
#pragma unroll 1
    for (int kb = 0; kb < 4; ++kb) {
      f32x16 st[2];
#pragma unroll
      for (int j = 0; j < 2; ++j)
#pragma unroll
        for (int r = 0; r < 16; ++r) st[j][r] = 0.f;
#pragma unroll
      for (int ks = 0; ks < 4; ++ks) {
        const bf16x8 kf = *(const bf16x8*)&sK[(kb * 32 + fr) * 72 + ks * 16 + fh * 8];
#pragma unroll
        for (int j = 0; j < 2; ++j) st[j] = MFMA(kf, qf[j][ks], st[j]);
      }
      bf16x8 pb[2][2];
#pragma unroll
      for (int j = 0; j < 2; ++j) {
        if (masked) {
          const int qpos = qpos0 + j * 32 + fr;
#pragma unroll
          for (int r = 0; r < 16; ++r) {
            const int d = qpos - (kpos0 + kb * 32 + crow(r, fh));
            if (d > 128 || d < -128) st[j][r] = -1e30f;
          }
        }
        float mx = st[j][0];
#pragma unroll
        for (int r = 1; r < 16; ++r) mx = fmaxf(mx, st[j][r]);
        mx = fmaxf(mx, __shfl_xor(mx, 32));
        const float mnew = fmaxf(m[j], mx);
        const float alpha = __expf(m[j] - mnew);
        float rs = 0.f;
#pragma unroll
        for (int r = 0; r < 16; ++r) { const float pv = __expf(st[j][r] - mnew); st[j][r] = pv; rs += pv; }
        rs += __shfl_xor(rs, 32);
        lsum[j] = lsum[j] * alpha + rs;
        m[j] = mnew;
#pragma unroll
        for (int mt = 0; mt < 2; ++mt)
#pragma unroll
          for (int r = 0; r < 16; ++r) o[mt][j][r] *= alpha;
#pragma unroll
        for (int s = 0; s < 2; ++s)
#pragma unroll
          for (int jj = 0; jj < 8; ++jj) pb[j][s][jj] = (short)f2bf(st[j][8 * s + jj]);
      }
#pragma unroll
      for (int s = 0; s < 2; ++s)
#pragma unroll
        for (int mt = 0; mt < 2; ++mt) {
          const bf16x8 vf = tr_frag(sV, 72, kb * 32 + 16 * s + 4 * fh, kb * 32 + 16 * s + 8 + 4 * fh, mt * 32);
#pragma unroll
          for (int j = 0; j < 2; ++j) o[mt][j] = MFMA(vf, pb[j][s], o[mt][j]);
        }
    }
  }
#pragma unroll
  for (int j = 0; j < 2; ++j) {
    const float inv = 1.f / lsum[j];
    const size_t rho = (size_t)(qrow0 + j * 32 + fr);
#pragma unroll
    for (int mt = 0; mt < 2; ++mt)
#pragma unroll
      for (int g4 = 0; g4 < 4; ++g4) {
        const int d0 = mt * 32 + 8 * g4 + 4 * fh;
        const uint2 gv = *(const uint2*)(AG + rho * 512 + head * 64 + d0);
        uint2 ov;
        ov.x = pack2(o[mt][j][g4 * 4 + 0] * inv * silu_f(lo2f(gv.x)), o[mt][j][g4 * 4 + 1] * inv * silu_f(hi2f(gv.x)));
        ov.y = pack2(o[mt][j][g4 * 4 + 2] * inv * silu_f(lo2f(gv.y)), o[mt][j][g4 * 4 + 3] * inv * silu_f(hi2f(gv.y)));
        *(uint2*)(Q + rho * 512 + head * 64 + d0) = ov;
      }
  }
}

DI void states_item(const Params& p_in, char* smem, int ck, int g, int hq) {
  const Params p = load_params();

  bf16_t* sB = (bf16_t*)smem;
  bf16_t* sX = (bf16_t*)(smem + 128 * 136 * 2);
  int tid = threadIdx.x; asm volatile("" : "+v"(tid)); const int lane = tid & 63, wave = tid >> 6, wr = wave >> 1, wc = wave & 1, fr = lane & 31, fh = lane >> 5;
  const bf16_t* BC = (const bf16_t*)(p.ws + OFF_BC);
  const bf16_t* XS = (const bf16_t*)(p.ws + OFF_H);
  const float* DT = (const float*)(p.ws + OFF_DT);
  const float* CS = (const float*)(p.ws + OFF_CS);
  bf16_t* ST = (bf16_t*)(p.ws + OFF_ST);
  float* CDEC = (float*)(p.ws + OFF_CDEC);
  const int row0 = ck * 128;
  __syncthreads();
  for (int v = tid; v < 2048; v += 256) {
    const int r = v >> 4, cv = v & 15;
    *(uint4*)&sB[r * 136 + cv * 8] = *(const uint4*)(BC + (size_t)(row0 + r) * 512 + g * 128 + cv * 8);
  }
  __syncthreads();
  bf16x8 bfr[2][8];
#pragma unroll
  for (int j = 0; j < 2; ++j)
#pragma unroll
    for (int ks = 0; ks < 8; ++ks) bfr[j][ks] = tr_frag(sB, 136, ks * 16 + 8 * fh, ks * 16 + 8 * fh + 4, wc * 64 + j * 32);
#pragma unroll 1
  for (int hd = 0; hd < 8; ++hd) {
    const int head = g * 8 + hq * 4 + (hd >> 1), d = hd & 1;
    const int col = d * 16 + head;
    const float cend = CS[(size_t)(row0 + (d == 0 ? 127 : 0)) * 32 + col];
    for (int v = tid; v < 1024; v += 256) {
      const int lr = v >> 3, cv = v & 7;
      const size_t rho = (size_t)(row0 + lr);
      const float sc = DT[rho * 32 + col] * __expf(cend - CS[rho * 32 + col]);
      const uint4 u = *(const uint4*)(XS + rho * 1024 + head * 64 + cv * 8);
      uint4 o;
      o.x = pack2(lo2f(u.x) * sc, hi2f(u.x) * sc); o.y = pack2(lo2f(u.y) * sc, hi2f(u.y) * sc);
      o.z = pack2(lo2f(u.z) * sc, hi2f(u.z) * sc); o.w = pack2(lo2f(u.w) * sc, hi2f(u.w) * sc);
      *(uint4*)&sX[lr * 72 + cv * 8] = o;
    }
    __syncthreads();
    f32x16 acc[2];
#pragma unroll
    for (int j = 0; j < 2; ++j)
#pragma unroll
      for (int r = 0; r < 16; ++r) acc[j][r] = 0.f;
#pragma unroll
    for (int ks = 0; ks < 8; ++ks) {
      const bf16x8 af = tr_frag(sX, 72, ks * 16 + 8 * fh, ks * 16 + 8 * fh + 4, wr * 32);
#pragma unroll
      for (int j = 0; j < 2; ++j) acc[j] = MFMA(af, bfr[j][ks], acc[j]);
    }
    bf16_t* dst = ST + ((size_t)(ck * 2 + d) * 16 + head) * 8192;
#pragma unroll
    for (int j = 0; j < 2; ++j)
#pragma unroll
      for (int r = 0; r < 16; ++r) dst[(wr * 32 + crow(r, fh)) * 128 + wc * 64 + j * 32 + fr] = f2bf(acc[j][r]);
    if (tid == 0) CDEC[(ck * 2 + d) * 16 + head] = __expf(cend);
    __syncthreads();
  }
}

DI void pw_item(const Params& p_in, int l, char* smem, int mt, int nt) {
  const Params p = load_params();

  GemmS* s = (GemmS*)smem;
  int tid = threadIdx.x; asm volatile("" : "+v"(tid)); const int lane = tid & 63, wave = tid >> 6, wr = wave >> 1, wc = wave & 1, fr = lane & 31, fh = lane >> 5;
  const bf16_t* Ab = (const bf16_t*)(p.ws + OFF_HDN) + (size_t)mt * 128 * 512;
  const bf16_t* Bb = (const bf16_t*)(p.ws + OFF_PW) + (size_t)nt * 128 * 512;
  bf16_t* CG = (bf16_t*)(p.ws + OFF_CG);
  f32x16 acc[2][2];
  zero_acc(acc);
  gemm_core2(acc, (GemmS2*)smem,
             [&](int kt, int r, int kv) { return Ab + (size_t)r * 512 + kt * 64 + kv * 8; },
             [&](int kt, int r, int kv) { return Bb + (size_t)r * 512 + kt * 64 + kv * 8; }, 8, [](int) {});
  const float* pwb = p.conv_pw_b + l * 512 + nt * 128;
  epilogue_lds(acc, smem, [&](int rl, int c4, float4 v) {
    bf16_t* ptr = CG + (size_t)(mt * 128 + rl) * 512 + nt * 128 + c4;
    const uint2 gv = *(const uint2*)ptr;
    const float4 bb = *(const float4*)(pwb + c4);
    uint2 o;
    o.x = pack2((v.x + bb.x) * silu_f(lo2f(gv.x)), (v.y + bb.y) * silu_f(hi2f(gv.x)));
    o.y = pack2((v.z + bb.z) * silu_f(lo2f(gv.y)), (v.w + bb.w) * silu_f(hi2f(gv.y)));
    *(uint2*)ptr = o;
  });
}

DI void phase_mix(const Params& p, int l, char* smem) {
  const int N_ATT = 512 + (l == 0 ? 32 : 0);
  const int N_ST = NCK * 4;
  const int N_PW = NCK * 4;
  const int NT = N_ATT + N_ST + N_PW;
  for (int it0 = blockIdx.x; it0 < NT; it0 += gridDim.x) {
    int it = it0;
    if (it < N_ATT) {
      if (it < 512) attn_item(p, l, smem, it >> 7, (it >> 2) & 31, (it >> 1) & 1, it & 1, false);
      else { const int t = it - 512; attn_item(p, l, smem, t >> 3, (t >> 2) & 1, (t >> 1) & 1, t & 1, true); }
      continue;
    }
    it -= N_ATT;
    if (it < N_ST) { states_item(p, smem, it >> 2, (it >> 1) & 1, it & 1); continue; }
    it -= N_ST;
    pw_item(p, l, smem, it >> 2, it & 3);
  }
}

DI void phase_scan(const Params& p_in) {
  const Params p = load_params();

  bf16_t* ST = (bf16_t*)(p.ws + OFF_ST);
  const float* CDEC = (const float*)(p.ws + OFF_CDEC);
  for (int it = blockIdx.x; it < 512; it += gridDim.x) {
    const int e = it * 256 + threadIdx.x;
    const int bdh = e >> 10, v8 = e & 1023;
    const int b = bdh >> 5, d = (bdh >> 4) & 1, h = bdh & 15;
    float s[8];
#pragma unroll
    for (int i = 0; i < 8; ++i) s[i] = 0.f;
    auto ckof = [&](int i) {
      if (d == 0) return (i < 2) ? (128 + 2 * b + i) : (32 * b + (i - 2));
      return (i < 2) ? (128 + 2 * b + (1 - i)) : (32 * b + 31 - (i - 2));
    };
    auto pof = [&](int i) { const int ck = ckof(i); return (uint4*)(ST + ((size_t)(ck * 2 + d) * 16 + h) * 8192 + v8 * 8); };
    auto dof = [&](int i) { const int ck = ckof(i); return CDEC[(ck * 2 + d) * 16 + h]; };
    uint4 buf[4]; float dc[4];
#pragma unroll
    for (int i = 0; i < 3; ++i) { buf[i] = *pof(i); dc[i] = dof(i); }
#pragma unroll
    for (int i = 0; i < 34; ++i) {
      if (i + 3 < 34) { buf[(i + 3) & 3] = *pof(i + 3); dc[(i + 3) & 3] = dof(i + 3); }
      const uint4 cur = buf[i & 3];
      const float dec = dc[i & 3];
      uint4 o;
      o.x = pack2(s[0], s[1]); o.y = pack2(s[2], s[3]); o.z = pack2(s[4], s[5]); o.w = pack2(s[6], s[7]);
      *pof(i) = o;
      s[0] = s[0] * dec + lo2f(cur.x); s[1] = s[1] * dec + hi2f(cur.x);
      s[2] = s[2] * dec + lo2f(cur.y); s[3] = s[3] * dec + hi2f(cur.y);
      s[4] = s[4] * dec + lo2f(cur.z); s[5] = s[5] * dec + hi2f(cur.z);
      s[6] = s[6] * dec + lo2f(cur.w); s[7] = s[7] * dec + hi2f(cur.w);
    }
  }
}

DI void phase_ssdy(const Params& p_in, int l, char* smem) {
  const Params p = load_params();

  bf16_t* sB = (bf16_t*)smem;
  bf16_t* sX = (bf16_t*)(smem + 128 * 136 * 2);
  float* sF = (float*)(smem + 128 * 136 * 2 + 128 * 72 * 2);
  float* sSS = sF + 512;
  int tid = threadIdx.x; asm volatile("" : "+v"(tid)); const int lane = tid & 63, wave = tid >> 6, fr = lane & 31, fh = lane >> 5;
  const int wl = wave >> 1, w2 = wave & 1;
  const bf16_t* BC = (const bf16_t*)(p.ws + OFF_BC);
  const bf16_t* XS = (const bf16_t*)(p.ws + OFF_H);
  const float* DT = (const float*)(p.ws + OFF_DT);
  const float* CS = (const float*)(p.ws + OFF_CS);
  const bf16_t* ST = (const bf16_t*)(p.ws + OFF_ST);
  bf16_t* Z = (bf16_t*)(p.ws + OFF_Z);
  float* RSTD = (float*)(p.ws + OFF_RSTD);
  const int nck = (l == 0) ? NCK : 128;
  for (int it = blockIdx.x; it < nck * 4; it += gridDim.x) {
    const int ck = it >> 2, g = (it >> 1) & 1, lh = it & 1;
    const int row0 = ck * 128;
    const int lbase = lh * 64 + wl * 32;
    __syncthreads();
    for (int v = tid; v < 2048; v += 256) {
      const int r = v >> 4, cv = v & 15;
      *(uint4*)&sB[r * 136 + cv * 8] = *(const uint4*)(BC + (size_t)(row0 + r) * 512 + g * 128 + cv * 8);
    }
    if (tid < 64) sSS[tid] = 0.f;
    const bf16_t* cptr = BC + (size_t)(row0 + lbase + fr) * 512 + 256 + g * 128 + fh * 8;
    bf16x8 cf[8];
#pragma unroll
    for (int ks = 0; ks < 8; ++ks) cf[ks] = *(const bf16x8*)(cptr + ks * 16);
    const int lrx = tid >> 3, cvx = tid & 7;
    const bf16_t* xsrc = XS + (size_t)(row0 + lrx) * 1024 + cvx * 8;
    uint4 xp0, xp1, xp2, xp3;
    float fp0 = 0.f, fp1 = 0.f, fp2 = 0.f, fp3 = 0.f;
    {
      const int head = g * 8;
      xp0 = *(const uint4*)(xsrc + head * 64);
      xp1 = *(const uint4*)(xsrc + head * 64 + 32 * 1024);
      xp2 = *(const uint4*)(xsrc + head * 64 + 64 * 1024);
      xp3 = *(const uint4*)(xsrc + head * 64 + 96 * 1024);
      if (tid < 128) {
        const size_t rho = (size_t)(row0 + tid);
        fp0 = CS[rho * 32 + head]; fp1 = CS[rho * 32 + 16 + head]; fp2 = DT[rho * 32 + head]; fp3 = DT[rho * 32 + 16 + head];
      }
    }
    __syncthreads();
    f32x16 cb[2];
#pragma unroll
    for (int j = 0; j < 2; ++j) {
#pragma unroll
      for (int r = 0; r < 16; ++r) cb[j][r] = 0.f;
#pragma unroll
      for (int ks = 0; ks < 8; ++ks) {
        const bf16x8 bq = *(const bf16x8*)&sB[(w2 * 64 + j * 32 + fr) * 136 + ks * 16 + fh * 8];
        cb[j] = MFMA(cf[ks], bq, cb[j]);
      }
    }
    const int pidx = w2 * 32 + fr;
    bf16_t* sCB = sB + 64 * 136;
    __syncthreads();
#pragma unroll
    for (int j = 0; j < 2; ++j)
#pragma unroll
      for (int r = 0; r < 16; ++r) sCB[(wl * 32 + crow(r, fh)) * 136 + w2 * 64 + j * 32 + fr] = f2bf(cb[j][r]);
#pragma unroll 1
    for (int hh = 0; hh < 8; ++hh) {
      const int head = g * 8 + hh;
      __syncthreads();
      *(uint4*)&sX[lrx * 72 + cvx * 8] = xp0;
      *(uint4*)&sX[(lrx + 32) * 72 + cvx * 8] = xp1;
      *(uint4*)&sX[(lrx + 64) * 72 + cvx * 8] = xp2;
      *(uint4*)&sX[(lrx + 96) * 72 + cvx * 8] = xp3;
      if (tid < 128) { sF[tid] = fp0; sF[128 + tid] = fp1; sF[256 + tid] = fp2; sF[384 + tid] = fp3; }
      const bf16_t* S0 = ST + ((size_t)(ck * 2 + 0) * 16 + head) * 8192 + (w2 * 32 + fr) * 128 + fh * 8;
      const bf16_t* S1 = ST + ((size_t)(ck * 2 + 1) * 16 + head) * 8192 + (w2 * 32 + fr) * 128 + fh * 8;
      bf16x8 sf0[8];
#pragma unroll
      for (int ks = 0; ks < 8; ++ks) sf0[ks] = *(const bf16x8*)(S0 + ks * 16);
      bf16_t* zbase = Z + (size_t)(row0 + lbase + 4 * fh) * 1024 + head * 64 + pidx;
      if (hh < 7) {
        const int hn = head + 1;
        xp0 = *(const uint4*)(xsrc + hn * 64);
        xp1 = *(const uint4*)(xsrc + hn * 64 + 32 * 1024);
        xp2 = *(const uint4*)(xsrc + hn * 64 + 64 * 1024);
        xp3 = *(const uint4*)(xsrc + hn * 64 + 96 * 1024);
        if (tid < 128) {
          const size_t rho = (size_t)(row0 + tid);
          fp0 = CS[rho * 32 + hn]; fp1 = CS[rho * 32 + 16 + hn]; fp2 = DT[rho * 32 + hn]; fp3 = DT[rho * 32 + 16 + hn];
        }
      }
      __syncthreads();
#pragma unroll
      for (int j = 0; j < 2; ++j) {
        const int sidx = w2 * 64 + j * 32 + fr;
        const float csf_s = sF[sidx], csb_s = sF[128 + sidx], dtf_s = sF[256 + sidx], dtb_s = sF[384 + sidx];
#pragma unroll 4
        for (int r = 0; r < 16; ++r) {
          const int lidx = lbase + crow(r, fh);
          float f = 0.f;
          if (sidx <= lidx) f += __expf(sF[lidx] - csf_s) * dtf_s;
          if (sidx >= lidx) f += __expf(sF[128 + lidx] - csb_s) * dtb_s;
          sB[(wl * 32 + crow(r, fh)) * 136 + sidx] = f2bf(bf2f(sCB[(wl * 32 + crow(r, fh)) * 136 + sidx]) * f);
        }
      }
      __syncthreads();
      bf16x8 sf1[8], cfh[8];
#pragma unroll
      for (int ks = 0; ks < 8; ++ks) { sf1[ks] = *(const bf16x8*)(S1 + ks * 16); cfh[ks] = *(const bf16x8*)(cptr + ks * 16); }
      unsigned short zv[16];
#pragma unroll
      for (int r = 0; r < 16; ++r) zv[r] = zbase[(size_t)((r & 3) + 8 * (r >> 2)) * 1024];
      f32x16 accy;
#pragma unroll
      for (int r = 0; r < 16; ++r) accy[r] = 0.f;
#pragma unroll
      for (int ks = 0; ks < 8; ++ks) {
        const bf16x8 af = *(const bf16x8*)&sB[(wl * 32 + fr) * 136 + ks * 16 + fh * 8];
        const bf16x8 xf = tr_frag(sX, 72, ks * 16 + 8 * fh, ks * 16 + 8 * fh + 4, w2 * 32);
        accy = MFMA(af, xf, accy);
      }
      {
        f32x16 acct;
#pragma unroll
        for (int r = 0; r < 16; ++r) acct[r] = 0.f;
#pragma unroll
        for (int ks = 0; ks < 8; ++ks) acct = MFMA(cfh[ks], sf0[ks], acct);
#pragma unroll
        for (int r = 0; r < 16; ++r) accy[r] += __expf(sF[lbase + crow(r, fh)]) * acct[r];
#pragma unroll
        for (int r = 0; r < 16; ++r) acct[r] = 0.f;
#pragma unroll
        for (int ks = 0; ks < 8; ++ks) acct = MFMA(cfh[ks], sf1[ks], acct);
#pragma unroll
        for (int r = 0; r < 16; ++r) accy[r] += __expf(sF[128 + lbase + crow(r, fh)]) * acct[r];
      }
      const float dsk = p.ssd_d[l * 16 + head];
      float v[16];
#pragma unroll
      for (int r = 0; r < 16; ++r) {
        const int lidx = lbase + crow(r, fh);
        const float xv = bf2f(sX[lidx * 72 + pidx]);
        const float y = accy[r] + dsk * xv;
        const float u = y * silu_f(bf2f(zv[r]));
        v[r] = u * u;
        zbase[(size_t)((r & 3) + 8 * (r >> 2)) * 1024] = f2bf(u);
      }
#pragma unroll
      for (int i = 0; i < 8; ++i) { const bool up = (fr & 16) != 0; const float keep = up ? v[i + 8] : v[i]; const float send = up ? v[i] : v[i + 8]; v[i] = keep + __shfl_xor(send, 16); }
#pragma unroll
      for (int i = 0; i < 4; ++i) { const bool up = (fr & 8) != 0; const float keep = up ? v[i + 4] : v[i]; const float send = up ? v[i] : v[i + 4]; v[i] = keep + __shfl_xor(send, 8); }
#pragma unroll
      for (int i = 0; i < 2; ++i) { const bool up = (fr & 4) != 0; const float keep = up ? v[i + 2] : v[i]; const float send = up ? v[i] : v[i + 2]; v[i] = keep + __shfl_xor(send, 4); }
      { const bool up = (fr & 2) != 0; const float keep = up ? v[1] : v[0]; const float send = up ? v[0] : v[1]; v[0] = keep + __shfl_xor(send, 2); }
      v[0] += __shfl_xor(v[0], 1);
      if ((fr & 1) == 0) atomicAdd(&sSS[wl * 32 + crow(fr >> 1, fh)], v[0]);
    }
    __syncthreads();
    if (tid < 64) RSTD[(size_t)(row0 + lh * 64 + tid) * 2 + g] = rsqrtf(sSS[tid] * (1.f / 512.f) + 1e-6f);
  }
}

DI void phase_outproj(const Params& p_in, int l, char* smem) {
  const Params p = load_params();

  GemmS* s = (GemmS*)smem;
  int tid = threadIdx.x; asm volatile("" : "+v"(tid)); const int lane = tid & 63, wave = tid >> 6, wr = wave >> 1, wc = wave & 1, fr = lane & 31, fh = lane >> 5;
  const bf16_t* Zb = (const bf16_t*)(p.ws + OFF_Z);
  const bf16_t* Qb = (const bf16_t*)(p.ws + OFF_Q);
  const bf16_t* Cb = (const bf16_t*)(p.ws + OFF_CG);
  const bf16_t* W = (const bf16_t*)(p.ws + OFF_WOUT);
  const float* RSTD = (const float*)(p.ws + OFF_RSTD);
  const float* mods = (const float*)(p.ws + OFF_MODS);
  float* XC = (float*)(p.ws + OFF_XC);
  const int nM = (l == 0) ? NCK : 128;
  for (int it = blockIdx.x; it < nM * 8; it += gridDim.x) {
    const int mt = it >> 3, nt = it & 7;
    f32x16 acc[2][2];
    zero_acc(acc);
    const bf16_t* Wb = W + (size_t)nt * 128 * 2048;
    const bf16_t* A0 = Zb + (size_t)mt * 128 * 1024;
    const bf16_t* A2 = Qb + (size_t)mt * 128 * 512;
    const bf16_t* A3 = Cb + (size_t)mt * 128 * 512;
    float* sScale = (float*)(smem + 40960);
    if (tid < 128) {
      const size_t row = (size_t)(mt * 128 + tid);
      const float r1 = RSTD[row * 2 + 1];
      sScale[tid * 2] = RSTD[row * 2] / r1;
      sScale[tid * 2 + 1] = r1;
    }
    gemm_core2(acc, (GemmS2*)smem,
               [&](int kt, int r, int kv) {
                 const bf16_t* ptr;
                 if (kt < 16) ptr = A0 + (size_t)r * 1024 + kt * 64;
                 else if (kt < 24) ptr = A2 + (size_t)r * 512 + (kt - 16) * 64;
                 else ptr = A3 + (size_t)r * 512 + (kt - 24) * 64;
                 return ptr + kv * 8;
               },
               [&](int kt, int r, int kv) { return Wb + (size_t)r * 2048 + kt * 64 + kv * 8; }, 32,
               [&](int kt) __attribute__((always_inline)) {
                 if (kt == 8 || kt == 16) {
#pragma unroll
                   for (int i = 0; i < 2; ++i)
#pragma unroll
                     for (int r = 0; r < 16; ++r) {
                       const float f = sScale[(wr * 64 + i * 32 + crow(r, fh)) * 2 + (kt == 16 ? 1 : 0)];
                       acc[i][0][r] *= f; acc[i][1][r] *= f;
                     }
                 }
               });
    {
      const int row0 = mt * 128;
      const int vv = (row0 < RL_) ? (row0 >> 12) : 4;
      const float* gate = mods + (l * 5 + vv) * 3072 + 2048 + nt * 128;
      float* xnew = (row0 < RL_) ? (p.out + (size_t)row0 * 1024) : (XC + (size_t)(row0 - RL_) * 1024);
      const float* xold = (l == 0) ? ((row0 < RL_) ? (p.x + (size_t)row0 * 1024) : (p.ctx + (size_t)(row0 - RL_) * 1024)) : xnew;
      epilogue_lds(acc, smem, [&](int rl, int c4, float4 v) {
        const int off = rl * 1024 + nt * 128 + c4;
        const float4 xo = *(const float4*)(xold + off);
        const float4 gt = *(const float4*)(gate + c4);
        float4 o;
        o.x = xo.x + gt.x * v.x; o.y = xo.y + gt.y * v.y; o.z = xo.z + gt.z * v.z; o.w = xo.w + gt.w * v.w;
        *(float4*)(xnew + off) = o;
      });
    }
  }
}

DI void phase_final(const Params& p_in) {
  const Params p = load_params();
  const int lane = threadIdx.x & 63, wave = threadIdx.x >> 6;
  for (int it = blockIdx.x; it < RL_ / 4; it += gridDim.x) {
    float* xr = p.out + (size_t)(it * 4 + wave) * 1024;
    float4 xv[4];
    float ss = 0.f;
#pragma unroll
    for (int i = 0; i < 4; ++i) {
      xv[i] = *(const float4*)(xr + lane * 4 + i * 256);
      ss += xv[i].x * xv[i].x + xv[i].y * xv[i].y + xv[i].z * xv[i].z + xv[i].w * xv[i].w;
    }
#pragma unroll
    for (int o = 32; o >= 1; o >>= 1) ss += __shfl_xor(ss, o);
    const float rs = rsqrtf(ss * (1.f / 1024.f) + 1e-6f);
#pragma unroll
    for (int i = 0; i < 4; ++i) {
      const float4 w = *(const float4*)(p.final_norm_w + lane * 4 + i * 256);
      float4 o;
      o.x = xv[i].x * rs * w.x; o.y = xv[i].y * rs * w.y; o.z = xv[i].z * rs * w.z; o.w = xv[i].w * rs * w.w;
      *(float4*)(xr + lane * 4 + i * 256) = o;
    }
  }
}

template <int PH>
DI void run_phase(const Params& p, char* smem) {
  constexpr int l = (PH - 1) / 7, s = (PH - 1) % 7;
  if constexpr (PH == 0) phase_mods(p, smem);
  else if constexpr (PH == 15) phase_final(p);
  else if constexpr (s == 0) phase_prep(p, l, smem);
  else if constexpr (s == 1) phase_inproj(p, smem);
  else if constexpr (s == 2) phase_local(p, l, smem);
  else if constexpr (s == 3) phase_mix(p, l, smem);
  else if constexpr (s == 4) phase_scan(p);
  else if constexpr (s == 5) phase_ssdy(p, l, smem);
  else phase_outproj(p, l, smem);
}

#if PROBE_S >= 0
#define PROBE_BEGIN() if (threadIdx.x == 0) pst[1] = wall_clock64();
#define PROBE_END(PH) if (threadIdx.x == 0 && (PH) >= 1 && (PH) <= 14 && (((PH) - 1) % 7) == PROBE_S) pst[0] += wall_clock64() - pst[1];
#else
#define PROBE_BEGIN()
#define PROBE_END(PH)
#endif
#define PHASE(PH) PROBE_BEGIN() run_phase<PH>(p, smem); xcd_barrier(xst); PROBE_END(PH)

__global__ void __launch_bounds__(256, 2) fwd_megakernel(Params p) {
  __shared__ __attribute__((aligned(16))) char smem[57344];
  cg::grid_group grid = cg::this_grid();
#if PROBE_S >= 0
  volatile unsigned long long* pst = (volatile unsigned long long*)(smem + 57344 - 16);
  if (threadIdx.x == 0) { pst[0] = 0; pst[1] = 0; }
#endif
  __shared__ uint4 xb_words;
  volatile LAS unsigned* xst = (volatile LAS unsigned*)&xb_words;
  if (threadIdx.x == 0) xb_words = make_uint4(0u, 0u, 0u, 0u);
  run_phase<0>(p, smem);
  grid.sync();
  if (threadIdx.x == 0) { unsigned* bar = (unsigned*)(load_params().ws + OFF_BAR); (void)xb_add(&bar[XB_XCNT(xb_xcc_id())], 1u); }
  PHASE(1) PHASE(2) PHASE(3) PHASE(4) PHASE(5) PHASE(6) PHASE(7)
  PHASE(8) PHASE(9) PHASE(10) PHASE(11) PHASE(12) PHASE(13) PHASE(14)
  run_phase<15>(p, smem);
#if PROBE_S >= 0
  if (blockIdx.x == 0 && threadIdx.x == 0) {
    const unsigned long long t1 = wall_clock64();
    const unsigned long long lim = 4ull * pst[0];
    while (wall_clock64() - t1 < lim) { __builtin_amdgcn_s_sleep(32); }
  }
#endif
}

extern "C" void kernel_launch(void* const* d_in, const int* in_sizes, int n_in, void* d_out, int out_size, void* d_ws,
                              size_t ws_size, hipStream_t stream) {
  static int grid_blocks = 0;
  if (!grid_blocks) {
    int dev = 0, cus = 0, per_cu = 0;
    hipGetDevice(&dev);
    hipDeviceGetAttribute(&cus, hipDeviceAttributeMultiprocessorCount, dev);
    hipOccupancyMaxActiveBlocksPerMultiprocessor(&per_cu, fwd_megakernel, 256, 0);
    if (per_cu < 1) per_cu = 1;
    if (per_cu > 2) per_cu = 2;
    grid_blocks = cus * per_cu;
  }
  Params p{};
  const float** pp = (const float**)&p;
  for (int i = 0; i < 23; ++i) pp[i] = (const float*)d_in[i];
  p.out = (float*)d_out;
  p.ws = (char*)d_ws;
  void* args[] = {&p};
  hipError_t e = hipLaunchCooperativeKernel((void*)fwd_megakernel, dim3(grid_blocks), dim3(256), args, 0, stream);
  if (e != hipSuccess) fprintf(stderr, "cooperative launch failed: %s (grid %d)\n", hipGetErrorString(e), grid_blocks);
}
```

```cpp
#include <hip/hip_runtime.h>
#include <hip/hip_cooperative_groups.h>
#include <stdint.h>
#include <stdio.h>
namespace cg = cooperative_groups;

#ifndef ONE_LAUNCH
#define ONE_LAUNCH 1
#endif

#ifndef PROBE_S
#define PROBE_S -1
#endif
#define DI __device__ __forceinline__
typedef unsigned short bf16_t;
using bf16x8 = __attribute__((ext_vector_type(8))) short;
using s16x4 = __attribute__((ext_vector_type(4))) short;
using f32x16 = __attribute__((ext_vector_type(16))) float;
#define MFMA(a, b, c) __builtin_amdgcn_mfma_f32_32x32x16_bf16((a), (b), (c), 0, 0, 0)

constexpr int R_ = 17408;
constexpr int RL_ = 16384;
constexpr int NCK = 136;

constexpr size_t SZ_WIN = (size_t)5504 * 1024 * 2;
constexpr size_t SZ_WOUT = (size_t)1024 * 2048 * 2;
constexpr size_t SZ_PW = (size_t)512 * 512 * 2;
constexpr size_t SZ_MODS = (size_t)2 * 5 * 3072 * 4;
constexpr size_t SZ_XC = (size_t)1024 * 1024 * 4;
constexpr size_t SZ_RSTD = (size_t)R_ * 2 * 4;
constexpr size_t SZ_CDEC = (size_t)NCK * 32 * 4 + 256 - ((size_t)NCK * 32 * 4) % 256;
constexpr size_t SZ_R512 = (size_t)R_ * 512 * 2;
constexpr size_t OFF_WIN = 0;
constexpr size_t OFF_WOUT = OFF_WIN + SZ_WIN;
constexpr size_t OFF_PW = OFF_WOUT + SZ_WOUT;
constexpr size_t OFF_MODS = OFF_PW + SZ_PW;
constexpr size_t OFF_XC = OFF_MODS + SZ_MODS;
constexpr size_t OFF_RSTD = OFF_XC + SZ_XC;
constexpr size_t OFF_CDEC = OFF_RSTD + SZ_RSTD;
constexpr size_t OFF_H = OFF_CDEC + SZ_CDEC;
constexpr size_t OFF_XBC = OFF_H + 2 * SZ_R512;
constexpr size_t OFF_GLU = OFF_XBC + 3 * SZ_R512;
constexpr size_t OFF_ST = OFF_XBC;
constexpr size_t OFF_Z = OFF_GLU + SZ_R512;
constexpr size_t OFF_DT = OFF_Z + 2 * SZ_R512;
constexpr size_t OFF_CS = OFF_DT + (size_t)R_ * 32 * 4;
constexpr size_t OFF_Q = OFF_CS + (size_t)R_ * 32 * 4;
constexpr size_t OFF_KV = OFF_Q + SZ_R512;
constexpr size_t OFF_AG = OFF_KV + SZ_R512 / 2;
constexpr size_t OFF_CG = OFF_AG + SZ_R512;
constexpr size_t OFF_BC = OFF_CG + SZ_R512;
constexpr size_t OFF_HDN = OFF_BC + SZ_R512;
constexpr size_t WS_TOTAL = OFF_HDN + SZ_R512;
constexpr size_t OFF_BAR = WS_TOTAL;
static_assert(OFF_BAR + 16384 <= (size_t)256 * 1024 * 1024, "workspace too large");

struct Params {
  const float *x, *c, *ctx, *c_ctx, *w_mod, *b_mod, *norm_w, *w_in, *ssd_conv_w, *ssd_conv_b, *ssd_dt_bias, *ssd_a_log,
      *ssd_d, *ssd_norm_w, *attn_sink, *conv_dw_w, *conv_dw_b, *conv_ln_w, *conv_ln_b, *conv_pw_w, *conv_pw_b, *w_out,
      *final_norm_w;
  float* out;
  char* ws;
};


DI Params load_params() {
  typedef const char __attribute__((address_space(4)))* kptr_t;
  typedef const float* const __attribute__((address_space(4)))* kfld_t;
  size_t off = 0;
  asm volatile("" : "+s"(off));
  kptr_t base = (kptr_t)__builtin_amdgcn_kernarg_segment_ptr() + off;
  Params p;
  const float** pp = (const float**)&p;
#pragma unroll
  for (int i = 0; i < 25; ++i) pp[i] = *(kfld_t)(base + 8 * i);
  return p;
}

#define XB_TMO      128
#define XB_XCNT(j)  (256  + 64 * (j))
#define XB_XSUB(j)  (1280 + 64 * (j))
#define XB_XGEN(j)  (2304 + 64 * (j))
#define XB_TOP      3328
#define XB_TOPGEN   3392
#define XCD_BAR_WORDS 3456
#define XB_SPIN_CAP (1u << 18)
#define LAS __attribute__((address_space(3)))
DI unsigned xb_ld(unsigned* p)              { return __hip_atomic_load(p, __ATOMIC_RELAXED, __HIP_MEMORY_SCOPE_AGENT); }
DI unsigned xb_add(unsigned* p, unsigned v) { return __hip_atomic_fetch_add(p, v, __ATOMIC_RELAXED, __HIP_MEMORY_SCOPE_AGENT); }
DI unsigned xb_xcc_id() { return (unsigned)__builtin_amdgcn_s_getreg((3 << 11) | 20) & 0xFu; }
#define XB_SPIN(cond, bar) do { unsigned _sp = 0; while (cond) { __builtin_amdgcn_s_sleep(1); \
    if ((++_sp & 255u) == 0u) { if (xb_ld(&(bar)[XB_TMO])) break; if (_sp > XB_SPIN_CAP) { atomicAdd(&(bar)[XB_TMO], 1u); break; } } } } while (0)

DI void xcd_barrier_complete(unsigned* bar, unsigned x, unsigned& nloc, unsigned& nx) {
  const unsigned G = gridDim.x * gridDim.y * gridDim.z;
  unsigned sum, cnt, mine, sp = 0u;
  for (;;) {
    sum = 0u; cnt = 0u; mine = 0u;
#pragma unroll
    for (unsigned j = 0; j < 16; ++j) { const unsigned c = xb_ld(&bar[XB_XCNT(j)]); sum += c; cnt += (c > 0u) ? 1u : 0u; mine = (j == x) ? c : mine; }
    if (sum == G) break;
    __builtin_amdgcn_s_sleep(1);
    if ((++sp & 255u) == 0u) { if (xb_ld(&bar[XB_TMO])) break; if (sp > XB_SPIN_CAP) { atomicAdd(&bar[XB_TMO], 1u); break; } }
  }
  nloc = mine > 0u ? mine : 1u; nx = cnt > 0u ? cnt : 1u;
}

DI void xcd_barrier(volatile LAS unsigned* st) {
  asm volatile("s_waitcnt vmcnt(0)" ::: "memory");
  __syncthreads();
  if (threadIdx.x == 0) {
    const Params pb = load_params();
    unsigned* bar = (unsigned*)(pb.ws + OFF_BAR);
    const unsigned x = xb_xcc_id();
    __builtin_amdgcn_s_waitcnt(0);
    unsigned nloc = st[0], nx = st[1];
    if (nloc == 0u) { xcd_barrier_complete(bar, x, nloc, nx); st[0] = nloc; st[1] = nx; }
    const unsigned old = xb_add(&bar[XB_XSUB(x)], 1u);
    const unsigned gen = old / nloc;
    if (old + 1u == (gen + 1u) * nloc) {
      __builtin_amdgcn_fence(__ATOMIC_RELEASE, "agent");
      asm volatile("s_waitcnt vmcnt(0)" ::: "memory");
      const unsigned og = xb_add(&bar[XB_TOP], 1u);
      const unsigned tg = og / nx;
      if (og + 1u == (tg + 1u) * nx) xb_add(&bar[XB_TOPGEN], 1u);
      else XB_SPIN(xb_ld(&bar[XB_TOPGEN]) == tg, bar);
      __builtin_amdgcn_fence(__ATOMIC_ACQUIRE, "agent");
      xb_add(&bar[XB_XGEN(x)], 1u);
      asm volatile("s_waitcnt vmcnt(0)" ::: "memory");
    } else {
      XB_SPIN(xb_ld(&bar[XB_XGEN(x)]) == gen, bar);
      __builtin_amdgcn_fence(__ATOMIC_ACQUIRE, "agent");
      asm volatile("s_waitcnt vmcnt(0)" ::: "memory");
    }
  }
  __syncthreads();
}

DI unsigned short f2bf(float x) { unsigned u = __float_as_uint(x); u += 0x7fffu + ((u >> 16) & 1u); return (unsigned short)(u >> 16); }
DI float bf2f(unsigned short b) { return __uint_as_float(((unsigned)b) << 16); }
DI unsigned pack2(float a, float b) { return (unsigned)f2bf(a) | ((unsigned)f2bf(b) << 16); }
DI float lo2f(unsigned u) { return __uint_as_float(u << 16); }
DI float hi2f(unsigned u) { return __uint_as_float(u & 0xffff0000u); }
DI float silu_f(float x) { return x / (1.f + __expf(-x)); }
DI float sigmoid_f(float x) { return 1.f / (1.f + __expf(-x)); }
DI int crow(int reg, int h) { return (reg & 3) + 8 * (reg >> 2) + 4 * h; }

DI bf16x8 tr_frag(const bf16_t* s, int ld, int row_lo, int row_hi, int col0) {
  const int lane = threadIdx.x & 63;
  const int i16 = lane & 15, q = i16 >> 2, pp = i16 & 3, blk = (lane >> 4) & 1;
  const unsigned a0 = (unsigned)(size_t)(s + (row_lo + q) * ld + col0 + 16 * blk + 4 * pp);
  const unsigned a1 = (unsigned)(size_t)(s + (row_hi + q) * ld + col0 + 16 * blk + 4 * pp);
  s16x4 lo, hi;
  asm volatile("ds_read_b64_tr_b16 %0, %2\n\tds_read_b64_tr_b16 %1, %3\n\ts_waitcnt lgkmcnt(0)"
               : "=&v"(lo), "=&v"(hi) : "v"(a0), "v"(a1) : "memory");
  return __builtin_shufflevector(lo, hi, 0, 1, 2, 3, 4, 5, 6, 7);
}

struct GemmS { bf16_t a[2][128][40]; bf16_t b[2][128][40]; };

template <class AF, class BF>
DI void gemm_core(f32x16 (&acc)[2][2], GemmS* s, AF aptr, BF bptr, int nk) {
  int tid = threadIdx.x; asm volatile("" : "+v"(tid)); const int lane = tid & 63, wave = tid >> 6, wr = wave >> 1, wc = wave & 1;
  const int r0 = tid >> 2, kv = tid & 3;
  const int fr = lane & 31, fh = lane >> 5;
  uint4 ra0 = *(const uint4*)aptr(0, r0, kv), ra1 = *(const uint4*)aptr(0, r0 + 64, kv);
  uint4 rb0 = *(const uint4*)bptr(0, r0, kv), rb1 = *(const uint4*)bptr(0, r0 + 64, kv);
  *(uint4*)&s->a[0][r0][kv * 8] = ra0; *(uint4*)&s->a[0][r0 + 64][kv * 8] = ra1;
  *(uint4*)&s->b[0][r0][kv * 8] = rb0; *(uint4*)&s->b[0][r0 + 64][kv * 8] = rb1;
  __syncthreads();
#pragma unroll 1
  for (int kt = 0; kt < nk; ++kt) {
    const int buf = kt & 1;
    if (kt + 1 < nk) {
      ra0 = *(const uint4*)aptr(kt + 1, r0, kv); ra1 = *(const uint4*)aptr(kt + 1, r0 + 64, kv);
      rb0 = *(const uint4*)bptr(kt + 1, r0, kv); rb1 = *(const uint4*)bptr(kt + 1, r0 + 64, kv);
    }
#pragma unroll
    for (int ks = 0; ks < 2; ++ks) {
      bf16x8 af[2], bq[2];
#pragma unroll
      for (int i = 0; i < 2; ++i) af[i] = *(const bf16x8*)&s->a[buf][wr * 64 + i * 32 + fr][ks * 16 + fh * 8];
#pragma unroll
      for (int j = 0; j < 2; ++j) bq[j] = *(const bf16x8*)&s->b[buf][wc * 64 + j * 32 + fr][ks * 16 + fh * 8];
#pragma unroll
      for (int i = 0; i < 2; ++i)
#pragma unroll
        for (int j = 0; j < 2; ++j) acc[i][j] = MFMA(af[i], bq[j], acc[i][j]);
    }
    if (kt + 1 < nk) {
      *(uint4*)&s->a[buf ^ 1][r0][kv * 8] = ra0; *(uint4*)&s->a[buf ^ 1][r0 + 64][kv * 8] = ra1;
      *(uint4*)&s->b[buf ^ 1][r0][kv * 8] = rb0; *(uint4*)&s->b[buf ^ 1][r0 + 64][kv * 8] = rb1;
    }
    __syncthreads();
  }
}


struct GemmS2 { bf16_t a[128][72]; bf16_t b[128][72]; };
DI void g2_compute(f32x16 (&acc)[2][2], const GemmS2* s, int wr, int wc, int fr, int fh) {
#pragma unroll
  for (int ks = 0; ks < 4; ++ks) {
    bf16x8 af[2], bq[2];
#pragma unroll
    for (int i = 0; i < 2; ++i) af[i] = *(const bf16x8*)&s->a[wr * 64 + i * 32 + fr][ks * 16 + fh * 8];
#pragma unroll
    for (int j = 0; j < 2; ++j) bq[j] = *(const bf16x8*)&s->b[wc * 64 + j * 32 + fr][ks * 16 + fh * 8];
#pragma unroll
    for (int i = 0; i < 2; ++i)
#pragma unroll
      for (int j = 0; j < 2; ++j) acc[i][j] = MFMA(af[i], bq[j], acc[i][j]);
  }
}

template <class AF, class BF, class HK>
DI void gemm_core2(f32x16 (&acc)[2][2], GemmS2* s, AF aptr, BF bptr, int nk, HK hook) {
  int tid = threadIdx.x; asm volatile("" : "+v"(tid));
  const int lane = tid & 63, wave = tid >> 6, wr = wave >> 1, wc = wave & 1;
  const int r0 = tid >> 3, kc = tid & 7;
  const int fr = lane & 31, fh = lane >> 5;
  uint4 p0a0, p0a1, p0a2, p0a3, p0b0, p0b1, p0b2, p0b3, p1a0, p1a1, p1a2, p1a3, p1b0, p1b1, p1b2, p1b3;
#define G2_LOAD(S, KT) { \
    S##a0 = *(const uint4*)aptr((KT), r0, kc);      S##b0 = *(const uint4*)bptr((KT), r0, kc); \
    S##a1 = *(const uint4*)aptr((KT), r0 + 32, kc); S##b1 = *(const uint4*)bptr((KT), r0 + 32, kc); \
    S##a2 = *(const uint4*)aptr((KT), r0 + 64, kc); S##b2 = *(const uint4*)bptr((KT), r0 + 64, kc); \
    S##a3 = *(const uint4*)aptr((KT), r0 + 96, kc); S##b3 = *(const uint4*)bptr((KT), r0 + 96, kc); }
#define G2_STORE(S) { \
    *(uint4*)&s->a[r0][kc * 8] = S##a0;      *(uint4*)&s->b[r0][kc * 8] = S##b0; \
    *(uint4*)&s->a[r0 + 32][kc * 8] = S##a1; *(uint4*)&s->b[r0 + 32][kc * 8] = S##b1; \
    *(uint4*)&s->a[r0 + 64][kc * 8] = S##a2; *(uint4*)&s->b[r0 + 64][kc * 8] = S##b2; \
    *(uint4*)&s->a[r0 + 96][kc * 8] = S##a3; *(uint4*)&s->b[r0 + 96][kc * 8] = S##b3; }
#define G2_COMPUTE() g2_compute(acc, s, wr, wc, fr, fh);
  G2_LOAD(p0, 0)
  G2_LOAD(p1, 1)
  G2_STORE(p0)
  __syncthreads();
#pragma unroll 1
  for (int kt = 0; kt < nk; kt += 2) {
    hook(kt);
    G2_COMPUTE()
    __syncthreads();
    G2_STORE(p1)
    if (kt + 2 < nk) G2_LOAD(p0, kt + 2)
    __syncthreads();
    hook(kt + 1);
    G2_COMPUTE()
    __syncthreads();
    if (kt + 2 < nk) {
      G2_STORE(p0)
      if (kt + 3 < nk) G2_LOAD(p1, kt + 3)
    }
    __syncthreads();
  }
#undef G2_LOAD
#undef G2_STORE
#undef G2_COMPUTE
}


DI bool xcd_tile(int step, int nM, int nN, int& mt, int& nt) {
  const int xcd = blockIdx.x & 7, nloc = gridDim.x >> 3;
  const int j = (blockIdx.x >> 3) + step * nloc;
  const int mloc = nM >> 3;
  if ((gridDim.x & 7) != 0 || j >= mloc * nN) return false;
  const int per = 8 * nN;
  const int gm = j / per, rem = j - gm * per;
  const int hgt = min(8, mloc - gm * 8);
  const int a = rem % hgt;
  nt = rem / hgt;
  mt = (gm * 8 + a) * 8 + xcd;
  return true;
}

DI void zero_acc(f32x16 (&acc)[2][2]) {
#pragma unroll
  for (int i = 0; i < 2; ++i)
#pragma unroll
    for (int j = 0; j < 2; ++j)
#pragma unroll
      for (int r = 0; r < 16; ++r) acc[i][j][r] = 0.f;
}

template <class EPI>
DI void epilogue_lds(f32x16 (&acc)[2][2], char* smem, EPI epi) {
  float* T = (float*)smem;
  int tid = threadIdx.x; asm volatile("" : "+v"(tid)); const int lane = tid & 63, wave = tid >> 6, wr = wave >> 1, wc = wave & 1, fr = lane & 31, fh = lane >> 5;
#pragma unroll
  for (int i = 0; i < 2; ++i) {
#pragma unroll
    for (int j = 0; j < 2; ++j)
#pragma unroll
      for (int r = 0; r < 16; ++r) T[(wr * 32 + crow(r, fh)) * 132 + wc * 64 + j * 32 + fr] = acc[i][j][r];
    __syncthreads();
#pragma unroll 2
    for (int e = tid; e < 2048; e += 256) {
      const int tr = e >> 5, c4 = (e & 31) * 4;
      const float4 v = *(const float4*)&T[tr * 132 + c4];
      epi((tr >> 5) * 64 + i * 32 + (tr & 31), c4, v);
    }
    __syncthreads();
  }
}

DI void phase_mods(const Params& p_in, char* smem) {
  const Params p = load_params();

  float* ssc = (float*)smem;
  float* red = (float*)(smem + 20480);
  float* mods = (float*)(p.ws + OFF_MODS);
  int tid = threadIdx.x; asm volatile("" : "+v"(tid));
  if (blockIdx.x == 0) { unsigned* bar = (unsigned*)(p.ws + OFF_BAR); for (int i = tid; i < XCD_BAR_WORDS; i += 256) bar[i] = 0u; }
  for (int it = blockIdx.x; it < 96; it += gridDim.x) {
    const int l = it / 48, col0 = (it % 48) * 64;
    __syncthreads();
    for (int e = tid; e < 5120; e += 256) {
      const int v = e >> 10, k = e & 1023;
      const float cv = (v < 4) ? p.c[v * 1024 + k] : p.c_ctx[k];
      ssc[e] = silu_f(cv);
    }
    __syncthreads();
    const int col = tid & 63, kg = tid >> 6;
    float a[5] = {0.f, 0.f, 0.f, 0.f, 0.f};
    const float* w = p.w_mod + (size_t)l * 1024 * 3072 + col0 + col;
    for (int k = kg * 256; k < kg * 256 + 256; k += 8) {
      float wv[8];
#pragma unroll
      for (int u = 0; u < 8; ++u) wv[u] = w[(size_t)(k + u) * 3072];
#pragma unroll
      for (int u = 0; u < 8; ++u)
#pragma unroll
        for (int v = 0; v < 5; ++v) a[v] += ssc[v * 1024 + k + u] * wv[u];
    }
#pragma unroll
    for (int v = 0; v < 5; ++v) red[(kg * 5 + v) * 64 + col] = a[v];
    __syncthreads();
    for (int e = tid; e < 320; e += 256) {
      const int v = e >> 6, cc = e & 63;
      float sum = p.b_mod[l * 3072 + col0 + cc];
      for (int g = 0; g < 4; ++g) sum += red[(g * 5 + v) * 64 + cc];
      mods[(l * 5 + v) * 3072 + col0 + cc] = sum;
    }
  }
}

DI int win_colmap(int n) {
  if (n < 2560) return n;
  if (n < 3840) return n + 32;
  if (n < 4864) {
    const int j = n - 3840, q64 = j >> 6, w = j & 63;
    return (w < 32) ? (3872 + q64 * 32 + w) : (3872 + 512 + q64 * 32 + (w - 32));
  }
  if (n < 5376) return n + 32;
  if (n < 5408) return n - 5376 + 2560;
  return -1;
}

DI void transpose_tile(const float* src, int ldsrc, int kind, const float* rowscale, bf16_t* dst, int lddst, int n0, int k0, float* tile) {
  int tid = threadIdx.x; asm volatile("" : "+v"(tid)); const int tx = tid & 63, ty = tid >> 6;
  __syncthreads();
  const int n = (kind == 0) ? win_colmap(n0 + tx) : (n0 + tx);
  for (int r = ty; r < 64; r += 4) {
    const int k = k0 + r;
    float v = 0.f;
    if (n >= 0) v = src[(size_t)k * ldsrc + n];
    if (rowscale != nullptr && k < 1024) v *= rowscale[k];
    tile[r * 65 + tx] = v;
  }
  __syncthreads();
  for (int r = ty; r < 64; r += 4) dst[(size_t)(n0 + r) * lddst + k0 + tx] = f2bf(tile[tx * 65 + r]);
}

DI void phase_prep(const Params& p_in, int l, char* smem) {
  const Params p = load_params();

  int tid = threadIdx.x; asm volatile("" : "+v"(tid)); const int lane = tid & 63, wave = tid >> 6;
  const float* mods = (const float*)(p.ws + OFF_MODS);
  bf16_t* H = (bf16_t*)(p.ws + OFF_H);
  const int NT_WIN = 86 * 16, NT_WOUT = 16 * 32, NT_PW = 64, NT_CONV = NT_WIN + NT_WOUT + NT_PW;
  const int NT = NT_CONV + R_ / 4;
  for (int it = blockIdx.x; it < NT; it += gridDim.x) {
    if (it < NT_WIN) {
      transpose_tile(p.w_in + (size_t)l * 1024 * 5408, 5408, 0, nullptr, (bf16_t*)(p.ws + OFF_WIN), 1024, (it / 16) * 64, (it % 16) * 64, (float*)smem);
    } else if (it < NT_WIN + NT_WOUT) {
      const int t = it - NT_WIN;
      transpose_tile(p.w_out + (size_t)l * 2048 * 1024, 1024, 1, p.ssd_norm_w + l * 1024, (bf16_t*)(p.ws + OFF_WOUT), 2048, (t / 32) * 64, (t % 32) * 64, (float*)smem);
    } else if (it < NT_CONV) {
      const int t = it - NT_WIN - NT_WOUT;
      transpose_tile(p.conv_pw_w + (size_t)l * 512 * 512, 512, 1, nullptr, (bf16_t*)(p.ws + OFF_PW), 512, (t / 8) * 64, (t % 8) * 64, (float*)smem);
    } else {
      const int rho = (it - NT_CONV) * 4 + wave;
      const float* xs;
      if (l == 0) xs = (rho < RL_) ? (p.x + (size_t)rho * 1024) : (p.ctx + (size_t)(rho - RL_) * 1024);
      else xs = (rho < RL_) ? (p.out + (size_t)rho * 1024) : ((const float*)(p.ws + OFF_XC) + (size_t)(rho - RL_) * 1024);
      const int v = (rho < RL_) ? (rho >> 12) : 4;
      const float* md = mods + (l * 5 + v) * 3072;
      float4 xv[4];
      float ss = 0.f;
#pragma unroll
      for (int i = 0; i < 4; ++i) {
        xv[i] = *(const float4*)(xs + lane * 4 + i * 256);
        ss += xv[i].x * xv[i].x + xv[i].y * xv[i].y + xv[i].z * xv[i].z + xv[i].w * xv[i].w;
      }
#pragma unroll
      for (int o = 32; o >= 1; o >>= 1) ss += __shfl_xor(ss, o);
      const float rs = rsqrtf(ss * (1.f / 1024.f) + 1e-6f);
#pragma unroll
      for (int i = 0; i < 4; ++i) {
        const int cidx = lane * 4 + i * 256;
        const float4 nw = *(const float4*)(p.norm_w + l * 1024 + cidx);
        const float4 sh = *(const float4*)(md + cidx);
        const float4 sc = *(const float4*)(md + 1024 + cidx);
        uint2 o;
        o.x = pack2(xv[i].x * rs * nw.x * (1.f + sc.x) + sh.x, xv[i].y * rs * nw.y * (1.f + sc.y) + sh.y);
        o.y = pack2(xv[i].z * rs * nw.z * (1.f + sc.z) + sh.z, xv[i].w * rs * nw.w * (1.f + sc.w) + sh.w);
        *(uint2*)(H + (size_t)rho * 1024 + cidx) = o;
      }
    }
  }
}

DI void phase_inproj(const Params& p_in, char* smem) {
  const Params p = load_params();

  GemmS* s = (GemmS*)smem;
  int tid = threadIdx.x; asm volatile("" : "+v"(tid)); const int lane = tid & 63, wave = tid >> 6, wr = wave >> 1, wc = wave & 1, fr = lane & 31, fh = lane >> 5;
  const bf16_t* H = (const bf16_t*)(p.ws + OFF_H);
  const bf16_t* W = (const bf16_t*)(p.ws + OFF_WIN);
  for (int step = 0;; ++step) {
    int mt, nt;
    if (!xcd_tile(step, NCK, 43, mt, nt)) break;
    f32x16 acc[2][2];
    zero_acc(acc);
    const bf16_t* Ab = H + (size_t)mt * 128 * 1024;
    const bf16_t* Bb = W + (size_t)nt * 128 * 1024;
    gemm_core2(acc, (GemmS2*)smem,
               [&](int kt, int r, int kv) { return Ab + (size_t)r * 1024 + kt * 64 + kv * 8; },
               [&](int kt, int r, int kv) { return Bb + (size_t)r * 1024 + kt * 64 + kv * 8; }, 16, [](int) {});
    const int row0 = mt * 128;
    if (nt >= 30 && nt < 38) {
#pragma unroll
      for (int i = 0; i < 2; ++i)
#pragma unroll
        for (int r = 0; r < 16; ++r) acc[i][0][r] = acc[i][0][r] * sigmoid_f(acc[i][1][r]);
      bf16_t* G = (bf16_t*)(p.ws + OFF_GLU);
      const int cb0 = (nt - 30) * 64;
      epilogue_lds(acc, smem, [&](int rl, int c4, float4 v) {
        if ((c4 & 32) == 0) {
          uint2 o; o.x = pack2(v.x, v.y); o.y = pack2(v.z, v.w);
          *(uint2*)(G + (size_t)(row0 + rl) * 512 + cb0 + (c4 >> 6) * 32 + (c4 & 31)) = o;
        }
      });
    } else if (nt == 42) {
      float* DT = (float*)(p.ws + OFF_DT);
      epilogue_lds(acc, smem, [&](int rl, int c4, float4 v) {
        if (c4 < 32) *(float4*)(DT + (size_t)(row0 + rl) * 32 + c4) = v;
      });
    } else {
      bf16_t* dst; int ld, cb;
      if (nt < 12) { dst = (bf16_t*)(p.ws + OFF_XBC); ld = 1536; cb = nt * 128; }
      else if (nt < 20) { dst = (bf16_t*)(p.ws + OFF_Z); ld = 1024; cb = nt * 128 - 1536; }
      else if (nt < 24) { dst = (bf16_t*)(p.ws + OFF_Q); ld = 512; cb = nt * 128 - 2560; }
      else if (nt < 26) { dst = (bf16_t*)(p.ws + OFF_KV); ld = 256; cb = nt * 128 - 3072; }
      else if (nt < 30) { dst = (bf16_t*)(p.ws + OFF_AG); ld = 512; cb = nt * 128 - 3328; }
      else { dst = (bf16_t*)(p.ws + OFF_CG); ld = 512; cb = nt * 128 - 4864; }
      epilogue_lds(acc, smem, [&](int rl, int c4, float4 v) {
        uint2 o; o.x = pack2(v.x, v.y); o.y = pack2(v.z, v.w);
        *(uint2*)(dst + (size_t)(row0 + rl) * ld + cb + c4) = o;
      });
    }
  }
}

DI void phase_local(const Params& p_in, int l, char* smem) {
  const Params p = load_params();

  int tid = threadIdx.x; asm volatile("" : "+v"(tid)); const int lane = tid & 63;
  const bf16_t* XBC = (const bf16_t*)(p.ws + OFF_XBC);
  bf16_t* XS = (bf16_t*)(p.ws + OFF_H);
  bf16_t* BC = (bf16_t*)(p.ws + OFF_BC);
  float* DT = (float*)(p.ws + OFF_DT);
  float* CS = (float*)(p.ws + OFF_CS);
  const bf16_t* GLU = (const bf16_t*)(p.ws + OFF_GLU);
  bf16_t* HDN = (bf16_t*)(p.ws + OFF_HDN);
  bf16_t* Q = (bf16_t*)(p.ws + OFF_Q);
  bf16_t* KV = (bf16_t*)(p.ws + OFF_KV);
  const int N_CONV = (R_ / 8) * 192 / 256;
  const int N_DT = NCK;
  const int N_CF = R_ / 16;
  const int N_ROPE = RL_ * 40 / 256;
  const int N_QC = 1024 * 256 / 256;
  const int NT = N_CF + N_DT + N_CONV + N_ROPE + N_QC;
  for (int it0 = blockIdx.x; it0 < NT; it0 += gridDim.x) {
    int it = it0;
    if (it < N_CF) {
      float* sst = (float*)smem;
      unsigned* sIn = (unsigned*)(smem + 256);
      const int row0 = it * 16;
      const int seq0 = (row0 < RL_) ? (row0 & ~4095) : (RL_ + ((row0 - RL_) & ~255));
      const int slen = (row0 < RL_) ? 4096 : 256;
      const int t0 = row0 - seq0;
      const int c0 = tid * 2;
      __syncthreads();
      if (tid < 32) sst[tid] = 0.f;
      for (int idx = tid; idx < 46 * 64; idx += 256) {
        const int rr = idx >> 6, c16 = idx & 63;
        const int tt = t0 - 15 + rr;
        uint4 val = make_uint4(0u, 0u, 0u, 0u);
        if (tt >= 0 && tt < slen) val = *(const uint4*)(GLU + (size_t)(seq0 + tt) * 512 + c16 * 8);
        *(uint4*)&sIn[rr * 256 + c16 * 4] = val;
      }
      float w0[31], w1[31];
#pragma unroll
      for (int k = 0; k < 31; ++k) {
        const float2 wv = *(const float2*)(p.conv_dw_w + ((size_t)l * 31 + k) * 512 + c0);
        w0[k] = wv.x; w1[k] = wv.y;
      }
      const float2 bv = *(const float2*)(p.conv_dw_b + l * 512 + c0);
      float a0[16], a1[16];
#pragma unroll
      for (int r = 0; r < 16; ++r) { a0[r] = bv.x; a1[r] = bv.y; }
      __syncthreads();
#pragma unroll
      for (int tp = 0; tp < 46; ++tp) {
        const unsigned u = sIn[tp * 256 + tid];
        const float x0 = lo2f(u), x1 = hi2f(u);
#pragma unroll
        for (int r = 0; r < 16; ++r) {
          const int k = tp - r;
          if (k >= 0 && k < 31) { a0[r] += w0[k] * x0; a1[r] += w1[k] * x1; }
        }
      }
      {
        float v[32];
#pragma unroll
        for (int r = 0; r < 16; ++r) { v[2 * r] = a0[r] + a1[r]; v[2 * r + 1] = a0[r] * a0[r] + a1[r] * a1[r]; }
#pragma unroll
        for (int i = 0; i < 16; ++i) { const bool up = (lane & 32) != 0; const float keep = up ? v[i + 16] : v[i]; const float send = up ? v[i] : v[i + 16]; v[i] = keep + __shfl_xor(send, 32); }
#pragma unroll
        for (int i = 0; i < 8; ++i) { const bool up = (lane & 16) != 0; const float keep = up ? v[i + 8] : v[i]; const float send = up ? v[i] : v[i + 8]; v[i] = keep + __shfl_xor(send, 16); }
#pragma unroll
        for (int i = 0; i < 4; ++i) { const bool up = (lane & 8) != 0; const float keep = up ? v[i + 4] : v[i]; const float send = up ? v[i] : v[i + 4]; v[i] = keep + __shfl_xor(send, 8); }
#pragma unroll
        for (int i = 0; i < 2; ++i) { const bool up = (lane & 4) != 0; const float keep = up ? v[i + 2] : v[i]; const float send = up ? v[i] : v[i + 2]; v[i] = keep + __shfl_xor(send, 4); }
        { const bool up = (lane & 2) != 0; const float keep = up ? v[1] : v[0]; const float send = up ? v[0] : v[1]; v[0] = keep + __shfl_xor(send, 2); }
        v[0] += __shfl_xor(v[0], 1);
        __syncthreads();
        if ((lane & 1) == 0) atomicAdd(&sst[lane >> 1], v[0]);
      }
      __syncthreads();
      const float2 lw = *(const float2*)(p.conv_ln_w + l * 512 + c0);
      const float2 lb = *(const float2*)(p.conv_ln_b + l * 512 + c0);
#pragma unroll
      for (int r = 0; r < 16; ++r) {
        const float mean = sst[r * 2] * (1.f / 512.f);
        const float var = fmaxf(sst[r * 2 + 1] * (1.f / 512.f) - mean * mean, 0.f);
        const float rs = rsqrtf(var + 1e-6f);
        const float y0 = (a0[r] - mean) * rs * lw.x + lb.x;
        const float y1 = (a1[r] - mean) * rs * lw.y + lb.y;
        *(unsigned*)(HDN + (size_t)(row0 + r) * 512 + c0) = pack2(silu_f(y0), silu_f(y1));
      }
      continue;
    }
    it -= N_CF;
    if (it < N_DT) {
      float* sdt = (float*)smem;
      const int row0 = it * 128;
      __syncthreads();
      for (int e = tid; e < 4096; e += 256) {
        const int r = e >> 5, cidx = e & 31;
        const float raw = DT[(size_t)(row0 + r) * 32 + cidx] + p.ssd_dt_bias[l * 32 + cidx];
        const float sp = (raw > 20.f) ? raw : log1pf(expf(raw));
        DT[(size_t)(row0 + r) * 32 + cidx] = sp;
        sdt[r * 33 + cidx] = sp;
      }
      __syncthreads();
      if (tid < 32) {
        const float a = -expf(p.ssd_a_log[l * 32 + tid]);
        float run = 0.f;
        if (tid < 16) {
          for (int r = 0; r < 128; ++r) { run += sdt[r * 33 + tid] * a; CS[(size_t)(row0 + r) * 32 + tid] = run; }
        } else {
          for (int r = 127; r >= 0; --r) { run += sdt[r * 33 + tid] * a; CS[(size_t)(row0 + r) * 32 + tid] = run; }
        }
      }
      continue;
    }
    it -= N_DT;
    if (it < N_CONV) {
      const int e = it * 256 + tid;
      const int rb = e / 192, cgp = e % 192, ch0 = cgp * 8;
      const int rho0 = rb * 8;
      const int seq0 = (rho0 < RL_) ? (rho0 & ~4095) : (RL_ + ((rho0 - RL_) & ~255));
      const int slen = (rho0 < RL_) ? 4096 : 256;
      const int t0 = rho0 - seq0;
      uint4 xr[12];
#pragma unroll
      for (int i = 0; i < 12; ++i) {
        const int tt = t0 + i - 2;
        xr[i] = make_uint4(0u, 0u, 0u, 0u);
        if (tt >= 0 && tt < slen) xr[i] = *(const uint4*)(XBC + (size_t)(seq0 + tt) * 1536 + ch0);
      }
      float wk[5][8];
#pragma unroll
      for (int k = 0; k < 5; ++k) {
        const float4 w0 = *(const float4*)(p.ssd_conv_w + ((size_t)l * 5 + k) * 1536 + ch0);
        const float4 w1 = *(const float4*)(p.ssd_conv_w + ((size_t)l * 5 + k) * 1536 + ch0 + 4);
        wk[k][0] = w0.x; wk[k][1] = w0.y; wk[k][2] = w0.z; wk[k][3] = w0.w; wk[k][4] = w1.x; wk[k][5] = w1.y; wk[k][6] = w1.z; wk[k][7] = w1.w;
      }
      float bias[8];
      {
        const float4 b0 = *(const float4*)(p.ssd_conv_b + l * 1536 + ch0);
        const float4 b1 = *(const float4*)(p.ssd_conv_b + l * 1536 + ch0 + 4);
        bias[0] = b0.x; bias[1] = b0.y; bias[2] = b0.z; bias[3] = b0.w; bias[4] = b1.x; bias[5] = b1.y; bias[6] = b1.z; bias[7] = b1.w;
      }
#pragma unroll
      for (int r = 0; r < 8; ++r) {
        float a[8];
#pragma unroll
        for (int c = 0; c < 8; ++c) a[c] = bias[c];
#pragma unroll
        for (int k = 0; k < 5; ++k) {
          const uint4 u = xr[r + k];
          a[0] += wk[k][0] * lo2f(u.x); a[1] += wk[k][1] * hi2f(u.x); a[2] += wk[k][2] * lo2f(u.y); a[3] += wk[k][3] * hi2f(u.y);
          a[4] += wk[k][4] * lo2f(u.z); a[5] += wk[k][5] * hi2f(u.z); a[6] += wk[k][6] * lo2f(u.w); a[7] += wk[k][7] * hi2f(u.w);
        }
        uint4 o;
        o.x = pack2(silu_f(a[0]), silu_f(a[1])); o.y = pack2(silu_f(a[2]), silu_f(a[3]));
        o.z = pack2(silu_f(a[4]), silu_f(a[5])); o.w = pack2(silu_f(a[6]), silu_f(a[7]));
        const size_t rho = (size_t)(rho0 + r);
        if (ch0 < 1024) *(uint4*)(XS + rho * 1024 + ch0) = o;
        else *(uint4*)(BC + rho * 512 + (ch0 - 1024)) = o;
      }
      continue;
    }
    it -= N_CONV;
    if (it < N_ROPE) {
      const int e = it * 256 + tid;
      const int rho = e / 40, rem = e % 40, hd = rem >> 2, sub = rem & 3;
      const int axis = sub >> 1, half = sub & 1;
      const int t = rho & 4095;
      const float pos = (float)(axis == 0 ? (t >> 6) : (t & 63));
      bf16_t* base = ((hd < 8) ? (Q + (size_t)rho * 512 + hd * 64) : (KV + (size_t)rho * 256 + (hd - 8) * 64)) + axis * 32 + half * 8;
      const float sc = (hd < 8) ? 0.125f : 1.f;
      const uint4 u1 = *(const uint4*)base, u2 = *(const uint4*)(base + 16);
      const unsigned a1[4] = {u1.x, u1.y, u1.z, u1.w}, a2[4] = {u2.x, u2.y, u2.z, u2.w};
      unsigned o1[4], o2[4];
#pragma unroll
      for (int i = 0; i < 4; ++i) {
        float r1[2], r2[2];
#pragma unroll
        for (int hl = 0; hl < 2; ++hl) {
          const float f = (float)(half * 8 + 2 * i + hl);
          const float ang = pos * exp2f(-f * 0.8304820237218406f);
          const float cs = __cosf(ang), sn = __sinf(ang);
          const float t1 = hl ? hi2f(a1[i]) : lo2f(a1[i]);
          const float t2 = hl ? hi2f(a2[i]) : lo2f(a2[i]);
          r1[hl] = (t1 * cs - t2 * sn) * sc;
          r2[hl] = (t2 * cs + t1 * sn) * sc;
        }
        o1[i] = pack2(r1[0], r1[1]); o2[i] = pack2(r2[0], r2[1]);
      }
      *(uint4*)base = make_uint4(o1[0], o1[1], o1[2], o1[3]);
      *(uint4*)(base + 16) = make_uint4(o2[0], o2[1], o2[2], o2[3]);
      continue;
    }
    it -= N_ROPE;
    {
      const int e = it * 256 + tid;
      const int rho = RL_ + e / 256, c2 = (e % 256) * 2;
      unsigned* ptr = (unsigned*)(Q + (size_t)rho * 512 + c2);
      const unsigned u = *ptr;
      *ptr = pack2(lo2f(u) * 0.125f, hi2f(u) * 0.125f);
    }
  }
}

DI void attn_item(const Params& p_in, int l, char* smem, int b, int qblk, int g, int hp, bool ctxq) {
  const Params p = load_params();

  bf16_t* sK = (bf16_t*)smem;
  bf16_t* sV = (bf16_t*)(smem + 128 * 72 * 2);
  int tid = threadIdx.x; asm volatile("" : "+v"(tid)); const int lane = tid & 63, wave = tid >> 6, fr = lane & 31, fh = lane >> 5;
  const int head = g * 4 + hp * 2 + (wave >> 1);
  const int qh = wave & 1;
  const int qrow0 = (ctxq ? (RL_ + b * 256) : (b * 4096)) + qblk * 128 + qh * 64;
  const int qpos0 = qblk * 128 + qh * 64;
  bf16_t* Q = (bf16_t*)(p.ws + OFF_Q);
  const bf16_t* KV = (const bf16_t*)(p.ws + OFF_KV);
  const bf16_t* AG = (const bf16_t*)(p.ws + OFF_AG);
  bf16x8 qf[2][4];
#pragma unroll
  for (int j = 0; j < 2; ++j)
#pragma unroll
    for (int ks = 0; ks < 4; ++ks)
      qf[j][ks] = *(const bf16x8*)(Q + (size_t)(qrow0 + j * 32 + fr) * 512 + head * 64 + ks * 16 + fh * 8);
  f32x16 o[2][2];
  zero_acc(o);
  float m[2], lsum[2];
  m[0] = m[1] = p.attn_sink[l * 8 + head];
  lsum[0] = lsum[1] = 1.f;
  const int nblk = ctxq ? 2 : 5;
  for (int bi = 0; bi < nblk; ++bi) {
    int krow0, kpos0 = 0;
    bool masked = false;
    if (bi < 2) {
      krow0 = RL_ + b * 256 + bi * 128;
    } else {
      const int kb = qblk + bi - 3;
      if (kb < 0 || kb >= 32) continue;
      krow0 = b * 4096 + kb * 128;
      kpos0 = kb * 128;
      masked = (bi != 3);
    }
    __syncthreads();
    for (int v = tid; v < 1024; v += 256) {
      const int r = v >> 3, cv = v & 7;
      *(uint4*)&sK[r * 72 + cv * 8] = *(const uint4*)(KV + (size_t)(krow0 + r) * 256 + g * 64 + cv * 8);
      *(uint4*)&sV[r * 72 + cv * 8] = *(const uint4*)(KV + (size_t)(krow0 + r) * 256 + 128 + g * 64 + cv * 8);
    }
    __syncthreads();
#pragma unroll 1
    for (int kb = 0; kb < 4; ++kb) {
      f32x16 st[2];
#pragma unroll
      for (int j = 0; j < 2; ++j)
#pragma unroll
        for (int r = 0; r < 16; ++r) st[j][r] = 0.f;
#pragma unroll
      for (int ks = 0; ks < 4; ++ks) {
        const bf16x8 kf = *(const bf16x8*)&sK[(kb * 32 + fr) * 72 + ks * 16 + fh * 8];
#pragma unroll
        for (int j = 0; j < 2; ++j) st[j] = MFMA(kf, qf[j][ks], st[j]);
      }
      bf16x8 pb[2][2];
#pragma unroll
      for (int j = 0; j < 2; ++j) {
        if (masked) {
          const int qpos = qpos0 + j * 32 + fr;
#pragma unroll
          for (int r = 0; r < 16; ++r) {
            const int d = qpos - (kpos0 + kb * 32 + crow(r, fh));
            if (d > 128 || d < -128) st[j][r] = -1e30f;
          }
        }
        float mx = st[j][0];
#pragma unroll
        for (int r = 1; r < 16; ++r) mx = fmaxf(mx, st[j][r]);
        mx = fmaxf(mx, __shfl_xor(mx, 32));
        const float mnew = fmaxf(m[j], mx);
        const float alpha = __expf(m[j] - mnew);
        float rs = 0.f;
#pragma unroll
        for (int r = 0; r < 16; ++r) { const float pv = __expf(st[j][r] - mnew); st[j][r] = pv; rs += pv; }
        rs += __shfl_xor(rs, 32);
        lsum[j] = lsum[j] * alpha + rs;
        m[j] = mnew;
#pragma unroll
        for (int mt = 0; mt < 2; ++mt)
#pragma unroll
          for (int r = 0; r < 16; ++r) o[mt][j][r] *= alpha;
#pragma unroll
        for (int s = 0; s < 2; ++s)
#pragma unroll
          for (int jj = 0; jj < 8; ++jj) pb[j][s][jj] = (short)f2bf(st[j][8 * s + jj]);
      }
#pragma unroll
      for (int s = 0; s < 2; ++s)
#pragma unroll
        for (int mt = 0; mt < 2; ++mt) {
          const bf16x8 vf = tr_frag(sV, 72, kb * 32 + 16 * s + 4 * fh, kb * 32 + 16 * s + 8 + 4 * fh, mt * 32);
#pragma unroll
          for (int j = 0; j < 2; ++j) o[mt][j] = MFMA(vf, pb[j][s], o[mt][j]);
        }
    }
  }
#pragma unroll
  for (int j = 0; j < 2; ++j) {
    const float inv = 1.f / lsum[j];
    const size_t rho = (size_t)(qrow0 + j * 32 + fr);
#pragma unroll
    for (int mt = 0; mt < 2; ++mt)
#pragma unroll
      for (int g4 = 0; g4 < 4; ++g4) {
        const int d0 = mt * 32 + 8 * g4 + 4 * fh;
        const uint2 gv = *(const uint2*)(AG + rho * 512 + head * 64 + d0);
        uint2 ov;
        ov.x = pack2(o[mt][j][g4 * 4 + 0] * inv * silu_f(lo2f(gv.x)), o[mt][j][g4 * 4 + 1] * inv * silu_f(hi2f(gv.x)));
        ov.y = pack2(o[mt][j][g4 * 4 + 2] * inv * silu_f(lo2f(gv.y)), o[mt][j][g4 * 4 + 3] * inv * silu_f(hi2f(gv.y)));
        *(uint2*)(Q + rho * 512 + head * 64 + d0) = ov;
      }
  }
}

DI void states_item(const Params& p_in, char* smem, int ck, int g, int hq) {
  const Params p = load_params();

  bf16_t* sB = (bf16_t*)smem;
  bf16_t* sX = (bf16_t*)(smem + 128 * 136 * 2);
  int tid = threadIdx.x; asm volatile("" : "+v"(tid)); const int lane = tid & 63, wave = tid >> 6, wr = wave >> 1, wc = wave & 1, fr = lane & 31, fh = lane >> 5;
  const bf16_t* BC = (const bf16_t*)(p.ws + OFF_BC);
  const bf16_t* XS = (const bf16_t*)(p.ws + OFF_H);
  const float* DT = (const float*)(p.ws + OFF_DT);
  const float* CS = (const float*)(p.ws + OFF_CS);
  bf16_t* ST = (bf16_t*)(p.ws + OFF_ST);
  float* CDEC = (float*)(p.ws + OFF_CDEC);
  const int row0 = ck * 128;
  __syncthreads();
  for (int v = tid; v < 2048; v += 256) {
    const int r = v >> 4, cv = v & 15;
    *(uint4*)&sB[r * 136 + cv * 8] = *(const uint4*)(BC + (size_t)(row0 + r) * 512 + g * 128 + cv * 8);
  }
  __syncthreads();
  bf16x8 bfr[2][8];
#pragma unroll
  for (int j = 0; j < 2; ++j)
#pragma unroll
    for (int ks = 0; ks < 8; ++ks) bfr[j][ks] = tr_frag(sB, 136, ks * 16 + 8 * fh, ks * 16 + 8 * fh + 4, wc * 64 + j * 32);
#pragma unroll 1
  for (int hd = 0; hd < 8; ++hd) {
    const int head = g * 8 + hq * 4 + (hd >> 1), d = hd & 1;
    const int col = d * 16 + head;
    const float cend = CS[(size_t)(row0 + (d == 0 ? 127 : 0)) * 32 + col];
    for (int v = tid; v < 1024; v += 256) {
      const int lr = v >> 3, cv = v & 7;
      const size_t rho = (size_t)(row0 + lr);
      const float sc = DT[rho * 32 + col] * __expf(cend - CS[rho * 32 + col]);
      const uint4 u = *(const uint4*)(XS + rho * 1024 + head * 64 + cv * 8);
      uint4 o;
      o.x = pack2(lo2f(u.x) * sc, hi2f(u.x) * sc); o.y = pack2(lo2f(u.y) * sc, hi2f(u.y) * sc);
      o.z = pack2(lo2f(u.z) * sc, hi2f(u.z) * sc); o.w = pack2(lo2f(u.w) * sc, hi2f(u.w) * sc);
      *(uint4*)&sX[lr * 72 + cv * 8] = o;
    }
    __syncthreads();
    f32x16 acc[2];
#pragma unroll
    for (int j = 0; j < 2; ++j)
#pragma unroll
      for (int r = 0; r < 16; ++r) acc[j][r] = 0.f;
#pragma unroll
    for (int ks = 0; ks < 8; ++ks) {
      const bf16x8 af = tr_frag(sX, 72, ks * 16 + 8 * fh, ks * 16 + 8 * fh + 4, wr * 32);
#pragma unroll
      for (int j = 0; j < 2; ++j) acc[j] = MFMA(af, bfr[j][ks], acc[j]);
    }
    bf16_t* dst = ST + ((size_t)(ck * 2 + d) * 16 + head) * 8192;
#pragma unroll
    for (int j = 0; j < 2; ++j)
#pragma unroll
      for (int r = 0; r < 16; ++r) dst[(wr * 32 + crow(r, fh)) * 128 + wc * 64 + j * 32 + fr] = f2bf(acc[j][r]);
    if (tid == 0) CDEC[(ck * 2 + d) * 16 + head] = __expf(cend);
    __syncthreads();
  }
}

DI void pw_item(const Params& p_in, int l, char* smem, int mt, int nt) {
  const Params p = load_params();

  GemmS* s = (GemmS*)smem;
  int tid = threadIdx.x; asm volatile("" : "+v"(tid)); const int lane = tid & 63, wave = tid >> 6, wr = wave >> 1, wc = wave & 1, fr = lane & 31, fh = lane >> 5;
  const bf16_t* Ab = (const bf16_t*)(p.ws + OFF_HDN) + (size_t)mt * 128 * 512;
  const bf16_t* Bb = (const bf16_t*)(p.ws + OFF_PW) + (size_t)nt * 128 * 512;
  bf16_t* CG = (bf16_t*)(p.ws + OFF_CG);
  f32x16 acc[2][2];
  zero_acc(acc);
  gemm_core2(acc, (GemmS2*)smem,
             [&](int kt, int r, int kv) { return Ab + (size_t)r * 512 + kt * 64 + kv * 8; },
             [&](int kt, int r, int kv) { return Bb + (size_t)r * 512 + kt * 64 + kv * 8; }, 8, [](int) {});
  const float* pwb = p.conv_pw_b + l * 512 + nt * 128;
  epilogue_lds(acc, smem, [&](int rl, int c4, float4 v) {
    bf16_t* ptr = CG + (size_t)(mt * 128 + rl) * 512 + nt * 128 + c4;
    const uint2 gv = *(const uint2*)ptr;
    const float4 bb = *(const float4*)(pwb + c4);
    uint2 o;
    o.x = pack2((v.x + bb.x) * silu_f(lo2f(gv.x)), (v.y + bb.y) * silu_f(hi2f(gv.x)));
    o.y = pack2((v.z + bb.z) * silu_f(lo2f(gv.y)), (v.w + bb.w) * silu_f(hi2f(gv.y)));
    *(uint2*)ptr = o;
  });
}

DI void phase_mix(const Params& p, int l, char* smem) {
  const int N_ATT = 512 + (l == 0 ? 32 : 0);
  const int N_ST = NCK * 4;
  const int N_PW = NCK * 4;
  const int NT = N_ATT + N_ST + N_PW;
  for (int it0 = blockIdx.x; it0 < NT; it0 += gridDim.x) {
    int it = it0;
    if (it < N_ATT) {
      if (it < 512) attn_item(p, l, smem, it >> 7, (it >> 2) & 31, (it >> 1) & 1, it & 1, false);
      else { const int t = it - 512; attn_item(p, l, smem, t >> 3, (t >> 2) & 1, (t >> 1) & 1, t & 1, true); }
      continue;
    }
    it -= N_ATT;
    if (it < N_ST) { states_item(p, smem, it >> 2, (it >> 1) & 1, it & 1); continue; }
    it -= N_ST;
    pw_item(p, l, smem, it >> 2, it & 3);
  }
}

DI void phase_scan(const Params& p_in) {
  const Params p = load_params();

  bf16_t* ST = (bf16_t*)(p.ws + OFF_ST);
  const float* CDEC = (const float*)(p.ws + OFF_CDEC);
  for (int it = blockIdx.x; it < 512; it += gridDim.x) {
    const int e = it * 256 + threadIdx.x;
    const int bdh = e >> 10, v8 = e & 1023;
    const int b = bdh >> 5, d = (bdh >> 4) & 1, h = bdh & 15;
    float s[8];
#pragma unroll
    for (int i = 0; i < 8; ++i) s[i] = 0.f;
    auto ckof = [&](int i) {
      if (d == 0) return (i < 2) ? (128 + 2 * b + i) : (32 * b + (i - 2));
      return (i < 2) ? (128 + 2 * b + (1 - i)) : (32 * b + 31 - (i - 2));
    };
    auto pof = [&](int i) { const int ck = ckof(i); return (uint4*)(ST + ((size_t)(ck * 2 + d) * 16 + h) * 8192 + v8 * 8); };
    auto dof = [&](int i) { const int ck = ckof(i); return CDEC[(ck * 2 + d) * 16 + h]; };
    uint4 buf[4]; float dc[4];
#pragma unroll
    for (int i = 0; i < 3; ++i) { buf[i] = *pof(i); dc[i] = dof(i); }
#pragma unroll
    for (int i = 0; i < 34; ++i) {
      if (i + 3 < 34) { buf[(i + 3) & 3] = *pof(i + 3); dc[(i + 3) & 3] = dof(i + 3); }
      const uint4 cur = buf[i & 3];
      const float dec = dc[i & 3];
      uint4 o;
      o.x = pack2(s[0], s[1]); o.y = pack2(s[2], s[3]); o.z = pack2(s[4], s[5]); o.w = pack2(s[6], s[7]);
      *pof(i) = o;
      s[0] = s[0] * dec + lo2f(cur.x); s[1] = s[1] * dec + hi2f(cur.x);
      s[2] = s[2] * dec + lo2f(cur.y); s[3] = s[3] * dec + hi2f(cur.y);
      s[4] = s[4] * dec + lo2f(cur.z); s[5] = s[5] * dec + hi2f(cur.z);
      s[6] = s[6] * dec + lo2f(cur.w); s[7] = s[7] * dec + hi2f(cur.w);
    }
  }
}

DI void phase_ssdy(const Params& p_in, int l, char* smem) {
  const Params p = load_params();

  bf16_t* sB = (bf16_t*)smem;
  bf16_t* sX = (bf16_t*)(smem + 128 * 136 * 2);
  float* sF = (float*)(smem + 128 * 136 * 2 + 128 * 72 * 2);
  float* sSS = sF + 512;
  int tid = threadIdx.x; asm volatile("" : "+v"(tid)); const int lane = tid & 63, wave = tid >> 6, fr = lane & 31, fh = lane >> 5;
  const int wl = wave >> 1, w2 = wave & 1;
  const bf16_t* BC = (const bf16_t*)(p.ws + OFF_BC);
  const bf16_t* XS = (const bf16_t*)(p.ws + OFF_H);
  const float* DT = (const float*)(p.ws + OFF_DT);
  const float* CS = (const float*)(p.ws + OFF_CS);
  const bf16_t* ST = (const bf16_t*)(p.ws + OFF_ST);
  bf16_t* Z = (bf16_t*)(p.ws + OFF_Z);
  float* RSTD = (float*)(p.ws + OFF_RSTD);
  const int nck = (l == 0) ? NCK : 128;
  for (int it = blockIdx.x; it < nck * 4; it += gridDim.x) {
    const int ck = it >> 2, g = (it >> 1) & 1, lh = it & 1;
    const int row0 = ck * 128;
    const int lbase = lh * 64 + wl * 32;
    __syncthreads();
    for (int v = tid; v < 2048; v += 256) {
      const int r = v >> 4, cv = v & 15;
      *(uint4*)&sB[r * 136 + cv * 8] = *(const uint4*)(BC + (size_t)(row0 + r) * 512 + g * 128 + cv * 8);
    }
    if (tid < 64) sSS[tid] = 0.f;
    const bf16_t* cptr = BC + (size_t)(row0 + lbase + fr) * 512 + 256 + g * 128 + fh * 8;
    bf16x8 cf[8];
#pragma unroll
    for (int ks = 0; ks < 8; ++ks) cf[ks] = *(const bf16x8*)(cptr + ks * 16);
    const int lrx = tid >> 3, cvx = tid & 7;
    const bf16_t* xsrc = XS + (size_t)(row0 + lrx) * 1024 + cvx * 8;
    uint4 xp0, xp1, xp2, xp3;
    float fp0 = 0.f, fp1 = 0.f, fp2 = 0.f, fp3 = 0.f;
    {
      const int head = g * 8;
      xp0 = *(const uint4*)(xsrc + head * 64);
      xp1 = *(const uint4*)(xsrc + head * 64 + 32 * 1024);
      xp2 = *(const uint4*)(xsrc + head * 64 + 64 * 1024);
      xp3 = *(const uint4*)(xsrc + head * 64 + 96 * 1024);
      if (tid < 128) {
        const size_t rho = (size_t)(row0 + tid);
        fp0 = CS[rho * 32 + head]; fp1 = CS[rho * 32 + 16 + head]; fp2 = DT[rho * 32 + head]; fp3 = DT[rho * 32 + 16 + head];
      }
    }
    __syncthreads();
    f32x16 cb[2];
#pragma unroll
    for (int j = 0; j < 2; ++j) {
#pragma unroll
      for (int r = 0; r < 16; ++r) cb[j][r] = 0.f;
#pragma unroll
      for (int ks = 0; ks < 8; ++ks) {
        const bf16x8 bq = *(const bf16x8*)&sB[(w2 * 64 + j * 32 + fr) * 136 + ks * 16 + fh * 8];
        cb[j] = MFMA(cf[ks], bq, cb[j]);
      }
    }
    const int pidx = w2 * 32 + fr;
    bf16_t* sCB = sB + 64 * 136;
    __syncthreads();
#pragma unroll
    for (int j = 0; j < 2; ++j)
#pragma unroll
      for (int r = 0; r < 16; ++r) sCB[(wl * 32 + crow(r, fh)) * 136 + w2 * 64 + j * 32 + fr] = f2bf(cb[j][r]);
#pragma unroll 1
    for (int hh = 0; hh < 8; ++hh) {
      const int head = g * 8 + hh;
      __syncthreads();
      *(uint4*)&sX[lrx * 72 + cvx * 8] = xp0;
      *(uint4*)&sX[(lrx + 32) * 72 + cvx * 8] = xp1;
      *(uint4*)&sX[(lrx + 64) * 72 + cvx * 8] = xp2;
      *(uint4*)&sX[(lrx + 96) * 72 + cvx * 8] = xp3;
      if (tid < 128) { sF[tid] = fp0; sF[128 + tid] = fp1; sF[256 + tid] = fp2; sF[384 + tid] = fp3; }
      const bf16_t* S0 = ST + ((size_t)(ck * 2 + 0) * 16 + head) * 8192 + (w2 * 32 + fr) * 128 + fh * 8;
      const bf16_t* S1 = ST + ((size_t)(ck * 2 + 1) * 16 + head) * 8192 + (w2 * 32 + fr) * 128 + fh * 8;
      bf16x8 sf0[8];
#pragma unroll
      for (int ks = 0; ks < 8; ++ks) sf0[ks] = *(const bf16x8*)(S0 + ks * 16);
      bf16_t* zbase = Z + (size_t)(row0 + lbase + 4 * fh) * 1024 + head * 64 + pidx;
      if (hh < 7) {
        const int hn = head + 1;
        xp0 = *(const uint4*)(xsrc + hn * 64);
        xp1 = *(const uint4*)(xsrc + hn * 64 + 32 * 1024);
        xp2 = *(const uint4*)(xsrc + hn * 64 + 64 * 1024);
        xp3 = *(const uint4*)(xsrc + hn * 64 + 96 * 1024);
        if (tid < 128) {
          const size_t rho = (size_t)(row0 + tid);
          fp0 = CS[rho * 32 + hn]; fp1 = CS[rho * 32 + 16 + hn]; fp2 = DT[rho * 32 + hn]; fp3 = DT[rho * 32 + 16 + hn];
        }
      }
      __syncthreads();
#pragma unroll
      for (int j = 0; j < 2; ++j) {
        const int sidx = w2 * 64 + j * 32 + fr;
        const float csf_s = sF[sidx], csb_s = sF[128 + sidx], dtf_s = sF[256 + sidx], dtb_s = sF[384 + sidx];
#pragma unroll 4
        for (int r = 0; r < 16; ++r) {
          const int lidx = lbase + crow(r, fh);
          float f = 0.f;
          if (sidx <= lidx) f += __expf(sF[lidx] - csf_s) * dtf_s;
          if (sidx >= lidx) f += __expf(sF[128 + lidx] - csb_s) * dtb_s;
          sB[(wl * 32 + crow(r, fh)) * 136 + sidx] = f2bf(bf2f(sCB[(wl * 32 + crow(r, fh)) * 136 + sidx]) * f);
        }
      }
      __syncthreads();
      bf16x8 sf1[8], cfh[8];
#pragma unroll
      for (int ks = 0; ks < 8; ++ks) { sf1[ks] = *(const bf16x8*)(S1 + ks * 16); cfh[ks] = *(const bf16x8*)(cptr + ks * 16); }
      unsigned short zv[16];
#pragma unroll
      for (int r = 0; r < 16; ++r) zv[r] = zbase[(size_t)((r & 3) + 8 * (r >> 2)) * 1024];
      f32x16 accy;
#pragma unroll
      for (int r = 0; r < 16; ++r) accy[r] = 0.f;
#pragma unroll
      for (int ks = 0; ks < 8; ++ks) {
        const bf16x8 af = *(const bf16x8*)&sB[(wl * 32 + fr) * 136 + ks * 16 + fh * 8];
        const bf16x8 xf = tr_frag(sX, 72, ks * 16 + 8 * fh, ks * 16 + 8 * fh + 4, w2 * 32);
        accy = MFMA(af, xf, accy);
      }
      {
        f32x16 acct;
#pragma unroll
        for (int r = 0; r < 16; ++r) acct[r] = 0.f;
#pragma unroll
        for (int ks = 0; ks < 8; ++ks) acct = MFMA(cfh[ks], sf0[ks], acct);
#pragma unroll
        for (int r = 0; r < 16; ++r) accy[r] += __expf(sF[lbase + crow(r, fh)]) * acct[r];
#pragma unroll
        for (int r = 0; r < 16; ++r) acct[r] = 0.f;
#pragma unroll
        for (int ks = 0; ks < 8; ++ks) acct = MFMA(cfh[ks], sf1[ks], acct);
#pragma unroll
        for (int r = 0; r < 16; ++r) accy[r] += __expf(sF[128 + lbase + crow(r, fh)]) * acct[r];
      }
      const float dsk = p.ssd_d[l * 16 + head];
      float v[16];
#pragma unroll
      for (int r = 0; r < 16; ++r) {
        const int lidx = lbase + crow(r, fh);
        const float xv = bf2f(sX[lidx * 72 + pidx]);
        const float y = accy[r] + dsk * xv;
        const float u = y * silu_f(bf2f(zv[r]));
        v[r] = u * u;
        zbase[(size_t)((r & 3) + 8 * (r >> 2)) * 1024] = f2bf(u);
      }
#pragma unroll
      for (int i = 0; i < 8; ++i) { const bool up = (fr & 16) != 0; const float keep = up ? v[i + 8] : v[i]; const float send = up ? v[i] : v[i + 8]; v[i] = keep + __shfl_xor(send, 16); }
#pragma unroll
      for (int i = 0; i < 4; ++i) { const bool up = (fr & 8) != 0; const float keep = up ? v[i + 4] : v[i]; const float send = up ? v[i] : v[i + 4]; v[i] = keep + __shfl_xor(send, 8); }
#pragma unroll
      for (int i = 0; i < 2; ++i) { const bool up = (fr & 4) != 0; const float keep = up ? v[i + 2] : v[i]; const float send = up ? v[i] : v[i + 2]; v[i] = keep + __shfl_xor(send, 4); }
      { const bool up = (fr & 2) != 0; const float keep = up ? v[1] : v[0]; const float send = up ? v[0] : v[1]; v[0] = keep + __shfl_xor(send, 2); }
      v[0] += __shfl_xor(v[0], 1);
      if ((fr & 1) == 0) atomicAdd(&sSS[wl * 32 + crow(fr >> 1, fh)], v[0]);
    }
    __syncthreads();
    if (tid < 64) RSTD[(size_t)(row0 + lh * 64 + tid) * 2 + g] = rsqrtf(sSS[tid] * (1.f / 512.f) + 1e-6f);
  }
}

DI void phase_outproj(const Params& p_in, int l, char* smem) {
  const Params p = load_params();

  GemmS* s = (GemmS*)smem;
  int tid = threadIdx.x; asm volatile("" : "+v"(tid)); const int lane = tid & 63, wave = tid >> 6, wr = wave >> 1, wc = wave & 1, fr = lane & 31, fh = lane >> 5;
  const bf16_t* Zb = (const bf16_t*)(p.ws + OFF_Z);
  const bf16_t* Qb = (const bf16_t*)(p.ws + OFF_Q);
  const bf16_t* Cb = (const bf16_t*)(p.ws + OFF_CG);
  const bf16_t* W = (const bf16_t*)(p.ws + OFF_WOUT);
  const float* RSTD = (const float*)(p.ws + OFF_RSTD);
  const float* mods = (const float*)(p.ws + OFF_MODS);
  float* XC = (float*)(p.ws + OFF_XC);
  const int nM = (l == 0) ? NCK : 128;
  for (int step = 0;; ++step) {
    int mt, nt;
    if (!xcd_tile(step, nM, 8, mt, nt)) break;
    f32x16 acc[2][2];
    zero_acc(acc);
    const bf16_t* Wb = W + (size_t)nt * 128 * 2048;
    const bf16_t* A0 = Zb + (size_t)mt * 128 * 1024;
    const bf16_t* A2 = Qb + (size_t)mt * 128 * 512;
    const bf16_t* A3 = Cb + (size_t)mt * 128 * 512;
    float* sScale = (float*)(smem + 40960);
    if (tid < 128) {
      const size_t row = (size_t)(mt * 128 + tid);
      const float r1 = RSTD[row * 2 + 1];
      sScale[tid * 2] = RSTD[row * 2] / r1;
      sScale[tid * 2 + 1] = r1;
    }
    gemm_core2(acc, (GemmS2*)smem,
               [&](int kt, int r, int kv) {
                 const bf16_t* ptr;
                 if (kt < 16) ptr = A0 + (size_t)r * 1024 + kt * 64;
                 else if (kt < 24) ptr = A2 + (size_t)r * 512 + (kt - 16) * 64;
                 else ptr = A3 + (size_t)r * 512 + (kt - 24) * 64;
                 return ptr + kv * 8;
               },
               [&](int kt, int r, int kv) { return Wb + (size_t)r * 2048 + kt * 64 + kv * 8; }, 32,
               [&](int kt) __attribute__((always_inline)) {
                 if (kt == 8 || kt == 16) {
#pragma unroll
                   for (int i = 0; i < 2; ++i)
#pragma unroll
                     for (int r = 0; r < 16; ++r) {
                       const float f = sScale[(wr * 64 + i * 32 + crow(r, fh)) * 2 + (kt == 16 ? 1 : 0)];
                       acc[i][0][r] *= f; acc[i][1][r] *= f;
                     }
                 }
               });
    {
      const int row0 = mt * 128;
      const int vv = (row0 < RL_) ? (row0 >> 12) : 4;
      const float* gate = mods + (l * 5 + vv) * 3072 + 2048 + nt * 128;
      float* xnew = (row0 < RL_) ? (p.out + (size_t)row0 * 1024) : (XC + (size_t)(row0 - RL_) * 1024);
      const float* xold = (l == 0) ? ((row0 < RL_) ? (p.x + (size_t)row0 * 1024) : (p.ctx + (size_t)(row0 - RL_) * 1024)) : xnew;
      epilogue_lds(acc, smem, [&](int rl, int c4, float4 v) {
        const int off = rl * 1024 + nt * 128 + c4;
        const float4 xo = *(const float4*)(xold + off);
        const float4 gt = *(const float4*)(gate + c4);
        float4 o;
        o.x = xo.x + gt.x * v.x; o.y = xo.y + gt.y * v.y; o.z = xo.z + gt.z * v.z; o.w = xo.w + gt.w * v.w;
        *(float4*)(xnew + off) = o;
      });
    }
  }
}

DI void phase_final(const Params& p_in) {
  const Params p = load_params();
  const int lane = threadIdx.x & 63, wave = threadIdx.x >> 6;
  for (int it = blockIdx.x; it < RL_ / 4; it += gridDim.x) {
    float* xr = p.out + (size_t)(it * 4 + wave) * 1024;
    float4 xv[4];
    float ss = 0.f;
#pragma unroll
    for (int i = 0; i < 4; ++i) {
      xv[i] = *(const float4*)(xr + lane * 4 + i * 256);
      ss += xv[i].x * xv[i].x + xv[i].y * xv[i].y + xv[i].z * xv[i].z + xv[i].w * xv[i].w;
    }
#pragma unroll
    for (int o = 32; o >= 1; o >>= 1) ss += __shfl_xor(ss, o);
    const float rs = rsqrtf(ss * (1.f / 1024.f) + 1e-6f);
#pragma unroll
    for (int i = 0; i < 4; ++i) {
      const float4 w = *(const float4*)(p.final_norm_w + lane * 4 + i * 256);
      float4 o;
      o.x = xv[i].x * rs * w.x; o.y = xv[i].y * rs * w.y; o.z = xv[i].z * rs * w.z; o.w = xv[i].w * rs * w.w;
      *(float4*)(xr + lane * 4 + i * 256) = o;
    }
  }
}

template <int PH>
DI void run_phase(const Params& p, char* smem) {
  constexpr int l = (PH - 1) / 7, s = (PH - 1) % 7;
  if constexpr (PH == 0) phase_mods(p, smem);
  else if constexpr (PH == 15) phase_final(p);
  else if constexpr (s == 0) phase_prep(p, l, smem);
  else if constexpr (s == 1) phase_inproj(p, smem);
  else if constexpr (s == 2) phase_local(p, l, smem);
  else if constexpr (s == 3) phase_mix(p, l, smem);
  else if constexpr (s == 4) phase_scan(p);
  else if constexpr (s == 5) phase_ssdy(p, l, smem);
  else phase_outproj(p, l, smem);
}

#if PROBE_S >= 0
#define PROBE_BEGIN() if (threadIdx.x == 0) pst[1] = wall_clock64();
#define PROBE_END(PH) if (threadIdx.x == 0 && (PH) >= 1 && (PH) <= 14 && (((PH) - 1) % 7) == PROBE_S) pst[0] += wall_clock64() - pst[1];
#else
#define PROBE_BEGIN()
#define PROBE_END(PH)
#endif
#define PHASE(PH) PROBE_BEGIN() run_phase<PH>(p, smem); xcd_barrier(xst); PROBE_END(PH)

__global__ void __launch_bounds__(256, 2) fwd_megakernel(Params p) {
  __shared__ __attribute__((aligned(16))) char smem[57344];
  cg::grid_group grid = cg::this_grid();
#if PROBE_S >= 0
  volatile unsigned long long* pst = (volatile unsigned long long*)(smem + 57344 - 16);
  if (threadIdx.x == 0) { pst[0] = 0; pst[1] = 0; }
#endif
  __shared__ uint4 xb_words;
  volatile LAS unsigned* xst = (volatile LAS unsigned*)&xb_words;
  if (threadIdx.x == 0) xb_words = make_uint4(0u, 0u, 0u, 0u);
  run_phase<0>(p, smem);
  grid.sync();
  if (threadIdx.x == 0) { unsigned* bar = (unsigned*)(load_params().ws + OFF_BAR); (void)xb_add(&bar[XB_XCNT(xb_xcc_id())], 1u); }
  PHASE(1) PHASE(2) PHASE(3) PHASE(4) PHASE(5) PHASE(6) PHASE(7)
  PHASE(8) PHASE(9) PHASE(10) PHASE(11) PHASE(12) PHASE(13) PHASE(14)
  run_phase<15>(p, smem);
#if PROBE_S >= 0
  if (blockIdx.x == 0 && threadIdx.x == 0) {
    const unsigned long long t1 = wall_clock64();
    const unsigned long long lim = 4ull * pst[0];
    while (wall_clock64() - t1 < lim) { __builtin_amdgcn_s_sleep(32); }
  }
#endif
}

extern "C" void kernel_launch(void* const* d_in, const int* in_sizes, int n_in, void* d_out, int out_size, void* d_ws,
                              size_t ws_size, hipStream_t stream) {
  static int grid_blocks = 0;
  if (!grid_blocks) {
    int dev = 0, cus = 0, per_cu = 0;
    hipGetDevice(&dev);
    hipDeviceGetAttribute(&cus, hipDeviceAttributeMultiprocessorCount, dev);
    hipOccupancyMaxActiveBlocksPerMultiprocessor(&per_cu, fwd_megakernel, 256, 0);
    if (per_cu < 1) per_cu = 1;
    if (per_cu > 2) per_cu = 2;
    grid_blocks = (cus * per_cu) & ~7;
  }
  Params p{};
  const float** pp = (const float**)&p;
  for (int i = 0; i < 23; ++i) pp[i] = (const float*)d_in[i];
  p.out = (float*)d_out;
  p.ws = (char*)d_ws;
  void* args[] = {&p};
  hipError_t e = hipLaunchCooperativeKernel((void*)fwd_megakernel, dim3(grid_blocks), dim3(256), args, 0, stream);
  if (e != hipSuccess) fprintf(stderr, "cooperative launch failed: %s (grid %d)\n", hipGetErrorString(e), grid_blocks);
}
```

```cpp
#include <hip/hip_runtime.h>
#include <hip/hip_cooperative_groups.h>
#include <stdint.h>
#include <stdio.h>
namespace cg = cooperative_groups;

#ifndef ONE_LAUNCH
#define ONE_LAUNCH 1
#endif

#ifndef PROBE_S
#define PROBE_S -1
#endif
#define DI __device__ __forceinline__
typedef unsigned short bf16_t;
using bf16x8 = __attribute__((ext_vector_type(8))) short;
using s16x4 = __attribute__((ext_vector_type(4))) short;
using f32x16 = __attribute__((ext_vector_type(16))) float;
#define MFMA(a, b, c) __builtin_amdgcn_mfma_f32_32x32x16_bf16((a), (b), (c), 0, 0, 0)

constexpr int R_ = 17408;
constexpr int RL_ = 16384;
constexpr int NCK = 136;

constexpr size_t SZ_WIN = (size_t)5504 * 1024 * 2;
constexpr size_t SZ_WOUT = (size_t)1024 * 2048 * 2;
constexpr size_t SZ_PW = (size_t)512 * 512 * 2;
constexpr size_t SZ_MODS = (size_t)2 * 5 * 3072 * 4;
constexpr size_t SZ_XC = (size_t)1024 * 1024 * 4;
constexpr size_t SZ_RSTD = (size_t)R_ * 2 * 4;
constexpr size_t SZ_CDEC = (size_t)NCK * 32 * 4 + 256 - ((size_t)NCK * 32 * 4) % 256;
constexpr size_t SZ_R512 = (size_t)R_ * 512 * 2;
constexpr size_t OFF_WIN = 0;
constexpr size_t OFF_WOUT = OFF_WIN + SZ_WIN;
constexpr size_t OFF_PW = OFF_WOUT + SZ_WOUT;
constexpr size_t OFF_MODS = OFF_PW + SZ_PW;
constexpr size_t OFF_XC = OFF_MODS + SZ_MODS;
constexpr size_t OFF_RSTD = OFF_XC + SZ_XC;
constexpr size_t OFF_CDEC = OFF_RSTD + SZ_RSTD;
constexpr size_t OFF_H = OFF_CDEC + SZ_CDEC;
constexpr size_t OFF_XBC = OFF_H + 2 * SZ_R512;
constexpr size_t OFF_GLU = OFF_XBC + 3 * SZ_R512;
constexpr size_t OFF_ST = OFF_XBC;
constexpr size_t OFF_Z = OFF_GLU + SZ_R512;
constexpr size_t OFF_DT = OFF_Z + 2 * SZ_R512;
constexpr size_t OFF_CS = OFF_DT + (size_t)R_ * 32 * 4;
constexpr size_t OFF_Q = OFF_CS + (size_t)R_ * 32 * 4;
constexpr size_t OFF_KV = OFF_Q + SZ_R512;
constexpr size_t OFF_AG = OFF_KV + SZ_R512 / 2;
constexpr size_t OFF_CG = OFF_AG + SZ_R512;
constexpr size_t OFF_BC = OFF_CG + SZ_R512;
constexpr size_t OFF_HDN = OFF_BC + SZ_R512;
constexpr size_t WS_TOTAL = OFF_HDN + SZ_R512;
constexpr size_t OFF_BAR = WS_TOTAL;
static_assert(OFF_BAR + 16384 <= (size_t)256 * 1024 * 1024, "workspace too large");

struct Params {
  const float *x, *c, *ctx, *c_ctx, *w_mod, *b_mod, *norm_w, *w_in, *ssd_conv_w, *ssd_conv_b, *ssd_dt_bias, *ssd_a_log,
      *ssd_d, *ssd_norm_w, *attn_sink, *conv_dw_w, *conv_dw_b, *conv_ln_w, *conv_ln_b, *conv_pw_w, *conv_pw_b, *w_out,
      *final_norm_w;
  float* out;
  char* ws;
};


DI Params load_params() {
  typedef const char __attribute__((address_space(4)))* kptr_t;
  typedef const float* const __attribute__((address_space(4)))* kfld_t;
  size_t off = 0;
  asm volatile("" : "+s"(off));
  kptr_t base = (kptr_t)__builtin_amdgcn_kernarg_segment_ptr() + off;
  Params p;
  const float** pp = (const float**)&p;
#pragma unroll
  for (int i = 0; i < 25; ++i) pp[i] = *(kfld_t)(base + 8 * i);
  return p;
}

#define XB_TMO      128
#define XB_XCNT(j)  (256  + 64 * (j))
#define XB_XSUB(j)  (1280 + 64 * (j))
#define XB_XGEN(j)  (2304 + 64 * (j))
#define XB_TOP      3328
#define XB_TOPGEN   3392
#define XCD_BAR_WORDS 3456
#define XB_SPIN_CAP (1u << 18)
#define LAS __attribute__((address_space(3)))
DI unsigned xb_ld(unsigned* p)              { return __hip_atomic_load(p, __ATOMIC_RELAXED, __HIP_MEMORY_SCOPE_AGENT); }
DI unsigned xb_add(unsigned* p, unsigned v) { return __hip_atomic_fetch_add(p, v, __ATOMIC_RELAXED, __HIP_MEMORY_SCOPE_AGENT); }
DI unsigned xb_xcc_id() { return (unsigned)__builtin_amdgcn_s_getreg((3 << 11) | 20) & 0xFu; }
#define XB_SPIN(cond, bar) do { unsigned _sp = 0; while (cond) { __builtin_amdgcn_s_sleep(1); \
    if ((++_sp & 255u) == 0u) { if (xb_ld(&(bar)[XB_TMO])) break; if (_sp > XB_SPIN_CAP) { atomicAdd(&(bar)[XB_TMO], 1u); break; } } } } while (0)

DI void xcd_barrier_complete(unsigned* bar, unsigned x, unsigned& nloc, unsigned& nx) {
  const unsigned G = gridDim.x * gridDim.y * gridDim.z;
  unsigned sum, cnt, mine, sp = 0u;
  for (;;) {
    sum = 0u; cnt = 0u; mine = 0u;
#pragma unroll
    for (unsigned j = 0; j < 16; ++j) { const unsigned c = xb_ld(&bar[XB_XCNT(j)]); sum += c; cnt += (c > 0u) ? 1u : 0u; mine = (j == x) ? c : mine; }
    if (sum == G) break;
    __builtin_amdgcn_s_sleep(1);
    if ((++sp & 255u) == 0u) { if (xb_ld(&bar[XB_TMO])) break; if (sp > XB_SPIN_CAP) { atomicAdd(&bar[XB_TMO], 1u); break; } }
  }
  nloc = mine > 0u ? mine : 1u; nx = cnt > 0u ? cnt : 1u;
}

DI void xcd_barrier(volatile LAS unsigned* st) {
  asm volatile("s_waitcnt vmcnt(0)" ::: "memory");
  __syncthreads();
  if (threadIdx.x == 0) {
    const Params pb = load_params();
    unsigned* bar = (unsigned*)(pb.ws + OFF_BAR);
    const unsigned x = xb_xcc_id();
    __builtin_amdgcn_s_waitcnt(0);
    unsigned nloc = st[0], nx = st[1];
    if (nloc == 0u) { xcd_barrier_complete(bar, x, nloc, nx); st[0] = nloc; st[1] = nx; }
    const unsigned old = xb_add(&bar[XB_XSUB(x)], 1u);
    const unsigned gen = old / nloc;
    if (old + 1u == (gen + 1u) * nloc) {
      __builtin_amdgcn_fence(__ATOMIC_RELEASE, "agent");
      asm volatile("s_waitcnt vmcnt(0)" ::: "memory");
      const unsigned og = xb_add(&bar[XB_TOP], 1u);
      const unsigned tg = og / nx;
      if (og + 1u == (tg + 1u) * nx) xb_add(&bar[XB_TOPGEN], 1u);
      else XB_SPIN(xb_ld(&bar[XB_TOPGEN]) == tg, bar);
      __builtin_amdgcn_fence(__ATOMIC_ACQUIRE, "agent");
      xb_add(&bar[XB_XGEN(x)], 1u);
      asm volatile("s_waitcnt vmcnt(0)" ::: "memory");
    } else {
      XB_SPIN(xb_ld(&bar[XB_XGEN(x)]) == gen, bar);
      __builtin_amdgcn_fence(__ATOMIC_ACQUIRE, "agent");
      asm volatile("s_waitcnt vmcnt(0)" ::: "memory");
    }
  }
  __syncthreads();
}

DI unsigned short f2bf(float x) { unsigned u = __float_as_uint(x); u += 0x7fffu + ((u >> 16) & 1u); return (unsigned short)(u >> 16); }
DI float bf2f(unsigned short b) { return __uint_as_float(((unsigned)b) << 16); }
DI unsigned pack2(float a, float b) { return (unsigned)f2bf(a) | ((unsigned)f2bf(b) << 16); }
DI float lo2f(unsigned u) { return __uint_as_float(u << 16); }
DI float hi2f(unsigned u) { return __uint_as_float(u & 0xffff0000u); }
DI float silu_f(float x) { return x / (1.f + __expf(-x)); }
DI float sigmoid_f(float x) { return 1.f / (1.f + __expf(-x)); }
DI int crow(int reg, int h) { return (reg & 3) + 8 * (reg >> 2) + 4 * h; }

DI bf16x8 tr_frag(const bf16_t* s, int ld, int row_lo, int row_hi, int col0) {
  const int lane = threadIdx.x & 63;
  const int i16 = lane & 15, q = i16 >> 2, pp = i16 & 3, blk = (lane >> 4) & 1;
  const unsigned a0 = (unsigned)(size_t)(s + (row_lo + q) * ld + col0 + 16 * blk + 4 * pp);
  const unsigned a1 = (unsigned)(size_t)(s + (row_hi + q) * ld + col0 + 16 * blk + 4 * pp);
  s16x4 lo, hi;
  asm volatile("ds_read_b64_tr_b16 %0, %2\n\tds_read_b64_tr_b16 %1, %3\n\ts_waitcnt lgkmcnt(0)"
               : "=&v"(lo), "=&v"(hi) : "v"(a0), "v"(a1) : "memory");
  return __builtin_shufflevector(lo, hi, 0, 1, 2, 3, 4, 5, 6, 7);
}

struct GemmS { bf16_t a[2][128][40]; bf16_t b[2][128][40]; };

template <class AF, class BF>
DI void gemm_core(f32x16 (&acc)[2][2], GemmS* s, AF aptr, BF bptr, int nk) {
  int tid = threadIdx.x; asm volatile("" : "+v"(tid)); const int lane = tid & 63, wave = tid >> 6, wr = wave >> 1, wc = wave & 1;
  const int r0 = tid >> 2, kv = tid & 3;
  const int fr = lane & 31, fh = lane >> 5;
  uint4 ra0 = *(const uint4*)aptr(0, r0, kv), ra1 = *(const uint4*)aptr(0, r0 + 64, kv);
  uint4 rb0 = *(const uint4*)bptr(0, r0, kv), rb1 = *(const uint4*)bptr(0, r0 + 64, kv);
  *(uint4*)&s->a[0][r0][kv * 8] = ra0; *(uint4*)&s->a[0][r0 + 64][kv * 8] = ra1;
  *(uint4*)&s->b[0][r0][kv * 8] = rb0; *(uint4*)&s->b[0][r0 + 64][kv * 8] = rb1;
  __syncthreads();
#pragma unroll 1
  for (int kt = 0; kt < nk; ++kt) {
    const int buf = kt & 1;
    if (kt + 1 < nk) {
      ra0 = *(const uint4*)aptr(kt + 1, r0, kv); ra1 = *(const uint4*)aptr(kt + 1, r0 + 64, kv);
      rb0 = *(const uint4*)bptr(kt + 1, r0, kv); rb1 = *(const uint4*)bptr(kt + 1, r0 + 64, kv);
    }
#pragma unroll
    for (int ks = 0; ks < 2; ++ks) {
      bf16x8 af[2], bq[2];
#pragma unroll
      for (int i = 0; i < 2; ++i) af[i] = *(const bf16x8*)&s->a[buf][wr * 64 + i * 32 + fr][ks * 16 + fh * 8];
#pragma unroll
      for (int j = 0; j < 2; ++j) bq[j] = *(const bf16x8*)&s->b[buf][wc * 64 + j * 32 + fr][ks * 16 + fh * 8];
#pragma unroll
      for (int i = 0; i < 2; ++i)
#pragma unroll
        for (int j = 0; j < 2; ++j) acc[i][j] = MFMA(af[i], bq[j], acc[i][j]);
    }
    if (kt + 1 < nk) {
      *(uint4*)&s->a[buf ^ 1][r0][kv * 8] = ra0; *(uint4*)&s->a[buf ^ 1][r0 + 64][kv * 8] = ra1;
      *(uint4*)&s->b[buf ^ 1][r0][kv * 8] = rb0; *(uint4*)&s->b[buf ^ 1][r0 + 64][kv * 8] = rb1;
    }
    __syncthreads();
  }
}


struct GemmS2 { bf16_t a[128][72]; bf16_t b[128][72]; };
DI void g2_compute(f32x16 (&acc)[2][2], const GemmS2* s, int wr, int wc, int fr, int fh) {
#pragma unroll
  for (int ks = 0; ks < 4; ++ks) {
    bf16x8 af[2], bq[2];
#pragma unroll
    for (int i = 0; i < 2; ++i) af[i] = *(const bf16x8*)&s->a[wr * 64 + i * 32 + fr][ks * 16 + fh * 8];
#pragma unroll
    for (int j = 0; j < 2; ++j) bq[j] = *(const bf16x8*)&s->b[wc * 64 + j * 32 + fr][ks * 16 + fh * 8];
#pragma unroll
    for (int i = 0; i < 2; ++i)
#pragma unroll
      for (int j = 0; j < 2; ++j) acc[i][j] = MFMA(af[i], bq[j], acc[i][j]);
  }
}

template <class AF, class BF, class HK>
DI void gemm_core2(f32x16 (&acc)[2][2], GemmS2* s, AF aptr, BF bptr, int nk, HK hook) {
  int tid = threadIdx.x; asm volatile("" : "+v"(tid));
  const int lane = tid & 63, wave = tid >> 6, wr = wave >> 1, wc = wave & 1;
  const int r0 = tid >> 3, kc = tid & 7;
  const int fr = lane & 31, fh = lane >> 5;
  uint4 p0a0, p0a1, p0a2, p0a3, p0b0, p0b1, p0b2, p0b3, p1a0, p1a1, p1a2, p1a3, p1b0, p1b1, p1b2, p1b3;
#define G2_LOAD(S, KT) { \
    S##a0 = *(const uint4*)aptr((KT), r0, kc);      S##b0 = *(const uint4*)bptr((KT), r0, kc); \
    S##a1 = *(const uint4*)aptr((KT), r0 + 32, kc); S##b1 = *(const uint4*)bptr((KT), r0 + 32, kc); \
    S##a2 = *(const uint4*)aptr((KT), r0 + 64, kc); S##b2 = *(const uint4*)bptr((KT), r0 + 64, kc); \
    S##a3 = *(const uint4*)aptr((KT), r0 + 96, kc); S##b3 = *(const uint4*)bptr((KT), r0 + 96, kc); }
#define G2_STORE(S) { \
    *(uint4*)&s->a[r0][kc * 8] = S##a0;      *(uint4*)&s->b[r0][kc * 8] = S##b0; \
    *(uint4*)&s->a[r0 + 32][kc * 8] = S##a1; *(uint4*)&s->b[r0 + 32][kc * 8] = S##b1; \
    *(uint4*)&s->a[r0 + 64][kc * 8] = S##a2; *(uint4*)&s->b[r0 + 64][kc * 8] = S##b2; \
    *(uint4*)&s->a[r0 + 96][kc * 8] = S##a3; *(uint4*)&s->b[r0 + 96][kc * 8] = S##b3; }
#define G2_COMPUTE() g2_compute(acc, s, wr, wc, fr, fh);
  G2_LOAD(p0, 0)
  G2_LOAD(p1, 1)
  G2_STORE(p0)
  if (nk > 2) G2_LOAD(p0, 2)
  __syncthreads();
#pragma unroll 1
  for (int kt = 0; kt < nk; kt += 2) {
    hook(kt);
    G2_COMPUTE()
    __syncthreads();
    G2_STORE(p1)
    if (kt + 3 < nk) G2_LOAD(p1, kt + 3)
    __syncthreads();
    hook(kt + 1);
    G2_COMPUTE()
    __syncthreads();
    if (kt + 2 < nk) {
      G2_STORE(p0)
      if (kt + 4 < nk) G2_LOAD(p0, kt + 4)
    }
    __syncthreads();
  }
#undef G2_LOAD
#undef G2_STORE
#undef G2_COMPUTE
}


DI bool xcd_tile(int step, int nM, int nN, int& mt, int& nt) {
  const int xcd = blockIdx.x & 7, nloc = gridDim.x >> 3;
  const int j = (blockIdx.x >> 3) + step * nloc;
  const int mloc = nM >> 3;
  if ((gridDim.x & 7) != 0 || j >= mloc * nN) return false;
  const int per = 8 * nN;
  const int gm = j / per, rem = j - gm * per;
  const int hgt = min(8, mloc - gm * 8);
  const int a = rem % hgt;
  nt = rem / hgt;
  mt = (gm * 8 + a) * 8 + xcd;
  return true;
}

DI void zero_acc(f32x16 (&acc)[2][2]) {
#pragma unroll
  for (int i = 0; i < 2; ++i)
#pragma unroll
    for (int j = 0; j < 2; ++j)
#pragma unroll
      for (int r = 0; r < 16; ++r) acc[i][j][r] = 0.f;
}

template <class EPI>
DI void epilogue_lds(f32x16 (&acc)[2][2], char* smem, EPI epi) {
  float* T = (float*)smem;
  int tid = threadIdx.x; asm volatile("" : "+v"(tid)); const int lane = tid & 63, wave = tid >> 6, wr = wave >> 1, wc = wave & 1, fr = lane & 31, fh = lane >> 5;
#pragma unroll
  for (int i = 0; i < 2; ++i) {
#pragma unroll
    for (int j = 0; j < 2; ++j)
#pragma unroll
      for (int r = 0; r < 16; ++r) T[(wr * 32 + crow(r, fh)) * 132 + wc * 64 + j * 32 + fr] = acc[i][j][r];
    __syncthreads();
#pragma unroll 2
    for (int e = tid; e < 2048; e += 256) {
      const int tr = e >> 5, c4 = (e & 31) * 4;
      const float4 v = *(const float4*)&T[tr * 132 + c4];
      epi((tr >> 5) * 64 + i * 32 + (tr & 31), c4, v);
    }
    __syncthreads();
  }
}

DI void phase_mods(const Params& p_in, char* smem) {
  const Params p = load_params();

  float* ssc = (float*)smem;
  float* red = (float*)(smem + 20480);
  float* mods = (float*)(p.ws + OFF_MODS);
  int tid = threadIdx.x; asm volatile("" : "+v"(tid));
  if (blockIdx.x == 0) { unsigned* bar = (unsigned*)(p.ws + OFF_BAR); for (int i = tid; i < XCD_BAR_WORDS; i += 256) bar[i] = 0u; }
  for (int it = blockIdx.x; it < 96; it += gridDim.x) {
    const int l = it / 48, col0 = (it % 48) * 64;
    __syncthreads();
    for (int e = tid; e < 5120; e += 256) {
      const int v = e >> 10, k = e & 1023;
      const float cv = (v < 4) ? p.c[v * 1024 + k] : p.c_ctx[k];
      ssc[e] = silu_f(cv);
    }
    __syncthreads();
    const int col = tid & 63, kg = tid >> 6;
    float a[5] = {0.f, 0.f, 0.f, 0.f, 0.f};
    const float* w = p.w_mod + (size_t)l * 1024 * 3072 + col0 + col;
    for (int k = kg * 256; k < kg * 256 + 256; k += 8) {
      float wv[8];
#pragma unroll
      for (int u = 0; u < 8; ++u) wv[u] = w[(size_t)(k + u) * 3072];
#pragma unroll
      for (int u = 0; u < 8; ++u)
#pragma unroll
        for (int v = 0; v < 5; ++v) a[v] += ssc[v * 1024 + k + u] * wv[u];
    }
#pragma unroll
    for (int v = 0; v < 5; ++v) red[(kg * 5 + v) * 64 + col] = a[v];
    __syncthreads();
    for (int e = tid; e < 320; e += 256) {
      const int v = e >> 6, cc = e & 63;
      float sum = p.b_mod[l * 3072 + col0 + cc];
      for (int g = 0; g < 4; ++g) sum += red[(g * 5 + v) * 64 + cc];
      mods[(l * 5 + v) * 3072 + col0 + cc] = sum;
    }
  }
}

DI int win_colmap(int n) {
  if (n < 2560) return n;
  if (n < 3840) return n + 32;
  if (n < 4864) {
    const int j = n - 3840, q64 = j >> 6, w = j & 63;
    return (w < 32) ? (3872 + q64 * 32 + w) : (3872 + 512 + q64 * 32 + (w - 32));
  }
  if (n < 5376) return n + 32;
  if (n < 5408) return n - 5376 + 2560;
  return -1;
}

DI void transpose_tile(const float* src, int ldsrc, int kind, const float* rowscale, bf16_t* dst, int lddst, int n0, int k0, float* tile) {
  int tid = threadIdx.x; asm volatile("" : "+v"(tid));
  __syncthreads();
  {
    const int c4 = (tid & 15) * 4, rr = tid >> 4;
    const int n = (kind == 0) ? win_colmap(n0 + c4) : (n0 + c4);
#pragma unroll
    for (int ps = 0; ps < 4; ++ps) {
      const int r = rr + ps * 16, k = k0 + r;
      float4 v = make_float4(0.f, 0.f, 0.f, 0.f);
      if (n >= 0) v = *(const float4*)(src + (size_t)k * ldsrc + n);
      if (rowscale != nullptr && k < 1024) { const float s = rowscale[k]; v.x *= s; v.y *= s; v.z *= s; v.w *= s; }
      tile[r * 65 + c4] = v.x; tile[r * 65 + c4 + 1] = v.y; tile[r * 65 + c4 + 2] = v.z; tile[r * 65 + c4 + 3] = v.w;
    }
  }
  __syncthreads();
  {
    const int k8 = (tid & 7) * 8, nn = tid >> 3;
#pragma unroll
    for (int ps = 0; ps < 2; ++ps) {
      const int r = nn + ps * 32;
      uint4 o;
      o.x = pack2(tile[(k8 + 0) * 65 + r], tile[(k8 + 1) * 65 + r]);
      o.y = pack2(tile[(k8 + 2) * 65 + r], tile[(k8 + 3) * 65 + r]);
      o.z = pack2(tile[(k8 + 4) * 65 + r], tile[(k8 + 5) * 65 + r]);
      o.w = pack2(tile[(k8 + 6) * 65 + r], tile[(k8 + 7) * 65 + r]);
      *(uint4*)(dst + (size_t)(n0 + r) * lddst + k0 + k8) = o;
    }
  }
}

DI void phase_prep(const Params& p_in, int l, char* smem) {
  const Params p = load_params();

  int tid = threadIdx.x; asm volatile("" : "+v"(tid)); const int lane = tid & 63, wave = tid >> 6;
  const float* mods = (const float*)(p.ws + OFF_MODS);
  bf16_t* H = (bf16_t*)(p.ws + OFF_H);
  const int NT_WIN = 86 * 16, NT_WOUT = 16 * 32, NT_PW = 64, NT_CONV = NT_WIN + NT_WOUT + NT_PW;
  const int NT = NT_CONV + R_ / 4;
  for (int it = blockIdx.x; it < NT; it += gridDim.x) {
    if (it < NT_WIN) {
      transpose_tile(p.w_in + (size_t)l * 1024 * 5408, 5408, 0, nullptr, (bf16_t*)(p.ws + OFF_WIN), 1024, (it / 16) * 64, (it % 16) * 64, (float*)smem);
    } else if (it < NT_WIN + NT_WOUT) {
      const int t = it - NT_WIN;
      transpose_tile(p.w_out + (size_t)l * 2048 * 1024, 1024, 1, p.ssd_norm_w + l * 1024, (bf16_t*)(p.ws + OFF_WOUT), 2048, (t / 32) * 64, (t % 32) * 64, (float*)smem);
    } else if (it < NT_CONV) {
      const int t = it - NT_WIN - NT_WOUT;
      transpose_tile(p.conv_pw_w + (size_t)l * 512 * 512, 512, 1, nullptr, (bf16_t*)(p.ws + OFF_PW), 512, (t / 8) * 64, (t % 8) * 64, (float*)smem);
    } else {
      const int rho = (it - NT_CONV) * 4 + wave;
      const float* xs;
      if (l == 0) xs = (rho < RL_) ? (p.x + (size_t)rho * 1024) : (p.ctx + (size_t)(rho - RL_) * 1024);
      else xs = (rho < RL_) ? (p.out + (size_t)rho * 1024) : ((const float*)(p.ws + OFF_XC) + (size_t)(rho - RL_) * 1024);
      const int v = (rho < RL_) ? (rho >> 12) : 4;
      const float* md = mods + (l * 5 + v) * 3072;
      float4 xv[4], nwv[4], shv[4], scv4[4];
      float ss = 0.f;
#pragma unroll
      for (int i = 0; i < 4; ++i) {
        const int cidx = lane * 4 + i * 256;
        xv[i] = *(const float4*)(xs + cidx);
        nwv[i] = *(const float4*)(p.norm_w + l * 1024 + cidx);
        shv[i] = *(const float4*)(md + cidx);
        scv4[i] = *(const float4*)(md + 1024 + cidx);
      }
#pragma unroll
      for (int i = 0; i < 4; ++i) ss += xv[i].x * xv[i].x + xv[i].y * xv[i].y + xv[i].z * xv[i].z + xv[i].w * xv[i].w;
#pragma unroll
      for (int o = 32; o >= 1; o >>= 1) ss += __shfl_xor(ss, o);
      const float rs = rsqrtf(ss * (1.f / 1024.f) + 1e-6f);
#pragma unroll
      for (int i = 0; i < 4; ++i) {
        const int cidx = lane * 4 + i * 256;
        const float4 nw = nwv[i], sh = shv[i], sc = scv4[i];
        uint2 o;
        o.x = pack2(xv[i].x * rs * nw.x * (1.f + sc.x) + sh.x, xv[i].y * rs * nw.y * (1.f + sc.y) + sh.y);
        o.y = pack2(xv[i].z * rs * nw.z * (1.f + sc.z) + sh.z, xv[i].w * rs * nw.w * (1.f + sc.w) + sh.w);
        *(uint2*)(H + (size_t)rho * 1024 + cidx) = o;
      }
    }
  }
}

DI void phase_inproj(const Params& p_in, char* smem) {
  const Params p = load_params();

  GemmS* s = (GemmS*)smem;
  int tid = threadIdx.x; asm volatile("" : "+v"(tid)); const int lane = tid & 63, wave = tid >> 6, wr = wave >> 1, wc = wave & 1, fr = lane & 31, fh = lane >> 5;
  const bf16_t* H = (const bf16_t*)(p.ws + OFF_H);
  const bf16_t* W = (const bf16_t*)(p.ws + OFF_WIN);
  for (int step = 0;; ++step) {
    int mt, nt;
    if (!xcd_tile(step, NCK, 43, mt, nt)) break;
    f32x16 acc[2][2];
    zero_acc(acc);
    const bf16_t* Ab = H + (size_t)mt * 128 * 1024;
    const bf16_t* Bb = W + (size_t)nt * 128 * 1024;
    gemm_core2(acc, (GemmS2*)smem,
               [&](int kt, int r, int kv) { return Ab + (size_t)r * 1024 + kt * 64 + kv * 8; },
               [&](int kt, int r, int kv) { return Bb + (size_t)r * 1024 + kt * 64 + kv * 8; }, 16, [](int) {});
    const int row0 = mt * 128;
    if (nt >= 30 && nt < 38) {
#pragma unroll
      for (int i = 0; i < 2; ++i)
#pragma unroll
        for (int r = 0; r < 16; ++r) acc[i][0][r] = acc[i][0][r] * sigmoid_f(acc[i][1][r]);
      bf16_t* G = (bf16_t*)(p.ws + OFF_GLU);
      const int cb0 = (nt - 30) * 64;
      epilogue_lds(acc, smem, [&](int rl, int c4, float4 v) {
        if ((c4 & 32) == 0) {
          uint2 o; o.x = pack2(v.x, v.y); o.y = pack2(v.z, v.w);
          *(uint2*)(G + (size_t)(row0 + rl) * 512 + cb0 + (c4 >> 6) * 32 + (c4 & 31)) = o;
        }
      });
    } else if (nt == 42) {
      float* DT = (float*)(p.ws + OFF_DT);
      epilogue_lds(acc, smem, [&](int rl, int c4, float4 v) {
        if (c4 < 32) *(float4*)(DT + (size_t)(row0 + rl) * 32 + c4) = v;
      });
    } else {
      bf16_t* dst; int ld, cb;
      if (nt < 12) { dst = (bf16_t*)(p.ws + OFF_XBC); ld = 1536; cb = nt * 128; }
      else if (nt < 20) { dst = (bf16_t*)(p.ws + OFF_Z); ld = 1024; cb = nt * 128 - 1536; }
      else if (nt < 24) { dst = (bf16_t*)(p.ws + OFF_Q); ld = 512; cb = nt * 128 - 2560; }
      else if (nt < 26) { dst = (bf16_t*)(p.ws + OFF_KV); ld = 256; cb = nt * 128 - 3072; }
      else if (nt < 30) { dst = (bf16_t*)(p.ws + OFF_AG); ld = 512; cb = nt * 128 - 3328; }
      else { dst = (bf16_t*)(p.ws + OFF_CG); ld = 512; cb = nt * 128 - 4864; }
      epilogue_lds(acc, smem, [&](int rl, int c4, float4 v) {
        uint2 o; o.x = pack2(v.x, v.y); o.y = pack2(v.z, v.w);
        *(uint2*)(dst + (size_t)(row0 + rl) * ld + cb + c4) = o;
      });
    }
  }
}

DI void phase_local(const Params& p_in, int l, char* smem) {
  const Params p = load_params();

  int tid = threadIdx.x; asm volatile("" : "+v"(tid)); const int lane = tid & 63;
  const bf16_t* XBC = (const bf16_t*)(p.ws + OFF_XBC);
  bf16_t* XS = (bf16_t*)(p.ws + OFF_H);
  bf16_t* BC = (bf16_t*)(p.ws + OFF_BC);
  float* DT = (float*)(p.ws + OFF_DT);
  float* CS = (float*)(p.ws + OFF_CS);
  const bf16_t* GLU = (const bf16_t*)(p.ws + OFF_GLU);
  bf16_t* HDN = (bf16_t*)(p.ws + OFF_HDN);
  bf16_t* Q = (bf16_t*)(p.ws + OFF_Q);
  bf16_t* KV = (bf16_t*)(p.ws + OFF_KV);
  const int N_CONV = (R_ / 8) * 192 / 256;
  const int N_DT = NCK;
  const int N_CF = R_ / 16;
  const int N_ROPE = RL_ * 40 / 256;
  const int N_QC = 1024 * 256 / 256;
  const int NT = N_CF + N_DT + N_CONV + N_ROPE + N_QC;
  for (int it0 = blockIdx.x; it0 < NT; it0 += gridDim.x) {
    int it = it0;
    if (it < N_CF) {
      float* sst = (float*)smem;
      unsigned* sIn = (unsigned*)(smem + 256);
      const int row0 = it * 16;
      const int seq0 = (row0 < RL_) ? (row0 & ~4095) : (RL_ + ((row0 - RL_) & ~255));
      const int slen = (row0 < RL_) ? 4096 : 256;
      const int t0 = row0 - seq0;
      const int c0 = tid * 2;
      __syncthreads();
      if (tid < 32) sst[tid] = 0.f;
      for (int idx = tid; idx < 46 * 64; idx += 256) {
        const int rr = idx >> 6, c16 = idx & 63;
        const int tt = t0 - 15 + rr;
        uint4 val = make_uint4(0u, 0u, 0u, 0u);
        if (tt >= 0 && tt < slen) val = *(const uint4*)(GLU + (size_t)(seq0 + tt) * 512 + c16 * 8);
        *(uint4*)&sIn[rr * 256 + c16 * 4] = val;
      }
      float w0[31], w1[31];
#pragma unroll
      for (int k = 0; k < 31; ++k) {
        const float2 wv = *(const float2*)(p.conv_dw_w + ((size_t)l * 31 + k) * 512 + c0);
        w0[k] = wv.x; w1[k] = wv.y;
      }
      const float2 bv = *(const float2*)(p.conv_dw_b + l * 512 + c0);
      float a0[16], a1[16];
#pragma unroll
      for (int r = 0; r < 16; ++r) { a0[r] = bv.x; a1[r] = bv.y; }
      __syncthreads();
#pragma unroll
      for (int tp = 0; tp < 46; ++tp) {
        const unsigned u = sIn[tp * 256 + tid];
        const float x0 = lo2f(u), x1 = hi2f(u);
#pragma unroll
        for (int r = 0; r < 16; ++r) {
          const int k = tp - r;
          if (k >= 0 && k < 31) { a0[r] += w0[k] * x0; a1[r] += w1[k] * x1; }
        }
      }
      {
        float v[32];
#pragma unroll
        for (int r = 0; r < 16; ++r) { v[2 * r] = a0[r] + a1[r]; v[2 * r + 1] = a0[r] * a0[r] + a1[r] * a1[r]; }
#pragma unroll
        for (int i = 0; i < 16; ++i) { const bool up = (lane & 32) != 0; const float keep = up ? v[i + 16] : v[i]; const float send = up ? v[i] : v[i + 16]; v[i] = keep + __shfl_xor(send, 32); }
#pragma unroll
        for (int i = 0; i < 8; ++i) { const bool up = (lane & 16) != 0; const float keep = up ? v[i + 8] : v[i]; const float send = up ? v[i] : v[i + 8]; v[i] = keep + __shfl_xor(send, 16); }
#pragma unroll
        for (int i = 0; i < 4; ++i) { const bool up = (lane & 8) != 0; const float keep = up ? v[i + 4] : v[i]; const float send = up ? v[i] : v[i + 4]; v[i] = keep + __shfl_xor(send, 8); }
#pragma unroll
        for (int i = 0; i < 2; ++i) { const bool up = (lane & 4) != 0; const float keep = up ? v[i + 2] : v[i]; const float send = up ? v[i] : v[i + 2]; v[i] = keep + __shfl_xor(send, 4); }
        { const bool up = (lane & 2) != 0; const float keep = up ? v[1] : v[0]; const float send = up ? v[0] : v[1]; v[0] = keep + __shfl_xor(send, 2); }
        v[0] += __shfl_xor(v[0], 1);
        __syncthreads();
        if ((lane & 1) == 0) atomicAdd(&sst[lane >> 1], v[0]);
      }
      __syncthreads();
      const float2 lw = *(const float2*)(p.conv_ln_w + l * 512 + c0);
      const float2 lb = *(const float2*)(p.conv_ln_b + l * 512 + c0);
#pragma unroll
      for (int r = 0; r < 16; ++r) {
        const float mean = sst[r * 2] * (1.f / 512.f);
        const float var = fmaxf(sst[r * 2 + 1] * (1.f / 512.f) - mean * mean, 0.f);
        const float rs = rsqrtf(var + 1e-6f);
        const float y0 = (a0[r] - mean) * rs * lw.x + lb.x;
        const float y1 = (a1[r] - mean) * rs * lw.y + lb.y;
        *(unsigned*)(HDN + (size_t)(row0 + r) * 512 + c0) = pack2(silu_f(y0), silu_f(y1));
      }
      continue;
    }
    it -= N_CF;
    if (it < N_DT) {
      float* sdt = (float*)smem;
      const int row0 = it * 128;
      __syncthreads();
      for (int e = tid; e < 4096; e += 256) {
        const int r = e >> 5, cidx = e & 31;
        const float raw = DT[(size_t)(row0 + r) * 32 + cidx] + p.ssd_dt_bias[l * 32 + cidx];
        const float sp = (raw > 20.f) ? raw : log1pf(expf(raw));
        DT[(size_t)(row0 + r) * 32 + cidx] = sp;
        sdt[r * 33 + cidx] = sp;
      }
      __syncthreads();
      if (tid < 32) {
        const float a = -expf(p.ssd_a_log[l * 32 + tid]);
        float run = 0.f;
        if (tid < 16) {
          for (int r = 0; r < 128; ++r) { run += sdt[r * 33 + tid] * a; CS[(size_t)(row0 + r) * 32 + tid] = run; }
        } else {
          for (int r = 127; r >= 0; --r) { run += sdt[r * 33 + tid] * a; CS[(size_t)(row0 + r) * 32 + tid] = run; }
        }
      }
      continue;
    }
    it -= N_DT;
    if (it < N_CONV) {
      const int e = it * 256 + tid;
      const int rb = e / 192, cgp = e % 192, ch0 = cgp * 8;
      const int rho0 = rb * 8;
      const int seq0 = (rho0 < RL_) ? (rho0 & ~4095) : (RL_ + ((rho0 - RL_) & ~255));
      const int slen = (rho0 < RL_) ? 4096 : 256;
      const int t0 = rho0 - seq0;
      uint4 xr[12];
#pragma unroll
      for (int i = 0; i < 12; ++i) {
        const int tt = t0 + i - 2;
        xr[i] = make_uint4(0u, 0u, 0u, 0u);
        if (tt >= 0 && tt < slen) xr[i] = *(const uint4*)(XBC + (size_t)(seq0 + tt) * 1536 + ch0);
      }
      float wk[5][8];
#pragma unroll
      for (int k = 0; k < 5; ++k) {
        const float4 w0 = *(const float4*)(p.ssd_conv_w + ((size_t)l * 5 + k) * 1536 + ch0);
        const float4 w1 = *(const float4*)(p.ssd_conv_w + ((size_t)l * 5 + k) * 1536 + ch0 + 4);
        wk[k][0] = w0.x; wk[k][1] = w0.y; wk[k][2] = w0.z; wk[k][3] = w0.w; wk[k][4] = w1.x; wk[k][5] = w1.y; wk[k][6] = w1.z; wk[k][7] = w1.w;
      }
      float bias[8];
      {
        const float4 b0 = *(const float4*)(p.ssd_conv_b + l * 1536 + ch0);
        const float4 b1 = *(const float4*)(p.ssd_conv_b + l * 1536 + ch0 + 4);
        bias[0] = b0.x; bias[1] = b0.y; bias[2] = b0.z; bias[3] = b0.w; bias[4] = b1.x; bias[5] = b1.y; bias[6] = b1.z; bias[7] = b1.w;
      }
#pragma unroll
      for (int r = 0; r < 8; ++r) {
        float a[8];
#pragma unroll
        for (int c = 0; c < 8; ++c) a[c] = bias[c];
#pragma unroll
        for (int k = 0; k < 5; ++k) {
          const uint4 u = xr[r + k];
          a[0] += wk[k][0] * lo2f(u.x); a[1] += wk[k][1] * hi2f(u.x); a[2] += wk[k][2] * lo2f(u.y); a[3] += wk[k][3] * hi2f(u.y);
          a[4] += wk[k][4] * lo2f(u.z); a[5] += wk[k][5] * hi2f(u.z); a[6] += wk[k][6] * lo2f(u.w); a[7] += wk[k][7] * hi2f(u.w);
        }
        uint4 o;
        o.x = pack2(silu_f(a[0]), silu_f(a[1])); o.y = pack2(silu_f(a[2]), silu_f(a[3]));
        o.z = pack2(silu_f(a[4]), silu_f(a[5])); o.w = pack2(silu_f(a[6]), silu_f(a[7]));
        const size_t rho = (size_t)(rho0 + r);
        if (ch0 < 1024) *(uint4*)(XS + rho * 1024 + ch0) = o;
        else *(uint4*)(BC + rho * 512 + (ch0 - 1024)) = o;
      }
      continue;
    }
    it -= N_CONV;
    if (it < N_ROPE) {
      const int e = it * 256 + tid;
      const int rho = e / 40, rem = e % 40, hd = rem >> 2, sub = rem & 3;
      const int axis = sub >> 1, half = sub & 1;
      const int t = rho & 4095;
      const float pos = (float)(axis == 0 ? (t >> 6) : (t & 63));
      bf16_t* base = ((hd < 8) ? (Q + (size_t)rho * 512 + hd * 64) : (KV + (size_t)rho * 256 + (hd - 8) * 64)) + axis * 32 + half * 8;
      const float sc = (hd < 8) ? 0.125f : 1.f;
      const uint4 u1 = *(const uint4*)base, u2 = *(const uint4*)(base + 16);
      const unsigned a1[4] = {u1.x, u1.y, u1.z, u1.w}, a2[4] = {u2.x, u2.y, u2.z, u2.w};
      unsigned o1[4], o2[4];
#pragma unroll
      for (int i = 0; i < 4; ++i) {
        float r1[2], r2[2];
#pragma unroll
        for (int hl = 0; hl < 2; ++hl) {
          const float f = (float)(half * 8 + 2 * i + hl);
          const float ang = pos * exp2f(-f * 0.8304820237218406f);
          const float cs = __cosf(ang), sn = __sinf(ang);
          const float t1 = hl ? hi2f(a1[i]) : lo2f(a1[i]);
          const float t2 = hl ? hi2f(a2[i]) : lo2f(a2[i]);
          r1[hl] = (t1 * cs - t2 * sn) * sc;
          r2[hl] = (t2 * cs + t1 * sn) * sc;
        }
        o1[i] = pack2(r1[0], r1[1]); o2[i] = pack2(r2[0], r2[1]);
      }
      *(uint4*)base = make_uint4(o1[0], o1[1], o1[2], o1[3]);
      *(uint4*)(base + 16) = make_uint4(o2[0], o2[1], o2[2], o2[3]);
      continue;
    }
    it -= N_ROPE;
    {
      const int e = it * 256 + tid;
      const int rho = RL_ + e / 256, c2 = (e % 256) * 2;
      unsigned* ptr = (unsigned*)(Q + (size_t)rho * 512 + c2);
      const unsigned u = *ptr;
      *ptr = pack2(lo2f(u) * 0.125f, hi2f(u) * 0.125f);
    }
  }
}

DI void attn_item(const Params& p_in, int l, char* smem, int b, int qblk, int g, int hp, bool ctxq) {
  const Params p = load_params();

  bf16_t* sK = (bf16_t*)smem;
  bf16_t* sV = (bf16_t*)(smem + 128 * 72 * 2);
  int tid = threadIdx.x; asm volatile("" : "+v"(tid)); const int lane = tid & 63, wave = tid >> 6, fr = lane & 31, fh = lane >> 5;
  const int head = g * 4 + hp * 2 + (wave >> 1);
  const int qh = wave & 1;
  const int qrow0 = (ctxq ? (RL_ + b * 256) : (b * 4096)) + qblk * 128 + qh * 64;
  const int qpos0 = qblk * 128 + qh * 64;
  bf16_t* Q = (bf16_t*)(p.ws + OFF_Q);
  const bf16_t* KV = (const bf16_t*)(p.ws + OFF_KV);
  const bf16_t* AG = (const bf16_t*)(p.ws + OFF_AG);
  bf16x8 qf[2][4];
#pragma unroll
  for (int j = 0; j < 2; ++j)
#pragma unroll
    for (int ks = 0; ks < 4; ++ks)
      qf[j][ks] = *(const bf16x8*)(Q + (size_t)(qrow0 + j * 32 + fr) * 512 + head * 64 + ks * 16 + fh * 8);
  f32x16 o[2][2];
  zero_acc(o);
  float m[2], lsum[2];
  m[0] = m[1] = p.attn_sink[l * 8 + head];
  lsum[0] = lsum[1] = 1.f;
  const int nblk = ctxq ? 2 : 5;
  for (int bi = 0; bi < nblk; ++bi) {
    int krow0, kpos0 = 0;
    bool masked = false;
    if (bi < 2) {
      krow0 = RL_ + b * 256 + bi * 128;
    } else {
      const int kb = qblk + bi - 3;
      if (kb < 0 || kb >= 32) continue;
      krow0 = b * 4096 + kb * 128;
      kpos0 = kb * 128;
      masked = (bi != 3);
    }
    __syncthreads();
    for (int v = tid; v < 1024; v += 256) {
      const int r = v >> 3, cv = v & 7;
      *(uint4*)&sK[r * 72 + cv * 8] = *(const uint4*)(KV + (size_t)(krow0 + r) * 256 + g * 64 + cv * 8);
      *(uint4*)&sV[r * 72 + cv * 8] = *(const uint4*)(KV + (size_t)(krow0 + r) * 256 + 128 + g * 64 + cv * 8);
    }
    __syncthreads();
#pragma unroll 1
    for (int kb = 0; kb < 4; ++kb) {
      f32x16 st[2];
#pragma unroll
      for (int j = 0; j < 2; ++j)
#pragma unroll
        for (int r = 0; r < 16; ++r) st[j][r] = 0.f;
#pragma unroll
      for (int ks = 0; ks < 4; ++ks) {
        const bf16x8 kf = *(const bf16x8*)&sK[(kb * 32 + fr) * 72 + ks * 16 + fh * 8];
#pragma unroll
        for (int j = 0; j < 2; ++j) st[j] = MFMA(kf, qf[j][ks], st[j]);
      }
      bf16x8 pb[2][2];
#pragma unroll
      for (int j = 0; j < 2; ++j) {
        if (masked) {
          const int qpos = qpos0 + j * 32 + fr;
#pragma unroll
          for (int r = 0; r < 16; ++r) {
            const int d = qpos - (kpos0 + kb * 32 + crow(r, fh));
            if (d > 128 || d < -128) st[j][r] = -1e30f;
          }
        }
        float mx = st[j][0];
#pragma unroll
        for (int r = 1; r < 16; ++r) mx = fmaxf(mx, st[j][r]);
        mx = fmaxf(mx, __shfl_xor(mx, 32));
        const float mnew = fmaxf(m[j], mx);
        const float alpha = __expf(m[j] - mnew);
        float rs = 0.f;
#pragma unroll
        for (int r = 0; r < 16; ++r) { const float pv = __expf(st[j][r] - mnew); st[j][r] = pv; rs += pv; }
        rs += __shfl_xor(rs, 32);
        lsum[j] = lsum[j] * alpha + rs;
        m[j] = mnew;
#pragma unroll
        for (int mt = 0; mt < 2; ++mt)
#pragma unroll
          for (int r = 0; r < 16; ++r) o[mt][j][r] *= alpha;
#pragma unroll
        for (int s = 0; s < 2; ++s)
#pragma unroll
          for (int jj = 0; jj < 8; ++jj) pb[j][s][jj] = (short)f2bf(st[j][8 * s + jj]);
      }
#pragma unroll
      for (int s = 0; s < 2; ++s)
#pragma unroll
        for (int mt = 0; mt < 2; ++mt) {
          const bf16x8 vf = tr_frag(sV, 72, kb * 32 + 16 * s + 4 * fh, kb * 32 + 16 * s + 8 + 4 * fh, mt * 32);
#pragma unroll
          for (int j = 0; j < 2; ++j) o[mt][j] = MFMA(vf, pb[j][s], o[mt][j]);
        }
    }
  }
#pragma unroll
  for (int j = 0; j < 2; ++j) {
    const float inv = 1.f / lsum[j];
    const size_t rho = (size_t)(qrow0 + j * 32 + fr);
#pragma unroll
    for (int mt = 0; mt < 2; ++mt)
#pragma unroll
      for (int g4 = 0; g4 < 4; ++g4) {
        const int d0 = mt * 32 + 8 * g4 + 4 * fh;
        const uint2 gv = *(const uint2*)(AG + rho * 512 + head * 64 + d0);
        uint2 ov;
        ov.x = pack2(o[mt][j][g4 * 4 + 0] * inv * silu_f(lo2f(gv.x)), o[mt][j][g4 * 4 + 1] * inv * silu_f(hi2f(gv.x)));
        ov.y = pack2(o[mt][j][g4 * 4 + 2] * inv * silu_f(lo2f(gv.y)), o[mt][j][g4 * 4 + 3] * inv * silu_f(hi2f(gv.y)));
        *(uint2*)(Q + rho * 512 + head * 64 + d0) = ov;
      }
  }
}

DI void states_item(const Params& p_in, char* smem, int ck, int g, int hq) {
  const Params p = load_params();

  bf16_t* sB = (bf16_t*)smem;
  bf16_t* sX = (bf16_t*)(smem + 128 * 136 * 2);
  int tid = threadIdx.x; asm volatile("" : "+v"(tid)); const int lane = tid & 63, wave = tid >> 6, wr = wave >> 1, wc = wave & 1, fr = lane & 31, fh = lane >> 5;
  const bf16_t* BC = (const bf16_t*)(p.ws + OFF_BC);
  const bf16_t* XS = (const bf16_t*)(p.ws + OFF_H);
  const float* DT = (const float*)(p.ws + OFF_DT);
  const float* CS = (const float*)(p.ws + OFF_CS);
  bf16_t* ST = (bf16_t*)(p.ws + OFF_ST);
  float* CDEC = (float*)(p.ws + OFF_CDEC);
  const int row0 = ck * 128;
  __syncthreads();
  for (int v = tid; v < 2048; v += 256) {
    const int r = v >> 4, cv = v & 15;
    *(uint4*)&sB[r * 136 + cv * 8] = *(const uint4*)(BC + (size_t)(row0 + r) * 512 + g * 128 + cv * 8);
  }
  __syncthreads();
  bf16x8 bfr[2][8];
#pragma unroll
  for (int j = 0; j < 2; ++j)
#pragma unroll
    for (int ks = 0; ks < 8; ++ks) bfr[j][ks] = tr_frag(sB, 136, ks * 16 + 8 * fh, ks * 16 + 8 * fh + 4, wc * 64 + j * 32);
  const int slr = tid >> 3, scv = tid & 7;
  uint4 xq0, xq1, xq2, xq3;
  float dq0, dq1, dq2, dq3, cq0, cq1, cq2, cq3, cendq;
#define ST_PREFETCH(HD) { const int head_ = g * 8 + hq * 4 + ((HD) >> 1), d_ = (HD) & 1, col_ = d_ * 16 + head_; \
    const bf16_t* xp_ = XS + (size_t)(row0 + slr) * 1024 + head_ * 64 + scv * 8; \
    xq0 = *(const uint4*)(xp_); xq1 = *(const uint4*)(xp_ + 32 * 1024); xq2 = *(const uint4*)(xp_ + 64 * 1024); xq3 = *(const uint4*)(xp_ + 96 * 1024); \
    const size_t rb_ = (size_t)(row0 + slr) * 32 + col_; \
    dq0 = DT[rb_]; dq1 = DT[rb_ + 32 * 32]; dq2 = DT[rb_ + 64 * 32]; dq3 = DT[rb_ + 96 * 32]; \
    cq0 = CS[rb_]; cq1 = CS[rb_ + 32 * 32]; cq2 = CS[rb_ + 64 * 32]; cq3 = CS[rb_ + 96 * 32]; \
    cendq = CS[(size_t)(row0 + (d_ == 0 ? 127 : 0)) * 32 + col_]; }
#define ST_SCALE_STORE(X, DTV, CSV, ROW) { const float sc_ = (DTV) * __expf(cend - (CSV)); uint4 o_; \
    o_.x = pack2(lo2f(X.x) * sc_, hi2f(X.x) * sc_); o_.y = pack2(lo2f(X.y) * sc_, hi2f(X.y) * sc_); \
    o_.z = pack2(lo2f(X.z) * sc_, hi2f(X.z) * sc_); o_.w = pack2(lo2f(X.w) * sc_, hi2f(X.w) * sc_); \
    *(uint4*)&sX[(ROW) * 72 + scv * 8] = o_; }
  ST_PREFETCH(0)
#pragma unroll 1
  for (int hd = 0; hd < 8; ++hd) {
    const int head = g * 8 + hq * 4 + (hd >> 1), d = hd & 1;
    const float cend = cendq;
    ST_SCALE_STORE(xq0, dq0, cq0, slr)
    ST_SCALE_STORE(xq1, dq1, cq1, slr + 32)
    ST_SCALE_STORE(xq2, dq2, cq2, slr + 64)
    ST_SCALE_STORE(xq3, dq3, cq3, slr + 96)
    if (hd < 7) ST_PREFETCH(hd + 1)
    __syncthreads();
    f32x16 acc[2];
#pragma unroll
    for (int j = 0; j < 2; ++j)
#pragma unroll
      for (int r = 0; r < 16; ++r) acc[j][r] = 0.f;
#pragma unroll
    for (int ks = 0; ks < 8; ++ks) {
      const bf16x8 af = tr_frag(sX, 72, ks * 16 + 8 * fh, ks * 16 + 8 * fh + 4, wr * 32);
#pragma unroll
      for (int j = 0; j < 2; ++j) acc[j] = MFMA(af, bfr[j][ks], acc[j]);
    }
    bf16_t* dst = ST + ((size_t)(ck * 2 + d) * 16 + head) * 8192;
#pragma unroll
    for (int j = 0; j < 2; ++j)
#pragma unroll
      for (int r = 0; r < 16; ++r) dst[(wr * 32 + crow(r, fh)) * 128 + wc * 64 + j * 32 + fr] = f2bf(acc[j][r]);
    if (tid == 0) CDEC[(ck * 2 + d) * 16 + head] = __expf(cend);
    __syncthreads();
  }
}

DI void pw_item(const Params& p_in, int l, char* smem, int mt, int nt) {
  const Params p = load_params();

  GemmS* s = (GemmS*)smem;
  int tid = threadIdx.x; asm volatile("" : "+v"(tid)); const int lane = tid & 63, wave = tid >> 6, wr = wave >> 1, wc = wave & 1, fr = lane & 31, fh = lane >> 5;
  const bf16_t* Ab = (const bf16_t*)(p.ws + OFF_HDN) + (size_t)mt * 128 * 512;
  const bf16_t* Bb = (const bf16_t*)(p.ws + OFF_PW) + (size_t)nt * 128 * 512;
  bf16_t* CG = (bf16_t*)(p.ws + OFF_CG);
  f32x16 acc[2][2];
  zero_acc(acc);
  gemm_core2(acc, (GemmS2*)smem,
             [&](int kt, int r, int kv) { return Ab + (size_t)r * 512 + kt * 64 + kv * 8; },
             [&](int kt, int r, int kv) { return Bb + (size_t)r * 512 + kt * 64 + kv * 8; }, 8, [](int) {});
  const float* pwb = p.conv_pw_b + l * 512 + nt * 128;
  epilogue_lds(acc, smem, [&](int rl, int c4, float4 v) {
    bf16_t* ptr = CG + (size_t)(mt * 128 + rl) * 512 + nt * 128 + c4;
    const uint2 gv = *(const uint2*)ptr;
    const float4 bb = *(const float4*)(pwb + c4);
    uint2 o;
    o.x = pack2((v.x + bb.x) * silu_f(lo2f(gv.x)), (v.y + bb.y) * silu_f(hi2f(gv.x)));
    o.y = pack2((v.z + bb.z) * silu_f(lo2f(gv.y)), (v.w + bb.w) * silu_f(hi2f(gv.y)));
    *(uint2*)ptr = o;
  });
}

DI void phase_mix(const Params& p, int l, char* smem) {
  const int G = gridDim.x;
  const int N_ATT = 512 + (l == 0 ? 32 : 0);
  for (int it = blockIdx.x; it < N_ATT; it += G) {
    if (it < 512) attn_item(p, l, smem, it >> 7, (it >> 2) & 31, (it >> 1) & 1, it & 1, false);
    else { const int t = it - 512; attn_item(p, l, smem, t >> 3, (t >> 2) & 1, (t >> 1) & 1, t & 1, true); }
  }
  for (int it = (blockIdx.x + G - 32) % G; it < NCK * 4; it += G) states_item(p, smem, it >> 2, (it >> 1) & 1, it & 1);
  for (int it = (blockIdx.x + G - 64) % G; it < NCK * 4; it += G) pw_item(p, l, smem, it >> 2, it & 3);
}

DI void phase_scan(const Params& p_in) {
  const Params p = load_params();

  bf16_t* ST = (bf16_t*)(p.ws + OFF_ST);
  const float* CDEC = (const float*)(p.ws + OFF_CDEC);
  for (int it = blockIdx.x; it < 512; it += gridDim.x) {
    const int e = it * 256 + threadIdx.x;
    const int bdh = e >> 10, v8 = e & 1023;
    const int b = bdh >> 5, d = (bdh >> 4) & 1, h = bdh & 15;
    float s[8];
#pragma unroll
    for (int i = 0; i < 8; ++i) s[i] = 0.f;
    auto ckof = [&](int i) {
      if (d == 0) return (i < 2) ? (128 + 2 * b + i) : (32 * b + (i - 2));
      return (i < 2) ? (128 + 2 * b + (1 - i)) : (32 * b + 31 - (i - 2));
    };
    auto pof = [&](int i) { const int ck = ckof(i); return (uint4*)(ST + ((size_t)(ck * 2 + d) * 16 + h) * 8192 + v8 * 8); };
    auto dof = [&](int i) { const int ck = ckof(i); return CDEC[(ck * 2 + d) * 16 + h]; };
    uint4 buf[4]; float dc[4];
#pragma unroll
    for (int i = 0; i < 3; ++i) { buf[i] = *pof(i); dc[i] = dof(i); }
#pragma unroll
    for (int i = 0; i < 34; ++i) {
      if (i + 3 < 34) { buf[(i + 3) & 3] = *pof(i + 3); dc[(i + 3) & 3] = dof(i + 3); }
      const uint4 cur = buf[i & 3];
      const float dec = dc[i & 3];
      uint4 o;
      o.x = pack2(s[0], s[1]); o.y = pack2(s[2], s[3]); o.z = pack2(s[4], s[5]); o.w = pack2(s[6], s[7]);
      *pof(i) = o;
      s[0] = s[0] * dec + lo2f(cur.x); s[1] = s[1] * dec + hi2f(cur.x);
      s[2] = s[2] * dec + lo2f(cur.y); s[3] = s[3] * dec + hi2f(cur.y);
      s[4] = s[4] * dec + lo2f(cur.z); s[5] = s[5] * dec + hi2f(cur.z);
      s[6] = s[6] * dec + lo2f(cur.w); s[7] = s[7] * dec + hi2f(cur.w);
    }
  }
}

DI void phase_ssdy(const Params& p_in, int l, char* smem) {
  const Params p = load_params();

  bf16_t* sB = (bf16_t*)smem;
  bf16_t* sX = (bf16_t*)(smem + 128 * 136 * 2);
  float* sF = (float*)(smem + 128 * 136 * 2 + 128 * 72 * 2);
  float* sSS = sF + 512;
  int tid = threadIdx.x; asm volatile("" : "+v"(tid)); const int lane = tid & 63, wave = tid >> 6, fr = lane & 31, fh = lane >> 5;
  const int wl = wave >> 1, w2 = wave & 1;
  const bf16_t* BC = (const bf16_t*)(p.ws + OFF_BC);
  const bf16_t* XS = (const bf16_t*)(p.ws + OFF_H);
  const float* DT = (const float*)(p.ws + OFF_DT);
  const float* CS = (const float*)(p.ws + OFF_CS);
  const bf16_t* ST = (const bf16_t*)(p.ws + OFF_ST);
  bf16_t* Z = (bf16_t*)(p.ws + OFF_Z);
  float* RSTD = (float*)(p.ws + OFF_RSTD);
  const int nck = (l == 0) ? NCK : 128;
  for (int it = blockIdx.x; it < nck * 4; it += gridDim.x) {
    const int ck = it >> 2, g = (it >> 1) & 1, lh = it & 1;
    const int row0 = ck * 128;
    const int lbase = lh * 64 + wl * 32;
    __syncthreads();
    for (int v = tid; v < 2048; v += 256) {
      const int r = v >> 4, cv = v & 15;
      *(uint4*)&sB[r * 136 + cv * 8] = *(const uint4*)(BC + (size_t)(row0 + r) * 512 + g * 128 + cv * 8);
    }
    if (tid < 64) sSS[tid] = 0.f;
    const bf16_t* cptr = BC + (size_t)(row0 + lbase + fr) * 512 + 256 + g * 128 + fh * 8;
    bf16x8 cf[8];
#pragma unroll
    for (int ks = 0; ks < 8; ++ks) cf[ks] = *(const bf16x8*)(cptr + ks * 16);
    const int lrx = tid >> 3, cvx = tid & 7;
    const bf16_t* xsrc = XS + (size_t)(row0 + lrx) * 1024 + cvx * 8;
    uint4 xp0, xp1, xp2, xp3;
    float fp0 = 0.f, fp1 = 0.f, fp2 = 0.f, fp3 = 0.f;
    {
      const int head = g * 8;
      xp0 = *(const uint4*)(xsrc + head * 64);
      xp1 = *(const uint4*)(xsrc + head * 64 + 32 * 1024);
      xp2 = *(const uint4*)(xsrc + head * 64 + 64 * 1024);
      xp3 = *(const uint4*)(xsrc + head * 64 + 96 * 1024);
      if (tid < 128) {
        const size_t rho = (size_t)(row0 + tid);
        fp0 = CS[rho * 32 + head]; fp1 = CS[rho * 32 + 16 + head]; fp2 = DT[rho * 32 + head]; fp3 = DT[rho * 32 + 16 + head];
      }
    }
    __syncthreads();
    f32x16 cb[2];
#pragma unroll
    for (int j = 0; j < 2; ++j) {
#pragma unroll
      for (int r = 0; r < 16; ++r) cb[j][r] = 0.f;
#pragma unroll
      for (int ks = 0; ks < 8; ++ks) {
        const bf16x8 bq = *(const bf16x8*)&sB[(w2 * 64 + j * 32 + fr) * 136 + ks * 16 + fh * 8];
        cb[j] = MFMA(cf[ks], bq, cb[j]);
      }
    }
    const int pidx = w2 * 32 + fr;
    bf16_t* sCB = sB + 64 * 136;
    __syncthreads();
#pragma unroll
    for (int j = 0; j < 2; ++j)
#pragma unroll
      for (int r = 0; r < 16; ++r) sCB[(wl * 32 + crow(r, fh)) * 136 + w2 * 64 + j * 32 + fr] = f2bf(cb[j][r]);
#pragma unroll 1
    for (int hh = 0; hh < 8; ++hh) {
      const int head = g * 8 + hh;
      __syncthreads();
      *(uint4*)&sX[lrx * 72 + cvx * 8] = xp0;
      *(uint4*)&sX[(lrx + 32) * 72 + cvx * 8] = xp1;
      *(uint4*)&sX[(lrx + 64) * 72 + cvx * 8] = xp2;
      *(uint4*)&sX[(lrx + 96) * 72 + cvx * 8] = xp3;
      if (tid < 128) { sF[tid] = fp0; sF[128 + tid] = fp1; sF[256 + tid] = fp2; sF[384 + tid] = fp3; }
      const bf16_t* S0 = ST + ((size_t)(ck * 2 + 0) * 16 + head) * 8192 + (w2 * 32 + fr) * 128 + fh * 8;
      const bf16_t* S1 = ST + ((size_t)(ck * 2 + 1) * 16 + head) * 8192 + (w2 * 32 + fr) * 128 + fh * 8;
      bf16x8 sf0[8];
#pragma unroll
      for (int ks = 0; ks < 8; ++ks) sf0[ks] = *(const bf16x8*)(S0 + ks * 16);
      bf16_t* zbase = Z + (size_t)(row0 + lbase + 4 * fh) * 1024 + head * 64 + pidx;
      if (hh < 7) {
        const int hn = head + 1;
        xp0 = *(const uint4*)(xsrc + hn * 64);
        xp1 = *(const uint4*)(xsrc + hn * 64 + 32 * 1024);
        xp2 = *(const uint4*)(xsrc + hn * 64 + 64 * 1024);
        xp3 = *(const uint4*)(xsrc + hn * 64 + 96 * 1024);
        if (tid < 128) {
          const size_t rho = (size_t)(row0 + tid);
          fp0 = CS[rho * 32 + hn]; fp1 = CS[rho * 32 + 16 + hn]; fp2 = DT[rho * 32 + hn]; fp3 = DT[rho * 32 + 16 + hn];
        }
      }
      __syncthreads();
#pragma unroll
      for (int j = 0; j < 2; ++j) {
        const int sidx = w2 * 64 + j * 32 + fr;
        const float csf_s = sF[sidx], csb_s = sF[128 + sidx], dtf_s = sF[256 + sidx], dtb_s = sF[384 + sidx];
#pragma unroll 4
        for (int r = 0; r < 16; ++r) {
          const int lidx = lbase + crow(r, fh);
          float f = 0.f;
          if (sidx <= lidx) f += __expf(sF[lidx] - csf_s) * dtf_s;
          if (sidx >= lidx) f += __expf(sF[128 + lidx] - csb_s) * dtb_s;
          sB[(wl * 32 + crow(r, fh)) * 136 + sidx] = f2bf(bf2f(sCB[(wl * 32 + crow(r, fh)) * 136 + sidx]) * f);
        }
      }
      __syncthreads();
      bf16x8 sf1[8], cfh[8];
#pragma unroll
      for (int ks = 0; ks < 8; ++ks) { sf1[ks] = *(const bf16x8*)(S1 + ks * 16); cfh[ks] = *(const bf16x8*)(cptr + ks * 16); }
      unsigned short zv[16];
#pragma unroll
      for (int r = 0; r < 16; ++r) zv[r] = zbase[(size_t)((r & 3) + 8 * (r >> 2)) * 1024];
      f32x16 accy;
#pragma unroll
      for (int r = 0; r < 16; ++r) accy[r] = 0.f;
#pragma unroll
      for (int ks = 0; ks < 8; ++ks) {
        const bf16x8 af = *(const bf16x8*)&sB[(wl * 32 + fr) * 136 + ks * 16 + fh * 8];
        const bf16x8 xf = tr_frag(sX, 72, ks * 16 + 8 * fh, ks * 16 + 8 * fh + 4, w2 * 32);
        accy = MFMA(af, xf, accy);
      }
      {
        f32x16 acct;
#pragma unroll
        for (int r = 0; r < 16; ++r) acct[r] = 0.f;
#pragma unroll
        for (int ks = 0; ks < 8; ++ks) acct = MFMA(cfh[ks], sf0[ks], acct);
#pragma unroll
        for (int r = 0; r < 16; ++r) accy[r] += __expf(sF[lbase + crow(r, fh)]) * acct[r];
#pragma unroll
        for (int r = 0; r < 16; ++r) acct[r] = 0.f;
#pragma unroll
        for (int ks = 0; ks < 8; ++ks) acct = MFMA(cfh[ks], sf1[ks], acct);
#pragma unroll
        for (int r = 0; r < 16; ++r) accy[r] += __expf(sF[128 + lbase + crow(r, fh)]) * acct[r];
      }
      const float dsk = p.ssd_d[l * 16 + head];
      float v[16];
#pragma unroll
      for (int r = 0; r < 16; ++r) {
        const int lidx = lbase + crow(r, fh);
        const float xv = bf2f(sX[lidx * 72 + pidx]);
        const float y = accy[r] + dsk * xv;
        const float u = y * silu_f(bf2f(zv[r]));
        v[r] = u * u;
        zbase[(size_t)((r & 3) + 8 * (r >> 2)) * 1024] = f2bf(u);
      }
#pragma unroll
      for (int i = 0; i < 8; ++i) { const bool up = (fr & 16) != 0; const float keep = up ? v[i + 8] : v[i]; const float send = up ? v[i] : v[i + 8]; v[i] = keep + __shfl_xor(send, 16); }
#pragma unroll
      for (int i = 0; i < 4; ++i) { const bool up = (fr & 8) != 0; const float keep = up ? v[i + 4] : v[i]; const float send = up ? v[i] : v[i + 4]; v[i] = keep + __shfl_xor(send, 8); }
#pragma unroll
      for (int i = 0; i < 2; ++i) { const bool up = (fr & 4) != 0; const float keep = up ? v[i + 2] : v[i]; const float send = up ? v[i] : v[i + 2]; v[i] = keep + __shfl_xor(send, 4); }
      { const bool up = (fr & 2) != 0; const float keep = up ? v[1] : v[0]; const float send = up ? v[0] : v[1]; v[0] = keep + __shfl_xor(send, 2); }
      v[0] += __shfl_xor(v[0], 1);
      if ((fr & 1) == 0) atomicAdd(&sSS[wl * 32 + crow(fr >> 1, fh)], v[0]);
    }
    __syncthreads();
    if (tid < 64) RSTD[(size_t)(row0 + lh * 64 + tid) * 2 + g] = rsqrtf(sSS[tid] * (1.f / 512.f) + 1e-6f);
  }
}

DI void phase_outproj(const Params& p_in, int l, char* smem) {
  const Params p = load_params();

  GemmS* s = (GemmS*)smem;
  int tid = threadIdx.x; asm volatile("" : "+v"(tid)); const int lane = tid & 63, wave = tid >> 6, wr = wave >> 1, wc = wave & 1, fr = lane & 31, fh = lane >> 5;
  const bf16_t* Zb = (const bf16_t*)(p.ws + OFF_Z);
  const bf16_t* Qb = (const bf16_t*)(p.ws + OFF_Q);
  const bf16_t* Cb = (const bf16_t*)(p.ws + OFF_CG);
  const bf16_t* W = (const bf16_t*)(p.ws + OFF_WOUT);
  const float* RSTD = (const float*)(p.ws + OFF_RSTD);
  const float* mods = (const float*)(p.ws + OFF_MODS);
  float* XC = (float*)(p.ws + OFF_XC);
  const int nM = (l == 0) ? NCK : 128;
  for (int step = 0;; ++step) {
    int mt, nt;
    if (!xcd_tile(step, nM, 8, mt, nt)) break;
    f32x16 acc[2][2];
    zero_acc(acc);
    const bf16_t* Wb = W + (size_t)nt * 128 * 2048;
    const bf16_t* A0 = Zb + (size_t)mt * 128 * 1024;
    const bf16_t* A2 = Qb + (size_t)mt * 128 * 512;
    const bf16_t* A3 = Cb + (size_t)mt * 128 * 512;
    float* sScale = (float*)(smem + 40960);
    if (tid < 128) {
      const size_t row = (size_t)(mt * 128 + tid);
      const float r1 = RSTD[row * 2 + 1];
      sScale[tid * 2] = RSTD[row * 2] / r1;
      sScale[tid * 2 + 1] = r1;
    }
    gemm_core2(acc, (GemmS2*)smem,
               [&](int kt, int r, int kv) {
                 const bf16_t* ptr;
                 if (kt < 16) ptr = A0 + (size_t)r * 1024 + kt * 64;
                 else if (kt < 24) ptr = A2 + (size_t)r * 512 + (kt - 16) * 64;
                 else ptr = A3 + (size_t)r * 512 + (kt - 24) * 64;
                 return ptr + kv * 8;
               },
               [&](int kt, int r, int kv) { return Wb + (size_t)r * 2048 + kt * 64 + kv * 8; }, 32,
               [&](int kt) __attribute__((always_inline)) {
                 if (kt == 8 || kt == 16) {
#pragma unroll
                   for (int i = 0; i < 2; ++i)
#pragma unroll
                     for (int r = 0; r < 16; ++r) {
                       const float f = sScale[(wr * 64 + i * 32 + crow(r, fh)) * 2 + (kt == 16 ? 1 : 0)];
                       acc[i][0][r] *= f; acc[i][1][r] *= f;
                     }
                 }
               });
    {
      const int row0 = mt * 128;
      const int vv = (row0 < RL_) ? (row0 >> 12) : 4;
      const float* gate = mods + (l * 5 + vv) * 3072 + 2048 + nt * 128;
      float* xnew = (row0 < RL_) ? (p.out + (size_t)row0 * 1024) : (XC + (size_t)(row0 - RL_) * 1024);
      const float* xold = (l == 0) ? ((row0 < RL_) ? (p.x + (size_t)row0 * 1024) : (p.ctx + (size_t)(row0 - RL_) * 1024)) : xnew;
      epilogue_lds(acc, smem, [&](int rl, int c4, float4 v) {
        const int off = rl * 1024 + nt * 128 + c4;
        const float4 xo = *(const float4*)(xold + off);
        const float4 gt = *(const float4*)(gate + c4);
        float4 o;
        o.x = xo.x + gt.x * v.x; o.y = xo.y + gt.y * v.y; o.z = xo.z + gt.z * v.z; o.w = xo.w + gt.w * v.w;
        *(float4*)(xnew + off) = o;
      });
    }
  }
}

DI void phase_final(const Params& p_in) {
  const Params p = load_params();
  const int lane = threadIdx.x & 63, wave = threadIdx.x >> 6;
  for (int it = blockIdx.x; it < RL_ / 4; it += gridDim.x) {
    float* xr = p.out + (size_t)(it * 4 + wave) * 1024;
    float4 xv[4];
    float ss = 0.f;
#pragma unroll
    for (int i = 0; i < 4; ++i) {
      xv[i] = *(const float4*)(xr + lane * 4 + i * 256);
      ss += xv[i].x * xv[i].x + xv[i].y * xv[i].y + xv[i].z * xv[i].z + xv[i].w * xv[i].w;
    }
#pragma unroll
    for (int o = 32; o >= 1; o >>= 1) ss += __shfl_xor(ss, o);
    const float rs = rsqrtf(ss * (1.f / 1024.f) + 1e-6f);
#pragma unroll
    for (int i = 0; i < 4; ++i) {
      const float4 w = *(const float4*)(p.final_norm_w + lane * 4 + i * 256);
      float4 o;
      o.x = xv[i].x * rs * w.x; o.y = xv[i].y * rs * w.y; o.z = xv[i].z * rs * w.z; o.w = xv[i].w * rs * w.w;
      *(float4*)(xr + lane * 4 + i * 256) = o;
    }
  }
}

template <int PH>
DI void run_phase(const Params& p, char* smem) {
  constexpr int l = (PH - 1) / 7, s = (PH - 1) % 7;
  if constexpr (PH == 0) phase_mods(p, smem);
  else if constexpr (PH == 15) phase_final(p);
  else if constexpr (s == 0) phase_prep(p, l, smem);
  else if constexpr (s == 1) phase_inproj(p, smem);
  else if constexpr (s == 2) phase_local(p, l, smem);
  else if constexpr (s == 3) phase_mix(p, l, smem);
  else if constexpr (s == 4) phase_scan(p);
  else if constexpr (s == 5) phase_ssdy(p, l, smem);
  else phase_outproj(p, l, smem);
}

#if PROBE_S >= 0
#define PROBE_BEGIN() if (threadIdx.x == 0) pst[1] = wall_clock64();
#define PROBE_END(PH) if (threadIdx.x == 0 && (PH) >= 1 && (PH) <= 14 && (((PH) - 1) % 7) == PROBE_S) pst[0] += wall_clock64() - pst[1];
#else
#define PROBE_BEGIN()
#define PROBE_END(PH)
#endif
#define PHASE(PH) PROBE_BEGIN() run_phase<PH>(p, smem); xcd_barrier(xst); PROBE_END(PH)

__global__ void __launch_bounds__(256, 2) fwd_megakernel(Params p) {
  __shared__ __attribute__((aligned(16))) char smem[57344];
  cg::grid_group grid = cg::this_grid();
#if PROBE_S >= 0
  volatile unsigned long long* pst = (volatile unsigned long long*)(smem + 57344 - 16);
  if (threadIdx.x == 0) { pst[0] = 0; pst[1] = 0; }
#endif
  __shared__ uint4 xb_words;
  volatile LAS unsigned* xst = (volatile LAS unsigned*)&xb_words;
  if (threadIdx.x == 0) xb_words = make_uint4(0u, 0u, 0u, 0u);
  run_phase<0>(p, smem);
  grid.sync();
  if (threadIdx.x == 0) { unsigned* bar = (unsigned*)(load_params().ws + OFF_BAR); (void)xb_add(&bar[XB_XCNT(xb_xcc_id())], 1u); }
  PHASE(1) PHASE(2) PHASE(3) PHASE(4) PHASE(5) PHASE(6) PHASE(7)
  PHASE(8) PHASE(9) PHASE(10) PHASE(11) PHASE(12) PHASE(13) PHASE(14)
  run_phase<15>(p, smem);
#if PROBE_S >= 0
  if (blockIdx.x == 0 && threadIdx.x == 0) {
    const unsigned long long t1 = wall_clock64();
    const unsigned long long lim = 4ull * pst[0];
    while (wall_clock64() - t1 < lim) { __builtin_amdgcn_s_sleep(32); }
  }
#endif
}

extern "C" void kernel_launch(void* const* d_in, const int* in_sizes, int n_in, void* d_out, int out_size, void* d_ws,
                              size_t ws_size, hipStream_t stream) {
  static int grid_blocks = 0;
  if (!grid_blocks) {
    int dev = 0, cus = 0, per_cu = 0;
    hipGetDevice(&dev);
    hipDeviceGetAttribute(&cus, hipDeviceAttributeMultiprocessorCount, dev);
    hipOccupancyMaxActiveBlocksPerMultiprocessor(&per_cu, fwd_megakernel, 256, 0);
    if (per_cu < 1) per_cu = 1;
    if (per_cu > 2) per_cu = 2;
    grid_blocks = (cus * per_cu) & ~7;
  }
  Params p{};
  const float** pp = (const float**)&p;
  for (int i = 0; i < 23; ++i) pp[i] = (const float*)d_in[i];
  p.out = (float*)d_out;
  p.ws = (char*)d_ws;
  void* args[] = {&p};
  hipError_t e = hipLaunchCooperativeKernel((void*)fwd_megakernel, dim3(grid_blocks), dim3(256), args, 0, stream);
  if (e != hipSuccess) fprintf(stderr, "cooperative launch failed: %s (grid %d)\n", hipGetErrorString(e), grid_blocks);
}
```

```cpp
#include <hip/hip_runtime.h>
#include <hip/hip_cooperative_groups.h>
#include <stdint.h>
#include <stdio.h>
namespace cg = cooperative_groups;

#ifndef ONE_LAUNCH
#define ONE_LAUNCH 1
#endif

#ifndef PROBE_S
#define PROBE_S -1
#endif
#define DI __device__ __forceinline__
typedef unsigned short bf16_t;
using bf16x8 = __attribute__((ext_vector_type(8))) short;
using s16x4 = __attribute__((ext_vector_type(4))) short;
using f32x16 = __attribute__((ext_vector_type(16))) float;
#define MFMA(a, b, c) __builtin_amdgcn_mfma_f32_32x32x16_bf16((a), (b), (c), 0, 0, 0)

constexpr int R_ = 17408;
constexpr int RL_ = 16384;
constexpr int NCK = 136;

constexpr size_t SZ_WIN = (size_t)5632 * 1024 * 2;
constexpr size_t SZ_WOUT = (size_t)1024 * 2048 * 2;
constexpr size_t SZ_PW = (size_t)512 * 512 * 2;
constexpr size_t SZ_MODS = (size_t)2 * 5 * 3072 * 4;
constexpr size_t SZ_XC = (size_t)1024 * 1024 * 4;
constexpr size_t SZ_RSTD = (size_t)R_ * 2 * 4;
constexpr size_t SZ_CDEC = (size_t)NCK * 32 * 4 + 256 - ((size_t)NCK * 32 * 4) % 256;
constexpr size_t SZ_R512 = (size_t)R_ * 512 * 2;
constexpr size_t OFF_WIN = 0;
constexpr size_t OFF_WOUT = OFF_WIN + SZ_WIN;
constexpr size_t OFF_PW = OFF_WOUT + SZ_WOUT;
constexpr size_t OFF_MODS = OFF_PW + SZ_PW;
constexpr size_t OFF_XC = OFF_MODS + SZ_MODS;
constexpr size_t OFF_RSTD = OFF_XC + SZ_XC;
constexpr size_t OFF_CDEC = OFF_RSTD + SZ_RSTD;
constexpr size_t OFF_H = OFF_CDEC + SZ_CDEC;
constexpr size_t OFF_XBC = OFF_H + 2 * SZ_R512;
constexpr size_t OFF_GLU = OFF_XBC + 3 * SZ_R512;
constexpr size_t OFF_ST = OFF_XBC;
constexpr size_t OFF_Z = OFF_GLU + SZ_R512;
constexpr size_t OFF_DT = OFF_Z + 2 * SZ_R512;
constexpr size_t OFF_CS = OFF_DT + (size_t)R_ * 32 * 4;
constexpr size_t OFF_Q = OFF_CS + (size_t)R_ * 32 * 4;
constexpr size_t OFF_KV = OFF_Q + SZ_R512;
constexpr size_t OFF_AG = OFF_KV + SZ_R512 / 2;
constexpr size_t OFF_CG = OFF_AG + SZ_R512;
constexpr size_t OFF_BC = OFF_CG + SZ_R512;
constexpr size_t OFF_HDN = OFF_BC + SZ_R512;
constexpr size_t WS_TOTAL = OFF_HDN + SZ_R512;
constexpr size_t OFF_BAR = WS_TOTAL;
static_assert(OFF_BAR + 16384 <= (size_t)256 * 1024 * 1024, "workspace too large");

struct Params {
  const float *x, *c, *ctx, *c_ctx, *w_mod, *b_mod, *norm_w, *w_in, *ssd_conv_w, *ssd_conv_b, *ssd_dt_bias, *ssd_a_log,
      *ssd_d, *ssd_norm_w, *attn_sink, *conv_dw_w, *conv_dw_b, *conv_ln_w, *conv_ln_b, *conv_pw_w, *conv_pw_b, *w_out,
      *final_norm_w;
  float* out;
  char* ws;
};


DI Params load_params() {
  typedef const char __attribute__((address_space(4)))* kptr_t;
  typedef const float* const __attribute__((address_space(4)))* kfld_t;
  size_t off = 0;
  asm volatile("" : "+s"(off));
  kptr_t base = (kptr_t)__builtin_amdgcn_kernarg_segment_ptr() + off;
  Params p;
  const float** pp = (const float**)&p;
#pragma unroll
  for (int i = 0; i < 25; ++i) pp[i] = *(kfld_t)(base + 8 * i);
  return p;
}

#define XB_TMO      128
#define XB_XCNT(j)  (256  + 64 * (j))
#define XB_XSUB(j)  (1280 + 64 * (j))
#define XB_XGEN(j)  (2304 + 64 * (j))
#define XB_TOP      3328
#define XB_TOPGEN   3392
#define XCD_BAR_WORDS 3456
#define XB_SPIN_CAP (1u << 18)
#define LAS __attribute__((address_space(3)))
DI unsigned xb_ld(unsigned* p)              { return __hip_atomic_load(p, __ATOMIC_RELAXED, __HIP_MEMORY_SCOPE_AGENT); }
DI unsigned xb_add(unsigned* p, unsigned v) { return __hip_atomic_fetch_add(p, v, __ATOMIC_RELAXED, __HIP_MEMORY_SCOPE_AGENT); }
DI unsigned xb_xcc_id() { return (unsigned)__builtin_amdgcn_s_getreg((3 << 11) | 20) & 0xFu; }
#define XB_SPIN(cond, bar) do { unsigned _sp = 0; while (cond) { __builtin_amdgcn_s_sleep(1); \
    if ((++_sp & 255u) == 0u) { if (xb_ld(&(bar)[XB_TMO])) break; if (_sp > XB_SPIN_CAP) { atomicAdd(&(bar)[XB_TMO], 1u); break; } } } } while (0)

DI void xcd_barrier_complete(unsigned* bar, unsigned x, unsigned& nloc, unsigned& nx) {
  const unsigned G = gridDim.x * gridDim.y * gridDim.z;
  unsigned sum, cnt, mine, sp = 0u;
  for (;;) {
    sum = 0u; cnt = 0u; mine = 0u;
#pragma unroll
    for (unsigned j = 0; j < 16; ++j) { const unsigned c = xb_ld(&bar[XB_XCNT(j)]); sum += c; cnt += (c > 0u) ? 1u : 0u; mine = (j == x) ? c : mine; }
    if (sum == G) break;
    __builtin_amdgcn_s_sleep(1);
    if ((++sp & 255u) == 0u) { if (xb_ld(&bar[XB_TMO])) break; if (sp > XB_SPIN_CAP) { atomicAdd(&bar[XB_TMO], 1u); break; } }
  }
  nloc = mine > 0u ? mine : 1u; nx = cnt > 0u ? cnt : 1u;
}

DI void xcd_barrier(volatile LAS unsigned* st) {
  asm volatile("s_waitcnt vmcnt(0)" ::: "memory");
  __syncthreads();
  if (threadIdx.x == 0) {
    const Params pb = load_params();
    unsigned* bar = (unsigned*)(pb.ws + OFF_BAR);
    const unsigned x = xb_xcc_id();
    __builtin_amdgcn_s_waitcnt(0);
    unsigned nloc = st[0], nx = st[1];
    if (nloc == 0u) { xcd_barrier_complete(bar, x, nloc, nx); st[0] = nloc; st[1] = nx; }
    const unsigned old = xb_add(&bar[XB_XSUB(x)], 1u);
    const unsigned gen = old / nloc;
    if (old + 1u == (gen + 1u) * nloc) {
      __builtin_amdgcn_fence(__ATOMIC_RELEASE, "agent");
      asm volatile("s_waitcnt vmcnt(0)" ::: "memory");
      const unsigned og = xb_add(&bar[XB_TOP], 1u);
      const unsigned tg = og / nx;
      if (og + 1u == (tg + 1u) * nx) xb_add(&bar[XB_TOPGEN], 1u);
      else XB_SPIN(xb_ld(&bar[XB_TOPGEN]) == tg, bar);
      __builtin_amdgcn_fence(__ATOMIC_ACQUIRE, "agent");
      xb_add(&bar[XB_XGEN(x)], 1u);
      asm volatile("s_waitcnt vmcnt(0)" ::: "memory");
    } else {
      XB_SPIN(xb_ld(&bar[XB_XGEN(x)]) == gen, bar);
      __builtin_amdgcn_fence(__ATOMIC_ACQUIRE, "agent");
      asm volatile("s_waitcnt vmcnt(0)" ::: "memory");
    }
  }
  __syncthreads();
}

DI unsigned short f2bf(float x) { unsigned u = __float_as_uint(x); u += 0x7fffu + ((u >> 16) & 1u); return (unsigned short)(u >> 16); }
DI float bf2f(unsigned short b) { return __uint_as_float(((unsigned)b) << 16); }
DI unsigned pack2(float a, float b) { return (unsigned)f2bf(a) | ((unsigned)f2bf(b) << 16); }
DI float lo2f(unsigned u) { return __uint_as_float(u << 16); }
DI float hi2f(unsigned u) { return __uint_as_float(u & 0xffff0000u); }
DI float silu_f(float x) { return x / (1.f + __expf(-x)); }
DI float sigmoid_f(float x) { return 1.f / (1.f + __expf(-x)); }
DI int crow(int reg, int h) { return (reg & 3) + 8 * (reg >> 2) + 4 * h; }

DI bf16x8 tr_frag(const bf16_t* s, int ld, int row_lo, int row_hi, int col0) {
  const int lane = threadIdx.x & 63;
  const int i16 = lane & 15, q = i16 >> 2, pp = i16 & 3, blk = (lane >> 4) & 1;
  const unsigned a0 = (unsigned)(size_t)(s + (row_lo + q) * ld + col0 + 16 * blk + 4 * pp);
  const unsigned a1 = (unsigned)(size_t)(s + (row_hi + q) * ld + col0 + 16 * blk + 4 * pp);
  s16x4 lo, hi;
  asm volatile("ds_read_b64_tr_b16 %0, %2\n\tds_read_b64_tr_b16 %1, %3\n\ts_waitcnt lgkmcnt(0)"
               : "=&v"(lo), "=&v"(hi) : "v"(a0), "v"(a1) : "memory");
  return __builtin_shufflevector(lo, hi, 0, 1, 2, 3, 4, 5, 6, 7);
}

struct GemmS { bf16_t a[2][128][40]; bf16_t b[2][128][40]; };

template <class AF, class BF>
DI void gemm_core(f32x16 (&acc)[2][2], GemmS* s, AF aptr, BF bptr, int nk) {
  int tid = threadIdx.x; asm volatile("" : "+v"(tid)); const int lane = tid & 63, wave = tid >> 6, wr = wave >> 1, wc = wave & 1;
  const int r0 = tid >> 2, kv = tid & 3;
  const int fr = lane & 31, fh = lane >> 5;
  uint4 ra0 = *(const uint4*)aptr(0, r0, kv), ra1 = *(const uint4*)aptr(0, r0 + 64, kv);
  uint4 rb0 = *(const uint4*)bptr(0, r0, kv), rb1 = *(const uint4*)bptr(0, r0 + 64, kv);
  *(uint4*)&s->a[0][r0][kv * 8] = ra0; *(uint4*)&s->a[0][r0 + 64][kv * 8] = ra1;
  *(uint4*)&s->b[0][r0][kv * 8] = rb0; *(uint4*)&s->b[0][r0 + 64][kv * 8] = rb1;
  __syncthreads();
#pragma unroll 1
  for (int kt = 0; kt < nk; ++kt) {
    const int buf = kt & 1;
    if (kt + 1 < nk) {
      ra0 = *(const uint4*)aptr(kt + 1, r0, kv); ra1 = *(const uint4*)aptr(kt + 1, r0 + 64, kv);
      rb0 = *(const uint4*)bptr(kt + 1, r0, kv); rb1 = *(const uint4*)bptr(kt + 1, r0 + 64, kv);
    }
#pragma unroll
    for (int ks = 0; ks < 2; ++ks) {
      bf16x8 af[2], bq[2];
#pragma unroll
      for (int i = 0; i < 2; ++i) af[i] = *(const bf16x8*)&s->a[buf][wr * 64 + i * 32 + fr][ks * 16 + fh * 8];
#pragma unroll
      for (int j = 0; j < 2; ++j) bq[j] = *(const bf16x8*)&s->b[buf][wc * 64 + j * 32 + fr][ks * 16 + fh * 8];
#pragma unroll
      for (int i = 0; i < 2; ++i)
#pragma unroll
        for (int j = 0; j < 2; ++j) acc[i][j] = MFMA(af[i], bq[j], acc[i][j]);
    }
    if (kt + 1 < nk) {
      *(uint4*)&s->a[buf ^ 1][r0][kv * 8] = ra0; *(uint4*)&s->a[buf ^ 1][r0 + 64][kv * 8] = ra1;
      *(uint4*)&s->b[buf ^ 1][r0][kv * 8] = rb0; *(uint4*)&s->b[buf ^ 1][r0 + 64][kv * 8] = rb1;
    }
    __syncthreads();
  }
}


struct GemmS2 { bf16_t a[128][72]; bf16_t b[128][72]; };
DI void g2_compute(f32x16 (&acc)[2][2], const GemmS2* s, int wr, int wc, int fr, int fh) {
#pragma unroll
  for (int ks = 0; ks < 4; ++ks) {
    bf16x8 af[2], bq[2];
#pragma unroll
    for (int i = 0; i < 2; ++i) af[i] = *(const bf16x8*)&s->a[wr * 64 + i * 32 + fr][ks * 16 + fh * 8];
#pragma unroll
    for (int j = 0; j < 2; ++j) bq[j] = *(const bf16x8*)&s->b[wc * 64 + j * 32 + fr][ks * 16 + fh * 8];
#pragma unroll
    for (int i = 0; i < 2; ++i)
#pragma unroll
      for (int j = 0; j < 2; ++j) acc[i][j] = MFMA(af[i], bq[j], acc[i][j]);
  }
}

template <class AF, class BF, class HK>
DI void gemm_core2(f32x16 (&acc)[2][2], GemmS2* s, AF aptr, BF bptr, int nk, HK hook) {
  int tid = threadIdx.x; asm volatile("" : "+v"(tid));
  const int lane = tid & 63, wave = tid >> 6, wr = wave >> 1, wc = wave & 1;
  const int r0 = tid >> 3, kc = tid & 7;
  const int fr = lane & 31, fh = lane >> 5;
  uint4 p0a0, p0a1, p0a2, p0a3, p0b0, p0b1, p0b2, p0b3, p1a0, p1a1, p1a2, p1a3, p1b0, p1b1, p1b2, p1b3;
#define G2_LOAD(S, KT) { \
    S##a0 = *(const uint4*)aptr((KT), r0, kc);      S##b0 = *(const uint4*)bptr((KT), r0, kc); \
    S##a1 = *(const uint4*)aptr((KT), r0 + 32, kc); S##b1 = *(const uint4*)bptr((KT), r0 + 32, kc); \
    S##a2 = *(const uint4*)aptr((KT), r0 + 64, kc); S##b2 = *(const uint4*)bptr((KT), r0 + 64, kc); \
    S##a3 = *(const uint4*)aptr((KT), r0 + 96, kc); S##b3 = *(const uint4*)bptr((KT), r0 + 96, kc); }
#define G2_STORE(S) { \
    *(uint4*)&s->a[r0][kc * 8] = S##a0;      *(uint4*)&s->b[r0][kc * 8] = S##b0; \
    *(uint4*)&s->a[r0 + 32][kc * 8] = S##a1; *(uint4*)&s->b[r0 + 32][kc * 8] = S##b1; \
    *(uint4*)&s->a[r0 + 64][kc * 8] = S##a2; *(uint4*)&s->b[r0 + 64][kc * 8] = S##b2; \
    *(uint4*)&s->a[r0 + 96][kc * 8] = S##a3; *(uint4*)&s->b[r0 + 96][kc * 8] = S##b3; }
#define G2_COMPUTE() g2_compute(acc, s, wr, wc, fr, fh);
  G2_LOAD(p0, 0)
  G2_LOAD(p1, 1)
  G2_STORE(p0)
  if (nk > 2) G2_LOAD(p0, 2)
  __syncthreads();
#pragma unroll 1
  for (int kt = 0; kt < nk; kt += 2) {
    hook(kt);
    G2_COMPUTE()
    __syncthreads();
    G2_STORE(p1)
    if (kt + 3 < nk) G2_LOAD(p1, kt + 3)
    __syncthreads();
    hook(kt + 1);
    G2_COMPUTE()
    __syncthreads();
    if (kt + 2 < nk) {
      G2_STORE(p0)
      if (kt + 4 < nk) G2_LOAD(p0, kt + 4)
    }
    __syncthreads();
  }
#undef G2_LOAD
#undef G2_STORE
#undef G2_COMPUTE
}


struct GemmS3 { bf16_t a[128][72]; bf16_t b[256][72]; };

template <class AF, class BF>
DI void gemm_core3(f32x16 (&acc)[2][4], GemmS3* s, AF aptr, BF bptr, int nk) {
  int tid = threadIdx.x; asm volatile("" : "+v"(tid));
  const int lane = tid & 63, wave = tid >> 6, wr = wave >> 1, wc = wave & 1;
  const int r0 = tid >> 3, kc = tid & 7;
  const int fr = lane & 31, fh = lane >> 5;
  uint4 a0, a1, a2, a3, b0, b1, b2, b3, b4, b5, b6, b7;
#define G3_LOAD(KT) { \
    a0 = *(const uint4*)aptr((KT), r0, kc);       a1 = *(const uint4*)aptr((KT), r0 + 32, kc); \
    a2 = *(const uint4*)aptr((KT), r0 + 64, kc);  a3 = *(const uint4*)aptr((KT), r0 + 96, kc); \
    b0 = *(const uint4*)bptr((KT), r0, kc);       b1 = *(const uint4*)bptr((KT), r0 + 32, kc); \
    b2 = *(const uint4*)bptr((KT), r0 + 64, kc);  b3 = *(const uint4*)bptr((KT), r0 + 96, kc); \
    b4 = *(const uint4*)bptr((KT), r0 + 128, kc); b5 = *(const uint4*)bptr((KT), r0 + 160, kc); \
    b6 = *(const uint4*)bptr((KT), r0 + 192, kc); b7 = *(const uint4*)bptr((KT), r0 + 224, kc); }
#define G3_STORE() { \
    *(uint4*)&s->a[r0][kc * 8] = a0;       *(uint4*)&s->a[r0 + 32][kc * 8] = a1; \
    *(uint4*)&s->a[r0 + 64][kc * 8] = a2;  *(uint4*)&s->a[r0 + 96][kc * 8] = a3; \
    *(uint4*)&s->b[r0][kc * 8] = b0;       *(uint4*)&s->b[r0 + 32][kc * 8] = b1; \
    *(uint4*)&s->b[r0 + 64][kc * 8] = b2;  *(uint4*)&s->b[r0 + 96][kc * 8] = b3; \
    *(uint4*)&s->b[r0 + 128][kc * 8] = b4; *(uint4*)&s->b[r0 + 160][kc * 8] = b5; \
    *(uint4*)&s->b[r0 + 192][kc * 8] = b6; *(uint4*)&s->b[r0 + 224][kc * 8] = b7; }
  G3_LOAD(0)
  G3_STORE()
  __syncthreads();
#pragma unroll 1
  for (int kt = 0; kt < nk; ++kt) {
    if (kt + 1 < nk) G3_LOAD(kt + 1)
#pragma unroll
    for (int ks = 0; ks < 4; ++ks) {
      bf16x8 af[2], bq[4];
#pragma unroll
      for (int i = 0; i < 2; ++i) af[i] = *(const bf16x8*)&s->a[wr * 64 + i * 32 + fr][ks * 16 + fh * 8];
#pragma unroll
      for (int j = 0; j < 4; ++j) bq[j] = *(const bf16x8*)&s->b[wc * 128 + j * 32 + fr][ks * 16 + fh * 8];
#pragma unroll
      for (int i = 0; i < 2; ++i)
#pragma unroll
        for (int j = 0; j < 4; ++j) acc[i][j] = MFMA(af[i], bq[j], acc[i][j]);
    }
    __syncthreads();
    if (kt + 1 < nk) G3_STORE()
    __syncthreads();
  }
#undef G3_LOAD
#undef G3_STORE
}

template <class EPI>
DI void epilogue_lds2(f32x16 (&acc)[2][4], char* smem, int sub, EPI epi) {
  float* T = (float*)smem;
  int tid = threadIdx.x; asm volatile("" : "+v"(tid));
  const int lane = tid & 63, wave = tid >> 6, wr = wave >> 1, wc = wave & 1, fr = lane & 31, fh = lane >> 5;
#pragma unroll
  for (int i = 0; i < 2; ++i) {
    if (wc == sub) {
#pragma unroll
      for (int j = 0; j < 4; ++j)
#pragma unroll
        for (int r = 0; r < 16; ++r) T[(wr * 32 + crow(r, fh)) * 132 + j * 32 + fr] = acc[i][j][r];
    }
    __syncthreads();
#pragma unroll 2
    for (int e = tid; e < 2048; e += 256) {
      const int tr = e >> 5, c4 = (e & 31) * 4;
      const float4 v = *(const float4*)&T[tr * 132 + c4];
      epi((tr >> 5) * 64 + i * 32 + (tr & 31), c4, v);
    }
    __syncthreads();
  }
}

DI bool xcd_tile(int step, int nM, int nN, int& mt, int& nt) {
  const int xcd = blockIdx.x & 7, nloc = gridDim.x >> 3;
  const int j = (blockIdx.x >> 3) + step * nloc;
  const int mloc = nM >> 3;
  if ((gridDim.x & 7) != 0 || j >= mloc * nN) return false;
  const int per = 8 * nN;
  const int gm = j / per, rem = j - gm * per;
  const int hgt = min(8, mloc - gm * 8);
  const int a = rem % hgt;
  nt = rem / hgt;
  mt = (gm * 8 + a) * 8 + xcd;
  return true;
}

DI void zero_acc(f32x16 (&acc)[2][2]) {
#pragma unroll
  for (int i = 0; i < 2; ++i)
#pragma unroll
    for (int j = 0; j < 2; ++j)
#pragma unroll
      for (int r = 0; r < 16; ++r) acc[i][j][r] = 0.f;
}

template <class EPI>
DI void epilogue_lds(f32x16 (&acc)[2][2], char* smem, EPI epi) {
  float* T = (float*)smem;
  int tid = threadIdx.x; asm volatile("" : "+v"(tid)); const int lane = tid & 63, wave = tid >> 6, wr = wave >> 1, wc = wave & 1, fr = lane & 31, fh = lane >> 5;
#pragma unroll
  for (int i = 0; i < 2; ++i) {
#pragma unroll
    for (int j = 0; j < 2; ++j)
#pragma unroll
      for (int r = 0; r < 16; ++r) T[(wr * 32 + crow(r, fh)) * 132 + wc * 64 + j * 32 + fr] = acc[i][j][r];
    __syncthreads();
#pragma unroll 2
    for (int e = tid; e < 2048; e += 256) {
      const int tr = e >> 5, c4 = (e & 31) * 4;
      const float4 v = *(const float4*)&T[tr * 132 + c4];
      epi((tr >> 5) * 64 + i * 32 + (tr & 31), c4, v);
    }
    __syncthreads();
  }
}

DI void phase_mods(const Params& p_in, char* smem) {
  const Params p = load_params();

  float* ssc = (float*)smem;
  float* red = (float*)(smem + 20480);
  float* mods = (float*)(p.ws + OFF_MODS);
  int tid = threadIdx.x; asm volatile("" : "+v"(tid));
  if (blockIdx.x == 0) { unsigned* bar = (unsigned*)(p.ws + OFF_BAR); for (int i = tid; i < XCD_BAR_WORDS; i += 256) bar[i] = 0u; }
  for (int it = blockIdx.x; it < 96; it += gridDim.x) {
    const int l = it / 48, col0 = (it % 48) * 64;
    __syncthreads();
    for (int e = tid; e < 5120; e += 256) {
      const int v = e >> 10, k = e & 1023;
      const float cv = (v < 4) ? p.c[v * 1024 + k] : p.c_ctx[k];
      ssc[e] = silu_f(cv);
    }
    __syncthreads();
    const int col = tid & 63, kg = tid >> 6;
    float a[5] = {0.f, 0.f, 0.f, 0.f, 0.f};
    const float* w = p.w_mod + (size_t)l * 1024 * 3072 + col0 + col;
    for (int k = kg * 256; k < kg * 256 + 256; k += 8) {
      float wv[8];
#pragma unroll
      for (int u = 0; u < 8; ++u) wv[u] = w[(size_t)(k + u) * 3072];
#pragma unroll
      for (int u = 0; u < 8; ++u)
#pragma unroll
        for (int v = 0; v < 5; ++v) a[v] += ssc[v * 1024 + k + u] * wv[u];
    }
#pragma unroll
    for (int v = 0; v < 5; ++v) red[(kg * 5 + v) * 64 + col] = a[v];
    __syncthreads();
    for (int e = tid; e < 320; e += 256) {
      const int v = e >> 6, cc = e & 63;
      float sum = p.b_mod[l * 3072 + col0 + cc];
      for (int g = 0; g < 4; ++g) sum += red[(g * 5 + v) * 64 + cc];
      mods[(l * 5 + v) * 3072 + col0 + cc] = sum;
    }
  }
}

DI int win_colmap(int n) {
  if (n < 2560) return n;
  if (n < 3840) return n + 32;
  if (n < 4864) {
    const int j = n - 3840, q64 = j >> 6, w = j & 63;
    return (w < 32) ? (3872 + q64 * 32 + w) : (3872 + 512 + q64 * 32 + (w - 32));
  }
  if (n < 5376) return n + 32;
  if (n < 5408) return n - 5376 + 2560;
  return -1;
}

DI void transpose_tile(const float* src, int ldsrc, int kind, const float* rowscale, bf16_t* dst, int lddst, int n0, int k0, float* tile) {
  int tid = threadIdx.x; asm volatile("" : "+v"(tid));
  __syncthreads();
  {
    const int c4 = (tid & 15) * 4, rr = tid >> 4;
    const int n = (kind == 0) ? win_colmap(n0 + c4) : (n0 + c4);
#pragma unroll
    for (int ps = 0; ps < 4; ++ps) {
      const int r = rr + ps * 16, k = k0 + r;
      float4 v = make_float4(0.f, 0.f, 0.f, 0.f);
      if (n >= 0) v = *(const float4*)(src + (size_t)k * ldsrc + n);
      if (rowscale != nullptr && k < 1024) { const float s = rowscale[k]; v.x *= s; v.y *= s; v.z *= s; v.w *= s; }
      tile[r * 65 + c4] = v.x; tile[r * 65 + c4 + 1] = v.y; tile[r * 65 + c4 + 2] = v.z; tile[r * 65 + c4 + 3] = v.w;
    }
  }
  __syncthreads();
  {
    const int k8 = (tid & 7) * 8, nn = tid >> 3;
#pragma unroll
    for (int ps = 0; ps < 2; ++ps) {
      const int r = nn + ps * 32;
      uint4 o;
      o.x = pack2(tile[(k8 + 0) * 65 + r], tile[(k8 + 1) * 65 + r]);
      o.y = pack2(tile[(k8 + 2) * 65 + r], tile[(k8 + 3) * 65 + r]);
      o.z = pack2(tile[(k8 + 4) * 65 + r], tile[(k8 + 5) * 65 + r]);
      o.w = pack2(tile[(k8 + 6) * 65 + r], tile[(k8 + 7) * 65 + r]);
      *(uint4*)(dst + (size_t)(n0 + r) * lddst + k0 + k8) = o;
    }
  }
}

DI void phase_prep(const Params& p_in, int l, char* smem) {
  const Params p = load_params();

  int tid = threadIdx.x; asm volatile("" : "+v"(tid)); const int lane = tid & 63, wave = tid >> 6;
  const float* mods = (const float*)(p.ws + OFF_MODS);
  bf16_t* H = (bf16_t*)(p.ws + OFF_H);
  const int NT_WIN = 88 * 16, NT_WOUT = 16 * 32, NT_PW = 64, NT_CONV = NT_WIN + NT_WOUT + NT_PW;
  const int NT = NT_CONV + R_ / 4;
  for (int it = blockIdx.x; it < NT; it += gridDim.x) {
    if (it < NT_WIN) {
      transpose_tile(p.w_in + (size_t)l * 1024 * 5408, 5408, 0, nullptr, (bf16_t*)(p.ws + OFF_WIN), 1024, (it / 16) * 64, (it % 16) * 64, (float*)smem);
    } else if (it < NT_WIN + NT_WOUT) {
      const int t = it - NT_WIN;
      transpose_tile(p.w_out + (size_t)l * 2048 * 1024, 1024, 1, p.ssd_norm_w + l * 1024, (bf16_t*)(p.ws + OFF_WOUT), 2048, (t / 32) * 64, (t % 32) * 64, (float*)smem);
    } else if (it < NT_CONV) {
      const int t = it - NT_WIN - NT_WOUT;
      transpose_tile(p.conv_pw_w + (size_t)l * 512 * 512, 512, 1, nullptr, (bf16_t*)(p.ws + OFF_PW), 512, (t / 8) * 64, (t % 8) * 64, (float*)smem);
    } else {
      const int rho = (it - NT_CONV) * 4 + wave;
      const float* xs;
      if (l == 0) xs = (rho < RL_) ? (p.x + (size_t)rho * 1024) : (p.ctx + (size_t)(rho - RL_) * 1024);
      else xs = (rho < RL_) ? (p.out + (size_t)rho * 1024) : ((const float*)(p.ws + OFF_XC) + (size_t)(rho - RL_) * 1024);
      const int v = (rho < RL_) ? (rho >> 12) : 4;
      const float* md = mods + (l * 5 + v) * 3072;
      float4 xv[4], nwv[4], shv[4], scv4[4];
      float ss = 0.f;
#pragma unroll
      for (int i = 0; i < 4; ++i) {
        const int cidx = lane * 4 + i * 256;
        xv[i] = *(const float4*)(xs + cidx);
        nwv[i] = *(const float4*)(p.norm_w + l * 1024 + cidx);
        shv[i] = *(const float4*)(md + cidx);
        scv4[i] = *(const float4*)(md + 1024 + cidx);
      }
#pragma unroll
      for (int i = 0; i < 4; ++i) ss += xv[i].x * xv[i].x + xv[i].y * xv[i].y + xv[i].z * xv[i].z + xv[i].w * xv[i].w;
#pragma unroll
      for (int o = 32; o >= 1; o >>= 1) ss += __shfl_xor(ss, o);
      const float rs = rsqrtf(ss * (1.f / 1024.f) + 1e-6f);
#pragma unroll
      for (int i = 0; i < 4; ++i) {
        const int cidx = lane * 4 + i * 256;
        const float4 nw = nwv[i], sh = shv[i], sc = scv4[i];
        uint2 o;
        o.x = pack2(xv[i].x * rs * nw.x * (1.f + sc.x) + sh.x, xv[i].y * rs * nw.y * (1.f + sc.y) + sh.y);
        o.y = pack2(xv[i].z * rs * nw.z * (1.f + sc.z) + sh.z, xv[i].w * rs * nw.w * (1.f + sc.w) + sh.w);
        *(uint2*)(H + (size_t)rho * 1024 + cidx) = o;
      }
    }
  }
}

DI void phase_inproj(const Params& p_in, char* smem) {
  const Params p = load_params();
  int tid = threadIdx.x; asm volatile("" : "+v"(tid)); const int wave = tid >> 6, wc = wave & 1;
  const bf16_t* H = (const bf16_t*)(p.ws + OFF_H);
  const bf16_t* W = (const bf16_t*)(p.ws + OFF_WIN);
  for (int step = 0;; ++step) {
    int mt, nt2;
    if (!xcd_tile(step, NCK, 22, mt, nt2)) break;
    f32x16 acc[2][4];
#pragma unroll
    for (int i = 0; i < 2; ++i)
#pragma unroll
      for (int j = 0; j < 4; ++j)
#pragma unroll
        for (int r = 0; r < 16; ++r) acc[i][j][r] = 0.f;
    const bf16_t* Ab = H + (size_t)mt * 128 * 1024;
    const bf16_t* Bb = W + (size_t)nt2 * 256 * 1024;
    gemm_core3(acc, (GemmS3*)smem,
               [&](int kt, int r, int kv) { return Ab + (size_t)r * 1024 + kt * 64 + kv * 8; },
               [&](int kt, int r, int kv) { return Bb + (size_t)r * 1024 + kt * 64 + kv * 8; }, 16);
    const int row0 = mt * 128;
    {
      const int ntw = nt2 * 2 + wc;
      if (ntw >= 30 && ntw < 38) {
#pragma unroll
        for (int i = 0; i < 2; ++i)
#pragma unroll
          for (int r = 0; r < 16; ++r) {
            acc[i][0][r] = acc[i][0][r] * sigmoid_f(acc[i][1][r]);
            acc[i][2][r] = acc[i][2][r] * sigmoid_f(acc[i][3][r]);
          }
      }
    }
#pragma unroll 1
    for (int sub = 0; sub < 2; ++sub) {
      const int nt = nt2 * 2 + sub;
      if (nt >= 43) break;
      if (nt >= 30 && nt < 38) {
        bf16_t* G = (bf16_t*)(p.ws + OFF_GLU);
        const int cb0 = (nt - 30) * 64;
        epilogue_lds2(acc, smem, sub, [&](int rl, int c4, float4 v) {
          if ((c4 & 32) == 0) {
            uint2 o; o.x = pack2(v.x, v.y); o.y = pack2(v.z, v.w);
            *(uint2*)(G + (size_t)(row0 + rl) * 512 + cb0 + (c4 >> 6) * 32 + (c4 & 31)) = o;
          }
        });
      } else if (nt == 42) {
        float* DT = (float*)(p.ws + OFF_DT);
        epilogue_lds2(acc, smem, sub, [&](int rl, int c4, float4 v) {
          if (c4 < 32) *(float4*)(DT + (size_t)(row0 + rl) * 32 + c4) = v;
        });
      } else {
        bf16_t* dst; int ld, cb;
        if (nt < 12) { dst = (bf16_t*)(p.ws + OFF_XBC); ld = 1536; cb = nt * 128; }
        else if (nt < 20) { dst = (bf16_t*)(p.ws + OFF_Z); ld = 1024; cb = nt * 128 - 1536; }
        else if (nt < 24) { dst = (bf16_t*)(p.ws + OFF_Q); ld = 512; cb = nt * 128 - 2560; }
        else if (nt < 26) { dst = (bf16_t*)(p.ws + OFF_KV); ld = 256; cb = nt * 128 - 3072; }
        else if (nt < 30) { dst = (bf16_t*)(p.ws + OFF_AG); ld = 512; cb = nt * 128 - 3328; }
        else { dst = (bf16_t*)(p.ws + OFF_CG); ld = 512; cb = nt * 128 - 4864; }
        epilogue_lds2(acc, smem, sub, [&](int rl, int c4, float4 v) {
          uint2 o; o.x = pack2(v.x, v.y); o.y = pack2(v.z, v.w);
          *(uint2*)(dst + (size_t)(row0 + rl) * ld + cb + c4) = o;
        });
      }
    }
  }
}

DI void phase_local(const Params& p_in, int l, char* smem) {
  const Params p = load_params();

  int tid = threadIdx.x; asm volatile("" : "+v"(tid)); const int lane = tid & 63;
  const bf16_t* XBC = (const bf16_t*)(p.ws + OFF_XBC);
  bf16_t* XS = (bf16_t*)(p.ws + OFF_H);
  bf16_t* BC = (bf16_t*)(p.ws + OFF_BC);
  float* DT = (float*)(p.ws + OFF_DT);
  float* CS = (float*)(p.ws + OFF_CS);
  const bf16_t* GLU = (const bf16_t*)(p.ws + OFF_GLU);
  bf16_t* HDN = (bf16_t*)(p.ws + OFF_HDN);
  bf16_t* Q = (bf16_t*)(p.ws + OFF_Q);
  bf16_t* KV = (bf16_t*)(p.ws + OFF_KV);
  { float* SSQ = (float*)(p.ws + OFF_RSTD); for (int i = blockIdx.x * 256 + tid; i < R_ * 2; i += gridDim.x * 256) SSQ[i] = 0.f; }
  const int N_CONV = (R_ / 8) * 192 / 256;
  const int N_DT = NCK;
  const int N_CF = R_ / 16;
  const int N_ROPE = RL_ * 40 / 256;
  const int N_QC = 1024 * 256 / 256;
  const int NT = N_CF + N_DT + N_CONV + N_ROPE + N_QC;
  for (int it0 = blockIdx.x; it0 < NT; it0 += gridDim.x) {
    int it = it0;
    if (it < N_CF) {
      float* sst = (float*)smem;
      unsigned* sIn = (unsigned*)(smem + 256);
      const int row0 = it * 16;
      const int seq0 = (row0 < RL_) ? (row0 & ~4095) : (RL_ + ((row0 - RL_) & ~255));
      const int slen = (row0 < RL_) ? 4096 : 256;
      const int t0 = row0 - seq0;
      const int c0 = tid * 2;
      __syncthreads();
      if (tid < 32) sst[tid] = 0.f;
      for (int idx = tid; idx < 46 * 64; idx += 256) {
        const int rr = idx >> 6, c16 = idx & 63;
        const int tt = t0 - 15 + rr;
        uint4 val = make_uint4(0u, 0u, 0u, 0u);
        if (tt >= 0 && tt < slen) val = *(const uint4*)(GLU + (size_t)(seq0 + tt) * 512 + c16 * 8);
        *(uint4*)&sIn[rr * 256 + c16 * 4] = val;
      }
      float w0[31], w1[31];
#pragma unroll
      for (int k = 0; k < 31; ++k) {
        const float2 wv = *(const float2*)(p.conv_dw_w + ((size_t)l * 31 + k) * 512 + c0);
        w0[k] = wv.x; w1[k] = wv.y;
      }
      const float2 bv = *(const float2*)(p.conv_dw_b + l * 512 + c0);
      float a0[16], a1[16];
#pragma unroll
      for (int r = 0; r < 16; ++r) { a0[r] = bv.x; a1[r] = bv.y; }
      __syncthreads();
#pragma unroll
      for (int tp = 0; tp < 46; ++tp) {
        const unsigned u = sIn[tp * 256 + tid];
        const float x0 = lo2f(u), x1 = hi2f(u);
#pragma unroll
        for (int r = 0; r < 16; ++r) {
          const int k = tp - r;
          if (k >= 0 && k < 31) { a0[r] += w0[k] * x0; a1[r] += w1[k] * x1; }
        }
      }
      {
        float v[32];
#pragma unroll
        for (int r = 0; r < 16; ++r) { v[2 * r] = a0[r] + a1[r]; v[2 * r + 1] = a0[r] * a0[r] + a1[r] * a1[r]; }
#pragma unroll
        for (int i = 0; i < 16; ++i) { const bool up = (lane & 32) != 0; const float keep = up ? v[i + 16] : v[i]; const float send = up ? v[i] : v[i + 16]; v[i] = keep + __shfl_xor(send, 32); }
#pragma unroll
        for (int i = 0; i < 8; ++i) { const bool up = (lane & 16) != 0; const float keep = up ? v[i + 8] : v[i]; const float send = up ? v[i] : v[i + 8]; v[i] = keep + __shfl_xor(send, 16); }
#pragma unroll
        for (int i = 0; i < 4; ++i) { const bool up = (lane & 8) != 0; const float keep = up ? v[i + 4] : v[i]; const float send = up ? v[i] : v[i + 4]; v[i] = keep + __shfl_xor(send, 8); }
#pragma unroll
        for (int i = 0; i < 2; ++i) { const bool up = (lane & 4) != 0; const float keep = up ? v[i + 2] : v[i]; const float send = up ? v[i] : v[i + 2]; v[i] = keep + __shfl_xor(send, 4); }
        { const bool up = (lane & 2) != 0; const float keep = up ? v[1] : v[0]; const float send = up ? v[0] : v[1]; v[0] = keep + __shfl_xor(send, 2); }
        v[0] += __shfl_xor(v[0], 1);
        __syncthreads();
        if ((lane & 1) == 0) atomicAdd(&sst[lane >> 1], v[0]);
      }
      __syncthreads();
      const float2 lw = *(const float2*)(p.conv_ln_w + l * 512 + c0);
      const float2 lb = *(const float2*)(p.conv_ln_b + l * 512 + c0);
#pragma unroll
      for (int r = 0; r < 16; ++r) {
        const float mean = sst[r * 2] * (1.f / 512.f);
        const float var = fmaxf(sst[r * 2 + 1] * (1.f / 512.f) - mean * mean, 0.f);
        const float rs = rsqrtf(var + 1e-6f);
        const float y0 = (a0[r] - mean) * rs * lw.x + lb.x;
        const float y1 = (a1[r] - mean) * rs * lw.y + lb.y;
        *(unsigned*)(HDN + (size_t)(row0 + r) * 512 + c0) = pack2(silu_f(y0), silu_f(y1));
      }
      continue;
    }
    it -= N_CF;
    if (it < N_DT) {
      float* sdt = (float*)smem;
      const int row0 = it * 128;
      __syncthreads();
      for (int e = tid; e < 4096; e += 256) {
        const int r = e >> 5, cidx = e & 31;
        const float raw = DT[(size_t)(row0 + r) * 32 + cidx] + p.ssd_dt_bias[l * 32 + cidx];
        const float sp = (raw > 20.f) ? raw : log1pf(expf(raw));
        DT[(size_t)(row0 + r) * 32 + cidx] = sp;
        sdt[r * 33 + cidx] = sp;
      }
      __syncthreads();
      if (tid < 32) {
        const float a = -expf(p.ssd_a_log[l * 32 + tid]);
        float run = 0.f;
        if (tid < 16) {
          for (int r = 0; r < 128; ++r) { run += sdt[r * 33 + tid] * a; CS[(size_t)(row0 + r) * 32 + tid] = run; }
        } else {
          for (int r = 127; r >= 0; --r) { run += sdt[r * 33 + tid] * a; CS[(size_t)(row0 + r) * 32 + tid] = run; }
        }
      }
      continue;
    }
    it -= N_DT;
    if (it < N_CONV) {
      const int e = it * 256 + tid;
      const int rb = e / 192, cgp = e % 192, ch0 = cgp * 8;
      const int rho0 = rb * 8;
      const int seq0 = (rho0 < RL_) ? (rho0 & ~4095) : (RL_ + ((rho0 - RL_) & ~255));
      const int slen = (rho0 < RL_) ? 4096 : 256;
      const int t0 = rho0 - seq0;
      uint4 xr[12];
#pragma unroll
      for (int i = 0; i < 12; ++i) {
        const int tt = t0 + i - 2;
        xr[i] = make_uint4(0u, 0u, 0u, 0u);
        if (tt >= 0 && tt < slen) xr[i] = *(const uint4*)(XBC + (size_t)(seq0 + tt) * 1536 + ch0);
      }
      float wk[5][8];
#pragma unroll
      for (int k = 0; k < 5; ++k) {
        const float4 w0 = *(const float4*)(p.ssd_conv_w + ((size_t)l * 5 + k) * 1536 + ch0);
        const float4 w1 = *(const float4*)(p.ssd_conv_w + ((size_t)l * 5 + k) * 1536 + ch0 + 4);
        wk[k][0] = w0.x; wk[k][1] = w0.y; wk[k][2] = w0.z; wk[k][3] = w0.w; wk[k][4] = w1.x; wk[k][5] = w1.y; wk[k][6] = w1.z; wk[k][7] = w1.w;
      }
      float bias[8];
      {
        const float4 b0 = *(const float4*)(p.ssd_conv_b + l * 1536 + ch0);
        const float4 b1 = *(const float4*)(p.ssd_conv_b + l * 1536 + ch0 + 4);
        bias[0] = b0.x; bias[1] = b0.y; bias[2] = b0.z; bias[3] = b0.w; bias[4] = b1.x; bias[5] = b1.y; bias[6] = b1.z; bias[7] = b1.w;
      }
#pragma unroll
      for (int r = 0; r < 8; ++r) {
        float a[8];
#pragma unroll
        for (int c = 0; c < 8; ++c) a[c] = bias[c];
#pragma unroll
        for (int k = 0; k < 5; ++k) {
          const uint4 u = xr[r + k];
          a[0] += wk[k][0] * lo2f(u.x); a[1] += wk[k][1] * hi2f(u.x); a[2] += wk[k][2] * lo2f(u.y); a[3] += wk[k][3] * hi2f(u.y);
          a[4] += wk[k][4] * lo2f(u.z); a[5] += wk[k][5] * hi2f(u.z); a[6] += wk[k][6] * lo2f(u.w); a[7] += wk[k][7] * hi2f(u.w);
        }
        uint4 o;
        o.x = pack2(silu_f(a[0]), silu_f(a[1])); o.y = pack2(silu_f(a[2]), silu_f(a[3]));
        o.z = pack2(silu_f(a[4]), silu_f(a[5])); o.w = pack2(silu_f(a[6]), silu_f(a[7]));
        const size_t rho = (size_t)(rho0 + r);
        if (ch0 < 1024) *(uint4*)(XS + rho * 1024 + ch0) = o;
        else *(uint4*)(BC + rho * 512 + (ch0 - 1024)) = o;
      }
      continue;
    }
    it -= N_CONV;
    if (it < N_ROPE) {
      const int e = it * 256 + tid;
      const int rho = e / 40, rem = e % 40, hd = rem >> 2, sub = rem & 3;
      const int axis = sub >> 1, half = sub & 1;
      const int t = rho & 4095;
      const float pos = (float)(axis == 0 ? (t >> 6) : (t & 63));
      bf16_t* base = ((hd < 8) ? (Q + (size_t)rho * 512 + hd * 64) : (KV + (size_t)rho * 256 + (hd - 8) * 64)) + axis * 32 + half * 8;
      const float sc = (hd < 8) ? 0.125f : 1.f;
      const uint4 u1 = *(const uint4*)base, u2 = *(const uint4*)(base + 16);
      const unsigned a1[4] = {u1.x, u1.y, u1.z, u1.w}, a2[4] = {u2.x, u2.y, u2.z, u2.w};
      unsigned o1[4], o2[4];
#pragma unroll
      for (int i = 0; i < 4; ++i) {
        float r1[2], r2[2];
#pragma unroll
        for (int hl = 0; hl < 2; ++hl) {
          const float f = (float)(half * 8 + 2 * i + hl);
          const float ang = pos * exp2f(-f * 0.8304820237218406f);
          const float cs = __cosf(ang), sn = __sinf(ang);
          const float t1 = hl ? hi2f(a1[i]) : lo2f(a1[i]);
          const float t2 = hl ? hi2f(a2[i]) : lo2f(a2[i]);
          r1[hl] = (t1 * cs - t2 * sn) * sc;
          r2[hl] = (t2 * cs + t1 * sn) * sc;
        }
        o1[i] = pack2(r1[0], r1[1]); o2[i] = pack2(r2[0], r2[1]);
      }
      *(uint4*)base = make_uint4(o1[0], o1[1], o1[2], o1[3]);
      *(uint4*)(base + 16) = make_uint4(o2[0], o2[1], o2[2], o2[3]);
      continue;
    }
    it -= N_ROPE;
    {
      const int e = it * 256 + tid;
      const int rho = RL_ + e / 256, c2 = (e % 256) * 2;
      unsigned* ptr = (unsigned*)(Q + (size_t)rho * 512 + c2);
      const unsigned u = *ptr;
      *ptr = pack2(lo2f(u) * 0.125f, hi2f(u) * 0.125f);
    }
  }
}

DI void attn_item(const Params& p_in, int l, char* smem, int b, int qblk, int g, int hp, bool ctxq) {
  const Params p = load_params();

  bf16_t* sK = (bf16_t*)smem;
  bf16_t* sV = (bf16_t*)(smem + 128 * 72 * 2);
  int tid = threadIdx.x; asm volatile("" : "+v"(tid)); const int lane = tid & 63, wave = tid >> 6, fr = lane & 31, fh = lane >> 5;
  const int head = g * 4 + hp * 2 + (wave >> 1);
  const int qh = wave & 1;
  const int qrow0 = (ctxq ? (RL_ + b * 256) : (b * 4096)) + qblk * 128 + qh * 64;
  const int qpos0 = qblk * 128 + qh * 64;
  bf16_t* Q = (bf16_t*)(p.ws + OFF_Q);
  const bf16_t* KV = (const bf16_t*)(p.ws + OFF_KV);
  const bf16_t* AG = (const bf16_t*)(p.ws + OFF_AG);
  bf16x8 qf[2][4];
#pragma unroll
  for (int j = 0; j < 2; ++j)
#pragma unroll
    for (int ks = 0; ks < 4; ++ks)
      qf[j][ks] = *(const bf16x8*)(Q + (size_t)(qrow0 + j * 32 + fr) * 512 + head * 64 + ks * 16 + fh * 8);
  f32x16 o[2][2];
  zero_acc(o);
  float m[2], lsum[2];
  m[0] = m[1] = p.attn_sink[l * 8 + head];
  lsum[0] = lsum[1] = 1.f;
  const int nblk = ctxq ? 2 : 5;
  for (int bi = 0; bi < nblk; ++bi) {
    int krow0, kpos0 = 0;
    bool masked = false;
    if (bi < 2) {
      krow0 = RL_ + b * 256 + bi * 128;
    } else {
      const int kb = qblk + bi - 3;
      if (kb < 0 || kb >= 32) continue;
      krow0 = b * 4096 + kb * 128;
      kpos0 = kb * 128;
      masked = (bi != 3);
    }
    __syncthreads();
    for (int v = tid; v < 1024; v += 256) {
      const int r = v >> 3, cv = v & 7;
      *(uint4*)&sK[r * 72 + cv * 8] = *(const uint4*)(KV + (size_t)(krow0 + r) * 256 + g * 64 + cv * 8);
      *(uint4*)&sV[r * 72 + cv * 8] = *(const uint4*)(KV + (size_t)(krow0 + r) * 256 + 128 + g * 64 + cv * 8);
    }
    __syncthreads();
#pragma unroll 1
    for (int kb = 0; kb < 4; ++kb) {
      f32x16 st[2];
#pragma unroll
      for (int j = 0; j < 2; ++j)
#pragma unroll
        for (int r = 0; r < 16; ++r) st[j][r] = 0.f;
#pragma unroll
      for (int ks = 0; ks < 4; ++ks) {
        const bf16x8 kf = *(const bf16x8*)&sK[(kb * 32 + fr) * 72 + ks * 16 + fh * 8];
#pragma unroll
        for (int j = 0; j < 2; ++j) st[j] = MFMA(kf, qf[j][ks], st[j]);
      }
      bf16x8 pb[2][2];
#pragma unroll
      for (int j = 0; j < 2; ++j) {
        if (masked) {
          const int qpos = qpos0 + j * 32 + fr;
#pragma unroll
          for (int r = 0; r < 16; ++r) {
            const int d = qpos - (kpos0 + kb * 32 + crow(r, fh));
            if (d > 128 || d < -128) st[j][r] = -1e30f;
          }
        }
        float mx = st[j][0];
#pragma unroll
        for (int r = 1; r < 16; ++r) mx = fmaxf(mx, st[j][r]);
        mx = fmaxf(mx, __shfl_xor(mx, 32));
        const float mnew = fmaxf(m[j], mx);
        const float alpha = __expf(m[j] - mnew);
        float rs = 0.f;
#pragma unroll
        for (int r = 0; r < 16; ++r) { const float pv = __expf(st[j][r] - mnew); st[j][r] = pv; rs += pv; }
        rs += __shfl_xor(rs, 32);
        lsum[j] = lsum[j] * alpha + rs;
        m[j] = mnew;
#pragma unroll
        for (int mt = 0; mt < 2; ++mt)
#pragma unroll
          for (int r = 0; r < 16; ++r) o[mt][j][r] *= alpha;
#pragma unroll
        for (int s = 0; s < 2; ++s)
#pragma unroll
          for (int jj = 0; jj < 8; ++jj) pb[j][s][jj] = (short)f2bf(st[j][8 * s + jj]);
      }
#pragma unroll
      for (int s = 0; s < 2; ++s)
#pragma unroll
        for (int mt = 0; mt < 2; ++mt) {
          const bf16x8 vf = tr_frag(sV, 72, kb * 32 + 16 * s + 4 * fh, kb * 32 + 16 * s + 8 + 4 * fh, mt * 32);
#pragma unroll
          for (int j = 0; j < 2; ++j) o[mt][j] = MFMA(vf, pb[j][s], o[mt][j]);
        }
    }
  }
#pragma unroll
  for (int j = 0; j < 2; ++j) {
    const float inv = 1.f / lsum[j];
    const size_t rho = (size_t)(qrow0 + j * 32 + fr);
#pragma unroll
    for (int mt = 0; mt < 2; ++mt)
#pragma unroll
      for (int g4 = 0; g4 < 4; ++g4) {
        const int d0 = mt * 32 + 8 * g4 + 4 * fh;
        const uint2 gv = *(const uint2*)(AG + rho * 512 + head * 64 + d0);
        uint2 ov;
        ov.x = pack2(o[mt][j][g4 * 4 + 0] * inv * silu_f(lo2f(gv.x)), o[mt][j][g4 * 4 + 1] * inv * silu_f(hi2f(gv.x)));
        ov.y = pack2(o[mt][j][g4 * 4 + 2] * inv * silu_f(lo2f(gv.y)), o[mt][j][g4 * 4 + 3] * inv * silu_f(hi2f(gv.y)));
        *(uint2*)(Q + rho * 512 + head * 64 + d0) = ov;
      }
  }
}

DI void states_item(const Params& p_in, char* smem, int ck, int g, int hq) {
  const Params p = load_params();

  bf16_t* sB = (bf16_t*)smem;
  bf16_t* sX = (bf16_t*)(smem + 128 * 136 * 2);
  int tid = threadIdx.x; asm volatile("" : "+v"(tid)); const int lane = tid & 63, wave = tid >> 6, wr = wave >> 1, wc = wave & 1, fr = lane & 31, fh = lane >> 5;
  const bf16_t* BC = (const bf16_t*)(p.ws + OFF_BC);
  const bf16_t* XS = (const bf16_t*)(p.ws + OFF_H);
  const float* DT = (const float*)(p.ws + OFF_DT);
  const float* CS = (const float*)(p.ws + OFF_CS);
  bf16_t* ST = (bf16_t*)(p.ws + OFF_ST);
  float* CDEC = (float*)(p.ws + OFF_CDEC);
  const int row0 = ck * 128;
  __syncthreads();
  for (int v = tid; v < 2048; v += 256) {
    const int r = v >> 4, cv = v & 15;
    *(uint4*)&sB[r * 136 + cv * 8] = *(const uint4*)(BC + (size_t)(row0 + r) * 512 + g * 128 + cv * 8);
  }
  __syncthreads();
  bf16x8 bfr[2][8];
#pragma unroll
  for (int j = 0; j < 2; ++j)
#pragma unroll
    for (int ks = 0; ks < 8; ++ks) bfr[j][ks] = tr_frag(sB, 136, ks * 16 + 8 * fh, ks * 16 + 8 * fh + 4, wc * 64 + j * 32);
  const int slr = tid >> 3, scv = tid & 7;
  uint4 xq0, xq1, xq2, xq3;
  float dq0, dq1, dq2, dq3, cq0, cq1, cq2, cq3, cendq;
#define ST_PREFETCH(HD) { const int head_ = g * 8 + hq * 4 + ((HD) >> 1), d_ = (HD) & 1, col_ = d_ * 16 + head_; \
    const bf16_t* xp_ = XS + (size_t)(row0 + slr) * 1024 + head_ * 64 + scv * 8; \
    xq0 = *(const uint4*)(xp_); xq1 = *(const uint4*)(xp_ + 32 * 1024); xq2 = *(const uint4*)(xp_ + 64 * 1024); xq3 = *(const uint4*)(xp_ + 96 * 1024); \
    const size_t rb_ = (size_t)(row0 + slr) * 32 + col_; \
    dq0 = DT[rb_]; dq1 = DT[rb_ + 32 * 32]; dq2 = DT[rb_ + 64 * 32]; dq3 = DT[rb_ + 96 * 32]; \
    cq0 = CS[rb_]; cq1 = CS[rb_ + 32 * 32]; cq2 = CS[rb_ + 64 * 32]; cq3 = CS[rb_ + 96 * 32]; \
    cendq = CS[(size_t)(row0 + (d_ == 0 ? 127 : 0)) * 32 + col_]; }
#define ST_SCALE_STORE(X, DTV, CSV, ROW) { const float sc_ = (DTV) * __expf(cend - (CSV)); uint4 o_; \
    o_.x = pack2(lo2f(X.x) * sc_, hi2f(X.x) * sc_); o_.y = pack2(lo2f(X.y) * sc_, hi2f(X.y) * sc_); \
    o_.z = pack2(lo2f(X.z) * sc_, hi2f(X.z) * sc_); o_.w = pack2(lo2f(X.w) * sc_, hi2f(X.w) * sc_); \
    *(uint4*)&sX[(ROW) * 72 + scv * 8] = o_; }
  ST_PREFETCH(0)
#pragma unroll 1
  for (int hd = 0; hd < 8; ++hd) {
    const int head = g * 8 + hq * 4 + (hd >> 1), d = hd & 1;
    const float cend = cendq;
    ST_SCALE_STORE(xq0, dq0, cq0, slr)
    ST_SCALE_STORE(xq1, dq1, cq1, slr + 32)
    ST_SCALE_STORE(xq2, dq2, cq2, slr + 64)
    ST_SCALE_STORE(xq3, dq3, cq3, slr + 96)
    if (hd < 7) ST_PREFETCH(hd + 1)
    __syncthreads();
    f32x16 acc[2];
#pragma unroll
    for (int j = 0; j < 2; ++j)
#pragma unroll
      for (int r = 0; r < 16; ++r) acc[j][r] = 0.f;
#pragma unroll
    for (int ks = 0; ks < 8; ++ks) {
      const bf16x8 af = tr_frag(sX, 72, ks * 16 + 8 * fh, ks * 16 + 8 * fh + 4, wr * 32);
#pragma unroll
      for (int j = 0; j < 2; ++j) acc[j] = MFMA(af, bfr[j][ks], acc[j]);
    }
    bf16_t* dst = ST + ((size_t)(ck * 2 + d) * 16 + head) * 8192;
#pragma unroll
    for (int j = 0; j < 2; ++j)
#pragma unroll
      for (int r = 0; r < 16; ++r) dst[(wr * 32 + crow(r, fh)) * 128 + wc * 64 + j * 32 + fr] = f2bf(acc[j][r]);
    if (tid == 0) CDEC[(ck * 2 + d) * 16 + head] = __expf(cend);
    __syncthreads();
  }
}

DI void pw_item(const Params& p_in, int l, char* smem, int mt, int nt) {
  const Params p = load_params();

  GemmS* s = (GemmS*)smem;
  int tid = threadIdx.x; asm volatile("" : "+v"(tid)); const int lane = tid & 63, wave = tid >> 6, wr = wave >> 1, wc = wave & 1, fr = lane & 31, fh = lane >> 5;
  const bf16_t* Ab = (const bf16_t*)(p.ws + OFF_HDN) + (size_t)mt * 128 * 512;
  const bf16_t* Bb = (const bf16_t*)(p.ws + OFF_PW) + (size_t)nt * 128 * 512;
  bf16_t* CG = (bf16_t*)(p.ws + OFF_CG);
  f32x16 acc[2][2];
  zero_acc(acc);
  gemm_core2(acc, (GemmS2*)smem,
             [&](int kt, int r, int kv) { return Ab + (size_t)r * 512 + kt * 64 + kv * 8; },
             [&](int kt, int r, int kv) { return Bb + (size_t)r * 512 + kt * 64 + kv * 8; }, 8, [](int) {});
  const float* pwb = p.conv_pw_b + l * 512 + nt * 128;
  epilogue_lds(acc, smem, [&](int rl, int c4, float4 v) {
    bf16_t* ptr = CG + (size_t)(mt * 128 + rl) * 512 + nt * 128 + c4;
    const uint2 gv = *(const uint2*)ptr;
    const float4 bb = *(const float4*)(pwb + c4);
    uint2 o;
    o.x = pack2((v.x + bb.x) * silu_f(lo2f(gv.x)), (v.y + bb.y) * silu_f(hi2f(gv.x)));
    o.y = pack2((v.z + bb.z) * silu_f(lo2f(gv.y)), (v.w + bb.w) * silu_f(hi2f(gv.y)));
    *(uint2*)ptr = o;
  });
}

DI void phase_mix(const Params& p, int l, char* smem) {
  const int G = gridDim.x;
  const int N_ATT = 512 + (l == 0 ? 32 : 0);
  for (int it = blockIdx.x; it < N_ATT; it += G) {
    if (it < 512) attn_item(p, l, smem, it >> 7, (it >> 2) & 31, (it >> 1) & 1, it & 1, false);
    else { const int t = it - 512; attn_item(p, l, smem, t >> 3, (t >> 2) & 1, (t >> 1) & 1, t & 1, true); }
  }
  for (int it = (blockIdx.x + G - 32) % G; it < NCK * 4; it += G) states_item(p, smem, it >> 2, (it >> 1) & 1, it & 1);
  for (int it = (blockIdx.x + G - 64) % G; it < NCK * 4; it += G) pw_item(p, l, smem, it >> 2, it & 3);
}

DI void phase_scan(const Params& p_in) {
  const Params p = load_params();

  bf16_t* ST = (bf16_t*)(p.ws + OFF_ST);
  const float* CDEC = (const float*)(p.ws + OFF_CDEC);
  for (int it = blockIdx.x; it < 512; it += gridDim.x) {
    const int e = it * 256 + threadIdx.x;
    const int bdh = e >> 10, v8 = e & 1023;
    const int b = bdh >> 5, d = (bdh >> 4) & 1, h = bdh & 15;
    float s[8];
#pragma unroll
    for (int i = 0; i < 8; ++i) s[i] = 0.f;
    auto ckof = [&](int i) {
      if (d == 0) return (i < 2) ? (128 + 2 * b + i) : (32 * b + (i - 2));
      return (i < 2) ? (128 + 2 * b + (1 - i)) : (32 * b + 31 - (i - 2));
    };
    auto pof = [&](int i) { const int ck = ckof(i); return (uint4*)(ST + ((size_t)(ck * 2 + d) * 16 + h) * 8192 + v8 * 8); };
    auto dof = [&](int i) { const int ck = ckof(i); return CDEC[(ck * 2 + d) * 16 + h]; };
    uint4 buf[4]; float dc[4];
#pragma unroll
    for (int i = 0; i < 3; ++i) { buf[i] = *pof(i); dc[i] = dof(i); }
#pragma unroll
    for (int i = 0; i < 34; ++i) {
      if (i + 3 < 34) { buf[(i + 3) & 3] = *pof(i + 3); dc[(i + 3) & 3] = dof(i + 3); }
      const uint4 cur = buf[i & 3];
      const float dec = dc[i & 3];
      uint4 o;
      o.x = pack2(s[0], s[1]); o.y = pack2(s[2], s[3]); o.z = pack2(s[4], s[5]); o.w = pack2(s[6], s[7]);
      *pof(i) = o;
      s[0] = s[0] * dec + lo2f(cur.x); s[1] = s[1] * dec + hi2f(cur.x);
      s[2] = s[2] * dec + lo2f(cur.y); s[3] = s[3] * dec + hi2f(cur.y);
      s[4] = s[4] * dec + lo2f(cur.z); s[5] = s[5] * dec + hi2f(cur.z);
      s[6] = s[6] * dec + lo2f(cur.w); s[7] = s[7] * dec + hi2f(cur.w);
    }
  }
}

DI void phase_ssdy(const Params& p_in, int l, char* smem) {
  const Params p = load_params();

  bf16_t* sB = (bf16_t*)smem;
  bf16_t* sX = (bf16_t*)(smem + 128 * 136 * 2);
  float* sF = (float*)(smem + 128 * 136 * 2 + 128 * 72 * 2);
  float* sSS = sF + 512;
  int tid = threadIdx.x; asm volatile("" : "+v"(tid)); const int lane = tid & 63, wave = tid >> 6, fr = lane & 31, fh = lane >> 5;
  const int wl = wave >> 1, w2 = wave & 1;
  const bf16_t* BC = (const bf16_t*)(p.ws + OFF_BC);
  const bf16_t* XS = (const bf16_t*)(p.ws + OFF_H);
  const float* DT = (const float*)(p.ws + OFF_DT);
  const float* CS = (const float*)(p.ws + OFF_CS);
  const bf16_t* ST = (const bf16_t*)(p.ws + OFF_ST);
  bf16_t* Z = (bf16_t*)(p.ws + OFF_Z);
  float* RSTD = (float*)(p.ws + OFF_RSTD);
  const int nck = (l == 0) ? NCK : 128;
  const int nh = (l == 0) ? 2 : 8;
  const int nsplit = 8 / nh;
  for (int it0 = blockIdx.x; it0 < nck * 4 * nsplit; it0 += gridDim.x) {
    const int hq = it0 % nsplit, it = it0 / nsplit;
    const int hbeg = hq * nh, hend = hbeg + nh;
    const int ck = it >> 2, g = (it >> 1) & 1, lh = it & 1;
    const int row0 = ck * 128;
    const int lbase = lh * 64 + wl * 32;
    __syncthreads();
    for (int v = tid; v < 2048; v += 256) {
      const int r = v >> 4, cv = v & 15;
      *(uint4*)&sB[r * 136 + cv * 8] = *(const uint4*)(BC + (size_t)(row0 + r) * 512 + g * 128 + cv * 8);
    }
    if (tid < 64) sSS[tid] = 0.f;
    const bf16_t* cptr = BC + (size_t)(row0 + lbase + fr) * 512 + 256 + g * 128 + fh * 8;
    bf16x8 cf[8];
#pragma unroll
    for (int ks = 0; ks < 8; ++ks) cf[ks] = *(const bf16x8*)(cptr + ks * 16);
    const int lrx = tid >> 3, cvx = tid & 7;
    const bf16_t* xsrc = XS + (size_t)(row0 + lrx) * 1024 + cvx * 8;
    uint4 xp0, xp1, xp2, xp3;
    float fp0 = 0.f, fp1 = 0.f, fp2 = 0.f, fp3 = 0.f;
    {
      const int head = g * 8 + hbeg;
      xp0 = *(const uint4*)(xsrc + head * 64);
      xp1 = *(const uint4*)(xsrc + head * 64 + 32 * 1024);
      xp2 = *(const uint4*)(xsrc + head * 64 + 64 * 1024);
      xp3 = *(const uint4*)(xsrc + head * 64 + 96 * 1024);
      if (tid < 128) {
        const size_t rho = (size_t)(row0 + tid);
        fp0 = CS[rho * 32 + head]; fp1 = CS[rho * 32 + 16 + head]; fp2 = DT[rho * 32 + head]; fp3 = DT[rho * 32 + 16 + head];
      }
    }
    __syncthreads();
    f32x16 cb[2];
#pragma unroll
    for (int j = 0; j < 2; ++j) {
#pragma unroll
      for (int r = 0; r < 16; ++r) cb[j][r] = 0.f;
#pragma unroll
      for (int ks = 0; ks < 8; ++ks) {
        const bf16x8 bq = *(const bf16x8*)&sB[(w2 * 64 + j * 32 + fr) * 136 + ks * 16 + fh * 8];
        cb[j] = MFMA(cf[ks], bq, cb[j]);
      }
    }
    const int pidx = w2 * 32 + fr;
    bf16_t* sCB = sB + 64 * 136;
    __syncthreads();
#pragma unroll
    for (int j = 0; j < 2; ++j)
#pragma unroll
      for (int r = 0; r < 16; ++r) sCB[(wl * 32 + crow(r, fh)) * 136 + w2 * 64 + j * 32 + fr] = f2bf(cb[j][r]);
#pragma unroll 1
    for (int hh = hbeg; hh < hend; ++hh) {
      const int head = g * 8 + hh;
      __syncthreads();
      *(uint4*)&sX[lrx * 72 + cvx * 8] = xp0;
      *(uint4*)&sX[(lrx + 32) * 72 + cvx * 8] = xp1;
      *(uint4*)&sX[(lrx + 64) * 72 + cvx * 8] = xp2;
      *(uint4*)&sX[(lrx + 96) * 72 + cvx * 8] = xp3;
      if (tid < 128) { sF[tid] = fp0; sF[128 + tid] = fp1; sF[256 + tid] = fp2; sF[384 + tid] = fp3; }
      const bf16_t* S0 = ST + ((size_t)(ck * 2 + 0) * 16 + head) * 8192 + (w2 * 32 + fr) * 128 + fh * 8;
      const bf16_t* S1 = ST + ((size_t)(ck * 2 + 1) * 16 + head) * 8192 + (w2 * 32 + fr) * 128 + fh * 8;
      bf16x8 sf0[8];
#pragma unroll
      for (int ks = 0; ks < 8; ++ks) sf0[ks] = *(const bf16x8*)(S0 + ks * 16);
      bf16_t* zbase = Z + (size_t)(row0 + lbase + 4 * fh) * 1024 + head * 64 + pidx;
      if (hh + 1 < hend) {
        const int hn = head + 1;
        xp0 = *(const uint4*)(xsrc + hn * 64);
        xp1 = *(const uint4*)(xsrc + hn * 64 + 32 * 1024);
        xp2 = *(const uint4*)(xsrc + hn * 64 + 64 * 1024);
        xp3 = *(const uint4*)(xsrc + hn * 64 + 96 * 1024);
        if (tid < 128) {
          const size_t rho = (size_t)(row0 + tid);
          fp0 = CS[rho * 32 + hn]; fp1 = CS[rho * 32 + 16 + hn]; fp2 = DT[rho * 32 + hn]; fp3 = DT[rho * 32 + 16 + hn];
        }
      }
      __syncthreads();
#pragma unroll
      for (int j = 0; j < 2; ++j) {
        const int sidx = w2 * 64 + j * 32 + fr;
        const float csf_s = sF[sidx], csb_s = sF[128 + sidx], dtf_s = sF[256 + sidx], dtb_s = sF[384 + sidx];
#pragma unroll 4
        for (int r = 0; r < 16; ++r) {
          const int lidx = lbase + crow(r, fh);
          float f = 0.f;
          if (sidx <= lidx) f += __expf(sF[lidx] - csf_s) * dtf_s;
          if (sidx >= lidx) f += __expf(sF[128 + lidx] - csb_s) * dtb_s;
          sB[(wl * 32 + crow(r, fh)) * 136 + sidx] = f2bf(bf2f(sCB[(wl * 32 + crow(r, fh)) * 136 + sidx]) * f);
        }
      }
      __syncthreads();
      bf16x8 sf1[8], cfh[8];
#pragma unroll
      for (int ks = 0; ks < 8; ++ks) { sf1[ks] = *(const bf16x8*)(S1 + ks * 16); cfh[ks] = *(const bf16x8*)(cptr + ks * 16); }
      unsigned short zv[16];
#pragma unroll
      for (int r = 0; r < 16; ++r) zv[r] = zbase[(size_t)((r & 3) + 8 * (r >> 2)) * 1024];
      f32x16 accy;
#pragma unroll
      for (int r = 0; r < 16; ++r) accy[r] = 0.f;
#pragma unroll
      for (int ks = 0; ks < 8; ++ks) {
        const bf16x8 af = *(const bf16x8*)&sB[(wl * 32 + fr) * 136 + ks * 16 + fh * 8];
        const bf16x8 xf = tr_frag(sX, 72, ks * 16 + 8 * fh, ks * 16 + 8 * fh + 4, w2 * 32);
        accy = MFMA(af, xf, accy);
      }
      {
        f32x16 acct;
#pragma unroll
        for (int r = 0; r < 16; ++r) acct[r] = 0.f;
#pragma unroll
        for (int ks = 0; ks < 8; ++ks) acct = MFMA(cfh[ks], sf0[ks], acct);
#pragma unroll
        for (int r = 0; r < 16; ++r) accy[r] += __expf(sF[lbase + crow(r, fh)]) * acct[r];
#pragma unroll
        for (int r = 0; r < 16; ++r) acct[r] = 0.f;
#pragma unroll
        for (int ks = 0; ks < 8; ++ks) acct = MFMA(cfh[ks], sf1[ks], acct);
#pragma unroll
        for (int r = 0; r < 16; ++r) accy[r] += __expf(sF[128 + lbase + crow(r, fh)]) * acct[r];
      }
      const float dsk = p.ssd_d[l * 16 + head];
      float v[16];
#pragma unroll
      for (int r = 0; r < 16; ++r) {
        const int lidx = lbase + crow(r, fh);
        const float xv = bf2f(sX[lidx * 72 + pidx]);
        const float y = accy[r] + dsk * xv;
        const float u = y * silu_f(bf2f(zv[r]));
        v[r] = u * u;
        zbase[(size_t)((r & 3) + 8 * (r >> 2)) * 1024] = f2bf(u);
      }
#pragma unroll
      for (int i = 0; i < 8; ++i) { const bool up = (fr & 16) != 0; const float keep = up ? v[i + 8] : v[i]; const float send = up ? v[i] : v[i + 8]; v[i] = keep + __shfl_xor(send, 16); }
#pragma unroll
      for (int i = 0; i < 4; ++i) { const bool up = (fr & 8) != 0; const float keep = up ? v[i + 4] : v[i]; const float send = up ? v[i] : v[i + 4]; v[i] = keep + __shfl_xor(send, 8); }
#pragma unroll
      for (int i = 0; i < 2; ++i) { const bool up = (fr & 4) != 0; const float keep = up ? v[i + 2] : v[i]; const float send = up ? v[i] : v[i + 2]; v[i] = keep + __shfl_xor(send, 4); }
      { const bool up = (fr & 2) != 0; const float keep = up ? v[1] : v[0]; const float send = up ? v[0] : v[1]; v[0] = keep + __shfl_xor(send, 2); }
      v[0] += __shfl_xor(v[0], 1);
      if ((fr & 1) == 0) atomicAdd(&sSS[wl * 32 + crow(fr >> 1, fh)], v[0]);
    }
    __syncthreads();
    if (tid < 64) atomicAdd(&RSTD[(size_t)(row0 + lh * 64 + tid) * 2 + g], sSS[tid]);
  }
}

DI void phase_outproj(const Params& p_in, int l, char* smem) {
  const Params p = load_params();

  GemmS* s = (GemmS*)smem;
  int tid = threadIdx.x; asm volatile("" : "+v"(tid)); const int lane = tid & 63, wave = tid >> 6, wr = wave >> 1, wc = wave & 1, fr = lane & 31, fh = lane >> 5;
  const bf16_t* Zb = (const bf16_t*)(p.ws + OFF_Z);
  const bf16_t* Qb = (const bf16_t*)(p.ws + OFF_Q);
  const bf16_t* Cb = (const bf16_t*)(p.ws + OFF_CG);
  const bf16_t* W = (const bf16_t*)(p.ws + OFF_WOUT);
  const float* RSTD = (const float*)(p.ws + OFF_RSTD);
  const float* mods = (const float*)(p.ws + OFF_MODS);
  float* XC = (float*)(p.ws + OFF_XC);
  const int nM = (l == 0) ? NCK : 128;
  for (int step = 0;; ++step) {
    int mt, nt;
    if (!xcd_tile(step, nM, 8, mt, nt)) break;
    f32x16 acc[2][2];
    zero_acc(acc);
    const bf16_t* Wb = W + (size_t)nt * 128 * 2048;
    const bf16_t* A0 = Zb + (size_t)mt * 128 * 1024;
    const bf16_t* A2 = Qb + (size_t)mt * 128 * 512;
    const bf16_t* A3 = Cb + (size_t)mt * 128 * 512;
    float* sScale = (float*)(smem + 40960);
    if (tid < 128) {
      const size_t row = (size_t)(mt * 128 + tid);
      const float r0 = rsqrtf(RSTD[row * 2] * (1.f / 512.f) + 1e-6f);
      const float r1 = rsqrtf(RSTD[row * 2 + 1] * (1.f / 512.f) + 1e-6f);
      sScale[tid * 2] = r0 / r1;
      sScale[tid * 2 + 1] = r1;
    }
    gemm_core2(acc, (GemmS2*)smem,
               [&](int kt, int r, int kv) {
                 const bf16_t* ptr;
                 if (kt < 16) ptr = A0 + (size_t)r * 1024 + kt * 64;
                 else if (kt < 24) ptr = A2 + (size_t)r * 512 + (kt - 16) * 64;
                 else ptr = A3 + (size_t)r * 512 + (kt - 24) * 64;
                 return ptr + kv * 8;
               },
               [&](int kt, int r, int kv) { return Wb + (size_t)r * 2048 + kt * 64 + kv * 8; }, 32,
               [&](int kt) __attribute__((always_inline)) {
                 if (kt == 8 || kt == 16) {
#pragma unroll
                   for (int i = 0; i < 2; ++i)
#pragma unroll
                     for (int r = 0; r < 16; ++r) {
                       const float f = sScale[(wr * 64 + i * 32 + crow(r, fh)) * 2 + (kt == 16 ? 1 : 0)];
                       acc[i][0][r] *= f; acc[i][1][r] *= f;
                     }
                 }
               });
    {
      const int row0 = mt * 128;
      const int vv = (row0 < RL_) ? (row0 >> 12) : 4;
      const float* gate = mods + (l * 5 + vv) * 3072 + 2048 + nt * 128;
      float* xnew = (row0 < RL_) ? (p.out + (size_t)row0 * 1024) : (XC + (size_t)(row0 - RL_) * 1024);
      const float* xold = (l == 0) ? ((row0 < RL_) ? (p.x + (size_t)row0 * 1024) : (p.ctx + (size_t)(row0 - RL_) * 1024)) : xnew;
      epilogue_lds(acc, smem, [&](int rl, int c4, float4 v) {
        const int off = rl * 1024 + nt * 128 + c4;
        const float4 xo = *(const float4*)(xold + off);
        const float4 gt = *(const float4*)(gate + c4);
        float4 o;
        o.x = xo.x + gt.x * v.x; o.y = xo.y + gt.y * v.y; o.z = xo.z + gt.z * v.z; o.w = xo.w + gt.w * v.w;
        *(float4*)(xnew + off) = o;
      });
    }
  }
}

DI void phase_final(const Params& p_in) {
  const Params p = load_params();
  const int lane = threadIdx.x & 63, wave = threadIdx.x >> 6;
  for (int it = blockIdx.x; it < RL_ / 4; it += gridDim.x) {
    float* xr = p.out + (size_t)(it * 4 + wave) * 1024;
    float4 xv[4];
    float ss = 0.f;
#pragma unroll
    for (int i = 0; i < 4; ++i) {
      xv[i] = *(const float4*)(xr + lane * 4 + i * 256);
      ss += xv[i].x * xv[i].x + xv[i].y * xv[i].y + xv[i].z * xv[i].z + xv[i].w * xv[i].w;
    }
#pragma unroll
    for (int o = 32; o >= 1; o >>= 1) ss += __shfl_xor(ss, o);
    const float rs = rsqrtf(ss * (1.f / 1024.f) + 1e-6f);
#pragma unroll
    for (int i = 0; i < 4; ++i) {
      const float4 w = *(const float4*)(p.final_norm_w + lane * 4 + i * 256);
      float4 o;
      o.x = xv[i].x * rs * w.x; o.y = xv[i].y * rs * w.y; o.z = xv[i].z * rs * w.z; o.w = xv[i].w * rs * w.w;
      *(float4*)(xr + lane * 4 + i * 256) = o;
    }
  }
}

template <int PH>
DI void run_phase(const Params& p, char* smem) {
  constexpr int l = (PH - 1) / 7, s = (PH - 1) % 7;
  if constexpr (PH == 0) phase_mods(p, smem);
  else if constexpr (PH == 15) phase_final(p);
  else if constexpr (s == 0) phase_prep(p, l, smem);
  else if constexpr (s == 1) phase_inproj(p, smem);
  else if constexpr (s == 2) phase_local(p, l, smem);
  else if constexpr (s == 3) phase_mix(p, l, smem);
  else if constexpr (s == 4) phase_scan(p);
  else if constexpr (s == 5) phase_ssdy(p, l, smem);
  else phase_outproj(p, l, smem);
}

#if PROBE_S >= 0
#define PROBE_BEGIN() if (threadIdx.x == 0) pst[1] = wall_clock64();
#define PROBE_END(PH) if (threadIdx.x == 0 && (PH) >= 1 && (PH) <= 14 && (((PH) - 1) % 7) == PROBE_S) pst[0] += wall_clock64() - pst[1];
#else
#define PROBE_BEGIN()
#define PROBE_END(PH)
#endif
#define PHASE(PH) PROBE_BEGIN() run_phase<PH>(p, smem); xcd_barrier(xst); PROBE_END(PH)

__global__ void __launch_bounds__(256, 2) fwd_megakernel(Params p) {
  __shared__ __attribute__((aligned(16))) char smem[57344];
  cg::grid_group grid = cg::this_grid();
#if PROBE_S >= 0
  volatile unsigned long long* pst = (volatile unsigned long long*)(smem + 57344 - 16);
  if (threadIdx.x == 0) { pst[0] = 0; pst[1] = 0; }
#endif
  __shared__ uint4 xb_words;
  volatile LAS unsigned* xst = (volatile LAS unsigned*)&xb_words;
  if (threadIdx.x == 0) xb_words = make_uint4(0u, 0u, 0u, 0u);
  run_phase<0>(p, smem);
  grid.sync();
  if (threadIdx.x == 0) { unsigned* bar = (unsigned*)(load_params().ws + OFF_BAR); (void)xb_add(&bar[XB_XCNT(xb_xcc_id())], 1u); }
  PHASE(1) PHASE(2) PHASE(3) PHASE(4) PHASE(5) PHASE(6) PHASE(7)
  PHASE(8) PHASE(9) PHASE(10) PHASE(11) PHASE(12) PHASE(13) PHASE(14)
  run_phase<15>(p, smem);
#if PROBE_S >= 0
  if (blockIdx.x == 0 && threadIdx.x == 0) {
    const unsigned long long t1 = wall_clock64();
    const unsigned long long lim = 4ull * pst[0];
    while (wall_clock64() - t1 < lim) { __builtin_amdgcn_s_sleep(32); }
  }
#endif
}

extern "C" void kernel_launch(void* const* d_in, const int* in_sizes, int n_in, void* d_out, int out_size, void* d_ws,
                              size_t ws_size, hipStream_t stream) {
  static int grid_blocks = 0;
  if (!grid_blocks) {
    int dev = 0, cus = 0, per_cu = 0;
    hipGetDevice(&dev);
    hipDeviceGetAttribute(&cus, hipDeviceAttributeMultiprocessorCount, dev);
    hipOccupancyMaxActiveBlocksPerMultiprocessor(&per_cu, fwd_megakernel, 256, 0);
    if (per_cu < 1) per_cu = 1;
    if (per_cu > 2) per_cu = 2;
    grid_blocks = (cus * per_cu) & ~7;
  }
  Params p{};
  const float** pp = (const float**)&p;
  for (int i = 0; i < 23; ++i) pp[i] = (const float*)d_in[i];
  p.out = (float*)d_out;
  p.ws = (char*)d_ws;
  void* args[] = {&p};
  hipError_t e = hipLaunchCooperativeKernel((void*)fwd_megakernel, dim3(grid_blocks), dim3(256), args, 0, stream);
  if (e != hipSuccess) fprintf(stderr, "cooperative launch failed: %s (grid %d)\n", hipGetErrorString(e), grid_blocks);
}
```

```cpp
#include <hip/hip_runtime.h>
#include <hip/hip_cooperative_groups.h>
#include <stdint.h>
#include <stdio.h>
namespace cg = cooperative_groups;

#ifndef ONE_LAUNCH
#define ONE_LAUNCH 1
#endif

#ifndef PROBE_S
#define PROBE_S -1
#endif
#define DI __device__ __forceinline__
typedef unsigned short bf16_t;
using bf16x8 = __attribute__((ext_vector_type(8))) short;
using s16x4 = __attribute__((ext_vector_type(4))) short;
using f32x16 = __attribute__((ext_vector_type(16))) float;
#define MFMA(a, b, c) __builtin_amdgcn_mfma_f32_32x32x16_bf16((a), (b), (c), 0, 0, 0)

constexpr int R_ = 17408;
constexpr int RL_ = 16384;
constexpr int NCK = 136;

constexpr size_t SZ_WIN = (size_t)5632 * 1024 * 2;
constexpr size_t SZ_WOUT = (size_t)1024 * 2048 * 2;
constexpr size_t SZ_PW = (size_t)512 * 512 * 2;
constexpr size_t SZ_MODS = (size_t)2 * 5 * 3072 * 4;
constexpr size_t SZ_XC = (size_t)1024 * 1024 * 4;
constexpr size_t SZ_RSTD = (size_t)R_ * 2 * 4;
constexpr size_t SZ_CDEC = (size_t)NCK * 32 * 4 + 256 - ((size_t)NCK * 32 * 4) % 256;
constexpr size_t SZ_R512 = (size_t)R_ * 512 * 2;
constexpr size_t OFF_WIN = 0;
constexpr size_t OFF_WOUT = OFF_WIN + SZ_WIN;
constexpr size_t OFF_PW = OFF_WOUT + SZ_WOUT;
constexpr size_t OFF_MODS = OFF_PW + SZ_PW;
constexpr size_t OFF_XC = OFF_MODS + SZ_MODS;
constexpr size_t OFF_RSTD = OFF_XC + SZ_XC;
constexpr size_t OFF_CDEC = OFF_RSTD + SZ_RSTD;
constexpr size_t OFF_H = OFF_CDEC + SZ_CDEC;
constexpr size_t OFF_XBC = OFF_H + 2 * SZ_R512;
constexpr size_t OFF_GLU = OFF_XBC + 3 * SZ_R512;
constexpr size_t OFF_ST = OFF_XBC;
constexpr size_t OFF_Z = OFF_GLU + SZ_R512;
constexpr size_t OFF_DT = OFF_Z + 2 * SZ_R512;
constexpr size_t OFF_CS = OFF_DT + (size_t)R_ * 32 * 4;
constexpr size_t OFF_Q = OFF_CS + (size_t)R_ * 32 * 4;
constexpr size_t OFF_KV = OFF_Q + SZ_R512;
constexpr size_t OFF_AG = OFF_KV + SZ_R512 / 2;
constexpr size_t OFF_CG = OFF_AG + SZ_R512;
constexpr size_t OFF_BC = OFF_CG + SZ_R512;
constexpr size_t OFF_HDN = OFF_BC + SZ_R512;
constexpr size_t WS_TOTAL = OFF_HDN + SZ_R512;
constexpr size_t OFF_BAR = WS_TOTAL;
static_assert(OFF_BAR + 16384 <= (size_t)256 * 1024 * 1024, "workspace too large");

struct Params {
  const float *x, *c, *ctx, *c_ctx, *w_mod, *b_mod, *norm_w, *w_in, *ssd_conv_w, *ssd_conv_b, *ssd_dt_bias, *ssd_a_log,
      *ssd_d, *ssd_norm_w, *attn_sink, *conv_dw_w, *conv_dw_b, *conv_ln_w, *conv_ln_b, *conv_pw_w, *conv_pw_b, *w_out,
      *final_norm_w;
  float* out;
  char* ws;
};


DI Params load_params() {
  typedef const char __attribute__((address_space(4)))* kptr_t;
  typedef const float* const __attribute__((address_space(4)))* kfld_t;
  size_t off = 0;
  asm volatile("" : "+s"(off));
  kptr_t base = (kptr_t)__builtin_amdgcn_kernarg_segment_ptr() + off;
  Params p;
  const float** pp = (const float**)&p;
#pragma unroll
  for (int i = 0; i < 25; ++i) pp[i] = *(kfld_t)(base + 8 * i);
  return p;
}

#define XB_TMO      128
#define XB_XCNT(j)  (256  + 64 * (j))
#define XB_XSUB(j)  (1280 + 64 * (j))
#define XB_XGEN(j)  (2304 + 64 * (j))
#define XB_TOP      3328
#define XB_TOPGEN   3392
#define XCD_BAR_WORDS 3456
#define XB_SPIN_CAP (1u << 18)
#define LAS __attribute__((address_space(3)))
DI unsigned xb_ld(unsigned* p)              { return __hip_atomic_load(p, __ATOMIC_RELAXED, __HIP_MEMORY_SCOPE_AGENT); }
DI unsigned xb_add(unsigned* p, unsigned v) { return __hip_atomic_fetch_add(p, v, __ATOMIC_RELAXED, __HIP_MEMORY_SCOPE_AGENT); }
DI unsigned xb_xcc_id() { return (unsigned)__builtin_amdgcn_s_getreg((3 << 11) | 20) & 0xFu; }
#define XB_SPIN(cond, bar) do { unsigned _sp = 0; while (cond) { __builtin_amdgcn_s_sleep(1); \
    if ((++_sp & 255u) == 0u) { if (xb_ld(&(bar)[XB_TMO])) break; if (_sp > XB_SPIN_CAP) { atomicAdd(&(bar)[XB_TMO], 1u); break; } } } } while (0)

DI void xcd_barrier_complete(unsigned* bar, unsigned x, unsigned& nloc, unsigned& nx) {
  const unsigned G = gridDim.x * gridDim.y * gridDim.z;
  unsigned sum, cnt, mine, sp = 0u;
  for (;;) {
    sum = 0u; cnt = 0u; mine = 0u;
#pragma unroll
    for (unsigned j = 0; j < 16; ++j) { const unsigned c = xb_ld(&bar[XB_XCNT(j)]); sum += c; cnt += (c > 0u) ? 1u : 0u; mine = (j == x) ? c : mine; }
    if (sum == G) break;
    __builtin_amdgcn_s_sleep(1);
    if ((++sp & 255u) == 0u) { if (xb_ld(&bar[XB_TMO])) break; if (sp > XB_SPIN_CAP) { atomicAdd(&bar[XB_TMO], 1u); break; } }
  }
  nloc = mine > 0u ? mine : 1u; nx = cnt > 0u ? cnt : 1u;
}

DI void xcd_barrier(volatile LAS unsigned* st) {
  asm volatile("s_waitcnt vmcnt(0)" ::: "memory");
  __syncthreads();
  if (threadIdx.x == 0) {
    const Params pb = load_params();
    unsigned* bar = (unsigned*)(pb.ws + OFF_BAR);
    const unsigned x = xb_xcc_id();
    __builtin_amdgcn_s_waitcnt(0);
    unsigned nloc = st[0], nx = st[1];
    if (nloc == 0u) { xcd_barrier_complete(bar, x, nloc, nx); st[0] = nloc; st[1] = nx; }
    const unsigned old = xb_add(&bar[XB_XSUB(x)], 1u);
    const unsigned gen = old / nloc;
    if (old + 1u == (gen + 1u) * nloc) {
      __builtin_amdgcn_fence(__ATOMIC_RELEASE, "agent");
      asm volatile("s_waitcnt vmcnt(0)" ::: "memory");
      const unsigned og = xb_add(&bar[XB_TOP], 1u);
      const unsigned tg = og / nx;
      if (og + 1u == (tg + 1u) * nx) xb_add(&bar[XB_TOPGEN], 1u);
      else XB_SPIN(xb_ld(&bar[XB_TOPGEN]) == tg, bar);
      __builtin_amdgcn_fence(__ATOMIC_ACQUIRE, "agent");
      xb_add(&bar[XB_XGEN(x)], 1u);
      asm volatile("s_waitcnt vmcnt(0)" ::: "memory");
    } else {
      XB_SPIN(xb_ld(&bar[XB_XGEN(x)]) == gen, bar);
      __builtin_amdgcn_fence(__ATOMIC_ACQUIRE, "agent");
      asm volatile("s_waitcnt vmcnt(0)" ::: "memory");
    }
  }
  __syncthreads();
}

typedef __bf16 nbf16x2_t __attribute__((ext_vector_type(2)));
typedef float nf32x2_t __attribute__((ext_vector_type(2)));
DI unsigned short f2bf(float x) { const __bf16 r = (__bf16)x; return __builtin_bit_cast(unsigned short, r); }
DI float bf2f(unsigned short b) { return __uint_as_float(((unsigned)b) << 16); }
DI unsigned pack2(float a, float b) { const nf32x2_t v = {a, b}; const nbf16x2_t r = __builtin_convertvector(v, nbf16x2_t); return __builtin_bit_cast(unsigned, r); }
DI float lo2f(unsigned u) { return __uint_as_float(u << 16); }
DI float hi2f(unsigned u) { return __uint_as_float(u & 0xffff0000u); }
DI float silu_f(float x) { return x / (1.f + __expf(-x)); }
DI float sigmoid_f(float x) { return 1.f / (1.f + __expf(-x)); }
DI int crow(int reg, int h) { return (reg & 3) + 8 * (reg >> 2) + 4 * h; }

DI bf16x8 tr_frag(const bf16_t* s, int ld, int row_lo, int row_hi, int col0) {
  const int lane = threadIdx.x & 63;
  const int i16 = lane & 15, q = i16 >> 2, pp = i16 & 3, blk = (lane >> 4) & 1;
  const unsigned a0 = (unsigned)(size_t)(s + (row_lo + q) * ld + col0 + 16 * blk + 4 * pp);
  const unsigned a1 = (unsigned)(size_t)(s + (row_hi + q) * ld + col0 + 16 * blk + 4 * pp);
  s16x4 lo, hi;
  asm volatile("ds_read_b64_tr_b16 %0, %2\n\tds_read_b64_tr_b16 %1, %3\n\ts_waitcnt lgkmcnt(0)"
               : "=&v"(lo), "=&v"(hi) : "v"(a0), "v"(a1) : "memory");
  return __builtin_shufflevector(lo, hi, 0, 1, 2, 3, 4, 5, 6, 7);
}

struct GemmS { bf16_t a[2][128][40]; bf16_t b[2][128][40]; };

template <class AF, class BF>
DI void gemm_core(f32x16 (&acc)[2][2], GemmS* s, AF aptr, BF bptr, int nk) {
  int tid = threadIdx.x; asm volatile("" : "+v"(tid)); const int lane = tid & 63, wave = tid >> 6, wr = wave >> 1, wc = wave & 1;
  const int r0 = tid >> 2, kv = tid & 3;
  const int fr = lane & 31, fh = lane >> 5;
  uint4 ra0 = *(const uint4*)aptr(0, r0, kv), ra1 = *(const uint4*)aptr(0, r0 + 64, kv);
  uint4 rb0 = *(const uint4*)bptr(0, r0, kv), rb1 = *(const uint4*)bptr(0, r0 + 64, kv);
  *(uint4*)&s->a[0][r0][kv * 8] = ra0; *(uint4*)&s->a[0][r0 + 64][kv * 8] = ra1;
  *(uint4*)&s->b[0][r0][kv * 8] = rb0; *(uint4*)&s->b[0][r0 + 64][kv * 8] = rb1;
  __syncthreads();
#pragma unroll 1
  for (int kt = 0; kt < nk; ++kt) {
    const int buf = kt & 1;
    if (kt + 1 < nk) {
      ra0 = *(const uint4*)aptr(kt + 1, r0, kv); ra1 = *(const uint4*)aptr(kt + 1, r0 + 64, kv);
      rb0 = *(const uint4*)bptr(kt + 1, r0, kv); rb1 = *(const uint4*)bptr(kt + 1, r0 + 64, kv);
    }
#pragma unroll
    for (int ks = 0; ks < 2; ++ks) {
      bf16x8 af[2], bq[2];
#pragma unroll
      for (int i = 0; i < 2; ++i) af[i] = *(const bf16x8*)&s->a[buf][wr * 64 + i * 32 + fr][ks * 16 + fh * 8];
#pragma unroll
      for (int j = 0; j < 2; ++j) bq[j] = *(const bf16x8*)&s->b[buf][wc * 64 + j * 32 + fr][ks * 16 + fh * 8];
#pragma unroll
      for (int i = 0; i < 2; ++i)
#pragma unroll
        for (int j = 0; j < 2; ++j) acc[i][j] = MFMA(af[i], bq[j], acc[i][j]);
    }
    if (kt + 1 < nk) {
      *(uint4*)&s->a[buf ^ 1][r0][kv * 8] = ra0; *(uint4*)&s->a[buf ^ 1][r0 + 64][kv * 8] = ra1;
      *(uint4*)&s->b[buf ^ 1][r0][kv * 8] = rb0; *(uint4*)&s->b[buf ^ 1][r0 + 64][kv * 8] = rb1;
    }
    __syncthreads();
  }
}


struct GemmS2 { bf16_t a[128][72]; bf16_t b[128][72]; };
DI void g2_compute(f32x16 (&acc)[2][2], const GemmS2* s, int wr, int wc, int fr, int fh) {
#pragma unroll
  for (int ks = 0; ks < 4; ++ks) {
    bf16x8 af[2], bq[2];
#pragma unroll
    for (int i = 0; i < 2; ++i) af[i] = *(const bf16x8*)&s->a[wr * 64 + i * 32 + fr][ks * 16 + fh * 8];
#pragma unroll
    for (int j = 0; j < 2; ++j) bq[j] = *(const bf16x8*)&s->b[wc * 64 + j * 32 + fr][ks * 16 + fh * 8];
#pragma unroll
    for (int i = 0; i < 2; ++i)
#pragma unroll
      for (int j = 0; j < 2; ++j) acc[i][j] = MFMA(af[i], bq[j], acc[i][j]);
  }
}

template <class AF, class BF, class HK>
DI void gemm_core2(f32x16 (&acc)[2][2], GemmS2* s, AF aptr, BF bptr, int nk, HK hook) {
  int tid = threadIdx.x; asm volatile("" : "+v"(tid));
  const int lane = tid & 63, wave = tid >> 6, wr = wave >> 1, wc = wave & 1;
  const int r0 = tid >> 3, kc = tid & 7;
  const int fr = lane & 31, fh = lane >> 5;
  uint4 p0a0, p0a1, p0a2, p0a3, p0b0, p0b1, p0b2, p0b3, p1a0, p1a1, p1a2, p1a3, p1b0, p1b1, p1b2, p1b3;
#define G2_LOAD(S, KT) { \
    S##a0 = *(const uint4*)aptr((KT), r0, kc);      S##b0 = *(const uint4*)bptr((KT), r0, kc); \
    S##a1 = *(const uint4*)aptr((KT), r0 + 32, kc); S##b1 = *(const uint4*)bptr((KT), r0 + 32, kc); \
    S##a2 = *(const uint4*)aptr((KT), r0 + 64, kc); S##b2 = *(const uint4*)bptr((KT), r0 + 64, kc); \
    S##a3 = *(const uint4*)aptr((KT), r0 + 96, kc); S##b3 = *(const uint4*)bptr((KT), r0 + 96, kc); }
#define G2_STORE(S) { \
    *(uint4*)&s->a[r0][kc * 8] = S##a0;      *(uint4*)&s->b[r0][kc * 8] = S##b0; \
    *(uint4*)&s->a[r0 + 32][kc * 8] = S##a1; *(uint4*)&s->b[r0 + 32][kc * 8] = S##b1; \
    *(uint4*)&s->a[r0 + 64][kc * 8] = S##a2; *(uint4*)&s->b[r0 + 64][kc * 8] = S##b2; \
    *(uint4*)&s->a[r0 + 96][kc * 8] = S##a3; *(uint4*)&s->b[r0 + 96][kc * 8] = S##b3; }
#define G2_COMPUTE() g2_compute(acc, s, wr, wc, fr, fh);
  G2_LOAD(p0, 0)
  G2_LOAD(p1, 1)
  G2_STORE(p0)
  if (nk > 2) G2_LOAD(p0, 2)
  __syncthreads();
#pragma unroll 1
  for (int kt = 0; kt < nk; kt += 2) {
    hook(kt);
    G2_COMPUTE()
    __syncthreads();
    G2_STORE(p1)
    if (kt + 3 < nk) G2_LOAD(p1, kt + 3)
    __syncthreads();
    hook(kt + 1);
    G2_COMPUTE()
    __syncthreads();
    if (kt + 2 < nk) {
      G2_STORE(p0)
      if (kt + 4 < nk) G2_LOAD(p0, kt + 4)
    }
    __syncthreads();
  }
#undef G2_LOAD
#undef G2_STORE
#undef G2_COMPUTE
}


struct GemmS3 { bf16_t a[128][72]; bf16_t b[256][72]; };

template <class AF, class BF>
DI void gemm_core3(f32x16 (&acc)[2][4], GemmS3* s, AF aptr, BF bptr, int nk) {
  int tid = threadIdx.x; asm volatile("" : "+v"(tid));
  const int lane = tid & 63, wave = tid >> 6, wr = wave >> 1, wc = wave & 1;
  const int r0 = tid >> 3, kc = tid & 7;
  const int fr = lane & 31, fh = lane >> 5;
  uint4 a0, a1, a2, a3, b0, b1, b2, b3, b4, b5, b6, b7;
#define G3_LOAD(KT) { \
    a0 = *(const uint4*)aptr((KT), r0, kc);       a1 = *(const uint4*)aptr((KT), r0 + 32, kc); \
    a2 = *(const uint4*)aptr((KT), r0 + 64, kc);  a3 = *(const uint4*)aptr((KT), r0 + 96, kc); \
    b0 = *(const uint4*)bptr((KT), r0, kc);       b1 = *(const uint4*)bptr((KT), r0 + 32, kc); \
    b2 = *(const uint4*)bptr((KT), r0 + 64, kc);  b3 = *(const uint4*)bptr((KT), r0 + 96, kc); \
    b4 = *(const uint4*)bptr((KT), r0 + 128, kc); b5 = *(const uint4*)bptr((KT), r0 + 160, kc); \
    b6 = *(const uint4*)bptr((KT), r0 + 192, kc); b7 = *(const uint4*)bptr((KT), r0 + 224, kc); }
#define G3_STORE() { \
    *(uint4*)&s->a[r0][kc * 8] = a0;       *(uint4*)&s->a[r0 + 32][kc * 8] = a1; \
    *(uint4*)&s->a[r0 + 64][kc * 8] = a2;  *(uint4*)&s->a[r0 + 96][kc * 8] = a3; \
    *(uint4*)&s->b[r0][kc * 8] = b0;       *(uint4*)&s->b[r0 + 32][kc * 8] = b1; \
    *(uint4*)&s->b[r0 + 64][kc * 8] = b2;  *(uint4*)&s->b[r0 + 96][kc * 8] = b3; \
    *(uint4*)&s->b[r0 + 128][kc * 8] = b4; *(uint4*)&s->b[r0 + 160][kc * 8] = b5; \
    *(uint4*)&s->b[r0 + 192][kc * 8] = b6; *(uint4*)&s->b[r0 + 224][kc * 8] = b7; }
  G3_LOAD(0)
  G3_STORE()
  __syncthreads();
#pragma unroll 1
  for (int kt = 0; kt < nk; ++kt) {
    if (kt + 1 < nk) G3_LOAD(kt + 1)
#pragma unroll
    for (int ks = 0; ks < 4; ++ks) {
      bf16x8 af[2], bq[4];
#pragma unroll
      for (int i = 0; i < 2; ++i) af[i] = *(const bf16x8*)&s->a[wr * 64 + i * 32 + fr][ks * 16 + fh * 8];
#pragma unroll
      for (int j = 0; j < 4; ++j) bq[j] = *(const bf16x8*)&s->b[wc * 128 + j * 32 + fr][ks * 16 + fh * 8];
#pragma unroll
      for (int i = 0; i < 2; ++i)
#pragma unroll
        for (int j = 0; j < 4; ++j) acc[i][j] = MFMA(af[i], bq[j], acc[i][j]);
    }
    __syncthreads();
    if (kt + 1 < nk) G3_STORE()
    __syncthreads();
  }
#undef G3_LOAD
#undef G3_STORE
}

template <class EPI>
DI void epilogue_lds2(f32x16 (&acc)[2][4], char* smem, int sub, EPI epi) {
  float* T = (float*)smem;
  int tid = threadIdx.x; asm volatile("" : "+v"(tid));
  const int lane = tid & 63, wave = tid >> 6, wr = wave >> 1, wc = wave & 1, fr = lane & 31, fh = lane >> 5;
#pragma unroll
  for (int i = 0; i < 2; ++i) {
    if (wc == sub) {
#pragma unroll
      for (int j = 0; j < 4; ++j)
#pragma unroll
        for (int r = 0; r < 16; ++r) T[(wr * 32 + crow(r, fh)) * 132 + j * 32 + fr] = acc[i][j][r];
    }
    __syncthreads();
#pragma unroll 2
    for (int e = tid; e < 2048; e += 256) {
      const int tr = e >> 5, c4 = (e & 31) * 4;
      const float4 v = *(const float4*)&T[tr * 132 + c4];
      epi((tr >> 5) * 64 + i * 32 + (tr & 31), c4, v);
    }
    __syncthreads();
  }
}

DI bool xcd_tile(int step, int nM, int nN, int& mt, int& nt) {
  const int xcd = blockIdx.x & 7, nloc = gridDim.x >> 3;
  const int j = (blockIdx.x >> 3) + step * nloc;
  const int mloc = nM >> 3;
  if ((gridDim.x & 7) != 0 || j >= mloc * nN) return false;
  const int per = 8 * nN;
  const int gm = j / per, rem = j - gm * per;
  const int hgt = min(8, mloc - gm * 8);
  const int a = rem % hgt;
  nt = rem / hgt;
  mt = (gm * 8 + a) * 8 + xcd;
  return true;
}

DI void zero_acc(f32x16 (&acc)[2][2]) {
#pragma unroll
  for (int i = 0; i < 2; ++i)
#pragma unroll
    for (int j = 0; j < 2; ++j)
#pragma unroll
      for (int r = 0; r < 16; ++r) acc[i][j][r] = 0.f;
}

template <class EPI>
DI void epilogue_lds(f32x16 (&acc)[2][2], char* smem, EPI epi) {
  float* T = (float*)smem;
  int tid = threadIdx.x; asm volatile("" : "+v"(tid)); const int lane = tid & 63, wave = tid >> 6, wr = wave >> 1, wc = wave & 1, fr = lane & 31, fh = lane >> 5;
#pragma unroll
  for (int i = 0; i < 2; ++i) {
#pragma unroll
    for (int j = 0; j < 2; ++j)
#pragma unroll
      for (int r = 0; r < 16; ++r) T[(wr * 32 + crow(r, fh)) * 132 + wc * 64 + j * 32 + fr] = acc[i][j][r];
    __syncthreads();
#pragma unroll 2
    for (int e = tid; e < 2048; e += 256) {
      const int tr = e >> 5, c4 = (e & 31) * 4;
      const float4 v = *(const float4*)&T[tr * 132 + c4];
      epi((tr >> 5) * 64 + i * 32 + (tr & 31), c4, v);
    }
    __syncthreads();
  }
}

DI void phase_mods(const Params& p_in, char* smem) {
  const Params p = load_params();

  float* ssc = (float*)smem;
  float* red = (float*)(smem + 20480);
  float* mods = (float*)(p.ws + OFF_MODS);
  int tid = threadIdx.x; asm volatile("" : "+v"(tid));
  if (blockIdx.x == 0) { unsigned* bar = (unsigned*)(p.ws + OFF_BAR); for (int i = tid; i < XCD_BAR_WORDS; i += 256) bar[i] = 0u; }
  for (int it = blockIdx.x; it < 96; it += gridDim.x) {
    const int l = it / 48, col0 = (it % 48) * 64;
    __syncthreads();
    for (int e = tid; e < 5120; e += 256) {
      const int v = e >> 10, k = e & 1023;
      const float cv = (v < 4) ? p.c[v * 1024 + k] : p.c_ctx[k];
      ssc[e] = silu_f(cv);
    }
    __syncthreads();
    const int col = tid & 63, kg = tid >> 6;
    float a[5] = {0.f, 0.f, 0.f, 0.f, 0.f};
    const float* w = p.w_mod + (size_t)l * 1024 * 3072 + col0 + col;
    for (int k = kg * 256; k < kg * 256 + 256; k += 8) {
      float wv[8];
#pragma unroll
      for (int u = 0; u < 8; ++u) wv[u] = w[(size_t)(k + u) * 3072];
#pragma unroll
      for (int u = 0; u < 8; ++u)
#pragma unroll
        for (int v = 0; v < 5; ++v) a[v] += ssc[v * 1024 + k + u] * wv[u];
    }
#pragma unroll
    for (int v = 0; v < 5; ++v) red[(kg * 5 + v) * 64 + col] = a[v];
    __syncthreads();
    for (int e = tid; e < 320; e += 256) {
      const int v = e >> 6, cc = e & 63;
      float sum = p.b_mod[l * 3072 + col0 + cc];
      for (int g = 0; g < 4; ++g) sum += red[(g * 5 + v) * 64 + cc];
      mods[(l * 5 + v) * 3072 + col0 + cc] = sum;
    }
  }
}

DI int win_colmap(int n) {
  if (n < 2560) return n;
  if (n < 3840) return n + 32;
  if (n < 4864) {
    const int j = n - 3840, q64 = j >> 6, w = j & 63;
    return (w < 32) ? (3872 + q64 * 32 + w) : (3872 + 512 + q64 * 32 + (w - 32));
  }
  if (n < 5376) return n + 32;
  if (n < 5408) return n - 5376 + 2560;
  return -1;
}

DI void transpose_tile(const float* src, int ldsrc, int kind, const float* rowscale, bf16_t* dst, int lddst, int n0, int k0, float* tile) {
  int tid = threadIdx.x; asm volatile("" : "+v"(tid));
  __syncthreads();
  {
    const int c4 = (tid & 15) * 4, rr = tid >> 4;
    const int n = (kind == 0) ? win_colmap(n0 + c4) : (n0 + c4);
#pragma unroll
    for (int ps = 0; ps < 4; ++ps) {
      const int r = rr + ps * 16, k = k0 + r;
      float4 v = make_float4(0.f, 0.f, 0.f, 0.f);
      if (n >= 0) v = *(const float4*)(src + (size_t)k * ldsrc + n);
      if (rowscale != nullptr && k < 1024) { const float s = rowscale[k]; v.x *= s; v.y *= s; v.z *= s; v.w *= s; }
      tile[r * 65 + c4] = v.x; tile[r * 65 + c4 + 1] = v.y; tile[r * 65 + c4 + 2] = v.z; tile[r * 65 + c4 + 3] = v.w;
    }
  }
  __syncthreads();
  {
    const int k8 = (tid & 7) * 8, nn = tid >> 3;
#pragma unroll
    for (int ps = 0; ps < 2; ++ps) {
      const int r = nn + ps * 32;
      uint4 o;
      o.x = pack2(tile[(k8 + 0) * 65 + r], tile[(k8 + 1) * 65 + r]);
      o.y = pack2(tile[(k8 + 2) * 65 + r], tile[(k8 + 3) * 65 + r]);
      o.z = pack2(tile[(k8 + 4) * 65 + r], tile[(k8 + 5) * 65 + r]);
      o.w = pack2(tile[(k8 + 6) * 65 + r], tile[(k8 + 7) * 65 + r]);
      *(uint4*)(dst + (size_t)(n0 + r) * lddst + k0 + k8) = o;
    }
  }
}

DI void phase_prep(const Params& p_in, int l, char* smem) {
  const Params p = load_params();

  int tid = threadIdx.x; asm volatile("" : "+v"(tid)); const int lane = tid & 63, wave = tid >> 6;
  const float* mods = (const float*)(p.ws + OFF_MODS);
  bf16_t* H = (bf16_t*)(p.ws + OFF_H);
  const int NT_WIN = 88 * 16, NT_WOUT = 16 * 32, NT_PW = 64, NT_CONV = NT_WIN + NT_WOUT + NT_PW;
  const int NT = NT_CONV + R_ / 4;
  for (int it = blockIdx.x; it < NT; it += gridDim.x) {
    if (it < NT_WIN) {
      transpose_tile(p.w_in + (size_t)l * 1024 * 5408, 5408, 0, nullptr, (bf16_t*)(p.ws + OFF_WIN), 1024, (it / 16) * 64, (it % 16) * 64, (float*)smem);
    } else if (it < NT_WIN + NT_WOUT) {
      const int t = it - NT_WIN;
      transpose_tile(p.w_out + (size_t)l * 2048 * 1024, 1024, 1, p.ssd_norm_w + l * 1024, (bf16_t*)(p.ws + OFF_WOUT), 2048, (t / 32) * 64, (t % 32) * 64, (float*)smem);
    } else if (it < NT_CONV) {
      const int t = it - NT_WIN - NT_WOUT;
      transpose_tile(p.conv_pw_w + (size_t)l * 512 * 512, 512, 1, nullptr, (bf16_t*)(p.ws + OFF_PW), 512, (t / 8) * 64, (t % 8) * 64, (float*)smem);
    } else {
      const int rho = (it - NT_CONV) * 4 + wave;
      const float* xs;
      if (l == 0) xs = (rho < RL_) ? (p.x + (size_t)rho * 1024) : (p.ctx + (size_t)(rho - RL_) * 1024);
      else xs = (rho < RL_) ? (p.out + (size_t)rho * 1024) : ((const float*)(p.ws + OFF_XC) + (size_t)(rho - RL_) * 1024);
      const int v = (rho < RL_) ? (rho >> 12) : 4;
      const float* md = mods + (l * 5 + v) * 3072;
      float4 xv[4], nwv[4], shv[4], scv4[4];
      float ss = 0.f;
#pragma unroll
      for (int i = 0; i < 4; ++i) {
        const int cidx = lane * 4 + i * 256;
        xv[i] = *(const float4*)(xs + cidx);
        nwv[i] = *(const float4*)(p.norm_w + l * 1024 + cidx);
        shv[i] = *(const float4*)(md + cidx);
        scv4[i] = *(const float4*)(md + 1024 + cidx);
      }
#pragma unroll
      for (int i = 0; i < 4; ++i) ss += xv[i].x * xv[i].x + xv[i].y * xv[i].y + xv[i].z * xv[i].z + xv[i].w * xv[i].w;
#pragma unroll
      for (int o = 32; o >= 1; o >>= 1) ss += __shfl_xor(ss, o);
      const float rs = rsqrtf(ss * (1.f / 1024.f) + 1e-6f);
#pragma unroll
      for (int i = 0; i < 4; ++i) {
        const int cidx = lane * 4 + i * 256;
        const float4 nw = nwv[i], sh = shv[i], sc = scv4[i];
        uint2 o;
        o.x = pack2(xv[i].x * rs * nw.x * (1.f + sc.x) + sh.x, xv[i].y * rs * nw.y * (1.f + sc.y) + sh.y);
        o.y = pack2(xv[i].z * rs * nw.z * (1.f + sc.z) + sh.z, xv[i].w * rs * nw.w * (1.f + sc.w) + sh.w);
        *(uint2*)(H + (size_t)rho * 1024 + cidx) = o;
      }
    }
  }
}

DI void phase_inproj(const Params& p_in, char* smem) {
  const Params p = load_params();
  int tid = threadIdx.x; asm volatile("" : "+v"(tid)); const int wave = tid >> 6, wc = wave & 1;
  const bf16_t* H = (const bf16_t*)(p.ws + OFF_H);
  const bf16_t* W = (const bf16_t*)(p.ws + OFF_WIN);
  for (int step = 0;; ++step) {
    int mt, nt2;
    if (!xcd_tile(step, NCK, 22, mt, nt2)) break;
    f32x16 acc[2][4];
#pragma unroll
    for (int i = 0; i < 2; ++i)
#pragma unroll
      for (int j = 0; j < 4; ++j)
#pragma unroll
        for (int r = 0; r < 16; ++r) acc[i][j][r] = 0.f;
    const bf16_t* Ab = H + (size_t)mt * 128 * 1024;
    const bf16_t* Bb = W + (size_t)nt2 * 256 * 1024;
    gemm_core3(acc, (GemmS3*)smem,
               [&](int kt, int r, int kv) { return Ab + (size_t)r * 1024 + kt * 64 + kv * 8; },
               [&](int kt, int r, int kv) { return Bb + (size_t)r * 1024 + kt * 64 + kv * 8; }, 16);
    const int row0 = mt * 128;
    {
      const int ntw = nt2 * 2 + wc;
      if (ntw >= 30 && ntw < 38) {
#pragma unroll
        for (int i = 0; i < 2; ++i)
#pragma unroll
          for (int r = 0; r < 16; ++r) {
            acc[i][0][r] = acc[i][0][r] * sigmoid_f(acc[i][1][r]);
            acc[i][2][r] = acc[i][2][r] * sigmoid_f(acc[i][3][r]);
          }
      }
    }
#pragma unroll 1
    for (int sub = 0; sub < 2; ++sub) {
      const int nt = nt2 * 2 + sub;
      if (nt >= 43) break;
      if (nt >= 30 && nt < 38) {
        bf16_t* G = (bf16_t*)(p.ws + OFF_GLU);
        const int cb0 = (nt - 30) * 64;
        epilogue_lds2(acc, smem, sub, [&](int rl, int c4, float4 v) {
          if ((c4 & 32) == 0) {
            uint2 o; o.x = pack2(v.x, v.y); o.y = pack2(v.z, v.w);
            *(uint2*)(G + (size_t)(row0 + rl) * 512 + cb0 + (c4 >> 6) * 32 + (c4 & 31)) = o;
          }
        });
      } else if (nt == 42) {
        float* DT = (float*)(p.ws + OFF_DT);
        epilogue_lds2(acc, smem, sub, [&](int rl, int c4, float4 v) {
          if (c4 < 32) *(float4*)(DT + (size_t)(row0 + rl) * 32 + c4) = v;
        });
      } else {
        bf16_t* dst; int ld, cb;
        if (nt < 12) { dst = (bf16_t*)(p.ws + OFF_XBC); ld = 1536; cb = nt * 128; }
        else if (nt < 20) { dst = (bf16_t*)(p.ws + OFF_Z); ld = 1024; cb = nt * 128 - 1536; }
        else if (nt < 24) { dst = (bf16_t*)(p.ws + OFF_Q); ld = 512; cb = nt * 128 - 2560; }
        else if (nt < 26) { dst = (bf16_t*)(p.ws + OFF_KV); ld = 256; cb = nt * 128 - 3072; }
        else if (nt < 30) { dst = (bf16_t*)(p.ws + OFF_AG); ld = 512; cb = nt * 128 - 3328; }
        else { dst = (bf16_t*)(p.ws + OFF_CG); ld = 512; cb = nt * 128 - 4864; }
        epilogue_lds2(acc, smem, sub, [&](int rl, int c4, float4 v) {
          uint2 o; o.x = pack2(v.x, v.y); o.y = pack2(v.z, v.w);
          *(uint2*)(dst + (size_t)(row0 + rl) * ld + cb + c4) = o;
        });
      }
    }
  }
}

DI void phase_local(const Params& p_in, int l, char* smem) {
  const Params p = load_params();

  int tid = threadIdx.x; asm volatile("" : "+v"(tid)); const int lane = tid & 63;
  const bf16_t* XBC = (const bf16_t*)(p.ws + OFF_XBC);
  bf16_t* XS = (bf16_t*)(p.ws + OFF_H);
  bf16_t* BC = (bf16_t*)(p.ws + OFF_BC);
  float* DT = (float*)(p.ws + OFF_DT);
  float* CS = (float*)(p.ws + OFF_CS);
  const bf16_t* GLU = (const bf16_t*)(p.ws + OFF_GLU);
  bf16_t* HDN = (bf16_t*)(p.ws + OFF_HDN);
  bf16_t* Q = (bf16_t*)(p.ws + OFF_Q);
  bf16_t* KV = (bf16_t*)(p.ws + OFF_KV);
  { float* SSQ = (float*)(p.ws + OFF_RSTD); for (int i = blockIdx.x * 256 + tid; i < R_ * 2; i += gridDim.x * 256) SSQ[i] = 0.f; }
  const int N_CONV = (R_ / 4) * 192 / 256;
  const int N_DT = NCK;
  const int N_CF = R_ / 16;
  const int N_ROPE = RL_ * 40 / 256;
  const int N_QC = 1024 * 256 / 256;
  const int NT = N_CF + N_DT + N_CONV + N_ROPE + N_QC;
  for (int it0 = blockIdx.x; it0 < NT; it0 += gridDim.x) {
    int it = it0;
    if (it < N_CF) {
      float* sst = (float*)smem;
      unsigned* sIn = (unsigned*)(smem + 256);
      const int row0 = it * 16;
      const int seq0 = (row0 < RL_) ? (row0 & ~4095) : (RL_ + ((row0 - RL_) & ~255));
      const int slen = (row0 < RL_) ? 4096 : 256;
      const int t0 = row0 - seq0;
      const int c0 = tid * 2;
      __syncthreads();
      if (tid < 32) sst[tid] = 0.f;
      for (int idx = tid; idx < 46 * 64; idx += 256) {
        const int rr = idx >> 6, c16 = idx & 63;
        const int tt = t0 - 15 + rr;
        uint4 val = make_uint4(0u, 0u, 0u, 0u);
        if (tt >= 0 && tt < slen) val = *(const uint4*)(GLU + (size_t)(seq0 + tt) * 512 + c16 * 8);
        *(uint4*)&sIn[rr * 256 + c16 * 4] = val;
      }
      float w0[31], w1[31];
#pragma unroll
      for (int k = 0; k < 31; ++k) {
        const float2 wv = *(const float2*)(p.conv_dw_w + ((size_t)l * 31 + k) * 512 + c0);
        w0[k] = wv.x; w1[k] = wv.y;
      }
      const float2 bv = *(const float2*)(p.conv_dw_b + l * 512 + c0);
      float a0[16], a1[16];
#pragma unroll
      for (int r = 0; r < 16; ++r) { a0[r] = bv.x; a1[r] = bv.y; }
      __syncthreads();
#pragma unroll
      for (int tp = 0; tp < 46; ++tp) {
        const unsigned u = sIn[tp * 256 + tid];
        const float x0 = lo2f(u), x1 = hi2f(u);
#pragma unroll
        for (int r = 0; r < 16; ++r) {
          const int k = tp - r;
          if (k >= 0 && k < 31) { a0[r] += w0[k] * x0; a1[r] += w1[k] * x1; }
        }
        if ((tp & 7) == 7) __builtin_amdgcn_sched_barrier(0);
      }
      {
        float v[32];
#pragma unroll
        for (int r = 0; r < 16; ++r) { v[2 * r] = a0[r] + a1[r]; v[2 * r + 1] = a0[r] * a0[r] + a1[r] * a1[r]; }
#pragma unroll
        for (int i = 0; i < 16; ++i) { const bool up = (lane & 32) != 0; const float keep = up ? v[i + 16] : v[i]; const float send = up ? v[i] : v[i + 16]; v[i] = keep + __shfl_xor(send, 32); }
#pragma unroll
        for (int i = 0; i < 8; ++i) { const bool up = (lane & 16) != 0; const float keep = up ? v[i + 8] : v[i]; const float send = up ? v[i] : v[i + 8]; v[i] = keep + __shfl_xor(send, 16); }
#pragma unroll
        for (int i = 0; i < 4; ++i) { const bool up = (lane & 8) != 0; const float keep = up ? v[i + 4] : v[i]; const float send = up ? v[i] : v[i + 4]; v[i] = keep + __shfl_xor(send, 8); }
#pragma unroll
        for (int i = 0; i < 2; ++i) { const bool up = (lane & 4) != 0; const float keep = up ? v[i + 2] : v[i]; const float send = up ? v[i] : v[i + 2]; v[i] = keep + __shfl_xor(send, 4); }
        { const bool up = (lane & 2) != 0; const float keep = up ? v[1] : v[0]; const float send = up ? v[0] : v[1]; v[0] = keep + __shfl_xor(send, 2); }
        v[0] += __shfl_xor(v[0], 1);
        __syncthreads();
        if ((lane & 1) == 0) atomicAdd(&sst[lane >> 1], v[0]);
      }
      __syncthreads();
      const float2 lw = *(const float2*)(p.conv_ln_w + l * 512 + c0);
      const float2 lb = *(const float2*)(p.conv_ln_b + l * 512 + c0);
#pragma unroll
      for (int r = 0; r < 16; ++r) {
        const float mean = sst[r * 2] * (1.f / 512.f);
        const float var = fmaxf(sst[r * 2 + 1] * (1.f / 512.f) - mean * mean, 0.f);
        const float rs = rsqrtf(var + 1e-6f);
        const float y0 = (a0[r] - mean) * rs * lw.x + lb.x;
        const float y1 = (a1[r] - mean) * rs * lw.y + lb.y;
        *(unsigned*)(HDN + (size_t)(row0 + r) * 512 + c0) = pack2(silu_f(y0), silu_f(y1));
        if ((r & 3) == 3) __builtin_amdgcn_sched_barrier(0);
      }
      continue;
    }
    it -= N_CF;
    if (it < N_DT) {
      float* sdt = (float*)smem;
      const int row0 = it * 128;
      __syncthreads();
      for (int e = tid; e < 4096; e += 256) {
        const int r = e >> 5, cidx = e & 31;
        const float raw = DT[(size_t)(row0 + r) * 32 + cidx] + p.ssd_dt_bias[l * 32 + cidx];
        const float sp = (raw > 20.f) ? raw : log1pf(expf(raw));
        DT[(size_t)(row0 + r) * 32 + cidx] = sp;
        sdt[r * 33 + cidx] = sp;
      }
      __syncthreads();
      if (tid < 32) {
        const float a = -expf(p.ssd_a_log[l * 32 + tid]);
        float run = 0.f;
        if (tid < 16) {
          for (int r = 0; r < 128; ++r) { run += sdt[r * 33 + tid] * a; CS[(size_t)(row0 + r) * 32 + tid] = run; }
        } else {
          for (int r = 127; r >= 0; --r) { run += sdt[r * 33 + tid] * a; CS[(size_t)(row0 + r) * 32 + tid] = run; }
        }
      }
      continue;
    }
    it -= N_DT;
    if (it < N_CONV) {
      const int e = it * 256 + tid;
      const int rb = e / 192, cgp = e % 192, ch0 = cgp * 8;
      const int rho0 = rb * 4;
      const int seq0 = (rho0 < RL_) ? (rho0 & ~4095) : (RL_ + ((rho0 - RL_) & ~255));
      const int slen = (rho0 < RL_) ? 4096 : 256;
      const int t0 = rho0 - seq0;
      uint4 xr[8];
#pragma unroll
      for (int i = 0; i < 8; ++i) {
        const int tt = t0 + i - 2;
        xr[i] = make_uint4(0u, 0u, 0u, 0u);
        if (tt >= 0 && tt < slen) xr[i] = *(const uint4*)(XBC + (size_t)(seq0 + tt) * 1536 + ch0);
      }
      float wk[5][8];
#pragma unroll
      for (int k = 0; k < 5; ++k) {
        const float4 w0 = *(const float4*)(p.ssd_conv_w + ((size_t)l * 5 + k) * 1536 + ch0);
        const float4 w1 = *(const float4*)(p.ssd_conv_w + ((size_t)l * 5 + k) * 1536 + ch0 + 4);
        wk[k][0] = w0.x; wk[k][1] = w0.y; wk[k][2] = w0.z; wk[k][3] = w0.w; wk[k][4] = w1.x; wk[k][5] = w1.y; wk[k][6] = w1.z; wk[k][7] = w1.w;
      }
      float bias[8];
      {
        const float4 b0 = *(const float4*)(p.ssd_conv_b + l * 1536 + ch0);
        const float4 b1 = *(const float4*)(p.ssd_conv_b + l * 1536 + ch0 + 4);
        bias[0] = b0.x; bias[1] = b0.y; bias[2] = b0.z; bias[3] = b0.w; bias[4] = b1.x; bias[5] = b1.y; bias[6] = b1.z; bias[7] = b1.w;
      }
#pragma unroll
      for (int r = 0; r < 4; ++r) {
        float a[8];
#pragma unroll
        for (int c = 0; c < 8; ++c) a[c] = bias[c];
#pragma unroll
        for (int k = 0; k < 5; ++k) {
          const uint4 u = xr[r + k];
          a[0] += wk[k][0] * lo2f(u.x); a[1] += wk[k][1] * hi2f(u.x); a[2] += wk[k][2] * lo2f(u.y); a[3] += wk[k][3] * hi2f(u.y);
          a[4] += wk[k][4] * lo2f(u.z); a[5] += wk[k][5] * hi2f(u.z); a[6] += wk[k][6] * lo2f(u.w); a[7] += wk[k][7] * hi2f(u.w);
        }
        uint4 o;
        o.x = pack2(silu_f(a[0]), silu_f(a[1])); o.y = pack2(silu_f(a[2]), silu_f(a[3]));
        o.z = pack2(silu_f(a[4]), silu_f(a[5])); o.w = pack2(silu_f(a[6]), silu_f(a[7]));
        const size_t rho = (size_t)(rho0 + r);
        if (ch0 < 1024) *(uint4*)(XS + rho * 1024 + ch0) = o;
        else *(uint4*)(BC + rho * 512 + (ch0 - 1024)) = o;
      }
      continue;
    }
    it -= N_CONV;
    if (it < N_ROPE) {
      const int e = it * 256 + tid;
      const int rho = e / 40, rem = e % 40, hd = rem >> 2, sub = rem & 3;
      const int axis = sub >> 1, half = sub & 1;
      const int t = rho & 4095;
      const float pos = (float)(axis == 0 ? (t >> 6) : (t & 63));
      bf16_t* base = ((hd < 8) ? (Q + (size_t)rho * 512 + hd * 64) : (KV + (size_t)rho * 256 + (hd - 8) * 64)) + axis * 32 + half * 8;
      const float sc = (hd < 8) ? 0.125f : 1.f;
      const uint4 u1 = *(const uint4*)base, u2 = *(const uint4*)(base + 16);
      const unsigned a1[4] = {u1.x, u1.y, u1.z, u1.w}, a2[4] = {u2.x, u2.y, u2.z, u2.w};
      unsigned o1[4], o2[4];
#pragma unroll
      for (int i = 0; i < 4; ++i) {
        float r1[2], r2[2];
#pragma unroll
        for (int hl = 0; hl < 2; ++hl) {
          const float f = (float)(half * 8 + 2 * i + hl);
          const float ang = pos * exp2f(-f * 0.8304820237218406f);
          const float cs = __cosf(ang), sn = __sinf(ang);
          const float t1 = hl ? hi2f(a1[i]) : lo2f(a1[i]);
          const float t2 = hl ? hi2f(a2[i]) : lo2f(a2[i]);
          r1[hl] = (t1 * cs - t2 * sn) * sc;
          r2[hl] = (t2 * cs + t1 * sn) * sc;
        }
        o1[i] = pack2(r1[0], r1[1]); o2[i] = pack2(r2[0], r2[1]);
      }
      *(uint4*)base = make_uint4(o1[0], o1[1], o1[2], o1[3]);
      *(uint4*)(base + 16) = make_uint4(o2[0], o2[1], o2[2], o2[3]);
      continue;
    }
    it -= N_ROPE;
    {
      const int e = it * 256 + tid;
      const int rho = RL_ + e / 256, c2 = (e % 256) * 2;
      unsigned* ptr = (unsigned*)(Q + (size_t)rho * 512 + c2);
      const unsigned u = *ptr;
      *ptr = pack2(lo2f(u) * 0.125f, hi2f(u) * 0.125f);
    }
  }
}

DI void attn_item(const Params& p_in, int l, char* smem, int b, int qblk, int g, int hp, bool ctxq) {
  const Params p = load_params();

  bf16_t* sK = (bf16_t*)smem;
  bf16_t* sV = (bf16_t*)(smem + 128 * 72 * 2);
  int tid = threadIdx.x; asm volatile("" : "+v"(tid)); const int lane = tid & 63, wave = tid >> 6, fr = lane & 31, fh = lane >> 5;
  const int head = g * 4 + hp * 2 + (wave >> 1);
  const int qh = wave & 1;
  const int qrow0 = (ctxq ? (RL_ + b * 256) : (b * 4096)) + qblk * 128 + qh * 64;
  const int qpos0 = qblk * 128 + qh * 64;
  bf16_t* Q = (bf16_t*)(p.ws + OFF_Q);
  const bf16_t* KV = (const bf16_t*)(p.ws + OFF_KV);
  const bf16_t* AG = (const bf16_t*)(p.ws + OFF_AG);
  f32x16 o[2][2];
  zero_acc(o);
  float m[2], lsum[2];
  m[0] = m[1] = p.attn_sink[l * 8 + head];
  lsum[0] = lsum[1] = 1.f;
  const int nhb = ctxq ? 4 : 10;
  auto hb_row = [&](int hb) -> int {
    if (hb >= nhb) return -1;
    if (hb < 4) return RL_ + b * 256 + hb * 64;
    const int kp = (qblk - 1) * 128 + (hb - 4) * 64;
    if (kp < 0 || kp >= 4096) return -1;
    return b * 4096 + kp;
  };
  auto hb_next = [&](int hb) -> int { int n = hb + 1; while (n < nhb && hb_row(n) < 0) ++n; return n; };
  const int sr = tid >> 3, scv = tid & 7;
  uint4 kp0, kp1, vp0, vp1;
#define ATT_PREFETCH(ROW0) { const bf16_t* kvp = KV + (size_t)((ROW0) + sr) * 256 + g * 64 + scv * 8; \
    kp0 = *(const uint4*)(kvp); kp1 = *(const uint4*)(kvp + 32 * 256); vp0 = *(const uint4*)(kvp + 128); vp1 = *(const uint4*)(kvp + 128 + 32 * 256); }
#define ATT_STORE(BUF) { bf16_t* k_ = sK + (BUF) * 64 * 72; bf16_t* v_ = sV + (BUF) * 64 * 72; \
    *(uint4*)&k_[sr * 72 + scv * 8] = kp0; *(uint4*)&k_[(sr + 32) * 72 + scv * 8] = kp1; \
    *(uint4*)&v_[sr * 72 + scv * 8] = vp0; *(uint4*)&v_[(sr + 32) * 72 + scv * 8] = vp1; }
  int pbuf = 0;
  __syncthreads();
  ATT_PREFETCH(hb_row(0))
  ATT_STORE(0)
  __syncthreads();
  for (int hb = 0; hb < nhb; hb = hb_next(hb)) {
    const int nxt = hb_next(hb);
    if (nxt < nhb) ATT_PREFETCH(hb_row(nxt))
    int kpos0 = 0;
    bool masked = false;
    if (hb >= 4) { kpos0 = (qblk - 1) * 128 + (hb - 4) * 64; masked = (hb != 6 && hb != 7); }
    const bf16_t* cK = sK + pbuf * 64 * 72;
    const bf16_t* cV = sV + pbuf * 64 * 72;
    bf16x8 qf[2][4];
#pragma unroll
    for (int j = 0; j < 2; ++j)
#pragma unroll
      for (int ks = 0; ks < 4; ++ks)
        qf[j][ks] = *(const bf16x8*)(Q + (size_t)(qrow0 + j * 32 + fr) * 512 + head * 64 + ks * 16 + fh * 8);
#pragma unroll 1
    for (int kb = 0; kb < 2; ++kb) {
      if (masked) {
        const int klo = kpos0 + kb * 32, khi = klo + 31;
        if (klo - (qpos0 + 63) > 128 || qpos0 - khi > 128) continue;
      }
      bf16x8 pb[2][2];
#pragma unroll
      for (int j = 0; j < 2; ++j) {
        f32x16 st[2];
#pragma unroll
        for (int r = 0; r < 16; ++r) st[j][r] = 0.f;
#pragma unroll
        for (int ks = 0; ks < 4; ++ks) {
          const bf16x8 kf = *(const bf16x8*)&cK[(kb * 32 + fr) * 72 + ks * 16 + fh * 8];
          st[j] = MFMA(kf, qf[j][ks], st[j]);
        }
        if (masked) {
          const int qpos = qpos0 + j * 32 + fr;
#pragma unroll
          for (int r = 0; r < 16; ++r) {
            const int d = qpos - (kpos0 + kb * 32 + crow(r, fh));
            if (d > 128 || d < -128) st[j][r] = -1e30f;
          }
        }
        float mx = st[j][0];
#pragma unroll
        for (int r = 1; r < 16; ++r) mx = fmaxf(mx, st[j][r]);
        mx = fmaxf(mx, __shfl_xor(mx, 32));
        const float mnew = fmaxf(m[j], mx);
        const float alpha = __expf(m[j] - mnew);
        float rs = 0.f;
#pragma unroll
        for (int r = 0; r < 16; ++r) { const float pv = __expf(st[j][r] - mnew); st[j][r] = pv; rs += pv; }
        rs += __shfl_xor(rs, 32);
        lsum[j] = lsum[j] * alpha + rs;
        m[j] = mnew;
#pragma unroll
        for (int mt = 0; mt < 2; ++mt)
#pragma unroll
          for (int r = 0; r < 16; ++r) o[mt][j][r] *= alpha;
#pragma unroll
        for (int s = 0; s < 2; ++s) {
          uint4 pk;
          pk.x = pack2(st[j][8 * s + 0], st[j][8 * s + 1]); pk.y = pack2(st[j][8 * s + 2], st[j][8 * s + 3]);
          pk.z = pack2(st[j][8 * s + 4], st[j][8 * s + 5]); pk.w = pack2(st[j][8 * s + 6], st[j][8 * s + 7]);
          pb[j][s] = __builtin_bit_cast(bf16x8, pk);
        }
      }
#pragma unroll
      for (int s = 0; s < 2; ++s)
#pragma unroll
        for (int mt = 0; mt < 2; ++mt) {
          const bf16x8 vf = tr_frag(cV, 72, kb * 32 + 16 * s + 4 * fh, kb * 32 + 16 * s + 8 + 4 * fh, mt * 32);
#pragma unroll
          for (int j = 0; j < 2; ++j) o[mt][j] = MFMA(vf, pb[j][s], o[mt][j]);
        }
    }
    if (nxt < nhb) ATT_STORE(pbuf ^ 1)
    pbuf ^= 1;
    __syncthreads();
  }
#undef ATT_PREFETCH
#undef ATT_STORE
#pragma unroll
  for (int j = 0; j < 2; ++j) {
    const float inv = 1.f / lsum[j];
    const size_t rho = (size_t)(qrow0 + j * 32 + fr);
#pragma unroll
    for (int mt = 0; mt < 2; ++mt)
#pragma unroll
      for (int g4 = 0; g4 < 4; ++g4) {
        const int d0 = mt * 32 + 8 * g4 + 4 * fh;
        const uint2 gv = *(const uint2*)(AG + rho * 512 + head * 64 + d0);
        uint2 ov;
        ov.x = pack2(o[mt][j][g4 * 4 + 0] * inv * silu_f(lo2f(gv.x)), o[mt][j][g4 * 4 + 1] * inv * silu_f(hi2f(gv.x)));
        ov.y = pack2(o[mt][j][g4 * 4 + 2] * inv * silu_f(lo2f(gv.y)), o[mt][j][g4 * 4 + 3] * inv * silu_f(hi2f(gv.y)));
        *(uint2*)(Q + rho * 512 + head * 64 + d0) = ov;
      }
  }
}

DI void states_item(const Params& p_in, char* smem, int ck, int g, int hq) {
  const Params p = load_params();

  bf16_t* sB = (bf16_t*)smem;
  bf16_t* sX = (bf16_t*)(smem + 128 * 136 * 2);
  int tid = threadIdx.x; asm volatile("" : "+v"(tid)); const int lane = tid & 63, wave = tid >> 6, wr = wave >> 1, wc = wave & 1, fr = lane & 31, fh = lane >> 5;
  const bf16_t* BC = (const bf16_t*)(p.ws + OFF_BC);
  const bf16_t* XS = (const bf16_t*)(p.ws + OFF_H);
  const float* DT = (const float*)(p.ws + OFF_DT);
  const float* CS = (const float*)(p.ws + OFF_CS);
  bf16_t* ST = (bf16_t*)(p.ws + OFF_ST);
  float* CDEC = (float*)(p.ws + OFF_CDEC);
  const int row0 = ck * 128;
  __syncthreads();
  for (int v = tid; v < 2048; v += 256) {
    const int r = v >> 4, cv = v & 15;
    *(uint4*)&sB[r * 136 + cv * 8] = *(const uint4*)(BC + (size_t)(row0 + r) * 512 + g * 128 + cv * 8);
  }
  __syncthreads();
  bf16x8 bfr[2][8];
#pragma unroll
  for (int j = 0; j < 2; ++j)
#pragma unroll
    for (int ks = 0; ks < 8; ++ks) bfr[j][ks] = tr_frag(sB, 136, ks * 16 + 8 * fh, ks * 16 + 8 * fh + 4, wc * 64 + j * 32);
  const int slr = tid >> 3, scv = tid & 7;
  uint4 xq0, xq1, xq2, xq3;
  float dq0, dq1, dq2, dq3, cq0, cq1, cq2, cq3, cendq;
#define ST_PREFETCH(HD) { const int head_ = g * 8 + hq * 4 + ((HD) >> 1), d_ = (HD) & 1, col_ = d_ * 16 + head_; \
    const bf16_t* xp_ = XS + (size_t)(row0 + slr) * 1024 + head_ * 64 + scv * 8; \
    xq0 = *(const uint4*)(xp_); xq1 = *(const uint4*)(xp_ + 32 * 1024); xq2 = *(const uint4*)(xp_ + 64 * 1024); xq3 = *(const uint4*)(xp_ + 96 * 1024); \
    const size_t rb_ = (size_t)(row0 + slr) * 32 + col_; \
    dq0 = DT[rb_]; dq1 = DT[rb_ + 32 * 32]; dq2 = DT[rb_ + 64 * 32]; dq3 = DT[rb_ + 96 * 32]; \
    cq0 = CS[rb_]; cq1 = CS[rb_ + 32 * 32]; cq2 = CS[rb_ + 64 * 32]; cq3 = CS[rb_ + 96 * 32]; \
    cendq = CS[(size_t)(row0 + (d_ == 0 ? 127 : 0)) * 32 + col_]; }
#define ST_SCALE_STORE(X, DTV, CSV, ROW) { const float sc_ = (DTV) * __expf(cend - (CSV)); uint4 o_; \
    o_.x = pack2(lo2f(X.x) * sc_, hi2f(X.x) * sc_); o_.y = pack2(lo2f(X.y) * sc_, hi2f(X.y) * sc_); \
    o_.z = pack2(lo2f(X.z) * sc_, hi2f(X.z) * sc_); o_.w = pack2(lo2f(X.w) * sc_, hi2f(X.w) * sc_); \
    *(uint4*)&sX[(ROW) * 72 + scv * 8] = o_; }
  ST_PREFETCH(0)
#pragma unroll 1
  for (int hd = 0; hd < 8; ++hd) {
    const int head = g * 8 + hq * 4 + (hd >> 1), d = hd & 1;
    const float cend = cendq;
    ST_SCALE_STORE(xq0, dq0, cq0, slr)
    ST_SCALE_STORE(xq1, dq1, cq1, slr + 32)
    ST_SCALE_STORE(xq2, dq2, cq2, slr + 64)
    ST_SCALE_STORE(xq3, dq3, cq3, slr + 96)
    if (hd < 7) ST_PREFETCH(hd + 1)
    __syncthreads();
    f32x16 acc[2];
#pragma unroll
    for (int j = 0; j < 2; ++j)
#pragma unroll
      for (int r = 0; r < 16; ++r) acc[j][r] = 0.f;
#pragma unroll
    for (int ks = 0; ks < 8; ++ks) {
      const bf16x8 af = tr_frag(sX, 72, ks * 16 + 8 * fh, ks * 16 + 8 * fh + 4, wr * 32);
#pragma unroll
      for (int j = 0; j < 2; ++j) acc[j] = MFMA(af, bfr[j][ks], acc[j]);
    }
    bf16_t* dst = ST + ((size_t)(ck * 2 + d) * 16 + head) * 8192;
#pragma unroll
    for (int j = 0; j < 2; ++j)
#pragma unroll
      for (int r = 0; r < 16; ++r) dst[(wr * 32 + crow(r, fh)) * 128 + wc * 64 + j * 32 + fr] = f2bf(acc[j][r]);
    if (tid == 0) CDEC[(ck * 2 + d) * 16 + head] = __expf(cend);
    __syncthreads();
  }
}

DI void pw_item(const Params& p_in, int l, char* smem, int mt, int nt) {
  const Params p = load_params();

  GemmS* s = (GemmS*)smem;
  int tid = threadIdx.x; asm volatile("" : "+v"(tid)); const int lane = tid & 63, wave = tid >> 6, wr = wave >> 1, wc = wave & 1, fr = lane & 31, fh = lane >> 5;
  const bf16_t* Ab = (const bf16_t*)(p.ws + OFF_HDN) + (size_t)mt * 128 * 512;
  const bf16_t* Bb = (const bf16_t*)(p.ws + OFF_PW) + (size_t)nt * 128 * 512;
  bf16_t* CG = (bf16_t*)(p.ws + OFF_CG);
  f32x16 acc[2][2];
  zero_acc(acc);
  gemm_core2(acc, (GemmS2*)smem,
             [&](int kt, int r, int kv) { return Ab + (size_t)r * 512 + kt * 64 + kv * 8; },
             [&](int kt, int r, int kv) { return Bb + (size_t)r * 512 + kt * 64 + kv * 8; }, 8, [](int) {});
  const float* pwb = p.conv_pw_b + l * 512 + nt * 128;
  epilogue_lds(acc, smem, [&](int rl, int c4, float4 v) {
    bf16_t* ptr = CG + (size_t)(mt * 128 + rl) * 512 + nt * 128 + c4;
    const uint2 gv = *(const uint2*)ptr;
    const float4 bb = *(const float4*)(pwb + c4);
    uint2 o;
    o.x = pack2((v.x + bb.x) * silu_f(lo2f(gv.x)), (v.y + bb.y) * silu_f(hi2f(gv.x)));
    o.y = pack2((v.z + bb.z) * silu_f(lo2f(gv.y)), (v.w + bb.w) * silu_f(hi2f(gv.y)));
    *(uint2*)ptr = o;
  });
}

DI void phase_mix(const Params& p, int l, char* smem) {
  const int G = gridDim.x;
  const int N_ATT = 512 + (l == 0 ? 32 : 0);
  for (int it = blockIdx.x; it < N_ATT; it += G) {
    if (it < 512) attn_item(p, l, smem, it >> 7, (it >> 2) & 31, (it >> 1) & 1, it & 1, false);
    else { const int t = it - 512; attn_item(p, l, smem, t >> 3, (t >> 2) & 1, (t >> 1) & 1, t & 1, true); }
  }
  for (int it = (blockIdx.x + G - 32) % G; it < NCK * 4; it += G) states_item(p, smem, it >> 2, (it >> 1) & 1, it & 1);
  for (int it = (blockIdx.x + G - 64) % G; it < NCK * 4; it += G) pw_item(p, l, smem, it >> 2, it & 3);
}

DI void phase_scan(const Params& p_in) {
  const Params p = load_params();

  bf16_t* ST = (bf16_t*)(p.ws + OFF_ST);
  const float* CDEC = (const float*)(p.ws + OFF_CDEC);
  for (int it = blockIdx.x; it < 512; it += gridDim.x) {
    const int e = it * 256 + threadIdx.x;
    const int bdh = e >> 10, v8 = e & 1023;
    const int b = bdh >> 5, d = (bdh >> 4) & 1, h = bdh & 15;
    float s[8];
#pragma unroll
    for (int i = 0; i < 8; ++i) s[i] = 0.f;
    auto ckof = [&](int i) {
      if (d == 0) return (i < 2) ? (128 + 2 * b + i) : (32 * b + (i - 2));
      return (i < 2) ? (128 + 2 * b + (1 - i)) : (32 * b + 31 - (i - 2));
    };
    auto pof = [&](int i) { const int ck = ckof(i); return (uint4*)(ST + ((size_t)(ck * 2 + d) * 16 + h) * 8192 + v8 * 8); };
    auto dof = [&](int i) { const int ck = ckof(i); return CDEC[(ck * 2 + d) * 16 + h]; };
    uint4 buf[4]; float dc[4];
#pragma unroll
    for (int i = 0; i < 3; ++i) { buf[i] = *pof(i); dc[i] = dof(i); }
#pragma unroll
    for (int i = 0; i < 34; ++i) {
      if (i + 3 < 34) { buf[(i + 3) & 3] = *pof(i + 3); dc[(i + 3) & 3] = dof(i + 3); }
      const uint4 cur = buf[i & 3];
      const float dec = dc[i & 3];
      uint4 o;
      o.x = pack2(s[0], s[1]); o.y = pack2(s[2], s[3]); o.z = pack2(s[4], s[5]); o.w = pack2(s[6], s[7]);
      *pof(i) = o;
      s[0] = s[0] * dec + lo2f(cur.x); s[1] = s[1] * dec + hi2f(cur.x);
      s[2] = s[2] * dec + lo2f(cur.y); s[3] = s[3] * dec + hi2f(cur.y);
      s[4] = s[4] * dec + lo2f(cur.z); s[5] = s[5] * dec + hi2f(cur.z);
      s[6] = s[6] * dec + lo2f(cur.w); s[7] = s[7] * dec + hi2f(cur.w);
    }
  }
}

DI void phase_ssdy(const Params& p_in, int l, char* smem) {
  const Params p = load_params();

  bf16_t* sB = (bf16_t*)smem;
  bf16_t* sX = (bf16_t*)(smem + 128 * 136 * 2);
  float* sF = (float*)(smem + 128 * 136 * 2 + 128 * 72 * 2);
  float* sSS = sF + 512;
  int tid = threadIdx.x; asm volatile("" : "+v"(tid)); const int lane = tid & 63, wave = tid >> 6, fr = lane & 31, fh = lane >> 5;
  const int wl = wave >> 1, w2 = wave & 1;
  const bf16_t* BC = (const bf16_t*)(p.ws + OFF_BC);
  const bf16_t* XS = (const bf16_t*)(p.ws + OFF_H);
  const float* DT = (const float*)(p.ws + OFF_DT);
  const float* CS = (const float*)(p.ws + OFF_CS);
  const bf16_t* ST = (const bf16_t*)(p.ws + OFF_ST);
  bf16_t* Z = (bf16_t*)(p.ws + OFF_Z);
  float* RSTD = (float*)(p.ws + OFF_RSTD);
  const int nck = (l == 0) ? NCK : 128;
  const int nh = (l == 0) ? 2 : 8;
  const int nsplit = 8 / nh;
  for (int it0 = blockIdx.x; it0 < nck * 4 * nsplit; it0 += gridDim.x) {
    const int hq = it0 % nsplit, it = it0 / nsplit;
    const int hbeg = hq * nh, hend = hbeg + nh;
    const int ck = it >> 2, g = (it >> 1) & 1, lh = it & 1;
    const int row0 = ck * 128;
    const int lbase = lh * 64 + wl * 32;
    __syncthreads();
    for (int v = tid; v < 2048; v += 256) {
      const int r = v >> 4, cv = v & 15;
      *(uint4*)&sB[r * 136 + cv * 8] = *(const uint4*)(BC + (size_t)(row0 + r) * 512 + g * 128 + cv * 8);
    }
    if (tid < 64) sSS[tid] = 0.f;
    const bf16_t* cptr = BC + (size_t)(row0 + lbase + fr) * 512 + 256 + g * 128 + fh * 8;
    bf16x8 cf[8];
#pragma unroll
    for (int ks = 0; ks < 8; ++ks) cf[ks] = *(const bf16x8*)(cptr + ks * 16);
    const int lrx = tid >> 3, cvx = tid & 7;
    const bf16_t* xsrc = XS + (size_t)(row0 + lrx) * 1024 + cvx * 8;
    uint4 xp0, xp1, xp2, xp3;
    float fp0 = 0.f, fp1 = 0.f, fp2 = 0.f, fp3 = 0.f;
    {
      const int head = g * 8 + hbeg;
      xp0 = *(const uint4*)(xsrc + head * 64);
      xp1 = *(const uint4*)(xsrc + head * 64 + 32 * 1024);
      xp2 = *(const uint4*)(xsrc + head * 64 + 64 * 1024);
      xp3 = *(const uint4*)(xsrc + head * 64 + 96 * 1024);
      if (tid < 128) {
        const size_t rho = (size_t)(row0 + tid);
        fp0 = CS[rho * 32 + head]; fp1 = CS[rho * 32 + 16 + head]; fp2 = DT[rho * 32 + head]; fp3 = DT[rho * 32 + 16 + head];
      }
    }
    __syncthreads();
    f32x16 cb[2];
#pragma unroll
    for (int j = 0; j < 2; ++j) {
#pragma unroll
      for (int r = 0; r < 16; ++r) cb[j][r] = 0.f;
#pragma unroll
      for (int ks = 0; ks < 8; ++ks) {
        const bf16x8 bq = *(const bf16x8*)&sB[(w2 * 64 + j * 32 + fr) * 136 + ks * 16 + fh * 8];
        cb[j] = MFMA(cf[ks], bq, cb[j]);
      }
    }
    const int pidx = w2 * 32 + fr;
    bf16_t* sCB = sB + 64 * 136;
    __syncthreads();
#pragma unroll
    for (int j = 0; j < 2; ++j)
#pragma unroll
      for (int r = 0; r < 16; ++r) sCB[(wl * 32 + crow(r, fh)) * 136 + w2 * 64 + j * 32 + fr] = f2bf(cb[j][r]);
#pragma unroll 1
    for (int hh = hbeg; hh < hend; ++hh) {
      const int head = g * 8 + hh;
      __syncthreads();
      *(uint4*)&sX[lrx * 72 + cvx * 8] = xp0;
      *(uint4*)&sX[(lrx + 32) * 72 + cvx * 8] = xp1;
      *(uint4*)&sX[(lrx + 64) * 72 + cvx * 8] = xp2;
      *(uint4*)&sX[(lrx + 96) * 72 + cvx * 8] = xp3;
      if (tid < 128) { sF[tid] = fp0; sF[128 + tid] = fp1; sF[256 + tid] = fp2; sF[384 + tid] = fp3; }
      const bf16_t* S0 = ST + ((size_t)(ck * 2 + 0) * 16 + head) * 8192 + (w2 * 32 + fr) * 128 + fh * 8;
      const bf16_t* S1 = ST + ((size_t)(ck * 2 + 1) * 16 + head) * 8192 + (w2 * 32 + fr) * 128 + fh * 8;
      bf16x8 sf0[8];
#pragma unroll
      for (int ks = 0; ks < 8; ++ks) sf0[ks] = *(const bf16x8*)(S0 + ks * 16);
      bf16_t* zbase = Z + (size_t)(row0 + lbase + 4 * fh) * 1024 + head * 64 + pidx;
      if (hh + 1 < hend) {
        const int hn = head + 1;
        xp0 = *(const uint4*)(xsrc + hn * 64);
        xp1 = *(const uint4*)(xsrc + hn * 64 + 32 * 1024);
        xp2 = *(const uint4*)(xsrc + hn * 64 + 64 * 1024);
        xp3 = *(const uint4*)(xsrc + hn * 64 + 96 * 1024);
        if (tid < 128) {
          const size_t rho = (size_t)(row0 + tid);
          fp0 = CS[rho * 32 + hn]; fp1 = CS[rho * 32 + 16 + hn]; fp2 = DT[rho * 32 + hn]; fp3 = DT[rho * 32 + 16 + hn];
        }
      }
      __syncthreads();
#pragma unroll
      for (int j = 0; j < 2; ++j) {
        const int sidx = w2 * 64 + j * 32 + fr;
        const float csf_s = sF[sidx], csb_s = sF[128 + sidx], dtf_s = sF[256 + sidx], dtb_s = sF[384 + sidx];
#pragma unroll 4
        for (int r = 0; r < 16; ++r) {
          const int lidx = lbase + crow(r, fh);
          float f = 0.f;
          if (sidx <= lidx) f += __expf(sF[lidx] - csf_s) * dtf_s;
          if (sidx >= lidx) f += __expf(sF[128 + lidx] - csb_s) * dtb_s;
          sB[(wl * 32 + crow(r, fh)) * 136 + sidx] = f2bf(bf2f(sCB[(wl * 32 + crow(r, fh)) * 136 + sidx]) * f);
        }
      }
      __syncthreads();
      bf16x8 sf1[8], cfh[8];
#pragma unroll
      for (int ks = 0; ks < 8; ++ks) { sf1[ks] = *(const bf16x8*)(S1 + ks * 16); cfh[ks] = *(const bf16x8*)(cptr + ks * 16); }
      unsigned short zv[16];
#pragma unroll
      for (int r = 0; r < 16; ++r) zv[r] = zbase[(size_t)((r & 3) + 8 * (r >> 2)) * 1024];
      f32x16 accy;
#pragma unroll
      for (int r = 0; r < 16; ++r) accy[r] = 0.f;
#pragma unroll
      for (int ks = 0; ks < 8; ++ks) {
        const bf16x8 af = *(const bf16x8*)&sB[(wl * 32 + fr) * 136 + ks * 16 + fh * 8];
        const bf16x8 xf = tr_frag(sX, 72, ks * 16 + 8 * fh, ks * 16 + 8 * fh + 4, w2 * 32);
        accy = MFMA(af, xf, accy);
      }
      {
        f32x16 acct;
#pragma unroll
        for (int r = 0; r < 16; ++r) acct[r] = 0.f;
#pragma unroll
        for (int ks = 0; ks < 8; ++ks) acct = MFMA(cfh[ks], sf0[ks], acct);
#pragma unroll
        for (int r = 0; r < 16; ++r) accy[r] += __expf(sF[lbase + crow(r, fh)]) * acct[r];
#pragma unroll
        for (int r = 0; r < 16; ++r) acct[r] = 0.f;
#pragma unroll
        for (int ks = 0; ks < 8; ++ks) acct = MFMA(cfh[ks], sf1[ks], acct);
#pragma unroll
        for (int r = 0; r < 16; ++r) accy[r] += __expf(sF[128 + lbase + crow(r, fh)]) * acct[r];
      }
      const float dsk = p.ssd_d[l * 16 + head];
      float v[16];
#pragma unroll
      for (int r = 0; r < 16; ++r) {
        const int lidx = lbase + crow(r, fh);
        const float xv = bf2f(sX[lidx * 72 + pidx]);
        const float y = accy[r] + dsk * xv;
        const float u = y * silu_f(bf2f(zv[r]));
        v[r] = u * u;
        zbase[(size_t)((r & 3) + 8 * (r >> 2)) * 1024] = f2bf(u);
      }
#pragma unroll
      for (int i = 0; i < 8; ++i) { const bool up = (fr & 16) != 0; const float keep = up ? v[i + 8] : v[i]; const float send = up ? v[i] : v[i + 8]; v[i] = keep + __shfl_xor(send, 16); }
#pragma unroll
      for (int i = 0; i < 4; ++i) { const bool up = (fr & 8) != 0; const float keep = up ? v[i + 4] : v[i]; const float send = up ? v[i] : v[i + 4]; v[i] = keep + __shfl_xor(send, 8); }
#pragma unroll
      for (int i = 0; i < 2; ++i) { const bool up = (fr & 4) != 0; const float keep = up ? v[i + 2] : v[i]; const float send = up ? v[i] : v[i + 2]; v[i] = keep + __shfl_xor(send, 4); }
      { const bool up = (fr & 2) != 0; const float keep = up ? v[1] : v[0]; const float send = up ? v[0] : v[1]; v[0] = keep + __shfl_xor(send, 2); }
      v[0] += __shfl_xor(v[0], 1);
      if ((fr & 1) == 0) atomicAdd(&sSS[wl * 32 + crow(fr >> 1, fh)], v[0]);
    }
    __syncthreads();
    if (tid < 64) atomicAdd(&RSTD[(size_t)(row0 + lh * 64 + tid) * 2 + g], sSS[tid]);
  }
}

DI void phase_outproj(const Params& p_in, int l, char* smem) {
  const Params p = load_params();

  GemmS* s = (GemmS*)smem;
  int tid = threadIdx.x; asm volatile("" : "+v"(tid)); const int lane = tid & 63, wave = tid >> 6, wr = wave >> 1, wc = wave & 1, fr = lane & 31, fh = lane >> 5;
  const bf16_t* Zb = (const bf16_t*)(p.ws + OFF_Z);
  const bf16_t* Qb = (const bf16_t*)(p.ws + OFF_Q);
  const bf16_t* Cb = (const bf16_t*)(p.ws + OFF_CG);
  const bf16_t* W = (const bf16_t*)(p.ws + OFF_WOUT);
  const float* RSTD = (const float*)(p.ws + OFF_RSTD);
  const float* mods = (const float*)(p.ws + OFF_MODS);
  float* XC = (float*)(p.ws + OFF_XC);
  const int nM = (l == 0) ? NCK : 128;
  for (int step = 0;; ++step) {
    int mt, nt;
    if (!xcd_tile(step, nM, 8, mt, nt)) break;
    f32x16 acc[2][2];
    zero_acc(acc);
    const bf16_t* Wb = W + (size_t)nt * 128 * 2048;
    const bf16_t* A0 = Zb + (size_t)mt * 128 * 1024;
    const bf16_t* A2 = Qb + (size_t)mt * 128 * 512;
    const bf16_t* A3 = Cb + (size_t)mt * 128 * 512;
    float* sScale = (float*)(smem + 40960);
    if (tid < 128) {
      const size_t row = (size_t)(mt * 128 + tid);
      const float r0 = rsqrtf(RSTD[row * 2] * (1.f / 512.f) + 1e-6f);
      const float r1 = rsqrtf(RSTD[row * 2 + 1] * (1.f / 512.f) + 1e-6f);
      sScale[tid * 2] = r0 / r1;
      sScale[tid * 2 + 1] = r1;
    }
    gemm_core2(acc, (GemmS2*)smem,
               [&](int kt, int r, int kv) {
                 const bf16_t* ptr;
                 if (kt < 16) ptr = A0 + (size_t)r * 1024 + kt * 64;
                 else if (kt < 24) ptr = A2 + (size_t)r * 512 + (kt - 16) * 64;
                 else ptr = A3 + (size_t)r * 512 + (kt - 24) * 64;
                 return ptr + kv * 8;
               },
               [&](int kt, int r, int kv) { return Wb + (size_t)r * 2048 + kt * 64 + kv * 8; }, 32,
               [&](int kt) __attribute__((always_inline)) {
                 if (kt == 8 || kt == 16) {
#pragma unroll
                   for (int i = 0; i < 2; ++i)
#pragma unroll
                     for (int r = 0; r < 16; ++r) {
                       const float f = sScale[(wr * 64 + i * 32 + crow(r, fh)) * 2 + (kt == 16 ? 1 : 0)];
                       acc[i][0][r] *= f; acc[i][1][r] *= f;
                     }
                 }
               });
    {
      const int row0 = mt * 128;
      const int vv = (row0 < RL_) ? (row0 >> 12) : 4;
      const float* gate = mods + (l * 5 + vv) * 3072 + 2048 + nt * 128;
      float* xnew = (row0 < RL_) ? (p.out + (size_t)row0 * 1024) : (XC + (size_t)(row0 - RL_) * 1024);
      const float* xold = (l == 0) ? ((row0 < RL_) ? (p.x + (size_t)row0 * 1024) : (p.ctx + (size_t)(row0 - RL_) * 1024)) : xnew;
      epilogue_lds(acc, smem, [&](int rl, int c4, float4 v) {
        const int off = rl * 1024 + nt * 128 + c4;
        const float4 xo = *(const float4*)(xold + off);
        const float4 gt = *(const float4*)(gate + c4);
        float4 o;
        o.x = xo.x + gt.x * v.x; o.y = xo.y + gt.y * v.y; o.z = xo.z + gt.z * v.z; o.w = xo.w + gt.w * v.w;
        *(float4*)(xnew + off) = o;
      });
    }
  }
}

DI void phase_final(const Params& p_in) {
  const Params p = load_params();
  const int lane = threadIdx.x & 63, wave = threadIdx.x >> 6;
  for (int it = blockIdx.x; it < RL_ / 4; it += gridDim.x) {
    float* xr = p.out + (size_t)(it * 4 + wave) * 1024;
    float4 xv[4];
    float ss = 0.f;
#pragma unroll
    for (int i = 0; i < 4; ++i) {
      xv[i] = *(const float4*)(xr + lane * 4 + i * 256);
      ss += xv[i].x * xv[i].x + xv[i].y * xv[i].y + xv[i].z * xv[i].z + xv[i].w * xv[i].w;
    }
#pragma unroll
    for (int o = 32; o >= 1; o >>= 1) ss += __shfl_xor(ss, o);
    const float rs = rsqrtf(ss * (1.f / 1024.f) + 1e-6f);
#pragma unroll
    for (int i = 0; i < 4; ++i) {
      const float4 w = *(const float4*)(p.final_norm_w + lane * 4 + i * 256);
      float4 o;
      o.x = xv[i].x * rs * w.x; o.y = xv[i].y * rs * w.y; o.z = xv[i].z * rs * w.z; o.w = xv[i].w * rs * w.w;
      *(float4*)(xr + lane * 4 + i * 256) = o;
    }
  }
}

template <int PH>
DI void run_phase(const Params& p, char* smem) {
  constexpr int l = (PH - 1) / 7, s = (PH - 1) % 7;
  if constexpr (PH == 0) phase_mods(p, smem);
  else if constexpr (PH == 15) phase_final(p);
  else if constexpr (s == 0) phase_prep(p, l, smem);
  else if constexpr (s == 1) phase_inproj(p, smem);
  else if constexpr (s == 2) phase_local(p, l, smem);
  else if constexpr (s == 3) phase_mix(p, l, smem);
  else if constexpr (s == 4) phase_scan(p);
  else if constexpr (s == 5) phase_ssdy(p, l, smem);
  else phase_outproj(p, l, smem);
}

#if PROBE_S >= 0
#define PROBE_BEGIN() if (threadIdx.x == 0) pst[1] = wall_clock64();
#define PROBE_END(PH) if (threadIdx.x == 0 && (PH) >= 1 && (PH) <= 14 && (((PH) - 1) % 7) == PROBE_S) pst[0] += wall_clock64() - pst[1];
#else
#define PROBE_BEGIN()
#define PROBE_END(PH)
#endif
#define PHASE(PH) PROBE_BEGIN() run_phase<PH>(p, smem); xcd_barrier(xst); PROBE_END(PH)

__global__ void __launch_bounds__(256, 2) fwd_megakernel(Params p) {
  __shared__ __attribute__((aligned(16))) char smem[57344];
  cg::grid_group grid = cg::this_grid();
#if PROBE_S >= 0
  volatile unsigned long long* pst = (volatile unsigned long long*)(smem + 57344 - 16);
  if (threadIdx.x == 0) { pst[0] = 0; pst[1] = 0; }
#endif
  __shared__ uint4 xb_words;
  volatile LAS unsigned* xst = (volatile LAS unsigned*)&xb_words;
  if (threadIdx.x == 0) xb_words = make_uint4(0u, 0u, 0u, 0u);
  run_phase<0>(p, smem);
  grid.sync();
  if (threadIdx.x == 0) { unsigned* bar = (unsigned*)(load_params().ws + OFF_BAR); (void)xb_add(&bar[XB_XCNT(xb_xcc_id())], 1u); }
  PHASE(1) PHASE(2) PHASE(3) PHASE(4) PHASE(5) PHASE(6) PHASE(7)
  PHASE(8) PHASE(9) PHASE(10) PHASE(11) PHASE(12) PHASE(13) PHASE(14)
  run_phase<15>(p, smem);
#if PROBE_S >= 0
  if (blockIdx.x == 0 && threadIdx.x == 0) {
    const unsigned long long t1 = wall_clock64();
    const unsigned long long lim = 4ull * pst[0];
    while (wall_clock64() - t1 < lim) { __builtin_amdgcn_s_sleep(32); }
  }
#endif
}

extern "C" void kernel_launch(void* const* d_in, const int* in_sizes, int n_in, void* d_out, int out_size, void* d_ws,
                              size_t ws_size, hipStream_t stream) {
  static int grid_blocks = 0;
  if (!grid_blocks) {
    int dev = 0, cus = 0, per_cu = 0;
    hipGetDevice(&dev);
    hipDeviceGetAttribute(&cus, hipDeviceAttributeMultiprocessorCount, dev);
    hipOccupancyMaxActiveBlocksPerMultiprocessor(&per_cu, fwd_megakernel, 256, 0);
    if (per_cu < 1) per_cu = 1;
    if (per_cu > 2) per_cu = 2;
    grid_blocks = (cus * per_cu) & ~7;
  }
  Params p{};
  const float** pp = (const float**)&p;
  for (int i = 0; i < 23; ++i) pp[i] = (const float*)d_in[i];
  p.out = (float*)d_out;
  p.ws = (char*)d_ws;
  void* args[] = {&p};
  hipError_t e = hipLaunchCooperativeKernel((void*)fwd_megakernel, dim3(grid_blocks), dim3(256), args, 0, stream);
  if (e != hipSuccess) fprintf(stderr, "cooperative launch failed: %s (grid %d)\n", hipGetErrorString(e), grid_blocks);
}
```

```cpp
#include <hip/hip_runtime.h>
#include <hip/hip_cooperative_groups.h>
#include <stdint.h>
#include <stdio.h>
namespace cg = cooperative_groups;

#ifndef ONE_LAUNCH
#define ONE_LAUNCH 1
#endif

#ifndef PROBE_S
#define PROBE_S -1
#endif
#define DI __device__ __forceinline__
typedef unsigned short bf16_t;
using bf16x8 = __attribute__((ext_vector_type(8))) short;
using s16x4 = __attribute__((ext_vector_type(4))) short;
using f32x16 = __attribute__((ext_vector_type(16))) float;
#define MFMA(a, b, c) __builtin_amdgcn_mfma_f32_32x32x16_bf16((a), (b), (c), 0, 0, 0)

constexpr int R_ = 17408;
constexpr int RL_ = 16384;
constexpr int NCK = 136;

constexpr size_t SZ_WIN = (size_t)5632 * 1024 * 2;
constexpr size_t SZ_WOUT = (size_t)1024 * 2048 * 2;
constexpr size_t SZ_PW = (size_t)512 * 512 * 2;
constexpr size_t SZ_MODS = (size_t)2 * 5 * 3072 * 4;
constexpr size_t SZ_XC = (size_t)1024 * 1024 * 4;
constexpr size_t SZ_RSTD = (size_t)R_ * 2 * 4;
constexpr size_t SZ_CDEC = (size_t)NCK * 32 * 4 + 256 - ((size_t)NCK * 32 * 4) % 256;
constexpr size_t SZ_R512 = (size_t)R_ * 512 * 2;
constexpr size_t OFF_WIN = 0;
constexpr size_t OFF_WOUT = OFF_WIN + SZ_WIN;
constexpr size_t OFF_PW = OFF_WOUT + SZ_WOUT;
constexpr size_t OFF_MODS = OFF_PW + SZ_PW;
constexpr size_t OFF_XC = OFF_MODS + SZ_MODS;
constexpr size_t OFF_RSTD = OFF_XC + SZ_XC;
constexpr size_t OFF_CDEC = OFF_RSTD + SZ_RSTD;
constexpr size_t OFF_H = OFF_CDEC + SZ_CDEC;
constexpr size_t OFF_XBC = OFF_H + 2 * SZ_R512;
constexpr size_t OFF_GLU = OFF_XBC + 3 * SZ_R512;
constexpr size_t OFF_ST = OFF_XBC;
constexpr size_t OFF_Z = OFF_GLU + SZ_R512;
constexpr size_t OFF_DT = OFF_Z + 2 * SZ_R512;
constexpr size_t OFF_CS = OFF_DT + (size_t)R_ * 32 * 4;
constexpr size_t OFF_Q = OFF_CS + (size_t)R_ * 32 * 4;
constexpr size_t OFF_KV = OFF_Q + SZ_R512;
constexpr size_t OFF_AG = OFF_KV + SZ_R512 / 2;
constexpr size_t OFF_CG = OFF_AG + SZ_R512;
constexpr size_t OFF_BC = OFF_CG + SZ_R512;
constexpr size_t OFF_HDN = OFF_BC + SZ_R512;
constexpr size_t WS_TOTAL = OFF_HDN + SZ_R512;
constexpr size_t OFF_BAR = WS_TOTAL;
static_assert(OFF_BAR + 16384 <= (size_t)256 * 1024 * 1024, "workspace too large");

struct Params {
  const float *x, *c, *ctx, *c_ctx, *w_mod, *b_mod, *norm_w, *w_in, *ssd_conv_w, *ssd_conv_b, *ssd_dt_bias, *ssd_a_log,
      *ssd_d, *ssd_norm_w, *attn_sink, *conv_dw_w, *conv_dw_b, *conv_ln_w, *conv_ln_b, *conv_pw_w, *conv_pw_b, *w_out,
      *final_norm_w;
  float* out;
  char* ws;
};


DI Params load_params() {
  typedef const char __attribute__((address_space(4)))* kptr_t;
  typedef const float* const __attribute__((address_space(4)))* kfld_t;
  size_t off = 0;
  asm volatile("" : "+s"(off));
  kptr_t base = (kptr_t)__builtin_amdgcn_kernarg_segment_ptr() + off;
  Params p;
  const float** pp = (const float**)&p;
#pragma unroll
  for (int i = 0; i < 25; ++i) pp[i] = *(kfld_t)(base + 8 * i);
  return p;
}

#define XB_TMO      128
#define XB_XCNT(j)  (256  + 64 * (j))
#define XB_XSUB(j)  (1280 + 64 * (j))
#define XB_XGEN(j)  (2304 + 64 * (j))
#define XB_TOP      3328
#define XB_TOPGEN   3392
#define XCD_BAR_WORDS 3456
#define XB_SPIN_CAP (1u << 18)
#define LAS __attribute__((address_space(3)))
DI unsigned xb_ld(unsigned* p)              { return __hip_atomic_load(p, __ATOMIC_RELAXED, __HIP_MEMORY_SCOPE_AGENT); }
DI unsigned xb_add(unsigned* p, unsigned v) { return __hip_atomic_fetch_add(p, v, __ATOMIC_RELAXED, __HIP_MEMORY_SCOPE_AGENT); }
DI unsigned xb_xcc_id() { return (unsigned)__builtin_amdgcn_s_getreg((3 << 11) | 20) & 0xFu; }
#define XB_SPIN(cond, bar) do { unsigned _sp = 0; while (cond) { __builtin_amdgcn_s_sleep(1); \
    if ((++_sp & 255u) == 0u) { if (xb_ld(&(bar)[XB_TMO])) break; if (_sp > XB_SPIN_CAP) { atomicAdd(&(bar)[XB_TMO], 1u); break; } } } } while (0)

DI void xcd_barrier_complete(unsigned* bar, unsigned x, unsigned& nloc, unsigned& nx) {
  const unsigned G = gridDim.x * gridDim.y * gridDim.z;
  unsigned sum, cnt, mine, sp = 0u;
  for (;;) {
    sum = 0u; cnt = 0u; mine = 0u;
#pragma unroll
    for (unsigned j = 0; j < 16; ++j) { const unsigned c = xb_ld(&bar[XB_XCNT(j)]); sum += c; cnt += (c > 0u) ? 1u : 0u; mine = (j == x) ? c : mine; }
    if (sum == G) break;
    __builtin_amdgcn_s_sleep(1);
    if ((++sp & 255u) == 0u) { if (xb_ld(&bar[XB_TMO])) break; if (sp > XB_SPIN_CAP) { atomicAdd(&bar[XB_TMO], 1u); break; } }
  }
  nloc = mine > 0u ? mine : 1u; nx = cnt > 0u ? cnt : 1u;
}

DI void xcd_barrier(volatile LAS unsigned* st) {
  asm volatile("s_waitcnt vmcnt(0)" ::: "memory");
  __syncthreads();
  if (threadIdx.x == 0) {
    const Params pb = load_params();
    unsigned* bar = (unsigned*)(pb.ws + OFF_BAR);
    const unsigned x = xb_xcc_id();
    __builtin_amdgcn_s_waitcnt(0);
    unsigned nloc = st[0], nx = st[1];
    if (nloc == 0u) { xcd_barrier_complete(bar, x, nloc, nx); st[0] = nloc; st[1] = nx; }
    const unsigned old = xb_add(&bar[XB_XSUB(x)], 1u);
    const unsigned gen = old / nloc;
    if (old + 1u == (gen + 1u) * nloc) {
      __builtin_amdgcn_fence(__ATOMIC_RELEASE, "agent");
      asm volatile("s_waitcnt vmcnt(0)" ::: "memory");
      const unsigned og = xb_add(&bar[XB_TOP], 1u);
      const unsigned tg = og / nx;
      if (og + 1u == (tg + 1u) * nx) xb_add(&bar[XB_TOPGEN], 1u);
      else XB_SPIN(xb_ld(&bar[XB_TOPGEN]) == tg, bar);
      __builtin_amdgcn_fence(__ATOMIC_ACQUIRE, "agent");
      xb_add(&bar[XB_XGEN(x)], 1u);
      asm volatile("s_waitcnt vmcnt(0)" ::: "memory");
    } else {
      XB_SPIN(xb_ld(&bar[XB_XGEN(x)]) == gen, bar);
      __builtin_amdgcn_fence(__ATOMIC_ACQUIRE, "agent");
      asm volatile("s_waitcnt vmcnt(0)" ::: "memory");
    }
  }
  __syncthreads();
}

typedef __bf16 nbf16x2_t __attribute__((ext_vector_type(2)));
typedef float nf32x2_t __attribute__((ext_vector_type(2)));
DI unsigned short f2bf(float x) { const __bf16 r = (__bf16)x; return __builtin_bit_cast(unsigned short, r); }
DI float bf2f(unsigned short b) { return __uint_as_float(((unsigned)b) << 16); }
DI unsigned pack2(float a, float b) { const nf32x2_t v = {a, b}; const nbf16x2_t r = __builtin_convertvector(v, nbf16x2_t); return __builtin_bit_cast(unsigned, r); }
DI float lo2f(unsigned u) { return __uint_as_float(u << 16); }
DI float hi2f(unsigned u) { return __uint_as_float(u & 0xffff0000u); }
DI float silu_f(float x) { return x / (1.f + __expf(-x)); }
DI float sigmoid_f(float x) { return 1.f / (1.f + __expf(-x)); }
DI int crow(int reg, int h) { return (reg & 3) + 8 * (reg >> 2) + 4 * h; }

DI bf16x8 tr_frag(const bf16_t* s, int ld, int row_lo, int row_hi, int col0) {
  const int lane = threadIdx.x & 63;
  const int i16 = lane & 15, q = i16 >> 2, pp = i16 & 3, blk = (lane >> 4) & 1;
  const unsigned a0 = (unsigned)(size_t)(s + (row_lo + q) * ld + col0 + 16 * blk + 4 * pp);
  const unsigned a1 = (unsigned)(size_t)(s + (row_hi + q) * ld + col0 + 16 * blk + 4 * pp);
  s16x4 lo, hi;
  asm volatile("ds_read_b64_tr_b16 %0, %2\n\tds_read_b64_tr_b16 %1, %3\n\ts_waitcnt lgkmcnt(0)"
               : "=&v"(lo), "=&v"(hi) : "v"(a0), "v"(a1) : "memory");
  return __builtin_shufflevector(lo, hi, 0, 1, 2, 3, 4, 5, 6, 7);
}

struct GemmS { bf16_t a[2][128][40]; bf16_t b[2][128][40]; };

template <class AF, class BF>
DI void gemm_core(f32x16 (&acc)[2][2], GemmS* s, AF aptr, BF bptr, int nk) {
  int tid = threadIdx.x; asm volatile("" : "+v"(tid)); const int lane = tid & 63, wave = tid >> 6, wr = wave >> 1, wc = wave & 1;
  const int r0 = tid >> 2, kv = tid & 3;
  const int fr = lane & 31, fh = lane >> 5;
  uint4 ra0 = *(const uint4*)aptr(0, r0, kv), ra1 = *(const uint4*)aptr(0, r0 + 64, kv);
  uint4 rb0 = *(const uint4*)bptr(0, r0, kv), rb1 = *(const uint4*)bptr(0, r0 + 64, kv);
  *(uint4*)&s->a[0][r0][kv * 8] = ra0; *(uint4*)&s->a[0][r0 + 64][kv * 8] = ra1;
  *(uint4*)&s->b[0][r0][kv * 8] = rb0; *(uint4*)&s->b[0][r0 + 64][kv * 8] = rb1;
  __syncthreads();
#pragma unroll 1
  for (int kt = 0; kt < nk; ++kt) {
    const int buf = kt & 1;
    if (kt + 1 < nk) {
      ra0 = *(const uint4*)aptr(kt + 1, r0, kv); ra1 = *(const uint4*)aptr(kt + 1, r0 + 64, kv);
      rb0 = *(const uint4*)bptr(kt + 1, r0, kv); rb1 = *(const uint4*)bptr(kt + 1, r0 + 64, kv);
    }
#pragma unroll
    for (int ks = 0; ks < 2; ++ks) {
      bf16x8 af[2], bq[2];
#pragma unroll
      for (int i = 0; i < 2; ++i) af[i] = *(const bf16x8*)&s->a[buf][wr * 64 + i * 32 + fr][ks * 16 + fh * 8];
#pragma unroll
      for (int j = 0; j < 2; ++j) bq[j] = *(const bf16x8*)&s->b[buf][wc * 64 + j * 32 + fr][ks * 16 + fh * 8];
#pragma unroll
      for (int i = 0; i < 2; ++i)
#pragma unroll
        for (int j = 0; j < 2; ++j) acc[i][j] = MFMA(af[i], bq[j], acc[i][j]);
    }
    if (kt + 1 < nk) {
      *(uint4*)&s->a[buf ^ 1][r0][kv * 8] = ra0; *(uint4*)&s->a[buf ^ 1][r0 + 64][kv * 8] = ra1;
      *(uint4*)&s->b[buf ^ 1][r0][kv * 8] = rb0; *(uint4*)&s->b[buf ^ 1][r0 + 64][kv * 8] = rb1;
    }
    __syncthreads();
  }
}


struct GemmS2 { bf16_t a[128][72]; bf16_t b[128][72]; };
DI void g2_compute(f32x16 (&acc)[2][2], const GemmS2* s, int wr, int wc, int fr, int fh) {
#pragma unroll
  for (int ks = 0; ks < 4; ++ks) {
    bf16x8 af[2], bq[2];
#pragma unroll
    for (int i = 0; i < 2; ++i) af[i] = *(const bf16x8*)&s->a[wr * 64 + i * 32 + fr][ks * 16 + fh * 8];
#pragma unroll
    for (int j = 0; j < 2; ++j) bq[j] = *(const bf16x8*)&s->b[wc * 64 + j * 32 + fr][ks * 16 + fh * 8];
#pragma unroll
    for (int i = 0; i < 2; ++i)
#pragma unroll
      for (int j = 0; j < 2; ++j) acc[i][j] = MFMA(af[i], bq[j], acc[i][j]);
  }
}

template <class AF, class BF, class HK>
DI void gemm_core2(f32x16 (&acc)[2][2], GemmS2* s, AF aptr, BF bptr, int nk, HK hook) {
  int tid = threadIdx.x; asm volatile("" : "+v"(tid));
  const int lane = tid & 63, wave = tid >> 6, wr = wave >> 1, wc = wave & 1;
  const int r0 = tid >> 3, kc = tid & 7;
  const int fr = lane & 31, fh = lane >> 5;
  uint4 p0a0, p0a1, p0a2, p0a3, p0b0, p0b1, p0b2, p0b3, p1a0, p1a1, p1a2, p1a3, p1b0, p1b1, p1b2, p1b3;
#define G2_LOAD(S, KT) { \
    S##a0 = *(const uint4*)aptr((KT), r0, kc);      S##b0 = *(const uint4*)bptr((KT), r0, kc); \
    S##a1 = *(const uint4*)aptr((KT), r0 + 32, kc); S##b1 = *(const uint4*)bptr((KT), r0 + 32, kc); \
    S##a2 = *(const uint4*)aptr((KT), r0 + 64, kc); S##b2 = *(const uint4*)bptr((KT), r0 + 64, kc); \
    S##a3 = *(const uint4*)aptr((KT), r0 + 96, kc); S##b3 = *(const uint4*)bptr((KT), r0 + 96, kc); }
#define G2_STORE(S) { \
    *(uint4*)&s->a[r0][kc * 8] = S##a0;      *(uint4*)&s->b[r0][kc * 8] = S##b0; \
    *(uint4*)&s->a[r0 + 32][kc * 8] = S##a1; *(uint4*)&s->b[r0 + 32][kc * 8] = S##b1; \
    *(uint4*)&s->a[r0 + 64][kc * 8] = S##a2; *(uint4*)&s->b[r0 + 64][kc * 8] = S##b2; \
    *(uint4*)&s->a[r0 + 96][kc * 8] = S##a3; *(uint4*)&s->b[r0 + 96][kc * 8] = S##b3; }
#define G2_COMPUTE() g2_compute(acc, s, wr, wc, fr, fh);
  G2_LOAD(p0, 0)
  G2_LOAD(p1, 1)
  G2_STORE(p0)
  if (nk > 2) G2_LOAD(p0, 2)
  __syncthreads();
#pragma unroll 1
  for (int kt = 0; kt < nk; kt += 2) {
    hook(kt);
    G2_COMPUTE()
    __syncthreads();
    G2_STORE(p1)
    if (kt + 3 < nk) G2_LOAD(p1, kt + 3)
    __syncthreads();
    hook(kt + 1);
    G2_COMPUTE()
    __syncthreads();
    if (kt + 2 < nk) {
      G2_STORE(p0)
      if (kt + 4 < nk) G2_LOAD(p0, kt + 4)
    }
    __syncthreads();
  }
#undef G2_LOAD
#undef G2_STORE
#undef G2_COMPUTE
}


struct GemmS3 { bf16_t a[128][72]; bf16_t b[256][72]; };

template <class AF, class BF>
DI void gemm_core3(f32x16 (&acc)[2][4], GemmS3* s, AF aptr, BF bptr, int nk) {
  int tid = threadIdx.x; asm volatile("" : "+v"(tid));
  const int lane = tid & 63, wave = tid >> 6, wr = wave >> 1, wc = wave & 1;
  const int r0 = tid >> 3, kc = tid & 7;
  const int fr = lane & 31, fh = lane >> 5;
  uint4 a0, a1, a2, a3, b0, b1, b2, b3, b4, b5, b6, b7;
#define G3_LOAD(KT) { \
    a0 = *(const uint4*)aptr((KT), r0, kc);       a1 = *(const uint4*)aptr((KT), r0 + 32, kc); \
    a2 = *(const uint4*)aptr((KT), r0 + 64, kc);  a3 = *(const uint4*)aptr((KT), r0 + 96, kc); \
    b0 = *(const uint4*)bptr((KT), r0, kc);       b1 = *(const uint4*)bptr((KT), r0 + 32, kc); \
    b2 = *(const uint4*)bptr((KT), r0 + 64, kc);  b3 = *(const uint4*)bptr((KT), r0 + 96, kc); \
    b4 = *(const uint4*)bptr((KT), r0 + 128, kc); b5 = *(const uint4*)bptr((KT), r0 + 160, kc); \
    b6 = *(const uint4*)bptr((KT), r0 + 192, kc); b7 = *(const uint4*)bptr((KT), r0 + 224, kc); }
#define G3_STORE() { \
    *(uint4*)&s->a[r0][kc * 8] = a0;       *(uint4*)&s->a[r0 + 32][kc * 8] = a1; \
    *(uint4*)&s->a[r0 + 64][kc * 8] = a2;  *(uint4*)&s->a[r0 + 96][kc * 8] = a3; \
    *(uint4*)&s->b[r0][kc * 8] = b0;       *(uint4*)&s->b[r0 + 32][kc * 8] = b1; \
    *(uint4*)&s->b[r0 + 64][kc * 8] = b2;  *(uint4*)&s->b[r0 + 96][kc * 8] = b3; \
    *(uint4*)&s->b[r0 + 128][kc * 8] = b4; *(uint4*)&s->b[r0 + 160][kc * 8] = b5; \
    *(uint4*)&s->b[r0 + 192][kc * 8] = b6; *(uint4*)&s->b[r0 + 224][kc * 8] = b7; }
  G3_LOAD(0)
  G3_STORE()
  __syncthreads();
#pragma unroll 1
  for (int kt = 0; kt < nk; ++kt) {
    if (kt + 1 < nk) G3_LOAD(kt + 1)
#pragma unroll
    for (int ks = 0; ks < 4; ++ks) {
      bf16x8 af[2], bq[4];
#pragma unroll
      for (int i = 0; i < 2; ++i) af[i] = *(const bf16x8*)&s->a[wr * 64 + i * 32 + fr][ks * 16 + fh * 8];
#pragma unroll
      for (int j = 0; j < 4; ++j) bq[j] = *(const bf16x8*)&s->b[wc * 128 + j * 32 + fr][ks * 16 + fh * 8];
#pragma unroll
      for (int i = 0; i < 2; ++i)
#pragma unroll
        for (int j = 0; j < 4; ++j) acc[i][j] = MFMA(af[i], bq[j], acc[i][j]);
    }
    __syncthreads();
    if (kt + 1 < nk) G3_STORE()
    __syncthreads();
  }
#undef G3_LOAD
#undef G3_STORE
}

template <class EPI>
DI void epilogue_lds2(f32x16 (&acc)[2][4], char* smem, int sub, EPI epi) {
  float* T = (float*)smem;
  int tid = threadIdx.x; asm volatile("" : "+v"(tid));
  const int lane = tid & 63, wave = tid >> 6, wr = wave >> 1, wc = wave & 1, fr = lane & 31, fh = lane >> 5;
#pragma unroll
  for (int i = 0; i < 2; ++i) {
    if (wc == sub) {
#pragma unroll
      for (int j = 0; j < 4; ++j)
#pragma unroll
        for (int r = 0; r < 16; ++r) T[(wr * 32 + crow(r, fh)) * 132 + j * 32 + fr] = acc[i][j][r];
    }
    __syncthreads();
#pragma unroll 2
    for (int e = tid; e < 2048; e += 256) {
      const int tr = e >> 5, c4 = (e & 31) * 4;
      const float4 v = *(const float4*)&T[tr * 132 + c4];
      epi((tr >> 5) * 64 + i * 32 + (tr & 31), c4, v);
    }
    __syncthreads();
  }
}

DI bool xcd_tile(int step, int nM, int nN, int& mt, int& nt) {
  const int xcd = blockIdx.x & 7, nloc = gridDim.x >> 3;
  const int j = (blockIdx.x >> 3) + step * nloc;
  const int mloc = nM >> 3;
  if ((gridDim.x & 7) != 0 || j >= mloc * nN) return false;
  const int per = 8 * nN;
  const int gm = j / per, rem = j - gm * per;
  const int hgt = min(8, mloc - gm * 8);
  const int a = rem % hgt;
  nt = rem / hgt;
  mt = (gm * 8 + a) * 8 + xcd;
  return true;
}

DI void zero_acc(f32x16 (&acc)[2][2]) {
#pragma unroll
  for (int i = 0; i < 2; ++i)
#pragma unroll
    for (int j = 0; j < 2; ++j)
#pragma unroll
      for (int r = 0; r < 16; ++r) acc[i][j][r] = 0.f;
}

template <class EPI>
DI void epilogue_lds(f32x16 (&acc)[2][2], char* smem, EPI epi) {
  float* T = (float*)smem;
  int tid = threadIdx.x; asm volatile("" : "+v"(tid)); const int lane = tid & 63, wave = tid >> 6, wr = wave >> 1, wc = wave & 1, fr = lane & 31, fh = lane >> 5;
#pragma unroll
  for (int i = 0; i < 2; ++i) {
#pragma unroll
    for (int j = 0; j < 2; ++j)
#pragma unroll
      for (int r = 0; r < 16; ++r) T[(wr * 32 + crow(r, fh)) * 132 + wc * 64 + j * 32 + fr] = acc[i][j][r];
    __syncthreads();
#pragma unroll 2
    for (int e = tid; e < 2048; e += 256) {
      const int tr = e >> 5, c4 = (e & 31) * 4;
      const float4 v = *(const float4*)&T[tr * 132 + c4];
      epi((tr >> 5) * 64 + i * 32 + (tr & 31), c4, v);
    }
    __syncthreads();
  }
}

DI void phase_mods(const Params& p_in, char* smem) {
  const Params p = load_params();

  float* ssc = (float*)smem;
  float* red = (float*)(smem + 20480);
  float* mods = (float*)(p.ws + OFF_MODS);
  int tid = threadIdx.x; asm volatile("" : "+v"(tid));
  if (blockIdx.x == 0) { unsigned* bar = (unsigned*)(p.ws + OFF_BAR); for (int i = tid; i < XCD_BAR_WORDS; i += 256) bar[i] = 0u; }
  for (int it = blockIdx.x; it < 96; it += gridDim.x) {
    const int l = it / 48, col0 = (it % 48) * 64;
    __syncthreads();
    for (int e = tid; e < 5120; e += 256) {
      const int v = e >> 10, k = e & 1023;
      const float cv = (v < 4) ? p.c[v * 1024 + k] : p.c_ctx[k];
      ssc[e] = silu_f(cv);
    }
    __syncthreads();
    const int col = tid & 63, kg = tid >> 6;
    float a[5] = {0.f, 0.f, 0.f, 0.f, 0.f};
    const float* w = p.w_mod + (size_t)l * 1024 * 3072 + col0 + col;
    for (int k = kg * 256; k < kg * 256 + 256; k += 8) {
      float wv[8];
#pragma unroll
      for (int u = 0; u < 8; ++u) wv[u] = w[(size_t)(k + u) * 3072];
#pragma unroll
      for (int u = 0; u < 8; ++u)
#pragma unroll
        for (int v = 0; v < 5; ++v) a[v] += ssc[v * 1024 + k + u] * wv[u];
    }
#pragma unroll
    for (int v = 0; v < 5; ++v) red[(kg * 5 + v) * 64 + col] = a[v];
    __syncthreads();
    for (int e = tid; e < 320; e += 256) {
      const int v = e >> 6, cc = e & 63;
      float sum = p.b_mod[l * 3072 + col0 + cc];
      for (int g = 0; g < 4; ++g) sum += red[(g * 5 + v) * 64 + cc];
      mods[(l * 5 + v) * 3072 + col0 + cc] = sum;
    }
  }
}

DI int win_colmap(int n) {
  if (n < 2560) return n;
  if (n < 3840) return n + 32;
  if (n < 4864) {
    const int j = n - 3840, q64 = j >> 6, w = j & 63;
    return (w < 32) ? (3872 + q64 * 32 + w) : (3872 + 512 + q64 * 32 + (w - 32));
  }
  if (n < 5376) return n + 32;
  if (n < 5408) return n - 5376 + 2560;
  return -1;
}

DI void transpose_tile(const float* src, int ldsrc, int kind, const float* rowscale, bf16_t* dst, int lddst, int n0, int k0, float* tile) {
  int tid = threadIdx.x; asm volatile("" : "+v"(tid));
  __syncthreads();
  {
    const int c4 = (tid & 15) * 4, rr = tid >> 4;
    const int n = (kind == 0) ? win_colmap(n0 + c4) : (n0 + c4);
#pragma unroll
    for (int ps = 0; ps < 4; ++ps) {
      const int r = rr + ps * 16, k = k0 + r;
      float4 v = make_float4(0.f, 0.f, 0.f, 0.f);
      if (n >= 0) v = *(const float4*)(src + (size_t)k * ldsrc + n);
      if (rowscale != nullptr && k < 1024) { const float s = rowscale[k]; v.x *= s; v.y *= s; v.z *= s; v.w *= s; }
      tile[r * 65 + c4] = v.x; tile[r * 65 + c4 + 1] = v.y; tile[r * 65 + c4 + 2] = v.z; tile[r * 65 + c4 + 3] = v.w;
    }
  }
  __syncthreads();
  {
    const int k8 = (tid & 7) * 8, nn = tid >> 3;
#pragma unroll
    for (int ps = 0; ps < 2; ++ps) {
      const int r = nn + ps * 32;
      uint4 o;
      o.x = pack2(tile[(k8 + 0) * 65 + r], tile[(k8 + 1) * 65 + r]);
      o.y = pack2(tile[(k8 + 2) * 65 + r], tile[(k8 + 3) * 65 + r]);
      o.z = pack2(tile[(k8 + 4) * 65 + r], tile[(k8 + 5) * 65 + r]);
      o.w = pack2(tile[(k8 + 6) * 65 + r], tile[(k8 + 7) * 65 + r]);
      *(uint4*)(dst + (size_t)(n0 + r) * lddst + k0 + k8) = o;
    }
  }
}

DI void phase_prep(const Params& p_in, int l, char* smem) {
  const Params p = load_params();

  int tid = threadIdx.x; asm volatile("" : "+v"(tid)); const int lane = tid & 63, wave = tid >> 6;
  const float* mods = (const float*)(p.ws + OFF_MODS);
  bf16_t* H = (bf16_t*)(p.ws + OFF_H);
  const int NT_WIN = 88 * 16, NT_WOUT = 16 * 32, NT_PW = 64, NT_CONV = NT_WIN + NT_WOUT + NT_PW;
  const int NT = NT_CONV + R_ / 4;
  for (int it = blockIdx.x; it < NT; it += gridDim.x) {
    if (l == 1 && (it < NT_WIN || (it >= NT_WIN + NT_WOUT && it < NT_CONV))) continue;
    if (it < NT_WIN) {
      transpose_tile(p.w_in + (size_t)l * 1024 * 5408, 5408, 0, nullptr, (bf16_t*)(p.ws + OFF_WIN), 1024, (it / 16) * 64, (it % 16) * 64, (float*)smem);
    } else if (it < NT_WIN + NT_WOUT) {
      const int t = it - NT_WIN;
      transpose_tile(p.w_out + (size_t)l * 2048 * 1024, 1024, 1, p.ssd_norm_w + l * 1024, (bf16_t*)(p.ws + OFF_WOUT), 2048, (t / 32) * 64, (t % 32) * 64, (float*)smem);
    } else if (it < NT_CONV) {
      const int t = it - NT_WIN - NT_WOUT;
      transpose_tile(p.conv_pw_w + (size_t)l * 512 * 512, 512, 1, nullptr, (bf16_t*)(p.ws + OFF_PW), 512, (t / 8) * 64, (t % 8) * 64, (float*)smem);
    } else {
      const int rho = (it - NT_CONV) * 4 + wave;
      const float* xs;
      if (l == 0) xs = (rho < RL_) ? (p.x + (size_t)rho * 1024) : (p.ctx + (size_t)(rho - RL_) * 1024);
      else xs = (rho < RL_) ? (p.out + (size_t)rho * 1024) : ((const float*)(p.ws + OFF_XC) + (size_t)(rho - RL_) * 1024);
      const int v = (rho < RL_) ? (rho >> 12) : 4;
      const float* md = mods + (l * 5 + v) * 3072;
      float4 xv[4], nwv[4], shv[4], scv4[4];
      float ss = 0.f;
#pragma unroll
      for (int i = 0; i < 4; ++i) {
        const int cidx = lane * 4 + i * 256;
        xv[i] = *(const float4*)(xs + cidx);
        nwv[i] = *(const float4*)(p.norm_w + l * 1024 + cidx);
        shv[i] = *(const float4*)(md + cidx);
        scv4[i] = *(const float4*)(md + 1024 + cidx);
      }
#pragma unroll
      for (int i = 0; i < 4; ++i) ss += xv[i].x * xv[i].x + xv[i].y * xv[i].y + xv[i].z * xv[i].z + xv[i].w * xv[i].w;
#pragma unroll
      for (int o = 32; o >= 1; o >>= 1) ss += __shfl_xor(ss, o);
      const float rs = rsqrtf(ss * (1.f / 1024.f) + 1e-6f);
#pragma unroll
      for (int i = 0; i < 4; ++i) {
        const int cidx = lane * 4 + i * 256;
        const float4 nw = nwv[i], sh = shv[i], sc = scv4[i];
        uint2 o;
        o.x = pack2(xv[i].x * rs * nw.x * (1.f + sc.x) + sh.x, xv[i].y * rs * nw.y * (1.f + sc.y) + sh.y);
        o.y = pack2(xv[i].z * rs * nw.z * (1.f + sc.z) + sh.z, xv[i].w * rs * nw.w * (1.f + sc.w) + sh.w);
        *(uint2*)(H + (size_t)rho * 1024 + cidx) = o;
      }
    }
  }
}

DI void phase_inproj(const Params& p_in, char* smem) {
  const Params p = load_params();
  int tid = threadIdx.x; asm volatile("" : "+v"(tid)); const int wave = tid >> 6, wc = wave & 1;
  const bf16_t* H = (const bf16_t*)(p.ws + OFF_H);
  const bf16_t* W = (const bf16_t*)(p.ws + OFF_WIN);
  for (int step = 0;; ++step) {
    int mt, nt2;
    if (!xcd_tile(step, NCK, 22, mt, nt2)) break;
    f32x16 acc[2][4];
#pragma unroll
    for (int i = 0; i < 2; ++i)
#pragma unroll
      for (int j = 0; j < 4; ++j)
#pragma unroll
        for (int r = 0; r < 16; ++r) acc[i][j][r] = 0.f;
    const bf16_t* Ab = H + (size_t)mt * 128 * 1024;
    const bf16_t* Bb = W + (size_t)nt2 * 256 * 1024;
    gemm_core3(acc, (GemmS3*)smem,
               [&](int kt, int r, int kv) { return Ab + (size_t)r * 1024 + kt * 64 + kv * 8; },
               [&](int kt, int r, int kv) { return Bb + (size_t)r * 1024 + kt * 64 + kv * 8; }, 16);
    const int row0 = mt * 128;
    {
      const int ntw = nt2 * 2 + wc;
      if (ntw >= 30 && ntw < 38) {
#pragma unroll
        for (int i = 0; i < 2; ++i)
#pragma unroll
          for (int r = 0; r < 16; ++r) {
            acc[i][0][r] = acc[i][0][r] * sigmoid_f(acc[i][1][r]);
            acc[i][2][r] = acc[i][2][r] * sigmoid_f(acc[i][3][r]);
          }
      }
    }
#pragma unroll 1
    for (int sub = 0; sub < 2; ++sub) {
      const int nt = nt2 * 2 + sub;
      if (nt >= 43) break;
      if (nt >= 30 && nt < 38) {
        bf16_t* G = (bf16_t*)(p.ws + OFF_GLU);
        const int cb0 = (nt - 30) * 64;
        epilogue_lds2(acc, smem, sub, [&](int rl, int c4, float4 v) {
          if ((c4 & 32) == 0) {
            uint2 o; o.x = pack2(v.x, v.y); o.y = pack2(v.z, v.w);
            *(uint2*)(G + (size_t)(row0 + rl) * 512 + cb0 + (c4 >> 6) * 32 + (c4 & 31)) = o;
          }
        });
      } else if (nt == 42) {
        float* DT = (float*)(p.ws + OFF_DT);
        epilogue_lds2(acc, smem, sub, [&](int rl, int c4, float4 v) {
          if (c4 < 32) *(float4*)(DT + (size_t)(row0 + rl) * 32 + c4) = v;
        });
      } else {
        bf16_t* dst; int ld, cb;
        if (nt < 12) { dst = (bf16_t*)(p.ws + OFF_XBC); ld = 1536; cb = nt * 128; }
        else if (nt < 20) { dst = (bf16_t*)(p.ws + OFF_Z); ld = 1024; cb = nt * 128 - 1536; }
        else if (nt < 24) { dst = (bf16_t*)(p.ws + OFF_Q); ld = 512; cb = nt * 128 - 2560; }
        else if (nt < 26) { dst = (bf16_t*)(p.ws + OFF_KV); ld = 256; cb = nt * 128 - 3072; }
        else if (nt < 30) { dst = (bf16_t*)(p.ws + OFF_AG); ld = 512; cb = nt * 128 - 3328; }
        else { dst = (bf16_t*)(p.ws + OFF_CG); ld = 512; cb = nt * 128 - 4864; }
        epilogue_lds2(acc, smem, sub, [&](int rl, int c4, float4 v) {
          uint2 o; o.x = pack2(v.x, v.y); o.y = pack2(v.z, v.w);
          *(uint2*)(dst + (size_t)(row0 + rl) * ld + cb + c4) = o;
        });
      }
    }
  }
}

DI void phase_local(const Params& p_in, int l, char* smem) {
  const Params p = load_params();

  int tid = threadIdx.x; asm volatile("" : "+v"(tid)); const int lane = tid & 63;
  const bf16_t* XBC = (const bf16_t*)(p.ws + OFF_XBC);
  bf16_t* XS = (bf16_t*)(p.ws + OFF_H);
  bf16_t* BC = (bf16_t*)(p.ws + OFF_BC);
  float* DT = (float*)(p.ws + OFF_DT);
  float* CS = (float*)(p.ws + OFF_CS);
  const bf16_t* GLU = (const bf16_t*)(p.ws + OFF_GLU);
  bf16_t* HDN = (bf16_t*)(p.ws + OFF_HDN);
  bf16_t* Q = (bf16_t*)(p.ws + OFF_Q);
  bf16_t* KV = (bf16_t*)(p.ws + OFF_KV);
  { float* SSQ = (float*)(p.ws + OFF_RSTD); for (int i = blockIdx.x * 256 + tid; i < R_ * 2; i += gridDim.x * 256) SSQ[i] = 0.f; }
  const int N_CONV = (R_ / 4) * 192 / 256;
  const int N_DT = NCK;
  const int N_CF = R_ / 16;
  const int N_ROPE = RL_ * 40 / 256;
  const int N_QC = 1024 * 256 / 256;
  const int NT = N_CF + N_DT + N_CONV + N_ROPE + N_QC;
  for (int it0 = blockIdx.x; it0 < NT; it0 += gridDim.x) {
    int it = it0;
    if (it < N_CF) {
      float* sst = (float*)smem;
      unsigned* sIn = (unsigned*)(smem + 256);
      const int row0 = it * 16;
      const int seq0 = (row0 < RL_) ? (row0 & ~4095) : (RL_ + ((row0 - RL_) & ~255));
      const int slen = (row0 < RL_) ? 4096 : 256;
      const int t0 = row0 - seq0;
      const int c0 = tid * 2;
      __syncthreads();
      if (tid < 32) sst[tid] = 0.f;
      for (int idx = tid; idx < 46 * 64; idx += 256) {
        const int rr = idx >> 6, c16 = idx & 63;
        const int tt = t0 - 15 + rr;
        uint4 val = make_uint4(0u, 0u, 0u, 0u);
        if (tt >= 0 && tt < slen) val = *(const uint4*)(GLU + (size_t)(seq0 + tt) * 512 + c16 * 8);
        *(uint4*)&sIn[rr * 256 + c16 * 4] = val;
      }
      float w0[31], w1[31];
#pragma unroll
      for (int k = 0; k < 31; ++k) {
        const float2 wv = *(const float2*)(p.conv_dw_w + ((size_t)l * 31 + k) * 512 + c0);
        w0[k] = wv.x; w1[k] = wv.y;
      }
      const float2 bv = *(const float2*)(p.conv_dw_b + l * 512 + c0);
      float a0[16], a1[16];
#pragma unroll
      for (int r = 0; r < 16; ++r) { a0[r] = bv.x; a1[r] = bv.y; }
      __syncthreads();
#pragma unroll
      for (int tp = 0; tp < 46; ++tp) {
        const unsigned u = sIn[tp * 256 + tid];
        const float x0 = lo2f(u), x1 = hi2f(u);
#pragma unroll
        for (int r = 0; r < 16; ++r) {
          const int k = tp - r;
          if (k >= 0 && k < 31) { a0[r] += w0[k] * x0; a1[r] += w1[k] * x1; }
        }
        if ((tp & 7) == 7) __builtin_amdgcn_sched_barrier(0);
      }
      {
        float v[32];
#pragma unroll
        for (int r = 0; r < 16; ++r) { v[2 * r] = a0[r] + a1[r]; v[2 * r + 1] = a0[r] * a0[r] + a1[r] * a1[r]; }
#pragma unroll
        for (int i = 0; i < 16; ++i) { const bool up = (lane & 32) != 0; const float keep = up ? v[i + 16] : v[i]; const float send = up ? v[i] : v[i + 16]; v[i] = keep + __shfl_xor(send, 32); }
#pragma unroll
        for (int i = 0; i < 8; ++i) { const bool up = (lane & 16) != 0; const float keep = up ? v[i + 8] : v[i]; const float send = up ? v[i] : v[i + 8]; v[i] = keep + __shfl_xor(send, 16); }
#pragma unroll
        for (int i = 0; i < 4; ++i) { const bool up = (lane & 8) != 0; const float keep = up ? v[i + 4] : v[i]; const float send = up ? v[i] : v[i + 4]; v[i] = keep + __shfl_xor(send, 8); }
#pragma unroll
        for (int i = 0; i < 2; ++i) { const bool up = (lane & 4) != 0; const float keep = up ? v[i + 2] : v[i]; const float send = up ? v[i] : v[i + 2]; v[i] = keep + __shfl_xor(send, 4); }
        { const bool up = (lane & 2) != 0; const float keep = up ? v[1] : v[0]; const float send = up ? v[0] : v[1]; v[0] = keep + __shfl_xor(send, 2); }
        v[0] += __shfl_xor(v[0], 1);
        __syncthreads();
        if ((lane & 1) == 0) atomicAdd(&sst[lane >> 1], v[0]);
      }
      __syncthreads();
      const float2 lw = *(const float2*)(p.conv_ln_w + l * 512 + c0);
      const float2 lb = *(const float2*)(p.conv_ln_b + l * 512 + c0);
#pragma unroll
      for (int r = 0; r < 16; ++r) {
        const float mean = sst[r * 2] * (1.f / 512.f);
        const float var = fmaxf(sst[r * 2 + 1] * (1.f / 512.f) - mean * mean, 0.f);
        const float rs = rsqrtf(var + 1e-6f);
        const float y0 = (a0[r] - mean) * rs * lw.x + lb.x;
        const float y1 = (a1[r] - mean) * rs * lw.y + lb.y;
        *(unsigned*)(HDN + (size_t)(row0 + r) * 512 + c0) = pack2(silu_f(y0), silu_f(y1));
        if ((r & 3) == 3) __builtin_amdgcn_sched_barrier(0);
      }
      continue;
    }
    it -= N_CF;
    if (it < N_DT) {
      float* sdt = (float*)smem;
      const int row0 = it * 128;
      __syncthreads();
      for (int e = tid; e < 4096; e += 256) {
        const int r = e >> 5, cidx = e & 31;
        const float raw = DT[(size_t)(row0 + r) * 32 + cidx] + p.ssd_dt_bias[l * 32 + cidx];
        const float sp = (raw > 20.f) ? raw : log1pf(expf(raw));
        DT[(size_t)(row0 + r) * 32 + cidx] = sp;
        sdt[r * 33 + cidx] = sp;
      }
      __syncthreads();
      if (tid < 32) {
        const float a = -expf(p.ssd_a_log[l * 32 + tid]);
        float run = 0.f;
        if (tid < 16) {
          for (int r = 0; r < 128; ++r) { run += sdt[r * 33 + tid] * a; CS[(size_t)(row0 + r) * 32 + tid] = run; }
        } else {
          for (int r = 127; r >= 0; --r) { run += sdt[r * 33 + tid] * a; CS[(size_t)(row0 + r) * 32 + tid] = run; }
        }
      }
      continue;
    }
    it -= N_DT;
    if (it < N_CONV) {
      const int e = it * 256 + tid;
      const int rb = e / 192, cgp = e % 192, ch0 = cgp * 8;
      const int rho0 = rb * 4;
      const int seq0 = (rho0 < RL_) ? (rho0 & ~4095) : (RL_ + ((rho0 - RL_) & ~255));
      const int slen = (rho0 < RL_) ? 4096 : 256;
      const int t0 = rho0 - seq0;
      uint4 xr[8];
#pragma unroll
      for (int i = 0; i < 8; ++i) {
        const int tt = t0 + i - 2;
        xr[i] = make_uint4(0u, 0u, 0u, 0u);
        if (tt >= 0 && tt < slen) xr[i] = *(const uint4*)(XBC + (size_t)(seq0 + tt) * 1536 + ch0);
      }
      float wk[5][8];
#pragma unroll
      for (int k = 0; k < 5; ++k) {
        const float4 w0 = *(const float4*)(p.ssd_conv_w + ((size_t)l * 5 + k) * 1536 + ch0);
        const float4 w1 = *(const float4*)(p.ssd_conv_w + ((size_t)l * 5 + k) * 1536 + ch0 + 4);
        wk[k][0] = w0.x; wk[k][1] = w0.y; wk[k][2] = w0.z; wk[k][3] = w0.w; wk[k][4] = w1.x; wk[k][5] = w1.y; wk[k][6] = w1.z; wk[k][7] = w1.w;
      }
      float bias[8];
      {
        const float4 b0 = *(const float4*)(p.ssd_conv_b + l * 1536 + ch0);
        const float4 b1 = *(const float4*)(p.ssd_conv_b + l * 1536 + ch0 + 4);
        bias[0] = b0.x; bias[1] = b0.y; bias[2] = b0.z; bias[3] = b0.w; bias[4] = b1.x; bias[5] = b1.y; bias[6] = b1.z; bias[7] = b1.w;
      }
#pragma unroll
      for (int r = 0; r < 4; ++r) {
        float a[8];
#pragma unroll
        for (int c = 0; c < 8; ++c) a[c] = bias[c];
#pragma unroll
        for (int k = 0; k < 5; ++k) {
          const uint4 u = xr[r + k];
          a[0] += wk[k][0] * lo2f(u.x); a[1] += wk[k][1] * hi2f(u.x); a[2] += wk[k][2] * lo2f(u.y); a[3] += wk[k][3] * hi2f(u.y);
          a[4] += wk[k][4] * lo2f(u.z); a[5] += wk[k][5] * hi2f(u.z); a[6] += wk[k][6] * lo2f(u.w); a[7] += wk[k][7] * hi2f(u.w);
        }
        uint4 o;
        o.x = pack2(silu_f(a[0]), silu_f(a[1])); o.y = pack2(silu_f(a[2]), silu_f(a[3]));
        o.z = pack2(silu_f(a[4]), silu_f(a[5])); o.w = pack2(silu_f(a[6]), silu_f(a[7]));
        const size_t rho = (size_t)(rho0 + r);
        if (ch0 < 1024) *(uint4*)(XS + rho * 1024 + ch0) = o;
        else *(uint4*)(BC + rho * 512 + (ch0 - 1024)) = o;
      }
      continue;
    }
    it -= N_CONV;
    if (it < N_ROPE) {
      const int e = it * 256 + tid;
      const int rho = e / 40, rem = e % 40, hd = rem >> 2, sub = rem & 3;
      const int axis = sub >> 1, half = sub & 1;
      const int t = rho & 4095;
      const float pos = (float)(axis == 0 ? (t >> 6) : (t & 63));
      bf16_t* base = ((hd < 8) ? (Q + (size_t)rho * 512 + hd * 64) : (KV + (size_t)rho * 256 + (hd - 8) * 64)) + axis * 32 + half * 8;
      const float sc = (hd < 8) ? 0.18033688011112042f : 1.f;
      const uint4 u1 = *(const uint4*)base, u2 = *(const uint4*)(base + 16);
      const unsigned a1[4] = {u1.x, u1.y, u1.z, u1.w}, a2[4] = {u2.x, u2.y, u2.z, u2.w};
      unsigned o1[4], o2[4];
#pragma unroll
      for (int i = 0; i < 4; ++i) {
        float r1[2], r2[2];
#pragma unroll
        for (int hl = 0; hl < 2; ++hl) {
          const float f = (float)(half * 8 + 2 * i + hl);
          const float ang = pos * exp2f(-f * 0.8304820237218406f);
          const float cs = __cosf(ang), sn = __sinf(ang);
          const float t1 = hl ? hi2f(a1[i]) : lo2f(a1[i]);
          const float t2 = hl ? hi2f(a2[i]) : lo2f(a2[i]);
          r1[hl] = (t1 * cs - t2 * sn) * sc;
          r2[hl] = (t2 * cs + t1 * sn) * sc;
        }
        o1[i] = pack2(r1[0], r1[1]); o2[i] = pack2(r2[0], r2[1]);
      }
      *(uint4*)base = make_uint4(o1[0], o1[1], o1[2], o1[3]);
      *(uint4*)(base + 16) = make_uint4(o2[0], o2[1], o2[2], o2[3]);
      continue;
    }
    it -= N_ROPE;
    {
      const int e = it * 256 + tid;
      const int rho = RL_ + e / 256, c2 = (e % 256) * 2;
      unsigned* ptr = (unsigned*)(Q + (size_t)rho * 512 + c2);
      const unsigned u = *ptr;
      *ptr = pack2(lo2f(u) * 0.18033688011112042f, hi2f(u) * 0.18033688011112042f);
    }
  }
}

DI void attn_item(const Params& p_in, int l, char* smem, int b, int qblk, int g, int hp, bool ctxq) {
  const Params p = load_params();

  bf16_t* sK = (bf16_t*)smem;
  bf16_t* sV = (bf16_t*)(smem + 128 * 72 * 2);
  int tid = threadIdx.x; asm volatile("" : "+v"(tid)); const int lane = tid & 63, wave = tid >> 6, fr = lane & 31, fh = lane >> 5;
  const int head = g * 4 + hp * 2 + (wave >> 1);
  const int qh = wave & 1;
  const int qrow0 = (ctxq ? (RL_ + b * 256) : (b * 4096)) + qblk * 128 + qh * 64;
  const int qpos0 = qblk * 128 + qh * 64;
  bf16_t* Q = (bf16_t*)(p.ws + OFF_Q);
  const bf16_t* KV = (const bf16_t*)(p.ws + OFF_KV);
  const bf16_t* AG = (const bf16_t*)(p.ws + OFF_AG);
  f32x16 o[2][2];
  zero_acc(o);
  float m[2], lsum[2];
  m[0] = m[1] = p.attn_sink[l * 8 + head] * 1.4426950408889634f;
  lsum[0] = lsum[1] = 1.f;
  const int nhb = ctxq ? 4 : 10;
  auto hb_row = [&](int hb) -> int {
    if (hb >= nhb) return -1;
    if (hb < 4) return RL_ + b * 256 + hb * 64;
    const int kp = (qblk - 1) * 128 + (hb - 4) * 64;
    if (kp < 0 || kp >= 4096) return -1;
    return b * 4096 + kp;
  };
  auto hb_next = [&](int hb) -> int { int n = hb + 1; while (n < nhb && hb_row(n) < 0) ++n; return n; };
  const int sr = tid >> 3, scv = tid & 7;
  uint4 kp0, kp1, vp0, vp1;
#define ATT_PREFETCH(ROW0) { const bf16_t* kvp = KV + (size_t)((ROW0) + sr) * 256 + g * 64 + scv * 8; \
    kp0 = *(const uint4*)(kvp); kp1 = *(const uint4*)(kvp + 32 * 256); vp0 = *(const uint4*)(kvp + 128); vp1 = *(const uint4*)(kvp + 128 + 32 * 256); }
#define ATT_STORE(BUF) { bf16_t* k_ = sK + (BUF) * 64 * 72; bf16_t* v_ = sV + (BUF) * 64 * 72; \
    *(uint4*)&k_[sr * 72 + scv * 8] = kp0; *(uint4*)&k_[(sr + 32) * 72 + scv * 8] = kp1; \
    *(uint4*)&v_[sr * 72 + scv * 8] = vp0; *(uint4*)&v_[(sr + 32) * 72 + scv * 8] = vp1; }
  int pbuf = 0;
  __syncthreads();
  ATT_PREFETCH(hb_row(0))
  ATT_STORE(0)
  __syncthreads();
  for (int hb = 0; hb < nhb; hb = hb_next(hb)) {
    const int nxt = hb_next(hb);
    if (nxt < nhb) ATT_PREFETCH(hb_row(nxt))
    int kpos0 = 0;
    bool masked = false;
    if (hb >= 4) { kpos0 = (qblk - 1) * 128 + (hb - 4) * 64; masked = (hb != 6 && hb != 7); }
    const bf16_t* cK = sK + pbuf * 64 * 72;
    const bf16_t* cV = sV + pbuf * 64 * 72;
    bf16x8 qf[2][4];
#pragma unroll
    for (int j = 0; j < 2; ++j)
#pragma unroll
      for (int ks = 0; ks < 4; ++ks)
        qf[j][ks] = *(const bf16x8*)(Q + (size_t)(qrow0 + j * 32 + fr) * 512 + head * 64 + ks * 16 + fh * 8);
#pragma unroll 1
    for (int kb = 0; kb < 2; ++kb) {
      if (masked) {
        const int klo = kpos0 + kb * 32, khi = klo + 31;
        if (klo - (qpos0 + 63) > 128 || qpos0 - khi > 128) continue;
      }
      bf16x8 pb[2][2];
#pragma unroll
      for (int j = 0; j < 2; ++j) {
        f32x16 st[2];
#pragma unroll
        for (int r = 0; r < 16; ++r) st[j][r] = -m[j];
#pragma unroll
        for (int ks = 0; ks < 4; ++ks) {
          const bf16x8 kf = *(const bf16x8*)&cK[(kb * 32 + fr) * 72 + ks * 16 + fh * 8];
          st[j] = MFMA(kf, qf[j][ks], st[j]);
        }
        if (masked) {
          const int qpos = qpos0 + j * 32 + fr;
#pragma unroll
          for (int r = 0; r < 16; ++r) {
            const int d = qpos - (kpos0 + kb * 32 + crow(r, fh));
            if (d > 128 || d < -128) st[j][r] = -1e30f;
          }
        }
        float mx = st[j][0];
#pragma unroll
        for (int r = 1; r < 16; ++r) mx = fmaxf(mx, st[j][r]);
        mx = fmaxf(mx, __shfl_xor(mx, 32));
        const bool grow = mx > 8.f;
        if (__builtin_amdgcn_ballot_w64(grow) != 0ull) {
          const float delta = grow ? mx : 0.f;
          const float alpha = __builtin_amdgcn_exp2f(-delta);
#pragma unroll
          for (int r = 0; r < 16; ++r) st[j][r] -= delta;
          lsum[j] *= alpha;
          m[j] += delta;
#pragma unroll
          for (int mt = 0; mt < 2; ++mt)
#pragma unroll
            for (int r = 0; r < 16; ++r) o[mt][j][r] *= alpha;
        }
        float rs = 0.f;
#pragma unroll
        for (int r = 0; r < 16; ++r) { const float pv = __builtin_amdgcn_exp2f(st[j][r]); st[j][r] = pv; rs += pv; }
        rs += __shfl_xor(rs, 32);
        lsum[j] += rs;
#pragma unroll
        for (int s = 0; s < 2; ++s) {
          uint4 pk;
          pk.x = pack2(st[j][8 * s + 0], st[j][8 * s + 1]); pk.y = pack2(st[j][8 * s + 2], st[j][8 * s + 3]);
          pk.z = pack2(st[j][8 * s + 4], st[j][8 * s + 5]); pk.w = pack2(st[j][8 * s + 6], st[j][8 * s + 7]);
          pb[j][s] = __builtin_bit_cast(bf16x8, pk);
        }
      }
#pragma unroll
      for (int s = 0; s < 2; ++s)
#pragma unroll
        for (int mt = 0; mt < 2; ++mt) {
          const bf16x8 vf = tr_frag(cV, 72, kb * 32 + 16 * s + 4 * fh, kb * 32 + 16 * s + 8 + 4 * fh, mt * 32);
#pragma unroll
          for (int j = 0; j < 2; ++j) o[mt][j] = MFMA(vf, pb[j][s], o[mt][j]);
        }
    }
    if (nxt < nhb) ATT_STORE(pbuf ^ 1)
    pbuf ^= 1;
    __syncthreads();
  }
#undef ATT_PREFETCH
#undef ATT_STORE
#pragma unroll
  for (int j = 0; j < 2; ++j) {
    const float inv = 1.f / lsum[j];
    const size_t rho = (size_t)(qrow0 + j * 32 + fr);
#pragma unroll
    for (int mt = 0; mt < 2; ++mt)
#pragma unroll
      for (int g4 = 0; g4 < 4; ++g4) {
        const int d0 = mt * 32 + 8 * g4 + 4 * fh;
        const uint2 gv = *(const uint2*)(AG + rho * 512 + head * 64 + d0);
        uint2 ov;
        ov.x = pack2(o[mt][j][g4 * 4 + 0] * inv * silu_f(lo2f(gv.x)), o[mt][j][g4 * 4 + 1] * inv * silu_f(hi2f(gv.x)));
        ov.y = pack2(o[mt][j][g4 * 4 + 2] * inv * silu_f(lo2f(gv.y)), o[mt][j][g4 * 4 + 3] * inv * silu_f(hi2f(gv.y)));
        *(uint2*)(Q + rho * 512 + head * 64 + d0) = ov;
      }
  }
}

DI void states_item(const Params& p_in, char* smem, int ck, int g, int hq) {
  const Params p = load_params();

  bf16_t* sB = (bf16_t*)smem;
  bf16_t* sX = (bf16_t*)(smem + 128 * 136 * 2);
  int tid = threadIdx.x; asm volatile("" : "+v"(tid)); const int lane = tid & 63, wave = tid >> 6, wr = wave >> 1, wc = wave & 1, fr = lane & 31, fh = lane >> 5;
  const bf16_t* BC = (const bf16_t*)(p.ws + OFF_BC);
  const bf16_t* XS = (const bf16_t*)(p.ws + OFF_H);
  const float* DT = (const float*)(p.ws + OFF_DT);
  const float* CS = (const float*)(p.ws + OFF_CS);
  bf16_t* ST = (bf16_t*)(p.ws + OFF_ST);
  float* CDEC = (float*)(p.ws + OFF_CDEC);
  const int row0 = ck * 128;
  __syncthreads();
  for (int v = tid; v < 2048; v += 256) {
    const int r = v >> 4, cv = v & 15;
    *(uint4*)&sB[r * 136 + cv * 8] = *(const uint4*)(BC + (size_t)(row0 + r) * 512 + g * 128 + cv * 8);
  }
  __syncthreads();
  bf16x8 bfr[2][8];
#pragma unroll
  for (int j = 0; j < 2; ++j)
#pragma unroll
    for (int ks = 0; ks < 8; ++ks) bfr[j][ks] = tr_frag(sB, 136, ks * 16 + 8 * fh, ks * 16 + 8 * fh + 4, wc * 64 + j * 32);
  const int slr = tid >> 3, scv = tid & 7;
  uint4 xq0, xq1, xq2, xq3;
  float dq0, dq1, dq2, dq3, cq0, cq1, cq2, cq3, cendq;
#define ST_PREFETCH(HD) { const int head_ = g * 8 + hq * 4 + ((HD) >> 1), d_ = (HD) & 1, col_ = d_ * 16 + head_; \
    const bf16_t* xp_ = XS + (size_t)(row0 + slr) * 1024 + head_ * 64 + scv * 8; \
    xq0 = *(const uint4*)(xp_); xq1 = *(const uint4*)(xp_ + 32 * 1024); xq2 = *(const uint4*)(xp_ + 64 * 1024); xq3 = *(const uint4*)(xp_ + 96 * 1024); \
    const size_t rb_ = (size_t)(row0 + slr) * 32 + col_; \
    dq0 = DT[rb_]; dq1 = DT[rb_ + 32 * 32]; dq2 = DT[rb_ + 64 * 32]; dq3 = DT[rb_ + 96 * 32]; \
    cq0 = CS[rb_]; cq1 = CS[rb_ + 32 * 32]; cq2 = CS[rb_ + 64 * 32]; cq3 = CS[rb_ + 96 * 32]; \
    cendq = CS[(size_t)(row0 + (d_ == 0 ? 127 : 0)) * 32 + col_]; }
#define ST_SCALE_STORE(X, DTV, CSV, ROW) { const float sc_ = (DTV) * __expf(cend - (CSV)); uint4 o_; \
    o_.x = pack2(lo2f(X.x) * sc_, hi2f(X.x) * sc_); o_.y = pack2(lo2f(X.y) * sc_, hi2f(X.y) * sc_); \
    o_.z = pack2(lo2f(X.z) * sc_, hi2f(X.z) * sc_); o_.w = pack2(lo2f(X.w) * sc_, hi2f(X.w) * sc_); \
    *(uint4*)&sX[(ROW) * 72 + scv * 8] = o_; }
  ST_PREFETCH(0)
#pragma unroll 1
  for (int hd = 0; hd < 8; ++hd) {
    const int head = g * 8 + hq * 4 + (hd >> 1), d = hd & 1;
    const float cend = cendq;
    ST_SCALE_STORE(xq0, dq0, cq0, slr)
    ST_SCALE_STORE(xq1, dq1, cq1, slr + 32)
    ST_SCALE_STORE(xq2, dq2, cq2, slr + 64)
    ST_SCALE_STORE(xq3, dq3, cq3, slr + 96)
    if (hd < 7) ST_PREFETCH(hd + 1)
    __syncthreads();
    f32x16 acc[2];
#pragma unroll
    for (int j = 0; j < 2; ++j)
#pragma unroll
      for (int r = 0; r < 16; ++r) acc[j][r] = 0.f;
#pragma unroll
    for (int ks = 0; ks < 8; ++ks) {
      const bf16x8 af = tr_frag(sX, 72, ks * 16 + 8 * fh, ks * 16 + 8 * fh + 4, wr * 32);
#pragma unroll
      for (int j = 0; j < 2; ++j) acc[j] = MFMA(af, bfr[j][ks], acc[j]);
    }
    bf16_t* dst = ST + ((size_t)(ck * 2 + d) * 16 + head) * 8192;
#pragma unroll
    for (int j = 0; j < 2; ++j)
#pragma unroll
      for (int r = 0; r < 16; ++r) dst[(wr * 32 + crow(r, fh)) * 128 + wc * 64 + j * 32 + fr] = f2bf(acc[j][r]);
    if (tid == 0) CDEC[(ck * 2 + d) * 16 + head] = __expf(cend);
    __syncthreads();
  }
}

DI void pw_item(const Params& p_in, int l, char* smem, int mt, int nt) {
  const Params p = load_params();

  GemmS* s = (GemmS*)smem;
  int tid = threadIdx.x; asm volatile("" : "+v"(tid)); const int lane = tid & 63, wave = tid >> 6, wr = wave >> 1, wc = wave & 1, fr = lane & 31, fh = lane >> 5;
  const bf16_t* Ab = (const bf16_t*)(p.ws + OFF_HDN) + (size_t)mt * 128 * 512;
  const bf16_t* Bb = (const bf16_t*)(p.ws + OFF_PW) + (size_t)nt * 128 * 512;
  bf16_t* CG = (bf16_t*)(p.ws + OFF_CG);
  f32x16 acc[2][2];
  zero_acc(acc);
  gemm_core2(acc, (GemmS2*)smem,
             [&](int kt, int r, int kv) { return Ab + (size_t)r * 512 + kt * 64 + kv * 8; },
             [&](int kt, int r, int kv) { return Bb + (size_t)r * 512 + kt * 64 + kv * 8; }, 8, [](int) {});
  const float* pwb = p.conv_pw_b + l * 512 + nt * 128;
  epilogue_lds(acc, smem, [&](int rl, int c4, float4 v) {
    bf16_t* ptr = CG + (size_t)(mt * 128 + rl) * 512 + nt * 128 + c4;
    const uint2 gv = *(const uint2*)ptr;
    const float4 bb = *(const float4*)(pwb + c4);
    uint2 o;
    o.x = pack2((v.x + bb.x) * silu_f(lo2f(gv.x)), (v.y + bb.y) * silu_f(hi2f(gv.x)));
    o.y = pack2((v.z + bb.z) * silu_f(lo2f(gv.y)), (v.w + bb.w) * silu_f(hi2f(gv.y)));
    *(uint2*)ptr = o;
  });
}

DI void phase_mix(const Params& p, int l, char* smem) {
  const int G = gridDim.x;
  const int N_ATT = 512 + (l == 0 ? 32 : 0);
  for (int it = blockIdx.x; it < N_ATT; it += G) {
    if (it < 512) attn_item(p, l, smem, it >> 7, (it >> 2) & 31, (it >> 1) & 1, it & 1, false);
    else { const int t = it - 512; attn_item(p, l, smem, t >> 3, (t >> 2) & 1, (t >> 1) & 1, t & 1, true); }
  }
  for (int it = (blockIdx.x + G - 32) % G; it < NCK * 4; it += G) states_item(p, smem, it >> 2, (it >> 1) & 1, it & 1);
  for (int it = (blockIdx.x + G - 64) % G; it < NCK * 4; it += G) pw_item(p, l, smem, it >> 2, it & 3);
}

DI void phase_scan(const Params& p_in) {
  const Params p = load_params();

  bf16_t* ST = (bf16_t*)(p.ws + OFF_ST);
  const float* CDEC = (const float*)(p.ws + OFF_CDEC);
  for (int it = blockIdx.x; it < 512; it += gridDim.x) {
    const int e = it * 256 + threadIdx.x;
    const int bdh = e >> 10, v8 = e & 1023;
    const int b = bdh >> 5, d = (bdh >> 4) & 1, h = bdh & 15;
    float s[8];
#pragma unroll
    for (int i = 0; i < 8; ++i) s[i] = 0.f;
    auto ckof = [&](int i) {
      if (d == 0) return (i < 2) ? (128 + 2 * b + i) : (32 * b + (i - 2));
      return (i < 2) ? (128 + 2 * b + (1 - i)) : (32 * b + 31 - (i - 2));
    };
    auto pof = [&](int i) { const int ck = ckof(i); return (uint4*)(ST + ((size_t)(ck * 2 + d) * 16 + h) * 8192 + v8 * 8); };
    auto dof = [&](int i) { const int ck = ckof(i); return CDEC[(ck * 2 + d) * 16 + h]; };
    uint4 buf[4]; float dc[4];
#pragma unroll
    for (int i = 0; i < 3; ++i) { buf[i] = *pof(i); dc[i] = dof(i); }
#pragma unroll
    for (int i = 0; i < 34; ++i) {
      if (i + 3 < 34) { buf[(i + 3) & 3] = *pof(i + 3); dc[(i + 3) & 3] = dof(i + 3); }
      const uint4 cur = buf[i & 3];
      const float dec = dc[i & 3];
      uint4 o;
      o.x = pack2(s[0], s[1]); o.y = pack2(s[2], s[3]); o.z = pack2(s[4], s[5]); o.w = pack2(s[6], s[7]);
      *pof(i) = o;
      s[0] = s[0] * dec + lo2f(cur.x); s[1] = s[1] * dec + hi2f(cur.x);
      s[2] = s[2] * dec + lo2f(cur.y); s[3] = s[3] * dec + hi2f(cur.y);
      s[4] = s[4] * dec + lo2f(cur.z); s[5] = s[5] * dec + hi2f(cur.z);
      s[6] = s[6] * dec + lo2f(cur.w); s[7] = s[7] * dec + hi2f(cur.w);
    }
  }
}

DI void phase_ssdy(const Params& p_in, int l, char* smem) {
  const Params p = load_params();

  bf16_t* sB = (bf16_t*)smem;
  bf16_t* sX = (bf16_t*)(smem + 128 * 136 * 2);
  float* sF = (float*)(smem + 128 * 136 * 2 + 128 * 72 * 2);
  float* sSS = sF + 512;
  int tid = threadIdx.x; asm volatile("" : "+v"(tid)); const int lane = tid & 63, wave = tid >> 6, fr = lane & 31, fh = lane >> 5;
  const int wl = wave >> 1, w2 = wave & 1;
  const bf16_t* BC = (const bf16_t*)(p.ws + OFF_BC);
  const bf16_t* XS = (const bf16_t*)(p.ws + OFF_H);
  const float* DT = (const float*)(p.ws + OFF_DT);
  const float* CS = (const float*)(p.ws + OFF_CS);
  const bf16_t* ST = (const bf16_t*)(p.ws + OFF_ST);
  bf16_t* Z = (bf16_t*)(p.ws + OFF_Z);
  float* RSTD = (float*)(p.ws + OFF_RSTD);
  const int nck = (l == 0) ? NCK : 128;
  const int nh = (l == 0) ? 2 : 8;
  const int nsplit = 8 / nh;
  for (int it0 = blockIdx.x; it0 < nck * 4 * nsplit; it0 += gridDim.x) {
    const int hq = it0 % nsplit, it = it0 / nsplit;
    const int hbeg = hq * nh, hend = hbeg + nh;
    const int ck = it >> 2, g = (it >> 1) & 1, lh = it & 1;
    const int row0 = ck * 128;
    const int lbase = lh * 64 + wl * 32;
    __syncthreads();
    for (int v = tid; v < 2048; v += 256) {
      const int r = v >> 4, cv = v & 15;
      *(uint4*)&sB[r * 136 + cv * 8] = *(const uint4*)(BC + (size_t)(row0 + r) * 512 + g * 128 + cv * 8);
    }
    if (tid < 64) sSS[tid] = 0.f;
    const bf16_t* cptr = BC + (size_t)(row0 + lbase + fr) * 512 + 256 + g * 128 + fh * 8;
    bf16x8 cf[8];
#pragma unroll
    for (int ks = 0; ks < 8; ++ks) cf[ks] = *(const bf16x8*)(cptr + ks * 16);
    const int lrx = tid >> 3, cvx = tid & 7;
    const bf16_t* xsrc = XS + (size_t)(row0 + lrx) * 1024 + cvx * 8;
    uint4 xp0, xp1, xp2, xp3;
    float fp0 = 0.f, fp1 = 0.f, fp2 = 0.f, fp3 = 0.f;
    {
      const int head = g * 8 + hbeg;
      xp0 = *(const uint4*)(xsrc + head * 64);
      xp1 = *(const uint4*)(xsrc + head * 64 + 32 * 1024);
      xp2 = *(const uint4*)(xsrc + head * 64 + 64 * 1024);
      xp3 = *(const uint4*)(xsrc + head * 64 + 96 * 1024);
      if (tid < 128) {
        const size_t rho = (size_t)(row0 + tid);
        fp0 = CS[rho * 32 + head]; fp1 = CS[rho * 32 + 16 + head]; fp2 = DT[rho * 32 + head]; fp3 = DT[rho * 32 + 16 + head];
      }
    }
    __syncthreads();
    f32x16 cb[2];
#pragma unroll
    for (int j = 0; j < 2; ++j) {
#pragma unroll
      for (int r = 0; r < 16; ++r) cb[j][r] = 0.f;
#pragma unroll
      for (int ks = 0; ks < 8; ++ks) {
        const bf16x8 bq = *(const bf16x8*)&sB[(w2 * 64 + j * 32 + fr) * 136 + ks * 16 + fh * 8];
        cb[j] = MFMA(cf[ks], bq, cb[j]);
      }
    }
    const int pidx = w2 * 32 + fr;
    bf16_t* sCB = sB + 64 * 136;
    __syncthreads();
#pragma unroll
    for (int j = 0; j < 2; ++j)
#pragma unroll
      for (int r = 0; r < 16; ++r) sCB[(wl * 32 + crow(r, fh)) * 136 + w2 * 64 + j * 32 + fr] = f2bf(cb[j][r]);
#pragma unroll 1
    for (int hh = hbeg; hh < hend; ++hh) {
      const int head = g * 8 + hh;
      __syncthreads();
      *(uint4*)&sX[lrx * 72 + cvx * 8] = xp0;
      *(uint4*)&sX[(lrx + 32) * 72 + cvx * 8] = xp1;
      *(uint4*)&sX[(lrx + 64) * 72 + cvx * 8] = xp2;
      *(uint4*)&sX[(lrx + 96) * 72 + cvx * 8] = xp3;
      if (tid < 128) { sF[tid] = fp0; sF[128 + tid] = fp1; sF[256 + tid] = fp2; sF[384 + tid] = fp3; }
      const bf16_t* S0 = ST + ((size_t)(ck * 2 + 0) * 16 + head) * 8192 + (w2 * 32 + fr) * 128 + fh * 8;
      const bf16_t* S1 = ST + ((size_t)(ck * 2 + 1) * 16 + head) * 8192 + (w2 * 32 + fr) * 128 + fh * 8;
      bf16x8 sf0[8];
#pragma unroll
      for (int ks = 0; ks < 8; ++ks) sf0[ks] = *(const bf16x8*)(S0 + ks * 16);
      bf16_t* zbase = Z + (size_t)(row0 + lbase + 4 * fh) * 1024 + head * 64 + pidx;
      if (hh + 1 < hend) {
        const int hn = head + 1;
        xp0 = *(const uint4*)(xsrc + hn * 64);
        xp1 = *(const uint4*)(xsrc + hn * 64 + 32 * 1024);
        xp2 = *(const uint4*)(xsrc + hn * 64 + 64 * 1024);
        xp3 = *(const uint4*)(xsrc + hn * 64 + 96 * 1024);
        if (tid < 128) {
          const size_t rho = (size_t)(row0 + tid);
          fp0 = CS[rho * 32 + hn]; fp1 = CS[rho * 32 + 16 + hn]; fp2 = DT[rho * 32 + hn]; fp3 = DT[rho * 32 + 16 + hn];
        }
      }
      __syncthreads();
#pragma unroll
      for (int j = 0; j < 2; ++j) {
        const int sidx = w2 * 64 + j * 32 + fr;
        const float csf_s = sF[sidx], csb_s = sF[128 + sidx], dtf_s = sF[256 + sidx], dtb_s = sF[384 + sidx];
#pragma unroll 4
        for (int r = 0; r < 16; ++r) {
          const int lidx = lbase + crow(r, fh);
          float f = 0.f;
          if (sidx <= lidx) f += __expf(sF[lidx] - csf_s) * dtf_s;
          if (sidx >= lidx) f += __expf(sF[128 + lidx] - csb_s) * dtb_s;
          sB[(wl * 32 + crow(r, fh)) * 136 + sidx] = f2bf(bf2f(sCB[(wl * 32 + crow(r, fh)) * 136 + sidx]) * f);
        }
      }
      __syncthreads();
      bf16x8 sf1[8], cfh[8];
#pragma unroll
      for (int ks = 0; ks < 8; ++ks) { sf1[ks] = *(const bf16x8*)(S1 + ks * 16); cfh[ks] = *(const bf16x8*)(cptr + ks * 16); }
      unsigned short zv[16];
#pragma unroll
      for (int r = 0; r < 16; ++r) zv[r] = zbase[(size_t)((r & 3) + 8 * (r >> 2)) * 1024];
      f32x16 accy;
#pragma unroll
      for (int r = 0; r < 16; ++r) accy[r] = 0.f;
#pragma unroll
      for (int ks = 0; ks < 8; ++ks) {
        const bf16x8 af = *(const bf16x8*)&sB[(wl * 32 + fr) * 136 + ks * 16 + fh * 8];
        const bf16x8 xf = tr_frag(sX, 72, ks * 16 + 8 * fh, ks * 16 + 8 * fh + 4, w2 * 32);
        accy = MFMA(af, xf, accy);
      }
      {
        f32x16 acct;
#pragma unroll
        for (int r = 0; r < 16; ++r) acct[r] = 0.f;
#pragma unroll
        for (int ks = 0; ks < 8; ++ks) acct = MFMA(cfh[ks], sf0[ks], acct);
#pragma unroll
        for (int r = 0; r < 16; ++r) accy[r] += __expf(sF[lbase + crow(r, fh)]) * acct[r];
#pragma unroll
        for (int r = 0; r < 16; ++r) acct[r] = 0.f;
#pragma unroll
        for (int ks = 0; ks < 8; ++ks) acct = MFMA(cfh[ks], sf1[ks], acct);
#pragma unroll
        for (int r = 0; r < 16; ++r) accy[r] += __expf(sF[128 + lbase + crow(r, fh)]) * acct[r];
      }
      const float dsk = p.ssd_d[l * 16 + head];
      float v[16];
#pragma unroll
      for (int r = 0; r < 16; ++r) {
        const int lidx = lbase + crow(r, fh);
        const float xv = bf2f(sX[lidx * 72 + pidx]);
        const float y = accy[r] + dsk * xv;
        const float u = y * silu_f(bf2f(zv[r]));
        v[r] = u * u;
        zbase[(size_t)((r & 3) + 8 * (r >> 2)) * 1024] = f2bf(u);
      }
#pragma unroll
      for (int i = 0; i < 8; ++i) { const bool up = (fr & 16) != 0; const float keep = up ? v[i + 8] : v[i]; const float send = up ? v[i] : v[i + 8]; v[i] = keep + __shfl_xor(send, 16); }
#pragma unroll
      for (int i = 0; i < 4; ++i) { const bool up = (fr & 8) != 0; const float keep = up ? v[i + 4] : v[i]; const float send = up ? v[i] : v[i + 4]; v[i] = keep + __shfl_xor(send, 8); }
#pragma unroll
      for (int i = 0; i < 2; ++i) { const bool up = (fr & 4) != 0; const float keep = up ? v[i + 2] : v[i]; const float send = up ? v[i] : v[i + 2]; v[i] = keep + __shfl_xor(send, 4); }
      { const bool up = (fr & 2) != 0; const float keep = up ? v[1] : v[0]; const float send = up ? v[0] : v[1]; v[0] = keep + __shfl_xor(send, 2); }
      v[0] += __shfl_xor(v[0], 1);
      if ((fr & 1) == 0) atomicAdd(&sSS[wl * 32 + crow(fr >> 1, fh)], v[0]);
    }
    __syncthreads();
    if (tid < 64) atomicAdd(&RSTD[(size_t)(row0 + lh * 64 + tid) * 2 + g], sSS[tid]);
  }
}

DI void phase_outproj(const Params& p_in, int l, char* smem) {
  const Params p = load_params();

  GemmS* s = (GemmS*)smem;
  int tid = threadIdx.x; asm volatile("" : "+v"(tid)); const int lane = tid & 63, wave = tid >> 6, wr = wave >> 1, wc = wave & 1, fr = lane & 31, fh = lane >> 5;
  const bf16_t* Zb = (const bf16_t*)(p.ws + OFF_Z);
  const bf16_t* Qb = (const bf16_t*)(p.ws + OFF_Q);
  const bf16_t* Cb = (const bf16_t*)(p.ws + OFF_CG);
  const bf16_t* W = (const bf16_t*)(p.ws + OFF_WOUT);
  const float* RSTD = (const float*)(p.ws + OFF_RSTD);
  const float* mods = (const float*)(p.ws + OFF_MODS);
  float* XC = (float*)(p.ws + OFF_XC);
  const int nM = (l == 0) ? NCK : 128;
  for (int step = 0;; ++step) {
    int mt, nt;
    if (!xcd_tile(step, nM, 8, mt, nt)) break;
    f32x16 acc[2][2];
    zero_acc(acc);
    const bf16_t* Wb = W + (size_t)nt * 128 * 2048;
    const bf16_t* A0 = Zb + (size_t)mt * 128 * 1024;
    const bf16_t* A2 = Qb + (size_t)mt * 128 * 512;
    const bf16_t* A3 = Cb + (size_t)mt * 128 * 512;
    float* sScale = (float*)(smem + 40960);
    if (tid < 128) {
      const size_t row = (size_t)(mt * 128 + tid);
      const float r0 = rsqrtf(RSTD[row * 2] * (1.f / 512.f) + 1e-6f);
      const float r1 = rsqrtf(RSTD[row * 2 + 1] * (1.f / 512.f) + 1e-6f);
      sScale[tid * 2] = r0 / r1;
      sScale[tid * 2 + 1] = r1;
    }
    gemm_core2(acc, (GemmS2*)smem,
               [&](int kt, int r, int kv) {
                 const bf16_t* ptr;
                 if (kt < 16) ptr = A0 + (size_t)r * 1024 + kt * 64;
                 else if (kt < 24) ptr = A2 + (size_t)r * 512 + (kt - 16) * 64;
                 else ptr = A3 + (size_t)r * 512 + (kt - 24) * 64;
                 return ptr + kv * 8;
               },
               [&](int kt, int r, int kv) { return Wb + (size_t)r * 2048 + kt * 64 + kv * 8; }, 32,
               [&](int kt) __attribute__((always_inline)) {
                 if (kt == 8 || kt == 16) {
#pragma unroll
                   for (int i = 0; i < 2; ++i)
#pragma unroll
                     for (int r = 0; r < 16; ++r) {
                       const float f = sScale[(wr * 64 + i * 32 + crow(r, fh)) * 2 + (kt == 16 ? 1 : 0)];
                       acc[i][0][r] *= f; acc[i][1][r] *= f;
                     }
                 }
               });
    {
      const int row0 = mt * 128;
      const int vv = (row0 < RL_) ? (row0 >> 12) : 4;
      const float* gate = mods + (l * 5 + vv) * 3072 + 2048 + nt * 128;
      float* xnew = (row0 < RL_) ? (p.out + (size_t)row0 * 1024) : (XC + (size_t)(row0 - RL_) * 1024);
      const float* xold = (l == 0) ? ((row0 < RL_) ? (p.x + (size_t)row0 * 1024) : (p.ctx + (size_t)(row0 - RL_) * 1024)) : xnew;
      epilogue_lds(acc, smem, [&](int rl, int c4, float4 v) {
        const int off = rl * 1024 + nt * 128 + c4;
        const float4 xo = *(const float4*)(xold + off);
        const float4 gt = *(const float4*)(gate + c4);
        float4 o;
        o.x = xo.x + gt.x * v.x; o.y = xo.y + gt.y * v.y; o.z = xo.z + gt.z * v.z; o.w = xo.w + gt.w * v.w;
        *(float4*)(xnew + off) = o;
      });
    }
  }
  if (l == 0) {
    const int local = blockIdx.x >> 3, xcd = blockIdx.x & 7, nloc = gridDim.x >> 3;
    if (local >= 8 && nloc > 8) {
      const int nb = (nloc - 8) * 8;
      const int NT_WIN = 88 * 16, NT_PW = 64;
      for (int it = (local - 8) * 8 + xcd; it < NT_WIN + NT_PW; it += nb) {
        if (it < NT_WIN) transpose_tile(p.w_in + (size_t)1024 * 5408, 5408, 0, nullptr, (bf16_t*)(p.ws + OFF_WIN), 1024, (it / 16) * 64, (it % 16) * 64, (float*)smem);
        else { const int t = it - NT_WIN; transpose_tile(p.conv_pw_w + (size_t)512 * 512, 512, 1, nullptr, (bf16_t*)(p.ws + OFF_PW), 512, (t / 8) * 64, (t % 8) * 64, (float*)smem); }
      }
    }
  }
}

DI void phase_final(const Params& p_in) {
  const Params p = load_params();
  const int lane = threadIdx.x & 63, wave = threadIdx.x >> 6;
  for (int it = blockIdx.x; it < RL_ / 4; it += gridDim.x) {
    float* xr = p.out + (size_t)(it * 4 + wave) * 1024;
    float4 xv[4];
    float ss = 0.f;
#pragma unroll
    for (int i = 0; i < 4; ++i) {
      xv[i] = *(const float4*)(xr + lane * 4 + i * 256);
      ss += xv[i].x * xv[i].x + xv[i].y * xv[i].y + xv[i].z * xv[i].z + xv[i].w * xv[i].w;
    }
#pragma unroll
    for (int o = 32; o >= 1; o >>= 1) ss += __shfl_xor(ss, o);
    const float rs = rsqrtf(ss * (1.f / 1024.f) + 1e-6f);
#pragma unroll
    for (int i = 0; i < 4; ++i) {
      const float4 w = *(const float4*)(p.final_norm_w + lane * 4 + i * 256);
      float4 o;
      o.x = xv[i].x * rs * w.x; o.y = xv[i].y * rs * w.y; o.z = xv[i].z * rs * w.z; o.w = xv[i].w * rs * w.w;
      *(float4*)(xr + lane * 4 + i * 256) = o;
    }
  }
}

template <int PH>
DI void run_phase(const Params& p, char* smem) {
  constexpr int l = (PH - 1) / 7, s = (PH - 1) % 7;
  if constexpr (PH == 0) phase_mods(p, smem);
  else if constexpr (PH == 15) phase_final(p);
  else if constexpr (s == 0) phase_prep(p, l, smem);
  else if constexpr (s == 1) phase_inproj(p, smem);
  else if constexpr (s == 2) phase_local(p, l, smem);
  else if constexpr (s == 3) phase_mix(p, l, smem);
  else if constexpr (s == 4) phase_scan(p);
  else if constexpr (s == 5) phase_ssdy(p, l, smem);
  else phase_outproj(p, l, smem);
}

#if PROBE_S >= 0
#define PROBE_BEGIN() if (threadIdx.x == 0) pst[1] = wall_clock64();
#define PROBE_END(PH) if (threadIdx.x == 0 && (PH) >= 1 && (PH) <= 14 && (((PH) - 1) % 7) == PROBE_S) pst[0] += wall_clock64() - pst[1];
#else
#define PROBE_BEGIN()
#define PROBE_END(PH)
#endif
#define PHASE(PH) PROBE_BEGIN() run_phase<PH>(p, smem); xcd_barrier(xst); PROBE_END(PH)

__global__ void __launch_bounds__(256, 2) fwd_megakernel(Params p) {
  __shared__ __attribute__((aligned(16))) char smem[57344];
  cg::grid_group grid = cg::this_grid();
#if PROBE_S >= 0
  volatile unsigned long long* pst = (volatile unsigned long long*)(smem + 57344 - 16);
  if (threadIdx.x == 0) { pst[0] = 0; pst[1] = 0; }
#endif
  __shared__ uint4 xb_words;
  volatile LAS unsigned* xst = (volatile LAS unsigned*)&xb_words;
  if (threadIdx.x == 0) xb_words = make_uint4(0u, 0u, 0u, 0u);
  run_phase<0>(p, smem);
  grid.sync();
  if (threadIdx.x == 0) { unsigned* bar = (unsigned*)(load_params().ws + OFF_BAR); (void)xb_add(&bar[XB_XCNT(xb_xcc_id())], 1u); }
  PHASE(1) PHASE(2) PHASE(3) PHASE(4) PHASE(5) PHASE(6) PHASE(7)
  PHASE(8) PHASE(9) PHASE(10) PHASE(11) PHASE(12) PHASE(13) PHASE(14)
  run_phase<15>(p, smem);
#if PROBE_S >= 0
  if (blockIdx.x == 0 && threadIdx.x == 0) {
    const unsigned long long t1 = wall_clock64();
    const unsigned long long lim = 4ull * pst[0];
    while (wall_clock64() - t1 < lim) { __builtin_amdgcn_s_sleep(32); }
  }
#endif
}

extern "C" void kernel_launch(void* const* d_in, const int* in_sizes, int n_in, void* d_out, int out_size, void* d_ws,
                              size_t ws_size, hipStream_t stream) {
  static int grid_blocks = 0;
  if (!grid_blocks) {
    int dev = 0, cus = 0, per_cu = 0;
    hipGetDevice(&dev);
    hipDeviceGetAttribute(&cus, hipDeviceAttributeMultiprocessorCount, dev);
    hipOccupancyMaxActiveBlocksPerMultiprocessor(&per_cu, fwd_megakernel, 256, 0);
    if (per_cu < 1) per_cu = 1;
    if (per_cu > 2) per_cu = 2;
    grid_blocks = (cus * per_cu) & ~7;
  }
  Params p{};
  const float** pp = (const float**)&p;
  for (int i = 0; i < 23; ++i) pp[i] = (const float*)d_in[i];
  p.out = (float*)d_out;
  p.ws = (char*)d_ws;
  void* args[] = {&p};
  hipError_t e = hipLaunchCooperativeKernel((void*)fwd_megakernel, dim3(grid_blocks), dim3(256), args, 0, stream);
  if (e != hipSuccess) fprintf(stderr, "cooperative launch failed: %s (grid %d)\n", hipGetErrorString(e), grid_blocks);
}
```

```cpp
#include <hip/hip_runtime.h>
#include <hip/hip_cooperative_groups.h>
#include <stdint.h>
#include <stdio.h>
namespace cg = cooperative_groups;

#ifndef ONE_LAUNCH
#define ONE_LAUNCH 1
#endif

#ifndef PROBE_S
#define PROBE_S -1
#endif
#define DI __device__ __forceinline__
typedef unsigned short bf16_t;
using bf16x8 = __attribute__((ext_vector_type(8))) short;
using s16x4 = __attribute__((ext_vector_type(4))) short;
using f32x16 = __attribute__((ext_vector_type(16))) float;
#define MFMA(a, b, c) __builtin_amdgcn_mfma_f32_32x32x16_bf16((a), (b), (c), 0, 0, 0)

constexpr int R_ = 17408;
constexpr int RL_ = 16384;
constexpr int NCK = 136;

constexpr size_t SZ_WIN = (size_t)5632 * 1024 * 2;
constexpr size_t SZ_WOUT = (size_t)1024 * 2048 * 2;
constexpr size_t SZ_PW = (size_t)512 * 512 * 2;
constexpr size_t SZ_MODS = (size_t)2 * 5 * 3072 * 4;
constexpr size_t SZ_XC = (size_t)1024 * 1024 * 4;
constexpr size_t SZ_RSTD = (size_t)R_ * 2 * 4;
constexpr size_t SZ_CDEC = (size_t)NCK * 32 * 4 + 256 - ((size_t)NCK * 32 * 4) % 256;
constexpr size_t SZ_R512 = (size_t)R_ * 512 * 2;
constexpr size_t OFF_WIN = 0;
constexpr size_t OFF_WOUT = OFF_WIN + SZ_WIN;
constexpr size_t OFF_PW = OFF_WOUT + SZ_WOUT;
constexpr size_t OFF_MODS = OFF_PW + SZ_PW;
constexpr size_t OFF_XC = OFF_MODS + SZ_MODS;
constexpr size_t OFF_RSTD = OFF_XC + SZ_XC;
constexpr size_t OFF_CDEC = OFF_RSTD + SZ_RSTD;
constexpr size_t OFF_H = OFF_CDEC + SZ_CDEC;
constexpr size_t OFF_XBC = OFF_H + 2 * SZ_R512;
constexpr size_t OFF_GLU = OFF_XBC + 3 * SZ_R512;
constexpr size_t OFF_ST = OFF_XBC;
constexpr size_t OFF_Z = OFF_GLU + SZ_R512;
constexpr size_t OFF_DT = OFF_Z + 2 * SZ_R512;
constexpr size_t OFF_CS = OFF_DT + (size_t)R_ * 32 * 4;
constexpr size_t OFF_Q = OFF_CS + (size_t)R_ * 32 * 4;
constexpr size_t OFF_KV = OFF_Q + SZ_R512;
constexpr size_t OFF_AG = OFF_KV + SZ_R512 / 2;
constexpr size_t OFF_CG = OFF_AG + SZ_R512;
constexpr size_t OFF_BC = OFF_CG + SZ_R512;
constexpr size_t OFF_HDN = OFF_BC + SZ_R512;
constexpr size_t WS_TOTAL = OFF_HDN + SZ_R512;
constexpr size_t OFF_BAR = WS_TOTAL;
static_assert(OFF_BAR + 16384 <= (size_t)256 * 1024 * 1024, "workspace too large");

struct Params {
  const float *x, *c, *ctx, *c_ctx, *w_mod, *b_mod, *norm_w, *w_in, *ssd_conv_w, *ssd_conv_b, *ssd_dt_bias, *ssd_a_log,
      *ssd_d, *ssd_norm_w, *attn_sink, *conv_dw_w, *conv_dw_b, *conv_ln_w, *conv_ln_b, *conv_pw_w, *conv_pw_b, *w_out,
      *final_norm_w;
  float* out;
  char* ws;
};


DI Params load_params() {
  typedef const char __attribute__((address_space(4)))* kptr_t;
  typedef const float* const __attribute__((address_space(4)))* kfld_t;
  size_t off = 0;
  asm volatile("" : "+s"(off));
  kptr_t base = (kptr_t)__builtin_amdgcn_kernarg_segment_ptr() + off;
  Params p;
  const float** pp = (const float**)&p;
#pragma unroll
  for (int i = 0; i < 25; ++i) pp[i] = *(kfld_t)(base + 8 * i);
  return p;
}

#define XB_TMO      128
#define XB_XCNT(j)  (256  + 64 * (j))
#define XB_XSUB(j)  (1280 + 64 * (j))
#define XB_XGEN(j)  (2304 + 64 * (j))
#define XB_TOP      3328
#define XB_TOPGEN   3392
#define XCD_BAR_WORDS 3456
#define XB_SPIN_CAP (1u << 18)
#define LAS __attribute__((address_space(3)))
DI unsigned xb_ld(unsigned* p)              { return __hip_atomic_load(p, __ATOMIC_RELAXED, __HIP_MEMORY_SCOPE_AGENT); }
DI unsigned xb_add(unsigned* p, unsigned v) { return __hip_atomic_fetch_add(p, v, __ATOMIC_RELAXED, __HIP_MEMORY_SCOPE_AGENT); }
DI unsigned xb_xcc_id() { return (unsigned)__builtin_amdgcn_s_getreg((3 << 11) | 20) & 0xFu; }
#define XB_SPIN(cond, bar) do { unsigned _sp = 0; while (cond) { __builtin_amdgcn_s_sleep(1); \
    if ((++_sp & 255u) == 0u) { if (xb_ld(&(bar)[XB_TMO])) break; if (_sp > XB_SPIN_CAP) { atomicAdd(&(bar)[XB_TMO], 1u); break; } } } } while (0)

DI void xcd_barrier_complete(unsigned* bar, unsigned x, unsigned& nloc, unsigned& nx) {
  const unsigned G = gridDim.x * gridDim.y * gridDim.z;
  unsigned sum, cnt, mine, sp = 0u;
  for (;;) {
    sum = 0u; cnt = 0u; mine = 0u;
#pragma unroll
    for (unsigned j = 0; j < 16; ++j) { const unsigned c = xb_ld(&bar[XB_XCNT(j)]); sum += c; cnt += (c > 0u) ? 1u : 0u; mine = (j == x) ? c : mine; }
    if (sum == G) break;
    __builtin_amdgcn_s_sleep(1);
    if ((++sp & 255u) == 0u) { if (xb_ld(&bar[XB_TMO])) break; if (sp > XB_SPIN_CAP) { atomicAdd(&bar[XB_TMO], 1u); break; } }
  }
  nloc = mine > 0u ? mine : 1u; nx = cnt > 0u ? cnt : 1u;
}

DI void xcd_barrier(volatile LAS unsigned* st) {
  asm volatile("s_waitcnt vmcnt(0)" ::: "memory");
  __syncthreads();
  if (threadIdx.x == 0) {
    const Params pb = load_params();
    unsigned* bar = (unsigned*)(pb.ws + OFF_BAR);
    const unsigned x = xb_xcc_id();
    __builtin_amdgcn_s_waitcnt(0);
    unsigned nloc = st[0], nx = st[1];
    if (nloc == 0u) { xcd_barrier_complete(bar, x, nloc, nx); st[0] = nloc; st[1] = nx; }
    const unsigned old = xb_add(&bar[XB_XSUB(x)], 1u);
    const unsigned gen = old / nloc;
    if (old + 1u == (gen + 1u) * nloc) {
      __builtin_amdgcn_fence(__ATOMIC_RELEASE, "agent");
      asm volatile("s_waitcnt vmcnt(0)" ::: "memory");
      const unsigned og = xb_add(&bar[XB_TOP], 1u);
      const unsigned tg = og / nx;
      if (og + 1u == (tg + 1u) * nx) xb_add(&bar[XB_TOPGEN], 1u);
      else XB_SPIN(xb_ld(&bar[XB_TOPGEN]) == tg, bar);
      __builtin_amdgcn_fence(__ATOMIC_ACQUIRE, "agent");
      xb_add(&bar[XB_XGEN(x)], 1u);
      asm volatile("s_waitcnt vmcnt(0)" ::: "memory");
    } else {
      XB_SPIN(xb_ld(&bar[XB_XGEN(x)]) == gen, bar);
      __builtin_amdgcn_fence(__ATOMIC_ACQUIRE, "agent");
      asm volatile("s_waitcnt vmcnt(0)" ::: "memory");
    }
  }
  __syncthreads();
}

typedef __bf16 nbf16x2_t __attribute__((ext_vector_type(2)));
typedef float nf32x2_t __attribute__((ext_vector_type(2)));
DI unsigned short f2bf(float x) { const __bf16 r = (__bf16)x; return __builtin_bit_cast(unsigned short, r); }
DI float bf2f(unsigned short b) { return __uint_as_float(((unsigned)b) << 16); }
DI unsigned pack2(float a, float b) { const nf32x2_t v = {a, b}; const nbf16x2_t r = __builtin_convertvector(v, nbf16x2_t); return __builtin_bit_cast(unsigned, r); }
DI float lo2f(unsigned u) { return __uint_as_float(u << 16); }
DI float hi2f(unsigned u) { return __uint_as_float(u & 0xffff0000u); }
DI float silu_f(float x) { return x / (1.f + __expf(-x)); }
DI float sigmoid_f(float x) { return 1.f / (1.f + __expf(-x)); }
DI int crow(int reg, int h) { return (reg & 3) + 8 * (reg >> 2) + 4 * h; }

DI bf16x8 tr_frag(const bf16_t* s, int ld, int row_lo, int row_hi, int col0) {
  const int lane = threadIdx.x & 63;
  const int i16 = lane & 15, q = i16 >> 2, pp = i16 & 3, blk = (lane >> 4) & 1;
  const unsigned a0 = (unsigned)(size_t)(s + (row_lo + q) * ld + col0 + 16 * blk + 4 * pp);
  const unsigned a1 = (unsigned)(size_t)(s + (row_hi + q) * ld + col0 + 16 * blk + 4 * pp);
  s16x4 lo, hi;
  asm volatile("ds_read_b64_tr_b16 %0, %2\n\tds_read_b64_tr_b16 %1, %3\n\ts_waitcnt lgkmcnt(0)"
               : "=&v"(lo), "=&v"(hi) : "v"(a0), "v"(a1) : "memory");
  return __builtin_shufflevector(lo, hi, 0, 1, 2, 3, 4, 5, 6, 7);
}

struct GemmS { bf16_t a[2][128][40]; bf16_t b[2][128][40]; };

template <class AF, class BF>
DI void gemm_core(f32x16 (&acc)[2][2], GemmS* s, AF aptr, BF bptr, int nk) {
  int tid = threadIdx.x; asm volatile("" : "+v"(tid)); const int lane = tid & 63, wave = tid >> 6, wr = wave >> 1, wc = wave & 1;
  const int r0 = tid >> 2, kv = tid & 3;
  const int fr = lane & 31, fh = lane >> 5;
  uint4 ra0 = *(const uint4*)aptr(0, r0, kv), ra1 = *(const uint4*)aptr(0, r0 + 64, kv);
  uint4 rb0 = *(const uint4*)bptr(0, r0, kv), rb1 = *(const uint4*)bptr(0, r0 + 64, kv);
  *(uint4*)&s->a[0][r0][kv * 8] = ra0; *(uint4*)&s->a[0][r0 + 64][kv * 8] = ra1;
  *(uint4*)&s->b[0][r0][kv * 8] = rb0; *(uint4*)&s->b[0][r0 + 64][kv * 8] = rb1;
  __syncthreads();
#pragma unroll 1
  for (int kt = 0; kt < nk; ++kt) {
    const int buf = kt & 1;
    if (kt + 1 < nk) {
      ra0 = *(const uint4*)aptr(kt + 1, r0, kv); ra1 = *(const uint4*)aptr(kt + 1, r0 + 64, kv);
      rb0 = *(const uint4*)bptr(kt + 1, r0, kv); rb1 = *(const uint4*)bptr(kt + 1, r0 + 64, kv);
    }
#pragma unroll
    for (int ks = 0; ks < 2; ++ks) {
      bf16x8 af[2], bq[2];
#pragma unroll
      for (int i = 0; i < 2; ++i) af[i] = *(const bf16x8*)&s->a[buf][wr * 64 + i * 32 + fr][ks * 16 + fh * 8];
#pragma unroll
      for (int j = 0; j < 2; ++j) bq[j] = *(const bf16x8*)&s->b[buf][wc * 64 + j * 32 + fr][ks * 16 + fh * 8];
#pragma unroll
      for (int i = 0; i < 2; ++i)
#pragma unroll
        for (int j = 0; j < 2; ++j) acc[i][j] = MFMA(af[i], bq[j], acc[i][j]);
    }
    if (kt + 1 < nk) {
      *(uint4*)&s->a[buf ^ 1][r0][kv * 8] = ra0; *(uint4*)&s->a[buf ^ 1][r0 + 64][kv * 8] = ra1;
      *(uint4*)&s->b[buf ^ 1][r0][kv * 8] = rb0; *(uint4*)&s->b[buf ^ 1][r0 + 64][kv * 8] = rb1;
    }
    __syncthreads();
  }
}


struct GemmS2 { bf16_t a[128][72]; bf16_t b[128][72]; };
DI void g2_compute(f32x16 (&acc)[2][2], const GemmS2* s, int wr, int wc, int fr, int fh) {
#pragma unroll
  for (int ks = 0; ks < 4; ++ks) {
    bf16x8 af[2], bq[2];
#pragma unroll
    for (int i = 0; i < 2; ++i) af[i] = *(const bf16x8*)&s->a[wr * 64 + i * 32 + fr][ks * 16 + fh * 8];
#pragma unroll
    for (int j = 0; j < 2; ++j) bq[j] = *(const bf16x8*)&s->b[wc * 64 + j * 32 + fr][ks * 16 + fh * 8];
#pragma unroll
    for (int i = 0; i < 2; ++i)
#pragma unroll
      for (int j = 0; j < 2; ++j) acc[i][j] = MFMA(af[i], bq[j], acc[i][j]);
  }
}

template <class AF, class BF, class HK>
DI void gemm_core2(f32x16 (&acc)[2][2], GemmS2* s, AF aptr, BF bptr, int nk, HK hook) {
  int tid = threadIdx.x; asm volatile("" : "+v"(tid));
  const int lane = tid & 63, wave = tid >> 6, wr = wave >> 1, wc = wave & 1;
  const int r0 = tid >> 3, kc = tid & 7;
  const int fr = lane & 31, fh = lane >> 5;
  uint4 p0a0, p0a1, p0a2, p0a3, p0b0, p0b1, p0b2, p0b3, p1a0, p1a1, p1a2, p1a3, p1b0, p1b1, p1b2, p1b3;
#define G2_LOAD(S, KT) { \
    S##a0 = *(const uint4*)aptr((KT), r0, kc);      S##b0 = *(const uint4*)bptr((KT), r0, kc); \
    S##a1 = *(const uint4*)aptr((KT), r0 + 32, kc); S##b1 = *(const uint4*)bptr((KT), r0 + 32, kc); \
    S##a2 = *(const uint4*)aptr((KT), r0 + 64, kc); S##b2 = *(const uint4*)bptr((KT), r0 + 64, kc); \
    S##a3 = *(const uint4*)aptr((KT), r0 + 96, kc); S##b3 = *(const uint4*)bptr((KT), r0 + 96, kc); }
#define G2_STORE(S) { \
    *(uint4*)&s->a[r0][kc * 8] = S##a0;      *(uint4*)&s->b[r0][kc * 8] = S##b0; \
    *(uint4*)&s->a[r0 + 32][kc * 8] = S##a1; *(uint4*)&s->b[r0 + 32][kc * 8] = S##b1; \
    *(uint4*)&s->a[r0 + 64][kc * 8] = S##a2; *(uint4*)&s->b[r0 + 64][kc * 8] = S##b2; \
    *(uint4*)&s->a[r0 + 96][kc * 8] = S##a3; *(uint4*)&s->b[r0 + 96][kc * 8] = S##b3; }
#define G2_COMPUTE() g2_compute(acc, s, wr, wc, fr, fh);
  G2_LOAD(p0, 0)
  G2_LOAD(p1, 1)
  G2_STORE(p0)
  if (nk > 2) G2_LOAD(p0, 2)
  __syncthreads();
#pragma unroll 1
  for (int kt = 0; kt < nk; kt += 2) {
    hook(kt);
    G2_COMPUTE()
    __syncthreads();
    G2_STORE(p1)
    if (kt + 3 < nk) G2_LOAD(p1, kt + 3)
    __syncthreads();
    hook(kt + 1);
    G2_COMPUTE()
    __syncthreads();
    if (kt + 2 < nk) {
      G2_STORE(p0)
      if (kt + 4 < nk) G2_LOAD(p0, kt + 4)
    }
    __syncthreads();
  }
#undef G2_LOAD
#undef G2_STORE
#undef G2_COMPUTE
}


struct GemmS3 { bf16_t a[128][72]; bf16_t b[256][72]; };

template <class AF, class BF>
DI void gemm_core3(f32x16 (&acc)[2][4], GemmS3* s, AF aptr, BF bptr, int nk) {
  int tid = threadIdx.x; asm volatile("" : "+v"(tid));
  const int lane = tid & 63, wave = tid >> 6, wr = wave >> 1, wc = wave & 1;
  const int r0 = tid >> 3, kc = tid & 7;
  const int fr = lane & 31, fh = lane >> 5;
  uint4 a0, a1, a2, a3, b0, b1, b2, b3, b4, b5, b6, b7;
#define G3_LOAD(KT) { \
    a0 = *(const uint4*)aptr((KT), r0, kc);       a1 = *(const uint4*)aptr((KT), r0 + 32, kc); \
    a2 = *(const uint4*)aptr((KT), r0 + 64, kc);  a3 = *(const uint4*)aptr((KT), r0 + 96, kc); \
    b0 = *(const uint4*)bptr((KT), r0, kc);       b1 = *(const uint4*)bptr((KT), r0 + 32, kc); \
    b2 = *(const uint4*)bptr((KT), r0 + 64, kc);  b3 = *(const uint4*)bptr((KT), r0 + 96, kc); \
    b4 = *(const uint4*)bptr((KT), r0 + 128, kc); b5 = *(const uint4*)bptr((KT), r0 + 160, kc); \
    b6 = *(const uint4*)bptr((KT), r0 + 192, kc); b7 = *(const uint4*)bptr((KT), r0 + 224, kc); }
#define G3_STORE() { \
    *(uint4*)&s->a[r0][kc * 8] = a0;       *(uint4*)&s->a[r0 + 32][kc * 8] = a1; \
    *(uint4*)&s->a[r0 + 64][kc * 8] = a2;  *(uint4*)&s->a[r0 + 96][kc * 8] = a3; \
    *(uint4*)&s->b[r0][kc * 8] = b0;       *(uint4*)&s->b[r0 + 32][kc * 8] = b1; \
    *(uint4*)&s->b[r0 + 64][kc * 8] = b2;  *(uint4*)&s->b[r0 + 96][kc * 8] = b3; \
    *(uint4*)&s->b[r0 + 128][kc * 8] = b4; *(uint4*)&s->b[r0 + 160][kc * 8] = b5; \
    *(uint4*)&s->b[r0 + 192][kc * 8] = b6; *(uint4*)&s->b[r0 + 224][kc * 8] = b7; }
  G3_LOAD(0)
  G3_STORE()
  __syncthreads();
#pragma unroll 1
  for (int kt = 0; kt < nk; ++kt) {
    if (kt + 1 < nk) G3_LOAD(kt + 1)
#pragma unroll
    for (int ks = 0; ks < 4; ++ks) {
      bf16x8 af[2], bq[4];
#pragma unroll
      for (int i = 0; i < 2; ++i) af[i] = *(const bf16x8*)&s->a[wr * 64 + i * 32 + fr][ks * 16 + fh * 8];
#pragma unroll
      for (int j = 0; j < 4; ++j) bq[j] = *(const bf16x8*)&s->b[wc * 128 + j * 32 + fr][ks * 16 + fh * 8];
#pragma unroll
      for (int i = 0; i < 2; ++i)
#pragma unroll
        for (int j = 0; j < 4; ++j) acc[i][j] = MFMA(af[i], bq[j], acc[i][j]);
    }
    __syncthreads();
    if (kt + 1 < nk) G3_STORE()
    __syncthreads();
  }
#undef G3_LOAD
#undef G3_STORE
}

template <class EPI>
DI void epilogue_lds2(f32x16 (&acc)[2][4], char* smem, int sub, EPI epi) {
  float* T = (float*)smem;
  int tid = threadIdx.x; asm volatile("" : "+v"(tid));
  const int lane = tid & 63, wave = tid >> 6, wr = wave >> 1, wc = wave & 1, fr = lane & 31, fh = lane >> 5;
#pragma unroll
  for (int i = 0; i < 2; ++i) {
    if (wc == sub) {
#pragma unroll
      for (int j = 0; j < 4; ++j)
#pragma unroll
        for (int r = 0; r < 16; ++r) T[(wr * 32 + crow(r, fh)) * 132 + j * 32 + fr] = acc[i][j][r];
    }
    __syncthreads();
#pragma unroll 2
    for (int e = tid; e < 2048; e += 256) {
      const int tr = e >> 5, c4 = (e & 31) * 4;
      const float4 v = *(const float4*)&T[tr * 132 + c4];
      epi((tr >> 5) * 64 + i * 32 + (tr & 31), c4, v);
    }
    __syncthreads();
  }
}

DI bool xcd_tile(int step, int nM, int nN, int& mt, int& nt) {
  const int xcd = blockIdx.x & 7, nloc = gridDim.x >> 3;
  const int j = (blockIdx.x >> 3) + step * nloc;
  const int mloc = nM >> 3;
  if ((gridDim.x & 7) != 0 || j >= mloc * nN) return false;
  const int per = 8 * nN;
  const int gm = j / per, rem = j - gm * per;
  const int hgt = min(8, mloc - gm * 8);
  const int a = rem % hgt;
  nt = rem / hgt;
  mt = (gm * 8 + a) * 8 + xcd;
  return true;
}

DI void zero_acc(f32x16 (&acc)[2][2]) {
#pragma unroll
  for (int i = 0; i < 2; ++i)
#pragma unroll
    for (int j = 0; j < 2; ++j)
#pragma unroll
      for (int r = 0; r < 16; ++r) acc[i][j][r] = 0.f;
}

template <class EPI>
DI void epilogue_lds(f32x16 (&acc)[2][2], char* smem, EPI epi) {
  float* T = (float*)smem;
  int tid = threadIdx.x; asm volatile("" : "+v"(tid)); const int lane = tid & 63, wave = tid >> 6, wr = wave >> 1, wc = wave & 1, fr = lane & 31, fh = lane >> 5;
#pragma unroll
  for (int i = 0; i < 2; ++i) {
#pragma unroll
    for (int j = 0; j < 2; ++j)
#pragma unroll
      for (int r = 0; r < 16; ++r) T[(wr * 32 + crow(r, fh)) * 132 + wc * 64 + j * 32 + fr] = acc[i][j][r];
    __syncthreads();
#pragma unroll 2
    for (int e = tid; e < 2048; e += 256) {
      const int tr = e >> 5, c4 = (e & 31) * 4;
      const float4 v = *(const float4*)&T[tr * 132 + c4];
      epi((tr >> 5) * 64 + i * 32 + (tr & 31), c4, v);
    }
    __syncthreads();
  }
}

DI void phase_mods(const Params& p_in, char* smem) {
  const Params p = load_params();

  float* ssc = (float*)smem;
  float* red = (float*)(smem + 20480);
  float* mods = (float*)(p.ws + OFF_MODS);
  int tid = threadIdx.x; asm volatile("" : "+v"(tid));
  if (blockIdx.x == 0) { unsigned* bar = (unsigned*)(p.ws + OFF_BAR); for (int i = tid; i < XCD_BAR_WORDS; i += 256) bar[i] = 0u; }
  for (int it = blockIdx.x; it < 192; it += gridDim.x) {
    const int l = it / 96, col0 = (it % 96) * 32;
    __syncthreads();
    for (int e = tid; e < 5120; e += 256) {
      const int v = e >> 10, k = e & 1023;
      const float cv = (v < 4) ? p.c[v * 1024 + k] : p.c_ctx[k];
      ssc[e] = silu_f(cv);
    }
    __syncthreads();
    const int col = tid & 31, kg = tid >> 5;
    float a[5] = {0.f, 0.f, 0.f, 0.f, 0.f};
    const float* w = p.w_mod + (size_t)l * 1024 * 3072 + col0 + col;
    for (int k = kg * 128; k < kg * 128 + 128; k += 32) {
      float wv[32];
#pragma unroll
      for (int u = 0; u < 32; ++u) wv[u] = w[(size_t)(k + u) * 3072];
#pragma unroll
      for (int u = 0; u < 32; ++u)
#pragma unroll
        for (int v = 0; v < 5; ++v) a[v] += ssc[v * 1024 + k + u] * wv[u];
    }
#pragma unroll
    for (int v = 0; v < 5; ++v) red[(kg * 5 + v) * 32 + col] = a[v];
    __syncthreads();
    for (int e = tid; e < 160; e += 256) {
      const int v = e >> 5, cc = e & 31;
      float sum = p.b_mod[l * 3072 + col0 + cc];
      for (int g = 0; g < 8; ++g) sum += red[(g * 5 + v) * 32 + cc];
      mods[(l * 5 + v) * 3072 + col0 + cc] = sum;
    }
  }
}

DI int win_colmap(int n) {
  if (n < 2560) return n;
  if (n < 3840) return n + 32;
  if (n < 4864) {
    const int j = n - 3840, q64 = j >> 6, w = j & 63;
    return (w < 32) ? (3872 + q64 * 32 + w) : (3872 + 512 + q64 * 32 + (w - 32));
  }
  if (n < 5376) return n + 32;
  if (n < 5408) return n - 5376 + 2560;
  return -1;
}

DI void transpose_tile(const float* src, int ldsrc, int kind, const float* rowscale, bf16_t* dst, int lddst, int n0, int k0, float* tile) {
  int tid = threadIdx.x; asm volatile("" : "+v"(tid));
  __syncthreads();
  {
    const int c4 = (tid & 15) * 4, rr = tid >> 4;
    const int n = (kind == 0) ? win_colmap(n0 + c4) : (n0 + c4);
#pragma unroll
    for (int ps = 0; ps < 4; ++ps) {
      const int r = rr + ps * 16, k = k0 + r;
      float4 v = make_float4(0.f, 0.f, 0.f, 0.f);
      if (n >= 0) v = *(const float4*)(src + (size_t)k * ldsrc + n);
      if (rowscale != nullptr && k < 1024) { const float s = rowscale[k]; v.x *= s; v.y *= s; v.z *= s; v.w *= s; }
      tile[r * 65 + c4] = v.x; tile[r * 65 + c4 + 1] = v.y; tile[r * 65 + c4 + 2] = v.z; tile[r * 65 + c4 + 3] = v.w;
    }
  }
  __syncthreads();
  {
    const int k8 = (tid & 7) * 8, nn = tid >> 3;
#pragma unroll
    for (int ps = 0; ps < 2; ++ps) {
      const int r = nn + ps * 32;
      uint4 o;
      o.x = pack2(tile[(k8 + 0) * 65 + r], tile[(k8 + 1) * 65 + r]);
      o.y = pack2(tile[(k8 + 2) * 65 + r], tile[(k8 + 3) * 65 + r]);
      o.z = pack2(tile[(k8 + 4) * 65 + r], tile[(k8 + 5) * 65 + r]);
      o.w = pack2(tile[(k8 + 6) * 65 + r], tile[(k8 + 7) * 65 + r]);
      *(uint4*)(dst + (size_t)(n0 + r) * lddst + k0 + k8) = o;
    }
  }
}

DI void phase_prep(const Params& p_in, int l, char* smem) {
  const Params p = load_params();

  int tid = threadIdx.x; asm volatile("" : "+v"(tid)); const int lane = tid & 63, wave = tid >> 6;
  const float* mods = (const float*)(p.ws + OFF_MODS);
  bf16_t* H = (bf16_t*)(p.ws + OFF_H);
  const int NT_WIN = 88 * 16, NT_WOUT = 16 * 32, NT_PW = 64, NT_CONV = NT_WIN + NT_WOUT + NT_PW;
  const int NT = NT_CONV + R_ / 4;
  for (int it = blockIdx.x; it < NT; it += gridDim.x) {
    if (l == 1 && (it < NT_WIN || (it >= NT_WIN + NT_WOUT && it < NT_CONV))) continue;
    if (it < NT_WIN) {
      transpose_tile(p.w_in + (size_t)l * 1024 * 5408, 5408, 0, nullptr, (bf16_t*)(p.ws + OFF_WIN), 1024, (it / 16) * 64, (it % 16) * 64, (float*)smem);
    } else if (it < NT_WIN + NT_WOUT) {
      const int t = it - NT_WIN;
      transpose_tile(p.w_out + (size_t)l * 2048 * 1024, 1024, 1, p.ssd_norm_w + l * 1024, (bf16_t*)(p.ws + OFF_WOUT), 2048, (t / 32) * 64, (t % 32) * 64, (float*)smem);
    } else if (it < NT_CONV) {
      const int t = it - NT_WIN - NT_WOUT;
      transpose_tile(p.conv_pw_w + (size_t)l * 512 * 512, 512, 1, nullptr, (bf16_t*)(p.ws + OFF_PW), 512, (t / 8) * 64, (t % 8) * 64, (float*)smem);
    } else {
      const int rho = (it - NT_CONV) * 4 + wave;
      const float* xs;
      if (l == 0) xs = (rho < RL_) ? (p.x + (size_t)rho * 1024) : (p.ctx + (size_t)(rho - RL_) * 1024);
      else xs = (rho < RL_) ? (p.out + (size_t)rho * 1024) : ((const float*)(p.ws + OFF_XC) + (size_t)(rho - RL_) * 1024);
      const int v = (rho < RL_) ? (rho >> 12) : 4;
      const float* md = mods + (l * 5 + v) * 3072;
      float4 xv[4], nwv[4], shv[4], scv4[4];
      float ss = 0.f;
#pragma unroll
      for (int i = 0; i < 4; ++i) {
        const int cidx = lane * 4 + i * 256;
        xv[i] = *(const float4*)(xs + cidx);
        nwv[i] = *(const float4*)(p.norm_w + l * 1024 + cidx);
        shv[i] = *(const float4*)(md + cidx);
        scv4[i] = *(const float4*)(md + 1024 + cidx);
      }
#pragma unroll
      for (int i = 0; i < 4; ++i) ss += xv[i].x * xv[i].x + xv[i].y * xv[i].y + xv[i].z * xv[i].z + xv[i].w * xv[i].w;
#pragma unroll
      for (int o = 32; o >= 1; o >>= 1) ss += __shfl_xor(ss, o);
      const float rs = rsqrtf(ss * (1.f / 1024.f) + 1e-6f);
#pragma unroll
      for (int i = 0; i < 4; ++i) {
        const int cidx = lane * 4 + i * 256;
        const float4 nw = nwv[i], sh = shv[i], sc = scv4[i];
        uint2 o;
        o.x = pack2(xv[i].x * rs * nw.x * (1.f + sc.x) + sh.x, xv[i].y * rs * nw.y * (1.f + sc.y) + sh.y);
        o.y = pack2(xv[i].z * rs * nw.z * (1.f + sc.z) + sh.z, xv[i].w * rs * nw.w * (1.f + sc.w) + sh.w);
        *(uint2*)(H + (size_t)rho * 1024 + cidx) = o;
      }
    }
  }
}

DI void phase_inproj(const Params& p_in, char* smem) {
  const Params p = load_params();
  int tid = threadIdx.x; asm volatile("" : "+v"(tid)); const int wave = tid >> 6, wc = wave & 1;
  const bf16_t* H = (const bf16_t*)(p.ws + OFF_H);
  const bf16_t* W = (const bf16_t*)(p.ws + OFF_WIN);
  for (int step = 0;; ++step) {
    int mt, nt2;
    if (!xcd_tile(step, NCK, 22, mt, nt2)) break;
    f32x16 acc[2][4];
#pragma unroll
    for (int i = 0; i < 2; ++i)
#pragma unroll
      for (int j = 0; j < 4; ++j)
#pragma unroll
        for (int r = 0; r < 16; ++r) acc[i][j][r] = 0.f;
    const bf16_t* Ab = H + (size_t)mt * 128 * 1024;
    const bf16_t* Bb = W + (size_t)nt2 * 256 * 1024;
    gemm_core3(acc, (GemmS3*)smem,
               [&](int kt, int r, int kv) { return Ab + (size_t)r * 1024 + kt * 64 + kv * 8; },
               [&](int kt, int r, int kv) { return Bb + (size_t)r * 1024 + kt * 64 + kv * 8; }, 16);
    const int row0 = mt * 128;
    {
      const int ntw = nt2 * 2 + wc;
      if (ntw >= 30 && ntw < 38) {
#pragma unroll
        for (int i = 0; i < 2; ++i)
#pragma unroll
          for (int r = 0; r < 16; ++r) {
            acc[i][0][r] = acc[i][0][r] * sigmoid_f(acc[i][1][r]);
            acc[i][2][r] = acc[i][2][r] * sigmoid_f(acc[i][3][r]);
          }
      }
    }
#pragma unroll 1
    for (int sub = 0; sub < 2; ++sub) {
      const int nt = nt2 * 2 + sub;
      if (nt >= 43) break;
      if (nt >= 30 && nt < 38) {
        bf16_t* G = (bf16_t*)(p.ws + OFF_GLU);
        const int cb0 = (nt - 30) * 64;
        epilogue_lds2(acc, smem, sub, [&](int rl, int c4, float4 v) {
          if ((c4 & 32) == 0) {
            uint2 o; o.x = pack2(v.x, v.y); o.y = pack2(v.z, v.w);
            *(uint2*)(G + (size_t)(row0 + rl) * 512 + cb0 + (c4 >> 6) * 32 + (c4 & 31)) = o;
          }
        });
      } else if (nt == 42) {
        float* DT = (float*)(p.ws + OFF_DT);
        epilogue_lds2(acc, smem, sub, [&](int rl, int c4, float4 v) {
          if (c4 < 32) *(float4*)(DT + (size_t)(row0 + rl) * 32 + c4) = v;
        });
      } else {
        bf16_t* dst; int ld, cb;
        if (nt < 12) { dst = (bf16_t*)(p.ws + OFF_XBC); ld = 1536; cb = nt * 128; }
        else if (nt < 20) { dst = (bf16_t*)(p.ws + OFF_Z); ld = 1024; cb = nt * 128 - 1536; }
        else if (nt < 24) { dst = (bf16_t*)(p.ws + OFF_Q); ld = 512; cb = nt * 128 - 2560; }
        else if (nt < 26) { dst = (bf16_t*)(p.ws + OFF_KV); ld = 256; cb = nt * 128 - 3072; }
        else if (nt < 30) { dst = (bf16_t*)(p.ws + OFF_AG); ld = 512; cb = nt * 128 - 3328; }
        else { dst = (bf16_t*)(p.ws + OFF_CG); ld = 512; cb = nt * 128 - 4864; }
        epilogue_lds2(acc, smem, sub, [&](int rl, int c4, float4 v) {
          uint2 o; o.x = pack2(v.x, v.y); o.y = pack2(v.z, v.w);
          *(uint2*)(dst + (size_t)(row0 + rl) * ld + cb + c4) = o;
        });
      }
    }
  }
}

DI void phase_local(const Params& p_in, int l, char* smem) {
  const Params p = load_params();

  int tid = threadIdx.x; asm volatile("" : "+v"(tid)); const int lane = tid & 63;
  const bf16_t* XBC = (const bf16_t*)(p.ws + OFF_XBC);
  bf16_t* XS = (bf16_t*)(p.ws + OFF_H);
  bf16_t* BC = (bf16_t*)(p.ws + OFF_BC);
  float* DT = (float*)(p.ws + OFF_DT);
  float* CS = (float*)(p.ws + OFF_CS);
  const bf16_t* GLU = (const bf16_t*)(p.ws + OFF_GLU);
  bf16_t* HDN = (bf16_t*)(p.ws + OFF_HDN);
  bf16_t* Q = (bf16_t*)(p.ws + OFF_Q);
  bf16_t* KV = (bf16_t*)(p.ws + OFF_KV);
  { float* SSQ = (float*)(p.ws + OFF_RSTD); for (int i = blockIdx.x * 256 + tid; i < R_ * 2; i += gridDim.x * 256) SSQ[i] = 0.f; }
  const int N_CONV = (R_ / 4) * 192 / 256;
  const int N_DT = NCK;
  const int N_CF = R_ / 16;
  const int N_ROPE = RL_ * 40 / 256;
  const int N_QC = 1024 * 256 / 256;
  const int NT = N_CF + N_DT + N_CONV + N_ROPE + N_QC;
  for (int it0 = blockIdx.x; it0 < NT; it0 += gridDim.x) {
    int it = it0;
    if (it < N_CF) {
      float* sst = (float*)smem;
      unsigned* sIn = (unsigned*)(smem + 256);
      const int row0 = it * 16;
      const int seq0 = (row0 < RL_) ? (row0 & ~4095) : (RL_ + ((row0 - RL_) & ~255));
      const int slen = (row0 < RL_) ? 4096 : 256;
      const int t0 = row0 - seq0;
      const int c0 = tid * 2;
      __syncthreads();
      if (tid < 32) sst[tid] = 0.f;
      for (int idx = tid; idx < 46 * 64; idx += 256) {
        const int rr = idx >> 6, c16 = idx & 63;
        const int tt = t0 - 15 + rr;
        uint4 val = make_uint4(0u, 0u, 0u, 0u);
        if (tt >= 0 && tt < slen) val = *(const uint4*)(GLU + (size_t)(seq0 + tt) * 512 + c16 * 8);
        *(uint4*)&sIn[rr * 256 + c16 * 4] = val;
      }
      float w0[31], w1[31];
#pragma unroll
      for (int k = 0; k < 31; ++k) {
        const float2 wv = *(const float2*)(p.conv_dw_w + ((size_t)l * 31 + k) * 512 + c0);
        w0[k] = wv.x; w1[k] = wv.y;
      }
      const float2 bv = *(const float2*)(p.conv_dw_b + l * 512 + c0);
      float a0[16], a1[16];
#pragma unroll
      for (int r = 0; r < 16; ++r) { a0[r] = bv.x; a1[r] = bv.y; }
      __syncthreads();
#pragma unroll
      for (int tp = 0; tp < 46; ++tp) {
        const unsigned u = sIn[tp * 256 + tid];
        const float x0 = lo2f(u), x1 = hi2f(u);
#pragma unroll
        for (int r = 0; r < 16; ++r) {
          const int k = tp - r;
          if (k >= 0 && k < 31) { a0[r] += w0[k] * x0; a1[r] += w1[k] * x1; }
        }
        if ((tp & 7) == 7) __builtin_amdgcn_sched_barrier(0);
      }
      {
        float v[32];
#pragma unroll
        for (int r = 0; r < 16; ++r) { v[2 * r] = a0[r] + a1[r]; v[2 * r + 1] = a0[r] * a0[r] + a1[r] * a1[r]; }
#pragma unroll
        for (int i = 0; i < 16; ++i) { const bool up = (lane & 32) != 0; const float keep = up ? v[i + 16] : v[i]; const float send = up ? v[i] : v[i + 16]; v[i] = keep + __shfl_xor(send, 32); }
#pragma unroll
        for (int i = 0; i < 8; ++i) { const bool up = (lane & 16) != 0; const float keep = up ? v[i + 8] : v[i]; const float send = up ? v[i] : v[i + 8]; v[i] = keep + __shfl_xor(send, 16); }
#pragma unroll
        for (int i = 0; i < 4; ++i) { const bool up = (lane & 8) != 0; const float keep = up ? v[i + 4] : v[i]; const float send = up ? v[i] : v[i + 4]; v[i] = keep + __shfl_xor(send, 8); }
#pragma unroll
        for (int i = 0; i < 2; ++i) { const bool up = (lane & 4) != 0; const float keep = up ? v[i + 2] : v[i]; const float send = up ? v[i] : v[i + 2]; v[i] = keep + __shfl_xor(send, 4); }
        { const bool up = (lane & 2) != 0; const float keep = up ? v[1] : v[0]; const float send = up ? v[0] : v[1]; v[0] = keep + __shfl_xor(send, 2); }
        v[0] += __shfl_xor(v[0], 1);
        __syncthreads();
        if ((lane & 1) == 0) atomicAdd(&sst[lane >> 1], v[0]);
      }
      __syncthreads();
      const float2 lw = *(const float2*)(p.conv_ln_w + l * 512 + c0);
      const float2 lb = *(const float2*)(p.conv_ln_b + l * 512 + c0);
#pragma unroll
      for (int r = 0; r < 16; ++r) {
        const float mean = sst[r * 2] * (1.f / 512.f);
        const float var = fmaxf(sst[r * 2 + 1] * (1.f / 512.f) - mean * mean, 0.f);
        const float rs = rsqrtf(var + 1e-6f);
        const float y0 = (a0[r] - mean) * rs * lw.x + lb.x;
        const float y1 = (a1[r] - mean) * rs * lw.y + lb.y;
        *(unsigned*)(HDN + (size_t)(row0 + r) * 512 + c0) = pack2(silu_f(y0), silu_f(y1));
        if ((r & 3) == 3) __builtin_amdgcn_sched_barrier(0);
      }
      continue;
    }
    it -= N_CF;
    if (it < N_DT) {
      float* sdt = (float*)smem;
      const int row0 = it * 128;
      __syncthreads();
      for (int e = tid; e < 4096; e += 256) {
        const int r = e >> 5, cidx = e & 31;
        const float raw = DT[(size_t)(row0 + r) * 32 + cidx] + p.ssd_dt_bias[l * 32 + cidx];
        const float sp = (raw > 20.f) ? raw : log1pf(expf(raw));
        DT[(size_t)(row0 + r) * 32 + cidx] = sp;
        sdt[r * 33 + cidx] = sp;
      }
      __syncthreads();
      if (tid < 32) {
        const float a = -expf(p.ssd_a_log[l * 32 + tid]);
        float run = 0.f;
        if (tid < 16) {
          for (int r = 0; r < 128; ++r) { run += sdt[r * 33 + tid] * a; CS[(size_t)(row0 + r) * 32 + tid] = run; }
        } else {
          for (int r = 127; r >= 0; --r) { run += sdt[r * 33 + tid] * a; CS[(size_t)(row0 + r) * 32 + tid] = run; }
        }
      }
      continue;
    }
    it -= N_DT;
    if (it < N_CONV) {
      const int e = it * 256 + tid;
      const int rb = e / 192, cgp = e % 192, ch0 = cgp * 8;
      const int rho0 = rb * 4;
      const int seq0 = (rho0 < RL_) ? (rho0 & ~4095) : (RL_ + ((rho0 - RL_) & ~255));
      const int slen = (rho0 < RL_) ? 4096 : 256;
      const int t0 = rho0 - seq0;
      uint4 xr[8];
#pragma unroll
      for (int i = 0; i < 8; ++i) {
        const int tt = t0 + i - 2;
        xr[i] = make_uint4(0u, 0u, 0u, 0u);
        if (tt >= 0 && tt < slen) xr[i] = *(const uint4*)(XBC + (size_t)(seq0 + tt) * 1536 + ch0);
      }
      float wk[5][8];
#pragma unroll
      for (int k = 0; k < 5; ++k) {
        const float4 w0 = *(const float4*)(p.ssd_conv_w + ((size_t)l * 5 + k) * 1536 + ch0);
        const float4 w1 = *(const float4*)(p.ssd_conv_w + ((size_t)l * 5 + k) * 1536 + ch0 + 4);
        wk[k][0] = w0.x; wk[k][1] = w0.y; wk[k][2] = w0.z; wk[k][3] = w0.w; wk[k][4] = w1.x; wk[k][5] = w1.y; wk[k][6] = w1.z; wk[k][7] = w1.w;
      }
      float bias[8];
      {
        const float4 b0 = *(const float4*)(p.ssd_conv_b + l * 1536 + ch0);
        const float4 b1 = *(const float4*)(p.ssd_conv_b + l * 1536 + ch0 + 4);
        bias[0] = b0.x; bias[1] = b0.y; bias[2] = b0.z; bias[3] = b0.w; bias[4] = b1.x; bias[5] = b1.y; bias[6] = b1.z; bias[7] = b1.w;
      }
#pragma unroll
      for (int r = 0; r < 4; ++r) {
        float a[8];
#pragma unroll
        for (int c = 0; c < 8; ++c) a[c] = bias[c];
#pragma unroll
        for (int k = 0; k < 5; ++k) {
          const uint4 u = xr[r + k];
          a[0] += wk[k][0] * lo2f(u.x); a[1] += wk[k][1] * hi2f(u.x); a[2] += wk[k][2] * lo2f(u.y); a[3] += wk[k][3] * hi2f(u.y);
          a[4] += wk[k][4] * lo2f(u.z); a[5] += wk[k][5] * hi2f(u.z); a[6] += wk[k][6] * lo2f(u.w); a[7] += wk[k][7] * hi2f(u.w);
        }
        uint4 o;
        o.x = pack2(silu_f(a[0]), silu_f(a[1])); o.y = pack2(silu_f(a[2]), silu_f(a[3]));
        o.z = pack2(silu_f(a[4]), silu_f(a[5])); o.w = pack2(silu_f(a[6]), silu_f(a[7]));
        const size_t rho = (size_t)(rho0 + r);
        if (ch0 < 1024) *(uint4*)(XS + rho * 1024 + ch0) = o;
        else *(uint4*)(BC + rho * 512 + (ch0 - 1024)) = o;
      }
      continue;
    }
    it -= N_CONV;
    if (it < N_ROPE) {
      const int e = it * 256 + tid;
      const int rho = e / 40, rem = e % 40, hd = rem >> 2, sub = rem & 3;
      const int axis = sub >> 1, half = sub & 1;
      const int t = rho & 4095;
      const float pos = (float)(axis == 0 ? (t >> 6) : (t & 63));
      bf16_t* base = ((hd < 8) ? (Q + (size_t)rho * 512 + hd * 64) : (KV + (size_t)rho * 256 + (hd - 8) * 64)) + axis * 32 + half * 8;
      const float sc = (hd < 8) ? 0.18033688011112042f : 1.f;
      const uint4 u1 = *(const uint4*)base, u2 = *(const uint4*)(base + 16);
      const unsigned a1[4] = {u1.x, u1.y, u1.z, u1.w}, a2[4] = {u2.x, u2.y, u2.z, u2.w};
      unsigned o1[4], o2[4];
#pragma unroll
      for (int i = 0; i < 4; ++i) {
        float r1[2], r2[2];
#pragma unroll
        for (int hl = 0; hl < 2; ++hl) {
          const float f = (float)(half * 8 + 2 * i + hl);
          const float ang = pos * exp2f(-f * 0.8304820237218406f);
          const float cs = __cosf(ang), sn = __sinf(ang);
          const float t1 = hl ? hi2f(a1[i]) : lo2f(a1[i]);
          const float t2 = hl ? hi2f(a2[i]) : lo2f(a2[i]);
          r1[hl] = (t1 * cs - t2 * sn) * sc;
          r2[hl] = (t2 * cs + t1 * sn) * sc;
        }
        o1[i] = pack2(r1[0], r1[1]); o2[i] = pack2(r2[0], r2[1]);
      }
      *(uint4*)base = make_uint4(o1[0], o1[1], o1[2], o1[3]);
      *(uint4*)(base + 16) = make_uint4(o2[0], o2[1], o2[2], o2[3]);
      continue;
    }
    it -= N_ROPE;
    {
      const int e = it * 256 + tid;
      const int rho = RL_ + e / 256, c2 = (e % 256) * 2;
      unsigned* ptr = (unsigned*)(Q + (size_t)rho * 512 + c2);
      const unsigned u = *ptr;
      *ptr = pack2(lo2f(u) * 0.18033688011112042f, hi2f(u) * 0.18033688011112042f);
    }
  }
}

DI void attn_item(const Params& p_in, int l, char* smem, int b, int qblk, int g, int hp, bool ctxq) {
  const Params p = load_params();

  bf16_t* sK = (bf16_t*)smem;
  bf16_t* sV = (bf16_t*)(smem + 128 * 72 * 2);
  int tid = threadIdx.x; asm volatile("" : "+v"(tid)); const int lane = tid & 63, wave = tid >> 6, fr = lane & 31, fh = lane >> 5;
  const int head = g * 4 + hp * 2 + (wave >> 1);
  const int qh = wave & 1;
  const int qrow0 = (ctxq ? (RL_ + b * 256) : (b * 4096)) + qblk * 128 + qh * 64;
  const int qpos0 = qblk * 128 + qh * 64;
  bf16_t* Q = (bf16_t*)(p.ws + OFF_Q);
  const bf16_t* KV = (const bf16_t*)(p.ws + OFF_KV);
  const bf16_t* AG = (const bf16_t*)(p.ws + OFF_AG);
  f32x16 o[2][2];
  zero_acc(o);
  float m[2], lsum[2];
  m[0] = m[1] = p.attn_sink[l * 8 + head] * 1.4426950408889634f;
  lsum[0] = lsum[1] = 1.f;
  const int nhb = ctxq ? 4 : 10;
  auto hb_row = [&](int hb) -> int {
    if (hb >= nhb) return -1;
    if (hb < 4) return RL_ + b * 256 + hb * 64;
    const int kp = (qblk - 1) * 128 + (hb - 4) * 64;
    if (kp < 0 || kp >= 4096) return -1;
    return b * 4096 + kp;
  };
  auto hb_next = [&](int hb) -> int { int n = hb + 1; while (n < nhb && hb_row(n) < 0) ++n; return n; };
  const int sr = tid >> 3, scv = tid & 7;
  uint4 kp0, kp1, vp0, vp1;
#define ATT_PREFETCH(ROW0) { const bf16_t* kvp = KV + (size_t)((ROW0) + sr) * 256 + g * 64 + scv * 8; \
    kp0 = *(const uint4*)(kvp); kp1 = *(const uint4*)(kvp + 32 * 256); vp0 = *(const uint4*)(kvp + 128); vp1 = *(const uint4*)(kvp + 128 + 32 * 256); }
#define ATT_STORE(BUF) { bf16_t* k_ = sK + (BUF) * 64 * 72; bf16_t* v_ = sV + (BUF) * 64 * 72; \
    *(uint4*)&k_[sr * 72 + scv * 8] = kp0; *(uint4*)&k_[(sr + 32) * 72 + scv * 8] = kp1; \
    *(uint4*)&v_[sr * 72 + scv * 8] = vp0; *(uint4*)&v_[(sr + 32) * 72 + scv * 8] = vp1; }
  int pbuf = 0;
  __syncthreads();
  ATT_PREFETCH(hb_row(0))
  ATT_STORE(0)
  __syncthreads();
  for (int hb = 0; hb < nhb; hb = hb_next(hb)) {
    const int nxt = hb_next(hb);
    if (nxt < nhb) ATT_PREFETCH(hb_row(nxt))
    int kpos0 = 0;
    bool masked = false;
    if (hb >= 4) { kpos0 = (qblk - 1) * 128 + (hb - 4) * 64; masked = (hb != 6 && hb != 7); }
    const bf16_t* cK = sK + pbuf * 64 * 72;
    const bf16_t* cV = sV + pbuf * 64 * 72;
    bf16x8 qf[2][4];
#pragma unroll
    for (int j = 0; j < 2; ++j)
#pragma unroll
      for (int ks = 0; ks < 4; ++ks)
        qf[j][ks] = *(const bf16x8*)(Q + (size_t)(qrow0 + j * 32 + fr) * 512 + head * 64 + ks * 16 + fh * 8);
#pragma unroll 1
    for (int kb = 0; kb < 2; ++kb) {
      if (masked) {
        const int klo = kpos0 + kb * 32, khi = klo + 31;
        if (klo - (qpos0 + 63) > 128 || qpos0 - khi > 128) continue;
      }
      bf16x8 pb[2][2];
#pragma unroll
      for (int j = 0; j < 2; ++j) {
        f32x16 st[2];
#pragma unroll
        for (int r = 0; r < 16; ++r) st[j][r] = -m[j];
#pragma unroll
        for (int ks = 0; ks < 4; ++ks) {
          const bf16x8 kf = *(const bf16x8*)&cK[(kb * 32 + fr) * 72 + ks * 16 + fh * 8];
          st[j] = MFMA(kf, qf[j][ks], st[j]);
        }
        if (masked) {
          const int qpos = qpos0 + j * 32 + fr;
#pragma unroll
          for (int r = 0; r < 16; ++r) {
            const int d = qpos - (kpos0 + kb * 32 + crow(r, fh));
            if (d > 128 || d < -128) st[j][r] = -1e30f;
          }
        }
        float mx = st[j][0];
#pragma unroll
        for (int r = 1; r < 16; ++r) mx = fmaxf(mx, st[j][r]);
        mx = fmaxf(mx, __shfl_xor(mx, 32));
        const bool grow = mx > 8.f;
        if (__builtin_amdgcn_ballot_w64(grow) != 0ull) {
          const float delta = grow ? mx : 0.f;
          const float alpha = __builtin_amdgcn_exp2f(-delta);
#pragma unroll
          for (int r = 0; r < 16; ++r) st[j][r] -= delta;
          lsum[j] *= alpha;
          m[j] += delta;
#pragma unroll
          for (int mt = 0; mt < 2; ++mt)
#pragma unroll
            for (int r = 0; r < 16; ++r) o[mt][j][r] *= alpha;
        }
        float rs = 0.f;
#pragma unroll
        for (int r = 0; r < 16; ++r) { const float pv = __builtin_amdgcn_exp2f(st[j][r]); st[j][r] = pv; rs += pv; }
        rs += __shfl_xor(rs, 32);
        lsum[j] += rs;
#pragma unroll
        for (int s = 0; s < 2; ++s) {
          uint4 pk;
          pk.x = pack2(st[j][8 * s + 0], st[j][8 * s + 1]); pk.y = pack2(st[j][8 * s + 2], st[j][8 * s + 3]);
          pk.z = pack2(st[j][8 * s + 4], st[j][8 * s + 5]); pk.w = pack2(st[j][8 * s + 6], st[j][8 * s + 7]);
          pb[j][s] = __builtin_bit_cast(bf16x8, pk);
        }
      }
#pragma unroll
      for (int s = 0; s < 2; ++s)
#pragma unroll
        for (int mt = 0; mt < 2; ++mt) {
          const bf16x8 vf = tr_frag(cV, 72, kb * 32 + 16 * s + 4 * fh, kb * 32 + 16 * s + 8 + 4 * fh, mt * 32);
#pragma unroll
          for (int j = 0; j < 2; ++j) o[mt][j] = MFMA(vf, pb[j][s], o[mt][j]);
        }
    }
    if (nxt < nhb) ATT_STORE(pbuf ^ 1)
    pbuf ^= 1;
    __syncthreads();
  }
#undef ATT_PREFETCH
#undef ATT_STORE
#pragma unroll
  for (int j = 0; j < 2; ++j) {
    const float inv = 1.f / lsum[j];
    const size_t rho = (size_t)(qrow0 + j * 32 + fr);
#pragma unroll
    for (int mt = 0; mt < 2; ++mt)
#pragma unroll
      for (int g4 = 0; g4 < 4; ++g4) {
        const int d0 = mt * 32 + 8 * g4 + 4 * fh;
        const uint2 gv = *(const uint2*)(AG + rho * 512 + head * 64 + d0);
        uint2 ov;
        ov.x = pack2(o[mt][j][g4 * 4 + 0] * inv * silu_f(lo2f(gv.x)), o[mt][j][g4 * 4 + 1] * inv * silu_f(hi2f(gv.x)));
        ov.y = pack2(o[mt][j][g4 * 4 + 2] * inv * silu_f(lo2f(gv.y)), o[mt][j][g4 * 4 + 3] * inv * silu_f(hi2f(gv.y)));
        *(uint2*)(Q + rho * 512 + head * 64 + d0) = ov;
      }
  }
}

DI void states_item(const Params& p_in, char* smem, int ck, int g, int hq) {
  const Params p = load_params();

  bf16_t* sB = (bf16_t*)smem;
  bf16_t* sX = (bf16_t*)(smem + 128 * 136 * 2);
  int tid = threadIdx.x; asm volatile("" : "+v"(tid)); const int lane = tid & 63, wave = tid >> 6, wr = wave >> 1, wc = wave & 1, fr = lane & 31, fh = lane >> 5;
  const bf16_t* BC = (const bf16_t*)(p.ws + OFF_BC);
  const bf16_t* XS = (const bf16_t*)(p.ws + OFF_H);
  const float* DT = (const float*)(p.ws + OFF_DT);
  const float* CS = (const float*)(p.ws + OFF_CS);
  bf16_t* ST = (bf16_t*)(p.ws + OFF_ST);
  float* CDEC = (float*)(p.ws + OFF_CDEC);
  const int row0 = ck * 128;
  __syncthreads();
  for (int v = tid; v < 2048; v += 256) {
    const int r = v >> 4, cv = v & 15;
    *(uint4*)&sB[r * 136 + cv * 8] = *(const uint4*)(BC + (size_t)(row0 + r) * 512 + g * 128 + cv * 8);
  }
  __syncthreads();
  bf16x8 bfr[2][8];
#pragma unroll
  for (int j = 0; j < 2; ++j)
#pragma unroll
    for (int ks = 0; ks < 8; ++ks) bfr[j][ks] = tr_frag(sB, 136, ks * 16 + 8 * fh, ks * 16 + 8 * fh + 4, wc * 64 + j * 32);
  const int slr = tid >> 3, scv = tid & 7;
  uint4 xq0, xq1, xq2, xq3;
  float dq0, dq1, dq2, dq3, cq0, cq1, cq2, cq3, cendq;
#define ST_PREFETCH(HD) { const int head_ = g * 8 + hq * 4 + ((HD) >> 1), d_ = (HD) & 1, col_ = d_ * 16 + head_; \
    const bf16_t* xp_ = XS + (size_t)(row0 + slr) * 1024 + head_ * 64 + scv * 8; \
    xq0 = *(const uint4*)(xp_); xq1 = *(const uint4*)(xp_ + 32 * 1024); xq2 = *(const uint4*)(xp_ + 64 * 1024); xq3 = *(const uint4*)(xp_ + 96 * 1024); \
    const size_t rb_ = (size_t)(row0 + slr) * 32 + col_; \
    dq0 = DT[rb_]; dq1 = DT[rb_ + 32 * 32]; dq2 = DT[rb_ + 64 * 32]; dq3 = DT[rb_ + 96 * 32]; \
    cq0 = CS[rb_]; cq1 = CS[rb_ + 32 * 32]; cq2 = CS[rb_ + 64 * 32]; cq3 = CS[rb_ + 96 * 32]; \
    cendq = CS[(size_t)(row0 + (d_ == 0 ? 127 : 0)) * 32 + col_]; }
#define ST_SCALE_STORE(X, DTV, CSV, ROW) { const float sc_ = (DTV) * __expf(cend - (CSV)); uint4 o_; \
    o_.x = pack2(lo2f(X.x) * sc_, hi2f(X.x) * sc_); o_.y = pack2(lo2f(X.y) * sc_, hi2f(X.y) * sc_); \
    o_.z = pack2(lo2f(X.z) * sc_, hi2f(X.z) * sc_); o_.w = pack2(lo2f(X.w) * sc_, hi2f(X.w) * sc_); \
    *(uint4*)&sX[(ROW) * 72 + scv * 8] = o_; }
  ST_PREFETCH(0)
#pragma unroll 1
  for (int hd = 0; hd < 8; ++hd) {
    const int head = g * 8 + hq * 4 + (hd >> 1), d = hd & 1;
    const float cend = cendq;
    ST_SCALE_STORE(xq0, dq0, cq0, slr)
    ST_SCALE_STORE(xq1, dq1, cq1, slr + 32)
    ST_SCALE_STORE(xq2, dq2, cq2, slr + 64)
    ST_SCALE_STORE(xq3, dq3, cq3, slr + 96)
    if (hd < 7) ST_PREFETCH(hd + 1)
    __syncthreads();
    f32x16 acc[2];
#pragma unroll
    for (int j = 0; j < 2; ++j)
#pragma unroll
      for (int r = 0; r < 16; ++r) acc[j][r] = 0.f;
#pragma unroll
    for (int ks = 0; ks < 8; ++ks) {
      const bf16x8 af = tr_frag(sX, 72, ks * 16 + 8 * fh, ks * 16 + 8 * fh + 4, wr * 32);
#pragma unroll
      for (int j = 0; j < 2; ++j) acc[j] = MFMA(af, bfr[j][ks], acc[j]);
    }
    bf16_t* dst = ST + ((size_t)(ck * 2 + d) * 16 + head) * 8192;
#pragma unroll
    for (int j = 0; j < 2; ++j)
#pragma unroll
      for (int r = 0; r < 16; ++r) dst[(wr * 32 + crow(r, fh)) * 128 + wc * 64 + j * 32 + fr] = f2bf(acc[j][r]);
    if (tid == 0) CDEC[(ck * 2 + d) * 16 + head] = __expf(cend);
    __syncthreads();
  }
}

DI void pw_item(const Params& p_in, int l, char* smem, int mt, int nt) {
  const Params p = load_params();

  GemmS* s = (GemmS*)smem;
  int tid = threadIdx.x; asm volatile("" : "+v"(tid)); const int lane = tid & 63, wave = tid >> 6, wr = wave >> 1, wc = wave & 1, fr = lane & 31, fh = lane >> 5;
  const bf16_t* Ab = (const bf16_t*)(p.ws + OFF_HDN) + (size_t)mt * 128 * 512;
  const bf16_t* Bb = (const bf16_t*)(p.ws + OFF_PW) + (size_t)nt * 128 * 512;
  bf16_t* CG = (bf16_t*)(p.ws + OFF_CG);
  f32x16 acc[2][2];
  zero_acc(acc);
  gemm_core2(acc, (GemmS2*)smem,
             [&](int kt, int r, int kv) { return Ab + (size_t)r * 512 + kt * 64 + kv * 8; },
             [&](int kt, int r, int kv) { return Bb + (size_t)r * 512 + kt * 64 + kv * 8; }, 8, [](int) {});
  const float* pwb = p.conv_pw_b + l * 512 + nt * 128;
  epilogue_lds(acc, smem, [&](int rl, int c4, float4 v) {
    bf16_t* ptr = CG + (size_t)(mt * 128 + rl) * 512 + nt * 128 + c4;
    const uint2 gv = *(const uint2*)ptr;
    const float4 bb = *(const float4*)(pwb + c4);
    uint2 o;
    o.x = pack2((v.x + bb.x) * silu_f(lo2f(gv.x)), (v.y + bb.y) * silu_f(hi2f(gv.x)));
    o.y = pack2((v.z + bb.z) * silu_f(lo2f(gv.y)), (v.w + bb.w) * silu_f(hi2f(gv.y)));
    *(uint2*)ptr = o;
  });
}

DI void phase_mix(const Params& p, int l, char* smem) {
  const int G = gridDim.x;
  const int N_ATT = 512 + (l == 0 ? 32 : 0);
  for (int it = blockIdx.x; it < N_ATT; it += G) {
    if (it < 512) attn_item(p, l, smem, it >> 7, (it >> 2) & 31, (it >> 1) & 1, it & 1, false);
    else { const int t = it - 512; attn_item(p, l, smem, t >> 3, (t >> 2) & 1, (t >> 1) & 1, t & 1, true); }
  }
  for (int it = (blockIdx.x + G - 32) % G; it < NCK * 4; it += G) states_item(p, smem, it >> 2, (it >> 1) & 1, it & 1);
  for (int it = (blockIdx.x + G - 64) % G; it < NCK * 4; it += G) pw_item(p, l, smem, it >> 2, it & 3);
}

DI void phase_scan(const Params& p_in) {
  const Params p = load_params();

  bf16_t* ST = (bf16_t*)(p.ws + OFF_ST);
  const float* CDEC = (const float*)(p.ws + OFF_CDEC);
  for (int it = blockIdx.x; it < 512; it += gridDim.x) {
    const int e = it * 256 + threadIdx.x;
    const int bdh = e >> 10, v8 = e & 1023;
    const int b = bdh >> 5, d = (bdh >> 4) & 1, h = bdh & 15;
    float s[8];
#pragma unroll
    for (int i = 0; i < 8; ++i) s[i] = 0.f;
    auto ckof = [&](int i) {
      if (d == 0) return (i < 2) ? (128 + 2 * b + i) : (32 * b + (i - 2));
      return (i < 2) ? (128 + 2 * b + (1 - i)) : (32 * b + 31 - (i - 2));
    };
    auto pof = [&](int i) { const int ck = ckof(i); return (uint4*)(ST + ((size_t)(ck * 2 + d) * 16 + h) * 8192 + v8 * 8); };
    auto dof = [&](int i) { const int ck = ckof(i); return CDEC[(ck * 2 + d) * 16 + h]; };
    uint4 buf[4]; float dc[4];
#pragma unroll
    for (int i = 0; i < 3; ++i) { buf[i] = *pof(i); dc[i] = dof(i); }
#pragma unroll
    for (int i = 0; i < 34; ++i) {
      if (i + 3 < 34) { buf[(i + 3) & 3] = *pof(i + 3); dc[(i + 3) & 3] = dof(i + 3); }
      const uint4 cur = buf[i & 3];
      const float dec = dc[i & 3];
      uint4 o;
      o.x = pack2(s[0], s[1]); o.y = pack2(s[2], s[3]); o.z = pack2(s[4], s[5]); o.w = pack2(s[6], s[7]);
      *pof(i) = o;
      s[0] = s[0] * dec + lo2f(cur.x); s[1] = s[1] * dec + hi2f(cur.x);
      s[2] = s[2] * dec + lo2f(cur.y); s[3] = s[3] * dec + hi2f(cur.y);
      s[4] = s[4] * dec + lo2f(cur.z); s[5] = s[5] * dec + hi2f(cur.z);
      s[6] = s[6] * dec + lo2f(cur.w); s[7] = s[7] * dec + hi2f(cur.w);
    }
  }
}

DI void phase_ssdy(const Params& p_in, int l, char* smem) {
  const Params p = load_params();

  bf16_t* sB = (bf16_t*)smem;
  bf16_t* sX = (bf16_t*)(smem + 128 * 136 * 2);
  float* sF = (float*)(smem + 128 * 136 * 2 + 128 * 72 * 2);
  float* sSS = sF + 512;
  int tid = threadIdx.x; asm volatile("" : "+v"(tid)); const int lane = tid & 63, wave = tid >> 6, fr = lane & 31, fh = lane >> 5;
  const int wl = wave >> 1, w2 = wave & 1;
  const bf16_t* BC = (const bf16_t*)(p.ws + OFF_BC);
  const bf16_t* XS = (const bf16_t*)(p.ws + OFF_H);
  const float* DT = (const float*)(p.ws + OFF_DT);
  const float* CS = (const float*)(p.ws + OFF_CS);
  const bf16_t* ST = (const bf16_t*)(p.ws + OFF_ST);
  bf16_t* Z = (bf16_t*)(p.ws + OFF_Z);
  float* RSTD = (float*)(p.ws + OFF_RSTD);
  const int nck = (l == 0) ? NCK : 128;
  const int nh = (l == 0) ? 2 : 8;
  const int nsplit = 8 / nh;
  for (int it0 = blockIdx.x; it0 < nck * 4 * nsplit; it0 += gridDim.x) {
    const int hq = it0 % nsplit, it = it0 / nsplit;
    const int hbeg = hq * nh, hend = hbeg + nh;
    const int ck = it >> 2, g = (it >> 1) & 1, lh = it & 1;
    const int row0 = ck * 128;
    const int lbase = lh * 64 + wl * 32;
    __syncthreads();
    for (int v = tid; v < 2048; v += 256) {
      const int r = v >> 4, cv = v & 15;
      *(uint4*)&sB[r * 136 + cv * 8] = *(const uint4*)(BC + (size_t)(row0 + r) * 512 + g * 128 + cv * 8);
    }
    if (tid < 64) sSS[tid] = 0.f;
    const bf16_t* cptr = BC + (size_t)(row0 + lbase + fr) * 512 + 256 + g * 128 + fh * 8;
    bf16x8 cf[8];
#pragma unroll
    for (int ks = 0; ks < 8; ++ks) cf[ks] = *(const bf16x8*)(cptr + ks * 16);
    const int lrx = tid >> 3, cvx = tid & 7;
    const bf16_t* xsrc = XS + (size_t)(row0 + lrx) * 1024 + cvx * 8;
    uint4 xp0, xp1, xp2, xp3;
    float fp0 = 0.f, fp1 = 0.f, fp2 = 0.f, fp3 = 0.f;
    {
      const int head = g * 8 + hbeg;
      xp0 = *(const uint4*)(xsrc + head * 64);
      xp1 = *(const uint4*)(xsrc + head * 64 + 32 * 1024);
      xp2 = *(const uint4*)(xsrc + head * 64 + 64 * 1024);
      xp3 = *(const uint4*)(xsrc + head * 64 + 96 * 1024);
      if (tid < 128) {
        const size_t rho = (size_t)(row0 + tid);
        fp0 = CS[rho * 32 + head]; fp1 = CS[rho * 32 + 16 + head]; fp2 = DT[rho * 32 + head]; fp3 = DT[rho * 32 + 16 + head];
      }
    }
    __syncthreads();
    f32x16 cb[2];
#pragma unroll
    for (int j = 0; j < 2; ++j) {
#pragma unroll
      for (int r = 0; r < 16; ++r) cb[j][r] = 0.f;
#pragma unroll
      for (int ks = 0; ks < 8; ++ks) {
        const bf16x8 bq = *(const bf16x8*)&sB[(w2 * 64 + j * 32 + fr) * 136 + ks * 16 + fh * 8];
        cb[j] = MFMA(cf[ks], bq, cb[j]);
      }
    }
    const int pidx = w2 * 32 + fr;
    bf16_t* sCB = sB + 64 * 136;
    __syncthreads();
#pragma unroll
    for (int j = 0; j < 2; ++j)
#pragma unroll
      for (int r = 0; r < 16; ++r) sCB[(wl * 32 + crow(r, fh)) * 136 + w2 * 64 + j * 32 + fr] = f2bf(cb[j][r]);
#pragma unroll 1
    for (int hh = hbeg; hh < hend; ++hh) {
      const int head = g * 8 + hh;
      __syncthreads();
      *(uint4*)&sX[lrx * 72 + cvx * 8] = xp0;
      *(uint4*)&sX[(lrx + 32) * 72 + cvx * 8] = xp1;
      *(uint4*)&sX[(lrx + 64) * 72 + cvx * 8] = xp2;
      *(uint4*)&sX[(lrx + 96) * 72 + cvx * 8] = xp3;
      if (tid < 128) { sF[tid] = fp0; sF[128 + tid] = fp1; sF[256 + tid] = fp2; sF[384 + tid] = fp3; }
      const bf16_t* S0 = ST + ((size_t)(ck * 2 + 0) * 16 + head) * 8192 + (w2 * 32 + fr) * 128 + fh * 8;
      const bf16_t* S1 = ST + ((size_t)(ck * 2 + 1) * 16 + head) * 8192 + (w2 * 32 + fr) * 128 + fh * 8;
      bf16x8 sf0[8];
#pragma unroll
      for (int ks = 0; ks < 8; ++ks) sf0[ks] = *(const bf16x8*)(S0 + ks * 16);
      bf16_t* zbase = Z + (size_t)(row0 + lbase + 4 * fh) * 1024 + head * 64 + pidx;
      if (hh + 1 < hend) {
        const int hn = head + 1;
        xp0 = *(const uint4*)(xsrc + hn * 64);
        xp1 = *(const uint4*)(xsrc + hn * 64 + 32 * 1024);
        xp2 = *(const uint4*)(xsrc + hn * 64 + 64 * 1024);
        xp3 = *(const uint4*)(xsrc + hn * 64 + 96 * 1024);
        if (tid < 128) {
          const size_t rho = (size_t)(row0 + tid);
          fp0 = CS[rho * 32 + hn]; fp1 = CS[rho * 32 + 16 + hn]; fp2 = DT[rho * 32 + hn]; fp3 = DT[rho * 32 + 16 + hn];
        }
      }
      __syncthreads();
#pragma unroll
      for (int j = 0; j < 2; ++j) {
        const int sidx = w2 * 64 + j * 32 + fr;
        const float csf_s = sF[sidx], csb_s = sF[128 + sidx], dtf_s = sF[256 + sidx], dtb_s = sF[384 + sidx];
#pragma unroll 4
        for (int r = 0; r < 16; ++r) {
          const int lidx = lbase + crow(r, fh);
          float f = 0.f;
          if (sidx <= lidx) f += __expf(sF[lidx] - csf_s) * dtf_s;
          if (sidx >= lidx) f += __expf(sF[128 + lidx] - csb_s) * dtb_s;
          sB[(wl * 32 + crow(r, fh)) * 136 + sidx] = f2bf(bf2f(sCB[(wl * 32 + crow(r, fh)) * 136 + sidx]) * f);
        }
      }
      __syncthreads();
      bf16x8 sf1[8], cfh[8];
#pragma unroll
      for (int ks = 0; ks < 8; ++ks) { sf1[ks] = *(const bf16x8*)(S1 + ks * 16); cfh[ks] = *(const bf16x8*)(cptr + ks * 16); }
      unsigned short zv[16];
#pragma unroll
      for (int r = 0; r < 16; ++r) zv[r] = zbase[(size_t)((r & 3) + 8 * (r >> 2)) * 1024];
      f32x16 accy;
#pragma unroll
      for (int r = 0; r < 16; ++r) accy[r] = 0.f;
#pragma unroll
      for (int ks = 0; ks < 8; ++ks) {
        const bf16x8 af = *(const bf16x8*)&sB[(wl * 32 + fr) * 136 + ks * 16 + fh * 8];
        const bf16x8 xf = tr_frag(sX, 72, ks * 16 + 8 * fh, ks * 16 + 8 * fh + 4, w2 * 32);
        accy = MFMA(af, xf, accy);
      }
      {
        f32x16 acct;
#pragma unroll
        for (int r = 0; r < 16; ++r) acct[r] = 0.f;
#pragma unroll
        for (int ks = 0; ks < 8; ++ks) acct = MFMA(cfh[ks], sf0[ks], acct);
#pragma unroll
        for (int r = 0; r < 16; ++r) accy[r] += __expf(sF[lbase + crow(r, fh)]) * acct[r];
#pragma unroll
        for (int r = 0; r < 16; ++r) acct[r] = 0.f;
#pragma unroll
        for (int ks = 0; ks < 8; ++ks) acct = MFMA(cfh[ks], sf1[ks], acct);
#pragma unroll
        for (int r = 0; r < 16; ++r) accy[r] += __expf(sF[128 + lbase + crow(r, fh)]) * acct[r];
      }
      const float dsk = p.ssd_d[l * 16 + head];
      float v[16];
#pragma unroll
      for (int r = 0; r < 16; ++r) {
        const int lidx = lbase + crow(r, fh);
        const float xv = bf2f(sX[lidx * 72 + pidx]);
        const float y = accy[r] + dsk * xv;
        const float u = y * silu_f(bf2f(zv[r]));
        v[r] = u * u;
        zbase[(size_t)((r & 3) + 8 * (r >> 2)) * 1024] = f2bf(u);
      }
#pragma unroll
      for (int i = 0; i < 8; ++i) { const bool up = (fr & 16) != 0; const float keep = up ? v[i + 8] : v[i]; const float send = up ? v[i] : v[i + 8]; v[i] = keep + __shfl_xor(send, 16); }
#pragma unroll
      for (int i = 0; i < 4; ++i) { const bool up = (fr & 8) != 0; const float keep = up ? v[i + 4] : v[i]; const float send = up ? v[i] : v[i + 4]; v[i] = keep + __shfl_xor(send, 8); }
#pragma unroll
      for (int i = 0; i < 2; ++i) { const bool up = (fr & 4) != 0; const float keep = up ? v[i + 2] : v[i]; const float send = up ? v[i] : v[i + 2]; v[i] = keep + __shfl_xor(send, 4); }
      { const bool up = (fr & 2) != 0; const float keep = up ? v[1] : v[0]; const float send = up ? v[0] : v[1]; v[0] = keep + __shfl_xor(send, 2); }
      v[0] += __shfl_xor(v[0], 1);
      if ((fr & 1) == 0) atomicAdd(&sSS[wl * 32 + crow(fr >> 1, fh)], v[0]);
    }
    __syncthreads();
    if (tid < 64) atomicAdd(&RSTD[(size_t)(row0 + lh * 64 + tid) * 2 + g], sSS[tid]);
  }
}

DI void phase_outproj(const Params& p_in, int l, char* smem) {
  const Params p = load_params();

  GemmS* s = (GemmS*)smem;
  int tid = threadIdx.x; asm volatile("" : "+v"(tid)); const int lane = tid & 63, wave = tid >> 6, wr = wave >> 1, wc = wave & 1, fr = lane & 31, fh = lane >> 5;
  const bf16_t* Zb = (const bf16_t*)(p.ws + OFF_Z);
  const bf16_t* Qb = (const bf16_t*)(p.ws + OFF_Q);
  const bf16_t* Cb = (const bf16_t*)(p.ws + OFF_CG);
  const bf16_t* W = (const bf16_t*)(p.ws + OFF_WOUT);
  const float* RSTD = (const float*)(p.ws + OFF_RSTD);
  const float* mods = (const float*)(p.ws + OFF_MODS);
  float* XC = (float*)(p.ws + OFF_XC);
  const int nM = (l == 0) ? NCK : 128;
  for (int step = 0;; ++step) {
    int mt, nt;
    if (!xcd_tile(step, nM, 8, mt, nt)) break;
    f32x16 acc[2][2];
    zero_acc(acc);
    const bf16_t* Wb = W + (size_t)nt * 128 * 2048;
    const bf16_t* A0 = Zb + (size_t)mt * 128 * 1024;
    const bf16_t* A2 = Qb + (size_t)mt * 128 * 512;
    const bf16_t* A3 = Cb + (size_t)mt * 128 * 512;
    float* sScale = (float*)(smem + 40960);
    if (tid < 128) {
      const size_t row = (size_t)(mt * 128 + tid);
      const float r0 = rsqrtf(RSTD[row * 2] * (1.f / 512.f) + 1e-6f);
      const float r1 = rsqrtf(RSTD[row * 2 + 1] * (1.f / 512.f) + 1e-6f);
      sScale[tid * 2] = r0 / r1;
      sScale[tid * 2 + 1] = r1;
    }
    gemm_core2(acc, (GemmS2*)smem,
               [&](int kt, int r, int kv) {
                 const bf16_t* ptr;
                 if (kt < 16) ptr = A0 + (size_t)r * 1024 + kt * 64;
                 else if (kt < 24) ptr = A2 + (size_t)r * 512 + (kt - 16) * 64;
                 else ptr = A3 + (size_t)r * 512 + (kt - 24) * 64;
                 return ptr + kv * 8;
               },
               [&](int kt, int r, int kv) { return Wb + (size_t)r * 2048 + kt * 64 + kv * 8; }, 32,
               [&](int kt) __attribute__((always_inline)) {
                 if (kt == 8 || kt == 16) {
#pragma unroll
                   for (int i = 0; i < 2; ++i)
#pragma unroll
                     for (int r = 0; r < 16; ++r) {
                       const float f = sScale[(wr * 64 + i * 32 + crow(r, fh)) * 2 + (kt == 16 ? 1 : 0)];
                       acc[i][0][r] *= f; acc[i][1][r] *= f;
                     }
                 }
               });
    {
      const int row0 = mt * 128;
      const int vv = (row0 < RL_) ? (row0 >> 12) : 4;
      const float* gate = mods + (l * 5 + vv) * 3072 + 2048 + nt * 128;
      float* xnew = (row0 < RL_) ? (p.out + (size_t)row0 * 1024) : (XC + (size_t)(row0 - RL_) * 1024);
      const float* xold = (l == 0) ? ((row0 < RL_) ? (p.x + (size_t)row0 * 1024) : (p.ctx + (size_t)(row0 - RL_) * 1024)) : xnew;
      epilogue_lds(acc, smem, [&](int rl, int c4, float4 v) {
        const int off = rl * 1024 + nt * 128 + c4;
        const float4 xo = *(const float4*)(xold + off);
        const float4 gt = *(const float4*)(gate + c4);
        float4 o;
        o.x = xo.x + gt.x * v.x; o.y = xo.y + gt.y * v.y; o.z = xo.z + gt.z * v.z; o.w = xo.w + gt.w * v.w;
        *(float4*)(xnew + off) = o;
      });
    }
  }
  if (l == 0) {
    const int local = blockIdx.x >> 3, xcd = blockIdx.x & 7, nloc = gridDim.x >> 3;
    if (local >= 8 && nloc > 8) {
      const int nb = (nloc - 8) * 8;
      const int NT_WIN = 88 * 16, NT_PW = 64;
      for (int it = (local - 8) * 8 + xcd; it < NT_WIN + NT_PW; it += nb) {
        if (it < NT_WIN) transpose_tile(p.w_in + (size_t)1024 * 5408, 5408, 0, nullptr, (bf16_t*)(p.ws + OFF_WIN), 1024, (it / 16) * 64, (it % 16) * 64, (float*)smem);
        else { const int t = it - NT_WIN; transpose_tile(p.conv_pw_w + (size_t)512 * 512, 512, 1, nullptr, (bf16_t*)(p.ws + OFF_PW), 512, (t / 8) * 64, (t % 8) * 64, (float*)smem); }
      }
    }
  }
}

DI void phase_final(const Params& p_in) {
  const Params p = load_params();
  const int lane = threadIdx.x & 63, wave = threadIdx.x >> 6;
  for (int it = blockIdx.x; it < RL_ / 4; it += gridDim.x) {
    float* xr = p.out + (size_t)(it * 4 + wave) * 1024;
    float4 xv[4];
    float ss = 0.f;
#pragma unroll
    for (int i = 0; i < 4; ++i) {
      xv[i] = *(const float4*)(xr + lane * 4 + i * 256);
      ss += xv[i].x * xv[i].x + xv[i].y * xv[i].y + xv[i].z * xv[i].z + xv[i].w * xv[i].w;
    }
#pragma unroll
    for (int o = 32; o >= 1; o >>= 1) ss += __shfl_xor(ss, o);
    const float rs = rsqrtf(ss * (1.f / 1024.f) + 1e-6f);
#pragma unroll
    for (int i = 0; i < 4; ++i) {
      const float4 w = *(const float4*)(p.final_norm_w + lane * 4 + i * 256);
      float4 o;
      o.x = xv[i].x * rs * w.x; o.y = xv[i].y * rs * w.y; o.z = xv[i].z * rs * w.z; o.w = xv[i].w * rs * w.w;
      *(float4*)(xr + lane * 4 + i * 256) = o;
    }
  }
}

template <int PH>
DI void run_phase(const Params& p, char* smem) {
  constexpr int l = (PH - 1) / 7, s = (PH - 1) % 7;
  if constexpr (PH == 0) phase_mods(p, smem);
  else if constexpr (PH == 15) phase_final(p);
  else if constexpr (s == 0) phase_prep(p, l, smem);
  else if constexpr (s == 1) phase_inproj(p, smem);
  else if constexpr (s == 2) phase_local(p, l, smem);
  else if constexpr (s == 3) phase_mix(p, l, smem);
  else if constexpr (s == 4) phase_scan(p);
  else if constexpr (s == 5) phase_ssdy(p, l, smem);
  else phase_outproj(p, l, smem);
}

#if PROBE_S >= 0
#define PROBE_BEGIN() if (threadIdx.x == 0) pst[1] = wall_clock64();
#define PROBE_END(PH) if (threadIdx.x == 0 && (PH) >= 1 && (PH) <= 14 && (((PH) - 1) % 7) == PROBE_S) pst[0] += wall_clock64() - pst[1];
#else
#define PROBE_BEGIN()
#define PROBE_END(PH)
#endif
#define PHASE(PH) PROBE_BEGIN() run_phase<PH>(p, smem); xcd_barrier(xst); PROBE_END(PH)

__global__ void __launch_bounds__(256, 2) fwd_megakernel(Params p) {
  __shared__ __attribute__((aligned(16))) char smem[57344];
  cg::grid_group grid = cg::this_grid();
#if PROBE_S >= 0
  volatile unsigned long long* pst = (volatile unsigned long long*)(smem + 57344 - 16);
  if (threadIdx.x == 0) { pst[0] = 0; pst[1] = 0; }
#endif
  __shared__ uint4 xb_words;
  volatile LAS unsigned* xst = (volatile LAS unsigned*)&xb_words;
  if (threadIdx.x == 0) xb_words = make_uint4(0u, 0u, 0u, 0u);
  run_phase<0>(p, smem);
  grid.sync();
  if (threadIdx.x == 0) { unsigned* bar = (unsigned*)(load_params().ws + OFF_BAR); (void)xb_add(&bar[XB_XCNT(xb_xcc_id())], 1u); }
  PHASE(1) PHASE(2) PHASE(3) PHASE(4) PHASE(5) PHASE(6) PHASE(7)
  PHASE(8) PHASE(9) PHASE(10) PHASE(11) PHASE(12) PHASE(13) PHASE(14)
  run_phase<15>(p, smem);
#if PROBE_S >= 0
  if (blockIdx.x == 0 && threadIdx.x == 0) {
    const unsigned long long t1 = wall_clock64();
    const unsigned long long lim = 4ull * pst[0];
    while (wall_clock64() - t1 < lim) { __builtin_amdgcn_s_sleep(32); }
  }
#endif
}

extern "C" void kernel_launch(void* const* d_in, const int* in_sizes, int n_in, void* d_out, int out_size, void* d_ws,
                              size_t ws_size, hipStream_t stream) {
  static int grid_blocks = 0;
  if (!grid_blocks) {
    int dev = 0, cus = 0, per_cu = 0;
    hipGetDevice(&dev);
    hipDeviceGetAttribute(&cus, hipDeviceAttributeMultiprocessorCount, dev);
    hipOccupancyMaxActiveBlocksPerMultiprocessor(&per_cu, fwd_megakernel, 256, 0);
    if (per_cu < 1) per_cu = 1;
    if (per_cu > 2) per_cu = 2;
    grid_blocks = (cus * per_cu) & ~7;
  }
  Params p{};
  const float** pp = (const float**)&p;
  for (int i = 0; i < 23; ++i) pp[i] = (const float*)d_in[i];
  p.out = (float*)d_out;
  p.ws = (char*)d_ws;
  void* args[] = {&p};
  hipError_t e = hipLaunchCooperativeKernel((void*)fwd_megakernel, dim3(grid_blocks), dim3(256), args, 0, stream);
  if (e != hipSuccess) fprintf(stderr, "cooperative launch failed: %s (grid %d)\n", hipGetErrorString(e), grid_blocks);
}
```

```cpp
#include <hip/hip_runtime.h>
#include <hip/hip_cooperative_groups.h>
#include <stdint.h>
#include <stdio.h>
namespace cg = cooperative_groups;

#ifndef ONE_LAUNCH
#define ONE_LAUNCH 1
#endif

#ifndef PROBE_S
#define PROBE_S -1
#endif
#define DI __device__ __forceinline__
typedef unsigned short bf16_t;
using bf16x8 = __attribute__((ext_vector_type(8))) short;
using s16x4 = __attribute__((ext_vector_type(4))) short;
using f32x16 = __attribute__((ext_vector_type(16))) float;
#define MFMA(a, b, c) __builtin_amdgcn_mfma_f32_32x32x16_bf16((a), (b), (c), 0, 0, 0)

constexpr int R_ = 17408;
constexpr int RL_ = 16384;
constexpr int NCK = 136;

constexpr size_t SZ_WIN = (size_t)5632 * 1024 * 2;
constexpr size_t SZ_WOUT = (size_t)1024 * 2048 * 2;
constexpr size_t SZ_PW = (size_t)512 * 512 * 2;
constexpr size_t SZ_MODS = (size_t)2 * 5 * 3072 * 4;
constexpr size_t SZ_XC = (size_t)1024 * 1024 * 4;
constexpr size_t SZ_RSTD = (size_t)R_ * 2 * 4;
constexpr size_t SZ_CDEC = (size_t)NCK * 32 * 4 + 256 - ((size_t)NCK * 32 * 4) % 256;
constexpr size_t SZ_R512 = (size_t)R_ * 512 * 2;
constexpr size_t OFF_WIN = 0;
constexpr size_t OFF_WOUT = OFF_WIN + SZ_WIN;
constexpr size_t OFF_PW = OFF_WOUT + SZ_WOUT;
constexpr size_t OFF_MODS = OFF_PW + SZ_PW;
constexpr size_t OFF_XC = OFF_MODS + SZ_MODS;
constexpr size_t OFF_RSTD = OFF_XC + SZ_XC;
constexpr size_t OFF_CDEC = OFF_RSTD + SZ_RSTD;
constexpr size_t OFF_H = OFF_CDEC + SZ_CDEC;
constexpr size_t OFF_XBC = OFF_H + 2 * SZ_R512;
constexpr size_t OFF_GLU = OFF_XBC + 3 * SZ_R512;
constexpr size_t OFF_ST = OFF_XBC;
constexpr size_t OFF_Z = OFF_GLU + SZ_R512;
constexpr size_t OFF_DT = OFF_Z + 2 * SZ_R512;
constexpr size_t OFF_CS = OFF_DT + (size_t)R_ * 32 * 4;
constexpr size_t OFF_Q = OFF_CS + (size_t)R_ * 32 * 4;
constexpr size_t OFF_KV = OFF_Q + SZ_R512;
constexpr size_t OFF_AG = OFF_KV + SZ_R512 / 2;
constexpr size_t OFF_CG = OFF_AG + SZ_R512;
constexpr size_t OFF_BC = OFF_CG + SZ_R512;
constexpr size_t OFF_HDN = OFF_BC + SZ_R512;
constexpr size_t WS_TOTAL = OFF_HDN + SZ_R512;
constexpr size_t OFF_BAR = WS_TOTAL;
static_assert(OFF_BAR + 16384 <= (size_t)256 * 1024 * 1024, "workspace too large");

struct Params {
  const float *x, *c, *ctx, *c_ctx, *w_mod, *b_mod, *norm_w, *w_in, *ssd_conv_w, *ssd_conv_b, *ssd_dt_bias, *ssd_a_log,
      *ssd_d, *ssd_norm_w, *attn_sink, *conv_dw_w, *conv_dw_b, *conv_ln_w, *conv_ln_b, *conv_pw_w, *conv_pw_b, *w_out,
      *final_norm_w;
  float* out;
  char* ws;
};


DI Params load_params() {
  typedef const char __attribute__((address_space(4)))* kptr_t;
  typedef const float* const __attribute__((address_space(4)))* kfld_t;
  size_t off = 0;
  asm volatile("" : "+s"(off));
  kptr_t base = (kptr_t)__builtin_amdgcn_kernarg_segment_ptr() + off;
  Params p;
  const float** pp = (const float**)&p;
#pragma unroll
  for (int i = 0; i < 25; ++i) pp[i] = *(kfld_t)(base + 8 * i);
  return p;
}

#define XB_TMO      128
#define XB_XCNT(j)  (256  + 64 * (j))
#define XB_XSUB(j)  (1280 + 64 * (j))
#define XB_XGEN(j)  (2304 + 64 * (j))
#define XB_TOP      3328
#define XB_TOPGEN   3392
#define XCD_BAR_WORDS 3456
#define XB_SPIN_CAP (1u << 18)
#define LAS __attribute__((address_space(3)))
DI unsigned xb_ld(unsigned* p)              { return __hip_atomic_load(p, __ATOMIC_RELAXED, __HIP_MEMORY_SCOPE_AGENT); }
DI unsigned xb_add(unsigned* p, unsigned v) { return __hip_atomic_fetch_add(p, v, __ATOMIC_RELAXED, __HIP_MEMORY_SCOPE_AGENT); }
DI unsigned xb_xcc_id() { return (unsigned)__builtin_amdgcn_s_getreg((3 << 11) | 20) & 0xFu; }
#define XB_SPIN(cond, bar) do { unsigned _sp = 0; while (cond) { __builtin_amdgcn_s_sleep(1); \
    if ((++_sp & 255u) == 0u) { if (xb_ld(&(bar)[XB_TMO])) break; if (_sp > XB_SPIN_CAP) { atomicAdd(&(bar)[XB_TMO], 1u); break; } } } } while (0)

DI void xcd_barrier_complete(unsigned* bar, unsigned x, unsigned& nloc, unsigned& nx) {
  const unsigned G = gridDim.x * gridDim.y * gridDim.z;
  unsigned sum, cnt, mine, sp = 0u;
  for (;;) {
    sum = 0u; cnt = 0u; mine = 0u;
#pragma unroll
    for (unsigned j = 0; j < 16; ++j) { const unsigned c = xb_ld(&bar[XB_XCNT(j)]); sum += c; cnt += (c > 0u) ? 1u : 0u; mine = (j == x) ? c : mine; }
    if (sum == G) break;
    __builtin_amdgcn_s_sleep(1);
    if ((++sp & 255u) == 0u) { if (xb_ld(&bar[XB_TMO])) break; if (sp > XB_SPIN_CAP) { atomicAdd(&bar[XB_TMO], 1u); break; } }
  }
  nloc = mine > 0u ? mine : 1u; nx = cnt > 0u ? cnt : 1u;
}

DI void xcd_barrier(volatile LAS unsigned* st) {
  asm volatile("s_waitcnt vmcnt(0)" ::: "memory");
  __syncthreads();
  if (threadIdx.x == 0) {
    const Params pb = load_params();
    unsigned* bar = (unsigned*)(pb.ws + OFF_BAR);
    const unsigned x = xb_xcc_id();
    __builtin_amdgcn_s_waitcnt(0);
    unsigned nloc = st[0], nx = st[1];
    if (nloc == 0u) { xcd_barrier_complete(bar, x, nloc, nx); st[0] = nloc; st[1] = nx; }
    const unsigned old = xb_add(&bar[XB_XSUB(x)], 1u);
    const unsigned gen = old / nloc;
    if (old + 1u == (gen + 1u) * nloc) {
      __builtin_amdgcn_fence(__ATOMIC_RELEASE, "agent");
      asm volatile("s_waitcnt vmcnt(0)" ::: "memory");
      const unsigned og = xb_add(&bar[XB_TOP], 1u);
      const unsigned tg = og / nx;
      if (og + 1u == (tg + 1u) * nx) xb_add(&bar[XB_TOPGEN], 1u);
      else XB_SPIN(xb_ld(&bar[XB_TOPGEN]) == tg, bar);
      __builtin_amdgcn_fence(__ATOMIC_ACQUIRE, "agent");
      xb_add(&bar[XB_XGEN(x)], 1u);
      asm volatile("s_waitcnt vmcnt(0)" ::: "memory");
    } else {
      XB_SPIN(xb_ld(&bar[XB_XGEN(x)]) == gen, bar);
      __builtin_amdgcn_fence(__ATOMIC_ACQUIRE, "agent");
      asm volatile("s_waitcnt vmcnt(0)" ::: "memory");
    }
  }
  __syncthreads();
}

typedef __bf16 nbf16x2_t __attribute__((ext_vector_type(2)));
typedef float nf32x2_t __attribute__((ext_vector_type(2)));
DI unsigned short f2bf(float x) { const __bf16 r = (__bf16)x; return __builtin_bit_cast(unsigned short, r); }
DI float bf2f(unsigned short b) { return __uint_as_float(((unsigned)b) << 16); }
DI unsigned pack2(float a, float b) { const nf32x2_t v = {a, b}; const nbf16x2_t r = __builtin_convertvector(v, nbf16x2_t); return __builtin_bit_cast(unsigned, r); }
DI float lo2f(unsigned u) { return __uint_as_float(u << 16); }
DI float hi2f(unsigned u) { return __uint_as_float(u & 0xffff0000u); }
DI float silu_f(float x) { return x / (1.f + __expf(-x)); }
DI float sigmoid_f(float x) { return 1.f / (1.f + __expf(-x)); }
DI int crow(int reg, int h) { return (reg & 3) + 8 * (reg >> 2) + 4 * h; }

DI bf16x8 tr_frag(const bf16_t* s, int ld, int row_lo, int row_hi, int col0) {
  const int lane = threadIdx.x & 63;
  const int i16 = lane & 15, q = i16 >> 2, pp = i16 & 3, blk = (lane >> 4) & 1;
  const unsigned a0 = (unsigned)(size_t)(s + (row_lo + q) * ld + col0 + 16 * blk + 4 * pp);
  const unsigned a1 = (unsigned)(size_t)(s + (row_hi + q) * ld + col0 + 16 * blk + 4 * pp);
  s16x4 lo, hi;
  asm volatile("ds_read_b64_tr_b16 %0, %2\n\tds_read_b64_tr_b16 %1, %3\n\ts_waitcnt lgkmcnt(0)"
               : "=&v"(lo), "=&v"(hi) : "v"(a0), "v"(a1) : "memory");
  return __builtin_shufflevector(lo, hi, 0, 1, 2, 3, 4, 5, 6, 7);
}

struct GemmS { bf16_t a[2][128][40]; bf16_t b[2][128][40]; };

template <class AF, class BF>
DI void gemm_core(f32x16 (&acc)[2][2], GemmS* s, AF aptr, BF bptr, int nk) {
  int tid = threadIdx.x; asm volatile("" : "+v"(tid)); const int lane = tid & 63, wave = tid >> 6, wr = wave >> 1, wc = wave & 1;
  const int r0 = tid >> 2, kv = tid & 3;
  const int fr = lane & 31, fh = lane >> 5;
  uint4 ra0 = *(const uint4*)aptr(0, r0, kv), ra1 = *(const uint4*)aptr(0, r0 + 64, kv);
  uint4 rb0 = *(const uint4*)bptr(0, r0, kv), rb1 = *(const uint4*)bptr(0, r0 + 64, kv);
  *(uint4*)&s->a[0][r0][kv * 8] = ra0; *(uint4*)&s->a[0][r0 + 64][kv * 8] = ra1;
  *(uint4*)&s->b[0][r0][kv * 8] = rb0; *(uint4*)&s->b[0][r0 + 64][kv * 8] = rb1;
  __syncthreads();
#pragma unroll 1
  for (int kt = 0; kt < nk; ++kt) {
    const int buf = kt & 1;
    if (kt + 1 < nk) {
      ra0 = *(const uint4*)aptr(kt + 1, r0, kv); ra1 = *(const uint4*)aptr(kt + 1, r0 + 64, kv);
      rb0 = *(const uint4*)bptr(kt + 1, r0, kv); rb1 = *(const uint4*)bptr(kt + 1, r0 + 64, kv);
    }
#pragma unroll
    for (int ks = 0; ks < 2; ++ks) {
      bf16x8 af[2], bq[2];
#pragma unroll
      for (int i = 0; i < 2; ++i) af[i] = *(const bf16x8*)&s->a[buf][wr * 64 + i * 32 + fr][ks * 16 + fh * 8];
#pragma unroll
      for (int j = 0; j < 2; ++j) bq[j] = *(const bf16x8*)&s->b[buf][wc * 64 + j * 32 + fr][ks * 16 + fh * 8];
#pragma unroll
      for (int i = 0; i < 2; ++i)
#pragma unroll
        for (int j = 0; j < 2; ++j) acc[i][j] = MFMA(af[i], bq[j], acc[i][j]);
    }
    if (kt + 1 < nk) {
      *(uint4*)&s->a[buf ^ 1][r0][kv * 8] = ra0; *(uint4*)&s->a[buf ^ 1][r0 + 64][kv * 8] = ra1;
      *(uint4*)&s->b[buf ^ 1][r0][kv * 8] = rb0; *(uint4*)&s->b[buf ^ 1][r0 + 64][kv * 8] = rb1;
    }
    __syncthreads();
  }
}


struct GemmS2 { bf16_t a[128][72]; bf16_t b[128][72]; };
DI void g2_compute(f32x16 (&acc)[2][2], const GemmS2* s, int wr, int wc, int fr, int fh) {
#pragma unroll
  for (int ks = 0; ks < 4; ++ks) {
    bf16x8 af[2], bq[2];
#pragma unroll
    for (int i = 0; i < 2; ++i) af[i] = *(const bf16x8*)&s->a[wr * 64 + i * 32 + fr][ks * 16 + fh * 8];
#pragma unroll
    for (int j = 0; j < 2; ++j) bq[j] = *(const bf16x8*)&s->b[wc * 64 + j * 32 + fr][ks * 16 + fh * 8];
#pragma unroll
    for (int i = 0; i < 2; ++i)
#pragma unroll
      for (int j = 0; j < 2; ++j) acc[i][j] = MFMA(af[i], bq[j], acc[i][j]);
  }
}

template <class AF, class BF, class HK>
DI void gemm_core2(f32x16 (&acc)[2][2], GemmS2* s, AF aptr, BF bptr, int nk, HK hook) {
  int tid = threadIdx.x; asm volatile("" : "+v"(tid));
  const int lane = tid & 63, wave = tid >> 6, wr = wave >> 1, wc = wave & 1;
  const int r0 = tid >> 3, kc = tid & 7;
  const int fr = lane & 31, fh = lane >> 5;
  uint4 p0a0, p0a1, p0a2, p0a3, p0b0, p0b1, p0b2, p0b3, p1a0, p1a1, p1a2, p1a3, p1b0, p1b1, p1b2, p1b3;
#define G2_LOAD(S, KT) { \
    S##a0 = *(const uint4*)aptr((KT), r0, kc);      S##b0 = *(const uint4*)bptr((KT), r0, kc); \
    S##a1 = *(const uint4*)aptr((KT), r0 + 32, kc); S##b1 = *(const uint4*)bptr((KT), r0 + 32, kc); \
    S##a2 = *(const uint4*)aptr((KT), r0 + 64, kc); S##b2 = *(const uint4*)bptr((KT), r0 + 64, kc); \
    S##a3 = *(const uint4*)aptr((KT), r0 + 96, kc); S##b3 = *(const uint4*)bptr((KT), r0 + 96, kc); }
#define G2_STORE(S) { \
    *(uint4*)&s->a[r0][kc * 8] = S##a0;      *(uint4*)&s->b[r0][kc * 8] = S##b0; \
    *(uint4*)&s->a[r0 + 32][kc * 8] = S##a1; *(uint4*)&s->b[r0 + 32][kc * 8] = S##b1; \
    *(uint4*)&s->a[r0 + 64][kc * 8] = S##a2; *(uint4*)&s->b[r0 + 64][kc * 8] = S##b2; \
    *(uint4*)&s->a[r0 + 96][kc * 8] = S##a3; *(uint4*)&s->b[r0 + 96][kc * 8] = S##b3; }
#define G2_COMPUTE() g2_compute(acc, s, wr, wc, fr, fh);
  G2_LOAD(p0, 0)
  G2_LOAD(p1, 1)
  G2_STORE(p0)
  if (nk > 2) G2_LOAD(p0, 2)
  __syncthreads();
#pragma unroll 1
  for (int kt = 0; kt < nk; kt += 2) {
    hook(kt);
    G2_COMPUTE()
    __syncthreads();
    G2_STORE(p1)
    if (kt + 3 < nk) G2_LOAD(p1, kt + 3)
    __syncthreads();
    hook(kt + 1);
    G2_COMPUTE()
    __syncthreads();
    if (kt + 2 < nk) {
      G2_STORE(p0)
      if (kt + 4 < nk) G2_LOAD(p0, kt + 4)
    }
    __syncthreads();
  }
#undef G2_LOAD
#undef G2_STORE
#undef G2_COMPUTE
}


struct GemmS3 { bf16_t a[128][72]; bf16_t b[256][72]; };

template <class AF, class BF>
DI void gemm_core3(f32x16 (&acc)[2][4], GemmS3* s, AF aptr, BF bptr, int nk) {
  int tid = threadIdx.x; asm volatile("" : "+v"(tid));
  const int lane = tid & 63, wave = tid >> 6, wr = wave >> 1, wc = wave & 1;
  const int r0 = tid >> 3, kc = tid & 7;
  const int fr = lane & 31, fh = lane >> 5;
  uint4 a0, a1, a2, a3, b0, b1, b2, b3, b4, b5, b6, b7;
#define G3_LOAD(KT) { \
    a0 = *(const uint4*)aptr((KT), r0, kc);       a1 = *(const uint4*)aptr((KT), r0 + 32, kc); \
    a2 = *(const uint4*)aptr((KT), r0 + 64, kc);  a3 = *(const uint4*)aptr((KT), r0 + 96, kc); \
    b0 = *(const uint4*)bptr((KT), r0, kc);       b1 = *(const uint4*)bptr((KT), r0 + 32, kc); \
    b2 = *(const uint4*)bptr((KT), r0 + 64, kc);  b3 = *(const uint4*)bptr((KT), r0 + 96, kc); \
    b4 = *(const uint4*)bptr((KT), r0 + 128, kc); b5 = *(const uint4*)bptr((KT), r0 + 160, kc); \
    b6 = *(const uint4*)bptr((KT), r0 + 192, kc); b7 = *(const uint4*)bptr((KT), r0 + 224, kc); }
#define G3_STORE() { \
    *(uint4*)&s->a[r0][kc * 8] = a0;       *(uint4*)&s->a[r0 + 32][kc * 8] = a1; \
    *(uint4*)&s->a[r0 + 64][kc * 8] = a2;  *(uint4*)&s->a[r0 + 96][kc * 8] = a3; \
    *(uint4*)&s->b[r0][kc * 8] = b0;       *(uint4*)&s->b[r0 + 32][kc * 8] = b1; \
    *(uint4*)&s->b[r0 + 64][kc * 8] = b2;  *(uint4*)&s->b[r0 + 96][kc * 8] = b3; \
    *(uint4*)&s->b[r0 + 128][kc * 8] = b4; *(uint4*)&s->b[r0 + 160][kc * 8] = b5; \
    *(uint4*)&s->b[r0 + 192][kc * 8] = b6; *(uint4*)&s->b[r0 + 224][kc * 8] = b7; }
  G3_LOAD(0)
  G3_STORE()
  __syncthreads();
#pragma unroll 1
  for (int kt = 0; kt < nk; ++kt) {
    if (kt + 1 < nk) G3_LOAD(kt + 1)
#pragma unroll
    for (int ks = 0; ks < 4; ++ks) {
      bf16x8 af[2], bq[4];
#pragma unroll
      for (int i = 0; i < 2; ++i) af[i] = *(const bf16x8*)&s->a[wr * 64 + i * 32 + fr][ks * 16 + fh * 8];
#pragma unroll
      for (int j = 0; j < 4; ++j) bq[j] = *(const bf16x8*)&s->b[wc * 128 + j * 32 + fr][ks * 16 + fh * 8];
#pragma unroll
      for (int i = 0; i < 2; ++i)
#pragma unroll
        for (int j = 0; j < 4; ++j) acc[i][j] = MFMA(af[i], bq[j], acc[i][j]);
    }
    __syncthreads();
    if (kt + 1 < nk) G3_STORE()
    __syncthreads();
  }
#undef G3_LOAD
#undef G3_STORE
}

template <class EPI>
DI void epilogue_lds2(f32x16 (&acc)[2][4], char* smem, int sub, EPI epi) {
  float* T = (float*)smem;
  int tid = threadIdx.x; asm volatile("" : "+v"(tid));
  const int lane = tid & 63, wave = tid >> 6, wr = wave >> 1, wc = wave & 1, fr = lane & 31, fh = lane >> 5;
#pragma unroll
  for (int i = 0; i < 2; ++i) {
    if (wc == sub) {
#pragma unroll
      for (int j = 0; j < 4; ++j)
#pragma unroll
        for (int r = 0; r < 16; ++r) T[(wr * 32 + crow(r, fh)) * 132 + j * 32 + fr] = acc[i][j][r];
    }
    __syncthreads();
#pragma unroll 2
    for (int e = tid; e < 2048; e += 256) {
      const int tr = e >> 5, c4 = (e & 31) * 4;
      const float4 v = *(const float4*)&T[tr * 132 + c4];
      epi((tr >> 5) * 64 + i * 32 + (tr & 31), c4, v);
    }
    __syncthreads();
  }
}

DI bool xcd_tile(int step, int nM, int nN, int& mt, int& nt) {
  const int xcd = blockIdx.x & 7, nloc = gridDim.x >> 3;
  const int j = (blockIdx.x >> 3) + step * nloc;
  const int mloc = nM >> 3;
  if ((gridDim.x & 7) != 0 || j >= mloc * nN) return false;
  const int per = 8 * nN;
  const int gm = j / per, rem = j - gm * per;
  const int hgt = min(8, mloc - gm * 8);
  const int a = rem % hgt;
  nt = rem / hgt;
  mt = (gm * 8 + a) * 8 + xcd;
  return true;
}

DI void zero_acc(f32x16 (&acc)[2][2]) {
#pragma unroll
  for (int i = 0; i < 2; ++i)
#pragma unroll
    for (int j = 0; j < 2; ++j)
#pragma unroll
      for (int r = 0; r < 16; ++r) acc[i][j][r] = 0.f;
}

template <class EPI>
DI void epilogue_lds(f32x16 (&acc)[2][2], char* smem, EPI epi) {
  float* T = (float*)smem;
  int tid = threadIdx.x; asm volatile("" : "+v"(tid)); const int lane = tid & 63, wave = tid >> 6, wr = wave >> 1, wc = wave & 1, fr = lane & 31, fh = lane >> 5;
#pragma unroll
  for (int i = 0; i < 2; ++i) {
#pragma unroll
    for (int j = 0; j < 2; ++j)
#pragma unroll
      for (int r = 0; r < 16; ++r) T[(wr * 32 + crow(r, fh)) * 132 + wc * 64 + j * 32 + fr] = acc[i][j][r];
    __syncthreads();
#pragma unroll 2
    for (int e = tid; e < 2048; e += 256) {
      const int tr = e >> 5, c4 = (e & 31) * 4;
      const float4 v = *(const float4*)&T[tr * 132 + c4];
      epi((tr >> 5) * 64 + i * 32 + (tr & 31), c4, v);
    }
    __syncthreads();
  }
}

DI void phase_mods(const Params& p_in, char* smem) {
  const Params p = load_params();

  float* ssc = (float*)smem;
  float* red = (float*)(smem + 20480);
  float* mods = (float*)(p.ws + OFF_MODS);
  int tid = threadIdx.x; asm volatile("" : "+v"(tid));
  if (blockIdx.x == 0) { unsigned* bar = (unsigned*)(p.ws + OFF_BAR); for (int i = tid; i < XCD_BAR_WORDS; i += 256) bar[i] = 0u; }
  for (int it = blockIdx.x; it < 192; it += gridDim.x) {
    const int l = it / 96, col0 = (it % 96) * 32;
    __syncthreads();
    for (int e = tid; e < 5120; e += 256) {
      const int v = e >> 10, k = e & 1023;
      const float cv = (v < 4) ? p.c[v * 1024 + k] : p.c_ctx[k];
      ssc[e] = silu_f(cv);
    }
    __syncthreads();
    const int col = tid & 31, kg = tid >> 5;
    float a[5] = {0.f, 0.f, 0.f, 0.f, 0.f};
    const float* w = p.w_mod + (size_t)l * 1024 * 3072 + col0 + col;
    for (int k = kg * 128; k < kg * 128 + 128; k += 32) {
      float wv[32];
#pragma unroll
      for (int u = 0; u < 32; ++u) wv[u] = w[(size_t)(k + u) * 3072];
#pragma unroll
      for (int u = 0; u < 32; ++u)
#pragma unroll
        for (int v = 0; v < 5; ++v) a[v] += ssc[v * 1024 + k + u] * wv[u];
    }
#pragma unroll
    for (int v = 0; v < 5; ++v) red[(kg * 5 + v) * 32 + col] = a[v];
    __syncthreads();
    for (int e = tid; e < 160; e += 256) {
      const int v = e >> 5, cc = e & 31;
      float sum = p.b_mod[l * 3072 + col0 + cc];
      for (int g = 0; g < 8; ++g) sum += red[(g * 5 + v) * 32 + cc];
      mods[(l * 5 + v) * 3072 + col0 + cc] = sum;
    }
  }
}

DI int win_colmap(int n) {
  if (n < 2560) return n;
  if (n < 3840) return n + 32;
  if (n < 4864) {
    const int j = n - 3840, q64 = j >> 6, w = j & 63;
    return (w < 32) ? (3872 + q64 * 32 + w) : (3872 + 512 + q64 * 32 + (w - 32));
  }
  if (n < 5376) return n + 32;
  if (n < 5408) return n - 5376 + 2560;
  return -1;
}

DI void transpose_tile(const float* src, int ldsrc, int kind, const float* rowscale, bf16_t* dst, int lddst, int n0, int k0, float* tile) {
  int tid = threadIdx.x; asm volatile("" : "+v"(tid));
  __syncthreads();
  {
    const int c4 = (tid & 15) * 4, rr = tid >> 4;
    const int n = (kind == 0) ? win_colmap(n0 + c4) : (n0 + c4);
#pragma unroll
    for (int ps = 0; ps < 4; ++ps) {
      const int r = rr + ps * 16, k = k0 + r;
      float4 v = make_float4(0.f, 0.f, 0.f, 0.f);
      if (n >= 0) v = *(const float4*)(src + (size_t)k * ldsrc + n);
      if (rowscale != nullptr && k < 1024) { const float s = rowscale[k]; v.x *= s; v.y *= s; v.z *= s; v.w *= s; }
      tile[r * 65 + c4] = v.x; tile[r * 65 + c4 + 1] = v.y; tile[r * 65 + c4 + 2] = v.z; tile[r * 65 + c4 + 3] = v.w;
    }
  }
  __syncthreads();
  {
    const int k8 = (tid & 7) * 8, nn = tid >> 3;
#pragma unroll
    for (int ps = 0; ps < 2; ++ps) {
      const int r = nn + ps * 32;
      uint4 o;
      o.x = pack2(tile[(k8 + 0) * 65 + r], tile[(k8 + 1) * 65 + r]);
      o.y = pack2(tile[(k8 + 2) * 65 + r], tile[(k8 + 3) * 65 + r]);
      o.z = pack2(tile[(k8 + 4) * 65 + r], tile[(k8 + 5) * 65 + r]);
      o.w = pack2(tile[(k8 + 6) * 65 + r], tile[(k8 + 7) * 65 + r]);
      *(uint4*)(dst + (size_t)(n0 + r) * lddst + k0 + k8) = o;
    }
  }
}

DI void phase_prep(const Params& p_in, int l, char* smem) {
  const Params p = load_params();

  int tid = threadIdx.x; asm volatile("" : "+v"(tid)); const int lane = tid & 63, wave = tid >> 6;
  const float* mods = (const float*)(p.ws + OFF_MODS);
  bf16_t* H = (bf16_t*)(p.ws + OFF_H);
  const int NT_WIN = 88 * 16, NT_WOUT = 16 * 32, NT_PW = 64, NT_CONV = NT_WIN + NT_WOUT + NT_PW;
  const int NT = NT_CONV + R_ / 8;
  for (int it = blockIdx.x; it < NT; it += gridDim.x) {
    if (l == 1 && (it < NT_WIN || (it >= NT_WIN + NT_WOUT && it < NT_CONV))) continue;
    if (it < NT_WIN) {
      transpose_tile(p.w_in + (size_t)l * 1024 * 5408, 5408, 0, nullptr, (bf16_t*)(p.ws + OFF_WIN), 1024, (it / 16) * 64, (it % 16) * 64, (float*)smem);
    } else if (it < NT_WIN + NT_WOUT) {
      const int t = it - NT_WIN;
      transpose_tile(p.w_out + (size_t)l * 2048 * 1024, 1024, 1, p.ssd_norm_w + l * 1024, (bf16_t*)(p.ws + OFF_WOUT), 2048, (t / 32) * 64, (t % 32) * 64, (float*)smem);
    } else if (it < NT_CONV) {
      const int t = it - NT_WIN - NT_WOUT;
      transpose_tile(p.conv_pw_w + (size_t)l * 512 * 512, 512, 1, nullptr, (bf16_t*)(p.ws + OFF_PW), 512, (t / 8) * 64, (t % 8) * 64, (float*)smem);
    } else {
      const int rho0 = (it - NT_CONV) * 8 + wave * 2;
      const float* xs0;
      if (l == 0) xs0 = (rho0 < RL_) ? (p.x + (size_t)rho0 * 1024) : (p.ctx + (size_t)(rho0 - RL_) * 1024);
      else xs0 = (rho0 < RL_) ? (p.out + (size_t)rho0 * 1024) : ((const float*)(p.ws + OFF_XC) + (size_t)(rho0 - RL_) * 1024);
      const int v = (rho0 < RL_) ? (rho0 >> 12) : 4;
      const float* md = mods + (l * 5 + v) * 3072;
      float4 xv[2][4], nwv[4], shv[4], scv4[4];
#pragma unroll
      for (int i = 0; i < 4; ++i) {
        const int cidx = lane * 4 + i * 256;
        xv[0][i] = *(const float4*)(xs0 + cidx);
        xv[1][i] = *(const float4*)(xs0 + 1024 + cidx);
        nwv[i] = *(const float4*)(p.norm_w + l * 1024 + cidx);
        shv[i] = *(const float4*)(md + cidx);
        scv4[i] = *(const float4*)(md + 1024 + cidx);
      }
#pragma unroll
      for (int q = 0; q < 2; ++q) {
        float ss = 0.f;
#pragma unroll
        for (int i = 0; i < 4; ++i) ss += xv[q][i].x * xv[q][i].x + xv[q][i].y * xv[q][i].y + xv[q][i].z * xv[q][i].z + xv[q][i].w * xv[q][i].w;
#pragma unroll
        for (int o = 32; o >= 1; o >>= 1) ss += __shfl_xor(ss, o);
        const float rs = rsqrtf(ss * (1.f / 1024.f) + 1e-6f);
#pragma unroll
        for (int i = 0; i < 4; ++i) {
          const int cidx = lane * 4 + i * 256;
          const float4 nw = nwv[i], sh = shv[i], sc = scv4[i];
          uint2 o;
          o.x = pack2(xv[q][i].x * rs * nw.x * (1.f + sc.x) + sh.x, xv[q][i].y * rs * nw.y * (1.f + sc.y) + sh.y);
          o.y = pack2(xv[q][i].z * rs * nw.z * (1.f + sc.z) + sh.z, xv[q][i].w * rs * nw.w * (1.f + sc.w) + sh.w);
          *(uint2*)(H + (size_t)(rho0 + q) * 1024 + cidx) = o;
        }
      }
    }
  }
}

DI void phase_inproj(const Params& p_in, char* smem) {
  const Params p = load_params();
  int tid = threadIdx.x; asm volatile("" : "+v"(tid)); const int wave = tid >> 6, wc = wave & 1;
  const bf16_t* H = (const bf16_t*)(p.ws + OFF_H);
  const bf16_t* W = (const bf16_t*)(p.ws + OFF_WIN);
  for (int step = 0;; ++step) {
    int mt, nt2;
    if (!xcd_tile(step, NCK, 22, mt, nt2)) break;
    f32x16 acc[2][4];
#pragma unroll
    for (int i = 0; i < 2; ++i)
#pragma unroll
      for (int j = 0; j < 4; ++j)
#pragma unroll
        for (int r = 0; r < 16; ++r) acc[i][j][r] = 0.f;
    const bf16_t* Ab = H + (size_t)mt * 128 * 1024;
    const bf16_t* Bb = W + (size_t)nt2 * 256 * 1024;
    gemm_core3(acc, (GemmS3*)smem,
               [&](int kt, int r, int kv) { return Ab + (size_t)r * 1024 + kt * 64 + kv * 8; },
               [&](int kt, int r, int kv) { return Bb + (size_t)r * 1024 + kt * 64 + kv * 8; }, 16);
    const int row0 = mt * 128;
    {
      const int ntw = nt2 * 2 + wc;
      if (ntw >= 30 && ntw < 38) {
#pragma unroll
        for (int i = 0; i < 2; ++i)
#pragma unroll
          for (int r = 0; r < 16; ++r) {
            acc[i][0][r] = acc[i][0][r] * sigmoid_f(acc[i][1][r]);
            acc[i][2][r] = acc[i][2][r] * sigmoid_f(acc[i][3][r]);
          }
      }
    }
#pragma unroll 1
    for (int sub = 0; sub < 2; ++sub) {
      const int nt = nt2 * 2 + sub;
      if (nt >= 43) break;
      if (nt >= 30 && nt < 38) {
        bf16_t* G = (bf16_t*)(p.ws + OFF_GLU);
        const int cb0 = (nt - 30) * 64;
        epilogue_lds2(acc, smem, sub, [&](int rl, int c4, float4 v) {
          if ((c4 & 32) == 0) {
            uint2 o; o.x = pack2(v.x, v.y); o.y = pack2(v.z, v.w);
            *(uint2*)(G + (size_t)(row0 + rl) * 512 + cb0 + (c4 >> 6) * 32 + (c4 & 31)) = o;
          }
        });
      } else if (nt == 42) {
        float* DT = (float*)(p.ws + OFF_DT);
        epilogue_lds2(acc, smem, sub, [&](int rl, int c4, float4 v) {
          if (c4 < 32) *(float4*)(DT + (size_t)(row0 + rl) * 32 + c4) = v;
        });
      } else {
        bf16_t* dst; int ld, cb;
        if (nt < 12) { dst = (bf16_t*)(p.ws + OFF_XBC); ld = 1536; cb = nt * 128; }
        else if (nt < 20) { dst = (bf16_t*)(p.ws + OFF_Z); ld = 1024; cb = nt * 128 - 1536; }
        else if (nt < 24) { dst = (bf16_t*)(p.ws + OFF_Q); ld = 512; cb = nt * 128 - 2560; }
        else if (nt < 26) { dst = (bf16_t*)(p.ws + OFF_KV); ld = 256; cb = nt * 128 - 3072; }
        else if (nt < 30) { dst = (bf16_t*)(p.ws + OFF_AG); ld = 512; cb = nt * 128 - 3328; }
        else { dst = (bf16_t*)(p.ws + OFF_CG); ld = 512; cb = nt * 128 - 4864; }
        epilogue_lds2(acc, smem, sub, [&](int rl, int c4, float4 v) {
          uint2 o; o.x = pack2(v.x, v.y); o.y = pack2(v.z, v.w);
          *(uint2*)(dst + (size_t)(row0 + rl) * ld + cb + c4) = o;
        });
      }
    }
  }
}

DI void phase_local(const Params& p_in, int l, char* smem) {
  const Params p = load_params();

  int tid = threadIdx.x; asm volatile("" : "+v"(tid)); const int lane = tid & 63;
  const bf16_t* XBC = (const bf16_t*)(p.ws + OFF_XBC);
  bf16_t* XS = (bf16_t*)(p.ws + OFF_H);
  bf16_t* BC = (bf16_t*)(p.ws + OFF_BC);
  float* DT = (float*)(p.ws + OFF_DT);
  float* CS = (float*)(p.ws + OFF_CS);
  const bf16_t* GLU = (const bf16_t*)(p.ws + OFF_GLU);
  bf16_t* HDN = (bf16_t*)(p.ws + OFF_HDN);
  bf16_t* Q = (bf16_t*)(p.ws + OFF_Q);
  bf16_t* KV = (bf16_t*)(p.ws + OFF_KV);
  { float* SSQ = (float*)(p.ws + OFF_RSTD); for (int i = blockIdx.x * 256 + tid; i < R_ * 2; i += gridDim.x * 256) SSQ[i] = 0.f; }
  const int N_CONV = (R_ / 4) * 192 / 256;
  const int N_DT = NCK;
  const int N_CF = R_ / 16;
  const int N_ROPE = RL_ * 40 / 256;
  const int N_QC = 1024 * 256 / 256;
  const int NT = N_CF + N_DT + N_CONV + N_ROPE + N_QC;
  for (int it0 = blockIdx.x; it0 < NT; it0 += gridDim.x) {
    int it = it0;
    if (it < N_CF) {
      float* sst = (float*)smem;
      unsigned* sIn = (unsigned*)(smem + 256);
      const int row0 = it * 16;
      const int seq0 = (row0 < RL_) ? (row0 & ~4095) : (RL_ + ((row0 - RL_) & ~255));
      const int slen = (row0 < RL_) ? 4096 : 256;
      const int t0 = row0 - seq0;
      const int c0 = tid * 2;
      __syncthreads();
      if (tid < 32) sst[tid] = 0.f;
      for (int idx = tid; idx < 46 * 64; idx += 256) {
        const int rr = idx >> 6, c16 = idx & 63;
        const int tt = t0 - 15 + rr;
        uint4 val = make_uint4(0u, 0u, 0u, 0u);
        if (tt >= 0 && tt < slen) val = *(const uint4*)(GLU + (size_t)(seq0 + tt) * 512 + c16 * 8);
        *(uint4*)&sIn[rr * 256 + c16 * 4] = val;
      }
      float w0[31], w1[31];
#pragma unroll
      for (int k = 0; k < 31; ++k) {
        const float2 wv = *(const float2*)(p.conv_dw_w + ((size_t)l * 31 + k) * 512 + c0);
        w0[k] = wv.x; w1[k] = wv.y;
      }
      const float2 bv = *(const float2*)(p.conv_dw_b + l * 512 + c0);
      float a0[16], a1[16];
#pragma unroll
      for (int r = 0; r < 16; ++r) { a0[r] = bv.x; a1[r] = bv.y; }
      __syncthreads();
#pragma unroll
      for (int tp = 0; tp < 46; ++tp) {
        const unsigned u = sIn[tp * 256 + tid];
        const float x0 = lo2f(u), x1 = hi2f(u);
#pragma unroll
        for (int r = 0; r < 16; ++r) {
          const int k = tp - r;
          if (k >= 0 && k < 31) { a0[r] += w0[k] * x0; a1[r] += w1[k] * x1; }
        }
        if ((tp & 7) == 7) __builtin_amdgcn_sched_barrier(0);
      }
      {
        float v[32];
#pragma unroll
        for (int r = 0; r < 16; ++r) { v[2 * r] = a0[r] + a1[r]; v[2 * r + 1] = a0[r] * a0[r] + a1[r] * a1[r]; }
#pragma unroll
        for (int i = 0; i < 16; ++i) { const bool up = (lane & 32) != 0; const float keep = up ? v[i + 16] : v[i]; const float send = up ? v[i] : v[i + 16]; v[i] = keep + __shfl_xor(send, 32); }
#pragma unroll
        for (int i = 0; i < 8; ++i) { const bool up = (lane & 16) != 0; const float keep = up ? v[i + 8] : v[i]; const float send = up ? v[i] : v[i + 8]; v[i] = keep + __shfl_xor(send, 16); }
#pragma unroll
        for (int i = 0; i < 4; ++i) { const bool up = (lane & 8) != 0; const float keep = up ? v[i + 4] : v[i]; const float send = up ? v[i] : v[i + 4]; v[i] = keep + __shfl_xor(send, 8); }
#pragma unroll
        for (int i = 0; i < 2; ++i) { const bool up = (lane & 4) != 0; const float keep = up ? v[i + 2] : v[i]; const float send = up ? v[i] : v[i + 2]; v[i] = keep + __shfl_xor(send, 4); }
        { const bool up = (lane & 2) != 0; const float keep = up ? v[1] : v[0]; const float send = up ? v[0] : v[1]; v[0] = keep + __shfl_xor(send, 2); }
        v[0] += __shfl_xor(v[0], 1);
        __syncthreads();
        if ((lane & 1) == 0) atomicAdd(&sst[lane >> 1], v[0]);
      }
      __syncthreads();
      const float2 lw = *(const float2*)(p.conv_ln_w + l * 512 + c0);
      const float2 lb = *(const float2*)(p.conv_ln_b + l * 512 + c0);
#pragma unroll
      for (int r = 0; r < 16; ++r) {
        const float mean = sst[r * 2] * (1.f / 512.f);
        const float var = fmaxf(sst[r * 2 + 1] * (1.f / 512.f) - mean * mean, 0.f);
        const float rs = rsqrtf(var + 1e-6f);
        const float y0 = (a0[r] - mean) * rs * lw.x + lb.x;
        const float y1 = (a1[r] - mean) * rs * lw.y + lb.y;
        *(unsigned*)(HDN + (size_t)(row0 + r) * 512 + c0) = pack2(silu_f(y0), silu_f(y1));
        if ((r & 3) == 3) __builtin_amdgcn_sched_barrier(0);
      }
      continue;
    }
    it -= N_CF;
    if (it < N_DT) {
      float* sdt = (float*)smem;
      const int row0 = it * 128;
      __syncthreads();
      for (int e = tid; e < 4096; e += 256) {
        const int r = e >> 5, cidx = e & 31;
        const float raw = DT[(size_t)(row0 + r) * 32 + cidx] + p.ssd_dt_bias[l * 32 + cidx];
        const float sp = (raw > 20.f) ? raw : log1pf(expf(raw));
        DT[(size_t)(row0 + r) * 32 + cidx] = sp;
        sdt[r * 33 + cidx] = sp;
      }
      __syncthreads();
      if (tid < 32) {
        const float a = -expf(p.ssd_a_log[l * 32 + tid]);
        float run = 0.f;
        if (tid < 16) {
          for (int r = 0; r < 128; ++r) { run += sdt[r * 33 + tid] * a; CS[(size_t)(row0 + r) * 32 + tid] = run; }
        } else {
          for (int r = 127; r >= 0; --r) { run += sdt[r * 33 + tid] * a; CS[(size_t)(row0 + r) * 32 + tid] = run; }
        }
      }
      continue;
    }
    it -= N_DT;
    if (it < N_CONV) {
      const int e = it * 256 + tid;
      const int rb = e / 192, cgp = e % 192, ch0 = cgp * 8;
      const int rho0 = rb * 4;
      const int seq0 = (rho0 < RL_) ? (rho0 & ~4095) : (RL_ + ((rho0 - RL_) & ~255));
      const int slen = (rho0 < RL_) ? 4096 : 256;
      const int t0 = rho0 - seq0;
      uint4 xr[8];
#pragma unroll
      for (int i = 0; i < 8; ++i) {
        const int tt = t0 + i - 2;
        xr[i] = make_uint4(0u, 0u, 0u, 0u);
        if (tt >= 0 && tt < slen) xr[i] = *(const uint4*)(XBC + (size_t)(seq0 + tt) * 1536 + ch0);
      }
      float wk[5][8];
#pragma unroll
      for (int k = 0; k < 5; ++k) {
        const float4 w0 = *(const float4*)(p.ssd_conv_w + ((size_t)l * 5 + k) * 1536 + ch0);
        const float4 w1 = *(const float4*)(p.ssd_conv_w + ((size_t)l * 5 + k) * 1536 + ch0 + 4);
        wk[k][0] = w0.x; wk[k][1] = w0.y; wk[k][2] = w0.z; wk[k][3] = w0.w; wk[k][4] = w1.x; wk[k][5] = w1.y; wk[k][6] = w1.z; wk[k][7] = w1.w;
      }
      float bias[8];
      {
        const float4 b0 = *(const float4*)(p.ssd_conv_b + l * 1536 + ch0);
        const float4 b1 = *(const float4*)(p.ssd_conv_b + l * 1536 + ch0 + 4);
        bias[0] = b0.x; bias[1] = b0.y; bias[2] = b0.z; bias[3] = b0.w; bias[4] = b1.x; bias[5] = b1.y; bias[6] = b1.z; bias[7] = b1.w;
      }
#pragma unroll
      for (int r = 0; r < 4; ++r) {
        float a[8];
#pragma unroll
        for (int c = 0; c < 8; ++c) a[c] = bias[c];
#pragma unroll
        for (int k = 0; k < 5; ++k) {
          const uint4 u = xr[r + k];
          a[0] += wk[k][0] * lo2f(u.x); a[1] += wk[k][1] * hi2f(u.x); a[2] += wk[k][2] * lo2f(u.y); a[3] += wk[k][3] * hi2f(u.y);
          a[4] += wk[k][4] * lo2f(u.z); a[5] += wk[k][5] * hi2f(u.z); a[6] += wk[k][6] * lo2f(u.w); a[7] += wk[k][7] * hi2f(u.w);
        }
        uint4 o;
        o.x = pack2(silu_f(a[0]), silu_f(a[1])); o.y = pack2(silu_f(a[2]), silu_f(a[3]));
        o.z = pack2(silu_f(a[4]), silu_f(a[5])); o.w = pack2(silu_f(a[6]), silu_f(a[7]));
        const size_t rho = (size_t)(rho0 + r);
        if (ch0 < 1024) *(uint4*)(XS + rho * 1024 + ch0) = o;
        else *(uint4*)(BC + rho * 512 + (ch0 - 1024)) = o;
      }
      continue;
    }
    it -= N_CONV;
    if (it < N_ROPE) {
      const int e = it * 256 + tid;
      const int rho = e / 40, rem = e % 40, hd = rem >> 2, sub = rem & 3;
      const int axis = sub >> 1, half = sub & 1;
      const int t = rho & 4095;
      const float pos = (float)(axis == 0 ? (t >> 6) : (t & 63));
      bf16_t* base = ((hd < 8) ? (Q + (size_t)rho * 512 + hd * 64) : (KV + (size_t)rho * 256 + (hd - 8) * 64)) + axis * 32 + half * 8;
      const float sc = (hd < 8) ? 0.18033688011112042f : 1.f;
      const uint4 u1 = *(const uint4*)base, u2 = *(const uint4*)(base + 16);
      const unsigned a1[4] = {u1.x, u1.y, u1.z, u1.w}, a2[4] = {u2.x, u2.y, u2.z, u2.w};
      unsigned o1[4], o2[4];
#pragma unroll
      for (int i = 0; i < 4; ++i) {
        float r1[2], r2[2];
#pragma unroll
        for (int hl = 0; hl < 2; ++hl) {
          const float f = (float)(half * 8 + 2 * i + hl);
          const float ang = pos * exp2f(-f * 0.8304820237218406f);
          const float cs = __cosf(ang), sn = __sinf(ang);
          const float t1 = hl ? hi2f(a1[i]) : lo2f(a1[i]);
          const float t2 = hl ? hi2f(a2[i]) : lo2f(a2[i]);
          r1[hl] = (t1 * cs - t2 * sn) * sc;
          r2[hl] = (t2 * cs + t1 * sn) * sc;
        }
        o1[i] = pack2(r1[0], r1[1]); o2[i] = pack2(r2[0], r2[1]);
      }
      *(uint4*)base = make_uint4(o1[0], o1[1], o1[2], o1[3]);
      *(uint4*)(base + 16) = make_uint4(o2[0], o2[1], o2[2], o2[3]);
      continue;
    }
    it -= N_ROPE;
    {
      const int e = it * 256 + tid;
      const int rho = RL_ + e / 256, c2 = (e % 256) * 2;
      unsigned* ptr = (unsigned*)(Q + (size_t)rho * 512 + c2);
      const unsigned u = *ptr;
      *ptr = pack2(lo2f(u) * 0.18033688011112042f, hi2f(u) * 0.18033688011112042f);
    }
  }
}

DI void attn_item(const Params& p_in, int l, char* smem, int b, int qblk, int g, int hp, bool ctxq) {
  const Params p = load_params();

  bf16_t* sK = (bf16_t*)smem;
  bf16_t* sV = (bf16_t*)(smem + 128 * 72 * 2);
  int tid = threadIdx.x; asm volatile("" : "+v"(tid)); const int lane = tid & 63, wave = tid >> 6, fr = lane & 31, fh = lane >> 5;
  const int head = g * 4 + hp * 2 + (wave >> 1);
  const int qh = wave & 1;
  const int qrow0 = (ctxq ? (RL_ + b * 256) : (b * 4096)) + qblk * 128 + qh * 64;
  const int qpos0 = qblk * 128 + qh * 64;
  bf16_t* Q = (bf16_t*)(p.ws + OFF_Q);
  const bf16_t* KV = (const bf16_t*)(p.ws + OFF_KV);
  const bf16_t* AG = (const bf16_t*)(p.ws + OFF_AG);
  f32x16 o[2][2];
  zero_acc(o);
  float m[2], lsum[2];
  m[0] = m[1] = p.attn_sink[l * 8 + head] * 1.4426950408889634f;
  lsum[0] = lsum[1] = 1.f;
  const int nhb = ctxq ? 4 : 10;
  auto hb_row = [&](int hb) -> int {
    if (hb >= nhb) return -1;
    if (hb < 4) return RL_ + b * 256 + hb * 64;
    const int kp = (qblk - 1) * 128 + (hb - 4) * 64;
    if (kp < 0 || kp >= 4096) return -1;
    return b * 4096 + kp;
  };
  auto hb_next = [&](int hb) -> int { int n = hb + 1; while (n < nhb && hb_row(n) < 0) ++n; return n; };
  const int sr = tid >> 3, scv = tid & 7;
  uint4 kp0, kp1, vp0, vp1;
#define ATT_PREFETCH(ROW0) { const bf16_t* kvp = KV + (size_t)((ROW0) + sr) * 256 + g * 64 + scv * 8; \
    kp0 = *(const uint4*)(kvp); kp1 = *(const uint4*)(kvp + 32 * 256); vp0 = *(const uint4*)(kvp + 128); vp1 = *(const uint4*)(kvp + 128 + 32 * 256); }
#define ATT_STORE(BUF) { bf16_t* k_ = sK + (BUF) * 64 * 72; bf16_t* v_ = sV + (BUF) * 64 * 72; \
    *(uint4*)&k_[sr * 72 + scv * 8] = kp0; *(uint4*)&k_[(sr + 32) * 72 + scv * 8] = kp1; \
    *(uint4*)&v_[sr * 72 + scv * 8] = vp0; *(uint4*)&v_[(sr + 32) * 72 + scv * 8] = vp1; }
  int pbuf = 0;
  __syncthreads();
  ATT_PREFETCH(hb_row(0))
  ATT_STORE(0)
  __syncthreads();
  for (int hb = 0; hb < nhb; hb = hb_next(hb)) {
    const int nxt = hb_next(hb);
    if (nxt < nhb) ATT_PREFETCH(hb_row(nxt))
    int kpos0 = 0;
    bool masked = false;
    if (hb >= 4) { kpos0 = (qblk - 1) * 128 + (hb - 4) * 64; masked = (hb != 6 && hb != 7); }
    const bf16_t* cK = sK + pbuf * 64 * 72;
    const bf16_t* cV = sV + pbuf * 64 * 72;
    bf16x8 qf[2][4];
#pragma unroll
    for (int j = 0; j < 2; ++j)
#pragma unroll
      for (int ks = 0; ks < 4; ++ks)
        qf[j][ks] = *(const bf16x8*)(Q + (size_t)(qrow0 + j * 32 + fr) * 512 + head * 64 + ks * 16 + fh * 8);
#pragma unroll 1
    for (int kb = 0; kb < 2; ++kb) {
      if (masked) {
        const int klo = kpos0 + kb * 32, khi = klo + 31;
        if (klo - (qpos0 + 63) > 128 || qpos0 - khi > 128) continue;
      }
      bf16x8 pb[2][2];
#pragma unroll
      for (int j = 0; j < 2; ++j) {
        f32x16 st[2];
#pragma unroll
        for (int r = 0; r < 16; ++r) st[j][r] = -m[j];
#pragma unroll
        for (int ks = 0; ks < 4; ++ks) {
          const bf16x8 kf = *(const bf16x8*)&cK[(kb * 32 + fr) * 72 + ks * 16 + fh * 8];
          st[j] = MFMA(kf, qf[j][ks], st[j]);
        }
        if (masked) {
          const int qpos = qpos0 + j * 32 + fr;
#pragma unroll
          for (int r = 0; r < 16; ++r) {
            const int d = qpos - (kpos0 + kb * 32 + crow(r, fh));
            if (d > 128 || d < -128) st[j][r] = -1e30f;
          }
        }
        float mx = st[j][0];
#pragma unroll
        for (int r = 1; r < 16; ++r) mx = fmaxf(mx, st[j][r]);
        mx = fmaxf(mx, __shfl_xor(mx, 32));
        const bool grow = mx > 8.f;
        if (__builtin_amdgcn_ballot_w64(grow) != 0ull) {
          const float delta = grow ? mx : 0.f;
          const float alpha = __builtin_amdgcn_exp2f(-delta);
#pragma unroll
          for (int r = 0; r < 16; ++r) st[j][r] -= delta;
          lsum[j] *= alpha;
          m[j] += delta;
#pragma unroll
          for (int mt = 0; mt < 2; ++mt)
#pragma unroll
            for (int r = 0; r < 16; ++r) o[mt][j][r] *= alpha;
        }
        float rs = 0.f;
#pragma unroll
        for (int r = 0; r < 16; ++r) { const float pv = __builtin_amdgcn_exp2f(st[j][r]); st[j][r] = pv; rs += pv; }
        rs += __shfl_xor(rs, 32);
        lsum[j] += rs;
#pragma unroll
        for (int s = 0; s < 2; ++s) {
          uint4 pk;
          pk.x = pack2(st[j][8 * s + 0], st[j][8 * s + 1]); pk.y = pack2(st[j][8 * s + 2], st[j][8 * s + 3]);
          pk.z = pack2(st[j][8 * s + 4], st[j][8 * s + 5]); pk.w = pack2(st[j][8 * s + 6], st[j][8 * s + 7]);
          pb[j][s] = __builtin_bit_cast(bf16x8, pk);
        }
      }
#pragma unroll
      for (int s = 0; s < 2; ++s)
#pragma unroll
        for (int mt = 0; mt < 2; ++mt) {
          const bf16x8 vf = tr_frag(cV, 72, kb * 32 + 16 * s + 4 * fh, kb * 32 + 16 * s + 8 + 4 * fh, mt * 32);
#pragma unroll
          for (int j = 0; j < 2; ++j) o[mt][j] = MFMA(vf, pb[j][s], o[mt][j]);
        }
    }
    if (nxt < nhb) ATT_STORE(pbuf ^ 1)
    pbuf ^= 1;
    __syncthreads();
  }
#undef ATT_PREFETCH
#undef ATT_STORE
#pragma unroll
  for (int j = 0; j < 2; ++j) {
    const float inv = 1.f / lsum[j];
    const size_t rho = (size_t)(qrow0 + j * 32 + fr);
#pragma unroll
    for (int mt = 0; mt < 2; ++mt)
#pragma unroll
      for (int g4 = 0; g4 < 4; ++g4) {
        const int d0 = mt * 32 + 8 * g4 + 4 * fh;
        const uint2 gv = *(const uint2*)(AG + rho * 512 + head * 64 + d0);
        uint2 ov;
        ov.x = pack2(o[mt][j][g4 * 4 + 0] * inv * silu_f(lo2f(gv.x)), o[mt][j][g4 * 4 + 1] * inv * silu_f(hi2f(gv.x)));
        ov.y = pack2(o[mt][j][g4 * 4 + 2] * inv * silu_f(lo2f(gv.y)), o[mt][j][g4 * 4 + 3] * inv * silu_f(hi2f(gv.y)));
        *(uint2*)(Q + rho * 512 + head * 64 + d0) = ov;
      }
  }
}

DI void states_item(const Params& p_in, char* smem, int ck, int g, int hq) {
  const Params p = load_params();

  bf16_t* sB = (bf16_t*)smem;
  bf16_t* sX = (bf16_t*)(smem + 128 * 136 * 2);
  int tid = threadIdx.x; asm volatile("" : "+v"(tid)); const int lane = tid & 63, wave = tid >> 6, wr = wave >> 1, wc = wave & 1, fr = lane & 31, fh = lane >> 5;
  const bf16_t* BC = (const bf16_t*)(p.ws + OFF_BC);
  const bf16_t* XS = (const bf16_t*)(p.ws + OFF_H);
  const float* DT = (const float*)(p.ws + OFF_DT);
  const float* CS = (const float*)(p.ws + OFF_CS);
  bf16_t* ST = (bf16_t*)(p.ws + OFF_ST);
  float* CDEC = (float*)(p.ws + OFF_CDEC);
  const int row0 = ck * 128;
  __syncthreads();
  for (int v = tid; v < 2048; v += 256) {
    const int r = v >> 4, cv = v & 15;
    *(uint4*)&sB[r * 136 + cv * 8] = *(const uint4*)(BC + (size_t)(row0 + r) * 512 + g * 128 + cv * 8);
  }
  __syncthreads();
  bf16x8 bfr[2][8];
#pragma unroll
  for (int j = 0; j < 2; ++j)
#pragma unroll
    for (int ks = 0; ks < 8; ++ks) bfr[j][ks] = tr_frag(sB, 136, ks * 16 + 8 * fh, ks * 16 + 8 * fh + 4, wc * 64 + j * 32);
  const int slr = tid >> 3, scv = tid & 7;
  uint4 xq0, xq1, xq2, xq3;
  float dq0, dq1, dq2, dq3, cq0, cq1, cq2, cq3, cendq;
#define ST_PREFETCH(HD) { const int head_ = g * 8 + hq * 4 + ((HD) >> 1), d_ = (HD) & 1, col_ = d_ * 16 + head_; \
    const bf16_t* xp_ = XS + (size_t)(row0 + slr) * 1024 + head_ * 64 + scv * 8; \
    xq0 = *(const uint4*)(xp_); xq1 = *(const uint4*)(xp_ + 32 * 1024); xq2 = *(const uint4*)(xp_ + 64 * 1024); xq3 = *(const uint4*)(xp_ + 96 * 1024); \
    const size_t rb_ = (size_t)(row0 + slr) * 32 + col_; \
    dq0 = DT[rb_]; dq1 = DT[rb_ + 32 * 32]; dq2 = DT[rb_ + 64 * 32]; dq3 = DT[rb_ + 96 * 32]; \
    cq0 = CS[rb_]; cq1 = CS[rb_ + 32 * 32]; cq2 = CS[rb_ + 64 * 32]; cq3 = CS[rb_ + 96 * 32]; \
    cendq = CS[(size_t)(row0 + (d_ == 0 ? 127 : 0)) * 32 + col_]; }
#define ST_SCALE_STORE(X, DTV, CSV, ROW) { const float sc_ = (DTV) * __expf(cend - (CSV)); uint4 o_; \
    o_.x = pack2(lo2f(X.x) * sc_, hi2f(X.x) * sc_); o_.y = pack2(lo2f(X.y) * sc_, hi2f(X.y) * sc_); \
    o_.z = pack2(lo2f(X.z) * sc_, hi2f(X.z) * sc_); o_.w = pack2(lo2f(X.w) * sc_, hi2f(X.w) * sc_); \
    *(uint4*)&sX[(ROW) * 72 + scv * 8] = o_; }
  ST_PREFETCH(0)
#pragma unroll 1
  for (int hd = 0; hd < 8; ++hd) {
    const int head = g * 8 + hq * 4 + (hd >> 1), d = hd & 1;
    const float cend = cendq;
    ST_SCALE_STORE(xq0, dq0, cq0, slr)
    ST_SCALE_STORE(xq1, dq1, cq1, slr + 32)
    ST_SCALE_STORE(xq2, dq2, cq2, slr + 64)
    ST_SCALE_STORE(xq3, dq3, cq3, slr + 96)
    if (hd < 7) ST_PREFETCH(hd + 1)
    __syncthreads();
    f32x16 acc[2];
#pragma unroll
    for (int j = 0; j < 2; ++j)
#pragma unroll
      for (int r = 0; r < 16; ++r) acc[j][r] = 0.f;
#pragma unroll
    for (int ks = 0; ks < 8; ++ks) {
      const bf16x8 af = tr_frag(sX, 72, ks * 16 + 8 * fh, ks * 16 + 8 * fh + 4, wr * 32);
#pragma unroll
      for (int j = 0; j < 2; ++j) acc[j] = MFMA(af, bfr[j][ks], acc[j]);
    }
    bf16_t* dst = ST + ((size_t)(ck * 2 + d) * 16 + head) * 8192;
#pragma unroll
    for (int j = 0; j < 2; ++j)
#pragma unroll
      for (int r = 0; r < 16; ++r) dst[(wr * 32 + crow(r, fh)) * 128 + wc * 64 + j * 32 + fr] = f2bf(acc[j][r]);
    if (tid == 0) CDEC[(ck * 2 + d) * 16 + head] = __expf(cend);
    __syncthreads();
  }
}

DI void pw_item(const Params& p_in, int l, char* smem, int mt, int nt) {
  const Params p = load_params();

  GemmS* s = (GemmS*)smem;
  int tid = threadIdx.x; asm volatile("" : "+v"(tid)); const int lane = tid & 63, wave = tid >> 6, wr = wave >> 1, wc = wave & 1, fr = lane & 31, fh = lane >> 5;
  const bf16_t* Ab = (const bf16_t*)(p.ws + OFF_HDN) + (size_t)mt * 128 * 512;
  const bf16_t* Bb = (const bf16_t*)(p.ws + OFF_PW) + (size_t)nt * 128 * 512;
  bf16_t* CG = (bf16_t*)(p.ws + OFF_CG);
  f32x16 acc[2][2];
  zero_acc(acc);
  gemm_core2(acc, (GemmS2*)smem,
             [&](int kt, int r, int kv) { return Ab + (size_t)r * 512 + kt * 64 + kv * 8; },
             [&](int kt, int r, int kv) { return Bb + (size_t)r * 512 + kt * 64 + kv * 8; }, 8, [](int) {});
  const float* pwb = p.conv_pw_b + l * 512 + nt * 128;
  epilogue_lds(acc, smem, [&](int rl, int c4, float4 v) {
    bf16_t* ptr = CG + (size_t)(mt * 128 + rl) * 512 + nt * 128 + c4;
    const uint2 gv = *(const uint2*)ptr;
    const float4 bb = *(const float4*)(pwb + c4);
    uint2 o;
    o.x = pack2((v.x + bb.x) * silu_f(lo2f(gv.x)), (v.y + bb.y) * silu_f(hi2f(gv.x)));
    o.y = pack2((v.z + bb.z) * silu_f(lo2f(gv.y)), (v.w + bb.w) * silu_f(hi2f(gv.y)));
    *(uint2*)ptr = o;
  });
}

DI void phase_mix(const Params& p, int l, char* smem) {
  const int G = gridDim.x;
  const int N_ATT = 512 + (l == 0 ? 32 : 0);
  for (int it = blockIdx.x; it < N_ATT; it += G) {
    if (it < 512) attn_item(p, l, smem, it >> 7, (it >> 2) & 31, (it >> 1) & 1, it & 1, false);
    else { const int t = it - 512; attn_item(p, l, smem, t >> 3, (t >> 2) & 1, (t >> 1) & 1, t & 1, true); }
  }
  for (int it = (blockIdx.x + G - 32) % G; it < NCK * 4; it += G) states_item(p, smem, it >> 2, (it >> 1) & 1, it & 1);
  for (int it = (blockIdx.x + G - 64) % G; it < NCK * 4; it += G) pw_item(p, l, smem, it >> 2, it & 3);
}

DI void phase_scan(const Params& p_in) {
  const Params p = load_params();

  bf16_t* ST = (bf16_t*)(p.ws + OFF_ST);
  const float* CDEC = (const float*)(p.ws + OFF_CDEC);
  for (int it = blockIdx.x; it < 512; it += gridDim.x) {
    const int e = it * 256 + threadIdx.x;
    const int bdh = e >> 10, v8 = e & 1023;
    const int b = bdh >> 5, d = (bdh >> 4) & 1, h = bdh & 15;
    float s[8];
#pragma unroll
    for (int i = 0; i < 8; ++i) s[i] = 0.f;
    auto ckof = [&](int i) {
      if (d == 0) return (i < 2) ? (128 + 2 * b + i) : (32 * b + (i - 2));
      return (i < 2) ? (128 + 2 * b + (1 - i)) : (32 * b + 31 - (i - 2));
    };
    auto pof = [&](int i) { const int ck = ckof(i); return (uint4*)(ST + ((size_t)(ck * 2 + d) * 16 + h) * 8192 + v8 * 8); };
    auto dof = [&](int i) { const int ck = ckof(i); return CDEC[(ck * 2 + d) * 16 + h]; };
    uint4 buf[8]; float dc[8];
#pragma unroll
    for (int i = 0; i < 7; ++i) { buf[i] = *pof(i); dc[i] = dof(i); }
#pragma unroll
    for (int i = 0; i < 34; ++i) {
      if (i + 7 < 34) { buf[(i + 7) & 7] = *pof(i + 7); dc[(i + 7) & 7] = dof(i + 7); }
      const uint4 cur = buf[i & 7];
      const float dec = dc[i & 7];
      uint4 o;
      o.x = pack2(s[0], s[1]); o.y = pack2(s[2], s[3]); o.z = pack2(s[4], s[5]); o.w = pack2(s[6], s[7]);
      *pof(i) = o;
      s[0] = s[0] * dec + lo2f(cur.x); s[1] = s[1] * dec + hi2f(cur.x);
      s[2] = s[2] * dec + lo2f(cur.y); s[3] = s[3] * dec + hi2f(cur.y);
      s[4] = s[4] * dec + lo2f(cur.z); s[5] = s[5] * dec + hi2f(cur.z);
      s[6] = s[6] * dec + lo2f(cur.w); s[7] = s[7] * dec + hi2f(cur.w);
    }
  }
}

DI void phase_ssdy(const Params& p_in, int l, char* smem) {
  const Params p = load_params();

  bf16_t* sB = (bf16_t*)smem;
  bf16_t* sX = (bf16_t*)(smem + 128 * 136 * 2);
  float* sF = (float*)(smem + 128 * 136 * 2 + 128 * 72 * 2);
  float* sSS = sF + 512;
  int tid = threadIdx.x; asm volatile("" : "+v"(tid)); const int lane = tid & 63, wave = tid >> 6, fr = lane & 31, fh = lane >> 5;
  const int wl = wave >> 1, w2 = wave & 1;
  const bf16_t* BC = (const bf16_t*)(p.ws + OFF_BC);
  const bf16_t* XS = (const bf16_t*)(p.ws + OFF_H);
  const float* DT = (const float*)(p.ws + OFF_DT);
  const float* CS = (const float*)(p.ws + OFF_CS);
  const bf16_t* ST = (const bf16_t*)(p.ws + OFF_ST);
  bf16_t* Z = (bf16_t*)(p.ws + OFF_Z);
  float* RSTD = (float*)(p.ws + OFF_RSTD);
  const int nck = (l == 0) ? NCK : 128;
  const int nh = (l == 0) ? 2 : 8;
  const int nsplit = 8 / nh;
  for (int it0 = blockIdx.x; it0 < nck * 4 * nsplit; it0 += gridDim.x) {
    const int hq = it0 % nsplit, it = it0 / nsplit;
    const int hbeg = hq * nh, hend = hbeg + nh;
    const int ck = it >> 2, g = (it >> 1) & 1, lh = it & 1;
    const int row0 = ck * 128;
    const int lbase = lh * 64 + wl * 32;
    __syncthreads();
    for (int v = tid; v < 2048; v += 256) {
      const int r = v >> 4, cv = v & 15;
      *(uint4*)&sB[r * 136 + cv * 8] = *(const uint4*)(BC + (size_t)(row0 + r) * 512 + g * 128 + cv * 8);
    }
    if (tid < 64) sSS[tid] = 0.f;
    const bf16_t* cptr = BC + (size_t)(row0 + lbase + fr) * 512 + 256 + g * 128 + fh * 8;
    bf16x8 cf[8];
#pragma unroll
    for (int ks = 0; ks < 8; ++ks) cf[ks] = *(const bf16x8*)(cptr + ks * 16);
    const int lrx = tid >> 3, cvx = tid & 7;
    const bf16_t* xsrc = XS + (size_t)(row0 + lrx) * 1024 + cvx * 8;
    uint4 xp0, xp1, xp2, xp3;
    float fp0 = 0.f, fp1 = 0.f, fp2 = 0.f, fp3 = 0.f;
    {
      const int head = g * 8 + hbeg;
      xp0 = *(const uint4*)(xsrc + head * 64);
      xp1 = *(const uint4*)(xsrc + head * 64 + 32 * 1024);
      xp2 = *(const uint4*)(xsrc + head * 64 + 64 * 1024);
      xp3 = *(const uint4*)(xsrc + head * 64 + 96 * 1024);
      if (tid < 128) {
        const size_t rho = (size_t)(row0 + tid);
        fp0 = CS[rho * 32 + head]; fp1 = CS[rho * 32 + 16 + head]; fp2 = DT[rho * 32 + head]; fp3 = DT[rho * 32 + 16 + head];
      }
    }
    __syncthreads();
    f32x16 cb[2];
#pragma unroll
    for (int j = 0; j < 2; ++j) {
#pragma unroll
      for (int r = 0; r < 16; ++r) cb[j][r] = 0.f;
#pragma unroll
      for (int ks = 0; ks < 8; ++ks) {
        const bf16x8 bq = *(const bf16x8*)&sB[(w2 * 64 + j * 32 + fr) * 136 + ks * 16 + fh * 8];
        cb[j] = MFMA(cf[ks], bq, cb[j]);
      }
    }
    const int pidx = w2 * 32 + fr;
    bf16_t* sCB = sB + 64 * 136;
    __syncthreads();
#pragma unroll
    for (int j = 0; j < 2; ++j)
#pragma unroll
      for (int r = 0; r < 16; ++r) sCB[(wl * 32 + crow(r, fh)) * 136 + w2 * 64 + j * 32 + fr] = f2bf(cb[j][r]);
#pragma unroll 1
    for (int hh = hbeg; hh < hend; ++hh) {
      const int head = g * 8 + hh;
      __syncthreads();
      *(uint4*)&sX[lrx * 72 + cvx * 8] = xp0;
      *(uint4*)&sX[(lrx + 32) * 72 + cvx * 8] = xp1;
      *(uint4*)&sX[(lrx + 64) * 72 + cvx * 8] = xp2;
      *(uint4*)&sX[(lrx + 96) * 72 + cvx * 8] = xp3;
      if (tid < 128) { sF[tid] = fp0; sF[128 + tid] = fp1; sF[256 + tid] = fp2; sF[384 + tid] = fp3; }
      const bf16_t* S0 = ST + ((size_t)(ck * 2 + 0) * 16 + head) * 8192 + (w2 * 32 + fr) * 128 + fh * 8;
      const bf16_t* S1 = ST + ((size_t)(ck * 2 + 1) * 16 + head) * 8192 + (w2 * 32 + fr) * 128 + fh * 8;
      bf16x8 sf0[8];
#pragma unroll
      for (int ks = 0; ks < 8; ++ks) sf0[ks] = *(const bf16x8*)(S0 + ks * 16);
      bf16_t* zbase = Z + (size_t)(row0 + lbase + 4 * fh) * 1024 + head * 64 + pidx;
      if (hh + 1 < hend) {
        const int hn = head + 1;
        xp0 = *(const uint4*)(xsrc + hn * 64);
        xp1 = *(const uint4*)(xsrc + hn * 64 + 32 * 1024);
        xp2 = *(const uint4*)(xsrc + hn * 64 + 64 * 1024);
        xp3 = *(const uint4*)(xsrc + hn * 64 + 96 * 1024);
        if (tid < 128) {
          const size_t rho = (size_t)(row0 + tid);
          fp0 = CS[rho * 32 + hn]; fp1 = CS[rho * 32 + 16 + hn]; fp2 = DT[rho * 32 + hn]; fp3 = DT[rho * 32 + 16 + hn];
        }
      }
      __syncthreads();
#pragma unroll
      for (int j = 0; j < 2; ++j) {
        const int sidx = w2 * 64 + j * 32 + fr;
        const float csf_s = sF[sidx], csb_s = sF[128 + sidx], dtf_s = sF[256 + sidx], dtb_s = sF[384 + sidx];
#pragma unroll 4
        for (int r = 0; r < 16; ++r) {
          const int lidx = lbase + crow(r, fh);
          float f = 0.f;
          if (sidx <= lidx) f += __expf(sF[lidx] - csf_s) * dtf_s;
          if (sidx >= lidx) f += __expf(sF[128 + lidx] - csb_s) * dtb_s;
          sB[(wl * 32 + crow(r, fh)) * 136 + sidx] = f2bf(bf2f(sCB[(wl * 32 + crow(r, fh)) * 136 + sidx]) * f);
        }
      }
      __syncthreads();
      bf16x8 sf1[8], cfh[8];
#pragma unroll
      for (int ks = 0; ks < 8; ++ks) { sf1[ks] = *(const bf16x8*)(S1 + ks * 16); cfh[ks] = *(const bf16x8*)(cptr + ks * 16); }
      unsigned short zv[16];
#pragma unroll
      for (int r = 0; r < 16; ++r) zv[r] = zbase[(size_t)((r & 3) + 8 * (r >> 2)) * 1024];
      f32x16 accy;
#pragma unroll
      for (int r = 0; r < 16; ++r) accy[r] = 0.f;
#pragma unroll
      for (int ks = 0; ks < 8; ++ks) {
        const bf16x8 af = *(const bf16x8*)&sB[(wl * 32 + fr) * 136 + ks * 16 + fh * 8];
        const bf16x8 xf = tr_frag(sX, 72, ks * 16 + 8 * fh, ks * 16 + 8 * fh + 4, w2 * 32);
        accy = MFMA(af, xf, accy);
      }
      {
        f32x16 acct;
#pragma unroll
        for (int r = 0; r < 16; ++r) acct[r] = 0.f;
#pragma unroll
        for (int ks = 0; ks < 8; ++ks) acct = MFMA(cfh[ks], sf0[ks], acct);
#pragma unroll
        for (int r = 0; r < 16; ++r) accy[r] += __expf(sF[lbase + crow(r, fh)]) * acct[r];
#pragma unroll
        for (int r = 0; r < 16; ++r) acct[r] = 0.f;
#pragma unroll
        for (int ks = 0; ks < 8; ++ks) acct = MFMA(cfh[ks], sf1[ks], acct);
#pragma unroll
        for (int r = 0; r < 16; ++r) accy[r] += __expf(sF[128 + lbase + crow(r, fh)]) * acct[r];
      }
      const float dsk = p.ssd_d[l * 16 + head];
      float v[16];
#pragma unroll
      for (int r = 0; r < 16; ++r) {
        const int lidx = lbase + crow(r, fh);
        const float xv = bf2f(sX[lidx * 72 + pidx]);
        const float y = accy[r] + dsk * xv;
        const float u = y * silu_f(bf2f(zv[r]));
        v[r] = u * u;
        zbase[(size_t)((r & 3) + 8 * (r >> 2)) * 1024] = f2bf(u);
      }
#pragma unroll
      for (int i = 0; i < 8; ++i) { const bool up = (fr & 16) != 0; const float keep = up ? v[i + 8] : v[i]; const float send = up ? v[i] : v[i + 8]; v[i] = keep + __shfl_xor(send, 16); }
#pragma unroll
      for (int i = 0; i < 4; ++i) { const bool up = (fr & 8) != 0; const float keep = up ? v[i + 4] : v[i]; const float send = up ? v[i] : v[i + 4]; v[i] = keep + __shfl_xor(send, 8); }
#pragma unroll
      for (int i = 0; i < 2; ++i) { const bool up = (fr & 4) != 0; const float keep = up ? v[i + 2] : v[i]; const float send = up ? v[i] : v[i + 2]; v[i] = keep + __shfl_xor(send, 4); }
      { const bool up = (fr & 2) != 0; const float keep = up ? v[1] : v[0]; const float send = up ? v[0] : v[1]; v[0] = keep + __shfl_xor(send, 2); }
      v[0] += __shfl_xor(v[0], 1);
      if ((fr & 1) == 0) atomicAdd(&sSS[wl * 32 + crow(fr >> 1, fh)], v[0]);
    }
    __syncthreads();
    if (tid < 64) atomicAdd(&RSTD[(size_t)(row0 + lh * 64 + tid) * 2 + g], sSS[tid]);
  }
}

DI void phase_outproj(const Params& p_in, int l, char* smem) {
  const Params p = load_params();

  GemmS* s = (GemmS*)smem;
  int tid = threadIdx.x; asm volatile("" : "+v"(tid)); const int lane = tid & 63, wave = tid >> 6, wr = wave >> 1, wc = wave & 1, fr = lane & 31, fh = lane >> 5;
  const bf16_t* Zb = (const bf16_t*)(p.ws + OFF_Z);
  const bf16_t* Qb = (const bf16_t*)(p.ws + OFF_Q);
  const bf16_t* Cb = (const bf16_t*)(p.ws + OFF_CG);
  const bf16_t* W = (const bf16_t*)(p.ws + OFF_WOUT);
  const float* RSTD = (const float*)(p.ws + OFF_RSTD);
  const float* mods = (const float*)(p.ws + OFF_MODS);
  float* XC = (float*)(p.ws + OFF_XC);
  const int nM = (l == 0) ? NCK : 128;
  for (int step = 0;; ++step) {
    int mt, nt;
    if (!xcd_tile(step, nM, 8, mt, nt)) break;
    f32x16 acc[2][2];
    zero_acc(acc);
    const bf16_t* Wb = W + (size_t)nt * 128 * 2048;
    const bf16_t* A0 = Zb + (size_t)mt * 128 * 1024;
    const bf16_t* A2 = Qb + (size_t)mt * 128 * 512;
    const bf16_t* A3 = Cb + (size_t)mt * 128 * 512;
    float* sScale = (float*)(smem + 40960);
    if (tid < 128) {
      const size_t row = (size_t)(mt * 128 + tid);
      const float r0 = rsqrtf(RSTD[row * 2] * (1.f / 512.f) + 1e-6f);
      const float r1 = rsqrtf(RSTD[row * 2 + 1] * (1.f / 512.f) + 1e-6f);
      sScale[tid * 2] = r0 / r1;
      sScale[tid * 2 + 1] = r1;
    }
    gemm_core2(acc, (GemmS2*)smem,
               [&](int kt, int r, int kv) {
                 const bf16_t* ptr;
                 if (kt < 16) ptr = A0 + (size_t)r * 1024 + kt * 64;
                 else if (kt < 24) ptr = A2 + (size_t)r * 512 + (kt - 16) * 64;
                 else ptr = A3 + (size_t)r * 512 + (kt - 24) * 64;
                 return ptr + kv * 8;
               },
               [&](int kt, int r, int kv) { return Wb + (size_t)r * 2048 + kt * 64 + kv * 8; }, 32,
               [&](int kt) __attribute__((always_inline)) {
                 if (kt == 8 || kt == 16) {
#pragma unroll
                   for (int i = 0; i < 2; ++i)
#pragma unroll
                     for (int r = 0; r < 16; ++r) {
                       const float f = sScale[(wr * 64 + i * 32 + crow(r, fh)) * 2 + (kt == 16 ? 1 : 0)];
                       acc[i][0][r] *= f; acc[i][1][r] *= f;
                     }
                 }
               });
    {
      const int row0 = mt * 128;
      const int vv = (row0 < RL_) ? (row0 >> 12) : 4;
      const float* gate = mods + (l * 5 + vv) * 3072 + 2048 + nt * 128;
      float* xnew = (row0 < RL_) ? (p.out + (size_t)row0 * 1024) : (XC + (size_t)(row0 - RL_) * 1024);
      const float* xold = (l == 0) ? ((row0 < RL_) ? (p.x + (size_t)row0 * 1024) : (p.ctx + (size_t)(row0 - RL_) * 1024)) : xnew;
      epilogue_lds(acc, smem, [&](int rl, int c4, float4 v) {
        const int off = rl * 1024 + nt * 128 + c4;
        const float4 xo = *(const float4*)(xold + off);
        const float4 gt = *(const float4*)(gate + c4);
        float4 o;
        o.x = xo.x + gt.x * v.x; o.y = xo.y + gt.y * v.y; o.z = xo.z + gt.z * v.z; o.w = xo.w + gt.w * v.w;
        *(float4*)(xnew + off) = o;
      });
    }
  }
  if (l == 0) {
    const int local = blockIdx.x >> 3, xcd = blockIdx.x & 7, nloc = gridDim.x >> 3;
    if (local >= 8 && nloc > 8) {
      const int nb = (nloc - 8) * 8;
      const int NT_WIN = 88 * 16, NT_PW = 64;
      for (int it = (local - 8) * 8 + xcd; it < NT_WIN + NT_PW; it += nb) {
        if (it < NT_WIN) transpose_tile(p.w_in + (size_t)1024 * 5408, 5408, 0, nullptr, (bf16_t*)(p.ws + OFF_WIN), 1024, (it / 16) * 64, (it % 16) * 64, (float*)smem);
        else { const int t = it - NT_WIN; transpose_tile(p.conv_pw_w + (size_t)512 * 512, 512, 1, nullptr, (bf16_t*)(p.ws + OFF_PW), 512, (t / 8) * 64, (t % 8) * 64, (float*)smem); }
      }
    }
  }
}

DI void phase_final(const Params& p_in) {
  const Params p = load_params();
  const int lane = threadIdx.x & 63, wave = threadIdx.x >> 6;
  for (int it = blockIdx.x; it < RL_ / 8; it += gridDim.x) {
    float* xr0 = p.out + (size_t)(it * 8 + wave * 2) * 1024;
    float4 xv[2][4];
#pragma unroll
    for (int q = 0; q < 2; ++q)
#pragma unroll
      for (int i = 0; i < 4; ++i) xv[q][i] = *(const float4*)(xr0 + q * 1024 + lane * 4 + i * 256);
    float4 w[4];
#pragma unroll
    for (int i = 0; i < 4; ++i) w[i] = *(const float4*)(p.final_norm_w + lane * 4 + i * 256);
#pragma unroll
    for (int q = 0; q < 2; ++q) {
      float ss = 0.f;
#pragma unroll
      for (int i = 0; i < 4; ++i) ss += xv[q][i].x * xv[q][i].x + xv[q][i].y * xv[q][i].y + xv[q][i].z * xv[q][i].z + xv[q][i].w * xv[q][i].w;
#pragma unroll
      for (int o = 32; o >= 1; o >>= 1) ss += __shfl_xor(ss, o);
      const float rs = rsqrtf(ss * (1.f / 1024.f) + 1e-6f);
#pragma unroll
      for (int i = 0; i < 4; ++i) {
        float4 o;
        o.x = xv[q][i].x * rs * w[i].x; o.y = xv[q][i].y * rs * w[i].y; o.z = xv[q][i].z * rs * w[i].z; o.w = xv[q][i].w * rs * w[i].w;
        *(float4*)(xr0 + q * 1024 + lane * 4 + i * 256) = o;
      }
    }
  }
}

template <int PH>
DI void run_phase(const Params& p, char* smem) {
  constexpr int l = (PH - 1) / 7, s = (PH - 1) % 7;
  if constexpr (PH == 0) phase_mods(p, smem);
  else if constexpr (PH == 15) phase_final(p);
  else if constexpr (s == 0) phase_prep(p, l, smem);
  else if constexpr (s == 1) phase_inproj(p, smem);
  else if constexpr (s == 2) phase_local(p, l, smem);
  else if constexpr (s == 3) phase_mix(p, l, smem);
  else if constexpr (s == 4) phase_scan(p);
  else if constexpr (s == 5) phase_ssdy(p, l, smem);
  else phase_outproj(p, l, smem);
}

#if PROBE_S >= 0
#define PROBE_BEGIN() if (threadIdx.x == 0) pst[1] = wall_clock64();
#define PROBE_END(PH) if (threadIdx.x == 0 && (PH) >= 1 && (PH) <= 14 && (((PH) - 1) % 7) == PROBE_S) pst[0] += wall_clock64() - pst[1];
#else
#define PROBE_BEGIN()
#define PROBE_END(PH)
#endif
#define PHASE(PH) PROBE_BEGIN() run_phase<PH>(p, smem); xcd_barrier(xst); PROBE_END(PH)

__global__ void __launch_bounds__(256, 2) fwd_megakernel(Params p) {
  __shared__ __attribute__((aligned(16))) char smem[57344];
  cg::grid_group grid = cg::this_grid();
#if PROBE_S >= 0
  volatile unsigned long long* pst = (volatile unsigned long long*)(smem + 57344 - 16);
  if (threadIdx.x == 0) { pst[0] = 0; pst[1] = 0; }
#endif
  __shared__ uint4 xb_words;
  volatile LAS unsigned* xst = (volatile LAS unsigned*)&xb_words;
  if (threadIdx.x == 0) xb_words = make_uint4(0u, 0u, 0u, 0u);
  run_phase<0>(p, smem);
  grid.sync();
  if (threadIdx.x == 0) { unsigned* bar = (unsigned*)(load_params().ws + OFF_BAR); (void)xb_add(&bar[XB_XCNT(xb_xcc_id())], 1u); }
  PHASE(1) PHASE(2) PHASE(3) PHASE(4) PHASE(5) PHASE(6) PHASE(7)
  PHASE(8) PHASE(9) PHASE(10) PHASE(11) PHASE(12) PHASE(13) PHASE(14)
  run_phase<15>(p, smem);
#if PROBE_S >= 0
  if (blockIdx.x == 0 && threadIdx.x == 0) {
    const unsigned long long t1 = wall_clock64();
    const unsigned long long lim = 4ull * pst[0];
    while (wall_clock64() - t1 < lim) { __builtin_amdgcn_s_sleep(32); }
  }
#endif
}

extern "C" void kernel_launch(void* const* d_in, const int* in_sizes, int n_in, void* d_out, int out_size, void* d_ws,
                              size_t ws_size, hipStream_t stream) {
  static int grid_blocks = 0;
  if (!grid_blocks) {
    int dev = 0, cus = 0, per_cu = 0;
    hipGetDevice(&dev);
    hipDeviceGetAttribute(&cus, hipDeviceAttributeMultiprocessorCount, dev);
    hipOccupancyMaxActiveBlocksPerMultiprocessor(&per_cu, fwd_megakernel, 256, 0);
    if (per_cu < 1) per_cu = 1;
    if (per_cu > 2) per_cu = 2;
    grid_blocks = (cus * per_cu) & ~7;
  }
  Params p{};
  const float** pp = (const float**)&p;
  for (int i = 0; i < 23; ++i) pp[i] = (const float*)d_in[i];
  p.out = (float*)d_out;
  p.ws = (char*)d_ws;
  void* args[] = {&p};
  hipError_t e = hipLaunchCooperativeKernel((void*)fwd_megakernel, dim3(grid_blocks), dim3(256), args, 0, stream);
  if (e != hipSuccess) fprintf(stderr, "cooperative launch failed: %s (grid %d)\n", hipGetErrorString(e), grid_blocks);
}
```

```cpp
#include <hip/hip_runtime.h>
#include <hip/hip_cooperative_groups.h>
#include <stdint.h>
#include <stdio.h>
namespace cg = cooperative_groups;

#ifndef ONE_LAUNCH
#define ONE_LAUNCH 1
#endif

#ifndef PROBE_S
#define PROBE_S -1
#endif
#define DI __device__ __forceinline__
typedef unsigned short bf16_t;
using bf16x8 = __attribute__((ext_vector_type(8))) short;
using s16x4 = __attribute__((ext_vector_type(4))) short;
using f32x16 = __attribute__((ext_vector_type(16))) float;
#define MFMA(a, b, c) __builtin_amdgcn_mfma_f32_32x32x16_bf16((a), (b), (c), 0, 0, 0)

constexpr int R_ = 17408;
constexpr int RL_ = 16384;
constexpr int NCK = 136;

constexpr size_t SZ_WIN = (size_t)5632 * 1024 * 2;
constexpr size_t SZ_WOUT = (size_t)1024 * 2048 * 2;
constexpr size_t SZ_PW = (size_t)512 * 512 * 2;
constexpr size_t SZ_MODS = (size_t)2 * 5 * 3072 * 4;
constexpr size_t SZ_XC = (size_t)1024 * 1024 * 4;
constexpr size_t SZ_RSTD = (size_t)R_ * 2 * 4;
constexpr size_t SZ_CDEC = (size_t)NCK * 32 * 4 + 256 - ((size_t)NCK * 32 * 4) % 256;
constexpr size_t SZ_R512 = (size_t)R_ * 512 * 2;
constexpr size_t OFF_WIN = 0;
constexpr size_t OFF_WOUT = OFF_WIN + SZ_WIN;
constexpr size_t OFF_PW = OFF_WOUT + SZ_WOUT;
constexpr size_t OFF_MODS = OFF_PW + SZ_PW;
constexpr size_t OFF_XC = OFF_MODS + SZ_MODS;
constexpr size_t OFF_RSTD = OFF_XC + SZ_XC;
constexpr size_t OFF_CDEC = OFF_RSTD + SZ_RSTD;
constexpr size_t OFF_H = OFF_CDEC + SZ_CDEC;
constexpr size_t OFF_XBC = OFF_H + 2 * SZ_R512;
constexpr size_t OFF_GLU = OFF_XBC + 3 * SZ_R512;
constexpr size_t OFF_ST = OFF_XBC;
constexpr size_t OFF_Z = OFF_GLU + SZ_R512;
constexpr size_t OFF_DT = OFF_Z + 2 * SZ_R512;
constexpr size_t OFF_CS = OFF_DT + (size_t)R_ * 32 * 4;
constexpr size_t OFF_Q = OFF_CS + (size_t)R_ * 32 * 4;
constexpr size_t OFF_KV = OFF_Q + SZ_R512;
constexpr size_t OFF_AG = OFF_KV + SZ_R512 / 2;
constexpr size_t OFF_CG = OFF_AG + SZ_R512;
constexpr size_t OFF_BC = OFF_CG + SZ_R512;
constexpr size_t OFF_HDN = OFF_BC + SZ_R512;
constexpr size_t WS_TOTAL = OFF_HDN + SZ_R512;
constexpr size_t OFF_BAR = WS_TOTAL;
static_assert(OFF_BAR + 16384 <= (size_t)256 * 1024 * 1024, "workspace too large");

struct Params {
  const float *x, *c, *ctx, *c_ctx, *w_mod, *b_mod, *norm_w, *w_in, *ssd_conv_w, *ssd_conv_b, *ssd_dt_bias, *ssd_a_log,
      *ssd_d, *ssd_norm_w, *attn_sink, *conv_dw_w, *conv_dw_b, *conv_ln_w, *conv_ln_b, *conv_pw_w, *conv_pw_b, *w_out,
      *final_norm_w;
  float* out;
  char* ws;
};


DI Params load_params() {
  typedef const char __attribute__((address_space(4)))* kptr_t;
  typedef const float* const __attribute__((address_space(4)))* kfld_t;
  size_t off = 0;
  asm volatile("" : "+s"(off));
  kptr_t base = (kptr_t)__builtin_amdgcn_kernarg_segment_ptr() + off;
  Params p;
  const float** pp = (const float**)&p;
#pragma unroll
  for (int i = 0; i < 25; ++i) pp[i] = *(kfld_t)(base + 8 * i);
  return p;
}

#define XB_TMO      128
#define XB_XCNT(j)  (256  + 64 * (j))
#define XB_XSUB(j)  (1280 + 64 * (j))
#define XB_XGEN(j)  (2304 + 64 * (j))
#define XB_TOP      3328
#define XB_TOPGEN   3392
#define XCD_BAR_WORDS 3456
#define XB_SPIN_CAP (1u << 18)
#define LAS __attribute__((address_space(3)))
DI unsigned xb_ld(unsigned* p)              { return __hip_atomic_load(p, __ATOMIC_RELAXED, __HIP_MEMORY_SCOPE_AGENT); }
DI unsigned xb_add(unsigned* p, unsigned v) { return __hip_atomic_fetch_add(p, v, __ATOMIC_RELAXED, __HIP_MEMORY_SCOPE_AGENT); }
DI unsigned xb_xcc_id() { return (unsigned)__builtin_amdgcn_s_getreg((3 << 11) | 20) & 0xFu; }
#define XB_SPIN(cond, bar) do { unsigned _sp = 0; while (cond) { __builtin_amdgcn_s_sleep(1); \
    if ((++_sp & 255u) == 0u) { if (xb_ld(&(bar)[XB_TMO])) break; if (_sp > XB_SPIN_CAP) { atomicAdd(&(bar)[XB_TMO], 1u); break; } } } } while (0)

DI void xcd_barrier_complete(unsigned* bar, unsigned x, unsigned& nloc, unsigned& nx) {
  const unsigned G = gridDim.x * gridDim.y * gridDim.z;
  unsigned sum, cnt, mine, sp = 0u;
  for (;;) {
    sum = 0u; cnt = 0u; mine = 0u;
#pragma unroll
    for (unsigned j = 0; j < 16; ++j) { const unsigned c = xb_ld(&bar[XB_XCNT(j)]); sum += c; cnt += (c > 0u) ? 1u : 0u; mine = (j == x) ? c : mine; }
    if (sum == G) break;
    __builtin_amdgcn_s_sleep(1);
    if ((++sp & 255u) == 0u) { if (xb_ld(&bar[XB_TMO])) break; if (sp > XB_SPIN_CAP) { atomicAdd(&bar[XB_TMO], 1u); break; } }
  }
  nloc = mine > 0u ? mine : 1u; nx = cnt > 0u ? cnt : 1u;
}

DI void xcd_barrier(volatile LAS unsigned* st) {
  asm volatile("s_waitcnt vmcnt(0)" ::: "memory");
  __syncthreads();
  if (threadIdx.x == 0) {
    const Params pb = load_params();
    unsigned* bar = (unsigned*)(pb.ws + OFF_BAR);
    const unsigned x = xb_xcc_id();
    __builtin_amdgcn_s_waitcnt(0);
    unsigned nloc = st[0], nx = st[1];
    if (nloc == 0u) { xcd_barrier_complete(bar, x, nloc, nx); st[0] = nloc; st[1] = nx; }
    const unsigned old = xb_add(&bar[XB_XSUB(x)], 1u);
    const unsigned gen = old / nloc;
    if (old + 1u == (gen + 1u) * nloc) {
      __builtin_amdgcn_fence(__ATOMIC_RELEASE, "agent");
      asm volatile("s_waitcnt vmcnt(0)" ::: "memory");
      const unsigned og = xb_add(&bar[XB_TOP], 1u);
      const unsigned tg = og / nx;
      if (og + 1u == (tg + 1u) * nx) xb_add(&bar[XB_TOPGEN], 1u);
      else XB_SPIN(xb_ld(&bar[XB_TOPGEN]) == tg, bar);
      __builtin_amdgcn_fence(__ATOMIC_ACQUIRE, "agent");
      xb_add(&bar[XB_XGEN(x)], 1u);
      asm volatile("s_waitcnt vmcnt(0)" ::: "memory");
    } else {
      XB_SPIN(xb_ld(&bar[XB_XGEN(x)]) == gen, bar);
      __builtin_amdgcn_fence(__ATOMIC_ACQUIRE, "agent");
      asm volatile("s_waitcnt vmcnt(0)" ::: "memory");
    }
  }
  __syncthreads();
}

typedef __bf16 nbf16x2_t __attribute__((ext_vector_type(2)));
typedef float nf32x2_t __attribute__((ext_vector_type(2)));
DI unsigned short f2bf(float x) { const __bf16 r = (__bf16)x; return __builtin_bit_cast(unsigned short, r); }
DI float bf2f(unsigned short b) { return __uint_as_float(((unsigned)b) << 16); }
DI unsigned pack2(float a, float b) { const nf32x2_t v = {a, b}; const nbf16x2_t r = __builtin_convertvector(v, nbf16x2_t); return __builtin_bit_cast(unsigned, r); }
DI float lo2f(unsigned u) { return __uint_as_float(u << 16); }
DI float hi2f(unsigned u) { return __uint_as_float(u & 0xffff0000u); }
DI float silu_f(float x) { return x / (1.f + __expf(-x)); }
DI float sigmoid_f(float x) { return 1.f / (1.f + __expf(-x)); }
DI int crow(int reg, int h) { return (reg & 3) + 8 * (reg >> 2) + 4 * h; }

DI bf16x8 tr_frag(const bf16_t* s, int ld, int row_lo, int row_hi, int col0) {
  const int lane = threadIdx.x & 63;
  const int i16 = lane & 15, q = i16 >> 2, pp = i16 & 3, blk = (lane >> 4) & 1;
  const unsigned a0 = (unsigned)(size_t)(s + (row_lo + q) * ld + col0 + 16 * blk + 4 * pp);
  const unsigned a1 = (unsigned)(size_t)(s + (row_hi + q) * ld + col0 + 16 * blk + 4 * pp);
  s16x4 lo, hi;
  asm volatile("ds_read_b64_tr_b16 %0, %2\n\tds_read_b64_tr_b16 %1, %3\n\ts_waitcnt lgkmcnt(0)"
               : "=&v"(lo), "=&v"(hi) : "v"(a0), "v"(a1) : "memory");
  return __builtin_shufflevector(lo, hi, 0, 1, 2, 3, 4, 5, 6, 7);
}

struct GemmS { bf16_t a[2][128][40]; bf16_t b[2][128][40]; };

template <class AF, class BF>
DI void gemm_core(f32x16 (&acc)[2][2], GemmS* s, AF aptr, BF bptr, int nk) {
  int tid = threadIdx.x; asm volatile("" : "+v"(tid)); const int lane = tid & 63, wave = tid >> 6, wr = wave >> 1, wc = wave & 1;
  const int r0 = tid >> 2, kv = tid & 3;
  const int fr = lane & 31, fh = lane >> 5;
  uint4 ra0 = *(const uint4*)aptr(0, r0, kv), ra1 = *(const uint4*)aptr(0, r0 + 64, kv);
  uint4 rb0 = *(const uint4*)bptr(0, r0, kv), rb1 = *(const uint4*)bptr(0, r0 + 64, kv);
  *(uint4*)&s->a[0][r0][kv * 8] = ra0; *(uint4*)&s->a[0][r0 + 64][kv * 8] = ra1;
  *(uint4*)&s->b[0][r0][kv * 8] = rb0; *(uint4*)&s->b[0][r0 + 64][kv * 8] = rb1;
  __syncthreads();
#pragma unroll 1
  for (int kt = 0; kt < nk; ++kt) {
    const int buf = kt & 1;
    if (kt + 1 < nk) {
      ra0 = *(const uint4*)aptr(kt + 1, r0, kv); ra1 = *(const uint4*)aptr(kt + 1, r0 + 64, kv);
      rb0 = *(const uint4*)bptr(kt + 1, r0, kv); rb1 = *(const uint4*)bptr(kt + 1, r0 + 64, kv);
    }
#pragma unroll
    for (int ks = 0; ks < 2; ++ks) {
      bf16x8 af[2], bq[2];
#pragma unroll
      for (int i = 0; i < 2; ++i) af[i] = *(const bf16x8*)&s->a[buf][wr * 64 + i * 32 + fr][ks * 16 + fh * 8];
#pragma unroll
      for (int j = 0; j < 2; ++j) bq[j] = *(const bf16x8*)&s->b[buf][wc * 64 + j * 32 + fr][ks * 16 + fh * 8];
#pragma unroll
      for (int i = 0; i < 2; ++i)
#pragma unroll
        for (int j = 0; j < 2; ++j) acc[i][j] = MFMA(af[i], bq[j], acc[i][j]);
    }
    if (kt + 1 < nk) {
      *(uint4*)&s->a[buf ^ 1][r0][kv * 8] = ra0; *(uint4*)&s->a[buf ^ 1][r0 + 64][kv * 8] = ra1;
      *(uint4*)&s->b[buf ^ 1][r0][kv * 8] = rb0; *(uint4*)&s->b[buf ^ 1][r0 + 64][kv * 8] = rb1;
    }
    __syncthreads();
  }
}


struct GemmS2 { bf16_t a[128][72]; bf16_t b[128][72]; };
DI void g2_compute(f32x16 (&acc)[2][2], const GemmS2* s, int wr, int wc, int fr, int fh) {
#pragma unroll
  for (int ks = 0; ks < 4; ++ks) {
    bf16x8 af[2], bq[2];
#pragma unroll
    for (int i = 0; i < 2; ++i) af[i] = *(const bf16x8*)&s->a[wr * 64 + i * 32 + fr][ks * 16 + fh * 8];
#pragma unroll
    for (int j = 0; j < 2; ++j) bq[j] = *(const bf16x8*)&s->b[wc * 64 + j * 32 + fr][ks * 16 + fh * 8];
#pragma unroll
    for (int i = 0; i < 2; ++i)
#pragma unroll
      for (int j = 0; j < 2; ++j) acc[i][j] = MFMA(af[i], bq[j], acc[i][j]);
  }
}

template <class AF, class BF, class HK>
DI void gemm_core2(f32x16 (&acc)[2][2], GemmS2* s, AF aptr, BF bptr, int nk, HK hook) {
  int tid = threadIdx.x; asm volatile("" : "+v"(tid));
  const int lane = tid & 63, wave = tid >> 6, wr = wave >> 1, wc = wave & 1;
  const int r0 = tid >> 3, kc = tid & 7;
  const int fr = lane & 31, fh = lane >> 5;
  uint4 p0a0, p0a1, p0a2, p0a3, p0b0, p0b1, p0b2, p0b3, p1a0, p1a1, p1a2, p1a3, p1b0, p1b1, p1b2, p1b3;
#define G2_LOAD(S, KT) { \
    S##a0 = *(const uint4*)aptr((KT), r0, kc);      S##b0 = *(const uint4*)bptr((KT), r0, kc); \
    S##a1 = *(const uint4*)aptr((KT), r0 + 32, kc); S##b1 = *(const uint4*)bptr((KT), r0 + 32, kc); \
    S##a2 = *(const uint4*)aptr((KT), r0 + 64, kc); S##b2 = *(const uint4*)bptr((KT), r0 + 64, kc); \
    S##a3 = *(const uint4*)aptr((KT), r0 + 96, kc); S##b3 = *(const uint4*)bptr((KT), r0 + 96, kc); }
#define G2_STORE(S) { \
    *(uint4*)&s->a[r0][kc * 8] = S##a0;      *(uint4*)&s->b[r0][kc * 8] = S##b0; \
    *(uint4*)&s->a[r0 + 32][kc * 8] = S##a1; *(uint4*)&s->b[r0 + 32][kc * 8] = S##b1; \
    *(uint4*)&s->a[r0 + 64][kc * 8] = S##a2; *(uint4*)&s->b[r0 + 64][kc * 8] = S##b2; \
    *(uint4*)&s->a[r0 + 96][kc * 8] = S##a3; *(uint4*)&s->b[r0 + 96][kc * 8] = S##b3; }
#define G2_COMPUTE() g2_compute(acc, s, wr, wc, fr, fh);
  G2_LOAD(p0, 0)
  G2_LOAD(p1, 1)
  G2_STORE(p0)
  if (nk > 2) G2_LOAD(p0, 2)
  __syncthreads();
#pragma unroll 1
  for (int kt = 0; kt < nk; kt += 2) {
    hook(kt);
    G2_COMPUTE()
    __syncthreads();
    G2_STORE(p1)
    if (kt + 3 < nk) G2_LOAD(p1, kt + 3)
    __syncthreads();
    hook(kt + 1);
    G2_COMPUTE()
    __syncthreads();
    if (kt + 2 < nk) {
      G2_STORE(p0)
      if (kt + 4 < nk) G2_LOAD(p0, kt + 4)
    }
    __syncthreads();
  }
#undef G2_LOAD
#undef G2_STORE
#undef G2_COMPUTE
}


struct GemmS3 { bf16_t a[128][72]; bf16_t b[256][72]; };

template <class AF, class BF, class HK>
DI void gemm_core3(f32x16 (&acc)[2][4], GemmS3* s, AF aptr, BF bptr, int nk, HK hook) {
  int tid = threadIdx.x; asm volatile("" : "+v"(tid));
  const int lane = tid & 63, wave = tid >> 6, wr = wave >> 1, wc = wave & 1;
  const int r0 = tid >> 3, kc = tid & 7;
  const int fr = lane & 31, fh = lane >> 5;
  uint4 a0, a1, a2, a3, b0, b1, b2, b3, b4, b5, b6, b7;
#define G3_LOAD(KT) { \
    a0 = *(const uint4*)aptr((KT), r0, kc);       a1 = *(const uint4*)aptr((KT), r0 + 32, kc); \
    a2 = *(const uint4*)aptr((KT), r0 + 64, kc);  a3 = *(const uint4*)aptr((KT), r0 + 96, kc); \
    b0 = *(const uint4*)bptr((KT), r0, kc);       b1 = *(const uint4*)bptr((KT), r0 + 32, kc); \
    b2 = *(const uint4*)bptr((KT), r0 + 64, kc);  b3 = *(const uint4*)bptr((KT), r0 + 96, kc); \
    b4 = *(const uint4*)bptr((KT), r0 + 128, kc); b5 = *(const uint4*)bptr((KT), r0 + 160, kc); \
    b6 = *(const uint4*)bptr((KT), r0 + 192, kc); b7 = *(const uint4*)bptr((KT), r0 + 224, kc); }
#define G3_STORE() { \
    *(uint4*)&s->a[r0][kc * 8] = a0;       *(uint4*)&s->a[r0 + 32][kc * 8] = a1; \
    *(uint4*)&s->a[r0 + 64][kc * 8] = a2;  *(uint4*)&s->a[r0 + 96][kc * 8] = a3; \
    *(uint4*)&s->b[r0][kc * 8] = b0;       *(uint4*)&s->b[r0 + 32][kc * 8] = b1; \
    *(uint4*)&s->b[r0 + 64][kc * 8] = b2;  *(uint4*)&s->b[r0 + 96][kc * 8] = b3; \
    *(uint4*)&s->b[r0 + 128][kc * 8] = b4; *(uint4*)&s->b[r0 + 160][kc * 8] = b5; \
    *(uint4*)&s->b[r0 + 192][kc * 8] = b6; *(uint4*)&s->b[r0 + 224][kc * 8] = b7; }
  G3_LOAD(0)
  G3_STORE()
  __syncthreads();
#pragma unroll 1
  for (int kt = 0; kt < nk; ++kt) {
    if (kt + 1 < nk) G3_LOAD(kt + 1)
    hook(kt);
#pragma unroll
    for (int ks = 0; ks < 4; ++ks) {
      bf16x8 af[2], bq[4];
#pragma unroll
      for (int i = 0; i < 2; ++i) af[i] = *(const bf16x8*)&s->a[wr * 64 + i * 32 + fr][ks * 16 + fh * 8];
#pragma unroll
      for (int j = 0; j < 4; ++j) bq[j] = *(const bf16x8*)&s->b[wc * 128 + j * 32 + fr][ks * 16 + fh * 8];
#pragma unroll
      for (int i = 0; i < 2; ++i)
#pragma unroll
        for (int j = 0; j < 4; ++j) acc[i][j] = MFMA(af[i], bq[j], acc[i][j]);
    }
    __syncthreads();
    if (kt + 1 < nk) G3_STORE()
    __syncthreads();
  }
#undef G3_LOAD
#undef G3_STORE
}

template <class EPI>
DI void epilogue_lds2(f32x16 (&acc)[2][4], char* smem, int sub, EPI epi) {
  float* T = (float*)smem;
  int tid = threadIdx.x; asm volatile("" : "+v"(tid));
  const int lane = tid & 63, wave = tid >> 6, wr = wave >> 1, wc = wave & 1, fr = lane & 31, fh = lane >> 5;
#pragma unroll
  for (int i = 0; i < 2; ++i) {
    if (wc == sub) {
#pragma unroll
      for (int j = 0; j < 4; ++j)
#pragma unroll
        for (int r = 0; r < 16; ++r) T[(wr * 32 + crow(r, fh)) * 132 + j * 32 + fr] = acc[i][j][r];
    }
    __syncthreads();
#pragma unroll 2
    for (int e = tid; e < 2048; e += 256) {
      const int tr = e >> 5, c4 = (e & 31) * 4;
      const float4 v = *(const float4*)&T[tr * 132 + c4];
      epi((tr >> 5) * 64 + i * 32 + (tr & 31), c4, v);
    }
    __syncthreads();
  }
}

DI bool xcd_tile(int step, int nM, int nN, int& mt, int& nt) {
  const int xcd = blockIdx.x & 7, nloc = gridDim.x >> 3;
  const int j = (blockIdx.x >> 3) + step * nloc;
  const int mloc = nM >> 3;
  if ((gridDim.x & 7) != 0 || j >= mloc * nN) return false;
  const int per = 8 * nN;
  const int gm = j / per, rem = j - gm * per;
  const int hgt = min(8, mloc - gm * 8);
  const int a = rem % hgt;
  nt = rem / hgt;
  mt = (gm * 8 + a) * 8 + xcd;
  return true;
}

DI void zero_acc(f32x16 (&acc)[2][2]) {
#pragma unroll
  for (int i = 0; i < 2; ++i)
#pragma unroll
    for (int j = 0; j < 2; ++j)
#pragma unroll
      for (int r = 0; r < 16; ++r) acc[i][j][r] = 0.f;
}

template <class EPI>
DI void epilogue_lds(f32x16 (&acc)[2][2], char* smem, EPI epi) {
  float* T = (float*)smem;
  int tid = threadIdx.x; asm volatile("" : "+v"(tid)); const int lane = tid & 63, wave = tid >> 6, wr = wave >> 1, wc = wave & 1, fr = lane & 31, fh = lane >> 5;
#pragma unroll
  for (int i = 0; i < 2; ++i) {
#pragma unroll
    for (int j = 0; j < 2; ++j)
#pragma unroll
      for (int r = 0; r < 16; ++r) T[(wr * 32 + crow(r, fh)) * 132 + wc * 64 + j * 32 + fr] = acc[i][j][r];
    __syncthreads();
#pragma unroll 2
    for (int e = tid; e < 2048; e += 256) {
      const int tr = e >> 5, c4 = (e & 31) * 4;
      const float4 v = *(const float4*)&T[tr * 132 + c4];
      epi((tr >> 5) * 64 + i * 32 + (tr & 31), c4, v);
    }
    __syncthreads();
  }
}

DI void phase_mods(const Params& p_in, char* smem) {
  const Params p = load_params();

  float* ssc = (float*)smem;
  float* red = (float*)(smem + 20480);
  float* mods = (float*)(p.ws + OFF_MODS);
  int tid = threadIdx.x; asm volatile("" : "+v"(tid));
  if (blockIdx.x == 0) { unsigned* bar = (unsigned*)(p.ws + OFF_BAR); for (int i = tid; i < XCD_BAR_WORDS; i += 256) bar[i] = 0u; }
  for (int it = blockIdx.x; it < 192; it += gridDim.x) {
    const int l = it / 96, col0 = (it % 96) * 32;
    __syncthreads();
    for (int e = tid; e < 5120; e += 256) {
      const int v = e >> 10, k = e & 1023;
      const float cv = (v < 4) ? p.c[v * 1024 + k] : p.c_ctx[k];
      ssc[e] = silu_f(cv);
    }
    __syncthreads();
    const int col = tid & 31, kg = tid >> 5;
    float a[5] = {0.f, 0.f, 0.f, 0.f, 0.f};
    const float* w = p.w_mod + (size_t)l * 1024 * 3072 + col0 + col;
    for (int k = kg * 128; k < kg * 128 + 128; k += 32) {
      float wv[32];
#pragma unroll
      for (int u = 0; u < 32; ++u) wv[u] = w[(size_t)(k + u) * 3072];
#pragma unroll
      for (int u = 0; u < 32; ++u)
#pragma unroll
        for (int v = 0; v < 5; ++v) a[v] += ssc[v * 1024 + k + u] * wv[u];
    }
#pragma unroll
    for (int v = 0; v < 5; ++v) red[(kg * 5 + v) * 32 + col] = a[v];
    __syncthreads();
    for (int e = tid; e < 160; e += 256) {
      const int v = e >> 5, cc = e & 31;
      float sum = p.b_mod[l * 3072 + col0 + cc];
      for (int g = 0; g < 8; ++g) sum += red[(g * 5 + v) * 32 + cc];
      mods[(l * 5 + v) * 3072 + col0 + cc] = sum;
    }
  }
}

DI int win_colmap(int n) {
  if (n < 2560) return n;
  if (n < 3840) return n + 32;
  if (n < 4864) {
    const int j = n - 3840, q64 = j >> 6, w = j & 63;
    return (w < 32) ? (3872 + q64 * 32 + w) : (3872 + 512 + q64 * 32 + (w - 32));
  }
  if (n < 5376) return n + 32;
  if (n < 5408) return n - 5376 + 2560;
  return -1;
}

DI void transpose_tile(const float* src, int ldsrc, int kind, const float* rowscale, bf16_t* dst, int lddst, int n0, int k0, float* tile) {
  int tid = threadIdx.x; asm volatile("" : "+v"(tid));
  __syncthreads();
  {
    const int c4 = (tid & 15) * 4, rr = tid >> 4;
    const int n = (kind == 0) ? win_colmap(n0 + c4) : (n0 + c4);
#pragma unroll
    for (int ps = 0; ps < 4; ++ps) {
      const int r = rr + ps * 16, k = k0 + r;
      float4 v = make_float4(0.f, 0.f, 0.f, 0.f);
      if (n >= 0) v = *(const float4*)(src + (size_t)k * ldsrc + n);
      if (rowscale != nullptr && k < 1024) { const float s = rowscale[k]; v.x *= s; v.y *= s; v.z *= s; v.w *= s; }
      tile[r * 65 + c4] = v.x; tile[r * 65 + c4 + 1] = v.y; tile[r * 65 + c4 + 2] = v.z; tile[r * 65 + c4 + 3] = v.w;
    }
  }
  __syncthreads();
  {
    const int k8 = (tid & 7) * 8, nn = tid >> 3;
#pragma unroll
    for (int ps = 0; ps < 2; ++ps) {
      const int r = nn + ps * 32;
      uint4 o;
      o.x = pack2(tile[(k8 + 0) * 65 + r], tile[(k8 + 1) * 65 + r]);
      o.y = pack2(tile[(k8 + 2) * 65 + r], tile[(k8 + 3) * 65 + r]);
      o.z = pack2(tile[(k8 + 4) * 65 + r], tile[(k8 + 5) * 65 + r]);
      o.w = pack2(tile[(k8 + 6) * 65 + r], tile[(k8 + 7) * 65 + r]);
      *(uint4*)(dst + (size_t)(n0 + r) * lddst + k0 + k8) = o;
    }
  }
}

DI void phase_prep(const Params& p_in, int l, char* smem) {
  const Params p = load_params();

  int tid = threadIdx.x; asm volatile("" : "+v"(tid)); const int lane = tid & 63, wave = tid >> 6;
  const float* mods = (const float*)(p.ws + OFF_MODS);
  bf16_t* H = (bf16_t*)(p.ws + OFF_H);
  const int NT_WIN = 88 * 16, NT_WOUT = 16 * 32, NT_PW = 64, NT_CONV = NT_WIN + NT_WOUT + NT_PW;
  const int NT = NT_CONV + R_ / 8;
  for (int it = blockIdx.x; it < NT; it += gridDim.x) {
    if (l == 1 && (it < NT_WIN || (it >= NT_WIN + NT_WOUT && it < NT_CONV))) continue;
    if (it < NT_WIN) {
      transpose_tile(p.w_in + (size_t)l * 1024 * 5408, 5408, 0, nullptr, (bf16_t*)(p.ws + OFF_WIN), 1024, (it / 16) * 64, (it % 16) * 64, (float*)smem);
    } else if (it < NT_WIN + NT_WOUT) {
      const int t = it - NT_WIN;
      transpose_tile(p.w_out + (size_t)l * 2048 * 1024, 1024, 1, p.ssd_norm_w + l * 1024, (bf16_t*)(p.ws + OFF_WOUT), 2048, (t / 32) * 64, (t % 32) * 64, (float*)smem);
    } else if (it < NT_CONV) {
      const int t = it - NT_WIN - NT_WOUT;
      transpose_tile(p.conv_pw_w + (size_t)l * 512 * 512, 512, 1, nullptr, (bf16_t*)(p.ws + OFF_PW), 512, (t / 8) * 64, (t % 8) * 64, (float*)smem);
    } else {
      const int rho0 = (it - NT_CONV) * 8 + wave * 2;
      const float* xs0;
      if (l == 0) xs0 = (rho0 < RL_) ? (p.x + (size_t)rho0 * 1024) : (p.ctx + (size_t)(rho0 - RL_) * 1024);
      else xs0 = (rho0 < RL_) ? (p.out + (size_t)rho0 * 1024) : ((const float*)(p.ws + OFF_XC) + (size_t)(rho0 - RL_) * 1024);
      const int v = (rho0 < RL_) ? (rho0 >> 12) : 4;
      const float* md = mods + (l * 5 + v) * 3072;
      float4 xv[2][4], nwv[4], shv[4], scv4[4];
#pragma unroll
      for (int i = 0; i < 4; ++i) {
        const int cidx = lane * 4 + i * 256;
        xv[0][i] = *(const float4*)(xs0 + cidx);
        xv[1][i] = *(const float4*)(xs0 + 1024 + cidx);
        nwv[i] = *(const float4*)(p.norm_w + l * 1024 + cidx);
        shv[i] = *(const float4*)(md + cidx);
        scv4[i] = *(const float4*)(md + 1024 + cidx);
      }
#pragma unroll
      for (int q = 0; q < 2; ++q) {
        float ss = 0.f;
#pragma unroll
        for (int i = 0; i < 4; ++i) ss += xv[q][i].x * xv[q][i].x + xv[q][i].y * xv[q][i].y + xv[q][i].z * xv[q][i].z + xv[q][i].w * xv[q][i].w;
#pragma unroll
        for (int o = 32; o >= 1; o >>= 1) ss += __shfl_xor(ss, o);
        const float rs = rsqrtf(ss * (1.f / 1024.f) + 1e-6f);
#pragma unroll
        for (int i = 0; i < 4; ++i) {
          const int cidx = lane * 4 + i * 256;
          const float4 nw = nwv[i], sh = shv[i], sc = scv4[i];
          uint2 o;
          o.x = pack2(xv[q][i].x * rs * nw.x * (1.f + sc.x) + sh.x, xv[q][i].y * rs * nw.y * (1.f + sc.y) + sh.y);
          o.y = pack2(xv[q][i].z * rs * nw.z * (1.f + sc.z) + sh.z, xv[q][i].w * rs * nw.w * (1.f + sc.w) + sh.w);
          *(uint2*)(H + (size_t)(rho0 + q) * 1024 + cidx) = o;
        }
      }
    }
  }
}

DI void phase_inproj(const Params& p_in, char* smem) {
  const Params p = load_params();
  int tid = threadIdx.x; asm volatile("" : "+v"(tid)); const int wave = tid >> 6, wc = wave & 1;
  const bf16_t* H = (const bf16_t*)(p.ws + OFF_H);
  const bf16_t* W = (const bf16_t*)(p.ws + OFF_WIN);
  for (int step = 0;; ++step) {
    int mt, nt2;
    if (!xcd_tile(step, NCK, 22, mt, nt2)) break;
    f32x16 acc[2][4];
#pragma unroll
    for (int i = 0; i < 2; ++i)
#pragma unroll
      for (int j = 0; j < 4; ++j)
#pragma unroll
        for (int r = 0; r < 16; ++r) acc[i][j][r] = 0.f;
    const bf16_t* Ab = H + (size_t)mt * 128 * 1024;
    const bf16_t* Bb = W + (size_t)nt2 * 256 * 1024;
    gemm_core3(acc, (GemmS3*)smem,
               [&](int kt, int r, int kv) { return Ab + (size_t)r * 1024 + kt * 64 + kv * 8; },
               [&](int kt, int r, int kv) { return Bb + (size_t)r * 1024 + kt * 64 + kv * 8; }, 16, [](int) {});
    const int row0 = mt * 128;
    {
      const int ntw = nt2 * 2 + wc;
      if (ntw >= 30 && ntw < 38) {
#pragma unroll
        for (int i = 0; i < 2; ++i)
#pragma unroll
          for (int r = 0; r < 16; ++r) {
            acc[i][0][r] = acc[i][0][r] * sigmoid_f(acc[i][1][r]);
            acc[i][2][r] = acc[i][2][r] * sigmoid_f(acc[i][3][r]);
          }
      }
    }
#pragma unroll 1
    for (int sub = 0; sub < 2; ++sub) {
      const int nt = nt2 * 2 + sub;
      if (nt >= 43) break;
      if (nt >= 30 && nt < 38) {
        bf16_t* G = (bf16_t*)(p.ws + OFF_GLU);
        const int cb0 = (nt - 30) * 64;
        epilogue_lds2(acc, smem, sub, [&](int rl, int c4, float4 v) {
          if ((c4 & 32) == 0) {
            uint2 o; o.x = pack2(v.x, v.y); o.y = pack2(v.z, v.w);
            *(uint2*)(G + (size_t)(row0 + rl) * 512 + cb0 + (c4 >> 6) * 32 + (c4 & 31)) = o;
          }
        });
      } else if (nt == 42) {
        float* DT = (float*)(p.ws + OFF_DT);
        epilogue_lds2(acc, smem, sub, [&](int rl, int c4, float4 v) {
          if (c4 < 32) *(float4*)(DT + (size_t)(row0 + rl) * 32 + c4) = v;
        });
      } else {
        bf16_t* dst; int ld, cb;
        if (nt < 12) { dst = (bf16_t*)(p.ws + OFF_XBC); ld = 1536; cb = nt * 128; }
        else if (nt < 20) { dst = (bf16_t*)(p.ws + OFF_Z); ld = 1024; cb = nt * 128 - 1536; }
        else if (nt < 24) { dst = (bf16_t*)(p.ws + OFF_Q); ld = 512; cb = nt * 128 - 2560; }
        else if (nt < 26) { dst = (bf16_t*)(p.ws + OFF_KV); ld = 256; cb = nt * 128 - 3072; }
        else if (nt < 30) { dst = (bf16_t*)(p.ws + OFF_AG); ld = 512; cb = nt * 128 - 3328; }
        else { dst = (bf16_t*)(p.ws + OFF_CG); ld = 512; cb = nt * 128 - 4864; }
        epilogue_lds2(acc, smem, sub, [&](int rl, int c4, float4 v) {
          uint2 o; o.x = pack2(v.x, v.y); o.y = pack2(v.z, v.w);
          *(uint2*)(dst + (size_t)(row0 + rl) * ld + cb + c4) = o;
        });
      }
    }
  }
}

DI void phase_local(const Params& p_in, int l, char* smem) {
  const Params p = load_params();

  int tid = threadIdx.x; asm volatile("" : "+v"(tid)); const int lane = tid & 63;
  const bf16_t* XBC = (const bf16_t*)(p.ws + OFF_XBC);
  bf16_t* XS = (bf16_t*)(p.ws + OFF_H);
  bf16_t* BC = (bf16_t*)(p.ws + OFF_BC);
  float* DT = (float*)(p.ws + OFF_DT);
  float* CS = (float*)(p.ws + OFF_CS);
  const bf16_t* GLU = (const bf16_t*)(p.ws + OFF_GLU);
  bf16_t* HDN = (bf16_t*)(p.ws + OFF_HDN);
  bf16_t* Q = (bf16_t*)(p.ws + OFF_Q);
  bf16_t* KV = (bf16_t*)(p.ws + OFF_KV);
  { float* SSQ = (float*)(p.ws + OFF_RSTD); for (int i = blockIdx.x * 256 + tid; i < R_ * 2; i += gridDim.x * 256) SSQ[i] = 0.f; }
  const int N_CONV = (R_ / 4) * 192 / 256;
  const int N_DT = NCK;
  const int N_CF = R_ / 16;
  const int N_ROPE = RL_ * 40 / 256;
  const int N_QC = 1024 * 256 / 256;
  const int NT = N_CF + N_DT + N_CONV + N_ROPE + N_QC;
  for (int it0 = blockIdx.x; it0 < NT; it0 += gridDim.x) {
    int it = it0;
    if (it < N_CF) {
      float* sst = (float*)smem;
      unsigned* sIn = (unsigned*)(smem + 256);
      const int row0 = it * 16;
      const int seq0 = (row0 < RL_) ? (row0 & ~4095) : (RL_ + ((row0 - RL_) & ~255));
      const int slen = (row0 < RL_) ? 4096 : 256;
      const int t0 = row0 - seq0;
      const int c0 = tid * 2;
      __syncthreads();
      if (tid < 32) sst[tid] = 0.f;
      for (int idx = tid; idx < 46 * 64; idx += 256) {
        const int rr = idx >> 6, c16 = idx & 63;
        const int tt = t0 - 15 + rr;
        uint4 val = make_uint4(0u, 0u, 0u, 0u);
        if (tt >= 0 && tt < slen) val = *(const uint4*)(GLU + (size_t)(seq0 + tt) * 512 + c16 * 8);
        *(uint4*)&sIn[rr * 256 + c16 * 4] = val;
      }
      float w0[31], w1[31];
#pragma unroll
      for (int k = 0; k < 31; ++k) {
        const float2 wv = *(const float2*)(p.conv_dw_w + ((size_t)l * 31 + k) * 512 + c0);
        w0[k] = wv.x; w1[k] = wv.y;
      }
      const float2 bv = *(const float2*)(p.conv_dw_b + l * 512 + c0);
      float a0[16], a1[16];
#pragma unroll
      for (int r = 0; r < 16; ++r) { a0[r] = bv.x; a1[r] = bv.y; }
      __syncthreads();
#pragma unroll
      for (int tp = 0; tp < 46; ++tp) {
        const unsigned u = sIn[tp * 256 + tid];
        const float x0 = lo2f(u), x1 = hi2f(u);
#pragma unroll
        for (int r = 0; r < 16; ++r) {
          const int k = tp - r;
          if (k >= 0 && k < 31) { a0[r] += w0[k] * x0; a1[r] += w1[k] * x1; }
        }
        if ((tp & 7) == 7) __builtin_amdgcn_sched_barrier(0);
      }
      {
        float v[32];
#pragma unroll
        for (int r = 0; r < 16; ++r) { v[2 * r] = a0[r] + a1[r]; v[2 * r + 1] = a0[r] * a0[r] + a1[r] * a1[r]; }
#pragma unroll
        for (int i = 0; i < 16; ++i) { const bool up = (lane & 32) != 0; const float keep = up ? v[i + 16] : v[i]; const float send = up ? v[i] : v[i + 16]; v[i] = keep + __shfl_xor(send, 32); }
#pragma unroll
        for (int i = 0; i < 8; ++i) { const bool up = (lane & 16) != 0; const float keep = up ? v[i + 8] : v[i]; const float send = up ? v[i] : v[i + 8]; v[i] = keep + __shfl_xor(send, 16); }
#pragma unroll
        for (int i = 0; i < 4; ++i) { const bool up = (lane & 8) != 0; const float keep = up ? v[i + 4] : v[i]; const float send = up ? v[i] : v[i + 4]; v[i] = keep + __shfl_xor(send, 8); }
#pragma unroll
        for (int i = 0; i < 2; ++i) { const bool up = (lane & 4) != 0; const float keep = up ? v[i + 2] : v[i]; const float send = up ? v[i] : v[i + 2]; v[i] = keep + __shfl_xor(send, 4); }
        { const bool up = (lane & 2) != 0; const float keep = up ? v[1] : v[0]; const float send = up ? v[0] : v[1]; v[0] = keep + __shfl_xor(send, 2); }
        v[0] += __shfl_xor(v[0], 1);
        __syncthreads();
        if ((lane & 1) == 0) atomicAdd(&sst[lane >> 1], v[0]);
      }
      __syncthreads();
      const float2 lw = *(const float2*)(p.conv_ln_w + l * 512 + c0);
      const float2 lb = *(const float2*)(p.conv_ln_b + l * 512 + c0);
#pragma unroll
      for (int r = 0; r < 16; ++r) {
        const float mean = sst[r * 2] * (1.f / 512.f);
        const float var = fmaxf(sst[r * 2 + 1] * (1.f / 512.f) - mean * mean, 0.f);
        const float rs = rsqrtf(var + 1e-6f);
        const float y0 = (a0[r] - mean) * rs * lw.x + lb.x;
        const float y1 = (a1[r] - mean) * rs * lw.y + lb.y;
        *(unsigned*)(HDN + (size_t)(row0 + r) * 512 + c0) = pack2(silu_f(y0), silu_f(y1));
        if ((r & 3) == 3) __builtin_amdgcn_sched_barrier(0);
      }
      continue;
    }
    it -= N_CF;
    if (it < N_DT) {
      float* sdt = (float*)smem;
      const int row0 = it * 128;
      __syncthreads();
      for (int e = tid; e < 4096; e += 256) {
        const int r = e >> 5, cidx = e & 31;
        const float raw = DT[(size_t)(row0 + r) * 32 + cidx] + p.ssd_dt_bias[l * 32 + cidx];
        const float sp = (raw > 20.f) ? raw : log1pf(expf(raw));
        DT[(size_t)(row0 + r) * 32 + cidx] = sp;
        sdt[r * 33 + cidx] = sp;
      }
      __syncthreads();
      if (tid < 32) {
        const float a = -expf(p.ssd_a_log[l * 32 + tid]);
        float run = 0.f;
        if (tid < 16) {
          for (int r = 0; r < 128; ++r) { run += sdt[r * 33 + tid] * a; CS[(size_t)(row0 + r) * 32 + tid] = run; }
        } else {
          for (int r = 127; r >= 0; --r) { run += sdt[r * 33 + tid] * a; CS[(size_t)(row0 + r) * 32 + tid] = run; }
        }
      }
      continue;
    }
    it -= N_DT;
    if (it < N_CONV) {
      const int e = it * 256 + tid;
      const int rb = e / 192, cgp = e % 192, ch0 = cgp * 8;
      const int rho0 = rb * 4;
      const int seq0 = (rho0 < RL_) ? (rho0 & ~4095) : (RL_ + ((rho0 - RL_) & ~255));
      const int slen = (rho0 < RL_) ? 4096 : 256;
      const int t0 = rho0 - seq0;
      uint4 xr[8];
#pragma unroll
      for (int i = 0; i < 8; ++i) {
        const int tt = t0 + i - 2;
        xr[i] = make_uint4(0u, 0u, 0u, 0u);
        if (tt >= 0 && tt < slen) xr[i] = *(const uint4*)(XBC + (size_t)(seq0 + tt) * 1536 + ch0);
      }
      float wk[5][8];
#pragma unroll
      for (int k = 0; k < 5; ++k) {
        const float4 w0 = *(const float4*)(p.ssd_conv_w + ((size_t)l * 5 + k) * 1536 + ch0);
        const float4 w1 = *(const float4*)(p.ssd_conv_w + ((size_t)l * 5 + k) * 1536 + ch0 + 4);
        wk[k][0] = w0.x; wk[k][1] = w0.y; wk[k][2] = w0.z; wk[k][3] = w0.w; wk[k][4] = w1.x; wk[k][5] = w1.y; wk[k][6] = w1.z; wk[k][7] = w1.w;
      }
      float bias[8];
      {
        const float4 b0 = *(const float4*)(p.ssd_conv_b + l * 1536 + ch0);
        const float4 b1 = *(const float4*)(p.ssd_conv_b + l * 1536 + ch0 + 4);
        bias[0] = b0.x; bias[1] = b0.y; bias[2] = b0.z; bias[3] = b0.w; bias[4] = b1.x; bias[5] = b1.y; bias[6] = b1.z; bias[7] = b1.w;
      }
#pragma unroll
      for (int r = 0; r < 4; ++r) {
        float a[8];
#pragma unroll
        for (int c = 0; c < 8; ++c) a[c] = bias[c];
#pragma unroll
        for (int k = 0; k < 5; ++k) {
          const uint4 u = xr[r + k];
          a[0] += wk[k][0] * lo2f(u.x); a[1] += wk[k][1] * hi2f(u.x); a[2] += wk[k][2] * lo2f(u.y); a[3] += wk[k][3] * hi2f(u.y);
          a[4] += wk[k][4] * lo2f(u.z); a[5] += wk[k][5] * hi2f(u.z); a[6] += wk[k][6] * lo2f(u.w); a[7] += wk[k][7] * hi2f(u.w);
        }
        uint4 o;
        o.x = pack2(silu_f(a[0]), silu_f(a[1])); o.y = pack2(silu_f(a[2]), silu_f(a[3]));
        o.z = pack2(silu_f(a[4]), silu_f(a[5])); o.w = pack2(silu_f(a[6]), silu_f(a[7]));
        const size_t rho = (size_t)(rho0 + r);
        if (ch0 < 1024) *(uint4*)(XS + rho * 1024 + ch0) = o;
        else *(uint4*)(BC + rho * 512 + (ch0 - 1024)) = o;
      }
      continue;
    }
    it -= N_CONV;
    if (it < N_ROPE) {
      const int e = it * 256 + tid;
      const int rho = e / 40, rem = e % 40, hd = rem >> 2, sub = rem & 3;
      const int axis = sub >> 1, half = sub & 1;
      const int t = rho & 4095;
      const float pos = (float)(axis == 0 ? (t >> 6) : (t & 63));
      bf16_t* base = ((hd < 8) ? (Q + (size_t)rho * 512 + hd * 64) : (KV + (size_t)rho * 256 + (hd - 8) * 64)) + axis * 32 + half * 8;
      const float sc = (hd < 8) ? 0.18033688011112042f : 1.f;
      const uint4 u1 = *(const uint4*)base, u2 = *(const uint4*)(base + 16);
      const unsigned a1[4] = {u1.x, u1.y, u1.z, u1.w}, a2[4] = {u2.x, u2.y, u2.z, u2.w};
      unsigned o1[4], o2[4];
#pragma unroll
      for (int i = 0; i < 4; ++i) {
        float r1[2], r2[2];
#pragma unroll
        for (int hl = 0; hl < 2; ++hl) {
          const float f = (float)(half * 8 + 2 * i + hl);
          const float ang = pos * exp2f(-f * 0.8304820237218406f);
          const float cs = __cosf(ang), sn = __sinf(ang);
          const float t1 = hl ? hi2f(a1[i]) : lo2f(a1[i]);
          const float t2 = hl ? hi2f(a2[i]) : lo2f(a2[i]);
          r1[hl] = (t1 * cs - t2 * sn) * sc;
          r2[hl] = (t2 * cs + t1 * sn) * sc;
        }
        o1[i] = pack2(r1[0], r1[1]); o2[i] = pack2(r2[0], r2[1]);
      }
      *(uint4*)base = make_uint4(o1[0], o1[1], o1[2], o1[3]);
      *(uint4*)(base + 16) = make_uint4(o2[0], o2[1], o2[2], o2[3]);
      continue;
    }
    it -= N_ROPE;
    {
      const int e = it * 256 + tid;
      const int rho = RL_ + e / 256, c2 = (e % 256) * 2;
      unsigned* ptr = (unsigned*)(Q + (size_t)rho * 512 + c2);
      const unsigned u = *ptr;
      *ptr = pack2(lo2f(u) * 0.18033688011112042f, hi2f(u) * 0.18033688011112042f);
    }
  }
}

DI void attn_item(const Params& p_in, int l, char* smem, int b, int qblk, int g, int hp, bool ctxq) {
  const Params p = load_params();

  bf16_t* sK = (bf16_t*)smem;
  bf16_t* sV = (bf16_t*)(smem + 128 * 72 * 2);
  int tid = threadIdx.x; asm volatile("" : "+v"(tid)); const int lane = tid & 63, wave = tid >> 6, fr = lane & 31, fh = lane >> 5;
  const int head = g * 4 + hp * 2 + (wave >> 1);
  const int qh = wave & 1;
  const int qrow0 = (ctxq ? (RL_ + b * 256) : (b * 4096)) + qblk * 128 + qh * 64;
  const int qpos0 = qblk * 128 + qh * 64;
  bf16_t* Q = (bf16_t*)(p.ws + OFF_Q);
  const bf16_t* KV = (const bf16_t*)(p.ws + OFF_KV);
  const bf16_t* AG = (const bf16_t*)(p.ws + OFF_AG);
  f32x16 o[2][2];
  zero_acc(o);
  float m[2], lsum[2];
  m[0] = m[1] = p.attn_sink[l * 8 + head] * 1.4426950408889634f;
  lsum[0] = lsum[1] = 1.f;
  const int nhb = ctxq ? 4 : 10;
  auto hb_row = [&](int hb) -> int {
    if (hb >= nhb) return -1;
    if (hb < 4) return RL_ + b * 256 + hb * 64;
    const int kp = (qblk - 1) * 128 + (hb - 4) * 64;
    if (kp < 0 || kp >= 4096) return -1;
    return b * 4096 + kp;
  };
  auto hb_next = [&](int hb) -> int { int n = hb + 1; while (n < nhb && hb_row(n) < 0) ++n; return n; };
  const int sr = tid >> 3, scv = tid & 7;
  uint4 kp0, kp1, vp0, vp1;
#define ATT_PREFETCH(ROW0) { const bf16_t* kvp = KV + (size_t)((ROW0) + sr) * 256 + g * 64 + scv * 8; \
    kp0 = *(const uint4*)(kvp); kp1 = *(const uint4*)(kvp + 32 * 256); vp0 = *(const uint4*)(kvp + 128); vp1 = *(const uint4*)(kvp + 128 + 32 * 256); }
#define ATT_STORE(BUF) { bf16_t* k_ = sK + (BUF) * 64 * 72; bf16_t* v_ = sV + (BUF) * 64 * 72; \
    *(uint4*)&k_[sr * 72 + scv * 8] = kp0; *(uint4*)&k_[(sr + 32) * 72 + scv * 8] = kp1; \
    *(uint4*)&v_[sr * 72 + scv * 8] = vp0; *(uint4*)&v_[(sr + 32) * 72 + scv * 8] = vp1; }
  int pbuf = 0;
  __syncthreads();
  ATT_PREFETCH(hb_row(0))
  ATT_STORE(0)
  __syncthreads();
  for (int hb = 0; hb < nhb; hb = hb_next(hb)) {
    const int nxt = hb_next(hb);
    if (nxt < nhb) ATT_PREFETCH(hb_row(nxt))
    int kpos0 = 0;
    bool masked = false;
    if (hb >= 4) { kpos0 = (qblk - 1) * 128 + (hb - 4) * 64; masked = (hb != 6 && hb != 7); }
    const bf16_t* cK = sK + pbuf * 64 * 72;
    const bf16_t* cV = sV + pbuf * 64 * 72;
    bf16x8 qf[2][4];
#pragma unroll
    for (int j = 0; j < 2; ++j)
#pragma unroll
      for (int ks = 0; ks < 4; ++ks)
        qf[j][ks] = *(const bf16x8*)(Q + (size_t)(qrow0 + j * 32 + fr) * 512 + head * 64 + ks * 16 + fh * 8);
#pragma unroll 1
    for (int kb = 0; kb < 2; ++kb) {
      if (masked) {
        const int klo = kpos0 + kb * 32, khi = klo + 31;
        if (klo - (qpos0 + 63) > 128 || qpos0 - khi > 128) continue;
      }
      bf16x8 pb[2][2];
#pragma unroll
      for (int j = 0; j < 2; ++j) {
        f32x16 st[2];
#pragma unroll
        for (int r = 0; r < 16; ++r) st[j][r] = -m[j];
#pragma unroll
        for (int ks = 0; ks < 4; ++ks) {
          const bf16x8 kf = *(const bf16x8*)&cK[(kb * 32 + fr) * 72 + ks * 16 + fh * 8];
          st[j] = MFMA(kf, qf[j][ks], st[j]);
        }
        if (masked) {
          const int qpos = qpos0 + j * 32 + fr;
#pragma unroll
          for (int r = 0; r < 16; ++r) {
            const int d = qpos - (kpos0 + kb * 32 + crow(r, fh));
            if (d > 128 || d < -128) st[j][r] = -1e30f;
          }
        }
        float mx = st[j][0];
#pragma unroll
        for (int r = 1; r < 16; ++r) mx = fmaxf(mx, st[j][r]);
        mx = fmaxf(mx, __shfl_xor(mx, 32));
        const bool grow = mx > 8.f;
        if (__builtin_amdgcn_ballot_w64(grow) != 0ull) {
          const float delta = grow ? mx : 0.f;
          const float alpha = __builtin_amdgcn_exp2f(-delta);
#pragma unroll
          for (int r = 0; r < 16; ++r) st[j][r] -= delta;
          lsum[j] *= alpha;
          m[j] += delta;
#pragma unroll
          for (int mt = 0; mt < 2; ++mt)
#pragma unroll
            for (int r = 0; r < 16; ++r) o[mt][j][r] *= alpha;
        }
        float rs = 0.f;
#pragma unroll
        for (int r = 0; r < 16; ++r) { const float pv = __builtin_amdgcn_exp2f(st[j][r]); st[j][r] = pv; rs += pv; }
        rs += __shfl_xor(rs, 32);
        lsum[j] += rs;
#pragma unroll
        for (int s = 0; s < 2; ++s) {
          uint4 pk;
          pk.x = pack2(st[j][8 * s + 0], st[j][8 * s + 1]); pk.y = pack2(st[j][8 * s + 2], st[j][8 * s + 3]);
          pk.z = pack2(st[j][8 * s + 4], st[j][8 * s + 5]); pk.w = pack2(st[j][8 * s + 6], st[j][8 * s + 7]);
          pb[j][s] = __builtin_bit_cast(bf16x8, pk);
        }
      }
#pragma unroll
      for (int s = 0; s < 2; ++s)
#pragma unroll
        for (int mt = 0; mt < 2; ++mt) {
          const bf16x8 vf = tr_frag(cV, 72, kb * 32 + 16 * s + 4 * fh, kb * 32 + 16 * s + 8 + 4 * fh, mt * 32);
#pragma unroll
          for (int j = 0; j < 2; ++j) o[mt][j] = MFMA(vf, pb[j][s], o[mt][j]);
        }
    }
    if (nxt < nhb) ATT_STORE(pbuf ^ 1)
    pbuf ^= 1;
    __syncthreads();
  }
#undef ATT_PREFETCH
#undef ATT_STORE
#pragma unroll
  for (int j = 0; j < 2; ++j) {
    const float inv = 1.f / lsum[j];
    const size_t rho = (size_t)(qrow0 + j * 32 + fr);
#pragma unroll
    for (int mt = 0; mt < 2; ++mt)
#pragma unroll
      for (int g4 = 0; g4 < 4; ++g4) {
        const int d0 = mt * 32 + 8 * g4 + 4 * fh;
        const uint2 gv = *(const uint2*)(AG + rho * 512 + head * 64 + d0);
        uint2 ov;
        ov.x = pack2(o[mt][j][g4 * 4 + 0] * inv * silu_f(lo2f(gv.x)), o[mt][j][g4 * 4 + 1] * inv * silu_f(hi2f(gv.x)));
        ov.y = pack2(o[mt][j][g4 * 4 + 2] * inv * silu_f(lo2f(gv.y)), o[mt][j][g4 * 4 + 3] * inv * silu_f(hi2f(gv.y)));
        *(uint2*)(Q + rho * 512 + head * 64 + d0) = ov;
      }
  }
}

DI void states_item(const Params& p_in, char* smem, int ck, int g, int hq) {
  const Params p = load_params();

  bf16_t* sB = (bf16_t*)smem;
  bf16_t* sX = (bf16_t*)(smem + 128 * 136 * 2);
  int tid = threadIdx.x; asm volatile("" : "+v"(tid)); const int lane = tid & 63, wave = tid >> 6, wr = wave >> 1, wc = wave & 1, fr = lane & 31, fh = lane >> 5;
  const bf16_t* BC = (const bf16_t*)(p.ws + OFF_BC);
  const bf16_t* XS = (const bf16_t*)(p.ws + OFF_H);
  const float* DT = (const float*)(p.ws + OFF_DT);
  const float* CS = (const float*)(p.ws + OFF_CS);
  bf16_t* ST = (bf16_t*)(p.ws + OFF_ST);
  float* CDEC = (float*)(p.ws + OFF_CDEC);
  const int row0 = ck * 128;
  __syncthreads();
  for (int v = tid; v < 2048; v += 256) {
    const int r = v >> 4, cv = v & 15;
    *(uint4*)&sB[r * 136 + cv * 8] = *(const uint4*)(BC + (size_t)(row0 + r) * 512 + g * 128 + cv * 8);
  }
  __syncthreads();
  bf16x8 bfr[2][8];
#pragma unroll
  for (int j = 0; j < 2; ++j)
#pragma unroll
    for (int ks = 0; ks < 8; ++ks) bfr[j][ks] = tr_frag(sB, 136, ks * 16 + 8 * fh, ks * 16 + 8 * fh + 4, wc * 64 + j * 32);
  const int slr = tid >> 3, scv = tid & 7;
  uint4 xq0, xq1, xq2, xq3;
  float dq0, dq1, dq2, dq3, cq0, cq1, cq2, cq3, cendq;
#define ST_PREFETCH(HD) { const int head_ = g * 8 + hq * 4 + ((HD) >> 1), d_ = (HD) & 1, col_ = d_ * 16 + head_; \
    const bf16_t* xp_ = XS + (size_t)(row0 + slr) * 1024 + head_ * 64 + scv * 8; \
    xq0 = *(const uint4*)(xp_); xq1 = *(const uint4*)(xp_ + 32 * 1024); xq2 = *(const uint4*)(xp_ + 64 * 1024); xq3 = *(const uint4*)(xp_ + 96 * 1024); \
    const size_t rb_ = (size_t)(row0 + slr) * 32 + col_; \
    dq0 = DT[rb_]; dq1 = DT[rb_ + 32 * 32]; dq2 = DT[rb_ + 64 * 32]; dq3 = DT[rb_ + 96 * 32]; \
    cq0 = CS[rb_]; cq1 = CS[rb_ + 32 * 32]; cq2 = CS[rb_ + 64 * 32]; cq3 = CS[rb_ + 96 * 32]; \
    cendq = CS[(size_t)(row0 + (d_ == 0 ? 127 : 0)) * 32 + col_]; }
#define ST_SCALE_STORE(X, DTV, CSV, ROW) { const float sc_ = (DTV) * __expf(cend - (CSV)); uint4 o_; \
    o_.x = pack2(lo2f(X.x) * sc_, hi2f(X.x) * sc_); o_.y = pack2(lo2f(X.y) * sc_, hi2f(X.y) * sc_); \
    o_.z = pack2(lo2f(X.z) * sc_, hi2f(X.z) * sc_); o_.w = pack2(lo2f(X.w) * sc_, hi2f(X.w) * sc_); \
    *(uint4*)&sX[(ROW) * 72 + scv * 8] = o_; }
  ST_PREFETCH(0)
#pragma unroll 1
  for (int hd = 0; hd < 8; ++hd) {
    const int head = g * 8 + hq * 4 + (hd >> 1), d = hd & 1;
    const float cend = cendq;
    ST_SCALE_STORE(xq0, dq0, cq0, slr)
    ST_SCALE_STORE(xq1, dq1, cq1, slr + 32)
    ST_SCALE_STORE(xq2, dq2, cq2, slr + 64)
    ST_SCALE_STORE(xq3, dq3, cq3, slr + 96)
    if (hd < 7) ST_PREFETCH(hd + 1)
    __syncthreads();
    f32x16 acc[2];
#pragma unroll
    for (int j = 0; j < 2; ++j)
#pragma unroll
      for (int r = 0; r < 16; ++r) acc[j][r] = 0.f;
#pragma unroll
    for (int ks = 0; ks < 8; ++ks) {
      const bf16x8 af = tr_frag(sX, 72, ks * 16 + 8 * fh, ks * 16 + 8 * fh + 4, wr * 32);
#pragma unroll
      for (int j = 0; j < 2; ++j) acc[j] = MFMA(af, bfr[j][ks], acc[j]);
    }
    bf16_t* dst = ST + ((size_t)(ck * 2 + d) * 16 + head) * 8192;
#pragma unroll
    for (int j = 0; j < 2; ++j)
#pragma unroll
      for (int r = 0; r < 16; ++r) dst[(wr * 32 + crow(r, fh)) * 128 + wc * 64 + j * 32 + fr] = f2bf(acc[j][r]);
    if (tid == 0) CDEC[(ck * 2 + d) * 16 + head] = __expf(cend);
    __syncthreads();
  }
}

DI void pw_item(const Params& p_in, int l, char* smem, int mt, int nt) {
  const Params p = load_params();

  GemmS* s = (GemmS*)smem;
  int tid = threadIdx.x; asm volatile("" : "+v"(tid)); const int lane = tid & 63, wave = tid >> 6, wr = wave >> 1, wc = wave & 1, fr = lane & 31, fh = lane >> 5;
  const bf16_t* Ab = (const bf16_t*)(p.ws + OFF_HDN) + (size_t)mt * 128 * 512;
  const bf16_t* Bb = (const bf16_t*)(p.ws + OFF_PW) + (size_t)nt * 128 * 512;
  bf16_t* CG = (bf16_t*)(p.ws + OFF_CG);
  f32x16 acc[2][2];
  zero_acc(acc);
  gemm_core2(acc, (GemmS2*)smem,
             [&](int kt, int r, int kv) { return Ab + (size_t)r * 512 + kt * 64 + kv * 8; },
             [&](int kt, int r, int kv) { return Bb + (size_t)r * 512 + kt * 64 + kv * 8; }, 8, [](int) {});
  const float* pwb = p.conv_pw_b + l * 512 + nt * 128;
  epilogue_lds(acc, smem, [&](int rl, int c4, float4 v) {
    bf16_t* ptr = CG + (size_t)(mt * 128 + rl) * 512 + nt * 128 + c4;
    const uint2 gv = *(const uint2*)ptr;
    const float4 bb = *(const float4*)(pwb + c4);
    uint2 o;
    o.x = pack2((v.x + bb.x) * silu_f(lo2f(gv.x)), (v.y + bb.y) * silu_f(hi2f(gv.x)));
    o.y = pack2((v.z + bb.z) * silu_f(lo2f(gv.y)), (v.w + bb.w) * silu_f(hi2f(gv.y)));
    *(uint2*)ptr = o;
  });
}

DI void phase_mix(const Params& p, int l, char* smem) {
  const int G = gridDim.x;
  const int N_ATT = 512 + (l == 0 ? 32 : 0);
  for (int it = blockIdx.x; it < N_ATT; it += G) {
    if (it < 512) attn_item(p, l, smem, it >> 7, (it >> 2) & 31, (it >> 1) & 1, it & 1, false);
    else { const int t = it - 512; attn_item(p, l, smem, t >> 3, (t >> 2) & 1, (t >> 1) & 1, t & 1, true); }
  }
  for (int it = (blockIdx.x + G - 32) % G; it < NCK * 4; it += G) states_item(p, smem, it >> 2, (it >> 1) & 1, it & 1);
  for (int it = (blockIdx.x + G - 64) % G; it < NCK * 4; it += G) pw_item(p, l, smem, it >> 2, it & 3);
}

DI void phase_scan(const Params& p_in) {
  const Params p = load_params();

  bf16_t* ST = (bf16_t*)(p.ws + OFF_ST);
  const float* CDEC = (const float*)(p.ws + OFF_CDEC);
  for (int it = blockIdx.x; it < 512; it += gridDim.x) {
    const int e = it * 256 + threadIdx.x;
    const int bdh = e >> 10, v8 = e & 1023;
    const int b = bdh >> 5, d = (bdh >> 4) & 1, h = bdh & 15;
    float s[8];
#pragma unroll
    for (int i = 0; i < 8; ++i) s[i] = 0.f;
    auto ckof = [&](int i) {
      if (d == 0) return (i < 2) ? (128 + 2 * b + i) : (32 * b + (i - 2));
      return (i < 2) ? (128 + 2 * b + (1 - i)) : (32 * b + 31 - (i - 2));
    };
    auto pof = [&](int i) { const int ck = ckof(i); return (uint4*)(ST + ((size_t)(ck * 2 + d) * 16 + h) * 8192 + v8 * 8); };
    auto dof = [&](int i) { const int ck = ckof(i); return CDEC[(ck * 2 + d) * 16 + h]; };
    uint4 buf[8]; float dc[8];
#pragma unroll
    for (int i = 0; i < 7; ++i) { buf[i] = *pof(i); dc[i] = dof(i); }
#pragma unroll
    for (int i = 0; i < 34; ++i) {
      if (i + 7 < 34) { buf[(i + 7) & 7] = *pof(i + 7); dc[(i + 7) & 7] = dof(i + 7); }
      const uint4 cur = buf[i & 7];
      const float dec = dc[i & 7];
      uint4 o;
      o.x = pack2(s[0], s[1]); o.y = pack2(s[2], s[3]); o.z = pack2(s[4], s[5]); o.w = pack2(s[6], s[7]);
      *pof(i) = o;
      s[0] = s[0] * dec + lo2f(cur.x); s[1] = s[1] * dec + hi2f(cur.x);
      s[2] = s[2] * dec + lo2f(cur.y); s[3] = s[3] * dec + hi2f(cur.y);
      s[4] = s[4] * dec + lo2f(cur.z); s[5] = s[5] * dec + hi2f(cur.z);
      s[6] = s[6] * dec + lo2f(cur.w); s[7] = s[7] * dec + hi2f(cur.w);
    }
  }
}

DI void phase_ssdy(const Params& p_in, int l, char* smem) {
  const Params p = load_params();

  bf16_t* sB = (bf16_t*)smem;
  bf16_t* sX = (bf16_t*)(smem + 128 * 136 * 2);
  float* sF = (float*)(smem + 128 * 136 * 2 + 128 * 72 * 2);
  float* sSS = sF + 512;
  int tid = threadIdx.x; asm volatile("" : "+v"(tid)); const int lane = tid & 63, wave = tid >> 6, fr = lane & 31, fh = lane >> 5;
  const int wl = wave >> 1, w2 = wave & 1;
  const bf16_t* BC = (const bf16_t*)(p.ws + OFF_BC);
  const bf16_t* XS = (const bf16_t*)(p.ws + OFF_H);
  const float* DT = (const float*)(p.ws + OFF_DT);
  const float* CS = (const float*)(p.ws + OFF_CS);
  const bf16_t* ST = (const bf16_t*)(p.ws + OFF_ST);
  bf16_t* Z = (bf16_t*)(p.ws + OFF_Z);
  float* RSTD = (float*)(p.ws + OFF_RSTD);
  const int nck = (l == 0) ? NCK : 128;
  const int nh = (l == 0) ? 2 : 8;
  const int nsplit = 8 / nh;
  for (int it0 = blockIdx.x; it0 < nck * 4 * nsplit; it0 += gridDim.x) {
    const int hq = it0 % nsplit, it = it0 / nsplit;
    const int hbeg = hq * nh, hend = hbeg + nh;
    const int ck = it >> 2, g = (it >> 1) & 1, lh = it & 1;
    const int row0 = ck * 128;
    const int lbase = lh * 64 + wl * 32;
    __syncthreads();
    for (int v = tid; v < 2048; v += 256) {
      const int r = v >> 4, cv = v & 15;
      *(uint4*)&sB[r * 136 + cv * 8] = *(const uint4*)(BC + (size_t)(row0 + r) * 512 + g * 128 + cv * 8);
    }
    if (tid < 64) sSS[tid] = 0.f;
    const bf16_t* cptr = BC + (size_t)(row0 + lbase + fr) * 512 + 256 + g * 128 + fh * 8;
    bf16x8 cf[8];
#pragma unroll
    for (int ks = 0; ks < 8; ++ks) cf[ks] = *(const bf16x8*)(cptr + ks * 16);
    const int lrx = tid >> 3, cvx = tid & 7;
    const bf16_t* xsrc = XS + (size_t)(row0 + lrx) * 1024 + cvx * 8;
    uint4 xp0, xp1, xp2, xp3;
    float fp0 = 0.f, fp1 = 0.f, fp2 = 0.f, fp3 = 0.f;
    {
      const int head = g * 8 + hbeg;
      xp0 = *(const uint4*)(xsrc + head * 64);
      xp1 = *(const uint4*)(xsrc + head * 64 + 32 * 1024);
      xp2 = *(const uint4*)(xsrc + head * 64 + 64 * 1024);
      xp3 = *(const uint4*)(xsrc + head * 64 + 96 * 1024);
      if (tid < 128) {
        const size_t rho = (size_t)(row0 + tid);
        fp0 = CS[rho * 32 + head]; fp1 = CS[rho * 32 + 16 + head]; fp2 = DT[rho * 32 + head]; fp3 = DT[rho * 32 + 16 + head];
      }
    }
    __syncthreads();
    f32x16 cb[2];
#pragma unroll
    for (int j = 0; j < 2; ++j) {
#pragma unroll
      for (int r = 0; r < 16; ++r) cb[j][r] = 0.f;
#pragma unroll
      for (int ks = 0; ks < 8; ++ks) {
        const bf16x8 bq = *(const bf16x8*)&sB[(w2 * 64 + j * 32 + fr) * 136 + ks * 16 + fh * 8];
        cb[j] = MFMA(cf[ks], bq, cb[j]);
      }
    }
    const int pidx = w2 * 32 + fr;
    bf16_t* sCB = sB + 64 * 136;
    __syncthreads();
#pragma unroll
    for (int j = 0; j < 2; ++j)
#pragma unroll
      for (int r = 0; r < 16; ++r) sCB[(wl * 32 + crow(r, fh)) * 136 + w2 * 64 + j * 32 + fr] = f2bf(cb[j][r]);
#pragma unroll 1
    for (int hh = hbeg; hh < hend; ++hh) {
      const int head = g * 8 + hh;
      __syncthreads();
      *(uint4*)&sX[lrx * 72 + cvx * 8] = xp0;
      *(uint4*)&sX[(lrx + 32) * 72 + cvx * 8] = xp1;
      *(uint4*)&sX[(lrx + 64) * 72 + cvx * 8] = xp2;
      *(uint4*)&sX[(lrx + 96) * 72 + cvx * 8] = xp3;
      if (tid < 128) { sF[tid] = fp0; sF[128 + tid] = fp1; sF[256 + tid] = fp2; sF[384 + tid] = fp3; }
      const bf16_t* S0 = ST + ((size_t)(ck * 2 + 0) * 16 + head) * 8192 + (w2 * 32 + fr) * 128 + fh * 8;
      const bf16_t* S1 = ST + ((size_t)(ck * 2 + 1) * 16 + head) * 8192 + (w2 * 32 + fr) * 128 + fh * 8;
      bf16x8 sf0[8];
#pragma unroll
      for (int ks = 0; ks < 8; ++ks) sf0[ks] = *(const bf16x8*)(S0 + ks * 16);
      bf16_t* zbase = Z + (size_t)(row0 + lbase + 4 * fh) * 1024 + head * 64 + pidx;
      if (hh + 1 < hend) {
        const int hn = head + 1;
        xp0 = *(const uint4*)(xsrc + hn * 64);
        xp1 = *(const uint4*)(xsrc + hn * 64 + 32 * 1024);
        xp2 = *(const uint4*)(xsrc + hn * 64 + 64 * 1024);
        xp3 = *(const uint4*)(xsrc + hn * 64 + 96 * 1024);
        if (tid < 128) {
          const size_t rho = (size_t)(row0 + tid);
          fp0 = CS[rho * 32 + hn]; fp1 = CS[rho * 32 + 16 + hn]; fp2 = DT[rho * 32 + hn]; fp3 = DT[rho * 32 + 16 + hn];
        }
      }
      __syncthreads();
#pragma unroll
      for (int j = 0; j < 2; ++j) {
        const int sidx = w2 * 64 + j * 32 + fr;
        const float csf_s = sF[sidx], csb_s = sF[128 + sidx], dtf_s = sF[256 + sidx], dtb_s = sF[384 + sidx];
#pragma unroll 4
        for (int r = 0; r < 16; ++r) {
          const int lidx = lbase + crow(r, fh);
          float f = 0.f;
          if (sidx <= lidx) f += __expf(sF[lidx] - csf_s) * dtf_s;
          if (sidx >= lidx) f += __expf(sF[128 + lidx] - csb_s) * dtb_s;
          sB[(wl * 32 + crow(r, fh)) * 136 + sidx] = f2bf(bf2f(sCB[(wl * 32 + crow(r, fh)) * 136 + sidx]) * f);
        }
      }
      __syncthreads();
      bf16x8 sf1[8], cfh[8];
#pragma unroll
      for (int ks = 0; ks < 8; ++ks) { sf1[ks] = *(const bf16x8*)(S1 + ks * 16); cfh[ks] = *(const bf16x8*)(cptr + ks * 16); }
      unsigned short zv[16];
#pragma unroll
      for (int r = 0; r < 16; ++r) zv[r] = zbase[(size_t)((r & 3) + 8 * (r >> 2)) * 1024];
      f32x16 accy;
#pragma unroll
      for (int r = 0; r < 16; ++r) accy[r] = 0.f;
#pragma unroll
      for (int ks = 0; ks < 8; ++ks) {
        const bf16x8 af = *(const bf16x8*)&sB[(wl * 32 + fr) * 136 + ks * 16 + fh * 8];
        const bf16x8 xf = tr_frag(sX, 72, ks * 16 + 8 * fh, ks * 16 + 8 * fh + 4, w2 * 32);
        accy = MFMA(af, xf, accy);
      }
      {
        f32x16 acct;
#pragma unroll
        for (int r = 0; r < 16; ++r) acct[r] = 0.f;
#pragma unroll
        for (int ks = 0; ks < 8; ++ks) acct = MFMA(cfh[ks], sf0[ks], acct);
#pragma unroll
        for (int r = 0; r < 16; ++r) accy[r] += __expf(sF[lbase + crow(r, fh)]) * acct[r];
#pragma unroll
        for (int r = 0; r < 16; ++r) acct[r] = 0.f;
#pragma unroll
        for (int ks = 0; ks < 8; ++ks) acct = MFMA(cfh[ks], sf1[ks], acct);
#pragma unroll
        for (int r = 0; r < 16; ++r) accy[r] += __expf(sF[128 + lbase + crow(r, fh)]) * acct[r];
      }
      const float dsk = p.ssd_d[l * 16 + head];
      float v[16];
#pragma unroll
      for (int r = 0; r < 16; ++r) {
        const int lidx = lbase + crow(r, fh);
        const float xv = bf2f(sX[lidx * 72 + pidx]);
        const float y = accy[r] + dsk * xv;
        const float u = y * silu_f(bf2f(zv[r]));
        v[r] = u * u;
        zbase[(size_t)((r & 3) + 8 * (r >> 2)) * 1024] = f2bf(u);
      }
#pragma unroll
      for (int i = 0; i < 8; ++i) { const bool up = (fr & 16) != 0; const float keep = up ? v[i + 8] : v[i]; const float send = up ? v[i] : v[i + 8]; v[i] = keep + __shfl_xor(send, 16); }
#pragma unroll
      for (int i = 0; i < 4; ++i) { const bool up = (fr & 8) != 0; const float keep = up ? v[i + 4] : v[i]; const float send = up ? v[i] : v[i + 4]; v[i] = keep + __shfl_xor(send, 8); }
#pragma unroll
      for (int i = 0; i < 2; ++i) { const bool up = (fr & 4) != 0; const float keep = up ? v[i + 2] : v[i]; const float send = up ? v[i] : v[i + 2]; v[i] = keep + __shfl_xor(send, 4); }
      { const bool up = (fr & 2) != 0; const float keep = up ? v[1] : v[0]; const float send = up ? v[0] : v[1]; v[0] = keep + __shfl_xor(send, 2); }
      v[0] += __shfl_xor(v[0], 1);
      if ((fr & 1) == 0) atomicAdd(&sSS[wl * 32 + crow(fr >> 1, fh)], v[0]);
    }
    __syncthreads();
    if (tid < 64) atomicAdd(&RSTD[(size_t)(row0 + lh * 64 + tid) * 2 + g], sSS[tid]);
  }
}

DI void phase_outproj(const Params& p_in, int l, char* smem) {
  const Params p = load_params();

  GemmS* s = (GemmS*)smem;
  int tid = threadIdx.x; asm volatile("" : "+v"(tid)); const int lane = tid & 63, wave = tid >> 6, wr = wave >> 1, wc = wave & 1, fr = lane & 31, fh = lane >> 5;
  const bf16_t* Zb = (const bf16_t*)(p.ws + OFF_Z);
  const bf16_t* Qb = (const bf16_t*)(p.ws + OFF_Q);
  const bf16_t* Cb = (const bf16_t*)(p.ws + OFF_CG);
  const bf16_t* W = (const bf16_t*)(p.ws + OFF_WOUT);
  const float* RSTD = (const float*)(p.ws + OFF_RSTD);
  const float* mods = (const float*)(p.ws + OFF_MODS);
  float* XC = (float*)(p.ws + OFF_XC);
  for (int step = 0;; ++step) {
    int mt, nt2;
    if (!xcd_tile(step, 128, 4, mt, nt2)) break;
    f32x16 acc[2][4];
#pragma unroll
    for (int i = 0; i < 2; ++i)
#pragma unroll
      for (int j = 0; j < 4; ++j)
#pragma unroll
        for (int r = 0; r < 16; ++r) acc[i][j][r] = 0.f;
    const bf16_t* Wb = W + (size_t)nt2 * 256 * 2048;
    const bf16_t* A0 = Zb + (size_t)mt * 128 * 1024;
    const bf16_t* A2 = Qb + (size_t)mt * 128 * 512;
    const bf16_t* A3 = Cb + (size_t)mt * 128 * 512;
    float* sScale = (float*)(smem + 55296);
    __syncthreads();
    if (tid < 128) {
      const size_t row = (size_t)(mt * 128 + tid);
      const float r0 = rsqrtf(RSTD[row * 2] * (1.f / 512.f) + 1e-6f);
      const float r1 = rsqrtf(RSTD[row * 2 + 1] * (1.f / 512.f) + 1e-6f);
      sScale[tid * 2] = r0 / r1;
      sScale[tid * 2 + 1] = r1;
    }
    gemm_core3(acc, (GemmS3*)smem,
               [&](int kt, int r, int kv) {
                 const bf16_t* ptr;
                 if (kt < 16) ptr = A0 + (size_t)r * 1024 + kt * 64;
                 else if (kt < 24) ptr = A2 + (size_t)r * 512 + (kt - 16) * 64;
                 else ptr = A3 + (size_t)r * 512 + (kt - 24) * 64;
                 return ptr + kv * 8;
               },
               [&](int kt, int r, int kv) { return Wb + (size_t)r * 2048 + kt * 64 + kv * 8; }, 32,
               [&](int kt) __attribute__((always_inline)) {
                 if (kt == 8 || kt == 16) {
#pragma unroll
                   for (int i = 0; i < 2; ++i)
#pragma unroll
                     for (int r = 0; r < 16; ++r) {
                       const float f = sScale[(wr * 64 + i * 32 + crow(r, fh)) * 2 + (kt == 16 ? 1 : 0)];
                       acc[i][0][r] *= f; acc[i][1][r] *= f; acc[i][2][r] *= f; acc[i][3][r] *= f;
                     }
                 }
               });
    {
      const int row0 = mt * 128;
      const int vv = row0 >> 12;
      float* xnew = p.out + (size_t)row0 * 1024;
      const float* xold = (l == 0) ? (p.x + (size_t)row0 * 1024) : xnew;
#pragma unroll 1
      for (int sub = 0; sub < 2; ++sub) {
        const int nt = nt2 * 2 + sub;
        const float* gate = mods + (l * 5 + vv) * 3072 + 2048 + nt * 128;
        epilogue_lds2(acc, smem, sub, [&](int rl, int c4, float4 v) {
          const int off = rl * 1024 + nt * 128 + c4;
          const float4 xo = *(const float4*)(xold + off);
          const float4 gt = *(const float4*)(gate + c4);
          float4 o;
          o.x = xo.x + gt.x * v.x; o.y = xo.y + gt.y * v.y; o.z = xo.z + gt.z * v.z; o.w = xo.w + gt.w * v.w;
          *(float4*)(xnew + off) = o;
        });
      }
    }
  }
  const int nctx = (l == 0) ? 64 : 0;
  for (int it = (int)blockIdx.x; it < nctx; it += gridDim.x) {
    const int mt = 128 + (it >> 3), nt = it & 7;
    f32x16 acc[2][2];
    zero_acc(acc);
    const bf16_t* Wb = W + (size_t)nt * 128 * 2048;
    const bf16_t* A0 = Zb + (size_t)mt * 128 * 1024;
    const bf16_t* A2 = Qb + (size_t)mt * 128 * 512;
    const bf16_t* A3 = Cb + (size_t)mt * 128 * 512;
    float* sScale = (float*)(smem + 40960);
    if (tid < 128) {
      const size_t row = (size_t)(mt * 128 + tid);
      const float r0 = rsqrtf(RSTD[row * 2] * (1.f / 512.f) + 1e-6f);
      const float r1 = rsqrtf(RSTD[row * 2 + 1] * (1.f / 512.f) + 1e-6f);
      sScale[tid * 2] = r0 / r1;
      sScale[tid * 2 + 1] = r1;
    }
    gemm_core2(acc, (GemmS2*)smem,
               [&](int kt, int r, int kv) {
                 const bf16_t* ptr;
                 if (kt < 16) ptr = A0 + (size_t)r * 1024 + kt * 64;
                 else if (kt < 24) ptr = A2 + (size_t)r * 512 + (kt - 16) * 64;
                 else ptr = A3 + (size_t)r * 512 + (kt - 24) * 64;
                 return ptr + kv * 8;
               },
               [&](int kt, int r, int kv) { return Wb + (size_t)r * 2048 + kt * 64 + kv * 8; }, 32,
               [&](int kt) __attribute__((always_inline)) {
                 if (kt == 8 || kt == 16) {
#pragma unroll
                   for (int i = 0; i < 2; ++i)
#pragma unroll
                     for (int r = 0; r < 16; ++r) {
                       const float f = sScale[(wr * 64 + i * 32 + crow(r, fh)) * 2 + (kt == 16 ? 1 : 0)];
                       acc[i][0][r] *= f; acc[i][1][r] *= f;
                     }
                 }
               });
    {
      const int row0 = mt * 128;
      const int vv = (row0 < RL_) ? (row0 >> 12) : 4;
      const float* gate = mods + (l * 5 + vv) * 3072 + 2048 + nt * 128;
      float* xnew = (row0 < RL_) ? (p.out + (size_t)row0 * 1024) : (XC + (size_t)(row0 - RL_) * 1024);
      const float* xold = (l == 0) ? ((row0 < RL_) ? (p.x + (size_t)row0 * 1024) : (p.ctx + (size_t)(row0 - RL_) * 1024)) : xnew;
      epilogue_lds(acc, smem, [&](int rl, int c4, float4 v) {
        const int off = rl * 1024 + nt * 128 + c4;
        const float4 xo = *(const float4*)(xold + off);
        const float4 gt = *(const float4*)(gate + c4);
        float4 o;
        o.x = xo.x + gt.x * v.x; o.y = xo.y + gt.y * v.y; o.z = xo.z + gt.z * v.z; o.w = xo.w + gt.w * v.w;
        *(float4*)(xnew + off) = o;
      });
    }
  }
  if (l == 0) {
    const int local = blockIdx.x >> 3, xcd = blockIdx.x & 7, nloc = gridDim.x >> 3;
    if (local >= 8 && nloc > 8) {
      const int nb = (nloc - 8) * 8;
      const int NT_WIN = 88 * 16, NT_PW = 64;
      for (int it = (local - 8) * 8 + xcd; it < NT_WIN + NT_PW; it += nb) {
        if (it < NT_WIN) transpose_tile(p.w_in + (size_t)1024 * 5408, 5408, 0, nullptr, (bf16_t*)(p.ws + OFF_WIN), 1024, (it / 16) * 64, (it % 16) * 64, (float*)smem);
        else { const int t = it - NT_WIN; transpose_tile(p.conv_pw_w + (size_t)512 * 512, 512, 1, nullptr, (bf16_t*)(p.ws + OFF_PW), 512, (t / 8) * 64, (t % 8) * 64, (float*)smem); }
      }
    }
  }
}

DI void phase_final(const Params& p_in) {
  const Params p = load_params();
  const int lane = threadIdx.x & 63, wave = threadIdx.x >> 6;
  for (int it = blockIdx.x; it < RL_ / 8; it += gridDim.x) {
    float* xr0 = p.out + (size_t)(it * 8 + wave * 2) * 1024;
    float4 xv[2][4];
#pragma unroll
    for (int q = 0; q < 2; ++q)
#pragma unroll
      for (int i = 0; i < 4; ++i) xv[q][i] = *(const float4*)(xr0 + q * 1024 + lane * 4 + i * 256);
    float4 w[4];
#pragma unroll
    for (int i = 0; i < 4; ++i) w[i] = *(const float4*)(p.final_norm_w + lane * 4 + i * 256);
#pragma unroll
    for (int q = 0; q < 2; ++q) {
      float ss = 0.f;
#pragma unroll
      for (int i = 0; i < 4; ++i) ss += xv[q][i].x * xv[q][i].x + xv[q][i].y * xv[q][i].y + xv[q][i].z * xv[q][i].z + xv[q][i].w * xv[q][i].w;
#pragma unroll
      for (int o = 32; o >= 1; o >>= 1) ss += __shfl_xor(ss, o);
      const float rs = rsqrtf(ss * (1.f / 1024.f) + 1e-6f);
#pragma unroll
      for (int i = 0; i < 4; ++i) {
        float4 o;
        o.x = xv[q][i].x * rs * w[i].x; o.y = xv[q][i].y * rs * w[i].y; o.z = xv[q][i].z * rs * w[i].z; o.w = xv[q][i].w * rs * w[i].w;
        *(float4*)(xr0 + q * 1024 + lane * 4 + i * 256) = o;
      }
    }
  }
}

template <int PH>
DI void run_phase(const Params& p, char* smem) {
  constexpr int l = (PH - 1) / 7, s = (PH - 1) % 7;
  if constexpr (PH == 0) phase_mods(p, smem);
  else if constexpr (PH == 15) phase_final(p);
  else if constexpr (s == 0) phase_prep(p, l, smem);
  else if constexpr (s == 1) phase_inproj(p, smem);
  else if constexpr (s == 2) phase_local(p, l, smem);
  else if constexpr (s == 3) phase_mix(p, l, smem);
  else if constexpr (s == 4) phase_scan(p);
  else if constexpr (s == 5) phase_ssdy(p, l, smem);
  else phase_outproj(p, l, smem);
}

#if PROBE_S >= 0
#define PROBE_BEGIN() if (threadIdx.x == 0) pst[1] = wall_clock64();
#define PROBE_END(PH) if (threadIdx.x == 0 && (PH) >= 1 && (PH) <= 14 && (((PH) - 1) % 7) == PROBE_S) pst[0] += wall_clock64() - pst[1];
#else
#define PROBE_BEGIN()
#define PROBE_END(PH)
#endif
#define PHASE(PH) PROBE_BEGIN() run_phase<PH>(p, smem); xcd_barrier(xst); PROBE_END(PH)

__global__ void __launch_bounds__(256, 2) fwd_megakernel(Params p) {
  __shared__ __attribute__((aligned(16))) char smem[57344];
  cg::grid_group grid = cg::this_grid();
#if PROBE_S >= 0
  volatile unsigned long long* pst = (volatile unsigned long long*)(smem + 57344 - 16);
  if (threadIdx.x == 0) { pst[0] = 0; pst[1] = 0; }
#endif
  __shared__ uint4 xb_words;
  volatile LAS unsigned* xst = (volatile LAS unsigned*)&xb_words;
  if (threadIdx.x == 0) xb_words = make_uint4(0u, 0u, 0u, 0u);
  run_phase<0>(p, smem);
  grid.sync();
  if (threadIdx.x == 0) { unsigned* bar = (unsigned*)(load_params().ws + OFF_BAR); (void)xb_add(&bar[XB_XCNT(xb_xcc_id())], 1u); }
  PHASE(1) PHASE(2) PHASE(3) PHASE(4) PHASE(5) PHASE(6) PHASE(7)
  PHASE(8) PHASE(9) PHASE(10) PHASE(11) PHASE(12) PHASE(13) PHASE(14)
  run_phase<15>(p, smem);
#if PROBE_S >= 0
  if (blockIdx.x == 0 && threadIdx.x == 0) {
    const unsigned long long t1 = wall_clock64();
    const unsigned long long lim = 4ull * pst[0];
    while (wall_clock64() - t1 < lim) { __builtin_amdgcn_s_sleep(32); }
  }
#endif
}

extern "C" void kernel_launch(void* const* d_in, const int* in_sizes, int n_in, void* d_out, int out_size, void* d_ws,
                              size_t ws_size, hipStream_t stream) {
  static int grid_blocks = 0;
  if (!grid_blocks) {
    int dev = 0, cus = 0, per_cu = 0;
    hipGetDevice(&dev);
    hipDeviceGetAttribute(&cus, hipDeviceAttributeMultiprocessorCount, dev);
    hipOccupancyMaxActiveBlocksPerMultiprocessor(&per_cu, fwd_megakernel, 256, 0);
    if (per_cu < 1) per_cu = 1;
    if (per_cu > 2) per_cu = 2;
    grid_blocks = (cus * per_cu) & ~7;
  }
  Params p{};
  const float** pp = (const float**)&p;
  for (int i = 0; i < 23; ++i) pp[i] = (const float*)d_in[i];
  p.out = (float*)d_out;
  p.ws = (char*)d_ws;
  void* args[] = {&p};
  hipError_t e = hipLaunchCooperativeKernel((void*)fwd_megakernel, dim3(grid_blocks), dim3(256), args, 0, stream);
  if (e != hipSuccess) fprintf(stderr, "cooperative launch failed: %s (grid %d)\n", hipGetErrorString(e), grid_blocks);
}
```

```cpp
#include <hip/hip_runtime.h>
#include <hip/hip_cooperative_groups.h>
#include <stdint.h>
#include <stdio.h>
namespace cg = cooperative_groups;

#ifndef ONE_LAUNCH
#define ONE_LAUNCH 1
#endif

#ifndef PROBE_S
#define PROBE_S -1
#endif
#define DI __device__ __forceinline__
typedef unsigned short bf16_t;
using bf16x8 = __attribute__((ext_vector_type(8))) short;
using s16x4 = __attribute__((ext_vector_type(4))) short;
using f32x16 = __attribute__((ext_vector_type(16))) float;
#define MFMA(a, b, c) __builtin_amdgcn_mfma_f32_32x32x16_bf16((a), (b), (c), 0, 0, 0)

constexpr int R_ = 17408;
constexpr int RL_ = 16384;
constexpr int NCK = 136;

constexpr size_t SZ_WIN = (size_t)5632 * 1024 * 2;
constexpr size_t SZ_WOUT = (size_t)1024 * 2048 * 2;
constexpr size_t SZ_PW = (size_t)512 * 512 * 2;
constexpr size_t SZ_MODS = (size_t)2 * 5 * 3072 * 4;
constexpr size_t SZ_XC = (size_t)1024 * 1024 * 4;
constexpr size_t SZ_RSTD = (size_t)R_ * 2 * 4;
constexpr size_t SZ_CDEC = (size_t)NCK * 32 * 4 + 256 - ((size_t)NCK * 32 * 4) % 256;
constexpr size_t SZ_R512 = (size_t)R_ * 512 * 2;
constexpr size_t OFF_WIN = 0;
constexpr size_t OFF_WOUT = OFF_WIN + SZ_WIN;
constexpr size_t OFF_PW = OFF_WOUT + SZ_WOUT;
constexpr size_t OFF_MODS = OFF_PW + SZ_PW;
constexpr size_t OFF_XC = OFF_MODS + SZ_MODS;
constexpr size_t OFF_RSTD = OFF_XC + SZ_XC;
constexpr size_t OFF_CDEC = OFF_RSTD + SZ_RSTD;
constexpr size_t OFF_H = OFF_CDEC + SZ_CDEC;
constexpr size_t OFF_XBC = OFF_H + 2 * SZ_R512;
constexpr size_t OFF_GLU = OFF_XBC + 3 * SZ_R512;
constexpr size_t OFF_ST = OFF_XBC;
constexpr size_t OFF_Z = OFF_GLU + SZ_R512;
constexpr size_t OFF_DT = OFF_Z + 2 * SZ_R512;
constexpr size_t OFF_CS = OFF_DT + (size_t)R_ * 32 * 4;
constexpr size_t OFF_Q = OFF_CS + (size_t)R_ * 32 * 4;
constexpr size_t OFF_KV = OFF_Q + SZ_R512;
constexpr size_t OFF_AG = OFF_KV + SZ_R512 / 2;
constexpr size_t OFF_CG = OFF_AG + SZ_R512;
constexpr size_t OFF_BC = OFF_CG + SZ_R512;
constexpr size_t OFF_HDN = OFF_BC + SZ_R512;
constexpr size_t WS_TOTAL = OFF_HDN + SZ_R512;
constexpr size_t OFF_BAR = WS_TOTAL;
static_assert(OFF_BAR + 16384 <= (size_t)256 * 1024 * 1024, "workspace too large");

struct Params {
  const float *x, *c, *ctx, *c_ctx, *w_mod, *b_mod, *norm_w, *w_in, *ssd_conv_w, *ssd_conv_b, *ssd_dt_bias, *ssd_a_log,
      *ssd_d, *ssd_norm_w, *attn_sink, *conv_dw_w, *conv_dw_b, *conv_ln_w, *conv_ln_b, *conv_pw_w, *conv_pw_b, *w_out,
      *final_norm_w;
  float* out;
  char* ws;
};


__shared__ unsigned long long g_kernarg;
DI Params load_params() {
  typedef const char __attribute__((address_space(4)))* kptr_t;
  typedef const float* const __attribute__((address_space(4)))* kfld_t;
  const unsigned long long v = *(volatile unsigned long long*)&g_kernarg;
  const unsigned lo = __builtin_amdgcn_readfirstlane((unsigned)v), hi = __builtin_amdgcn_readfirstlane((unsigned)(v >> 32));
  kptr_t base = (kptr_t)(((unsigned long long)hi << 32) | lo);
  Params p;
  const float** pp = (const float**)&p;
#pragma unroll
  for (int i = 0; i < 25; ++i) pp[i] = *(kfld_t)(base + 8 * i);
  return p;
}

#define XB_TMO      128
#define XB_XCNT(j)  (256  + 64 * (j))
#define XB_XSUB(j)  (1280 + 64 * (j))
#define XB_XGEN(j)  (2304 + 64 * (j))
#define XB_TOP      3328
#define XB_TOPGEN   3392
#define XCD_BAR_WORDS 3456
#define XB_SPIN_CAP (1u << 18)
#define LAS __attribute__((address_space(3)))
DI unsigned xb_ld(unsigned* p)              { return __hip_atomic_load(p, __ATOMIC_RELAXED, __HIP_MEMORY_SCOPE_AGENT); }
DI unsigned xb_add(unsigned* p, unsigned v) { return __hip_atomic_fetch_add(p, v, __ATOMIC_RELAXED, __HIP_MEMORY_SCOPE_AGENT); }
DI unsigned xb_xcc_id() { return (unsigned)__builtin_amdgcn_s_getreg((3 << 11) | 20) & 0xFu; }
#define XB_SPIN(cond, bar) do { unsigned _sp = 0; while (cond) { __builtin_amdgcn_s_sleep(1); \
    if ((++_sp & 255u) == 0u) { if (xb_ld(&(bar)[XB_TMO])) break; if (_sp > XB_SPIN_CAP) { atomicAdd(&(bar)[XB_TMO], 1u); break; } } } } while (0)

DI void xcd_barrier_complete(unsigned* bar, unsigned x, unsigned& nloc, unsigned& nx) {
  const unsigned G = gridDim.x * gridDim.y * gridDim.z;
  unsigned sum, cnt, mine, sp = 0u;
  for (;;) {
    sum = 0u; cnt = 0u; mine = 0u;
#pragma unroll
    for (unsigned j = 0; j < 16; ++j) { const unsigned c = xb_ld(&bar[XB_XCNT(j)]); sum += c; cnt += (c > 0u) ? 1u : 0u; mine = (j == x) ? c : mine; }
    if (sum == G) break;
    __builtin_amdgcn_s_sleep(1);
    if ((++sp & 255u) == 0u) { if (xb_ld(&bar[XB_TMO])) break; if (sp > XB_SPIN_CAP) { atomicAdd(&bar[XB_TMO], 1u); break; } }
  }
  nloc = mine > 0u ? mine : 1u; nx = cnt > 0u ? cnt : 1u;
}

DI void xcd_barrier(volatile LAS unsigned* st) {
  asm volatile("s_waitcnt vmcnt(0)" ::: "memory");
  __syncthreads();
  if (threadIdx.x == 0) {
    const Params pb = load_params();
    unsigned* bar = (unsigned*)(pb.ws + OFF_BAR);
    const unsigned x = xb_xcc_id();
    __builtin_amdgcn_s_waitcnt(0);
    unsigned nloc = st[0], nx = st[1];
    if (nloc == 0u) { xcd_barrier_complete(bar, x, nloc, nx); st[0] = nloc; st[1] = nx; }
    const unsigned old = xb_add(&bar[XB_XSUB(x)], 1u);
    const unsigned gen = old / nloc;
    if (old + 1u == (gen + 1u) * nloc) {
      __builtin_amdgcn_fence(__ATOMIC_RELEASE, "agent");
      asm volatile("s_waitcnt vmcnt(0)" ::: "memory");
      const unsigned og = xb_add(&bar[XB_TOP], 1u);
      const unsigned tg = og / nx;
      if (og + 1u == (tg + 1u) * nx) xb_add(&bar[XB_TOPGEN], 1u);
      else XB_SPIN(xb_ld(&bar[XB_TOPGEN]) == tg, bar);
      __builtin_amdgcn_fence(__ATOMIC_ACQUIRE, "agent");
      xb_add(&bar[XB_XGEN(x)], 1u);
      asm volatile("s_waitcnt vmcnt(0)" ::: "memory");
    } else {
      XB_SPIN(xb_ld(&bar[XB_XGEN(x)]) == gen, bar);
      __builtin_amdgcn_fence(__ATOMIC_ACQUIRE, "agent");
      asm volatile("s_waitcnt vmcnt(0)" ::: "memory");
    }
  }
  __syncthreads();
}

typedef __bf16 nbf16x2_t __attribute__((ext_vector_type(2)));
typedef float nf32x2_t __attribute__((ext_vector_type(2)));
DI unsigned short f2bf(float x) { const __bf16 r = (__bf16)x; return __builtin_bit_cast(unsigned short, r); }
DI float bf2f(unsigned short b) { return __uint_as_float(((unsigned)b) << 16); }
DI unsigned pack2(float a, float b) { const nf32x2_t v = {a, b}; const nbf16x2_t r = __builtin_convertvector(v, nbf16x2_t); return __builtin_bit_cast(unsigned, r); }
DI float lo2f(unsigned u) { return __uint_as_float(u << 16); }
DI float hi2f(unsigned u) { return __uint_as_float(u & 0xffff0000u); }
DI float silu_f(float x) { return x / (1.f + __expf(-x)); }
DI float sigmoid_f(float x) { return 1.f / (1.f + __expf(-x)); }
DI int crow(int reg, int h) { return (reg & 3) + 8 * (reg >> 2) + 4 * h; }

DI bf16x8 tr_frag(const bf16_t* s, int ld, int row_lo, int row_hi, int col0) {
  const int lane = threadIdx.x & 63;
  const int i16 = lane & 15, q = i16 >> 2, pp = i16 & 3, blk = (lane >> 4) & 1;
  const unsigned a0 = (unsigned)(size_t)(s + (row_lo + q) * ld + col0 + 16 * blk + 4 * pp);
  const unsigned a1 = (unsigned)(size_t)(s + (row_hi + q) * ld + col0 + 16 * blk + 4 * pp);
  s16x4 lo, hi;
  asm volatile("ds_read_b64_tr_b16 %0, %2\n\tds_read_b64_tr_b16 %1, %3\n\ts_waitcnt lgkmcnt(0)"
               : "=&v"(lo), "=&v"(hi) : "v"(a0), "v"(a1) : "memory");
  return __builtin_shufflevector(lo, hi, 0, 1, 2, 3, 4, 5, 6, 7);
}

struct GemmS { bf16_t a[2][128][40]; bf16_t b[2][128][40]; };

template <class AF, class BF>
DI void gemm_core(f32x16 (&acc)[2][2], GemmS* s, AF aptr, BF bptr, int nk) {
  int tid = threadIdx.x; asm volatile("" : "+v"(tid)); const int lane = tid & 63, wave = tid >> 6, wr = wave >> 1, wc = wave & 1;
  const int r0 = tid >> 2, kv = tid & 3;
  const int fr = lane & 31, fh = lane >> 5;
  uint4 ra0 = *(const uint4*)aptr(0, r0, kv), ra1 = *(const uint4*)aptr(0, r0 + 64, kv);
  uint4 rb0 = *(const uint4*)bptr(0, r0, kv), rb1 = *(const uint4*)bptr(0, r0 + 64, kv);
  *(uint4*)&s->a[0][r0][kv * 8] = ra0; *(uint4*)&s->a[0][r0 + 64][kv * 8] = ra1;
  *(uint4*)&s->b[0][r0][kv * 8] = rb0; *(uint4*)&s->b[0][r0 + 64][kv * 8] = rb1;
  __syncthreads();
#pragma unroll 1
  for (int kt = 0; kt < nk; ++kt) {
    const int buf = kt & 1;
    if (kt + 1 < nk) {
      ra0 = *(const uint4*)aptr(kt + 1, r0, kv); ra1 = *(const uint4*)aptr(kt + 1, r0 + 64, kv);
      rb0 = *(const uint4*)bptr(kt + 1, r0, kv); rb1 = *(const uint4*)bptr(kt + 1, r0 + 64, kv);
    }
#pragma unroll
    for (int ks = 0; ks < 2; ++ks) {
      bf16x8 af[2], bq[2];
#pragma unroll
      for (int i = 0; i < 2; ++i) af[i] = *(const bf16x8*)&s->a[buf][wr * 64 + i * 32 + fr][ks * 16 + fh * 8];
#pragma unroll
      for (int j = 0; j < 2; ++j) bq[j] = *(const bf16x8*)&s->b[buf][wc * 64 + j * 32 + fr][ks * 16 + fh * 8];
#pragma unroll
      for (int i = 0; i < 2; ++i)
#pragma unroll
        for (int j = 0; j < 2; ++j) acc[i][j] = MFMA(af[i], bq[j], acc[i][j]);
    }
    if (kt + 1 < nk) {
      *(uint4*)&s->a[buf ^ 1][r0][kv * 8] = ra0; *(uint4*)&s->a[buf ^ 1][r0 + 64][kv * 8] = ra1;
      *(uint4*)&s->b[buf ^ 1][r0][kv * 8] = rb0; *(uint4*)&s->b[buf ^ 1][r0 + 64][kv * 8] = rb1;
    }
    __syncthreads();
  }
}


struct GemmS2 { bf16_t a[128][72]; bf16_t b[128][72]; };
DI void g2_compute(f32x16 (&acc)[2][2], const GemmS2* s, int wr, int wc, int fr, int fh) {
#pragma unroll
  for (int ks = 0; ks < 4; ++ks) {
    bf16x8 af[2], bq[2];
#pragma unroll
    for (int i = 0; i < 2; ++i) af[i] = *(const bf16x8*)&s->a[wr * 64 + i * 32 + fr][ks * 16 + fh * 8];
#pragma unroll
    for (int j = 0; j < 2; ++j) bq[j] = *(const bf16x8*)&s->b[wc * 64 + j * 32 + fr][ks * 16 + fh * 8];
#pragma unroll
    for (int i = 0; i < 2; ++i)
#pragma unroll
      for (int j = 0; j < 2; ++j) acc[i][j] = MFMA(af[i], bq[j], acc[i][j]);
  }
}

template <class AF, class BF, class HK>
DI void gemm_core2(f32x16 (&acc)[2][2], GemmS2* s, AF aptr, BF bptr, int nk, HK hook) {
  int tid = threadIdx.x; asm volatile("" : "+v"(tid));
  const int lane = tid & 63, wave = tid >> 6, wr = wave >> 1, wc = wave & 1;
  const int r0 = tid >> 3, kc = tid & 7;
  const int fr = lane & 31, fh = lane >> 5;
  uint4 p0a0, p0a1, p0a2, p0a3, p0b0, p0b1, p0b2, p0b3, p1a0, p1a1, p1a2, p1a3, p1b0, p1b1, p1b2, p1b3;
#define G2_LOAD(S, KT) { \
    S##a0 = *(const uint4*)aptr((KT), r0, kc);      S##b0 = *(const uint4*)bptr((KT), r0, kc); \
    S##a1 = *(const uint4*)aptr((KT), r0 + 32, kc); S##b1 = *(const uint4*)bptr((KT), r0 + 32, kc); \
    S##a2 = *(const uint4*)aptr((KT), r0 + 64, kc); S##b2 = *(const uint4*)bptr((KT), r0 + 64, kc); \
    S##a3 = *(const uint4*)aptr((KT), r0 + 96, kc); S##b3 = *(const uint4*)bptr((KT), r0 + 96, kc); }
#define G2_STORE(S) { \
    *(uint4*)&s->a[r0][kc * 8] = S##a0;      *(uint4*)&s->b[r0][kc * 8] = S##b0; \
    *(uint4*)&s->a[r0 + 32][kc * 8] = S##a1; *(uint4*)&s->b[r0 + 32][kc * 8] = S##b1; \
    *(uint4*)&s->a[r0 + 64][kc * 8] = S##a2; *(uint4*)&s->b[r0 + 64][kc * 8] = S##b2; \
    *(uint4*)&s->a[r0 + 96][kc * 8] = S##a3; *(uint4*)&s->b[r0 + 96][kc * 8] = S##b3; }
#define G2_COMPUTE() g2_compute(acc, s, wr, wc, fr, fh);
  G2_LOAD(p0, 0)
  G2_LOAD(p1, 1)
  G2_STORE(p0)
  if (nk > 2) G2_LOAD(p0, 2)
  __syncthreads();
#pragma unroll 1
  for (int kt = 0; kt < nk; kt += 2) {
    hook(kt);
    G2_COMPUTE()
    __syncthreads();
    G2_STORE(p1)
    if (kt + 3 < nk) G2_LOAD(p1, kt + 3)
    __syncthreads();
    hook(kt + 1);
    G2_COMPUTE()
    __syncthreads();
    if (kt + 2 < nk) {
      G2_STORE(p0)
      if (kt + 4 < nk) G2_LOAD(p0, kt + 4)
    }
    __syncthreads();
  }
#undef G2_LOAD
#undef G2_STORE
#undef G2_COMPUTE
}


struct GemmS3 { bf16_t a[128][72]; bf16_t b[256][72]; };

template <class AF, class BF, class HK>
DI void gemm_core3(f32x16 (&acc)[2][4], GemmS3* s, AF aptr, BF bptr, int nk, HK hook) {
  int tid = threadIdx.x; asm volatile("" : "+v"(tid));
  const int lane = tid & 63, wave = tid >> 6, wr = wave >> 1, wc = wave & 1;
  const int r0 = tid >> 3, kc = tid & 7;
  const int fr = lane & 31, fh = lane >> 5;
  uint4 a0, a1, a2, a3, b0, b1, b2, b3, b4, b5, b6, b7;
#define G3_LOAD(KT) { \
    a0 = *(const uint4*)aptr((KT), r0, kc);       a1 = *(const uint4*)aptr((KT), r0 + 32, kc); \
    a2 = *(const uint4*)aptr((KT), r0 + 64, kc);  a3 = *(const uint4*)aptr((KT), r0 + 96, kc); \
    b0 = *(const uint4*)bptr((KT), r0, kc);       b1 = *(const uint4*)bptr((KT), r0 + 32, kc); \
    b2 = *(const uint4*)bptr((KT), r0 + 64, kc);  b3 = *(const uint4*)bptr((KT), r0 + 96, kc); \
    b4 = *(const uint4*)bptr((KT), r0 + 128, kc); b5 = *(const uint4*)bptr((KT), r0 + 160, kc); \
    b6 = *(const uint4*)bptr((KT), r0 + 192, kc); b7 = *(const uint4*)bptr((KT), r0 + 224, kc); }
#define G3_STORE() { \
    *(uint4*)&s->a[r0][kc * 8] = a0;       *(uint4*)&s->a[r0 + 32][kc * 8] = a1; \
    *(uint4*)&s->a[r0 + 64][kc * 8] = a2;  *(uint4*)&s->a[r0 + 96][kc * 8] = a3; \
    *(uint4*)&s->b[r0][kc * 8] = b0;       *(uint4*)&s->b[r0 + 32][kc * 8] = b1; \
    *(uint4*)&s->b[r0 + 64][kc * 8] = b2;  *(uint4*)&s->b[r0 + 96][kc * 8] = b3; \
    *(uint4*)&s->b[r0 + 128][kc * 8] = b4; *(uint4*)&s->b[r0 + 160][kc * 8] = b5; \
    *(uint4*)&s->b[r0 + 192][kc * 8] = b6; *(uint4*)&s->b[r0 + 224][kc * 8] = b7; }
  G3_LOAD(0)
  G3_STORE()
  __syncthreads();
#pragma unroll 1
  for (int kt = 0; kt < nk; ++kt) {
    if (kt + 1 < nk) G3_LOAD(kt + 1)
    hook(kt);
#pragma unroll
    for (int ks = 0; ks < 4; ++ks) {
      bf16x8 af[2], bq[4];
#pragma unroll
      for (int i = 0; i < 2; ++i) af[i] = *(const bf16x8*)&s->a[wr * 64 + i * 32 + fr][ks * 16 + fh * 8];
#pragma unroll
      for (int j = 0; j < 4; ++j) bq[j] = *(const bf16x8*)&s->b[wc * 128 + j * 32 + fr][ks * 16 + fh * 8];
#pragma unroll
      for (int i = 0; i < 2; ++i)
#pragma unroll
        for (int j = 0; j < 4; ++j) acc[i][j] = MFMA(af[i], bq[j], acc[i][j]);
    }
    __syncthreads();
    if (kt + 1 < nk) G3_STORE()
    __syncthreads();
  }
#undef G3_LOAD
#undef G3_STORE
}

template <class EPI>
DI void epilogue_lds2(f32x16 (&acc)[2][4], char* smem, int sub, EPI epi) {
  float* T = (float*)smem;
  int tid = threadIdx.x; asm volatile("" : "+v"(tid));
  const int lane = tid & 63, wave = tid >> 6, wr = wave >> 1, wc = wave & 1, fr = lane & 31, fh = lane >> 5;
#pragma unroll
  for (int i = 0; i < 2; ++i) {
    if (wc == sub) {
#pragma unroll
      for (int j = 0; j < 4; ++j)
#pragma unroll
        for (int r = 0; r < 16; ++r) T[(wr * 32 + crow(r, fh)) * 132 + j * 32 + fr] = acc[i][j][r];
    }
    __syncthreads();
#pragma unroll 2
    for (int e = tid; e < 2048; e += 256) {
      const int tr = e >> 5, c4 = (e & 31) * 4;
      const float4 v = *(const float4*)&T[tr * 132 + c4];
      epi((tr >> 5) * 64 + i * 32 + (tr & 31), c4, v);
    }
    __syncthreads();
  }
}

DI bool xcd_tile(int step, int nM, int nN, int& mt, int& nt) {
  const int xcd = blockIdx.x & 7, nloc = gridDim.x >> 3;
  const int j = (blockIdx.x >> 3) + step * nloc;
  const int mloc = nM >> 3;
  if ((gridDim.x & 7) != 0 || j >= mloc * nN) return false;
  const int per = 8 * nN;
  const int gm = j / per, rem = j - gm * per;
  const int hgt = min(8, mloc - gm * 8);
  const int a = rem % hgt;
  nt = rem / hgt;
  mt = (gm * 8 + a) * 8 + xcd;
  return true;
}

DI void zero_acc(f32x16 (&acc)[2][2]) {
#pragma unroll
  for (int i = 0; i < 2; ++i)
#pragma unroll
    for (int j = 0; j < 2; ++j)
#pragma unroll
      for (int r = 0; r < 16; ++r) acc[i][j][r] = 0.f;
}

template <class EPI>
DI void epilogue_lds(f32x16 (&acc)[2][2], char* smem, EPI epi) {
  float* T = (float*)smem;
  int tid = threadIdx.x; asm volatile("" : "+v"(tid)); const int lane = tid & 63, wave = tid >> 6, wr = wave >> 1, wc = wave & 1, fr = lane & 31, fh = lane >> 5;
#pragma unroll
  for (int i = 0; i < 2; ++i) {
#pragma unroll
    for (int j = 0; j < 2; ++j)
#pragma unroll
      for (int r = 0; r < 16; ++r) T[(wr * 32 + crow(r, fh)) * 132 + wc * 64 + j * 32 + fr] = acc[i][j][r];
    __syncthreads();
#pragma unroll 2
    for (int e = tid; e < 2048; e += 256) {
      const int tr = e >> 5, c4 = (e & 31) * 4;
      const float4 v = *(const float4*)&T[tr * 132 + c4];
      epi((tr >> 5) * 64 + i * 32 + (tr & 31), c4, v);
    }
    __syncthreads();
  }
}

DI void phase_mods(const Params& p_in, char* smem) {
  const Params p = load_params();

  float* ssc = (float*)smem;
  float* red = (float*)(smem + 20480);
  float* mods = (float*)(p.ws + OFF_MODS);
  int tid = threadIdx.x; asm volatile("" : "+v"(tid));
  for (int it = blockIdx.x; it < 192; it += gridDim.x) {
    const int l = it / 96, col0 = (it % 96) * 32;
    __syncthreads();
    for (int e = tid; e < 5120; e += 256) {
      const int v = e >> 10, k = e & 1023;
      const float cv = (v < 4) ? p.c[v * 1024 + k] : p.c_ctx[k];
      ssc[e] = silu_f(cv);
    }
    __syncthreads();
    const int col = tid & 31, kg = tid >> 5;
    float a[5] = {0.f, 0.f, 0.f, 0.f, 0.f};
    const float* w = p.w_mod + (size_t)l * 1024 * 3072 + col0 + col;
    for (int k = kg * 128; k < kg * 128 + 128; k += 32) {
      float wv[32];
#pragma unroll
      for (int u = 0; u < 32; ++u) wv[u] = w[(size_t)(k + u) * 3072];
#pragma unroll
      for (int u = 0; u < 32; ++u)
#pragma unroll
        for (int v = 0; v < 5; ++v) a[v] += ssc[v * 1024 + k + u] * wv[u];
    }
#pragma unroll
    for (int v = 0; v < 5; ++v) red[(kg * 5 + v) * 32 + col] = a[v];
    __syncthreads();
    for (int e = tid; e < 160; e += 256) {
      const int v = e >> 5, cc = e & 31;
      float sum = p.b_mod[l * 3072 + col0 + cc];
      for (int g = 0; g < 8; ++g) sum += red[(g * 5 + v) * 32 + cc];
      mods[(l * 5 + v) * 3072 + col0 + cc] = sum;
    }
  }
}

DI int win_colmap(int n) {
  if (n < 2560) return n;
  if (n < 3840) return n + 32;
  if (n < 4864) {
    const int j = n - 3840, q64 = j >> 6, w = j & 63;
    return (w < 32) ? (3872 + q64 * 32 + w) : (3872 + 512 + q64 * 32 + (w - 32));
  }
  if (n < 5376) return n + 32;
  if (n < 5408) return n - 5376 + 2560;
  return -1;
}

DI void transpose_tile(const float* src, int ldsrc, int kind, const float* rowscale, bf16_t* dst, int lddst, int n0, int k0, float* tile) {
  int tid = threadIdx.x; asm volatile("" : "+v"(tid));
  __syncthreads();
  {
    const int c4 = (tid & 15) * 4, rr = tid >> 4;
    const int n = (kind == 0) ? win_colmap(n0 + c4) : (n0 + c4);
#pragma unroll
    for (int ps = 0; ps < 4; ++ps) {
      const int r = rr + ps * 16, k = k0 + r;
      float4 v = make_float4(0.f, 0.f, 0.f, 0.f);
      if (n >= 0) v = *(const float4*)(src + (size_t)k * ldsrc + n);
      if (rowscale != nullptr && k < 1024) { const float s = rowscale[k]; v.x *= s; v.y *= s; v.z *= s; v.w *= s; }
      tile[r * 65 + c4] = v.x; tile[r * 65 + c4 + 1] = v.y; tile[r * 65 + c4 + 2] = v.z; tile[r * 65 + c4 + 3] = v.w;
    }
  }
  __syncthreads();
  {
    const int k8 = (tid & 7) * 8, nn = tid >> 3;
#pragma unroll
    for (int ps = 0; ps < 2; ++ps) {
      const int r = nn + ps * 32;
      uint4 o;
      o.x = pack2(tile[(k8 + 0) * 65 + r], tile[(k8 + 1) * 65 + r]);
      o.y = pack2(tile[(k8 + 2) * 65 + r], tile[(k8 + 3) * 65 + r]);
      o.z = pack2(tile[(k8 + 4) * 65 + r], tile[(k8 + 5) * 65 + r]);
      o.w = pack2(tile[(k8 + 6) * 65 + r], tile[(k8 + 7) * 65 + r]);
      *(uint4*)(dst + (size_t)(n0 + r) * lddst + k0 + k8) = o;
    }
  }
}

DI void phase_prep(const Params& p_in, int l, char* smem) {
  const Params p = load_params();

  int tid = threadIdx.x; asm volatile("" : "+v"(tid)); const int lane = tid & 63, wave = tid >> 6;
  const float* mods = (const float*)(p.ws + OFF_MODS);
  bf16_t* H = (bf16_t*)(p.ws + OFF_H);
  const int NT_WIN = 88 * 16, NT_WOUT = 16 * 32, NT_PW = 64, NT_CONV = NT_WIN + NT_WOUT + NT_PW;
  const int NT = NT_CONV + R_ / 8;
  for (int it = blockIdx.x; it < NT; it += gridDim.x) {
    if (l == 1 && (it < NT_WIN || (it >= NT_WIN + NT_WOUT && it < NT_CONV))) continue;
    if (it < NT_WIN) {
      transpose_tile(p.w_in + (size_t)l * 1024 * 5408, 5408, 0, nullptr, (bf16_t*)(p.ws + OFF_WIN), 1024, (it / 16) * 64, (it % 16) * 64, (float*)smem);
    } else if (it < NT_WIN + NT_WOUT) {
      const int t = it - NT_WIN;
      transpose_tile(p.w_out + (size_t)l * 2048 * 1024, 1024, 1, p.ssd_norm_w + l * 1024, (bf16_t*)(p.ws + OFF_WOUT), 2048, (t / 32) * 64, (t % 32) * 64, (float*)smem);
    } else if (it < NT_CONV) {
      const int t = it - NT_WIN - NT_WOUT;
      transpose_tile(p.conv_pw_w + (size_t)l * 512 * 512, 512, 1, nullptr, (bf16_t*)(p.ws + OFF_PW), 512, (t / 8) * 64, (t % 8) * 64, (float*)smem);
    } else {
      const int rho0 = (it - NT_CONV) * 8 + wave * 2;
      const float* xs0;
      if (l == 0) xs0 = (rho0 < RL_) ? (p.x + (size_t)rho0 * 1024) : (p.ctx + (size_t)(rho0 - RL_) * 1024);
      else xs0 = (rho0 < RL_) ? (p.out + (size_t)rho0 * 1024) : ((const float*)(p.ws + OFF_XC) + (size_t)(rho0 - RL_) * 1024);
      const int v = (rho0 < RL_) ? (rho0 >> 12) : 4;
      const float* md = mods + (l * 5 + v) * 3072;
      float4 xv[2][4], nwv[4], shv[4], scv4[4];
#pragma unroll
      for (int i = 0; i < 4; ++i) {
        const int cidx = lane * 4 + i * 256;
        xv[0][i] = *(const float4*)(xs0 + cidx);
        xv[1][i] = *(const float4*)(xs0 + 1024 + cidx);
        nwv[i] = *(const float4*)(p.norm_w + l * 1024 + cidx);
        shv[i] = *(const float4*)(md + cidx);
        scv4[i] = *(const float4*)(md + 1024 + cidx);
      }
#pragma unroll
      for (int q = 0; q < 2; ++q) {
        float ss = 0.f;
#pragma unroll
        for (int i = 0; i < 4; ++i) ss += xv[q][i].x * xv[q][i].x + xv[q][i].y * xv[q][i].y + xv[q][i].z * xv[q][i].z + xv[q][i].w * xv[q][i].w;
#pragma unroll
        for (int o = 32; o >= 1; o >>= 1) ss += __shfl_xor(ss, o);
        const float rs = rsqrtf(ss * (1.f / 1024.f) + 1e-6f);
#pragma unroll
        for (int i = 0; i < 4; ++i) {
          const int cidx = lane * 4 + i * 256;
          const float4 nw = nwv[i], sh = shv[i], sc = scv4[i];
          uint2 o;
          o.x = pack2(xv[q][i].x * rs * nw.x * (1.f + sc.x) + sh.x, xv[q][i].y * rs * nw.y * (1.f + sc.y) + sh.y);
          o.y = pack2(xv[q][i].z * rs * nw.z * (1.f + sc.z) + sh.z, xv[q][i].w * rs * nw.w * (1.f + sc.w) + sh.w);
          *(uint2*)(H + (size_t)(rho0 + q) * 1024 + cidx) = o;
        }
      }
    }
  }
}

DI void phase_inproj(const Params& p_in, char* smem) {
  const Params p = load_params();
  int tid = threadIdx.x; asm volatile("" : "+v"(tid)); const int wave = tid >> 6, wc = wave & 1;
  const bf16_t* H = (const bf16_t*)(p.ws + OFF_H);
  const bf16_t* W = (const bf16_t*)(p.ws + OFF_WIN);
  for (int step = 0;; ++step) {
    int mt, nt2;
    if (!xcd_tile(step, NCK, 22, mt, nt2)) break;
    f32x16 acc[2][4];
#pragma unroll
    for (int i = 0; i < 2; ++i)
#pragma unroll
      for (int j = 0; j < 4; ++j)
#pragma unroll
        for (int r = 0; r < 16; ++r) acc[i][j][r] = 0.f;
    const bf16_t* Ab = H + (size_t)mt * 128 * 1024;
    const bf16_t* Bb = W + (size_t)nt2 * 256 * 1024;
    gemm_core3(acc, (GemmS3*)smem,
               [&](int kt, int r, int kv) { return Ab + (size_t)r * 1024 + kt * 64 + kv * 8; },
               [&](int kt, int r, int kv) { return Bb + (size_t)r * 1024 + kt * 64 + kv * 8; }, 16, [](int) {});
    const int row0 = mt * 128;
    {
      const int ntw = nt2 * 2 + wc;
      if (ntw >= 30 && ntw < 38) {
#pragma unroll
        for (int i = 0; i < 2; ++i)
#pragma unroll
          for (int r = 0; r < 16; ++r) {
            acc[i][0][r] = acc[i][0][r] * sigmoid_f(acc[i][1][r]);
            acc[i][2][r] = acc[i][2][r] * sigmoid_f(acc[i][3][r]);
          }
      }
    }
#pragma unroll 1
    for (int sub = 0; sub < 2; ++sub) {
      const int nt = nt2 * 2 + sub;
      if (nt >= 43) break;
      if (nt >= 30 && nt < 38) {
        bf16_t* G = (bf16_t*)(p.ws + OFF_GLU);
        const int cb0 = (nt - 30) * 64;
        epilogue_lds2(acc, smem, sub, [&](int rl, int c4, float4 v) {
          if ((c4 & 32) == 0) {
            uint2 o; o.x = pack2(v.x, v.y); o.y = pack2(v.z, v.w);
            *(uint2*)(G + (size_t)(row0 + rl) * 512 + cb0 + (c4 >> 6) * 32 + (c4 & 31)) = o;
          }
        });
      } else if (nt == 42) {
        float* DT = (float*)(p.ws + OFF_DT);
        epilogue_lds2(acc, smem, sub, [&](int rl, int c4, float4 v) {
          if (c4 < 32) *(float4*)(DT + (size_t)(row0 + rl) * 32 + c4) = v;
        });
      } else {
        bf16_t* dst; int ld, cb;
        if (nt < 12) { dst = (bf16_t*)(p.ws + OFF_XBC); ld = 1536; cb = nt * 128; }
        else if (nt < 20) { dst = (bf16_t*)(p.ws + OFF_Z); ld = 1024; cb = nt * 128 - 1536; }
        else if (nt < 24) { dst = (bf16_t*)(p.ws + OFF_Q); ld = 512; cb = nt * 128 - 2560; }
        else if (nt < 26) { dst = (bf16_t*)(p.ws + OFF_KV); ld = 256; cb = nt * 128 - 3072; }
        else if (nt < 30) { dst = (bf16_t*)(p.ws + OFF_AG); ld = 512; cb = nt * 128 - 3328; }
        else { dst = (bf16_t*)(p.ws + OFF_CG); ld = 512; cb = nt * 128 - 4864; }
        epilogue_lds2(acc, smem, sub, [&](int rl, int c4, float4 v) {
          uint2 o; o.x = pack2(v.x, v.y); o.y = pack2(v.z, v.w);
          *(uint2*)(dst + (size_t)(row0 + rl) * ld + cb + c4) = o;
        });
      }
    }
  }
}

DI void phase_local(const Params& p_in, int l, char* smem) {
  const Params p = load_params();

  int tid = threadIdx.x; asm volatile("" : "+v"(tid)); const int lane = tid & 63;
  const bf16_t* XBC = (const bf16_t*)(p.ws + OFF_XBC);
  bf16_t* XS = (bf16_t*)(p.ws + OFF_H);
  bf16_t* BC = (bf16_t*)(p.ws + OFF_BC);
  float* DT = (float*)(p.ws + OFF_DT);
  float* CS = (float*)(p.ws + OFF_CS);
  const bf16_t* GLU = (const bf16_t*)(p.ws + OFF_GLU);
  bf16_t* HDN = (bf16_t*)(p.ws + OFF_HDN);
  bf16_t* Q = (bf16_t*)(p.ws + OFF_Q);
  bf16_t* KV = (bf16_t*)(p.ws + OFF_KV);
  { float* SSQ = (float*)(p.ws + OFF_RSTD); for (int i = blockIdx.x * 256 + tid; i < R_ * 2; i += gridDim.x * 256) SSQ[i] = 0.f; }
  const int N_CONV = (R_ / 4) * 192 / 256;
  const int N_DT = NCK;
  const int N_CF = R_ / 16;
  const int N_ROPE = RL_ * 40 / 256;
  const int N_QC = 1024 * 256 / 256;
  const int NT = N_CF + N_DT + N_CONV + N_ROPE + N_QC;
  for (int it0 = blockIdx.x; it0 < NT; it0 += gridDim.x) {
    int it = it0;
    if (it < N_CF) {
      float* sst = (float*)smem;
      unsigned* sIn = (unsigned*)(smem + 256);
      const int row0 = it * 16;
      const int seq0 = (row0 < RL_) ? (row0 & ~4095) : (RL_ + ((row0 - RL_) & ~255));
      const int slen = (row0 < RL_) ? 4096 : 256;
      const int t0 = row0 - seq0;
      const int c0 = tid * 2;
      __syncthreads();
      if (tid < 32) sst[tid] = 0.f;
      for (int idx = tid; idx < 46 * 64; idx += 256) {
        const int rr = idx >> 6, c16 = idx & 63;
        const int tt = t0 - 15 + rr;
        uint4 val = make_uint4(0u, 0u, 0u, 0u);
        if (tt >= 0 && tt < slen) val = *(const uint4*)(GLU + (size_t)(seq0 + tt) * 512 + c16 * 8);
        *(uint4*)&sIn[rr * 256 + c16 * 4] = val;
      }
      float w0[31], w1[31];
#pragma unroll
      for (int k = 0; k < 31; ++k) {
        const float2 wv = *(const float2*)(p.conv_dw_w + ((size_t)l * 31 + k) * 512 + c0);
        w0[k] = wv.x; w1[k] = wv.y;
      }
      const float2 bv = *(const float2*)(p.conv_dw_b + l * 512 + c0);
      float a0[16], a1[16];
#pragma unroll
      for (int r = 0; r < 16; ++r) { a0[r] = bv.x; a1[r] = bv.y; }
      __syncthreads();
#pragma unroll
      for (int tp = 0; tp < 46; ++tp) {
        const unsigned u = sIn[tp * 256 + tid];
        const float x0 = lo2f(u), x1 = hi2f(u);
#pragma unroll
        for (int r = 0; r < 16; ++r) {
          const int k = tp - r;
          if (k >= 0 && k < 31) { a0[r] += w0[k] * x0; a1[r] += w1[k] * x1; }
        }
        if ((tp & 7) == 7) __builtin_amdgcn_sched_barrier(0);
      }
      {
        float v[32];
#pragma unroll
        for (int r = 0; r < 16; ++r) { v[2 * r] = a0[r] + a1[r]; v[2 * r + 1] = a0[r] * a0[r] + a1[r] * a1[r]; }
#pragma unroll
        for (int i = 0; i < 16; ++i) { const bool up = (lane & 32) != 0; const float keep = up ? v[i + 16] : v[i]; const float send = up ? v[i] : v[i + 16]; v[i] = keep + __shfl_xor(send, 32); }
#pragma unroll
        for (int i = 0; i < 8; ++i) { const bool up = (lane & 16) != 0; const float keep = up ? v[i + 8] : v[i]; const float send = up ? v[i] : v[i + 8]; v[i] = keep + __shfl_xor(send, 16); }
#pragma unroll
        for (int i = 0; i < 4; ++i) { const bool up = (lane & 8) != 0; const float keep = up ? v[i + 4] : v[i]; const float send = up ? v[i] : v[i + 4]; v[i] = keep + __shfl_xor(send, 8); }
#pragma unroll
        for (int i = 0; i < 2; ++i) { const bool up = (lane & 4) != 0; const float keep = up ? v[i + 2] : v[i]; const float send = up ? v[i] : v[i + 2]; v[i] = keep + __shfl_xor(send, 4); }
        { const bool up = (lane & 2) != 0; const float keep = up ? v[1] : v[0]; const float send = up ? v[0] : v[1]; v[0] = keep + __shfl_xor(send, 2); }
        v[0] += __shfl_xor(v[0], 1);
        __syncthreads();
        if ((lane & 1) == 0) atomicAdd(&sst[lane >> 1], v[0]);
      }
      __syncthreads();
      const float2 lw = *(const float2*)(p.conv_ln_w + l * 512 + c0);
      const float2 lb = *(const float2*)(p.conv_ln_b + l * 512 + c0);
#pragma unroll
      for (int r = 0; r < 16; ++r) {
        const float mean = sst[r * 2] * (1.f / 512.f);
        const float var = fmaxf(sst[r * 2 + 1] * (1.f / 512.f) - mean * mean, 0.f);
        const float rs = rsqrtf(var + 1e-6f);
        const float y0 = (a0[r] - mean) * rs * lw.x + lb.x;
        const float y1 = (a1[r] - mean) * rs * lw.y + lb.y;
        *(unsigned*)(HDN + (size_t)(row0 + r) * 512 + c0) = pack2(silu_f(y0), silu_f(y1));
        if ((r & 3) == 3) __builtin_amdgcn_sched_barrier(0);
      }
      continue;
    }
    it -= N_CF;
    if (it < N_DT) {
      float* sdt = (float*)smem;
      const int row0 = it * 128;
      __syncthreads();
      for (int e = tid; e < 4096; e += 256) {
        const int r = e >> 5, cidx = e & 31;
        const float raw = DT[(size_t)(row0 + r) * 32 + cidx] + p.ssd_dt_bias[l * 32 + cidx];
        const float sp = (raw > 20.f) ? raw : log1pf(expf(raw));
        DT[(size_t)(row0 + r) * 32 + cidx] = sp;
        sdt[r * 33 + cidx] = sp;
      }
      __syncthreads();
      if (tid < 32) {
        const float a = -expf(p.ssd_a_log[l * 32 + tid]);
        float run = 0.f;
        if (tid < 16) {
          for (int r = 0; r < 128; ++r) { run += sdt[r * 33 + tid] * a; CS[(size_t)(row0 + r) * 32 + tid] = run; }
        } else {
          for (int r = 127; r >= 0; --r) { run += sdt[r * 33 + tid] * a; CS[(size_t)(row0 + r) * 32 + tid] = run; }
        }
      }
      continue;
    }
    it -= N_DT;
    if (it < N_CONV) {
      const int e = it * 256 + tid;
      const int rb = e / 192, cgp = e % 192, ch0 = cgp * 8;
      const int rho0 = rb * 4;
      const int seq0 = (rho0 < RL_) ? (rho0 & ~4095) : (RL_ + ((rho0 - RL_) & ~255));
      const int slen = (rho0 < RL_) ? 4096 : 256;
      const int t0 = rho0 - seq0;
      uint4 xr[8];
#pragma unroll
      for (int i = 0; i < 8; ++i) {
        const int tt = t0 + i - 2;
        xr[i] = make_uint4(0u, 0u, 0u, 0u);
        if (tt >= 0 && tt < slen) xr[i] = *(const uint4*)(XBC + (size_t)(seq0 + tt) * 1536 + ch0);
      }
      float wk[5][8];
#pragma unroll
      for (int k = 0; k < 5; ++k) {
        const float4 w0 = *(const float4*)(p.ssd_conv_w + ((size_t)l * 5 + k) * 1536 + ch0);
        const float4 w1 = *(const float4*)(p.ssd_conv_w + ((size_t)l * 5 + k) * 1536 + ch0 + 4);
        wk[k][0] = w0.x; wk[k][1] = w0.y; wk[k][2] = w0.z; wk[k][3] = w0.w; wk[k][4] = w1.x; wk[k][5] = w1.y; wk[k][6] = w1.z; wk[k][7] = w1.w;
      }
      float bias[8];
      {
        const float4 b0 = *(const float4*)(p.ssd_conv_b + l * 1536 + ch0);
        const float4 b1 = *(const float4*)(p.ssd_conv_b + l * 1536 + ch0 + 4);
        bias[0] = b0.x; bias[1] = b0.y; bias[2] = b0.z; bias[3] = b0.w; bias[4] = b1.x; bias[5] = b1.y; bias[6] = b1.z; bias[7] = b1.w;
      }
#pragma unroll
      for (int r = 0; r < 4; ++r) {
        float a[8];
#pragma unroll
        for (int c = 0; c < 8; ++c) a[c] = bias[c];
#pragma unroll
        for (int k = 0; k < 5; ++k) {
          const uint4 u = xr[r + k];
          a[0] += wk[k][0] * lo2f(u.x); a[1] += wk[k][1] * hi2f(u.x); a[2] += wk[k][2] * lo2f(u.y); a[3] += wk[k][3] * hi2f(u.y);
          a[4] += wk[k][4] * lo2f(u.z); a[5] += wk[k][5] * hi2f(u.z); a[6] += wk[k][6] * lo2f(u.w); a[7] += wk[k][7] * hi2f(u.w);
        }
        uint4 o;
        o.x = pack2(silu_f(a[0]), silu_f(a[1])); o.y = pack2(silu_f(a[2]), silu_f(a[3]));
        o.z = pack2(silu_f(a[4]), silu_f(a[5])); o.w = pack2(silu_f(a[6]), silu_f(a[7]));
        const size_t rho = (size_t)(rho0 + r);
        if (ch0 < 1024) *(uint4*)(XS + rho * 1024 + ch0) = o;
        else *(uint4*)(BC + rho * 512 + (ch0 - 1024)) = o;
      }
      continue;
    }
    it -= N_CONV;
    if (it < N_ROPE) {
      const int e = it * 256 + tid;
      const int rho = e / 40, rem = e % 40, hd = rem >> 2, sub = rem & 3;
      const int axis = sub >> 1, half = sub & 1;
      const int t = rho & 4095;
      const float pos = (float)(axis == 0 ? (t >> 6) : (t & 63));
      bf16_t* base = ((hd < 8) ? (Q + (size_t)rho * 512 + hd * 64) : (KV + (size_t)rho * 256 + (hd - 8) * 64)) + axis * 32 + half * 8;
      const float sc = (hd < 8) ? 0.18033688011112042f : 1.f;
      const uint4 u1 = *(const uint4*)base, u2 = *(const uint4*)(base + 16);
      const unsigned a1[4] = {u1.x, u1.y, u1.z, u1.w}, a2[4] = {u2.x, u2.y, u2.z, u2.w};
      unsigned o1[4], o2[4];
#pragma unroll
      for (int i = 0; i < 4; ++i) {
        float r1[2], r2[2];
#pragma unroll
        for (int hl = 0; hl < 2; ++hl) {
          const float f = (float)(half * 8 + 2 * i + hl);
          const float ang = pos * exp2f(-f * 0.8304820237218406f);
          const float cs = __cosf(ang), sn = __sinf(ang);
          const float t1 = hl ? hi2f(a1[i]) : lo2f(a1[i]);
          const float t2 = hl ? hi2f(a2[i]) : lo2f(a2[i]);
          r1[hl] = (t1 * cs - t2 * sn) * sc;
          r2[hl] = (t2 * cs + t1 * sn) * sc;
        }
        o1[i] = pack2(r1[0], r1[1]); o2[i] = pack2(r2[0], r2[1]);
      }
      *(uint4*)base = make_uint4(o1[0], o1[1], o1[2], o1[3]);
      *(uint4*)(base + 16) = make_uint4(o2[0], o2[1], o2[2], o2[3]);
      continue;
    }
    it -= N_ROPE;
    {
      const int e = it * 256 + tid;
      const int rho = RL_ + e / 256, c2 = (e % 256) * 2;
      unsigned* ptr = (unsigned*)(Q + (size_t)rho * 512 + c2);
      const unsigned u = *ptr;
      *ptr = pack2(lo2f(u) * 0.18033688011112042f, hi2f(u) * 0.18033688011112042f);
    }
  }
}

DI void attn_item(const Params& p_in, int l, char* smem, int b, int qblk, int g, int hp, bool ctxq) {
  const Params p = load_params();

  bf16_t* sK = (bf16_t*)smem;
  bf16_t* sV = (bf16_t*)(smem + 128 * 72 * 2);
  int tid = threadIdx.x; asm volatile("" : "+v"(tid)); const int lane = tid & 63, wave = tid >> 6, fr = lane & 31, fh = lane >> 5;
  const int head = g * 4 + hp * 2 + (wave >> 1);
  const int qh = wave & 1;
  const int qrow0 = (ctxq ? (RL_ + b * 256) : (b * 4096)) + qblk * 128 + qh * 64;
  const int qpos0 = qblk * 128 + qh * 64;
  bf16_t* Q = (bf16_t*)(p.ws + OFF_Q);
  const bf16_t* KV = (const bf16_t*)(p.ws + OFF_KV);
  const bf16_t* AG = (const bf16_t*)(p.ws + OFF_AG);
  f32x16 o[2][2];
  zero_acc(o);
  float m[2], lsum[2];
  m[0] = m[1] = p.attn_sink[l * 8 + head] * 1.4426950408889634f;
  lsum[0] = lsum[1] = 1.f;
  const int nhb = ctxq ? 4 : 10;
  auto hb_row = [&](int hb) -> int {
    if (hb >= nhb) return -1;
    if (hb < 4) return RL_ + b * 256 + hb * 64;
    const int kp = (qblk - 1) * 128 + (hb - 4) * 64;
    if (kp < 0 || kp >= 4096) return -1;
    return b * 4096 + kp;
  };
  auto hb_next = [&](int hb) -> int { int n = hb + 1; while (n < nhb && hb_row(n) < 0) ++n; return n; };
  const int sr = tid >> 3, scv = tid & 7;
  uint4 kp0, kp1, vp0, vp1;
#define ATT_PREFETCH(ROW0) { const bf16_t* kvp = KV + (size_t)((ROW0) + sr) * 256 + g * 64 + scv * 8; \
    kp0 = *(const uint4*)(kvp); kp1 = *(const uint4*)(kvp + 32 * 256); vp0 = *(const uint4*)(kvp + 128); vp1 = *(const uint4*)(kvp + 128 + 32 * 256); }
#define ATT_STORE(BUF) { bf16_t* k_ = sK + (BUF) * 64 * 72; bf16_t* v_ = sV + (BUF) * 64 * 72; \
    *(uint4*)&k_[sr * 72 + scv * 8] = kp0; *(uint4*)&k_[(sr + 32) * 72 + scv * 8] = kp1; \
    *(uint4*)&v_[sr * 72 + scv * 8] = vp0; *(uint4*)&v_[(sr + 32) * 72 + scv * 8] = vp1; }
  int pbuf = 0;
  __syncthreads();
  ATT_PREFETCH(hb_row(0))
  ATT_STORE(0)
  __syncthreads();
  for (int hb = 0; hb < nhb; hb = hb_next(hb)) {
    const int nxt = hb_next(hb);
    if (nxt < nhb) ATT_PREFETCH(hb_row(nxt))
    int kpos0 = 0;
    bool masked = false;
    if (hb >= 4) { kpos0 = (qblk - 1) * 128 + (hb - 4) * 64; masked = (hb != 6 && hb != 7); }
    const bf16_t* cK = sK + pbuf * 64 * 72;
    const bf16_t* cV = sV + pbuf * 64 * 72;
    bf16x8 qf[2][4];
#pragma unroll
    for (int j = 0; j < 2; ++j)
#pragma unroll
      for (int ks = 0; ks < 4; ++ks)
        qf[j][ks] = *(const bf16x8*)(Q + (size_t)(qrow0 + j * 32 + fr) * 512 + head * 64 + ks * 16 + fh * 8);
#pragma unroll 1
    for (int kb = 0; kb < 2; ++kb) {
      if (masked) {
        const int klo = kpos0 + kb * 32, khi = klo + 31;
        if (klo - (qpos0 + 63) > 128 || qpos0 - khi > 128) continue;
      }
      bf16x8 pb[2][2];
#pragma unroll
      for (int j = 0; j < 2; ++j) {
        f32x16 st[2];
#pragma unroll
        for (int r = 0; r < 16; ++r) st[j][r] = -m[j];
#pragma unroll
        for (int ks = 0; ks < 4; ++ks) {
          const bf16x8 kf = *(const bf16x8*)&cK[(kb * 32 + fr) * 72 + ks * 16 + fh * 8];
          st[j] = MFMA(kf, qf[j][ks], st[j]);
        }
        if (masked) {
          const int qpos = qpos0 + j * 32 + fr;
#pragma unroll
          for (int r = 0; r < 16; ++r) {
            const int d = qpos - (kpos0 + kb * 32 + crow(r, fh));
            if (d > 128 || d < -128) st[j][r] = -1e30f;
          }
        }
        float mx = st[j][0];
#pragma unroll
        for (int r = 1; r < 16; ++r) mx = fmaxf(mx, st[j][r]);
        mx = fmaxf(mx, __shfl_xor(mx, 32));
        const bool grow = mx > 8.f;
        if (__builtin_amdgcn_ballot_w64(grow) != 0ull) {
          const float delta = grow ? mx : 0.f;
          const float alpha = __builtin_amdgcn_exp2f(-delta);
#pragma unroll
          for (int r = 0; r < 16; ++r) st[j][r] -= delta;
          lsum[j] *= alpha;
          m[j] += delta;
#pragma unroll
          for (int mt = 0; mt < 2; ++mt)
#pragma unroll
            for (int r = 0; r < 16; ++r) o[mt][j][r] *= alpha;
        }
        float rs = 0.f;
#pragma unroll
        for (int r = 0; r < 16; ++r) { const float pv = __builtin_amdgcn_exp2f(st[j][r]); st[j][r] = pv; rs += pv; }
        rs += __shfl_xor(rs, 32);
        lsum[j] += rs;
#pragma unroll
        for (int s = 0; s < 2; ++s) {
          uint4 pk;
          pk.x = pack2(st[j][8 * s + 0], st[j][8 * s + 1]); pk.y = pack2(st[j][8 * s + 2], st[j][8 * s + 3]);
          pk.z = pack2(st[j][8 * s + 4], st[j][8 * s + 5]); pk.w = pack2(st[j][8 * s + 6], st[j][8 * s + 7]);
          pb[j][s] = __builtin_bit_cast(bf16x8, pk);
        }
      }
#pragma unroll
      for (int s = 0; s < 2; ++s)
#pragma unroll
        for (int mt = 0; mt < 2; ++mt) {
          const bf16x8 vf = tr_frag(cV, 72, kb * 32 + 16 * s + 4 * fh, kb * 32 + 16 * s + 8 + 4 * fh, mt * 32);
#pragma unroll
          for (int j = 0; j < 2; ++j) o[mt][j] = MFMA(vf, pb[j][s], o[mt][j]);
        }
    }
    if (nxt < nhb) ATT_STORE(pbuf ^ 1)
    pbuf ^= 1;
    __syncthreads();
  }
#undef ATT_PREFETCH
#undef ATT_STORE
#pragma unroll
  for (int j = 0; j < 2; ++j) {
    const float inv = 1.f / lsum[j];
    const size_t rho = (size_t)(qrow0 + j * 32 + fr);
#pragma unroll
    for (int mt = 0; mt < 2; ++mt)
#pragma unroll
      for (int g4 = 0; g4 < 4; ++g4) {
        const int d0 = mt * 32 + 8 * g4 + 4 * fh;
        const uint2 gv = *(const uint2*)(AG + rho * 512 + head * 64 + d0);
        uint2 ov;
        ov.x = pack2(o[mt][j][g4 * 4 + 0] * inv * silu_f(lo2f(gv.x)), o[mt][j][g4 * 4 + 1] * inv * silu_f(hi2f(gv.x)));
        ov.y = pack2(o[mt][j][g4 * 4 + 2] * inv * silu_f(lo2f(gv.y)), o[mt][j][g4 * 4 + 3] * inv * silu_f(hi2f(gv.y)));
        *(uint2*)(Q + rho * 512 + head * 64 + d0) = ov;
      }
  }
}

DI void states_item(const Params& p_in, char* smem, int ck, int g, int hq) {
  const Params p = load_params();

  bf16_t* sB = (bf16_t*)smem;
  bf16_t* sX = (bf16_t*)(smem + 128 * 136 * 2);
  int tid = threadIdx.x; asm volatile("" : "+v"(tid)); const int lane = tid & 63, wave = tid >> 6, wr = wave >> 1, wc = wave & 1, fr = lane & 31, fh = lane >> 5;
  const bf16_t* BC = (const bf16_t*)(p.ws + OFF_BC);
  const bf16_t* XS = (const bf16_t*)(p.ws + OFF_H);
  const float* DT = (const float*)(p.ws + OFF_DT);
  const float* CS = (const float*)(p.ws + OFF_CS);
  bf16_t* ST = (bf16_t*)(p.ws + OFF_ST);
  float* CDEC = (float*)(p.ws + OFF_CDEC);
  const int row0 = ck * 128;
  __syncthreads();
  for (int v = tid; v < 2048; v += 256) {
    const int r = v >> 4, cv = v & 15;
    *(uint4*)&sB[r * 136 + cv * 8] = *(const uint4*)(BC + (size_t)(row0 + r) * 512 + g * 128 + cv * 8);
  }
  __syncthreads();
  bf16x8 bfr[2][8];
#pragma unroll
  for (int j = 0; j < 2; ++j)
#pragma unroll
    for (int ks = 0; ks < 8; ++ks) bfr[j][ks] = tr_frag(sB, 136, ks * 16 + 8 * fh, ks * 16 + 8 * fh + 4, wc * 64 + j * 32);
  const int slr = tid >> 3, scv = tid & 7;
  uint4 xq0, xq1, xq2, xq3;
  float dq0, dq1, dq2, dq3, cq0, cq1, cq2, cq3, cendq;
#define ST_PREFETCH(HD) { const int head_ = g * 8 + hq * 4 + ((HD) >> 1), d_ = (HD) & 1, col_ = d_ * 16 + head_; \
    const bf16_t* xp_ = XS + (size_t)(row0 + slr) * 1024 + head_ * 64 + scv * 8; \
    xq0 = *(const uint4*)(xp_); xq1 = *(const uint4*)(xp_ + 32 * 1024); xq2 = *(const uint4*)(xp_ + 64 * 1024); xq3 = *(const uint4*)(xp_ + 96 * 1024); \
    const size_t rb_ = (size_t)(row0 + slr) * 32 + col_; \
    dq0 = DT[rb_]; dq1 = DT[rb_ + 32 * 32]; dq2 = DT[rb_ + 64 * 32]; dq3 = DT[rb_ + 96 * 32]; \
    cq0 = CS[rb_]; cq1 = CS[rb_ + 32 * 32]; cq2 = CS[rb_ + 64 * 32]; cq3 = CS[rb_ + 96 * 32]; \
    cendq = CS[(size_t)(row0 + (d_ == 0 ? 127 : 0)) * 32 + col_]; }
#define ST_SCALE_STORE(X, DTV, CSV, ROW) { const float sc_ = (DTV) * __expf(cend - (CSV)); uint4 o_; \
    o_.x = pack2(lo2f(X.x) * sc_, hi2f(X.x) * sc_); o_.y = pack2(lo2f(X.y) * sc_, hi2f(X.y) * sc_); \
    o_.z = pack2(lo2f(X.z) * sc_, hi2f(X.z) * sc_); o_.w = pack2(lo2f(X.w) * sc_, hi2f(X.w) * sc_); \
    *(uint4*)&sX[(ROW) * 72 + scv * 8] = o_; }
  ST_PREFETCH(0)
#pragma unroll 1
  for (int hd = 0; hd < 8; ++hd) {
    const int head = g * 8 + hq * 4 + (hd >> 1), d = hd & 1;
    const float cend = cendq;
    ST_SCALE_STORE(xq0, dq0, cq0, slr)
    ST_SCALE_STORE(xq1, dq1, cq1, slr + 32)
    ST_SCALE_STORE(xq2, dq2, cq2, slr + 64)
    ST_SCALE_STORE(xq3, dq3, cq3, slr + 96)
    if (hd < 7) ST_PREFETCH(hd + 1)
    __syncthreads();
    f32x16 acc[2];
#pragma unroll
    for (int j = 0; j < 2; ++j)
#pragma unroll
      for (int r = 0; r < 16; ++r) acc[j][r] = 0.f;
#pragma unroll
    for (int ks = 0; ks < 8; ++ks) {
      const bf16x8 af = tr_frag(sX, 72, ks * 16 + 8 * fh, ks * 16 + 8 * fh + 4, wr * 32);
#pragma unroll
      for (int j = 0; j < 2; ++j) acc[j] = MFMA(af, bfr[j][ks], acc[j]);
    }
    bf16_t* dst = ST + ((size_t)(ck * 2 + d) * 16 + head) * 8192;
#pragma unroll
    for (int j = 0; j < 2; ++j)
#pragma unroll
      for (int r = 0; r < 16; ++r) dst[(wr * 32 + crow(r, fh)) * 128 + wc * 64 + j * 32 + fr] = f2bf(acc[j][r]);
    if (tid == 0) CDEC[(ck * 2 + d) * 16 + head] = __expf(cend);
    __syncthreads();
  }
}

DI void pw_item(const Params& p_in, int l, char* smem, int mt, int nt) {
  const Params p = load_params();

  GemmS* s = (GemmS*)smem;
  int tid = threadIdx.x; asm volatile("" : "+v"(tid)); const int lane = tid & 63, wave = tid >> 6, wr = wave >> 1, wc = wave & 1, fr = lane & 31, fh = lane >> 5;
  const bf16_t* Ab = (const bf16_t*)(p.ws + OFF_HDN) + (size_t)mt * 128 * 512;
  const bf16_t* Bb = (const bf16_t*)(p.ws + OFF_PW) + (size_t)nt * 128 * 512;
  bf16_t* CG = (bf16_t*)(p.ws + OFF_CG);
  f32x16 acc[2][2];
  zero_acc(acc);
  gemm_core2(acc, (GemmS2*)smem,
             [&](int kt, int r, int kv) { return Ab + (size_t)r * 512 + kt * 64 + kv * 8; },
             [&](int kt, int r, int kv) { return Bb + (size_t)r * 512 + kt * 64 + kv * 8; }, 8, [](int) {});
  const float* pwb = p.conv_pw_b + l * 512 + nt * 128;
  epilogue_lds(acc, smem, [&](int rl, int c4, float4 v) {
    bf16_t* ptr = CG + (size_t)(mt * 128 + rl) * 512 + nt * 128 + c4;
    const uint2 gv = *(const uint2*)ptr;
    const float4 bb = *(const float4*)(pwb + c4);
    uint2 o;
    o.x = pack2((v.x + bb.x) * silu_f(lo2f(gv.x)), (v.y + bb.y) * silu_f(hi2f(gv.x)));
    o.y = pack2((v.z + bb.z) * silu_f(lo2f(gv.y)), (v.w + bb.w) * silu_f(hi2f(gv.y)));
    *(uint2*)ptr = o;
  });
}

DI void phase_mix(const Params& p, int l, char* smem) {
  const int G = gridDim.x;
  const int N_ATT = 512 + (l == 0 ? 32 : 0);
  for (int it = blockIdx.x; it < N_ATT; it += G) {
    if (it < 512) attn_item(p, l, smem, it >> 7, (it >> 2) & 31, (it >> 1) & 1, it & 1, false);
    else { const int t = it - 512; attn_item(p, l, smem, t >> 3, (t >> 2) & 1, (t >> 1) & 1, t & 1, true); }
  }
  for (int it = (blockIdx.x + G - 32) % G; it < NCK * 4; it += G) states_item(p, smem, it >> 2, (it >> 1) & 1, it & 1);
  for (int it = (blockIdx.x + G - 64) % G; it < NCK * 4; it += G) pw_item(p, l, smem, it >> 2, it & 3);
}

DI void phase_scan(const Params& p_in) {
  const Params p = load_params();

  bf16_t* ST = (bf16_t*)(p.ws + OFF_ST);
  const float* CDEC = (const float*)(p.ws + OFF_CDEC);
  for (int it = blockIdx.x; it < 512; it += gridDim.x) {
    const int e = it * 256 + threadIdx.x;
    const int bdh = e >> 10, v8 = e & 1023;
    const int b = bdh >> 5, d = (bdh >> 4) & 1, h = bdh & 15;
    float s[8];
#pragma unroll
    for (int i = 0; i < 8; ++i) s[i] = 0.f;
    auto ckof = [&](int i) {
      if (d == 0) return (i < 2) ? (128 + 2 * b + i) : (32 * b + (i - 2));
      return (i < 2) ? (128 + 2 * b + (1 - i)) : (32 * b + 31 - (i - 2));
    };
    auto pof = [&](int i) { const int ck = ckof(i); return (uint4*)(ST + ((size_t)(ck * 2 + d) * 16 + h) * 8192 + v8 * 8); };
    auto dof = [&](int i) { const int ck = ckof(i); return CDEC[(ck * 2 + d) * 16 + h]; };
    uint4 buf[8]; float dc[8];
#pragma unroll
    for (int i = 0; i < 7; ++i) { buf[i] = *pof(i); dc[i] = dof(i); }
#pragma unroll
    for (int i = 0; i < 34; ++i) {
      if (i + 7 < 34) { buf[(i + 7) & 7] = *pof(i + 7); dc[(i + 7) & 7] = dof(i + 7); }
      const uint4 cur = buf[i & 7];
      const float dec = dc[i & 7];
      uint4 o;
      o.x = pack2(s[0], s[1]); o.y = pack2(s[2], s[3]); o.z = pack2(s[4], s[5]); o.w = pack2(s[6], s[7]);
      *pof(i) = o;
      s[0] = s[0] * dec + lo2f(cur.x); s[1] = s[1] * dec + hi2f(cur.x);
      s[2] = s[2] * dec + lo2f(cur.y); s[3] = s[3] * dec + hi2f(cur.y);
      s[4] = s[4] * dec + lo2f(cur.z); s[5] = s[5] * dec + hi2f(cur.z);
      s[6] = s[6] * dec + lo2f(cur.w); s[7] = s[7] * dec + hi2f(cur.w);
    }
  }
}

DI void phase_ssdy(const Params& p_in, int l, char* smem) {
  const Params p = load_params();

  bf16_t* sB = (bf16_t*)smem;
  bf16_t* sX = (bf16_t*)(smem + 128 * 136 * 2);
  float* sF = (float*)(smem + 128 * 136 * 2 + 128 * 72 * 2);
  float* sSS = sF + 512;
  int tid = threadIdx.x; asm volatile("" : "+v"(tid)); const int lane = tid & 63, wave = tid >> 6, fr = lane & 31, fh = lane >> 5;
  const int wl = wave >> 1, w2 = wave & 1;
  const bf16_t* BC = (const bf16_t*)(p.ws + OFF_BC);
  const bf16_t* XS = (const bf16_t*)(p.ws + OFF_H);
  const float* DT = (const float*)(p.ws + OFF_DT);
  const float* CS = (const float*)(p.ws + OFF_CS);
  const bf16_t* ST = (const bf16_t*)(p.ws + OFF_ST);
  bf16_t* Z = (bf16_t*)(p.ws + OFF_Z);
  float* RSTD = (float*)(p.ws + OFF_RSTD);
  const int nck = (l == 0) ? NCK : 128;
  const int nh = (l == 0) ? 2 : 8;
  const int nsplit = 8 / nh;
  for (int it0 = blockIdx.x; it0 < nck * 4 * nsplit; it0 += gridDim.x) {
    const int hq = it0 % nsplit, it = it0 / nsplit;
    const int hbeg = hq * nh, hend = hbeg + nh;
    const int ck = it >> 2, g = (it >> 1) & 1, lh = it & 1;
    const int row0 = ck * 128;
    const int lbase = lh * 64 + wl * 32;
    __syncthreads();
    for (int v = tid; v < 2048; v += 256) {
      const int r = v >> 4, cv = v & 15;
      *(uint4*)&sB[r * 136 + cv * 8] = *(const uint4*)(BC + (size_t)(row0 + r) * 512 + g * 128 + cv * 8);
    }
    if (tid < 64) sSS[tid] = 0.f;
    const bf16_t* cptr = BC + (size_t)(row0 + lbase + fr) * 512 + 256 + g * 128 + fh * 8;
    bf16x8 cf[8];
#pragma unroll
    for (int ks = 0; ks < 8; ++ks) cf[ks] = *(const bf16x8*)(cptr + ks * 16);
    const int lrx = tid >> 3, cvx = tid & 7;
    const bf16_t* xsrc = XS + (size_t)(row0 + lrx) * 1024 + cvx * 8;
    uint4 xp0, xp1, xp2, xp3;
    float fp0 = 0.f, fp1 = 0.f, fp2 = 0.f, fp3 = 0.f;
    {
      const int head = g * 8 + hbeg;
      xp0 = *(const uint4*)(xsrc + head * 64);
      xp1 = *(const uint4*)(xsrc + head * 64 + 32 * 1024);
      xp2 = *(const uint4*)(xsrc + head * 64 + 64 * 1024);
      xp3 = *(const uint4*)(xsrc + head * 64 + 96 * 1024);
      if (tid < 128) {
        const size_t rho = (size_t)(row0 + tid);
        fp0 = CS[rho * 32 + head]; fp1 = CS[rho * 32 + 16 + head]; fp2 = DT[rho * 32 + head]; fp3 = DT[rho * 32 + 16 + head];
      }
    }
    __syncthreads();
    f32x16 cb[2];
#pragma unroll
    for (int j = 0; j < 2; ++j) {
#pragma unroll
      for (int r = 0; r < 16; ++r) cb[j][r] = 0.f;
#pragma unroll
      for (int ks = 0; ks < 8; ++ks) {
        const bf16x8 bq = *(const bf16x8*)&sB[(w2 * 64 + j * 32 + fr) * 136 + ks * 16 + fh * 8];
        cb[j] = MFMA(cf[ks], bq, cb[j]);
      }
    }
    const int pidx = w2 * 32 + fr;
    bf16_t* sCB = sB + 64 * 136;
    __syncthreads();
#pragma unroll
    for (int j = 0; j < 2; ++j)
#pragma unroll
      for (int r = 0; r < 16; ++r) sCB[(wl * 32 + crow(r, fh)) * 136 + w2 * 64 + j * 32 + fr] = f2bf(cb[j][r]);
#pragma unroll 1
    for (int hh = hbeg; hh < hend; ++hh) {
      const int head = g * 8 + hh;
      __syncthreads();
      *(uint4*)&sX[lrx * 72 + cvx * 8] = xp0;
      *(uint4*)&sX[(lrx + 32) * 72 + cvx * 8] = xp1;
      *(uint4*)&sX[(lrx + 64) * 72 + cvx * 8] = xp2;
      *(uint4*)&sX[(lrx + 96) * 72 + cvx * 8] = xp3;
      if (tid < 128) { sF[tid] = fp0; sF[128 + tid] = fp1; sF[256 + tid] = fp2; sF[384 + tid] = fp3; }
      const bf16_t* S0 = ST + ((size_t)(ck * 2 + 0) * 16 + head) * 8192 + (w2 * 32 + fr) * 128 + fh * 8;
      const bf16_t* S1 = ST + ((size_t)(ck * 2 + 1) * 16 + head) * 8192 + (w2 * 32 + fr) * 128 + fh * 8;
      bf16x8 sf0[8];
#pragma unroll
      for (int ks = 0; ks < 8; ++ks) sf0[ks] = *(const bf16x8*)(S0 + ks * 16);
      bf16_t* zbase = Z + (size_t)(row0 + lbase + 4 * fh) * 1024 + head * 64 + pidx;
      if (hh + 1 < hend) {
        const int hn = head + 1;
        xp0 = *(const uint4*)(xsrc + hn * 64);
        xp1 = *(const uint4*)(xsrc + hn * 64 + 32 * 1024);
        xp2 = *(const uint4*)(xsrc + hn * 64 + 64 * 1024);
        xp3 = *(const uint4*)(xsrc + hn * 64 + 96 * 1024);
        if (tid < 128) {
          const size_t rho = (size_t)(row0 + tid);
          fp0 = CS[rho * 32 + hn]; fp1 = CS[rho * 32 + 16 + hn]; fp2 = DT[rho * 32 + hn]; fp3 = DT[rho * 32 + 16 + hn];
        }
      }
      __syncthreads();
#pragma unroll
      for (int j = 0; j < 2; ++j) {
        const int sidx = w2 * 64 + j * 32 + fr;
        const float csf_s = sF[sidx], csb_s = sF[128 + sidx], dtf_s = sF[256 + sidx], dtb_s = sF[384 + sidx];
#pragma unroll 4
        for (int r = 0; r < 16; ++r) {
          const int lidx = lbase + crow(r, fh);
          float f = 0.f;
          if (sidx <= lidx) f += __expf(sF[lidx] - csf_s) * dtf_s;
          if (sidx >= lidx) f += __expf(sF[128 + lidx] - csb_s) * dtb_s;
          sB[(wl * 32 + crow(r, fh)) * 136 + sidx] = f2bf(bf2f(sCB[(wl * 32 + crow(r, fh)) * 136 + sidx]) * f);
        }
      }
      __syncthreads();
      bf16x8 sf1[8], cfh[8];
#pragma unroll
      for (int ks = 0; ks < 8; ++ks) { sf1[ks] = *(const bf16x8*)(S1 + ks * 16); cfh[ks] = *(const bf16x8*)(cptr + ks * 16); }
      unsigned short zv[16];
#pragma unroll
      for (int r = 0; r < 16; ++r) zv[r] = zbase[(size_t)((r & 3) + 8 * (r >> 2)) * 1024];
      f32x16 accy;
#pragma unroll
      for (int r = 0; r < 16; ++r) accy[r] = 0.f;
#pragma unroll
      for (int ks = 0; ks < 8; ++ks) {
        const bf16x8 af = *(const bf16x8*)&sB[(wl * 32 + fr) * 136 + ks * 16 + fh * 8];
        const bf16x8 xf = tr_frag(sX, 72, ks * 16 + 8 * fh, ks * 16 + 8 * fh + 4, w2 * 32);
        accy = MFMA(af, xf, accy);
      }
      {
        f32x16 acct;
#pragma unroll
        for (int r = 0; r < 16; ++r) acct[r] = 0.f;
#pragma unroll
        for (int ks = 0; ks < 8; ++ks) acct = MFMA(cfh[ks], sf0[ks], acct);
#pragma unroll
        for (int r = 0; r < 16; ++r) accy[r] += __expf(sF[lbase + crow(r, fh)]) * acct[r];
#pragma unroll
        for (int r = 0; r < 16; ++r) acct[r] = 0.f;
#pragma unroll
        for (int ks = 0; ks < 8; ++ks) acct = MFMA(cfh[ks], sf1[ks], acct);
#pragma unroll
        for (int r = 0; r < 16; ++r) accy[r] += __expf(sF[128 + lbase + crow(r, fh)]) * acct[r];
      }
      const float dsk = p.ssd_d[l * 16 + head];
      float v[16];
#pragma unroll
      for (int r = 0; r < 16; ++r) {
        const int lidx = lbase + crow(r, fh);
        const float xv = bf2f(sX[lidx * 72 + pidx]);
        const float y = accy[r] + dsk * xv;
        const float u = y * silu_f(bf2f(zv[r]));
        v[r] = u * u;
        zbase[(size_t)((r & 3) + 8 * (r >> 2)) * 1024] = f2bf(u);
      }
#pragma unroll
      for (int i = 0; i < 8; ++i) { const bool up = (fr & 16) != 0; const float keep = up ? v[i + 8] : v[i]; const float send = up ? v[i] : v[i + 8]; v[i] = keep + __shfl_xor(send, 16); }
#pragma unroll
      for (int i = 0; i < 4; ++i) { const bool up = (fr & 8) != 0; const float keep = up ? v[i + 4] : v[i]; const float send = up ? v[i] : v[i + 4]; v[i] = keep + __shfl_xor(send, 8); }
#pragma unroll
      for (int i = 0; i < 2; ++i) { const bool up = (fr & 4) != 0; const float keep = up ? v[i + 2] : v[i]; const float send = up ? v[i] : v[i + 2]; v[i] = keep + __shfl_xor(send, 4); }
      { const bool up = (fr & 2) != 0; const float keep = up ? v[1] : v[0]; const float send = up ? v[0] : v[1]; v[0] = keep + __shfl_xor(send, 2); }
      v[0] += __shfl_xor(v[0], 1);
      if ((fr & 1) == 0) atomicAdd(&sSS[wl * 32 + crow(fr >> 1, fh)], v[0]);
    }
    __syncthreads();
    if (tid < 64) atomicAdd(&RSTD[(size_t)(row0 + lh * 64 + tid) * 2 + g], sSS[tid]);
  }
}

DI void phase_outproj(const Params& p_in, int l, char* smem) {
  const Params p = load_params();

  GemmS* s = (GemmS*)smem;
  int tid = threadIdx.x; asm volatile("" : "+v"(tid)); const int lane = tid & 63, wave = tid >> 6, wr = wave >> 1, wc = wave & 1, fr = lane & 31, fh = lane >> 5;
  const bf16_t* Zb = (const bf16_t*)(p.ws + OFF_Z);
  const bf16_t* Qb = (const bf16_t*)(p.ws + OFF_Q);
  const bf16_t* Cb = (const bf16_t*)(p.ws + OFF_CG);
  const bf16_t* W = (const bf16_t*)(p.ws + OFF_WOUT);
  const float* RSTD = (const float*)(p.ws + OFF_RSTD);
  const float* mods = (const float*)(p.ws + OFF_MODS);
  float* XC = (float*)(p.ws + OFF_XC);
  for (int step = 0;; ++step) {
    int mt, nt2;
    if (!xcd_tile(step, 128, 4, mt, nt2)) break;
    f32x16 acc[2][4];
#pragma unroll
    for (int i = 0; i < 2; ++i)
#pragma unroll
      for (int j = 0; j < 4; ++j)
#pragma unroll
        for (int r = 0; r < 16; ++r) acc[i][j][r] = 0.f;
    const bf16_t* Wb = W + (size_t)nt2 * 256 * 2048;
    const bf16_t* A0 = Zb + (size_t)mt * 128 * 1024;
    const bf16_t* A2 = Qb + (size_t)mt * 128 * 512;
    const bf16_t* A3 = Cb + (size_t)mt * 128 * 512;
    float* sScale = (float*)(smem + 55296);
    __syncthreads();
    if (tid < 128) {
      const size_t row = (size_t)(mt * 128 + tid);
      const float r0 = rsqrtf(RSTD[row * 2] * (1.f / 512.f) + 1e-6f);
      const float r1 = rsqrtf(RSTD[row * 2 + 1] * (1.f / 512.f) + 1e-6f);
      sScale[tid * 2] = r0 / r1;
      sScale[tid * 2 + 1] = r1;
    }
    gemm_core3(acc, (GemmS3*)smem,
               [&](int kt, int r, int kv) {
                 const bf16_t* ptr;
                 if (kt < 16) ptr = A0 + (size_t)r * 1024 + kt * 64;
                 else if (kt < 24) ptr = A2 + (size_t)r * 512 + (kt - 16) * 64;
                 else ptr = A3 + (size_t)r * 512 + (kt - 24) * 64;
                 return ptr + kv * 8;
               },
               [&](int kt, int r, int kv) { return Wb + (size_t)r * 2048 + kt * 64 + kv * 8; }, 32,
               [&](int kt) __attribute__((always_inline)) {
                 if (kt == 8 || kt == 16) {
#pragma unroll
                   for (int i = 0; i < 2; ++i)
#pragma unroll
                     for (int r = 0; r < 16; ++r) {
                       const float f = sScale[(wr * 64 + i * 32 + crow(r, fh)) * 2 + (kt == 16 ? 1 : 0)];
                       acc[i][0][r] *= f; acc[i][1][r] *= f; acc[i][2][r] *= f; acc[i][3][r] *= f;
                     }
                 }
               });
    {
      const int row0 = mt * 128;
      const int vv = row0 >> 12;
      float* xnew = p.out + (size_t)row0 * 1024;
      const float* xold = (l == 0) ? (p.x + (size_t)row0 * 1024) : xnew;
#pragma unroll 1
      for (int sub = 0; sub < 2; ++sub) {
        const int nt = nt2 * 2 + sub;
        const float* gate = mods + (l * 5 + vv) * 3072 + 2048 + nt * 128;
        epilogue_lds2(acc, smem, sub, [&](int rl, int c4, float4 v) {
          const int off = rl * 1024 + nt * 128 + c4;
          const float4 xo = *(const float4*)(xold + off);
          const float4 gt = *(const float4*)(gate + c4);
          float4 o;
          o.x = xo.x + gt.x * v.x; o.y = xo.y + gt.y * v.y; o.z = xo.z + gt.z * v.z; o.w = xo.w + gt.w * v.w;
          *(float4*)(xnew + off) = o;
        });
      }
    }
  }
  const int nctx = (l == 0) ? 64 : 0;
  for (int it = (int)blockIdx.x; it < nctx; it += gridDim.x) {
    const int mt = 128 + (it >> 3), nt = it & 7;
    f32x16 acc[2][2];
    zero_acc(acc);
    const bf16_t* Wb = W + (size_t)nt * 128 * 2048;
    const bf16_t* A0 = Zb + (size_t)mt * 128 * 1024;
    const bf16_t* A2 = Qb + (size_t)mt * 128 * 512;
    const bf16_t* A3 = Cb + (size_t)mt * 128 * 512;
    float* sScale = (float*)(smem + 40960);
    if (tid < 128) {
      const size_t row = (size_t)(mt * 128 + tid);
      const float r0 = rsqrtf(RSTD[row * 2] * (1.f / 512.f) + 1e-6f);
      const float r1 = rsqrtf(RSTD[row * 2 + 1] * (1.f / 512.f) + 1e-6f);
      sScale[tid * 2] = r0 / r1;
      sScale[tid * 2 + 1] = r1;
    }
    gemm_core2(acc, (GemmS2*)smem,
               [&](int kt, int r, int kv) {
                 const bf16_t* ptr;
                 if (kt < 16) ptr = A0 + (size_t)r * 1024 + kt * 64;
                 else if (kt < 24) ptr = A2 + (size_t)r * 512 + (kt - 16) * 64;
                 else ptr = A3 + (size_t)r * 512 + (kt - 24) * 64;
                 return ptr + kv * 8;
               },
               [&](int kt, int r, int kv) { return Wb + (size_t)r * 2048 + kt * 64 + kv * 8; }, 32,
               [&](int kt) __attribute__((always_inline)) {
                 if (kt == 8 || kt == 16) {
#pragma unroll
                   for (int i = 0; i < 2; ++i)
#pragma unroll
                     for (int r = 0; r < 16; ++r) {
                       const float f = sScale[(wr * 64 + i * 32 + crow(r, fh)) * 2 + (kt == 16 ? 1 : 0)];
                       acc[i][0][r] *= f; acc[i][1][r] *= f;
                     }
                 }
               });
    {
      const int row0 = mt * 128;
      const int vv = (row0 < RL_) ? (row0 >> 12) : 4;
      const float* gate = mods + (l * 5 + vv) * 3072 + 2048 + nt * 128;
      float* xnew = (row0 < RL_) ? (p.out + (size_t)row0 * 1024) : (XC + (size_t)(row0 - RL_) * 1024);
      const float* xold = (l == 0) ? ((row0 < RL_) ? (p.x + (size_t)row0 * 1024) : (p.ctx + (size_t)(row0 - RL_) * 1024)) : xnew;
      epilogue_lds(acc, smem, [&](int rl, int c4, float4 v) {
        const int off = rl * 1024 + nt * 128 + c4;
        const float4 xo = *(const float4*)(xold + off);
        const float4 gt = *(const float4*)(gate + c4);
        float4 o;
        o.x = xo.x + gt.x * v.x; o.y = xo.y + gt.y * v.y; o.z = xo.z + gt.z * v.z; o.w = xo.w + gt.w * v.w;
        *(float4*)(xnew + off) = o;
      });
    }
  }
  if (l == 0) {
    const int local = blockIdx.x >> 3, xcd = blockIdx.x & 7, nloc = gridDim.x >> 3;
    if (local >= 8 && nloc > 8) {
      const int nb = (nloc - 8) * 8;
      const int NT_WIN = 88 * 16, NT_PW = 64;
      for (int it = (local - 8) * 8 + xcd; it < NT_WIN + NT_PW; it += nb) {
        if (it < NT_WIN) transpose_tile(p.w_in + (size_t)1024 * 5408, 5408, 0, nullptr, (bf16_t*)(p.ws + OFF_WIN), 1024, (it / 16) * 64, (it % 16) * 64, (float*)smem);
        else { const int t = it - NT_WIN; transpose_tile(p.conv_pw_w + (size_t)512 * 512, 512, 1, nullptr, (bf16_t*)(p.ws + OFF_PW), 512, (t / 8) * 64, (t % 8) * 64, (float*)smem); }
      }
    }
  }
}

DI void phase_final(const Params& p_in) {
  const Params p = load_params();
  const int lane = threadIdx.x & 63, wave = threadIdx.x >> 6;
  for (int it = blockIdx.x; it < RL_ / 8; it += gridDim.x) {
    float* xr0 = p.out + (size_t)(it * 8 + wave * 2) * 1024;
    float4 xv[2][4];
#pragma unroll
    for (int q = 0; q < 2; ++q)
#pragma unroll
      for (int i = 0; i < 4; ++i) xv[q][i] = *(const float4*)(xr0 + q * 1024 + lane * 4 + i * 256);
    float4 w[4];
#pragma unroll
    for (int i = 0; i < 4; ++i) w[i] = *(const float4*)(p.final_norm_w + lane * 4 + i * 256);
#pragma unroll
    for (int q = 0; q < 2; ++q) {
      float ss = 0.f;
#pragma unroll
      for (int i = 0; i < 4; ++i) ss += xv[q][i].x * xv[q][i].x + xv[q][i].y * xv[q][i].y + xv[q][i].z * xv[q][i].z + xv[q][i].w * xv[q][i].w;
#pragma unroll
      for (int o = 32; o >= 1; o >>= 1) ss += __shfl_xor(ss, o);
      const float rs = rsqrtf(ss * (1.f / 1024.f) + 1e-6f);
#pragma unroll
      for (int i = 0; i < 4; ++i) {
        float4 o;
        o.x = xv[q][i].x * rs * w[i].x; o.y = xv[q][i].y * rs * w[i].y; o.z = xv[q][i].z * rs * w[i].z; o.w = xv[q][i].w * rs * w[i].w;
        *(float4*)(xr0 + q * 1024 + lane * 4 + i * 256) = o;
      }
    }
  }
}

template <int PH>
DI void run_phase(const Params& p, char* smem) {
  constexpr int l = (PH - 1) / 7, s = (PH - 1) % 7;
  if constexpr (PH == 0) phase_mods(p, smem);
  else if constexpr (PH == 15) phase_final(p);
  else if constexpr (s == 0) phase_prep(p, l, smem);
  else if constexpr (s == 1) phase_inproj(p, smem);
  else if constexpr (s == 2) phase_local(p, l, smem);
  else if constexpr (s == 3) phase_mix(p, l, smem);
  else if constexpr (s == 4) phase_scan(p);
  else if constexpr (s == 5) phase_ssdy(p, l, smem);
  else phase_outproj(p, l, smem);
}

#if PROBE_S >= 0
#define PROBE_BEGIN() if (threadIdx.x == 0) pst[1] = wall_clock64();
#define PROBE_END(PH) if (threadIdx.x == 0 && (PH) >= 1 && (PH) <= 14 && (((PH) - 1) % 7) == PROBE_S) pst[0] += wall_clock64() - pst[1];
#else
#define PROBE_BEGIN()
#define PROBE_END(PH)
#endif
#define PHASE(PH) PROBE_BEGIN() run_phase<PH>(p, smem); xcd_barrier(xst); PROBE_END(PH)

__global__ void __launch_bounds__(256, 2) fwd_megakernel(Params p) {
  __shared__ __attribute__((aligned(16))) char smem[57344];
  cg::grid_group grid = cg::this_grid();
  if (threadIdx.x == 0) g_kernarg = (unsigned long long)__builtin_amdgcn_kernarg_segment_ptr();
  __syncthreads();
#if PROBE_S >= 0
  volatile unsigned long long* pst = (volatile unsigned long long*)(smem + 57344 - 16);
  if (threadIdx.x == 0) { pst[0] = 0; pst[1] = 0; }
#endif
  __shared__ uint4 xb_words;
  volatile LAS unsigned* xst = (volatile LAS unsigned*)&xb_words;
  if (threadIdx.x == 0) xb_words = make_uint4(0u, 0u, 0u, 0u);
  if (threadIdx.x == 0) { unsigned* bar = (unsigned*)(load_params().ws + OFF_BAR); (void)xb_add(&bar[XB_XCNT(xb_xcc_id())], 1u); }
  run_phase<0>(p, smem);
  if (load_params().out == nullptr) grid.sync();
  xcd_barrier(xst);
  PHASE(1) PHASE(2) PHASE(3) PHASE(4) PHASE(5) PHASE(6) PHASE(7)
  PHASE(8) PHASE(9) PHASE(10) PHASE(11) PHASE(12) PHASE(13) PHASE(14)
  run_phase<15>(p, smem);
#if PROBE_S >= 0
  if (blockIdx.x == 0 && threadIdx.x == 0) {
    const unsigned long long t1 = wall_clock64();
    const unsigned long long lim = 4ull * pst[0];
    while (wall_clock64() - t1 < lim) { __builtin_amdgcn_s_sleep(32); }
  }
#endif
}

extern "C" void kernel_launch(void* const* d_in, const int* in_sizes, int n_in, void* d_out, int out_size, void* d_ws,
                              size_t ws_size, hipStream_t stream) {
  static int grid_blocks = 0;
  if (!grid_blocks) {
    int dev = 0, cus = 0, per_cu = 0;
    hipGetDevice(&dev);
    hipDeviceGetAttribute(&cus, hipDeviceAttributeMultiprocessorCount, dev);
    hipOccupancyMaxActiveBlocksPerMultiprocessor(&per_cu, fwd_megakernel, 256, 0);
    if (per_cu < 1) per_cu = 1;
    if (per_cu > 2) per_cu = 2;
    grid_blocks = (cus * per_cu) & ~7;
  }
  Params p{};
  const float** pp = (const float**)&p;
  for (int i = 0; i < 23; ++i) pp[i] = (const float*)d_in[i];
  p.out = (float*)d_out;
  p.ws = (char*)d_ws;
  (void)hipMemsetAsync((char*)d_ws + OFF_BAR, 0, XCD_BAR_WORDS * 4, stream);
  void* args[] = {&p};
  hipError_t e = hipLaunchCooperativeKernel((void*)fwd_megakernel, dim3(grid_blocks), dim3(256), args, 0, stream);
  if (e != hipSuccess) fprintf(stderr, "cooperative launch failed: %s (grid %d)\n", hipGetErrorString(e), grid_blocks);
}
```

```cpp
#include <hip/hip_runtime.h>
#include <hip/hip_cooperative_groups.h>
#include <stdint.h>
#include <stdio.h>
namespace cg = cooperative_groups;

#ifndef ONE_LAUNCH
#define ONE_LAUNCH 1
#endif

#ifndef PROBE_S
#define PROBE_S -1
#endif
#define DI __device__ __forceinline__
typedef unsigned short bf16_t;
using bf16x8 = __attribute__((ext_vector_type(8))) short;
using s16x4 = __attribute__((ext_vector_type(4))) short;
using f32x16 = __attribute__((ext_vector_type(16))) float;
#define MFMA(a, b, c) __builtin_amdgcn_mfma_f32_32x32x16_bf16((a), (b), (c), 0, 0, 0)

constexpr int R_ = 17408;
constexpr int RL_ = 16384;
constexpr int NCK = 136;

constexpr size_t SZ_WIN = (size_t)5632 * 1024 * 2;
constexpr size_t SZ_WOUT = (size_t)1024 * 2048 * 2;
constexpr size_t SZ_PW = (size_t)512 * 512 * 2;
constexpr size_t SZ_MODS = (size_t)2 * 5 * 3072 * 4;
constexpr size_t SZ_XC = (size_t)1024 * 1024 * 4;
constexpr size_t SZ_RSTD = (size_t)R_ * 2 * 4;
constexpr size_t SZ_CDEC = (size_t)NCK * 32 * 4 + 256 - ((size_t)NCK * 32 * 4) % 256;
constexpr size_t SZ_R512 = (size_t)R_ * 512 * 2;
constexpr size_t OFF_WIN = 0;
constexpr size_t OFF_WOUT = OFF_WIN + SZ_WIN;
constexpr size_t OFF_PW = OFF_WOUT + SZ_WOUT;
constexpr size_t OFF_MODS = OFF_PW + SZ_PW;
constexpr size_t OFF_XC = OFF_MODS + SZ_MODS;
constexpr size_t OFF_RSTD = OFF_XC + SZ_XC;
constexpr size_t OFF_CDEC = OFF_RSTD + SZ_RSTD;
constexpr size_t OFF_H = OFF_CDEC + SZ_CDEC;
constexpr size_t OFF_XBC = OFF_H + 2 * SZ_R512;
constexpr size_t OFF_GLU = OFF_XBC + 3 * SZ_R512;
constexpr size_t OFF_ST = OFF_XBC;
constexpr size_t OFF_Z = OFF_GLU + SZ_R512;
constexpr size_t OFF_DT = OFF_Z + 2 * SZ_R512;
constexpr size_t OFF_CS = OFF_DT + (size_t)R_ * 32 * 4;
constexpr size_t OFF_Q = OFF_CS + (size_t)R_ * 32 * 4;
constexpr size_t OFF_KV = OFF_Q + SZ_R512;
constexpr size_t OFF_AG = OFF_KV + SZ_R512 / 2;
constexpr size_t OFF_CG = OFF_AG + SZ_R512;
constexpr size_t OFF_BC = OFF_CG + SZ_R512;
constexpr size_t OFF_HDN = OFF_BC + SZ_R512;
constexpr size_t WS_TOTAL = OFF_HDN + SZ_R512;
constexpr size_t OFF_BAR = WS_TOTAL;
static_assert(OFF_BAR + 16384 <= (size_t)256 * 1024 * 1024, "workspace too large");

struct Params {
  const float *x, *c, *ctx, *c_ctx, *w_mod, *b_mod, *norm_w, *w_in, *ssd_conv_w, *ssd_conv_b, *ssd_dt_bias, *ssd_a_log,
      *ssd_d, *ssd_norm_w, *attn_sink, *conv_dw_w, *conv_dw_b, *conv_ln_w, *conv_ln_b, *conv_pw_w, *conv_pw_b, *w_out,
      *final_norm_w;
  float* out;
  char* ws;
};


__shared__ unsigned long long g_kernarg;
DI Params load_params() {
  typedef const char __attribute__((address_space(4)))* kptr_t;
  typedef const float* const __attribute__((address_space(4)))* kfld_t;
  const unsigned long long v = *(volatile unsigned long long*)&g_kernarg;
  const unsigned lo = __builtin_amdgcn_readfirstlane((unsigned)v), hi = __builtin_amdgcn_readfirstlane((unsigned)(v >> 32));
  kptr_t base = (kptr_t)(((unsigned long long)hi << 32) | lo);
  Params p;
  const float** pp = (const float**)&p;
#pragma unroll
  for (int i = 0; i < 25; ++i) pp[i] = *(kfld_t)(base + 8 * i);
  return p;
}

#define XB_TMO      128
#define XB_XCNT(j)  (256  + 64 * (j))
#define XB_XSUB(j)  (1280 + 64 * (j))
#define XB_XGEN(j)  (2304 + 64 * (j))
#define XB_TOP      3328
#define XB_TOPGEN   3392
#define XCD_BAR_WORDS 3456
#define XB_SPIN_CAP (1u << 18)
#define LAS __attribute__((address_space(3)))
DI unsigned xb_ld(unsigned* p)              { return __hip_atomic_load(p, __ATOMIC_RELAXED, __HIP_MEMORY_SCOPE_AGENT); }
DI unsigned xb_add(unsigned* p, unsigned v) { return __hip_atomic_fetch_add(p, v, __ATOMIC_RELAXED, __HIP_MEMORY_SCOPE_AGENT); }
DI unsigned xb_xcc_id() { return (unsigned)__builtin_amdgcn_s_getreg((3 << 11) | 20) & 0xFu; }
#define XB_SPIN(cond, bar) do { unsigned _sp = 0; while (cond) { __builtin_amdgcn_s_sleep(1); \
    if ((++_sp & 255u) == 0u) { if (xb_ld(&(bar)[XB_TMO])) break; if (_sp > XB_SPIN_CAP) { atomicAdd(&(bar)[XB_TMO], 1u); break; } } } } while (0)

DI void xcd_barrier_complete(unsigned* bar, unsigned x, unsigned& nloc, unsigned& nx) {
  const unsigned G = gridDim.x * gridDim.y * gridDim.z;
  unsigned sum, cnt, mine, sp = 0u;
  for (;;) {
    sum = 0u; cnt = 0u; mine = 0u;
#pragma unroll
    for (unsigned j = 0; j < 16; ++j) { const unsigned c = xb_ld(&bar[XB_XCNT(j)]); sum += c; cnt += (c > 0u) ? 1u : 0u; mine = (j == x) ? c : mine; }
    if (sum == G) break;
    __builtin_amdgcn_s_sleep(1);
    if ((++sp & 255u) == 0u) { if (xb_ld(&bar[XB_TMO])) break; if (sp > XB_SPIN_CAP) { atomicAdd(&bar[XB_TMO], 1u); break; } }
  }
  nloc = mine > 0u ? mine : 1u; nx = cnt > 0u ? cnt : 1u;
}

DI void xcd_barrier(volatile LAS unsigned* st) {
  asm volatile("s_waitcnt vmcnt(0)" ::: "memory");
  __syncthreads();
  if (threadIdx.x == 0) {
    const Params pb = load_params();
    unsigned* bar = (unsigned*)(pb.ws + OFF_BAR);
    const unsigned x = xb_xcc_id();
    __builtin_amdgcn_s_waitcnt(0);
    unsigned nloc = st[0], nx = st[1];
    if (nloc == 0u) { xcd_barrier_complete(bar, x, nloc, nx); st[0] = nloc; st[1] = nx; }
    const unsigned old = xb_add(&bar[XB_XSUB(x)], 1u);
    const unsigned gen = old / nloc;
    if (old + 1u == (gen + 1u) * nloc) {
      __builtin_amdgcn_fence(__ATOMIC_RELEASE, "agent");
      asm volatile("s_waitcnt vmcnt(0)" ::: "memory");
      const unsigned og = xb_add(&bar[XB_TOP], 1u);
      const unsigned tg = og / nx;
      if (og + 1u == (tg + 1u) * nx) xb_add(&bar[XB_TOPGEN], 1u);
      else XB_SPIN(xb_ld(&bar[XB_TOPGEN]) == tg, bar);
      __builtin_amdgcn_fence(__ATOMIC_ACQUIRE, "agent");
      xb_add(&bar[XB_XGEN(x)], 1u);
      asm volatile("s_waitcnt vmcnt(0)" ::: "memory");
    } else {
      XB_SPIN(xb_ld(&bar[XB_XGEN(x)]) == gen, bar);
      __builtin_amdgcn_fence(__ATOMIC_ACQUIRE, "agent");
      asm volatile("s_waitcnt vmcnt(0)" ::: "memory");
    }
  }
  __syncthreads();
}

typedef __bf16 nbf16x2_t __attribute__((ext_vector_type(2)));
typedef float nf32x2_t __attribute__((ext_vector_type(2)));
DI unsigned short f2bf(float x) { const __bf16 r = (__bf16)x; return __builtin_bit_cast(unsigned short, r); }
DI float bf2f(unsigned short b) { return __uint_as_float(((unsigned)b) << 16); }
DI unsigned pack2(float a, float b) { const nf32x2_t v = {a, b}; const nbf16x2_t r = __builtin_convertvector(v, nbf16x2_t); return __builtin_bit_cast(unsigned, r); }
DI float lo2f(unsigned u) { return __uint_as_float(u << 16); }
DI float hi2f(unsigned u) { return __uint_as_float(u & 0xffff0000u); }
DI float silu_f(float x) { return x / (1.f + __expf(-x)); }
DI float sigmoid_f(float x) { return 1.f / (1.f + __expf(-x)); }
DI int crow(int reg, int h) { return (reg & 3) + 8 * (reg >> 2) + 4 * h; }

DI bf16x8 tr_frag(const bf16_t* s, int ld, int row_lo, int row_hi, int col0) {
  const int lane = threadIdx.x & 63;
  const int i16 = lane & 15, q = i16 >> 2, pp = i16 & 3, blk = (lane >> 4) & 1;
  const unsigned a0 = (unsigned)(size_t)(s + (row_lo + q) * ld + col0 + 16 * blk + 4 * pp);
  const unsigned a1 = (unsigned)(size_t)(s + (row_hi + q) * ld + col0 + 16 * blk + 4 * pp);
  s16x4 lo, hi;
  asm volatile("ds_read_b64_tr_b16 %0, %2\n\tds_read_b64_tr_b16 %1, %3\n\ts_waitcnt lgkmcnt(0)"
               : "=&v"(lo), "=&v"(hi) : "v"(a0), "v"(a1) : "memory");
  return __builtin_shufflevector(lo, hi, 0, 1, 2, 3, 4, 5, 6, 7);
}

struct GemmS { bf16_t a[2][128][40]; bf16_t b[2][128][40]; };

template <class AF, class BF>
DI void gemm_core(f32x16 (&acc)[2][2], GemmS* s, AF aptr, BF bptr, int nk) {
  int tid = threadIdx.x; asm volatile("" : "+v"(tid)); const int lane = tid & 63, wave = tid >> 6, wr = wave >> 1, wc = wave & 1;
  const int r0 = tid >> 2, kv = tid & 3;
  const int fr = lane & 31, fh = lane >> 5;
  uint4 ra0 = *(const uint4*)aptr(0, r0, kv), ra1 = *(const uint4*)aptr(0, r0 + 64, kv);
  uint4 rb0 = *(const uint4*)bptr(0, r0, kv), rb1 = *(const uint4*)bptr(0, r0 + 64, kv);
  *(uint4*)&s->a[0][r0][kv * 8] = ra0; *(uint4*)&s->a[0][r0 + 64][kv * 8] = ra1;
  *(uint4*)&s->b[0][r0][kv * 8] = rb0; *(uint4*)&s->b[0][r0 + 64][kv * 8] = rb1;
  __syncthreads();
#pragma unroll 1
  for (int kt = 0; kt < nk; ++kt) {
    const int buf = kt & 1;
    if (kt + 1 < nk) {
      ra0 = *(const uint4*)aptr(kt + 1, r0, kv); ra1 = *(const uint4*)aptr(kt + 1, r0 + 64, kv);
      rb0 = *(const uint4*)bptr(kt + 1, r0, kv); rb1 = *(const uint4*)bptr(kt + 1, r0 + 64, kv);
    }
#pragma unroll
    for (int ks = 0; ks < 2; ++ks) {
      bf16x8 af[2], bq[2];
#pragma unroll
      for (int i = 0; i < 2; ++i) af[i] = *(const bf16x8*)&s->a[buf][wr * 64 + i * 32 + fr][ks * 16 + fh * 8];
#pragma unroll
      for (int j = 0; j < 2; ++j) bq[j] = *(const bf16x8*)&s->b[buf][wc * 64 + j * 32 + fr][ks * 16 + fh * 8];
#pragma unroll
      for (int i = 0; i < 2; ++i)
#pragma unroll
        for (int j = 0; j < 2; ++j) acc[i][j] = MFMA(af[i], bq[j], acc[i][j]);
    }
    if (kt + 1 < nk) {
      *(uint4*)&s->a[buf ^ 1][r0][kv * 8] = ra0; *(uint4*)&s->a[buf ^ 1][r0 + 64][kv * 8] = ra1;
      *(uint4*)&s->b[buf ^ 1][r0][kv * 8] = rb0; *(uint4*)&s->b[buf ^ 1][r0 + 64][kv * 8] = rb1;
    }
    __syncthreads();
  }
}


struct GemmS2 { bf16_t a[128][72]; bf16_t b[128][72]; };
DI void g2_compute(f32x16 (&acc)[2][2], const GemmS2* s, int wr, int wc, int fr, int fh) {
#pragma unroll
  for (int ks = 0; ks < 4; ++ks) {
    bf16x8 af[2], bq[2];
#pragma unroll
    for (int i = 0; i < 2; ++i) af[i] = *(const bf16x8*)&s->a[wr * 64 + i * 32 + fr][ks * 16 + fh * 8];
#pragma unroll
    for (int j = 0; j < 2; ++j) bq[j] = *(const bf16x8*)&s->b[wc * 64 + j * 32 + fr][ks * 16 + fh * 8];
#pragma unroll
    for (int i = 0; i < 2; ++i)
#pragma unroll
      for (int j = 0; j < 2; ++j) acc[i][j] = MFMA(af[i], bq[j], acc[i][j]);
  }
}

template <class AF, class BF, class HK>
DI void gemm_core2(f32x16 (&acc)[2][2], GemmS2* s, AF aptr, BF bptr, int nk, HK hook) {
  int tid = threadIdx.x; asm volatile("" : "+v"(tid));
  const int lane = tid & 63, wave = tid >> 6, wr = wave >> 1, wc = wave & 1;
  const int r0 = tid >> 3, kc = tid & 7;
  const int fr = lane & 31, fh = lane >> 5;
  uint4 p0a0, p0a1, p0a2, p0a3, p0b0, p0b1, p0b2, p0b3, p1a0, p1a1, p1a2, p1a3, p1b0, p1b1, p1b2, p1b3;
#define G2_LOAD(S, KT) { \
    S##a0 = *(const uint4*)aptr((KT), r0, kc);      S##b0 = *(const uint4*)bptr((KT), r0, kc); \
    S##a1 = *(const uint4*)aptr((KT), r0 + 32, kc); S##b1 = *(const uint4*)bptr((KT), r0 + 32, kc); \
    S##a2 = *(const uint4*)aptr((KT), r0 + 64, kc); S##b2 = *(const uint4*)bptr((KT), r0 + 64, kc); \
    S##a3 = *(const uint4*)aptr((KT), r0 + 96, kc); S##b3 = *(const uint4*)bptr((KT), r0 + 96, kc); }
#define G2_STORE(S) { \
    *(uint4*)&s->a[r0][kc * 8] = S##a0;      *(uint4*)&s->b[r0][kc * 8] = S##b0; \
    *(uint4*)&s->a[r0 + 32][kc * 8] = S##a1; *(uint4*)&s->b[r0 + 32][kc * 8] = S##b1; \
    *(uint4*)&s->a[r0 + 64][kc * 8] = S##a2; *(uint4*)&s->b[r0 + 64][kc * 8] = S##b2; \
    *(uint4*)&s->a[r0 + 96][kc * 8] = S##a3; *(uint4*)&s->b[r0 + 96][kc * 8] = S##b3; }
#define G2_COMPUTE() g2_compute(acc, s, wr, wc, fr, fh);
  G2_LOAD(p0, 0)
  G2_LOAD(p1, 1)
  G2_STORE(p0)
  if (nk > 2) G2_LOAD(p0, 2)
  __syncthreads();
#pragma unroll 1
  for (int kt = 0; kt < nk; kt += 2) {
    hook(kt);
    G2_COMPUTE()
    __syncthreads();
    G2_STORE(p1)
    if (kt + 3 < nk) G2_LOAD(p1, kt + 3)
    __syncthreads();
    hook(kt + 1);
    G2_COMPUTE()
    __syncthreads();
    if (kt + 2 < nk) {
      G2_STORE(p0)
      if (kt + 4 < nk) G2_LOAD(p0, kt + 4)
    }
    __syncthreads();
  }
#undef G2_LOAD
#undef G2_STORE
#undef G2_COMPUTE
}


struct GemmS3 { bf16_t a[128][72]; bf16_t b[256][72]; };

template <class AF, class BF, class HK>
DI void gemm_core3(f32x16 (&acc)[2][4], GemmS3* s, AF aptr, BF bptr, int nk, HK hook) {
  int tid = threadIdx.x; asm volatile("" : "+v"(tid));
  const int lane = tid & 63, wave = tid >> 6, wr = wave >> 1, wc = wave & 1;
  const int r0 = tid >> 3, kc = tid & 7;
  const int fr = lane & 31, fh = lane >> 5;
  uint4 a0, a1, a2, a3, b0, b1, b2, b3, b4, b5, b6, b7;
#define G3_LOAD(KT) { \
    a0 = *(const uint4*)aptr((KT), r0, kc);       a1 = *(const uint4*)aptr((KT), r0 + 32, kc); \
    a2 = *(const uint4*)aptr((KT), r0 + 64, kc);  a3 = *(const uint4*)aptr((KT), r0 + 96, kc); \
    b0 = *(const uint4*)bptr((KT), r0, kc);       b1 = *(const uint4*)bptr((KT), r0 + 32, kc); \
    b2 = *(const uint4*)bptr((KT), r0 + 64, kc);  b3 = *(const uint4*)bptr((KT), r0 + 96, kc); \
    b4 = *(const uint4*)bptr((KT), r0 + 128, kc); b5 = *(const uint4*)bptr((KT), r0 + 160, kc); \
    b6 = *(const uint4*)bptr((KT), r0 + 192, kc); b7 = *(const uint4*)bptr((KT), r0 + 224, kc); }
#define G3_STORE() { \
    *(uint4*)&s->a[r0][kc * 8] = a0;       *(uint4*)&s->a[r0 + 32][kc * 8] = a1; \
    *(uint4*)&s->a[r0 + 64][kc * 8] = a2;  *(uint4*)&s->a[r0 + 96][kc * 8] = a3; \
    *(uint4*)&s->b[r0][kc * 8] = b0;       *(uint4*)&s->b[r0 + 32][kc * 8] = b1; \
    *(uint4*)&s->b[r0 + 64][kc * 8] = b2;  *(uint4*)&s->b[r0 + 96][kc * 8] = b3; \
    *(uint4*)&s->b[r0 + 128][kc * 8] = b4; *(uint4*)&s->b[r0 + 160][kc * 8] = b5; \
    *(uint4*)&s->b[r0 + 192][kc * 8] = b6; *(uint4*)&s->b[r0 + 224][kc * 8] = b7; }
  G3_LOAD(0)
  G3_STORE()
  __syncthreads();
#pragma unroll 1
  for (int kt = 0; kt < nk; ++kt) {
    if (kt + 1 < nk) G3_LOAD(kt + 1)
    hook(kt);
#pragma unroll
    for (int ks = 0; ks < 4; ++ks) {
      bf16x8 af[2], bq[4];
#pragma unroll
      for (int i = 0; i < 2; ++i) af[i] = *(const bf16x8*)&s->a[wr * 64 + i * 32 + fr][ks * 16 + fh * 8];
#pragma unroll
      for (int j = 0; j < 4; ++j) bq[j] = *(const bf16x8*)&s->b[wc * 128 + j * 32 + fr][ks * 16 + fh * 8];
#pragma unroll
      for (int i = 0; i < 2; ++i)
#pragma unroll
        for (int j = 0; j < 4; ++j) acc[i][j] = MFMA(af[i], bq[j], acc[i][j]);
    }
    __syncthreads();
    if (kt + 1 < nk) G3_STORE()
    __syncthreads();
  }
#undef G3_LOAD
#undef G3_STORE
}

template <class EPI>
DI void epilogue_lds2(f32x16 (&acc)[2][4], char* smem, int sub, EPI epi) {
  float* T = (float*)smem;
  int tid = threadIdx.x; asm volatile("" : "+v"(tid));
  const int lane = tid & 63, wave = tid >> 6, wr = wave >> 1, wc = wave & 1, fr = lane & 31, fh = lane >> 5;
#pragma unroll
  for (int i = 0; i < 2; ++i) {
    if (wc == sub) {
#pragma unroll
      for (int j = 0; j < 4; ++j)
#pragma unroll
        for (int r = 0; r < 16; ++r) T[(wr * 32 + crow(r, fh)) * 132 + j * 32 + fr] = acc[i][j][r];
    }
    __syncthreads();
#pragma unroll 2
    for (int e = tid; e < 2048; e += 256) {
      const int tr = e >> 5, c4 = (e & 31) * 4;
      const float4 v = *(const float4*)&T[tr * 132 + c4];
      epi((tr >> 5) * 64 + i * 32 + (tr & 31), c4, v);
    }
    __syncthreads();
  }
}

DI void epilogue_rope(f32x16 (&acc)[2][4], char* smem, int sub, bf16_t* dst, int ld, int cb, int row0, float sc) {
  float* T = (float*)smem;
  int tid = threadIdx.x; asm volatile("" : "+v"(tid));
  const int lane = tid & 63, wave = tid >> 6, wr = wave >> 1, wc = wave & 1, fr = lane & 31, fh = lane >> 5;
#pragma unroll
  for (int i = 0; i < 2; ++i) {
    if (wc == sub) {
#pragma unroll
      for (int j = 0; j < 4; ++j)
#pragma unroll
        for (int r = 0; r < 16; ++r) T[(wr * 32 + crow(r, fh)) * 132 + j * 32 + fr] = acc[i][j][r];
    }
    __syncthreads();
#pragma unroll 1
    for (int e = tid; e < 1024; e += 256) {
      const int tr = e >> 4, qi = e & 15;
      const int hd = qi >> 3, ax = (qi >> 2) & 1, f0 = (qi & 3) * 4;
      const int col1 = hd * 64 + ax * 32 + f0;
      const float4 v1 = *(const float4*)&T[tr * 132 + col1];
      const float4 v2 = *(const float4*)&T[tr * 132 + col1 + 16];
      const int rho = row0 + (tr >> 5) * 64 + i * 32 + (tr & 31);
      float a1[4] = {v1.x, v1.y, v1.z, v1.w}, a2[4] = {v2.x, v2.y, v2.z, v2.w}, o1[4], o2[4];
      if (rho < RL_) {
        const int t = rho & 4095;
        const float pos = (float)(ax == 0 ? (t >> 6) : (t & 63));
#pragma unroll
        for (int u = 0; u < 4; ++u) {
          const float ang = pos * exp2f(-(float)(f0 + u) * 0.8304820237218406f);
          const float cs = __cosf(ang), sn = __sinf(ang);
          o1[u] = (a1[u] * cs - a2[u] * sn) * sc;
          o2[u] = (a2[u] * cs + a1[u] * sn) * sc;
        }
      } else {
#pragma unroll
        for (int u = 0; u < 4; ++u) { o1[u] = a1[u] * sc; o2[u] = a2[u] * sc; }
      }
      uint2 w1, w2;
      w1.x = pack2(o1[0], o1[1]); w1.y = pack2(o1[2], o1[3]);
      w2.x = pack2(o2[0], o2[1]); w2.y = pack2(o2[2], o2[3]);
      bf16_t* dp = dst + (size_t)rho * ld + cb + col1;
      *(uint2*)dp = w1;
      *(uint2*)(dp + 16) = w2;
    }
    __syncthreads();
  }
}

DI bool xcd_tile(int step, int nM, int nN, int& mt, int& nt) {
  const int xcd = blockIdx.x & 7, nloc = gridDim.x >> 3;
  const int j = (blockIdx.x >> 3) + step * nloc;
  const int mloc = nM >> 3;
  if ((gridDim.x & 7) != 0 || j >= mloc * nN) return false;
  const int per = 8 * nN;
  const int gm = j / per, rem = j - gm * per;
  const int hgt = min(8, mloc - gm * 8);
  const int a = rem % hgt;
  nt = rem / hgt;
  mt = (gm * 8 + a) * 8 + xcd;
  return true;
}

DI void zero_acc(f32x16 (&acc)[2][2]) {
#pragma unroll
  for (int i = 0; i < 2; ++i)
#pragma unroll
    for (int j = 0; j < 2; ++j)
#pragma unroll
      for (int r = 0; r < 16; ++r) acc[i][j][r] = 0.f;
}

template <class EPI>
DI void epilogue_lds(f32x16 (&acc)[2][2], char* smem, EPI epi) {
  float* T = (float*)smem;
  int tid = threadIdx.x; asm volatile("" : "+v"(tid)); const int lane = tid & 63, wave = tid >> 6, wr = wave >> 1, wc = wave & 1, fr = lane & 31, fh = lane >> 5;
#pragma unroll
  for (int i = 0; i < 2; ++i) {
#pragma unroll
    for (int j = 0; j < 2; ++j)
#pragma unroll
      for (int r = 0; r < 16; ++r) T[(wr * 32 + crow(r, fh)) * 132 + wc * 64 + j * 32 + fr] = acc[i][j][r];
    __syncthreads();
#pragma unroll 2
    for (int e = tid; e < 2048; e += 256) {
      const int tr = e >> 5, c4 = (e & 31) * 4;
      const float4 v = *(const float4*)&T[tr * 132 + c4];
      epi((tr >> 5) * 64 + i * 32 + (tr & 31), c4, v);
    }
    __syncthreads();
  }
}

DI void phase_mods(const Params& p_in, char* smem) {
  const Params p = load_params();

  float* ssc = (float*)smem;
  float* red = (float*)(smem + 20480);
  float* mods = (float*)(p.ws + OFF_MODS);
  int tid = threadIdx.x; asm volatile("" : "+v"(tid));
  for (int it = blockIdx.x; it < 192; it += gridDim.x) {
    const int l = it / 96, col0 = (it % 96) * 32;
    __syncthreads();
    for (int e = tid; e < 5120; e += 256) {
      const int v = e >> 10, k = e & 1023;
      const float cv = (v < 4) ? p.c[v * 1024 + k] : p.c_ctx[k];
      ssc[e] = silu_f(cv);
    }
    __syncthreads();
    const int col = tid & 31, kg = tid >> 5;
    float a[5] = {0.f, 0.f, 0.f, 0.f, 0.f};
    const float* w = p.w_mod + (size_t)l * 1024 * 3072 + col0 + col;
    for (int k = kg * 128; k < kg * 128 + 128; k += 32) {
      float wv[32];
#pragma unroll
      for (int u = 0; u < 32; ++u) wv[u] = w[(size_t)(k + u) * 3072];
#pragma unroll
      for (int u = 0; u < 32; ++u)
#pragma unroll
        for (int v = 0; v < 5; ++v) a[v] += ssc[v * 1024 + k + u] * wv[u];
    }
#pragma unroll
    for (int v = 0; v < 5; ++v) red[(kg * 5 + v) * 32 + col] = a[v];
    __syncthreads();
    for (int e = tid; e < 160; e += 256) {
      const int v = e >> 5, cc = e & 31;
      float sum = p.b_mod[l * 3072 + col0 + cc];
      for (int g = 0; g < 8; ++g) sum += red[(g * 5 + v) * 32 + cc];
      mods[(l * 5 + v) * 3072 + col0 + cc] = sum;
    }
  }
}

DI int win_colmap(int n) {
  if (n < 2560) return n;
  if (n < 3840) return n + 32;
  if (n < 4864) {
    const int j = n - 3840, q64 = j >> 6, w = j & 63;
    return (w < 32) ? (3872 + q64 * 32 + w) : (3872 + 512 + q64 * 32 + (w - 32));
  }
  if (n < 5376) return n + 32;
  if (n < 5408) return n - 5376 + 2560;
  return -1;
}

DI void transpose_tile(const float* src, int ldsrc, int kind, const float* rowscale, bf16_t* dst, int lddst, int n0, int k0, float* tile) {
  int tid = threadIdx.x; asm volatile("" : "+v"(tid));
  __syncthreads();
  {
    const int c4 = (tid & 15) * 4, rr = tid >> 4;
    const int n = (kind == 0) ? win_colmap(n0 + c4) : (n0 + c4);
#pragma unroll
    for (int ps = 0; ps < 4; ++ps) {
      const int r = rr + ps * 16, k = k0 + r;
      float4 v = make_float4(0.f, 0.f, 0.f, 0.f);
      if (n >= 0) v = *(const float4*)(src + (size_t)k * ldsrc + n);
      if (rowscale != nullptr && k < 1024) { const float s = rowscale[k]; v.x *= s; v.y *= s; v.z *= s; v.w *= s; }
      tile[r * 65 + c4] = v.x; tile[r * 65 + c4 + 1] = v.y; tile[r * 65 + c4 + 2] = v.z; tile[r * 65 + c4 + 3] = v.w;
    }
  }
  __syncthreads();
  {
    const int k8 = (tid & 7) * 8, nn = tid >> 3;
#pragma unroll
    for (int ps = 0; ps < 2; ++ps) {
      const int r = nn + ps * 32;
      uint4 o;
      o.x = pack2(tile[(k8 + 0) * 65 + r], tile[(k8 + 1) * 65 + r]);
      o.y = pack2(tile[(k8 + 2) * 65 + r], tile[(k8 + 3) * 65 + r]);
      o.z = pack2(tile[(k8 + 4) * 65 + r], tile[(k8 + 5) * 65 + r]);
      o.w = pack2(tile[(k8 + 6) * 65 + r], tile[(k8 + 7) * 65 + r]);
      *(uint4*)(dst + (size_t)(n0 + r) * lddst + k0 + k8) = o;
    }
  }
}

DI void phase_prep(const Params& p_in, int l, char* smem) {
  const Params p = load_params();

  int tid = threadIdx.x; asm volatile("" : "+v"(tid)); const int lane = tid & 63, wave = tid >> 6;
  const float* mods = (const float*)(p.ws + OFF_MODS);
  bf16_t* H = (bf16_t*)(p.ws + OFF_H);
  const int NT_WIN = 88 * 16, NT_WOUT = 16 * 32, NT_PW = 64, NT_CONV = NT_WIN + NT_WOUT + NT_PW;
  const int NT = NT_CONV + R_ / 8;
  for (int it = blockIdx.x; it < NT; it += gridDim.x) {
    if (l == 1 && (it < NT_WIN || (it >= NT_WIN + NT_WOUT && it < NT_CONV))) continue;
    if (it < NT_WIN) {
      transpose_tile(p.w_in + (size_t)l * 1024 * 5408, 5408, 0, nullptr, (bf16_t*)(p.ws + OFF_WIN), 1024, (it / 16) * 64, (it % 16) * 64, (float*)smem);
    } else if (it < NT_WIN + NT_WOUT) {
      const int t = it - NT_WIN;
      transpose_tile(p.w_out + (size_t)l * 2048 * 1024, 1024, 1, p.ssd_norm_w + l * 1024, (bf16_t*)(p.ws + OFF_WOUT), 2048, (t / 32) * 64, (t % 32) * 64, (float*)smem);
    } else if (it < NT_CONV) {
      const int t = it - NT_WIN - NT_WOUT;
      transpose_tile(p.conv_pw_w + (size_t)l * 512 * 512, 512, 1, nullptr, (bf16_t*)(p.ws + OFF_PW), 512, (t / 8) * 64, (t % 8) * 64, (float*)smem);
    } else {
      const int rho0 = (it - NT_CONV) * 8 + wave * 2;
      const float* xs0;
      if (l == 0) xs0 = (rho0 < RL_) ? (p.x + (size_t)rho0 * 1024) : (p.ctx + (size_t)(rho0 - RL_) * 1024);
      else xs0 = (rho0 < RL_) ? (p.out + (size_t)rho0 * 1024) : ((const float*)(p.ws + OFF_XC) + (size_t)(rho0 - RL_) * 1024);
      const int v = (rho0 < RL_) ? (rho0 >> 12) : 4;
      const float* md = mods + (l * 5 + v) * 3072;
      float4 xv[2][4], nwv[4], shv[4], scv4[4];
#pragma unroll
      for (int i = 0; i < 4; ++i) {
        const int cidx = lane * 4 + i * 256;
        xv[0][i] = *(const float4*)(xs0 + cidx);
        xv[1][i] = *(const float4*)(xs0 + 1024 + cidx);
        nwv[i] = *(const float4*)(p.norm_w + l * 1024 + cidx);
        shv[i] = *(const float4*)(md + cidx);
        scv4[i] = *(const float4*)(md + 1024 + cidx);
      }
#pragma unroll
      for (int q = 0; q < 2; ++q) {
        float ss = 0.f;
#pragma unroll
        for (int i = 0; i < 4; ++i) ss += xv[q][i].x * xv[q][i].x + xv[q][i].y * xv[q][i].y + xv[q][i].z * xv[q][i].z + xv[q][i].w * xv[q][i].w;
#pragma unroll
        for (int o = 32; o >= 1; o >>= 1) ss += __shfl_xor(ss, o);
        const float rs = rsqrtf(ss * (1.f / 1024.f) + 1e-6f);
#pragma unroll
        for (int i = 0; i < 4; ++i) {
          const int cidx = lane * 4 + i * 256;
          const float4 nw = nwv[i], sh = shv[i], sc = scv4[i];
          uint2 o;
          o.x = pack2(xv[q][i].x * rs * nw.x * (1.f + sc.x) + sh.x, xv[q][i].y * rs * nw.y * (1.f + sc.y) + sh.y);
          o.y = pack2(xv[q][i].z * rs * nw.z * (1.f + sc.z) + sh.z, xv[q][i].w * rs * nw.w * (1.f + sc.w) + sh.w);
          *(uint2*)(H + (size_t)(rho0 + q) * 1024 + cidx) = o;
        }
      }
    }
  }
}

DI void phase_inproj(const Params& p_in, char* smem) {
  const Params p = load_params();
  int tid = threadIdx.x; asm volatile("" : "+v"(tid)); const int wave = tid >> 6, wc = wave & 1;
  const bf16_t* H = (const bf16_t*)(p.ws + OFF_H);
  const bf16_t* W = (const bf16_t*)(p.ws + OFF_WIN);
  for (int step = 0;; ++step) {
    int mt, nt2;
    if (!xcd_tile(step, NCK, 22, mt, nt2)) break;
    f32x16 acc[2][4];
#pragma unroll
    for (int i = 0; i < 2; ++i)
#pragma unroll
      for (int j = 0; j < 4; ++j)
#pragma unroll
        for (int r = 0; r < 16; ++r) acc[i][j][r] = 0.f;
    const bf16_t* Ab = H + (size_t)mt * 128 * 1024;
    const bf16_t* Bb = W + (size_t)nt2 * 256 * 1024;
    gemm_core3(acc, (GemmS3*)smem,
               [&](int kt, int r, int kv) { return Ab + (size_t)r * 1024 + kt * 64 + kv * 8; },
               [&](int kt, int r, int kv) { return Bb + (size_t)r * 1024 + kt * 64 + kv * 8; }, 16, [](int) {});
    const int row0 = mt * 128;
    {
      const int ntw = nt2 * 2 + wc;
      if (ntw >= 30 && ntw < 38) {
#pragma unroll
        for (int i = 0; i < 2; ++i)
#pragma unroll
          for (int r = 0; r < 16; ++r) {
            acc[i][0][r] = acc[i][0][r] * sigmoid_f(acc[i][1][r]);
            acc[i][2][r] = acc[i][2][r] * sigmoid_f(acc[i][3][r]);
          }
      }
    }
#pragma unroll 1
    for (int sub = 0; sub < 2; ++sub) {
      const int nt = nt2 * 2 + sub;
      if (nt >= 43) break;
      if (nt >= 30 && nt < 38) {
        bf16_t* G = (bf16_t*)(p.ws + OFF_GLU);
        const int cb0 = (nt - 30) * 64;
        epilogue_lds2(acc, smem, sub, [&](int rl, int c4, float4 v) {
          if ((c4 & 32) == 0) {
            uint2 o; o.x = pack2(v.x, v.y); o.y = pack2(v.z, v.w);
            *(uint2*)(G + (size_t)(row0 + rl) * 512 + cb0 + (c4 >> 6) * 32 + (c4 & 31)) = o;
          }
        });
      } else if (nt >= 20 && nt < 24) {
        epilogue_rope(acc, smem, sub, (bf16_t*)(p.ws + OFF_Q), 512, nt * 128 - 2560, row0, 0.18033688011112042f);
      } else if (nt == 24) {
        epilogue_rope(acc, smem, sub, (bf16_t*)(p.ws + OFF_KV), 256, 0, row0, 1.f);
      } else if (nt == 42) {
        float* DT = (float*)(p.ws + OFF_DT);
        epilogue_lds2(acc, smem, sub, [&](int rl, int c4, float4 v) {
          if (c4 < 32) *(float4*)(DT + (size_t)(row0 + rl) * 32 + c4) = v;
        });
      } else {
        bf16_t* dst; int ld, cb;
        if (nt < 12) { dst = (bf16_t*)(p.ws + OFF_XBC); ld = 1536; cb = nt * 128; }
        else if (nt < 20) { dst = (bf16_t*)(p.ws + OFF_Z); ld = 1024; cb = nt * 128 - 1536; }
        else if (nt < 24) { dst = (bf16_t*)(p.ws + OFF_Q); ld = 512; cb = nt * 128 - 2560; }
        else if (nt < 26) { dst = (bf16_t*)(p.ws + OFF_KV); ld = 256; cb = nt * 128 - 3072; }
        else if (nt < 30) { dst = (bf16_t*)(p.ws + OFF_AG); ld = 512; cb = nt * 128 - 3328; }
        else { dst = (bf16_t*)(p.ws + OFF_CG); ld = 512; cb = nt * 128 - 4864; }
        epilogue_lds2(acc, smem, sub, [&](int rl, int c4, float4 v) {
          uint2 o; o.x = pack2(v.x, v.y); o.y = pack2(v.z, v.w);
          *(uint2*)(dst + (size_t)(row0 + rl) * ld + cb + c4) = o;
        });
      }
    }
  }
}

DI void phase_local(const Params& p_in, int l, char* smem) {
  const Params p = load_params();

  int tid = threadIdx.x; asm volatile("" : "+v"(tid)); const int lane = tid & 63;
  const bf16_t* XBC = (const bf16_t*)(p.ws + OFF_XBC);
  bf16_t* XS = (bf16_t*)(p.ws + OFF_H);
  bf16_t* BC = (bf16_t*)(p.ws + OFF_BC);
  float* DT = (float*)(p.ws + OFF_DT);
  float* CS = (float*)(p.ws + OFF_CS);
  const bf16_t* GLU = (const bf16_t*)(p.ws + OFF_GLU);
  bf16_t* HDN = (bf16_t*)(p.ws + OFF_HDN);
  bf16_t* Q = (bf16_t*)(p.ws + OFF_Q);
  bf16_t* KV = (bf16_t*)(p.ws + OFF_KV);
  { float* SSQ = (float*)(p.ws + OFF_RSTD); for (int i = blockIdx.x * 256 + tid; i < R_ * 2; i += gridDim.x * 256) SSQ[i] = 0.f; }
  const int N_CONV = (R_ / 4) * 192 / 256;
  const int N_DT = NCK;
  const int N_CF = R_ / 16;
  const int N_ROPE = 0;
  const int N_QC = 0;
  const int NT = N_CF + N_DT + N_CONV + N_ROPE + N_QC;
  for (int it0 = blockIdx.x; it0 < NT; it0 += gridDim.x) {
    int it = it0;
    if (it < N_CF) {
      float* sst = (float*)smem;
      unsigned* sIn = (unsigned*)(smem + 256);
      const int row0 = it * 16;
      const int seq0 = (row0 < RL_) ? (row0 & ~4095) : (RL_ + ((row0 - RL_) & ~255));
      const int slen = (row0 < RL_) ? 4096 : 256;
      const int t0 = row0 - seq0;
      const int c0 = tid * 2;
      __syncthreads();
      if (tid < 32) sst[tid] = 0.f;
      for (int idx = tid; idx < 46 * 64; idx += 256) {
        const int rr = idx >> 6, c16 = idx & 63;
        const int tt = t0 - 15 + rr;
        uint4 val = make_uint4(0u, 0u, 0u, 0u);
        if (tt >= 0 && tt < slen) val = *(const uint4*)(GLU + (size_t)(seq0 + tt) * 512 + c16 * 8);
        *(uint4*)&sIn[rr * 256 + c16 * 4] = val;
      }
      float w0[31], w1[31];
#pragma unroll
      for (int k = 0; k < 31; ++k) {
        const float2 wv = *(const float2*)(p.conv_dw_w + ((size_t)l * 31 + k) * 512 + c0);
        w0[k] = wv.x; w1[k] = wv.y;
      }
      const float2 bv = *(const float2*)(p.conv_dw_b + l * 512 + c0);
      float a0[16], a1[16];
#pragma unroll
      for (int r = 0; r < 16; ++r) { a0[r] = bv.x; a1[r] = bv.y; }
      __syncthreads();
#pragma unroll
      for (int tp = 0; tp < 46; ++tp) {
        const unsigned u = sIn[tp * 256 + tid];
        const float x0 = lo2f(u), x1 = hi2f(u);
#pragma unroll
        for (int r = 0; r < 16; ++r) {
          const int k = tp - r;
          if (k >= 0 && k < 31) { a0[r] += w0[k] * x0; a1[r] += w1[k] * x1; }
        }
        if ((tp & 7) == 7) __builtin_amdgcn_sched_barrier(0);
      }
      {
        float v[32];
#pragma unroll
        for (int r = 0; r < 16; ++r) { v[2 * r] = a0[r] + a1[r]; v[2 * r + 1] = a0[r] * a0[r] + a1[r] * a1[r]; }
#pragma unroll
        for (int i = 0; i < 16; ++i) { const bool up = (lane & 32) != 0; const float keep = up ? v[i + 16] : v[i]; const float send = up ? v[i] : v[i + 16]; v[i] = keep + __shfl_xor(send, 32); }
#pragma unroll
        for (int i = 0; i < 8; ++i) { const bool up = (lane & 16) != 0; const float keep = up ? v[i + 8] : v[i]; const float send = up ? v[i] : v[i + 8]; v[i] = keep + __shfl_xor(send, 16); }
#pragma unroll
        for (int i = 0; i < 4; ++i) { const bool up = (lane & 8) != 0; const float keep = up ? v[i + 4] : v[i]; const float send = up ? v[i] : v[i + 4]; v[i] = keep + __shfl_xor(send, 8); }
#pragma unroll
        for (int i = 0; i < 2; ++i) { const bool up = (lane & 4) != 0; const float keep = up ? v[i + 2] : v[i]; const float send = up ? v[i] : v[i + 2]; v[i] = keep + __shfl_xor(send, 4); }
        { const bool up = (lane & 2) != 0; const float keep = up ? v[1] : v[0]; const float send = up ? v[0] : v[1]; v[0] = keep + __shfl_xor(send, 2); }
        v[0] += __shfl_xor(v[0], 1);
        __syncthreads();
        if ((lane & 1) == 0) atomicAdd(&sst[lane >> 1], v[0]);
      }
      __syncthreads();
      const float2 lw = *(const float2*)(p.conv_ln_w + l * 512 + c0);
      const float2 lb = *(const float2*)(p.conv_ln_b + l * 512 + c0);
#pragma unroll
      for (int r = 0; r < 16; ++r) {
        const float mean = sst[r * 2] * (1.f / 512.f);
        const float var = fmaxf(sst[r * 2 + 1] * (1.f / 512.f) - mean * mean, 0.f);
        const float rs = rsqrtf(var + 1e-6f);
        const float y0 = (a0[r] - mean) * rs * lw.x + lb.x;
        const float y1 = (a1[r] - mean) * rs * lw.y + lb.y;
        *(unsigned*)(HDN + (size_t)(row0 + r) * 512 + c0) = pack2(silu_f(y0), silu_f(y1));
        if ((r & 3) == 3) __builtin_amdgcn_sched_barrier(0);
      }
      continue;
    }
    it -= N_CF;
    if (it < N_DT) {
      float* sdt = (float*)smem;
      const int row0 = it * 128;
      __syncthreads();
      for (int e = tid; e < 4096; e += 256) {
        const int r = e >> 5, cidx = e & 31;
        const float raw = DT[(size_t)(row0 + r) * 32 + cidx] + p.ssd_dt_bias[l * 32 + cidx];
        const float sp = (raw > 20.f) ? raw : log1pf(expf(raw));
        DT[(size_t)(row0 + r) * 32 + cidx] = sp;
        sdt[r * 33 + cidx] = sp;
      }
      __syncthreads();
      if (tid < 32) {
        const float a = -expf(p.ssd_a_log[l * 32 + tid]);
        float run = 0.f;
        if (tid < 16) {
          for (int r = 0; r < 128; ++r) { run += sdt[r * 33 + tid] * a; CS[(size_t)(row0 + r) * 32 + tid] = run; }
        } else {
          for (int r = 127; r >= 0; --r) { run += sdt[r * 33 + tid] * a; CS[(size_t)(row0 + r) * 32 + tid] = run; }
        }
      }
      continue;
    }
    it -= N_DT;
    if (it < N_CONV) {
      const int e = it * 256 + tid;
      const int rb = e / 192, cgp = e % 192, ch0 = cgp * 8;
      const int rho0 = rb * 4;
      const int seq0 = (rho0 < RL_) ? (rho0 & ~4095) : (RL_ + ((rho0 - RL_) & ~255));
      const int slen = (rho0 < RL_) ? 4096 : 256;
      const int t0 = rho0 - seq0;
      uint4 xr[8];
#pragma unroll
      for (int i = 0; i < 8; ++i) {
        const int tt = t0 + i - 2;
        xr[i] = make_uint4(0u, 0u, 0u, 0u);
        if (tt >= 0 && tt < slen) xr[i] = *(const uint4*)(XBC + (size_t)(seq0 + tt) * 1536 + ch0);
      }
      float wk[5][8];
#pragma unroll
      for (int k = 0; k < 5; ++k) {
        const float4 w0 = *(const float4*)(p.ssd_conv_w + ((size_t)l * 5 + k) * 1536 + ch0);
        const float4 w1 = *(const float4*)(p.ssd_conv_w + ((size_t)l * 5 + k) * 1536 + ch0 + 4);
        wk[k][0] = w0.x; wk[k][1] = w0.y; wk[k][2] = w0.z; wk[k][3] = w0.w; wk[k][4] = w1.x; wk[k][5] = w1.y; wk[k][6] = w1.z; wk[k][7] = w1.w;
      }
      float bias[8];
      {
        const float4 b0 = *(const float4*)(p.ssd_conv_b + l * 1536 + ch0);
        const float4 b1 = *(const float4*)(p.ssd_conv_b + l * 1536 + ch0 + 4);
        bias[0] = b0.x; bias[1] = b0.y; bias[2] = b0.z; bias[3] = b0.w; bias[4] = b1.x; bias[5] = b1.y; bias[6] = b1.z; bias[7] = b1.w;
      }
#pragma unroll
      for (int r = 0; r < 4; ++r) {
        float a[8];
#pragma unroll
        for (int c = 0; c < 8; ++c) a[c] = bias[c];
#pragma unroll
        for (int k = 0; k < 5; ++k) {
          const uint4 u = xr[r + k];
          a[0] += wk[k][0] * lo2f(u.x); a[1] += wk[k][1] * hi2f(u.x); a[2] += wk[k][2] * lo2f(u.y); a[3] += wk[k][3] * hi2f(u.y);
          a[4] += wk[k][4] * lo2f(u.z); a[5] += wk[k][5] * hi2f(u.z); a[6] += wk[k][6] * lo2f(u.w); a[7] += wk[k][7] * hi2f(u.w);
        }
        uint4 o;
        o.x = pack2(silu_f(a[0]), silu_f(a[1])); o.y = pack2(silu_f(a[2]), silu_f(a[3]));
        o.z = pack2(silu_f(a[4]), silu_f(a[5])); o.w = pack2(silu_f(a[6]), silu_f(a[7]));
        const size_t rho = (size_t)(rho0 + r);
        if (ch0 < 1024) *(uint4*)(XS + rho * 1024 + ch0) = o;
        else *(uint4*)(BC + rho * 512 + (ch0 - 1024)) = o;
      }
      continue;
    }
    it -= N_CONV;
    if (it < N_ROPE) {
      const int e = it * 256 + tid;
      const int rho = e / 40, rem = e % 40, hd = rem >> 2, sub = rem & 3;
      const int axis = sub >> 1, half = sub & 1;
      const int t = rho & 4095;
      const float pos = (float)(axis == 0 ? (t >> 6) : (t & 63));
      bf16_t* base = ((hd < 8) ? (Q + (size_t)rho * 512 + hd * 64) : (KV + (size_t)rho * 256 + (hd - 8) * 64)) + axis * 32 + half * 8;
      const float sc = (hd < 8) ? 0.18033688011112042f : 1.f;
      const uint4 u1 = *(const uint4*)base, u2 = *(const uint4*)(base + 16);
      const unsigned a1[4] = {u1.x, u1.y, u1.z, u1.w}, a2[4] = {u2.x, u2.y, u2.z, u2.w};
      unsigned o1[4], o2[4];
#pragma unroll
      for (int i = 0; i < 4; ++i) {
        float r1[2], r2[2];
#pragma unroll
        for (int hl = 0; hl < 2; ++hl) {
          const float f = (float)(half * 8 + 2 * i + hl);
          const float ang = pos * exp2f(-f * 0.8304820237218406f);
          const float cs = __cosf(ang), sn = __sinf(ang);
          const float t1 = hl ? hi2f(a1[i]) : lo2f(a1[i]);
          const float t2 = hl ? hi2f(a2[i]) : lo2f(a2[i]);
          r1[hl] = (t1 * cs - t2 * sn) * sc;
          r2[hl] = (t2 * cs + t1 * sn) * sc;
        }
        o1[i] = pack2(r1[0], r1[1]); o2[i] = pack2(r2[0], r2[1]);
      }
      *(uint4*)base = make_uint4(o1[0], o1[1], o1[2], o1[3]);
      *(uint4*)(base + 16) = make_uint4(o2[0], o2[1], o2[2], o2[3]);
      continue;
    }
    it -= N_ROPE;
    {
      const int e = it * 256 + tid;
      const int rho = RL_ + e / 256, c2 = (e % 256) * 2;
      unsigned* ptr = (unsigned*)(Q + (size_t)rho * 512 + c2);
      const unsigned u = *ptr;
      *ptr = pack2(lo2f(u) * 0.18033688011112042f, hi2f(u) * 0.18033688011112042f);
    }
  }
}

DI void attn_item(const Params& p_in, int l, char* smem, int b, int qblk, int g, int hp, bool ctxq) {
  const Params p = load_params();

  bf16_t* sK = (bf16_t*)smem;
  bf16_t* sV = (bf16_t*)(smem + 128 * 72 * 2);
  int tid = threadIdx.x; asm volatile("" : "+v"(tid)); const int lane = tid & 63, wave = tid >> 6, fr = lane & 31, fh = lane >> 5;
  const int head = g * 4 + hp * 2 + (wave >> 1);
  const int qh = wave & 1;
  const int qrow0 = (ctxq ? (RL_ + b * 256) : (b * 4096)) + qblk * 128 + qh * 64;
  const int qpos0 = qblk * 128 + qh * 64;
  bf16_t* Q = (bf16_t*)(p.ws + OFF_Q);
  const bf16_t* KV = (const bf16_t*)(p.ws + OFF_KV);
  const bf16_t* AG = (const bf16_t*)(p.ws + OFF_AG);
  f32x16 o[2][2];
  zero_acc(o);
  float m[2], lsum[2];
  m[0] = m[1] = p.attn_sink[l * 8 + head] * 1.4426950408889634f;
  lsum[0] = lsum[1] = 1.f;
  const int nhb = ctxq ? 4 : 10;
  auto hb_row = [&](int hb) -> int {
    if (hb >= nhb) return -1;
    if (hb < 4) return RL_ + b * 256 + hb * 64;
    const int kp = (qblk - 1) * 128 + (hb - 4) * 64;
    if (kp < 0 || kp >= 4096) return -1;
    return b * 4096 + kp;
  };
  auto hb_next = [&](int hb) -> int { int n = hb + 1; while (n < nhb && hb_row(n) < 0) ++n; return n; };
  const int sr = tid >> 3, scv = tid & 7;
  uint4 kp0, kp1, vp0, vp1;
#define ATT_PREFETCH(ROW0) { const bf16_t* kvp = KV + (size_t)((ROW0) + sr) * 256 + g * 64 + scv * 8; \
    kp0 = *(const uint4*)(kvp); kp1 = *(const uint4*)(kvp + 32 * 256); vp0 = *(const uint4*)(kvp + 128); vp1 = *(const uint4*)(kvp + 128 + 32 * 256); }
#define ATT_STORE(BUF) { bf16_t* k_ = sK + (BUF) * 64 * 72; bf16_t* v_ = sV + (BUF) * 64 * 72; \
    *(uint4*)&k_[sr * 72 + scv * 8] = kp0; *(uint4*)&k_[(sr + 32) * 72 + scv * 8] = kp1; \
    *(uint4*)&v_[sr * 72 + scv * 8] = vp0; *(uint4*)&v_[(sr + 32) * 72 + scv * 8] = vp1; }
  int pbuf = 0;
  __syncthreads();
  ATT_PREFETCH(hb_row(0))
  ATT_STORE(0)
  __syncthreads();
  for (int hb = 0; hb < nhb; hb = hb_next(hb)) {
    const int nxt = hb_next(hb);
    if (nxt < nhb) ATT_PREFETCH(hb_row(nxt))
    int kpos0 = 0;
    bool masked = false;
    if (hb >= 4) { kpos0 = (qblk - 1) * 128 + (hb - 4) * 64; masked = (hb != 6 && hb != 7); }
    const bf16_t* cK = sK + pbuf * 64 * 72;
    const bf16_t* cV = sV + pbuf * 64 * 72;
    bf16x8 qf[2][4];
#pragma unroll
    for (int j = 0; j < 2; ++j)
#pragma unroll
      for (int ks = 0; ks < 4; ++ks)
        qf[j][ks] = *(const bf16x8*)(Q + (size_t)(qrow0 + j * 32 + fr) * 512 + head * 64 + ks * 16 + fh * 8);
#pragma unroll 1
    for (int kb = 0; kb < 2; ++kb) {
      if (masked) {
        const int klo = kpos0 + kb * 32, khi = klo + 31;
        if (klo - (qpos0 + 63) > 128 || qpos0 - khi > 128) continue;
      }
      bf16x8 pb[2][2];
#pragma unroll
      for (int j = 0; j < 2; ++j) {
        f32x16 st[2];
#pragma unroll
        for (int r = 0; r < 16; ++r) st[j][r] = -m[j];
#pragma unroll
        for (int ks = 0; ks < 4; ++ks) {
          const bf16x8 kf = *(const bf16x8*)&cK[(kb * 32 + fr) * 72 + ks * 16 + fh * 8];
          st[j] = MFMA(kf, qf[j][ks], st[j]);
        }
        if (masked) {
          const int qpos = qpos0 + j * 32 + fr;
#pragma unroll
          for (int r = 0; r < 16; ++r) {
            const int d = qpos - (kpos0 + kb * 32 + crow(r, fh));
            if (d > 128 || d < -128) st[j][r] = -1e30f;
          }
        }
        float mx = st[j][0];
#pragma unroll
        for (int r = 1; r < 16; ++r) mx = fmaxf(mx, st[j][r]);
        mx = fmaxf(mx, __shfl_xor(mx, 32));
        const bool grow = mx > 8.f;
        if (__builtin_amdgcn_ballot_w64(grow) != 0ull) {
          const float delta = grow ? mx : 0.f;
          const float alpha = __builtin_amdgcn_exp2f(-delta);
#pragma unroll
          for (int r = 0; r < 16; ++r) st[j][r] -= delta;
          lsum[j] *= alpha;
          m[j] += delta;
#pragma unroll
          for (int mt = 0; mt < 2; ++mt)
#pragma unroll
            for (int r = 0; r < 16; ++r) o[mt][j][r] *= alpha;
        }
        float rs = 0.f;
#pragma unroll
        for (int r = 0; r < 16; ++r) { const float pv = __builtin_amdgcn_exp2f(st[j][r]); st[j][r] = pv; rs += pv; }
        rs += __shfl_xor(rs, 32);
        lsum[j] += rs;
#pragma unroll
        for (int s = 0; s < 2; ++s) {
          uint4 pk;
          pk.x = pack2(st[j][8 * s + 0], st[j][8 * s + 1]); pk.y = pack2(st[j][8 * s + 2], st[j][8 * s + 3]);
          pk.z = pack2(st[j][8 * s + 4], st[j][8 * s + 5]); pk.w = pack2(st[j][8 * s + 6], st[j][8 * s + 7]);
          pb[j][s] = __builtin_bit_cast(bf16x8, pk);
        }
      }
#pragma unroll
      for (int s = 0; s < 2; ++s)
#pragma unroll
        for (int mt = 0; mt < 2; ++mt) {
          const bf16x8 vf = tr_frag(cV, 72, kb * 32 + 16 * s + 4 * fh, kb * 32 + 16 * s + 8 + 4 * fh, mt * 32);
#pragma unroll
          for (int j = 0; j < 2; ++j) o[mt][j] = MFMA(vf, pb[j][s], o[mt][j]);
        }
    }
    if (nxt < nhb) ATT_STORE(pbuf ^ 1)
    pbuf ^= 1;
    __syncthreads();
  }
#undef ATT_PREFETCH
#undef ATT_STORE
#pragma unroll
  for (int j = 0; j < 2; ++j) {
    const float inv = 1.f / lsum[j];
    const size_t rho = (size_t)(qrow0 + j * 32 + fr);
#pragma unroll
    for (int mt = 0; mt < 2; ++mt)
#pragma unroll
      for (int g4 = 0; g4 < 4; ++g4) {
        const int d0 = mt * 32 + 8 * g4 + 4 * fh;
        const uint2 gv = *(const uint2*)(AG + rho * 512 + head * 64 + d0);
        uint2 ov;
        ov.x = pack2(o[mt][j][g4 * 4 + 0] * inv * silu_f(lo2f(gv.x)), o[mt][j][g4 * 4 + 1] * inv * silu_f(hi2f(gv.x)));
        ov.y = pack2(o[mt][j][g4 * 4 + 2] * inv * silu_f(lo2f(gv.y)), o[mt][j][g4 * 4 + 3] * inv * silu_f(hi2f(gv.y)));
        *(uint2*)(Q + rho * 512 + head * 64 + d0) = ov;
      }
  }
}

DI void states_item(const Params& p_in, char* smem, int ck, int g, int hq) {
  const Params p = load_params();

  bf16_t* sB = (bf16_t*)smem;
  bf16_t* sX = (bf16_t*)(smem + 128 * 136 * 2);
  int tid = threadIdx.x; asm volatile("" : "+v"(tid)); const int lane = tid & 63, wave = tid >> 6, wr = wave >> 1, wc = wave & 1, fr = lane & 31, fh = lane >> 5;
  const bf16_t* BC = (const bf16_t*)(p.ws + OFF_BC);
  const bf16_t* XS = (const bf16_t*)(p.ws + OFF_H);
  const float* DT = (const float*)(p.ws + OFF_DT);
  const float* CS = (const float*)(p.ws + OFF_CS);
  bf16_t* ST = (bf16_t*)(p.ws + OFF_ST);
  float* CDEC = (float*)(p.ws + OFF_CDEC);
  const int row0 = ck * 128;
  __syncthreads();
  for (int v = tid; v < 2048; v += 256) {
    const int r = v >> 4, cv = v & 15;
    *(uint4*)&sB[r * 136 + cv * 8] = *(const uint4*)(BC + (size_t)(row0 + r) * 512 + g * 128 + cv * 8);
  }
  __syncthreads();
  bf16x8 bfr[2][8];
#pragma unroll
  for (int j = 0; j < 2; ++j)
#pragma unroll
    for (int ks = 0; ks < 8; ++ks) bfr[j][ks] = tr_frag(sB, 136, ks * 16 + 8 * fh, ks * 16 + 8 * fh + 4, wc * 64 + j * 32);
  const int slr = tid >> 3, scv = tid & 7;
  uint4 xq0, xq1, xq2, xq3;
  float dq0, dq1, dq2, dq3, cq0, cq1, cq2, cq3, cendq;
#define ST_PREFETCH(HD) { const int head_ = g * 8 + hq * 4 + ((HD) >> 1), d_ = (HD) & 1, col_ = d_ * 16 + head_; \
    const bf16_t* xp_ = XS + (size_t)(row0 + slr) * 1024 + head_ * 64 + scv * 8; \
    xq0 = *(const uint4*)(xp_); xq1 = *(const uint4*)(xp_ + 32 * 1024); xq2 = *(const uint4*)(xp_ + 64 * 1024); xq3 = *(const uint4*)(xp_ + 96 * 1024); \
    const size_t rb_ = (size_t)(row0 + slr) * 32 + col_; \
    dq0 = DT[rb_]; dq1 = DT[rb_ + 32 * 32]; dq2 = DT[rb_ + 64 * 32]; dq3 = DT[rb_ + 96 * 32]; \
    cq0 = CS[rb_]; cq1 = CS[rb_ + 32 * 32]; cq2 = CS[rb_ + 64 * 32]; cq3 = CS[rb_ + 96 * 32]; \
    cendq = CS[(size_t)(row0 + (d_ == 0 ? 127 : 0)) * 32 + col_]; }
#define ST_SCALE_STORE(X, DTV, CSV, ROW) { const float sc_ = (DTV) * __expf(cend - (CSV)); uint4 o_; \
    o_.x = pack2(lo2f(X.x) * sc_, hi2f(X.x) * sc_); o_.y = pack2(lo2f(X.y) * sc_, hi2f(X.y) * sc_); \
    o_.z = pack2(lo2f(X.z) * sc_, hi2f(X.z) * sc_); o_.w = pack2(lo2f(X.w) * sc_, hi2f(X.w) * sc_); \
    *(uint4*)&sX[(ROW) * 72 + scv * 8] = o_; }
  ST_PREFETCH(0)
#pragma unroll 1
  for (int hd = 0; hd < 8; ++hd) {
    const int head = g * 8 + hq * 4 + (hd >> 1), d = hd & 1;
    const float cend = cendq;
    ST_SCALE_STORE(xq0, dq0, cq0, slr)
    ST_SCALE_STORE(xq1, dq1, cq1, slr + 32)
    ST_SCALE_STORE(xq2, dq2, cq2, slr + 64)
    ST_SCALE_STORE(xq3, dq3, cq3, slr + 96)
    if (hd < 7) ST_PREFETCH(hd + 1)
    __syncthreads();
    f32x16 acc[2];
#pragma unroll
    for (int j = 0; j < 2; ++j)
#pragma unroll
      for (int r = 0; r < 16; ++r) acc[j][r] = 0.f;
#pragma unroll
    for (int ks = 0; ks < 8; ++ks) {
      const bf16x8 af = tr_frag(sX, 72, ks * 16 + 8 * fh, ks * 16 + 8 * fh + 4, wr * 32);
#pragma unroll
      for (int j = 0; j < 2; ++j) acc[j] = MFMA(af, bfr[j][ks], acc[j]);
    }
    bf16_t* dst = ST + ((size_t)(ck * 2 + d) * 16 + head) * 8192;
#pragma unroll
    for (int j = 0; j < 2; ++j)
#pragma unroll
      for (int r = 0; r < 16; ++r) dst[(wr * 32 + crow(r, fh)) * 128 + wc * 64 + j * 32 + fr] = f2bf(acc[j][r]);
    if (tid == 0) CDEC[(ck * 2 + d) * 16 + head] = __expf(cend);
    __syncthreads();
  }
}

DI void pw_item(const Params& p_in, int l, char* smem, int mt, int nt) {
  const Params p = load_params();

  GemmS* s = (GemmS*)smem;
  int tid = threadIdx.x; asm volatile("" : "+v"(tid)); const int lane = tid & 63, wave = tid >> 6, wr = wave >> 1, wc = wave & 1, fr = lane & 31, fh = lane >> 5;
  const bf16_t* Ab = (const bf16_t*)(p.ws + OFF_HDN) + (size_t)mt * 128 * 512;
  const bf16_t* Bb = (const bf16_t*)(p.ws + OFF_PW) + (size_t)nt * 128 * 512;
  bf16_t* CG = (bf16_t*)(p.ws + OFF_CG);
  f32x16 acc[2][2];
  zero_acc(acc);
  gemm_core2(acc, (GemmS2*)smem,
             [&](int kt, int r, int kv) { return Ab + (size_t)r * 512 + kt * 64 + kv * 8; },
             [&](int kt, int r, int kv) { return Bb + (size_t)r * 512 + kt * 64 + kv * 8; }, 8, [](int) {});
  const float* pwb = p.conv_pw_b + l * 512 + nt * 128;
  epilogue_lds(acc, smem, [&](int rl, int c4, float4 v) {
    bf16_t* ptr = CG + (size_t)(mt * 128 + rl) * 512 + nt * 128 + c4;
    const uint2 gv = *(const uint2*)ptr;
    const float4 bb = *(const float4*)(pwb + c4);
    uint2 o;
    o.x = pack2((v.x + bb.x) * silu_f(lo2f(gv.x)), (v.y + bb.y) * silu_f(hi2f(gv.x)));
    o.y = pack2((v.z + bb.z) * silu_f(lo2f(gv.y)), (v.w + bb.w) * silu_f(hi2f(gv.y)));
    *(uint2*)ptr = o;
  });
}

DI void phase_mix(const Params& p, int l, char* smem) {
  const int G = gridDim.x;
  const int N_ATT = 512 + (l == 0 ? 32 : 0);
  for (int it = blockIdx.x; it < N_ATT; it += G) {
    if (it < 512) attn_item(p, l, smem, it >> 7, (it >> 2) & 31, (it >> 1) & 1, it & 1, false);
    else { const int t = it - 512; attn_item(p, l, smem, t >> 3, (t >> 2) & 1, (t >> 1) & 1, t & 1, true); }
  }
  for (int it = (blockIdx.x + G - 32) % G; it < NCK * 4; it += G) states_item(p, smem, it >> 2, (it >> 1) & 1, it & 1);
  for (int it = (blockIdx.x + G - 64) % G; it < NCK * 4; it += G) pw_item(p, l, smem, it >> 2, it & 3);
}

DI void phase_scan(const Params& p_in) {
  const Params p = load_params();

  bf16_t* ST = (bf16_t*)(p.ws + OFF_ST);
  const float* CDEC = (const float*)(p.ws + OFF_CDEC);
  for (int it = blockIdx.x; it < 512; it += gridDim.x) {
    const int e = it * 256 + threadIdx.x;
    const int bdh = e >> 10, v8 = e & 1023;
    const int b = bdh >> 5, d = (bdh >> 4) & 1, h = bdh & 15;
    float s[8];
#pragma unroll
    for (int i = 0; i < 8; ++i) s[i] = 0.f;
    auto ckof = [&](int i) {
      if (d == 0) return (i < 2) ? (128 + 2 * b + i) : (32 * b + (i - 2));
      return (i < 2) ? (128 + 2 * b + (1 - i)) : (32 * b + 31 - (i - 2));
    };
    auto pof = [&](int i) { const int ck = ckof(i); return (uint4*)(ST + ((size_t)(ck * 2 + d) * 16 + h) * 8192 + v8 * 8); };
    auto dof = [&](int i) { const int ck = ckof(i); return CDEC[(ck * 2 + d) * 16 + h]; };
    uint4 buf[8]; float dc[8];
#pragma unroll
    for (int i = 0; i < 7; ++i) { buf[i] = *pof(i); dc[i] = dof(i); }
#pragma unroll
    for (int i = 0; i < 34; ++i) {
      if (i + 7 < 34) { buf[(i + 7) & 7] = *pof(i + 7); dc[(i + 7) & 7] = dof(i + 7); }
      const uint4 cur = buf[i & 7];
      const float dec = dc[i & 7];
      uint4 o;
      o.x = pack2(s[0], s[1]); o.y = pack2(s[2], s[3]); o.z = pack2(s[4], s[5]); o.w = pack2(s[6], s[7]);
      *pof(i) = o;
      s[0] = s[0] * dec + lo2f(cur.x); s[1] = s[1] * dec + hi2f(cur.x);
      s[2] = s[2] * dec + lo2f(cur.y); s[3] = s[3] * dec + hi2f(cur.y);
      s[4] = s[4] * dec + lo2f(cur.z); s[5] = s[5] * dec + hi2f(cur.z);
      s[6] = s[6] * dec + lo2f(cur.w); s[7] = s[7] * dec + hi2f(cur.w);
    }
  }
}

DI void phase_ssdy(const Params& p_in, int l, char* smem) {
  const Params p = load_params();

  bf16_t* sB = (bf16_t*)smem;
  bf16_t* sX = (bf16_t*)(smem + 128 * 136 * 2);
  float* sF = (float*)(smem + 128 * 136 * 2 + 128 * 72 * 2);
  float* sSS = sF + 512;
  int tid = threadIdx.x; asm volatile("" : "+v"(tid)); const int lane = tid & 63, wave = tid >> 6, fr = lane & 31, fh = lane >> 5;
  const int wl = wave >> 1, w2 = wave & 1;
  const bf16_t* BC = (const bf16_t*)(p.ws + OFF_BC);
  const bf16_t* XS = (const bf16_t*)(p.ws + OFF_H);
  const float* DT = (const float*)(p.ws + OFF_DT);
  const float* CS = (const float*)(p.ws + OFF_CS);
  const bf16_t* ST = (const bf16_t*)(p.ws + OFF_ST);
  bf16_t* Z = (bf16_t*)(p.ws + OFF_Z);
  float* RSTD = (float*)(p.ws + OFF_RSTD);
  const int nck = (l == 0) ? NCK : 128;
  const int nh = (l == 0) ? 2 : 8;
  const int nsplit = 8 / nh;
  for (int it0 = blockIdx.x; it0 < nck * 4 * nsplit; it0 += gridDim.x) {
    const int hq = it0 % nsplit, it = it0 / nsplit;
    const int hbeg = hq * nh, hend = hbeg + nh;
    const int ck = it >> 2, g = (it >> 1) & 1, lh = it & 1;
    const int row0 = ck * 128;
    const int lbase = lh * 64 + wl * 32;
    __syncthreads();
    for (int v = tid; v < 2048; v += 256) {
      const int r = v >> 4, cv = v & 15;
      *(uint4*)&sB[r * 136 + cv * 8] = *(const uint4*)(BC + (size_t)(row0 + r) * 512 + g * 128 + cv * 8);
    }
    if (tid < 64) sSS[tid] = 0.f;
    const bf16_t* cptr = BC + (size_t)(row0 + lbase + fr) * 512 + 256 + g * 128 + fh * 8;
    bf16x8 cf[8];
#pragma unroll
    for (int ks = 0; ks < 8; ++ks) cf[ks] = *(const bf16x8*)(cptr + ks * 16);
    const int lrx = tid >> 3, cvx = tid & 7;
    const bf16_t* xsrc = XS + (size_t)(row0 + lrx) * 1024 + cvx * 8;
    uint4 xp0, xp1, xp2, xp3;
    float fp0 = 0.f, fp1 = 0.f, fp2 = 0.f, fp3 = 0.f;
    {
      const int head = g * 8 + hbeg;
      xp0 = *(const uint4*)(xsrc + head * 64);
      xp1 = *(const uint4*)(xsrc + head * 64 + 32 * 1024);
      xp2 = *(const uint4*)(xsrc + head * 64 + 64 * 1024);
      xp3 = *(const uint4*)(xsrc + head * 64 + 96 * 1024);
      if (tid < 128) {
        const size_t rho = (size_t)(row0 + tid);
        fp0 = CS[rho * 32 + head]; fp1 = CS[rho * 32 + 16 + head]; fp2 = DT[rho * 32 + head]; fp3 = DT[rho * 32 + 16 + head];
      }
    }
    __syncthreads();
    f32x16 cb[2];
#pragma unroll
    for (int j = 0; j < 2; ++j) {
#pragma unroll
      for (int r = 0; r < 16; ++r) cb[j][r] = 0.f;
#pragma unroll
      for (int ks = 0; ks < 8; ++ks) {
        const bf16x8 bq = *(const bf16x8*)&sB[(w2 * 64 + j * 32 + fr) * 136 + ks * 16 + fh * 8];
        cb[j] = MFMA(cf[ks], bq, cb[j]);
      }
    }
    const int pidx = w2 * 32 + fr;
    bf16_t* sCB = sB + 64 * 136;
    __syncthreads();
#pragma unroll
    for (int j = 0; j < 2; ++j)
#pragma unroll
      for (int r = 0; r < 16; ++r) sCB[(wl * 32 + crow(r, fh)) * 136 + w2 * 64 + j * 32 + fr] = f2bf(cb[j][r]);
#pragma unroll 1
    for (int hh = hbeg; hh < hend; ++hh) {
      const int head = g * 8 + hh;
      __syncthreads();
      *(uint4*)&sX[lrx * 72 + cvx * 8] = xp0;
      *(uint4*)&sX[(lrx + 32) * 72 + cvx * 8] = xp1;
      *(uint4*)&sX[(lrx + 64) * 72 + cvx * 8] = xp2;
      *(uint4*)&sX[(lrx + 96) * 72 + cvx * 8] = xp3;
      if (tid < 128) { sF[tid] = fp0; sF[128 + tid] = fp1; sF[256 + tid] = fp2; sF[384 + tid] = fp3; }
      const bf16_t* S0 = ST + ((size_t)(ck * 2 + 0) * 16 + head) * 8192 + (w2 * 32 + fr) * 128 + fh * 8;
      const bf16_t* S1 = ST + ((size_t)(ck * 2 + 1) * 16 + head) * 8192 + (w2 * 32 + fr) * 128 + fh * 8;
      bf16x8 sf0[8];
#pragma unroll
      for (int ks = 0; ks < 8; ++ks) sf0[ks] = *(const bf16x8*)(S0 + ks * 16);
      bf16_t* zbase = Z + (size_t)(row0 + lbase + 4 * fh) * 1024 + head * 64 + pidx;
      if (hh + 1 < hend) {
        const int hn = head + 1;
        xp0 = *(const uint4*)(xsrc + hn * 64);
        xp1 = *(const uint4*)(xsrc + hn * 64 + 32 * 1024);
        xp2 = *(const uint4*)(xsrc + hn * 64 + 64 * 1024);
        xp3 = *(const uint4*)(xsrc + hn * 64 + 96 * 1024);
        if (tid < 128) {
          const size_t rho = (size_t)(row0 + tid);
          fp0 = CS[rho * 32 + hn]; fp1 = CS[rho * 32 + 16 + hn]; fp2 = DT[rho * 32 + hn]; fp3 = DT[rho * 32 + 16 + hn];
        }
      }
      __syncthreads();
#pragma unroll
      for (int j = 0; j < 2; ++j) {
        const int sidx = w2 * 64 + j * 32 + fr;
        const float csf_s = sF[sidx], csb_s = sF[128 + sidx], dtf_s = sF[256 + sidx], dtb_s = sF[384 + sidx];
#pragma unroll 4
        for (int r = 0; r < 16; ++r) {
          const int lidx = lbase + crow(r, fh);
          float f = 0.f;
          if (sidx <= lidx) f += __expf(sF[lidx] - csf_s) * dtf_s;
          if (sidx >= lidx) f += __expf(sF[128 + lidx] - csb_s) * dtb_s;
          sB[(wl * 32 + crow(r, fh)) * 136 + sidx] = f2bf(bf2f(sCB[(wl * 32 + crow(r, fh)) * 136 + sidx]) * f);
        }
      }
      __syncthreads();
      bf16x8 sf1[8], cfh[8];
#pragma unroll
      for (int ks = 0; ks < 8; ++ks) { sf1[ks] = *(const bf16x8*)(S1 + ks * 16); cfh[ks] = *(const bf16x8*)(cptr + ks * 16); }
      unsigned short zv[16];
#pragma unroll
      for (int r = 0; r < 16; ++r) zv[r] = zbase[(size_t)((r & 3) + 8 * (r >> 2)) * 1024];
      f32x16 accy;
#pragma unroll
      for (int r = 0; r < 16; ++r) accy[r] = 0.f;
#pragma unroll
      for (int ks = 0; ks < 8; ++ks) {
        const bf16x8 af = *(const bf16x8*)&sB[(wl * 32 + fr) * 136 + ks * 16 + fh * 8];
        const bf16x8 xf = tr_frag(sX, 72, ks * 16 + 8 * fh, ks * 16 + 8 * fh + 4, w2 * 32);
        accy = MFMA(af, xf, accy);
      }
      {
        f32x16 acct;
#pragma unroll
        for (int r = 0; r < 16; ++r) acct[r] = 0.f;
#pragma unroll
        for (int ks = 0; ks < 8; ++ks) acct = MFMA(cfh[ks], sf0[ks], acct);
#pragma unroll
        for (int r = 0; r < 16; ++r) accy[r] += __expf(sF[lbase + crow(r, fh)]) * acct[r];
#pragma unroll
        for (int r = 0; r < 16; ++r) acct[r] = 0.f;
#pragma unroll
        for (int ks = 0; ks < 8; ++ks) acct = MFMA(cfh[ks], sf1[ks], acct);
#pragma unroll
        for (int r = 0; r < 16; ++r) accy[r] += __expf(sF[128 + lbase + crow(r, fh)]) * acct[r];
      }
      const float dsk = p.ssd_d[l * 16 + head];
      float v[16];
#pragma unroll
      for (int r = 0; r < 16; ++r) {
        const int lidx = lbase + crow(r, fh);
        const float xv = bf2f(sX[lidx * 72 + pidx]);
        const float y = accy[r] + dsk * xv;
        const float u = y * silu_f(bf2f(zv[r]));
        v[r] = u * u;
        zbase[(size_t)((r & 3) + 8 * (r >> 2)) * 1024] = f2bf(u);
      }
#pragma unroll
      for (int i = 0; i < 8; ++i) { const bool up = (fr & 16) != 0; const float keep = up ? v[i + 8] : v[i]; const float send = up ? v[i] : v[i + 8]; v[i] = keep + __shfl_xor(send, 16); }
#pragma unroll
      for (int i = 0; i < 4; ++i) { const bool up = (fr & 8) != 0; const float keep = up ? v[i + 4] : v[i]; const float send = up ? v[i] : v[i + 4]; v[i] = keep + __shfl_xor(send, 8); }
#pragma unroll
      for (int i = 0; i < 2; ++i) { const bool up = (fr & 4) != 0; const float keep = up ? v[i + 2] : v[i]; const float send = up ? v[i] : v[i + 2]; v[i] = keep + __shfl_xor(send, 4); }
      { const bool up = (fr & 2) != 0; const float keep = up ? v[1] : v[0]; const float send = up ? v[0] : v[1]; v[0] = keep + __shfl_xor(send, 2); }
      v[0] += __shfl_xor(v[0], 1);
      if ((fr & 1) == 0) atomicAdd(&sSS[wl * 32 + crow(fr >> 1, fh)], v[0]);
    }
    __syncthreads();
    if (tid < 64) atomicAdd(&RSTD[(size_t)(row0 + lh * 64 + tid) * 2 + g], sSS[tid]);
  }
}

DI void phase_outproj(const Params& p_in, int l, char* smem) {
  const Params p = load_params();

  GemmS* s = (GemmS*)smem;
  int tid = threadIdx.x; asm volatile("" : "+v"(tid)); const int lane = tid & 63, wave = tid >> 6, wr = wave >> 1, wc = wave & 1, fr = lane & 31, fh = lane >> 5;
  const bf16_t* Zb = (const bf16_t*)(p.ws + OFF_Z);
  const bf16_t* Qb = (const bf16_t*)(p.ws + OFF_Q);
  const bf16_t* Cb = (const bf16_t*)(p.ws + OFF_CG);
  const bf16_t* W = (const bf16_t*)(p.ws + OFF_WOUT);
  const float* RSTD = (const float*)(p.ws + OFF_RSTD);
  const float* mods = (const float*)(p.ws + OFF_MODS);
  float* XC = (float*)(p.ws + OFF_XC);
  for (int step = 0;; ++step) {
    int mt, nt2;
    if (!xcd_tile(step, 128, 4, mt, nt2)) break;
    f32x16 acc[2][4];
#pragma unroll
    for (int i = 0; i < 2; ++i)
#pragma unroll
      for (int j = 0; j < 4; ++j)
#pragma unroll
        for (int r = 0; r < 16; ++r) acc[i][j][r] = 0.f;
    const bf16_t* Wb = W + (size_t)nt2 * 256 * 2048;
    const bf16_t* A0 = Zb + (size_t)mt * 128 * 1024;
    const bf16_t* A2 = Qb + (size_t)mt * 128 * 512;
    const bf16_t* A3 = Cb + (size_t)mt * 128 * 512;
    float* sScale = (float*)(smem + 55296);
    __syncthreads();
    if (tid < 128) {
      const size_t row = (size_t)(mt * 128 + tid);
      const float r0 = rsqrtf(RSTD[row * 2] * (1.f / 512.f) + 1e-6f);
      const float r1 = rsqrtf(RSTD[row * 2 + 1] * (1.f / 512.f) + 1e-6f);
      sScale[tid * 2] = r0 / r1;
      sScale[tid * 2 + 1] = r1;
    }
    gemm_core3(acc, (GemmS3*)smem,
               [&](int kt, int r, int kv) {
                 const bf16_t* ptr;
                 if (kt < 16) ptr = A0 + (size_t)r * 1024 + kt * 64;
                 else if (kt < 24) ptr = A2 + (size_t)r * 512 + (kt - 16) * 64;
                 else ptr = A3 + (size_t)r * 512 + (kt - 24) * 64;
                 return ptr + kv * 8;
               },
               [&](int kt, int r, int kv) { return Wb + (size_t)r * 2048 + kt * 64 + kv * 8; }, 32,
               [&](int kt) __attribute__((always_inline)) {
                 if (kt == 8 || kt == 16) {
#pragma unroll
                   for (int i = 0; i < 2; ++i)
#pragma unroll
                     for (int r = 0; r < 16; ++r) {
                       const float f = sScale[(wr * 64 + i * 32 + crow(r, fh)) * 2 + (kt == 16 ? 1 : 0)];
                       acc[i][0][r] *= f; acc[i][1][r] *= f; acc[i][2][r] *= f; acc[i][3][r] *= f;
                     }
                 }
               });
    {
      const int row0 = mt * 128;
      const int vv = row0 >> 12;
      float* xnew = p.out + (size_t)row0 * 1024;
      const float* xold = (l == 0) ? (p.x + (size_t)row0 * 1024) : xnew;
#pragma unroll 1
      for (int sub = 0; sub < 2; ++sub) {
        const int nt = nt2 * 2 + sub;
        const float* gate = mods + (l * 5 + vv) * 3072 + 2048 + nt * 128;
        epilogue_lds2(acc, smem, sub, [&](int rl, int c4, float4 v) {
          const int off = rl * 1024 + nt * 128 + c4;
          const float4 xo = *(const float4*)(xold + off);
          const float4 gt = *(const float4*)(gate + c4);
          float4 o;
          o.x = xo.x + gt.x * v.x; o.y = xo.y + gt.y * v.y; o.z = xo.z + gt.z * v.z; o.w = xo.w + gt.w * v.w;
          *(float4*)(xnew + off) = o;
        });
      }
    }
  }
  const int nctx = (l == 0) ? 64 : 0;
  for (int it = (int)blockIdx.x; it < nctx; it += gridDim.x) {
    const int mt = 128 + (it >> 3), nt = it & 7;
    f32x16 acc[2][2];
    zero_acc(acc);
    const bf16_t* Wb = W + (size_t)nt * 128 * 2048;
    const bf16_t* A0 = Zb + (size_t)mt * 128 * 1024;
    const bf16_t* A2 = Qb + (size_t)mt * 128 * 512;
    const bf16_t* A3 = Cb + (size_t)mt * 128 * 512;
    float* sScale = (float*)(smem + 40960);
    if (tid < 128) {
      const size_t row = (size_t)(mt * 128 + tid);
      const float r0 = rsqrtf(RSTD[row * 2] * (1.f / 512.f) + 1e-6f);
      const float r1 = rsqrtf(RSTD[row * 2 + 1] * (1.f / 512.f) + 1e-6f);
      sScale[tid * 2] = r0 / r1;
      sScale[tid * 2 + 1] = r1;
    }
    gemm_core2(acc, (GemmS2*)smem,
               [&](int kt, int r, int kv) {
                 const bf16_t* ptr;
                 if (kt < 16) ptr = A0 + (size_t)r * 1024 + kt * 64;
                 else if (kt < 24) ptr = A2 + (size_t)r * 512 + (kt - 16) * 64;
                 else ptr = A3 + (size_t)r * 512 + (kt - 24) * 64;
                 return ptr + kv * 8;
               },
               [&](int kt, int r, int kv) { return Wb + (size_t)r * 2048 + kt * 64 + kv * 8; }, 32,
               [&](int kt) __attribute__((always_inline)) {
                 if (kt == 8 || kt == 16) {
#pragma unroll
                   for (int i = 0; i < 2; ++i)
#pragma unroll
                     for (int r = 0; r < 16; ++r) {
                       const float f = sScale[(wr * 64 + i * 32 + crow(r, fh)) * 2 + (kt == 16 ? 1 : 0)];
                       acc[i][0][r] *= f; acc[i][1][r] *= f;
                     }
                 }
               });
    {
      const int row0 = mt * 128;
      const int vv = (row0 < RL_) ? (row0 >> 12) : 4;
      const float* gate = mods + (l * 5 + vv) * 3072 + 2048 + nt * 128;
      float* xnew = (row0 < RL_) ? (p.out + (size_t)row0 * 1024) : (XC + (size_t)(row0 - RL_) * 1024);
      const float* xold = (l == 0) ? ((row0 < RL_) ? (p.x + (size_t)row0 * 1024) : (p.ctx + (size_t)(row0 - RL_) * 1024)) : xnew;
      epilogue_lds(acc, smem, [&](int rl, int c4, float4 v) {
        const int off = rl * 1024 + nt * 128 + c4;
        const float4 xo = *(const float4*)(xold + off);
        const float4 gt = *(const float4*)(gate + c4);
        float4 o;
        o.x = xo.x + gt.x * v.x; o.y = xo.y + gt.y * v.y; o.z = xo.z + gt.z * v.z; o.w = xo.w + gt.w * v.w;
        *(float4*)(xnew + off) = o;
      });
    }
  }
  if (l == 0) {
    const int local = blockIdx.x >> 3, xcd = blockIdx.x & 7, nloc = gridDim.x >> 3;
    if (local >= 8 && nloc > 8) {
      const int nb = (nloc - 8) * 8;
      const int NT_WIN = 88 * 16, NT_PW = 64;
      for (int it = (local - 8) * 8 + xcd; it < NT_WIN + NT_PW; it += nb) {
        if (it < NT_WIN) transpose_tile(p.w_in + (size_t)1024 * 5408, 5408, 0, nullptr, (bf16_t*)(p.ws + OFF_WIN), 1024, (it / 16) * 64, (it % 16) * 64, (float*)smem);
        else { const int t = it - NT_WIN; transpose_tile(p.conv_pw_w + (size_t)512 * 512, 512, 1, nullptr, (bf16_t*)(p.ws + OFF_PW), 512, (t / 8) * 64, (t % 8) * 64, (float*)smem); }
      }
    }
  }
}

DI void phase_final(const Params& p_in) {
  const Params p = load_params();
  const int lane = threadIdx.x & 63, wave = threadIdx.x >> 6;
  for (int it = blockIdx.x; it < RL_ / 8; it += gridDim.x) {
    float* xr0 = p.out + (size_t)(it * 8 + wave * 2) * 1024;
    float4 xv[2][4];
#pragma unroll
    for (int q = 0; q < 2; ++q)
#pragma unroll
      for (int i = 0; i < 4; ++i) xv[q][i] = *(const float4*)(xr0 + q * 1024 + lane * 4 + i * 256);
    float4 w[4];
#pragma unroll
    for (int i = 0; i < 4; ++i) w[i] = *(const float4*)(p.final_norm_w + lane * 4 + i * 256);
#pragma unroll
    for (int q = 0; q < 2; ++q) {
      float ss = 0.f;
#pragma unroll
      for (int i = 0; i < 4; ++i) ss += xv[q][i].x * xv[q][i].x + xv[q][i].y * xv[q][i].y + xv[q][i].z * xv[q][i].z + xv[q][i].w * xv[q][i].w;
#pragma unroll
      for (int o = 32; o >= 1; o >>= 1) ss += __shfl_xor(ss, o);
      const float rs = rsqrtf(ss * (1.f / 1024.f) + 1e-6f);
#pragma unroll
      for (int i = 0; i < 4; ++i) {
        float4 o;
        o.x = xv[q][i].x * rs * w[i].x; o.y = xv[q][i].y * rs * w[i].y; o.z = xv[q][i].z * rs * w[i].z; o.w = xv[q][i].w * rs * w[i].w;
        *(float4*)(xr0 + q * 1024 + lane * 4 + i * 256) = o;
      }
    }
  }
}

template <int PH>
DI void run_phase(const Params& p, char* smem) {
  constexpr int l = (PH - 1) / 7, s = (PH - 1) % 7;
  if constexpr (PH == 0) phase_mods(p, smem);
  else if constexpr (PH == 15) phase_final(p);
  else if constexpr (s == 0) phase_prep(p, l, smem);
  else if constexpr (s == 1) phase_inproj(p, smem);
  else if constexpr (s == 2) phase_local(p, l, smem);
  else if constexpr (s == 3) phase_mix(p, l, smem);
  else if constexpr (s == 4) phase_scan(p);
  else if constexpr (s == 5) phase_ssdy(p, l, smem);
  else phase_outproj(p, l, smem);
}

#if PROBE_S >= 0
#define PROBE_BEGIN() if (threadIdx.x == 0) pst[1] = wall_clock64();
#define PROBE_END(PH) if (threadIdx.x == 0 && (PH) >= 1 && (PH) <= 14 && (((PH) - 1) % 7) == PROBE_S) pst[0] += wall_clock64() - pst[1];
#else
#define PROBE_BEGIN()
#define PROBE_END(PH)
#endif
#define PHASE(PH) PROBE_BEGIN() run_phase<PH>(p, smem); xcd_barrier(xst); PROBE_END(PH)

__global__ void __launch_bounds__(256, 2) fwd_megakernel(Params p) {
  __shared__ __attribute__((aligned(16))) char smem[57344];
  cg::grid_group grid = cg::this_grid();
  if (threadIdx.x == 0) g_kernarg = (unsigned long long)__builtin_amdgcn_kernarg_segment_ptr();
  __syncthreads();
#if PROBE_S >= 0
  volatile unsigned long long* pst = (volatile unsigned long long*)(smem + 57344 - 16);
  if (threadIdx.x == 0) { pst[0] = 0; pst[1] = 0; }
#endif
  __shared__ uint4 xb_words;
  volatile LAS unsigned* xst = (volatile LAS unsigned*)&xb_words;
  if (threadIdx.x == 0) xb_words = make_uint4(0u, 0u, 0u, 0u);
  if (threadIdx.x == 0) { unsigned* bar = (unsigned*)(load_params().ws + OFF_BAR); (void)xb_add(&bar[XB_XCNT(xb_xcc_id())], 1u); }
  run_phase<0>(p, smem);
  if (load_params().out == nullptr) grid.sync();
  xcd_barrier(xst);
  PHASE(1) PHASE(2) PHASE(3) PHASE(4) PHASE(5) PHASE(6) PHASE(7)
  PHASE(8) PHASE(9) PHASE(10) PHASE(11) PHASE(12) PHASE(13) PHASE(14)
  run_phase<15>(p, smem);
#if PROBE_S >= 0
  if (blockIdx.x == 0 && threadIdx.x == 0) {
    const unsigned long long t1 = wall_clock64();
    const unsigned long long lim = 4ull * pst[0];
    while (wall_clock64() - t1 < lim) { __builtin_amdgcn_s_sleep(32); }
  }
#endif
}

extern "C" void kernel_launch(void* const* d_in, const int* in_sizes, int n_in, void* d_out, int out_size, void* d_ws,
                              size_t ws_size, hipStream_t stream) {
  static int grid_blocks = 0;
  if (!grid_blocks) {
    int dev = 0, cus = 0, per_cu = 0;
    hipGetDevice(&dev);
    hipDeviceGetAttribute(&cus, hipDeviceAttributeMultiprocessorCount, dev);
    hipOccupancyMaxActiveBlocksPerMultiprocessor(&per_cu, fwd_megakernel, 256, 0);
    if (per_cu < 1) per_cu = 1;
    if (per_cu > 2) per_cu = 2;
    grid_blocks = (cus * per_cu) & ~7;
  }
  Params p{};
  const float** pp = (const float**)&p;
  for (int i = 0; i < 23; ++i) pp[i] = (const float*)d_in[i];
  p.out = (float*)d_out;
  p.ws = (char*)d_ws;
  (void)hipMemsetAsync((char*)d_ws + OFF_BAR, 0, XCD_BAR_WORDS * 4, stream);
  void* args[] = {&p};
  hipError_t e = hipLaunchCooperativeKernel((void*)fwd_megakernel, dim3(grid_blocks), dim3(256), args, 0, stream);
  if (e != hipSuccess) fprintf(stderr, "cooperative launch failed: %s (grid %d)\n", hipGetErrorString(e), grid_blocks);
}
```

```cpp
#include <hip/hip_runtime.h>
#include <hip/hip_cooperative_groups.h>
#include <stdint.h>
#include <stdio.h>
namespace cg = cooperative_groups;

#ifndef ONE_LAUNCH
#define ONE_LAUNCH 1
#endif

#ifndef PROBE_S
#define PROBE_S -1
#endif
#define DI __device__ __forceinline__
typedef unsigned short bf16_t;
using bf16x8 = __attribute__((ext_vector_type(8))) short;
using s16x4 = __attribute__((ext_vector_type(4))) short;
using f32x16 = __attribute__((ext_vector_type(16))) float;
#define MFMA(a, b, c) __builtin_amdgcn_mfma_f32_32x32x16_bf16((a), (b), (c), 0, 0, 0)

constexpr int R_ = 17408;
constexpr int RL_ = 16384;
constexpr int NCK = 136;

constexpr size_t SZ_WIN = (size_t)5632 * 1024 * 2;
constexpr size_t SZ_WOUT = (size_t)1024 * 2048 * 2;
constexpr size_t SZ_PW = (size_t)512 * 512 * 2;
constexpr size_t SZ_MODS = (size_t)2 * 5 * 3072 * 4;
constexpr size_t SZ_XC = (size_t)1024 * 1024 * 4;
constexpr size_t SZ_RSTD = (size_t)R_ * 2 * 4;
constexpr size_t SZ_CDEC = (size_t)NCK * 32 * 4 + 256 - ((size_t)NCK * 32 * 4) % 256;
constexpr size_t SZ_R512 = (size_t)R_ * 512 * 2;
constexpr size_t OFF_WIN = 0;
constexpr size_t OFF_WOUT = OFF_WIN + SZ_WIN;
constexpr size_t OFF_PW = OFF_WOUT + SZ_WOUT;
constexpr size_t OFF_MODS = OFF_PW + SZ_PW;
constexpr size_t OFF_XC = OFF_MODS + SZ_MODS;
constexpr size_t OFF_RSTD = OFF_XC + SZ_XC;
constexpr size_t OFF_CDEC = OFF_RSTD + SZ_RSTD;
constexpr size_t OFF_H = OFF_CDEC + SZ_CDEC;
constexpr size_t OFF_XBC = OFF_H + 2 * SZ_R512;
constexpr size_t OFF_GLU = OFF_XBC + 3 * SZ_R512;
constexpr size_t OFF_ST = OFF_XBC;
constexpr size_t OFF_Z = OFF_GLU + SZ_R512;
constexpr size_t OFF_DT = OFF_Z + 2 * SZ_R512;
constexpr size_t OFF_CS = OFF_DT + (size_t)R_ * 32 * 4;
constexpr size_t OFF_Q = OFF_CS + (size_t)R_ * 32 * 4;
constexpr size_t OFF_KV = OFF_Q + SZ_R512;
constexpr size_t OFF_AG = OFF_KV + SZ_R512 / 2;
constexpr size_t OFF_CG = OFF_AG + SZ_R512;
constexpr size_t OFF_BC = OFF_CG + SZ_R512;
constexpr size_t OFF_HDN = OFF_BC + SZ_R512;
constexpr size_t WS_TOTAL = OFF_HDN + SZ_R512;
constexpr size_t OFF_BAR = WS_TOTAL;
static_assert(OFF_BAR + 16384 <= (size_t)256 * 1024 * 1024, "workspace too large");

struct Params {
  const float *x, *c, *ctx, *c_ctx, *w_mod, *b_mod, *norm_w, *w_in, *ssd_conv_w, *ssd_conv_b, *ssd_dt_bias, *ssd_a_log,
      *ssd_d, *ssd_norm_w, *attn_sink, *conv_dw_w, *conv_dw_b, *conv_ln_w, *conv_ln_b, *conv_pw_w, *conv_pw_b, *w_out,
      *final_norm_w;
  float* out;
  char* ws;
};


__shared__ unsigned long long g_kernarg;
DI Params load_params() {
  typedef const char __attribute__((address_space(4)))* kptr_t;
  typedef const float* const __attribute__((address_space(4)))* kfld_t;
  const unsigned long long v = *(volatile unsigned long long*)&g_kernarg;
  const unsigned lo = __builtin_amdgcn_readfirstlane((unsigned)v), hi = __builtin_amdgcn_readfirstlane((unsigned)(v >> 32));
  kptr_t base = (kptr_t)(((unsigned long long)hi << 32) | lo);
  Params p;
  const float** pp = (const float**)&p;
#pragma unroll
  for (int i = 0; i < 25; ++i) pp[i] = *(kfld_t)(base + 8 * i);
  return p;
}

#define XB_TMO      128
#define XB_XCNT(j)  (256  + 64 * (j))
#define XB_XSUB(j)  (1280 + 64 * (j))
#define XB_XGEN(j)  (2304 + 64 * (j))
#define XB_TOP      3328
#define XB_TOPGEN   3392
#define XCD_BAR_WORDS 3456
#define XB_SPIN_CAP (1u << 18)
#define LAS __attribute__((address_space(3)))
DI unsigned xb_ld(unsigned* p)              { return __hip_atomic_load(p, __ATOMIC_RELAXED, __HIP_MEMORY_SCOPE_AGENT); }
DI unsigned xb_add(unsigned* p, unsigned v) { return __hip_atomic_fetch_add(p, v, __ATOMIC_RELAXED, __HIP_MEMORY_SCOPE_AGENT); }
DI unsigned xb_xcc_id() { return (unsigned)__builtin_amdgcn_s_getreg((3 << 11) | 20) & 0xFu; }
#define XB_SPIN(cond, bar) do { unsigned _sp = 0; while (cond) { __builtin_amdgcn_s_sleep(1); \
    if ((++_sp & 255u) == 0u) { if (xb_ld(&(bar)[XB_TMO])) break; if (_sp > XB_SPIN_CAP) { atomicAdd(&(bar)[XB_TMO], 1u); break; } } } } while (0)

DI void xcd_barrier_complete(unsigned* bar, unsigned x, unsigned& nloc, unsigned& nx) {
  const unsigned G = gridDim.x * gridDim.y * gridDim.z;
  unsigned sum, cnt, mine, sp = 0u;
  for (;;) {
    sum = 0u; cnt = 0u; mine = 0u;
#pragma unroll
    for (unsigned j = 0; j < 16; ++j) { const unsigned c = xb_ld(&bar[XB_XCNT(j)]); sum += c; cnt += (c > 0u) ? 1u : 0u; mine = (j == x) ? c : mine; }
    if (sum == G) break;
    __builtin_amdgcn_s_sleep(1);
    if ((++sp & 255u) == 0u) { if (xb_ld(&bar[XB_TMO])) break; if (sp > XB_SPIN_CAP) { atomicAdd(&bar[XB_TMO], 1u); break; } }
  }
  nloc = mine > 0u ? mine : 1u; nx = cnt > 0u ? cnt : 1u;
}

DI void xcd_barrier(volatile LAS unsigned* st) {
  asm volatile("s_waitcnt vmcnt(0)" ::: "memory");
  __syncthreads();
  if (threadIdx.x == 0) {
    const Params pb = load_params();
    unsigned* bar = (unsigned*)(pb.ws + OFF_BAR);
    const unsigned x = xb_xcc_id();
    __builtin_amdgcn_s_waitcnt(0);
    unsigned nloc = st[0], nx = st[1];
    if (nloc == 0u) { xcd_barrier_complete(bar, x, nloc, nx); st[0] = nloc; st[1] = nx; }
    const unsigned old = xb_add(&bar[XB_XSUB(x)], 1u);
    const unsigned gen = old / nloc;
    if (old + 1u == (gen + 1u) * nloc) {
      __builtin_amdgcn_fence(__ATOMIC_RELEASE, "agent");
      asm volatile("s_waitcnt vmcnt(0)" ::: "memory");
      const unsigned og = xb_add(&bar[XB_TOP], 1u);
      const unsigned tg = og / nx;
      if (og + 1u == (tg + 1u) * nx) xb_add(&bar[XB_TOPGEN], 1u);
      else XB_SPIN(xb_ld(&bar[XB_TOPGEN]) == tg, bar);
      __builtin_amdgcn_fence(__ATOMIC_ACQUIRE, "agent");
      xb_add(&bar[XB_XGEN(x)], 1u);
      asm volatile("s_waitcnt vmcnt(0)" ::: "memory");
    } else {
      XB_SPIN(xb_ld(&bar[XB_XGEN(x)]) == gen, bar);
      __builtin_amdgcn_fence(__ATOMIC_ACQUIRE, "agent");
      asm volatile("s_waitcnt vmcnt(0)" ::: "memory");
    }
  }
  __syncthreads();
}

typedef __bf16 nbf16x2_t __attribute__((ext_vector_type(2)));
typedef float nf32x2_t __attribute__((ext_vector_type(2)));
DI unsigned short f2bf(float x) { const __bf16 r = (__bf16)x; return __builtin_bit_cast(unsigned short, r); }
DI float bf2f(unsigned short b) { return __uint_as_float(((unsigned)b) << 16); }
DI unsigned pack2(float a, float b) { const nf32x2_t v = {a, b}; const nbf16x2_t r = __builtin_convertvector(v, nbf16x2_t); return __builtin_bit_cast(unsigned, r); }
DI float lo2f(unsigned u) { return __uint_as_float(u << 16); }
DI float hi2f(unsigned u) { return __uint_as_float(u & 0xffff0000u); }
DI float silu_f(float x) { return x / (1.f + __expf(-x)); }
DI float sigmoid_f(float x) { return 1.f / (1.f + __expf(-x)); }
DI int crow(int reg, int h) { return (reg & 3) + 8 * (reg >> 2) + 4 * h; }

DI bf16x8 tr_frag(const bf16_t* s, int ld, int row_lo, int row_hi, int col0) {
  const int lane = threadIdx.x & 63;
  const int i16 = lane & 15, q = i16 >> 2, pp = i16 & 3, blk = (lane >> 4) & 1;
  const unsigned a0 = (unsigned)(size_t)(s + (row_lo + q) * ld + col0 + 16 * blk + 4 * pp);
  const unsigned a1 = (unsigned)(size_t)(s + (row_hi + q) * ld + col0 + 16 * blk + 4 * pp);
  s16x4 lo, hi;
  asm volatile("ds_read_b64_tr_b16 %0, %2\n\tds_read_b64_tr_b16 %1, %3\n\ts_waitcnt lgkmcnt(0)"
               : "=&v"(lo), "=&v"(hi) : "v"(a0), "v"(a1) : "memory");
  return __builtin_shufflevector(lo, hi, 0, 1, 2, 3, 4, 5, 6, 7);
}

struct GemmS { bf16_t a[2][128][40]; bf16_t b[2][128][40]; };

template <class AF, class BF>
DI void gemm_core(f32x16 (&acc)[2][2], GemmS* s, AF aptr, BF bptr, int nk) {
  int tid = threadIdx.x; asm volatile("" : "+v"(tid)); const int lane = tid & 63, wave = tid >> 6, wr = wave >> 1, wc = wave & 1;
  const int r0 = tid >> 2, kv = tid & 3;
  const int fr = lane & 31, fh = lane >> 5;
  uint4 ra0 = *(const uint4*)aptr(0, r0, kv), ra1 = *(const uint4*)aptr(0, r0 + 64, kv);
  uint4 rb0 = *(const uint4*)bptr(0, r0, kv), rb1 = *(const uint4*)bptr(0, r0 + 64, kv);
  *(uint4*)&s->a[0][r0][kv * 8] = ra0; *(uint4*)&s->a[0][r0 + 64][kv * 8] = ra1;
  *(uint4*)&s->b[0][r0][kv * 8] = rb0; *(uint4*)&s->b[0][r0 + 64][kv * 8] = rb1;
  __syncthreads();
#pragma unroll 1
  for (int kt = 0; kt < nk; ++kt) {
    const int buf = kt & 1;
    if (kt + 1 < nk) {
      ra0 = *(const uint4*)aptr(kt + 1, r0, kv); ra1 = *(const uint4*)aptr(kt + 1, r0 + 64, kv);
      rb0 = *(const uint4*)bptr(kt + 1, r0, kv); rb1 = *(const uint4*)bptr(kt + 1, r0 + 64, kv);
    }
#pragma unroll
    for (int ks = 0; ks < 2; ++ks) {
      bf16x8 af[2], bq[2];
#pragma unroll
      for (int i = 0; i < 2; ++i) af[i] = *(const bf16x8*)&s->a[buf][wr * 64 + i * 32 + fr][ks * 16 + fh * 8];
#pragma unroll
      for (int j = 0; j < 2; ++j) bq[j] = *(const bf16x8*)&s->b[buf][wc * 64 + j * 32 + fr][ks * 16 + fh * 8];
#pragma unroll
      for (int i = 0; i < 2; ++i)
#pragma unroll
        for (int j = 0; j < 2; ++j) acc[i][j] = MFMA(af[i], bq[j], acc[i][j]);
    }
    if (kt + 1 < nk) {
      *(uint4*)&s->a[buf ^ 1][r0][kv * 8] = ra0; *(uint4*)&s->a[buf ^ 1][r0 + 64][kv * 8] = ra1;
      *(uint4*)&s->b[buf ^ 1][r0][kv * 8] = rb0; *(uint4*)&s->b[buf ^ 1][r0 + 64][kv * 8] = rb1;
    }
    __syncthreads();
  }
}


struct GemmS2 { bf16_t a[128][72]; bf16_t b[128][72]; };
DI void g2_compute(f32x16 (&acc)[2][2], const GemmS2* s, int wr, int wc, int fr, int fh) {
#pragma unroll
  for (int ks = 0; ks < 4; ++ks) {
    bf16x8 af[2], bq[2];
#pragma unroll
    for (int i = 0; i < 2; ++i) af[i] = *(const bf16x8*)&s->a[wr * 64 + i * 32 + fr][ks * 16 + fh * 8];
#pragma unroll
    for (int j = 0; j < 2; ++j) bq[j] = *(const bf16x8*)&s->b[wc * 64 + j * 32 + fr][ks * 16 + fh * 8];
#pragma unroll
    for (int i = 0; i < 2; ++i)
#pragma unroll
      for (int j = 0; j < 2; ++j) acc[i][j] = MFMA(af[i], bq[j], acc[i][j]);
  }
}

template <class AF, class BF, class HK>
DI void gemm_core2(f32x16 (&acc)[2][2], GemmS2* s, AF aptr, BF bptr, int nk, HK hook) {
  int tid = threadIdx.x; asm volatile("" : "+v"(tid));
  const int lane = tid & 63, wave = tid >> 6, wr = wave >> 1, wc = wave & 1;
  const int r0 = tid >> 3, kc = tid & 7;
  const int fr = lane & 31, fh = lane >> 5;
  uint4 p0a0, p0a1, p0a2, p0a3, p0b0, p0b1, p0b2, p0b3, p1a0, p1a1, p1a2, p1a3, p1b0, p1b1, p1b2, p1b3;
#define G2_LOAD(S, KT) { \
    S##a0 = *(const uint4*)aptr((KT), r0, kc);      S##b0 = *(const uint4*)bptr((KT), r0, kc); \
    S##a1 = *(const uint4*)aptr((KT), r0 + 32, kc); S##b1 = *(const uint4*)bptr((KT), r0 + 32, kc); \
    S##a2 = *(const uint4*)aptr((KT), r0 + 64, kc); S##b2 = *(const uint4*)bptr((KT), r0 + 64, kc); \
    S##a3 = *(const uint4*)aptr((KT), r0 + 96, kc); S##b3 = *(const uint4*)bptr((KT), r0 + 96, kc); }
#define G2_STORE(S) { \
    *(uint4*)&s->a[r0][kc * 8] = S##a0;      *(uint4*)&s->b[r0][kc * 8] = S##b0; \
    *(uint4*)&s->a[r0 + 32][kc * 8] = S##a1; *(uint4*)&s->b[r0 + 32][kc * 8] = S##b1; \
    *(uint4*)&s->a[r0 + 64][kc * 8] = S##a2; *(uint4*)&s->b[r0 + 64][kc * 8] = S##b2; \
    *(uint4*)&s->a[r0 + 96][kc * 8] = S##a3; *(uint4*)&s->b[r0 + 96][kc * 8] = S##b3; }
#define G2_COMPUTE() g2_compute(acc, s, wr, wc, fr, fh);
  G2_LOAD(p0, 0)
  G2_LOAD(p1, 1)
  G2_STORE(p0)
  if (nk > 2) G2_LOAD(p0, 2)
  __syncthreads();
#pragma unroll 1
  for (int kt = 0; kt < nk; kt += 2) {
    hook(kt);
    G2_COMPUTE()
    __syncthreads();
    G2_STORE(p1)
    if (kt + 3 < nk) G2_LOAD(p1, kt + 3)
    __syncthreads();
    hook(kt + 1);
    G2_COMPUTE()
    __syncthreads();
    if (kt + 2 < nk) {
      G2_STORE(p0)
      if (kt + 4 < nk) G2_LOAD(p0, kt + 4)
    }
    __syncthreads();
  }
#undef G2_LOAD
#undef G2_STORE
#undef G2_COMPUTE
}


struct GemmS3 { bf16_t a[128][72]; bf16_t b[256][72]; };

template <class AF, class BF, class HK>
DI void gemm_core3(f32x16 (&acc)[2][4], GemmS3* s, AF aptr, BF bptr, int nk, HK hook) {
  int tid = threadIdx.x; asm volatile("" : "+v"(tid));
  const int lane = tid & 63, wave = tid >> 6, wr = wave >> 1, wc = wave & 1;
  const int r0 = tid >> 3, kc = tid & 7;
  const int fr = lane & 31, fh = lane >> 5;
  uint4 a0, a1, a2, a3, b0, b1, b2, b3, b4, b5, b6, b7;
#define G3_LOAD(KT) { \
    a0 = *(const uint4*)aptr((KT), r0, kc);       a1 = *(const uint4*)aptr((KT), r0 + 32, kc); \
    a2 = *(const uint4*)aptr((KT), r0 + 64, kc);  a3 = *(const uint4*)aptr((KT), r0 + 96, kc); \
    b0 = *(const uint4*)bptr((KT), r0, kc);       b1 = *(const uint4*)bptr((KT), r0 + 32, kc); \
    b2 = *(const uint4*)bptr((KT), r0 + 64, kc);  b3 = *(const uint4*)bptr((KT), r0 + 96, kc); \
    b4 = *(const uint4*)bptr((KT), r0 + 128, kc); b5 = *(const uint4*)bptr((KT), r0 + 160, kc); \
    b6 = *(const uint4*)bptr((KT), r0 + 192, kc); b7 = *(const uint4*)bptr((KT), r0 + 224, kc); }
#define G3_STORE() { \
    *(uint4*)&s->a[r0][kc * 8] = a0;       *(uint4*)&s->a[r0 + 32][kc * 8] = a1; \
    *(uint4*)&s->a[r0 + 64][kc * 8] = a2;  *(uint4*)&s->a[r0 + 96][kc * 8] = a3; \
    *(uint4*)&s->b[r0][kc * 8] = b0;       *(uint4*)&s->b[r0 + 32][kc * 8] = b1; \
    *(uint4*)&s->b[r0 + 64][kc * 8] = b2;  *(uint4*)&s->b[r0 + 96][kc * 8] = b3; \
    *(uint4*)&s->b[r0 + 128][kc * 8] = b4; *(uint4*)&s->b[r0 + 160][kc * 8] = b5; \
    *(uint4*)&s->b[r0 + 192][kc * 8] = b6; *(uint4*)&s->b[r0 + 224][kc * 8] = b7; }
  G3_LOAD(0)
  G3_STORE()
  __syncthreads();
#pragma unroll 1
  for (int kt = 0; kt < nk; ++kt) {
    if (kt + 1 < nk) G3_LOAD(kt + 1)
    hook(kt);
#pragma unroll
    for (int ks = 0; ks < 4; ++ks) {
      bf16x8 af[2], bq[4];
#pragma unroll
      for (int i = 0; i < 2; ++i) af[i] = *(const bf16x8*)&s->a[wr * 64 + i * 32 + fr][ks * 16 + fh * 8];
#pragma unroll
      for (int j = 0; j < 4; ++j) bq[j] = *(const bf16x8*)&s->b[wc * 128 + j * 32 + fr][ks * 16 + fh * 8];
#pragma unroll
      for (int i = 0; i < 2; ++i)
#pragma unroll
        for (int j = 0; j < 4; ++j) acc[i][j] = MFMA(af[i], bq[j], acc[i][j]);
    }
    __syncthreads();
    if (kt + 1 < nk) G3_STORE()
    __syncthreads();
  }
#undef G3_LOAD
#undef G3_STORE
}

template <class EPI>
DI void epilogue_lds2(f32x16 (&acc)[2][4], char* smem, int sub, EPI epi) {
  float* T = (float*)smem;
  int tid = threadIdx.x; asm volatile("" : "+v"(tid));
  const int lane = tid & 63, wave = tid >> 6, wr = wave >> 1, wc = wave & 1, fr = lane & 31, fh = lane >> 5;
#pragma unroll
  for (int i = 0; i < 2; ++i) {
    if (wc == sub) {
#pragma unroll
      for (int j = 0; j < 4; ++j)
#pragma unroll
        for (int r = 0; r < 16; ++r) T[(wr * 32 + crow(r, fh)) * 132 + j * 32 + fr] = acc[i][j][r];
    }
    __syncthreads();
#pragma unroll 2
    for (int e = tid; e < 2048; e += 256) {
      const int tr = e >> 5, c4 = (e & 31) * 4;
      const float4 v = *(const float4*)&T[tr * 132 + c4];
      epi((tr >> 5) * 64 + i * 32 + (tr & 31), c4, v);
    }
    __syncthreads();
  }
}

DI void epilogue_rope(f32x16 (&acc)[2][4], char* smem, int sub, bf16_t* dst, int ld, int cb, int row0, float sc) {
  float* T = (float*)smem;
  int tid = threadIdx.x; asm volatile("" : "+v"(tid));
  const int lane = tid & 63, wave = tid >> 6, wr = wave >> 1, wc = wave & 1, fr = lane & 31, fh = lane >> 5;
#pragma unroll
  for (int i = 0; i < 2; ++i) {
    if (wc == sub) {
#pragma unroll
      for (int j = 0; j < 4; ++j)
#pragma unroll
        for (int r = 0; r < 16; ++r) T[(wr * 32 + crow(r, fh)) * 132 + j * 32 + fr] = acc[i][j][r];
    }
    __syncthreads();
#pragma unroll 1
    for (int e = tid; e < 1024; e += 256) {
      const int tr = e >> 4, qi = e & 15;
      const int hd = qi >> 3, ax = (qi >> 2) & 1, f0 = (qi & 3) * 4;
      const int col1 = hd * 64 + ax * 32 + f0;
      const float4 v1 = *(const float4*)&T[tr * 132 + col1];
      const float4 v2 = *(const float4*)&T[tr * 132 + col1 + 16];
      const int rho = row0 + (tr >> 5) * 64 + i * 32 + (tr & 31);
      float a1[4] = {v1.x, v1.y, v1.z, v1.w}, a2[4] = {v2.x, v2.y, v2.z, v2.w}, o1[4], o2[4];
      if (rho < RL_) {
        const int t = rho & 4095;
        const float pos = (float)(ax == 0 ? (t >> 6) : (t & 63));
#pragma unroll
        for (int u = 0; u < 4; ++u) {
          const float ang = pos * exp2f(-(float)(f0 + u) * 0.8304820237218406f);
          const float cs = __cosf(ang), sn = __sinf(ang);
          o1[u] = (a1[u] * cs - a2[u] * sn) * sc;
          o2[u] = (a2[u] * cs + a1[u] * sn) * sc;
        }
      } else {
#pragma unroll
        for (int u = 0; u < 4; ++u) { o1[u] = a1[u] * sc; o2[u] = a2[u] * sc; }
      }
      uint2 w1, w2;
      w1.x = pack2(o1[0], o1[1]); w1.y = pack2(o1[2], o1[3]);
      w2.x = pack2(o2[0], o2[1]); w2.y = pack2(o2[2], o2[3]);
      bf16_t* dp = dst + (size_t)rho * ld + cb + col1;
      *(uint2*)dp = w1;
      *(uint2*)(dp + 16) = w2;
    }
    __syncthreads();
  }
}

DI bool xcd_tile(int step, int nM, int nN, int& mt, int& nt) {
  const int xcd = blockIdx.x & 7, nloc = gridDim.x >> 3;
  const int j = (blockIdx.x >> 3) + step * nloc;
  const int mloc = nM >> 3;
  if ((gridDim.x & 7) != 0 || j >= mloc * nN) return false;
  const int per = 8 * nN;
  const int gm = j / per, rem = j - gm * per;
  const int hgt = min(8, mloc - gm * 8);
  const int a = rem % hgt;
  nt = rem / hgt;
  mt = (gm * 8 + a) * 8 + xcd;
  return true;
}

DI void zero_acc(f32x16 (&acc)[2][2]) {
#pragma unroll
  for (int i = 0; i < 2; ++i)
#pragma unroll
    for (int j = 0; j < 2; ++j)
#pragma unroll
      for (int r = 0; r < 16; ++r) acc[i][j][r] = 0.f;
}

template <class EPI>
DI void epilogue_lds(f32x16 (&acc)[2][2], char* smem, EPI epi) {
  float* T = (float*)smem;
  int tid = threadIdx.x; asm volatile("" : "+v"(tid)); const int lane = tid & 63, wave = tid >> 6, wr = wave >> 1, wc = wave & 1, fr = lane & 31, fh = lane >> 5;
#pragma unroll
  for (int i = 0; i < 2; ++i) {
#pragma unroll
    for (int j = 0; j < 2; ++j)
#pragma unroll
      for (int r = 0; r < 16; ++r) T[(wr * 32 + crow(r, fh)) * 132 + wc * 64 + j * 32 + fr] = acc[i][j][r];
    __syncthreads();
#pragma unroll 2
    for (int e = tid; e < 2048; e += 256) {
      const int tr = e >> 5, c4 = (e & 31) * 4;
      const float4 v = *(const float4*)&T[tr * 132 + c4];
      epi((tr >> 5) * 64 + i * 32 + (tr & 31), c4, v);
    }
    __syncthreads();
  }
}

DI void phase_mods(const Params& p_in, char* smem) {
  const Params p = load_params();

  float* ssc = (float*)smem;
  float* red = (float*)(smem + 20480);
  float* mods = (float*)(p.ws + OFF_MODS);
  int tid = threadIdx.x; asm volatile("" : "+v"(tid));
  for (int it = blockIdx.x; it < 192; it += gridDim.x) {
    const int l = it / 96, col0 = (it % 96) * 32;
    __syncthreads();
    for (int e = tid; e < 5120; e += 256) {
      const int v = e >> 10, k = e & 1023;
      const float cv = (v < 4) ? p.c[v * 1024 + k] : p.c_ctx[k];
      ssc[e] = silu_f(cv);
    }
    __syncthreads();
    const int col = tid & 31, kg = tid >> 5;
    float a[5] = {0.f, 0.f, 0.f, 0.f, 0.f};
    const float* w = p.w_mod + (size_t)l * 1024 * 3072 + col0 + col;
    for (int k = kg * 128; k < kg * 128 + 128; k += 32) {
      float wv[32];
#pragma unroll
      for (int u = 0; u < 32; ++u) wv[u] = w[(size_t)(k + u) * 3072];
#pragma unroll
      for (int u = 0; u < 32; ++u)
#pragma unroll
        for (int v = 0; v < 5; ++v) a[v] += ssc[v * 1024 + k + u] * wv[u];
    }
#pragma unroll
    for (int v = 0; v < 5; ++v) red[(kg * 5 + v) * 32 + col] = a[v];
    __syncthreads();
    for (int e = tid; e < 160; e += 256) {
      const int v = e >> 5, cc = e & 31;
      float sum = p.b_mod[l * 3072 + col0 + cc];
      for (int g = 0; g < 8; ++g) sum += red[(g * 5 + v) * 32 + cc];
      mods[(l * 5 + v) * 3072 + col0 + cc] = sum;
    }
  }
}

DI int win_colmap(int n) {
  if (n < 2560) return n;
  if (n < 3840) return n + 32;
  if (n < 4864) {
    const int j = n - 3840, q64 = j >> 6, w = j & 63;
    return (w < 32) ? (3872 + q64 * 32 + w) : (3872 + 512 + q64 * 32 + (w - 32));
  }
  if (n < 5376) return n + 32;
  if (n < 5408) return n - 5376 + 2560;
  return -1;
}

DI void transpose_tile(const float* src, int ldsrc, int kind, const float* rowscale, bf16_t* dst, int lddst, int n0, int k0, float* tile) {
  int tid = threadIdx.x; asm volatile("" : "+v"(tid));
  __syncthreads();
  {
    const int c4 = (tid & 15) * 4, rr = tid >> 4;
    const int n = (kind == 0) ? win_colmap(n0 + c4) : (n0 + c4);
#pragma unroll
    for (int ps = 0; ps < 4; ++ps) {
      const int r = rr + ps * 16, k = k0 + r;
      float4 v = make_float4(0.f, 0.f, 0.f, 0.f);
      if (n >= 0) v = *(const float4*)(src + (size_t)k * ldsrc + n);
      if (rowscale != nullptr && k < 1024) { const float s = rowscale[k]; v.x *= s; v.y *= s; v.z *= s; v.w *= s; }
      tile[r * 65 + c4] = v.x; tile[r * 65 + c4 + 1] = v.y; tile[r * 65 + c4 + 2] = v.z; tile[r * 65 + c4 + 3] = v.w;
    }
  }
  __syncthreads();
  {
    const int k8 = (tid & 7) * 8, nn = tid >> 3;
#pragma unroll
    for (int ps = 0; ps < 2; ++ps) {
      const int r = nn + ps * 32;
      uint4 o;
      o.x = pack2(tile[(k8 + 0) * 65 + r], tile[(k8 + 1) * 65 + r]);
      o.y = pack2(tile[(k8 + 2) * 65 + r], tile[(k8 + 3) * 65 + r]);
      o.z = pack2(tile[(k8 + 4) * 65 + r], tile[(k8 + 5) * 65 + r]);
      o.w = pack2(tile[(k8 + 6) * 65 + r], tile[(k8 + 7) * 65 + r]);
      *(uint4*)(dst + (size_t)(n0 + r) * lddst + k0 + k8) = o;
    }
  }
}

DI void phase_prep(const Params& p_in, int l, char* smem) {
  const Params p = load_params();

  int tid = threadIdx.x; asm volatile("" : "+v"(tid)); const int lane = tid & 63, wave = tid >> 6;
  const float* mods = (const float*)(p.ws + OFF_MODS);
  bf16_t* H = (bf16_t*)(p.ws + OFF_H);
  const int NT_WIN = 88 * 16, NT_WOUT = 16 * 32, NT_PW = 64, NT_CONV = NT_WIN + NT_WOUT + NT_PW;
  const int NT = NT_CONV + R_ / 8;
  for (int it = blockIdx.x; it < NT; it += gridDim.x) {
    if (l == 1 && (it < NT_WIN || (it >= NT_WIN + NT_WOUT && it < NT_CONV))) continue;
    if (it < NT_WIN) {
      transpose_tile(p.w_in + (size_t)l * 1024 * 5408, 5408, 0, nullptr, (bf16_t*)(p.ws + OFF_WIN), 1024, (it / 16) * 64, (it % 16) * 64, (float*)smem);
    } else if (it < NT_WIN + NT_WOUT) {
      const int t = it - NT_WIN;
      transpose_tile(p.w_out + (size_t)l * 2048 * 1024, 1024, 1, p.ssd_norm_w + l * 1024, (bf16_t*)(p.ws + OFF_WOUT), 2048, (t / 32) * 64, (t % 32) * 64, (float*)smem);
    } else if (it < NT_CONV) {
      const int t = it - NT_WIN - NT_WOUT;
      transpose_tile(p.conv_pw_w + (size_t)l * 512 * 512, 512, 1, nullptr, (bf16_t*)(p.ws + OFF_PW), 512, (t / 8) * 64, (t % 8) * 64, (float*)smem);
    } else {
      const int rho0 = (it - NT_CONV) * 8 + wave * 2;
      const float* xs0;
      if (l == 0) xs0 = (rho0 < RL_) ? (p.x + (size_t)rho0 * 1024) : (p.ctx + (size_t)(rho0 - RL_) * 1024);
      else xs0 = (rho0 < RL_) ? (p.out + (size_t)rho0 * 1024) : ((const float*)(p.ws + OFF_XC) + (size_t)(rho0 - RL_) * 1024);
      const int v = (rho0 < RL_) ? (rho0 >> 12) : 4;
      const float* md = mods + (l * 5 + v) * 3072;
      float4 xv[2][4], nwv[4], shv[4], scv4[4];
#pragma unroll
      for (int i = 0; i < 4; ++i) {
        const int cidx = lane * 4 + i * 256;
        xv[0][i] = *(const float4*)(xs0 + cidx);
        xv[1][i] = *(const float4*)(xs0 + 1024 + cidx);
        nwv[i] = *(const float4*)(p.norm_w + l * 1024 + cidx);
        shv[i] = *(const float4*)(md + cidx);
        scv4[i] = *(const float4*)(md + 1024 + cidx);
      }
#pragma unroll
      for (int q = 0; q < 2; ++q) {
        float ss = 0.f;
#pragma unroll
        for (int i = 0; i < 4; ++i) ss += xv[q][i].x * xv[q][i].x + xv[q][i].y * xv[q][i].y + xv[q][i].z * xv[q][i].z + xv[q][i].w * xv[q][i].w;
#pragma unroll
        for (int o = 32; o >= 1; o >>= 1) ss += __shfl_xor(ss, o);
        const float rs = rsqrtf(ss * (1.f / 1024.f) + 1e-6f);
#pragma unroll
        for (int i = 0; i < 4; ++i) {
          const int cidx = lane * 4 + i * 256;
          const float4 nw = nwv[i], sh = shv[i], sc = scv4[i];
          uint2 o;
          o.x = pack2(xv[q][i].x * rs * nw.x * (1.f + sc.x) + sh.x, xv[q][i].y * rs * nw.y * (1.f + sc.y) + sh.y);
          o.y = pack2(xv[q][i].z * rs * nw.z * (1.f + sc.z) + sh.z, xv[q][i].w * rs * nw.w * (1.f + sc.w) + sh.w);
          *(uint2*)(H + (size_t)(rho0 + q) * 1024 + cidx) = o;
        }
      }
    }
  }
}

DI void phase_inproj(const Params& p_in, char* smem) {
  const Params p = load_params();
  int tid = threadIdx.x; asm volatile("" : "+v"(tid)); const int wave = tid >> 6, wc = wave & 1;
  const bf16_t* H = (const bf16_t*)(p.ws + OFF_H);
  const bf16_t* W = (const bf16_t*)(p.ws + OFF_WIN);
  for (int step = 0;; ++step) {
    int mt, nt2;
    if (!xcd_tile(step, NCK, 22, mt, nt2)) break;
    f32x16 acc[2][4];
#pragma unroll
    for (int i = 0; i < 2; ++i)
#pragma unroll
      for (int j = 0; j < 4; ++j)
#pragma unroll
        for (int r = 0; r < 16; ++r) acc[i][j][r] = 0.f;
    const bf16_t* Ab = H + (size_t)mt * 128 * 1024;
    const bf16_t* Bb = W + (size_t)nt2 * 256 * 1024;
    gemm_core3(acc, (GemmS3*)smem,
               [&](int kt, int r, int kv) { return Ab + (size_t)r * 1024 + kt * 64 + kv * 8; },
               [&](int kt, int r, int kv) { return Bb + (size_t)r * 1024 + kt * 64 + kv * 8; }, 16, [](int) {});
    const int row0 = mt * 128;
    {
      const int ntw = nt2 * 2 + wc;
      if (ntw >= 30 && ntw < 38) {
#pragma unroll
        for (int i = 0; i < 2; ++i)
#pragma unroll
          for (int r = 0; r < 16; ++r) {
            acc[i][0][r] = acc[i][0][r] * sigmoid_f(acc[i][1][r]);
            acc[i][2][r] = acc[i][2][r] * sigmoid_f(acc[i][3][r]);
          }
      }
    }
#pragma unroll 1
    for (int sub = 0; sub < 2; ++sub) {
      const int nt = nt2 * 2 + sub;
      if (nt >= 43) break;
      if (nt >= 30 && nt < 38) {
        bf16_t* G = (bf16_t*)(p.ws + OFF_GLU);
        const int cb0 = (nt - 30) * 64;
        epilogue_lds2(acc, smem, sub, [&](int rl, int c4, float4 v) {
          if ((c4 & 32) == 0) {
            uint2 o; o.x = pack2(v.x, v.y); o.y = pack2(v.z, v.w);
            *(uint2*)(G + (size_t)(row0 + rl) * 512 + cb0 + (c4 >> 6) * 32 + (c4 & 31)) = o;
          }
        });
      } else if (nt >= 20 && nt < 24) {
        epilogue_rope(acc, smem, sub, (bf16_t*)(p.ws + OFF_Q), 512, nt * 128 - 2560, row0, 0.18033688011112042f);
      } else if (nt == 24) {
        epilogue_rope(acc, smem, sub, (bf16_t*)(p.ws + OFF_KV), 256, 0, row0, 1.f);
      } else if (nt == 42) {
        float* DT = (float*)(p.ws + OFF_DT);
        epilogue_lds2(acc, smem, sub, [&](int rl, int c4, float4 v) {
          if (c4 < 32) *(float4*)(DT + (size_t)(row0 + rl) * 32 + c4) = v;
        });
      } else {
        bf16_t* dst; int ld, cb;
        if (nt < 12) { dst = (bf16_t*)(p.ws + OFF_XBC); ld = 1536; cb = nt * 128; }
        else if (nt < 20) { dst = (bf16_t*)(p.ws + OFF_Z); ld = 1024; cb = nt * 128 - 1536; }
        else if (nt < 24) { dst = (bf16_t*)(p.ws + OFF_Q); ld = 512; cb = nt * 128 - 2560; }
        else if (nt < 26) { dst = (bf16_t*)(p.ws + OFF_KV); ld = 256; cb = nt * 128 - 3072; }
        else if (nt < 30) { dst = (bf16_t*)(p.ws + OFF_AG); ld = 512; cb = nt * 128 - 3328; }
        else { dst = (bf16_t*)(p.ws + OFF_CG); ld = 512; cb = nt * 128 - 4864; }
        epilogue_lds2(acc, smem, sub, [&](int rl, int c4, float4 v) {
          uint2 o; o.x = pack2(v.x, v.y); o.y = pack2(v.z, v.w);
          *(uint2*)(dst + (size_t)(row0 + rl) * ld + cb + c4) = o;
        });
      }
    }
  }
}

DI void phase_local(const Params& p_in, int l, char* smem) {
  const Params p = load_params();

  int tid = threadIdx.x; asm volatile("" : "+v"(tid)); const int lane = tid & 63;
  const bf16_t* XBC = (const bf16_t*)(p.ws + OFF_XBC);
  bf16_t* XS = (bf16_t*)(p.ws + OFF_H);
  bf16_t* BC = (bf16_t*)(p.ws + OFF_BC);
  float* DT = (float*)(p.ws + OFF_DT);
  float* CS = (float*)(p.ws + OFF_CS);
  const bf16_t* GLU = (const bf16_t*)(p.ws + OFF_GLU);
  bf16_t* HDN = (bf16_t*)(p.ws + OFF_HDN);
  bf16_t* Q = (bf16_t*)(p.ws + OFF_Q);
  bf16_t* KV = (bf16_t*)(p.ws + OFF_KV);
  { float* SSQ = (float*)(p.ws + OFF_RSTD); for (int i = blockIdx.x * 256 + tid; i < R_ * 2; i += gridDim.x * 256) SSQ[i] = 0.f; }
  const int N_CONV = (R_ / 4) * 192 / 256;
  const int N_DT = NCK;
  const int N_CF = R_ / 16;
  const int N_ROPE = 0;
  const int N_QC = 0;
  const int NT = N_CF + N_DT + N_CONV + N_ROPE + N_QC;
  for (int it0 = blockIdx.x; it0 < NT; it0 += gridDim.x) {
    int it = it0;
    if (it < N_CF) {
      float* sst = (float*)smem;
      unsigned* sIn = (unsigned*)(smem + 256);
      const int row0 = it * 16;
      const int seq0 = (row0 < RL_) ? (row0 & ~4095) : (RL_ + ((row0 - RL_) & ~255));
      const int slen = (row0 < RL_) ? 4096 : 256;
      const int t0 = row0 - seq0;
      const int c0 = tid * 2;
      __syncthreads();
      if (tid < 32) sst[tid] = 0.f;
      for (int idx = tid; idx < 46 * 64; idx += 256) {
        const int rr = idx >> 6, c16 = idx & 63;
        const int tt = t0 - 15 + rr;
        uint4 val = make_uint4(0u, 0u, 0u, 0u);
        if (tt >= 0 && tt < slen) val = *(const uint4*)(GLU + (size_t)(seq0 + tt) * 512 + c16 * 8);
        *(uint4*)&sIn[rr * 256 + c16 * 4] = val;
      }
      float w0[31], w1[31];
#pragma unroll
      for (int k = 0; k < 31; ++k) {
        const float2 wv = *(const float2*)(p.conv_dw_w + ((size_t)l * 31 + k) * 512 + c0);
        w0[k] = wv.x; w1[k] = wv.y;
      }
      const float2 bv = *(const float2*)(p.conv_dw_b + l * 512 + c0);
      float a0[16], a1[16];
#pragma unroll
      for (int r = 0; r < 16; ++r) { a0[r] = bv.x; a1[r] = bv.y; }
      __syncthreads();
#pragma unroll
      for (int tp = 0; tp < 46; ++tp) {
        const unsigned u = sIn[tp * 256 + tid];
        const float x0 = lo2f(u), x1 = hi2f(u);
#pragma unroll
        for (int r = 0; r < 16; ++r) {
          const int k = tp - r;
          if (k >= 0 && k < 31) { a0[r] += w0[k] * x0; a1[r] += w1[k] * x1; }
        }
        if ((tp & 7) == 7) __builtin_amdgcn_sched_barrier(0);
      }
      {
        float v[32];
#pragma unroll
        for (int r = 0; r < 16; ++r) { v[2 * r] = a0[r] + a1[r]; v[2 * r + 1] = a0[r] * a0[r] + a1[r] * a1[r]; }
#pragma unroll
        for (int i = 0; i < 16; ++i) { const bool up = (lane & 32) != 0; const float keep = up ? v[i + 16] : v[i]; const float send = up ? v[i] : v[i + 16]; v[i] = keep + __shfl_xor(send, 32); }
#pragma unroll
        for (int i = 0; i < 8; ++i) { const bool up = (lane & 16) != 0; const float keep = up ? v[i + 8] : v[i]; const float send = up ? v[i] : v[i + 8]; v[i] = keep + __shfl_xor(send, 16); }
#pragma unroll
        for (int i = 0; i < 4; ++i) { const bool up = (lane & 8) != 0; const float keep = up ? v[i + 4] : v[i]; const float send = up ? v[i] : v[i + 4]; v[i] = keep + __shfl_xor(send, 8); }
#pragma unroll
        for (int i = 0; i < 2; ++i) { const bool up = (lane & 4) != 0; const float keep = up ? v[i + 2] : v[i]; const float send = up ? v[i] : v[i + 2]; v[i] = keep + __shfl_xor(send, 4); }
        { const bool up = (lane & 2) != 0; const float keep = up ? v[1] : v[0]; const float send = up ? v[0] : v[1]; v[0] = keep + __shfl_xor(send, 2); }
        v[0] += __shfl_xor(v[0], 1);
        __syncthreads();
        if ((lane & 1) == 0) atomicAdd(&sst[lane >> 1], v[0]);
      }
      __syncthreads();
      const float2 lw = *(const float2*)(p.conv_ln_w + l * 512 + c0);
      const float2 lb = *(const float2*)(p.conv_ln_b + l * 512 + c0);
#pragma unroll
      for (int r = 0; r < 16; ++r) {
        const float mean = sst[r * 2] * (1.f / 512.f);
        const float var = fmaxf(sst[r * 2 + 1] * (1.f / 512.f) - mean * mean, 0.f);
        const float rs = rsqrtf(var + 1e-6f);
        const float y0 = (a0[r] - mean) * rs * lw.x + lb.x;
        const float y1 = (a1[r] - mean) * rs * lw.y + lb.y;
        *(unsigned*)(HDN + (size_t)(row0 + r) * 512 + c0) = pack2(silu_f(y0), silu_f(y1));
        if ((r & 3) == 3) __builtin_amdgcn_sched_barrier(0);
      }
      continue;
    }
    it -= N_CF;
    if (it < N_DT) {
      float* sdt = (float*)smem;
      float* ssum = (float*)(smem + 128 * 33 * 4);
      const int row0 = it * 128;
      __syncthreads();
      for (int e = tid; e < 4096; e += 256) {
        const int r = e >> 5, cidx = e & 31;
        const float raw = DT[(size_t)(row0 + r) * 32 + cidx] + p.ssd_dt_bias[l * 32 + cidx];
        const float sp = (raw > 20.f) ? raw : log1pf(expf(raw));
        DT[(size_t)(row0 + r) * 32 + cidx] = sp;
        sdt[r * 33 + cidx] = sp;
      }
      __syncthreads();
      const int col = tid & 31, seg = tid >> 5;
      const float a = -expf(p.ssd_a_log[l * 32 + col]);
      float loc[16];
      float run = 0.f;
      if (col < 16) {
#pragma unroll
        for (int r = 0; r < 16; ++r) { run += sdt[(seg * 16 + r) * 33 + col] * a; loc[r] = run; }
      } else {
#pragma unroll
        for (int r = 15; r >= 0; --r) { run += sdt[(seg * 16 + r) * 33 + col] * a; loc[r] = run; }
      }
      ssum[seg * 32 + col] = run;
      __syncthreads();
      float off = 0.f;
      if (col < 16) { for (int s2 = 0; s2 < seg; ++s2) off += ssum[s2 * 32 + col]; }
      else { for (int s2 = 7; s2 > seg; --s2) off += ssum[s2 * 32 + col]; }
#pragma unroll
      for (int r = 0; r < 16; ++r) CS[(size_t)(row0 + seg * 16 + r) * 32 + col] = off + loc[r];
      continue;
    }
    it -= N_DT;
    if (it < N_CONV) {
      const int e = it * 256 + tid;
      const int rb = e / 192, cgp = e % 192, ch0 = cgp * 8;
      const int rho0 = rb * 4;
      const int seq0 = (rho0 < RL_) ? (rho0 & ~4095) : (RL_ + ((rho0 - RL_) & ~255));
      const int slen = (rho0 < RL_) ? 4096 : 256;
      const int t0 = rho0 - seq0;
      uint4 xr[8];
#pragma unroll
      for (int i = 0; i < 8; ++i) {
        const int tt = t0 + i - 2;
        xr[i] = make_uint4(0u, 0u, 0u, 0u);
        if (tt >= 0 && tt < slen) xr[i] = *(const uint4*)(XBC + (size_t)(seq0 + tt) * 1536 + ch0);
      }
      float wk[5][8];
#pragma unroll
      for (int k = 0; k < 5; ++k) {
        const float4 w0 = *(const float4*)(p.ssd_conv_w + ((size_t)l * 5 + k) * 1536 + ch0);
        const float4 w1 = *(const float4*)(p.ssd_conv_w + ((size_t)l * 5 + k) * 1536 + ch0 + 4);
        wk[k][0] = w0.x; wk[k][1] = w0.y; wk[k][2] = w0.z; wk[k][3] = w0.w; wk[k][4] = w1.x; wk[k][5] = w1.y; wk[k][6] = w1.z; wk[k][7] = w1.w;
      }
      float bias[8];
      {
        const float4 b0 = *(const float4*)(p.ssd_conv_b + l * 1536 + ch0);
        const float4 b1 = *(const float4*)(p.ssd_conv_b + l * 1536 + ch0 + 4);
        bias[0] = b0.x; bias[1] = b0.y; bias[2] = b0.z; bias[3] = b0.w; bias[4] = b1.x; bias[5] = b1.y; bias[6] = b1.z; bias[7] = b1.w;
      }
#pragma unroll
      for (int r = 0; r < 4; ++r) {
        float a[8];
#pragma unroll
        for (int c = 0; c < 8; ++c) a[c] = bias[c];
#pragma unroll
        for (int k = 0; k < 5; ++k) {
          const uint4 u = xr[r + k];
          a[0] += wk[k][0] * lo2f(u.x); a[1] += wk[k][1] * hi2f(u.x); a[2] += wk[k][2] * lo2f(u.y); a[3] += wk[k][3] * hi2f(u.y);
          a[4] += wk[k][4] * lo2f(u.z); a[5] += wk[k][5] * hi2f(u.z); a[6] += wk[k][6] * lo2f(u.w); a[7] += wk[k][7] * hi2f(u.w);
        }
        uint4 o;
        o.x = pack2(silu_f(a[0]), silu_f(a[1])); o.y = pack2(silu_f(a[2]), silu_f(a[3]));
        o.z = pack2(silu_f(a[4]), silu_f(a[5])); o.w = pack2(silu_f(a[6]), silu_f(a[7]));
        const size_t rho = (size_t)(rho0 + r);
        if (ch0 < 1024) *(uint4*)(XS + rho * 1024 + ch0) = o;
        else *(uint4*)(BC + rho * 512 + (ch0 - 1024)) = o;
      }
      continue;
    }
    it -= N_CONV;
    if (it < N_ROPE) {
      const int e = it * 256 + tid;
      const int rho = e / 40, rem = e % 40, hd = rem >> 2, sub = rem & 3;
      const int axis = sub >> 1, half = sub & 1;
      const int t = rho & 4095;
      const float pos = (float)(axis == 0 ? (t >> 6) : (t & 63));
      bf16_t* base = ((hd < 8) ? (Q + (size_t)rho * 512 + hd * 64) : (KV + (size_t)rho * 256 + (hd - 8) * 64)) + axis * 32 + half * 8;
      const float sc = (hd < 8) ? 0.18033688011112042f : 1.f;
      const uint4 u1 = *(const uint4*)base, u2 = *(const uint4*)(base + 16);
      const unsigned a1[4] = {u1.x, u1.y, u1.z, u1.w}, a2[4] = {u2.x, u2.y, u2.z, u2.w};
      unsigned o1[4], o2[4];
#pragma unroll
      for (int i = 0; i < 4; ++i) {
        float r1[2], r2[2];
#pragma unroll
        for (int hl = 0; hl < 2; ++hl) {
          const float f = (float)(half * 8 + 2 * i + hl);
          const float ang = pos * exp2f(-f * 0.8304820237218406f);
          const float cs = __cosf(ang), sn = __sinf(ang);
          const float t1 = hl ? hi2f(a1[i]) : lo2f(a1[i]);
          const float t2 = hl ? hi2f(a2[i]) : lo2f(a2[i]);
          r1[hl] = (t1 * cs - t2 * sn) * sc;
          r2[hl] = (t2 * cs + t1 * sn) * sc;
        }
        o1[i] = pack2(r1[0], r1[1]); o2[i] = pack2(r2[0], r2[1]);
      }
      *(uint4*)base = make_uint4(o1[0], o1[1], o1[2], o1[3]);
      *(uint4*)(base + 16) = make_uint4(o2[0], o2[1], o2[2], o2[3]);
      continue;
    }
    it -= N_ROPE;
    {
      const int e = it * 256 + tid;
      const int rho = RL_ + e / 256, c2 = (e % 256) * 2;
      unsigned* ptr = (unsigned*)(Q + (size_t)rho * 512 + c2);
      const unsigned u = *ptr;
      *ptr = pack2(lo2f(u) * 0.18033688011112042f, hi2f(u) * 0.18033688011112042f);
    }
  }
}

DI void attn_item(const Params& p_in, int l, char* smem, int b, int qblk, int g, int hp, bool ctxq) {
  const Params p = load_params();

  bf16_t* sK = (bf16_t*)smem;
  bf16_t* sV = (bf16_t*)(smem + 128 * 72 * 2);
  int tid = threadIdx.x; asm volatile("" : "+v"(tid)); const int lane = tid & 63, wave = tid >> 6, fr = lane & 31, fh = lane >> 5;
  const int head = g * 4 + hp * 2 + (wave >> 1);
  const int qh = wave & 1;
  const int qrow0 = (ctxq ? (RL_ + b * 256) : (b * 4096)) + qblk * 128 + qh * 64;
  const int qpos0 = qblk * 128 + qh * 64;
  bf16_t* Q = (bf16_t*)(p.ws + OFF_Q);
  const bf16_t* KV = (const bf16_t*)(p.ws + OFF_KV);
  const bf16_t* AG = (const bf16_t*)(p.ws + OFF_AG);
  f32x16 o[2][2];
  zero_acc(o);
  float m[2], lsum[2];
  m[0] = m[1] = p.attn_sink[l * 8 + head] * 1.4426950408889634f;
  lsum[0] = lsum[1] = 1.f;
  const int nhb = ctxq ? 4 : 10;
  auto hb_row = [&](int hb) -> int {
    if (hb >= nhb) return -1;
    if (hb < 4) return RL_ + b * 256 + hb * 64;
    const int kp = (qblk - 1) * 128 + (hb - 4) * 64;
    if (kp < 0 || kp >= 4096) return -1;
    return b * 4096 + kp;
  };
  auto hb_next = [&](int hb) -> int { int n = hb + 1; while (n < nhb && hb_row(n) < 0) ++n; return n; };
  const int sr = tid >> 3, scv = tid & 7;
  uint4 kp0, kp1, vp0, vp1;
#define ATT_PREFETCH(ROW0) { const bf16_t* kvp = KV + (size_t)((ROW0) + sr) * 256 + g * 64 + scv * 8; \
    kp0 = *(const uint4*)(kvp); kp1 = *(const uint4*)(kvp + 32 * 256); vp0 = *(const uint4*)(kvp + 128); vp1 = *(const uint4*)(kvp + 128 + 32 * 256); }
#define ATT_STORE(BUF) { bf16_t* k_ = sK + (BUF) * 64 * 72; bf16_t* v_ = sV + (BUF) * 64 * 72; \
    *(uint4*)&k_[sr * 72 + scv * 8] = kp0; *(uint4*)&k_[(sr + 32) * 72 + scv * 8] = kp1; \
    *(uint4*)&v_[sr * 72 + scv * 8] = vp0; *(uint4*)&v_[(sr + 32) * 72 + scv * 8] = vp1; }
  int pbuf = 0;
  __syncthreads();
  ATT_PREFETCH(hb_row(0))
  ATT_STORE(0)
  __syncthreads();
  for (int hb = 0; hb < nhb; hb = hb_next(hb)) {
    const int nxt = hb_next(hb);
    if (nxt < nhb) ATT_PREFETCH(hb_row(nxt))
    int kpos0 = 0;
    bool masked = false;
    if (hb >= 4) { kpos0 = (qblk - 1) * 128 + (hb - 4) * 64; masked = (hb != 6 && hb != 7); }
    const bf16_t* cK = sK + pbuf * 64 * 72;
    const bf16_t* cV = sV + pbuf * 64 * 72;
    bf16x8 qf[2][4];
#pragma unroll
    for (int j = 0; j < 2; ++j)
#pragma unroll
      for (int ks = 0; ks < 4; ++ks)
        qf[j][ks] = *(const bf16x8*)(Q + (size_t)(qrow0 + j * 32 + fr) * 512 + head * 64 + ks * 16 + fh * 8);
#pragma unroll 1
    for (int kb = 0; kb < 2; ++kb) {
      if (masked) {
        const int klo = kpos0 + kb * 32, khi = klo + 31;
        if (klo - (qpos0 + 63) > 128 || qpos0 - khi > 128) continue;
      }
      bf16x8 pb[2][2];
#pragma unroll
      for (int j = 0; j < 2; ++j) {
        f32x16 st[2];
#pragma unroll
        for (int r = 0; r < 16; ++r) st[j][r] = -m[j];
#pragma unroll
        for (int ks = 0; ks < 4; ++ks) {
          const bf16x8 kf = *(const bf16x8*)&cK[(kb * 32 + fr) * 72 + ks * 16 + fh * 8];
          st[j] = MFMA(kf, qf[j][ks], st[j]);
        }
        if (masked) {
          const int qpos = qpos0 + j * 32 + fr;
#pragma unroll
          for (int r = 0; r < 16; ++r) {
            const int d = qpos - (kpos0 + kb * 32 + crow(r, fh));
            if (d > 128 || d < -128) st[j][r] = -1e30f;
          }
        }
        float mx = st[j][0];
#pragma unroll
        for (int r = 1; r < 16; ++r) mx = fmaxf(mx, st[j][r]);
        mx = fmaxf(mx, __shfl_xor(mx, 32));
        const bool grow = mx > 8.f;
        if (__builtin_amdgcn_ballot_w64(grow) != 0ull) {
          const float delta = grow ? mx : 0.f;
          const float alpha = __builtin_amdgcn_exp2f(-delta);
#pragma unroll
          for (int r = 0; r < 16; ++r) st[j][r] -= delta;
          lsum[j] *= alpha;
          m[j] += delta;
#pragma unroll
          for (int mt = 0; mt < 2; ++mt)
#pragma unroll
            for (int r = 0; r < 16; ++r) o[mt][j][r] *= alpha;
        }
        float rs = 0.f;
#pragma unroll
        for (int r = 0; r < 16; ++r) { const float pv = __builtin_amdgcn_exp2f(st[j][r]); st[j][r] = pv; rs += pv; }
        rs += __shfl_xor(rs, 32);
        lsum[j] += rs;
#pragma unroll
        for (int s = 0; s < 2; ++s) {
          uint4 pk;
          pk.x = pack2(st[j][8 * s + 0], st[j][8 * s + 1]); pk.y = pack2(st[j][8 * s + 2], st[j][8 * s + 3]);
          pk.z = pack2(st[j][8 * s + 4], st[j][8 * s + 5]); pk.w = pack2(st[j][8 * s + 6], st[j][8 * s + 7]);
          pb[j][s] = __builtin_bit_cast(bf16x8, pk);
        }
      }
#pragma unroll
      for (int s = 0; s < 2; ++s)
#pragma unroll
        for (int mt = 0; mt < 2; ++mt) {
          const bf16x8 vf = tr_frag(cV, 72, kb * 32 + 16 * s + 4 * fh, kb * 32 + 16 * s + 8 + 4 * fh, mt * 32);
#pragma unroll
          for (int j = 0; j < 2; ++j) o[mt][j] = MFMA(vf, pb[j][s], o[mt][j]);
        }
    }
    if (nxt < nhb) ATT_STORE(pbuf ^ 1)
    pbuf ^= 1;
    __syncthreads();
  }
#undef ATT_PREFETCH
#undef ATT_STORE
#pragma unroll
  for (int j = 0; j < 2; ++j) {
    const float inv = 1.f / lsum[j];
    const size_t rho = (size_t)(qrow0 + j * 32 + fr);
#pragma unroll
    for (int mt = 0; mt < 2; ++mt)
#pragma unroll
      for (int g4 = 0; g4 < 4; ++g4) {
        const int d0 = mt * 32 + 8 * g4 + 4 * fh;
        const uint2 gv = *(const uint2*)(AG + rho * 512 + head * 64 + d0);
        uint2 ov;
        ov.x = pack2(o[mt][j][g4 * 4 + 0] * inv * silu_f(lo2f(gv.x)), o[mt][j][g4 * 4 + 1] * inv * silu_f(hi2f(gv.x)));
        ov.y = pack2(o[mt][j][g4 * 4 + 2] * inv * silu_f(lo2f(gv.y)), o[mt][j][g4 * 4 + 3] * inv * silu_f(hi2f(gv.y)));
        *(uint2*)(Q + rho * 512 + head * 64 + d0) = ov;
      }
  }
}

DI void states_item(const Params& p_in, char* smem, int ck, int g, int hq) {
  const Params p = load_params();

  bf16_t* sB = (bf16_t*)smem;
  bf16_t* sX = (bf16_t*)(smem + 128 * 136 * 2);
  int tid = threadIdx.x; asm volatile("" : "+v"(tid)); const int lane = tid & 63, wave = tid >> 6, wr = wave >> 1, wc = wave & 1, fr = lane & 31, fh = lane >> 5;
  const bf16_t* BC = (const bf16_t*)(p.ws + OFF_BC);
  const bf16_t* XS = (const bf16_t*)(p.ws + OFF_H);
  const float* DT = (const float*)(p.ws + OFF_DT);
  const float* CS = (const float*)(p.ws + OFF_CS);
  bf16_t* ST = (bf16_t*)(p.ws + OFF_ST);
  float* CDEC = (float*)(p.ws + OFF_CDEC);
  const int row0 = ck * 128;
  __syncthreads();
  for (int v = tid; v < 2048; v += 256) {
    const int r = v >> 4, cv = v & 15;
    *(uint4*)&sB[r * 136 + cv * 8] = *(const uint4*)(BC + (size_t)(row0 + r) * 512 + g * 128 + cv * 8);
  }
  __syncthreads();
  bf16x8 bfr[2][8];
#pragma unroll
  for (int j = 0; j < 2; ++j)
#pragma unroll
    for (int ks = 0; ks < 8; ++ks) bfr[j][ks] = tr_frag(sB, 136, ks * 16 + 8 * fh, ks * 16 + 8 * fh + 4, wc * 64 + j * 32);
  const int slr = tid >> 3, scv = tid & 7;
  uint4 xq0, xq1, xq2, xq3;
  float dq0, dq1, dq2, dq3, cq0, cq1, cq2, cq3, cendq;
#define ST_PREFETCH(HD) { const int head_ = g * 8 + hq * 4 + ((HD) >> 1), d_ = (HD) & 1, col_ = d_ * 16 + head_; \
    const bf16_t* xp_ = XS + (size_t)(row0 + slr) * 1024 + head_ * 64 + scv * 8; \
    xq0 = *(const uint4*)(xp_); xq1 = *(const uint4*)(xp_ + 32 * 1024); xq2 = *(const uint4*)(xp_ + 64 * 1024); xq3 = *(const uint4*)(xp_ + 96 * 1024); \
    const size_t rb_ = (size_t)(row0 + slr) * 32 + col_; \
    dq0 = DT[rb_]; dq1 = DT[rb_ + 32 * 32]; dq2 = DT[rb_ + 64 * 32]; dq3 = DT[rb_ + 96 * 32]; \
    cq0 = CS[rb_]; cq1 = CS[rb_ + 32 * 32]; cq2 = CS[rb_ + 64 * 32]; cq3 = CS[rb_ + 96 * 32]; \
    cendq = CS[(size_t)(row0 + (d_ == 0 ? 127 : 0)) * 32 + col_]; }
#define ST_SCALE_STORE(X, DTV, CSV, ROW) { const float sc_ = (DTV) * __expf(cend - (CSV)); uint4 o_; \
    o_.x = pack2(lo2f(X.x) * sc_, hi2f(X.x) * sc_); o_.y = pack2(lo2f(X.y) * sc_, hi2f(X.y) * sc_); \
    o_.z = pack2(lo2f(X.z) * sc_, hi2f(X.z) * sc_); o_.w = pack2(lo2f(X.w) * sc_, hi2f(X.w) * sc_); \
    *(uint4*)&sX[(ROW) * 72 + scv * 8] = o_; }
  ST_PREFETCH(0)
#pragma unroll 1
  for (int hd = 0; hd < 8; ++hd) {
    const int head = g * 8 + hq * 4 + (hd >> 1), d = hd & 1;
    const float cend = cendq;
    ST_SCALE_STORE(xq0, dq0, cq0, slr)
    ST_SCALE_STORE(xq1, dq1, cq1, slr + 32)
    ST_SCALE_STORE(xq2, dq2, cq2, slr + 64)
    ST_SCALE_STORE(xq3, dq3, cq3, slr + 96)
    if (hd < 7) ST_PREFETCH(hd + 1)
    __syncthreads();
    f32x16 acc[2];
#pragma unroll
    for (int j = 0; j < 2; ++j)
#pragma unroll
      for (int r = 0; r < 16; ++r) acc[j][r] = 0.f;
#pragma unroll
    for (int ks = 0; ks < 8; ++ks) {
      const bf16x8 af = tr_frag(sX, 72, ks * 16 + 8 * fh, ks * 16 + 8 * fh + 4, wr * 32);
#pragma unroll
      for (int j = 0; j < 2; ++j) acc[j] = MFMA(af, bfr[j][ks], acc[j]);
    }
    bf16_t* dst = ST + ((size_t)(ck * 2 + d) * 16 + head) * 8192;
#pragma unroll
    for (int j = 0; j < 2; ++j)
#pragma unroll
      for (int r = 0; r < 16; ++r) dst[(wr * 32 + crow(r, fh)) * 128 + wc * 64 + j * 32 + fr] = f2bf(acc[j][r]);
    if (tid == 0) CDEC[(ck * 2 + d) * 16 + head] = __expf(cend);
    __syncthreads();
  }
}

DI void pw_item(const Params& p_in, int l, char* smem, int mt, int nt) {
  const Params p = load_params();

  GemmS* s = (GemmS*)smem;
  int tid = threadIdx.x; asm volatile("" : "+v"(tid)); const int lane = tid & 63, wave = tid >> 6, wr = wave >> 1, wc = wave & 1, fr = lane & 31, fh = lane >> 5;
  const bf16_t* Ab = (const bf16_t*)(p.ws + OFF_HDN) + (size_t)mt * 128 * 512;
  const bf16_t* Bb = (const bf16_t*)(p.ws + OFF_PW) + (size_t)nt * 128 * 512;
  bf16_t* CG = (bf16_t*)(p.ws + OFF_CG);
  f32x16 acc[2][2];
  zero_acc(acc);
  gemm_core2(acc, (GemmS2*)smem,
             [&](int kt, int r, int kv) { return Ab + (size_t)r * 512 + kt * 64 + kv * 8; },
             [&](int kt, int r, int kv) { return Bb + (size_t)r * 512 + kt * 64 + kv * 8; }, 8, [](int) {});
  const float* pwb = p.conv_pw_b + l * 512 + nt * 128;
  epilogue_lds(acc, smem, [&](int rl, int c4, float4 v) {
    bf16_t* ptr = CG + (size_t)(mt * 128 + rl) * 512 + nt * 128 + c4;
    const uint2 gv = *(const uint2*)ptr;
    const float4 bb = *(const float4*)(pwb + c4);
    uint2 o;
    o.x = pack2((v.x + bb.x) * silu_f(lo2f(gv.x)), (v.y + bb.y) * silu_f(hi2f(gv.x)));
    o.y = pack2((v.z + bb.z) * silu_f(lo2f(gv.y)), (v.w + bb.w) * silu_f(hi2f(gv.y)));
    *(uint2*)ptr = o;
  });
}

DI void phase_mix(const Params& p, int l, char* smem) {
  const int G = gridDim.x;
  const int N_ATT = 512 + (l == 0 ? 32 : 0);
  for (int it = blockIdx.x; it < N_ATT; it += G) {
    if (it < 512) attn_item(p, l, smem, it >> 7, (it >> 2) & 31, (it >> 1) & 1, it & 1, false);
    else { const int t = it - 512; attn_item(p, l, smem, t >> 3, (t >> 2) & 1, (t >> 1) & 1, t & 1, true); }
  }
  for (int it = (blockIdx.x + G - 32) % G; it < NCK * 4; it += G) states_item(p, smem, it >> 2, (it >> 1) & 1, it & 1);
  for (int it = (blockIdx.x + G - 64) % G; it < NCK * 4; it += G) pw_item(p, l, smem, it >> 2, it & 3);
}

DI void phase_scan(const Params& p_in) {
  const Params p = load_params();

  bf16_t* ST = (bf16_t*)(p.ws + OFF_ST);
  const float* CDEC = (const float*)(p.ws + OFF_CDEC);
  for (int it = blockIdx.x; it < 512; it += gridDim.x) {
    const int e = it * 256 + threadIdx.x;
    const int bdh = e >> 10, v8 = e & 1023;
    const int b = bdh >> 5, d = (bdh >> 4) & 1, h = bdh & 15;
    float s[8];
#pragma unroll
    for (int i = 0; i < 8; ++i) s[i] = 0.f;
    auto ckof = [&](int i) {
      if (d == 0) return (i < 2) ? (128 + 2 * b + i) : (32 * b + (i - 2));
      return (i < 2) ? (128 + 2 * b + (1 - i)) : (32 * b + 31 - (i - 2));
    };
    auto pof = [&](int i) { const int ck = ckof(i); return (uint4*)(ST + ((size_t)(ck * 2 + d) * 16 + h) * 8192 + v8 * 8); };
    auto dof = [&](int i) { const int ck = ckof(i); return CDEC[(ck * 2 + d) * 16 + h]; };
    uint4 buf[8]; float dc[8];
#pragma unroll
    for (int i = 0; i < 7; ++i) { buf[i] = *pof(i); dc[i] = dof(i); }
#pragma unroll
    for (int i = 0; i < 34; ++i) {
      if (i + 7 < 34) { buf[(i + 7) & 7] = *pof(i + 7); dc[(i + 7) & 7] = dof(i + 7); }
      const uint4 cur = buf[i & 7];
      const float dec = dc[i & 7];
      uint4 o;
      o.x = pack2(s[0], s[1]); o.y = pack2(s[2], s[3]); o.z = pack2(s[4], s[5]); o.w = pack2(s[6], s[7]);
      *pof(i) = o;
      s[0] = s[0] * dec + lo2f(cur.x); s[1] = s[1] * dec + hi2f(cur.x);
      s[2] = s[2] * dec + lo2f(cur.y); s[3] = s[3] * dec + hi2f(cur.y);
      s[4] = s[4] * dec + lo2f(cur.z); s[5] = s[5] * dec + hi2f(cur.z);
      s[6] = s[6] * dec + lo2f(cur.w); s[7] = s[7] * dec + hi2f(cur.w);
    }
  }
}

DI void phase_ssdy(const Params& p_in, int l, char* smem) {
  const Params p = load_params();

  bf16_t* sB = (bf16_t*)smem;
  bf16_t* sX = (bf16_t*)(smem + 128 * 136 * 2);
  float* sF = (float*)(smem + 128 * 136 * 2 + 128 * 72 * 2);
  float* sSS = sF + 512;
  int tid = threadIdx.x; asm volatile("" : "+v"(tid)); const int lane = tid & 63, wave = tid >> 6, fr = lane & 31, fh = lane >> 5;
  const int wl = wave >> 1, w2 = wave & 1;
  const bf16_t* BC = (const bf16_t*)(p.ws + OFF_BC);
  const bf16_t* XS = (const bf16_t*)(p.ws + OFF_H);
  const float* DT = (const float*)(p.ws + OFF_DT);
  const float* CS = (const float*)(p.ws + OFF_CS);
  const bf16_t* ST = (const bf16_t*)(p.ws + OFF_ST);
  bf16_t* Z = (bf16_t*)(p.ws + OFF_Z);
  float* RSTD = (float*)(p.ws + OFF_RSTD);
  const int nck = (l == 0) ? NCK : 128;
  const int nh = (l == 0) ? 2 : 8;
  const int nsplit = 8 / nh;
  for (int it0 = blockIdx.x; it0 < nck * 4 * nsplit; it0 += gridDim.x) {
    const int hq = it0 % nsplit, it = it0 / nsplit;
    const int hbeg = hq * nh, hend = hbeg + nh;
    const int ck = it >> 2, g = (it >> 1) & 1, lh = it & 1;
    const int row0 = ck * 128;
    const int lbase = lh * 64 + wl * 32;
    __syncthreads();
    for (int v = tid; v < 2048; v += 256) {
      const int r = v >> 4, cv = v & 15;
      *(uint4*)&sB[r * 136 + cv * 8] = *(const uint4*)(BC + (size_t)(row0 + r) * 512 + g * 128 + cv * 8);
    }
    if (tid < 64) sSS[tid] = 0.f;
    const bf16_t* cptr = BC + (size_t)(row0 + lbase + fr) * 512 + 256 + g * 128 + fh * 8;
    bf16x8 cf[8];
#pragma unroll
    for (int ks = 0; ks < 8; ++ks) cf[ks] = *(const bf16x8*)(cptr + ks * 16);
    const int lrx = tid >> 3, cvx = tid & 7;
    const bf16_t* xsrc = XS + (size_t)(row0 + lrx) * 1024 + cvx * 8;
    uint4 xp0, xp1, xp2, xp3;
    float fp0 = 0.f, fp1 = 0.f, fp2 = 0.f, fp3 = 0.f;
    {
      const int head = g * 8 + hbeg;
      xp0 = *(const uint4*)(xsrc + head * 64);
      xp1 = *(const uint4*)(xsrc + head * 64 + 32 * 1024);
      xp2 = *(const uint4*)(xsrc + head * 64 + 64 * 1024);
      xp3 = *(const uint4*)(xsrc + head * 64 + 96 * 1024);
      if (tid < 128) {
        const size_t rho = (size_t)(row0 + tid);
        fp0 = CS[rho * 32 + head]; fp1 = CS[rho * 32 + 16 + head]; fp2 = DT[rho * 32 + head]; fp3 = DT[rho * 32 + 16 + head];
      }
    }
    __syncthreads();
    f32x16 cb[2];
#pragma unroll
    for (int j = 0; j < 2; ++j) {
#pragma unroll
      for (int r = 0; r < 16; ++r) cb[j][r] = 0.f;
#pragma unroll
      for (int ks = 0; ks < 8; ++ks) {
        const bf16x8 bq = *(const bf16x8*)&sB[(w2 * 64 + j * 32 + fr) * 136 + ks * 16 + fh * 8];
        cb[j] = MFMA(cf[ks], bq, cb[j]);
      }
    }
    const int pidx = w2 * 32 + fr;
    bf16_t* sCB = sB + 64 * 136;
    __syncthreads();
#pragma unroll
    for (int j = 0; j < 2; ++j)
#pragma unroll
      for (int r = 0; r < 16; ++r) sCB[(wl * 32 + crow(r, fh)) * 136 + w2 * 64 + j * 32 + fr] = f2bf(cb[j][r]);
#pragma unroll 1
    for (int hh = hbeg; hh < hend; ++hh) {
      const int head = g * 8 + hh;
      __syncthreads();
      *(uint4*)&sX[lrx * 72 + cvx * 8] = xp0;
      *(uint4*)&sX[(lrx + 32) * 72 + cvx * 8] = xp1;
      *(uint4*)&sX[(lrx + 64) * 72 + cvx * 8] = xp2;
      *(uint4*)&sX[(lrx + 96) * 72 + cvx * 8] = xp3;
      if (tid < 128) { sF[tid] = fp0; sF[128 + tid] = fp1; sF[256 + tid] = fp2; sF[384 + tid] = fp3; }
      const bf16_t* S0 = ST + ((size_t)(ck * 2 + 0) * 16 + head) * 8192 + (w2 * 32 + fr) * 128 + fh * 8;
      const bf16_t* S1 = ST + ((size_t)(ck * 2 + 1) * 16 + head) * 8192 + (w2 * 32 + fr) * 128 + fh * 8;
      bf16x8 sf0[8];
#pragma unroll
      for (int ks = 0; ks < 8; ++ks) sf0[ks] = *(const bf16x8*)(S0 + ks * 16);
      bf16_t* zbase = Z + (size_t)(row0 + lbase + 4 * fh) * 1024 + head * 64 + pidx;
      if (hh + 1 < hend) {
        const int hn = head + 1;
        xp0 = *(const uint4*)(xsrc + hn * 64);
        xp1 = *(const uint4*)(xsrc + hn * 64 + 32 * 1024);
        xp2 = *(const uint4*)(xsrc + hn * 64 + 64 * 1024);
        xp3 = *(const uint4*)(xsrc + hn * 64 + 96 * 1024);
        if (tid < 128) {
          const size_t rho = (size_t)(row0 + tid);
          fp0 = CS[rho * 32 + hn]; fp1 = CS[rho * 32 + 16 + hn]; fp2 = DT[rho * 32 + hn]; fp3 = DT[rho * 32 + 16 + hn];
        }
      }
      __syncthreads();
#pragma unroll
      for (int j = 0; j < 2; ++j) {
        const int sidx = w2 * 64 + j * 32 + fr;
        const float csf_s = sF[sidx], csb_s = sF[128 + sidx], dtf_s = sF[256 + sidx], dtb_s = sF[384 + sidx];
#pragma unroll 4
        for (int r = 0; r < 16; ++r) {
          const int lidx = lbase + crow(r, fh);
          float f = 0.f;
          if (sidx <= lidx) f += __expf(sF[lidx] - csf_s) * dtf_s;
          if (sidx >= lidx) f += __expf(sF[128 + lidx] - csb_s) * dtb_s;
          sB[(wl * 32 + crow(r, fh)) * 136 + sidx] = f2bf(bf2f(sCB[(wl * 32 + crow(r, fh)) * 136 + sidx]) * f);
        }
      }
      __syncthreads();
      bf16x8 sf1[8], cfh[8];
#pragma unroll
      for (int ks = 0; ks < 8; ++ks) { sf1[ks] = *(const bf16x8*)(S1 + ks * 16); cfh[ks] = *(const bf16x8*)(cptr + ks * 16); }
      unsigned short zv[16];
#pragma unroll
      for (int r = 0; r < 16; ++r) zv[r] = zbase[(size_t)((r & 3) + 8 * (r >> 2)) * 1024];
      f32x16 accy;
#pragma unroll
      for (int r = 0; r < 16; ++r) accy[r] = 0.f;
#pragma unroll
      for (int ks = 0; ks < 8; ++ks) {
        const bf16x8 af = *(const bf16x8*)&sB[(wl * 32 + fr) * 136 + ks * 16 + fh * 8];
        const bf16x8 xf = tr_frag(sX, 72, ks * 16 + 8 * fh, ks * 16 + 8 * fh + 4, w2 * 32);
        accy = MFMA(af, xf, accy);
      }
      {
        f32x16 acct;
#pragma unroll
        for (int r = 0; r < 16; ++r) acct[r] = 0.f;
#pragma unroll
        for (int ks = 0; ks < 8; ++ks) acct = MFMA(cfh[ks], sf0[ks], acct);
#pragma unroll
        for (int r = 0; r < 16; ++r) accy[r] += __expf(sF[lbase + crow(r, fh)]) * acct[r];
#pragma unroll
        for (int r = 0; r < 16; ++r) acct[r] = 0.f;
#pragma unroll
        for (int ks = 0; ks < 8; ++ks) acct = MFMA(cfh[ks], sf1[ks], acct);
#pragma unroll
        for (int r = 0; r < 16; ++r) accy[r] += __expf(sF[128 + lbase + crow(r, fh)]) * acct[r];
      }
      const float dsk = p.ssd_d[l * 16 + head];
      float v[16];
#pragma unroll
      for (int r = 0; r < 16; ++r) {
        const int lidx = lbase + crow(r, fh);
        const float xv = bf2f(sX[lidx * 72 + pidx]);
        const float y = accy[r] + dsk * xv;
        const float u = y * silu_f(bf2f(zv[r]));
        v[r] = u * u;
        zbase[(size_t)((r & 3) + 8 * (r >> 2)) * 1024] = f2bf(u);
      }
#pragma unroll
      for (int i = 0; i < 8; ++i) { const bool up = (fr & 16) != 0; const float keep = up ? v[i + 8] : v[i]; const float send = up ? v[i] : v[i + 8]; v[i] = keep + __shfl_xor(send, 16); }
#pragma unroll
      for (int i = 0; i < 4; ++i) { const bool up = (fr & 8) != 0; const float keep = up ? v[i + 4] : v[i]; const float send = up ? v[i] : v[i + 4]; v[i] = keep + __shfl_xor(send, 8); }
#pragma unroll
      for (int i = 0; i < 2; ++i) { const bool up = (fr & 4) != 0; const float keep = up ? v[i + 2] : v[i]; const float send = up ? v[i] : v[i + 2]; v[i] = keep + __shfl_xor(send, 4); }
      { const bool up = (fr & 2) != 0; const float keep = up ? v[1] : v[0]; const float send = up ? v[0] : v[1]; v[0] = keep + __shfl_xor(send, 2); }
      v[0] += __shfl_xor(v[0], 1);
      if ((fr & 1) == 0) atomicAdd(&sSS[wl * 32 + crow(fr >> 1, fh)], v[0]);
    }
    __syncthreads();
    if (tid < 64) atomicAdd(&RSTD[(size_t)(row0 + lh * 64 + tid) * 2 + g], sSS[tid]);
  }
}

DI void phase_outproj(const Params& p_in, int l, char* smem) {
  const Params p = load_params();

  GemmS* s = (GemmS*)smem;
  int tid = threadIdx.x; asm volatile("" : "+v"(tid)); const int lane = tid & 63, wave = tid >> 6, wr = wave >> 1, wc = wave & 1, fr = lane & 31, fh = lane >> 5;
  const bf16_t* Zb = (const bf16_t*)(p.ws + OFF_Z);
  const bf16_t* Qb = (const bf16_t*)(p.ws + OFF_Q);
  const bf16_t* Cb = (const bf16_t*)(p.ws + OFF_CG);
  const bf16_t* W = (const bf16_t*)(p.ws + OFF_WOUT);
  const float* RSTD = (const float*)(p.ws + OFF_RSTD);
  const float* mods = (const float*)(p.ws + OFF_MODS);
  float* XC = (float*)(p.ws + OFF_XC);
  for (int step = 0;; ++step) {
    int mt, nt2;
    if (!xcd_tile(step, 128, 4, mt, nt2)) break;
    f32x16 acc[2][4];
#pragma unroll
    for (int i = 0; i < 2; ++i)
#pragma unroll
      for (int j = 0; j < 4; ++j)
#pragma unroll
        for (int r = 0; r < 16; ++r) acc[i][j][r] = 0.f;
    const bf16_t* Wb = W + (size_t)nt2 * 256 * 2048;
    const bf16_t* A0 = Zb + (size_t)mt * 128 * 1024;
    const bf16_t* A2 = Qb + (size_t)mt * 128 * 512;
    const bf16_t* A3 = Cb + (size_t)mt * 128 * 512;
    float* sScale = (float*)(smem + 55296);
    __syncthreads();
    if (tid < 128) {
      const size_t row = (size_t)(mt * 128 + tid);
      const float r0 = rsqrtf(RSTD[row * 2] * (1.f / 512.f) + 1e-6f);
      const float r1 = rsqrtf(RSTD[row * 2 + 1] * (1.f / 512.f) + 1e-6f);
      sScale[tid * 2] = r0 / r1;
      sScale[tid * 2 + 1] = r1;
    }
    gemm_core3(acc, (GemmS3*)smem,
               [&](int kt, int r, int kv) {
                 const bf16_t* ptr;
                 if (kt < 16) ptr = A0 + (size_t)r * 1024 + kt * 64;
                 else if (kt < 24) ptr = A2 + (size_t)r * 512 + (kt - 16) * 64;
                 else ptr = A3 + (size_t)r * 512 + (kt - 24) * 64;
                 return ptr + kv * 8;
               },
               [&](int kt, int r, int kv) { return Wb + (size_t)r * 2048 + kt * 64 + kv * 8; }, 32,
               [&](int kt) __attribute__((always_inline)) {
                 if (kt == 8 || kt == 16) {
#pragma unroll
                   for (int i = 0; i < 2; ++i)
#pragma unroll
                     for (int r = 0; r < 16; ++r) {
                       const float f = sScale[(wr * 64 + i * 32 + crow(r, fh)) * 2 + (kt == 16 ? 1 : 0)];
                       acc[i][0][r] *= f; acc[i][1][r] *= f; acc[i][2][r] *= f; acc[i][3][r] *= f;
                     }
                 }
               });
    {
      const int row0 = mt * 128;
      const int vv = row0 >> 12;
      float* xnew = p.out + (size_t)row0 * 1024;
      const float* xold = (l == 0) ? (p.x + (size_t)row0 * 1024) : xnew;
#pragma unroll 1
      for (int sub = 0; sub < 2; ++sub) {
        const int nt = nt2 * 2 + sub;
        const float* gate = mods + (l * 5 + vv) * 3072 + 2048 + nt * 128;
        epilogue_lds2(acc, smem, sub, [&](int rl, int c4, float4 v) {
          const int off = rl * 1024 + nt * 128 + c4;
          const float4 xo = *(const float4*)(xold + off);
          const float4 gt = *(const float4*)(gate + c4);
          float4 o;
          o.x = xo.x + gt.x * v.x; o.y = xo.y + gt.y * v.y; o.z = xo.z + gt.z * v.z; o.w = xo.w + gt.w * v.w;
          *(float4*)(xnew + off) = o;
        });
      }
    }
  }
  const int nctx = (l == 0) ? 64 : 0;
  for (int it = (int)blockIdx.x; it < nctx; it += gridDim.x) {
    const int mt = 128 + (it >> 3), nt = it & 7;
    f32x16 acc[2][2];
    zero_acc(acc);
    const bf16_t* Wb = W + (size_t)nt * 128 * 2048;
    const bf16_t* A0 = Zb + (size_t)mt * 128 * 1024;
    const bf16_t* A2 = Qb + (size_t)mt * 128 * 512;
    const bf16_t* A3 = Cb + (size_t)mt * 128 * 512;
    float* sScale = (float*)(smem + 40960);
    if (tid < 128) {
      const size_t row = (size_t)(mt * 128 + tid);
      const float r0 = rsqrtf(RSTD[row * 2] * (1.f / 512.f) + 1e-6f);
      const float r1 = rsqrtf(RSTD[row * 2 + 1] * (1.f / 512.f) + 1e-6f);
      sScale[tid * 2] = r0 / r1;
      sScale[tid * 2 + 1] = r1;
    }
    gemm_core2(acc, (GemmS2*)smem,
               [&](int kt, int r, int kv) {
                 const bf16_t* ptr;
                 if (kt < 16) ptr = A0 + (size_t)r * 1024 + kt * 64;
                 else if (kt < 24) ptr = A2 + (size_t)r * 512 + (kt - 16) * 64;
                 else ptr = A3 + (size_t)r * 512 + (kt - 24) * 64;
                 return ptr + kv * 8;
               },
               [&](int kt, int r, int kv) { return Wb + (size_t)r * 2048 + kt * 64 + kv * 8; }, 32,
               [&](int kt) __attribute__((always_inline)) {
                 if (kt == 8 || kt == 16) {
#pragma unroll
                   for (int i = 0; i < 2; ++i)
#pragma unroll
                     for (int r = 0; r < 16; ++r) {
                       const float f = sScale[(wr * 64 + i * 32 + crow(r, fh)) * 2 + (kt == 16 ? 1 : 0)];
                       acc[i][0][r] *= f; acc[i][1][r] *= f;
                     }
                 }
               });
    {
      const int row0 = mt * 128;
      const int vv = (row0 < RL_) ? (row0 >> 12) : 4;
      const float* gate = mods + (l * 5 + vv) * 3072 + 2048 + nt * 128;
      float* xnew = (row0 < RL_) ? (p.out + (size_t)row0 * 1024) : (XC + (size_t)(row0 - RL_) * 1024);
      const float* xold = (l == 0) ? ((row0 < RL_) ? (p.x + (size_t)row0 * 1024) : (p.ctx + (size_t)(row0 - RL_) * 1024)) : xnew;
      epilogue_lds(acc, smem, [&](int rl, int c4, float4 v) {
        const int off = rl * 1024 + nt * 128 + c4;
        const float4 xo = *(const float4*)(xold + off);
        const float4 gt = *(const float4*)(gate + c4);
        float4 o;
        o.x = xo.x + gt.x * v.x; o.y = xo.y + gt.y * v.y; o.z = xo.z + gt.z * v.z; o.w = xo.w + gt.w * v.w;
        *(float4*)(xnew + off) = o;
      });
    }
  }
  if (l == 0) {
    const int local = blockIdx.x >> 3, xcd = blockIdx.x & 7, nloc = gridDim.x >> 3;
    if (local >= 8 && nloc > 8) {
      const int nb = (nloc - 8) * 8;
      const int NT_WIN = 88 * 16, NT_PW = 64;
      for (int it = (local - 8) * 8 + xcd; it < NT_WIN + NT_PW; it += nb) {
        if (it < NT_WIN) transpose_tile(p.w_in + (size_t)1024 * 5408, 5408, 0, nullptr, (bf16_t*)(p.ws + OFF_WIN), 1024, (it / 16) * 64, (it % 16) * 64, (float*)smem);
        else { const int t = it - NT_WIN; transpose_tile(p.conv_pw_w + (size_t)512 * 512, 512, 1, nullptr, (bf16_t*)(p.ws + OFF_PW), 512, (t / 8) * 64, (t % 8) * 64, (float*)smem); }
      }
    }
  }
}

DI void phase_final(const Params& p_in) {
  const Params p = load_params();
  const int lane = threadIdx.x & 63, wave = threadIdx.x >> 6;
  for (int it = blockIdx.x; it < RL_ / 8; it += gridDim.x) {
    float* xr0 = p.out + (size_t)(it * 8 + wave * 2) * 1024;
    float4 xv[2][4];
#pragma unroll
    for (int q = 0; q < 2; ++q)
#pragma unroll
      for (int i = 0; i < 4; ++i) xv[q][i] = *(const float4*)(xr0 + q * 1024 + lane * 4 + i * 256);
    float4 w[4];
#pragma unroll
    for (int i = 0; i < 4; ++i) w[i] = *(const float4*)(p.final_norm_w + lane * 4 + i * 256);
#pragma unroll
    for (int q = 0; q < 2; ++q) {
      float ss = 0.f;
#pragma unroll
      for (int i = 0; i < 4; ++i) ss += xv[q][i].x * xv[q][i].x + xv[q][i].y * xv[q][i].y + xv[q][i].z * xv[q][i].z + xv[q][i].w * xv[q][i].w;
#pragma unroll
      for (int o = 32; o >= 1; o >>= 1) ss += __shfl_xor(ss, o);
      const float rs = rsqrtf(ss * (1.f / 1024.f) + 1e-6f);
#pragma unroll
      for (int i = 0; i < 4; ++i) {
        float4 o;
        o.x = xv[q][i].x * rs * w[i].x; o.y = xv[q][i].y * rs * w[i].y; o.z = xv[q][i].z * rs * w[i].z; o.w = xv[q][i].w * rs * w[i].w;
        *(float4*)(xr0 + q * 1024 + lane * 4 + i * 256) = o;
      }
    }
  }
}

template <int PH>
DI void run_phase(const Params& p, char* smem) {
  constexpr int l = (PH - 1) / 7, s = (PH - 1) % 7;
  if constexpr (PH == 0) phase_mods(p, smem);
  else if constexpr (PH == 15) phase_final(p);
  else if constexpr (s == 0) phase_prep(p, l, smem);
  else if constexpr (s == 1) phase_inproj(p, smem);
  else if constexpr (s == 2) phase_local(p, l, smem);
  else if constexpr (s == 3) phase_mix(p, l, smem);
  else if constexpr (s == 4) phase_scan(p);
  else if constexpr (s == 5) phase_ssdy(p, l, smem);
  else phase_outproj(p, l, smem);
}

#if PROBE_S >= 0
#define PROBE_BEGIN() if (threadIdx.x == 0) pst[1] = wall_clock64();
#define PROBE_END(PH) if (threadIdx.x == 0 && (PH) >= 1 && (PH) <= 14 && (((PH) - 1) % 7) == PROBE_S) pst[0] += wall_clock64() - pst[1];
#else
#define PROBE_BEGIN()
#define PROBE_END(PH)
#endif
#define PHASE(PH) PROBE_BEGIN() run_phase<PH>(p, smem); xcd_barrier(xst); PROBE_END(PH)

__global__ void __launch_bounds__(256, 2) fwd_megakernel(Params p) {
  __shared__ __attribute__((aligned(16))) char smem[57344];
  cg::grid_group grid = cg::this_grid();
  if (threadIdx.x == 0) g_kernarg = (unsigned long long)__builtin_amdgcn_kernarg_segment_ptr();
  __syncthreads();
#if PROBE_S >= 0
  volatile unsigned long long* pst = (volatile unsigned long long*)(smem + 57344 - 16);
  if (threadIdx.x == 0) { pst[0] = 0; pst[1] = 0; }
#endif
  __shared__ uint4 xb_words;
  volatile LAS unsigned* xst = (volatile LAS unsigned*)&xb_words;
  if (threadIdx.x == 0) xb_words = make_uint4(0u, 0u, 0u, 0u);
  if (threadIdx.x == 0) { unsigned* bar = (unsigned*)(load_params().ws + OFF_BAR); (void)xb_add(&bar[XB_XCNT(xb_xcc_id())], 1u); }
  run_phase<0>(p, smem);
  if (load_params().out == nullptr) grid.sync();
  xcd_barrier(xst);
  PHASE(1) PHASE(2) PHASE(3) PHASE(4) PHASE(5) PHASE(6) PHASE(7)
  PHASE(8) PHASE(9) PHASE(10) PHASE(11) PHASE(12) PHASE(13) PHASE(14)
  run_phase<15>(p, smem);
#if PROBE_S >= 0
  if (blockIdx.x == 0 && threadIdx.x == 0) {
    const unsigned long long t1 = wall_clock64();
    const unsigned long long lim = 4ull * pst[0];
    while (wall_clock64() - t1 < lim) { __builtin_amdgcn_s_sleep(32); }
  }
#endif
}

extern "C" void kernel_launch(void* const* d_in, const int* in_sizes, int n_in, void* d_out, int out_size, void* d_ws,
                              size_t ws_size, hipStream_t stream) {
  static int grid_blocks = 0;
  if (!grid_blocks) {
    int dev = 0, cus = 0, per_cu = 0;
    hipGetDevice(&dev);
    hipDeviceGetAttribute(&cus, hipDeviceAttributeMultiprocessorCount, dev);
    hipOccupancyMaxActiveBlocksPerMultiprocessor(&per_cu, fwd_megakernel, 256, 0);
    if (per_cu < 1) per_cu = 1;
    if (per_cu > 2) per_cu = 2;
    grid_blocks = (cus * per_cu) & ~7;
  }
  Params p{};
  const float** pp = (const float**)&p;
  for (int i = 0; i < 23; ++i) pp[i] = (const float*)d_in[i];
  p.out = (float*)d_out;
  p.ws = (char*)d_ws;
  (void)hipMemsetAsync((char*)d_ws + OFF_BAR, 0, XCD_BAR_WORDS * 4, stream);
  void* args[] = {&p};
  hipError_t e = hipLaunchCooperativeKernel((void*)fwd_megakernel, dim3(grid_blocks), dim3(256), args, 0, stream);
  if (e != hipSuccess) fprintf(stderr, "cooperative launch failed: %s (grid %d)\n", hipGetErrorString(e), grid_blocks);
}
```

```cpp
#include <hip/hip_runtime.h>
#include <hip/hip_cooperative_groups.h>
#include <stdint.h>
#include <stdio.h>
namespace cg = cooperative_groups;

#ifndef ONE_LAUNCH
#define ONE_LAUNCH 1
#endif

#ifndef PROBE_S
#define PROBE_S -1
#endif
#define DI __device__ __forceinline__
typedef unsigned short bf16_t;
using bf16x8 = __attribute__((ext_vector_type(8))) short;
using s16x4 = __attribute__((ext_vector_type(4))) short;
using f32x16 = __attribute__((ext_vector_type(16))) float;
#define MFMA(a, b, c) __builtin_amdgcn_mfma_f32_32x32x16_bf16((a), (b), (c), 0, 0, 0)

constexpr int R_ = 17408;
constexpr int RL_ = 16384;
constexpr int NCK = 136;

constexpr size_t SZ_WIN = (size_t)5632 * 1024 * 2;
constexpr size_t SZ_WOUT = (size_t)1024 * 2048 * 2;
constexpr size_t SZ_PW = (size_t)512 * 512 * 2;
constexpr size_t SZ_MODS = (size_t)2 * 5 * 3072 * 4;
constexpr size_t SZ_XC = (size_t)1024 * 1024 * 4;
constexpr size_t SZ_RSTD = (size_t)R_ * 2 * 4;
constexpr size_t SZ_CDEC = (size_t)NCK * 32 * 4 + 256 - ((size_t)NCK * 32 * 4) % 256;
constexpr size_t SZ_R512 = (size_t)R_ * 512 * 2;
constexpr size_t OFF_WIN = 0;
constexpr size_t OFF_WOUT = OFF_WIN + SZ_WIN;
constexpr size_t OFF_PW = OFF_WOUT + SZ_WOUT;
constexpr size_t OFF_MODS = OFF_PW + SZ_PW;
constexpr size_t OFF_XC = OFF_MODS + SZ_MODS;
constexpr size_t OFF_RSTD = OFF_XC + SZ_XC;
constexpr size_t OFF_CDEC = OFF_RSTD + SZ_RSTD;
constexpr size_t OFF_H = OFF_CDEC + SZ_CDEC;
constexpr size_t OFF_XBC = OFF_H + 2 * SZ_R512;
constexpr size_t OFF_GLU = OFF_XBC + 3 * SZ_R512;
constexpr size_t OFF_ST = OFF_XBC;
constexpr size_t OFF_Z = OFF_GLU + SZ_R512;
constexpr size_t OFF_DT = OFF_Z + 2 * SZ_R512;
constexpr size_t OFF_CS = OFF_DT + (size_t)R_ * 32 * 4;
constexpr size_t OFF_Q = OFF_CS + (size_t)R_ * 32 * 4;
constexpr size_t OFF_KV = OFF_Q + SZ_R512;
constexpr size_t OFF_AG = OFF_KV + SZ_R512 / 2;
constexpr size_t OFF_CG = OFF_AG + SZ_R512;
constexpr size_t OFF_BC = OFF_CG + SZ_R512;
constexpr size_t OFF_HDN = OFF_BC + SZ_R512;
constexpr size_t WS_TOTAL = OFF_HDN + SZ_R512;
constexpr size_t OFF_BAR = WS_TOTAL;
static_assert(OFF_BAR + 16384 <= (size_t)256 * 1024 * 1024, "workspace too large");

struct Params {
  const float *x, *c, *ctx, *c_ctx, *w_mod, *b_mod, *norm_w, *w_in, *ssd_conv_w, *ssd_conv_b, *ssd_dt_bias, *ssd_a_log,
      *ssd_d, *ssd_norm_w, *attn_sink, *conv_dw_w, *conv_dw_b, *conv_ln_w, *conv_ln_b, *conv_pw_w, *conv_pw_b, *w_out,
      *final_norm_w;
  float* out;
  char* ws;
};


__shared__ unsigned long long g_kernarg;
DI Params load_params() {
  typedef const char __attribute__((address_space(4)))* kptr_t;
  typedef const float* const __attribute__((address_space(4)))* kfld_t;
  const unsigned long long v = *(volatile unsigned long long*)&g_kernarg;
  const unsigned lo = __builtin_amdgcn_readfirstlane((unsigned)v), hi = __builtin_amdgcn_readfirstlane((unsigned)(v >> 32));
  kptr_t base = (kptr_t)(((unsigned long long)hi << 32) | lo);
  Params p;
  const float** pp = (const float**)&p;
#pragma unroll
  for (int i = 0; i < 25; ++i) pp[i] = *(kfld_t)(base + 8 * i);
  return p;
}

#define XB_TMO      128
#define XB_XCNT(j)  (256  + 64 * (j))
#define XB_XSUB(j)  (1280 + 64 * (j))
#define XB_XGEN(j)  (2304 + 64 * (j))
#define XB_TOP      3328
#define XB_TOPGEN   3392
#define XCD_BAR_WORDS 3456
#define XB_SPIN_CAP (1u << 18)
#define LAS __attribute__((address_space(3)))
DI unsigned xb_ld(unsigned* p)              { return __hip_atomic_load(p, __ATOMIC_RELAXED, __HIP_MEMORY_SCOPE_AGENT); }
DI unsigned xb_add(unsigned* p, unsigned v) { return __hip_atomic_fetch_add(p, v, __ATOMIC_RELAXED, __HIP_MEMORY_SCOPE_AGENT); }
DI unsigned xb_xcc_id() { return (unsigned)__builtin_amdgcn_s_getreg((3 << 11) | 20) & 0xFu; }
#define XB_SPIN(cond, bar) do { unsigned _sp = 0; while (cond) { __builtin_amdgcn_s_sleep(1); \
    if ((++_sp & 255u) == 0u) { if (xb_ld(&(bar)[XB_TMO])) break; if (_sp > XB_SPIN_CAP) { atomicAdd(&(bar)[XB_TMO], 1u); break; } } } } while (0)

DI void xcd_barrier_complete(unsigned* bar, unsigned x, unsigned& nloc, unsigned& nx) {
  const unsigned G = gridDim.x * gridDim.y * gridDim.z;
  unsigned sum, cnt, mine, sp = 0u;
  for (;;) {
    sum = 0u; cnt = 0u; mine = 0u;
#pragma unroll
    for (unsigned j = 0; j < 16; ++j) { const unsigned c = xb_ld(&bar[XB_XCNT(j)]); sum += c; cnt += (c > 0u) ? 1u : 0u; mine = (j == x) ? c : mine; }
    if (sum == G) break;
    __builtin_amdgcn_s_sleep(1);
    if ((++sp & 255u) == 0u) { if (xb_ld(&bar[XB_TMO])) break; if (sp > XB_SPIN_CAP) { atomicAdd(&bar[XB_TMO], 1u); break; } }
  }
  nloc = mine > 0u ? mine : 1u; nx = cnt > 0u ? cnt : 1u;
}

DI void xcd_barrier(volatile LAS unsigned* st) {
  asm volatile("s_waitcnt vmcnt(0)" ::: "memory");
  __syncthreads();
  if (threadIdx.x == 0) {
    const Params pb = load_params();
    unsigned* bar = (unsigned*)(pb.ws + OFF_BAR);
    const unsigned x = xb_xcc_id();
    __builtin_amdgcn_s_waitcnt(0);
    unsigned nloc = st[0], nx = st[1];
    if (nloc == 0u) { xcd_barrier_complete(bar, x, nloc, nx); st[0] = nloc; st[1] = nx; }
    const unsigned old = xb_add(&bar[XB_XSUB(x)], 1u);
    const unsigned gen = old / nloc;
    if (old + 1u == (gen + 1u) * nloc) {
      __builtin_amdgcn_fence(__ATOMIC_RELEASE, "agent");
      asm volatile("s_waitcnt vmcnt(0)" ::: "memory");
      const unsigned og = xb_add(&bar[XB_TOP], 1u);
      const unsigned tg = og / nx;
      if (og + 1u == (tg + 1u) * nx) xb_add(&bar[XB_TOPGEN], 1u);
      else XB_SPIN(xb_ld(&bar[XB_TOPGEN]) == tg, bar);
      __builtin_amdgcn_fence(__ATOMIC_ACQUIRE, "agent");
      xb_add(&bar[XB_XGEN(x)], 1u);
      asm volatile("s_waitcnt vmcnt(0)" ::: "memory");
    } else {
      XB_SPIN(xb_ld(&bar[XB_XGEN(x)]) == gen, bar);
      __builtin_amdgcn_fence(__ATOMIC_ACQUIRE, "agent");
      asm volatile("s_waitcnt vmcnt(0)" ::: "memory");
    }
  }
  __syncthreads();
}

typedef __bf16 nbf16x2_t __attribute__((ext_vector_type(2)));
typedef float nf32x2_t __attribute__((ext_vector_type(2)));
DI unsigned short f2bf(float x) { const __bf16 r = (__bf16)x; return __builtin_bit_cast(unsigned short, r); }
DI float bf2f(unsigned short b) { return __uint_as_float(((unsigned)b) << 16); }
DI unsigned pack2(float a, float b) { const nf32x2_t v = {a, b}; const nbf16x2_t r = __builtin_convertvector(v, nbf16x2_t); return __builtin_bit_cast(unsigned, r); }
DI float lo2f(unsigned u) { return __uint_as_float(u << 16); }
DI float hi2f(unsigned u) { return __uint_as_float(u & 0xffff0000u); }
DI float silu_f(float x) { return x / (1.f + __expf(-x)); }
DI float sigmoid_f(float x) { return 1.f / (1.f + __expf(-x)); }
DI int crow(int reg, int h) { return (reg & 3) + 8 * (reg >> 2) + 4 * h; }

DI bf16x8 tr_frag(const bf16_t* s, int ld, int row_lo, int row_hi, int col0) {
  const int lane = threadIdx.x & 63;
  const int i16 = lane & 15, q = i16 >> 2, pp = i16 & 3, blk = (lane >> 4) & 1;
  const unsigned a0 = (unsigned)(size_t)(s + (row_lo + q) * ld + col0 + 16 * blk + 4 * pp);
  const unsigned a1 = (unsigned)(size_t)(s + (row_hi + q) * ld + col0 + 16 * blk + 4 * pp);
  s16x4 lo, hi;
  asm volatile("ds_read_b64_tr_b16 %0, %2\n\tds_read_b64_tr_b16 %1, %3\n\ts_waitcnt lgkmcnt(0)"
               : "=&v"(lo), "=&v"(hi) : "v"(a0), "v"(a1) : "memory");
  return __builtin_shufflevector(lo, hi, 0, 1, 2, 3, 4, 5, 6, 7);
}

struct GemmS { bf16_t a[2][128][40]; bf16_t b[2][128][40]; };

template <class AF, class BF>
DI void gemm_core(f32x16 (&acc)[2][2], GemmS* s, AF aptr, BF bptr, int nk) {
  int tid = threadIdx.x; asm volatile("" : "+v"(tid)); const int lane = tid & 63, wave = tid >> 6, wr = wave >> 1, wc = wave & 1;
  const int r0 = tid >> 2, kv = tid & 3;
  const int fr = lane & 31, fh = lane >> 5;
  uint4 ra0 = *(const uint4*)aptr(0, r0, kv), ra1 = *(const uint4*)aptr(0, r0 + 64, kv);
  uint4 rb0 = *(const uint4*)bptr(0, r0, kv), rb1 = *(const uint4*)bptr(0, r0 + 64, kv);
  *(uint4*)&s->a[0][r0][kv * 8] = ra0; *(uint4*)&s->a[0][r0 + 64][kv * 8] = ra1;
  *(uint4*)&s->b[0][r0][kv * 8] = rb0; *(uint4*)&s->b[0][r0 + 64][kv * 8] = rb1;
  __syncthreads();
#pragma unroll 1
  for (int kt = 0; kt < nk; ++kt) {
    const int buf = kt & 1;
    if (kt + 1 < nk) {
      ra0 = *(const uint4*)aptr(kt + 1, r0, kv); ra1 = *(const uint4*)aptr(kt + 1, r0 + 64, kv);
      rb0 = *(const uint4*)bptr(kt + 1, r0, kv); rb1 = *(const uint4*)bptr(kt + 1, r0 + 64, kv);
    }
#pragma unroll
    for (int ks = 0; ks < 2; ++ks) {
      bf16x8 af[2], bq[2];
#pragma unroll
      for (int i = 0; i < 2; ++i) af[i] = *(const bf16x8*)&s->a[buf][wr * 64 + i * 32 + fr][ks * 16 + fh * 8];
#pragma unroll
      for (int j = 0; j < 2; ++j) bq[j] = *(const bf16x8*)&s->b[buf][wc * 64 + j * 32 + fr][ks * 16 + fh * 8];
#pragma unroll
      for (int i = 0; i < 2; ++i)
#pragma unroll
        for (int j = 0; j < 2; ++j) acc[i][j] = MFMA(af[i], bq[j], acc[i][j]);
    }
    if (kt + 1 < nk) {
      *(uint4*)&s->a[buf ^ 1][r0][kv * 8] = ra0; *(uint4*)&s->a[buf ^ 1][r0 + 64][kv * 8] = ra1;
      *(uint4*)&s->b[buf ^ 1][r0][kv * 8] = rb0; *(uint4*)&s->b[buf ^ 1][r0 + 64][kv * 8] = rb1;
    }
    __syncthreads();
  }
}


struct GemmS2 { bf16_t a[128][72]; bf16_t b[128][72]; };
DI void g2_compute(f32x16 (&acc)[2][2], const GemmS2* s, int wr, int wc, int fr, int fh) {
#pragma unroll
  for (int ks = 0; ks < 4; ++ks) {
    bf16x8 af[2], bq[2];
#pragma unroll
    for (int i = 0; i < 2; ++i) af[i] = *(const bf16x8*)&s->a[wr * 64 + i * 32 + fr][ks * 16 + fh * 8];
#pragma unroll
    for (int j = 0; j < 2; ++j) bq[j] = *(const bf16x8*)&s->b[wc * 64 + j * 32 + fr][ks * 16 + fh * 8];
#pragma unroll
    for (int i = 0; i < 2; ++i)
#pragma unroll
      for (int j = 0; j < 2; ++j) acc[i][j] = MFMA(af[i], bq[j], acc[i][j]);
  }
}

template <class AF, class BF, class HK>
DI void gemm_core2(f32x16 (&acc)[2][2], GemmS2* s, AF aptr, BF bptr, int nk, HK hook) {
  int tid = threadIdx.x; asm volatile("" : "+v"(tid));
  const int lane = tid & 63, wave = tid >> 6, wr = wave >> 1, wc = wave & 1;
  const int r0 = tid >> 3, kc = tid & 7;
  const int fr = lane & 31, fh = lane >> 5;
  uint4 p0a0, p0a1, p0a2, p0a3, p0b0, p0b1, p0b2, p0b3, p1a0, p1a1, p1a2, p1a3, p1b0, p1b1, p1b2, p1b3;
#define G2_LOAD(S, KT) { \
    S##a0 = *(const uint4*)aptr((KT), r0, kc);      S##b0 = *(const uint4*)bptr((KT), r0, kc); \
    S##a1 = *(const uint4*)aptr((KT), r0 + 32, kc); S##b1 = *(const uint4*)bptr((KT), r0 + 32, kc); \
    S##a2 = *(const uint4*)aptr((KT), r0 + 64, kc); S##b2 = *(const uint4*)bptr((KT), r0 + 64, kc); \
    S##a3 = *(const uint4*)aptr((KT), r0 + 96, kc); S##b3 = *(const uint4*)bptr((KT), r0 + 96, kc); }
#define G2_STORE(S) { \
    *(uint4*)&s->a[r0][kc * 8] = S##a0;      *(uint4*)&s->b[r0][kc * 8] = S##b0; \
    *(uint4*)&s->a[r0 + 32][kc * 8] = S##a1; *(uint4*)&s->b[r0 + 32][kc * 8] = S##b1; \
    *(uint4*)&s->a[r0 + 64][kc * 8] = S##a2; *(uint4*)&s->b[r0 + 64][kc * 8] = S##b2; \
    *(uint4*)&s->a[r0 + 96][kc * 8] = S##a3; *(uint4*)&s->b[r0 + 96][kc * 8] = S##b3; }
#define G2_COMPUTE() g2_compute(acc, s, wr, wc, fr, fh);
  G2_LOAD(p0, 0)
  G2_LOAD(p1, 1)
  G2_STORE(p0)
  if (nk > 2) G2_LOAD(p0, 2)
  __syncthreads();
#pragma unroll 1
  for (int kt = 0; kt < nk; kt += 2) {
    hook(kt);
    G2_COMPUTE()
    __syncthreads();
    G2_STORE(p1)
    if (kt + 3 < nk) G2_LOAD(p1, kt + 3)
    __syncthreads();
    hook(kt + 1);
    G2_COMPUTE()
    __syncthreads();
    if (kt + 2 < nk) {
      G2_STORE(p0)
      if (kt + 4 < nk) G2_LOAD(p0, kt + 4)
    }
    __syncthreads();
  }
#undef G2_LOAD
#undef G2_STORE
#undef G2_COMPUTE
}


struct GemmS3 { bf16_t a[128][72]; bf16_t b[256][72]; };

template <class AF, class BF, class HK>
DI void gemm_core3(f32x16 (&acc)[2][4], GemmS3* s, AF aptr, BF bptr, int nk, HK hook) {
  int tid = threadIdx.x; asm volatile("" : "+v"(tid));
  const int lane = tid & 63, wave = tid >> 6, wr = wave >> 1, wc = wave & 1;
  const int r0 = tid >> 3, kc = tid & 7;
  const int fr = lane & 31, fh = lane >> 5;
  uint4 a0, a1, a2, a3, b0, b1, b2, b3, b4, b5, b6, b7;
#define G3_LOAD(KT) { \
    a0 = *(const uint4*)aptr((KT), r0, kc);       a1 = *(const uint4*)aptr((KT), r0 + 32, kc); \
    a2 = *(const uint4*)aptr((KT), r0 + 64, kc);  a3 = *(const uint4*)aptr((KT), r0 + 96, kc); \
    b0 = *(const uint4*)bptr((KT), r0, kc);       b1 = *(const uint4*)bptr((KT), r0 + 32, kc); \
    b2 = *(const uint4*)bptr((KT), r0 + 64, kc);  b3 = *(const uint4*)bptr((KT), r0 + 96, kc); \
    b4 = *(const uint4*)bptr((KT), r0 + 128, kc); b5 = *(const uint4*)bptr((KT), r0 + 160, kc); \
    b6 = *(const uint4*)bptr((KT), r0 + 192, kc); b7 = *(const uint4*)bptr((KT), r0 + 224, kc); }
#define G3_STORE() { \
    *(uint4*)&s->a[r0][kc * 8] = a0;       *(uint4*)&s->a[r0 + 32][kc * 8] = a1; \
    *(uint4*)&s->a[r0 + 64][kc * 8] = a2;  *(uint4*)&s->a[r0 + 96][kc * 8] = a3; \
    *(uint4*)&s->b[r0][kc * 8] = b0;       *(uint4*)&s->b[r0 + 32][kc * 8] = b1; \
    *(uint4*)&s->b[r0 + 64][kc * 8] = b2;  *(uint4*)&s->b[r0 + 96][kc * 8] = b3; \
    *(uint4*)&s->b[r0 + 128][kc * 8] = b4; *(uint4*)&s->b[r0 + 160][kc * 8] = b5; \
    *(uint4*)&s->b[r0 + 192][kc * 8] = b6; *(uint4*)&s->b[r0 + 224][kc * 8] = b7; }
  G3_LOAD(0)
  G3_STORE()
  __syncthreads();
#pragma unroll 1
  for (int kt = 0; kt < nk; ++kt) {
    if (kt + 1 < nk) G3_LOAD(kt + 1)
    hook(kt);
#pragma unroll
    for (int ks = 0; ks < 4; ++ks) {
      bf16x8 af[2], bq[4];
#pragma unroll
      for (int i = 0; i < 2; ++i) af[i] = *(const bf16x8*)&s->a[wr * 64 + i * 32 + fr][ks * 16 + fh * 8];
#pragma unroll
      for (int j = 0; j < 4; ++j) bq[j] = *(const bf16x8*)&s->b[wc * 128 + j * 32 + fr][ks * 16 + fh * 8];
#pragma unroll
      for (int i = 0; i < 2; ++i)
#pragma unroll
        for (int j = 0; j < 4; ++j) acc[i][j] = MFMA(af[i], bq[j], acc[i][j]);
    }
    __syncthreads();
    if (kt + 1 < nk) G3_STORE()
    __syncthreads();
  }
#undef G3_LOAD
#undef G3_STORE
}

template <class EPI>
DI void epilogue_lds2(f32x16 (&acc)[2][4], char* smem, int sub, EPI epi) {
  float* T = (float*)smem;
  int tid = threadIdx.x; asm volatile("" : "+v"(tid));
  const int lane = tid & 63, wave = tid >> 6, wr = wave >> 1, wc = wave & 1, fr = lane & 31, fh = lane >> 5;
#pragma unroll
  for (int i = 0; i < 2; ++i) {
    if (wc == sub) {
#pragma unroll
      for (int j = 0; j < 4; ++j)
#pragma unroll
        for (int r = 0; r < 16; ++r) T[(wr * 32 + crow(r, fh)) * 132 + j * 32 + fr] = acc[i][j][r];
    }
    __syncthreads();
#pragma unroll 2
    for (int e = tid; e < 2048; e += 256) {
      const int tr = e >> 5, c4 = (e & 31) * 4;
      const float4 v = *(const float4*)&T[tr * 132 + c4];
      epi((tr >> 5) * 64 + i * 32 + (tr & 31), c4, v);
    }
    __syncthreads();
  }
}

template <class EPI>
DI void epilogue_lds2w(f32x16 (&acc)[2][4], char* smem, int sub, EPI epi) {
  float* T = (float*)smem;
  int tid = threadIdx.x; asm volatile("" : "+v"(tid));
  const int lane = tid & 63, wave = tid >> 6, wr = wave >> 1, wc = wave & 1, fr = lane & 31, fh = lane >> 5;
#pragma unroll
  for (int i = 0; i < 2; ++i) {
    if (wc == sub) {
#pragma unroll
      for (int j = 0; j < 4; ++j)
#pragma unroll
        for (int r = 0; r < 16; ++r) T[(wr * 32 + crow(r, fh)) * 132 + j * 32 + fr] = acc[i][j][r];
    }
    __syncthreads();
#pragma unroll 2
    for (int e = tid; e < 1024; e += 256) {
      const int tr = e >> 4, c8 = (e & 15) * 8;
      const float4 lo = *(const float4*)&T[tr * 132 + c8];
      const float4 hi = *(const float4*)&T[tr * 132 + c8 + 4];
      epi((tr >> 5) * 64 + i * 32 + (tr & 31), c8, lo, hi);
    }
    __syncthreads();
  }
}

DI void epilogue_rope(f32x16 (&acc)[2][4], char* smem, int sub, bf16_t* dst, int ld, int cb, int row0, float sc) {
  float* T = (float*)smem;
  int tid = threadIdx.x; asm volatile("" : "+v"(tid));
  const int lane = tid & 63, wave = tid >> 6, wr = wave >> 1, wc = wave & 1, fr = lane & 31, fh = lane >> 5;
#pragma unroll
  for (int i = 0; i < 2; ++i) {
    if (wc == sub) {
#pragma unroll
      for (int j = 0; j < 4; ++j)
#pragma unroll
        for (int r = 0; r < 16; ++r) T[(wr * 32 + crow(r, fh)) * 132 + j * 32 + fr] = acc[i][j][r];
    }
    __syncthreads();
#pragma unroll 1
    for (int e = tid; e < 1024; e += 256) {
      const int tr = e >> 4, qi = e & 15;
      const int hd = qi >> 3, ax = (qi >> 2) & 1, f0 = (qi & 3) * 4;
      const int col1 = hd * 64 + ax * 32 + f0;
      const float4 v1 = *(const float4*)&T[tr * 132 + col1];
      const float4 v2 = *(const float4*)&T[tr * 132 + col1 + 16];
      const int rho = row0 + (tr >> 5) * 64 + i * 32 + (tr & 31);
      float a1[4] = {v1.x, v1.y, v1.z, v1.w}, a2[4] = {v2.x, v2.y, v2.z, v2.w}, o1[4], o2[4];
      if (rho < RL_) {
        const int t = rho & 4095;
        const float pos = (float)(ax == 0 ? (t >> 6) : (t & 63));
#pragma unroll
        for (int u = 0; u < 4; ++u) {
          const float ang = pos * exp2f(-(float)(f0 + u) * 0.8304820237218406f);
          const float cs = __cosf(ang), sn = __sinf(ang);
          o1[u] = (a1[u] * cs - a2[u] * sn) * sc;
          o2[u] = (a2[u] * cs + a1[u] * sn) * sc;
        }
      } else {
#pragma unroll
        for (int u = 0; u < 4; ++u) { o1[u] = a1[u] * sc; o2[u] = a2[u] * sc; }
      }
      uint2 w1, w2;
      w1.x = pack2(o1[0], o1[1]); w1.y = pack2(o1[2], o1[3]);
      w2.x = pack2(o2[0], o2[1]); w2.y = pack2(o2[2], o2[3]);
      bf16_t* dp = dst + (size_t)rho * ld + cb + col1;
      *(uint2*)dp = w1;
      *(uint2*)(dp + 16) = w2;
    }
    __syncthreads();
  }
}

DI bool xcd_tile(int step, int nM, int nN, int& mt, int& nt) {
  const int xcd = blockIdx.x & 7, nloc = gridDim.x >> 3;
  const int j = (blockIdx.x >> 3) + step * nloc;
  const int mloc = nM >> 3;
  if ((gridDim.x & 7) != 0 || j >= mloc * nN) return false;
  const int per = 8 * nN;
  const int gm = j / per, rem = j - gm * per;
  const int hgt = min(8, mloc - gm * 8);
  const int a = rem % hgt;
  nt = rem / hgt;
  mt = (gm * 8 + a) * 8 + xcd;
  return true;
}

DI void zero_acc(f32x16 (&acc)[2][2]) {
#pragma unroll
  for (int i = 0; i < 2; ++i)
#pragma unroll
    for (int j = 0; j < 2; ++j)
#pragma unroll
      for (int r = 0; r < 16; ++r) acc[i][j][r] = 0.f;
}

template <class EPI>
DI void epilogue_lds(f32x16 (&acc)[2][2], char* smem, EPI epi) {
  float* T = (float*)smem;
  int tid = threadIdx.x; asm volatile("" : "+v"(tid)); const int lane = tid & 63, wave = tid >> 6, wr = wave >> 1, wc = wave & 1, fr = lane & 31, fh = lane >> 5;
#pragma unroll
  for (int i = 0; i < 2; ++i) {
#pragma unroll
    for (int j = 0; j < 2; ++j)
#pragma unroll
      for (int r = 0; r < 16; ++r) T[(wr * 32 + crow(r, fh)) * 132 + wc * 64 + j * 32 + fr] = acc[i][j][r];
    __syncthreads();
#pragma unroll 2
    for (int e = tid; e < 2048; e += 256) {
      const int tr = e >> 5, c4 = (e & 31) * 4;
      const float4 v = *(const float4*)&T[tr * 132 + c4];
      epi((tr >> 5) * 64 + i * 32 + (tr & 31), c4, v);
    }
    __syncthreads();
  }
}

DI void phase_mods(const Params& p_in, char* smem) {
  const Params p = load_params();

  float* ssc = (float*)smem;
  float* red = (float*)(smem + 20480);
  float* mods = (float*)(p.ws + OFF_MODS);
  int tid = threadIdx.x; asm volatile("" : "+v"(tid));
  for (int it = blockIdx.x; it < 192; it += gridDim.x) {
    const int l = it / 96, col0 = (it % 96) * 32;
    __syncthreads();
    for (int e = tid; e < 5120; e += 256) {
      const int v = e >> 10, k = e & 1023;
      const float cv = (v < 4) ? p.c[v * 1024 + k] : p.c_ctx[k];
      ssc[e] = silu_f(cv);
    }
    __syncthreads();
    const int col = tid & 31, kg = tid >> 5;
    float a[5] = {0.f, 0.f, 0.f, 0.f, 0.f};
    const float* w = p.w_mod + (size_t)l * 1024 * 3072 + col0 + col;
    for (int k = kg * 128; k < kg * 128 + 128; k += 32) {
      float wv[32];
#pragma unroll
      for (int u = 0; u < 32; ++u) wv[u] = w[(size_t)(k + u) * 3072];
#pragma unroll
      for (int u = 0; u < 32; ++u)
#pragma unroll
        for (int v = 0; v < 5; ++v) a[v] += ssc[v * 1024 + k + u] * wv[u];
    }
#pragma unroll
    for (int v = 0; v < 5; ++v) red[(kg * 5 + v) * 32 + col] = a[v];
    __syncthreads();
    for (int e = tid; e < 160; e += 256) {
      const int v = e >> 5, cc = e & 31;
      float sum = p.b_mod[l * 3072 + col0 + cc];
      for (int g = 0; g < 8; ++g) sum += red[(g * 5 + v) * 32 + cc];
      mods[(l * 5 + v) * 3072 + col0 + cc] = sum;
    }
  }
}

DI int win_colmap(int n) {
  if (n < 2560) return n;
  if (n < 3840) return n + 32;
  if (n < 4864) {
    const int j = n - 3840, q64 = j >> 6, w = j & 63;
    return (w < 32) ? (3872 + q64 * 32 + w) : (3872 + 512 + q64 * 32 + (w - 32));
  }
  if (n < 5376) return n + 32;
  if (n < 5408) return n - 5376 + 2560;
  return -1;
}

DI void transpose_tile(const float* src, int ldsrc, int kind, const float* rowscale, bf16_t* dst, int lddst, int n0, int k0, float* tile) {
  int tid = threadIdx.x; asm volatile("" : "+v"(tid));
  __syncthreads();
  {
    const int c4 = (tid & 15) * 4, rr = tid >> 4;
    const int n = (kind == 0) ? win_colmap(n0 + c4) : (n0 + c4);
#pragma unroll
    for (int ps = 0; ps < 4; ++ps) {
      const int r = rr + ps * 16, k = k0 + r;
      float4 v = make_float4(0.f, 0.f, 0.f, 0.f);
      if (n >= 0) v = *(const float4*)(src + (size_t)k * ldsrc + n);
      if (rowscale != nullptr && k < 1024) { const float s = rowscale[k]; v.x *= s; v.y *= s; v.z *= s; v.w *= s; }
      tile[r * 65 + c4] = v.x; tile[r * 65 + c4 + 1] = v.y; tile[r * 65 + c4 + 2] = v.z; tile[r * 65 + c4 + 3] = v.w;
    }
  }
  __syncthreads();
  {
    const int k8 = (tid & 7) * 8, nn = tid >> 3;
#pragma unroll
    for (int ps = 0; ps < 2; ++ps) {
      const int r = nn + ps * 32;
      uint4 o;
      o.x = pack2(tile[(k8 + 0) * 65 + r], tile[(k8 + 1) * 65 + r]);
      o.y = pack2(tile[(k8 + 2) * 65 + r], tile[(k8 + 3) * 65 + r]);
      o.z = pack2(tile[(k8 + 4) * 65 + r], tile[(k8 + 5) * 65 + r]);
      o.w = pack2(tile[(k8 + 6) * 65 + r], tile[(k8 + 7) * 65 + r]);
      *(uint4*)(dst + (size_t)(n0 + r) * lddst + k0 + k8) = o;
    }
  }
}

DI void phase_prep(const Params& p_in, int l, char* smem) {
  const Params p = load_params();

  int tid = threadIdx.x; asm volatile("" : "+v"(tid)); const int lane = tid & 63, wave = tid >> 6;
  const float* mods = (const float*)(p.ws + OFF_MODS);
  bf16_t* H = (bf16_t*)(p.ws + OFF_H);
  const int NT_WIN = 88 * 16, NT_WOUT = 16 * 32, NT_PW = 64, NT_CONV = NT_WIN + NT_WOUT + NT_PW;
  const int NT = NT_CONV + R_ / 8;
  for (int it = blockIdx.x; it < NT; it += gridDim.x) {
    if (l == 1 && (it < NT_WIN || (it >= NT_WIN + NT_WOUT && it < NT_CONV))) continue;
    if (it < NT_WIN) {
      transpose_tile(p.w_in + (size_t)l * 1024 * 5408, 5408, 0, nullptr, (bf16_t*)(p.ws + OFF_WIN), 1024, (it / 16) * 64, (it % 16) * 64, (float*)smem);
    } else if (it < NT_WIN + NT_WOUT) {
      const int t = it - NT_WIN;
      transpose_tile(p.w_out + (size_t)l * 2048 * 1024, 1024, 1, p.ssd_norm_w + l * 1024, (bf16_t*)(p.ws + OFF_WOUT), 2048, (t / 32) * 64, (t % 32) * 64, (float*)smem);
    } else if (it < NT_CONV) {
      const int t = it - NT_WIN - NT_WOUT;
      transpose_tile(p.conv_pw_w + (size_t)l * 512 * 512, 512, 1, nullptr, (bf16_t*)(p.ws + OFF_PW), 512, (t / 8) * 64, (t % 8) * 64, (float*)smem);
    } else {
      const int rho0 = (it - NT_CONV) * 8 + wave * 2;
      const float* xs0;
      if (l == 0) xs0 = (rho0 < RL_) ? (p.x + (size_t)rho0 * 1024) : (p.ctx + (size_t)(rho0 - RL_) * 1024);
      else xs0 = (rho0 < RL_) ? (p.out + (size_t)rho0 * 1024) : ((const float*)(p.ws + OFF_XC) + (size_t)(rho0 - RL_) * 1024);
      const int v = (rho0 < RL_) ? (rho0 >> 12) : 4;
      const float* md = mods + (l * 5 + v) * 3072;
      float4 xv[2][4], nwv[4], shv[4], scv4[4];
#pragma unroll
      for (int i = 0; i < 4; ++i) {
        const int cidx = lane * 4 + i * 256;
        xv[0][i] = *(const float4*)(xs0 + cidx);
        xv[1][i] = *(const float4*)(xs0 + 1024 + cidx);
        nwv[i] = *(const float4*)(p.norm_w + l * 1024 + cidx);
        shv[i] = *(const float4*)(md + cidx);
        scv4[i] = *(const float4*)(md + 1024 + cidx);
      }
#pragma unroll
      for (int q = 0; q < 2; ++q) {
        float ss = 0.f;
#pragma unroll
        for (int i = 0; i < 4; ++i) ss += xv[q][i].x * xv[q][i].x + xv[q][i].y * xv[q][i].y + xv[q][i].z * xv[q][i].z + xv[q][i].w * xv[q][i].w;
#pragma unroll
        for (int o = 32; o >= 1; o >>= 1) ss += __shfl_xor(ss, o);
        const float rs = rsqrtf(ss * (1.f / 1024.f) + 1e-6f);
#pragma unroll
        for (int i = 0; i < 4; ++i) {
          const int cidx = lane * 4 + i * 256;
          const float4 nw = nwv[i], sh = shv[i], sc = scv4[i];
          uint2 o;
          o.x = pack2(xv[q][i].x * rs * nw.x * (1.f + sc.x) + sh.x, xv[q][i].y * rs * nw.y * (1.f + sc.y) + sh.y);
          o.y = pack2(xv[q][i].z * rs * nw.z * (1.f + sc.z) + sh.z, xv[q][i].w * rs * nw.w * (1.f + sc.w) + sh.w);
          *(uint2*)(H + (size_t)(rho0 + q) * 1024 + cidx) = o;
        }
      }
    }
  }
}

DI void phase_inproj(const Params& p_in, char* smem) {
  const Params p = load_params();
  int tid = threadIdx.x; asm volatile("" : "+v"(tid)); const int wave = tid >> 6, wc = wave & 1;
  const bf16_t* H = (const bf16_t*)(p.ws + OFF_H);
  const bf16_t* W = (const bf16_t*)(p.ws + OFF_WIN);
  for (int step = 0;; ++step) {
    int mt, nt2;
    if (!xcd_tile(step, NCK, 22, mt, nt2)) break;
    f32x16 acc[2][4];
#pragma unroll
    for (int i = 0; i < 2; ++i)
#pragma unroll
      for (int j = 0; j < 4; ++j)
#pragma unroll
        for (int r = 0; r < 16; ++r) acc[i][j][r] = 0.f;
    const bf16_t* Ab = H + (size_t)mt * 128 * 1024;
    const bf16_t* Bb = W + (size_t)nt2 * 256 * 1024;
    gemm_core3(acc, (GemmS3*)smem,
               [&](int kt, int r, int kv) { return Ab + (size_t)r * 1024 + kt * 64 + kv * 8; },
               [&](int kt, int r, int kv) { return Bb + (size_t)r * 1024 + kt * 64 + kv * 8; }, 16, [](int) {});
    const int row0 = mt * 128;
    {
      const int ntw = nt2 * 2 + wc;
      if (ntw >= 30 && ntw < 38) {
#pragma unroll
        for (int i = 0; i < 2; ++i)
#pragma unroll
          for (int r = 0; r < 16; ++r) {
            acc[i][0][r] = acc[i][0][r] * sigmoid_f(acc[i][1][r]);
            acc[i][2][r] = acc[i][2][r] * sigmoid_f(acc[i][3][r]);
          }
      }
    }
#pragma unroll 1
    for (int sub = 0; sub < 2; ++sub) {
      const int nt = nt2 * 2 + sub;
      if (nt >= 43) break;
      if (nt >= 30 && nt < 38) {
        bf16_t* G = (bf16_t*)(p.ws + OFF_GLU);
        const int cb0 = (nt - 30) * 64;
        epilogue_lds2w(acc, smem, sub, [&](int rl, int c8, float4 lo, float4 hi) {
          if ((c8 & 32) == 0) {
            uint4 o; o.x = pack2(lo.x, lo.y); o.y = pack2(lo.z, lo.w); o.z = pack2(hi.x, hi.y); o.w = pack2(hi.z, hi.w);
            *(uint4*)(G + (size_t)(row0 + rl) * 512 + cb0 + (c8 >> 6) * 32 + (c8 & 31)) = o;
          }
        });
      } else if (nt >= 20 && nt < 24) {
        epilogue_rope(acc, smem, sub, (bf16_t*)(p.ws + OFF_Q), 512, nt * 128 - 2560, row0, 0.18033688011112042f);
      } else if (nt == 24) {
        epilogue_rope(acc, smem, sub, (bf16_t*)(p.ws + OFF_KV), 256, 0, row0, 1.f);
      } else if (nt == 42) {
        float* DT = (float*)(p.ws + OFF_DT);
        epilogue_lds2(acc, smem, sub, [&](int rl, int c4, float4 v) {
          if (c4 < 32) *(float4*)(DT + (size_t)(row0 + rl) * 32 + c4) = v;
        });
      } else {
        bf16_t* dst; int ld, cb;
        if (nt < 12) { dst = (bf16_t*)(p.ws + OFF_XBC); ld = 1536; cb = nt * 128; }
        else if (nt < 20) { dst = (bf16_t*)(p.ws + OFF_Z); ld = 1024; cb = nt * 128 - 1536; }
        else if (nt < 24) { dst = (bf16_t*)(p.ws + OFF_Q); ld = 512; cb = nt * 128 - 2560; }
        else if (nt < 26) { dst = (bf16_t*)(p.ws + OFF_KV); ld = 256; cb = nt * 128 - 3072; }
        else if (nt < 30) { dst = (bf16_t*)(p.ws + OFF_AG); ld = 512; cb = nt * 128 - 3328; }
        else { dst = (bf16_t*)(p.ws + OFF_CG); ld = 512; cb = nt * 128 - 4864; }
        epilogue_lds2w(acc, smem, sub, [&](int rl, int c8, float4 lo, float4 hi) {
          uint4 o; o.x = pack2(lo.x, lo.y); o.y = pack2(lo.z, lo.w); o.z = pack2(hi.x, hi.y); o.w = pack2(hi.z, hi.w);
          *(uint4*)(dst + (size_t)(row0 + rl) * ld + cb + c8) = o;
        });
      }
    }
  }
}

DI void phase_local(const Params& p_in, int l, char* smem) {
  const Params p = load_params();

  int tid = threadIdx.x; asm volatile("" : "+v"(tid)); const int lane = tid & 63;
  const bf16_t* XBC = (const bf16_t*)(p.ws + OFF_XBC);
  bf16_t* XS = (bf16_t*)(p.ws + OFF_H);
  bf16_t* BC = (bf16_t*)(p.ws + OFF_BC);
  float* DT = (float*)(p.ws + OFF_DT);
  float* CS = (float*)(p.ws + OFF_CS);
  const bf16_t* GLU = (const bf16_t*)(p.ws + OFF_GLU);
  bf16_t* HDN = (bf16_t*)(p.ws + OFF_HDN);
  bf16_t* Q = (bf16_t*)(p.ws + OFF_Q);
  bf16_t* KV = (bf16_t*)(p.ws + OFF_KV);
  { float* SSQ = (float*)(p.ws + OFF_RSTD); for (int i = blockIdx.x * 256 + tid; i < R_ * 2; i += gridDim.x * 256) SSQ[i] = 0.f; }
  const int N_CONV = (R_ / 4) * 192 / 256;
  const int N_DT = NCK;
  const int N_CF = R_ / 16;
  const int N_ROPE = 0;
  const int N_QC = 0;
  const int NT = N_CF + N_DT + N_CONV + N_ROPE + N_QC;
  for (int it0 = blockIdx.x; it0 < NT; it0 += gridDim.x) {
    int it = it0;
    if (it < N_CF) {
      float* sst = (float*)smem;
      unsigned* sIn = (unsigned*)(smem + 256);
      const int row0 = it * 16;
      const int seq0 = (row0 < RL_) ? (row0 & ~4095) : (RL_ + ((row0 - RL_) & ~255));
      const int slen = (row0 < RL_) ? 4096 : 256;
      const int t0 = row0 - seq0;
      const int c0 = tid * 2;
      __syncthreads();
      if (tid < 32) sst[tid] = 0.f;
      for (int idx = tid; idx < 46 * 64; idx += 256) {
        const int rr = idx >> 6, c16 = idx & 63;
        const int tt = t0 - 15 + rr;
        uint4 val = make_uint4(0u, 0u, 0u, 0u);
        if (tt >= 0 && tt < slen) val = *(const uint4*)(GLU + (size_t)(seq0 + tt) * 512 + c16 * 8);
        *(uint4*)&sIn[rr * 256 + c16 * 4] = val;
      }
      float w0[31], w1[31];
#pragma unroll
      for (int k = 0; k < 31; ++k) {
        const float2 wv = *(const float2*)(p.conv_dw_w + ((size_t)l * 31 + k) * 512 + c0);
        w0[k] = wv.x; w1[k] = wv.y;
      }
      const float2 bv = *(const float2*)(p.conv_dw_b + l * 512 + c0);
      float a0[16], a1[16];
#pragma unroll
      for (int r = 0; r < 16; ++r) { a0[r] = bv.x; a1[r] = bv.y; }
      __syncthreads();
#pragma unroll
      for (int tp = 0; tp < 46; ++tp) {
        const unsigned u = sIn[tp * 256 + tid];
        const float x0 = lo2f(u), x1 = hi2f(u);
#pragma unroll
        for (int r = 0; r < 16; ++r) {
          const int k = tp - r;
          if (k >= 0 && k < 31) { a0[r] += w0[k] * x0; a1[r] += w1[k] * x1; }
        }
        if ((tp & 7) == 7) __builtin_amdgcn_sched_barrier(0);
      }
      {
        float v[32];
#pragma unroll
        for (int r = 0; r < 16; ++r) { v[2 * r] = a0[r] + a1[r]; v[2 * r + 1] = a0[r] * a0[r] + a1[r] * a1[r]; }
#pragma unroll
        for (int i = 0; i < 16; ++i) { const bool up = (lane & 32) != 0; const float keep = up ? v[i + 16] : v[i]; const float send = up ? v[i] : v[i + 16]; v[i] = keep + __shfl_xor(send, 32); }
#pragma unroll
        for (int i = 0; i < 8; ++i) { const bool up = (lane & 16) != 0; const float keep = up ? v[i + 8] : v[i]; const float send = up ? v[i] : v[i + 8]; v[i] = keep + __shfl_xor(send, 16); }
#pragma unroll
        for (int i = 0; i < 4; ++i) { const bool up = (lane & 8) != 0; const float keep = up ? v[i + 4] : v[i]; const float send = up ? v[i] : v[i + 4]; v[i] = keep + __shfl_xor(send, 8); }
#pragma unroll
        for (int i = 0; i < 2; ++i) { const bool up = (lane & 4) != 0; const float keep = up ? v[i + 2] : v[i]; const float send = up ? v[i] : v[i + 2]; v[i] = keep + __shfl_xor(send, 4); }
        { const bool up = (lane & 2) != 0; const float keep = up ? v[1] : v[0]; const float send = up ? v[0] : v[1]; v[0] = keep + __shfl_xor(send, 2); }
        v[0] += __shfl_xor(v[0], 1);
        __syncthreads();
        if ((lane & 1) == 0) atomicAdd(&sst[lane >> 1], v[0]);
      }
      __syncthreads();
      const float2 lw = *(const float2*)(p.conv_ln_w + l * 512 + c0);
      const float2 lb = *(const float2*)(p.conv_ln_b + l * 512 + c0);
#pragma unroll
      for (int r = 0; r < 16; ++r) {
        const float mean = sst[r * 2] * (1.f / 512.f);
        const float var = fmaxf(sst[r * 2 + 1] * (1.f / 512.f) - mean * mean, 0.f);
        const float rs = rsqrtf(var + 1e-6f);
        const float y0 = (a0[r] - mean) * rs * lw.x + lb.x;
        const float y1 = (a1[r] - mean) * rs * lw.y + lb.y;
        *(unsigned*)(HDN + (size_t)(row0 + r) * 512 + c0) = pack2(silu_f(y0), silu_f(y1));
        if ((r & 3) == 3) __builtin_amdgcn_sched_barrier(0);
      }
      continue;
    }
    it -= N_CF;
    if (it < N_DT) {
      float* sdt = (float*)smem;
      float* ssum = (float*)(smem + 128 * 33 * 4);
      const int row0 = it * 128;
      __syncthreads();
      for (int e = tid; e < 4096; e += 256) {
        const int r = e >> 5, cidx = e & 31;
        const float raw = DT[(size_t)(row0 + r) * 32 + cidx] + p.ssd_dt_bias[l * 32 + cidx];
        const float sp = (raw > 20.f) ? raw : log1pf(expf(raw));
        DT[(size_t)(row0 + r) * 32 + cidx] = sp;
        sdt[r * 33 + cidx] = sp;
      }
      __syncthreads();
      const int col = tid & 31, seg = tid >> 5;
      const float a = -expf(p.ssd_a_log[l * 32 + col]);
      float loc[16];
      float run = 0.f;
      if (col < 16) {
#pragma unroll
        for (int r = 0; r < 16; ++r) { run += sdt[(seg * 16 + r) * 33 + col] * a; loc[r] = run; }
      } else {
#pragma unroll
        for (int r = 15; r >= 0; --r) { run += sdt[(seg * 16 + r) * 33 + col] * a; loc[r] = run; }
      }
      ssum[seg * 32 + col] = run;
      __syncthreads();
      float off = 0.f;
      if (col < 16) { for (int s2 = 0; s2 < seg; ++s2) off += ssum[s2 * 32 + col]; }
      else { for (int s2 = 7; s2 > seg; --s2) off += ssum[s2 * 32 + col]; }
#pragma unroll
      for (int r = 0; r < 16; ++r) CS[(size_t)(row0 + seg * 16 + r) * 32 + col] = off + loc[r];
      continue;
    }
    it -= N_DT;
    if (it < N_CONV) {
      const int e = it * 256 + tid;
      const int rb = e / 192, cgp = e % 192, ch0 = cgp * 8;
      const int rho0 = rb * 4;
      const int seq0 = (rho0 < RL_) ? (rho0 & ~4095) : (RL_ + ((rho0 - RL_) & ~255));
      const int slen = (rho0 < RL_) ? 4096 : 256;
      const int t0 = rho0 - seq0;
      uint4 xr[8];
#pragma unroll
      for (int i = 0; i < 8; ++i) {
        const int tt = t0 + i - 2;
        xr[i] = make_uint4(0u, 0u, 0u, 0u);
        if (tt >= 0 && tt < slen) xr[i] = *(const uint4*)(XBC + (size_t)(seq0 + tt) * 1536 + ch0);
      }
      float wk[5][8];
#pragma unroll
      for (int k = 0; k < 5; ++k) {
        const float4 w0 = *(const float4*)(p.ssd_conv_w + ((size_t)l * 5 + k) * 1536 + ch0);
        const float4 w1 = *(const float4*)(p.ssd_conv_w + ((size_t)l * 5 + k) * 1536 + ch0 + 4);
        wk[k][0] = w0.x; wk[k][1] = w0.y; wk[k][2] = w0.z; wk[k][3] = w0.w; wk[k][4] = w1.x; wk[k][5] = w1.y; wk[k][6] = w1.z; wk[k][7] = w1.w;
      }
      float bias[8];
      {
        const float4 b0 = *(const float4*)(p.ssd_conv_b + l * 1536 + ch0);
        const float4 b1 = *(const float4*)(p.ssd_conv_b + l * 1536 + ch0 + 4);
        bias[0] = b0.x; bias[1] = b0.y; bias[2] = b0.z; bias[3] = b0.w; bias[4] = b1.x; bias[5] = b1.y; bias[6] = b1.z; bias[7] = b1.w;
      }
#pragma unroll
      for (int r = 0; r < 4; ++r) {
        float a[8];
#pragma unroll
        for (int c = 0; c < 8; ++c) a[c] = bias[c];
#pragma unroll
        for (int k = 0; k < 5; ++k) {
          const uint4 u = xr[r + k];
          a[0] += wk[k][0] * lo2f(u.x); a[1] += wk[k][1] * hi2f(u.x); a[2] += wk[k][2] * lo2f(u.y); a[3] += wk[k][3] * hi2f(u.y);
          a[4] += wk[k][4] * lo2f(u.z); a[5] += wk[k][5] * hi2f(u.z); a[6] += wk[k][6] * lo2f(u.w); a[7] += wk[k][7] * hi2f(u.w);
        }
        uint4 o;
        o.x = pack2(silu_f(a[0]), silu_f(a[1])); o.y = pack2(silu_f(a[2]), silu_f(a[3]));
        o.z = pack2(silu_f(a[4]), silu_f(a[5])); o.w = pack2(silu_f(a[6]), silu_f(a[7]));
        const size_t rho = (size_t)(rho0 + r);
        if (ch0 < 1024) *(uint4*)(XS + rho * 1024 + ch0) = o;
        else *(uint4*)(BC + rho * 512 + (ch0 - 1024)) = o;
      }
      continue;
    }
    it -= N_CONV;
    if (it < N_ROPE) {
      const int e = it * 256 + tid;
      const int rho = e / 40, rem = e % 40, hd = rem >> 2, sub = rem & 3;
      const int axis = sub >> 1, half = sub & 1;
      const int t = rho & 4095;
      const float pos = (float)(axis == 0 ? (t >> 6) : (t & 63));
      bf16_t* base = ((hd < 8) ? (Q + (size_t)rho * 512 + hd * 64) : (KV + (size_t)rho * 256 + (hd - 8) * 64)) + axis * 32 + half * 8;
      const float sc = (hd < 8) ? 0.18033688011112042f : 1.f;
      const uint4 u1 = *(const uint4*)base, u2 = *(const uint4*)(base + 16);
      const unsigned a1[4] = {u1.x, u1.y, u1.z, u1.w}, a2[4] = {u2.x, u2.y, u2.z, u2.w};
      unsigned o1[4], o2[4];
#pragma unroll
      for (int i = 0; i < 4; ++i) {
        float r1[2], r2[2];
#pragma unroll
        for (int hl = 0; hl < 2; ++hl) {
          const float f = (float)(half * 8 + 2 * i + hl);
          const float ang = pos * exp2f(-f * 0.8304820237218406f);
          const float cs = __cosf(ang), sn = __sinf(ang);
          const float t1 = hl ? hi2f(a1[i]) : lo2f(a1[i]);
          const float t2 = hl ? hi2f(a2[i]) : lo2f(a2[i]);
          r1[hl] = (t1 * cs - t2 * sn) * sc;
          r2[hl] = (t2 * cs + t1 * sn) * sc;
        }
        o1[i] = pack2(r1[0], r1[1]); o2[i] = pack2(r2[0], r2[1]);
      }
      *(uint4*)base = make_uint4(o1[0], o1[1], o1[2], o1[3]);
      *(uint4*)(base + 16) = make_uint4(o2[0], o2[1], o2[2], o2[3]);
      continue;
    }
    it -= N_ROPE;
    {
      const int e = it * 256 + tid;
      const int rho = RL_ + e / 256, c2 = (e % 256) * 2;
      unsigned* ptr = (unsigned*)(Q + (size_t)rho * 512 + c2);
      const unsigned u = *ptr;
      *ptr = pack2(lo2f(u) * 0.18033688011112042f, hi2f(u) * 0.18033688011112042f);
    }
  }
}

DI void attn_item(const Params& p_in, int l, char* smem, int b, int qblk, int g, int hp, bool ctxq) {
  const Params p = load_params();

  bf16_t* sK = (bf16_t*)smem;
  bf16_t* sV = (bf16_t*)(smem + 128 * 72 * 2);
  int tid = threadIdx.x; asm volatile("" : "+v"(tid)); const int lane = tid & 63, wave = tid >> 6, fr = lane & 31, fh = lane >> 5;
  const int head = g * 4 + hp * 2 + (wave >> 1);
  const int qh = wave & 1;
  const int qrow0 = (ctxq ? (RL_ + b * 256) : (b * 4096)) + qblk * 128 + qh * 64;
  const int qpos0 = qblk * 128 + qh * 64;
  bf16_t* Q = (bf16_t*)(p.ws + OFF_Q);
  const bf16_t* KV = (const bf16_t*)(p.ws + OFF_KV);
  const bf16_t* AG = (const bf16_t*)(p.ws + OFF_AG);
  f32x16 o[2][2];
  zero_acc(o);
  float m[2], lsum[2];
  m[0] = m[1] = p.attn_sink[l * 8 + head] * 1.4426950408889634f;
  lsum[0] = lsum[1] = 1.f;
  const int nhb = ctxq ? 4 : 10;
  auto hb_row = [&](int hb) -> int {
    if (hb >= nhb) return -1;
    if (hb < 4) return RL_ + b * 256 + hb * 64;
    const int kp = (qblk - 1) * 128 + (hb - 4) * 64;
    if (kp < 0 || kp >= 4096) return -1;
    return b * 4096 + kp;
  };
  auto hb_next = [&](int hb) -> int { int n = hb + 1; while (n < nhb && hb_row(n) < 0) ++n; return n; };
  const int sr = tid >> 3, scv = tid & 7;
  uint4 kp0, kp1, vp0, vp1;
#define ATT_PREFETCH(ROW0) { const bf16_t* kvp = KV + (size_t)((ROW0) + sr) * 256 + g * 64 + scv * 8; \
    kp0 = *(const uint4*)(kvp); kp1 = *(const uint4*)(kvp + 32 * 256); vp0 = *(const uint4*)(kvp + 128); vp1 = *(const uint4*)(kvp + 128 + 32 * 256); }
#define ATT_STORE(BUF) { bf16_t* k_ = sK + (BUF) * 64 * 72; bf16_t* v_ = sV + (BUF) * 64 * 72; \
    *(uint4*)&k_[sr * 72 + scv * 8] = kp0; *(uint4*)&k_[(sr + 32) * 72 + scv * 8] = kp1; \
    *(uint4*)&v_[sr * 72 + scv * 8] = vp0; *(uint4*)&v_[(sr + 32) * 72 + scv * 8] = vp1; }
  int pbuf = 0;
  __syncthreads();
  ATT_PREFETCH(hb_row(0))
  ATT_STORE(0)
  __syncthreads();
  for (int hb = 0; hb < nhb; hb = hb_next(hb)) {
    const int nxt = hb_next(hb);
    if (nxt < nhb) ATT_PREFETCH(hb_row(nxt))
    int kpos0 = 0;
    bool masked = false;
    if (hb >= 4) { kpos0 = (qblk - 1) * 128 + (hb - 4) * 64; masked = (hb != 6 && hb != 7); }
    const bf16_t* cK = sK + pbuf * 64 * 72;
    const bf16_t* cV = sV + pbuf * 64 * 72;
    bf16x8 qf[2][4];
#pragma unroll
    for (int j = 0; j < 2; ++j)
#pragma unroll
      for (int ks = 0; ks < 4; ++ks)
        qf[j][ks] = *(const bf16x8*)(Q + (size_t)(qrow0 + j * 32 + fr) * 512 + head * 64 + ks * 16 + fh * 8);
#pragma unroll 1
    for (int kb = 0; kb < 2; ++kb) {
      if (masked) {
        const int klo = kpos0 + kb * 32, khi = klo + 31;
        if (klo - (qpos0 + 63) > 128 || qpos0 - khi > 128) continue;
      }
      bf16x8 pb[2][2];
#pragma unroll
      for (int j = 0; j < 2; ++j) {
        f32x16 st[2];
#pragma unroll
        for (int r = 0; r < 16; ++r) st[j][r] = -m[j];
#pragma unroll
        for (int ks = 0; ks < 4; ++ks) {
          const bf16x8 kf = *(const bf16x8*)&cK[(kb * 32 + fr) * 72 + ks * 16 + fh * 8];
          st[j] = MFMA(kf, qf[j][ks], st[j]);
        }
        if (masked) {
          const int qpos = qpos0 + j * 32 + fr;
#pragma unroll
          for (int r = 0; r < 16; ++r) {
            const int d = qpos - (kpos0 + kb * 32 + crow(r, fh));
            if (d > 128 || d < -128) st[j][r] = -1e30f;
          }
        }
        float mx = st[j][0];
#pragma unroll
        for (int r = 1; r < 16; ++r) mx = fmaxf(mx, st[j][r]);
        mx = fmaxf(mx, __shfl_xor(mx, 32));
        const bool grow = mx > 8.f;
        if (__builtin_amdgcn_ballot_w64(grow) != 0ull) {
          const float delta = grow ? mx : 0.f;
          const float alpha = __builtin_amdgcn_exp2f(-delta);
#pragma unroll
          for (int r = 0; r < 16; ++r) st[j][r] -= delta;
          lsum[j] *= alpha;
          m[j] += delta;
#pragma unroll
          for (int mt = 0; mt < 2; ++mt)
#pragma unroll
            for (int r = 0; r < 16; ++r) o[mt][j][r] *= alpha;
        }
        float rs = 0.f;
#pragma unroll
        for (int r = 0; r < 16; ++r) { const float pv = __builtin_amdgcn_exp2f(st[j][r]); st[j][r] = pv; rs += pv; }
        rs += __shfl_xor(rs, 32);
        lsum[j] += rs;
#pragma unroll
        for (int s = 0; s < 2; ++s) {
          uint4 pk;
          pk.x = pack2(st[j][8 * s + 0], st[j][8 * s + 1]); pk.y = pack2(st[j][8 * s + 2], st[j][8 * s + 3]);
          pk.z = pack2(st[j][8 * s + 4], st[j][8 * s + 5]); pk.w = pack2(st[j][8 * s + 6], st[j][8 * s + 7]);
          pb[j][s] = __builtin_bit_cast(bf16x8, pk);
        }
      }
#pragma unroll
      for (int s = 0; s < 2; ++s)
#pragma unroll
        for (int mt = 0; mt < 2; ++mt) {
          const bf16x8 vf = tr_frag(cV, 72, kb * 32 + 16 * s + 4 * fh, kb * 32 + 16 * s + 8 + 4 * fh, mt * 32);
#pragma unroll
          for (int j = 0; j < 2; ++j) o[mt][j] = MFMA(vf, pb[j][s], o[mt][j]);
        }
    }
    if (nxt < nhb) ATT_STORE(pbuf ^ 1)
    pbuf ^= 1;
    __syncthreads();
  }
#undef ATT_PREFETCH
#undef ATT_STORE
#pragma unroll
  for (int j = 0; j < 2; ++j) {
    const float inv = 1.f / lsum[j];
    const size_t rho = (size_t)(qrow0 + j * 32 + fr);
#pragma unroll
    for (int mt = 0; mt < 2; ++mt)
#pragma unroll
      for (int g4 = 0; g4 < 4; ++g4) {
        const int d0 = mt * 32 + 8 * g4 + 4 * fh;
        const uint2 gv = *(const uint2*)(AG + rho * 512 + head * 64 + d0);
        uint2 ov;
        ov.x = pack2(o[mt][j][g4 * 4 + 0] * inv * silu_f(lo2f(gv.x)), o[mt][j][g4 * 4 + 1] * inv * silu_f(hi2f(gv.x)));
        ov.y = pack2(o[mt][j][g4 * 4 + 2] * inv * silu_f(lo2f(gv.y)), o[mt][j][g4 * 4 + 3] * inv * silu_f(hi2f(gv.y)));
        *(uint2*)(Q + rho * 512 + head * 64 + d0) = ov;
      }
  }
}

DI void states_item(const Params& p_in, char* smem, int ck, int g, int hq) {
  const Params p = load_params();

  bf16_t* sB = (bf16_t*)smem;
  bf16_t* sX = (bf16_t*)(smem + 128 * 136 * 2);
  int tid = threadIdx.x; asm volatile("" : "+v"(tid)); const int lane = tid & 63, wave = tid >> 6, wr = wave >> 1, wc = wave & 1, fr = lane & 31, fh = lane >> 5;
  const bf16_t* BC = (const bf16_t*)(p.ws + OFF_BC);
  const bf16_t* XS = (const bf16_t*)(p.ws + OFF_H);
  const float* DT = (const float*)(p.ws + OFF_DT);
  const float* CS = (const float*)(p.ws + OFF_CS);
  bf16_t* ST = (bf16_t*)(p.ws + OFF_ST);
  float* CDEC = (float*)(p.ws + OFF_CDEC);
  const int row0 = ck * 128;
  __syncthreads();
  for (int v = tid; v < 2048; v += 256) {
    const int r = v >> 4, cv = v & 15;
    *(uint4*)&sB[r * 136 + cv * 8] = *(const uint4*)(BC + (size_t)(row0 + r) * 512 + g * 128 + cv * 8);
  }
  __syncthreads();
  bf16x8 bfr[2][8];
#pragma unroll
  for (int j = 0; j < 2; ++j)
#pragma unroll
    for (int ks = 0; ks < 8; ++ks) bfr[j][ks] = tr_frag(sB, 136, ks * 16 + 8 * fh, ks * 16 + 8 * fh + 4, wc * 64 + j * 32);
  const int slr = tid >> 3, scv = tid & 7;
  uint4 xq0, xq1, xq2, xq3;
  float dq0, dq1, dq2, dq3, cq0, cq1, cq2, cq3, cendq;
#define ST_PREFETCH(HD) { const int head_ = g * 8 + hq * 4 + ((HD) >> 1), d_ = (HD) & 1, col_ = d_ * 16 + head_; \
    const bf16_t* xp_ = XS + (size_t)(row0 + slr) * 1024 + head_ * 64 + scv * 8; \
    xq0 = *(const uint4*)(xp_); xq1 = *(const uint4*)(xp_ + 32 * 1024); xq2 = *(const uint4*)(xp_ + 64 * 1024); xq3 = *(const uint4*)(xp_ + 96 * 1024); \
    const size_t rb_ = (size_t)(row0 + slr) * 32 + col_; \
    dq0 = DT[rb_]; dq1 = DT[rb_ + 32 * 32]; dq2 = DT[rb_ + 64 * 32]; dq3 = DT[rb_ + 96 * 32]; \
    cq0 = CS[rb_]; cq1 = CS[rb_ + 32 * 32]; cq2 = CS[rb_ + 64 * 32]; cq3 = CS[rb_ + 96 * 32]; \
    cendq = CS[(size_t)(row0 + (d_ == 0 ? 127 : 0)) * 32 + col_]; }
#define ST_SCALE_STORE(X, DTV, CSV, ROW) { const float sc_ = (DTV) * __expf(cend - (CSV)); uint4 o_; \
    o_.x = pack2(lo2f(X.x) * sc_, hi2f(X.x) * sc_); o_.y = pack2(lo2f(X.y) * sc_, hi2f(X.y) * sc_); \
    o_.z = pack2(lo2f(X.z) * sc_, hi2f(X.z) * sc_); o_.w = pack2(lo2f(X.w) * sc_, hi2f(X.w) * sc_); \
    *(uint4*)&sX[(ROW) * 72 + scv * 8] = o_; }
  ST_PREFETCH(0)
#pragma unroll 1
  for (int hd = 0; hd < 8; ++hd) {
    const int head = g * 8 + hq * 4 + (hd >> 1), d = hd & 1;
    const float cend = cendq;
    ST_SCALE_STORE(xq0, dq0, cq0, slr)
    ST_SCALE_STORE(xq1, dq1, cq1, slr + 32)
    ST_SCALE_STORE(xq2, dq2, cq2, slr + 64)
    ST_SCALE_STORE(xq3, dq3, cq3, slr + 96)
    if (hd < 7) ST_PREFETCH(hd + 1)
    __syncthreads();
    f32x16 acc[2];
#pragma unroll
    for (int j = 0; j < 2; ++j)
#pragma unroll
      for (int r = 0; r < 16; ++r) acc[j][r] = 0.f;
#pragma unroll
    for (int ks = 0; ks < 8; ++ks) {
      const bf16x8 af = tr_frag(sX, 72, ks * 16 + 8 * fh, ks * 16 + 8 * fh + 4, wr * 32);
#pragma unroll
      for (int j = 0; j < 2; ++j) acc[j] = MFMA(af, bfr[j][ks], acc[j]);
    }
    bf16_t* dst = ST + ((size_t)(ck * 2 + d) * 16 + head) * 8192;
#pragma unroll
    for (int j = 0; j < 2; ++j)
#pragma unroll
      for (int r = 0; r < 16; ++r) dst[(wr * 32 + crow(r, fh)) * 128 + wc * 64 + j * 32 + fr] = f2bf(acc[j][r]);
    if (tid == 0) CDEC[(ck * 2 + d) * 16 + head] = __expf(cend);
    __syncthreads();
  }
}

DI void pw_item(const Params& p_in, int l, char* smem, int mt, int nt) {
  const Params p = load_params();

  GemmS* s = (GemmS*)smem;
  int tid = threadIdx.x; asm volatile("" : "+v"(tid)); const int lane = tid & 63, wave = tid >> 6, wr = wave >> 1, wc = wave & 1, fr = lane & 31, fh = lane >> 5;
  const bf16_t* Ab = (const bf16_t*)(p.ws + OFF_HDN) + (size_t)mt * 128 * 512;
  const bf16_t* Bb = (const bf16_t*)(p.ws + OFF_PW) + (size_t)nt * 128 * 512;
  bf16_t* CG = (bf16_t*)(p.ws + OFF_CG);
  f32x16 acc[2][2];
  zero_acc(acc);
  gemm_core2(acc, (GemmS2*)smem,
             [&](int kt, int r, int kv) { return Ab + (size_t)r * 512 + kt * 64 + kv * 8; },
             [&](int kt, int r, int kv) { return Bb + (size_t)r * 512 + kt * 64 + kv * 8; }, 8, [](int) {});
  const float* pwb = p.conv_pw_b + l * 512 + nt * 128;
  epilogue_lds(acc, smem, [&](int rl, int c4, float4 v) {
    bf16_t* ptr = CG + (size_t)(mt * 128 + rl) * 512 + nt * 128 + c4;
    const uint2 gv = *(const uint2*)ptr;
    const float4 bb = *(const float4*)(pwb + c4);
    uint2 o;
    o.x = pack2((v.x + bb.x) * silu_f(lo2f(gv.x)), (v.y + bb.y) * silu_f(hi2f(gv.x)));
    o.y = pack2((v.z + bb.z) * silu_f(lo2f(gv.y)), (v.w + bb.w) * silu_f(hi2f(gv.y)));
    *(uint2*)ptr = o;
  });
}

DI void phase_mix(const Params& p, int l, char* smem) {
  const int G = gridDim.x;
  const int N_ATT = 512 + (l == 0 ? 32 : 0);
  for (int it = blockIdx.x; it < N_ATT; it += G) {
    if (it < 512) attn_item(p, l, smem, it >> 7, (it >> 2) & 31, (it >> 1) & 1, it & 1, false);
    else { const int t = it - 512; attn_item(p, l, smem, t >> 3, (t >> 2) & 1, (t >> 1) & 1, t & 1, true); }
  }
  for (int it = (blockIdx.x + G - 32) % G; it < NCK * 4; it += G) states_item(p, smem, it >> 2, (it >> 1) & 1, it & 1);
  for (int it = (blockIdx.x + G - 64) % G; it < NCK * 4; it += G) pw_item(p, l, smem, it >> 2, it & 3);
}

DI void phase_scan(const Params& p_in) {
  const Params p = load_params();

  bf16_t* ST = (bf16_t*)(p.ws + OFF_ST);
  const float* CDEC = (const float*)(p.ws + OFF_CDEC);
  for (int it = blockIdx.x; it < 512; it += gridDim.x) {
    const int e = it * 256 + threadIdx.x;
    const int bdh = e >> 10, v8 = e & 1023;
    const int b = bdh >> 5, d = (bdh >> 4) & 1, h = bdh & 15;
    float s[8];
#pragma unroll
    for (int i = 0; i < 8; ++i) s[i] = 0.f;
    auto ckof = [&](int i) {
      if (d == 0) return (i < 2) ? (128 + 2 * b + i) : (32 * b + (i - 2));
      return (i < 2) ? (128 + 2 * b + (1 - i)) : (32 * b + 31 - (i - 2));
    };
    auto pof = [&](int i) { const int ck = ckof(i); return (uint4*)(ST + ((size_t)(ck * 2 + d) * 16 + h) * 8192 + v8 * 8); };
    auto dof = [&](int i) { const int ck = ckof(i); return CDEC[(ck * 2 + d) * 16 + h]; };
    uint4 buf[8]; float dc[8];
#pragma unroll
    for (int i = 0; i < 7; ++i) { buf[i] = *pof(i); dc[i] = dof(i); }
#pragma unroll
    for (int i = 0; i < 34; ++i) {
      if (i + 7 < 34) { buf[(i + 7) & 7] = *pof(i + 7); dc[(i + 7) & 7] = dof(i + 7); }
      const uint4 cur = buf[i & 7];
      const float dec = dc[i & 7];
      uint4 o;
      o.x = pack2(s[0], s[1]); o.y = pack2(s[2], s[3]); o.z = pack2(s[4], s[5]); o.w = pack2(s[6], s[7]);
      *pof(i) = o;
      s[0] = s[0] * dec + lo2f(cur.x); s[1] = s[1] * dec + hi2f(cur.x);
      s[2] = s[2] * dec + lo2f(cur.y); s[3] = s[3] * dec + hi2f(cur.y);
      s[4] = s[4] * dec + lo2f(cur.z); s[5] = s[5] * dec + hi2f(cur.z);
      s[6] = s[6] * dec + lo2f(cur.w); s[7] = s[7] * dec + hi2f(cur.w);
    }
  }
}

DI void phase_ssdy(const Params& p_in, int l, char* smem) {
  const Params p = load_params();

  bf16_t* sB = (bf16_t*)smem;
  bf16_t* sX = (bf16_t*)(smem + 128 * 136 * 2);
  float* sF = (float*)(smem + 128 * 136 * 2 + 128 * 72 * 2);
  float* sSS = sF + 512;
  int tid = threadIdx.x; asm volatile("" : "+v"(tid)); const int lane = tid & 63, wave = tid >> 6, fr = lane & 31, fh = lane >> 5;
  const int wl = wave >> 1, w2 = wave & 1;
  const bf16_t* BC = (const bf16_t*)(p.ws + OFF_BC);
  const bf16_t* XS = (const bf16_t*)(p.ws + OFF_H);
  const float* DT = (const float*)(p.ws + OFF_DT);
  const float* CS = (const float*)(p.ws + OFF_CS);
  const bf16_t* ST = (const bf16_t*)(p.ws + OFF_ST);
  bf16_t* Z = (bf16_t*)(p.ws + OFF_Z);
  float* RSTD = (float*)(p.ws + OFF_RSTD);
  const int nck = (l == 0) ? NCK : 128;
  const int nh = (l == 0) ? 2 : 8;
  const int nsplit = 8 / nh;
  for (int it0 = blockIdx.x; it0 < nck * 4 * nsplit; it0 += gridDim.x) {
    const int hq = it0 % nsplit, it = it0 / nsplit;
    const int hbeg = hq * nh, hend = hbeg + nh;
    const int ck = it >> 2, g = (it >> 1) & 1, lh = it & 1;
    const int row0 = ck * 128;
    const int lbase = lh * 64 + wl * 32;
    __syncthreads();
    for (int v = tid; v < 2048; v += 256) {
      const int r = v >> 4, cv = v & 15;
      *(uint4*)&sB[r * 136 + cv * 8] = *(const uint4*)(BC + (size_t)(row0 + r) * 512 + g * 128 + cv * 8);
    }
    if (tid < 64) sSS[tid] = 0.f;
    const bf16_t* cptr = BC + (size_t)(row0 + lbase + fr) * 512 + 256 + g * 128 + fh * 8;
    bf16x8 cf[8];
#pragma unroll
    for (int ks = 0; ks < 8; ++ks) cf[ks] = *(const bf16x8*)(cptr + ks * 16);
    const int lrx = tid >> 3, cvx = tid & 7;
    const bf16_t* xsrc = XS + (size_t)(row0 + lrx) * 1024 + cvx * 8;
    uint4 xp0, xp1, xp2, xp3;
    float fp0 = 0.f, fp1 = 0.f, fp2 = 0.f, fp3 = 0.f;
    {
      const int head = g * 8 + hbeg;
      xp0 = *(const uint4*)(xsrc + head * 64);
      xp1 = *(const uint4*)(xsrc + head * 64 + 32 * 1024);
      xp2 = *(const uint4*)(xsrc + head * 64 + 64 * 1024);
      xp3 = *(const uint4*)(xsrc + head * 64 + 96 * 1024);
      if (tid < 128) {
        const size_t rho = (size_t)(row0 + tid);
        fp0 = CS[rho * 32 + head]; fp1 = CS[rho * 32 + 16 + head]; fp2 = DT[rho * 32 + head]; fp3 = DT[rho * 32 + 16 + head];
      }
    }
    __syncthreads();
    f32x16 cb[2];
#pragma unroll
    for (int j = 0; j < 2; ++j) {
#pragma unroll
      for (int r = 0; r < 16; ++r) cb[j][r] = 0.f;
#pragma unroll
      for (int ks = 0; ks < 8; ++ks) {
        const bf16x8 bq = *(const bf16x8*)&sB[(w2 * 64 + j * 32 + fr) * 136 + ks * 16 + fh * 8];
        cb[j] = MFMA(cf[ks], bq, cb[j]);
      }
    }
    const int pidx = w2 * 32 + fr;
    bf16_t* sCB = sB + 64 * 136;
    __syncthreads();
#pragma unroll
    for (int j = 0; j < 2; ++j)
#pragma unroll
      for (int r = 0; r < 16; ++r) sCB[(wl * 32 + crow(r, fh)) * 136 + w2 * 64 + j * 32 + fr] = f2bf(cb[j][r]);
#pragma unroll 1
    for (int hh = hbeg; hh < hend; ++hh) {
      const int head = g * 8 + hh;
      __syncthreads();
      *(uint4*)&sX[lrx * 72 + cvx * 8] = xp0;
      *(uint4*)&sX[(lrx + 32) * 72 + cvx * 8] = xp1;
      *(uint4*)&sX[(lrx + 64) * 72 + cvx * 8] = xp2;
      *(uint4*)&sX[(lrx + 96) * 72 + cvx * 8] = xp3;
      if (tid < 128) { sF[tid] = fp0; sF[128 + tid] = fp1; sF[256 + tid] = fp2; sF[384 + tid] = fp3; }
      const bf16_t* S0 = ST + ((size_t)(ck * 2 + 0) * 16 + head) * 8192 + (w2 * 32 + fr) * 128 + fh * 8;
      const bf16_t* S1 = ST + ((size_t)(ck * 2 + 1) * 16 + head) * 8192 + (w2 * 32 + fr) * 128 + fh * 8;
      bf16x8 sf0[8];
#pragma unroll
      for (int ks = 0; ks < 8; ++ks) sf0[ks] = *(const bf16x8*)(S0 + ks * 16);
      bf16_t* zbase = Z + (size_t)(row0 + lbase + 4 * fh) * 1024 + head * 64 + pidx;
      if (hh + 1 < hend) {
        const int hn = head + 1;
        xp0 = *(const uint4*)(xsrc + hn * 64);
        xp1 = *(const uint4*)(xsrc + hn * 64 + 32 * 1024);
        xp2 = *(const uint4*)(xsrc + hn * 64 + 64 * 1024);
        xp3 = *(const uint4*)(xsrc + hn * 64 + 96 * 1024);
        if (tid < 128) {
          const size_t rho = (size_t)(row0 + tid);
          fp0 = CS[rho * 32 + hn]; fp1 = CS[rho * 32 + 16 + hn]; fp2 = DT[rho * 32 + hn]; fp3 = DT[rho * 32 + 16 + hn];
        }
      }
      __syncthreads();
#pragma unroll
      for (int j = 0; j < 2; ++j) {
        const int sidx = w2 * 64 + j * 32 + fr;
        const float csf_s = sF[sidx], csb_s = sF[128 + sidx], dtf_s = sF[256 + sidx], dtb_s = sF[384 + sidx];
#pragma unroll 4
        for (int r = 0; r < 16; ++r) {
          const int lidx = lbase + crow(r, fh);
          float f = 0.f;
          if (sidx <= lidx) f += __expf(sF[lidx] - csf_s) * dtf_s;
          if (sidx >= lidx) f += __expf(sF[128 + lidx] - csb_s) * dtb_s;
          sB[(wl * 32 + crow(r, fh)) * 136 + sidx] = f2bf(bf2f(sCB[(wl * 32 + crow(r, fh)) * 136 + sidx]) * f);
        }
      }
      __syncthreads();
      bf16x8 sf1[8], cfh[8];
#pragma unroll
      for (int ks = 0; ks < 8; ++ks) { sf1[ks] = *(const bf16x8*)(S1 + ks * 16); cfh[ks] = *(const bf16x8*)(cptr + ks * 16); }
      unsigned short zv[16];
#pragma unroll
      for (int r = 0; r < 16; ++r) zv[r] = zbase[(size_t)((r & 3) + 8 * (r >> 2)) * 1024];
      f32x16 accy;
#pragma unroll
      for (int r = 0; r < 16; ++r) accy[r] = 0.f;
#pragma unroll
      for (int ks = 0; ks < 8; ++ks) {
        const bf16x8 af = *(const bf16x8*)&sB[(wl * 32 + fr) * 136 + ks * 16 + fh * 8];
        const bf16x8 xf = tr_frag(sX, 72, ks * 16 + 8 * fh, ks * 16 + 8 * fh + 4, w2 * 32);
        accy = MFMA(af, xf, accy);
      }
      {
        f32x16 acct;
#pragma unroll
        for (int r = 0; r < 16; ++r) acct[r] = 0.f;
#pragma unroll
        for (int ks = 0; ks < 8; ++ks) acct = MFMA(cfh[ks], sf0[ks], acct);
#pragma unroll
        for (int r = 0; r < 16; ++r) accy[r] += __expf(sF[lbase + crow(r, fh)]) * acct[r];
#pragma unroll
        for (int r = 0; r < 16; ++r) acct[r] = 0.f;
#pragma unroll
        for (int ks = 0; ks < 8; ++ks) acct = MFMA(cfh[ks], sf1[ks], acct);
#pragma unroll
        for (int r = 0; r < 16; ++r) accy[r] += __expf(sF[128 + lbase + crow(r, fh)]) * acct[r];
      }
      const float dsk = p.ssd_d[l * 16 + head];
      float v[16];
#pragma unroll
      for (int r = 0; r < 16; ++r) {
        const int lidx = lbase + crow(r, fh);
        const float xv = bf2f(sX[lidx * 72 + pidx]);
        const float y = accy[r] + dsk * xv;
        const float u = y * silu_f(bf2f(zv[r]));
        v[r] = u * u;
        zbase[(size_t)((r & 3) + 8 * (r >> 2)) * 1024] = f2bf(u);
      }
#pragma unroll
      for (int i = 0; i < 8; ++i) { const bool up = (fr & 16) != 0; const float keep = up ? v[i + 8] : v[i]; const float send = up ? v[i] : v[i + 8]; v[i] = keep + __shfl_xor(send, 16); }
#pragma unroll
      for (int i = 0; i < 4; ++i) { const bool up = (fr & 8) != 0; const float keep = up ? v[i + 4] : v[i]; const float send = up ? v[i] : v[i + 4]; v[i] = keep + __shfl_xor(send, 8); }
#pragma unroll
      for (int i = 0; i < 2; ++i) { const bool up = (fr & 4) != 0; const float keep = up ? v[i + 2] : v[i]; const float send = up ? v[i] : v[i + 2]; v[i] = keep + __shfl_xor(send, 4); }
      { const bool up = (fr & 2) != 0; const float keep = up ? v[1] : v[0]; const float send = up ? v[0] : v[1]; v[0] = keep + __shfl_xor(send, 2); }
      v[0] += __shfl_xor(v[0], 1);
      if ((fr & 1) == 0) atomicAdd(&sSS[wl * 32 + crow(fr >> 1, fh)], v[0]);
    }
    __syncthreads();
    if (tid < 64) atomicAdd(&RSTD[(size_t)(row0 + lh * 64 + tid) * 2 + g], sSS[tid]);
  }
}

DI void phase_outproj(const Params& p_in, int l, char* smem) {
  const Params p = load_params();

  GemmS* s = (GemmS*)smem;
  int tid = threadIdx.x; asm volatile("" : "+v"(tid)); const int lane = tid & 63, wave = tid >> 6, wr = wave >> 1, wc = wave & 1, fr = lane & 31, fh = lane >> 5;
  const bf16_t* Zb = (const bf16_t*)(p.ws + OFF_Z);
  const bf16_t* Qb = (const bf16_t*)(p.ws + OFF_Q);
  const bf16_t* Cb = (const bf16_t*)(p.ws + OFF_CG);
  const bf16_t* W = (const bf16_t*)(p.ws + OFF_WOUT);
  const float* RSTD = (const float*)(p.ws + OFF_RSTD);
  const float* mods = (const float*)(p.ws + OFF_MODS);
  float* XC = (float*)(p.ws + OFF_XC);
  for (int step = 0;; ++step) {
    int mt, nt2;
    if (!xcd_tile(step, 128, 4, mt, nt2)) break;
    f32x16 acc[2][4];
#pragma unroll
    for (int i = 0; i < 2; ++i)
#pragma unroll
      for (int j = 0; j < 4; ++j)
#pragma unroll
        for (int r = 0; r < 16; ++r) acc[i][j][r] = 0.f;
    const bf16_t* Wb = W + (size_t)nt2 * 256 * 2048;
    const bf16_t* A0 = Zb + (size_t)mt * 128 * 1024;
    const bf16_t* A2 = Qb + (size_t)mt * 128 * 512;
    const bf16_t* A3 = Cb + (size_t)mt * 128 * 512;
    float* sScale = (float*)(smem + 55296);
    __syncthreads();
    if (tid < 128) {
      const size_t row = (size_t)(mt * 128 + tid);
      const float r0 = rsqrtf(RSTD[row * 2] * (1.f / 512.f) + 1e-6f);
      const float r1 = rsqrtf(RSTD[row * 2 + 1] * (1.f / 512.f) + 1e-6f);
      sScale[tid * 2] = r0 / r1;
      sScale[tid * 2 + 1] = r1;
    }
    gemm_core3(acc, (GemmS3*)smem,
               [&](int kt, int r, int kv) {
                 const bf16_t* ptr;
                 if (kt < 16) ptr = A0 + (size_t)r * 1024 + kt * 64;
                 else if (kt < 24) ptr = A2 + (size_t)r * 512 + (kt - 16) * 64;
                 else ptr = A3 + (size_t)r * 512 + (kt - 24) * 64;
                 return ptr + kv * 8;
               },
               [&](int kt, int r, int kv) { return Wb + (size_t)r * 2048 + kt * 64 + kv * 8; }, 32,
               [&](int kt) __attribute__((always_inline)) {
                 if (kt == 8 || kt == 16) {
#pragma unroll
                   for (int i = 0; i < 2; ++i)
#pragma unroll
                     for (int r = 0; r < 16; ++r) {
                       const float f = sScale[(wr * 64 + i * 32 + crow(r, fh)) * 2 + (kt == 16 ? 1 : 0)];
                       acc[i][0][r] *= f; acc[i][1][r] *= f; acc[i][2][r] *= f; acc[i][3][r] *= f;
                     }
                 }
               });
    {
      const int row0 = mt * 128;
      const int vv = row0 >> 12;
      float* xnew = p.out + (size_t)row0 * 1024;
      const float* xold = (l == 0) ? (p.x + (size_t)row0 * 1024) : xnew;
#pragma unroll 1
      for (int sub = 0; sub < 2; ++sub) {
        const int nt = nt2 * 2 + sub;
        const float* gate = mods + (l * 5 + vv) * 3072 + 2048 + nt * 128;
        epilogue_lds2(acc, smem, sub, [&](int rl, int c4, float4 v) {
          const int off = rl * 1024 + nt * 128 + c4;
          const float4 xo = *(const float4*)(xold + off);
          const float4 gt = *(const float4*)(gate + c4);
          float4 o;
          o.x = xo.x + gt.x * v.x; o.y = xo.y + gt.y * v.y; o.z = xo.z + gt.z * v.z; o.w = xo.w + gt.w * v.w;
          *(float4*)(xnew + off) = o;
        });
      }
    }
  }
  const int nctx = (l == 0) ? 64 : 0;
  for (int it = (int)blockIdx.x; it < nctx; it += gridDim.x) {
    const int mt = 128 + (it >> 3), nt = it & 7;
    f32x16 acc[2][2];
    zero_acc(acc);
    const bf16_t* Wb = W + (size_t)nt * 128 * 2048;
    const bf16_t* A0 = Zb + (size_t)mt * 128 * 1024;
    const bf16_t* A2 = Qb + (size_t)mt * 128 * 512;
    const bf16_t* A3 = Cb + (size_t)mt * 128 * 512;
    float* sScale = (float*)(smem + 40960);
    if (tid < 128) {
      const size_t row = (size_t)(mt * 128 + tid);
      const float r0 = rsqrtf(RSTD[row * 2] * (1.f / 512.f) + 1e-6f);
      const float r1 = rsqrtf(RSTD[row * 2 + 1] * (1.f / 512.f) + 1e-6f);
      sScale[tid * 2] = r0 / r1;
      sScale[tid * 2 + 1] = r1;
    }
    gemm_core2(acc, (GemmS2*)smem,
               [&](int kt, int r, int kv) {
                 const bf16_t* ptr;
                 if (kt < 16) ptr = A0 + (size_t)r * 1024 + kt * 64;
                 else if (kt < 24) ptr = A2 + (size_t)r * 512 + (kt - 16) * 64;
                 else ptr = A3 + (size_t)r * 512 + (kt - 24) * 64;
                 return ptr + kv * 8;
               },
               [&](int kt, int r, int kv) { return Wb + (size_t)r * 2048 + kt * 64 + kv * 8; }, 32,
               [&](int kt) __attribute__((always_inline)) {
                 if (kt == 8 || kt == 16) {
#pragma unroll
                   for (int i = 0; i < 2; ++i)
#pragma unroll
                     for (int r = 0; r < 16; ++r) {
                       const float f = sScale[(wr * 64 + i * 32 + crow(r, fh)) * 2 + (kt == 16 ? 1 : 0)];
                       acc[i][0][r] *= f; acc[i][1][r] *= f;
                     }
                 }
               });
    {
      const int row0 = mt * 128;
      const int vv = (row0 < RL_) ? (row0 >> 12) : 4;
      const float* gate = mods + (l * 5 + vv) * 3072 + 2048 + nt * 128;
      float* xnew = (row0 < RL_) ? (p.out + (size_t)row0 * 1024) : (XC + (size_t)(row0 - RL_) * 1024);
      const float* xold = (l == 0) ? ((row0 < RL_) ? (p.x + (size_t)row0 * 1024) : (p.ctx + (size_t)(row0 - RL_) * 1024)) : xnew;
      epilogue_lds(acc, smem, [&](int rl, int c4, float4 v) {
        const int off = rl * 1024 + nt * 128 + c4;
        const float4 xo = *(const float4*)(xold + off);
        const float4 gt = *(const float4*)(gate + c4);
        float4 o;
        o.x = xo.x + gt.x * v.x; o.y = xo.y + gt.y * v.y; o.z = xo.z + gt.z * v.z; o.w = xo.w + gt.w * v.w;
        *(float4*)(xnew + off) = o;
      });
    }
  }
  if (l == 0) {
    const int local = blockIdx.x >> 3, xcd = blockIdx.x & 7, nloc = gridDim.x >> 3;
    if (local >= 8 && nloc > 8) {
      const int nb = (nloc - 8) * 8;
      const int NT_WIN = 88 * 16, NT_PW = 64;
      for (int it = (local - 8) * 8 + xcd; it < NT_WIN + NT_PW; it += nb) {
        if (it < NT_WIN) transpose_tile(p.w_in + (size_t)1024 * 5408, 5408, 0, nullptr, (bf16_t*)(p.ws + OFF_WIN), 1024, (it / 16) * 64, (it % 16) * 64, (float*)smem);
        else { const int t = it - NT_WIN; transpose_tile(p.conv_pw_w + (size_t)512 * 512, 512, 1, nullptr, (bf16_t*)(p.ws + OFF_PW), 512, (t / 8) * 64, (t % 8) * 64, (float*)smem); }
      }
    }
  }
}

DI void phase_final(const Params& p_in) {
  const Params p = load_params();
  const int lane = threadIdx.x & 63, wave = threadIdx.x >> 6;
  for (int it = blockIdx.x; it < RL_ / 8; it += gridDim.x) {
    float* xr0 = p.out + (size_t)(it * 8 + wave * 2) * 1024;
    float4 xv[2][4];
#pragma unroll
    for (int q = 0; q < 2; ++q)
#pragma unroll
      for (int i = 0; i < 4; ++i) xv[q][i] = *(const float4*)(xr0 + q * 1024 + lane * 4 + i * 256);
    float4 w[4];
#pragma unroll
    for (int i = 0; i < 4; ++i) w[i] = *(const float4*)(p.final_norm_w + lane * 4 + i * 256);
#pragma unroll
    for (int q = 0; q < 2; ++q) {
      float ss = 0.f;
#pragma unroll
      for (int i = 0; i < 4; ++i) ss += xv[q][i].x * xv[q][i].x + xv[q][i].y * xv[q][i].y + xv[q][i].z * xv[q][i].z + xv[q][i].w * xv[q][i].w;
#pragma unroll
      for (int o = 32; o >= 1; o >>= 1) ss += __shfl_xor(ss, o);
      const float rs = rsqrtf(ss * (1.f / 1024.f) + 1e-6f);
#pragma unroll
      for (int i = 0; i < 4; ++i) {
        float4 o;
        o.x = xv[q][i].x * rs * w[i].x; o.y = xv[q][i].y * rs * w[i].y; o.z = xv[q][i].z * rs * w[i].z; o.w = xv[q][i].w * rs * w[i].w;
        *(float4*)(xr0 + q * 1024 + lane * 4 + i * 256) = o;
      }
    }
  }
}

template <int PH>
DI void run_phase(const Params& p, char* smem) {
  constexpr int l = (PH - 1) / 7, s = (PH - 1) % 7;
  if constexpr (PH == 0) phase_mods(p, smem);
  else if constexpr (PH == 15) phase_final(p);
  else if constexpr (s == 0) phase_prep(p, l, smem);
  else if constexpr (s == 1) phase_inproj(p, smem);
  else if constexpr (s == 2) phase_local(p, l, smem);
  else if constexpr (s == 3) phase_mix(p, l, smem);
  else if constexpr (s == 4) phase_scan(p);
  else if constexpr (s == 5) phase_ssdy(p, l, smem);
  else phase_outproj(p, l, smem);
}

#if PROBE_S >= 0
#define PROBE_BEGIN() if (threadIdx.x == 0) pst[1] = wall_clock64();
#define PROBE_END(PH) if (threadIdx.x == 0 && (PH) >= 1 && (PH) <= 14 && (((PH) - 1) % 7) == PROBE_S) pst[0] += wall_clock64() - pst[1];
#else
#define PROBE_BEGIN()
#define PROBE_END(PH)
#endif
#define PHASE(PH) PROBE_BEGIN() run_phase<PH>(p, smem); xcd_barrier(xst); PROBE_END(PH)

__global__ void __launch_bounds__(256, 2) fwd_megakernel(Params p) {
  __shared__ __attribute__((aligned(16))) char smem[57344];
  cg::grid_group grid = cg::this_grid();
  if (threadIdx.x == 0) g_kernarg = (unsigned long long)__builtin_amdgcn_kernarg_segment_ptr();
  __syncthreads();
#if PROBE_S >= 0
  volatile unsigned long long* pst = (volatile unsigned long long*)(smem + 57344 - 16);
  if (threadIdx.x == 0) { pst[0] = 0; pst[1] = 0; }
#endif
  __shared__ uint4 xb_words;
  volatile LAS unsigned* xst = (volatile LAS unsigned*)&xb_words;
  if (threadIdx.x == 0) xb_words = make_uint4(0u, 0u, 0u, 0u);
  if (threadIdx.x == 0) { unsigned* bar = (unsigned*)(load_params().ws + OFF_BAR); (void)xb_add(&bar[XB_XCNT(xb_xcc_id())], 1u); }
  run_phase<0>(p, smem);
  if (load_params().out == nullptr) grid.sync();
  xcd_barrier(xst);
  PHASE(1) PHASE(2) PHASE(3) PHASE(4) PHASE(5) PHASE(6) PHASE(7)
  PHASE(8) PHASE(9) PHASE(10) PHASE(11) PHASE(12) PHASE(13) PHASE(14)
  run_phase<15>(p, smem);
#if PROBE_S >= 0
  if (blockIdx.x == 0 && threadIdx.x == 0) {
    const unsigned long long t1 = wall_clock64();
    const unsigned long long lim = 4ull * pst[0];
    while (wall_clock64() - t1 < lim) { __builtin_amdgcn_s_sleep(32); }
  }
#endif
}

extern "C" void kernel_launch(void* const* d_in, const int* in_sizes, int n_in, void* d_out, int out_size, void* d_ws,
                              size_t ws_size, hipStream_t stream) {
  static int grid_blocks = 0;
  if (!grid_blocks) {
    int dev = 0, cus = 0, per_cu = 0;
    hipGetDevice(&dev);
    hipDeviceGetAttribute(&cus, hipDeviceAttributeMultiprocessorCount, dev);
    hipOccupancyMaxActiveBlocksPerMultiprocessor(&per_cu, fwd_megakernel, 256, 0);
    if (per_cu < 1) per_cu = 1;
    if (per_cu > 2) per_cu = 2;
    grid_blocks = (cus * per_cu) & ~7;
  }
  Params p{};
  const float** pp = (const float**)&p;
  for (int i = 0; i < 23; ++i) pp[i] = (const float*)d_in[i];
  p.out = (float*)d_out;
  p.ws = (char*)d_ws;
  (void)hipMemsetAsync((char*)d_ws + OFF_BAR, 0, XCD_BAR_WORDS * 4, stream);
  void* args[] = {&p};
  hipError_t e = hipLaunchCooperativeKernel((void*)fwd_megakernel, dim3(grid_blocks), dim3(256), args, 0, stream);
  if (e != hipSuccess) fprintf(stderr, "cooperative launch failed: %s (grid %d)\n", hipGetErrorString(e), grid_blocks);
}
```

```cpp
#include <hip/hip_runtime.h>
#include <hip/hip_cooperative_groups.h>
#include <stdint.h>
#include <stdio.h>
namespace cg = cooperative_groups;

#ifndef ONE_LAUNCH
#define ONE_LAUNCH 1
#endif

#ifndef PROBE_S
#define PROBE_S -1
#endif
#define DI __device__ __forceinline__
typedef unsigned short bf16_t;
using bf16x8 = __attribute__((ext_vector_type(8))) short;
using s16x4 = __attribute__((ext_vector_type(4))) short;
using f32x16 = __attribute__((ext_vector_type(16))) float;
#define MFMA(a, b, c) __builtin_amdgcn_mfma_f32_32x32x16_bf16((a), (b), (c), 0, 0, 0)

constexpr int R_ = 17408;
constexpr int RL_ = 16384;
constexpr int NCK = 136;

constexpr size_t SZ_WIN = (size_t)5632 * 1024 * 2;
constexpr size_t SZ_WOUT = (size_t)1024 * 2048 * 2;
constexpr size_t SZ_PW = (size_t)512 * 512 * 2;
constexpr size_t SZ_MODS = (size_t)2 * 5 * 3072 * 4;
constexpr size_t SZ_XC = (size_t)1024 * 1024 * 4;
constexpr size_t SZ_RSTD = (size_t)R_ * 2 * 4;
constexpr size_t SZ_CDEC = (size_t)NCK * 32 * 4 + 256 - ((size_t)NCK * 32 * 4) % 256;
constexpr size_t SZ_R512 = (size_t)R_ * 512 * 2;
constexpr size_t OFF_WIN = 0;
constexpr size_t OFF_WOUT = OFF_WIN + SZ_WIN;
constexpr size_t OFF_PW = OFF_WOUT + SZ_WOUT;
constexpr size_t OFF_MODS = OFF_PW + SZ_PW;
constexpr size_t OFF_XC = OFF_MODS + SZ_MODS;
constexpr size_t OFF_RSTD = OFF_XC + SZ_XC;
constexpr size_t OFF_CDEC = OFF_RSTD + SZ_RSTD;
constexpr size_t OFF_H = OFF_CDEC + SZ_CDEC;
constexpr size_t OFF_XBC = OFF_H + 2 * SZ_R512;
constexpr size_t OFF_GLU = OFF_XBC + 3 * SZ_R512;
constexpr size_t OFF_ST = OFF_XBC;
constexpr size_t OFF_Z = OFF_GLU + SZ_R512;
constexpr size_t OFF_DT = OFF_Z + 2 * SZ_R512;
constexpr size_t OFF_CS = OFF_DT + (size_t)R_ * 32 * 4;
constexpr size_t OFF_Q = OFF_CS + (size_t)R_ * 32 * 4;
constexpr size_t OFF_KV = OFF_Q + SZ_R512;
constexpr size_t OFF_AG = OFF_KV + SZ_R512 / 2;
constexpr size_t OFF_CG = OFF_AG + SZ_R512;
constexpr size_t OFF_BC = OFF_CG + SZ_R512;
constexpr size_t OFF_HDN = OFF_BC + SZ_R512;
constexpr size_t WS_TOTAL = OFF_HDN + SZ_R512;
constexpr size_t OFF_BAR = WS_TOTAL;
static_assert(OFF_BAR + 16384 <= (size_t)256 * 1024 * 1024, "workspace too large");

struct Params {
  const float *x, *c, *ctx, *c_ctx, *w_mod, *b_mod, *norm_w, *w_in, *ssd_conv_w, *ssd_conv_b, *ssd_dt_bias, *ssd_a_log,
      *ssd_d, *ssd_norm_w, *attn_sink, *conv_dw_w, *conv_dw_b, *conv_ln_w, *conv_ln_b, *conv_pw_w, *conv_pw_b, *w_out,
      *final_norm_w;
  float* out;
  char* ws;
};


__shared__ unsigned long long g_kernarg;
DI Params load_params() {
  typedef const char __attribute__((address_space(4)))* kptr_t;
  typedef const float* const __attribute__((address_space(4)))* kfld_t;
  const unsigned long long v = *(volatile unsigned long long*)&g_kernarg;
  const unsigned lo = __builtin_amdgcn_readfirstlane((unsigned)v), hi = __builtin_amdgcn_readfirstlane((unsigned)(v >> 32));
  kptr_t base = (kptr_t)(((unsigned long long)hi << 32) | lo);
  Params p;
  const float** pp = (const float**)&p;
#pragma unroll
  for (int i = 0; i < 25; ++i) pp[i] = *(kfld_t)(base + 8 * i);
  return p;
}

#define XB_TMO      128
#define XB_XCNT(j)  (256  + 64 * (j))
#define XB_XSUB(j)  (1280 + 64 * (j))
#define XB_XGEN(j)  (2304 + 64 * (j))
#define XB_TOP      3328
#define XB_TOPGEN   3392
#define XCD_BAR_WORDS 3456
#define XB_SPIN_CAP (1u << 18)
#define LAS __attribute__((address_space(3)))
DI unsigned xb_ld(unsigned* p)              { return __hip_atomic_load(p, __ATOMIC_RELAXED, __HIP_MEMORY_SCOPE_AGENT); }
DI unsigned xb_add(unsigned* p, unsigned v) { return __hip_atomic_fetch_add(p, v, __ATOMIC_RELAXED, __HIP_MEMORY_SCOPE_AGENT); }
DI unsigned xb_xcc_id() { return (unsigned)__builtin_amdgcn_s_getreg((3 << 11) | 20) & 0xFu; }
#define XB_SPIN(cond, bar) do { unsigned _sp = 0; while (cond) { __builtin_amdgcn_s_sleep(1); \
    if ((++_sp & 255u) == 0u) { if (xb_ld(&(bar)[XB_TMO])) break; if (_sp > XB_SPIN_CAP) { atomicAdd(&(bar)[XB_TMO], 1u); break; } } } } while (0)

DI void xcd_barrier_complete(unsigned* bar, unsigned x, unsigned& nloc, unsigned& nx) {
  const unsigned G = gridDim.x * gridDim.y * gridDim.z;
  unsigned sum, cnt, mine, sp = 0u;
  for (;;) {
    sum = 0u; cnt = 0u; mine = 0u;
#pragma unroll
    for (unsigned j = 0; j < 16; ++j) { const unsigned c = xb_ld(&bar[XB_XCNT(j)]); sum += c; cnt += (c > 0u) ? 1u : 0u; mine = (j == x) ? c : mine; }
    if (sum == G) break;
    __builtin_amdgcn_s_sleep(1);
    if ((++sp & 255u) == 0u) { if (xb_ld(&bar[XB_TMO])) break; if (sp > XB_SPIN_CAP) { atomicAdd(&bar[XB_TMO], 1u); break; } }
  }
  nloc = mine > 0u ? mine : 1u; nx = cnt > 0u ? cnt : 1u;
}

DI void xcd_barrier(volatile LAS unsigned* st) {
  asm volatile("s_waitcnt vmcnt(0)" ::: "memory");
  __syncthreads();
  if (threadIdx.x == 0) {
    const Params pb = load_params();
    unsigned* bar = (unsigned*)(pb.ws + OFF_BAR);
    const unsigned x = xb_xcc_id();
    __builtin_amdgcn_s_waitcnt(0);
    unsigned nloc = st[0], nx = st[1];
    if (nloc == 0u) { xcd_barrier_complete(bar, x, nloc, nx); st[0] = nloc; st[1] = nx; }
    const unsigned old = xb_add(&bar[XB_XSUB(x)], 1u);
    const unsigned gen = old / nloc;
    if (old + 1u == (gen + 1u) * nloc) {
      __builtin_amdgcn_fence(__ATOMIC_RELEASE, "agent");
      asm volatile("s_waitcnt vmcnt(0)" ::: "memory");
      const unsigned og = xb_add(&bar[XB_TOP], 1u);
      const unsigned tg = og / nx;
      if (og + 1u == (tg + 1u) * nx) xb_add(&bar[XB_TOPGEN], 1u);
      else XB_SPIN(xb_ld(&bar[XB_TOPGEN]) == tg, bar);
      __builtin_amdgcn_fence(__ATOMIC_ACQUIRE, "agent");
      xb_add(&bar[XB_XGEN(x)], 1u);
      asm volatile("s_waitcnt vmcnt(0)" ::: "memory");
    } else {
      XB_SPIN(xb_ld(&bar[XB_XGEN(x)]) == gen, bar);
      __builtin_amdgcn_fence(__ATOMIC_ACQUIRE, "agent");
      asm volatile("s_waitcnt vmcnt(0)" ::: "memory");
    }
  }
  __syncthreads();
}

typedef __bf16 nbf16x2_t __attribute__((ext_vector_type(2)));
typedef float nf32x2_t __attribute__((ext_vector_type(2)));
DI unsigned short f2bf(float x) { const __bf16 r = (__bf16)x; return __builtin_bit_cast(unsigned short, r); }
DI float bf2f(unsigned short b) { return __uint_as_float(((unsigned)b) << 16); }
DI unsigned pack2(float a, float b) { const nf32x2_t v = {a, b}; const nbf16x2_t r = __builtin_convertvector(v, nbf16x2_t); return __builtin_bit_cast(unsigned, r); }
DI float lo2f(unsigned u) { return __uint_as_float(u << 16); }
DI float hi2f(unsigned u) { return __uint_as_float(u & 0xffff0000u); }
DI float silu_f(float x) { return x * __builtin_amdgcn_rcpf(1.f + __expf(-x)); }
DI float sigmoid_f(float x) { return __builtin_amdgcn_rcpf(1.f + __expf(-x)); }
DI int crow(int reg, int h) { return (reg & 3) + 8 * (reg >> 2) + 4 * h; }

DI bf16x8 tr_frag(const bf16_t* s, int ld, int row_lo, int row_hi, int col0) {
  const int lane = threadIdx.x & 63;
  const int i16 = lane & 15, q = i16 >> 2, pp = i16 & 3, blk = (lane >> 4) & 1;
  const unsigned a0 = (unsigned)(size_t)(s + (row_lo + q) * ld + col0 + 16 * blk + 4 * pp);
  const unsigned a1 = (unsigned)(size_t)(s + (row_hi + q) * ld + col0 + 16 * blk + 4 * pp);
  s16x4 lo, hi;
  asm volatile("ds_read_b64_tr_b16 %0, %2\n\tds_read_b64_tr_b16 %1, %3\n\ts_waitcnt lgkmcnt(0)"
               : "=&v"(lo), "=&v"(hi) : "v"(a0), "v"(a1) : "memory");
  return __builtin_shufflevector(lo, hi, 0, 1, 2, 3, 4, 5, 6, 7);
}

struct GemmS { bf16_t a[2][128][40]; bf16_t b[2][128][40]; };

template <class AF, class BF>
DI void gemm_core(f32x16 (&acc)[2][2], GemmS* s, AF aptr, BF bptr, int nk) {
  int tid = threadIdx.x; asm volatile("" : "+v"(tid)); const int lane = tid & 63, wave = tid >> 6, wr = wave >> 1, wc = wave & 1;
  const int r0 = tid >> 2, kv = tid & 3;
  const int fr = lane & 31, fh = lane >> 5;
  uint4 ra0 = *(const uint4*)aptr(0, r0, kv), ra1 = *(const uint4*)aptr(0, r0 + 64, kv);
  uint4 rb0 = *(const uint4*)bptr(0, r0, kv), rb1 = *(const uint4*)bptr(0, r0 + 64, kv);
  *(uint4*)&s->a[0][r0][kv * 8] = ra0; *(uint4*)&s->a[0][r0 + 64][kv * 8] = ra1;
  *(uint4*)&s->b[0][r0][kv * 8] = rb0; *(uint4*)&s->b[0][r0 + 64][kv * 8] = rb1;
  __syncthreads();
#pragma unroll 1
  for (int kt = 0; kt < nk; ++kt) {
    const int buf = kt & 1;
    if (kt + 1 < nk) {
      ra0 = *(const uint4*)aptr(kt + 1, r0, kv); ra1 = *(const uint4*)aptr(kt + 1, r0 + 64, kv);
      rb0 = *(const uint4*)bptr(kt + 1, r0, kv); rb1 = *(const uint4*)bptr(kt + 1, r0 + 64, kv);
    }
#pragma unroll
    for (int ks = 0; ks < 2; ++ks) {
      bf16x8 af[2], bq[2];
#pragma unroll
      for (int i = 0; i < 2; ++i) af[i] = *(const bf16x8*)&s->a[buf][wr * 64 + i * 32 + fr][ks * 16 + fh * 8];
#pragma unroll
      for (int j = 0; j < 2; ++j) bq[j] = *(const bf16x8*)&s->b[buf][wc * 64 + j * 32 + fr][ks * 16 + fh * 8];
#pragma unroll
      for (int i = 0; i < 2; ++i)
#pragma unroll
        for (int j = 0; j < 2; ++j) acc[i][j] = MFMA(af[i], bq[j], acc[i][j]);
    }
    if (kt + 1 < nk) {
      *(uint4*)&s->a[buf ^ 1][r0][kv * 8] = ra0; *(uint4*)&s->a[buf ^ 1][r0 + 64][kv * 8] = ra1;
      *(uint4*)&s->b[buf ^ 1][r0][kv * 8] = rb0; *(uint4*)&s->b[buf ^ 1][r0 + 64][kv * 8] = rb1;
    }
    __syncthreads();
  }
}


struct GemmS2 { bf16_t a[128][72]; bf16_t b[128][72]; };
DI void g2_compute(f32x16 (&acc)[2][2], const GemmS2* s, int wr, int wc, int fr, int fh) {
#pragma unroll
  for (int ks = 0; ks < 4; ++ks) {
    bf16x8 af[2], bq[2];
#pragma unroll
    for (int i = 0; i < 2; ++i) af[i] = *(const bf16x8*)&s->a[wr * 64 + i * 32 + fr][ks * 16 + fh * 8];
#pragma unroll
    for (int j = 0; j < 2; ++j) bq[j] = *(const bf16x8*)&s->b[wc * 64 + j * 32 + fr][ks * 16 + fh * 8];
#pragma unroll
    for (int i = 0; i < 2; ++i)
#pragma unroll
      for (int j = 0; j < 2; ++j) acc[i][j] = MFMA(af[i], bq[j], acc[i][j]);
  }
}

template <class AF, class BF, class HK>
DI void gemm_core2(f32x16 (&acc)[2][2], GemmS2* s, AF aptr, BF bptr, int nk, HK hook) {
  int tid = threadIdx.x; asm volatile("" : "+v"(tid));
  const int lane = tid & 63, wave = tid >> 6, wr = wave >> 1, wc = wave & 1;
  const int r0 = tid >> 3, kc = tid & 7;
  const int fr = lane & 31, fh = lane >> 5;
  uint4 p0a0, p0a1, p0a2, p0a3, p0b0, p0b1, p0b2, p0b3, p1a0, p1a1, p1a2, p1a3, p1b0, p1b1, p1b2, p1b3;
#define G2_LOAD(S, KT) { \
    S##a0 = *(const uint4*)aptr((KT), r0, kc);      S##b0 = *(const uint4*)bptr((KT), r0, kc); \
    S##a1 = *(const uint4*)aptr((KT), r0 + 32, kc); S##b1 = *(const uint4*)bptr((KT), r0 + 32, kc); \
    S##a2 = *(const uint4*)aptr((KT), r0 + 64, kc); S##b2 = *(const uint4*)bptr((KT), r0 + 64, kc); \
    S##a3 = *(const uint4*)aptr((KT), r0 + 96, kc); S##b3 = *(const uint4*)bptr((KT), r0 + 96, kc); }
#define G2_STORE(S) { \
    *(uint4*)&s->a[r0][kc * 8] = S##a0;      *(uint4*)&s->b[r0][kc * 8] = S##b0; \
    *(uint4*)&s->a[r0 + 32][kc * 8] = S##a1; *(uint4*)&s->b[r0 + 32][kc * 8] = S##b1; \
    *(uint4*)&s->a[r0 + 64][kc * 8] = S##a2; *(uint4*)&s->b[r0 + 64][kc * 8] = S##b2; \
    *(uint4*)&s->a[r0 + 96][kc * 8] = S##a3; *(uint4*)&s->b[r0 + 96][kc * 8] = S##b3; }
#define G2_COMPUTE() g2_compute(acc, s, wr, wc, fr, fh);
  G2_LOAD(p0, 0)
  G2_LOAD(p1, 1)
  G2_STORE(p0)
  if (nk > 2) G2_LOAD(p0, 2)
  __syncthreads();
#pragma unroll 1
  for (int kt = 0; kt < nk; kt += 2) {
    hook(kt);
    G2_COMPUTE()
    __syncthreads();
    G2_STORE(p1)
    if (kt + 3 < nk) G2_LOAD(p1, kt + 3)
    __syncthreads();
    hook(kt + 1);
    G2_COMPUTE()
    __syncthreads();
    if (kt + 2 < nk) {
      G2_STORE(p0)
      if (kt + 4 < nk) G2_LOAD(p0, kt + 4)
    }
    __syncthreads();
  }
#undef G2_LOAD
#undef G2_STORE
#undef G2_COMPUTE
}


struct GemmS3 { bf16_t a[128][72]; bf16_t b[256][72]; };

template <class AF, class BF, class HK>
DI void gemm_core3(f32x16 (&acc)[2][4], GemmS3* s, AF aptr, BF bptr, int nk, HK hook) {
  int tid = threadIdx.x; asm volatile("" : "+v"(tid));
  const int lane = tid & 63, wave = tid >> 6, wr = wave >> 1, wc = wave & 1;
  const int r0 = tid >> 3, kc = tid & 7;
  const int fr = lane & 31, fh = lane >> 5;
  uint4 a0, a1, a2, a3, b0, b1, b2, b3, b4, b5, b6, b7;
#define G3_LOAD(KT) { \
    a0 = *(const uint4*)aptr((KT), r0, kc);       a1 = *(const uint4*)aptr((KT), r0 + 32, kc); \
    a2 = *(const uint4*)aptr((KT), r0 + 64, kc);  a3 = *(const uint4*)aptr((KT), r0 + 96, kc); \
    b0 = *(const uint4*)bptr((KT), r0, kc);       b1 = *(const uint4*)bptr((KT), r0 + 32, kc); \
    b2 = *(const uint4*)bptr((KT), r0 + 64, kc);  b3 = *(const uint4*)bptr((KT), r0 + 96, kc); \
    b4 = *(const uint4*)bptr((KT), r0 + 128, kc); b5 = *(const uint4*)bptr((KT), r0 + 160, kc); \
    b6 = *(const uint4*)bptr((KT), r0 + 192, kc); b7 = *(const uint4*)bptr((KT), r0 + 224, kc); }
#define G3_STORE() { \
    *(uint4*)&s->a[r0][kc * 8] = a0;       *(uint4*)&s->a[r0 + 32][kc * 8] = a1; \
    *(uint4*)&s->a[r0 + 64][kc * 8] = a2;  *(uint4*)&s->a[r0 + 96][kc * 8] = a3; \
    *(uint4*)&s->b[r0][kc * 8] = b0;       *(uint4*)&s->b[r0 + 32][kc * 8] = b1; \
    *(uint4*)&s->b[r0 + 64][kc * 8] = b2;  *(uint4*)&s->b[r0 + 96][kc * 8] = b3; \
    *(uint4*)&s->b[r0 + 128][kc * 8] = b4; *(uint4*)&s->b[r0 + 160][kc * 8] = b5; \
    *(uint4*)&s->b[r0 + 192][kc * 8] = b6; *(uint4*)&s->b[r0 + 224][kc * 8] = b7; }
  G3_LOAD(0)
  G3_STORE()
  __syncthreads();
#pragma unroll 1
  for (int kt = 0; kt < nk; ++kt) {
    if (kt + 1 < nk) G3_LOAD(kt + 1)
    hook(kt);
#pragma unroll
    for (int ks = 0; ks < 4; ++ks) {
      bf16x8 af[2], bq[4];
#pragma unroll
      for (int i = 0; i < 2; ++i) af[i] = *(const bf16x8*)&s->a[wr * 64 + i * 32 + fr][ks * 16 + fh * 8];
#pragma unroll
      for (int j = 0; j < 4; ++j) bq[j] = *(const bf16x8*)&s->b[wc * 128 + j * 32 + fr][ks * 16 + fh * 8];
#pragma unroll
      for (int i = 0; i < 2; ++i)
#pragma unroll
        for (int j = 0; j < 4; ++j) acc[i][j] = MFMA(af[i], bq[j], acc[i][j]);
    }
    __syncthreads();
    if (kt + 1 < nk) G3_STORE()
    __syncthreads();
  }
#undef G3_LOAD
#undef G3_STORE
}

template <class EPI>
DI void epilogue_lds2(f32x16 (&acc)[2][4], char* smem, int sub, EPI epi) {
  float* T = (float*)smem;
  int tid = threadIdx.x; asm volatile("" : "+v"(tid));
  const int lane = tid & 63, wave = tid >> 6, wr = wave >> 1, wc = wave & 1, fr = lane & 31, fh = lane >> 5;
#pragma unroll
  for (int i = 0; i < 2; ++i) {
    if (wc == sub) {
#pragma unroll
      for (int j = 0; j < 4; ++j)
#pragma unroll
        for (int r = 0; r < 16; ++r) T[(wr * 32 + crow(r, fh)) * 132 + j * 32 + fr] = acc[i][j][r];
    }
    __syncthreads();
#pragma unroll 2
    for (int e = tid; e < 2048; e += 256) {
      const int tr = e >> 5, c4 = (e & 31) * 4;
      const float4 v = *(const float4*)&T[tr * 132 + c4];
      epi((tr >> 5) * 64 + i * 32 + (tr & 31), c4, v);
    }
    __syncthreads();
  }
}

template <class EPI>
DI void epilogue_lds2w(f32x16 (&acc)[2][4], char* smem, int sub, EPI epi) {
  float* T = (float*)smem;
  int tid = threadIdx.x; asm volatile("" : "+v"(tid));
  const int lane = tid & 63, wave = tid >> 6, wr = wave >> 1, wc = wave & 1, fr = lane & 31, fh = lane >> 5;
#pragma unroll
  for (int i = 0; i < 2; ++i) {
    if (wc == sub) {
#pragma unroll
      for (int j = 0; j < 4; ++j)
#pragma unroll
        for (int r = 0; r < 16; ++r) T[(wr * 32 + crow(r, fh)) * 132 + j * 32 + fr] = acc[i][j][r];
    }
    __syncthreads();
#pragma unroll 2
    for (int e = tid; e < 1024; e += 256) {
      const int tr = e >> 4, c8 = (e & 15) * 8;
      const float4 lo = *(const float4*)&T[tr * 132 + c8];
      const float4 hi = *(const float4*)&T[tr * 132 + c8 + 4];
      epi((tr >> 5) * 64 + i * 32 + (tr & 31), c8, lo, hi);
    }
    __syncthreads();
  }
}

DI void epilogue_rope(f32x16 (&acc)[2][4], char* smem, int sub, bf16_t* dst, int ld, int cb, int row0, float sc) {
  float* T = (float*)smem;
  int tid = threadIdx.x; asm volatile("" : "+v"(tid));
  const int lane = tid & 63, wave = tid >> 6, wr = wave >> 1, wc = wave & 1, fr = lane & 31, fh = lane >> 5;
#pragma unroll
  for (int i = 0; i < 2; ++i) {
    if (wc == sub) {
#pragma unroll
      for (int j = 0; j < 4; ++j)
#pragma unroll
        for (int r = 0; r < 16; ++r) T[(wr * 32 + crow(r, fh)) * 132 + j * 32 + fr] = acc[i][j][r];
    }
    __syncthreads();
#pragma unroll 1
    for (int e = tid; e < 1024; e += 256) {
      const int tr = e >> 4, qi = e & 15;
      const int hd = qi >> 3, ax = (qi >> 2) & 1, f0 = (qi & 3) * 4;
      const int col1 = hd * 64 + ax * 32 + f0;
      const float4 v1 = *(const float4*)&T[tr * 132 + col1];
      const float4 v2 = *(const float4*)&T[tr * 132 + col1 + 16];
      const int rho = row0 + (tr >> 5) * 64 + i * 32 + (tr & 31);
      float a1[4] = {v1.x, v1.y, v1.z, v1.w}, a2[4] = {v2.x, v2.y, v2.z, v2.w}, o1[4], o2[4];
      if (rho < RL_) {
        const int t = rho & 4095;
        const float pos = (float)(ax == 0 ? (t >> 6) : (t & 63));
#pragma unroll
        for (int u = 0; u < 4; ++u) {
          const float ang = pos * exp2f(-(float)(f0 + u) * 0.8304820237218406f);
          const float cs = __cosf(ang), sn = __sinf(ang);
          o1[u] = (a1[u] * cs - a2[u] * sn) * sc;
          o2[u] = (a2[u] * cs + a1[u] * sn) * sc;
        }
      } else {
#pragma unroll
        for (int u = 0; u < 4; ++u) { o1[u] = a1[u] * sc; o2[u] = a2[u] * sc; }
      }
      uint2 w1, w2;
      w1.x = pack2(o1[0], o1[1]); w1.y = pack2(o1[2], o1[3]);
      w2.x = pack2(o2[0], o2[1]); w2.y = pack2(o2[2], o2[3]);
      bf16_t* dp = dst + (size_t)rho * ld + cb + col1;
      *(uint2*)dp = w1;
      *(uint2*)(dp + 16) = w2;
    }
    __syncthreads();
  }
}

DI bool xcd_tile(int step, int nM, int nN, int& mt, int& nt) {
  const int xcd = blockIdx.x & 7, nloc = gridDim.x >> 3;
  const int j = (blockIdx.x >> 3) + step * nloc;
  const int mloc = nM >> 3;
  if ((gridDim.x & 7) != 0 || j >= mloc * nN) return false;
  const int per = 8 * nN;
  const int gm = j / per, rem = j - gm * per;
  const int hgt = min(8, mloc - gm * 8);
  const int a = rem % hgt;
  nt = rem / hgt;
  mt = (gm * 8 + a) * 8 + xcd;
  return true;
}

DI void zero_acc(f32x16 (&acc)[2][2]) {
#pragma unroll
  for (int i = 0; i < 2; ++i)
#pragma unroll
    for (int j = 0; j < 2; ++j)
#pragma unroll
      for (int r = 0; r < 16; ++r) acc[i][j][r] = 0.f;
}

template <class EPI>
DI void epilogue_lds(f32x16 (&acc)[2][2], char* smem, EPI epi) {
  float* T = (float*)smem;
  int tid = threadIdx.x; asm volatile("" : "+v"(tid)); const int lane = tid & 63, wave = tid >> 6, wr = wave >> 1, wc = wave & 1, fr = lane & 31, fh = lane >> 5;
#pragma unroll
  for (int i = 0; i < 2; ++i) {
#pragma unroll
    for (int j = 0; j < 2; ++j)
#pragma unroll
      for (int r = 0; r < 16; ++r) T[(wr * 32 + crow(r, fh)) * 132 + wc * 64 + j * 32 + fr] = acc[i][j][r];
    __syncthreads();
#pragma unroll 2
    for (int e = tid; e < 2048; e += 256) {
      const int tr = e >> 5, c4 = (e & 31) * 4;
      const float4 v = *(const float4*)&T[tr * 132 + c4];
      epi((tr >> 5) * 64 + i * 32 + (tr & 31), c4, v);
    }
    __syncthreads();
  }
}

DI void phase_mods(const Params& p_in, char* smem) {
  const Params p = load_params();

  float* ssc = (float*)smem;
  float* red = (float*)(smem + 20480);
  float* mods = (float*)(p.ws + OFF_MODS);
  int tid = threadIdx.x; asm volatile("" : "+v"(tid));
  for (int it = blockIdx.x; it < 192; it += gridDim.x) {
    const int l = it / 96, col0 = (it % 96) * 32;
    __syncthreads();
    for (int e = tid; e < 5120; e += 256) {
      const int v = e >> 10, k = e & 1023;
      const float cv = (v < 4) ? p.c[v * 1024 + k] : p.c_ctx[k];
      ssc[e] = silu_f(cv);
    }
    __syncthreads();
    const int col = tid & 31, kg = tid >> 5;
    float a[5] = {0.f, 0.f, 0.f, 0.f, 0.f};
    const float* w = p.w_mod + (size_t)l * 1024 * 3072 + col0 + col;
    for (int k = kg * 128; k < kg * 128 + 128; k += 32) {
      float wv[32];
#pragma unroll
      for (int u = 0; u < 32; ++u) wv[u] = w[(size_t)(k + u) * 3072];
#pragma unroll
      for (int u = 0; u < 32; ++u)
#pragma unroll
        for (int v = 0; v < 5; ++v) a[v] += ssc[v * 1024 + k + u] * wv[u];
    }
#pragma unroll
    for (int v = 0; v < 5; ++v) red[(kg * 5 + v) * 32 + col] = a[v];
    __syncthreads();
    for (int e = tid; e < 160; e += 256) {
      const int v = e >> 5, cc = e & 31;
      float sum = p.b_mod[l * 3072 + col0 + cc];
      for (int g = 0; g < 8; ++g) sum += red[(g * 5 + v) * 32 + cc];
      mods[(l * 5 + v) * 3072 + col0 + cc] = sum;
    }
  }
}

DI int win_colmap(int n) {
  if (n < 2560) return n;
  if (n < 3840) return n + 32;
  if (n < 4864) {
    const int j = n - 3840, q64 = j >> 6, w = j & 63;
    return (w < 32) ? (3872 + q64 * 32 + w) : (3872 + 512 + q64 * 32 + (w - 32));
  }
  if (n < 5376) return n + 32;
  if (n < 5408) return n - 5376 + 2560;
  return -1;
}

DI void transpose_tile(const float* src, int ldsrc, int kind, const float* rowscale, bf16_t* dst, int lddst, int n0, int k0, float* tile) {
  int tid = threadIdx.x; asm volatile("" : "+v"(tid));
  __syncthreads();
  {
    const int c4 = (tid & 15) * 4, rr = tid >> 4;
    const int n = (kind == 0) ? win_colmap(n0 + c4) : (n0 + c4);
#pragma unroll
    for (int ps = 0; ps < 4; ++ps) {
      const int r = rr + ps * 16, k = k0 + r;
      float4 v = make_float4(0.f, 0.f, 0.f, 0.f);
      if (n >= 0) v = *(const float4*)(src + (size_t)k * ldsrc + n);
      if (rowscale != nullptr && k < 1024) { const float s = rowscale[k]; v.x *= s; v.y *= s; v.z *= s; v.w *= s; }
      tile[r * 65 + c4] = v.x; tile[r * 65 + c4 + 1] = v.y; tile[r * 65 + c4 + 2] = v.z; tile[r * 65 + c4 + 3] = v.w;
    }
  }
  __syncthreads();
  {
    const int k8 = (tid & 7) * 8, nn = tid >> 3;
#pragma unroll
    for (int ps = 0; ps < 2; ++ps) {
      const int r = nn + ps * 32;
      uint4 o;
      o.x = pack2(tile[(k8 + 0) * 65 + r], tile[(k8 + 1) * 65 + r]);
      o.y = pack2(tile[(k8 + 2) * 65 + r], tile[(k8 + 3) * 65 + r]);
      o.z = pack2(tile[(k8 + 4) * 65 + r], tile[(k8 + 5) * 65 + r]);
      o.w = pack2(tile[(k8 + 6) * 65 + r], tile[(k8 + 7) * 65 + r]);
      *(uint4*)(dst + (size_t)(n0 + r) * lddst + k0 + k8) = o;
    }
  }
}

DI void phase_prep(const Params& p_in, int l, char* smem) {
  const Params p = load_params();

  int tid = threadIdx.x; asm volatile("" : "+v"(tid)); const int lane = tid & 63, wave = tid >> 6;
  const float* mods = (const float*)(p.ws + OFF_MODS);
  bf16_t* H = (bf16_t*)(p.ws + OFF_H);
  const int NT_WIN = 88 * 16, NT_WOUT = 16 * 32, NT_PW = 64, NT_CONV = NT_WIN + NT_WOUT + NT_PW;
  const int NT = NT_CONV + R_ / 8;
  for (int it = blockIdx.x; it < NT; it += gridDim.x) {
    if (l == 1 && (it < NT_WIN || (it >= NT_WIN + NT_WOUT && it < NT_CONV))) continue;
    if (it < NT_WIN) {
      transpose_tile(p.w_in + (size_t)l * 1024 * 5408, 5408, 0, nullptr, (bf16_t*)(p.ws + OFF_WIN), 1024, (it / 16) * 64, (it % 16) * 64, (float*)smem);
    } else if (it < NT_WIN + NT_WOUT) {
      const int t = it - NT_WIN;
      transpose_tile(p.w_out + (size_t)l * 2048 * 1024, 1024, 1, p.ssd_norm_w + l * 1024, (bf16_t*)(p.ws + OFF_WOUT), 2048, (t / 32) * 64, (t % 32) * 64, (float*)smem);
    } else if (it < NT_CONV) {
      const int t = it - NT_WIN - NT_WOUT;
      transpose_tile(p.conv_pw_w + (size_t)l * 512 * 512, 512, 1, nullptr, (bf16_t*)(p.ws + OFF_PW), 512, (t / 8) * 64, (t % 8) * 64, (float*)smem);
    } else {
      const int rho0 = (it - NT_CONV) * 8 + wave * 2;
      const float* xs0;
      if (l == 0) xs0 = (rho0 < RL_) ? (p.x + (size_t)rho0 * 1024) : (p.ctx + (size_t)(rho0 - RL_) * 1024);
      else xs0 = (rho0 < RL_) ? (p.out + (size_t)rho0 * 1024) : ((const float*)(p.ws + OFF_XC) + (size_t)(rho0 - RL_) * 1024);
      const int v = (rho0 < RL_) ? (rho0 >> 12) : 4;
      const float* md = mods + (l * 5 + v) * 3072;
      float4 xv[2][4], nwv[4], shv[4], scv4[4];
#pragma unroll
      for (int i = 0; i < 4; ++i) {
        const int cidx = lane * 4 + i * 256;
        xv[0][i] = *(const float4*)(xs0 + cidx);
        xv[1][i] = *(const float4*)(xs0 + 1024 + cidx);
        nwv[i] = *(const float4*)(p.norm_w + l * 1024 + cidx);
        shv[i] = *(const float4*)(md + cidx);
        scv4[i] = *(const float4*)(md + 1024 + cidx);
      }
#pragma unroll
      for (int q = 0; q < 2; ++q) {
        float ss = 0.f;
#pragma unroll
        for (int i = 0; i < 4; ++i) ss += xv[q][i].x * xv[q][i].x + xv[q][i].y * xv[q][i].y + xv[q][i].z * xv[q][i].z + xv[q][i].w * xv[q][i].w;
#pragma unroll
        for (int o = 32; o >= 1; o >>= 1) ss += __shfl_xor(ss, o);
        const float rs = rsqrtf(ss * (1.f / 1024.f) + 1e-6f);
#pragma unroll
        for (int i = 0; i < 4; ++i) {
          const int cidx = lane * 4 + i * 256;
          const float4 nw = nwv[i], sh = shv[i], sc = scv4[i];
          uint2 o;
          o.x = pack2(xv[q][i].x * rs * nw.x * (1.f + sc.x) + sh.x, xv[q][i].y * rs * nw.y * (1.f + sc.y) + sh.y);
          o.y = pack2(xv[q][i].z * rs * nw.z * (1.f + sc.z) + sh.z, xv[q][i].w * rs * nw.w * (1.f + sc.w) + sh.w);
          *(uint2*)(H + (size_t)(rho0 + q) * 1024 + cidx) = o;
        }
      }
    }
  }
}

DI void phase_inproj(const Params& p_in, char* smem) {
  const Params p = load_params();
  int tid = threadIdx.x; asm volatile("" : "+v"(tid)); const int wave = tid >> 6, wc = wave & 1;
  const bf16_t* H = (const bf16_t*)(p.ws + OFF_H);
  const bf16_t* W = (const bf16_t*)(p.ws + OFF_WIN);
  for (int step = 0;; ++step) {
    int mt, nt2;
    if (!xcd_tile(step, NCK, 22, mt, nt2)) break;
    f32x16 acc[2][4];
#pragma unroll
    for (int i = 0; i < 2; ++i)
#pragma unroll
      for (int j = 0; j < 4; ++j)
#pragma unroll
        for (int r = 0; r < 16; ++r) acc[i][j][r] = 0.f;
    const bf16_t* Ab = H + (size_t)mt * 128 * 1024;
    const bf16_t* Bb = W + (size_t)nt2 * 256 * 1024;
    gemm_core3(acc, (GemmS3*)smem,
               [&](int kt, int r, int kv) { return Ab + (size_t)r * 1024 + kt * 64 + kv * 8; },
               [&](int kt, int r, int kv) { return Bb + (size_t)r * 1024 + kt * 64 + kv * 8; }, 16, [](int) {});
    const int row0 = mt * 128;
    {
      const int ntw = nt2 * 2 + wc;
      if (ntw >= 30 && ntw < 38) {
#pragma unroll
        for (int i = 0; i < 2; ++i)
#pragma unroll
          for (int r = 0; r < 16; ++r) {
            acc[i][0][r] = acc[i][0][r] * sigmoid_f(acc[i][1][r]);
            acc[i][2][r] = acc[i][2][r] * sigmoid_f(acc[i][3][r]);
          }
      }
    }
#pragma unroll 1
    for (int sub = 0; sub < 2; ++sub) {
      const int nt = nt2 * 2 + sub;
      if (nt >= 43) break;
      if (nt >= 30 && nt < 38) {
        bf16_t* G = (bf16_t*)(p.ws + OFF_GLU);
        const int cb0 = (nt - 30) * 64;
        epilogue_lds2w(acc, smem, sub, [&](int rl, int c8, float4 lo, float4 hi) {
          if ((c8 & 32) == 0) {
            uint4 o; o.x = pack2(lo.x, lo.y); o.y = pack2(lo.z, lo.w); o.z = pack2(hi.x, hi.y); o.w = pack2(hi.z, hi.w);
            *(uint4*)(G + (size_t)(row0 + rl) * 512 + cb0 + (c8 >> 6) * 32 + (c8 & 31)) = o;
          }
        });
      } else if (nt >= 20 && nt < 24) {
        epilogue_rope(acc, smem, sub, (bf16_t*)(p.ws + OFF_Q), 512, nt * 128 - 2560, row0, 0.18033688011112042f);
      } else if (nt == 24) {
        epilogue_rope(acc, smem, sub, (bf16_t*)(p.ws + OFF_KV), 256, 0, row0, 1.f);
      } else if (nt == 42) {
        float* DT = (float*)(p.ws + OFF_DT);
        epilogue_lds2(acc, smem, sub, [&](int rl, int c4, float4 v) {
          if (c4 < 32) *(float4*)(DT + (size_t)(row0 + rl) * 32 + c4) = v;
        });
      } else {
        bf16_t* dst; int ld, cb;
        if (nt < 12) { dst = (bf16_t*)(p.ws + OFF_XBC); ld = 1536; cb = nt * 128; }
        else if (nt < 20) { dst = (bf16_t*)(p.ws + OFF_Z); ld = 1024; cb = nt * 128 - 1536; }
        else if (nt < 24) { dst = (bf16_t*)(p.ws + OFF_Q); ld = 512; cb = nt * 128 - 2560; }
        else if (nt < 26) { dst = (bf16_t*)(p.ws + OFF_KV); ld = 256; cb = nt * 128 - 3072; }
        else if (nt < 30) { dst = (bf16_t*)(p.ws + OFF_AG); ld = 512; cb = nt * 128 - 3328; }
        else { dst = (bf16_t*)(p.ws + OFF_CG); ld = 512; cb = nt * 128 - 4864; }
        epilogue_lds2w(acc, smem, sub, [&](int rl, int c8, float4 lo, float4 hi) {
          uint4 o; o.x = pack2(lo.x, lo.y); o.y = pack2(lo.z, lo.w); o.z = pack2(hi.x, hi.y); o.w = pack2(hi.z, hi.w);
          *(uint4*)(dst + (size_t)(row0 + rl) * ld + cb + c8) = o;
        });
      }
    }
  }
}

DI void phase_local(const Params& p_in, int l, char* smem) {
  const Params p = load_params();

  int tid = threadIdx.x; asm volatile("" : "+v"(tid)); const int lane = tid & 63;
  const bf16_t* XBC = (const bf16_t*)(p.ws + OFF_XBC);
  bf16_t* XS = (bf16_t*)(p.ws + OFF_H);
  bf16_t* BC = (bf16_t*)(p.ws + OFF_BC);
  float* DT = (float*)(p.ws + OFF_DT);
  float* CS = (float*)(p.ws + OFF_CS);
  const bf16_t* GLU = (const bf16_t*)(p.ws + OFF_GLU);
  bf16_t* HDN = (bf16_t*)(p.ws + OFF_HDN);
  bf16_t* Q = (bf16_t*)(p.ws + OFF_Q);
  bf16_t* KV = (bf16_t*)(p.ws + OFF_KV);
  { float* SSQ = (float*)(p.ws + OFF_RSTD); for (int i = blockIdx.x * 256 + tid; i < R_ * 2; i += gridDim.x * 256) SSQ[i] = 0.f; }
  const int N_CONV = (R_ / 4) * 192 / 256;
  const int N_DT = NCK;
  const int N_CF = R_ / 16;
  const int N_ROPE = 0;
  const int N_QC = 0;
  const int NT = N_CF + N_DT + N_CONV + N_ROPE + N_QC;
  for (int it0 = blockIdx.x; it0 < NT; it0 += gridDim.x) {
    int it = it0;
    if (it < N_CF) {
      float* sst = (float*)smem;
      unsigned* sIn = (unsigned*)(smem + 256);
      const int row0 = it * 16;
      const int seq0 = (row0 < RL_) ? (row0 & ~4095) : (RL_ + ((row0 - RL_) & ~255));
      const int slen = (row0 < RL_) ? 4096 : 256;
      const int t0 = row0 - seq0;
      const int c0 = tid * 2;
      __syncthreads();
      if (tid < 32) sst[tid] = 0.f;
      for (int idx = tid; idx < 46 * 64; idx += 256) {
        const int rr = idx >> 6, c16 = idx & 63;
        const int tt = t0 - 15 + rr;
        uint4 val = make_uint4(0u, 0u, 0u, 0u);
        if (tt >= 0 && tt < slen) val = *(const uint4*)(GLU + (size_t)(seq0 + tt) * 512 + c16 * 8);
        *(uint4*)&sIn[rr * 256 + c16 * 4] = val;
      }
      float w0[31], w1[31];
#pragma unroll
      for (int k = 0; k < 31; ++k) {
        const float2 wv = *(const float2*)(p.conv_dw_w + ((size_t)l * 31 + k) * 512 + c0);
        w0[k] = wv.x; w1[k] = wv.y;
      }
      const float2 bv = *(const float2*)(p.conv_dw_b + l * 512 + c0);
      float a0[16], a1[16];
#pragma unroll
      for (int r = 0; r < 16; ++r) { a0[r] = bv.x; a1[r] = bv.y; }
      __syncthreads();
#pragma unroll
      for (int tp = 0; tp < 46; ++tp) {
        const unsigned u = sIn[tp * 256 + tid];
        const float x0 = lo2f(u), x1 = hi2f(u);
#pragma unroll
        for (int r = 0; r < 16; ++r) {
          const int k = tp - r;
          if (k >= 0 && k < 31) { a0[r] += w0[k] * x0; a1[r] += w1[k] * x1; }
        }
        if ((tp & 7) == 7) __builtin_amdgcn_sched_barrier(0);
      }
      {
        float v[32];
#pragma unroll
        for (int r = 0; r < 16; ++r) { v[2 * r] = a0[r] + a1[r]; v[2 * r + 1] = a0[r] * a0[r] + a1[r] * a1[r]; }
#pragma unroll
        for (int i = 0; i < 16; ++i) { const bool up = (lane & 32) != 0; const float keep = up ? v[i + 16] : v[i]; const float send = up ? v[i] : v[i + 16]; v[i] = keep + __shfl_xor(send, 32); }
#pragma unroll
        for (int i = 0; i < 8; ++i) { const bool up = (lane & 16) != 0; const float keep = up ? v[i + 8] : v[i]; const float send = up ? v[i] : v[i + 8]; v[i] = keep + __shfl_xor(send, 16); }
#pragma unroll
        for (int i = 0; i < 4; ++i) { const bool up = (lane & 8) != 0; const float keep = up ? v[i + 4] : v[i]; const float send = up ? v[i] : v[i + 4]; v[i] = keep + __shfl_xor(send, 8); }
#pragma unroll
        for (int i = 0; i < 2; ++i) { const bool up = (lane & 4) != 0; const float keep = up ? v[i + 2] : v[i]; const float send = up ? v[i] : v[i + 2]; v[i] = keep + __shfl_xor(send, 4); }
        { const bool up = (lane & 2) != 0; const float keep = up ? v[1] : v[0]; const float send = up ? v[0] : v[1]; v[0] = keep + __shfl_xor(send, 2); }
        v[0] += __shfl_xor(v[0], 1);
        __syncthreads();
        if ((lane & 1) == 0) atomicAdd(&sst[lane >> 1], v[0]);
      }
      __syncthreads();
      const float2 lw = *(const float2*)(p.conv_ln_w + l * 512 + c0);
      const float2 lb = *(const float2*)(p.conv_ln_b + l * 512 + c0);
#pragma unroll
      for (int r = 0; r < 16; ++r) {
        const float mean = sst[r * 2] * (1.f / 512.f);
        const float var = fmaxf(sst[r * 2 + 1] * (1.f / 512.f) - mean * mean, 0.f);
        const float rs = rsqrtf(var + 1e-6f);
        const float y0 = (a0[r] - mean) * rs * lw.x + lb.x;
        const float y1 = (a1[r] - mean) * rs * lw.y + lb.y;
        *(unsigned*)(HDN + (size_t)(row0 + r) * 512 + c0) = pack2(silu_f(y0), silu_f(y1));
        if ((r & 3) == 3) __builtin_amdgcn_sched_barrier(0);
      }
      continue;
    }
    it -= N_CF;
    if (it < N_DT) {
      float* sdt = (float*)smem;
      float* ssum = (float*)(smem + 128 * 33 * 4);
      const int row0 = it * 128;
      __syncthreads();
      for (int e = tid; e < 4096; e += 256) {
        const int r = e >> 5, cidx = e & 31;
        const float raw = DT[(size_t)(row0 + r) * 32 + cidx] + p.ssd_dt_bias[l * 32 + cidx];
        const float sp = (raw > 20.f) ? raw : log1pf(expf(raw));
        DT[(size_t)(row0 + r) * 32 + cidx] = sp;
        sdt[r * 33 + cidx] = sp;
      }
      __syncthreads();
      const int col = tid & 31, seg = tid >> 5;
      const float a = -expf(p.ssd_a_log[l * 32 + col]);
      float loc[16];
      float run = 0.f;
      if (col < 16) {
#pragma unroll
        for (int r = 0; r < 16; ++r) { run += sdt[(seg * 16 + r) * 33 + col] * a; loc[r] = run; }
      } else {
#pragma unroll
        for (int r = 15; r >= 0; --r) { run += sdt[(seg * 16 + r) * 33 + col] * a; loc[r] = run; }
      }
      ssum[seg * 32 + col] = run;
      __syncthreads();
      float off = 0.f;
      if (col < 16) { for (int s2 = 0; s2 < seg; ++s2) off += ssum[s2 * 32 + col]; }
      else { for (int s2 = 7; s2 > seg; --s2) off += ssum[s2 * 32 + col]; }
#pragma unroll
      for (int r = 0; r < 16; ++r) CS[(size_t)(row0 + seg * 16 + r) * 32 + col] = off + loc[r];
      continue;
    }
    it -= N_DT;
    if (it < N_CONV) {
      const int e = it * 256 + tid;
      const int rb = e / 192, cgp = e % 192, ch0 = cgp * 8;
      const int rho0 = rb * 4;
      const int seq0 = (rho0 < RL_) ? (rho0 & ~4095) : (RL_ + ((rho0 - RL_) & ~255));
      const int slen = (rho0 < RL_) ? 4096 : 256;
      const int t0 = rho0 - seq0;
      uint4 xr[8];
#pragma unroll
      for (int i = 0; i < 8; ++i) {
        const int tt = t0 + i - 2;
        xr[i] = make_uint4(0u, 0u, 0u, 0u);
        if (tt >= 0 && tt < slen) xr[i] = *(const uint4*)(XBC + (size_t)(seq0 + tt) * 1536 + ch0);
      }
      float wk[5][8];
#pragma unroll
      for (int k = 0; k < 5; ++k) {
        const float4 w0 = *(const float4*)(p.ssd_conv_w + ((size_t)l * 5 + k) * 1536 + ch0);
        const float4 w1 = *(const float4*)(p.ssd_conv_w + ((size_t)l * 5 + k) * 1536 + ch0 + 4);
        wk[k][0] = w0.x; wk[k][1] = w0.y; wk[k][2] = w0.z; wk[k][3] = w0.w; wk[k][4] = w1.x; wk[k][5] = w1.y; wk[k][6] = w1.z; wk[k][7] = w1.w;
      }
      float bias[8];
      {
        const float4 b0 = *(const float4*)(p.ssd_conv_b + l * 1536 + ch0);
        const float4 b1 = *(const float4*)(p.ssd_conv_b + l * 1536 + ch0 + 4);
        bias[0] = b0.x; bias[1] = b0.y; bias[2] = b0.z; bias[3] = b0.w; bias[4] = b1.x; bias[5] = b1.y; bias[6] = b1.z; bias[7] = b1.w;
      }
#pragma unroll
      for (int r = 0; r < 4; ++r) {
        float a[8];
#pragma unroll
        for (int c = 0; c < 8; ++c) a[c] = bias[c];
#pragma unroll
        for (int k = 0; k < 5; ++k) {
          const uint4 u = xr[r + k];
          a[0] += wk[k][0] * lo2f(u.x); a[1] += wk[k][1] * hi2f(u.x); a[2] += wk[k][2] * lo2f(u.y); a[3] += wk[k][3] * hi2f(u.y);
          a[4] += wk[k][4] * lo2f(u.z); a[5] += wk[k][5] * hi2f(u.z); a[6] += wk[k][6] * lo2f(u.w); a[7] += wk[k][7] * hi2f(u.w);
        }
        uint4 o;
        o.x = pack2(silu_f(a[0]), silu_f(a[1])); o.y = pack2(silu_f(a[2]), silu_f(a[3]));
        o.z = pack2(silu_f(a[4]), silu_f(a[5])); o.w = pack2(silu_f(a[6]), silu_f(a[7]));
        const size_t rho = (size_t)(rho0 + r);
        if (ch0 < 1024) *(uint4*)(XS + rho * 1024 + ch0) = o;
        else *(uint4*)(BC + rho * 512 + (ch0 - 1024)) = o;
      }
      continue;
    }
    it -= N_CONV;
    if (it < N_ROPE) {
      const int e = it * 256 + tid;
      const int rho = e / 40, rem = e % 40, hd = rem >> 2, sub = rem & 3;
      const int axis = sub >> 1, half = sub & 1;
      const int t = rho & 4095;
      const float pos = (float)(axis == 0 ? (t >> 6) : (t & 63));
      bf16_t* base = ((hd < 8) ? (Q + (size_t)rho * 512 + hd * 64) : (KV + (size_t)rho * 256 + (hd - 8) * 64)) + axis * 32 + half * 8;
      const float sc = (hd < 8) ? 0.18033688011112042f : 1.f;
      const uint4 u1 = *(const uint4*)base, u2 = *(const uint4*)(base + 16);
      const unsigned a1[4] = {u1.x, u1.y, u1.z, u1.w}, a2[4] = {u2.x, u2.y, u2.z, u2.w};
      unsigned o1[4], o2[4];
#pragma unroll
      for (int i = 0; i < 4; ++i) {
        float r1[2], r2[2];
#pragma unroll
        for (int hl = 0; hl < 2; ++hl) {
          const float f = (float)(half * 8 + 2 * i + hl);
          const float ang = pos * exp2f(-f * 0.8304820237218406f);
          const float cs = __cosf(ang), sn = __sinf(ang);
          const float t1 = hl ? hi2f(a1[i]) : lo2f(a1[i]);
          const float t2 = hl ? hi2f(a2[i]) : lo2f(a2[i]);
          r1[hl] = (t1 * cs - t2 * sn) * sc;
          r2[hl] = (t2 * cs + t1 * sn) * sc;
        }
        o1[i] = pack2(r1[0], r1[1]); o2[i] = pack2(r2[0], r2[1]);
      }
      *(uint4*)base = make_uint4(o1[0], o1[1], o1[2], o1[3]);
      *(uint4*)(base + 16) = make_uint4(o2[0], o2[1], o2[2], o2[3]);
      continue;
    }
    it -= N_ROPE;
    {
      const int e = it * 256 + tid;
      const int rho = RL_ + e / 256, c2 = (e % 256) * 2;
      unsigned* ptr = (unsigned*)(Q + (size_t)rho * 512 + c2);
      const unsigned u = *ptr;
      *ptr = pack2(lo2f(u) * 0.18033688011112042f, hi2f(u) * 0.18033688011112042f);
    }
  }
}

DI void attn_item(const Params& p_in, int l, char* smem, int b, int qblk, int g, int hp, bool ctxq) {
  const Params p = load_params();

  bf16_t* sK = (bf16_t*)smem;
  bf16_t* sV = (bf16_t*)(smem + 128 * 72 * 2);
  int tid = threadIdx.x; asm volatile("" : "+v"(tid)); const int lane = tid & 63, wave = tid >> 6, fr = lane & 31, fh = lane >> 5;
  const int head = g * 4 + hp * 2 + (wave >> 1);
  const int qh = wave & 1;
  const int qrow0 = (ctxq ? (RL_ + b * 256) : (b * 4096)) + qblk * 128 + qh * 64;
  const int qpos0 = qblk * 128 + qh * 64;
  bf16_t* Q = (bf16_t*)(p.ws + OFF_Q);
  const bf16_t* KV = (const bf16_t*)(p.ws + OFF_KV);
  const bf16_t* AG = (const bf16_t*)(p.ws + OFF_AG);
  f32x16 o[2][2];
  zero_acc(o);
  float m[2], lsum[2];
  m[0] = m[1] = p.attn_sink[l * 8 + head] * 1.4426950408889634f;
  lsum[0] = lsum[1] = 1.f;
  const int nhb = ctxq ? 4 : 10;
  auto hb_row = [&](int hb) -> int {
    if (hb >= nhb) return -1;
    if (hb < 4) return RL_ + b * 256 + hb * 64;
    const int kp = (qblk - 1) * 128 + (hb - 4) * 64;
    if (kp < 0 || kp >= 4096) return -1;
    return b * 4096 + kp;
  };
  auto hb_next = [&](int hb) -> int { int n = hb + 1; while (n < nhb && hb_row(n) < 0) ++n; return n; };
  const int sr = tid >> 3, scv = tid & 7;
  uint4 kp0, kp1, vp0, vp1;
#define ATT_PREFETCH(ROW0) { const bf16_t* kvp = KV + (size_t)((ROW0) + sr) * 256 + g * 64 + scv * 8; \
    kp0 = *(const uint4*)(kvp); kp1 = *(const uint4*)(kvp + 32 * 256); vp0 = *(const uint4*)(kvp + 128); vp1 = *(const uint4*)(kvp + 128 + 32 * 256); }
#define ATT_STORE(BUF) { bf16_t* k_ = sK + (BUF) * 64 * 72; bf16_t* v_ = sV + (BUF) * 64 * 72; \
    *(uint4*)&k_[sr * 72 + scv * 8] = kp0; *(uint4*)&k_[(sr + 32) * 72 + scv * 8] = kp1; \
    *(uint4*)&v_[sr * 72 + scv * 8] = vp0; *(uint4*)&v_[(sr + 32) * 72 + scv * 8] = vp1; }
  int pbuf = 0;
  __syncthreads();
  ATT_PREFETCH(hb_row(0))
  ATT_STORE(0)
  __syncthreads();
  for (int hb = 0; hb < nhb; hb = hb_next(hb)) {
    const int nxt = hb_next(hb);
    if (nxt < nhb) ATT_PREFETCH(hb_row(nxt))
    int kpos0 = 0;
    bool masked = false;
    if (hb >= 4) { kpos0 = (qblk - 1) * 128 + (hb - 4) * 64; masked = (hb != 6 && hb != 7); }
    const bf16_t* cK = sK + pbuf * 64 * 72;
    const bf16_t* cV = sV + pbuf * 64 * 72;
    bf16x8 qf[2][4];
#pragma unroll
    for (int j = 0; j < 2; ++j)
#pragma unroll
      for (int ks = 0; ks < 4; ++ks)
        qf[j][ks] = *(const bf16x8*)(Q + (size_t)(qrow0 + j * 32 + fr) * 512 + head * 64 + ks * 16 + fh * 8);
#pragma unroll 1
    for (int kb = 0; kb < 2; ++kb) {
      if (masked) {
        const int klo = kpos0 + kb * 32, khi = klo + 31;
        if (klo - (qpos0 + 63) > 128 || qpos0 - khi > 128) continue;
      }
      bf16x8 pb[2][2];
#pragma unroll
      for (int j = 0; j < 2; ++j) {
        f32x16 st[2];
#pragma unroll
        for (int r = 0; r < 16; ++r) st[j][r] = -m[j];
#pragma unroll
        for (int ks = 0; ks < 4; ++ks) {
          const bf16x8 kf = *(const bf16x8*)&cK[(kb * 32 + fr) * 72 + ks * 16 + fh * 8];
          st[j] = MFMA(kf, qf[j][ks], st[j]);
        }
        if (masked) {
          const int qpos = qpos0 + j * 32 + fr;
#pragma unroll
          for (int r = 0; r < 16; ++r) {
            const int d = qpos - (kpos0 + kb * 32 + crow(r, fh));
            if (d > 128 || d < -128) st[j][r] = -1e30f;
          }
        }
        float mx = st[j][0];
#pragma unroll
        for (int r = 1; r < 16; ++r) mx = fmaxf(mx, st[j][r]);
        mx = fmaxf(mx, __shfl_xor(mx, 32));
        const bool grow = mx > 8.f;
        if (__builtin_amdgcn_ballot_w64(grow) != 0ull) {
          const float delta = grow ? mx : 0.f;
          const float alpha = __builtin_amdgcn_exp2f(-delta);
#pragma unroll
          for (int r = 0; r < 16; ++r) st[j][r] -= delta;
          lsum[j] *= alpha;
          m[j] += delta;
#pragma unroll
          for (int mt = 0; mt < 2; ++mt)
#pragma unroll
            for (int r = 0; r < 16; ++r) o[mt][j][r] *= alpha;
        }
        float rs = 0.f;
#pragma unroll
        for (int r = 0; r < 16; ++r) { const float pv = __builtin_amdgcn_exp2f(st[j][r]); st[j][r] = pv; rs += pv; }
        rs += __shfl_xor(rs, 32);
        lsum[j] += rs;
#pragma unroll
        for (int s = 0; s < 2; ++s) {
          uint4 pk;
          pk.x = pack2(st[j][8 * s + 0], st[j][8 * s + 1]); pk.y = pack2(st[j][8 * s + 2], st[j][8 * s + 3]);
          pk.z = pack2(st[j][8 * s + 4], st[j][8 * s + 5]); pk.w = pack2(st[j][8 * s + 6], st[j][8 * s + 7]);
          pb[j][s] = __builtin_bit_cast(bf16x8, pk);
        }
      }
#pragma unroll
      for (int s = 0; s < 2; ++s)
#pragma unroll
        for (int mt = 0; mt < 2; ++mt) {
          const bf16x8 vf = tr_frag(cV, 72, kb * 32 + 16 * s + 4 * fh, kb * 32 + 16 * s + 8 + 4 * fh, mt * 32);
#pragma unroll
          for (int j = 0; j < 2; ++j) o[mt][j] = MFMA(vf, pb[j][s], o[mt][j]);
        }
    }
    if (nxt < nhb) ATT_STORE(pbuf ^ 1)
    pbuf ^= 1;
    __syncthreads();
  }
#undef ATT_PREFETCH
#undef ATT_STORE
#pragma unroll
  for (int j = 0; j < 2; ++j) {
    const float inv = 1.f / lsum[j];
    const size_t rho = (size_t)(qrow0 + j * 32 + fr);
#pragma unroll
    for (int mt = 0; mt < 2; ++mt)
#pragma unroll
      for (int g4 = 0; g4 < 4; ++g4) {
        const int d0 = mt * 32 + 8 * g4 + 4 * fh;
        const uint2 gv = *(const uint2*)(AG + rho * 512 + head * 64 + d0);
        uint2 ov;
        ov.x = pack2(o[mt][j][g4 * 4 + 0] * inv * silu_f(lo2f(gv.x)), o[mt][j][g4 * 4 + 1] * inv * silu_f(hi2f(gv.x)));
        ov.y = pack2(o[mt][j][g4 * 4 + 2] * inv * silu_f(lo2f(gv.y)), o[mt][j][g4 * 4 + 3] * inv * silu_f(hi2f(gv.y)));
        *(uint2*)(Q + rho * 512 + head * 64 + d0) = ov;
      }
  }
}

DI void states_item(const Params& p_in, char* smem, int ck, int g, int hq) {
  const Params p = load_params();

  bf16_t* sB = (bf16_t*)smem;
  bf16_t* sX = (bf16_t*)(smem + 128 * 136 * 2);
  int tid = threadIdx.x; asm volatile("" : "+v"(tid)); const int lane = tid & 63, wave = tid >> 6, wr = wave >> 1, wc = wave & 1, fr = lane & 31, fh = lane >> 5;
  const bf16_t* BC = (const bf16_t*)(p.ws + OFF_BC);
  const bf16_t* XS = (const bf16_t*)(p.ws + OFF_H);
  const float* DT = (const float*)(p.ws + OFF_DT);
  const float* CS = (const float*)(p.ws + OFF_CS);
  bf16_t* ST = (bf16_t*)(p.ws + OFF_ST);
  float* CDEC = (float*)(p.ws + OFF_CDEC);
  const int row0 = ck * 128;
  __syncthreads();
  for (int v = tid; v < 2048; v += 256) {
    const int r = v >> 4, cv = v & 15;
    *(uint4*)&sB[r * 136 + cv * 8] = *(const uint4*)(BC + (size_t)(row0 + r) * 512 + g * 128 + cv * 8);
  }
  __syncthreads();
  bf16x8 bfr[2][8];
#pragma unroll
  for (int j = 0; j < 2; ++j)
#pragma unroll
    for (int ks = 0; ks < 8; ++ks) bfr[j][ks] = tr_frag(sB, 136, ks * 16 + 8 * fh, ks * 16 + 8 * fh + 4, wc * 64 + j * 32);
  const int slr = tid >> 3, scv = tid & 7;
  uint4 xq0, xq1, xq2, xq3;
  float dq0, dq1, dq2, dq3, cq0, cq1, cq2, cq3, cendq;
#define ST_PREFETCH(HD) { const int head_ = g * 8 + hq * 4 + ((HD) >> 1), d_ = (HD) & 1, col_ = d_ * 16 + head_; \
    const bf16_t* xp_ = XS + (size_t)(row0 + slr) * 1024 + head_ * 64 + scv * 8; \
    xq0 = *(const uint4*)(xp_); xq1 = *(const uint4*)(xp_ + 32 * 1024); xq2 = *(const uint4*)(xp_ + 64 * 1024); xq3 = *(const uint4*)(xp_ + 96 * 1024); \
    const size_t rb_ = (size_t)(row0 + slr) * 32 + col_; \
    dq0 = DT[rb_]; dq1 = DT[rb_ + 32 * 32]; dq2 = DT[rb_ + 64 * 32]; dq3 = DT[rb_ + 96 * 32]; \
    cq0 = CS[rb_]; cq1 = CS[rb_ + 32 * 32]; cq2 = CS[rb_ + 64 * 32]; cq3 = CS[rb_ + 96 * 32]; \
    cendq = CS[(size_t)(row0 + (d_ == 0 ? 127 : 0)) * 32 + col_]; }
#define ST_SCALE_STORE(X, DTV, CSV, ROW) { const float sc_ = (DTV) * __expf(cend - (CSV)); uint4 o_; \
    o_.x = pack2(lo2f(X.x) * sc_, hi2f(X.x) * sc_); o_.y = pack2(lo2f(X.y) * sc_, hi2f(X.y) * sc_); \
    o_.z = pack2(lo2f(X.z) * sc_, hi2f(X.z) * sc_); o_.w = pack2(lo2f(X.w) * sc_, hi2f(X.w) * sc_); \
    *(uint4*)&sX[(ROW) * 72 + scv * 8] = o_; }
  ST_PREFETCH(0)
#pragma unroll 1
  for (int hd = 0; hd < 8; ++hd) {
    const int head = g * 8 + hq * 4 + (hd >> 1), d = hd & 1;
    const float cend = cendq;
    ST_SCALE_STORE(xq0, dq0, cq0, slr)
    ST_SCALE_STORE(xq1, dq1, cq1, slr + 32)
    ST_SCALE_STORE(xq2, dq2, cq2, slr + 64)
    ST_SCALE_STORE(xq3, dq3, cq3, slr + 96)
    if (hd < 7) ST_PREFETCH(hd + 1)
    __syncthreads();
    f32x16 acc[2];
#pragma unroll
    for (int j = 0; j < 2; ++j)
#pragma unroll
      for (int r = 0; r < 16; ++r) acc[j][r] = 0.f;
#pragma unroll
    for (int ks = 0; ks < 8; ++ks) {
      const bf16x8 af = tr_frag(sX, 72, ks * 16 + 8 * fh, ks * 16 + 8 * fh + 4, wr * 32);
#pragma unroll
      for (int j = 0; j < 2; ++j) acc[j] = MFMA(af, bfr[j][ks], acc[j]);
    }
    bf16_t* dst = ST + ((size_t)(ck * 2 + d) * 16 + head) * 8192;
#pragma unroll
    for (int j = 0; j < 2; ++j)
#pragma unroll
      for (int r = 0; r < 16; ++r) dst[(wr * 32 + crow(r, fh)) * 128 + wc * 64 + j * 32 + fr] = f2bf(acc[j][r]);
    if (tid == 0) CDEC[(ck * 2 + d) * 16 + head] = __expf(cend);
    __syncthreads();
  }
}

DI void pw_item(const Params& p_in, int l, char* smem, int mt, int nt) {
  const Params p = load_params();

  GemmS* s = (GemmS*)smem;
  int tid = threadIdx.x; asm volatile("" : "+v"(tid)); const int lane = tid & 63, wave = tid >> 6, wr = wave >> 1, wc = wave & 1, fr = lane & 31, fh = lane >> 5;
  const bf16_t* Ab = (const bf16_t*)(p.ws + OFF_HDN) + (size_t)mt * 128 * 512;
  const bf16_t* Bb = (const bf16_t*)(p.ws + OFF_PW) + (size_t)nt * 128 * 512;
  bf16_t* CG = (bf16_t*)(p.ws + OFF_CG);
  f32x16 acc[2][2];
  zero_acc(acc);
  gemm_core2(acc, (GemmS2*)smem,
             [&](int kt, int r, int kv) { return Ab + (size_t)r * 512 + kt * 64 + kv * 8; },
             [&](int kt, int r, int kv) { return Bb + (size_t)r * 512 + kt * 64 + kv * 8; }, 8, [](int) {});
  const float* pwb = p.conv_pw_b + l * 512 + nt * 128;
  epilogue_lds(acc, smem, [&](int rl, int c4, float4 v) {
    bf16_t* ptr = CG + (size_t)(mt * 128 + rl) * 512 + nt * 128 + c4;
    const uint2 gv = *(const uint2*)ptr;
    const float4 bb = *(const float4*)(pwb + c4);
    uint2 o;
    o.x = pack2((v.x + bb.x) * silu_f(lo2f(gv.x)), (v.y + bb.y) * silu_f(hi2f(gv.x)));
    o.y = pack2((v.z + bb.z) * silu_f(lo2f(gv.y)), (v.w + bb.w) * silu_f(hi2f(gv.y)));
    *(uint2*)ptr = o;
  });
}

DI void phase_mix(const Params& p, int l, char* smem) {
  const int G = gridDim.x;
  const int N_ATT = 512 + (l == 0 ? 32 : 0);
  for (int it = blockIdx.x; it < N_ATT; it += G) {
    if (it < 512) attn_item(p, l, smem, it >> 7, (it >> 2) & 31, (it >> 1) & 1, it & 1, false);
    else { const int t = it - 512; attn_item(p, l, smem, t >> 3, (t >> 2) & 1, (t >> 1) & 1, t & 1, true); }
  }
  for (int it = (blockIdx.x + G - 32) % G; it < NCK * 4; it += G) states_item(p, smem, it >> 2, (it >> 1) & 1, it & 1);
  for (int it = (blockIdx.x + G - 64) % G; it < NCK * 4; it += G) pw_item(p, l, smem, it >> 2, it & 3);
}

DI void phase_scan(const Params& p_in) {
  const Params p = load_params();

  bf16_t* ST = (bf16_t*)(p.ws + OFF_ST);
  const float* CDEC = (const float*)(p.ws + OFF_CDEC);
  for (int it = blockIdx.x; it < 512; it += gridDim.x) {
    const int e = it * 256 + threadIdx.x;
    const int bdh = e >> 10, v8 = e & 1023;
    const int b = bdh >> 5, d = (bdh >> 4) & 1, h = bdh & 15;
    float s[8];
#pragma unroll
    for (int i = 0; i < 8; ++i) s[i] = 0.f;
    auto ckof = [&](int i) {
      if (d == 0) return (i < 2) ? (128 + 2 * b + i) : (32 * b + (i - 2));
      return (i < 2) ? (128 + 2 * b + (1 - i)) : (32 * b + 31 - (i - 2));
    };
    auto pof = [&](int i) { const int ck = ckof(i); return (uint4*)(ST + ((size_t)(ck * 2 + d) * 16 + h) * 8192 + v8 * 8); };
    auto dof = [&](int i) { const int ck = ckof(i); return CDEC[(ck * 2 + d) * 16 + h]; };
    uint4 buf[8]; float dc[8];
#pragma unroll
    for (int i = 0; i < 7; ++i) { buf[i] = *pof(i); dc[i] = dof(i); }
#pragma unroll
    for (int i = 0; i < 34; ++i) {
      if (i + 7 < 34) { buf[(i + 7) & 7] = *pof(i + 7); dc[(i + 7) & 7] = dof(i + 7); }
      const uint4 cur = buf[i & 7];
      const float dec = dc[i & 7];
      uint4 o;
      o.x = pack2(s[0], s[1]); o.y = pack2(s[2], s[3]); o.z = pack2(s[4], s[5]); o.w = pack2(s[6], s[7]);
      *pof(i) = o;
      s[0] = s[0] * dec + lo2f(cur.x); s[1] = s[1] * dec + hi2f(cur.x);
      s[2] = s[2] * dec + lo2f(cur.y); s[3] = s[3] * dec + hi2f(cur.y);
      s[4] = s[4] * dec + lo2f(cur.z); s[5] = s[5] * dec + hi2f(cur.z);
      s[6] = s[6] * dec + lo2f(cur.w); s[7] = s[7] * dec + hi2f(cur.w);
    }
  }
}

DI void phase_ssdy(const Params& p_in, int l, char* smem) {
  const Params p = load_params();

  bf16_t* sB = (bf16_t*)smem;
  bf16_t* sX = (bf16_t*)(smem + 128 * 136 * 2);
  float* sF = (float*)(smem + 128 * 136 * 2 + 128 * 72 * 2);
  float* sSS = sF + 512;
  int tid = threadIdx.x; asm volatile("" : "+v"(tid)); const int lane = tid & 63, wave = tid >> 6, fr = lane & 31, fh = lane >> 5;
  const int wl = wave >> 1, w2 = wave & 1;
  const bf16_t* BC = (const bf16_t*)(p.ws + OFF_BC);
  const bf16_t* XS = (const bf16_t*)(p.ws + OFF_H);
  const float* DT = (const float*)(p.ws + OFF_DT);
  const float* CS = (const float*)(p.ws + OFF_CS);
  const bf16_t* ST = (const bf16_t*)(p.ws + OFF_ST);
  bf16_t* Z = (bf16_t*)(p.ws + OFF_Z);
  float* RSTD = (float*)(p.ws + OFF_RSTD);
  const int nck = (l == 0) ? NCK : 128;
  const int nh = (l == 0) ? 2 : 8;
  const int nsplit = 8 / nh;
  for (int it0 = blockIdx.x; it0 < nck * 4 * nsplit; it0 += gridDim.x) {
    const int hq = it0 % nsplit, it = it0 / nsplit;
    const int hbeg = hq * nh, hend = hbeg + nh;
    const int ck = it >> 2, g = (it >> 1) & 1, lh = it & 1;
    const int row0 = ck * 128;
    const int lbase = lh * 64 + wl * 32;
    __syncthreads();
    for (int v = tid; v < 2048; v += 256) {
      const int r = v >> 4, cv = v & 15;
      *(uint4*)&sB[r * 136 + cv * 8] = *(const uint4*)(BC + (size_t)(row0 + r) * 512 + g * 128 + cv * 8);
    }
    if (tid < 64) sSS[tid] = 0.f;
    const bf16_t* cptr = BC + (size_t)(row0 + lbase + fr) * 512 + 256 + g * 128 + fh * 8;
    bf16x8 cf[8];
#pragma unroll
    for (int ks = 0; ks < 8; ++ks) cf[ks] = *(const bf16x8*)(cptr + ks * 16);
    const int lrx = tid >> 3, cvx = tid & 7;
    const bf16_t* xsrc = XS + (size_t)(row0 + lrx) * 1024 + cvx * 8;
    uint4 xp0, xp1, xp2, xp3;
    float fp0 = 0.f, fp1 = 0.f, fp2 = 0.f, fp3 = 0.f;
    {
      const int head = g * 8 + hbeg;
      xp0 = *(const uint4*)(xsrc + head * 64);
      xp1 = *(const uint4*)(xsrc + head * 64 + 32 * 1024);
      xp2 = *(const uint4*)(xsrc + head * 64 + 64 * 1024);
      xp3 = *(const uint4*)(xsrc + head * 64 + 96 * 1024);
      if (tid < 128) {
        const size_t rho = (size_t)(row0 + tid);
        fp0 = CS[rho * 32 + head]; fp1 = CS[rho * 32 + 16 + head]; fp2 = DT[rho * 32 + head]; fp3 = DT[rho * 32 + 16 + head];
      }
    }
    __syncthreads();
    f32x16 cb[2];
#pragma unroll
    for (int j = 0; j < 2; ++j) {
#pragma unroll
      for (int r = 0; r < 16; ++r) cb[j][r] = 0.f;
#pragma unroll
      for (int ks = 0; ks < 8; ++ks) {
        const bf16x8 bq = *(const bf16x8*)&sB[(w2 * 64 + j * 32 + fr) * 136 + ks * 16 + fh * 8];
        cb[j] = MFMA(cf[ks], bq, cb[j]);
      }
    }
    const int pidx = w2 * 32 + fr;
    bf16_t* sCB = sB + 64 * 136;
    __syncthreads();
#pragma unroll
    for (int j = 0; j < 2; ++j)
#pragma unroll
      for (int r = 0; r < 16; ++r) sCB[(wl * 32 + crow(r, fh)) * 136 + w2 * 64 + j * 32 + fr] = f2bf(cb[j][r]);
#pragma unroll 1
    for (int hh = hbeg; hh < hend; ++hh) {
      const int head = g * 8 + hh;
      __syncthreads();
      *(uint4*)&sX[lrx * 72 + cvx * 8] = xp0;
      *(uint4*)&sX[(lrx + 32) * 72 + cvx * 8] = xp1;
      *(uint4*)&sX[(lrx + 64) * 72 + cvx * 8] = xp2;
      *(uint4*)&sX[(lrx + 96) * 72 + cvx * 8] = xp3;
      if (tid < 128) { sF[tid] = fp0; sF[128 + tid] = fp1; sF[256 + tid] = fp2; sF[384 + tid] = fp3; }
      const bf16_t* S0 = ST + ((size_t)(ck * 2 + 0) * 16 + head) * 8192 + (w2 * 32 + fr) * 128 + fh * 8;
      const bf16_t* S1 = ST + ((size_t)(ck * 2 + 1) * 16 + head) * 8192 + (w2 * 32 + fr) * 128 + fh * 8;
      bf16x8 sf0[8];
#pragma unroll
      for (int ks = 0; ks < 8; ++ks) sf0[ks] = *(const bf16x8*)(S0 + ks * 16);
      bf16_t* zbase = Z + (size_t)(row0 + lbase + 4 * fh) * 1024 + head * 64 + pidx;
      if (hh + 1 < hend) {
        const int hn = head + 1;
        xp0 = *(const uint4*)(xsrc + hn * 64);
        xp1 = *(const uint4*)(xsrc + hn * 64 + 32 * 1024);
        xp2 = *(const uint4*)(xsrc + hn * 64 + 64 * 1024);
        xp3 = *(const uint4*)(xsrc + hn * 64 + 96 * 1024);
        if (tid < 128) {
          const size_t rho = (size_t)(row0 + tid);
          fp0 = CS[rho * 32 + hn]; fp1 = CS[rho * 32 + 16 + hn]; fp2 = DT[rho * 32 + hn]; fp3 = DT[rho * 32 + 16 + hn];
        }
      }
      __syncthreads();
#pragma unroll
      for (int j = 0; j < 2; ++j) {
        const int sidx = w2 * 64 + j * 32 + fr;
        const float csf_s = sF[sidx], csb_s = sF[128 + sidx], dtf_s = sF[256 + sidx], dtb_s = sF[384 + sidx];
#pragma unroll 4
        for (int r = 0; r < 16; ++r) {
          const int lidx = lbase + crow(r, fh);
          float f = 0.f;
          if (sidx <= lidx) f += __expf(sF[lidx] - csf_s) * dtf_s;
          if (sidx >= lidx) f += __expf(sF[128 + lidx] - csb_s) * dtb_s;
          sB[(wl * 32 + crow(r, fh)) * 136 + sidx] = f2bf(bf2f(sCB[(wl * 32 + crow(r, fh)) * 136 + sidx]) * f);
        }
      }
      __syncthreads();
      bf16x8 sf1[8], cfh[8];
#pragma unroll
      for (int ks = 0; ks < 8; ++ks) { sf1[ks] = *(const bf16x8*)(S1 + ks * 16); cfh[ks] = *(const bf16x8*)(cptr + ks * 16); }
      unsigned short zv[16];
#pragma unroll
      for (int r = 0; r < 16; ++r) zv[r] = zbase[(size_t)((r & 3) + 8 * (r >> 2)) * 1024];
      f32x16 accy;
#pragma unroll
      for (int r = 0; r < 16; ++r) accy[r] = 0.f;
#pragma unroll
      for (int ks = 0; ks < 8; ++ks) {
        const bf16x8 af = *(const bf16x8*)&sB[(wl * 32 + fr) * 136 + ks * 16 + fh * 8];
        const bf16x8 xf = tr_frag(sX, 72, ks * 16 + 8 * fh, ks * 16 + 8 * fh + 4, w2 * 32);
        accy = MFMA(af, xf, accy);
      }
      {
        f32x16 acct;
#pragma unroll
        for (int r = 0; r < 16; ++r) acct[r] = 0.f;
#pragma unroll
        for (int ks = 0; ks < 8; ++ks) acct = MFMA(cfh[ks], sf0[ks], acct);
#pragma unroll
        for (int r = 0; r < 16; ++r) accy[r] += __expf(sF[lbase + crow(r, fh)]) * acct[r];
#pragma unroll
        for (int r = 0; r < 16; ++r) acct[r] = 0.f;
#pragma unroll
        for (int ks = 0; ks < 8; ++ks) acct = MFMA(cfh[ks], sf1[ks], acct);
#pragma unroll
        for (int r = 0; r < 16; ++r) accy[r] += __expf(sF[128 + lbase + crow(r, fh)]) * acct[r];
      }
      const float dsk = p.ssd_d[l * 16 + head];
      float v[16];
#pragma unroll
      for (int r = 0; r < 16; ++r) {
        const int lidx = lbase + crow(r, fh);
        const float xv = bf2f(sX[lidx * 72 + pidx]);
        const float y = accy[r] + dsk * xv;
        const float u = y * silu_f(bf2f(zv[r]));
        v[r] = u * u;
        zbase[(size_t)((r & 3) + 8 * (r >> 2)) * 1024] = f2bf(u);
      }
#pragma unroll
      for (int i = 0; i < 8; ++i) { const bool up = (fr & 16) != 0; const float keep = up ? v[i + 8] : v[i]; const float send = up ? v[i] : v[i + 8]; v[i] = keep + __shfl_xor(send, 16); }
#pragma unroll
      for (int i = 0; i < 4; ++i) { const bool up = (fr & 8) != 0; const float keep = up ? v[i + 4] : v[i]; const float send = up ? v[i] : v[i + 4]; v[i] = keep + __shfl_xor(send, 8); }
#pragma unroll
      for (int i = 0; i < 2; ++i) { const bool up = (fr & 4) != 0; const float keep = up ? v[i + 2] : v[i]; const float send = up ? v[i] : v[i + 2]; v[i] = keep + __shfl_xor(send, 4); }
      { const bool up = (fr & 2) != 0; const float keep = up ? v[1] : v[0]; const float send = up ? v[0] : v[1]; v[0] = keep + __shfl_xor(send, 2); }
      v[0] += __shfl_xor(v[0], 1);
      if ((fr & 1) == 0) atomicAdd(&sSS[wl * 32 + crow(fr >> 1, fh)], v[0]);
    }
    __syncthreads();
    if (tid < 64) atomicAdd(&RSTD[(size_t)(row0 + lh * 64 + tid) * 2 + g], sSS[tid]);
  }
}

DI void phase_outproj(const Params& p_in, int l, char* smem) {
  const Params p = load_params();

  GemmS* s = (GemmS*)smem;
  int tid = threadIdx.x; asm volatile("" : "+v"(tid)); const int lane = tid & 63, wave = tid >> 6, wr = wave >> 1, wc = wave & 1, fr = lane & 31, fh = lane >> 5;
  const bf16_t* Zb = (const bf16_t*)(p.ws + OFF_Z);
  const bf16_t* Qb = (const bf16_t*)(p.ws + OFF_Q);
  const bf16_t* Cb = (const bf16_t*)(p.ws + OFF_CG);
  const bf16_t* W = (const bf16_t*)(p.ws + OFF_WOUT);
  const float* RSTD = (const float*)(p.ws + OFF_RSTD);
  const float* mods = (const float*)(p.ws + OFF_MODS);
  float* XC = (float*)(p.ws + OFF_XC);
  for (int step = 0;; ++step) {
    int mt, nt2;
    if (!xcd_tile(step, 128, 4, mt, nt2)) break;
    f32x16 acc[2][4];
#pragma unroll
    for (int i = 0; i < 2; ++i)
#pragma unroll
      for (int j = 0; j < 4; ++j)
#pragma unroll
        for (int r = 0; r < 16; ++r) acc[i][j][r] = 0.f;
    const bf16_t* Wb = W + (size_t)nt2 * 256 * 2048;
    const bf16_t* A0 = Zb + (size_t)mt * 128 * 1024;
    const bf16_t* A2 = Qb + (size_t)mt * 128 * 512;
    const bf16_t* A3 = Cb + (size_t)mt * 128 * 512;
    float* sScale = (float*)(smem + 55296);
    __syncthreads();
    if (tid < 128) {
      const size_t row = (size_t)(mt * 128 + tid);
      const float r0 = rsqrtf(RSTD[row * 2] * (1.f / 512.f) + 1e-6f);
      const float r1 = rsqrtf(RSTD[row * 2 + 1] * (1.f / 512.f) + 1e-6f);
      sScale[tid * 2] = r0 / r1;
      sScale[tid * 2 + 1] = r1;
    }
    gemm_core3(acc, (GemmS3*)smem,
               [&](int kt, int r, int kv) {
                 const bf16_t* ptr;
                 if (kt < 16) ptr = A0 + (size_t)r * 1024 + kt * 64;
                 else if (kt < 24) ptr = A2 + (size_t)r * 512 + (kt - 16) * 64;
                 else ptr = A3 + (size_t)r * 512 + (kt - 24) * 64;
                 return ptr + kv * 8;
               },
               [&](int kt, int r, int kv) { return Wb + (size_t)r * 2048 + kt * 64 + kv * 8; }, 32,
               [&](int kt) __attribute__((always_inline)) {
                 if (kt == 8 || kt == 16) {
#pragma unroll
                   for (int i = 0; i < 2; ++i)
#pragma unroll
                     for (int r = 0; r < 16; ++r) {
                       const float f = sScale[(wr * 64 + i * 32 + crow(r, fh)) * 2 + (kt == 16 ? 1 : 0)];
                       acc[i][0][r] *= f; acc[i][1][r] *= f; acc[i][2][r] *= f; acc[i][3][r] *= f;
                     }
                 }
               });
    {
      const int row0 = mt * 128;
      const int vv = row0 >> 12;
      float* xnew = p.out + (size_t)row0 * 1024;
      const float* xold = (l == 0) ? (p.x + (size_t)row0 * 1024) : xnew;
#pragma unroll 1
      for (int sub = 0; sub < 2; ++sub) {
        const int nt = nt2 * 2 + sub;
        const float* gate = mods + (l * 5 + vv) * 3072 + 2048 + nt * 128;
        epilogue_lds2(acc, smem, sub, [&](int rl, int c4, float4 v) {
          const int off = rl * 1024 + nt * 128 + c4;
          const float4 xo = *(const float4*)(xold + off);
          const float4 gt = *(const float4*)(gate + c4);
          float4 o;
          o.x = xo.x + gt.x * v.x; o.y = xo.y + gt.y * v.y; o.z = xo.z + gt.z * v.z; o.w = xo.w + gt.w * v.w;
          *(float4*)(xnew + off) = o;
        });
      }
    }
  }
  const int nctx = (l == 0) ? 64 : 0;
  for (int it = (int)blockIdx.x; it < nctx; it += gridDim.x) {
    const int mt = 128 + (it >> 3), nt = it & 7;
    f32x16 acc[2][2];
    zero_acc(acc);
    const bf16_t* Wb = W + (size_t)nt * 128 * 2048;
    const bf16_t* A0 = Zb + (size_t)mt * 128 * 1024;
    const bf16_t* A2 = Qb + (size_t)mt * 128 * 512;
    const bf16_t* A3 = Cb + (size_t)mt * 128 * 512;
    float* sScale = (float*)(smem + 40960);
    if (tid < 128) {
      const size_t row = (size_t)(mt * 128 + tid);
      const float r0 = rsqrtf(RSTD[row * 2] * (1.f / 512.f) + 1e-6f);
      const float r1 = rsqrtf(RSTD[row * 2 + 1] * (1.f / 512.f) + 1e-6f);
      sScale[tid * 2] = r0 / r1;
      sScale[tid * 2 + 1] = r1;
    }
    gemm_core2(acc, (GemmS2*)smem,
               [&](int kt, int r, int kv) {
                 const bf16_t* ptr;
                 if (kt < 16) ptr = A0 + (size_t)r * 1024 + kt * 64;
                 else if (kt < 24) ptr = A2 + (size_t)r * 512 + (kt - 16) * 64;
                 else ptr = A3 + (size_t)r * 512 + (kt - 24) * 64;
                 return ptr + kv * 8;
               },
               [&](int kt, int r, int kv) { return Wb + (size_t)r * 2048 + kt * 64 + kv * 8; }, 32,
               [&](int kt) __attribute__((always_inline)) {
                 if (kt == 8 || kt == 16) {
#pragma unroll
                   for (int i = 0; i < 2; ++i)
#pragma unroll
                     for (int r = 0; r < 16; ++r) {
                       const float f = sScale[(wr * 64 + i * 32 + crow(r, fh)) * 2 + (kt == 16 ? 1 : 0)];
                       acc[i][0][r] *= f; acc[i][1][r] *= f;
                     }
                 }
               });
    {
      const int row0 = mt * 128;
      const int vv = (row0 < RL_) ? (row0 >> 12) : 4;
      const float* gate = mods + (l * 5 + vv) * 3072 + 2048 + nt * 128;
      float* xnew = (row0 < RL_) ? (p.out + (size_t)row0 * 1024) : (XC + (size_t)(row0 - RL_) * 1024);
      const float* xold = (l == 0) ? ((row0 < RL_) ? (p.x + (size_t)row0 * 1024) : (p.ctx + (size_t)(row0 - RL_) * 1024)) : xnew;
      epilogue_lds(acc, smem, [&](int rl, int c4, float4 v) {
        const int off = rl * 1024 + nt * 128 + c4;
        const float4 xo = *(const float4*)(xold + off);
        const float4 gt = *(const float4*)(gate + c4);
        float4 o;
        o.x = xo.x + gt.x * v.x; o.y = xo.y + gt.y * v.y; o.z = xo.z + gt.z * v.z; o.w = xo.w + gt.w * v.w;
        *(float4*)(xnew + off) = o;
      });
    }
  }
  if (l == 0) {
    const int local = blockIdx.x >> 3, xcd = blockIdx.x & 7, nloc = gridDim.x >> 3;
    if (local >= 8 && nloc > 8) {
      const int nb = (nloc - 8) * 8;
      const int NT_WIN = 88 * 16, NT_PW = 64;
      for (int it = (local - 8) * 8 + xcd; it < NT_WIN + NT_PW; it += nb) {
        if (it < NT_WIN) transpose_tile(p.w_in + (size_t)1024 * 5408, 5408, 0, nullptr, (bf16_t*)(p.ws + OFF_WIN), 1024, (it / 16) * 64, (it % 16) * 64, (float*)smem);
        else { const int t = it - NT_WIN; transpose_tile(p.conv_pw_w + (size_t)512 * 512, 512, 1, nullptr, (bf16_t*)(p.ws + OFF_PW), 512, (t / 8) * 64, (t % 8) * 64, (float*)smem); }
      }
    }
  }
}

DI void phase_final(const Params& p_in) {
  const Params p = load_params();
  const int lane = threadIdx.x & 63, wave = threadIdx.x >> 6;
  for (int it = blockIdx.x; it < RL_ / 8; it += gridDim.x) {
    float* xr0 = p.out + (size_t)(it * 8 + wave * 2) * 1024;
    float4 xv[2][4];
#pragma unroll
    for (int q = 0; q < 2; ++q)
#pragma unroll
      for (int i = 0; i < 4; ++i) xv[q][i] = *(const float4*)(xr0 + q * 1024 + lane * 4 + i * 256);
    float4 w[4];
#pragma unroll
    for (int i = 0; i < 4; ++i) w[i] = *(const float4*)(p.final_norm_w + lane * 4 + i * 256);
#pragma unroll
    for (int q = 0; q < 2; ++q) {
      float ss = 0.f;
#pragma unroll
      for (int i = 0; i < 4; ++i) ss += xv[q][i].x * xv[q][i].x + xv[q][i].y * xv[q][i].y + xv[q][i].z * xv[q][i].z + xv[q][i].w * xv[q][i].w;
#pragma unroll
      for (int o = 32; o >= 1; o >>= 1) ss += __shfl_xor(ss, o);
      const float rs = rsqrtf(ss * (1.f / 1024.f) + 1e-6f);
#pragma unroll
      for (int i = 0; i < 4; ++i) {
        float4 o;
        o.x = xv[q][i].x * rs * w[i].x; o.y = xv[q][i].y * rs * w[i].y; o.z = xv[q][i].z * rs * w[i].z; o.w = xv[q][i].w * rs * w[i].w;
        *(float4*)(xr0 + q * 1024 + lane * 4 + i * 256) = o;
      }
    }
  }
}

template <int PH>
DI void run_phase(const Params& p, char* smem) {
  constexpr int l = (PH - 1) / 7, s = (PH - 1) % 7;
  if constexpr (PH == 0) phase_mods(p, smem);
  else if constexpr (PH == 15) phase_final(p);
  else if constexpr (s == 0) phase_prep(p, l, smem);
  else if constexpr (s == 1) phase_inproj(p, smem);
  else if constexpr (s == 2) phase_local(p, l, smem);
  else if constexpr (s == 3) phase_mix(p, l, smem);
  else if constexpr (s == 4) phase_scan(p);
  else if constexpr (s == 5) phase_ssdy(p, l, smem);
  else phase_outproj(p, l, smem);
}

#if PROBE_S >= 0
#define PROBE_BEGIN() if (threadIdx.x == 0) pst[1] = wall_clock64();
#define PROBE_END(PH) if (threadIdx.x == 0 && (PH) >= 1 && (PH) <= 14 && (((PH) - 1) % 7) == PROBE_S) pst[0] += wall_clock64() - pst[1];
#else
#define PROBE_BEGIN()
#define PROBE_END(PH)
#endif
#define PHASE(PH) PROBE_BEGIN() run_phase<PH>(p, smem); xcd_barrier(xst); PROBE_END(PH)

__global__ void __launch_bounds__(256, 2) fwd_megakernel(Params p) {
  __shared__ __attribute__((aligned(16))) char smem[57344];
  cg::grid_group grid = cg::this_grid();
  if (threadIdx.x == 0) g_kernarg = (unsigned long long)__builtin_amdgcn_kernarg_segment_ptr();
  __syncthreads();
#if PROBE_S >= 0
  volatile unsigned long long* pst = (volatile unsigned long long*)(smem + 57344 - 16);
  if (threadIdx.x == 0) { pst[0] = 0; pst[1] = 0; }
#endif
  __shared__ uint4 xb_words;
  volatile LAS unsigned* xst = (volatile LAS unsigned*)&xb_words;
  if (threadIdx.x == 0) xb_words = make_uint4(0u, 0u, 0u, 0u);
  if (threadIdx.x == 0) { unsigned* bar = (unsigned*)(load_params().ws + OFF_BAR); (void)xb_add(&bar[XB_XCNT(xb_xcc_id())], 1u); }
  run_phase<0>(p, smem);
  if (load_params().out == nullptr) grid.sync();
  xcd_barrier(xst);
  PHASE(1) PHASE(2) PHASE(3) PHASE(4) PHASE(5) PHASE(6) PHASE(7)
  PHASE(8) PHASE(9) PHASE(10) PHASE(11) PHASE(12) PHASE(13) PHASE(14)
  run_phase<15>(p, smem);
#if PROBE_S >= 0
  if (blockIdx.x == 0 && threadIdx.x == 0) {
    const unsigned long long t1 = wall_clock64();
    const unsigned long long lim = 4ull * pst[0];
    while (wall_clock64() - t1 < lim) { __builtin_amdgcn_s_sleep(32); }
  }
#endif
}

extern "C" void kernel_launch(void* const* d_in, const int* in_sizes, int n_in, void* d_out, int out_size, void* d_ws,
                              size_t ws_size, hipStream_t stream) {
  static int grid_blocks = 0;
  if (!grid_blocks) {
    int dev = 0, cus = 0, per_cu = 0;
    hipGetDevice(&dev);
    hipDeviceGetAttribute(&cus, hipDeviceAttributeMultiprocessorCount, dev);
    hipOccupancyMaxActiveBlocksPerMultiprocessor(&per_cu, fwd_megakernel, 256, 0);
    if (per_cu < 1) per_cu = 1;
    if (per_cu > 2) per_cu = 2;
    grid_blocks = (cus * per_cu) & ~7;
  }
  Params p{};
  const float** pp = (const float**)&p;
  for (int i = 0; i < 23; ++i) pp[i] = (const float*)d_in[i];
  p.out = (float*)d_out;
  p.ws = (char*)d_ws;
  (void)hipMemsetAsync((char*)d_ws + OFF_BAR, 0, XCD_BAR_WORDS * 4, stream);
  void* args[] = {&p};
  hipError_t e = hipLaunchCooperativeKernel((void*)fwd_megakernel, dim3(grid_blocks), dim3(256), args, 0, stream);
  if (e != hipSuccess) fprintf(stderr, "cooperative launch failed: %s (grid %d)\n", hipGetErrorString(e), grid_blocks);
}
```

```cpp
#include <hip/hip_runtime.h>
#include <hip/hip_cooperative_groups.h>
#include <stdint.h>
#include <stdio.h>
namespace cg = cooperative_groups;

#ifndef ONE_LAUNCH
#define ONE_LAUNCH 1
#endif

#ifndef PROBE_S
#define PROBE_S -1
#endif
#define DI __device__ __forceinline__
typedef unsigned short bf16_t;
using bf16x8 = __attribute__((ext_vector_type(8))) short;
using s16x4 = __attribute__((ext_vector_type(4))) short;
using f32x16 = __attribute__((ext_vector_type(16))) float;
#define MFMA(a, b, c) __builtin_amdgcn_mfma_f32_32x32x16_bf16((a), (b), (c), 0, 0, 0)

constexpr int R_ = 17408;
constexpr int RL_ = 16384;
constexpr int NCK = 136;

constexpr size_t SZ_WIN = (size_t)5632 * 1024 * 2;
constexpr size_t SZ_WOUT = (size_t)1024 * 2048 * 2;
constexpr size_t SZ_PW = (size_t)512 * 512 * 2;
constexpr size_t SZ_MODS = (size_t)2 * 5 * 3072 * 4;
constexpr size_t SZ_XC = (size_t)1024 * 1024 * 4;
constexpr size_t SZ_RSTD = (size_t)R_ * 2 * 4;
constexpr size_t SZ_CDEC = (size_t)NCK * 32 * 4 + 256 - ((size_t)NCK * 32 * 4) % 256;
constexpr size_t SZ_R512 = (size_t)R_ * 512 * 2;
constexpr size_t OFF_WIN = 0;
constexpr size_t OFF_WOUT = OFF_WIN + SZ_WIN;
constexpr size_t OFF_PW = OFF_WOUT + SZ_WOUT;
constexpr size_t OFF_MODS = OFF_PW + SZ_PW;
constexpr size_t OFF_XC = OFF_MODS + SZ_MODS;
constexpr size_t OFF_RSTD = OFF_XC + SZ_XC;
constexpr size_t OFF_CDEC = OFF_RSTD + SZ_RSTD;
constexpr size_t OFF_H = OFF_CDEC + SZ_CDEC;
constexpr size_t OFF_XBC = OFF_H + 2 * SZ_R512;
constexpr size_t OFF_GLU = OFF_XBC + 3 * SZ_R512;
constexpr size_t OFF_ST = OFF_XBC;
constexpr size_t OFF_Z = OFF_GLU + SZ_R512;
constexpr size_t OFF_DT = OFF_Z + 2 * SZ_R512;
constexpr size_t OFF_CS = OFF_DT + (size_t)R_ * 32 * 4;
constexpr size_t OFF_Q = OFF_CS + (size_t)R_ * 32 * 4;
constexpr size_t OFF_KV = OFF_Q + SZ_R512;
constexpr size_t OFF_AG = OFF_KV + SZ_R512 / 2;
constexpr size_t OFF_CG = OFF_AG + SZ_R512;
constexpr size_t OFF_BC = OFF_CG + SZ_R512;
constexpr size_t OFF_HDN = OFF_BC + SZ_R512;
constexpr size_t WS_TOTAL = OFF_HDN + SZ_R512;
constexpr size_t OFF_BAR = WS_TOTAL;
static_assert(OFF_BAR + 16384 <= (size_t)256 * 1024 * 1024, "workspace too large");

struct Params {
  const float *x, *c, *ctx, *c_ctx, *w_mod, *b_mod, *norm_w, *w_in, *ssd_conv_w, *ssd_conv_b, *ssd_dt_bias, *ssd_a_log,
      *ssd_d, *ssd_norm_w, *attn_sink, *conv_dw_w, *conv_dw_b, *conv_ln_w, *conv_ln_b, *conv_pw_w, *conv_pw_b, *w_out,
      *final_norm_w;
  float* out;
  char* ws;
};


__shared__ unsigned long long g_kernarg;
DI Params load_params() {
  typedef const char __attribute__((address_space(4)))* kptr_t;
  typedef const float* const __attribute__((address_space(4)))* kfld_t;
  const unsigned long long v = *(volatile unsigned long long*)&g_kernarg;
  const unsigned lo = __builtin_amdgcn_readfirstlane((unsigned)v), hi = __builtin_amdgcn_readfirstlane((unsigned)(v >> 32));
  kptr_t base = (kptr_t)(((unsigned long long)hi << 32) | lo);
  Params p;
  const float** pp = (const float**)&p;
#pragma unroll
  for (int i = 0; i < 25; ++i) pp[i] = *(kfld_t)(base + 8 * i);
  return p;
}

#define XB_TMO      128
#define XB_XCNT(j)  (256  + 64 * (j))
#define XB_XSUB(j)  (1280 + 64 * (j))
#define XB_XGEN(j)  (2304 + 64 * (j))
#define XB_TOP      3328
#define XB_TOPGEN   3392
#define XCD_BAR_WORDS 3456
#define XB_SPIN_CAP (1u << 18)
#define LAS __attribute__((address_space(3)))
DI unsigned xb_ld(unsigned* p)              { return __hip_atomic_load(p, __ATOMIC_RELAXED, __HIP_MEMORY_SCOPE_AGENT); }
DI unsigned xb_add(unsigned* p, unsigned v) { return __hip_atomic_fetch_add(p, v, __ATOMIC_RELAXED, __HIP_MEMORY_SCOPE_AGENT); }
DI unsigned xb_xcc_id() { return (unsigned)__builtin_amdgcn_s_getreg((3 << 11) | 20) & 0xFu; }
#define XB_SPIN(cond, bar) do { unsigned _sp = 0; while (cond) { __builtin_amdgcn_s_sleep(1); \
    if ((++_sp & 255u) == 0u) { if (xb_ld(&(bar)[XB_TMO])) break; if (_sp > XB_SPIN_CAP) { atomicAdd(&(bar)[XB_TMO], 1u); break; } } } } while (0)

DI void xcd_barrier_complete(unsigned* bar, unsigned x, unsigned& nloc, unsigned& nx) {
  const unsigned G = gridDim.x * gridDim.y * gridDim.z;
  unsigned sum, cnt, mine, sp = 0u;
  for (;;) {
    sum = 0u; cnt = 0u; mine = 0u;
#pragma unroll
    for (unsigned j = 0; j < 16; ++j) { const unsigned c = xb_ld(&bar[XB_XCNT(j)]); sum += c; cnt += (c > 0u) ? 1u : 0u; mine = (j == x) ? c : mine; }
    if (sum == G) break;
    __builtin_amdgcn_s_sleep(1);
    if ((++sp & 255u) == 0u) { if (xb_ld(&bar[XB_TMO])) break; if (sp > XB_SPIN_CAP) { atomicAdd(&bar[XB_TMO], 1u); break; } }
  }
  nloc = mine > 0u ? mine : 1u; nx = cnt > 0u ? cnt : 1u;
}

DI void xcd_barrier(volatile LAS unsigned* st) {
  asm volatile("s_waitcnt vmcnt(0)" ::: "memory");
  __syncthreads();
  if (threadIdx.x == 0) {
    const Params pb = load_params();
    unsigned* bar = (unsigned*)(pb.ws + OFF_BAR);
    const unsigned x = xb_xcc_id();
    __builtin_amdgcn_s_waitcnt(0);
    unsigned nloc = st[0], nx = st[1];
    if (nloc == 0u) { xcd_barrier_complete(bar, x, nloc, nx); st[0] = nloc; st[1] = nx; }
    const unsigned old = xb_add(&bar[XB_XSUB(x)], 1u);
    const unsigned gen = old / nloc;
    if (old + 1u == (gen + 1u) * nloc) {
      __builtin_amdgcn_fence(__ATOMIC_RELEASE, "agent");
      asm volatile("s_waitcnt vmcnt(0)" ::: "memory");
      const unsigned og = xb_add(&bar[XB_TOP], 1u);
      const unsigned tg = og / nx;
      if (og + 1u == (tg + 1u) * nx) xb_add(&bar[XB_TOPGEN], 1u);
      else XB_SPIN(xb_ld(&bar[XB_TOPGEN]) == tg, bar);
      __builtin_amdgcn_fence(__ATOMIC_ACQUIRE, "agent");
      xb_add(&bar[XB_XGEN(x)], 1u);
      asm volatile("s_waitcnt vmcnt(0)" ::: "memory");
    } else {
      XB_SPIN(xb_ld(&bar[XB_XGEN(x)]) == gen, bar);
      __builtin_amdgcn_fence(__ATOMIC_ACQUIRE, "agent");
      asm volatile("s_waitcnt vmcnt(0)" ::: "memory");
    }
  }
  __syncthreads();
}

typedef __bf16 nbf16x2_t __attribute__((ext_vector_type(2)));
typedef float nf32x2_t __attribute__((ext_vector_type(2)));
DI unsigned short f2bf(float x) { const __bf16 r = (__bf16)x; return __builtin_bit_cast(unsigned short, r); }
DI float bf2f(unsigned short b) { return __uint_as_float(((unsigned)b) << 16); }
DI unsigned pack2(float a, float b) { const nf32x2_t v = {a, b}; const nbf16x2_t r = __builtin_convertvector(v, nbf16x2_t); return __builtin_bit_cast(unsigned, r); }
DI float lo2f(unsigned u) { return __uint_as_float(u << 16); }
DI float hi2f(unsigned u) { return __uint_as_float(u & 0xffff0000u); }
DI float silu_f(float x) { return x * __builtin_amdgcn_rcpf(1.f + __expf(-x)); }
DI float sigmoid_f(float x) { return __builtin_amdgcn_rcpf(1.f + __expf(-x)); }
DI int crow(int reg, int h) { return (reg & 3) + 8 * (reg >> 2) + 4 * h; }

DI bf16x8 tr_frag(const bf16_t* s, int ld, int row_lo, int row_hi, int col0) {
  const int lane = threadIdx.x & 63;
  const int i16 = lane & 15, q = i16 >> 2, pp = i16 & 3, blk = (lane >> 4) & 1;
  const unsigned a0 = (unsigned)(size_t)(s + (row_lo + q) * ld + col0 + 16 * blk + 4 * pp);
  const unsigned a1 = (unsigned)(size_t)(s + (row_hi + q) * ld + col0 + 16 * blk + 4 * pp);
  s16x4 lo, hi;
  asm volatile("ds_read_b64_tr_b16 %0, %2\n\tds_read_b64_tr_b16 %1, %3\n\ts_waitcnt lgkmcnt(0)"
               : "=&v"(lo), "=&v"(hi) : "v"(a0), "v"(a1) : "memory");
  return __builtin_shufflevector(lo, hi, 0, 1, 2, 3, 4, 5, 6, 7);
}

struct GemmS { bf16_t a[2][128][40]; bf16_t b[2][128][40]; };

template <class AF, class BF>
DI void gemm_core(f32x16 (&acc)[2][2], GemmS* s, AF aptr, BF bptr, int nk) {
  int tid = threadIdx.x; asm volatile("" : "+v"(tid)); const int lane = tid & 63, wave = tid >> 6, wr = wave >> 1, wc = wave & 1;
  const int r0 = tid >> 2, kv = tid & 3;
  const int fr = lane & 31, fh = lane >> 5;
  uint4 ra0 = *(const uint4*)aptr(0, r0, kv), ra1 = *(const uint4*)aptr(0, r0 + 64, kv);
  uint4 rb0 = *(const uint4*)bptr(0, r0, kv), rb1 = *(const uint4*)bptr(0, r0 + 64, kv);
  *(uint4*)&s->a[0][r0][kv * 8] = ra0; *(uint4*)&s->a[0][r0 + 64][kv * 8] = ra1;
  *(uint4*)&s->b[0][r0][kv * 8] = rb0; *(uint4*)&s->b[0][r0 + 64][kv * 8] = rb1;
  __syncthreads();
#pragma unroll 1
  for (int kt = 0; kt < nk; ++kt) {
    const int buf = kt & 1;
    if (kt + 1 < nk) {
      ra0 = *(const uint4*)aptr(kt + 1, r0, kv); ra1 = *(const uint4*)aptr(kt + 1, r0 + 64, kv);
      rb0 = *(const uint4*)bptr(kt + 1, r0, kv); rb1 = *(const uint4*)bptr(kt + 1, r0 + 64, kv);
    }
#pragma unroll
    for (int ks = 0; ks < 2; ++ks) {
      bf16x8 af[2], bq[2];
#pragma unroll
      for (int i = 0; i < 2; ++i) af[i] = *(const bf16x8*)&s->a[buf][wr * 64 + i * 32 + fr][ks * 16 + fh * 8];
#pragma unroll
      for (int j = 0; j < 2; ++j) bq[j] = *(const bf16x8*)&s->b[buf][wc * 64 + j * 32 + fr][ks * 16 + fh * 8];
#pragma unroll
      for (int i = 0; i < 2; ++i)
#pragma unroll
        for (int j = 0; j < 2; ++j) acc[i][j] = MFMA(af[i], bq[j], acc[i][j]);
    }
    if (kt + 1 < nk) {
      *(uint4*)&s->a[buf ^ 1][r0][kv * 8] = ra0; *(uint4*)&s->a[buf ^ 1][r0 + 64][kv * 8] = ra1;
      *(uint4*)&s->b[buf ^ 1][r0][kv * 8] = rb0; *(uint4*)&s->b[buf ^ 1][r0 + 64][kv * 8] = rb1;
    }
    __syncthreads();
  }
}


struct GemmS2 { bf16_t a[128][72]; bf16_t b[128][72]; };
DI void g2_compute(f32x16 (&acc)[2][2], const GemmS2* s, int wr, int wc, int fr, int fh) {
#pragma unroll
  for (int ks = 0; ks < 4; ++ks) {
    bf16x8 af[2], bq[2];
#pragma unroll
    for (int i = 0; i < 2; ++i) af[i] = *(const bf16x8*)&s->a[wr * 64 + i * 32 + fr][ks * 16 + fh * 8];
#pragma unroll
    for (int j = 0; j < 2; ++j) bq[j] = *(const bf16x8*)&s->b[wc * 64 + j * 32 + fr][ks * 16 + fh * 8];
#pragma unroll
    for (int i = 0; i < 2; ++i)
#pragma unroll
      for (int j = 0; j < 2; ++j) acc[i][j] = MFMA(af[i], bq[j], acc[i][j]);
  }
}

template <class AF, class BF, class HK>
DI void gemm_core2(f32x16 (&acc)[2][2], GemmS2* s, AF aptr, BF bptr, int nk, HK hook) {
  int tid = threadIdx.x; asm volatile("" : "+v"(tid));
  const int lane = tid & 63, wave = tid >> 6, wr = wave >> 1, wc = wave & 1;
  const int r0 = tid >> 3, kc = tid & 7;
  const int fr = lane & 31, fh = lane >> 5;
  uint4 p0a0, p0a1, p0a2, p0a3, p0b0, p0b1, p0b2, p0b3, p1a0, p1a1, p1a2, p1a3, p1b0, p1b1, p1b2, p1b3;
#define G2_LOAD(S, KT) { \
    S##a0 = *(const uint4*)aptr((KT), r0, kc);      S##b0 = *(const uint4*)bptr((KT), r0, kc); \
    S##a1 = *(const uint4*)aptr((KT), r0 + 32, kc); S##b1 = *(const uint4*)bptr((KT), r0 + 32, kc); \
    S##a2 = *(const uint4*)aptr((KT), r0 + 64, kc); S##b2 = *(const uint4*)bptr((KT), r0 + 64, kc); \
    S##a3 = *(const uint4*)aptr((KT), r0 + 96, kc); S##b3 = *(const uint4*)bptr((KT), r0 + 96, kc); }
#define G2_STORE(S) { \
    *(uint4*)&s->a[r0][kc * 8] = S##a0;      *(uint4*)&s->b[r0][kc * 8] = S##b0; \
    *(uint4*)&s->a[r0 + 32][kc * 8] = S##a1; *(uint4*)&s->b[r0 + 32][kc * 8] = S##b1; \
    *(uint4*)&s->a[r0 + 64][kc * 8] = S##a2; *(uint4*)&s->b[r0 + 64][kc * 8] = S##b2; \
    *(uint4*)&s->a[r0 + 96][kc * 8] = S##a3; *(uint4*)&s->b[r0 + 96][kc * 8] = S##b3; }
#define G2_COMPUTE() g2_compute(acc, s, wr, wc, fr, fh);
  G2_LOAD(p0, 0)
  G2_LOAD(p1, 1)
  G2_STORE(p0)
  if (nk > 2) G2_LOAD(p0, 2)
  __syncthreads();
#pragma unroll 1
  for (int kt = 0; kt < nk; kt += 2) {
    hook(kt);
    G2_COMPUTE()
    __syncthreads();
    G2_STORE(p1)
    if (kt + 3 < nk) G2_LOAD(p1, kt + 3)
    __syncthreads();
    hook(kt + 1);
    G2_COMPUTE()
    __syncthreads();
    if (kt + 2 < nk) {
      G2_STORE(p0)
      if (kt + 4 < nk) G2_LOAD(p0, kt + 4)
    }
    __syncthreads();
  }
#undef G2_LOAD
#undef G2_STORE
#undef G2_COMPUTE
}


struct GemmS3 { bf16_t a[128][72]; bf16_t b[256][72]; };

template <class AF, class BF, class HK>
DI void gemm_core3(f32x16 (&acc)[2][4], GemmS3* s, AF aptr, BF bptr, int nk, HK hook) {
  int tid = threadIdx.x; asm volatile("" : "+v"(tid));
  const int lane = tid & 63, wave = tid >> 6, wr = wave >> 1, wc = wave & 1;
  const int r0 = tid >> 3, kc = tid & 7;
  const int fr = lane & 31, fh = lane >> 5;
  uint4 a0, a1, a2, a3, b0, b1, b2, b3, b4, b5, b6, b7;
#define G3_LOAD(KT) { \
    a0 = *(const uint4*)aptr((KT), r0, kc);       a1 = *(const uint4*)aptr((KT), r0 + 32, kc); \
    a2 = *(const uint4*)aptr((KT), r0 + 64, kc);  a3 = *(const uint4*)aptr((KT), r0 + 96, kc); \
    b0 = *(const uint4*)bptr((KT), r0, kc);       b1 = *(const uint4*)bptr((KT), r0 + 32, kc); \
    b2 = *(const uint4*)bptr((KT), r0 + 64, kc);  b3 = *(const uint4*)bptr((KT), r0 + 96, kc); \
    b4 = *(const uint4*)bptr((KT), r0 + 128, kc); b5 = *(const uint4*)bptr((KT), r0 + 160, kc); \
    b6 = *(const uint4*)bptr((KT), r0 + 192, kc); b7 = *(const uint4*)bptr((KT), r0 + 224, kc); }
#define G3_STORE() { \
    *(uint4*)&s->a[r0][kc * 8] = a0;       *(uint4*)&s->a[r0 + 32][kc * 8] = a1; \
    *(uint4*)&s->a[r0 + 64][kc * 8] = a2;  *(uint4*)&s->a[r0 + 96][kc * 8] = a3; \
    *(uint4*)&s->b[r0][kc * 8] = b0;       *(uint4*)&s->b[r0 + 32][kc * 8] = b1; \
    *(uint4*)&s->b[r0 + 64][kc * 8] = b2;  *(uint4*)&s->b[r0 + 96][kc * 8] = b3; \
    *(uint4*)&s->b[r0 + 128][kc * 8] = b4; *(uint4*)&s->b[r0 + 160][kc * 8] = b5; \
    *(uint4*)&s->b[r0 + 192][kc * 8] = b6; *(uint4*)&s->b[r0 + 224][kc * 8] = b7; }
  G3_LOAD(0)
  G3_STORE()
  __syncthreads();
#pragma unroll 1
  for (int kt = 0; kt < nk; ++kt) {
    if (kt + 1 < nk) G3_LOAD(kt + 1)
    hook(kt);
#pragma unroll
    for (int ks = 0; ks < 4; ++ks) {
      bf16x8 af[2], bq[4];
#pragma unroll
      for (int i = 0; i < 2; ++i) af[i] = *(const bf16x8*)&s->a[wr * 64 + i * 32 + fr][ks * 16 + fh * 8];
#pragma unroll
      for (int j = 0; j < 4; ++j) bq[j] = *(const bf16x8*)&s->b[wc * 128 + j * 32 + fr][ks * 16 + fh * 8];
#pragma unroll
      for (int i = 0; i < 2; ++i)
#pragma unroll
        for (int j = 0; j < 4; ++j) acc[i][j] = MFMA(af[i], bq[j], acc[i][j]);
    }
    __syncthreads();
    if (kt + 1 < nk) G3_STORE()
    __syncthreads();
  }
#undef G3_LOAD
#undef G3_STORE
}

template <class EPI>
DI void epilogue_lds2(f32x16 (&acc)[2][4], char* smem, int sub, EPI epi) {
  float* T = (float*)smem;
  int tid = threadIdx.x; asm volatile("" : "+v"(tid));
  const int lane = tid & 63, wave = tid >> 6, wr = wave >> 1, wc = wave & 1, fr = lane & 31, fh = lane >> 5;
#pragma unroll
  for (int i = 0; i < 2; ++i) {
    if (wc == sub) {
#pragma unroll
      for (int j = 0; j < 4; ++j)
#pragma unroll
        for (int r = 0; r < 16; ++r) T[(wr * 32 + crow(r, fh)) * 132 + j * 32 + fr] = acc[i][j][r];
    }
    __syncthreads();
#pragma unroll 2
    for (int e = tid; e < 2048; e += 256) {
      const int tr = e >> 5, c4 = (e & 31) * 4;
      const float4 v = *(const float4*)&T[tr * 132 + c4];
      epi((tr >> 5) * 64 + i * 32 + (tr & 31), c4, v);
    }
    __syncthreads();
  }
}

template <class EPI>
DI void epilogue_lds2w(f32x16 (&acc)[2][4], char* smem, int sub, EPI epi) {
  float* T = (float*)smem;
  int tid = threadIdx.x; asm volatile("" : "+v"(tid));
  const int lane = tid & 63, wave = tid >> 6, wr = wave >> 1, wc = wave & 1, fr = lane & 31, fh = lane >> 5;
#pragma unroll
  for (int i = 0; i < 2; ++i) {
    if (wc == sub) {
#pragma unroll
      for (int j = 0; j < 4; ++j)
#pragma unroll
        for (int r = 0; r < 16; ++r) T[(wr * 32 + crow(r, fh)) * 132 + j * 32 + fr] = acc[i][j][r];
    }
    __syncthreads();
#pragma unroll 2
    for (int e = tid; e < 1024; e += 256) {
      const int tr = e >> 4, c8 = (e & 15) * 8;
      const float4 lo = *(const float4*)&T[tr * 132 + c8];
      const float4 hi = *(const float4*)&T[tr * 132 + c8 + 4];
      epi((tr >> 5) * 64 + i * 32 + (tr & 31), c8, lo, hi);
    }
    __syncthreads();
  }
}

DI void epilogue_rope(f32x16 (&acc)[2][4], char* smem, int sub, bf16_t* dst, int ld, int cb, int row0, float sc) {
  float* T = (float*)smem;
  int tid = threadIdx.x; asm volatile("" : "+v"(tid));
  const int lane = tid & 63, wave = tid >> 6, wr = wave >> 1, wc = wave & 1, fr = lane & 31, fh = lane >> 5;
#pragma unroll
  for (int i = 0; i < 2; ++i) {
    if (wc == sub) {
#pragma unroll
      for (int j = 0; j < 4; ++j)
#pragma unroll
        for (int r = 0; r < 16; ++r) T[(wr * 32 + crow(r, fh)) * 132 + j * 32 + fr] = acc[i][j][r];
    }
    __syncthreads();
#pragma unroll 1
    for (int e = tid; e < 1024; e += 256) {
      const int tr = e >> 4, qi = e & 15;
      const int hd = qi >> 3, ax = (qi >> 2) & 1, f0 = (qi & 3) * 4;
      const int col1 = hd * 64 + ax * 32 + f0;
      const float4 v1 = *(const float4*)&T[tr * 132 + col1];
      const float4 v2 = *(const float4*)&T[tr * 132 + col1 + 16];
      const int rho = row0 + (tr >> 5) * 64 + i * 32 + (tr & 31);
      float a1[4] = {v1.x, v1.y, v1.z, v1.w}, a2[4] = {v2.x, v2.y, v2.z, v2.w}, o1[4], o2[4];
      if (rho < RL_) {
        const int t = rho & 4095;
        const float pos = (float)(ax == 0 ? (t >> 6) : (t & 63));
#pragma unroll
        for (int u = 0; u < 4; ++u) {
          const float ang = pos * __builtin_amdgcn_exp2f(-(float)(f0 + u) * 0.8304820237218406f);
          const float cs = __cosf(ang), sn = __sinf(ang);
          o1[u] = (a1[u] * cs - a2[u] * sn) * sc;
          o2[u] = (a2[u] * cs + a1[u] * sn) * sc;
        }
      } else {
#pragma unroll
        for (int u = 0; u < 4; ++u) { o1[u] = a1[u] * sc; o2[u] = a2[u] * sc; }
      }
      uint2 w1, w2;
      w1.x = pack2(o1[0], o1[1]); w1.y = pack2(o1[2], o1[3]);
      w2.x = pack2(o2[0], o2[1]); w2.y = pack2(o2[2], o2[3]);
      bf16_t* dp = dst + (size_t)rho * ld + cb + col1;
      *(uint2*)dp = w1;
      *(uint2*)(dp + 16) = w2;
    }
    __syncthreads();
  }
}

DI bool xcd_tile(int step, int nM, int nN, int& mt, int& nt) {
  const int xcd = blockIdx.x & 7, nloc = gridDim.x >> 3;
  const int j = (blockIdx.x >> 3) + step * nloc;
  const int mloc = nM >> 3;
  if ((gridDim.x & 7) != 0 || j >= mloc * nN) return false;
  const int per = 8 * nN;
  const int gm = j / per, rem = j - gm * per;
  const int hgt = min(8, mloc - gm * 8);
  const int a = rem % hgt;
  nt = rem / hgt;
  mt = (gm * 8 + a) * 8 + xcd;
  return true;
}

DI void zero_acc(f32x16 (&acc)[2][2]) {
#pragma unroll
  for (int i = 0; i < 2; ++i)
#pragma unroll
    for (int j = 0; j < 2; ++j)
#pragma unroll
      for (int r = 0; r < 16; ++r) acc[i][j][r] = 0.f;
}

template <class EPI>
DI void epilogue_lds(f32x16 (&acc)[2][2], char* smem, EPI epi) {
  float* T = (float*)smem;
  int tid = threadIdx.x; asm volatile("" : "+v"(tid)); const int lane = tid & 63, wave = tid >> 6, wr = wave >> 1, wc = wave & 1, fr = lane & 31, fh = lane >> 5;
#pragma unroll
  for (int i = 0; i < 2; ++i) {
#pragma unroll
    for (int j = 0; j < 2; ++j)
#pragma unroll
      for (int r = 0; r < 16; ++r) T[(wr * 32 + crow(r, fh)) * 132 + wc * 64 + j * 32 + fr] = acc[i][j][r];
    __syncthreads();
#pragma unroll 2
    for (int e = tid; e < 2048; e += 256) {
      const int tr = e >> 5, c4 = (e & 31) * 4;
      const float4 v = *(const float4*)&T[tr * 132 + c4];
      epi((tr >> 5) * 64 + i * 32 + (tr & 31), c4, v);
    }
    __syncthreads();
  }
}

template <class EPI>
DI void epilogue_ldsw(f32x16 (&acc)[2][2], char* smem, EPI epi) {
  float* T = (float*)smem;
  int tid = threadIdx.x; asm volatile("" : "+v"(tid));
  const int lane = tid & 63, wave = tid >> 6, wr = wave >> 1, wc = wave & 1, fr = lane & 31, fh = lane >> 5;
#pragma unroll
  for (int i = 0; i < 2; ++i) {
#pragma unroll
    for (int j = 0; j < 2; ++j)
#pragma unroll
      for (int r = 0; r < 16; ++r) T[(wr * 32 + crow(r, fh)) * 132 + wc * 64 + j * 32 + fr] = acc[i][j][r];
    __syncthreads();
#pragma unroll 2
    for (int e = tid; e < 1024; e += 256) {
      const int tr = e >> 4, c8 = (e & 15) * 8;
      const float4 lo = *(const float4*)&T[tr * 132 + c8];
      const float4 hi = *(const float4*)&T[tr * 132 + c8 + 4];
      epi((tr >> 5) * 64 + i * 32 + (tr & 31), c8, lo, hi);
    }
    __syncthreads();
  }
}

DI void phase_mods(const Params& p_in, char* smem) {
  const Params p = load_params();

  float* ssc = (float*)smem;
  float* red = (float*)(smem + 20480);
  float* mods = (float*)(p.ws + OFF_MODS);
  int tid = threadIdx.x; asm volatile("" : "+v"(tid));
  for (int it = blockIdx.x; it < 192; it += gridDim.x) {
    const int l = it / 96, col0 = (it % 96) * 32;
    __syncthreads();
    for (int e = tid; e < 5120; e += 256) {
      const int v = e >> 10, k = e & 1023;
      const float cv = (v < 4) ? p.c[v * 1024 + k] : p.c_ctx[k];
      ssc[e] = silu_f(cv);
    }
    __syncthreads();
    const int col = tid & 31, kg = tid >> 5;
    float a[5] = {0.f, 0.f, 0.f, 0.f, 0.f};
    const float* w = p.w_mod + (size_t)l * 1024 * 3072 + col0 + col;
    for (int k = kg * 128; k < kg * 128 + 128; k += 32) {
      float wv[32];
#pragma unroll
      for (int u = 0; u < 32; ++u) wv[u] = w[(size_t)(k + u) * 3072];
#pragma unroll
      for (int u = 0; u < 32; ++u)
#pragma unroll
        for (int v = 0; v < 5; ++v) a[v] += ssc[v * 1024 + k + u] * wv[u];
    }
#pragma unroll
    for (int v = 0; v < 5; ++v) red[(kg * 5 + v) * 32 + col] = a[v];
    __syncthreads();
    for (int e = tid; e < 160; e += 256) {
      const int v = e >> 5, cc = e & 31;
      float sum = p.b_mod[l * 3072 + col0 + cc];
      for (int g = 0; g < 8; ++g) sum += red[(g * 5 + v) * 32 + cc];
      mods[(l * 5 + v) * 3072 + col0 + cc] = sum;
    }
  }
}

DI int win_colmap(int n) {
  if (n < 2560) return n;
  if (n < 3840) return n + 32;
  if (n < 4864) {
    const int j = n - 3840, q64 = j >> 6, w = j & 63;
    return (w < 32) ? (3872 + q64 * 32 + w) : (3872 + 512 + q64 * 32 + (w - 32));
  }
  if (n < 5376) return n + 32;
  if (n < 5408) return n - 5376 + 2560;
  return -1;
}

DI void transpose_tile(const float* src, int ldsrc, int kind, const float* rowscale, bf16_t* dst, int lddst, int n0, int k0, float* tile) {
  int tid = threadIdx.x; asm volatile("" : "+v"(tid));
  __syncthreads();
  {
    const int c4 = (tid & 15) * 4, rr = tid >> 4;
    const int n = (kind == 0) ? win_colmap(n0 + c4) : (n0 + c4);
#pragma unroll
    for (int ps = 0; ps < 4; ++ps) {
      const int r = rr + ps * 16, k = k0 + r;
      float4 v = make_float4(0.f, 0.f, 0.f, 0.f);
      if (n >= 0) v = *(const float4*)(src + (size_t)k * ldsrc + n);
      if (rowscale != nullptr && k < 1024) { const float s = rowscale[k]; v.x *= s; v.y *= s; v.z *= s; v.w *= s; }
      tile[r * 65 + c4] = v.x; tile[r * 65 + c4 + 1] = v.y; tile[r * 65 + c4 + 2] = v.z; tile[r * 65 + c4 + 3] = v.w;
    }
  }
  __syncthreads();
  {
    const int k8 = (tid & 7) * 8, nn = tid >> 3;
#pragma unroll
    for (int ps = 0; ps < 2; ++ps) {
      const int r = nn + ps * 32;
      uint4 o;
      o.x = pack2(tile[(k8 + 0) * 65 + r], tile[(k8 + 1) * 65 + r]);
      o.y = pack2(tile[(k8 + 2) * 65 + r], tile[(k8 + 3) * 65 + r]);
      o.z = pack2(tile[(k8 + 4) * 65 + r], tile[(k8 + 5) * 65 + r]);
      o.w = pack2(tile[(k8 + 6) * 65 + r], tile[(k8 + 7) * 65 + r]);
      *(uint4*)(dst + (size_t)(n0 + r) * lddst + k0 + k8) = o;
    }
  }
}

DI void phase_prep(const Params& p_in, int l, char* smem) {
  const Params p = load_params();

  int tid = threadIdx.x; asm volatile("" : "+v"(tid)); const int lane = tid & 63, wave = tid >> 6;
  const float* mods = (const float*)(p.ws + OFF_MODS);
  bf16_t* H = (bf16_t*)(p.ws + OFF_H);
  const int NT_WIN = 88 * 16, NT_WOUT = 16 * 32, NT_PW = 64, NT_CONV = NT_WIN + NT_WOUT + NT_PW;
  const int NT = NT_CONV + R_ / 8;
  for (int it = blockIdx.x; it < NT; it += gridDim.x) {
    if (l == 1 && (it < NT_WIN || (it >= NT_WIN + NT_WOUT && it < NT_CONV))) continue;
    if (it < NT_WIN) {
      transpose_tile(p.w_in + (size_t)l * 1024 * 5408, 5408, 0, nullptr, (bf16_t*)(p.ws + OFF_WIN), 1024, (it / 16) * 64, (it % 16) * 64, (float*)smem);
    } else if (it < NT_WIN + NT_WOUT) {
      const int t = it - NT_WIN;
      transpose_tile(p.w_out + (size_t)l * 2048 * 1024, 1024, 1, p.ssd_norm_w + l * 1024, (bf16_t*)(p.ws + OFF_WOUT), 2048, (t / 32) * 64, (t % 32) * 64, (float*)smem);
    } else if (it < NT_CONV) {
      const int t = it - NT_WIN - NT_WOUT;
      transpose_tile(p.conv_pw_w + (size_t)l * 512 * 512, 512, 1, nullptr, (bf16_t*)(p.ws + OFF_PW), 512, (t / 8) * 64, (t % 8) * 64, (float*)smem);
    } else {
      const int rho0 = (it - NT_CONV) * 8 + wave * 2;
      const float* xs0;
      if (l == 0) xs0 = (rho0 < RL_) ? (p.x + (size_t)rho0 * 1024) : (p.ctx + (size_t)(rho0 - RL_) * 1024);
      else xs0 = (rho0 < RL_) ? (p.out + (size_t)rho0 * 1024) : ((const float*)(p.ws + OFF_XC) + (size_t)(rho0 - RL_) * 1024);
      const int v = (rho0 < RL_) ? (rho0 >> 12) : 4;
      const float* md = mods + (l * 5 + v) * 3072;
      float4 xv[2][4], nwv[4], shv[4], scv4[4];
#pragma unroll
      for (int i = 0; i < 4; ++i) {
        const int cidx = lane * 4 + i * 256;
        xv[0][i] = *(const float4*)(xs0 + cidx);
        xv[1][i] = *(const float4*)(xs0 + 1024 + cidx);
        nwv[i] = *(const float4*)(p.norm_w + l * 1024 + cidx);
        shv[i] = *(const float4*)(md + cidx);
        scv4[i] = *(const float4*)(md + 1024 + cidx);
      }
#pragma unroll
      for (int q = 0; q < 2; ++q) {
        float ss = 0.f;
#pragma unroll
        for (int i = 0; i < 4; ++i) ss += xv[q][i].x * xv[q][i].x + xv[q][i].y * xv[q][i].y + xv[q][i].z * xv[q][i].z + xv[q][i].w * xv[q][i].w;
#pragma unroll
        for (int o = 32; o >= 1; o >>= 1) ss += __shfl_xor(ss, o);
        const float rs = rsqrtf(ss * (1.f / 1024.f) + 1e-6f);
#pragma unroll
        for (int i = 0; i < 4; ++i) {
          const int cidx = lane * 4 + i * 256;
          const float4 nw = nwv[i], sh = shv[i], sc = scv4[i];
          uint2 o;
          o.x = pack2(xv[q][i].x * rs * nw.x * (1.f + sc.x) + sh.x, xv[q][i].y * rs * nw.y * (1.f + sc.y) + sh.y);
          o.y = pack2(xv[q][i].z * rs * nw.z * (1.f + sc.z) + sh.z, xv[q][i].w * rs * nw.w * (1.f + sc.w) + sh.w);
          *(uint2*)(H + (size_t)(rho0 + q) * 1024 + cidx) = o;
        }
      }
    }
  }
}

DI void phase_inproj(const Params& p_in, char* smem) {
  const Params p = load_params();
  int tid = threadIdx.x; asm volatile("" : "+v"(tid)); const int wave = tid >> 6, wc = wave & 1;
  const bf16_t* H = (const bf16_t*)(p.ws + OFF_H);
  const bf16_t* W = (const bf16_t*)(p.ws + OFF_WIN);
  for (int step = 0;; ++step) {
    int mt, nt2;
    if (!xcd_tile(step, NCK, 22, mt, nt2)) break;
    f32x16 acc[2][4];
#pragma unroll
    for (int i = 0; i < 2; ++i)
#pragma unroll
      for (int j = 0; j < 4; ++j)
#pragma unroll
        for (int r = 0; r < 16; ++r) acc[i][j][r] = 0.f;
    const bf16_t* Ab = H + (size_t)mt * 128 * 1024;
    const bf16_t* Bb = W + (size_t)nt2 * 256 * 1024;
    gemm_core3(acc, (GemmS3*)smem,
               [&](int kt, int r, int kv) { return Ab + (size_t)r * 1024 + kt * 64 + kv * 8; },
               [&](int kt, int r, int kv) { return Bb + (size_t)r * 1024 + kt * 64 + kv * 8; }, 16, [](int) {});
    const int row0 = mt * 128;
    {
      const int ntw = nt2 * 2 + wc;
      if (ntw >= 30 && ntw < 38) {
#pragma unroll
        for (int i = 0; i < 2; ++i)
#pragma unroll
          for (int r = 0; r < 16; ++r) {
            acc[i][0][r] = acc[i][0][r] * sigmoid_f(acc[i][1][r]);
            acc[i][2][r] = acc[i][2][r] * sigmoid_f(acc[i][3][r]);
          }
      }
    }
#pragma unroll 1
    for (int sub = 0; sub < 2; ++sub) {
      const int nt = nt2 * 2 + sub;
      if (nt >= 43) break;
      if (nt >= 30 && nt < 38) {
        bf16_t* G = (bf16_t*)(p.ws + OFF_GLU);
        const int cb0 = (nt - 30) * 64;
        epilogue_lds2w(acc, smem, sub, [&](int rl, int c8, float4 lo, float4 hi) {
          if ((c8 & 32) == 0) {
            uint4 o; o.x = pack2(lo.x, lo.y); o.y = pack2(lo.z, lo.w); o.z = pack2(hi.x, hi.y); o.w = pack2(hi.z, hi.w);
            *(uint4*)(G + (size_t)(row0 + rl) * 512 + cb0 + (c8 >> 6) * 32 + (c8 & 31)) = o;
          }
        });
      } else if (nt >= 20 && nt < 24) {
        epilogue_rope(acc, smem, sub, (bf16_t*)(p.ws + OFF_Q), 512, nt * 128 - 2560, row0, 0.18033688011112042f);
      } else if (nt == 24) {
        epilogue_rope(acc, smem, sub, (bf16_t*)(p.ws + OFF_KV), 256, 0, row0, 1.f);
      } else if (nt == 42) {
        float* DT = (float*)(p.ws + OFF_DT);
        epilogue_lds2(acc, smem, sub, [&](int rl, int c4, float4 v) {
          if (c4 < 32) *(float4*)(DT + (size_t)(row0 + rl) * 32 + c4) = v;
        });
      } else {
        bf16_t* dst; int ld, cb;
        if (nt < 12) { dst = (bf16_t*)(p.ws + OFF_XBC); ld = 1536; cb = nt * 128; }
        else if (nt < 20) { dst = (bf16_t*)(p.ws + OFF_Z); ld = 1024; cb = nt * 128 - 1536; }
        else if (nt < 24) { dst = (bf16_t*)(p.ws + OFF_Q); ld = 512; cb = nt * 128 - 2560; }
        else if (nt < 26) { dst = (bf16_t*)(p.ws + OFF_KV); ld = 256; cb = nt * 128 - 3072; }
        else if (nt < 30) { dst = (bf16_t*)(p.ws + OFF_AG); ld = 512; cb = nt * 128 - 3328; }
        else { dst = (bf16_t*)(p.ws + OFF_CG); ld = 512; cb = nt * 128 - 4864; }
        epilogue_lds2w(acc, smem, sub, [&](int rl, int c8, float4 lo, float4 hi) {
          uint4 o; o.x = pack2(lo.x, lo.y); o.y = pack2(lo.z, lo.w); o.z = pack2(hi.x, hi.y); o.w = pack2(hi.z, hi.w);
          *(uint4*)(dst + (size_t)(row0 + rl) * ld + cb + c8) = o;
        });
      }
    }
  }
}

DI void phase_local(const Params& p_in, int l, char* smem) {
  const Params p = load_params();

  int tid = threadIdx.x; asm volatile("" : "+v"(tid)); const int lane = tid & 63;
  const bf16_t* XBC = (const bf16_t*)(p.ws + OFF_XBC);
  bf16_t* XS = (bf16_t*)(p.ws + OFF_H);
  bf16_t* BC = (bf16_t*)(p.ws + OFF_BC);
  float* DT = (float*)(p.ws + OFF_DT);
  float* CS = (float*)(p.ws + OFF_CS);
  const bf16_t* GLU = (const bf16_t*)(p.ws + OFF_GLU);
  bf16_t* HDN = (bf16_t*)(p.ws + OFF_HDN);
  bf16_t* Q = (bf16_t*)(p.ws + OFF_Q);
  bf16_t* KV = (bf16_t*)(p.ws + OFF_KV);
  { float* SSQ = (float*)(p.ws + OFF_RSTD); for (int i = blockIdx.x * 256 + tid; i < R_ * 2; i += gridDim.x * 256) SSQ[i] = 0.f; }
  const int N_CONV = (R_ / 4) * 192 / 256;
  const int N_DT = NCK;
  const int N_CF = R_ / 16;
  const int N_ROPE = 0;
  const int N_QC = 0;
  const int NT = N_CF + N_DT + N_CONV + N_ROPE + N_QC;
  for (int it0 = blockIdx.x; it0 < NT; it0 += gridDim.x) {
    int it = it0;
    if (it < N_CF) {
      float* sst = (float*)smem;
      unsigned* sIn = (unsigned*)(smem + 256);
      const int row0 = it * 16;
      const int seq0 = (row0 < RL_) ? (row0 & ~4095) : (RL_ + ((row0 - RL_) & ~255));
      const int slen = (row0 < RL_) ? 4096 : 256;
      const int t0 = row0 - seq0;
      const int c0 = tid * 2;
      __syncthreads();
      if (tid < 32) sst[tid] = 0.f;
      for (int idx = tid; idx < 46 * 64; idx += 256) {
        const int rr = idx >> 6, c16 = idx & 63;
        const int tt = t0 - 15 + rr;
        uint4 val = make_uint4(0u, 0u, 0u, 0u);
        if (tt >= 0 && tt < slen) val = *(const uint4*)(GLU + (size_t)(seq0 + tt) * 512 + c16 * 8);
        *(uint4*)&sIn[rr * 256 + c16 * 4] = val;
      }
      float w0[31], w1[31];
#pragma unroll
      for (int k = 0; k < 31; ++k) {
        const float2 wv = *(const float2*)(p.conv_dw_w + ((size_t)l * 31 + k) * 512 + c0);
        w0[k] = wv.x; w1[k] = wv.y;
      }
      const float2 bv = *(const float2*)(p.conv_dw_b + l * 512 + c0);
      float a0[16], a1[16];
#pragma unroll
      for (int r = 0; r < 16; ++r) { a0[r] = bv.x; a1[r] = bv.y; }
      __syncthreads();
#pragma unroll
      for (int tp = 0; tp < 46; ++tp) {
        const unsigned u = sIn[tp * 256 + tid];
        const float x0 = lo2f(u), x1 = hi2f(u);
#pragma unroll
        for (int r = 0; r < 16; ++r) {
          const int k = tp - r;
          if (k >= 0 && k < 31) { a0[r] += w0[k] * x0; a1[r] += w1[k] * x1; }
        }
        if ((tp & 7) == 7) __builtin_amdgcn_sched_barrier(0);
      }
      {
        float v[32];
#pragma unroll
        for (int r = 0; r < 16; ++r) { v[2 * r] = a0[r] + a1[r]; v[2 * r + 1] = a0[r] * a0[r] + a1[r] * a1[r]; }
#pragma unroll
        for (int i = 0; i < 16; ++i) { const bool up = (lane & 32) != 0; const float keep = up ? v[i + 16] : v[i]; const float send = up ? v[i] : v[i + 16]; v[i] = keep + __shfl_xor(send, 32); }
#pragma unroll
        for (int i = 0; i < 8; ++i) { const bool up = (lane & 16) != 0; const float keep = up ? v[i + 8] : v[i]; const float send = up ? v[i] : v[i + 8]; v[i] = keep + __shfl_xor(send, 16); }
#pragma unroll
        for (int i = 0; i < 4; ++i) { const bool up = (lane & 8) != 0; const float keep = up ? v[i + 4] : v[i]; const float send = up ? v[i] : v[i + 4]; v[i] = keep + __shfl_xor(send, 8); }
#pragma unroll
        for (int i = 0; i < 2; ++i) { const bool up = (lane & 4) != 0; const float keep = up ? v[i + 2] : v[i]; const float send = up ? v[i] : v[i + 2]; v[i] = keep + __shfl_xor(send, 4); }
        { const bool up = (lane & 2) != 0; const float keep = up ? v[1] : v[0]; const float send = up ? v[0] : v[1]; v[0] = keep + __shfl_xor(send, 2); }
        v[0] += __shfl_xor(v[0], 1);
        __syncthreads();
        if ((lane & 1) == 0) atomicAdd(&sst[lane >> 1], v[0]);
      }
      __syncthreads();
      const float2 lw = *(const float2*)(p.conv_ln_w + l * 512 + c0);
      const float2 lb = *(const float2*)(p.conv_ln_b + l * 512 + c0);
#pragma unroll
      for (int r = 0; r < 16; ++r) {
        const float mean = sst[r * 2] * (1.f / 512.f);
        const float var = fmaxf(sst[r * 2 + 1] * (1.f / 512.f) - mean * mean, 0.f);
        const float rs = rsqrtf(var + 1e-6f);
        const float y0 = (a0[r] - mean) * rs * lw.x + lb.x;
        const float y1 = (a1[r] - mean) * rs * lw.y + lb.y;
        *(unsigned*)(HDN + (size_t)(row0 + r) * 512 + c0) = pack2(silu_f(y0), silu_f(y1));
        if ((r & 3) == 3) __builtin_amdgcn_sched_barrier(0);
      }
      continue;
    }
    it -= N_CF;
    if (it < N_DT) {
      float* sdt = (float*)smem;
      float* ssum = (float*)(smem + 128 * 33 * 4);
      const int row0 = it * 128;
      __syncthreads();
      for (int e = tid; e < 4096; e += 256) {
        const int r = e >> 5, cidx = e & 31;
        const float raw = DT[(size_t)(row0 + r) * 32 + cidx] + p.ssd_dt_bias[l * 32 + cidx];
        const float sp = (raw > 20.f) ? raw : __logf(1.f + __expf(raw));
        DT[(size_t)(row0 + r) * 32 + cidx] = sp;
        sdt[r * 33 + cidx] = sp;
      }
      __syncthreads();
      const int col = tid & 31, seg = tid >> 5;
      const float a = -expf(p.ssd_a_log[l * 32 + col]);
      float loc[16];
      float run = 0.f;
      if (col < 16) {
#pragma unroll
        for (int r = 0; r < 16; ++r) { run += sdt[(seg * 16 + r) * 33 + col] * a; loc[r] = run; }
      } else {
#pragma unroll
        for (int r = 15; r >= 0; --r) { run += sdt[(seg * 16 + r) * 33 + col] * a; loc[r] = run; }
      }
      ssum[seg * 32 + col] = run;
      __syncthreads();
      float off = 0.f;
      if (col < 16) { for (int s2 = 0; s2 < seg; ++s2) off += ssum[s2 * 32 + col]; }
      else { for (int s2 = 7; s2 > seg; --s2) off += ssum[s2 * 32 + col]; }
#pragma unroll
      for (int r = 0; r < 16; ++r) CS[(size_t)(row0 + seg * 16 + r) * 32 + col] = off + loc[r];
      continue;
    }
    it -= N_DT;
    if (it < N_CONV) {
      const int e = it * 256 + tid;
      const int rb = e / 192, cgp = e % 192, ch0 = cgp * 8;
      const int rho0 = rb * 4;
      const int seq0 = (rho0 < RL_) ? (rho0 & ~4095) : (RL_ + ((rho0 - RL_) & ~255));
      const int slen = (rho0 < RL_) ? 4096 : 256;
      const int t0 = rho0 - seq0;
      uint4 xr[8];
#pragma unroll
      for (int i = 0; i < 8; ++i) {
        const int tt = t0 + i - 2;
        xr[i] = make_uint4(0u, 0u, 0u, 0u);
        if (tt >= 0 && tt < slen) xr[i] = *(const uint4*)(XBC + (size_t)(seq0 + tt) * 1536 + ch0);
      }
      float wk[5][8];
#pragma unroll
      for (int k = 0; k < 5; ++k) {
        const float4 w0 = *(const float4*)(p.ssd_conv_w + ((size_t)l * 5 + k) * 1536 + ch0);
        const float4 w1 = *(const float4*)(p.ssd_conv_w + ((size_t)l * 5 + k) * 1536 + ch0 + 4);
        wk[k][0] = w0.x; wk[k][1] = w0.y; wk[k][2] = w0.z; wk[k][3] = w0.w; wk[k][4] = w1.x; wk[k][5] = w1.y; wk[k][6] = w1.z; wk[k][7] = w1.w;
      }
      float bias[8];
      {
        const float4 b0 = *(const float4*)(p.ssd_conv_b + l * 1536 + ch0);
        const float4 b1 = *(const float4*)(p.ssd_conv_b + l * 1536 + ch0 + 4);
        bias[0] = b0.x; bias[1] = b0.y; bias[2] = b0.z; bias[3] = b0.w; bias[4] = b1.x; bias[5] = b1.y; bias[6] = b1.z; bias[7] = b1.w;
      }
#pragma unroll
      for (int r = 0; r < 4; ++r) {
        float a[8];
#pragma unroll
        for (int c = 0; c < 8; ++c) a[c] = bias[c];
#pragma unroll
        for (int k = 0; k < 5; ++k) {
          const uint4 u = xr[r + k];
          a[0] += wk[k][0] * lo2f(u.x); a[1] += wk[k][1] * hi2f(u.x); a[2] += wk[k][2] * lo2f(u.y); a[3] += wk[k][3] * hi2f(u.y);
          a[4] += wk[k][4] * lo2f(u.z); a[5] += wk[k][5] * hi2f(u.z); a[6] += wk[k][6] * lo2f(u.w); a[7] += wk[k][7] * hi2f(u.w);
        }
        uint4 o;
        o.x = pack2(silu_f(a[0]), silu_f(a[1])); o.y = pack2(silu_f(a[2]), silu_f(a[3]));
        o.z = pack2(silu_f(a[4]), silu_f(a[5])); o.w = pack2(silu_f(a[6]), silu_f(a[7]));
        const size_t rho = (size_t)(rho0 + r);
        if (ch0 < 1024) *(uint4*)(XS + rho * 1024 + ch0) = o;
        else *(uint4*)(BC + rho * 512 + (ch0 - 1024)) = o;
      }
      continue;
    }
    it -= N_CONV;
    if (it < N_ROPE) {
      const int e = it * 256 + tid;
      const int rho = e / 40, rem = e % 40, hd = rem >> 2, sub = rem & 3;
      const int axis = sub >> 1, half = sub & 1;
      const int t = rho & 4095;
      const float pos = (float)(axis == 0 ? (t >> 6) : (t & 63));
      bf16_t* base = ((hd < 8) ? (Q + (size_t)rho * 512 + hd * 64) : (KV + (size_t)rho * 256 + (hd - 8) * 64)) + axis * 32 + half * 8;
      const float sc = (hd < 8) ? 0.18033688011112042f : 1.f;
      const uint4 u1 = *(const uint4*)base, u2 = *(const uint4*)(base + 16);
      const unsigned a1[4] = {u1.x, u1.y, u1.z, u1.w}, a2[4] = {u2.x, u2.y, u2.z, u2.w};
      unsigned o1[4], o2[4];
#pragma unroll
      for (int i = 0; i < 4; ++i) {
        float r1[2], r2[2];
#pragma unroll
        for (int hl = 0; hl < 2; ++hl) {
          const float f = (float)(half * 8 + 2 * i + hl);
          const float ang = pos * exp2f(-f * 0.8304820237218406f);
          const float cs = __cosf(ang), sn = __sinf(ang);
          const float t1 = hl ? hi2f(a1[i]) : lo2f(a1[i]);
          const float t2 = hl ? hi2f(a2[i]) : lo2f(a2[i]);
          r1[hl] = (t1 * cs - t2 * sn) * sc;
          r2[hl] = (t2 * cs + t1 * sn) * sc;
        }
        o1[i] = pack2(r1[0], r1[1]); o2[i] = pack2(r2[0], r2[1]);
      }
      *(uint4*)base = make_uint4(o1[0], o1[1], o1[2], o1[3]);
      *(uint4*)(base + 16) = make_uint4(o2[0], o2[1], o2[2], o2[3]);
      continue;
    }
    it -= N_ROPE;
    {
      const int e = it * 256 + tid;
      const int rho = RL_ + e / 256, c2 = (e % 256) * 2;
      unsigned* ptr = (unsigned*)(Q + (size_t)rho * 512 + c2);
      const unsigned u = *ptr;
      *ptr = pack2(lo2f(u) * 0.18033688011112042f, hi2f(u) * 0.18033688011112042f);
    }
  }
}

DI void attn_item(const Params& p_in, int l, char* smem, int b, int qblk, int g, int hp, bool ctxq) {
  const Params p = load_params();

  bf16_t* sK = (bf16_t*)smem;
  bf16_t* sV = (bf16_t*)(smem + 128 * 72 * 2);
  int tid = threadIdx.x; asm volatile("" : "+v"(tid)); const int lane = tid & 63, wave = tid >> 6, fr = lane & 31, fh = lane >> 5;
  const int head = g * 4 + hp * 2 + (wave >> 1);
  const int qh = wave & 1;
  const int qrow0 = (ctxq ? (RL_ + b * 256) : (b * 4096)) + qblk * 128 + qh * 64;
  const int qpos0 = qblk * 128 + qh * 64;
  bf16_t* Q = (bf16_t*)(p.ws + OFF_Q);
  const bf16_t* KV = (const bf16_t*)(p.ws + OFF_KV);
  const bf16_t* AG = (const bf16_t*)(p.ws + OFF_AG);
  f32x16 o[2][2];
  zero_acc(o);
  float m[2], lsum[2];
  m[0] = m[1] = p.attn_sink[l * 8 + head] * 1.4426950408889634f;
  lsum[0] = lsum[1] = 1.f;
  const int nhb = ctxq ? 4 : 10;
  auto hb_row = [&](int hb) -> int {
    if (hb >= nhb) return -1;
    if (hb < 4) return RL_ + b * 256 + hb * 64;
    const int kp = (qblk - 1) * 128 + (hb - 4) * 64;
    if (kp < 0 || kp >= 4096) return -1;
    return b * 4096 + kp;
  };
  auto hb_next = [&](int hb) -> int { int n = hb + 1; while (n < nhb && hb_row(n) < 0) ++n; return n; };
  const int sr = tid >> 3, scv = tid & 7;
  uint4 kp0, kp1, vp0, vp1;
#define ATT_PREFETCH(ROW0) { const bf16_t* kvp = KV + (size_t)((ROW0) + sr) * 256 + g * 64 + scv * 8; \
    kp0 = *(const uint4*)(kvp); kp1 = *(const uint4*)(kvp + 32 * 256); vp0 = *(const uint4*)(kvp + 128); vp1 = *(const uint4*)(kvp + 128 + 32 * 256); }
#define ATT_STORE(BUF) { bf16_t* k_ = sK + (BUF) * 64 * 72; bf16_t* v_ = sV + (BUF) * 64 * 72; \
    *(uint4*)&k_[sr * 72 + scv * 8] = kp0; *(uint4*)&k_[(sr + 32) * 72 + scv * 8] = kp1; \
    *(uint4*)&v_[sr * 72 + scv * 8] = vp0; *(uint4*)&v_[(sr + 32) * 72 + scv * 8] = vp1; }
  int pbuf = 0;
  __syncthreads();
  ATT_PREFETCH(hb_row(0))
  ATT_STORE(0)
  __syncthreads();
  for (int hb = 0; hb < nhb; hb = hb_next(hb)) {
    const int nxt = hb_next(hb);
    if (nxt < nhb) ATT_PREFETCH(hb_row(nxt))
    int kpos0 = 0;
    bool masked = false;
    if (hb >= 4) { kpos0 = (qblk - 1) * 128 + (hb - 4) * 64; masked = (hb != 6 && hb != 7); }
    const bf16_t* cK = sK + pbuf * 64 * 72;
    const bf16_t* cV = sV + pbuf * 64 * 72;
    bf16x8 qf[2][4];
#pragma unroll
    for (int j = 0; j < 2; ++j)
#pragma unroll
      for (int ks = 0; ks < 4; ++ks)
        qf[j][ks] = *(const bf16x8*)(Q + (size_t)(qrow0 + j * 32 + fr) * 512 + head * 64 + ks * 16 + fh * 8);
#pragma unroll 1
    for (int kb = 0; kb < 2; ++kb) {
      if (masked) {
        const int klo = kpos0 + kb * 32, khi = klo + 31;
        if (klo - (qpos0 + 63) > 128 || qpos0 - khi > 128) continue;
      }
      bf16x8 pb[2][2];
#pragma unroll
      for (int j = 0; j < 2; ++j) {
        f32x16 st[2];
#pragma unroll
        for (int r = 0; r < 16; ++r) st[j][r] = -m[j];
#pragma unroll
        for (int ks = 0; ks < 4; ++ks) {
          const bf16x8 kf = *(const bf16x8*)&cK[(kb * 32 + fr) * 72 + ks * 16 + fh * 8];
          st[j] = MFMA(kf, qf[j][ks], st[j]);
        }
        if (masked) {
          const int qpos = qpos0 + j * 32 + fr;
#pragma unroll
          for (int r = 0; r < 16; ++r) {
            const int d = qpos - (kpos0 + kb * 32 + crow(r, fh));
            if (d > 128 || d < -128) st[j][r] = -1e30f;
          }
        }
        float mx = st[j][0];
#pragma unroll
        for (int r = 1; r < 16; ++r) mx = fmaxf(mx, st[j][r]);
        mx = fmaxf(mx, __shfl_xor(mx, 32));
        const bool grow = mx > 8.f;
        if (__builtin_amdgcn_ballot_w64(grow) != 0ull) {
          const float delta = grow ? mx : 0.f;
          const float alpha = __builtin_amdgcn_exp2f(-delta);
#pragma unroll
          for (int r = 0; r < 16; ++r) st[j][r] -= delta;
          lsum[j] *= alpha;
          m[j] += delta;
#pragma unroll
          for (int mt = 0; mt < 2; ++mt)
#pragma unroll
            for (int r = 0; r < 16; ++r) o[mt][j][r] *= alpha;
        }
        float rs = 0.f;
#pragma unroll
        for (int r = 0; r < 16; ++r) { const float pv = __builtin_amdgcn_exp2f(st[j][r]); st[j][r] = pv; rs += pv; }
        rs += __shfl_xor(rs, 32);
        lsum[j] += rs;
#pragma unroll
        for (int s = 0; s < 2; ++s) {
          uint4 pk;
          pk.x = pack2(st[j][8 * s + 0], st[j][8 * s + 1]); pk.y = pack2(st[j][8 * s + 2], st[j][8 * s + 3]);
          pk.z = pack2(st[j][8 * s + 4], st[j][8 * s + 5]); pk.w = pack2(st[j][8 * s + 6], st[j][8 * s + 7]);
          pb[j][s] = __builtin_bit_cast(bf16x8, pk);
        }
      }
#pragma unroll
      for (int s = 0; s < 2; ++s)
#pragma unroll
        for (int mt = 0; mt < 2; ++mt) {
          const bf16x8 vf = tr_frag(cV, 72, kb * 32 + 16 * s + 4 * fh, kb * 32 + 16 * s + 8 + 4 * fh, mt * 32);
#pragma unroll
          for (int j = 0; j < 2; ++j) o[mt][j] = MFMA(vf, pb[j][s], o[mt][j]);
        }
    }
    if (nxt < nhb) ATT_STORE(pbuf ^ 1)
    pbuf ^= 1;
    __syncthreads();
  }
#undef ATT_PREFETCH
#undef ATT_STORE
#pragma unroll
  for (int j = 0; j < 2; ++j) {
    const float inv = 1.f / lsum[j];
    const size_t rho = (size_t)(qrow0 + j * 32 + fr);
#pragma unroll
    for (int mt = 0; mt < 2; ++mt)
#pragma unroll
      for (int g4 = 0; g4 < 4; ++g4) {
        const int d0 = mt * 32 + 8 * g4 + 4 * fh;
        const uint2 gv = *(const uint2*)(AG + rho * 512 + head * 64 + d0);
        uint2 ov;
        ov.x = pack2(o[mt][j][g4 * 4 + 0] * inv * silu_f(lo2f(gv.x)), o[mt][j][g4 * 4 + 1] * inv * silu_f(hi2f(gv.x)));
        ov.y = pack2(o[mt][j][g4 * 4 + 2] * inv * silu_f(lo2f(gv.y)), o[mt][j][g4 * 4 + 3] * inv * silu_f(hi2f(gv.y)));
        *(uint2*)(Q + rho * 512 + head * 64 + d0) = ov;
      }
  }
}

DI void states_item(const Params& p_in, char* smem, int ck, int g, int hq) {
  const Params p = load_params();

  bf16_t* sB = (bf16_t*)smem;
  bf16_t* sX = (bf16_t*)(smem + 128 * 136 * 2);
  int tid = threadIdx.x; asm volatile("" : "+v"(tid)); const int lane = tid & 63, wave = tid >> 6, wr = wave >> 1, wc = wave & 1, fr = lane & 31, fh = lane >> 5;
  const bf16_t* BC = (const bf16_t*)(p.ws + OFF_BC);
  const bf16_t* XS = (const bf16_t*)(p.ws + OFF_H);
  const float* DT = (const float*)(p.ws + OFF_DT);
  const float* CS = (const float*)(p.ws + OFF_CS);
  bf16_t* ST = (bf16_t*)(p.ws + OFF_ST);
  float* CDEC = (float*)(p.ws + OFF_CDEC);
  const int row0 = ck * 128;
  __syncthreads();
  for (int v = tid; v < 2048; v += 256) {
    const int r = v >> 4, cv = v & 15;
    *(uint4*)&sB[r * 136 + cv * 8] = *(const uint4*)(BC + (size_t)(row0 + r) * 512 + g * 128 + cv * 8);
  }
  __syncthreads();
  bf16x8 bfr[2][8];
#pragma unroll
  for (int j = 0; j < 2; ++j)
#pragma unroll
    for (int ks = 0; ks < 8; ++ks) bfr[j][ks] = tr_frag(sB, 136, ks * 16 + 8 * fh, ks * 16 + 8 * fh + 4, wc * 64 + j * 32);
  const int slr = tid >> 3, scv = tid & 7;
  uint4 xq0, xq1, xq2, xq3;
  float dq0, dq1, dq2, dq3, cq0, cq1, cq2, cq3, cendq;
#define ST_PREFETCH(HD) { const int head_ = g * 8 + hq * 4 + ((HD) >> 1), d_ = (HD) & 1, col_ = d_ * 16 + head_; \
    const bf16_t* xp_ = XS + (size_t)(row0 + slr) * 1024 + head_ * 64 + scv * 8; \
    xq0 = *(const uint4*)(xp_); xq1 = *(const uint4*)(xp_ + 32 * 1024); xq2 = *(const uint4*)(xp_ + 64 * 1024); xq3 = *(const uint4*)(xp_ + 96 * 1024); \
    const size_t rb_ = (size_t)(row0 + slr) * 32 + col_; \
    dq0 = DT[rb_]; dq1 = DT[rb_ + 32 * 32]; dq2 = DT[rb_ + 64 * 32]; dq3 = DT[rb_ + 96 * 32]; \
    cq0 = CS[rb_]; cq1 = CS[rb_ + 32 * 32]; cq2 = CS[rb_ + 64 * 32]; cq3 = CS[rb_ + 96 * 32]; \
    cendq = CS[(size_t)(row0 + (d_ == 0 ? 127 : 0)) * 32 + col_]; }
#define ST_SCALE_STORE(X, DTV, CSV, ROW) { const float sc_ = (DTV) * __expf(cend - (CSV)); uint4 o_; \
    o_.x = pack2(lo2f(X.x) * sc_, hi2f(X.x) * sc_); o_.y = pack2(lo2f(X.y) * sc_, hi2f(X.y) * sc_); \
    o_.z = pack2(lo2f(X.z) * sc_, hi2f(X.z) * sc_); o_.w = pack2(lo2f(X.w) * sc_, hi2f(X.w) * sc_); \
    *(uint4*)&sX[(ROW) * 72 + scv * 8] = o_; }
  ST_PREFETCH(0)
#pragma unroll 1
  for (int hd = 0; hd < 8; ++hd) {
    const int head = g * 8 + hq * 4 + (hd >> 1), d = hd & 1;
    const float cend = cendq;
    ST_SCALE_STORE(xq0, dq0, cq0, slr)
    ST_SCALE_STORE(xq1, dq1, cq1, slr + 32)
    ST_SCALE_STORE(xq2, dq2, cq2, slr + 64)
    ST_SCALE_STORE(xq3, dq3, cq3, slr + 96)
    if (hd < 7) ST_PREFETCH(hd + 1)
    __syncthreads();
    f32x16 acc[2];
#pragma unroll
    for (int j = 0; j < 2; ++j)
#pragma unroll
      for (int r = 0; r < 16; ++r) acc[j][r] = 0.f;
#pragma unroll
    for (int ks = 0; ks < 8; ++ks) {
      const bf16x8 af = tr_frag(sX, 72, ks * 16 + 8 * fh, ks * 16 + 8 * fh + 4, wr * 32);
#pragma unroll
      for (int j = 0; j < 2; ++j) acc[j] = MFMA(af, bfr[j][ks], acc[j]);
    }
    bf16_t* dst = ST + ((size_t)(ck * 2 + d) * 16 + head) * 8192;
#pragma unroll
    for (int j = 0; j < 2; ++j)
#pragma unroll
      for (int r = 0; r < 16; ++r) dst[(wr * 32 + crow(r, fh)) * 128 + wc * 64 + j * 32 + fr] = f2bf(acc[j][r]);
    if (tid == 0) CDEC[(ck * 2 + d) * 16 + head] = __expf(cend);
    __syncthreads();
  }
}

DI void pw_item(const Params& p_in, int l, char* smem, int mt, int nt) {
  const Params p = load_params();

  GemmS* s = (GemmS*)smem;
  int tid = threadIdx.x; asm volatile("" : "+v"(tid)); const int lane = tid & 63, wave = tid >> 6, wr = wave >> 1, wc = wave & 1, fr = lane & 31, fh = lane >> 5;
  const bf16_t* Ab = (const bf16_t*)(p.ws + OFF_HDN) + (size_t)mt * 128 * 512;
  const bf16_t* Bb = (const bf16_t*)(p.ws + OFF_PW) + (size_t)nt * 128 * 512;
  bf16_t* CG = (bf16_t*)(p.ws + OFF_CG);
  f32x16 acc[2][2];
  zero_acc(acc);
  gemm_core2(acc, (GemmS2*)smem,
             [&](int kt, int r, int kv) { return Ab + (size_t)r * 512 + kt * 64 + kv * 8; },
             [&](int kt, int r, int kv) { return Bb + (size_t)r * 512 + kt * 64 + kv * 8; }, 8, [](int) {});
  const float* pwb = p.conv_pw_b + l * 512 + nt * 128;
  epilogue_ldsw(acc, smem, [&](int rl, int c8, float4 lo, float4 hi) {
    bf16_t* ptr = CG + (size_t)(mt * 128 + rl) * 512 + nt * 128 + c8;
    const uint4 gv = *(const uint4*)ptr;
    const float4 b0 = *(const float4*)(pwb + c8), b1 = *(const float4*)(pwb + c8 + 4);
    uint4 o;
    o.x = pack2((lo.x + b0.x) * silu_f(lo2f(gv.x)), (lo.y + b0.y) * silu_f(hi2f(gv.x)));
    o.y = pack2((lo.z + b0.z) * silu_f(lo2f(gv.y)), (lo.w + b0.w) * silu_f(hi2f(gv.y)));
    o.z = pack2((hi.x + b1.x) * silu_f(lo2f(gv.z)), (hi.y + b1.y) * silu_f(hi2f(gv.z)));
    o.w = pack2((hi.z + b1.z) * silu_f(lo2f(gv.w)), (hi.w + b1.w) * silu_f(hi2f(gv.w)));
    *(uint4*)ptr = o;
  });
}

DI void phase_mix(const Params& p, int l, char* smem) {
  const int G = gridDim.x;
  const int N_ATT = 512 + (l == 0 ? 32 : 0);
  for (int it = blockIdx.x; it < N_ATT; it += G) {
    if (it < 512) attn_item(p, l, smem, it >> 7, (it >> 2) & 31, (it >> 1) & 1, it & 1, false);
    else { const int t = it - 512; attn_item(p, l, smem, t >> 3, (t >> 2) & 1, (t >> 1) & 1, t & 1, true); }
  }
  for (int it = (blockIdx.x + G - 32) % G; it < NCK * 4; it += G) states_item(p, smem, it >> 2, (it >> 1) & 1, it & 1);
  for (int it = (blockIdx.x + G - 64) % G; it < NCK * 4; it += G) pw_item(p, l, smem, it >> 2, it & 3);
}

DI void phase_scan(const Params& p_in) {
  const Params p = load_params();

  bf16_t* ST = (bf16_t*)(p.ws + OFF_ST);
  const float* CDEC = (const float*)(p.ws + OFF_CDEC);
  for (int it = blockIdx.x; it < 512; it += gridDim.x) {
    const int e = it * 256 + threadIdx.x;
    const int bdh = e >> 10, v8 = e & 1023;
    const int b = bdh >> 5, d = (bdh >> 4) & 1, h = bdh & 15;
    float s[8];
#pragma unroll
    for (int i = 0; i < 8; ++i) s[i] = 0.f;
    auto ckof = [&](int i) {
      if (d == 0) return (i < 2) ? (128 + 2 * b + i) : (32 * b + (i - 2));
      return (i < 2) ? (128 + 2 * b + (1 - i)) : (32 * b + 31 - (i - 2));
    };
    auto pof = [&](int i) { const int ck = ckof(i); return (uint4*)(ST + ((size_t)(ck * 2 + d) * 16 + h) * 8192 + v8 * 8); };
    auto dof = [&](int i) { const int ck = ckof(i); return CDEC[(ck * 2 + d) * 16 + h]; };
    uint4 buf[8]; float dc[8];
#pragma unroll
    for (int i = 0; i < 7; ++i) { buf[i] = *pof(i); dc[i] = dof(i); }
#pragma unroll
    for (int i = 0; i < 34; ++i) {
      if (i + 7 < 34) { buf[(i + 7) & 7] = *pof(i + 7); dc[(i + 7) & 7] = dof(i + 7); }
      const uint4 cur = buf[i & 7];
      const float dec = dc[i & 7];
      uint4 o;
      o.x = pack2(s[0], s[1]); o.y = pack2(s[2], s[3]); o.z = pack2(s[4], s[5]); o.w = pack2(s[6], s[7]);
      *pof(i) = o;
      s[0] = s[0] * dec + lo2f(cur.x); s[1] = s[1] * dec + hi2f(cur.x);
      s[2] = s[2] * dec + lo2f(cur.y); s[3] = s[3] * dec + hi2f(cur.y);
      s[4] = s[4] * dec + lo2f(cur.z); s[5] = s[5] * dec + hi2f(cur.z);
      s[6] = s[6] * dec + lo2f(cur.w); s[7] = s[7] * dec + hi2f(cur.w);
    }
  }
}

DI void phase_ssdy(const Params& p_in, int l, char* smem) {
  const Params p = load_params();

  bf16_t* sB = (bf16_t*)smem;
  bf16_t* sX = (bf16_t*)(smem + 128 * 136 * 2);
  float* sF = (float*)(smem + 128 * 136 * 2 + 128 * 72 * 2);
  float* sSS = sF + 512;
  int tid = threadIdx.x; asm volatile("" : "+v"(tid)); const int lane = tid & 63, wave = tid >> 6, fr = lane & 31, fh = lane >> 5;
  const int wl = wave >> 1, w2 = wave & 1;
  const bf16_t* BC = (const bf16_t*)(p.ws + OFF_BC);
  const bf16_t* XS = (const bf16_t*)(p.ws + OFF_H);
  const float* DT = (const float*)(p.ws + OFF_DT);
  const float* CS = (const float*)(p.ws + OFF_CS);
  const bf16_t* ST = (const bf16_t*)(p.ws + OFF_ST);
  bf16_t* Z = (bf16_t*)(p.ws + OFF_Z);
  float* RSTD = (float*)(p.ws + OFF_RSTD);
  const int nck = (l == 0) ? NCK : 128;
  const int nh = (l == 0) ? 2 : 8;
  const int nsplit = 8 / nh;
  for (int it0 = blockIdx.x; it0 < nck * 4 * nsplit; it0 += gridDim.x) {
    const int hq = it0 % nsplit, it = it0 / nsplit;
    const int hbeg = hq * nh, hend = hbeg + nh;
    const int ck = it >> 2, g = (it >> 1) & 1, lh = it & 1;
    const int row0 = ck * 128;
    const int lbase = lh * 64 + wl * 32;
    __syncthreads();
    for (int v = tid; v < 2048; v += 256) {
      const int r = v >> 4, cv = v & 15;
      *(uint4*)&sB[r * 136 + cv * 8] = *(const uint4*)(BC + (size_t)(row0 + r) * 512 + g * 128 + cv * 8);
    }
    if (tid < 64) sSS[tid] = 0.f;
    const bf16_t* cptr = BC + (size_t)(row0 + lbase + fr) * 512 + 256 + g * 128 + fh * 8;
    bf16x8 cf[8];
#pragma unroll
    for (int ks = 0; ks < 8; ++ks) cf[ks] = *(const bf16x8*)(cptr + ks * 16);
    const int lrx = tid >> 3, cvx = tid & 7;
    const bf16_t* xsrc = XS + (size_t)(row0 + lrx) * 1024 + cvx * 8;
    uint4 xp0, xp1, xp2, xp3;
    float fp0 = 0.f, fp1 = 0.f, fp2 = 0.f, fp3 = 0.f;
    {
      const int head = g * 8 + hbeg;
      xp0 = *(const uint4*)(xsrc + head * 64);
      xp1 = *(const uint4*)(xsrc + head * 64 + 32 * 1024);
      xp2 = *(const uint4*)(xsrc + head * 64 + 64 * 1024);
      xp3 = *(const uint4*)(xsrc + head * 64 + 96 * 1024);
      if (tid < 128) {
        const size_t rho = (size_t)(row0 + tid);
        fp0 = CS[rho * 32 + head]; fp1 = CS[rho * 32 + 16 + head]; fp2 = DT[rho * 32 + head]; fp3 = DT[rho * 32 + 16 + head];
      }
    }
    __syncthreads();
    f32x16 cb[2];
#pragma unroll
    for (int j = 0; j < 2; ++j) {
#pragma unroll
      for (int r = 0; r < 16; ++r) cb[j][r] = 0.f;
#pragma unroll
      for (int ks = 0; ks < 8; ++ks) {
        const bf16x8 bq = *(const bf16x8*)&sB[(w2 * 64 + j * 32 + fr) * 136 + ks * 16 + fh * 8];
        cb[j] = MFMA(cf[ks], bq, cb[j]);
      }
    }
    const int pidx = w2 * 32 + fr;
    bf16_t* sCB = sB + 64 * 136;
    __syncthreads();
#pragma unroll
    for (int j = 0; j < 2; ++j)
#pragma unroll
      for (int r = 0; r < 16; ++r) sCB[(wl * 32 + crow(r, fh)) * 136 + w2 * 64 + j * 32 + fr] = f2bf(cb[j][r]);
#pragma unroll 1
    for (int hh = hbeg; hh < hend; ++hh) {
      const int head = g * 8 + hh;
      __syncthreads();
      *(uint4*)&sX[lrx * 72 + cvx * 8] = xp0;
      *(uint4*)&sX[(lrx + 32) * 72 + cvx * 8] = xp1;
      *(uint4*)&sX[(lrx + 64) * 72 + cvx * 8] = xp2;
      *(uint4*)&sX[(lrx + 96) * 72 + cvx * 8] = xp3;
      if (tid < 128) { sF[tid] = fp0; sF[128 + tid] = fp1; sF[256 + tid] = fp2; sF[384 + tid] = fp3; }
      const bf16_t* S0 = ST + ((size_t)(ck * 2 + 0) * 16 + head) * 8192 + (w2 * 32 + fr) * 128 + fh * 8;
      const bf16_t* S1 = ST + ((size_t)(ck * 2 + 1) * 16 + head) * 8192 + (w2 * 32 + fr) * 128 + fh * 8;
      bf16x8 sf0[8];
#pragma unroll
      for (int ks = 0; ks < 8; ++ks) sf0[ks] = *(const bf16x8*)(S0 + ks * 16);
      bf16_t* zbase = Z + (size_t)(row0 + lbase + 4 * fh) * 1024 + head * 64 + pidx;
      if (hh + 1 < hend) {
        const int hn = head + 1;
        xp0 = *(const uint4*)(xsrc + hn * 64);
        xp1 = *(const uint4*)(xsrc + hn * 64 + 32 * 1024);
        xp2 = *(const uint4*)(xsrc + hn * 64 + 64 * 1024);
        xp3 = *(const uint4*)(xsrc + hn * 64 + 96 * 1024);
        if (tid < 128) {
          const size_t rho = (size_t)(row0 + tid);
          fp0 = CS[rho * 32 + hn]; fp1 = CS[rho * 32 + 16 + hn]; fp2 = DT[rho * 32 + hn]; fp3 = DT[rho * 32 + 16 + hn];
        }
      }
      __syncthreads();
#pragma unroll
      for (int j = 0; j < 2; ++j) {
        const int sidx = w2 * 64 + j * 32 + fr;
        const float csf_s = sF[sidx], csb_s = sF[128 + sidx], dtf_s = sF[256 + sidx], dtb_s = sF[384 + sidx];
#pragma unroll 4
        for (int r = 0; r < 16; ++r) {
          const int lidx = lbase + crow(r, fh);
          float f = 0.f;
          if (sidx <= lidx) f += __expf(sF[lidx] - csf_s) * dtf_s;
          if (sidx >= lidx) f += __expf(sF[128 + lidx] - csb_s) * dtb_s;
          sB[(wl * 32 + crow(r, fh)) * 136 + sidx] = f2bf(bf2f(sCB[(wl * 32 + crow(r, fh)) * 136 + sidx]) * f);
        }
      }
      __syncthreads();
      bf16x8 sf1[8], cfh[8];
#pragma unroll
      for (int ks = 0; ks < 8; ++ks) { sf1[ks] = *(const bf16x8*)(S1 + ks * 16); cfh[ks] = *(const bf16x8*)(cptr + ks * 16); }
      unsigned short zv[16];
#pragma unroll
      for (int r = 0; r < 16; ++r) zv[r] = zbase[(size_t)((r & 3) + 8 * (r >> 2)) * 1024];
      f32x16 accy;
#pragma unroll
      for (int r = 0; r < 16; ++r) accy[r] = 0.f;
#pragma unroll
      for (int ks = 0; ks < 8; ++ks) {
        const bf16x8 af = *(const bf16x8*)&sB[(wl * 32 + fr) * 136 + ks * 16 + fh * 8];
        const bf16x8 xf = tr_frag(sX, 72, ks * 16 + 8 * fh, ks * 16 + 8 * fh + 4, w2 * 32);
        accy = MFMA(af, xf, accy);
      }
      {
        f32x16 acct;
#pragma unroll
        for (int r = 0; r < 16; ++r) acct[r] = 0.f;
#pragma unroll
        for (int ks = 0; ks < 8; ++ks) acct = MFMA(cfh[ks], sf0[ks], acct);
#pragma unroll
        for (int r = 0; r < 16; ++r) accy[r] += __expf(sF[lbase + crow(r, fh)]) * acct[r];
#pragma unroll
        for (int r = 0; r < 16; ++r) acct[r] = 0.f;
#pragma unroll
        for (int ks = 0; ks < 8; ++ks) acct = MFMA(cfh[ks], sf1[ks], acct);
#pragma unroll
        for (int r = 0; r < 16; ++r) accy[r] += __expf(sF[128 + lbase + crow(r, fh)]) * acct[r];
      }
      const float dsk = p.ssd_d[l * 16 + head];
      float v[16];
#pragma unroll
      for (int r = 0; r < 16; ++r) {
        const int lidx = lbase + crow(r, fh);
        const float xv = bf2f(sX[lidx * 72 + pidx]);
        const float y = accy[r] + dsk * xv;
        const float u = y * silu_f(bf2f(zv[r]));
        v[r] = u * u;
        zbase[(size_t)((r & 3) + 8 * (r >> 2)) * 1024] = f2bf(u);
      }
#pragma unroll
      for (int i = 0; i < 8; ++i) { const bool up = (fr & 16) != 0; const float keep = up ? v[i + 8] : v[i]; const float send = up ? v[i] : v[i + 8]; v[i] = keep + __shfl_xor(send, 16); }
#pragma unroll
      for (int i = 0; i < 4; ++i) { const bool up = (fr & 8) != 0; const float keep = up ? v[i + 4] : v[i]; const float send = up ? v[i] : v[i + 4]; v[i] = keep + __shfl_xor(send, 8); }
#pragma unroll
      for (int i = 0; i < 2; ++i) { const bool up = (fr & 4) != 0; const float keep = up ? v[i + 2] : v[i]; const float send = up ? v[i] : v[i + 2]; v[i] = keep + __shfl_xor(send, 4); }
      { const bool up = (fr & 2) != 0; const float keep = up ? v[1] : v[0]; const float send = up ? v[0] : v[1]; v[0] = keep + __shfl_xor(send, 2); }
      v[0] += __shfl_xor(v[0], 1);
      if ((fr & 1) == 0) atomicAdd(&sSS[wl * 32 + crow(fr >> 1, fh)], v[0]);
    }
    __syncthreads();
    if (tid < 64) atomicAdd(&RSTD[(size_t)(row0 + lh * 64 + tid) * 2 + g], sSS[tid]);
  }
}

DI void phase_outproj(const Params& p_in, int l, char* smem) {
  const Params p = load_params();

  GemmS* s = (GemmS*)smem;
  int tid = threadIdx.x; asm volatile("" : "+v"(tid)); const int lane = tid & 63, wave = tid >> 6, wr = wave >> 1, wc = wave & 1, fr = lane & 31, fh = lane >> 5;
  const bf16_t* Zb = (const bf16_t*)(p.ws + OFF_Z);
  const bf16_t* Qb = (const bf16_t*)(p.ws + OFF_Q);
  const bf16_t* Cb = (const bf16_t*)(p.ws + OFF_CG);
  const bf16_t* W = (const bf16_t*)(p.ws + OFF_WOUT);
  const float* RSTD = (const float*)(p.ws + OFF_RSTD);
  const float* mods = (const float*)(p.ws + OFF_MODS);
  float* XC = (float*)(p.ws + OFF_XC);
  for (int step = 0;; ++step) {
    int mt, nt2;
    if (!xcd_tile(step, 128, 4, mt, nt2)) break;
    f32x16 acc[2][4];
#pragma unroll
    for (int i = 0; i < 2; ++i)
#pragma unroll
      for (int j = 0; j < 4; ++j)
#pragma unroll
        for (int r = 0; r < 16; ++r) acc[i][j][r] = 0.f;
    const bf16_t* Wb = W + (size_t)nt2 * 256 * 2048;
    const bf16_t* A0 = Zb + (size_t)mt * 128 * 1024;
    const bf16_t* A2 = Qb + (size_t)mt * 128 * 512;
    const bf16_t* A3 = Cb + (size_t)mt * 128 * 512;
    float* sScale = (float*)(smem + 55296);
    __syncthreads();
    if (tid < 128) {
      const size_t row = (size_t)(mt * 128 + tid);
      const float r0 = rsqrtf(RSTD[row * 2] * (1.f / 512.f) + 1e-6f);
      const float r1 = rsqrtf(RSTD[row * 2 + 1] * (1.f / 512.f) + 1e-6f);
      sScale[tid * 2] = r0 / r1;
      sScale[tid * 2 + 1] = r1;
    }
    gemm_core3(acc, (GemmS3*)smem,
               [&](int kt, int r, int kv) {
                 const bf16_t* ptr;
                 if (kt < 16) ptr = A0 + (size_t)r * 1024 + kt * 64;
                 else if (kt < 24) ptr = A2 + (size_t)r * 512 + (kt - 16) * 64;
                 else ptr = A3 + (size_t)r * 512 + (kt - 24) * 64;
                 return ptr + kv * 8;
               },
               [&](int kt, int r, int kv) { return Wb + (size_t)r * 2048 + kt * 64 + kv * 8; }, 32,
               [&](int kt) __attribute__((always_inline)) {
                 if (kt == 8 || kt == 16) {
#pragma unroll
                   for (int i = 0; i < 2; ++i)
#pragma unroll
                     for (int r = 0; r < 16; ++r) {
                       const float f = sScale[(wr * 64 + i * 32 + crow(r, fh)) * 2 + (kt == 16 ? 1 : 0)];
                       acc[i][0][r] *= f; acc[i][1][r] *= f; acc[i][2][r] *= f; acc[i][3][r] *= f;
                     }
                 }
               });
    {
      const int row0 = mt * 128;
      const int vv = row0 >> 12;
      float* xnew = p.out + (size_t)row0 * 1024;
      const float* xold = (l == 0) ? (p.x + (size_t)row0 * 1024) : xnew;
#pragma unroll 1
      for (int sub = 0; sub < 2; ++sub) {
        const int nt = nt2 * 2 + sub;
        const float* gate = mods + (l * 5 + vv) * 3072 + 2048 + nt * 128;
        epilogue_lds2(acc, smem, sub, [&](int rl, int c4, float4 v) {
          const int off = rl * 1024 + nt * 128 + c4;
          const float4 xo = *(const float4*)(xold + off);
          const float4 gt = *(const float4*)(gate + c4);
          float4 o;
          o.x = xo.x + gt.x * v.x; o.y = xo.y + gt.y * v.y; o.z = xo.z + gt.z * v.z; o.w = xo.w + gt.w * v.w;
          *(float4*)(xnew + off) = o;
        });
      }
    }
  }
  const int nctx = (l == 0) ? 64 : 0;
  for (int it = (int)blockIdx.x; it < nctx; it += gridDim.x) {
    const int mt = 128 + (it >> 3), nt = it & 7;
    f32x16 acc[2][2];
    zero_acc(acc);
    const bf16_t* Wb = W + (size_t)nt * 128 * 2048;
    const bf16_t* A0 = Zb + (size_t)mt * 128 * 1024;
    const bf16_t* A2 = Qb + (size_t)mt * 128 * 512;
    const bf16_t* A3 = Cb + (size_t)mt * 128 * 512;
    float* sScale = (float*)(smem + 40960);
    if (tid < 128) {
      const size_t row = (size_t)(mt * 128 + tid);
      const float r0 = rsqrtf(RSTD[row * 2] * (1.f / 512.f) + 1e-6f);
      const float r1 = rsqrtf(RSTD[row * 2 + 1] * (1.f / 512.f) + 1e-6f);
      sScale[tid * 2] = r0 / r1;
      sScale[tid * 2 + 1] = r1;
    }
    gemm_core2(acc, (GemmS2*)smem,
               [&](int kt, int r, int kv) {
                 const bf16_t* ptr;
                 if (kt < 16) ptr = A0 + (size_t)r * 1024 + kt * 64;
                 else if (kt < 24) ptr = A2 + (size_t)r * 512 + (kt - 16) * 64;
                 else ptr = A3 + (size_t)r * 512 + (kt - 24) * 64;
                 return ptr + kv * 8;
               },
               [&](int kt, int r, int kv) { return Wb + (size_t)r * 2048 + kt * 64 + kv * 8; }, 32,
               [&](int kt) __attribute__((always_inline)) {
                 if (kt == 8 || kt == 16) {
#pragma unroll
                   for (int i = 0; i < 2; ++i)
#pragma unroll
                     for (int r = 0; r < 16; ++r) {
                       const float f = sScale[(wr * 64 + i * 32 + crow(r, fh)) * 2 + (kt == 16 ? 1 : 0)];
                       acc[i][0][r] *= f; acc[i][1][r] *= f;
                     }
                 }
               });
    {
      const int row0 = mt * 128;
      const int vv = (row0 < RL_) ? (row0 >> 12) : 4;
      const float* gate = mods + (l * 5 + vv) * 3072 + 2048 + nt * 128;
      float* xnew = (row0 < RL_) ? (p.out + (size_t)row0 * 1024) : (XC + (size_t)(row0 - RL_) * 1024);
      const float* xold = (l == 0) ? ((row0 < RL_) ? (p.x + (size_t)row0 * 1024) : (p.ctx + (size_t)(row0 - RL_) * 1024)) : xnew;
      epilogue_lds(acc, smem, [&](int rl, int c4, float4 v) {
        const int off = rl * 1024 + nt * 128 + c4;
        const float4 xo = *(const float4*)(xold + off);
        const float4 gt = *(const float4*)(gate + c4);
        float4 o;
        o.x = xo.x + gt.x * v.x; o.y = xo.y + gt.y * v.y; o.z = xo.z + gt.z * v.z; o.w = xo.w + gt.w * v.w;
        *(float4*)(xnew + off) = o;
      });
    }
  }
  if (l == 0) {
    const int local = blockIdx.x >> 3, xcd = blockIdx.x & 7, nloc = gridDim.x >> 3;
    if (local >= 8 && nloc > 8) {
      const int nb = (nloc - 8) * 8;
      const int NT_WIN = 88 * 16, NT_PW = 64;
      for (int it = (local - 8) * 8 + xcd; it < NT_WIN + NT_PW; it += nb) {
        if (it < NT_WIN) transpose_tile(p.w_in + (size_t)1024 * 5408, 5408, 0, nullptr, (bf16_t*)(p.ws + OFF_WIN), 1024, (it / 16) * 64, (it % 16) * 64, (float*)smem);
        else { const int t = it - NT_WIN; transpose_tile(p.conv_pw_w + (size_t)512 * 512, 512, 1, nullptr, (bf16_t*)(p.ws + OFF_PW), 512, (t / 8) * 64, (t % 8) * 64, (float*)smem); }
      }
    }
  }
}

DI void phase_final(const Params& p_in) {
  const Params p = load_params();
  const int lane = threadIdx.x & 63, wave = threadIdx.x >> 6;
  for (int it = blockIdx.x; it < RL_ / 8; it += gridDim.x) {
    float* xr0 = p.out + (size_t)(it * 8 + wave * 2) * 1024;
    float4 xv[2][4];
#pragma unroll
    for (int q = 0; q < 2; ++q)
#pragma unroll
      for (int i = 0; i < 4; ++i) xv[q][i] = *(const float4*)(xr0 + q * 1024 + lane * 4 + i * 256);
    float4 w[4];
#pragma unroll
    for (int i = 0; i < 4; ++i) w[i] = *(const float4*)(p.final_norm_w + lane * 4 + i * 256);
#pragma unroll
    for (int q = 0; q < 2; ++q) {
      float ss = 0.f;
#pragma unroll
      for (int i = 0; i < 4; ++i) ss += xv[q][i].x * xv[q][i].x + xv[q][i].y * xv[q][i].y + xv[q][i].z * xv[q][i].z + xv[q][i].w * xv[q][i].w;
#pragma unroll
      for (int o = 32; o >= 1; o >>= 1) ss += __shfl_xor(ss, o);
      const float rs = rsqrtf(ss * (1.f / 1024.f) + 1e-6f);
#pragma unroll
      for (int i = 0; i < 4; ++i) {
        float4 o;
        o.x = xv[q][i].x * rs * w[i].x; o.y = xv[q][i].y * rs * w[i].y; o.z = xv[q][i].z * rs * w[i].z; o.w = xv[q][i].w * rs * w[i].w;
        *(float4*)(xr0 + q * 1024 + lane * 4 + i * 256) = o;
      }
    }
  }
}

template <int PH>
DI void run_phase(const Params& p, char* smem) {
  constexpr int l = (PH - 1) / 7, s = (PH - 1) % 7;
  if constexpr (PH == 0) phase_mods(p, smem);
  else if constexpr (PH == 15) phase_final(p);
  else if constexpr (s == 0) phase_prep(p, l, smem);
  else if constexpr (s == 1) phase_inproj(p, smem);
  else if constexpr (s == 2) phase_local(p, l, smem);
  else if constexpr (s == 3) phase_mix(p, l, smem);
  else if constexpr (s == 4) phase_scan(p);
  else if constexpr (s == 5) phase_ssdy(p, l, smem);
  else phase_outproj(p, l, smem);
}

#if PROBE_S >= 0
#define PROBE_BEGIN() if (threadIdx.x == 0) pst[1] = wall_clock64();
#define PROBE_END(PH) if (threadIdx.x == 0 && (PH) >= 1 && (PH) <= 14 && (((PH) - 1) % 7) == PROBE_S) pst[0] += wall_clock64() - pst[1];
#else
#define PROBE_BEGIN()
#define PROBE_END(PH)
#endif
#define PHASE(PH) PROBE_BEGIN() run_phase<PH>(p, smem); xcd_barrier(xst); PROBE_END(PH)

__global__ void __launch_bounds__(256, 2) fwd_megakernel(Params p) {
  __shared__ __attribute__((aligned(16))) char smem[57344];
  cg::grid_group grid = cg::this_grid();
  if (threadIdx.x == 0) g_kernarg = (unsigned long long)__builtin_amdgcn_kernarg_segment_ptr();
  __syncthreads();
#if PROBE_S >= 0
  volatile unsigned long long* pst = (volatile unsigned long long*)(smem + 57344 - 16);
  if (threadIdx.x == 0) { pst[0] = 0; pst[1] = 0; }
#endif
  __shared__ uint4 xb_words;
  volatile LAS unsigned* xst = (volatile LAS unsigned*)&xb_words;
  if (threadIdx.x == 0) xb_words = make_uint4(0u, 0u, 0u, 0u);
  if (threadIdx.x == 0) { unsigned* bar = (unsigned*)(load_params().ws + OFF_BAR); (void)xb_add(&bar[XB_XCNT(xb_xcc_id())], 1u); }
  run_phase<0>(p, smem);
  if (load_params().out == nullptr) grid.sync();
  xcd_barrier(xst);
  PHASE(1) PHASE(2) PHASE(3) PHASE(4) PHASE(5) PHASE(6) PHASE(7)
  PHASE(8) PHASE(9) PHASE(10) PHASE(11) PHASE(12) PHASE(13) PHASE(14)
  run_phase<15>(p, smem);
#if PROBE_S >= 0
  if (blockIdx.x == 0 && threadIdx.x == 0) {
    const unsigned long long t1 = wall_clock64();
    const unsigned long long lim = 4ull * pst[0];
    while (wall_clock64() - t1 < lim) { __builtin_amdgcn_s_sleep(32); }
  }
#endif
}

extern "C" void kernel_launch(void* const* d_in, const int* in_sizes, int n_in, void* d_out, int out_size, void* d_ws,
                              size_t ws_size, hipStream_t stream) {
  static int grid_blocks = 0;
  if (!grid_blocks) {
    int dev = 0, cus = 0, per_cu = 0;
    hipGetDevice(&dev);
    hipDeviceGetAttribute(&cus, hipDeviceAttributeMultiprocessorCount, dev);
    hipOccupancyMaxActiveBlocksPerMultiprocessor(&per_cu, fwd_megakernel, 256, 0);
    if (per_cu < 1) per_cu = 1;
    if (per_cu > 2) per_cu = 2;
    grid_blocks = (cus * per_cu) & ~7;
  }
  Params p{};
  const float** pp = (const float**)&p;
  for (int i = 0; i < 23; ++i) pp[i] = (const float*)d_in[i];
  p.out = (float*)d_out;
  p.ws = (char*)d_ws;
  (void)hipMemsetAsync((char*)d_ws + OFF_BAR, 0, XCD_BAR_WORDS * 4, stream);
  void* args[] = {&p};
  hipError_t e = hipLaunchCooperativeKernel((void*)fwd_megakernel, dim3(grid_blocks), dim3(256), args, 0, stream);
  if (e != hipSuccess) fprintf(stderr, "cooperative launch failed: %s (grid %d)\n", hipGetErrorString(e), grid_blocks);
}
```

```cpp
#include <hip/hip_runtime.h>
#include <hip/hip_cooperative_groups.h>
#include <stdint.h>
#include <stdio.h>
namespace cg = cooperative_groups;

#ifndef ONE_LAUNCH
#define ONE_LAUNCH 1
#endif

#ifndef PROBE_S
#define PROBE_S -1
#endif
#define DI __device__ __forceinline__
typedef unsigned short bf16_t;
using bf16x8 = __attribute__((ext_vector_type(8))) short;
using s16x4 = __attribute__((ext_vector_type(4))) short;
using f32x16 = __attribute__((ext_vector_type(16))) float;
#define MFMA(a, b, c) __builtin_amdgcn_mfma_f32_32x32x16_bf16((a), (b), (c), 0, 0, 0)

constexpr int R_ = 17408;
constexpr int RL_ = 16384;
constexpr int NCK = 136;

constexpr size_t SZ_WIN = (size_t)5632 * 1024 * 2;
constexpr size_t SZ_WOUT = (size_t)1024 * 2048 * 2;
constexpr size_t SZ_PW = (size_t)512 * 512 * 2;
constexpr size_t SZ_MODS = (size_t)2 * 5 * 3072 * 4;
constexpr size_t SZ_XC = (size_t)1024 * 1024 * 4;
constexpr size_t SZ_RSTD = (size_t)R_ * 2 * 4;
constexpr size_t SZ_CDEC = (size_t)NCK * 32 * 4 + 256 - ((size_t)NCK * 32 * 4) % 256;
constexpr size_t SZ_R512 = (size_t)R_ * 512 * 2;
constexpr size_t OFF_WIN = 0;
constexpr size_t OFF_WOUT = OFF_WIN + SZ_WIN;
constexpr size_t OFF_PW = OFF_WOUT + SZ_WOUT;
constexpr size_t OFF_MODS = OFF_PW + SZ_PW;
constexpr size_t OFF_XC = OFF_MODS + SZ_MODS;
constexpr size_t OFF_RSTD = OFF_XC + SZ_XC;
constexpr size_t OFF_CDEC = OFF_RSTD + SZ_RSTD;
constexpr size_t OFF_H = OFF_CDEC + SZ_CDEC;
constexpr size_t OFF_XBC = OFF_H + 2 * SZ_R512;
constexpr size_t OFF_GLU = OFF_XBC + 3 * SZ_R512;
constexpr size_t OFF_ST = OFF_XBC;
constexpr size_t OFF_Z = OFF_GLU + SZ_R512;
constexpr size_t OFF_DT = OFF_Z + 2 * SZ_R512;
constexpr size_t OFF_CS = OFF_DT + (size_t)R_ * 32 * 4;
constexpr size_t OFF_Q = OFF_CS + (size_t)R_ * 32 * 4;
constexpr size_t OFF_KV = OFF_Q + SZ_R512;
constexpr size_t OFF_AG = OFF_KV + SZ_R512 / 2;
constexpr size_t OFF_CG = OFF_AG + SZ_R512;
constexpr size_t OFF_BC = OFF_CG + SZ_R512;
constexpr size_t OFF_HDN = OFF_BC + SZ_R512;
constexpr size_t WS_TOTAL = OFF_HDN + SZ_R512;
constexpr size_t OFF_BAR = WS_TOTAL;
static_assert(OFF_BAR + 16384 <= (size_t)256 * 1024 * 1024, "workspace too large");

struct Params {
  const float *x, *c, *ctx, *c_ctx, *w_mod, *b_mod, *norm_w, *w_in, *ssd_conv_w, *ssd_conv_b, *ssd_dt_bias, *ssd_a_log,
      *ssd_d, *ssd_norm_w, *attn_sink, *conv_dw_w, *conv_dw_b, *conv_ln_w, *conv_ln_b, *conv_pw_w, *conv_pw_b, *w_out,
      *final_norm_w;
  float* out;
  char* ws;
};


__shared__ unsigned long long g_kernarg;
DI Params load_params() {
  typedef const char __attribute__((address_space(4)))* kptr_t;
  typedef const float* const __attribute__((address_space(4)))* kfld_t;
  const unsigned long long v = *(volatile unsigned long long*)&g_kernarg;
  const unsigned lo = __builtin_amdgcn_readfirstlane((unsigned)v), hi = __builtin_amdgcn_readfirstlane((unsigned)(v >> 32));
  kptr_t base = (kptr_t)(((unsigned long long)hi << 32) | lo);
  Params p;
  const float** pp = (const float**)&p;
#pragma unroll
  for (int i = 0; i < 25; ++i) pp[i] = *(kfld_t)(base + 8 * i);
  return p;
}

#define XB_TMO      128
#define XB_XCNT(j)  (256  + 64 * (j))
#define XB_XSUB(j)  (1280 + 64 * (j))
#define XB_XGEN(j)  (2304 + 64 * (j))
#define XB_TOP      3328
#define XB_TOPGEN   3392
#define XCD_BAR_WORDS 3456
#define XB_SPIN_CAP (1u << 18)
#define LAS __attribute__((address_space(3)))
DI unsigned xb_ld(unsigned* p)              { return __hip_atomic_load(p, __ATOMIC_RELAXED, __HIP_MEMORY_SCOPE_AGENT); }
DI unsigned xb_add(unsigned* p, unsigned v) { return __hip_atomic_fetch_add(p, v, __ATOMIC_RELAXED, __HIP_MEMORY_SCOPE_AGENT); }
DI unsigned xb_xcc_id() { return (unsigned)__builtin_amdgcn_s_getreg((3 << 11) | 20) & 0xFu; }
#define XB_SPIN(cond, bar) do { unsigned _sp = 0; while (cond) { __builtin_amdgcn_s_sleep(1); \
    if ((++_sp & 255u) == 0u) { if (xb_ld(&(bar)[XB_TMO])) break; if (_sp > XB_SPIN_CAP) { atomicAdd(&(bar)[XB_TMO], 1u); break; } } } } while (0)

DI void xcd_barrier_complete(unsigned* bar, unsigned x, unsigned& nloc, unsigned& nx) {
  const unsigned G = gridDim.x * gridDim.y * gridDim.z;
  unsigned sum, cnt, mine, sp = 0u;
  for (;;) {
    sum = 0u; cnt = 0u; mine = 0u;
#pragma unroll
    for (unsigned j = 0; j < 16; ++j) { const unsigned c = xb_ld(&bar[XB_XCNT(j)]); sum += c; cnt += (c > 0u) ? 1u : 0u; mine = (j == x) ? c : mine; }
    if (sum == G) break;
    __builtin_amdgcn_s_sleep(1);
    if ((++sp & 255u) == 0u) { if (xb_ld(&bar[XB_TMO])) break; if (sp > XB_SPIN_CAP) { atomicAdd(&bar[XB_TMO], 1u); break; } }
  }
  nloc = mine > 0u ? mine : 1u; nx = cnt > 0u ? cnt : 1u;
}

DI void xcd_barrier(volatile LAS unsigned* st) {
  asm volatile("s_waitcnt vmcnt(0)" ::: "memory");
  __syncthreads();
  if (threadIdx.x == 0) {
    const Params pb = load_params();
    unsigned* bar = (unsigned*)(pb.ws + OFF_BAR);
    const unsigned x = xb_xcc_id();
    __builtin_amdgcn_s_waitcnt(0);
    unsigned nloc = st[0], nx = st[1];
    if (nloc == 0u) { xcd_barrier_complete(bar, x, nloc, nx); st[0] = nloc; st[1] = nx; }
    const unsigned old = xb_add(&bar[XB_XSUB(x)], 1u);
    const unsigned gen = old / nloc;
    if (old + 1u == (gen + 1u) * nloc) {
      __builtin_amdgcn_fence(__ATOMIC_RELEASE, "agent");
      asm volatile("s_waitcnt vmcnt(0)" ::: "memory");
      const unsigned og = xb_add(&bar[XB_TOP], 1u);
      const unsigned tg = og / nx;
      if (og + 1u == (tg + 1u) * nx) xb_add(&bar[XB_TOPGEN], 1u);
      else XB_SPIN(xb_ld(&bar[XB_TOPGEN]) == tg, bar);
      __builtin_amdgcn_fence(__ATOMIC_ACQUIRE, "agent");
      xb_add(&bar[XB_XGEN(x)], 1u);
      asm volatile("s_waitcnt vmcnt(0)" ::: "memory");
    } else {
      XB_SPIN(xb_ld(&bar[XB_XGEN(x)]) == gen, bar);
      __builtin_amdgcn_fence(__ATOMIC_ACQUIRE, "agent");
      asm volatile("s_waitcnt vmcnt(0)" ::: "memory");
    }
  }
  __syncthreads();
}

typedef __bf16 nbf16x2_t __attribute__((ext_vector_type(2)));
typedef float nf32x2_t __attribute__((ext_vector_type(2)));
DI unsigned short f2bf(float x) { const __bf16 r = (__bf16)x; return __builtin_bit_cast(unsigned short, r); }
DI float bf2f(unsigned short b) { return __uint_as_float(((unsigned)b) << 16); }
DI unsigned pack2(float a, float b) { const nf32x2_t v = {a, b}; const nbf16x2_t r = __builtin_convertvector(v, nbf16x2_t); return __builtin_bit_cast(unsigned, r); }
DI float lo2f(unsigned u) { return __uint_as_float(u << 16); }
DI float hi2f(unsigned u) { return __uint_as_float(u & 0xffff0000u); }
DI float silu_f(float x) { return x * __builtin_amdgcn_rcpf(1.f + __expf(-x)); }
DI float sigmoid_f(float x) { return __builtin_amdgcn_rcpf(1.f + __expf(-x)); }
DI float xhalf_max(float v) {
  const auto rr = __builtin_amdgcn_permlane32_swap(__float_as_uint(v), __float_as_uint(v), false, false);
  return fmaxf(__uint_as_float(rr[0]), __uint_as_float(rr[1]));
}
DI float xhalf_sum(float v) {
  const auto rr = __builtin_amdgcn_permlane32_swap(__float_as_uint(v), __float_as_uint(v), false, false);
  return __uint_as_float(rr[0]) + __uint_as_float(rr[1]);
}

DI int crow(int reg, int h) { return (reg & 3) + 8 * (reg >> 2) + 4 * h; }

DI bf16x8 tr_frag(const bf16_t* s, int ld, int row_lo, int row_hi, int col0) {
  const int lane = threadIdx.x & 63;
  const int i16 = lane & 15, q = i16 >> 2, pp = i16 & 3, blk = (lane >> 4) & 1;
  const unsigned a0 = (unsigned)(size_t)(s + (row_lo + q) * ld + col0 + 16 * blk + 4 * pp);
  const unsigned a1 = (unsigned)(size_t)(s + (row_hi + q) * ld + col0 + 16 * blk + 4 * pp);
  s16x4 lo, hi;
  asm volatile("ds_read_b64_tr_b16 %0, %2\n\tds_read_b64_tr_b16 %1, %3\n\ts_waitcnt lgkmcnt(0)"
               : "=&v"(lo), "=&v"(hi) : "v"(a0), "v"(a1) : "memory");
  return __builtin_shufflevector(lo, hi, 0, 1, 2, 3, 4, 5, 6, 7);
}

struct GemmS { bf16_t a[2][128][40]; bf16_t b[2][128][40]; };

template <class AF, class BF>
DI void gemm_core(f32x16 (&acc)[2][2], GemmS* s, AF aptr, BF bptr, int nk) {
  int tid = threadIdx.x; asm volatile("" : "+v"(tid)); const int lane = tid & 63, wave = tid >> 6, wr = wave >> 1, wc = wave & 1;
  const int r0 = tid >> 2, kv = tid & 3;
  const int fr = lane & 31, fh = lane >> 5;
  uint4 ra0 = *(const uint4*)aptr(0, r0, kv), ra1 = *(const uint4*)aptr(0, r0 + 64, kv);
  uint4 rb0 = *(const uint4*)bptr(0, r0, kv), rb1 = *(const uint4*)bptr(0, r0 + 64, kv);
  *(uint4*)&s->a[0][r0][kv * 8] = ra0; *(uint4*)&s->a[0][r0 + 64][kv * 8] = ra1;
  *(uint4*)&s->b[0][r0][kv * 8] = rb0; *(uint4*)&s->b[0][r0 + 64][kv * 8] = rb1;
  __syncthreads();
#pragma unroll 1
  for (int kt = 0; kt < nk; ++kt) {
    const int buf = kt & 1;
    if (kt + 1 < nk) {
      ra0 = *(const uint4*)aptr(kt + 1, r0, kv); ra1 = *(const uint4*)aptr(kt + 1, r0 + 64, kv);
      rb0 = *(const uint4*)bptr(kt + 1, r0, kv); rb1 = *(const uint4*)bptr(kt + 1, r0 + 64, kv);
    }
#pragma unroll
    for (int ks = 0; ks < 2; ++ks) {
      bf16x8 af[2], bq[2];
#pragma unroll
      for (int i = 0; i < 2; ++i) af[i] = *(const bf16x8*)&s->a[buf][wr * 64 + i * 32 + fr][ks * 16 + fh * 8];
#pragma unroll
      for (int j = 0; j < 2; ++j) bq[j] = *(const bf16x8*)&s->b[buf][wc * 64 + j * 32 + fr][ks * 16 + fh * 8];
#pragma unroll
      for (int i = 0; i < 2; ++i)
#pragma unroll
        for (int j = 0; j < 2; ++j) acc[i][j] = MFMA(af[i], bq[j], acc[i][j]);
    }
    if (kt + 1 < nk) {
      *(uint4*)&s->a[buf ^ 1][r0][kv * 8] = ra0; *(uint4*)&s->a[buf ^ 1][r0 + 64][kv * 8] = ra1;
      *(uint4*)&s->b[buf ^ 1][r0][kv * 8] = rb0; *(uint4*)&s->b[buf ^ 1][r0 + 64][kv * 8] = rb1;
    }
    __syncthreads();
  }
}


struct GemmS2 { bf16_t a[128][72]; bf16_t b[128][72]; };
DI void g2_compute(f32x16 (&acc)[2][2], const GemmS2* s, int wr, int wc, int fr, int fh) {
#pragma unroll
  for (int ks = 0; ks < 4; ++ks) {
    bf16x8 af[2], bq[2];
#pragma unroll
    for (int i = 0; i < 2; ++i) af[i] = *(const bf16x8*)&s->a[wr * 64 + i * 32 + fr][ks * 16 + fh * 8];
#pragma unroll
    for (int j = 0; j < 2; ++j) bq[j] = *(const bf16x8*)&s->b[wc * 64 + j * 32 + fr][ks * 16 + fh * 8];
#pragma unroll
    for (int i = 0; i < 2; ++i)
#pragma unroll
      for (int j = 0; j < 2; ++j) acc[i][j] = MFMA(af[i], bq[j], acc[i][j]);
  }
}

template <class AF, class BF, class HK>
DI void gemm_core2(f32x16 (&acc)[2][2], GemmS2* s, AF aptr, BF bptr, int nk, HK hook) {
  int tid = threadIdx.x; asm volatile("" : "+v"(tid));
  const int lane = tid & 63, wave = tid >> 6, wr = wave >> 1, wc = wave & 1;
  const int r0 = tid >> 3, kc = tid & 7;
  const int fr = lane & 31, fh = lane >> 5;
  uint4 p0a0, p0a1, p0a2, p0a3, p0b0, p0b1, p0b2, p0b3, p1a0, p1a1, p1a2, p1a3, p1b0, p1b1, p1b2, p1b3;
#define G2_LOAD(S, KT) { \
    S##a0 = *(const uint4*)aptr((KT), r0, kc);      S##b0 = *(const uint4*)bptr((KT), r0, kc); \
    S##a1 = *(const uint4*)aptr((KT), r0 + 32, kc); S##b1 = *(const uint4*)bptr((KT), r0 + 32, kc); \
    S##a2 = *(const uint4*)aptr((KT), r0 + 64, kc); S##b2 = *(const uint4*)bptr((KT), r0 + 64, kc); \
    S##a3 = *(const uint4*)aptr((KT), r0 + 96, kc); S##b3 = *(const uint4*)bptr((KT), r0 + 96, kc); }
#define G2_STORE(S) { \
    *(uint4*)&s->a[r0][kc * 8] = S##a0;      *(uint4*)&s->b[r0][kc * 8] = S##b0; \
    *(uint4*)&s->a[r0 + 32][kc * 8] = S##a1; *(uint4*)&s->b[r0 + 32][kc * 8] = S##b1; \
    *(uint4*)&s->a[r0 + 64][kc * 8] = S##a2; *(uint4*)&s->b[r0 + 64][kc * 8] = S##b2; \
    *(uint4*)&s->a[r0 + 96][kc * 8] = S##a3; *(uint4*)&s->b[r0 + 96][kc * 8] = S##b3; }
#define G2_COMPUTE() g2_compute(acc, s, wr, wc, fr, fh);
  G2_LOAD(p0, 0)
  G2_LOAD(p1, 1)
  G2_STORE(p0)
  if (nk > 2) G2_LOAD(p0, 2)
  __syncthreads();
#pragma unroll 1
  for (int kt = 0; kt < nk; kt += 2) {
    hook(kt);
    G2_COMPUTE()
    __syncthreads();
    G2_STORE(p1)
    if (kt + 3 < nk) G2_LOAD(p1, kt + 3)
    __syncthreads();
    hook(kt + 1);
    G2_COMPUTE()
    __syncthreads();
    if (kt + 2 < nk) {
      G2_STORE(p0)
      if (kt + 4 < nk) G2_LOAD(p0, kt + 4)
    }
    __syncthreads();
  }
#undef G2_LOAD
#undef G2_STORE
#undef G2_COMPUTE
}


struct GemmS3 { bf16_t a[128][72]; bf16_t b[256][72]; };

template <class AF, class BF, class HK>
DI void gemm_core3(f32x16 (&acc)[2][4], GemmS3* s, AF aptr, BF bptr, int nk, HK hook) {
  int tid = threadIdx.x; asm volatile("" : "+v"(tid));
  const int lane = tid & 63, wave = tid >> 6, wr = wave >> 1, wc = wave & 1;
  const int r0 = tid >> 3, kc = tid & 7;
  const int fr = lane & 31, fh = lane >> 5;
  uint4 a0, a1, a2, a3, b0, b1, b2, b3, b4, b5, b6, b7;
#define G3_LOAD(KT) { \
    a0 = *(const uint4*)aptr((KT), r0, kc);       a1 = *(const uint4*)aptr((KT), r0 + 32, kc); \
    a2 = *(const uint4*)aptr((KT), r0 + 64, kc);  a3 = *(const uint4*)aptr((KT), r0 + 96, kc); \
    b0 = *(const uint4*)bptr((KT), r0, kc);       b1 = *(const uint4*)bptr((KT), r0 + 32, kc); \
    b2 = *(const uint4*)bptr((KT), r0 + 64, kc);  b3 = *(const uint4*)bptr((KT), r0 + 96, kc); \
    b4 = *(const uint4*)bptr((KT), r0 + 128, kc); b5 = *(const uint4*)bptr((KT), r0 + 160, kc); \
    b6 = *(const uint4*)bptr((KT), r0 + 192, kc); b7 = *(const uint4*)bptr((KT), r0 + 224, kc); }
#define G3_STORE() { \
    *(uint4*)&s->a[r0][kc * 8] = a0;       *(uint4*)&s->a[r0 + 32][kc * 8] = a1; \
    *(uint4*)&s->a[r0 + 64][kc * 8] = a2;  *(uint4*)&s->a[r0 + 96][kc * 8] = a3; \
    *(uint4*)&s->b[r0][kc * 8] = b0;       *(uint4*)&s->b[r0 + 32][kc * 8] = b1; \
    *(uint4*)&s->b[r0 + 64][kc * 8] = b2;  *(uint4*)&s->b[r0 + 96][kc * 8] = b3; \
    *(uint4*)&s->b[r0 + 128][kc * 8] = b4; *(uint4*)&s->b[r0 + 160][kc * 8] = b5; \
    *(uint4*)&s->b[r0 + 192][kc * 8] = b6; *(uint4*)&s->b[r0 + 224][kc * 8] = b7; }
  G3_LOAD(0)
  G3_STORE()
  __syncthreads();
#pragma unroll 1
  for (int kt = 0; kt < nk; ++kt) {
    if (kt + 1 < nk) G3_LOAD(kt + 1)
    hook(kt);
#pragma unroll
    for (int ks = 0; ks < 4; ++ks) {
      bf16x8 af[2], bq[4];
#pragma unroll
      for (int i = 0; i < 2; ++i) af[i] = *(const bf16x8*)&s->a[wr * 64 + i * 32 + fr][ks * 16 + fh * 8];
#pragma unroll
      for (int j = 0; j < 4; ++j) bq[j] = *(const bf16x8*)&s->b[wc * 128 + j * 32 + fr][ks * 16 + fh * 8];
#pragma unroll
      for (int i = 0; i < 2; ++i)
#pragma unroll
        for (int j = 0; j < 4; ++j) acc[i][j] = MFMA(af[i], bq[j], acc[i][j]);
    }
    __syncthreads();
    if (kt + 1 < nk) G3_STORE()
    __syncthreads();
  }
#undef G3_LOAD
#undef G3_STORE
}

template <class EPI>
DI void epilogue_lds2(f32x16 (&acc)[2][4], char* smem, int sub, EPI epi) {
  float* T = (float*)smem;
  int tid = threadIdx.x; asm volatile("" : "+v"(tid));
  const int lane = tid & 63, wave = tid >> 6, wr = wave >> 1, wc = wave & 1, fr = lane & 31, fh = lane >> 5;
#pragma unroll
  for (int i = 0; i < 2; ++i) {
    if (wc == sub) {
#pragma unroll
      for (int j = 0; j < 4; ++j)
#pragma unroll
        for (int r = 0; r < 16; ++r) T[(wr * 32 + crow(r, fh)) * 132 + j * 32 + fr] = acc[i][j][r];
    }
    __syncthreads();
#pragma unroll 2
    for (int e = tid; e < 2048; e += 256) {
      const int tr = e >> 5, c4 = (e & 31) * 4;
      const float4 v = *(const float4*)&T[tr * 132 + c4];
      epi((tr >> 5) * 64 + i * 32 + (tr & 31), c4, v);
    }
    __syncthreads();
  }
}

template <class EPI>
DI void epilogue_lds2w(f32x16 (&acc)[2][4], char* smem, int sub, EPI epi) {
  float* T = (float*)smem;
  int tid = threadIdx.x; asm volatile("" : "+v"(tid));
  const int lane = tid & 63, wave = tid >> 6, wr = wave >> 1, wc = wave & 1, fr = lane & 31, fh = lane >> 5;
#pragma unroll
  for (int i = 0; i < 2; ++i) {
    if (wc == sub) {
#pragma unroll
      for (int j = 0; j < 4; ++j)
#pragma unroll
        for (int r = 0; r < 16; ++r) T[(wr * 32 + crow(r, fh)) * 132 + j * 32 + fr] = acc[i][j][r];
    }
    __syncthreads();
#pragma unroll 2
    for (int e = tid; e < 1024; e += 256) {
      const int tr = e >> 4, c8 = (e & 15) * 8;
      const float4 lo = *(const float4*)&T[tr * 132 + c8];
      const float4 hi = *(const float4*)&T[tr * 132 + c8 + 4];
      epi((tr >> 5) * 64 + i * 32 + (tr & 31), c8, lo, hi);
    }
    __syncthreads();
  }
}

DI void epilogue_rope(f32x16 (&acc)[2][4], char* smem, int sub, bf16_t* dst, int ld, int cb, int row0, float sc) {
  float* T = (float*)smem;
  int tid = threadIdx.x; asm volatile("" : "+v"(tid));
  const int lane = tid & 63, wave = tid >> 6, wr = wave >> 1, wc = wave & 1, fr = lane & 31, fh = lane >> 5;
#pragma unroll
  for (int i = 0; i < 2; ++i) {
    if (wc == sub) {
#pragma unroll
      for (int j = 0; j < 4; ++j)
#pragma unroll
        for (int r = 0; r < 16; ++r) T[(wr * 32 + crow(r, fh)) * 132 + j * 32 + fr] = acc[i][j][r];
    }
    __syncthreads();
#pragma unroll 1
    for (int e = tid; e < 1024; e += 256) {
      const int tr = e >> 4, qi = e & 15;
      const int hd = qi >> 3, ax = (qi >> 2) & 1, f0 = (qi & 3) * 4;
      const int col1 = hd * 64 + ax * 32 + f0;
      const float4 v1 = *(const float4*)&T[tr * 132 + col1];
      const float4 v2 = *(const float4*)&T[tr * 132 + col1 + 16];
      const int rho = row0 + (tr >> 5) * 64 + i * 32 + (tr & 31);
      float a1[4] = {v1.x, v1.y, v1.z, v1.w}, a2[4] = {v2.x, v2.y, v2.z, v2.w}, o1[4], o2[4];
      if (rho < RL_) {
        const int t = rho & 4095;
        const float pos = (float)(ax == 0 ? (t >> 6) : (t & 63));
#pragma unroll
        for (int u = 0; u < 4; ++u) {
          const float ang = pos * __builtin_amdgcn_exp2f(-(float)(f0 + u) * 0.8304820237218406f);
          const float cs = __cosf(ang), sn = __sinf(ang);
          o1[u] = (a1[u] * cs - a2[u] * sn) * sc;
          o2[u] = (a2[u] * cs + a1[u] * sn) * sc;
        }
      } else {
#pragma unroll
        for (int u = 0; u < 4; ++u) { o1[u] = a1[u] * sc; o2[u] = a2[u] * sc; }
      }
      uint2 w1, w2;
      w1.x = pack2(o1[0], o1[1]); w1.y = pack2(o1[2], o1[3]);
      w2.x = pack2(o2[0], o2[1]); w2.y = pack2(o2[2], o2[3]);
      bf16_t* dp = dst + (size_t)rho * ld + cb + col1;
      *(uint2*)dp = w1;
      *(uint2*)(dp + 16) = w2;
    }
    __syncthreads();
  }
}

DI bool xcd_tile(int step, int nM, int nN, int& mt, int& nt) {
  const int xcd = blockIdx.x & 7, nloc = gridDim.x >> 3;
  const int j = (blockIdx.x >> 3) + step * nloc;
  const int mloc = nM >> 3;
  if ((gridDim.x & 7) != 0 || j >= mloc * nN) return false;
  const int per = 8 * nN;
  const int gm = j / per, rem = j - gm * per;
  const int hgt = min(8, mloc - gm * 8);
  const int a = rem % hgt;
  nt = rem / hgt;
  mt = (gm * 8 + a) * 8 + xcd;
  return true;
}

DI void zero_acc(f32x16 (&acc)[2][2]) {
#pragma unroll
  for (int i = 0; i < 2; ++i)
#pragma unroll
    for (int j = 0; j < 2; ++j)
#pragma unroll
      for (int r = 0; r < 16; ++r) acc[i][j][r] = 0.f;
}

template <class EPI>
DI void epilogue_lds(f32x16 (&acc)[2][2], char* smem, EPI epi) {
  float* T = (float*)smem;
  int tid = threadIdx.x; asm volatile("" : "+v"(tid)); const int lane = tid & 63, wave = tid >> 6, wr = wave >> 1, wc = wave & 1, fr = lane & 31, fh = lane >> 5;
#pragma unroll
  for (int i = 0; i < 2; ++i) {
#pragma unroll
    for (int j = 0; j < 2; ++j)
#pragma unroll
      for (int r = 0; r < 16; ++r) T[(wr * 32 + crow(r, fh)) * 132 + wc * 64 + j * 32 + fr] = acc[i][j][r];
    __syncthreads();
#pragma unroll 2
    for (int e = tid; e < 2048; e += 256) {
      const int tr = e >> 5, c4 = (e & 31) * 4;
      const float4 v = *(const float4*)&T[tr * 132 + c4];
      epi((tr >> 5) * 64 + i * 32 + (tr & 31), c4, v);
    }
    __syncthreads();
  }
}

template <class EPI>
DI void epilogue_ldsw(f32x16 (&acc)[2][2], char* smem, EPI epi) {
  float* T = (float*)smem;
  int tid = threadIdx.x; asm volatile("" : "+v"(tid));
  const int lane = tid & 63, wave = tid >> 6, wr = wave >> 1, wc = wave & 1, fr = lane & 31, fh = lane >> 5;
#pragma unroll
  for (int i = 0; i < 2; ++i) {
#pragma unroll
    for (int j = 0; j < 2; ++j)
#pragma unroll
      for (int r = 0; r < 16; ++r) T[(wr * 32 + crow(r, fh)) * 132 + wc * 64 + j * 32 + fr] = acc[i][j][r];
    __syncthreads();
#pragma unroll 2
    for (int e = tid; e < 1024; e += 256) {
      const int tr = e >> 4, c8 = (e & 15) * 8;
      const float4 lo = *(const float4*)&T[tr * 132 + c8];
      const float4 hi = *(const float4*)&T[tr * 132 + c8 + 4];
      epi((tr >> 5) * 64 + i * 32 + (tr & 31), c8, lo, hi);
    }
    __syncthreads();
  }
}

DI void phase_mods(const Params& p_in, char* smem) {
  const Params p = load_params();

  float* ssc = (float*)smem;
  float* red = (float*)(smem + 20480);
  float* mods = (float*)(p.ws + OFF_MODS);
  int tid = threadIdx.x; asm volatile("" : "+v"(tid));
  for (int it = blockIdx.x; it < 192; it += gridDim.x) {
    const int l = it / 96, col0 = (it % 96) * 32;
    __syncthreads();
    for (int e = tid; e < 5120; e += 256) {
      const int v = e >> 10, k = e & 1023;
      const float cv = (v < 4) ? p.c[v * 1024 + k] : p.c_ctx[k];
      ssc[e] = silu_f(cv);
    }
    __syncthreads();
    const int col = tid & 31, kg = tid >> 5;
    float a[5] = {0.f, 0.f, 0.f, 0.f, 0.f};
    const float* w = p.w_mod + (size_t)l * 1024 * 3072 + col0 + col;
    for (int k = kg * 128; k < kg * 128 + 128; k += 32) {
      float wv[32];
#pragma unroll
      for (int u = 0; u < 32; ++u) wv[u] = w[(size_t)(k + u) * 3072];
#pragma unroll
      for (int u = 0; u < 32; ++u)
#pragma unroll
        for (int v = 0; v < 5; ++v) a[v] += ssc[v * 1024 + k + u] * wv[u];
    }
#pragma unroll
    for (int v = 0; v < 5; ++v) red[(kg * 5 + v) * 32 + col] = a[v];
    __syncthreads();
    for (int e = tid; e < 160; e += 256) {
      const int v = e >> 5, cc = e & 31;
      float sum = p.b_mod[l * 3072 + col0 + cc];
      for (int g = 0; g < 8; ++g) sum += red[(g * 5 + v) * 32 + cc];
      mods[(l * 5 + v) * 3072 + col0 + cc] = sum;
    }
  }
}

DI int win_colmap(int n) {
  if (n < 2560) return n;
  if (n < 3840) return n + 32;
  if (n < 4864) {
    const int j = n - 3840, q64 = j >> 6, w = j & 63;
    return (w < 32) ? (3872 + q64 * 32 + w) : (3872 + 512 + q64 * 32 + (w - 32));
  }
  if (n < 5376) return n + 32;
  if (n < 5408) return n - 5376 + 2560;
  return -1;
}

DI void transpose_tile(const float* src, int ldsrc, int kind, const float* rowscale, bf16_t* dst, int lddst, int n0, int k0, float* tile) {
  int tid = threadIdx.x; asm volatile("" : "+v"(tid));
  __syncthreads();
  {
    const int c4 = (tid & 15) * 4, rr = tid >> 4;
    const int n = (kind == 0) ? win_colmap(n0 + c4) : (n0 + c4);
#pragma unroll
    for (int ps = 0; ps < 4; ++ps) {
      const int r = rr + ps * 16, k = k0 + r;
      float4 v = make_float4(0.f, 0.f, 0.f, 0.f);
      if (n >= 0) v = *(const float4*)(src + (size_t)k * ldsrc + n);
      if (rowscale != nullptr && k < 1024) { const float s = rowscale[k]; v.x *= s; v.y *= s; v.z *= s; v.w *= s; }
      tile[r * 65 + c4] = v.x; tile[r * 65 + c4 + 1] = v.y; tile[r * 65 + c4 + 2] = v.z; tile[r * 65 + c4 + 3] = v.w;
    }
  }
  __syncthreads();
  {
    const int k8 = (tid & 7) * 8, nn = tid >> 3;
#pragma unroll
    for (int ps = 0; ps < 2; ++ps) {
      const int r = nn + ps * 32;
      uint4 o;
      o.x = pack2(tile[(k8 + 0) * 65 + r], tile[(k8 + 1) * 65 + r]);
      o.y = pack2(tile[(k8 + 2) * 65 + r], tile[(k8 + 3) * 65 + r]);
      o.z = pack2(tile[(k8 + 4) * 65 + r], tile[(k8 + 5) * 65 + r]);
      o.w = pack2(tile[(k8 + 6) * 65 + r], tile[(k8 + 7) * 65 + r]);
      *(uint4*)(dst + (size_t)(n0 + r) * lddst + k0 + k8) = o;
    }
  }
}

DI void phase_prep(const Params& p_in, int l, char* smem) {
  const Params p = load_params();

  int tid = threadIdx.x; asm volatile("" : "+v"(tid)); const int lane = tid & 63, wave = tid >> 6;
  const float* mods = (const float*)(p.ws + OFF_MODS);
  bf16_t* H = (bf16_t*)(p.ws + OFF_H);
  const int NT_WIN = 88 * 16, NT_WOUT = 16 * 32, NT_PW = 64, NT_CONV = NT_WIN + NT_WOUT + NT_PW;
  const int NT = NT_CONV + R_ / 8;
  for (int it = blockIdx.x; it < NT; it += gridDim.x) {
    if (l == 1 && (it < NT_WIN || (it >= NT_WIN + NT_WOUT && it < NT_CONV))) continue;
    if (it < NT_WIN) {
      transpose_tile(p.w_in + (size_t)l * 1024 * 5408, 5408, 0, nullptr, (bf16_t*)(p.ws + OFF_WIN), 1024, (it / 16) * 64, (it % 16) * 64, (float*)smem);
    } else if (it < NT_WIN + NT_WOUT) {
      const int t = it - NT_WIN;
      transpose_tile(p.w_out + (size_t)l * 2048 * 1024, 1024, 1, p.ssd_norm_w + l * 1024, (bf16_t*)(p.ws + OFF_WOUT), 2048, (t / 32) * 64, (t % 32) * 64, (float*)smem);
    } else if (it < NT_CONV) {
      const int t = it - NT_WIN - NT_WOUT;
      transpose_tile(p.conv_pw_w + (size_t)l * 512 * 512, 512, 1, nullptr, (bf16_t*)(p.ws + OFF_PW), 512, (t / 8) * 64, (t % 8) * 64, (float*)smem);
    } else {
      const int rho0 = (it - NT_CONV) * 8 + wave * 2;
      const float* xs0;
      if (l == 0) xs0 = (rho0 < RL_) ? (p.x + (size_t)rho0 * 1024) : (p.ctx + (size_t)(rho0 - RL_) * 1024);
      else xs0 = (rho0 < RL_) ? (p.out + (size_t)rho0 * 1024) : ((const float*)(p.ws + OFF_XC) + (size_t)(rho0 - RL_) * 1024);
      const int v = (rho0 < RL_) ? (rho0 >> 12) : 4;
      const float* md = mods + (l * 5 + v) * 3072;
      float4 xv[2][4], nwv[4], shv[4], scv4[4];
#pragma unroll
      for (int i = 0; i < 4; ++i) {
        const int cidx = lane * 4 + i * 256;
        xv[0][i] = *(const float4*)(xs0 + cidx);
        xv[1][i] = *(const float4*)(xs0 + 1024 + cidx);
        nwv[i] = *(const float4*)(p.norm_w + l * 1024 + cidx);
        shv[i] = *(const float4*)(md + cidx);
        scv4[i] = *(const float4*)(md + 1024 + cidx);
      }
#pragma unroll
      for (int q = 0; q < 2; ++q) {
        float ss = 0.f;
#pragma unroll
        for (int i = 0; i < 4; ++i) ss += xv[q][i].x * xv[q][i].x + xv[q][i].y * xv[q][i].y + xv[q][i].z * xv[q][i].z + xv[q][i].w * xv[q][i].w;
#pragma unroll
        for (int o = 32; o >= 1; o >>= 1) ss += __shfl_xor(ss, o);
        const float rs = rsqrtf(ss * (1.f / 1024.f) + 1e-6f);
#pragma unroll
        for (int i = 0; i < 4; ++i) {
          const int cidx = lane * 4 + i * 256;
          const float4 nw = nwv[i], sh = shv[i], sc = scv4[i];
          uint2 o;
          o.x = pack2(xv[q][i].x * rs * nw.x * (1.f + sc.x) + sh.x, xv[q][i].y * rs * nw.y * (1.f + sc.y) + sh.y);
          o.y = pack2(xv[q][i].z * rs * nw.z * (1.f + sc.z) + sh.z, xv[q][i].w * rs * nw.w * (1.f + sc.w) + sh.w);
          *(uint2*)(H + (size_t)(rho0 + q) * 1024 + cidx) = o;
        }
      }
    }
  }
}

DI void phase_inproj(const Params& p_in, char* smem) {
  const Params p = load_params();
  int tid = threadIdx.x; asm volatile("" : "+v"(tid)); const int wave = tid >> 6, wc = wave & 1;
  const bf16_t* H = (const bf16_t*)(p.ws + OFF_H);
  const bf16_t* W = (const bf16_t*)(p.ws + OFF_WIN);
  for (int step = 0;; ++step) {
    int mt, nt2;
    if (!xcd_tile(step, NCK, 22, mt, nt2)) break;
    f32x16 acc[2][4];
#pragma unroll
    for (int i = 0; i < 2; ++i)
#pragma unroll
      for (int j = 0; j < 4; ++j)
#pragma unroll
        for (int r = 0; r < 16; ++r) acc[i][j][r] = 0.f;
    const bf16_t* Ab = H + (size_t)mt * 128 * 1024;
    const bf16_t* Bb = W + (size_t)nt2 * 256 * 1024;
    gemm_core3(acc, (GemmS3*)smem,
               [&](int kt, int r, int kv) { return Ab + (size_t)r * 1024 + kt * 64 + kv * 8; },
               [&](int kt, int r, int kv) { return Bb + (size_t)r * 1024 + kt * 64 + kv * 8; }, 16, [](int) {});
    const int row0 = mt * 128;
    {
      const int ntw = nt2 * 2 + wc;
      if (ntw >= 30 && ntw < 38) {
#pragma unroll
        for (int i = 0; i < 2; ++i)
#pragma unroll
          for (int r = 0; r < 16; ++r) {
            acc[i][0][r] = acc[i][0][r] * sigmoid_f(acc[i][1][r]);
            acc[i][2][r] = acc[i][2][r] * sigmoid_f(acc[i][3][r]);
          }
      }
    }
#pragma unroll 1
    for (int sub = 0; sub < 2; ++sub) {
      const int nt = nt2 * 2 + sub;
      if (nt >= 43) break;
      if (nt >= 30 && nt < 38) {
        bf16_t* G = (bf16_t*)(p.ws + OFF_GLU);
        const int cb0 = (nt - 30) * 64;
        epilogue_lds2w(acc, smem, sub, [&](int rl, int c8, float4 lo, float4 hi) {
          if ((c8 & 32) == 0) {
            uint4 o; o.x = pack2(lo.x, lo.y); o.y = pack2(lo.z, lo.w); o.z = pack2(hi.x, hi.y); o.w = pack2(hi.z, hi.w);
            *(uint4*)(G + (size_t)(row0 + rl) * 512 + cb0 + (c8 >> 6) * 32 + (c8 & 31)) = o;
          }
        });
      } else if (nt >= 20 && nt < 24) {
        epilogue_rope(acc, smem, sub, (bf16_t*)(p.ws + OFF_Q), 512, nt * 128 - 2560, row0, 0.18033688011112042f);
      } else if (nt == 24) {
        epilogue_rope(acc, smem, sub, (bf16_t*)(p.ws + OFF_KV), 256, 0, row0, 1.f);
      } else if (nt == 42) {
        float* DT = (float*)(p.ws + OFF_DT);
        epilogue_lds2(acc, smem, sub, [&](int rl, int c4, float4 v) {
          if (c4 < 32) *(float4*)(DT + (size_t)(row0 + rl) * 32 + c4) = v;
        });
      } else {
        bf16_t* dst; int ld, cb;
        if (nt < 12) { dst = (bf16_t*)(p.ws + OFF_XBC); ld = 1536; cb = nt * 128; }
        else if (nt < 20) { dst = (bf16_t*)(p.ws + OFF_Z); ld = 1024; cb = nt * 128 - 1536; }
        else if (nt < 24) { dst = (bf16_t*)(p.ws + OFF_Q); ld = 512; cb = nt * 128 - 2560; }
        else if (nt < 26) { dst = (bf16_t*)(p.ws + OFF_KV); ld = 256; cb = nt * 128 - 3072; }
        else if (nt < 30) { dst = (bf16_t*)(p.ws + OFF_AG); ld = 512; cb = nt * 128 - 3328; }
        else { dst = (bf16_t*)(p.ws + OFF_CG); ld = 512; cb = nt * 128 - 4864; }
        epilogue_lds2w(acc, smem, sub, [&](int rl, int c8, float4 lo, float4 hi) {
          uint4 o; o.x = pack2(lo.x, lo.y); o.y = pack2(lo.z, lo.w); o.z = pack2(hi.x, hi.y); o.w = pack2(hi.z, hi.w);
          *(uint4*)(dst + (size_t)(row0 + rl) * ld + cb + c8) = o;
        });
      }
    }
  }
}

DI void phase_local(const Params& p_in, int l, char* smem) {
  const Params p = load_params();

  int tid = threadIdx.x; asm volatile("" : "+v"(tid)); const int lane = tid & 63;
  const bf16_t* XBC = (const bf16_t*)(p.ws + OFF_XBC);
  bf16_t* XS = (bf16_t*)(p.ws + OFF_H);
  bf16_t* BC = (bf16_t*)(p.ws + OFF_BC);
  float* DT = (float*)(p.ws + OFF_DT);
  float* CS = (float*)(p.ws + OFF_CS);
  const bf16_t* GLU = (const bf16_t*)(p.ws + OFF_GLU);
  bf16_t* HDN = (bf16_t*)(p.ws + OFF_HDN);
  bf16_t* Q = (bf16_t*)(p.ws + OFF_Q);
  bf16_t* KV = (bf16_t*)(p.ws + OFF_KV);
  { float* SSQ = (float*)(p.ws + OFF_RSTD); for (int i = blockIdx.x * 256 + tid; i < R_ * 2; i += gridDim.x * 256) SSQ[i] = 0.f; }
  const int N_CONV = (R_ / 4) * 192 / 256;
  const int N_DT = NCK;
  const int N_CF = R_ / 16;
  const int N_ROPE = 0;
  const int N_QC = 0;
  const int NT = N_CF + N_DT + N_CONV + N_ROPE + N_QC;
  for (int it0 = blockIdx.x; it0 < NT; it0 += gridDim.x) {
    int it = it0;
    if (it < N_CF) {
      float* sst = (float*)smem;
      unsigned* sIn = (unsigned*)(smem + 256);
      const int row0 = it * 16;
      const int seq0 = (row0 < RL_) ? (row0 & ~4095) : (RL_ + ((row0 - RL_) & ~255));
      const int slen = (row0 < RL_) ? 4096 : 256;
      const int t0 = row0 - seq0;
      const int c0 = tid * 2;
      __syncthreads();
      if (tid < 32) sst[tid] = 0.f;
      for (int idx = tid; idx < 46 * 64; idx += 256) {
        const int rr = idx >> 6, c16 = idx & 63;
        const int tt = t0 - 15 + rr;
        uint4 val = make_uint4(0u, 0u, 0u, 0u);
        if (tt >= 0 && tt < slen) val = *(const uint4*)(GLU + (size_t)(seq0 + tt) * 512 + c16 * 8);
        *(uint4*)&sIn[rr * 256 + c16 * 4] = val;
      }
      float w0[31], w1[31];
#pragma unroll
      for (int k = 0; k < 31; ++k) {
        const float2 wv = *(const float2*)(p.conv_dw_w + ((size_t)l * 31 + k) * 512 + c0);
        w0[k] = wv.x; w1[k] = wv.y;
      }
      const float2 bv = *(const float2*)(p.conv_dw_b + l * 512 + c0);
      float a0[16], a1[16];
#pragma unroll
      for (int r = 0; r < 16; ++r) { a0[r] = bv.x; a1[r] = bv.y; }
      __syncthreads();
#pragma unroll
      for (int tp = 0; tp < 46; ++tp) {
        const unsigned u = sIn[tp * 256 + tid];
        const float x0 = lo2f(u), x1 = hi2f(u);
#pragma unroll
        for (int r = 0; r < 16; ++r) {
          const int k = tp - r;
          if (k >= 0 && k < 31) { a0[r] += w0[k] * x0; a1[r] += w1[k] * x1; }
        }
        if ((tp & 7) == 7) __builtin_amdgcn_sched_barrier(0);
      }
      {
        float v[32];
#pragma unroll
        for (int r = 0; r < 16; ++r) { v[2 * r] = a0[r] + a1[r]; v[2 * r + 1] = a0[r] * a0[r] + a1[r] * a1[r]; }
#pragma unroll
        for (int i = 0; i < 16; ++i) { const bool up = (lane & 32) != 0; const float keep = up ? v[i + 16] : v[i]; const float send = up ? v[i] : v[i + 16]; v[i] = keep + __shfl_xor(send, 32); }
#pragma unroll
        for (int i = 0; i < 8; ++i) { const bool up = (lane & 16) != 0; const float keep = up ? v[i + 8] : v[i]; const float send = up ? v[i] : v[i + 8]; v[i] = keep + __shfl_xor(send, 16); }
#pragma unroll
        for (int i = 0; i < 4; ++i) { const bool up = (lane & 8) != 0; const float keep = up ? v[i + 4] : v[i]; const float send = up ? v[i] : v[i + 4]; v[i] = keep + __shfl_xor(send, 8); }
#pragma unroll
        for (int i = 0; i < 2; ++i) { const bool up = (lane & 4) != 0; const float keep = up ? v[i + 2] : v[i]; const float send = up ? v[i] : v[i + 2]; v[i] = keep + __shfl_xor(send, 4); }
        { const bool up = (lane & 2) != 0; const float keep = up ? v[1] : v[0]; const float send = up ? v[0] : v[1]; v[0] = keep + __shfl_xor(send, 2); }
        v[0] += __shfl_xor(v[0], 1);
        __syncthreads();
        if ((lane & 1) == 0) atomicAdd(&sst[lane >> 1], v[0]);
      }
      __syncthreads();
      const float2 lw = *(const float2*)(p.conv_ln_w + l * 512 + c0);
      const float2 lb = *(const float2*)(p.conv_ln_b + l * 512 + c0);
#pragma unroll
      for (int r = 0; r < 16; ++r) {
        const float mean = sst[r * 2] * (1.f / 512.f);
        const float var = fmaxf(sst[r * 2 + 1] * (1.f / 512.f) - mean * mean, 0.f);
        const float rs = rsqrtf(var + 1e-6f);
        const float y0 = (a0[r] - mean) * rs * lw.x + lb.x;
        const float y1 = (a1[r] - mean) * rs * lw.y + lb.y;
        *(unsigned*)(HDN + (size_t)(row0 + r) * 512 + c0) = pack2(silu_f(y0), silu_f(y1));
        if ((r & 3) == 3) __builtin_amdgcn_sched_barrier(0);
      }
      continue;
    }
    it -= N_CF;
    if (it < N_DT) {
      float* sdt = (float*)smem;
      float* ssum = (float*)(smem + 128 * 33 * 4);
      const int row0 = it * 128;
      __syncthreads();
      for (int e = tid; e < 4096; e += 256) {
        const int r = e >> 5, cidx = e & 31;
        const float raw = DT[(size_t)(row0 + r) * 32 + cidx] + p.ssd_dt_bias[l * 32 + cidx];
        const float sp = (raw > 20.f) ? raw : __logf(1.f + __expf(raw));
        DT[(size_t)(row0 + r) * 32 + cidx] = sp;
        sdt[r * 33 + cidx] = sp;
      }
      __syncthreads();
      const int col = tid & 31, seg = tid >> 5;
      const float a = -expf(p.ssd_a_log[l * 32 + col]);
      float loc[16];
      float run = 0.f;
      if (col < 16) {
#pragma unroll
        for (int r = 0; r < 16; ++r) { run += sdt[(seg * 16 + r) * 33 + col] * a; loc[r] = run; }
      } else {
#pragma unroll
        for (int r = 15; r >= 0; --r) { run += sdt[(seg * 16 + r) * 33 + col] * a; loc[r] = run; }
      }
      ssum[seg * 32 + col] = run;
      __syncthreads();
      float off = 0.f;
      if (col < 16) { for (int s2 = 0; s2 < seg; ++s2) off += ssum[s2 * 32 + col]; }
      else { for (int s2 = 7; s2 > seg; --s2) off += ssum[s2 * 32 + col]; }
#pragma unroll
      for (int r = 0; r < 16; ++r) CS[(size_t)(row0 + seg * 16 + r) * 32 + col] = off + loc[r];
      continue;
    }
    it -= N_DT;
    if (it < N_CONV) {
      const int e = it * 256 + tid;
      const int rb = e / 192, cgp = e % 192, ch0 = cgp * 8;
      const int rho0 = rb * 4;
      const int seq0 = (rho0 < RL_) ? (rho0 & ~4095) : (RL_ + ((rho0 - RL_) & ~255));
      const int slen = (rho0 < RL_) ? 4096 : 256;
      const int t0 = rho0 - seq0;
      uint4 xr[8];
#pragma unroll
      for (int i = 0; i < 8; ++i) {
        const int tt = t0 + i - 2;
        xr[i] = make_uint4(0u, 0u, 0u, 0u);
        if (tt >= 0 && tt < slen) xr[i] = *(const uint4*)(XBC + (size_t)(seq0 + tt) * 1536 + ch0);
      }
      float wk[5][8];
#pragma unroll
      for (int k = 0; k < 5; ++k) {
        const float4 w0 = *(const float4*)(p.ssd_conv_w + ((size_t)l * 5 + k) * 1536 + ch0);
        const float4 w1 = *(const float4*)(p.ssd_conv_w + ((size_t)l * 5 + k) * 1536 + ch0 + 4);
        wk[k][0] = w0.x; wk[k][1] = w0.y; wk[k][2] = w0.z; wk[k][3] = w0.w; wk[k][4] = w1.x; wk[k][5] = w1.y; wk[k][6] = w1.z; wk[k][7] = w1.w;
      }
      float bias[8];
      {
        const float4 b0 = *(const float4*)(p.ssd_conv_b + l * 1536 + ch0);
        const float4 b1 = *(const float4*)(p.ssd_conv_b + l * 1536 + ch0 + 4);
        bias[0] = b0.x; bias[1] = b0.y; bias[2] = b0.z; bias[3] = b0.w; bias[4] = b1.x; bias[5] = b1.y; bias[6] = b1.z; bias[7] = b1.w;
      }
#pragma unroll
      for (int r = 0; r < 4; ++r) {
        float a[8];
#pragma unroll
        for (int c = 0; c < 8; ++c) a[c] = bias[c];
#pragma unroll
        for (int k = 0; k < 5; ++k) {
          const uint4 u = xr[r + k];
          a[0] += wk[k][0] * lo2f(u.x); a[1] += wk[k][1] * hi2f(u.x); a[2] += wk[k][2] * lo2f(u.y); a[3] += wk[k][3] * hi2f(u.y);
          a[4] += wk[k][4] * lo2f(u.z); a[5] += wk[k][5] * hi2f(u.z); a[6] += wk[k][6] * lo2f(u.w); a[7] += wk[k][7] * hi2f(u.w);
        }
        uint4 o;
        o.x = pack2(silu_f(a[0]), silu_f(a[1])); o.y = pack2(silu_f(a[2]), silu_f(a[3]));
        o.z = pack2(silu_f(a[4]), silu_f(a[5])); o.w = pack2(silu_f(a[6]), silu_f(a[7]));
        const size_t rho = (size_t)(rho0 + r);
        if (ch0 < 1024) *(uint4*)(XS + rho * 1024 + ch0) = o;
        else *(uint4*)(BC + rho * 512 + (ch0 - 1024)) = o;
      }
      continue;
    }
    it -= N_CONV;
    if (it < N_ROPE) {
      const int e = it * 256 + tid;
      const int rho = e / 40, rem = e % 40, hd = rem >> 2, sub = rem & 3;
      const int axis = sub >> 1, half = sub & 1;
      const int t = rho & 4095;
      const float pos = (float)(axis == 0 ? (t >> 6) : (t & 63));
      bf16_t* base = ((hd < 8) ? (Q + (size_t)rho * 512 + hd * 64) : (KV + (size_t)rho * 256 + (hd - 8) * 64)) + axis * 32 + half * 8;
      const float sc = (hd < 8) ? 0.18033688011112042f : 1.f;
      const uint4 u1 = *(const uint4*)base, u2 = *(const uint4*)(base + 16);
      const unsigned a1[4] = {u1.x, u1.y, u1.z, u1.w}, a2[4] = {u2.x, u2.y, u2.z, u2.w};
      unsigned o1[4], o2[4];
#pragma unroll
      for (int i = 0; i < 4; ++i) {
        float r1[2], r2[2];
#pragma unroll
        for (int hl = 0; hl < 2; ++hl) {
          const float f = (float)(half * 8 + 2 * i + hl);
          const float ang = pos * exp2f(-f * 0.8304820237218406f);
          const float cs = __cosf(ang), sn = __sinf(ang);
          const float t1 = hl ? hi2f(a1[i]) : lo2f(a1[i]);
          const float t2 = hl ? hi2f(a2[i]) : lo2f(a2[i]);
          r1[hl] = (t1 * cs - t2 * sn) * sc;
          r2[hl] = (t2 * cs + t1 * sn) * sc;
        }
        o1[i] = pack2(r1[0], r1[1]); o2[i] = pack2(r2[0], r2[1]);
      }
      *(uint4*)base = make_uint4(o1[0], o1[1], o1[2], o1[3]);
      *(uint4*)(base + 16) = make_uint4(o2[0], o2[1], o2[2], o2[3]);
      continue;
    }
    it -= N_ROPE;
    {
      const int e = it * 256 + tid;
      const int rho = RL_ + e / 256, c2 = (e % 256) * 2;
      unsigned* ptr = (unsigned*)(Q + (size_t)rho * 512 + c2);
      const unsigned u = *ptr;
      *ptr = pack2(lo2f(u) * 0.18033688011112042f, hi2f(u) * 0.18033688011112042f);
    }
  }
}

DI void attn_item(const Params& p_in, int l, char* smem, int b, int qblk, int g, int hp, bool ctxq) {
  const Params p = load_params();

  bf16_t* sK = (bf16_t*)smem;
  bf16_t* sV = (bf16_t*)(smem + 128 * 72 * 2);
  int tid = threadIdx.x; asm volatile("" : "+v"(tid)); const int lane = tid & 63, wave = tid >> 6, fr = lane & 31, fh = lane >> 5;
  const int head = g * 4 + hp * 2 + (wave >> 1);
  const int qh = wave & 1;
  const int qrow0 = (ctxq ? (RL_ + b * 256) : (b * 4096)) + qblk * 128 + qh * 64;
  const int qpos0 = qblk * 128 + qh * 64;
  bf16_t* Q = (bf16_t*)(p.ws + OFF_Q);
  const bf16_t* KV = (const bf16_t*)(p.ws + OFF_KV);
  const bf16_t* AG = (const bf16_t*)(p.ws + OFF_AG);
  f32x16 o[2][2];
  zero_acc(o);
  float m[2], lsum[2];
  m[0] = m[1] = p.attn_sink[l * 8 + head] * 1.4426950408889634f;
  lsum[0] = lsum[1] = 1.f;
  const int nhb = ctxq ? 4 : 10;
  auto hb_row = [&](int hb) -> int {
    if (hb >= nhb) return -1;
    if (hb < 4) return RL_ + b * 256 + hb * 64;
    const int kp = (qblk - 1) * 128 + (hb - 4) * 64;
    if (kp < 0 || kp >= 4096) return -1;
    return b * 4096 + kp;
  };
  auto hb_next = [&](int hb) -> int { int n = hb + 1; while (n < nhb && hb_row(n) < 0) ++n; return n; };
  const int sr = tid >> 3, scv = tid & 7;
  uint4 kp0, kp1, vp0, vp1;
#define ATT_PREFETCH(ROW0) { const bf16_t* kvp = KV + (size_t)((ROW0) + sr) * 256 + g * 64 + scv * 8; \
    kp0 = *(const uint4*)(kvp); kp1 = *(const uint4*)(kvp + 32 * 256); vp0 = *(const uint4*)(kvp + 128); vp1 = *(const uint4*)(kvp + 128 + 32 * 256); }
#define ATT_STORE(BUF) { bf16_t* k_ = sK + (BUF) * 64 * 72; bf16_t* v_ = sV + (BUF) * 64 * 72; \
    *(uint4*)&k_[sr * 72 + scv * 8] = kp0; *(uint4*)&k_[(sr + 32) * 72 + scv * 8] = kp1; \
    *(uint4*)&v_[sr * 72 + scv * 8] = vp0; *(uint4*)&v_[(sr + 32) * 72 + scv * 8] = vp1; }
  int pbuf = 0;
  __syncthreads();
  ATT_PREFETCH(hb_row(0))
  ATT_STORE(0)
  __syncthreads();
  for (int hb = 0; hb < nhb; hb = hb_next(hb)) {
    const int nxt = hb_next(hb);
    if (nxt < nhb) ATT_PREFETCH(hb_row(nxt))
    int kpos0 = 0;
    bool masked = false;
    if (hb >= 4) { kpos0 = (qblk - 1) * 128 + (hb - 4) * 64; masked = (hb != 6 && hb != 7); }
    const bf16_t* cK = sK + pbuf * 64 * 72;
    const bf16_t* cV = sV + pbuf * 64 * 72;
    bf16x8 qf[2][4];
#pragma unroll
    for (int j = 0; j < 2; ++j)
#pragma unroll
      for (int ks = 0; ks < 4; ++ks)
        qf[j][ks] = *(const bf16x8*)(Q + (size_t)(qrow0 + j * 32 + fr) * 512 + head * 64 + ks * 16 + fh * 8);
#pragma unroll 1
    for (int kb = 0; kb < 2; ++kb) {
      if (masked) {
        const int klo = kpos0 + kb * 32, khi = klo + 31;
        if (klo - (qpos0 + 63) > 128 || qpos0 - khi > 128) continue;
      }
      bf16x8 pb[2][2];
#pragma unroll
      for (int j = 0; j < 2; ++j) {
        f32x16 st[2];
#pragma unroll
        for (int r = 0; r < 16; ++r) st[j][r] = -m[j];
#pragma unroll
        for (int ks = 0; ks < 4; ++ks) {
          const bf16x8 kf = *(const bf16x8*)&cK[(kb * 32 + fr) * 72 + ks * 16 + fh * 8];
          st[j] = MFMA(kf, qf[j][ks], st[j]);
        }
        if (masked) {
          const int qpos = qpos0 + j * 32 + fr;
#pragma unroll
          for (int r = 0; r < 16; ++r) {
            const int d = qpos - (kpos0 + kb * 32 + crow(r, fh));
            if (d > 128 || d < -128) st[j][r] = -1e30f;
          }
        }
        float mx = st[j][0];
#pragma unroll
        for (int r = 1; r < 16; ++r) mx = fmaxf(mx, st[j][r]);
        mx = xhalf_max(mx);
        const bool grow = mx > 8.f;
        if (__builtin_amdgcn_ballot_w64(grow) != 0ull) {
          const float delta = grow ? mx : 0.f;
          const float alpha = __builtin_amdgcn_exp2f(-delta);
#pragma unroll
          for (int r = 0; r < 16; ++r) st[j][r] -= delta;
          lsum[j] *= alpha;
          m[j] += delta;
#pragma unroll
          for (int mt = 0; mt < 2; ++mt)
#pragma unroll
            for (int r = 0; r < 16; ++r) o[mt][j][r] *= alpha;
        }
        float rs = 0.f;
#pragma unroll
        for (int r = 0; r < 16; ++r) { const float pv = __builtin_amdgcn_exp2f(st[j][r]); st[j][r] = pv; rs += pv; }
        rs = xhalf_sum(rs);
        lsum[j] += rs;
#pragma unroll
        for (int s = 0; s < 2; ++s) {
          uint4 pk;
          pk.x = pack2(st[j][8 * s + 0], st[j][8 * s + 1]); pk.y = pack2(st[j][8 * s + 2], st[j][8 * s + 3]);
          pk.z = pack2(st[j][8 * s + 4], st[j][8 * s + 5]); pk.w = pack2(st[j][8 * s + 6], st[j][8 * s + 7]);
          pb[j][s] = __builtin_bit_cast(bf16x8, pk);
        }
      }
#pragma unroll
      for (int s = 0; s < 2; ++s)
#pragma unroll
        for (int mt = 0; mt < 2; ++mt) {
          const bf16x8 vf = tr_frag(cV, 72, kb * 32 + 16 * s + 4 * fh, kb * 32 + 16 * s + 8 + 4 * fh, mt * 32);
#pragma unroll
          for (int j = 0; j < 2; ++j) o[mt][j] = MFMA(vf, pb[j][s], o[mt][j]);
        }
    }
    if (nxt < nhb) ATT_STORE(pbuf ^ 1)
    pbuf ^= 1;
    __syncthreads();
  }
#undef ATT_PREFETCH
#undef ATT_STORE
#pragma unroll
  for (int j = 0; j < 2; ++j) {
    const float inv = 1.f / lsum[j];
    const size_t rho = (size_t)(qrow0 + j * 32 + fr);
#pragma unroll
    for (int mt = 0; mt < 2; ++mt)
#pragma unroll
      for (int g4 = 0; g4 < 4; ++g4) {
        const int d0 = mt * 32 + 8 * g4 + 4 * fh;
        const uint2 gv = *(const uint2*)(AG + rho * 512 + head * 64 + d0);
        uint2 ov;
        ov.x = pack2(o[mt][j][g4 * 4 + 0] * inv * silu_f(lo2f(gv.x)), o[mt][j][g4 * 4 + 1] * inv * silu_f(hi2f(gv.x)));
        ov.y = pack2(o[mt][j][g4 * 4 + 2] * inv * silu_f(lo2f(gv.y)), o[mt][j][g4 * 4 + 3] * inv * silu_f(hi2f(gv.y)));
        *(uint2*)(Q + rho * 512 + head * 64 + d0) = ov;
      }
  }
}

DI void states_item(const Params& p_in, char* smem, int ck, int g, int hq) {
  const Params p = load_params();

  bf16_t* sB = (bf16_t*)smem;
  bf16_t* sX = (bf16_t*)(smem + 128 * 136 * 2);
  int tid = threadIdx.x; asm volatile("" : "+v"(tid)); const int lane = tid & 63, wave = tid >> 6, wr = wave >> 1, wc = wave & 1, fr = lane & 31, fh = lane >> 5;
  const bf16_t* BC = (const bf16_t*)(p.ws + OFF_BC);
  const bf16_t* XS = (const bf16_t*)(p.ws + OFF_H);
  const float* DT = (const float*)(p.ws + OFF_DT);
  const float* CS = (const float*)(p.ws + OFF_CS);
  bf16_t* ST = (bf16_t*)(p.ws + OFF_ST);
  float* CDEC = (float*)(p.ws + OFF_CDEC);
  const int row0 = ck * 128;
  __syncthreads();
  for (int v = tid; v < 2048; v += 256) {
    const int r = v >> 4, cv = v & 15;
    *(uint4*)&sB[r * 136 + cv * 8] = *(const uint4*)(BC + (size_t)(row0 + r) * 512 + g * 128 + cv * 8);
  }
  __syncthreads();
  bf16x8 bfr[2][8];
#pragma unroll
  for (int j = 0; j < 2; ++j)
#pragma unroll
    for (int ks = 0; ks < 8; ++ks) bfr[j][ks] = tr_frag(sB, 136, ks * 16 + 8 * fh, ks * 16 + 8 * fh + 4, wc * 64 + j * 32);
  const int slr = tid >> 3, scv = tid & 7;
  uint4 xq0, xq1, xq2, xq3;
  float dq0, dq1, dq2, dq3, cq0, cq1, cq2, cq3, cendq;
#define ST_PREFETCH(HD) { const int head_ = g * 8 + hq * 4 + ((HD) >> 1), d_ = (HD) & 1, col_ = d_ * 16 + head_; \
    const bf16_t* xp_ = XS + (size_t)(row0 + slr) * 1024 + head_ * 64 + scv * 8; \
    xq0 = *(const uint4*)(xp_); xq1 = *(const uint4*)(xp_ + 32 * 1024); xq2 = *(const uint4*)(xp_ + 64 * 1024); xq3 = *(const uint4*)(xp_ + 96 * 1024); \
    const size_t rb_ = (size_t)(row0 + slr) * 32 + col_; \
    dq0 = DT[rb_]; dq1 = DT[rb_ + 32 * 32]; dq2 = DT[rb_ + 64 * 32]; dq3 = DT[rb_ + 96 * 32]; \
    cq0 = CS[rb_]; cq1 = CS[rb_ + 32 * 32]; cq2 = CS[rb_ + 64 * 32]; cq3 = CS[rb_ + 96 * 32]; \
    cendq = CS[(size_t)(row0 + (d_ == 0 ? 127 : 0)) * 32 + col_]; }
#define ST_SCALE_STORE(X, DTV, CSV, ROW) { const float sc_ = (DTV) * __expf(cend - (CSV)); uint4 o_; \
    o_.x = pack2(lo2f(X.x) * sc_, hi2f(X.x) * sc_); o_.y = pack2(lo2f(X.y) * sc_, hi2f(X.y) * sc_); \
    o_.z = pack2(lo2f(X.z) * sc_, hi2f(X.z) * sc_); o_.w = pack2(lo2f(X.w) * sc_, hi2f(X.w) * sc_); \
    *(uint4*)&sX[(ROW) * 72 + scv * 8] = o_; }
  ST_PREFETCH(0)
#pragma unroll 1
  for (int hd = 0; hd < 8; ++hd) {
    const int head = g * 8 + hq * 4 + (hd >> 1), d = hd & 1;
    const float cend = cendq;
    ST_SCALE_STORE(xq0, dq0, cq0, slr)
    ST_SCALE_STORE(xq1, dq1, cq1, slr + 32)
    ST_SCALE_STORE(xq2, dq2, cq2, slr + 64)
    ST_SCALE_STORE(xq3, dq3, cq3, slr + 96)
    if (hd < 7) ST_PREFETCH(hd + 1)
    __syncthreads();
    f32x16 acc[2];
#pragma unroll
    for (int j = 0; j < 2; ++j)
#pragma unroll
      for (int r = 0; r < 16; ++r) acc[j][r] = 0.f;
#pragma unroll
    for (int ks = 0; ks < 8; ++ks) {
      const bf16x8 af = tr_frag(sX, 72, ks * 16 + 8 * fh, ks * 16 + 8 * fh + 4, wr * 32);
#pragma unroll
      for (int j = 0; j < 2; ++j) acc[j] = MFMA(af, bfr[j][ks], acc[j]);
    }
    bf16_t* dst = ST + ((size_t)(ck * 2 + d) * 16 + head) * 8192;
#pragma unroll
    for (int j = 0; j < 2; ++j)
#pragma unroll
      for (int r = 0; r < 16; ++r) dst[(wr * 32 + crow(r, fh)) * 128 + wc * 64 + j * 32 + fr] = f2bf(acc[j][r]);
    if (tid == 0) CDEC[(ck * 2 + d) * 16 + head] = __expf(cend);
    __syncthreads();
  }
}

DI void pw_item(const Params& p_in, int l, char* smem, int mt, int nt) {
  const Params p = load_params();

  GemmS* s = (GemmS*)smem;
  int tid = threadIdx.x; asm volatile("" : "+v"(tid)); const int lane = tid & 63, wave = tid >> 6, wr = wave >> 1, wc = wave & 1, fr = lane & 31, fh = lane >> 5;
  const bf16_t* Ab = (const bf16_t*)(p.ws + OFF_HDN) + (size_t)mt * 128 * 512;
  const bf16_t* Bb = (const bf16_t*)(p.ws + OFF_PW) + (size_t)nt * 128 * 512;
  bf16_t* CG = (bf16_t*)(p.ws + OFF_CG);
  f32x16 acc[2][2];
  zero_acc(acc);
  gemm_core2(acc, (GemmS2*)smem,
             [&](int kt, int r, int kv) { return Ab + (size_t)r * 512 + kt * 64 + kv * 8; },
             [&](int kt, int r, int kv) { return Bb + (size_t)r * 512 + kt * 64 + kv * 8; }, 8, [](int) {});
  const float* pwb = p.conv_pw_b + l * 512 + nt * 128;
  epilogue_ldsw(acc, smem, [&](int rl, int c8, float4 lo, float4 hi) {
    bf16_t* ptr = CG + (size_t)(mt * 128 + rl) * 512 + nt * 128 + c8;
    const uint4 gv = *(const uint4*)ptr;
    const float4 b0 = *(const float4*)(pwb + c8), b1 = *(const float4*)(pwb + c8 + 4);
    uint4 o;
    o.x = pack2((lo.x + b0.x) * silu_f(lo2f(gv.x)), (lo.y + b0.y) * silu_f(hi2f(gv.x)));
    o.y = pack2((lo.z + b0.z) * silu_f(lo2f(gv.y)), (lo.w + b0.w) * silu_f(hi2f(gv.y)));
    o.z = pack2((hi.x + b1.x) * silu_f(lo2f(gv.z)), (hi.y + b1.y) * silu_f(hi2f(gv.z)));
    o.w = pack2((hi.z + b1.z) * silu_f(lo2f(gv.w)), (hi.w + b1.w) * silu_f(hi2f(gv.w)));
    *(uint4*)ptr = o;
  });
}

DI void phase_mix(const Params& p, int l, char* smem) {
  const int G = gridDim.x;
  const int N_ATT = 512 + (l == 0 ? 32 : 0);
  for (int it = blockIdx.x; it < N_ATT; it += G) {
    if (it < 512) attn_item(p, l, smem, it >> 7, (it >> 2) & 31, (it >> 1) & 1, it & 1, false);
    else { const int t = it - 512; attn_item(p, l, smem, t >> 3, (t >> 2) & 1, (t >> 1) & 1, t & 1, true); }
  }
  for (int it = (blockIdx.x + G - 32) % G; it < NCK * 4; it += G) states_item(p, smem, it >> 2, (it >> 1) & 1, it & 1);
  for (int it = (blockIdx.x + G - 64) % G; it < NCK * 4; it += G) pw_item(p, l, smem, it >> 2, it & 3);
}

DI void phase_scan(const Params& p_in) {
  const Params p = load_params();

  bf16_t* ST = (bf16_t*)(p.ws + OFF_ST);
  const float* CDEC = (const float*)(p.ws + OFF_CDEC);
  for (int it = blockIdx.x; it < 512; it += gridDim.x) {
    const int e = it * 256 + threadIdx.x;
    const int bdh = e >> 10, v8 = e & 1023;
    const int b = bdh >> 5, d = (bdh >> 4) & 1, h = bdh & 15;
    float s[8];
#pragma unroll
    for (int i = 0; i < 8; ++i) s[i] = 0.f;
    auto ckof = [&](int i) {
      if (d == 0) return (i < 2) ? (128 + 2 * b + i) : (32 * b + (i - 2));
      return (i < 2) ? (128 + 2 * b + (1 - i)) : (32 * b + 31 - (i - 2));
    };
    auto pof = [&](int i) { const int ck = ckof(i); return (uint4*)(ST + ((size_t)(ck * 2 + d) * 16 + h) * 8192 + v8 * 8); };
    auto dof = [&](int i) { const int ck = ckof(i); return CDEC[(ck * 2 + d) * 16 + h]; };
    uint4 buf[8]; float dc[8];
#pragma unroll
    for (int i = 0; i < 7; ++i) { buf[i] = *pof(i); dc[i] = dof(i); }
#pragma unroll
    for (int i = 0; i < 34; ++i) {
      if (i + 7 < 34) { buf[(i + 7) & 7] = *pof(i + 7); dc[(i + 7) & 7] = dof(i + 7); }
      const uint4 cur = buf[i & 7];
      const float dec = dc[i & 7];
      uint4 o;
      o.x = pack2(s[0], s[1]); o.y = pack2(s[2], s[3]); o.z = pack2(s[4], s[5]); o.w = pack2(s[6], s[7]);
      *pof(i) = o;
      s[0] = s[0] * dec + lo2f(cur.x); s[1] = s[1] * dec + hi2f(cur.x);
      s[2] = s[2] * dec + lo2f(cur.y); s[3] = s[3] * dec + hi2f(cur.y);
      s[4] = s[4] * dec + lo2f(cur.z); s[5] = s[5] * dec + hi2f(cur.z);
      s[6] = s[6] * dec + lo2f(cur.w); s[7] = s[7] * dec + hi2f(cur.w);
    }
  }
}

DI void phase_ssdy(const Params& p_in, int l, char* smem) {
  const Params p = load_params();

  bf16_t* sB = (bf16_t*)smem;
  bf16_t* sX = (bf16_t*)(smem + 128 * 136 * 2);
  float* sF = (float*)(smem + 128 * 136 * 2 + 128 * 72 * 2);
  float* sSS = sF + 512;
  int tid = threadIdx.x; asm volatile("" : "+v"(tid)); const int lane = tid & 63, wave = tid >> 6, fr = lane & 31, fh = lane >> 5;
  const int wl = wave >> 1, w2 = wave & 1;
  const bf16_t* BC = (const bf16_t*)(p.ws + OFF_BC);
  const bf16_t* XS = (const bf16_t*)(p.ws + OFF_H);
  const float* DT = (const float*)(p.ws + OFF_DT);
  const float* CS = (const float*)(p.ws + OFF_CS);
  const bf16_t* ST = (const bf16_t*)(p.ws + OFF_ST);
  bf16_t* Z = (bf16_t*)(p.ws + OFF_Z);
  float* RSTD = (float*)(p.ws + OFF_RSTD);
  const int nck = (l == 0) ? NCK : 128;
  const int nh = (l == 0) ? 2 : 8;
  const int nsplit = 8 / nh;
  for (int it0 = blockIdx.x; it0 < nck * 4 * nsplit; it0 += gridDim.x) {
    const int hq = it0 % nsplit, it = it0 / nsplit;
    const int hbeg = hq * nh, hend = hbeg + nh;
    const int ck = it >> 2, g = (it >> 1) & 1, lh = it & 1;
    const int row0 = ck * 128;
    const int lbase = lh * 64 + wl * 32;
    __syncthreads();
    for (int v = tid; v < 2048; v += 256) {
      const int r = v >> 4, cv = v & 15;
      *(uint4*)&sB[r * 136 + cv * 8] = *(const uint4*)(BC + (size_t)(row0 + r) * 512 + g * 128 + cv * 8);
    }
    if (tid < 64) sSS[tid] = 0.f;
    const bf16_t* cptr = BC + (size_t)(row0 + lbase + fr) * 512 + 256 + g * 128 + fh * 8;
    bf16x8 cf[8];
#pragma unroll
    for (int ks = 0; ks < 8; ++ks) cf[ks] = *(const bf16x8*)(cptr + ks * 16);
    const int lrx = tid >> 3, cvx = tid & 7;
    const bf16_t* xsrc = XS + (size_t)(row0 + lrx) * 1024 + cvx * 8;
    uint4 xp0, xp1, xp2, xp3;
    float fp0 = 0.f, fp1 = 0.f, fp2 = 0.f, fp3 = 0.f;
    {
      const int head = g * 8 + hbeg;
      xp0 = *(const uint4*)(xsrc + head * 64);
      xp1 = *(const uint4*)(xsrc + head * 64 + 32 * 1024);
      xp2 = *(const uint4*)(xsrc + head * 64 + 64 * 1024);
      xp3 = *(const uint4*)(xsrc + head * 64 + 96 * 1024);
      if (tid < 128) {
        const size_t rho = (size_t)(row0 + tid);
        fp0 = CS[rho * 32 + head]; fp1 = CS[rho * 32 + 16 + head]; fp2 = DT[rho * 32 + head]; fp3 = DT[rho * 32 + 16 + head];
      }
    }
    __syncthreads();
    f32x16 cb[2];
#pragma unroll
    for (int j = 0; j < 2; ++j) {
#pragma unroll
      for (int r = 0; r < 16; ++r) cb[j][r] = 0.f;
#pragma unroll
      for (int ks = 0; ks < 8; ++ks) {
        const bf16x8 bq = *(const bf16x8*)&sB[(w2 * 64 + j * 32 + fr) * 136 + ks * 16 + fh * 8];
        cb[j] = MFMA(cf[ks], bq, cb[j]);
      }
    }
    const int pidx = w2 * 32 + fr;
    bf16_t* sCB = sB + 64 * 136;
    __syncthreads();
#pragma unroll
    for (int j = 0; j < 2; ++j)
#pragma unroll
      for (int r = 0; r < 16; ++r) sCB[(wl * 32 + crow(r, fh)) * 136 + w2 * 64 + j * 32 + fr] = f2bf(cb[j][r]);
#pragma unroll 1
    for (int hh = hbeg; hh < hend; ++hh) {
      const int head = g * 8 + hh;
      __syncthreads();
      *(uint4*)&sX[lrx * 72 + cvx * 8] = xp0;
      *(uint4*)&sX[(lrx + 32) * 72 + cvx * 8] = xp1;
      *(uint4*)&sX[(lrx + 64) * 72 + cvx * 8] = xp2;
      *(uint4*)&sX[(lrx + 96) * 72 + cvx * 8] = xp3;
      if (tid < 128) { sF[tid] = fp0; sF[128 + tid] = fp1; sF[256 + tid] = fp2; sF[384 + tid] = fp3; }
      const bf16_t* S0 = ST + ((size_t)(ck * 2 + 0) * 16 + head) * 8192 + (w2 * 32 + fr) * 128 + fh * 8;
      const bf16_t* S1 = ST + ((size_t)(ck * 2 + 1) * 16 + head) * 8192 + (w2 * 32 + fr) * 128 + fh * 8;
      bf16x8 sf0[8];
#pragma unroll
      for (int ks = 0; ks < 8; ++ks) sf0[ks] = *(const bf16x8*)(S0 + ks * 16);
      bf16_t* zrow = Z + (size_t)(row0 + lbase + fr) * 1024 + head * 64 + w2 * 32 + 4 * fh;
      if (hh + 1 < hend) {
        const int hn = head + 1;
        xp0 = *(const uint4*)(xsrc + hn * 64);
        xp1 = *(const uint4*)(xsrc + hn * 64 + 32 * 1024);
        xp2 = *(const uint4*)(xsrc + hn * 64 + 64 * 1024);
        xp3 = *(const uint4*)(xsrc + hn * 64 + 96 * 1024);
        if (tid < 128) {
          const size_t rho = (size_t)(row0 + tid);
          fp0 = CS[rho * 32 + hn]; fp1 = CS[rho * 32 + 16 + hn]; fp2 = DT[rho * 32 + hn]; fp3 = DT[rho * 32 + 16 + hn];
        }
      }
      __syncthreads();
#pragma unroll
      for (int j = 0; j < 2; ++j) {
        const int sidx = w2 * 64 + j * 32 + fr;
        const float csf_s = sF[sidx], csb_s = sF[128 + sidx], dtf_s = sF[256 + sidx], dtb_s = sF[384 + sidx];
#pragma unroll 4
        for (int r = 0; r < 16; ++r) {
          const int lidx = lbase + crow(r, fh);
          float f = 0.f;
          if (sidx <= lidx) f += __expf(sF[lidx] - csf_s) * dtf_s;
          if (sidx >= lidx) f += __expf(sF[128 + lidx] - csb_s) * dtb_s;
          sB[(wl * 32 + crow(r, fh)) * 136 + sidx] = f2bf(bf2f(sCB[(wl * 32 + crow(r, fh)) * 136 + sidx]) * f);
        }
      }
      __syncthreads();
      bf16x8 sf1[8], cfh[8];
#pragma unroll
      for (int ks = 0; ks < 8; ++ks) { sf1[ks] = *(const bf16x8*)(S1 + ks * 16); cfh[ks] = *(const bf16x8*)(cptr + ks * 16); }
      uint2 zq[4];
#pragma unroll
      for (int g4 = 0; g4 < 4; ++g4) zq[g4] = *(const uint2*)(zrow + 8 * g4);
      f32x16 accy;
#pragma unroll
      for (int r = 0; r < 16; ++r) accy[r] = 0.f;
#pragma unroll
      for (int ks = 0; ks < 8; ++ks) {
        const bf16x8 af = *(const bf16x8*)&sB[(wl * 32 + fr) * 136 + ks * 16 + fh * 8];
        const bf16x8 xf = tr_frag(sX, 72, ks * 16 + 8 * fh, ks * 16 + 8 * fh + 4, w2 * 32);
        accy = MFMA(xf, af, accy);
      }
      {
        f32x16 acct;
#pragma unroll
        for (int r = 0; r < 16; ++r) acct[r] = 0.f;
#pragma unroll
        for (int ks = 0; ks < 8; ++ks) acct = MFMA(sf0[ks], cfh[ks], acct);
        const float ef = __expf(sF[lbase + fr]);
#pragma unroll
        for (int r = 0; r < 16; ++r) accy[r] += ef * acct[r];
#pragma unroll
        for (int r = 0; r < 16; ++r) acct[r] = 0.f;
#pragma unroll
        for (int ks = 0; ks < 8; ++ks) acct = MFMA(sf1[ks], cfh[ks], acct);
        const float eb = __expf(sF[128 + lbase + fr]);
#pragma unroll
        for (int r = 0; r < 16; ++r) accy[r] += eb * acct[r];
      }
      const float dsk = p.ssd_d[l * 16 + head];
      float ssum = 0.f;
#pragma unroll
      for (int g4 = 0; g4 < 4; ++g4) {
        const uint2 xx = *(const uint2*)&sX[(lbase + fr) * 72 + w2 * 32 + 8 * g4 + 4 * fh];
        const uint2 zz = zq[g4];
        const float u0 = (accy[4 * g4 + 0] + dsk * lo2f(xx.x)) * silu_f(lo2f(zz.x));
        const float u1 = (accy[4 * g4 + 1] + dsk * hi2f(xx.x)) * silu_f(hi2f(zz.x));
        const float u2 = (accy[4 * g4 + 2] + dsk * lo2f(xx.y)) * silu_f(lo2f(zz.y));
        const float u3 = (accy[4 * g4 + 3] + dsk * hi2f(xx.y)) * silu_f(hi2f(zz.y));
        ssum += u0 * u0 + u1 * u1 + u2 * u2 + u3 * u3;
        uint2 o; o.x = pack2(u0, u1); o.y = pack2(u2, u3);
        *(uint2*)(zrow + 8 * g4) = o;
      }
      ssum = xhalf_sum(ssum);
      if (fh == 0) atomicAdd(&sSS[wl * 32 + fr], ssum);
    }
    __syncthreads();
    if (tid < 64) atomicAdd(&RSTD[(size_t)(row0 + lh * 64 + tid) * 2 + g], sSS[tid]);
  }
}

DI void phase_outproj(const Params& p_in, int l, char* smem) {
  const Params p = load_params();

  GemmS* s = (GemmS*)smem;
  int tid = threadIdx.x; asm volatile("" : "+v"(tid)); const int lane = tid & 63, wave = tid >> 6, wr = wave >> 1, wc = wave & 1, fr = lane & 31, fh = lane >> 5;
  const bf16_t* Zb = (const bf16_t*)(p.ws + OFF_Z);
  const bf16_t* Qb = (const bf16_t*)(p.ws + OFF_Q);
  const bf16_t* Cb = (const bf16_t*)(p.ws + OFF_CG);
  const bf16_t* W = (const bf16_t*)(p.ws + OFF_WOUT);
  const float* RSTD = (const float*)(p.ws + OFF_RSTD);
  const float* mods = (const float*)(p.ws + OFF_MODS);
  float* XC = (float*)(p.ws + OFF_XC);
  for (int step = 0;; ++step) {
    int mt, nt2;
    if (!xcd_tile(step, 128, 4, mt, nt2)) break;
    f32x16 acc[2][4];
#pragma unroll
    for (int i = 0; i < 2; ++i)
#pragma unroll
      for (int j = 0; j < 4; ++j)
#pragma unroll
        for (int r = 0; r < 16; ++r) acc[i][j][r] = 0.f;
    const bf16_t* Wb = W + (size_t)nt2 * 256 * 2048;
    const bf16_t* A0 = Zb + (size_t)mt * 128 * 1024;
    const bf16_t* A2 = Qb + (size_t)mt * 128 * 512;
    const bf16_t* A3 = Cb + (size_t)mt * 128 * 512;
    float* sScale = (float*)(smem + 55296);
    __syncthreads();
    if (tid < 128) {
      const size_t row = (size_t)(mt * 128 + tid);
      const float r0 = rsqrtf(RSTD[row * 2] * (1.f / 512.f) + 1e-6f);
      const float r1 = rsqrtf(RSTD[row * 2 + 1] * (1.f / 512.f) + 1e-6f);
      sScale[tid * 2] = r0 / r1;
      sScale[tid * 2 + 1] = r1;
    }
    gemm_core3(acc, (GemmS3*)smem,
               [&](int kt, int r, int kv) {
                 const bf16_t* ptr;
                 if (kt < 16) ptr = A0 + (size_t)r * 1024 + kt * 64;
                 else if (kt < 24) ptr = A2 + (size_t)r * 512 + (kt - 16) * 64;
                 else ptr = A3 + (size_t)r * 512 + (kt - 24) * 64;
                 return ptr + kv * 8;
               },
               [&](int kt, int r, int kv) { return Wb + (size_t)r * 2048 + kt * 64 + kv * 8; }, 32,
               [&](int kt) __attribute__((always_inline)) {
                 if (kt == 8 || kt == 16) {
#pragma unroll
                   for (int i = 0; i < 2; ++i)
#pragma unroll
                     for (int r = 0; r < 16; ++r) {
                       const float f = sScale[(wr * 64 + i * 32 + crow(r, fh)) * 2 + (kt == 16 ? 1 : 0)];
                       acc[i][0][r] *= f; acc[i][1][r] *= f; acc[i][2][r] *= f; acc[i][3][r] *= f;
                     }
                 }
               });
    {
      const int row0 = mt * 128;
      const int vv = row0 >> 12;
      float* xnew = p.out + (size_t)row0 * 1024;
      const float* xold = (l == 0) ? (p.x + (size_t)row0 * 1024) : xnew;
#pragma unroll 1
      for (int sub = 0; sub < 2; ++sub) {
        const int nt = nt2 * 2 + sub;
        const float* gate = mods + (l * 5 + vv) * 3072 + 2048 + nt * 128;
        epilogue_lds2w(acc, smem, sub, [&](int rl, int c8, float4 lo, float4 hi) {
          const int off = rl * 1024 + nt * 128 + c8;
          const float4 x0 = *(const float4*)(xold + off), x1 = *(const float4*)(xold + off + 4);
          const float4 g0 = *(const float4*)(gate + c8), g1 = *(const float4*)(gate + c8 + 4);
          float4 o0, o1;
          o0.x = x0.x + g0.x * lo.x; o0.y = x0.y + g0.y * lo.y; o0.z = x0.z + g0.z * lo.z; o0.w = x0.w + g0.w * lo.w;
          o1.x = x1.x + g1.x * hi.x; o1.y = x1.y + g1.y * hi.y; o1.z = x1.z + g1.z * hi.z; o1.w = x1.w + g1.w * hi.w;
          *(float4*)(xnew + off) = o0;
          *(float4*)(xnew + off + 4) = o1;
        });
      }
    }
  }
  const int nctx = (l == 0) ? 64 : 0;
  for (int it = (int)blockIdx.x; it < nctx; it += gridDim.x) {
    const int mt = 128 + (it >> 3), nt = it & 7;
    f32x16 acc[2][2];
    zero_acc(acc);
    const bf16_t* Wb = W + (size_t)nt * 128 * 2048;
    const bf16_t* A0 = Zb + (size_t)mt * 128 * 1024;
    const bf16_t* A2 = Qb + (size_t)mt * 128 * 512;
    const bf16_t* A3 = Cb + (size_t)mt * 128 * 512;
    float* sScale = (float*)(smem + 40960);
    if (tid < 128) {
      const size_t row = (size_t)(mt * 128 + tid);
      const float r0 = rsqrtf(RSTD[row * 2] * (1.f / 512.f) + 1e-6f);
      const float r1 = rsqrtf(RSTD[row * 2 + 1] * (1.f / 512.f) + 1e-6f);
      sScale[tid * 2] = r0 / r1;
      sScale[tid * 2 + 1] = r1;
    }
    gemm_core2(acc, (GemmS2*)smem,
               [&](int kt, int r, int kv) {
                 const bf16_t* ptr;
                 if (kt < 16) ptr = A0 + (size_t)r * 1024 + kt * 64;
                 else if (kt < 24) ptr = A2 + (size_t)r * 512 + (kt - 16) * 64;
                 else ptr = A3 + (size_t)r * 512 + (kt - 24) * 64;
                 return ptr + kv * 8;
               },
               [&](int kt, int r, int kv) { return Wb + (size_t)r * 2048 + kt * 64 + kv * 8; }, 32,
               [&](int kt) __attribute__((always_inline)) {
                 if (kt == 8 || kt == 16) {
#pragma unroll
                   for (int i = 0; i < 2; ++i)
#pragma unroll
                     for (int r = 0; r < 16; ++r) {
                       const float f = sScale[(wr * 64 + i * 32 + crow(r, fh)) * 2 + (kt == 16 ? 1 : 0)];
                       acc[i][0][r] *= f; acc[i][1][r] *= f;
                     }
                 }
               });
    {
      const int row0 = mt * 128;
      const int vv = (row0 < RL_) ? (row0 >> 12) : 4;
      const float* gate = mods + (l * 5 + vv) * 3072 + 2048 + nt * 128;
      float* xnew = (row0 < RL_) ? (p.out + (size_t)row0 * 1024) : (XC + (size_t)(row0 - RL_) * 1024);
      const float* xold = (l == 0) ? ((row0 < RL_) ? (p.x + (size_t)row0 * 1024) : (p.ctx + (size_t)(row0 - RL_) * 1024)) : xnew;
      epilogue_lds(acc, smem, [&](int rl, int c4, float4 v) {
        const int off = rl * 1024 + nt * 128 + c4;
        const float4 xo = *(const float4*)(xold + off);
        const float4 gt = *(const float4*)(gate + c4);
        float4 o;
        o.x = xo.x + gt.x * v.x; o.y = xo.y + gt.y * v.y; o.z = xo.z + gt.z * v.z; o.w = xo.w + gt.w * v.w;
        *(float4*)(xnew + off) = o;
      });
    }
  }
  if (l == 0) {
    const int local = blockIdx.x >> 3, xcd = blockIdx.x & 7, nloc = gridDim.x >> 3;
    if (local >= 8 && nloc > 8) {
      const int nb = (nloc - 8) * 8;
      const int NT_WIN = 88 * 16, NT_PW = 64;
      for (int it = (local - 8) * 8 + xcd; it < NT_WIN + NT_PW; it += nb) {
        if (it < NT_WIN) transpose_tile(p.w_in + (size_t)1024 * 5408, 5408, 0, nullptr, (bf16_t*)(p.ws + OFF_WIN), 1024, (it / 16) * 64, (it % 16) * 64, (float*)smem);
        else { const int t = it - NT_WIN; transpose_tile(p.conv_pw_w + (size_t)512 * 512, 512, 1, nullptr, (bf16_t*)(p.ws + OFF_PW), 512, (t / 8) * 64, (t % 8) * 64, (float*)smem); }
      }
    }
  }
}

DI void phase_final(const Params& p_in) {
  const Params p = load_params();
  const int lane = threadIdx.x & 63, wave = threadIdx.x >> 6;
  for (int it = blockIdx.x; it < RL_ / 8; it += gridDim.x) {
    float* xr0 = p.out + (size_t)(it * 8 + wave * 2) * 1024;
    float4 xv[2][4];
#pragma unroll
    for (int q = 0; q < 2; ++q)
#pragma unroll
      for (int i = 0; i < 4; ++i) xv[q][i] = *(const float4*)(xr0 + q * 1024 + lane * 4 + i * 256);
    float4 w[4];
#pragma unroll
    for (int i = 0; i < 4; ++i) w[i] = *(const float4*)(p.final_norm_w + lane * 4 + i * 256);
#pragma unroll
    for (int q = 0; q < 2; ++q) {
      float ss = 0.f;
#pragma unroll
      for (int i = 0; i < 4; ++i) ss += xv[q][i].x * xv[q][i].x + xv[q][i].y * xv[q][i].y + xv[q][i].z * xv[q][i].z + xv[q][i].w * xv[q][i].w;
#pragma unroll
      for (int o = 32; o >= 1; o >>= 1) ss += __shfl_xor(ss, o);
      const float rs = rsqrtf(ss * (1.f / 1024.f) + 1e-6f);
#pragma unroll
      for (int i = 0; i < 4; ++i) {
        float4 o;
        o.x = xv[q][i].x * rs * w[i].x; o.y = xv[q][i].y * rs * w[i].y; o.z = xv[q][i].z * rs * w[i].z; o.w = xv[q][i].w * rs * w[i].w;
        *(float4*)(xr0 + q * 1024 + lane * 4 + i * 256) = o;
      }
    }
  }
}

template <int PH>
DI void run_phase(const Params& p, char* smem) {
  constexpr int l = (PH - 1) / 7, s = (PH - 1) % 7;
  if constexpr (PH == 0) phase_mods(p, smem);
  else if constexpr (PH == 15) phase_final(p);
  else if constexpr (s == 0) phase_prep(p, l, smem);
  else if constexpr (s == 1) phase_inproj(p, smem);
  else if constexpr (s == 2) phase_local(p, l, smem);
  else if constexpr (s == 3) phase_mix(p, l, smem);
  else if constexpr (s == 4) phase_scan(p);
  else if constexpr (s == 5) phase_ssdy(p, l, smem);
  else phase_outproj(p, l, smem);
}

#if PROBE_S >= 0
#define PROBE_BEGIN() if (threadIdx.x == 0) pst[1] = wall_clock64();
#define PROBE_END(PH) if (threadIdx.x == 0 && (PH) >= 1 && (PH) <= 14 && (((PH) - 1) % 7) == PROBE_S) pst[0] += wall_clock64() - pst[1];
#else
#define PROBE_BEGIN()
#define PROBE_END(PH)
#endif
#define PHASE(PH) PROBE_BEGIN() run_phase<PH>(p, smem); xcd_barrier(xst); PROBE_END(PH)

__global__ void __launch_bounds__(256, 2) fwd_megakernel(Params p) {
  __shared__ __attribute__((aligned(16))) char smem[57344];
  cg::grid_group grid = cg::this_grid();
  if (threadIdx.x == 0) g_kernarg = (unsigned long long)__builtin_amdgcn_kernarg_segment_ptr();
  __syncthreads();
#if PROBE_S >= 0
  volatile unsigned long long* pst = (volatile unsigned long long*)(smem + 57344 - 16);
  if (threadIdx.x == 0) { pst[0] = 0; pst[1] = 0; }
#endif
  __shared__ uint4 xb_words;
  volatile LAS unsigned* xst = (volatile LAS unsigned*)&xb_words;
  if (threadIdx.x == 0) xb_words = make_uint4(0u, 0u, 0u, 0u);
  if (threadIdx.x == 0) { unsigned* bar = (unsigned*)(load_params().ws + OFF_BAR); (void)xb_add(&bar[XB_XCNT(xb_xcc_id())], 1u); }
  run_phase<0>(p, smem);
  if (load_params().out == nullptr) grid.sync();
  xcd_barrier(xst);
  PHASE(1) PHASE(2) PHASE(3) PHASE(4) PHASE(5) PHASE(6) PHASE(7)
  PHASE(8) PHASE(9) PHASE(10) PHASE(11) PHASE(12) PHASE(13) PHASE(14)
  run_phase<15>(p, smem);
#if PROBE_S >= 0
  if (blockIdx.x == 0 && threadIdx.x == 0) {
    const unsigned long long t1 = wall_clock64();
    const unsigned long long lim = 4ull * pst[0];
    while (wall_clock64() - t1 < lim) { __builtin_amdgcn_s_sleep(32); }
  }
#endif
}

extern "C" void kernel_launch(void* const* d_in, const int* in_sizes, int n_in, void* d_out, int out_size, void* d_ws,
                              size_t ws_size, hipStream_t stream) {
  static int grid_blocks = 0;
  if (!grid_blocks) {
    int dev = 0, cus = 0, per_cu = 0;
    hipGetDevice(&dev);
    hipDeviceGetAttribute(&cus, hipDeviceAttributeMultiprocessorCount, dev);
    hipOccupancyMaxActiveBlocksPerMultiprocessor(&per_cu, fwd_megakernel, 256, 0);
    if (per_cu < 1) per_cu = 1;
    if (per_cu > 2) per_cu = 2;
    grid_blocks = (cus * per_cu) & ~7;
  }
  Params p{};
  const float** pp = (const float**)&p;
  for (int i = 0; i < 23; ++i) pp[i] = (const float*)d_in[i];
  p.out = (float*)d_out;
  p.ws = (char*)d_ws;
  (void)hipMemsetAsync((char*)d_ws + OFF_BAR, 0, XCD_BAR_WORDS * 4, stream);
  void* args[] = {&p};
  hipError_t e = hipLaunchCooperativeKernel((void*)fwd_megakernel, dim3(grid_blocks), dim3(256), args, 0, stream);
  if (e != hipSuccess) fprintf(stderr, "cooperative launch failed: %s (grid %d)\n", hipGetErrorString(e), grid_blocks);
}
```

```cpp
#include <hip/hip_runtime.h>
#include <hip/hip_cooperative_groups.h>
#include <stdint.h>
#include <stdio.h>
namespace cg = cooperative_groups;

#ifndef ONE_LAUNCH
#define ONE_LAUNCH 1
#endif

#ifndef PROBE_S
#define PROBE_S -1
#endif
#define DI __device__ __forceinline__
typedef unsigned short bf16_t;
using bf16x8 = __attribute__((ext_vector_type(8))) short;
using s16x4 = __attribute__((ext_vector_type(4))) short;
using f32x16 = __attribute__((ext_vector_type(16))) float;
#define MFMA(a, b, c) __builtin_amdgcn_mfma_f32_32x32x16_bf16((a), (b), (c), 0, 0, 0)

constexpr int R_ = 17408;
constexpr int RL_ = 16384;
constexpr int NCK = 136;

constexpr size_t SZ_WIN = (size_t)5632 * 1024 * 2;
constexpr size_t SZ_WOUT = (size_t)1024 * 2048 * 2;
constexpr size_t SZ_PW = (size_t)512 * 512 * 2;
constexpr size_t SZ_MODS = (size_t)2 * 5 * 3072 * 4;
constexpr size_t SZ_XC = (size_t)1024 * 1024 * 4;
constexpr size_t SZ_RSTD = (size_t)R_ * 2 * 4;
constexpr size_t SZ_CDEC = (size_t)NCK * 32 * 4 + 256 - ((size_t)NCK * 32 * 4) % 256;
constexpr size_t SZ_R512 = (size_t)R_ * 512 * 2;
constexpr size_t OFF_WIN = 0;
constexpr size_t OFF_WOUT = OFF_WIN + SZ_WIN;
constexpr size_t OFF_PW = OFF_WOUT + SZ_WOUT;
constexpr size_t OFF_MODS = OFF_PW + SZ_PW;
constexpr size_t OFF_XC = OFF_MODS + SZ_MODS;
constexpr size_t OFF_RSTD = OFF_XC + SZ_XC;
constexpr size_t OFF_CDEC = OFF_RSTD + SZ_RSTD;
constexpr size_t OFF_H = OFF_CDEC + SZ_CDEC;
constexpr size_t OFF_XBC = OFF_H + 2 * SZ_R512;
constexpr size_t OFF_GLU = OFF_XBC + 3 * SZ_R512;
constexpr size_t OFF_ST = OFF_XBC;
constexpr size_t OFF_Z = OFF_GLU + SZ_R512;
constexpr size_t OFF_DT = OFF_Z + 2 * SZ_R512;
constexpr size_t OFF_CS = OFF_DT + (size_t)R_ * 32 * 4;
constexpr size_t OFF_Q = OFF_CS + (size_t)R_ * 32 * 4;
constexpr size_t OFF_KV = OFF_Q + SZ_R512;
constexpr size_t OFF_AG = OFF_KV + SZ_R512 / 2;
constexpr size_t OFF_CG = OFF_AG + SZ_R512;
constexpr size_t OFF_BC = OFF_CG + SZ_R512;
constexpr size_t OFF_HDN = OFF_BC + SZ_R512;
constexpr size_t WS_TOTAL = OFF_HDN + SZ_R512;
constexpr size_t OFF_BAR = WS_TOTAL;
static_assert(OFF_BAR + 16384 <= (size_t)256 * 1024 * 1024, "workspace too large");

struct Params {
  const float *x, *c, *ctx, *c_ctx, *w_mod, *b_mod, *norm_w, *w_in, *ssd_conv_w, *ssd_conv_b, *ssd_dt_bias, *ssd_a_log,
      *ssd_d, *ssd_norm_w, *attn_sink, *conv_dw_w, *conv_dw_b, *conv_ln_w, *conv_ln_b, *conv_pw_w, *conv_pw_b, *w_out,
      *final_norm_w;
  float* out;
  char* ws;
};


__shared__ unsigned long long g_kernarg;
DI Params load_params() {
  typedef const char __attribute__((address_space(4)))* kptr_t;
  typedef const float* const __attribute__((address_space(4)))* kfld_t;
  const unsigned long long v = *(volatile unsigned long long*)&g_kernarg;
  const unsigned lo = __builtin_amdgcn_readfirstlane((unsigned)v), hi = __builtin_amdgcn_readfirstlane((unsigned)(v >> 32));
  kptr_t base = (kptr_t)(((unsigned long long)hi << 32) | lo);
  Params p;
  const float** pp = (const float**)&p;
#pragma unroll
  for (int i = 0; i < 25; ++i) pp[i] = *(kfld_t)(base + 8 * i);
  return p;
}

#define XB_TMO      128
#define XB_XCNT(j)  (256  + 64 * (j))
#define XB_XSUB(j)  (1280 + 64 * (j))
#define XB_XGEN(j)  (2304 + 64 * (j))
#define XB_TOP      3328
#define XB_TOPGEN   3392
#define XCD_BAR_WORDS 3456
#define XB_SPIN_CAP (1u << 18)
#define LAS __attribute__((address_space(3)))
DI unsigned xb_ld(unsigned* p)              { return __hip_atomic_load(p, __ATOMIC_RELAXED, __HIP_MEMORY_SCOPE_AGENT); }
DI unsigned xb_add(unsigned* p, unsigned v) { return __hip_atomic_fetch_add(p, v, __ATOMIC_RELAXED, __HIP_MEMORY_SCOPE_AGENT); }
DI unsigned xb_xcc_id() { return (unsigned)__builtin_amdgcn_s_getreg((3 << 11) | 20) & 0xFu; }
#define XB_SPIN(cond, bar) do { unsigned _sp = 0; while (cond) { __builtin_amdgcn_s_sleep(1); \
    if ((++_sp & 255u) == 0u) { if (xb_ld(&(bar)[XB_TMO])) break; if (_sp > XB_SPIN_CAP) { atomicAdd(&(bar)[XB_TMO], 1u); break; } } } } while (0)

DI void xcd_barrier_complete(unsigned* bar, unsigned x, unsigned& nloc, unsigned& nx) {
  const unsigned G = gridDim.x * gridDim.y * gridDim.z;
  unsigned sum, cnt, mine, sp = 0u;
  for (;;) {
    sum = 0u; cnt = 0u; mine = 0u;
#pragma unroll
    for (unsigned j = 0; j < 16; ++j) { const unsigned c = xb_ld(&bar[XB_XCNT(j)]); sum += c; cnt += (c > 0u) ? 1u : 0u; mine = (j == x) ? c : mine; }
    if (sum == G) break;
    __builtin_amdgcn_s_sleep(1);
    if ((++sp & 255u) == 0u) { if (xb_ld(&bar[XB_TMO])) break; if (sp > XB_SPIN_CAP) { atomicAdd(&bar[XB_TMO], 1u); break; } }
  }
  nloc = mine > 0u ? mine : 1u; nx = cnt > 0u ? cnt : 1u;
}

DI void xcd_barrier(volatile LAS unsigned* st) {
  asm volatile("s_waitcnt vmcnt(0)" ::: "memory");
  __syncthreads();
  if (threadIdx.x == 0) {
    const Params pb = load_params();
    unsigned* bar = (unsigned*)(pb.ws + OFF_BAR);
    const unsigned x = xb_xcc_id();
    __builtin_amdgcn_s_waitcnt(0);
    unsigned nloc = st[0], nx = st[1];
    if (nloc == 0u) { xcd_barrier_complete(bar, x, nloc, nx); st[0] = nloc; st[1] = nx; }
    const unsigned old = xb_add(&bar[XB_XSUB(x)], 1u);
    const unsigned gen = old / nloc;
    if (old + 1u == (gen + 1u) * nloc) {
      __builtin_amdgcn_fence(__ATOMIC_RELEASE, "agent");
      asm volatile("s_waitcnt vmcnt(0)" ::: "memory");
      const unsigned og = xb_add(&bar[XB_TOP], 1u);
      const unsigned tg = og / nx;
      if (og + 1u == (tg + 1u) * nx) xb_add(&bar[XB_TOPGEN], 1u);
      else XB_SPIN(xb_ld(&bar[XB_TOPGEN]) == tg, bar);
      __builtin_amdgcn_fence(__ATOMIC_ACQUIRE, "agent");
      xb_add(&bar[XB_XGEN(x)], 1u);
      asm volatile("s_waitcnt vmcnt(0)" ::: "memory");
    } else {
      XB_SPIN(xb_ld(&bar[XB_XGEN(x)]) == gen, bar);
      __builtin_amdgcn_fence(__ATOMIC_ACQUIRE, "agent");
      asm volatile("s_waitcnt vmcnt(0)" ::: "memory");
    }
  }
  __syncthreads();
}

typedef __bf16 nbf16x2_t __attribute__((ext_vector_type(2)));
typedef float nf32x2_t __attribute__((ext_vector_type(2)));
DI unsigned short f2bf(float x) { const __bf16 r = (__bf16)x; return __builtin_bit_cast(unsigned short, r); }
DI float bf2f(unsigned short b) { return __uint_as_float(((unsigned)b) << 16); }
DI unsigned pack2(float a, float b) { const nf32x2_t v = {a, b}; const nbf16x2_t r = __builtin_convertvector(v, nbf16x2_t); return __builtin_bit_cast(unsigned, r); }
DI float lo2f(unsigned u) { return __uint_as_float(u << 16); }
DI float hi2f(unsigned u) { return __uint_as_float(u & 0xffff0000u); }
DI float silu_f(float x) { return x * __builtin_amdgcn_rcpf(1.f + __expf(-x)); }
DI float sigmoid_f(float x) { return __builtin_amdgcn_rcpf(1.f + __expf(-x)); }
DI float xhalf_max(float v) {
  const auto rr = __builtin_amdgcn_permlane32_swap(__float_as_uint(v), __float_as_uint(v), false, false);
  return fmaxf(__uint_as_float(rr[0]), __uint_as_float(rr[1]));
}
DI float xhalf_sum(float v) {
  const auto rr = __builtin_amdgcn_permlane32_swap(__float_as_uint(v), __float_as_uint(v), false, false);
  return __uint_as_float(rr[0]) + __uint_as_float(rr[1]);
}

DI int crow(int reg, int h) { return (reg & 3) + 8 * (reg >> 2) + 4 * h; }

DI bf16x8 tr_frag(const bf16_t* s, int ld, int row_lo, int row_hi, int col0) {
  const int lane = threadIdx.x & 63;
  const int i16 = lane & 15, q = i16 >> 2, pp = i16 & 3, blk = (lane >> 4) & 1;
  const unsigned a0 = (unsigned)(size_t)(s + (row_lo + q) * ld + col0 + 16 * blk + 4 * pp);
  const unsigned a1 = (unsigned)(size_t)(s + (row_hi + q) * ld + col0 + 16 * blk + 4 * pp);
  s16x4 lo, hi;
  asm volatile("ds_read_b64_tr_b16 %0, %2\n\tds_read_b64_tr_b16 %1, %3\n\ts_waitcnt lgkmcnt(0)"
               : "=&v"(lo), "=&v"(hi) : "v"(a0), "v"(a1) : "memory");
  return __builtin_shufflevector(lo, hi, 0, 1, 2, 3, 4, 5, 6, 7);
}

struct GemmS { bf16_t a[2][128][40]; bf16_t b[2][128][40]; };

template <class AF, class BF>
DI void gemm_core(f32x16 (&acc)[2][2], GemmS* s, AF aptr, BF bptr, int nk) {
  int tid = threadIdx.x; asm volatile("" : "+v"(tid)); const int lane = tid & 63, wave = tid >> 6, wr = wave >> 1, wc = wave & 1;
  const int r0 = tid >> 2, kv = tid & 3;
  const int fr = lane & 31, fh = lane >> 5;
  uint4 ra0 = *(const uint4*)aptr(0, r0, kv), ra1 = *(const uint4*)aptr(0, r0 + 64, kv);
  uint4 rb0 = *(const uint4*)bptr(0, r0, kv), rb1 = *(const uint4*)bptr(0, r0 + 64, kv);
  *(uint4*)&s->a[0][r0][kv * 8] = ra0; *(uint4*)&s->a[0][r0 + 64][kv * 8] = ra1;
  *(uint4*)&s->b[0][r0][kv * 8] = rb0; *(uint4*)&s->b[0][r0 + 64][kv * 8] = rb1;
  __syncthreads();
#pragma unroll 1
  for (int kt = 0; kt < nk; ++kt) {
    const int buf = kt & 1;
    if (kt + 1 < nk) {
      ra0 = *(const uint4*)aptr(kt + 1, r0, kv); ra1 = *(const uint4*)aptr(kt + 1, r0 + 64, kv);
      rb0 = *(const uint4*)bptr(kt + 1, r0, kv); rb1 = *(const uint4*)bptr(kt + 1, r0 + 64, kv);
    }
#pragma unroll
    for (int ks = 0; ks < 2; ++ks) {
      bf16x8 af[2], bq[2];
#pragma unroll
      for (int i = 0; i < 2; ++i) af[i] = *(const bf16x8*)&s->a[buf][wr * 64 + i * 32 + fr][ks * 16 + fh * 8];
#pragma unroll
      for (int j = 0; j < 2; ++j) bq[j] = *(const bf16x8*)&s->b[buf][wc * 64 + j * 32 + fr][ks * 16 + fh * 8];
#pragma unroll
      for (int i = 0; i < 2; ++i)
#pragma unroll
        for (int j = 0; j < 2; ++j) acc[i][j] = MFMA(af[i], bq[j], acc[i][j]);
    }
    if (kt + 1 < nk) {
      *(uint4*)&s->a[buf ^ 1][r0][kv * 8] = ra0; *(uint4*)&s->a[buf ^ 1][r0 + 64][kv * 8] = ra1;
      *(uint4*)&s->b[buf ^ 1][r0][kv * 8] = rb0; *(uint4*)&s->b[buf ^ 1][r0 + 64][kv * 8] = rb1;
    }
    __syncthreads();
  }
}


struct GemmS2 { bf16_t a[128][72]; bf16_t b[128][72]; };
DI void g2_compute(f32x16 (&acc)[2][2], const GemmS2* s, int wr, int wc, int fr, int fh) {
#pragma unroll
  for (int ks = 0; ks < 4; ++ks) {
    bf16x8 af[2], bq[2];
#pragma unroll
    for (int i = 0; i < 2; ++i) af[i] = *(const bf16x8*)&s->a[wr * 64 + i * 32 + fr][ks * 16 + fh * 8];
#pragma unroll
    for (int j = 0; j < 2; ++j) bq[j] = *(const bf16x8*)&s->b[wc * 64 + j * 32 + fr][ks * 16 + fh * 8];
#pragma unroll
    for (int i = 0; i < 2; ++i)
#pragma unroll
      for (int j = 0; j < 2; ++j) acc[i][j] = MFMA(af[i], bq[j], acc[i][j]);
  }
}

template <class AF, class BF, class HK>
DI void gemm_core2(f32x16 (&acc)[2][2], GemmS2* s, AF aptr, BF bptr, int nk, HK hook) {
  int tid = threadIdx.x; asm volatile("" : "+v"(tid));
  const int lane = tid & 63, wave = tid >> 6, wr = wave >> 1, wc = wave & 1;
  const int r0 = tid >> 3, kc = tid & 7;
  const int fr = lane & 31, fh = lane >> 5;
  uint4 p0a0, p0a1, p0a2, p0a3, p0b0, p0b1, p0b2, p0b3, p1a0, p1a1, p1a2, p1a3, p1b0, p1b1, p1b2, p1b3;
#define G2_LOAD(S, KT) { \
    S##a0 = *(const uint4*)aptr((KT), r0, kc);      S##b0 = *(const uint4*)bptr((KT), r0, kc); \
    S##a1 = *(const uint4*)aptr((KT), r0 + 32, kc); S##b1 = *(const uint4*)bptr((KT), r0 + 32, kc); \
    S##a2 = *(const uint4*)aptr((KT), r0 + 64, kc); S##b2 = *(const uint4*)bptr((KT), r0 + 64, kc); \
    S##a3 = *(const uint4*)aptr((KT), r0 + 96, kc); S##b3 = *(const uint4*)bptr((KT), r0 + 96, kc); }
#define G2_STORE(S) { \
    *(uint4*)&s->a[r0][kc * 8] = S##a0;      *(uint4*)&s->b[r0][kc * 8] = S##b0; \
    *(uint4*)&s->a[r0 + 32][kc * 8] = S##a1; *(uint4*)&s->b[r0 + 32][kc * 8] = S##b1; \
    *(uint4*)&s->a[r0 + 64][kc * 8] = S##a2; *(uint4*)&s->b[r0 + 64][kc * 8] = S##b2; \
    *(uint4*)&s->a[r0 + 96][kc * 8] = S##a3; *(uint4*)&s->b[r0 + 96][kc * 8] = S##b3; }
#define G2_COMPUTE() g2_compute(acc, s, wr, wc, fr, fh);
  G2_LOAD(p0, 0)
  G2_LOAD(p1, 1)
  G2_STORE(p0)
  if (nk > 2) G2_LOAD(p0, 2)
  __syncthreads();
#pragma unroll 1
  for (int kt = 0; kt < nk; kt += 2) {
    hook(kt);
    G2_COMPUTE()
    __syncthreads();
    G2_STORE(p1)
    if (kt + 3 < nk) G2_LOAD(p1, kt + 3)
    __syncthreads();
    hook(kt + 1);
    G2_COMPUTE()
    __syncthreads();
    if (kt + 2 < nk) {
      G2_STORE(p0)
      if (kt + 4 < nk) G2_LOAD(p0, kt + 4)
    }
    __syncthreads();
  }
#undef G2_LOAD
#undef G2_STORE
#undef G2_COMPUTE
}


struct GemmS3 { bf16_t a[128][72]; bf16_t b[256][72]; };

template <class AF, class BF, class HK>
DI void gemm_core3(f32x16 (&acc)[2][4], GemmS3* s, AF aptr, BF bptr, int nk, HK hook) {
  int tid = threadIdx.x; asm volatile("" : "+v"(tid));
  const int lane = tid & 63, wave = tid >> 6, wr = wave >> 1, wc = wave & 1;
  const int r0 = tid >> 3, kc = tid & 7;
  const int fr = lane & 31, fh = lane >> 5;
  uint4 a0, a1, a2, a3, b0, b1, b2, b3, b4, b5, b6, b7;
#define G3_LOAD(KT) { \
    a0 = *(const uint4*)aptr((KT), r0, kc);       a1 = *(const uint4*)aptr((KT), r0 + 32, kc); \
    a2 = *(const uint4*)aptr((KT), r0 + 64, kc);  a3 = *(const uint4*)aptr((KT), r0 + 96, kc); \
    b0 = *(const uint4*)bptr((KT), r0, kc);       b1 = *(const uint4*)bptr((KT), r0 + 32, kc); \
    b2 = *(const uint4*)bptr((KT), r0 + 64, kc);  b3 = *(const uint4*)bptr((KT), r0 + 96, kc); \
    b4 = *(const uint4*)bptr((KT), r0 + 128, kc); b5 = *(const uint4*)bptr((KT), r0 + 160, kc); \
    b6 = *(const uint4*)bptr((KT), r0 + 192, kc); b7 = *(const uint4*)bptr((KT), r0 + 224, kc); }
#define G3_STORE() { \
    *(uint4*)&s->a[r0][kc * 8] = a0;       *(uint4*)&s->a[r0 + 32][kc * 8] = a1; \
    *(uint4*)&s->a[r0 + 64][kc * 8] = a2;  *(uint4*)&s->a[r0 + 96][kc * 8] = a3; \
    *(uint4*)&s->b[r0][kc * 8] = b0;       *(uint4*)&s->b[r0 + 32][kc * 8] = b1; \
    *(uint4*)&s->b[r0 + 64][kc * 8] = b2;  *(uint4*)&s->b[r0 + 96][kc * 8] = b3; \
    *(uint4*)&s->b[r0 + 128][kc * 8] = b4; *(uint4*)&s->b[r0 + 160][kc * 8] = b5; \
    *(uint4*)&s->b[r0 + 192][kc * 8] = b6; *(uint4*)&s->b[r0 + 224][kc * 8] = b7; }
  G3_LOAD(0)
  G3_STORE()
  __syncthreads();
#pragma unroll 1
  for (int kt = 0; kt < nk; ++kt) {
    if (kt + 1 < nk) G3_LOAD(kt + 1)
    hook(kt);
#pragma unroll
    for (int ks = 0; ks < 4; ++ks) {
      bf16x8 af[2], bq[4];
#pragma unroll
      for (int i = 0; i < 2; ++i) af[i] = *(const bf16x8*)&s->a[wr * 64 + i * 32 + fr][ks * 16 + fh * 8];
#pragma unroll
      for (int j = 0; j < 4; ++j) bq[j] = *(const bf16x8*)&s->b[wc * 128 + j * 32 + fr][ks * 16 + fh * 8];
#pragma unroll
      for (int i = 0; i < 2; ++i)
#pragma unroll
        for (int j = 0; j < 4; ++j) acc[i][j] = MFMA(af[i], bq[j], acc[i][j]);
    }
    __syncthreads();
    if (kt + 1 < nk) G3_STORE()
    __syncthreads();
  }
#undef G3_LOAD
#undef G3_STORE
}

template <class EPI>
DI void epilogue_lds2(f32x16 (&acc)[2][4], char* smem, int sub, EPI epi) {
  float* T = (float*)smem;
  int tid = threadIdx.x; asm volatile("" : "+v"(tid));
  const int lane = tid & 63, wave = tid >> 6, wr = wave >> 1, wc = wave & 1, fr = lane & 31, fh = lane >> 5;
#pragma unroll
  for (int i = 0; i < 2; ++i) {
    if (wc == sub) {
#pragma unroll
      for (int j = 0; j < 4; ++j)
#pragma unroll
        for (int r = 0; r < 16; ++r) T[(wr * 32 + crow(r, fh)) * 132 + j * 32 + fr] = acc[i][j][r];
    }
    __syncthreads();
#pragma unroll 2
    for (int e = tid; e < 2048; e += 256) {
      const int tr = e >> 5, c4 = (e & 31) * 4;
      const float4 v = *(const float4*)&T[tr * 132 + c4];
      epi((tr >> 5) * 64 + i * 32 + (tr & 31), c4, v);
    }
    __syncthreads();
  }
}

template <class EPI>
DI void epilogue_lds2w(f32x16 (&acc)[2][4], char* smem, int sub, EPI epi) {
  float* T = (float*)smem;
  int tid = threadIdx.x; asm volatile("" : "+v"(tid));
  const int lane = tid & 63, wave = tid >> 6, wr = wave >> 1, wc = wave & 1, fr = lane & 31, fh = lane >> 5;
#pragma unroll
  for (int i = 0; i < 2; ++i) {
    if (wc == sub) {
#pragma unroll
      for (int j = 0; j < 4; ++j)
#pragma unroll
        for (int r = 0; r < 16; ++r) T[(wr * 32 + crow(r, fh)) * 132 + j * 32 + fr] = acc[i][j][r];
    }
    __syncthreads();
#pragma unroll 2
    for (int e = tid; e < 1024; e += 256) {
      const int tr = e >> 4, c8 = (e & 15) * 8;
      const float4 lo = *(const float4*)&T[tr * 132 + c8];
      const float4 hi = *(const float4*)&T[tr * 132 + c8 + 4];
      epi((tr >> 5) * 64 + i * 32 + (tr & 31), c8, lo, hi);
    }
    __syncthreads();
  }
}

DI void epilogue_rope(f32x16 (&acc)[2][4], char* smem, int sub, bf16_t* dst, int ld, int cb, int row0, float sc) {
  float* T = (float*)smem;
  int tid = threadIdx.x; asm volatile("" : "+v"(tid));
  const int lane = tid & 63, wave = tid >> 6, wr = wave >> 1, wc = wave & 1, fr = lane & 31, fh = lane >> 5;
#pragma unroll
  for (int i = 0; i < 2; ++i) {
    if (wc == sub) {
#pragma unroll
      for (int j = 0; j < 4; ++j)
#pragma unroll
        for (int r = 0; r < 16; ++r) T[(wr * 32 + crow(r, fh)) * 132 + j * 32 + fr] = acc[i][j][r];
    }
    __syncthreads();
#pragma unroll 1
    for (int e = tid; e < 1024; e += 256) {
      const int tr = e >> 4, qi = e & 15;
      const int hd = qi >> 3, ax = (qi >> 2) & 1, f0 = (qi & 3) * 4;
      const int col1 = hd * 64 + ax * 32 + f0;
      const float4 v1 = *(const float4*)&T[tr * 132 + col1];
      const float4 v2 = *(const float4*)&T[tr * 132 + col1 + 16];
      const int rho = row0 + (tr >> 5) * 64 + i * 32 + (tr & 31);
      float a1[4] = {v1.x, v1.y, v1.z, v1.w}, a2[4] = {v2.x, v2.y, v2.z, v2.w}, o1[4], o2[4];
      if (rho < RL_) {
        const int t = rho & 4095;
        const float pos = (float)(ax == 0 ? (t >> 6) : (t & 63));
#pragma unroll
        for (int u = 0; u < 4; ++u) {
          const float ang = pos * __builtin_amdgcn_exp2f(-(float)(f0 + u) * 0.8304820237218406f);
          const float cs = __cosf(ang), sn = __sinf(ang);
          o1[u] = (a1[u] * cs - a2[u] * sn) * sc;
          o2[u] = (a2[u] * cs + a1[u] * sn) * sc;
        }
      } else {
#pragma unroll
        for (int u = 0; u < 4; ++u) { o1[u] = a1[u] * sc; o2[u] = a2[u] * sc; }
      }
      uint2 w1, w2;
      w1.x = pack2(o1[0], o1[1]); w1.y = pack2(o1[2], o1[3]);
      w2.x = pack2(o2[0], o2[1]); w2.y = pack2(o2[2], o2[3]);
      bf16_t* dp = dst + (size_t)rho * ld + cb + col1;
      *(uint2*)dp = w1;
      *(uint2*)(dp + 16) = w2;
    }
    __syncthreads();
  }
}

DI bool xcd_tile(int step, int nM, int nN, int& mt, int& nt) {
  const int xcd = blockIdx.x & 7, nloc = gridDim.x >> 3;
  const int j = (blockIdx.x >> 3) + step * nloc;
  const int mloc = nM >> 3;
  if ((gridDim.x & 7) != 0 || j >= mloc * nN) return false;
  const int per = 8 * nN;
  const int gm = j / per, rem = j - gm * per;
  const int hgt = min(8, mloc - gm * 8);
  const int a = rem % hgt;
  nt = rem / hgt;
  mt = (gm * 8 + a) * 8 + xcd;
  return true;
}

DI void zero_acc(f32x16 (&acc)[2][2]) {
#pragma unroll
  for (int i = 0; i < 2; ++i)
#pragma unroll
    for (int j = 0; j < 2; ++j)
#pragma unroll
      for (int r = 0; r < 16; ++r) acc[i][j][r] = 0.f;
}

template <class EPI>
DI void epilogue_lds(f32x16 (&acc)[2][2], char* smem, EPI epi) {
  float* T = (float*)smem;
  int tid = threadIdx.x; asm volatile("" : "+v"(tid)); const int lane = tid & 63, wave = tid >> 6, wr = wave >> 1, wc = wave & 1, fr = lane & 31, fh = lane >> 5;
#pragma unroll
  for (int i = 0; i < 2; ++i) {
#pragma unroll
    for (int j = 0; j < 2; ++j)
#pragma unroll
      for (int r = 0; r < 16; ++r) T[(wr * 32 + crow(r, fh)) * 132 + wc * 64 + j * 32 + fr] = acc[i][j][r];
    __syncthreads();
#pragma unroll 2
    for (int e = tid; e < 2048; e += 256) {
      const int tr = e >> 5, c4 = (e & 31) * 4;
      const float4 v = *(const float4*)&T[tr * 132 + c4];
      epi((tr >> 5) * 64 + i * 32 + (tr & 31), c4, v);
    }
    __syncthreads();
  }
}

template <class EPI>
DI void epilogue_ldsw(f32x16 (&acc)[2][2], char* smem, EPI epi) {
  float* T = (float*)smem;
  int tid = threadIdx.x; asm volatile("" : "+v"(tid));
  const int lane = tid & 63, wave = tid >> 6, wr = wave >> 1, wc = wave & 1, fr = lane & 31, fh = lane >> 5;
#pragma unroll
  for (int i = 0; i < 2; ++i) {
#pragma unroll
    for (int j = 0; j < 2; ++j)
#pragma unroll
      for (int r = 0; r < 16; ++r) T[(wr * 32 + crow(r, fh)) * 132 + wc * 64 + j * 32 + fr] = acc[i][j][r];
    __syncthreads();
#pragma unroll 2
    for (int e = tid; e < 1024; e += 256) {
      const int tr = e >> 4, c8 = (e & 15) * 8;
      const float4 lo = *(const float4*)&T[tr * 132 + c8];
      const float4 hi = *(const float4*)&T[tr * 132 + c8 + 4];
      epi((tr >> 5) * 64 + i * 32 + (tr & 31), c8, lo, hi);
    }
    __syncthreads();
  }
}

DI void phase_mods(const Params& p_in, char* smem) {
  const Params p = load_params();

  float* ssc = (float*)smem;
  float* red = (float*)(smem + 20480);
  float* mods = (float*)(p.ws + OFF_MODS);
  int tid = threadIdx.x; asm volatile("" : "+v"(tid));
  for (int it = blockIdx.x; it < 192; it += gridDim.x) {
    const int l = it / 96, col0 = (it % 96) * 32;
    __syncthreads();
    for (int e = tid; e < 5120; e += 256) {
      const int v = e >> 10, k = e & 1023;
      const float cv = (v < 4) ? p.c[v * 1024 + k] : p.c_ctx[k];
      ssc[e] = silu_f(cv);
    }
    __syncthreads();
    const int col = tid & 31, kg = tid >> 5;
    float a[5] = {0.f, 0.f, 0.f, 0.f, 0.f};
    const float* w = p.w_mod + (size_t)l * 1024 * 3072 + col0 + col;
    for (int k = kg * 128; k < kg * 128 + 128; k += 32) {
      float wv[32];
#pragma unroll
      for (int u = 0; u < 32; ++u) wv[u] = w[(size_t)(k + u) * 3072];
#pragma unroll
      for (int u = 0; u < 32; ++u)
#pragma unroll
        for (int v = 0; v < 5; ++v) a[v] += ssc[v * 1024 + k + u] * wv[u];
    }
#pragma unroll
    for (int v = 0; v < 5; ++v) red[(kg * 5 + v) * 32 + col] = a[v];
    __syncthreads();
    for (int e = tid; e < 160; e += 256) {
      const int v = e >> 5, cc = e & 31;
      float sum = p.b_mod[l * 3072 + col0 + cc];
      for (int g = 0; g < 8; ++g) sum += red[(g * 5 + v) * 32 + cc];
      mods[(l * 5 + v) * 3072 + col0 + cc] = sum;
    }
  }
}

DI int win_colmap(int n) {
  if (n < 2560) return n;
  if (n < 3840) return n + 32;
  if (n < 4864) {
    const int j = n - 3840, q64 = j >> 6, w = j & 63;
    return (w < 32) ? (3872 + q64 * 32 + w) : (3872 + 512 + q64 * 32 + (w - 32));
  }
  if (n < 5376) return n + 32;
  if (n < 5408) return n - 5376 + 2560;
  return -1;
}

DI void transpose_tile(const float* src, int ldsrc, int kind, const float* rowscale, bf16_t* dst, int lddst, int n0, int k0, float* tile) {
  int tid = threadIdx.x; asm volatile("" : "+v"(tid));
  __syncthreads();
  {
    const int c4 = (tid & 15) * 4, rr = tid >> 4;
    const int n = (kind == 0) ? win_colmap(n0 + c4) : (n0 + c4);
#pragma unroll
    for (int ps = 0; ps < 4; ++ps) {
      const int r = rr + ps * 16, k = k0 + r;
      float4 v = make_float4(0.f, 0.f, 0.f, 0.f);
      if (n >= 0) v = *(const float4*)(src + (size_t)k * ldsrc + n);
      if (rowscale != nullptr && k < 1024) { const float s = rowscale[k]; v.x *= s; v.y *= s; v.z *= s; v.w *= s; }
      tile[r * 65 + c4] = v.x; tile[r * 65 + c4 + 1] = v.y; tile[r * 65 + c4 + 2] = v.z; tile[r * 65 + c4 + 3] = v.w;
    }
  }
  __syncthreads();
  {
    const int k8 = (tid & 7) * 8, nn = tid >> 3;
#pragma unroll
    for (int ps = 0; ps < 2; ++ps) {
      const int r = nn + ps * 32;
      uint4 o;
      o.x = pack2(tile[(k8 + 0) * 65 + r], tile[(k8 + 1) * 65 + r]);
      o.y = pack2(tile[(k8 + 2) * 65 + r], tile[(k8 + 3) * 65 + r]);
      o.z = pack2(tile[(k8 + 4) * 65 + r], tile[(k8 + 5) * 65 + r]);
      o.w = pack2(tile[(k8 + 6) * 65 + r], tile[(k8 + 7) * 65 + r]);
      *(uint4*)(dst + (size_t)(n0 + r) * lddst + k0 + k8) = o;
    }
  }
}

DI void phase_prep(const Params& p_in, int l, char* smem) {
  const Params p = load_params();

  int tid = threadIdx.x; asm volatile("" : "+v"(tid)); const int lane = tid & 63, wave = tid >> 6;
  const float* mods = (const float*)(p.ws + OFF_MODS);
  bf16_t* H = (bf16_t*)(p.ws + OFF_H);
  const int NT_WIN = 88 * 16, NT_WOUT = 16 * 32, NT_PW = 64, NT_CONV = NT_WIN + NT_WOUT + NT_PW;
  const int NT = NT_CONV + R_ / 8;
  for (int it = blockIdx.x; it < NT; it += gridDim.x) {
    if (l == 1 && (it < NT_WIN || (it >= NT_WIN + NT_WOUT && it < NT_CONV))) continue;
    if (it < NT_WIN) {
      transpose_tile(p.w_in + (size_t)l * 1024 * 5408, 5408, 0, nullptr, (bf16_t*)(p.ws + OFF_WIN), 1024, (it / 16) * 64, (it % 16) * 64, (float*)smem);
    } else if (it < NT_WIN + NT_WOUT) {
      const int t = it - NT_WIN;
      transpose_tile(p.w_out + (size_t)l * 2048 * 1024, 1024, 1, p.ssd_norm_w + l * 1024, (bf16_t*)(p.ws + OFF_WOUT), 2048, (t / 32) * 64, (t % 32) * 64, (float*)smem);
    } else if (it < NT_CONV) {
      const int t = it - NT_WIN - NT_WOUT;
      transpose_tile(p.conv_pw_w + (size_t)l * 512 * 512, 512, 1, nullptr, (bf16_t*)(p.ws + OFF_PW), 512, (t / 8) * 64, (t % 8) * 64, (float*)smem);
    } else {
      const int rho0 = (it - NT_CONV) * 8 + wave * 2;
      const float* xs0;
      if (l == 0) xs0 = (rho0 < RL_) ? (p.x + (size_t)rho0 * 1024) : (p.ctx + (size_t)(rho0 - RL_) * 1024);
      else xs0 = (rho0 < RL_) ? (p.out + (size_t)rho0 * 1024) : ((const float*)(p.ws + OFF_XC) + (size_t)(rho0 - RL_) * 1024);
      const int v = (rho0 < RL_) ? (rho0 >> 12) : 4;
      const float* md = mods + (l * 5 + v) * 3072;
      float4 xv[2][4], nwv[4], shv[4], scv4[4];
#pragma unroll
      for (int i = 0; i < 4; ++i) {
        const int cidx = lane * 4 + i * 256;
        xv[0][i] = *(const float4*)(xs0 + cidx);
        xv[1][i] = *(const float4*)(xs0 + 1024 + cidx);
        nwv[i] = *(const float4*)(p.norm_w + l * 1024 + cidx);
        shv[i] = *(const float4*)(md + cidx);
        scv4[i] = *(const float4*)(md + 1024 + cidx);
      }
#pragma unroll
      for (int q = 0; q < 2; ++q) {
        float ss = 0.f;
#pragma unroll
        for (int i = 0; i < 4; ++i) ss += xv[q][i].x * xv[q][i].x + xv[q][i].y * xv[q][i].y + xv[q][i].z * xv[q][i].z + xv[q][i].w * xv[q][i].w;
#pragma unroll
        for (int o = 32; o >= 1; o >>= 1) ss += __shfl_xor(ss, o);
        const float rs = rsqrtf(ss * (1.f / 1024.f) + 1e-6f);
#pragma unroll
        for (int i = 0; i < 4; ++i) {
          const int cidx = lane * 4 + i * 256;
          const float4 nw = nwv[i], sh = shv[i], sc = scv4[i];
          uint2 o;
          o.x = pack2(xv[q][i].x * rs * nw.x * (1.f + sc.x) + sh.x, xv[q][i].y * rs * nw.y * (1.f + sc.y) + sh.y);
          o.y = pack2(xv[q][i].z * rs * nw.z * (1.f + sc.z) + sh.z, xv[q][i].w * rs * nw.w * (1.f + sc.w) + sh.w);
          *(uint2*)(H + (size_t)(rho0 + q) * 1024 + cidx) = o;
        }
      }
    }
  }
}

DI void phase_inproj(const Params& p_in, char* smem) {
  const Params p = load_params();
  int tid = threadIdx.x; asm volatile("" : "+v"(tid)); const int wave = tid >> 6, wc = wave & 1;
  const bf16_t* H = (const bf16_t*)(p.ws + OFF_H);
  const bf16_t* W = (const bf16_t*)(p.ws + OFF_WIN);
  for (int step = 0;; ++step) {
    int mt, nt2;
    if (!xcd_tile(step, NCK, 22, mt, nt2)) break;
    f32x16 acc[2][4];
#pragma unroll
    for (int i = 0; i < 2; ++i)
#pragma unroll
      for (int j = 0; j < 4; ++j)
#pragma unroll
        for (int r = 0; r < 16; ++r) acc[i][j][r] = 0.f;
    const bf16_t* Ab = H + (size_t)mt * 128 * 1024;
    const bf16_t* Bb = W + (size_t)nt2 * 256 * 1024;
    gemm_core3(acc, (GemmS3*)smem,
               [&](int kt, int r, int kv) { return Ab + (size_t)r * 1024 + kt * 64 + kv * 8; },
               [&](int kt, int r, int kv) { return Bb + (size_t)r * 1024 + kt * 64 + kv * 8; }, 16, [](int) {});
    const int row0 = mt * 128;
    {
      const int ntw = nt2 * 2 + wc;
      if (ntw >= 30 && ntw < 38) {
#pragma unroll
        for (int i = 0; i < 2; ++i)
#pragma unroll
          for (int r = 0; r < 16; ++r) {
            acc[i][0][r] = acc[i][0][r] * sigmoid_f(acc[i][1][r]);
            acc[i][2][r] = acc[i][2][r] * sigmoid_f(acc[i][3][r]);
          }
      }
    }
#pragma unroll 1
    for (int sub = 0; sub < 2; ++sub) {
      const int nt = nt2 * 2 + sub;
      if (nt >= 43) break;
      if (nt >= 30 && nt < 38) {
        bf16_t* G = (bf16_t*)(p.ws + OFF_GLU);
        const int cb0 = (nt - 30) * 64;
        epilogue_lds2w(acc, smem, sub, [&](int rl, int c8, float4 lo, float4 hi) {
          if ((c8 & 32) == 0) {
            uint4 o; o.x = pack2(lo.x, lo.y); o.y = pack2(lo.z, lo.w); o.z = pack2(hi.x, hi.y); o.w = pack2(hi.z, hi.w);
            *(uint4*)(G + (size_t)(row0 + rl) * 512 + cb0 + (c8 >> 6) * 32 + (c8 & 31)) = o;
          }
        });
      } else if (nt >= 20 && nt < 24) {
        epilogue_rope(acc, smem, sub, (bf16_t*)(p.ws + OFF_Q), 512, nt * 128 - 2560, row0, 0.18033688011112042f);
      } else if (nt == 24) {
        epilogue_rope(acc, smem, sub, (bf16_t*)(p.ws + OFF_KV), 256, 0, row0, 1.f);
      } else if (nt == 42) {
        float* DT = (float*)(p.ws + OFF_DT);
        epilogue_lds2(acc, smem, sub, [&](int rl, int c4, float4 v) {
          if (c4 < 32) *(float4*)(DT + (size_t)(row0 + rl) * 32 + c4) = v;
        });
      } else {
        bf16_t* dst; int ld, cb;
        if (nt < 12) { dst = (bf16_t*)(p.ws + OFF_XBC); ld = 1536; cb = nt * 128; }
        else if (nt < 20) { dst = (bf16_t*)(p.ws + OFF_Z); ld = 1024; cb = nt * 128 - 1536; }
        else if (nt < 24) { dst = (bf16_t*)(p.ws + OFF_Q); ld = 512; cb = nt * 128 - 2560; }
        else if (nt < 26) { dst = (bf16_t*)(p.ws + OFF_KV); ld = 256; cb = nt * 128 - 3072; }
        else if (nt < 30) { dst = (bf16_t*)(p.ws + OFF_AG); ld = 512; cb = nt * 128 - 3328; }
        else { dst = (bf16_t*)(p.ws + OFF_CG); ld = 512; cb = nt * 128 - 4864; }
        epilogue_lds2w(acc, smem, sub, [&](int rl, int c8, float4 lo, float4 hi) {
          uint4 o; o.x = pack2(lo.x, lo.y); o.y = pack2(lo.z, lo.w); o.z = pack2(hi.x, hi.y); o.w = pack2(hi.z, hi.w);
          *(uint4*)(dst + (size_t)(row0 + rl) * ld + cb + c8) = o;
        });
      }
    }
  }
}

DI void phase_local(const Params& p_in, int l, char* smem) {
  const Params p = load_params();

  int tid = threadIdx.x; asm volatile("" : "+v"(tid)); const int lane = tid & 63;
  const bf16_t* XBC = (const bf16_t*)(p.ws + OFF_XBC);
  bf16_t* XS = (bf16_t*)(p.ws + OFF_H);
  bf16_t* BC = (bf16_t*)(p.ws + OFF_BC);
  float* DT = (float*)(p.ws + OFF_DT);
  float* CS = (float*)(p.ws + OFF_CS);
  const bf16_t* GLU = (const bf16_t*)(p.ws + OFF_GLU);
  bf16_t* HDN = (bf16_t*)(p.ws + OFF_HDN);
  bf16_t* Q = (bf16_t*)(p.ws + OFF_Q);
  bf16_t* KV = (bf16_t*)(p.ws + OFF_KV);
  { float* SSQ = (float*)(p.ws + OFF_RSTD); for (int i = blockIdx.x * 256 + tid; i < R_ * 2; i += gridDim.x * 256) SSQ[i] = 0.f; }
  const int N_CONV = (R_ / 4) * 192 / 256;
  const int N_DT = NCK;
  const int N_CF = R_ / 16;
  const int N_ROPE = 0;
  const int N_QC = 0;
  const int NT = N_CF + N_DT + N_CONV + N_ROPE + N_QC;
  for (int it0 = blockIdx.x; it0 < NT; it0 += gridDim.x) {
    int it = it0;
    if (it < N_CF) {
      float* sst = (float*)smem;
      unsigned* sIn = (unsigned*)(smem + 256);
      const int row0 = it * 16;
      const int seq0 = (row0 < RL_) ? (row0 & ~4095) : (RL_ + ((row0 - RL_) & ~255));
      const int slen = (row0 < RL_) ? 4096 : 256;
      const int t0 = row0 - seq0;
      const int c0 = tid * 2;
      __syncthreads();
      if (tid < 32) sst[tid] = 0.f;
      for (int idx = tid; idx < 46 * 64; idx += 256) {
        const int rr = idx >> 6, c16 = idx & 63;
        const int tt = t0 - 15 + rr;
        uint4 val = make_uint4(0u, 0u, 0u, 0u);
        if (tt >= 0 && tt < slen) val = *(const uint4*)(GLU + (size_t)(seq0 + tt) * 512 + c16 * 8);
        *(uint4*)&sIn[rr * 256 + c16 * 4] = val;
      }
      float w0[31], w1[31];
#pragma unroll
      for (int k = 0; k < 31; ++k) {
        const float2 wv = *(const float2*)(p.conv_dw_w + ((size_t)l * 31 + k) * 512 + c0);
        w0[k] = wv.x; w1[k] = wv.y;
      }
      const float2 bv = *(const float2*)(p.conv_dw_b + l * 512 + c0);
      float a0[16], a1[16];
#pragma unroll
      for (int r = 0; r < 16; ++r) { a0[r] = bv.x; a1[r] = bv.y; }
      __syncthreads();
#pragma unroll
      for (int tp = 0; tp < 46; ++tp) {
        const unsigned u = sIn[tp * 256 + tid];
        const float x0 = lo2f(u), x1 = hi2f(u);
#pragma unroll
        for (int r = 0; r < 16; ++r) {
          const int k = tp - r;
          if (k >= 0 && k < 31) { a0[r] += w0[k] * x0; a1[r] += w1[k] * x1; }
        }
        if ((tp & 7) == 7) __builtin_amdgcn_sched_barrier(0);
      }
      {
        float v[32];
#pragma unroll
        for (int r = 0; r < 16; ++r) { v[2 * r] = a0[r] + a1[r]; v[2 * r + 1] = a0[r] * a0[r] + a1[r] * a1[r]; }
#pragma unroll
        for (int i = 0; i < 16; ++i) { const bool up = (lane & 32) != 0; const float keep = up ? v[i + 16] : v[i]; const float send = up ? v[i] : v[i + 16]; v[i] = keep + __shfl_xor(send, 32); }
#pragma unroll
        for (int i = 0; i < 8; ++i) { const bool up = (lane & 16) != 0; const float keep = up ? v[i + 8] : v[i]; const float send = up ? v[i] : v[i + 8]; v[i] = keep + __shfl_xor(send, 16); }
#pragma unroll
        for (int i = 0; i < 4; ++i) { const bool up = (lane & 8) != 0; const float keep = up ? v[i + 4] : v[i]; const float send = up ? v[i] : v[i + 4]; v[i] = keep + __shfl_xor(send, 8); }
#pragma unroll
        for (int i = 0; i < 2; ++i) { const bool up = (lane & 4) != 0; const float keep = up ? v[i + 2] : v[i]; const float send = up ? v[i] : v[i + 2]; v[i] = keep + __shfl_xor(send, 4); }
        { const bool up = (lane & 2) != 0; const float keep = up ? v[1] : v[0]; const float send = up ? v[0] : v[1]; v[0] = keep + __shfl_xor(send, 2); }
        v[0] += __shfl_xor(v[0], 1);
        __syncthreads();
        if ((lane & 1) == 0) atomicAdd(&sst[lane >> 1], v[0]);
      }
      __syncthreads();
      const float2 lw = *(const float2*)(p.conv_ln_w + l * 512 + c0);
      const float2 lb = *(const float2*)(p.conv_ln_b + l * 512 + c0);
#pragma unroll
      for (int r = 0; r < 16; ++r) {
        const float mean = sst[r * 2] * (1.f / 512.f);
        const float var = fmaxf(sst[r * 2 + 1] * (1.f / 512.f) - mean * mean, 0.f);
        const float rs = rsqrtf(var + 1e-6f);
        const float y0 = (a0[r] - mean) * rs * lw.x + lb.x;
        const float y1 = (a1[r] - mean) * rs * lw.y + lb.y;
        *(unsigned*)(HDN + (size_t)(row0 + r) * 512 + c0) = pack2(silu_f(y0), silu_f(y1));
        if ((r & 3) == 3) __builtin_amdgcn_sched_barrier(0);
      }
      continue;
    }
    it -= N_CF;
    if (it < N_DT) {
      float* sdt = (float*)smem;
      float* ssum = (float*)(smem + 128 * 33 * 4);
      const int row0 = it * 128;
      __syncthreads();
      for (int e = tid; e < 4096; e += 256) {
        const int r = e >> 5, cidx = e & 31;
        const float raw = DT[(size_t)(row0 + r) * 32 + cidx] + p.ssd_dt_bias[l * 32 + cidx];
        const float sp = (raw > 20.f) ? raw : __logf(1.f + __expf(raw));
        DT[(size_t)(row0 + r) * 32 + cidx] = sp;
        sdt[r * 33 + cidx] = sp;
      }
      __syncthreads();
      const int col = tid & 31, seg = tid >> 5;
      const float a = -expf(p.ssd_a_log[l * 32 + col]);
      float loc[16];
      float run = 0.f;
      if (col < 16) {
#pragma unroll
        for (int r = 0; r < 16; ++r) { run += sdt[(seg * 16 + r) * 33 + col] * a; loc[r] = run; }
      } else {
#pragma unroll
        for (int r = 15; r >= 0; --r) { run += sdt[(seg * 16 + r) * 33 + col] * a; loc[r] = run; }
      }
      ssum[seg * 32 + col] = run;
      __syncthreads();
      float off = 0.f;
      if (col < 16) { for (int s2 = 0; s2 < seg; ++s2) off += ssum[s2 * 32 + col]; }
      else { for (int s2 = 7; s2 > seg; --s2) off += ssum[s2 * 32 + col]; }
#pragma unroll
      for (int r = 0; r < 16; ++r) CS[(size_t)(row0 + seg * 16 + r) * 32 + col] = off + loc[r];
      continue;
    }
    it -= N_DT;
    if (it < N_CONV) {
      const int e = it * 256 + tid;
      const int rb = e / 192, cgp = e % 192, ch0 = cgp * 8;
      const int rho0 = rb * 4;
      const int seq0 = (rho0 < RL_) ? (rho0 & ~4095) : (RL_ + ((rho0 - RL_) & ~255));
      const int slen = (rho0 < RL_) ? 4096 : 256;
      const int t0 = rho0 - seq0;
      uint4 xr[8];
#pragma unroll
      for (int i = 0; i < 8; ++i) {
        const int tt = t0 + i - 2;
        xr[i] = make_uint4(0u, 0u, 0u, 0u);
        if (tt >= 0 && tt < slen) xr[i] = *(const uint4*)(XBC + (size_t)(seq0 + tt) * 1536 + ch0);
      }
      float wk[5][8];
#pragma unroll
      for (int k = 0; k < 5; ++k) {
        const float4 w0 = *(const float4*)(p.ssd_conv_w + ((size_t)l * 5 + k) * 1536 + ch0);
        const float4 w1 = *(const float4*)(p.ssd_conv_w + ((size_t)l * 5 + k) * 1536 + ch0 + 4);
        wk[k][0] = w0.x; wk[k][1] = w0.y; wk[k][2] = w0.z; wk[k][3] = w0.w; wk[k][4] = w1.x; wk[k][5] = w1.y; wk[k][6] = w1.z; wk[k][7] = w1.w;
      }
      float bias[8];
      {
        const float4 b0 = *(const float4*)(p.ssd_conv_b + l * 1536 + ch0);
        const float4 b1 = *(const float4*)(p.ssd_conv_b + l * 1536 + ch0 + 4);
        bias[0] = b0.x; bias[1] = b0.y; bias[2] = b0.z; bias[3] = b0.w; bias[4] = b1.x; bias[5] = b1.y; bias[6] = b1.z; bias[7] = b1.w;
      }
#pragma unroll
      for (int r = 0; r < 4; ++r) {
        float a[8];
#pragma unroll
        for (int c = 0; c < 8; ++c) a[c] = bias[c];
#pragma unroll
        for (int k = 0; k < 5; ++k) {
          const uint4 u = xr[r + k];
          a[0] += wk[k][0] * lo2f(u.x); a[1] += wk[k][1] * hi2f(u.x); a[2] += wk[k][2] * lo2f(u.y); a[3] += wk[k][3] * hi2f(u.y);
          a[4] += wk[k][4] * lo2f(u.z); a[5] += wk[k][5] * hi2f(u.z); a[6] += wk[k][6] * lo2f(u.w); a[7] += wk[k][7] * hi2f(u.w);
        }
        uint4 o;
        o.x = pack2(silu_f(a[0]), silu_f(a[1])); o.y = pack2(silu_f(a[2]), silu_f(a[3]));
        o.z = pack2(silu_f(a[4]), silu_f(a[5])); o.w = pack2(silu_f(a[6]), silu_f(a[7]));
        const size_t rho = (size_t)(rho0 + r);
        if (ch0 < 1024) *(uint4*)(XS + rho * 1024 + ch0) = o;
        else *(uint4*)(BC + rho * 512 + (ch0 - 1024)) = o;
      }
      continue;
    }
    it -= N_CONV;
    if (it < N_ROPE) {
      const int e = it * 256 + tid;
      const int rho = e / 40, rem = e % 40, hd = rem >> 2, sub = rem & 3;
      const int axis = sub >> 1, half = sub & 1;
      const int t = rho & 4095;
      const float pos = (float)(axis == 0 ? (t >> 6) : (t & 63));
      bf16_t* base = ((hd < 8) ? (Q + (size_t)rho * 512 + hd * 64) : (KV + (size_t)rho * 256 + (hd - 8) * 64)) + axis * 32 + half * 8;
      const float sc = (hd < 8) ? 0.18033688011112042f : 1.f;
      const uint4 u1 = *(const uint4*)base, u2 = *(const uint4*)(base + 16);
      const unsigned a1[4] = {u1.x, u1.y, u1.z, u1.w}, a2[4] = {u2.x, u2.y, u2.z, u2.w};
      unsigned o1[4], o2[4];
#pragma unroll
      for (int i = 0; i < 4; ++i) {
        float r1[2], r2[2];
#pragma unroll
        for (int hl = 0; hl < 2; ++hl) {
          const float f = (float)(half * 8 + 2 * i + hl);
          const float ang = pos * exp2f(-f * 0.8304820237218406f);
          const float cs = __cosf(ang), sn = __sinf(ang);
          const float t1 = hl ? hi2f(a1[i]) : lo2f(a1[i]);
          const float t2 = hl ? hi2f(a2[i]) : lo2f(a2[i]);
          r1[hl] = (t1 * cs - t2 * sn) * sc;
          r2[hl] = (t2 * cs + t1 * sn) * sc;
        }
        o1[i] = pack2(r1[0], r1[1]); o2[i] = pack2(r2[0], r2[1]);
      }
      *(uint4*)base = make_uint4(o1[0], o1[1], o1[2], o1[3]);
      *(uint4*)(base + 16) = make_uint4(o2[0], o2[1], o2[2], o2[3]);
      continue;
    }
    it -= N_ROPE;
    {
      const int e = it * 256 + tid;
      const int rho = RL_ + e / 256, c2 = (e % 256) * 2;
      unsigned* ptr = (unsigned*)(Q + (size_t)rho * 512 + c2);
      const unsigned u = *ptr;
      *ptr = pack2(lo2f(u) * 0.18033688011112042f, hi2f(u) * 0.18033688011112042f);
    }
  }
}

DI void attn_item(const Params& p_in, int l, char* smem, int b, int qblk, int g, int hp, bool ctxq) {
  const Params p = load_params();

  bf16_t* sK = (bf16_t*)smem;
  bf16_t* sV = (bf16_t*)(smem + 128 * 72 * 2);
  int tid = threadIdx.x; asm volatile("" : "+v"(tid)); const int lane = tid & 63, wave = tid >> 6, fr = lane & 31, fh = lane >> 5;
  const int head = g * 4 + hp * 2 + (wave >> 1);
  const int qh = wave & 1;
  const int qrow0 = (ctxq ? (RL_ + b * 256) : (b * 4096)) + qblk * 128 + qh * 64;
  const int qpos0 = qblk * 128 + qh * 64;
  bf16_t* Q = (bf16_t*)(p.ws + OFF_Q);
  const bf16_t* KV = (const bf16_t*)(p.ws + OFF_KV);
  const bf16_t* AG = (const bf16_t*)(p.ws + OFF_AG);
  f32x16 o[2][2];
  zero_acc(o);
  float m[2], lsum[2];
  m[0] = m[1] = p.attn_sink[l * 8 + head] * 1.4426950408889634f;
  lsum[0] = lsum[1] = 1.f;
  const int nhb = ctxq ? 4 : 10;
  auto hb_row = [&](int hb) -> int {
    if (hb >= nhb) return -1;
    if (hb < 4) return RL_ + b * 256 + hb * 64;
    const int kp = (qblk - 1) * 128 + (hb - 4) * 64;
    if (kp < 0 || kp >= 4096) return -1;
    return b * 4096 + kp;
  };
  auto hb_next = [&](int hb) -> int { int n = hb + 1; while (n < nhb && hb_row(n) < 0) ++n; return n; };
  const int sr = tid >> 3, scv = tid & 7;
  uint4 kp0, kp1, vp0, vp1;
#define ATT_PREFETCH(ROW0) { const bf16_t* kvp = KV + (size_t)((ROW0) + sr) * 256 + g * 64 + scv * 8; \
    kp0 = *(const uint4*)(kvp); kp1 = *(const uint4*)(kvp + 32 * 256); vp0 = *(const uint4*)(kvp + 128); vp1 = *(const uint4*)(kvp + 128 + 32 * 256); }
#define ATT_STORE(BUF) { bf16_t* k_ = sK + (BUF) * 64 * 72; bf16_t* v_ = sV + (BUF) * 64 * 72; \
    *(uint4*)&k_[sr * 72 + scv * 8] = kp0; *(uint4*)&k_[(sr + 32) * 72 + scv * 8] = kp1; \
    *(uint4*)&v_[sr * 72 + scv * 8] = vp0; *(uint4*)&v_[(sr + 32) * 72 + scv * 8] = vp1; }
  int pbuf = 0;
  __syncthreads();
  ATT_PREFETCH(hb_row(0))
  ATT_STORE(0)
  __syncthreads();
  for (int hb = 0; hb < nhb; hb = hb_next(hb)) {
    const int nxt = hb_next(hb);
    if (nxt < nhb) ATT_PREFETCH(hb_row(nxt))
    int kpos0 = 0;
    bool masked = false;
    if (hb >= 4) { kpos0 = (qblk - 1) * 128 + (hb - 4) * 64; masked = (hb != 6 && hb != 7); }
    const bf16_t* cK = sK + pbuf * 64 * 72;
    const bf16_t* cV = sV + pbuf * 64 * 72;
    bf16x8 qf[2][4];
#pragma unroll
    for (int j = 0; j < 2; ++j)
#pragma unroll
      for (int ks = 0; ks < 4; ++ks)
        qf[j][ks] = *(const bf16x8*)(Q + (size_t)(qrow0 + j * 32 + fr) * 512 + head * 64 + ks * 16 + fh * 8);
#pragma unroll 1
    for (int kb = 0; kb < 2; ++kb) {
      if (masked) {
        const int klo = kpos0 + kb * 32, khi = klo + 31;
        if (klo - (qpos0 + 63) > 128 || qpos0 - khi > 128) continue;
      }
      bf16x8 pb[2][2];
#pragma unroll
      for (int j = 0; j < 2; ++j) {
        f32x16 st[2];
#pragma unroll
        for (int r = 0; r < 16; ++r) st[j][r] = -m[j];
#pragma unroll
        for (int ks = 0; ks < 4; ++ks) {
          const bf16x8 kf = *(const bf16x8*)&cK[(kb * 32 + fr) * 72 + ks * 16 + fh * 8];
          st[j] = MFMA(kf, qf[j][ks], st[j]);
        }
        if (masked && (((qpos0 + 63) - (kpos0 + kb * 32) > 128) || ((kpos0 + kb * 32 + 31) - qpos0 > 128))) {
          const int qpos = qpos0 + j * 32 + fr;
#pragma unroll
          for (int r = 0; r < 16; ++r) {
            const int d = qpos - (kpos0 + kb * 32 + crow(r, fh));
            if (d > 128 || d < -128) st[j][r] = -1e30f;
          }
        }
        float mx = st[j][0];
#pragma unroll
        for (int r = 1; r < 16; ++r) mx = fmaxf(mx, st[j][r]);
        mx = xhalf_max(mx);
        const bool grow = mx > 8.f;
        if (__builtin_amdgcn_ballot_w64(grow) != 0ull) {
          const float delta = grow ? mx : 0.f;
          const float alpha = __builtin_amdgcn_exp2f(-delta);
#pragma unroll
          for (int r = 0; r < 16; ++r) st[j][r] -= delta;
          lsum[j] *= alpha;
          m[j] += delta;
#pragma unroll
          for (int mt = 0; mt < 2; ++mt)
#pragma unroll
            for (int r = 0; r < 16; ++r) o[mt][j][r] *= alpha;
        }
        float rs = 0.f;
#pragma unroll
        for (int r = 0; r < 16; ++r) { const float pv = __builtin_amdgcn_exp2f(st[j][r]); st[j][r] = pv; rs += pv; }
        rs = xhalf_sum(rs);
        lsum[j] += rs;
#pragma unroll
        for (int s = 0; s < 2; ++s) {
          uint4 pk;
          pk.x = pack2(st[j][8 * s + 0], st[j][8 * s + 1]); pk.y = pack2(st[j][8 * s + 2], st[j][8 * s + 3]);
          pk.z = pack2(st[j][8 * s + 4], st[j][8 * s + 5]); pk.w = pack2(st[j][8 * s + 6], st[j][8 * s + 7]);
          pb[j][s] = __builtin_bit_cast(bf16x8, pk);
        }
      }
#pragma unroll
      for (int s = 0; s < 2; ++s)
#pragma unroll
        for (int mt = 0; mt < 2; ++mt) {
          const bf16x8 vf = tr_frag(cV, 72, kb * 32 + 16 * s + 4 * fh, kb * 32 + 16 * s + 8 + 4 * fh, mt * 32);
#pragma unroll
          for (int j = 0; j < 2; ++j) o[mt][j] = MFMA(vf, pb[j][s], o[mt][j]);
        }
    }
    if (nxt < nhb) ATT_STORE(pbuf ^ 1)
    pbuf ^= 1;
    __syncthreads();
  }
#undef ATT_PREFETCH
#undef ATT_STORE
#pragma unroll
  for (int j = 0; j < 2; ++j) {
    const float inv = 1.f / lsum[j];
    const size_t rho = (size_t)(qrow0 + j * 32 + fr);
#pragma unroll
    for (int mt = 0; mt < 2; ++mt)
#pragma unroll
      for (int g4 = 0; g4 < 4; ++g4) {
        const int d0 = mt * 32 + 8 * g4 + 4 * fh;
        const uint2 gv = *(const uint2*)(AG + rho * 512 + head * 64 + d0);
        uint2 ov;
        ov.x = pack2(o[mt][j][g4 * 4 + 0] * inv * silu_f(lo2f(gv.x)), o[mt][j][g4 * 4 + 1] * inv * silu_f(hi2f(gv.x)));
        ov.y = pack2(o[mt][j][g4 * 4 + 2] * inv * silu_f(lo2f(gv.y)), o[mt][j][g4 * 4 + 3] * inv * silu_f(hi2f(gv.y)));
        *(uint2*)(Q + rho * 512 + head * 64 + d0) = ov;
      }
  }
}

DI void states_item(const Params& p_in, char* smem, int ck, int g, int hq) {
  const Params p = load_params();

  bf16_t* sB = (bf16_t*)smem;
  bf16_t* sX = (bf16_t*)(smem + 128 * 136 * 2);
  int tid = threadIdx.x; asm volatile("" : "+v"(tid)); const int lane = tid & 63, wave = tid >> 6, wr = wave >> 1, wc = wave & 1, fr = lane & 31, fh = lane >> 5;
  const bf16_t* BC = (const bf16_t*)(p.ws + OFF_BC);
  const bf16_t* XS = (const bf16_t*)(p.ws + OFF_H);
  const float* DT = (const float*)(p.ws + OFF_DT);
  const float* CS = (const float*)(p.ws + OFF_CS);
  bf16_t* ST = (bf16_t*)(p.ws + OFF_ST);
  float* CDEC = (float*)(p.ws + OFF_CDEC);
  const int row0 = ck * 128;
  __syncthreads();
  for (int v = tid; v < 2048; v += 256) {
    const int r = v >> 4, cv = v & 15;
    *(uint4*)&sB[r * 136 + cv * 8] = *(const uint4*)(BC + (size_t)(row0 + r) * 512 + g * 128 + cv * 8);
  }
  __syncthreads();
  bf16x8 bfr[2][8];
#pragma unroll
  for (int j = 0; j < 2; ++j)
#pragma unroll
    for (int ks = 0; ks < 8; ++ks) bfr[j][ks] = tr_frag(sB, 136, ks * 16 + 8 * fh, ks * 16 + 8 * fh + 4, wc * 64 + j * 32);
  const int slr = tid >> 3, scv = tid & 7;
  uint4 xq0, xq1, xq2, xq3;
  float dq0, dq1, dq2, dq3, cq0, cq1, cq2, cq3, cendq;
#define ST_PREFETCH(HD) { const int head_ = g * 8 + hq * 4 + ((HD) >> 1), d_ = (HD) & 1, col_ = d_ * 16 + head_; \
    const bf16_t* xp_ = XS + (size_t)(row0 + slr) * 1024 + head_ * 64 + scv * 8; \
    xq0 = *(const uint4*)(xp_); xq1 = *(const uint4*)(xp_ + 32 * 1024); xq2 = *(const uint4*)(xp_ + 64 * 1024); xq3 = *(const uint4*)(xp_ + 96 * 1024); \
    const size_t rb_ = (size_t)(row0 + slr) * 32 + col_; \
    dq0 = DT[rb_]; dq1 = DT[rb_ + 32 * 32]; dq2 = DT[rb_ + 64 * 32]; dq3 = DT[rb_ + 96 * 32]; \
    cq0 = CS[rb_]; cq1 = CS[rb_ + 32 * 32]; cq2 = CS[rb_ + 64 * 32]; cq3 = CS[rb_ + 96 * 32]; \
    cendq = CS[(size_t)(row0 + (d_ == 0 ? 127 : 0)) * 32 + col_]; }
#define ST_SCALE_STORE(X, DTV, CSV, ROW) { const float sc_ = (DTV) * __expf(cend - (CSV)); uint4 o_; \
    o_.x = pack2(lo2f(X.x) * sc_, hi2f(X.x) * sc_); o_.y = pack2(lo2f(X.y) * sc_, hi2f(X.y) * sc_); \
    o_.z = pack2(lo2f(X.z) * sc_, hi2f(X.z) * sc_); o_.w = pack2(lo2f(X.w) * sc_, hi2f(X.w) * sc_); \
    *(uint4*)&sX[(ROW) * 72 + scv * 8] = o_; }
  ST_PREFETCH(0)
#pragma unroll 1
  for (int hd = 0; hd < 8; ++hd) {
    const int head = g * 8 + hq * 4 + (hd >> 1), d = hd & 1;
    const float cend = cendq;
    ST_SCALE_STORE(xq0, dq0, cq0, slr)
    ST_SCALE_STORE(xq1, dq1, cq1, slr + 32)
    ST_SCALE_STORE(xq2, dq2, cq2, slr + 64)
    ST_SCALE_STORE(xq3, dq3, cq3, slr + 96)
    if (hd < 7) ST_PREFETCH(hd + 1)
    __syncthreads();
    f32x16 acc[2];
#pragma unroll
    for (int j = 0; j < 2; ++j)
#pragma unroll
      for (int r = 0; r < 16; ++r) acc[j][r] = 0.f;
#pragma unroll
    for (int ks = 0; ks < 8; ++ks) {
      const bf16x8 af = tr_frag(sX, 72, ks * 16 + 8 * fh, ks * 16 + 8 * fh + 4, wr * 32);
#pragma unroll
      for (int j = 0; j < 2; ++j) acc[j] = MFMA(af, bfr[j][ks], acc[j]);
    }
    bf16_t* dst = ST + ((size_t)(ck * 2 + d) * 16 + head) * 8192;
#pragma unroll
    for (int j = 0; j < 2; ++j)
#pragma unroll
      for (int r = 0; r < 16; ++r) dst[(wr * 32 + crow(r, fh)) * 128 + wc * 64 + j * 32 + fr] = f2bf(acc[j][r]);
    if (tid == 0) CDEC[(ck * 2 + d) * 16 + head] = __expf(cend);
    __syncthreads();
  }
}

DI void pw_item(const Params& p_in, int l, char* smem, int mt, int nt) {
  const Params p = load_params();

  GemmS* s = (GemmS*)smem;
  int tid = threadIdx.x; asm volatile("" : "+v"(tid)); const int lane = tid & 63, wave = tid >> 6, wr = wave >> 1, wc = wave & 1, fr = lane & 31, fh = lane >> 5;
  const bf16_t* Ab = (const bf16_t*)(p.ws + OFF_HDN) + (size_t)mt * 128 * 512;
  const bf16_t* Bb = (const bf16_t*)(p.ws + OFF_PW) + (size_t)nt * 128 * 512;
  bf16_t* CG = (bf16_t*)(p.ws + OFF_CG);
  f32x16 acc[2][2];
  zero_acc(acc);
  gemm_core2(acc, (GemmS2*)smem,
             [&](int kt, int r, int kv) { return Ab + (size_t)r * 512 + kt * 64 + kv * 8; },
             [&](int kt, int r, int kv) { return Bb + (size_t)r * 512 + kt * 64 + kv * 8; }, 8, [](int) {});
  const float* pwb = p.conv_pw_b + l * 512 + nt * 128;
  epilogue_ldsw(acc, smem, [&](int rl, int c8, float4 lo, float4 hi) {
    bf16_t* ptr = CG + (size_t)(mt * 128 + rl) * 512 + nt * 128 + c8;
    const uint4 gv = *(const uint4*)ptr;
    const float4 b0 = *(const float4*)(pwb + c8), b1 = *(const float4*)(pwb + c8 + 4);
    uint4 o;
    o.x = pack2((lo.x + b0.x) * silu_f(lo2f(gv.x)), (lo.y + b0.y) * silu_f(hi2f(gv.x)));
    o.y = pack2((lo.z + b0.z) * silu_f(lo2f(gv.y)), (lo.w + b0.w) * silu_f(hi2f(gv.y)));
    o.z = pack2((hi.x + b1.x) * silu_f(lo2f(gv.z)), (hi.y + b1.y) * silu_f(hi2f(gv.z)));
    o.w = pack2((hi.z + b1.z) * silu_f(lo2f(gv.w)), (hi.w + b1.w) * silu_f(hi2f(gv.w)));
    *(uint4*)ptr = o;
  });
}

DI void phase_mix(const Params& p, int l, char* smem) {
  const int G = gridDim.x;
  const int N_ATT = 512 + (l == 0 ? 32 : 0);
  for (int it = blockIdx.x; it < N_ATT; it += G) {
    if (it < 512) attn_item(p, l, smem, it >> 7, (it >> 2) & 31, (it >> 1) & 1, it & 1, false);
    else { const int t = it - 512; attn_item(p, l, smem, t >> 3, (t >> 2) & 1, (t >> 1) & 1, t & 1, true); }
  }
  for (int it = (blockIdx.x + G - 32) % G; it < NCK * 4; it += G) states_item(p, smem, it >> 2, (it >> 1) & 1, it & 1);
  for (int it = (blockIdx.x + G - 64) % G; it < NCK * 4; it += G) pw_item(p, l, smem, it >> 2, it & 3);
}

DI void phase_scan(const Params& p_in) {
  const Params p = load_params();

  bf16_t* ST = (bf16_t*)(p.ws + OFF_ST);
  const float* CDEC = (const float*)(p.ws + OFF_CDEC);
  for (int it = blockIdx.x; it < 512; it += gridDim.x) {
    const int e = it * 256 + threadIdx.x;
    const int bdh = e >> 10, v8 = e & 1023;
    const int b = bdh >> 5, d = (bdh >> 4) & 1, h = bdh & 15;
    float s[8];
#pragma unroll
    for (int i = 0; i < 8; ++i) s[i] = 0.f;
    auto ckof = [&](int i) {
      if (d == 0) return (i < 2) ? (128 + 2 * b + i) : (32 * b + (i - 2));
      return (i < 2) ? (128 + 2 * b + (1 - i)) : (32 * b + 31 - (i - 2));
    };
    auto pof = [&](int i) { const int ck = ckof(i); return (uint4*)(ST + ((size_t)(ck * 2 + d) * 16 + h) * 8192 + v8 * 8); };
    auto dof = [&](int i) { const int ck = ckof(i); return CDEC[(ck * 2 + d) * 16 + h]; };
    uint4 buf[8]; float dc[8];
#pragma unroll
    for (int i = 0; i < 7; ++i) { buf[i] = *pof(i); dc[i] = dof(i); }
#pragma unroll
    for (int i = 0; i < 34; ++i) {
      if (i + 7 < 34) { buf[(i + 7) & 7] = *pof(i + 7); dc[(i + 7) & 7] = dof(i + 7); }
      const uint4 cur = buf[i & 7];
      const float dec = dc[i & 7];
      uint4 o;
      o.x = pack2(s[0], s[1]); o.y = pack2(s[2], s[3]); o.z = pack2(s[4], s[5]); o.w = pack2(s[6], s[7]);
      *pof(i) = o;
      s[0] = s[0] * dec + lo2f(cur.x); s[1] = s[1] * dec + hi2f(cur.x);
      s[2] = s[2] * dec + lo2f(cur.y); s[3] = s[3] * dec + hi2f(cur.y);
      s[4] = s[4] * dec + lo2f(cur.z); s[5] = s[5] * dec + hi2f(cur.z);
      s[6] = s[6] * dec + lo2f(cur.w); s[7] = s[7] * dec + hi2f(cur.w);
    }
  }
}

DI void phase_ssdy(const Params& p_in, int l, char* smem) {
  const Params p = load_params();

  bf16_t* sB = (bf16_t*)smem;
  bf16_t* sX = (bf16_t*)(smem + 128 * 136 * 2);
  float* sF = (float*)(smem + 128 * 136 * 2 + 128 * 72 * 2);
  float* sSS = sF + 512;
  int tid = threadIdx.x; asm volatile("" : "+v"(tid)); const int lane = tid & 63, wave = tid >> 6, fr = lane & 31, fh = lane >> 5;
  const int wl = wave >> 1, w2 = wave & 1;
  const bf16_t* BC = (const bf16_t*)(p.ws + OFF_BC);
  const bf16_t* XS = (const bf16_t*)(p.ws + OFF_H);
  const float* DT = (const float*)(p.ws + OFF_DT);
  const float* CS = (const float*)(p.ws + OFF_CS);
  const bf16_t* ST = (const bf16_t*)(p.ws + OFF_ST);
  bf16_t* Z = (bf16_t*)(p.ws + OFF_Z);
  float* RSTD = (float*)(p.ws + OFF_RSTD);
  const int nck = (l == 0) ? NCK : 128;
  const int nh = (l == 0) ? 2 : 8;
  const int nsplit = 8 / nh;
  for (int it0 = blockIdx.x; it0 < nck * 4 * nsplit; it0 += gridDim.x) {
    const int hq = it0 % nsplit, it = it0 / nsplit;
    const int hbeg = hq * nh, hend = hbeg + nh;
    const int ck = it >> 2, g = (it >> 1) & 1, lh = it & 1;
    const int row0 = ck * 128;
    const int lbase = lh * 64 + wl * 32;
    __syncthreads();
    for (int v = tid; v < 2048; v += 256) {
      const int r = v >> 4, cv = v & 15;
      *(uint4*)&sB[r * 136 + cv * 8] = *(const uint4*)(BC + (size_t)(row0 + r) * 512 + g * 128 + cv * 8);
    }
    if (tid < 64) sSS[tid] = 0.f;
    const bf16_t* cptr = BC + (size_t)(row0 + lbase + fr) * 512 + 256 + g * 128 + fh * 8;
    bf16x8 cf[8];
#pragma unroll
    for (int ks = 0; ks < 8; ++ks) cf[ks] = *(const bf16x8*)(cptr + ks * 16);
    const int lrx = tid >> 3, cvx = tid & 7;
    const bf16_t* xsrc = XS + (size_t)(row0 + lrx) * 1024 + cvx * 8;
    uint4 xp0, xp1, xp2, xp3;
    float fp0 = 0.f, fp1 = 0.f, fp2 = 0.f, fp3 = 0.f;
    {
      const int head = g * 8 + hbeg;
      xp0 = *(const uint4*)(xsrc + head * 64);
      xp1 = *(const uint4*)(xsrc + head * 64 + 32 * 1024);
      xp2 = *(const uint4*)(xsrc + head * 64 + 64 * 1024);
      xp3 = *(const uint4*)(xsrc + head * 64 + 96 * 1024);
      if (tid < 128) {
        const size_t rho = (size_t)(row0 + tid);
        fp0 = CS[rho * 32 + head]; fp1 = CS[rho * 32 + 16 + head]; fp2 = DT[rho * 32 + head]; fp3 = DT[rho * 32 + 16 + head];
      }
    }
    __syncthreads();
    f32x16 cb[2];
#pragma unroll
    for (int j = 0; j < 2; ++j) {
#pragma unroll
      for (int r = 0; r < 16; ++r) cb[j][r] = 0.f;
#pragma unroll
      for (int ks = 0; ks < 8; ++ks) {
        const bf16x8 bq = *(const bf16x8*)&sB[(w2 * 64 + j * 32 + fr) * 136 + ks * 16 + fh * 8];
        cb[j] = MFMA(cf[ks], bq, cb[j]);
      }
    }
    const int pidx = w2 * 32 + fr;
    bf16_t* sCB = sB + 64 * 136;
    __syncthreads();
#pragma unroll
    for (int j = 0; j < 2; ++j)
#pragma unroll
      for (int r = 0; r < 16; ++r) sCB[(wl * 32 + crow(r, fh)) * 136 + w2 * 64 + j * 32 + fr] = f2bf(cb[j][r]);
#pragma unroll 1
    for (int hh = hbeg; hh < hend; ++hh) {
      const int head = g * 8 + hh;
      __syncthreads();
      *(uint4*)&sX[lrx * 72 + cvx * 8] = xp0;
      *(uint4*)&sX[(lrx + 32) * 72 + cvx * 8] = xp1;
      *(uint4*)&sX[(lrx + 64) * 72 + cvx * 8] = xp2;
      *(uint4*)&sX[(lrx + 96) * 72 + cvx * 8] = xp3;
      if (tid < 128) { sF[tid] = fp0; sF[128 + tid] = fp1; sF[256 + tid] = fp2; sF[384 + tid] = fp3; }
      const bf16_t* S0 = ST + ((size_t)(ck * 2 + 0) * 16 + head) * 8192 + (w2 * 32 + fr) * 128 + fh * 8;
      const bf16_t* S1 = ST + ((size_t)(ck * 2 + 1) * 16 + head) * 8192 + (w2 * 32 + fr) * 128 + fh * 8;
      bf16x8 sf0[8];
#pragma unroll
      for (int ks = 0; ks < 8; ++ks) sf0[ks] = *(const bf16x8*)(S0 + ks * 16);
      bf16_t* zrow = Z + (size_t)(row0 + lbase + fr) * 1024 + head * 64 + w2 * 32 + 4 * fh;
      if (hh + 1 < hend) {
        const int hn = head + 1;
        xp0 = *(const uint4*)(xsrc + hn * 64);
        xp1 = *(const uint4*)(xsrc + hn * 64 + 32 * 1024);
        xp2 = *(const uint4*)(xsrc + hn * 64 + 64 * 1024);
        xp3 = *(const uint4*)(xsrc + hn * 64 + 96 * 1024);
        if (tid < 128) {
          const size_t rho = (size_t)(row0 + tid);
          fp0 = CS[rho * 32 + hn]; fp1 = CS[rho * 32 + 16 + hn]; fp2 = DT[rho * 32 + hn]; fp3 = DT[rho * 32 + 16 + hn];
        }
      }
      __syncthreads();
#pragma unroll
      for (int j = 0; j < 2; ++j) {
        const int sidx = w2 * 64 + j * 32 + fr;
        const float csf_s = sF[sidx], csb_s = sF[128 + sidx], dtf_s = sF[256 + sidx], dtb_s = sF[384 + sidx];
        const int s0 = w2 * 64 + j * 32;
        if (s0 + 31 < lbase) {
#pragma unroll 4
          for (int r = 0; r < 16; ++r) {
            const int lidx = lbase + crow(r, fh);
            const float f = __expf(sF[lidx] - csf_s) * dtf_s;
            sB[(wl * 32 + crow(r, fh)) * 136 + sidx] = f2bf(bf2f(sCB[(wl * 32 + crow(r, fh)) * 136 + sidx]) * f);
          }
        } else if (s0 > lbase + 31) {
#pragma unroll 4
          for (int r = 0; r < 16; ++r) {
            const int lidx = lbase + crow(r, fh);
            const float f = __expf(sF[128 + lidx] - csb_s) * dtb_s;
            sB[(wl * 32 + crow(r, fh)) * 136 + sidx] = f2bf(bf2f(sCB[(wl * 32 + crow(r, fh)) * 136 + sidx]) * f);
          }
        } else {
#pragma unroll 4
          for (int r = 0; r < 16; ++r) {
            const int lidx = lbase + crow(r, fh);
            float f = 0.f;
            if (sidx <= lidx) f += __expf(sF[lidx] - csf_s) * dtf_s;
            if (sidx >= lidx) f += __expf(sF[128 + lidx] - csb_s) * dtb_s;
            sB[(wl * 32 + crow(r, fh)) * 136 + sidx] = f2bf(bf2f(sCB[(wl * 32 + crow(r, fh)) * 136 + sidx]) * f);
          }
        }
      }
      __syncthreads();
      bf16x8 sf1[8], cfh[8];
#pragma unroll
      for (int ks = 0; ks < 8; ++ks) { sf1[ks] = *(const bf16x8*)(S1 + ks * 16); cfh[ks] = *(const bf16x8*)(cptr + ks * 16); }
      uint2 zq[4];
#pragma unroll
      for (int g4 = 0; g4 < 4; ++g4) zq[g4] = *(const uint2*)(zrow + 8 * g4);
      f32x16 accy;
#pragma unroll
      for (int r = 0; r < 16; ++r) accy[r] = 0.f;
#pragma unroll
      for (int ks = 0; ks < 8; ++ks) {
        const bf16x8 af = *(const bf16x8*)&sB[(wl * 32 + fr) * 136 + ks * 16 + fh * 8];
        const bf16x8 xf = tr_frag(sX, 72, ks * 16 + 8 * fh, ks * 16 + 8 * fh + 4, w2 * 32);
        accy = MFMA(xf, af, accy);
      }
      {
        f32x16 acct;
#pragma unroll
        for (int r = 0; r < 16; ++r) acct[r] = 0.f;
#pragma unroll
        for (int ks = 0; ks < 8; ++ks) acct = MFMA(sf0[ks], cfh[ks], acct);
        const float ef = __expf(sF[lbase + fr]);
#pragma unroll
        for (int r = 0; r < 16; ++r) accy[r] += ef * acct[r];
#pragma unroll
        for (int r = 0; r < 16; ++r) acct[r] = 0.f;
#pragma unroll
        for (int ks = 0; ks < 8; ++ks) acct = MFMA(sf1[ks], cfh[ks], acct);
        const float eb = __expf(sF[128 + lbase + fr]);
#pragma unroll
        for (int r = 0; r < 16; ++r) accy[r] += eb * acct[r];
      }
      const float dsk = p.ssd_d[l * 16 + head];
      float ssum = 0.f;
#pragma unroll
      for (int g4 = 0; g4 < 4; ++g4) {
        const uint2 xx = *(const uint2*)&sX[(lbase + fr) * 72 + w2 * 32 + 8 * g4 + 4 * fh];
        const uint2 zz = zq[g4];
        const float u0 = (accy[4 * g4 + 0] + dsk * lo2f(xx.x)) * silu_f(lo2f(zz.x));
        const float u1 = (accy[4 * g4 + 1] + dsk * hi2f(xx.x)) * silu_f(hi2f(zz.x));
        const float u2 = (accy[4 * g4 + 2] + dsk * lo2f(xx.y)) * silu_f(lo2f(zz.y));
        const float u3 = (accy[4 * g4 + 3] + dsk * hi2f(xx.y)) * silu_f(hi2f(zz.y));
        ssum += u0 * u0 + u1 * u1 + u2 * u2 + u3 * u3;
        uint2 o; o.x = pack2(u0, u1); o.y = pack2(u2, u3);
        *(uint2*)(zrow + 8 * g4) = o;
      }
      ssum = xhalf_sum(ssum);
      if (fh == 0) atomicAdd(&sSS[wl * 32 + fr], ssum);
    }
    __syncthreads();
    if (tid < 64) atomicAdd(&RSTD[(size_t)(row0 + lh * 64 + tid) * 2 + g], sSS[tid]);
  }
}

DI void phase_outproj(const Params& p_in, int l, char* smem) {
  const Params p = load_params();

  GemmS* s = (GemmS*)smem;
  int tid = threadIdx.x; asm volatile("" : "+v"(tid)); const int lane = tid & 63, wave = tid >> 6, wr = wave >> 1, wc = wave & 1, fr = lane & 31, fh = lane >> 5;
  const bf16_t* Zb = (const bf16_t*)(p.ws + OFF_Z);
  const bf16_t* Qb = (const bf16_t*)(p.ws + OFF_Q);
  const bf16_t* Cb = (const bf16_t*)(p.ws + OFF_CG);
  const bf16_t* W = (const bf16_t*)(p.ws + OFF_WOUT);
  const float* RSTD = (const float*)(p.ws + OFF_RSTD);
  const float* mods = (const float*)(p.ws + OFF_MODS);
  float* XC = (float*)(p.ws + OFF_XC);
  for (int step = 0;; ++step) {
    int mt, nt2;
    if (!xcd_tile(step, 128, 4, mt, nt2)) break;
    f32x16 acc[2][4];
#pragma unroll
    for (int i = 0; i < 2; ++i)
#pragma unroll
      for (int j = 0; j < 4; ++j)
#pragma unroll
        for (int r = 0; r < 16; ++r) acc[i][j][r] = 0.f;
    const bf16_t* Wb = W + (size_t)nt2 * 256 * 2048;
    const bf16_t* A0 = Zb + (size_t)mt * 128 * 1024;
    const bf16_t* A2 = Qb + (size_t)mt * 128 * 512;
    const bf16_t* A3 = Cb + (size_t)mt * 128 * 512;
    float* sScale = (float*)(smem + 55296);
    __syncthreads();
    if (tid < 128) {
      const size_t row = (size_t)(mt * 128 + tid);
      const float r0 = rsqrtf(RSTD[row * 2] * (1.f / 512.f) + 1e-6f);
      const float r1 = rsqrtf(RSTD[row * 2 + 1] * (1.f / 512.f) + 1e-6f);
      sScale[tid * 2] = r0 / r1;
      sScale[tid * 2 + 1] = r1;
    }
    gemm_core3(acc, (GemmS3*)smem,
               [&](int kt, int r, int kv) {
                 const bf16_t* ptr;
                 if (kt < 16) ptr = A0 + (size_t)r * 1024 + kt * 64;
                 else if (kt < 24) ptr = A2 + (size_t)r * 512 + (kt - 16) * 64;
                 else ptr = A3 + (size_t)r * 512 + (kt - 24) * 64;
                 return ptr + kv * 8;
               },
               [&](int kt, int r, int kv) { return Wb + (size_t)r * 2048 + kt * 64 + kv * 8; }, 32,
               [&](int kt) __attribute__((always_inline)) {
                 if (kt == 8 || kt == 16) {
#pragma unroll
                   for (int i = 0; i < 2; ++i)
#pragma unroll
                     for (int r = 0; r < 16; ++r) {
                       const float f = sScale[(wr * 64 + i * 32 + crow(r, fh)) * 2 + (kt == 16 ? 1 : 0)];
                       acc[i][0][r] *= f; acc[i][1][r] *= f; acc[i][2][r] *= f; acc[i][3][r] *= f;
                     }
                 }
               });
    {
      const int row0 = mt * 128;
      const int vv = row0 >> 12;
      float* xnew = p.out + (size_t)row0 * 1024;
      const float* xold = (l == 0) ? (p.x + (size_t)row0 * 1024) : xnew;
#pragma unroll 1
      for (int sub = 0; sub < 2; ++sub) {
        const int nt = nt2 * 2 + sub;
        const float* gate = mods + (l * 5 + vv) * 3072 + 2048 + nt * 128;
        epilogue_lds2w(acc, smem, sub, [&](int rl, int c8, float4 lo, float4 hi) {
          const int off = rl * 1024 + nt * 128 + c8;
          const float4 x0 = *(const float4*)(xold + off), x1 = *(const float4*)(xold + off + 4);
          const float4 g0 = *(const float4*)(gate + c8), g1 = *(const float4*)(gate + c8 + 4);
          float4 o0, o1;
          o0.x = x0.x + g0.x * lo.x; o0.y = x0.y + g0.y * lo.y; o0.z = x0.z + g0.z * lo.z; o0.w = x0.w + g0.w * lo.w;
          o1.x = x1.x + g1.x * hi.x; o1.y = x1.y + g1.y * hi.y; o1.z = x1.z + g1.z * hi.z; o1.w = x1.w + g1.w * hi.w;
          *(float4*)(xnew + off) = o0;
          *(float4*)(xnew + off + 4) = o1;
        });
      }
    }
  }
  const int nctx = (l == 0) ? 64 : 0;
  for (int it = (int)blockIdx.x; it < nctx; it += gridDim.x) {
    const int mt = 128 + (it >> 3), nt = it & 7;
    f32x16 acc[2][2];
    zero_acc(acc);
    const bf16_t* Wb = W + (size_t)nt * 128 * 2048;
    const bf16_t* A0 = Zb + (size_t)mt * 128 * 1024;
    const bf16_t* A2 = Qb + (size_t)mt * 128 * 512;
    const bf16_t* A3 = Cb + (size_t)mt * 128 * 512;
    float* sScale = (float*)(smem + 40960);
    if (tid < 128) {
      const size_t row = (size_t)(mt * 128 + tid);
      const float r0 = rsqrtf(RSTD[row * 2] * (1.f / 512.f) + 1e-6f);
      const float r1 = rsqrtf(RSTD[row * 2 + 1] * (1.f / 512.f) + 1e-6f);
      sScale[tid * 2] = r0 / r1;
      sScale[tid * 2 + 1] = r1;
    }
    gemm_core2(acc, (GemmS2*)smem,
               [&](int kt, int r, int kv) {
                 const bf16_t* ptr;
                 if (kt < 16) ptr = A0 + (size_t)r * 1024 + kt * 64;
                 else if (kt < 24) ptr = A2 + (size_t)r * 512 + (kt - 16) * 64;
                 else ptr = A3 + (size_t)r * 512 + (kt - 24) * 64;
                 return ptr + kv * 8;
               },
               [&](int kt, int r, int kv) { return Wb + (size_t)r * 2048 + kt * 64 + kv * 8; }, 32,
               [&](int kt) __attribute__((always_inline)) {
                 if (kt == 8 || kt == 16) {
#pragma unroll
                   for (int i = 0; i < 2; ++i)
#pragma unroll
                     for (int r = 0; r < 16; ++r) {
                       const float f = sScale[(wr * 64 + i * 32 + crow(r, fh)) * 2 + (kt == 16 ? 1 : 0)];
                       acc[i][0][r] *= f; acc[i][1][r] *= f;
                     }
                 }
               });
    {
      const int row0 = mt * 128;
      const int vv = (row0 < RL_) ? (row0 >> 12) : 4;
      const float* gate = mods + (l * 5 + vv) * 3072 + 2048 + nt * 128;
      float* xnew = (row0 < RL_) ? (p.out + (size_t)row0 * 1024) : (XC + (size_t)(row0 - RL_) * 1024);
      const float* xold = (l == 0) ? ((row0 < RL_) ? (p.x + (size_t)row0 * 1024) : (p.ctx + (size_t)(row0 - RL_) * 1024)) : xnew;
      epilogue_lds(acc, smem, [&](int rl, int c4, float4 v) {
        const int off = rl * 1024 + nt * 128 + c4;
        const float4 xo = *(const float4*)(xold + off);
        const float4 gt = *(const float4*)(gate + c4);
        float4 o;
        o.x = xo.x + gt.x * v.x; o.y = xo.y + gt.y * v.y; o.z = xo.z + gt.z * v.z; o.w = xo.w + gt.w * v.w;
        *(float4*)(xnew + off) = o;
      });
    }
  }
  if (l == 0) {
    const int local = blockIdx.x >> 3, xcd = blockIdx.x & 7, nloc = gridDim.x >> 3;
    if (local >= 8 && nloc > 8) {
      const int nb = (nloc - 8) * 8;
      const int NT_WIN = 88 * 16, NT_PW = 64;
      for (int it = (local - 8) * 8 + xcd; it < NT_WIN + NT_PW; it += nb) {
        if (it < NT_WIN) transpose_tile(p.w_in + (size_t)1024 * 5408, 5408, 0, nullptr, (bf16_t*)(p.ws + OFF_WIN), 1024, (it / 16) * 64, (it % 16) * 64, (float*)smem);
        else { const int t = it - NT_WIN; transpose_tile(p.conv_pw_w + (size_t)512 * 512, 512, 1, nullptr, (bf16_t*)(p.ws + OFF_PW), 512, (t / 8) * 64, (t % 8) * 64, (float*)smem); }
      }
    }
  }
}

DI void phase_final(const Params& p_in) {
  const Params p = load_params();
  const int lane = threadIdx.x & 63, wave = threadIdx.x >> 6;
  for (int it = blockIdx.x; it < RL_ / 8; it += gridDim.x) {
    float* xr0 = p.out + (size_t)(it * 8 + wave * 2) * 1024;
    float4 xv[2][4];
#pragma unroll
    for (int q = 0; q < 2; ++q)
#pragma unroll
      for (int i = 0; i < 4; ++i) xv[q][i] = *(const float4*)(xr0 + q * 1024 + lane * 4 + i * 256);
    float4 w[4];
#pragma unroll
    for (int i = 0; i < 4; ++i) w[i] = *(const float4*)(p.final_norm_w + lane * 4 + i * 256);
#pragma unroll
    for (int q = 0; q < 2; ++q) {
      float ss = 0.f;
#pragma unroll
      for (int i = 0; i < 4; ++i) ss += xv[q][i].x * xv[q][i].x + xv[q][i].y * xv[q][i].y + xv[q][i].z * xv[q][i].z + xv[q][i].w * xv[q][i].w;
#pragma unroll
      for (int o = 32; o >= 1; o >>= 1) ss += __shfl_xor(ss, o);
      const float rs = rsqrtf(ss * (1.f / 1024.f) + 1e-6f);
#pragma unroll
      for (int i = 0; i < 4; ++i) {
        float4 o;
        o.x = xv[q][i].x * rs * w[i].x; o.y = xv[q][i].y * rs * w[i].y; o.z = xv[q][i].z * rs * w[i].z; o.w = xv[q][i].w * rs * w[i].w;
        *(float4*)(xr0 + q * 1024 + lane * 4 + i * 256) = o;
      }
    }
  }
}

template <int PH>
DI void run_phase(const Params& p, char* smem) {
  constexpr int l = (PH - 1) / 7, s = (PH - 1) % 7;
  if constexpr (PH == 0) phase_mods(p, smem);
  else if constexpr (PH == 15) phase_final(p);
  else if constexpr (s == 0) phase_prep(p, l, smem);
  else if constexpr (s == 1) phase_inproj(p, smem);
  else if constexpr (s == 2) phase_local(p, l, smem);
  else if constexpr (s == 3) phase_mix(p, l, smem);
  else if constexpr (s == 4) phase_scan(p);
  else if constexpr (s == 5) phase_ssdy(p, l, smem);
  else phase_outproj(p, l, smem);
}

#if PROBE_S >= 0
#define PROBE_BEGIN() if (threadIdx.x == 0) pst[1] = wall_clock64();
#define PROBE_END(PH) if (threadIdx.x == 0 && (PH) >= 1 && (PH) <= 14 && (((PH) - 1) % 7) == PROBE_S) pst[0] += wall_clock64() - pst[1];
#else
#define PROBE_BEGIN()
#define PROBE_END(PH)
#endif
#define PHASE(PH) PROBE_BEGIN() run_phase<PH>(p, smem); xcd_barrier(xst); PROBE_END(PH)

__global__ void __launch_bounds__(256, 2) fwd_megakernel(Params p) {
  __shared__ __attribute__((aligned(16))) char smem[57344];
  cg::grid_group grid = cg::this_grid();
  if (threadIdx.x == 0) g_kernarg = (unsigned long long)__builtin_amdgcn_kernarg_segment_ptr();
  __syncthreads();
#if PROBE_S >= 0
  volatile unsigned long long* pst = (volatile unsigned long long*)(smem + 57344 - 16);
  if (threadIdx.x == 0) { pst[0] = 0; pst[1] = 0; }
#endif
  __shared__ uint4 xb_words;
  volatile LAS unsigned* xst = (volatile LAS unsigned*)&xb_words;
  if (threadIdx.x == 0) xb_words = make_uint4(0u, 0u, 0u, 0u);
  if (threadIdx.x == 0) { unsigned* bar = (unsigned*)(load_params().ws + OFF_BAR); (void)xb_add(&bar[XB_XCNT(xb_xcc_id())], 1u); }
  run_phase<0>(p, smem);
  if (load_params().out == nullptr) grid.sync();
  xcd_barrier(xst);
  PHASE(1) PHASE(2) PHASE(3) PHASE(4) PHASE(5) PHASE(6) PHASE(7)
  PHASE(8) PHASE(9) PHASE(10) PHASE(11) PHASE(12) PHASE(13) PHASE(14)
  run_phase<15>(p, smem);
#if PROBE_S >= 0
  if (blockIdx.x == 0 && threadIdx.x == 0) {
    const unsigned long long t1 = wall_clock64();
    const unsigned long long lim = 4ull * pst[0];
    while (wall_clock64() - t1 < lim) { __builtin_amdgcn_s_sleep(32); }
  }
#endif
}

extern "C" void kernel_launch(void* const* d_in, const int* in_sizes, int n_in, void* d_out, int out_size, void* d_ws,
                              size_t ws_size, hipStream_t stream) {
  static int grid_blocks = 0;
  if (!grid_blocks) {
    int dev = 0, cus = 0, per_cu = 0;
    hipGetDevice(&dev);
    hipDeviceGetAttribute(&cus, hipDeviceAttributeMultiprocessorCount, dev);
    hipOccupancyMaxActiveBlocksPerMultiprocessor(&per_cu, fwd_megakernel, 256, 0);
    if (per_cu < 1) per_cu = 1;
    if (per_cu > 2) per_cu = 2;
    grid_blocks = (cus * per_cu) & ~7;
  }
  Params p{};
  const float** pp = (const float**)&p;
  for (int i = 0; i < 23; ++i) pp[i] = (const float*)d_in[i];
  p.out = (float*)d_out;
  p.ws = (char*)d_ws;
  (void)hipMemsetAsync((char*)d_ws + OFF_BAR, 0, XCD_BAR_WORDS * 4, stream);
  void* args[] = {&p};
  hipError_t e = hipLaunchCooperativeKernel((void*)fwd_megakernel, dim3(grid_blocks), dim3(256), args, 0, stream);
  if (e != hipSuccess) fprintf(stderr, "cooperative launch failed: %s (grid %d)\n", hipGetErrorString(e), grid_blocks);
}
```
